# Optimizing an MI355X kernel written in HIP

```python
import math
import jax, jax.numpy as jnp
from jax import lax
import numpy as np

D_MODEL = 1024
BATCH = 8
SEQ = 2048
DEPTH = 1
DEC_BATCH = 32
DEC_SEQ = 1
PAST_LEN = 16384
PAGE_SIZE = 128

PLE_DIM = 256
GDN_HEADS = 8
GDN_DK = 64
GDN_DV = 64
GDN_WIDTH = GDN_HEADS * GDN_DV
GDN_QK_DIM = GDN_HEADS * GDN_DK
CONV_WIDTH = 4
CONV_DIM = 2 * GDN_QK_DIM + GDN_WIDTH
GDN_CHUNK = 64
MLA_HEADS = 8
MLA_NOPE = 64
MLA_ROPE = 32
MLA_VDIM = 64
MLA_QK = MLA_NOPE + MLA_ROPE
MLA_WIDTH = MLA_HEADS * MLA_VDIM
Q_LORA = 384
KV_LORA = 256
ROPE_THETA = 10000.0
ATTN_SCALE = MLA_QK ** -0.5
Q_BLOCK = 128
MIX_WIDTH = GDN_WIDTH + MLA_WIDTH
D_FF = -(-8 * D_MODEL // (3 * 256)) * 256
IN_SPLITS = (CONV_DIM, CONV_DIM + GDN_HEADS, CONV_DIM + 2 * GDN_HEADS,
             CONV_DIM + 2 * GDN_HEADS + GDN_WIDTH,
             CONV_DIM + 2 * GDN_HEADS + GDN_WIDTH + Q_LORA)
IN_DIM = IN_SPLITS[-1] + KV_LORA + MLA_ROPE
EPS = 1e-6

kernel_name = 'hybrid_gdn_mla_parallel_heads_step'


def rmsnorm(x, g):
    xf = x.astype(jnp.float32)
    y = xf * lax.rsqrt(jnp.mean(xf * xf, axis=-1, keepdims=True) + EPS)
    return (y * g.astype(jnp.float32)).astype(x.dtype)


def l2norm(x):
    xf = x.astype(jnp.float32)
    return xf * lax.rsqrt(jnp.sum(xf * xf, axis=-1, keepdims=True) + EPS)


def rope_tables(pos):
    half = MLA_ROPE // 2
    inv_freq = ROPE_THETA ** (-jnp.arange(half, dtype=jnp.float32) / half)
    ang = pos.astype(jnp.float32)[:, None] * inv_freq[None, :]
    return jnp.cos(ang), jnp.sin(ang)


def apply_rope(x, cos, sin):
    extra = x.ndim - 3
    c = cos.reshape(cos.shape[:1] + (1,) * extra + cos.shape[1:])
    s = sin.reshape(sin.shape[:1] + (1,) * extra + sin.shape[1:])
    xf = x.astype(jnp.float32)
    half = MLA_ROPE // 2
    x1, x2 = xf[..., :half], xf[..., half:]
    return jnp.concatenate([x1 * c - x2 * s, x1 * s + x2 * c], axis=-1).astype(x.dtype)


def split_in(z):
    return jnp.split(z, list(IN_SPLITS), axis=-1)


def causal_conv(ext, w):
    s = ext.shape[1] - (CONV_WIDTH - 1)
    y = ext[:, 0:s] * w[0]
    for j in range(1, CONV_WIDTH):
        y = y + ext[:, j:j + s] * w[j]
    return jax.nn.silu(y)


def gdn_prep(conv_out, a, b, a_log, dt_bias):
    bsz, s, _ = conv_out.shape
    q = l2norm(conv_out[..., :GDN_QK_DIM].reshape(bsz, s, GDN_HEADS, GDN_DK)) * (GDN_DK ** -0.5)
    k = l2norm(conv_out[..., GDN_QK_DIM:2 * GDN_QK_DIM].reshape(bsz, s, GDN_HEADS, GDN_DK))
    v = conv_out[..., 2 * GDN_QK_DIM:].reshape(bsz, s, GDN_HEADS, GDN_DV).astype(jnp.float32)
    g = -jnp.exp(a_log.astype(jnp.float32)) * jax.nn.softplus(a.astype(jnp.float32) + dt_bias.astype(jnp.float32))
    beta = jax.nn.sigmoid(b.astype(jnp.float32))
    return q, k, v, g, beta


def gdn_chunked(q, k, v, g, beta):
    bsz, s, h, dk = k.shape
    dv = v.shape[-1]
    c = GDN_CHUNK
    n = s // c

    def to_chunks(t):
        return jnp.moveaxis(t.reshape((bsz, n, c, h) + t.shape[3:]), 3, 1)

    q, k, v, g, beta = [to_chunks(t) for t in (q, k, v, g, beta)]
    gc = jnp.cumsum(g, axis=-1)
    tril = jnp.tril(jnp.ones((c, c), bool))
    strict = jnp.tril(jnp.ones((c, c), bool), -1)
    decay = jnp.exp(jnp.where(tril, gc[..., :, None] - gc[..., None, :], -jnp.inf))
    kb = k * beta[..., None]
    vb = v * beta[..., None]
    a_mat = jnp.where(strict, jnp.einsum('bhncd,bhnsd->bhncs', kb, k) * decay, 0.0)
    eye = jnp.eye(c, dtype=jnp.float32)
    t_inv = lax.linalg.triangular_solve(a_mat + eye, jnp.broadcast_to(eye, a_mat.shape), left_side=True, lower=True)
    u = t_inv @ vb
    w = t_inv @ (kb * jnp.exp(gc)[..., None])
    qk = jnp.einsum('bhncd,bhnsd->bhncs', q, k) * decay
    xs = tuple(jnp.moveaxis(t, 2, 0) for t in (q, k, u, w, gc, qk))

    def step(state, inp):
        q_c, k_c, u_c, w_c, g_c, qk_c = inp
        v_new = u_c - jnp.einsum('bhcd,bhde->bhce', w_c, state)
        o = jnp.einsum('bhcd,bhde->bhce', q_c * jnp.exp(g_c)[..., None], state) + jnp.einsum('bhcs,bhse->bhce', qk_c, v_new)
        g_last = g_c[..., -1]
        state = state * jnp.exp(g_last)[..., None, None] + jnp.einsum(
            'bhcd,bhce->bhde', k_c * jnp.exp(g_last[..., None] - g_c)[..., None], v_new)
        return state, o

    s0 = jnp.zeros((bsz, h, dk, dv), jnp.float32)
    s_fin, o = lax.scan(step, s0, xs)
    o = jnp.moveaxis(o, 0, 2).reshape(bsz, h, s, dv).transpose(0, 2, 1, 3)
    return o, s_fin


def gdn_recurrent(q, k, v, g, beta, s0):
    xs = tuple(jnp.moveaxis(t, 1, 0) for t in (q, k, v, g, beta))

    def step(state, inp):
        q_t, k_t, v_t, g_t, b_t = inp
        state = state * jnp.exp(g_t)[..., None, None]
        delta = (v_t - jnp.einsum('bhd,bhde->bhe', k_t, state)) * b_t[..., None]
        state = state + jnp.einsum('bhd,bhe->bhde', k_t, delta)
        return state, jnp.einsum('bhd,bhde->bhe', q_t, state)

    s_fin, o = lax.scan(step, s0.astype(jnp.float32), xs)
    return jnp.moveaxis(o, 0, 1), s_fin


def gdn_output(o, z, g_out):
    bsz, s = o.shape[:2]
    gate = jax.nn.silu(z.astype(jnp.float32).reshape(bsz, s, GDN_HEADS, GDN_DV))
    return (rmsnorm(o, g_out) * gate).reshape(bsz, s, GDN_WIDTH)


def mla_project(qa, kva, cos, sin, g_q_a, w_q_b, g_q_nope, g_q_rope, g_kv_a, g_k_rope):
    bsz, s = qa.shape[:2]
    q = (rmsnorm(qa, g_q_a) @ w_q_b).reshape(bsz, s, MLA_HEADS, MLA_QK)
    q_nope = rmsnorm(q[..., :MLA_NOPE], g_q_nope)
    q_rope = apply_rope(rmsnorm(q[..., MLA_NOPE:], g_q_rope), cos, sin)
    c_kv = rmsnorm(kva[..., :KV_LORA], g_kv_a)
    k_rope = apply_rope(rmsnorm(kva[..., KV_LORA:], g_k_rope), cos, sin)
    return q_nope, q_rope, c_kv, k_rope


def mla_expand(c_kv, w_kv_b, g_k_nope):
    kv = (c_kv @ w_kv_b).reshape(c_kv.shape[:-1] + (MLA_HEADS, MLA_NOPE + MLA_VDIM))
    return rmsnorm(kv[..., :MLA_NOPE], g_k_nope), kv[..., MLA_NOPE:]


def mla_prompt_attention(q_nope, q_rope, k_nope, k_rope, v):
    bsz, s, h, _ = q_nope.shape
    nb = s // Q_BLOCK
    qn = jnp.moveaxis(q_nope.reshape(bsz, nb, Q_BLOCK, h, MLA_NOPE), 1, 0)
    qr = jnp.moveaxis(q_rope.reshape(bsz, nb, Q_BLOCK, h, MLA_ROPE), 1, 0)
    key_pos = jnp.arange(s)
    kn = k_nope.astype(jnp.float32)
    kr = k_rope.astype(jnp.float32)
    vf = v.astype(jnp.float32)

    def block(args):
        qn_b, qr_b, i = args
        sc = (jnp.einsum('bqhd,bkhd->bhqk', qn_b.astype(jnp.float32), kn)
              + jnp.einsum('bqhd,bkd->bhqk', qr_b.astype(jnp.float32), kr)) * ATTN_SCALE
        qpos = i * Q_BLOCK + jnp.arange(Q_BLOCK)
        sc = jnp.where(qpos[:, None] >= key_pos[None, :], sc, -jnp.inf)
        p = jax.nn.softmax(sc, axis=-1)
        return jnp.einsum('bhqk,bkhd->bqhd', p, vf)

    o = lax.map(block, (qn, qr, jnp.arange(nb)))
    return jnp.moveaxis(o, 0, 1).reshape(bsz, s, h * MLA_VDIM)


def mla_sample_attention(q_nope, q_rope, ckv_new, kr_new, ckv_pool, kr_pool, page_table, w_kv_b, g_k_nope):
    bsz, t, h, _ = q_nope.shape
    qn = q_nope.astype(jnp.float32)
    qr = q_rope.astype(jnp.float32)

    def scores(k_nope, k_rope):
        return (jnp.einsum('bqhd,bkhd->bhqk', qn, k_nope.astype(jnp.float32))
                + jnp.einsum('bqhd,bkd->bhqk', qr, k_rope.astype(jnp.float32))) * ATTN_SCALE

    kn, vv = mla_expand(ckv_new, w_kv_b, g_k_nope)
    causal = jnp.tril(jnp.ones((t, t), bool))
    sc = jnp.where(causal, scores(kn, kr_new), -jnp.inf)
    m = sc.max(axis=-1)
    p = jnp.exp(sc - m[..., None])
    l = p.sum(axis=-1)
    acc = jnp.einsum('bhqk,bkhd->bhqd', p, vv.astype(jnp.float32))

    def page_step(carry, pages):
        m, l, acc = carry
        kn_p, v_p = mla_expand(ckv_pool[pages], w_kv_b, g_k_nope)
        sc_p = scores(kn_p, kr_pool[pages])
        m_new = jnp.maximum(m, sc_p.max(axis=-1))
        alpha = jnp.exp(m - m_new)
        p_p = jnp.exp(sc_p - m_new[..., None])
        l = l * alpha + p_p.sum(axis=-1)
        acc = acc * alpha[..., None] + jnp.einsum('bhqk,bkhd->bhqd', p_p, v_p.astype(jnp.float32))
        return (m_new, l, acc), None

    (m, l, acc), _ = lax.scan(page_step, (m, l, acc), page_table.T)
    o = acc / l[..., None]
    return o.transpose(0, 2, 1, 3).reshape(bsz, t, h * MLA_VDIM)


def layer_tail(h, o_mix, p, w_o, g_ffn, w_ffn_gate, w_ffn_up, w_ffn_down, g_ple, w_ple_gate, w_ple_proj):
    h = h + o_mix.astype(h.dtype) @ w_o
    u = rmsnorm(h, g_ffn)
    h = h + (jax.nn.silu(u @ w_ffn_gate) * (u @ w_ffn_up)) @ w_ffn_down
    gate = jax.nn.sigmoid(rmsnorm(h, g_ple) @ w_ple_gate)
    return h + (p.astype(h.dtype) @ w_ple_proj) * gate


def setup_inputs(seed: int = 0) -> dict:
    key = jax.random.key(seed)
    k = jax.random.split(key, 32)

    def nrm(i, shape, scale):
        return jax.random.normal(k[i], shape, jnp.float32) * scale

    def gain(i, n):
        return 1.0 + 0.02 * jax.random.normal(k[i], (DEPTH, n), jnp.float32)

    n_pages = PAST_LEN // PAGE_SIZE
    n_used = DEC_BATCH * n_pages
    n_phys = n_used + (n_used + 3) // 4
    page_table = jax.random.permutation(k[6], n_phys)[:n_used].reshape(DEC_BATCH, n_pages).astype(jnp.int32)
    a_log = jnp.log(jax.random.uniform(k[12], (DEPTH, GDN_HEADS), jnp.float32, 1.0, 16.0))
    dt = jnp.exp(jax.random.uniform(k[13], (DEPTH, GDN_HEADS), jnp.float32, math.log(1e-3), math.log(1e-1)))
    dt_bias = dt + jnp.log(-jnp.expm1(-dt))
    return {
        'x_prompt': nrm(0, (BATCH, SEQ, D_MODEL), 1.0),
        'x_sample': nrm(1, (DEC_BATCH, DEC_SEQ, D_MODEL), 1.0),
        'cache_ckv': nrm(2, (DEPTH, n_phys, PAGE_SIZE, KV_LORA), 1.0),
        'cache_krope': nrm(3, (DEPTH, n_phys, PAGE_SIZE, MLA_ROPE), 1.0),
        'state_gdn': nrm(4, (DEPTH, DEC_BATCH, GDN_HEADS, GDN_DK, GDN_DV), 0.1),
        'state_conv': nrm(5, (DEPTH, DEC_BATCH, CONV_WIDTH - 1, CONV_DIM), 1.0),
        'page_table': page_table,
        'p_prompt': nrm(7, (DEPTH, BATCH, SEQ, PLE_DIM), 1.0),
        'p_sample': nrm(8, (DEPTH, DEC_BATCH, DEC_SEQ, PLE_DIM), 1.0),
        'g_attn': gain(9, D_MODEL),
        'w_in': nrm(10, (DEPTH, D_MODEL, IN_DIM), D_MODEL ** -0.5),
        'w_conv': nrm(11, (DEPTH, CONV_WIDTH, CONV_DIM), CONV_WIDTH ** -0.5),
        'gdn_a_log': a_log,
        'gdn_dt_bias': dt_bias,
        'g_gdn_out': gain(14, GDN_DV),
        'g_q_a': gain(15, Q_LORA),
        'w_q_b': nrm(16, (DEPTH, Q_LORA, MLA_HEADS * MLA_QK), Q_LORA ** -0.5),
        'g_q_nope': gain(17, MLA_NOPE),
        'g_q_rope': gain(18, MLA_ROPE),
        'g_kv_a': gain(19, KV_LORA),
        'g_k_rope': gain(20, MLA_ROPE),
        'w_kv_b': nrm(21, (DEPTH, KV_LORA, MLA_HEADS * (MLA_NOPE + MLA_VDIM)), KV_LORA ** -0.5),
        'g_k_nope': gain(22, MLA_NOPE),
        'w_o': nrm(23, (DEPTH, MIX_WIDTH, D_MODEL), MIX_WIDTH ** -0.5),
        'g_ffn': gain(24, D_MODEL),
        'w_ffn_gate': nrm(25, (DEPTH, D_MODEL, D_FF), D_MODEL ** -0.5),
        'w_ffn_up': nrm(26, (DEPTH, D_MODEL, D_FF), D_MODEL ** -0.5),
        'w_ffn_down': nrm(27, (DEPTH, D_FF, D_MODEL), D_FF ** -0.5),
        'g_ple': gain(28, D_MODEL),
        'w_ple_gate': nrm(29, (DEPTH, D_MODEL, D_MODEL), D_MODEL ** -0.5),
        'w_ple_proj': nrm(30, (DEPTH, PLE_DIM, D_MODEL), PLE_DIM ** -0.5),
    }


def reference(x_prompt, x_sample, cache_ckv, cache_krope, state_gdn, state_conv, page_table,
              p_prompt, p_sample, g_attn, w_in, w_conv, gdn_a_log, gdn_dt_bias, g_gdn_out,
              g_q_a, w_q_b, g_q_nope, g_q_rope, g_kv_a, g_k_rope, w_kv_b, g_k_nope, w_o,
              g_ffn, w_ffn_gate, w_ffn_up, w_ffn_down, g_ple, w_ple_gate, w_ple_proj):
    bp, seq, _ = x_prompt.shape
    bs, dec_seq, _ = x_sample.shape
    past = page_table.shape[1] * cache_ckv.shape[2]
    cos_p, sin_p = rope_tables(jnp.arange(seq))
    cos_s, sin_s = rope_tables(past + jnp.arange(dec_seq))
    hp, hs = x_prompt, x_sample
    ckv_p_l, kr_p_l, gdn_p_l, conv_p_l = [], [], [], []
    ckv_s_l, kr_s_l, gdn_s_l, conv_s_l = [], [], [], []
    for i in range(DEPTH):
        conv_in, a, b, z, qa, kva = split_in(rmsnorm(hp, g_attn[i]) @ w_in[i])
        ext = jnp.concatenate([jnp.zeros((bp, CONV_WIDTH - 1, CONV_DIM), conv_in.dtype), conv_in], axis=1)
        q, k, v, g, beta = gdn_prep(causal_conv(ext, w_conv[i]), a, b, gdn_a_log[i], gdn_dt_bias[i])
        o_g, s_fin = gdn_chunked(q, k, v, g, beta)
        o_gdn = gdn_output(o_g, z, g_gdn_out[i])
        q_nope, q_rope, ckv, kr = mla_project(qa, kva, cos_p, sin_p, g_q_a[i], w_q_b[i], g_q_nope[i],
                                              g_q_rope[i], g_kv_a[i], g_k_rope[i])
        k_nope, v_mla = mla_expand(ckv, w_kv_b[i], g_k_nope[i])
        o_mla = mla_prompt_attention(q_nope, q_rope, k_nope, kr, v_mla)
        hp = layer_tail(hp, jnp.concatenate([o_gdn, o_mla.astype(o_gdn.dtype)], axis=-1), p_prompt[i], w_o[i],
                        g_ffn[i], w_ffn_gate[i], w_ffn_up[i], w_ffn_down[i], g_ple[i], w_ple_gate[i], w_ple_proj[i])
        ckv_p_l.append(ckv)
        kr_p_l.append(kr)
        gdn_p_l.append(s_fin)
        conv_p_l.append(ext[:, -(CONV_WIDTH - 1):])
        conv_in, a, b, z, qa, kva = split_in(rmsnorm(hs, g_attn[i]) @ w_in[i])
        ext = jnp.concatenate([state_conv[i].astype(conv_in.dtype), conv_in], axis=1)
        q, k, v, g, beta = gdn_prep(causal_conv(ext, w_conv[i]), a, b, gdn_a_log[i], gdn_dt_bias[i])
        o_g, s_fin = gdn_recurrent(q, k, v, g, beta, state_gdn[i])
        o_gdn = gdn_output(o_g, z, g_gdn_out[i])
        q_nope, q_rope, ckv, kr = mla_project(qa, kva, cos_s, sin_s, g_q_a[i], w_q_b[i], g_q_nope[i],
                                              g_q_rope[i], g_kv_a[i], g_k_rope[i])
        o_mla = mla_sample_attention(q_nope, q_rope, ckv, kr, cache_ckv[i], cache_krope[i], page_table,
                                     w_kv_b[i], g_k_nope[i])
        hs = layer_tail(hs, jnp.concatenate([o_gdn, o_mla.astype(o_gdn.dtype)], axis=-1), p_sample[i], w_o[i],
                        g_ffn[i], w_ffn_gate[i], w_ffn_up[i], w_ffn_down[i], g_ple[i], w_ple_gate[i], w_ple_proj[i])
        ckv_s_l.append(ckv)
        kr_s_l.append(kr)
        gdn_s_l.append(s_fin)
        conv_s_l.append(ext[:, -(CONV_WIDTH - 1):])
    y_prompt = hp
    y_sample = hs
    ckv_prompt = jnp.stack(ckv_p_l)
    krope_prompt = jnp.stack(kr_p_l)
    gdn_state_prompt = jnp.stack(gdn_p_l)
    conv_state_prompt = jnp.stack(conv_p_l)
    ckv_sample = jnp.stack(ckv_s_l)
    krope_sample = jnp.stack(kr_s_l)
    gdn_state_sample = jnp.stack(gdn_s_l)
    conv_state_sample = jnp.stack(conv_s_l)
    return (y_prompt, y_sample, ckv_prompt, krope_prompt, gdn_state_prompt, conv_state_prompt,
            ckv_sample, krope_sample, gdn_state_sample, conv_state_sample)
```

```cpp
#include <hip/hip_runtime.h>
#include <stdint.h>
#include <cstdio>

typedef unsigned short bf16_t;
typedef short bf16x8 __attribute__((ext_vector_type(8)));
typedef float f32x4 __attribute__((ext_vector_type(4)));

#define DMODEL 1024
#define NPT 16384
#define NST 32
#define NTOK 16416
#define MPAD 16640
#define SEQ 2048
#define ZW 2816
#define OFF_A 1536
#define OFF_B 1544
#define OFF_Z 1552
#define OFF_QA 2064
#define OFF_KVA 2448
#define OFF_KR 2704
#define DFF 2816
#define PAST 16384
#define NPAGES 128
#define EPSV 1e-6f

#define O_YP 0
#define O_YS (O_YP + 16777216)
#define O_CKVP (O_YS + 32768)
#define O_KRP (O_CKVP + 4194304)
#define O_GSP (O_KRP + 524288)
#define O_CSP (O_GSP + 262144)
#define O_CKVS (O_CSP + 36864)
#define O_KRS (O_CKVS + 8192)
#define O_GSS (O_KRS + 1024)
#define O_CSS (O_GSS + 1048576)

__device__ __forceinline__ bf16_t f2bf(float f) { unsigned u = __float_as_uint(f); return (bf16_t)((u + 0x7fffu + ((u >> 16) & 1u)) >> 16); }
__device__ __forceinline__ float bf2f(bf16_t b) { return __uint_as_float(((unsigned)b) << 16); }
__device__ __forceinline__ float wave_sum(float v) {
#pragma unroll
    for (int o = 1; o < 64; o <<= 1) v += __shfl_xor(v, o);
    return v;
}
__device__ __forceinline__ float sigmoidf_(float x) { return 1.f / (1.f + expf(-x)); }
__device__ __forceinline__ float siluf_(float x) { return x / (1.f + expf(-x)); }

__global__ void k_wt(const float* __restrict__ W, bf16_t* __restrict__ Wt, int ldw, int col0, int N, int ldt) {
    __shared__ float t[32][33];
    const int n0 = blockIdx.x * 32, k0 = blockIdx.y * 32;
    for (int i = threadIdx.y; i < 32; i += 8) {
        const int k = k0 + i, n = n0 + threadIdx.x; float v = 0.f;
        if (n < N) v = W[(size_t)k * ldw + col0 + n];
        t[i][threadIdx.x] = v;
    }
    __syncthreads();
    for (int i = threadIdx.y; i < 32; i += 8) { const int n = n0 + i, k = k0 + threadIdx.x; Wt[(size_t)n * ldt + k] = f2bf(t[threadIdx.x][i]); }
}

__global__ void k_rms1024(const float* __restrict__ xp, const float* __restrict__ xs, const float* __restrict__ g, bf16_t* __restrict__ out) {
    const int row = blockIdx.x * 4 + (threadIdx.x >> 6), lane = threadIdx.x & 63;
    bf16_t* o = out + (size_t)row * 1024;
    if (row >= NTOK) { for (int j = 0; j < 4; ++j) { ushort4 z = {0, 0, 0, 0}; *(ushort4*)(o + lane * 4 + 256 * j) = z; } return; }
    const float* src = (xs == nullptr) ? xp + (size_t)row * 1024 : (row < NPT ? xp + (size_t)row * 1024 : xs + (size_t)(row - NPT) * 1024);
    float4 v[4]; float ss = 0.f;
#pragma unroll
    for (int j = 0; j < 4; ++j) { v[j] = *(const float4*)(src + lane * 4 + 256 * j); ss += v[j].x * v[j].x + v[j].y * v[j].y + v[j].z * v[j].z + v[j].w * v[j].w; }
    ss = wave_sum(ss);
    const float rs = rsqrtf(ss * (1.f / 1024.f) + EPSV);
#pragma unroll
    for (int j = 0; j < 4; ++j) {
        const float4 gg = *(const float4*)(g + lane * 4 + 256 * j);
        ushort4 w; w.x = f2bf(v[j].x * rs * gg.x); w.y = f2bf(v[j].y * rs * gg.y); w.z = f2bf(v[j].z * rs * gg.z); w.w = f2bf(v[j].w * rs * gg.w);
        *(ushort4*)(o + lane * 4 + 256 * j) = w;
    }
}
__global__ void k_prep_p(const float* __restrict__ pp, const float* __restrict__ ps, bf16_t* __restrict__ out) {
    const int row = blockIdx.x * 4 + (threadIdx.x >> 6), lane = threadIdx.x & 63;
    bf16_t* o = out + (size_t)row * 256 + lane * 4;
    ushort4 w = {0, 0, 0, 0};
    if (row < NTOK) { const float* src = row < NPT ? pp + (size_t)row * 256 : ps + (size_t)(row - NPT) * 256; const float4 v = *(const float4*)(src + lane * 4); w.x = f2bf(v.x); w.y = f2bf(v.y); w.z = f2bf(v.z); w.w = f2bf(v.w); }
    *(ushort4*)o = w;
}

struct ABf16 { const bf16_t* p; int lda; int pad; __device__ __forceinline__ bf16x8 load(int m, int k) const { return *(const bf16x8*)(p + (size_t)m * lda + k); } };
struct ACache {
    const float* cache; const int* pt;
    __device__ __forceinline__ bf16x8 load(int m, int k) const {
        const int b = m >> 14, t = m & 16383; const int phys = pt[b * NPAGES + (t >> 7)];
        const float* r = cache + ((size_t)phys * 128 + (t & 127)) * 256 + k;
        const float4 a = *(const float4*)r, c = *(const float4*)(r + 4);
        bf16x8 o; o[0] = (short)f2bf(a.x); o[1] = (short)f2bf(a.y); o[2] = (short)f2bf(a.z); o[3] = (short)f2bf(a.w);
        o[4] = (short)f2bf(c.x); o[5] = (short)f2bf(c.y); o[6] = (short)f2bf(c.z); o[7] = (short)f2bf(c.w); return o;
    }
};
template <class AL, class Epi>
__global__ __launch_bounds__(256) void k_gemm(AL al, const bf16_t* __restrict__ Bt, int ldb, int K, Epi epi) {
    __shared__ __attribute__((aligned(16))) bf16_t sA[128][40];
    __shared__ __attribute__((aligned(16))) bf16_t sB[128][40];
    const int tid = threadIdx.x, lane = tid & 63, wid = tid >> 6, wm = wid >> 1, wn = wid & 1;
    const int m0 = blockIdx.y * 128, n0 = blockIdx.x * 128;
    f32x4 acc[4][4];
#pragma unroll
    for (int i = 0; i < 4; ++i)
#pragma unroll
        for (int j = 0; j < 4; ++j) acc[i][j] = (f32x4){0.f, 0.f, 0.f, 0.f};
    for (int k0 = 0; k0 < K; k0 += 32) {
#pragma unroll
        for (int i = 0; i < 2; ++i) {
            const int ch = tid + 256 * i, r = ch >> 2, kc = (ch & 3) * 8;
            *(bf16x8*)&sA[r][kc] = al.load(m0 + r, k0 + kc);
            *(bf16x8*)&sB[r][kc] = *(const bf16x8*)(Bt + (size_t)(n0 + r) * ldb + k0 + kc);
        }
        __syncthreads();
        bf16x8 af[4], bfr[4];
#pragma unroll
        for (int i = 0; i < 4; ++i) af[i] = *(const bf16x8*)&sA[wm * 64 + i * 16 + (lane & 15)][(lane >> 4) * 8];
#pragma unroll
        for (int j = 0; j < 4; ++j) bfr[j] = *(const bf16x8*)&sB[wn * 64 + j * 16 + (lane & 15)][(lane >> 4) * 8];
#pragma unroll
        for (int i = 0; i < 4; ++i)
#pragma unroll
            for (int j = 0; j < 4; ++j) acc[i][j] = __builtin_amdgcn_mfma_f32_16x16x32_bf16(af[i], bfr[j], acc[i][j], 0, 0, 0);
        __syncthreads();
    }
#pragma unroll
    for (int i = 0; i < 4; ++i)
#pragma unroll
        for (int j = 0; j < 4; ++j)
#pragma unroll
            for (int r = 0; r < 4; ++r) epi(m0 + wm * 64 + i * 16 + (lane >> 4) * 4 + r, n0 + wn * 64 + j * 16 + (lane & 15), acc[i][j][r]);
}
struct EpiF32 { float* C; int ldc; int pad; __device__ __forceinline__ void operator()(int m, int n, float v) const { C[(size_t)m * ldc + n] = v; } };
struct EpiBf16 { bf16_t* C; int ldc; int pad; __device__ __forceinline__ void operator()(int m, int n, float v) const { C[(size_t)m * ldc + n] = f2bf(v); } };
struct EpiResX {
    const float* xp; const float* xs; float* C;
    __device__ __forceinline__ void operator()(int m, int n, float v) const {
        if (m >= NTOK) return;
        const float x = m < NPT ? xp[(size_t)m * 1024 + n] : xs[(size_t)(m - NPT) * 1024 + n];
        C[(size_t)m * 1024 + n] = x + v;
    }
};
struct EpiSwiglu { const float* G; bf16_t* Hd; __device__ __forceinline__ void operator()(int m, int n, float v) const { const float gq = G[(size_t)m * DFF + n]; Hd[(size_t)m * DFF + n] = f2bf(siluf_(gq) * v); } };
struct EpiResH { const float* H; float* C; __device__ __forceinline__ void operator()(int m, int n, float v) const { if (m >= NTOK) return; C[(size_t)m * 1024 + n] = H[(size_t)m * 1024 + n] + v; } };
struct EpiPle {
    const float* H2; const float* PP; float* out;
    __device__ __forceinline__ void operator()(int m, int n, float v) const {
        if (m >= NTOK) return;
        const float y = H2[(size_t)m * 1024 + n] + PP[(size_t)m * 1024 + n] * sigmoidf_(v);
        if (m < NPT) out[O_YP + (size_t)m * 1024 + n] = y; else out[O_YS + (size_t)(m - NPT) * 1024 + n] = y;
    }
};

struct PostInArgs {
    const float* Z; const float* w_conv; const float* state_conv; const float* a_log; const float* dt_bias;
    const float* g_q_a; const float* g_kv_a; const float* g_k_rope;
    float* qf; float* kf; float* vf; float* gg; float* bb; bf16_t* qan; bf16_t* ckvb; float* krf; float* out;
};
__global__ __launch_bounds__(256) void k_post_in(PostInArgs a) {
    __shared__ float red[8];
    const int row = blockIdx.x, tid = threadIdx.x, lane = tid & 63, wid = tid >> 6;
    const bool samp = row >= NPT;
    const int b = samp ? row - NPT : row >> 11, t = samp ? 0 : row & 2047;
    const float* z = a.Z + (size_t)row * ZW;
#pragma unroll
    for (int i = 0; i < 6; ++i) {
        const int c = tid + 256 * i;
        float e0, e1, e2, e3;
        e3 = z[c];
        if (samp) { e0 = a.state_conv[((size_t)b * 3 + 0) * 1536 + c]; e1 = a.state_conv[((size_t)b * 3 + 1) * 1536 + c]; e2 = a.state_conv[((size_t)b * 3 + 2) * 1536 + c]; }
        else {
            e0 = t >= 3 ? a.Z[(size_t)(row - 3) * ZW + c] : 0.f;
            e1 = t >= 2 ? a.Z[(size_t)(row - 2) * ZW + c] : 0.f;
            e2 = t >= 1 ? a.Z[(size_t)(row - 1) * ZW + c] : 0.f;
        }
        float y = e0 * a.w_conv[c] + e1 * a.w_conv[1536 + c] + e2 * a.w_conv[2 * 1536 + c] + e3 * a.w_conv[3 * 1536 + c];
        y = siluf_(y);
        if (samp) { a.out[O_CSS + ((size_t)b * 3 + 0) * 1536 + c] = e1; a.out[O_CSS + ((size_t)b * 3 + 1) * 1536 + c] = e2; a.out[O_CSS + ((size_t)b * 3 + 2) * 1536 + c] = e3; }
        else if (t >= SEQ - 3) a.out[O_CSP + ((size_t)b * 3 + (t - (SEQ - 3))) * 1536 + c] = e3;
        const int sec = c >> 9, cc = c & 511;
        if (sec == 2) a.vf[(size_t)row * 512 + cc] = y;
        else {
            const float ss = wave_sum(y * y);
            const float r = rsqrtf(ss + EPSV);
            if (sec == 0) a.qf[(size_t)row * 512 + cc] = y * r * 0.125f; else a.kf[(size_t)row * 512 + cc] = y * r;
        }
    }
    if (tid < 8) {
        const float av = z[OFF_A + tid], bv = z[OFF_B + tid];
        const float xx = av + a.dt_bias[tid];
        const float sp = xx > 20.f ? xx : log1pf(expf(xx));
        a.gg[(size_t)row * 8 + tid] = -expf(a.a_log[tid]) * sp;
        a.bb[(size_t)row * 8 + tid] = sigmoidf_(bv);
    }
    {
        const float v0 = z[OFF_QA + tid], v1 = tid < 128 ? z[OFF_QA + 256 + tid] : 0.f;
        float ss = wave_sum(v0 * v0 + v1 * v1);
        if (lane == 0) red[wid] = ss;
        __syncthreads();
        ss = red[0] + red[1] + red[2] + red[3];
        const float rs = rsqrtf(ss * (1.f / 384.f) + EPSV);
        a.qan[(size_t)row * 384 + tid] = f2bf(v0 * rs * a.g_q_a[tid]);
        if (tid < 128) a.qan[(size_t)row * 384 + 256 + tid] = f2bf(v1 * rs * a.g_q_a[256 + tid]);
    }
    {
        const float v = z[OFF_KVA + tid];
        float ss = wave_sum(v * v);
        if (lane == 0) red[4 + wid] = ss;
        __syncthreads();
        ss = red[4] + red[5] + red[6] + red[7];
        const float rs = rsqrtf(ss * (1.f / 256.f) + EPSV);
        const float o = v * rs * a.g_kv_a[tid];
        a.ckvb[(size_t)row * 256 + tid] = f2bf(o);
        if (samp) a.out[O_CKVS + (size_t)b * 256 + tid] = o; else a.out[O_CKVP + (size_t)row * 256 + tid] = o;
    }
    if (wid == 0) {
        const float v = lane < 32 ? z[OFF_KR + lane] : 0.f;
        const float ss = wave_sum(v * v);
        const float rs = rsqrtf(ss * (1.f / 32.f) + EPSV);
        const float xn = lane < 32 ? v * rs * a.g_k_rope[lane] : 0.f;
        const float other = __shfl_xor(xn, 16);
        const int i = lane & 15;
        const float pos = samp ? (float)PAST : (float)t;
        const float inv = powf(10000.f, -(float)i / 16.f);
        const float ang = pos * inv;
        const float cs = cosf(ang), sn = sinf(ang);
        const float o = lane < 16 ? xn * cs - other * sn : other * sn + xn * cs;
        if (lane < 32) {
            a.krf[(size_t)row * 32 + lane] = o;
            if (samp) a.out[O_KRS + (size_t)b * 32 + lane] = o; else a.out[O_KRP + (size_t)row * 32 + lane] = o;
        }
    }
}

__global__ __launch_bounds__(256) void k_post_q(const float* __restrict__ Q, const float* __restrict__ g_q_nope, const float* __restrict__ g_q_rope, float* __restrict__ qh) {
    const int idx = blockIdx.x * 4 + (threadIdx.x >> 6), lane = threadIdx.x & 63;
    const int row = idx >> 3, h = idx & 7;
    if (row >= NTOK) return;
    const float* q = Q + (size_t)row * 768 + h * 96;
    float* o = qh + ((size_t)row * 8 + h) * 96;
    const float v = q[lane];
    const float ss = wave_sum(v * v);
    o[lane] = v * rsqrtf(ss * (1.f / 64.f) + EPSV) * g_q_nope[lane];
    const float r = lane < 32 ? q[64 + lane] : 0.f;
    const float s2 = wave_sum(r * r);
    const float xn = lane < 32 ? r * rsqrtf(s2 * (1.f / 32.f) + EPSV) * g_q_rope[lane] : 0.f;
    const float other = __shfl_xor(xn, 16);
    const int i = lane & 15;
    const float pos = row >= NPT ? (float)PAST : (float)(row & 2047);
    const float ang = pos * powf(10000.f, -(float)i / 16.f);
    const float cs = cosf(ang), sn = sinf(ang);
    const float ov = lane < 16 ? xn * cs - other * sn : other * sn + xn * cs;
    if (lane < 32) o[64 + lane] = ov;
}
__global__ __launch_bounds__(256) void k_post_kv(const float* __restrict__ KV, const float* __restrict__ g_k_nope, float* __restrict__ kh) {
    const int idx = blockIdx.x * 4 + (threadIdx.x >> 6), lane = threadIdx.x & 63;
    const int row = idx >> 3, h = idx & 7;
    if (row >= NTOK) return;
    const float v = KV[(size_t)row * 1024 + h * 128 + lane];
    const float ss = wave_sum(v * v);
    kh[((size_t)row * 8 + h) * 64 + lane] = v * rsqrtf(ss * (1.f / 64.f) + EPSV) * g_k_nope[lane];
}

__global__ __launch_bounds__(64) void k_attn_prompt(const float* __restrict__ qh, const float* __restrict__ kh, const float* __restrict__ krf, const float* __restrict__ KV, bf16_t* __restrict__ omix) {
    __shared__ __attribute__((aligned(16))) float sK[32][96];
    __shared__ __attribute__((aligned(16))) float sV[32][64];
    const int qb = 31 - (blockIdx.x & 31), h = (blockIdx.x >> 5) & 7, b = blockIdx.x >> 8, lane = threadIdx.x;
    const int qi = qb * 64 + lane; const size_t row = (size_t)b * SEQ + qi;
    float q[96], o[64];
    const float scale = 0.10206207261596577f;
#pragma unroll
    for (int d = 0; d < 96; ++d) q[d] = qh[(row * 8 + h) * 96 + d] * scale;
#pragma unroll
    for (int d = 0; d < 64; ++d) o[d] = 0.f;
    float m = -INFINITY, l = 0.f;
    const int nkt = (qb * 64 + 64) / 32;
    for (int kt = 0; kt < nkt; ++kt) {
        __syncthreads();
        for (int e = lane; e < 32 * 96; e += 64) { const int j = e / 96, d = e % 96; const size_t kr = (size_t)b * SEQ + kt * 32 + j; sK[j][d] = d < 64 ? kh[(kr * 8 + h) * 64 + d] : krf[kr * 32 + (d - 64)]; }
        for (int e = lane; e < 32 * 64; e += 64) { const int j = e >> 6, d = e & 63; const size_t kr = (size_t)b * SEQ + kt * 32 + j; sV[j][d] = KV[kr * 1024 + h * 128 + 64 + d]; }
        __syncthreads();
        float s[32]; float tm = -INFINITY;
#pragma unroll
        for (int j = 0; j < 32; ++j) {
            float acc = 0.f;
#pragma unroll
            for (int d = 0; d < 96; d += 4) { const float4 kk = *(const float4*)&sK[j][d]; acc += q[d] * kk.x + q[d + 1] * kk.y + q[d + 2] * kk.z + q[d + 3] * kk.w; }
            if (kt * 32 + j > qi) acc = -INFINITY;
            s[j] = acc; tm = fmaxf(tm, acc);
        }
        const float mn = fmaxf(m, tm);
        const float alpha = expf(m - mn);
        l *= alpha;
#pragma unroll
        for (int d = 0; d < 64; ++d) o[d] *= alpha;
#pragma unroll
        for (int j = 0; j < 32; ++j) {
            const float p = expf(s[j] - mn); l += p;
#pragma unroll
            for (int d = 0; d < 64; d += 4) { const float4 vv = *(const float4*)&sV[j][d]; o[d] += p * vv.x; o[d + 1] += p * vv.y; o[d + 2] += p * vv.z; o[d + 3] += p * vv.w; }
        }
        m = mn;
    }
    const float il = 1.f / l;
#pragma unroll
    for (int d = 0; d < 64; ++d) omix[row * 1024 + 512 + h * 64 + d] = f2bf(o[d] * il);
}

__global__ __launch_bounds__(64) void k_gdn(const float* __restrict__ qf, const float* __restrict__ kf, const float* __restrict__ vf, const float* __restrict__ gg, const float* __restrict__ bb,
                                            const float* __restrict__ Z, const float* __restrict__ g_out, const float* __restrict__ s0, float* __restrict__ sout, bf16_t* __restrict__ omix, int row0, int T) {
    __shared__ float sq[16][64], sk[16][64];
    const int b = blockIdx.x >> 3, h = blockIdx.x & 7, e = threadIdx.x;
    float S[64];
#pragma unroll
    for (int d = 0; d < 64; ++d) S[d] = s0 ? s0[(((size_t)b * 8 + h) * 64 + d) * 64 + e] : 0.f;
    const float go = g_out[e];
    for (int t0 = 0; t0 < T; t0 += 16) {
        const int nt = (T - t0) < 16 ? (T - t0) : 16;
        __syncthreads();
        for (int j = 0; j < nt; ++j) { const size_t r = (size_t)row0 + (size_t)b * T + t0 + j; sq[j][e] = qf[r * 512 + h * 64 + e]; sk[j][e] = kf[r * 512 + h * 64 + e]; }
        __syncthreads();
        for (int j = 0; j < nt; ++j) {
            const size_t r = (size_t)row0 + (size_t)b * T + t0 + j;
            const float v = vf[r * 512 + h * 64 + e], g = gg[r * 8 + h], be = bb[r * 8 + h];
            const float dec = expf(g);
            float ks = 0.f;
#pragma unroll
            for (int d = 0; d < 64; ++d) { S[d] *= dec; ks += sk[j][d] * S[d]; }
            const float delta = (v - ks) * be;
            float ov = 0.f;
#pragma unroll
            for (int d = 0; d < 64; ++d) { S[d] += sk[j][d] * delta; ov += sq[j][d] * S[d]; }
            const float ss = wave_sum(ov * ov);
            const float on = ov * rsqrtf(ss * (1.f / 64.f) + EPSV) * go;
            const float zg = Z[r * ZW + OFF_Z + h * 64 + e];
            omix[r * 1024 + h * 64 + e] = f2bf(on * siluf_(zg));
        }
    }
#pragma unroll
    for (int d = 0; d < 64; ++d) sout[(((size_t)b * 8 + h) * 64 + d) * 64 + e] = S[d];
}

__global__ __launch_bounds__(256) void k_samp_scores(const bf16_t* __restrict__ KN, const float* __restrict__ kr_pool, const int* __restrict__ pt, const float* __restrict__ qh,
                                                     const float* __restrict__ g_k_nope, float* __restrict__ SC) {
    const int m = blockIdx.x * 4 + (threadIdx.x >> 6), lane = threadIdx.x & 63;
    const int b = m >> 14, t = m & 16383, h = lane >> 3, ch = lane & 7;
    const bf16x8 kv = *(const bf16x8*)(KN + (size_t)m * 512 + h * 64 + ch * 8);
    const float* q = qh + ((size_t)(NPT + b) * 8 + h) * 96;
    float ss = 0.f, dot = 0.f;
#pragma unroll
    for (int j = 0; j < 8; ++j) { const float x = bf2f((bf16_t)kv[j]); ss += x * x; dot += x * g_k_nope[ch * 8 + j] * q[ch * 8 + j]; }
    const int phys = pt[b * NPAGES + (t >> 7)];
    const float* kr = kr_pool + ((size_t)phys * 128 + (t & 127)) * 32 + ch * 4;
    float rd = 0.f;
#pragma unroll
    for (int j = 0; j < 4; ++j) rd += kr[j] * q[64 + ch * 4 + j];
#pragma unroll
    for (int o = 1; o < 8; o <<= 1) { ss += __shfl_xor(ss, o); dot += __shfl_xor(dot, o); rd += __shfl_xor(rd, o); }
    if (ch == 0) SC[((size_t)b * 8 + h) * PAST + t] = (dot * rsqrtf(ss * (1.f / 64.f) + EPSV) + rd) * 0.10206207261596577f;
}
__global__ __launch_bounds__(256) void k_samp_part(const float* __restrict__ SC, const float* __restrict__ cache, const int* __restrict__ pt, float* __restrict__ part) {
    __shared__ float sm[8], sp[64][8];
    const int b = blockIdx.x >> 3, sp_i = blockIdx.x & 7, tid = threadIdx.x, lane = tid & 63, wid = tid >> 6;
    const int t0 = sp_i * 2048;
    for (int hh = 0; hh < 2; ++hh) {
        const int h = wid + 4 * hh; float mx = -INFINITY;
        for (int t = lane; t < 2048; t += 64) mx = fmaxf(mx, SC[((size_t)b * 8 + h) * PAST + t0 + t]);
#pragma unroll
        for (int o = 1; o < 64; o <<= 1) mx = fmaxf(mx, __shfl_xor(mx, o));
        if (lane == 0) sm[h] = mx;
    }
    __syncthreads();
    float lat[8], lsum = 0.f;
#pragma unroll
    for (int h = 0; h < 8; ++h) lat[h] = 0.f;
    for (int tc = 0; tc < 2048; tc += 64) {
        __syncthreads();
        for (int e = tid; e < 512; e += 256) { const int j = e >> 3, h = e & 7; sp[j][h] = expf(SC[((size_t)b * 8 + h) * PAST + t0 + tc + j] - sm[h]); }
        __syncthreads();
        if (tid < 8) { for (int j = 0; j < 64; ++j) lsum += sp[j][tid]; }
        const int phys = pt[b * NPAGES + ((t0 + tc) >> 7)];
        const float* base = cache + ((size_t)phys * 128 + ((t0 + tc) & 127)) * 256 + tid;
        for (int j = 0; j < 64; ++j) {
            const float cv = base[(size_t)j * 256];
#pragma unroll
            for (int h = 0; h < 8; ++h) lat[h] += sp[j][h] * cv;
        }
    }
    float* o = part + (size_t)blockIdx.x * 8 * 258;
#pragma unroll
    for (int h = 0; h < 8; ++h) o[h * 258 + 2 + tid] = lat[h];
    if (tid < 8) { o[tid * 258 + 0] = sm[tid]; o[tid * 258 + 1] = lsum; }
}
__global__ __launch_bounds__(256) void k_samp_comb(const float* __restrict__ part, const float* __restrict__ qh, const float* __restrict__ kh, const float* __restrict__ krf, const float* __restrict__ KV,
                                                   const float* __restrict__ w_kv_b, bf16_t* __restrict__ omix) {
    __shared__ float slat[256];
    const int b = blockIdx.x >> 3, h = blockIdx.x & 7, tid = threadIdx.x;
    const size_t row = NPT + b;
    const float* q = qh + (row * 8 + h) * 96;
    float s_self = 0.f;
    for (int d = 0; d < 64; ++d) s_self += q[d] * kh[(row * 8 + h) * 64 + d];
    for (int d = 0; d < 32; ++d) s_self += q[64 + d] * krf[row * 32 + d];
    s_self *= 0.10206207261596577f;
    float m = s_self;
    for (int s = 0; s < 8; ++s) m = fmaxf(m, part[((size_t)(b * 8 + s) * 8 + h) * 258]);
    const float pself = expf(s_self - m);
    float l = pself, lat = 0.f;
    for (int s = 0; s < 8; ++s) {
        const float* p = part + ((size_t)(b * 8 + s) * 8 + h) * 258;
        const float w = expf(p[0] - m);
        l += p[1] * w; lat += p[2 + tid] * w;
    }
    slat[tid] = lat;
    __syncthreads();
    if (tid < 64) {
        float o = 0.f;
        for (int c = 0; c < 256; ++c) o += slat[c] * w_kv_b[(size_t)c * 1024 + h * 128 + 64 + tid];
        o += pself * KV[row * 1024 + h * 128 + 64 + tid];
        omix[row * 1024 + 512 + h * 64 + tid] = f2bf(o / l);
    }
}
__global__ void k_zero_pad(bf16_t* omix) {
    const size_t i = (size_t)blockIdx.x * 256 + threadIdx.x;
    omix[(size_t)NTOK * 1024 + i] = 0;
}

static inline char* carve(char*& p, size_t bytes) { char* r = p; p += (bytes + 255) & ~(size_t)255; return r; }

extern "C" void kernel_launch(void* const* d_in, const int* in_sizes, int n_in, void* d_out, int out_size, void* d_ws, size_t ws_size, hipStream_t stream) {
    const float* x_prompt = (const float*)d_in[0]; const float* x_sample = (const float*)d_in[1];
    const float* cache_ckv = (const float*)d_in[2]; const float* cache_krope = (const float*)d_in[3];
    const float* state_gdn = (const float*)d_in[4]; const float* state_conv = (const float*)d_in[5];
    const int* page_table = (const int*)d_in[6];
    const float* p_prompt = (const float*)d_in[7]; const float* p_sample = (const float*)d_in[8];
    const float* g_attn = (const float*)d_in[9]; const float* w_in = (const float*)d_in[10]; const float* w_conv = (const float*)d_in[11];
    const float* a_log = (const float*)d_in[12]; const float* dt_bias = (const float*)d_in[13]; const float* g_gdn_out = (const float*)d_in[14];
    const float* g_q_a = (const float*)d_in[15]; const float* w_q_b = (const float*)d_in[16]; const float* g_q_nope = (const float*)d_in[17];
    const float* g_q_rope = (const float*)d_in[18]; const float* g_kv_a = (const float*)d_in[19]; const float* g_k_rope = (const float*)d_in[20];
    const float* w_kv_b = (const float*)d_in[21]; const float* g_k_nope = (const float*)d_in[22]; const float* w_o = (const float*)d_in[23];
    const float* g_ffn = (const float*)d_in[24]; const float* w_gate = (const float*)d_in[25]; const float* w_up = (const float*)d_in[26];
    const float* w_down = (const float*)d_in[27]; const float* g_ple = (const float*)d_in[28]; const float* w_ple_gate = (const float*)d_in[29];
    const float* w_ple_proj = (const float*)d_in[30];
    float* out = (float*)d_out;

    char* p = (char*)d_ws;
    bf16_t* WinT = (bf16_t*)carve(p, (size_t)ZW * 1024 * 2);
    bf16_t* WqbT = (bf16_t*)carve(p, (size_t)768 * 384 * 2);
    bf16_t* WkvT = (bf16_t*)carve(p, (size_t)1024 * 256 * 2);
    bf16_t* WknT = (bf16_t*)carve(p, (size_t)512 * 256 * 2);
    bf16_t* WoT = (bf16_t*)carve(p, (size_t)1024 * 1024 * 2);
    bf16_t* WgT = (bf16_t*)carve(p, (size_t)DFF * 1024 * 2);
    bf16_t* WuT = (bf16_t*)carve(p, (size_t)DFF * 1024 * 2);
    bf16_t* WdT = (bf16_t*)carve(p, (size_t)1024 * DFF * 2);
    bf16_t* WpgT = (bf16_t*)carve(p, (size_t)1024 * 1024 * 2);
    bf16_t* WppT = (bf16_t*)carve(p, (size_t)1024 * 256 * 2);
    bf16_t* xn = (bf16_t*)carve(p, (size_t)MPAD * 1024 * 2);
    bf16_t* pb = (bf16_t*)carve(p, (size_t)MPAD * 256 * 2);
    float* Z = (float*)carve(p, (size_t)MPAD * ZW * 4);
    float* qf = (float*)carve(p, (size_t)MPAD * 512 * 4);
    float* kf = (float*)carve(p, (size_t)MPAD * 512 * 4);
    float* vf = (float*)carve(p, (size_t)MPAD * 512 * 4);
    float* gg = (float*)carve(p, (size_t)MPAD * 8 * 4);
    float* bb = (float*)carve(p, (size_t)MPAD * 8 * 4);
    bf16_t* qan = (bf16_t*)carve(p, (size_t)MPAD * 384 * 2);
    bf16_t* ckvb = (bf16_t*)carve(p, (size_t)MPAD * 256 * 2);
    float* krf = (float*)carve(p, (size_t)MPAD * 32 * 4);
    float* Q = (float*)carve(p, (size_t)MPAD * 768 * 4);
    float* qh = (float*)carve(p, (size_t)MPAD * 768 * 4);
    float* KV = (float*)carve(p, (size_t)MPAD * 1024 * 4);
    float* kh = (float*)carve(p, (size_t)MPAD * 512 * 4);
    bf16_t* omix = (bf16_t*)carve(p, (size_t)MPAD * 1024 * 2);
    bf16_t* KN = (bf16_t*)carve(p, (size_t)NST * PAST * 512 * 2);
    float* SC = (float*)carve(p, (size_t)NST * 8 * PAST * 4);
    float* part = (float*)carve(p, (size_t)NST * 8 * 8 * 258 * 4);
    float* H = (float*)carve(p, (size_t)MPAD * 1024 * 4);
    bf16_t* un = (bf16_t*)carve(p, (size_t)MPAD * 1024 * 2);
    float* G = (float*)carve(p, (size_t)MPAD * DFF * 4);
    bf16_t* hid = (bf16_t*)carve(p, (size_t)MPAD * DFF * 2);
    float* H2 = (float*)carve(p, (size_t)MPAD * 1024 * 4);
    bf16_t* un2 = (bf16_t*)carve(p, (size_t)MPAD * 1024 * 2);
    float* PP = (float*)carve(p, (size_t)MPAD * 1024 * 4);
    if ((size_t)(p - (char*)d_ws) > ws_size) { fprintf(stderr, "kernel_launch: workspace too small: need %zu have %zu\n", (size_t)(p - (char*)d_ws), ws_size); return; }

    const dim3 tb(32, 8);
    k_wt<<<dim3(ZW / 32, 1024 / 32), tb, 0, stream>>>(w_in, WinT, 2736, 0, 2736, 1024);
    k_wt<<<dim3(768 / 32, 384 / 32), tb, 0, stream>>>(w_q_b, WqbT, 768, 0, 768, 384);
    k_wt<<<dim3(1024 / 32, 256 / 32), tb, 0, stream>>>(w_kv_b, WkvT, 1024, 0, 1024, 256);
    for (int h = 0; h < 8; ++h) k_wt<<<dim3(64 / 32, 256 / 32), tb, 0, stream>>>(w_kv_b, WknT + (size_t)h * 64 * 256, 1024, h * 128, 64, 256);
    k_wt<<<dim3(1024 / 32, 1024 / 32), tb, 0, stream>>>(w_o, WoT, 1024, 0, 1024, 1024);
    k_wt<<<dim3(DFF / 32, 1024 / 32), tb, 0, stream>>>(w_gate, WgT, DFF, 0, DFF, 1024);
    k_wt<<<dim3(DFF / 32, 1024 / 32), tb, 0, stream>>>(w_up, WuT, DFF, 0, DFF, 1024);
    k_wt<<<dim3(1024 / 32, DFF / 32), tb, 0, stream>>>(w_down, WdT, 1024, 0, 1024, DFF);
    k_wt<<<dim3(1024 / 32, 1024 / 32), tb, 0, stream>>>(w_ple_gate, WpgT, 1024, 0, 1024, 1024);
    k_wt<<<dim3(1024 / 32, 256 / 32), tb, 0, stream>>>(w_ple_proj, WppT, 1024, 0, 1024, 256);
    k_rms1024<<<MPAD / 4, 256, 0, stream>>>(x_prompt, x_sample, g_attn, xn);
    k_prep_p<<<MPAD / 4, 256, 0, stream>>>(p_prompt, p_sample, pb);
    k_gemm<<<dim3(ZW / 128, MPAD / 128), 256, 0, stream>>>(ABf16{xn, 1024, 0}, WinT, 1024, 1024, EpiF32{Z, ZW, 0});
    PostInArgs pa{Z, w_conv, state_conv, a_log, dt_bias, g_q_a, g_kv_a, g_k_rope, qf, kf, vf, gg, bb, qan, ckvb, krf, out};
    k_post_in<<<NTOK, 256, 0, stream>>>(pa);
    k_gemm<<<dim3(768 / 128, MPAD / 128), 256, 0, stream>>>(ABf16{qan, 384, 0}, WqbT, 384, 384, EpiF32{Q, 768, 0});
    k_post_q<<<NTOK * 8 / 4, 256, 0, stream>>>(Q, g_q_nope, g_q_rope, qh);
    k_gemm<<<dim3(1024 / 128, MPAD / 128), 256, 0, stream>>>(ABf16{ckvb, 256, 0}, WkvT, 256, 256, EpiF32{KV, 1024, 0});
    k_post_kv<<<NTOK * 8 / 4, 256, 0, stream>>>(KV, g_k_nope, kh);
    k_zero_pad<<<(MPAD - NTOK) * 1024 / 256, 256, 0, stream>>>(omix);
    k_attn_prompt<<<8 * 8 * 32, 64, 0, stream>>>(qh, kh, krf, KV, omix);
    k_gdn<<<64, 64, 0, stream>>>(qf, kf, vf, gg, bb, Z, g_gdn_out, nullptr, out + O_GSP, omix, 0, SEQ);
    k_gdn<<<NST * 8, 64, 0, stream>>>(qf, kf, vf, gg, bb, Z, g_gdn_out, state_gdn, out + O_GSS, omix, NPT, 1);
    k_gemm<<<dim3(512 / 128, NST * PAST / 128), 256, 0, stream>>>(ACache{cache_ckv, page_table}, WknT, 256, 256, EpiBf16{KN, 512, 0});
    k_samp_scores<<<NST * PAST / 4, 256, 0, stream>>>(KN, cache_krope, page_table, qh, g_k_nope, SC);
    k_samp_part<<<NST * 8, 256, 0, stream>>>(SC, cache_ckv, page_table, part);
    k_samp_comb<<<NST * 8, 256, 0, stream>>>(part, qh, kh, krf, KV, w_kv_b, omix);
    k_gemm<<<dim3(1024 / 128, MPAD / 128), 256, 0, stream>>>(ABf16{omix, 1024, 0}, WoT, 1024, 1024, EpiResX{x_prompt, x_sample, H});
    k_rms1024<<<MPAD / 4, 256, 0, stream>>>(H, nullptr, g_ffn, un);
    k_gemm<<<dim3(DFF / 128, MPAD / 128), 256, 0, stream>>>(ABf16{un, 1024, 0}, WgT, 1024, 1024, EpiF32{G, DFF, 0});
    k_gemm<<<dim3(DFF / 128, MPAD / 128), 256, 0, stream>>>(ABf16{un, 1024, 0}, WuT, 1024, 1024, EpiSwiglu{G, hid});
    k_gemm<<<dim3(1024 / 128, MPAD / 128), 256, 0, stream>>>(ABf16{hid, DFF, 0}, WdT, DFF, DFF, EpiResH{H, H2});
    k_rms1024<<<MPAD / 4, 256, 0, stream>>>(H2, nullptr, g_ple, un2);
    k_gemm<<<dim3(1024 / 128, MPAD / 128), 256, 0, stream>>>(ABf16{pb, 256, 0}, WppT, 256, 256, EpiF32{PP, 1024, 0});
    k_gemm<<<dim3(1024 / 128, MPAD / 128), 256, 0, stream>>>(ABf16{un2, 1024, 0}, WpgT, 1024, 1024, EpiPle{H2, PP, out});
}
```

```cpp
#include <hip/hip_runtime.h>
#include <stdint.h>
#include <cstdio>
#include <hip/hip_cooperative_groups.h>
namespace cg = cooperative_groups;

typedef unsigned short bf16_t;
typedef short bf16x8 __attribute__((ext_vector_type(8)));
typedef float f32x4 __attribute__((ext_vector_type(4)));

#define DMODEL 1024
#define NPT 16384
#define NST 32
#define NTOK 16416
#define MPAD 16640
#define SEQ 2048
#define ZW 2816
#define OFF_A 1536
#define OFF_B 1544
#define OFF_Z 1552
#define OFF_QA 2064
#define OFF_KVA 2448
#define OFF_KR 2704
#define DFF 2816
#define PAST 16384
#define NPAGES 128
#define EPSV 1e-6f

#define O_YP 0
#define O_YS (O_YP + 16777216)
#define O_CKVP (O_YS + 32768)
#define O_KRP (O_CKVP + 4194304)
#define O_GSP (O_KRP + 524288)
#define O_CSP (O_GSP + 262144)
#define O_CKVS (O_CSP + 36864)
#define O_KRS (O_CKVS + 8192)
#define O_GSS (O_KRS + 1024)
#define O_CSS (O_GSS + 1048576)

__device__ __forceinline__ bf16_t f2bf(float f) { unsigned u = __float_as_uint(f); return (bf16_t)((u + 0x7fffu + ((u >> 16) & 1u)) >> 16); }
__device__ __forceinline__ float bf2f(bf16_t b) { return __uint_as_float(((unsigned)b) << 16); }
__device__ __forceinline__ float wave_sum(float v) {
#pragma unroll
    for (int o = 1; o < 64; o <<= 1) v += __shfl_xor(v, o);
    return v;
}
__device__ __forceinline__ float sigmoidf_(float x) { return 1.f / (1.f + expf(-x)); }
__device__ __forceinline__ float siluf_(float x) { return x / (1.f + expf(-x)); }


#define WSYNC() do { __builtin_amdgcn_fence(__ATOMIC_ACQ_REL, "wavefront"); __builtin_amdgcn_wave_barrier(); } while (0)

__device__ __forceinline__ void wt_tile(const float* __restrict__ W, bf16_t* __restrict__ Wt, int ldw, int col0, int N, int ldt, int nb_, int kb_, float* t  ) {
    const int tx = threadIdx.x & 31, ty = threadIdx.x >> 5;
    const int n0 = nb_ * 32, k0 = kb_ * 32;
    __syncthreads();
    for (int i = ty; i < 32; i += 8) {
        const int k = k0 + i, n = n0 + tx; float v = 0.f;
        if (n < N) v = W[(size_t)k * ldw + col0 + n];
        t[i * 33 + tx] = v;
    }
    __syncthreads();
    for (int i = ty; i < 32; i += 8) { const int n = n0 + i, k = k0 + tx; Wt[(size_t)n * ldt + k] = f2bf(t[tx * 33 + i]); }
}

__device__ __forceinline__ void rms1024_row(const float* __restrict__ src, const float* __restrict__ g, bf16_t* __restrict__ o, bool zero, int lane) {
    if (zero) { for (int j = 0; j < 4; ++j) { ushort4 z = {0, 0, 0, 0}; *(ushort4*)(o + lane * 4 + 256 * j) = z; } return; }
    float4 v[4]; float ss = 0.f;
#pragma unroll
    for (int j = 0; j < 4; ++j) { v[j] = *(const float4*)(src + lane * 4 + 256 * j); ss += v[j].x * v[j].x + v[j].y * v[j].y + v[j].z * v[j].z + v[j].w * v[j].w; }
    ss = wave_sum(ss);
    const float rs = rsqrtf(ss * (1.f / 1024.f) + EPSV);
#pragma unroll
    for (int j = 0; j < 4; ++j) {
        const float4 gg = *(const float4*)(g + lane * 4 + 256 * j);
        ushort4 w; w.x = f2bf(v[j].x * rs * gg.x); w.y = f2bf(v[j].y * rs * gg.y); w.z = f2bf(v[j].z * rs * gg.z); w.w = f2bf(v[j].w * rs * gg.w);
        *(ushort4*)(o + lane * 4 + 256 * j) = w;
    }
}

struct ABf16 { const bf16_t* p; int lda; __device__ __forceinline__ bf16x8 load(int m, int k) const { return *(const bf16x8*)(p + (size_t)m * lda + k); } };
struct ACache {
    const float* cache; const int* pt;
    __device__ __forceinline__ bf16x8 load(int m, int k) const {
        const int b = m >> 14, t = m & 16383; const int phys = pt[b * NPAGES + (t >> 7)];
        const float* r = cache + ((size_t)phys * 128 + (t & 127)) * 256 + k;
        const float4 a = *(const float4*)r, c = *(const float4*)(r + 4);
        bf16x8 o; o[0] = (short)f2bf(a.x); o[1] = (short)f2bf(a.y); o[2] = (short)f2bf(a.z); o[3] = (short)f2bf(a.w);
        o[4] = (short)f2bf(c.x); o[5] = (short)f2bf(c.y); o[6] = (short)f2bf(c.z); o[7] = (short)f2bf(c.w); return o;
    }
};
template <class AL, class Epi>
__device__ __forceinline__ void gemm_tile(const AL& al, const bf16_t* __restrict__ Bt, int ldb, int K, const Epi& epi, int m0, int n0, char* smem) {
    bf16_t (*sA)[40] = (bf16_t (*)[40])smem;
    bf16_t (*sB)[40] = (bf16_t (*)[40])(smem + 10240);
    const int tid = threadIdx.x, lane = tid & 63, wid = tid >> 6, wm = wid >> 1, wn = wid & 1;
    f32x4 acc[4][4];
#pragma unroll
    for (int i = 0; i < 4; ++i)
#pragma unroll
        for (int j = 0; j < 4; ++j) acc[i][j] = (f32x4){0.f, 0.f, 0.f, 0.f};
    __syncthreads();
    for (int k0 = 0; k0 < K; k0 += 32) {
#pragma unroll
        for (int i = 0; i < 2; ++i) {
            const int ch = tid + 256 * i, r = ch >> 2, kc = (ch & 3) * 8;
            *(bf16x8*)&sA[r][kc] = al.load(m0 + r, k0 + kc);
            *(bf16x8*)&sB[r][kc] = *(const bf16x8*)(Bt + (size_t)(n0 + r) * ldb + k0 + kc);
        }
        __syncthreads();
        bf16x8 af[4], bfr[4];
#pragma unroll
        for (int i = 0; i < 4; ++i) af[i] = *(const bf16x8*)&sA[wm * 64 + i * 16 + (lane & 15)][(lane >> 4) * 8];
#pragma unroll
        for (int j = 0; j < 4; ++j) bfr[j] = *(const bf16x8*)&sB[wn * 64 + j * 16 + (lane & 15)][(lane >> 4) * 8];
#pragma unroll
        for (int i = 0; i < 4; ++i)
#pragma unroll
            for (int j = 0; j < 4; ++j) acc[i][j] = __builtin_amdgcn_mfma_f32_16x16x32_bf16(af[i], bfr[j], acc[i][j], 0, 0, 0);
        __syncthreads();
    }
#pragma unroll
    for (int i = 0; i < 4; ++i)
#pragma unroll
        for (int j = 0; j < 4; ++j)
#pragma unroll
            for (int r = 0; r < 4; ++r) epi(m0 + wm * 64 + i * 16 + (lane >> 4) * 4 + r, n0 + wn * 64 + j * 16 + (lane & 15), acc[i][j][r]);
}
template <class AL, class Epi>
__device__ __forceinline__ void gemm_all(const AL& al, const bf16_t* __restrict__ Bt, int ldb, int M, int N, int K, const Epi& epi, char* smem, int vb0, int nvb) {
    const int nn = N / 128, nt = nn * (M / 128);
    for (int t = vb0; t < nt; t += nvb) gemm_tile(al, Bt, ldb, K, epi, (t / nn) * 128, (t % nn) * 128, smem);
}
struct EpiF32 { float* C; int ldc; __device__ __forceinline__ void operator()(int m, int n, float v) const { C[(size_t)m * ldc + n] = v; } };
struct EpiBf16 { bf16_t* C; int ldc; __device__ __forceinline__ void operator()(int m, int n, float v) const { C[(size_t)m * ldc + n] = f2bf(v); } };
struct EpiResX {
    const float* xp; const float* xs; float* C;
    __device__ __forceinline__ void operator()(int m, int n, float v) const {
        if (m >= NTOK) return;
        const float x = m < NPT ? xp[(size_t)m * 1024 + n] : xs[(size_t)(m - NPT) * 1024 + n];
        C[(size_t)m * 1024 + n] = x + v;
    }
};
struct EpiSwiglu { const float* G; bf16_t* Hd; __device__ __forceinline__ void operator()(int m, int n, float v) const { const float gq = G[(size_t)m * DFF + n]; Hd[(size_t)m * DFF + n] = f2bf(siluf_(gq) * v); } };
struct EpiResH { const float* H; float* C; __device__ __forceinline__ void operator()(int m, int n, float v) const { if (m >= NTOK) return; C[(size_t)m * 1024 + n] = H[(size_t)m * 1024 + n] + v; } };
struct EpiPle {
    const float* H2; const float* PP; float* out;
    __device__ __forceinline__ void operator()(int m, int n, float v) const {
        if (m >= NTOK) return;
        const float y = H2[(size_t)m * 1024 + n] + PP[(size_t)m * 1024 + n] * sigmoidf_(v);
        if (m < NPT) out[O_YP + (size_t)m * 1024 + n] = y; else out[O_YS + (size_t)(m - NPT) * 1024 + n] = y;
    }
};

struct MK {
    const float *x_prompt, *x_sample, *cache_ckv, *cache_krope, *state_gdn, *state_conv; const int* page_table; const float *p_prompt, *p_sample;
    const float *g_attn, *w_in, *w_conv, *a_log, *dt_bias, *g_gdn_out, *g_q_a, *w_q_b, *g_q_nope, *g_q_rope, *g_kv_a, *g_k_rope, *w_kv_b, *g_k_nope, *w_o, *g_ffn, *w_gate, *w_up, *w_down, *g_ple, *w_ple_gate, *w_ple_proj;
    float* out;
    bf16_t *WinT, *WqbT, *WkvT, *WknT, *WoT, *WgT, *WuT, *WdT, *WpgT, *WppT, *xn, *pb;
    float *Z, *qf, *kf, *vf, *gg, *bb; bf16_t *qan, *ckvb; float *krf, *Q, *qh, *KV, *kh; bf16_t *omix, *KN; float *SC, *part, *H; bf16_t* un; float* G; bf16_t* hid; float* H2; bf16_t* un2; float* PP;
};

__device__ __forceinline__ void post_in_row(const MK& a, int row, float* red) {
    const int tid = threadIdx.x, lane = tid & 63, wid = tid >> 6;
    const bool samp = row >= NPT;
    const int b = samp ? row - NPT : row >> 11, t = samp ? 0 : row & 2047;
    const float* z = a.Z + (size_t)row * ZW;
#pragma unroll
    for (int i = 0; i < 6; ++i) {
        const int c = tid + 256 * i;
        float e0, e1, e2, e3;
        e3 = z[c];
        if (samp) { e0 = a.state_conv[((size_t)b * 3 + 0) * 1536 + c]; e1 = a.state_conv[((size_t)b * 3 + 1) * 1536 + c]; e2 = a.state_conv[((size_t)b * 3 + 2) * 1536 + c]; }
        else {
            e0 = t >= 3 ? a.Z[(size_t)(row - 3) * ZW + c] : 0.f;
            e1 = t >= 2 ? a.Z[(size_t)(row - 2) * ZW + c] : 0.f;
            e2 = t >= 1 ? a.Z[(size_t)(row - 1) * ZW + c] : 0.f;
        }
        float y = e0 * a.w_conv[c] + e1 * a.w_conv[1536 + c] + e2 * a.w_conv[2 * 1536 + c] + e3 * a.w_conv[3 * 1536 + c];
        y = siluf_(y);
        if (samp) { a.out[O_CSS + ((size_t)b * 3 + 0) * 1536 + c] = e1; a.out[O_CSS + ((size_t)b * 3 + 1) * 1536 + c] = e2; a.out[O_CSS + ((size_t)b * 3 + 2) * 1536 + c] = e3; }
        else if (t >= SEQ - 3) a.out[O_CSP + ((size_t)b * 3 + (t - (SEQ - 3))) * 1536 + c] = e3;
        const int sec = c >> 9, cc = c & 511;
        if (sec == 2) a.vf[(size_t)row * 512 + cc] = y;
        else {
            const float ss = wave_sum(y * y);
            const float r = rsqrtf(ss + EPSV);
            if (sec == 0) a.qf[(size_t)row * 512 + cc] = y * r * 0.125f; else a.kf[(size_t)row * 512 + cc] = y * r;
        }
    }
    if (tid < 8) {
        const float av = z[OFF_A + tid], bv = z[OFF_B + tid];
        const float xx = av + a.dt_bias[tid];
        const float sp = xx > 20.f ? xx : log1pf(expf(xx));
        a.gg[(size_t)row * 8 + tid] = -expf(a.a_log[tid]) * sp;
        a.bb[(size_t)row * 8 + tid] = sigmoidf_(bv);
    }
    {
        const float v0 = z[OFF_QA + tid], v1 = tid < 128 ? z[OFF_QA + 256 + tid] : 0.f;
        float ss = wave_sum(v0 * v0 + v1 * v1);
        if (lane == 0) red[wid] = ss;
        __syncthreads();
        ss = red[0] + red[1] + red[2] + red[3];
        const float rs = rsqrtf(ss * (1.f / 384.f) + EPSV);
        a.qan[(size_t)row * 384 + tid] = f2bf(v0 * rs * a.g_q_a[tid]);
        if (tid < 128) a.qan[(size_t)row * 384 + 256 + tid] = f2bf(v1 * rs * a.g_q_a[256 + tid]);
    }
    {
        const float v = z[OFF_KVA + tid];
        float ss = wave_sum(v * v);
        if (lane == 0) red[4 + wid] = ss;
        __syncthreads();
        ss = red[4] + red[5] + red[6] + red[7];
        const float rs = rsqrtf(ss * (1.f / 256.f) + EPSV);
        const float o = v * rs * a.g_kv_a[tid];
        a.ckvb[(size_t)row * 256 + tid] = f2bf(o);
        if (samp) a.out[O_CKVS + (size_t)b * 256 + tid] = o; else a.out[O_CKVP + (size_t)row * 256 + tid] = o;
    }
    if (wid == 0) {
        const float v = lane < 32 ? z[OFF_KR + lane] : 0.f;
        const float ss = wave_sum(v * v);
        const float rs = rsqrtf(ss * (1.f / 32.f) + EPSV);
        const float xn = lane < 32 ? v * rs * a.g_k_rope[lane] : 0.f;
        const float other = __shfl_xor(xn, 16);
        const int i = lane & 15;
        const float pos = samp ? (float)PAST : (float)t;
        const float ang = pos * powf(10000.f, -(float)i / 16.f);
        const float cs = cosf(ang), sn = sinf(ang);
        const float o = lane < 16 ? xn * cs - other * sn : other * sn + xn * cs;
        if (lane < 32) {
            a.krf[(size_t)row * 32 + lane] = o;
            if (samp) a.out[O_KRS + (size_t)b * 32 + lane] = o; else a.out[O_KRP + (size_t)row * 32 + lane] = o;
        }
    }
}

__device__ __forceinline__ void post_q_item(const MK& a, int idx, int lane) {
    const int row = idx >> 3, h = idx & 7;
    const float* q = a.Q + (size_t)row * 768 + h * 96;
    float* o = a.qh + ((size_t)row * 8 + h) * 96;
    const float v = q[lane];
    const float ss = wave_sum(v * v);
    o[lane] = v * rsqrtf(ss * (1.f / 64.f) + EPSV) * a.g_q_nope[lane];
    const float r = lane < 32 ? q[64 + lane] : 0.f;
    const float s2 = wave_sum(r * r);
    const float xn = lane < 32 ? r * rsqrtf(s2 * (1.f / 32.f) + EPSV) * a.g_q_rope[lane] : 0.f;
    const float other = __shfl_xor(xn, 16);
    const int i = lane & 15;
    const float pos = row >= NPT ? (float)PAST : (float)(row & 2047);
    const float ang = pos * powf(10000.f, -(float)i / 16.f);
    const float cs = cosf(ang), sn = sinf(ang);
    const float ov = lane < 16 ? xn * cs - other * sn : other * sn + xn * cs;
    if (lane < 32) o[64 + lane] = ov;
}
__device__ __forceinline__ void post_kv_item(const MK& a, int idx, int lane) {
    const int row = idx >> 3, h = idx & 7;
    const float v = a.KV[(size_t)row * 1024 + h * 128 + lane];
    const float ss = wave_sum(v * v);
    a.kh[((size_t)row * 8 + h) * 64 + lane] = v * rsqrtf(ss * (1.f / 64.f) + EPSV) * a.g_k_nope[lane];
}

__device__ __forceinline__ void attn_unit(const MK& a, int u, int lane, char* wsm) {
    float (*sK)[96] = (float (*)[96])wsm;
    float (*sV)[64] = (float (*)[64])(wsm + 6144);
    const int qb = 31 - (u & 31), h = (u >> 5) & 7, b = u >> 8;
    const int qi = qb * 64 + lane; const size_t row = (size_t)b * SEQ + qi;
    float q[96], o[64];
    const float scale = 0.10206207261596577f;
#pragma unroll
    for (int d = 0; d < 96; ++d) q[d] = a.qh[(row * 8 + h) * 96 + d] * scale;
#pragma unroll
    for (int d = 0; d < 64; ++d) o[d] = 0.f;
    float m = -INFINITY, l = 0.f;
    const int nkt = (qb * 64 + 64) / 16;
    for (int kt = 0; kt < nkt; ++kt) {
        WSYNC();
        for (int e = lane; e < 16 * 96; e += 64) { const int j = e / 96, d = e % 96; const size_t kr = (size_t)b * SEQ + kt * 16 + j; sK[j][d] = d < 64 ? a.kh[(kr * 8 + h) * 64 + d] : a.krf[kr * 32 + (d - 64)]; }
        for (int e = lane; e < 16 * 64; e += 64) { const int j = e >> 6, d = e & 63; const size_t kr = (size_t)b * SEQ + kt * 16 + j; sV[j][d] = a.KV[kr * 1024 + h * 128 + 64 + d]; }
        WSYNC();
        float s[16]; float tm = -INFINITY;
#pragma unroll
        for (int j = 0; j < 16; ++j) {
            float acc = 0.f;
#pragma unroll
            for (int d = 0; d < 96; d += 4) { const float4 kk = *(const float4*)&sK[j][d]; acc += q[d] * kk.x + q[d + 1] * kk.y + q[d + 2] * kk.z + q[d + 3] * kk.w; }
            if (kt * 16 + j > qi) acc = -INFINITY;
            s[j] = acc; tm = fmaxf(tm, acc);
        }
        const float mn = fmaxf(m, tm);
        const float alpha = expf(m - mn);
        l *= alpha;
#pragma unroll
        for (int d = 0; d < 64; ++d) o[d] *= alpha;
#pragma unroll
        for (int j = 0; j < 16; ++j) {
            const float p = expf(s[j] - mn); l += p;
#pragma unroll
            for (int d = 0; d < 64; d += 4) { const float4 vv = *(const float4*)&sV[j][d]; o[d] += p * vv.x; o[d + 1] += p * vv.y; o[d + 2] += p * vv.z; o[d + 3] += p * vv.w; }
        }
        m = mn;
    }
    const float il = 1.f / l;
#pragma unroll
    for (int d = 0; d < 64; ++d) a.omix[row * 1024 + 512 + h * 64 + d] = f2bf(o[d] * il);
}

__device__ __forceinline__ void gdn_unit(const MK& a, int b, int h, const float* s0, float* sout, int row0, int T, int e, char* wsm) {
    float (*sq)[64] = (float (*)[64])wsm;
    float (*sk)[64] = (float (*)[64])(wsm + 4096);
    float S[64];
#pragma unroll
    for (int d = 0; d < 64; ++d) S[d] = s0 ? s0[(((size_t)b * 8 + h) * 64 + d) * 64 + e] : 0.f;
    const float go = a.g_gdn_out[e];
    for (int t0 = 0; t0 < T; t0 += 16) {
        const int nt = (T - t0) < 16 ? (T - t0) : 16;
        WSYNC();
        for (int j = 0; j < nt; ++j) { const size_t r = (size_t)row0 + (size_t)b * T + t0 + j; sq[j][e] = a.qf[r * 512 + h * 64 + e]; sk[j][e] = a.kf[r * 512 + h * 64 + e]; }
        WSYNC();
        for (int j = 0; j < nt; ++j) {
            const size_t r = (size_t)row0 + (size_t)b * T + t0 + j;
            const float v = a.vf[r * 512 + h * 64 + e], g = a.gg[r * 8 + h], be = a.bb[r * 8 + h];
            const float dec = expf(g);
            float ks = 0.f;
#pragma unroll
            for (int d = 0; d < 64; ++d) { S[d] *= dec; ks += sk[j][d] * S[d]; }
            const float delta = (v - ks) * be;
            float ov = 0.f;
#pragma unroll
            for (int d = 0; d < 64; ++d) { S[d] += sk[j][d] * delta; ov += sq[j][d] * S[d]; }
            const float ss = wave_sum(ov * ov);
            const float on = ov * rsqrtf(ss * (1.f / 64.f) + EPSV) * go;
            const float zg = a.Z[r * ZW + OFF_Z + h * 64 + e];
            a.omix[r * 1024 + h * 64 + e] = f2bf(on * siluf_(zg));
        }
    }
#pragma unroll
    for (int d = 0; d < 64; ++d) sout[(((size_t)b * 8 + h) * 64 + d) * 64 + e] = S[d];
}

__device__ __forceinline__ void samp_scores_item(const MK& a, int m, int lane) {
    const int b = m >> 14, t = m & 16383, h = lane >> 3, ch = lane & 7;
    const bf16x8 kv = *(const bf16x8*)(a.KN + (size_t)m * 512 + h * 64 + ch * 8);
    const float* q = a.qh + ((size_t)(NPT + b) * 8 + h) * 96;
    float ss = 0.f, dot = 0.f;
#pragma unroll
    for (int j = 0; j < 8; ++j) { const float x = bf2f((bf16_t)kv[j]); ss += x * x; dot += x * a.g_k_nope[ch * 8 + j] * q[ch * 8 + j]; }
    const int phys = a.page_table[b * NPAGES + (t >> 7)];
    const float* kr = a.cache_krope + ((size_t)phys * 128 + (t & 127)) * 32 + ch * 4;
    float rd = 0.f;
#pragma unroll
    for (int j = 0; j < 4; ++j) rd += kr[j] * q[64 + ch * 4 + j];
#pragma unroll
    for (int o = 1; o < 8; o <<= 1) { ss += __shfl_xor(ss, o); dot += __shfl_xor(dot, o); rd += __shfl_xor(rd, o); }
    if (ch == 0) a.SC[((size_t)b * 8 + h) * PAST + t] = (dot * rsqrtf(ss * (1.f / 64.f) + EPSV) + rd) * 0.10206207261596577f;
}
__device__ __forceinline__ void samp_part_unit(const MK& a, int u, char* smem) {
    float* sm = (float*)smem; float (*sp)[8] = (float (*)[8])(smem + 64);
    const int b = u >> 3, sp_i = u & 7, tid = threadIdx.x, lane = tid & 63, wid = tid >> 6;
    const int t0 = sp_i * 2048;
    __syncthreads();
    for (int hh = 0; hh < 2; ++hh) {
        const int h = wid + 4 * hh; float mx = -INFINITY;
        for (int t = lane; t < 2048; t += 64) mx = fmaxf(mx, a.SC[((size_t)b * 8 + h) * PAST + t0 + t]);
#pragma unroll
        for (int o = 1; o < 64; o <<= 1) mx = fmaxf(mx, __shfl_xor(mx, o));
        if (lane == 0) sm[h] = mx;
    }
    __syncthreads();
    float lat[8], lsum = 0.f;
#pragma unroll
    for (int h = 0; h < 8; ++h) lat[h] = 0.f;
    for (int tc = 0; tc < 2048; tc += 64) {
        __syncthreads();
        for (int e = tid; e < 512; e += 256) { const int j = e >> 3, h = e & 7; sp[j][h] = expf(a.SC[((size_t)b * 8 + h) * PAST + t0 + tc + j] - sm[h]); }
        __syncthreads();
        if (tid < 8) { for (int j = 0; j < 64; ++j) lsum += sp[j][tid]; }
        const int phys = a.page_table[b * NPAGES + ((t0 + tc) >> 7)];
        const float* base = a.cache_ckv + ((size_t)phys * 128 + ((t0 + tc) & 127)) * 256 + tid;
        for (int j = 0; j < 64; ++j) {
            const float cv = base[(size_t)j * 256];
#pragma unroll
            for (int h = 0; h < 8; ++h) lat[h] += sp[j][h] * cv;
        }
    }
    float* o = a.part + (size_t)u * 8 * 258;
#pragma unroll
    for (int h = 0; h < 8; ++h) o[h * 258 + 2 + tid] = lat[h];
    if (tid < 8) { o[tid * 258 + 0] = sm[tid]; o[tid * 258 + 1] = lsum; }
}
__device__ __forceinline__ void samp_comb_unit(const MK& a, int u, char* smem) {
    float* slat = (float*)smem;
    const int b = u >> 3, h = u & 7, tid = threadIdx.x;
    const size_t row = NPT + b;
    const float* q = a.qh + (row * 8 + h) * 96;
    float s_self = 0.f;
    for (int d = 0; d < 64; ++d) s_self += q[d] * a.kh[(row * 8 + h) * 64 + d];
    for (int d = 0; d < 32; ++d) s_self += q[64 + d] * a.krf[row * 32 + d];
    s_self *= 0.10206207261596577f;
    float m = s_self;
    for (int s = 0; s < 8; ++s) m = fmaxf(m, a.part[((size_t)(b * 8 + s) * 8 + h) * 258]);
    const float pself = expf(s_self - m);
    float l = pself, lat = 0.f;
    for (int s = 0; s < 8; ++s) {
        const float* p = a.part + ((size_t)(b * 8 + s) * 8 + h) * 258;
        const float w = expf(p[0] - m);
        l += p[1] * w; lat += p[2 + tid] * w;
    }
    __syncthreads();
    slat[tid] = lat;
    __syncthreads();
    if (tid < 64) {
        float o = 0.f;
        for (int c = 0; c < 256; ++c) o += slat[c] * a.w_kv_b[(size_t)c * 1024 + h * 128 + 64 + tid];
        o += pself * a.KV[row * 1024 + h * 128 + 64 + tid];
        a.omix[row * 1024 + 512 + h * 64 + tid] = f2bf(o / l);
    }
}

#define SMEM_BYTES 40960
__global__ __launch_bounds__(256) void mega(MK a) {
    cg::grid_group grid = cg::this_grid();
    __shared__ __attribute__((aligned(16))) char smem[SMEM_BYTES];
    const int tid = threadIdx.x, lane = tid & 63, wid = tid >> 6;
    const int bid = blockIdx.x, nb = gridDim.x;
    const int gw = bid * 4 + wid, ngw = nb * 4;

    {
        const int T0 = (ZW / 32) * 32, T1 = 24 * 12, T2 = 32 * 8, T3 = 16 * 8, T4 = 32 * 32, T5 = 88 * 32, T6 = 88 * 32, T7 = 32 * 88, T8 = 32 * 32, T9 = 32 * 8;
        const int TT = T0 + T1 + T2 + T3 + T4 + T5 + T6 + T7 + T8 + T9;
        float* t = (float*)smem;
        for (int it = bid; it < TT; it += nb) {
            int r = it;
            if (r < T0) { wt_tile(a.w_in, a.WinT, 2736, 0, 2736, 1024, r % 88, r / 88, t); continue; } r -= T0;
            if (r < T1) { wt_tile(a.w_q_b, a.WqbT, 768, 0, 768, 384, r % 24, r / 24, t); continue; } r -= T1;
            if (r < T2) { wt_tile(a.w_kv_b, a.WkvT, 1024, 0, 1024, 256, r % 32, r / 32, t); continue; } r -= T2;
            if (r < T3) { const int nbk = r % 16, kb = r / 16, h = nbk >> 1; wt_tile(a.w_kv_b, a.WknT + (size_t)h * 64 * 256, 1024, h * 128, 64, 256, nbk & 1, kb, t); continue; } r -= T3;
            if (r < T4) { wt_tile(a.w_o, a.WoT, 1024, 0, 1024, 1024, r % 32, r / 32, t); continue; } r -= T4;
            if (r < T5) { wt_tile(a.w_gate, a.WgT, DFF, 0, DFF, 1024, r % 88, r / 88, t); continue; } r -= T5;
            if (r < T6) { wt_tile(a.w_up, a.WuT, DFF, 0, DFF, 1024, r % 88, r / 88, t); continue; } r -= T6;
            if (r < T7) { wt_tile(a.w_down, a.WdT, 1024, 0, 1024, DFF, r % 32, r / 32, t); continue; } r -= T7;
            if (r < T8) { wt_tile(a.w_ple_gate, a.WpgT, 1024, 0, 1024, 1024, r % 32, r / 32, t); continue; } r -= T8;
            wt_tile(a.w_ple_proj, a.WppT, 1024, 0, 1024, 256, r % 32, r / 32, t);
        }
        for (int row = gw; row < MPAD; row += ngw) {
            const float* src = row < NPT ? a.x_prompt + (size_t)row * 1024 : a.x_sample + (size_t)(row < NTOK ? row - NPT : 0) * 1024;
            rms1024_row(src, a.g_attn, a.xn + (size_t)row * 1024, row >= NTOK, lane);
            ushort4 w = {0, 0, 0, 0};
            if (row < NTOK) { const float* ps = row < NPT ? a.p_prompt + (size_t)row * 256 : a.p_sample + (size_t)(row - NPT) * 256; const float4 v = *(const float4*)(ps + lane * 4); w.x = f2bf(v.x); w.y = f2bf(v.y); w.z = f2bf(v.z); w.w = f2bf(v.w); }
            *(ushort4*)(a.pb + (size_t)row * 256 + lane * 4) = w;
            if (row >= NTOK) { for (int j = 0; j < 4; ++j) { ushort4 z = {0, 0, 0, 0}; *(ushort4*)(a.omix + (size_t)row * 1024 + lane * 4 + 256 * j) = z; } }
        }
    }
    grid.sync();
    gemm_all(ABf16{a.xn, 1024}, a.WinT, 1024, MPAD, ZW, 1024, EpiF32{a.Z, ZW}, smem, bid, nb);
    gemm_all(ABf16{a.pb, 256}, a.WppT, 256, MPAD, 1024, 256, EpiF32{a.PP, 1024}, smem, bid, nb);
    grid.sync();
    for (int row = bid; row < NTOK; row += nb) post_in_row(a, row, (float*)smem);
    grid.sync();
    for (int u = gw; u < 64 + NST * 8; u += ngw) {
        if (u < 64) gdn_unit(a, u >> 3, u & 7, nullptr, a.out + O_GSP, 0, SEQ, lane, smem + wid * 10240);
        else { const int v = u - 64; gdn_unit(a, v >> 3, v & 7, a.state_gdn, a.out + O_GSS, NPT, 1, lane, smem + wid * 10240); }
    }
    gemm_all(ABf16{a.qan, 384}, a.WqbT, 384, MPAD, 768, 384, EpiF32{a.Q, 768}, smem, bid, nb);
    gemm_all(ABf16{a.ckvb, 256}, a.WkvT, 256, MPAD, 1024, 256, EpiF32{a.KV, 1024}, smem, bid, nb);
    gemm_all(ACache{a.cache_ckv, a.page_table}, a.WknT, 256, NST * PAST, 512, 256, EpiBf16{a.KN, 512}, smem, bid, nb);
    grid.sync();
    for (int idx = gw; idx < NTOK * 8; idx += ngw) { post_q_item(a, idx, lane); post_kv_item(a, idx, lane); }
    grid.sync();
    __syncthreads();
    for (int u = gw; u < 2048; u += ngw) attn_unit(a, u, lane, smem + wid * 10240);
    for (int m = gw; m < NST * PAST; m += ngw) samp_scores_item(a, m, lane);
    grid.sync();
    for (int u = bid; u < NST * 8; u += nb) samp_part_unit(a, u, smem);
    grid.sync();
    for (int u = bid; u < NST * 8; u += nb) samp_comb_unit(a, u, smem);
    grid.sync();
    gemm_all(ABf16{a.omix, 1024}, a.WoT, 1024, MPAD, 1024, 1024, EpiResX{a.x_prompt, a.x_sample, a.H}, smem, bid, nb);
    grid.sync();
    for (int row = gw; row < MPAD; row += ngw) rms1024_row(a.H + (size_t)row * 1024, a.g_ffn, a.un + (size_t)row * 1024, row >= NTOK, lane);
    grid.sync();
    {
        const int nn = DFF / 128, nt = nn * (MPAD / 128);
        for (int t = bid; t < nt; t += nb) {
            gemm_tile(ABf16{a.un, 1024}, a.WgT, 1024, 1024, EpiF32{a.G, DFF}, (t / nn) * 128, (t % nn) * 128, smem);
            gemm_tile(ABf16{a.un, 1024}, a.WuT, 1024, 1024, EpiSwiglu{a.G, a.hid}, (t / nn) * 128, (t % nn) * 128, smem);
        }
    }
    grid.sync();
    gemm_all(ABf16{a.hid, DFF}, a.WdT, DFF, MPAD, 1024, DFF, EpiResH{a.H, a.H2}, smem, bid, nb);
    grid.sync();
    for (int row = gw; row < MPAD; row += ngw) rms1024_row(a.H2 + (size_t)row * 1024, a.g_ple, a.un2 + (size_t)row * 1024, row >= NTOK, lane);
    grid.sync();
    gemm_all(ABf16{a.un2, 1024}, a.WpgT, 1024, MPAD, 1024, 1024, EpiPle{a.H2, a.PP, a.out}, smem, bid, nb);
}

static inline char* carve(char*& p, size_t bytes) { char* r = p; p += (bytes + 255) & ~(size_t)255; return r; }

extern "C" void kernel_launch(void* const* d_in, const int* in_sizes, int n_in, void* d_out, int out_size, void* d_ws, size_t ws_size, hipStream_t stream) {
    MK a{};
    a.x_prompt = (const float*)d_in[0]; a.x_sample = (const float*)d_in[1]; a.cache_ckv = (const float*)d_in[2]; a.cache_krope = (const float*)d_in[3];
    a.state_gdn = (const float*)d_in[4]; a.state_conv = (const float*)d_in[5]; a.page_table = (const int*)d_in[6]; a.p_prompt = (const float*)d_in[7]; a.p_sample = (const float*)d_in[8];
    a.g_attn = (const float*)d_in[9]; a.w_in = (const float*)d_in[10]; a.w_conv = (const float*)d_in[11]; a.a_log = (const float*)d_in[12]; a.dt_bias = (const float*)d_in[13];
    a.g_gdn_out = (const float*)d_in[14]; a.g_q_a = (const float*)d_in[15]; a.w_q_b = (const float*)d_in[16]; a.g_q_nope = (const float*)d_in[17]; a.g_q_rope = (const float*)d_in[18];
    a.g_kv_a = (const float*)d_in[19]; a.g_k_rope = (const float*)d_in[20]; a.w_kv_b = (const float*)d_in[21]; a.g_k_nope = (const float*)d_in[22]; a.w_o = (const float*)d_in[23];
    a.g_ffn = (const float*)d_in[24]; a.w_gate = (const float*)d_in[25]; a.w_up = (const float*)d_in[26]; a.w_down = (const float*)d_in[27]; a.g_ple = (const float*)d_in[28];
    a.w_ple_gate = (const float*)d_in[29]; a.w_ple_proj = (const float*)d_in[30];
    a.out = (float*)d_out;
    char* p = (char*)d_ws;
    a.WinT = (bf16_t*)carve(p, (size_t)ZW * 1024 * 2);
    a.WqbT = (bf16_t*)carve(p, (size_t)768 * 384 * 2);
    a.WkvT = (bf16_t*)carve(p, (size_t)1024 * 256 * 2);
    a.WknT = (bf16_t*)carve(p, (size_t)512 * 256 * 2);
    a.WoT = (bf16_t*)carve(p, (size_t)1024 * 1024 * 2);
    a.WgT = (bf16_t*)carve(p, (size_t)DFF * 1024 * 2);
    a.WuT = (bf16_t*)carve(p, (size_t)DFF * 1024 * 2);
    a.WdT = (bf16_t*)carve(p, (size_t)1024 * DFF * 2);
    a.WpgT = (bf16_t*)carve(p, (size_t)1024 * 1024 * 2);
    a.WppT = (bf16_t*)carve(p, (size_t)1024 * 256 * 2);
    a.xn = (bf16_t*)carve(p, (size_t)MPAD * 1024 * 2);
    a.pb = (bf16_t*)carve(p, (size_t)MPAD * 256 * 2);
    a.Z = (float*)carve(p, (size_t)MPAD * ZW * 4);
    a.qf = (float*)carve(p, (size_t)MPAD * 512 * 4);
    a.kf = (float*)carve(p, (size_t)MPAD * 512 * 4);
    a.vf = (float*)carve(p, (size_t)MPAD * 512 * 4);
    a.gg = (float*)carve(p, (size_t)MPAD * 8 * 4);
    a.bb = (float*)carve(p, (size_t)MPAD * 8 * 4);
    a.qan = (bf16_t*)carve(p, (size_t)MPAD * 384 * 2);
    a.ckvb = (bf16_t*)carve(p, (size_t)MPAD * 256 * 2);
    a.krf = (float*)carve(p, (size_t)MPAD * 32 * 4);
    a.Q = (float*)carve(p, (size_t)MPAD * 768 * 4);
    a.qh = (float*)carve(p, (size_t)MPAD * 768 * 4);
    a.KV = (float*)carve(p, (size_t)MPAD * 1024 * 4);
    a.kh = (float*)carve(p, (size_t)MPAD * 512 * 4);
    a.omix = (bf16_t*)carve(p, (size_t)MPAD * 1024 * 2);
    a.KN = (bf16_t*)carve(p, (size_t)NST * PAST * 512 * 2);
    a.SC = (float*)carve(p, (size_t)NST * 8 * PAST * 4);
    a.part = (float*)carve(p, (size_t)NST * 8 * 8 * 258 * 4);
    a.H = (float*)carve(p, (size_t)MPAD * 1024 * 4);
    a.un = (bf16_t*)carve(p, (size_t)MPAD * 1024 * 2);
    a.G = (float*)carve(p, (size_t)MPAD * DFF * 4);
    a.hid = (bf16_t*)carve(p, (size_t)MPAD * DFF * 2);
    a.H2 = (float*)carve(p, (size_t)MPAD * 1024 * 4);
    a.un2 = (bf16_t*)carve(p, (size_t)MPAD * 1024 * 2);
    a.PP = (float*)carve(p, (size_t)MPAD * 1024 * 4);
    if ((size_t)(p - (char*)d_ws) > ws_size) { fprintf(stderr, "kernel_launch: workspace too small: need %zu have %zu\n", (size_t)(p - (char*)d_ws), ws_size); return; }

    static int grid_blocks = 0;
    if (!grid_blocks) {
        int dev = 0, cus = 0, per_cu = 0;
        (void)hipGetDevice(&dev);
        (void)hipDeviceGetAttribute(&cus, hipDeviceAttributeMultiprocessorCount, dev);
        (void)hipOccupancyMaxActiveBlocksPerMultiprocessor(&per_cu, (const void*)mega, 256, 0);
        if (per_cu < 1) per_cu = 1;
        if (per_cu > 2) per_cu = 2;
        grid_blocks = cus * per_cu;
    }
    void* args[] = {&a};
    hipError_t e = hipLaunchCooperativeKernel((const void*)mega, dim3(grid_blocks), dim3(256), args, 0, stream);
    if (e != hipSuccess) fprintf(stderr, "cooperative launch failed: %s (grid %d)\n", hipGetErrorString(e), grid_blocks);
}
```

```cpp
#include <hip/hip_runtime.h>
#include <stdint.h>
#include <cstdio>
#include <hip/hip_cooperative_groups.h>
namespace cg = cooperative_groups;


namespace pg8 {
#define PG8_LAS __attribute__((address_space(3)))
typedef unsigned short bf16_t;
typedef short bf16x8 __attribute__((ext_vector_type(8)));
typedef float f32x4 __attribute__((ext_vector_type(4)));
typedef unsigned u32x4 __attribute__((ext_vector_type(4)));
constexpr int BM = 256, BK = 64, HALF = 128, HTB = HALF * BK * 2  , STAGE_BYTES = 8 * HTB, NXCD = 8, WGM = 8;

__host__ __device__ __forceinline__ int lds_byte(int r, int c) { const int st = (r >> 4) * 2 + (c >> 5), rr = r & 15, cc = c & 31, ob = rr * 64 + cc * 2; return st * 1024 + (ob ^ (((ob >> 9) & 1) << 5)); }
__host__ __device__ __forceinline__ void stage_rc(int b, int& R, int& C) { const int st = b / 1024, sb = b % 1024, swz = sb ^ (((sb >> 9) & 1) << 5); R = (st >> 1) * 16 + swz / 64; C = (st & 1) * 32 + (swz % 64) / 2; }
__host__ __device__ __forceinline__ int perm32(int rho) { const int n = rho >> 4, i = rho & 15; return 8 * (i >> 2) + 4 * n + (i & 3); }

struct Unit { int pm, pn; };
struct Gemm { const bf16_t* A; const bf16_t* Bt; int M, N, K; };

struct StaticOrder {
    int nM, nN, nwg, G, c;
    __host__ __device__ void init(int M, int N, int G_, int c_) { nM = M / BM; nN = N / BM; nwg = nM * nN; G = G_; c = c_; }
    __host__ __device__ bool next(int i, Unit& u) const {
        const long L = (long)i * G + c; if (L >= nwg) return false;
        int wgid = (int)L; { const int q = nwg / NXCD, r = nwg % NXCD, xcd = wgid % NXCD, off = wgid / NXCD; wgid = (xcd < r ? xcd * (q + 1) : r * (q + 1) + (xcd - r) * q) + off; }
        const int nig = WGM * nN, gid = wgid / nig, fm = gid * WGM, gsz = (nM - fm) < WGM ? (nM - fm) : WGM;
        u.pm = fm + ((wgid % nig) % gsz); u.pn = (wgid % nig) / gsz; return true;
    }
    __device__ __forceinline__ void a_ready(const Unit&) const {}
    __device__ __forceinline__ void done(const Unit&) const {}
};

template <class Epi, class Sched, bool ALIGN_EPI = false, bool SP2 = false>
__device__ __forceinline__ void gemm_phase(PG8_LAS unsigned char* lds, const Gemm g, const Sched& S, const Epi& E) {
    const int tid = threadIdx.x, wid = __builtin_amdgcn_readfirstlane(tid >> 6), lane = tid & 63, wr = wid >> 2, wc = wid & 3, fr = lane & 15, fq = lane >> 4;
    const int K = g.K, nt = K / BK;
    unsigned voffA[2], voffB[2];
#pragma unroll
    for (int i = 0; i < 2; ++i) { int R, C; stage_rc(tid * 16 + i * 8192, R, C); const int Rb = Epi::PERM ? ((R & ~31) + perm32(R & 31)) : R;
        voffA[i] = (unsigned)(R * K + C) * 2u; voffB[i] = (unsigned)(Rb * K + C) * 2u; }
    const size_t kstep = (size_t)(BK * 2);
    const size_t hstep = (size_t)HALF * K * 2;
    const size_t tstep = 2 * hstep;
    const unsigned ldsw = (unsigned)wid * 1024u;
    const int aoff = lds_byte(wr * 64 + fr, fq * 8), boff = lds_byte(wc * 32 + fr, fq * 8);
#define PG8_SA(b, h) (((b) * 2 + (h)) * HTB)
#define PG8_SB(b, h) ((4 + (b) * 2 + (h)) * HTB)
#define PG8_STAGE(bufoff, gbase, voff) do { _Pragma("unroll") for (int _i = 0; _i < 2; ++_i) \
        __builtin_amdgcn_global_load_lds((const unsigned*)((const char*)(gbase) + (voff)[_i]), (PG8_LAS unsigned*)(lds + (bufoff) + ldsw + _i * 8192), 16, 0, 0); } while (0)
#define PG8_LDA(dst, b, h) do { _Pragma("unroll") for (int m = 0; m < 4; ++m) _Pragma("unroll") for (int k = 0; k < 2; ++k) dst[m][k] = *(const PG8_LAS bf16x8*)(lds + PG8_SA(b, h) + aoff + m * 2048 + k * 1024); } while (0)
#define PG8_LDB(dst, b, h) do { _Pragma("unroll") for (int n = 0; n < 2; ++n) _Pragma("unroll") for (int k = 0; k < 2; ++k) dst[n][k] = *(const PG8_LAS bf16x8*)(lds + PG8_SB(b, h) + boff + n * 2048 + k * 1024); } while (0)
#define PG8_MMA(ai, bj, At, Bt) do { __builtin_amdgcn_s_setprio(1); _Pragma("unroll") for (int m = 0; m < 4; ++m) _Pragma("unroll") for (int n = 0; n < 2; ++n) _Pragma("unroll") for (int k = 0; k < 2; ++k) \
        acc[ai][bj][m][n] = __builtin_amdgcn_mfma_f32_16x16x32_bf16(Bt[n][k], At[m][k], acc[ai][bj][m][n], 0, 0, 0); __builtin_amdgcn_s_setprio(0); } while (0)
#define PG8_WAIT_V(n) asm volatile("s_waitcnt vmcnt(" #n ")" ::: "memory")
#define PG8_WAIT_L(n) asm volatile("s_waitcnt lgkmcnt(" #n ")" ::: "memory")
#define PG8_BAR __builtin_amdgcn_s_barrier()
#define PG8_SCHED __builtin_amdgcn_sched_barrier(0)
    Unit cur, nxt; int ui = 0;
    if (!S.next(0, cur)) return;
    f32x4 acc[2][2][4][2];
#pragma unroll
    for (int a = 0; a < 2; ++a)
#pragma unroll
        for (int b = 0; b < 2; ++b)
#pragma unroll
            for (int m = 0; m < 4; ++m)
#pragma unroll
                for (int n = 0; n < 2; ++n) acc[a][b][m][n] = (f32x4){0.f, 0.f, 0.f, 0.f};
    bf16x8 At[4][2], B0[2][2], B1[2][2];
    const char* cA = (const char*)g.A + (size_t)cur.pm * tstep; const char* cB = (const char*)g.Bt + (size_t)cur.pn * tstep;
    S.a_ready(cur);
    if constexpr (SP2) {
        PG8_STAGE(PG8_SB(0, 0), cB, voffB); PG8_STAGE(PG8_SB(0, 1), cB + hstep, voffB); PG8_STAGE(PG8_SA(0, 0), cA, voffA); PG8_STAGE(PG8_SA(0, 1), cA + hstep, voffA);
        if (wr == 1) PG8_BAR;
        PG8_WAIT_V(2); PG8_BAR;
        PG8_STAGE(PG8_SB(1, 0), cB + kstep, voffB); PG8_STAGE(PG8_SA(1, 0), cA + kstep, voffA); PG8_STAGE(PG8_SB(1, 1), cB + hstep + kstep, voffB);
        PG8_WAIT_V(6); PG8_BAR;
    } else {
        PG8_STAGE(PG8_SB(0, 0), cB, voffB); PG8_STAGE(PG8_SA(0, 0), cA, voffA); PG8_STAGE(PG8_SB(0, 1), cB + hstep, voffB); PG8_STAGE(PG8_SA(0, 1), cA + hstep, voffA);
        if (wr == 1) PG8_BAR;
        PG8_WAIT_V(4); PG8_BAR;
        PG8_STAGE(PG8_SB(1, 0), cB + kstep, voffB); PG8_STAGE(PG8_SA(1, 0), cA + kstep, voffA); PG8_STAGE(PG8_SB(1, 1), cB + hstep + kstep, voffB);
        PG8_WAIT_V(6); PG8_BAR;
    }
    for (;;) {
        const bool has_next = S.next(ui + 1, nxt);
        const char* nA = has_next ? (const char*)g.A + (size_t)nxt.pm * tstep : cA; const char* nB = has_next ? (const char*)g.Bt + (size_t)nxt.pn * tstep : cB;
        for (int t = 0; t < nt; t += 2) {
            const bool last = (t == nt - 2);
            const char* a1 = cA + (size_t)(t + 1) * kstep;
            const char* a2 = last ? nA : cA + (size_t)(t + 2) * kstep; const char* b2 = last ? nB : cB + (size_t)(t + 2) * kstep;
            const char* a3 = a2 + kstep; const char* b3 = b2 + kstep;
            if (last && has_next) S.a_ready(nxt);
            if constexpr (SP2) {
            PG8_LDB(B0, 0, 0); PG8_LDB(B1, 0, 1); PG8_SCHED; PG8_LDA(At, 0, 0); PG8_STAGE(PG8_SA(1, 1), a1 + hstep, voffA);
            PG8_WAIT_V(8); PG8_WAIT_L(0); PG8_BAR; PG8_MMA(0, 0, At, B0); PG8_MMA(0, 1, At, B1); PG8_BAR; PG8_SCHED;
            PG8_LDA(At, 0, 1); PG8_STAGE(PG8_SB(0, 0), b2, voffB); PG8_STAGE(PG8_SB(0, 1), b2 + hstep, voffB); PG8_STAGE(PG8_SA(0, 0), a2, voffA);
            PG8_WAIT_V(8); PG8_WAIT_L(0); PG8_BAR; PG8_MMA(1, 0, At, B0); PG8_MMA(1, 1, At, B1); PG8_BAR; PG8_SCHED;
            PG8_LDB(B0, 1, 0); PG8_LDB(B1, 1, 1); PG8_SCHED; PG8_LDA(At, 1, 0); PG8_STAGE(PG8_SA(0, 1), a2 + hstep, voffA);
            PG8_WAIT_V(8); PG8_WAIT_L(0); PG8_BAR; PG8_MMA(0, 0, At, B0); PG8_MMA(0, 1, At, B1); PG8_BAR; PG8_SCHED;
            PG8_LDA(At, 1, 1); PG8_STAGE(PG8_SB(1, 0), b3, voffB); PG8_STAGE(PG8_SB(1, 1), b3 + hstep, voffB); PG8_STAGE(PG8_SA(1, 0), a3, voffA);
            PG8_WAIT_V(8); PG8_WAIT_L(0); PG8_BAR; PG8_MMA(1, 0, At, B0); PG8_MMA(1, 1, At, B1); PG8_BAR; PG8_SCHED;
            } else {
            PG8_LDB(B0, 0, 0); PG8_SCHED; PG8_LDA(At, 0, 0); PG8_STAGE(PG8_SA(1, 1), a1 + hstep, voffA);
            PG8_WAIT_L(8); PG8_BAR; PG8_WAIT_L(0); PG8_MMA(0, 0, At, B0); PG8_BAR; PG8_SCHED;
            PG8_LDB(B1, 0, 1); PG8_STAGE(PG8_SB(0, 0), b2, voffB);
            PG8_BAR; PG8_WAIT_L(0); PG8_MMA(0, 1, At, B1); PG8_BAR;
            PG8_LDA(At, 0, 1); PG8_STAGE(PG8_SA(0, 0), a2, voffA);
            PG8_BAR; PG8_WAIT_L(0); PG8_MMA(1, 0, At, B0); PG8_BAR; PG8_SCHED;
            PG8_STAGE(PG8_SB(0, 1), b2 + hstep, voffB);
            PG8_WAIT_V(6); PG8_BAR; PG8_MMA(1, 1, At, B1); PG8_BAR;
            PG8_LDB(B0, 1, 0); PG8_SCHED; PG8_LDA(At, 1, 0); PG8_STAGE(PG8_SA(0, 1), a2 + hstep, voffA);
            PG8_WAIT_L(8); PG8_BAR; PG8_WAIT_L(0); PG8_MMA(0, 0, At, B0); PG8_BAR; PG8_SCHED;
            PG8_LDB(B1, 1, 1); PG8_STAGE(PG8_SB(1, 0), b3, voffB);
            PG8_BAR; PG8_WAIT_L(0); PG8_MMA(0, 1, At, B1); PG8_BAR;
            PG8_LDA(At, 1, 1); PG8_STAGE(PG8_SA(1, 0), a3, voffA);
            PG8_BAR; PG8_WAIT_L(0); PG8_MMA(1, 0, At, B0); PG8_BAR; PG8_SCHED;
            PG8_STAGE(PG8_SB(1, 1), b3 + hstep, voffB);
            PG8_WAIT_V(6); PG8_BAR; PG8_MMA(1, 1, At, B1); PG8_BAR;
            }
        }
        if constexpr (ALIGN_EPI) { if (wr == 0) PG8_BAR; }
        if constexpr (!Epi::AFTER_DRAIN) { E(acc, cur, wr, wc, fr, fq); S.done(cur); }
        if (!has_next) break;
#pragma unroll
        for (int a = 0; a < 2; ++a)
#pragma unroll
            for (int b = 0; b < 2; ++b)
#pragma unroll
                for (int m = 0; m < 4; ++m)
#pragma unroll
                    for (int n = 0; n < 2; ++n) acc[a][b][m][n] = (f32x4){0.f, 0.f, 0.f, 0.f};
        cur = nxt; cA = nA; cB = nB; ++ui;
        if constexpr (ALIGN_EPI) { if (wr == 1) PG8_BAR; }
    }
    PG8_WAIT_V(0);
    if constexpr (!ALIGN_EPI) { if (wr == 0) PG8_BAR; }
    PG8_BAR;
    if constexpr (Epi::AFTER_DRAIN) { E.fused(acc, cur, wr, wc, fr, fq, lds, wid, lane); S.done(cur); }
#undef PG8_SA
#undef PG8_SB
#undef PG8_STAGE
#undef PG8_LDA
#undef PG8_LDB
#undef PG8_MMA
#undef PG8_WAIT_V
#undef PG8_WAIT_L
#undef PG8_BAR
#undef PG8_SCHED
}
}

using pg8::bf16_t; using pg8::bf16x8; using pg8::f32x4; using pg8::u32x4;
#define LAS __attribute__((address_space(3)))

#define DMODEL 1024
#define NPT 16384
#define NST 32
#define NTOK 16416
#define MPAD 16640
#define SEQ 2048
#define ZW 2816
#define OFF_A 1536
#define OFF_B 1544
#define OFF_Z 1552
#define OFF_QA 2064
#define OFF_KVA 2448
#define OFF_KR 2704
#define DFF 2816
#define PAST 16384
#define NPAGES 128
#define EPSV 1e-6f

#define O_YP 0
#define O_YS (O_YP + 16777216)
#define O_CKVP (O_YS + 32768)
#define O_KRP (O_CKVP + 4194304)
#define O_GSP (O_KRP + 524288)
#define O_CSP (O_GSP + 262144)
#define O_CKVS (O_CSP + 36864)
#define O_KRS (O_CKVS + 8192)
#define O_GSS (O_KRS + 1024)
#define O_CSS (O_GSS + 1048576)

__device__ __forceinline__ bf16_t f2bf(float f) { unsigned u = __float_as_uint(f); return (bf16_t)((u + 0x7fffu + ((u >> 16) & 1u)) >> 16); }
__device__ __forceinline__ float bf2f(bf16_t b) { return __uint_as_float(((unsigned)b) << 16); }
__device__ __forceinline__ float wave_sum(float v) {
#pragma unroll
    for (int o = 1; o < 64; o <<= 1) v += __shfl_xor(v, o);
    return v;
}
__device__ __forceinline__ float sigmoidf_(float x) { return 1.f / (1.f + expf(-x)); }
__device__ __forceinline__ float siluf_(float x) { return x / (1.f + expf(-x)); }


#define WSYNC() do { __builtin_amdgcn_fence(__ATOMIC_ACQ_REL, "wavefront"); __builtin_amdgcn_wave_barrier(); } while (0)
#define NTHR 512
#define NWAVE 8

__device__ __forceinline__ unsigned pk2bf(float lo, float hi) { return (unsigned)f2bf(lo) | ((unsigned)f2bf(hi) << 16); }

__device__ __forceinline__ void wt_tile(bool active, const float* __restrict__ W, bf16_t* __restrict__ Wt, int ldw, int col0, int N, int ldt, int nb_, int kb_, float* t  ) {
    const int tx = threadIdx.x & 31, ty = (threadIdx.x >> 5) & 7;
    const int n0 = nb_ * 32, k0 = kb_ * 32;
    __syncthreads();
    if (active) for (int i = ty; i < 32; i += 8) {
        const int k = k0 + i, n = n0 + tx; float v = 0.f;
        if (n < N) v = W[(size_t)k * ldw + col0 + n];
        t[i * 33 + tx] = v;
    }
    __syncthreads();
    if (active) for (int i = ty; i < 32; i += 8) { const int n = n0 + i, k = k0 + tx; Wt[(size_t)n * ldt + k] = f2bf(t[tx * 33 + i]); }
}

__device__ __forceinline__ void rms1024_row(const float* __restrict__ src, const float* __restrict__ g, bf16_t* __restrict__ o, bool zero, int lane) {
    if (zero) { for (int j = 0; j < 4; ++j) { ushort4 z = {0, 0, 0, 0}; *(ushort4*)(o + lane * 4 + 256 * j) = z; } return; }
    float4 v[4]; float ss = 0.f;
#pragma unroll
    for (int j = 0; j < 4; ++j) { v[j] = *(const float4*)(src + lane * 4 + 256 * j); ss += v[j].x * v[j].x + v[j].y * v[j].y + v[j].z * v[j].z + v[j].w * v[j].w; }
    ss = wave_sum(ss);
    const float rs = rsqrtf(ss * (1.f / 1024.f) + EPSV);
#pragma unroll
    for (int j = 0; j < 4; ++j) {
        const float4 gg = *(const float4*)(g + lane * 4 + 256 * j);
        ushort4 w; w.x = f2bf(v[j].x * rs * gg.x); w.y = f2bf(v[j].y * rs * gg.y); w.z = f2bf(v[j].z * rs * gg.z); w.w = f2bf(v[j].w * rs * gg.w);
        *(ushort4*)(o + lane * 4 + 256 * j) = w;
    }
}

struct ABf16 { const bf16_t* p; int lda; __device__ __forceinline__ bf16x8 load(int m, int k) const { return *(const bf16x8*)(p + (size_t)m * lda + k); } };
struct ACache {
    const float* cache; const int* pt;
    __device__ __forceinline__ bf16x8 load(int m, int k) const {
        const int b = m >> 14, t = m & 16383; const int phys = pt[b * NPAGES + (t >> 7)];
        const float* r = cache + ((size_t)phys * 128 + (t & 127)) * 256 + k;
        const float4 a = *(const float4*)r, c = *(const float4*)(r + 4);
        bf16x8 o; o[0] = (short)f2bf(a.x); o[1] = (short)f2bf(a.y); o[2] = (short)f2bf(a.z); o[3] = (short)f2bf(a.w);
        o[4] = (short)f2bf(c.x); o[5] = (short)f2bf(c.y); o[6] = (short)f2bf(c.z); o[7] = (short)f2bf(c.w); return o;
    }
};
template <class AL, class Epi>
__device__ __forceinline__ void gemm_tile_256x128(const AL& al, const bf16_t* __restrict__ Bt, int ldb, int K, const Epi& epi, int m0, int n0, char* smem) {
    bf16_t (*sA)[40] = (bf16_t (*)[40])smem;
    bf16_t (*sB)[40] = (bf16_t (*)[40])(smem + 20480);
    const int tid = threadIdx.x, lane = tid & 63, wid = tid >> 6, wm = wid >> 1, wn = wid & 1;
    f32x4 acc[4][4];
#pragma unroll
    for (int i = 0; i < 4; ++i)
#pragma unroll
        for (int j = 0; j < 4; ++j) acc[i][j] = (f32x4){0.f, 0.f, 0.f, 0.f};
    __syncthreads();
    for (int k0 = 0; k0 < K; k0 += 32) {
#pragma unroll
        for (int i = 0; i < 2; ++i) { const int ch = tid + 512 * i, r = ch >> 2, kc = (ch & 3) * 8; *(bf16x8*)&sA[r][kc] = al.load(m0 + r, k0 + kc); }
        { const int r = tid >> 2, kc = (tid & 3) * 8; *(bf16x8*)&sB[r][kc] = *(const bf16x8*)(Bt + (size_t)(n0 + r) * ldb + k0 + kc); }
        __syncthreads();
        bf16x8 af[4], bfr[4];
#pragma unroll
        for (int i = 0; i < 4; ++i) af[i] = *(const bf16x8*)&sA[wm * 64 + i * 16 + (lane & 15)][(lane >> 4) * 8];
#pragma unroll
        for (int j = 0; j < 4; ++j) bfr[j] = *(const bf16x8*)&sB[wn * 64 + j * 16 + (lane & 15)][(lane >> 4) * 8];
#pragma unroll
        for (int i = 0; i < 4; ++i)
#pragma unroll
            for (int j = 0; j < 4; ++j) acc[i][j] = __builtin_amdgcn_mfma_f32_16x16x32_bf16(af[i], bfr[j], acc[i][j], 0, 0, 0);
        __syncthreads();
    }
#pragma unroll
    for (int i = 0; i < 4; ++i)
#pragma unroll
        for (int j = 0; j < 4; ++j)
#pragma unroll
            for (int r = 0; r < 4; ++r) epi(m0 + wm * 64 + i * 16 + (lane >> 4) * 4 + r, n0 + wn * 64 + j * 16 + (lane & 15), acc[i][j][r]);
}
template <class Epi>
__device__ __forceinline__ void gemm_tile_32x256(const bf16_t* __restrict__ A, int lda, const bf16_t* __restrict__ Bt, int ldb, int K, const Epi& epi, int m0, int n0, char* smem) {
    bf16_t (*sA)[40] = (bf16_t (*)[40])smem;
    bf16_t (*sB)[40] = (bf16_t (*)[40])(smem + 2560);
    const int tid = threadIdx.x, lane = tid & 63, wid = tid >> 6;
    f32x4 acc[2][2];
#pragma unroll
    for (int i = 0; i < 2; ++i)
#pragma unroll
        for (int j = 0; j < 2; ++j) acc[i][j] = (f32x4){0.f, 0.f, 0.f, 0.f};
    __syncthreads();
    for (int k0 = 0; k0 < K; k0 += 32) {
        if (tid < 128) { const int r = tid >> 2, kc = (tid & 3) * 8; *(bf16x8*)&sA[r][kc] = *(const bf16x8*)(A + (size_t)(m0 + r) * lda + k0 + kc); }
#pragma unroll
        for (int i = 0; i < 2; ++i) { const int ch = tid + 512 * i, r = ch >> 2, kc = (ch & 3) * 8; *(bf16x8*)&sB[r][kc] = *(const bf16x8*)(Bt + (size_t)(n0 + r) * ldb + k0 + kc); }
        __syncthreads();
        bf16x8 af[2], bfr[2];
#pragma unroll
        for (int i = 0; i < 2; ++i) af[i] = *(const bf16x8*)&sA[i * 16 + (lane & 15)][(lane >> 4) * 8];
#pragma unroll
        for (int j = 0; j < 2; ++j) bfr[j] = *(const bf16x8*)&sB[wid * 32 + j * 16 + (lane & 15)][(lane >> 4) * 8];
#pragma unroll
        for (int i = 0; i < 2; ++i)
#pragma unroll
            for (int j = 0; j < 2; ++j) acc[i][j] = __builtin_amdgcn_mfma_f32_16x16x32_bf16(af[i], bfr[j], acc[i][j], 0, 0, 0);
        __syncthreads();
    }
#pragma unroll
    for (int i = 0; i < 2; ++i)
#pragma unroll
        for (int j = 0; j < 2; ++j)
#pragma unroll
            for (int r = 0; r < 4; ++r) epi(m0 + i * 16 + (lane >> 4) * 4 + r, n0 + wid * 32 + j * 16 + (lane & 15), acc[i][j][r]);
}
template <class Epi>
__device__ __forceinline__ void gemm_sample_rows(const bf16_t* __restrict__ A, int lda, const bf16_t* __restrict__ Bt, int K, int N, const Epi& epi, char* smem, int bid, int nb) {
    const int nu = N / 256;
    for (int u = nb - 1 - bid; u < nu; u += nb) gemm_tile_32x256(A, lda, Bt, K, K, epi, NPT, u * 256, smem);
}
struct EwF32 { float* C; int ldc; __device__ __forceinline__ void operator()(int m, int n, float v) const { C[(size_t)m * ldc + n] = v; } };
struct EwBf16 { bf16_t* C; int ldc; __device__ __forceinline__ void operator()(int m, int n, float v) const { C[(size_t)m * ldc + n] = f2bf(v); } };
struct EwResX { const float* xs; float* C; __device__ __forceinline__ void operator()(int m, int n, float v) const { C[(size_t)m * 1024 + n] = xs[(size_t)(m - NPT) * 1024 + n] + v; } };
struct EwSwiglu {
    float* G; bf16_t* Hd;
    __device__ __forceinline__ void operator()(int m, int n, float v) const {
        const int f = (n >> 8) * 128 + (n & 127);
        if ((n & 255) < 128) G[(size_t)(m - NPT) * DFF + f] = v;
    }
};
struct EwSwiglu2 {
    const float* G; bf16_t* Hd;
    __device__ __forceinline__ void operator()(int m, int n, float v) const {
        const int f = (n >> 8) * 128 + (n & 127);
        if ((n & 255) >= 128) Hd[(size_t)m * DFF + f] = f2bf(siluf_(G[(size_t)(m - NPT) * DFF + f]) * v);
    }
};
struct EwResH { const float* H; float* C; __device__ __forceinline__ void operator()(int m, int n, float v) const { C[(size_t)m * 1024 + n] = H[(size_t)m * 1024 + n] + v; } };
struct EwPle { const float* H2; const float* PP; float* out;
    __device__ __forceinline__ void operator()(int m, int n, float v) const { out[O_YS + (size_t)(m - NPT) * 1024 + n] = H2[(size_t)m * 1024 + n] + PP[(size_t)m * 1024 + n] * sigmoidf_(v); } };

struct PgBf16 {
    static constexpr bool PERM = true, AFTER_DRAIN = false; bf16_t* O; int ldc;
    __device__ __forceinline__ void operator()(const f32x4 (&acc)[2][2][4][2], const pg8::Unit& u, int wr, int wc, int fr, int fq) const {
#pragma unroll
        for (int ai = 0; ai < 2; ++ai)
#pragma unroll
            for (int m = 0; m < 4; ++m) { bf16_t* rowp = O + (size_t)(u.pm * 256 + ai * 128 + wr * 64 + m * 16 + fr) * ldc + u.pn * 256 + wc * 32 + 8 * fq;
#pragma unroll
                for (int bj = 0; bj < 2; ++bj) { const f32x4 v0 = acc[ai][bj][m][0], v1 = acc[ai][bj][m][1]; u32x4 w; w.x = pk2bf(v0[0], v0[1]); w.y = pk2bf(v0[2], v0[3]); w.z = pk2bf(v1[0], v1[1]); w.w = pk2bf(v1[2], v1[3]); *(u32x4*)(rowp + bj * 128) = w; } }
    }
};
struct PgF32 {
    static constexpr bool PERM = false, AFTER_DRAIN = false; float* O; int ldc;
    __device__ __forceinline__ void operator()(const f32x4 (&acc)[2][2][4][2], const pg8::Unit& u, int wr, int wc, int fr, int fq) const {
#pragma unroll
        for (int ai = 0; ai < 2; ++ai)
#pragma unroll
            for (int m = 0; m < 4; ++m) { float* rowp = O + (size_t)(u.pm * 256 + ai * 128 + wr * 64 + m * 16 + fr) * ldc + u.pn * 256 + wc * 32 + 4 * fq;
#pragma unroll
                for (int bj = 0; bj < 2; ++bj)
#pragma unroll
                    for (int n = 0; n < 2; ++n) *(f32x4*)(rowp + bj * 128 + n * 16) = acc[ai][bj][m][n]; }
    }
};
struct PgRes {
    static constexpr bool PERM = false, AFTER_DRAIN = false; const float* R; float* O;
    __device__ __forceinline__ void operator()(const f32x4 (&acc)[2][2][4][2], const pg8::Unit& u, int wr, int wc, int fr, int fq) const {
#pragma unroll
        for (int ai = 0; ai < 2; ++ai)
#pragma unroll
            for (int m = 0; m < 4; ++m) { const size_t off = (size_t)(u.pm * 256 + ai * 128 + wr * 64 + m * 16 + fr) * 1024 + u.pn * 256 + wc * 32 + 4 * fq;
#pragma unroll
                for (int bj = 0; bj < 2; ++bj)
#pragma unroll
                    for (int n = 0; n < 2; ++n) { const f32x4 r = *(const f32x4*)(R + off + bj * 128 + n * 16); *(f32x4*)(O + off + bj * 128 + n * 16) = r + acc[ai][bj][m][n]; } }
    }
};
struct PgSwiglu {
    static constexpr bool PERM = true, AFTER_DRAIN = false; bf16_t* Hd;
    __device__ __forceinline__ void operator()(const f32x4 (&acc)[2][2][4][2], const pg8::Unit& u, int wr, int wc, int fr, int fq) const {
#pragma unroll
        for (int ai = 0; ai < 2; ++ai)
#pragma unroll
            for (int m = 0; m < 4; ++m) { bf16_t* rowp = Hd + (size_t)(u.pm * 256 + ai * 128 + wr * 64 + m * 16 + fr) * DFF + u.pn * 128 + wc * 32 + 8 * fq;
                float h[8];
#pragma unroll
                for (int n = 0; n < 2; ++n)
#pragma unroll
                    for (int i = 0; i < 4; ++i) h[n * 4 + i] = siluf_(acc[ai][0][m][n][i]) * acc[ai][1][m][n][i];
                u32x4 w; w.x = pk2bf(h[0], h[1]); w.y = pk2bf(h[2], h[3]); w.z = pk2bf(h[4], h[5]); w.w = pk2bf(h[6], h[7]); *(u32x4*)rowp = w; }
    }
};
struct PgPle {
    static constexpr bool PERM = false, AFTER_DRAIN = false; const float* H2; const float* PP; float* out;
    __device__ __forceinline__ void operator()(const f32x4 (&acc)[2][2][4][2], const pg8::Unit& u, int wr, int wc, int fr, int fq) const {
#pragma unroll
        for (int ai = 0; ai < 2; ++ai)
#pragma unroll
            for (int m = 0; m < 4; ++m) { const size_t off = (size_t)(u.pm * 256 + ai * 128 + wr * 64 + m * 16 + fr) * 1024 + u.pn * 256 + wc * 32 + 4 * fq;
#pragma unroll
                for (int bj = 0; bj < 2; ++bj)
#pragma unroll
                    for (int n = 0; n < 2; ++n) { const f32x4 h = *(const f32x4*)(H2 + off + bj * 128 + n * 16), pp = *(const f32x4*)(PP + off + bj * 128 + n * 16), a = acc[ai][bj][m][n]; f32x4 y;
#pragma unroll
                        for (int i = 0; i < 4; ++i) y[i] = h[i] + pp[i] * sigmoidf_(a[i]);
                        *(f32x4*)(out + O_YP + off + bj * 128 + n * 16) = y; } }
    }
};
template <class Epi>
__device__ __forceinline__ void pg_gemm(LAS unsigned char* lds, const bf16_t* A, const bf16_t* Bt, int M, int N, int K, const Epi& E) {
    pg8::Gemm g{A, Bt, M, N, K}; pg8::StaticOrder S; S.init(M, N, (int)gridDim.x, (int)blockIdx.x);
    pg8::gemm_phase<Epi, pg8::StaticOrder, true, true>(lds, g, S, E);
}

struct MK {
    const float *x_prompt, *x_sample, *cache_ckv, *cache_krope, *state_gdn, *state_conv; const int* page_table; const float *p_prompt, *p_sample;
    const float *g_attn, *w_in, *w_conv, *a_log, *dt_bias, *g_gdn_out, *g_q_a, *w_q_b, *g_q_nope, *g_q_rope, *g_kv_a, *g_k_rope, *w_kv_b, *g_k_nope, *w_o, *g_ffn, *w_gate, *w_up, *w_down, *g_ple, *w_ple_gate, *w_ple_proj;
    float* out;
    bf16_t *WinT, *WqbT, *WkvT, *WknT, *WoT, *WguT, *WdT, *WpgT, *WppT, *xn, *pb, *Z;
    float *qf, *kf, *vf, *gg, *bb, *goraw; bf16_t *qan, *ckvb; float *krf, *Q, *qh, *KV, *kh; bf16_t *omix, *KN; float *SC, *part, *H; bf16_t* un; float* G; bf16_t* hid; float* H2; bf16_t* un2; float* PP;
};

__device__ __forceinline__ void post_in_row(const MK& a, int row, float* red) {
    const int tid = threadIdx.x & 255, lane = tid & 63, wid = tid >> 6;
    const bool samp = row >= NPT;
    const int b = samp ? row - NPT : row >> 11, t = samp ? 0 : row & 2047;
    const bf16_t* z = a.Z + (size_t)row * ZW;
#pragma unroll
    for (int i = 0; i < 6; ++i) {
        const int c = tid + 256 * i;
        float e0, e1, e2, e3;
        e3 = bf2f(z[c]);
        if (samp) { e0 = a.state_conv[((size_t)b * 3 + 0) * 1536 + c]; e1 = a.state_conv[((size_t)b * 3 + 1) * 1536 + c]; e2 = a.state_conv[((size_t)b * 3 + 2) * 1536 + c]; }
        else {
            e0 = t >= 3 ? bf2f(a.Z[(size_t)(row - 3) * ZW + c]) : 0.f;
            e1 = t >= 2 ? bf2f(a.Z[(size_t)(row - 2) * ZW + c]) : 0.f;
            e2 = t >= 1 ? bf2f(a.Z[(size_t)(row - 1) * ZW + c]) : 0.f;
        }
        float y = e0 * a.w_conv[c] + e1 * a.w_conv[1536 + c] + e2 * a.w_conv[2 * 1536 + c] + e3 * a.w_conv[3 * 1536 + c];
        y = siluf_(y);
        if (samp) { a.out[O_CSS + ((size_t)b * 3 + 0) * 1536 + c] = e1; a.out[O_CSS + ((size_t)b * 3 + 1) * 1536 + c] = e2; a.out[O_CSS + ((size_t)b * 3 + 2) * 1536 + c] = e3; }
        else if (t >= SEQ - 3) a.out[O_CSP + ((size_t)b * 3 + (t - (SEQ - 3))) * 1536 + c] = e3;
        const int sec = c >> 9, cc = c & 511;
        if (sec == 2) a.vf[(size_t)row * 512 + cc] = y;
        else {
            const float ss = wave_sum(y * y);
            const float r = rsqrtf(ss + EPSV);
            if (sec == 0) a.qf[(size_t)row * 512 + cc] = y * r * 0.125f; else a.kf[(size_t)row * 512 + cc] = y * r;
        }
    }
    if (tid < 8) {
        const float av = bf2f(z[OFF_A + tid]), bv = bf2f(z[OFF_B + tid]);
        const float xx = av + a.dt_bias[tid];
        const float sp = xx > 20.f ? xx : log1pf(expf(xx));
        a.gg[(size_t)row * 8 + tid] = -expf(a.a_log[tid]) * sp;
        a.bb[(size_t)row * 8 + tid] = sigmoidf_(bv);
    }
    {
        const float v0 = bf2f(z[OFF_QA + tid]), v1 = tid < 128 ? bf2f(z[OFF_QA + 256 + tid]) : 0.f;
        float ss = wave_sum(v0 * v0 + v1 * v1);
        if (lane == 0) red[wid] = ss;
        __syncthreads();
        ss = red[0] + red[1] + red[2] + red[3];
        const float rs = rsqrtf(ss * (1.f / 384.f) + EPSV);
        a.qan[(size_t)row * 384 + tid] = f2bf(v0 * rs * a.g_q_a[tid]);
        if (tid < 128) a.qan[(size_t)row * 384 + 256 + tid] = f2bf(v1 * rs * a.g_q_a[256 + tid]);
    }
    {
        const float v = bf2f(z[OFF_KVA + tid]);
        float ss = wave_sum(v * v);
        if (lane == 0) red[4 + wid] = ss;
        __syncthreads();
        ss = red[4] + red[5] + red[6] + red[7];
        const float rs = rsqrtf(ss * (1.f / 256.f) + EPSV);
        const float o = v * rs * a.g_kv_a[tid];
        a.ckvb[(size_t)row * 256 + tid] = f2bf(o);
        if (samp) a.out[O_CKVS + (size_t)b * 256 + tid] = o; else a.out[O_CKVP + (size_t)row * 256 + tid] = o;
    }
    if (wid == 0) {
        const float v = lane < 32 ? bf2f(z[OFF_KR + lane]) : 0.f;
        const float ss = wave_sum(v * v);
        const float rs = rsqrtf(ss * (1.f / 32.f) + EPSV);
        const float xn = lane < 32 ? v * rs * a.g_k_rope[lane] : 0.f;
        const float other = __shfl_xor(xn, 16);
        const int i = lane & 15;
        const float pos = samp ? (float)PAST : (float)t;
        const float ang = pos * powf(10000.f, -(float)i / 16.f);
        const float cs = cosf(ang), sn = sinf(ang);
        const float o = lane < 16 ? xn * cs - other * sn : other * sn + xn * cs;
        if (lane < 32) {
            a.krf[(size_t)row * 32 + lane] = o;
            if (samp) a.out[O_KRS + (size_t)b * 32 + lane] = o; else a.out[O_KRP + (size_t)row * 32 + lane] = o;
        }
    }
}
__device__ __forceinline__ void post_q_item(const MK& a, int idx, int lane) {
    const int row = idx >> 3, h = idx & 7;
    const float* q = a.Q + (size_t)row * 768 + h * 96;
    float* o = a.qh + ((size_t)row * 8 + h) * 96;
    const float v = q[lane];
    const float ss = wave_sum(v * v);
    o[lane] = v * rsqrtf(ss * (1.f / 64.f) + EPSV) * a.g_q_nope[lane];
    const float r = lane < 32 ? q[64 + lane] : 0.f;
    const float s2 = wave_sum(r * r);
    const float xn = lane < 32 ? r * rsqrtf(s2 * (1.f / 32.f) + EPSV) * a.g_q_rope[lane] : 0.f;
    const float other = __shfl_xor(xn, 16);
    const int i = lane & 15;
    const float pos = row >= NPT ? (float)PAST : (float)(row & 2047);
    const float ang = pos * powf(10000.f, -(float)i / 16.f);
    const float cs = cosf(ang), sn = sinf(ang);
    const float ov = lane < 16 ? xn * cs - other * sn : other * sn + xn * cs;
    if (lane < 32) o[64 + lane] = ov;
}
__device__ __forceinline__ void post_kv_item(const MK& a, int idx, int lane) {
    const int row = idx >> 3, h = idx & 7;
    const float v = a.KV[(size_t)row * 1024 + h * 128 + lane];
    const float ss = wave_sum(v * v);
    a.kh[((size_t)row * 8 + h) * 64 + lane] = v * rsqrtf(ss * (1.f / 64.f) + EPSV) * a.g_k_nope[lane];
}

__device__ __forceinline__ void attn_unit(const MK& a, int u2, int lane, char* wsm) {
    const int u = u2 >> 1, dh = (u2 & 1) * 32;
    float (*sK)[96] = (float (*)[96])wsm;
    float (*sV)[32] = (float (*)[32])(wsm + 6144);
    const int qb = 31 - (u & 31), h = (u >> 5) & 7, b = u >> 8;
    const int qi = qb * 64 + lane; const size_t row = (size_t)b * SEQ + qi;
    unsigned q[48]; float o[32];
    const float scale = 0.10206207261596577f;
#pragma unroll
    for (int d = 0; d < 48; ++d) q[d] = pk2bf(a.qh[(row * 8 + h) * 96 + 2 * d] * scale, a.qh[(row * 8 + h) * 96 + 2 * d + 1] * scale);
#pragma unroll
    for (int d = 0; d < 32; ++d) o[d] = 0.f;
    float m = -INFINITY, l = 0.f;
    const int nkt = (qb * 64 + 64) / 16;
    for (int kt = 0; kt < nkt; ++kt) {
        WSYNC();
        for (int e = lane; e < 16 * 96; e += 64) { const int j = e / 96, d = e % 96; const size_t kr = (size_t)b * SEQ + kt * 16 + j; sK[j][d] = d < 64 ? a.kh[(kr * 8 + h) * 64 + d] : a.krf[kr * 32 + (d - 64)]; }
        for (int e = lane; e < 16 * 32; e += 64) { const int j = e >> 5, d = e & 31; const size_t kr = (size_t)b * SEQ + kt * 16 + j; sV[j][d] = a.KV[kr * 1024 + h * 128 + 64 + dh + d]; }
        WSYNC();
        float s[16]; float tm = -INFINITY;
#pragma unroll
        for (int j = 0; j < 16; ++j) {
            float acc = 0.f;
#pragma unroll
            for (int d = 0; d < 96; d += 4) { const float4 kk = *(const float4*)&sK[j][d]; const unsigned q0 = q[d >> 1], q1 = q[(d >> 1) + 1];
                acc += __uint_as_float(q0 << 16) * kk.x + __uint_as_float(q0 & 0xffff0000u) * kk.y + __uint_as_float(q1 << 16) * kk.z + __uint_as_float(q1 & 0xffff0000u) * kk.w; }
            if (kt * 16 + j > qi) acc = -INFINITY;
            s[j] = acc; tm = fmaxf(tm, acc);
            asm volatile("" ::: "memory");
        }
        const float mn = fmaxf(m, tm);
        const float alpha = expf(m - mn);
        l *= alpha;
#pragma unroll
        for (int d = 0; d < 32; ++d) o[d] *= alpha;
#pragma unroll
        for (int j = 0; j < 16; ++j) {
            const float p = expf(s[j] - mn); l += p;
#pragma unroll
            for (int d = 0; d < 32; d += 4) { const float4 vv = *(const float4*)&sV[j][d]; o[d] += p * vv.x; o[d + 1] += p * vv.y; o[d + 2] += p * vv.z; o[d + 3] += p * vv.w; }
            asm volatile("" ::: "memory");
        }
        m = mn;
    }
    const float il = 1.f / l;
#pragma unroll
    for (int d = 0; d < 32; ++d) a.omix[row * 1024 + 512 + h * 64 + dh + d] = f2bf(o[d] * il);
}

__device__ __forceinline__ void gdn_unit(const MK& a, int b, int h, int dvh, const float* s0, float* sout, int row0, int T, int lane, char* wsm) {
    float (*sq)[64] = (float (*)[64])wsm;
    float (*sk)[64] = (float (*)[64])(wsm + 4096);
    const int e = lane & 31, kh = lane >> 5, col = dvh * 32 + e;
    float S[32];
#pragma unroll
    for (int d = 0; d < 32; ++d) S[d] = s0 ? s0[(((size_t)b * 8 + h) * 64 + kh * 32 + d) * 64 + col] : 0.f;
    for (int t0 = 0; t0 < T; t0 += 16) {
        const int nt = (T - t0) < 16 ? (T - t0) : 16;
        WSYNC();
        for (int j = 0; j < nt; ++j) { const size_t r = (size_t)row0 + (size_t)b * T + t0 + j; sq[j][lane] = a.qf[r * 512 + h * 64 + lane]; sk[j][lane] = a.kf[r * 512 + h * 64 + lane]; }
        WSYNC();
        for (int j = 0; j < nt; ++j) {
            const size_t r = (size_t)row0 + (size_t)b * T + t0 + j;
            const float v = a.vf[r * 512 + h * 64 + col], g = a.gg[r * 8 + h], be = a.bb[r * 8 + h];
            const float dec = expf(g);
            float ks = 0.f;
#pragma unroll
            for (int d = 0; d < 32; ++d) { S[d] *= dec; ks += sk[j][kh * 32 + d] * S[d]; }
            ks += __shfl_xor(ks, 32);
            const float delta = (v - ks) * be;
            float ov = 0.f;
#pragma unroll
            for (int d = 0; d < 32; ++d) { S[d] += sk[j][kh * 32 + d] * delta; ov += sq[j][kh * 32 + d] * S[d]; }
            ov += __shfl_xor(ov, 32);
            if (kh == 0) a.goraw[r * 512 + h * 64 + col] = ov;
        }
    }
#pragma unroll
    for (int d = 0; d < 32; ++d) sout[(((size_t)b * 8 + h) * 64 + kh * 32 + d) * 64 + col] = S[d];
}
__device__ __forceinline__ void gdn_out_item(const MK& a, int idx, int lane) {
    const int row = idx >> 3, h = idx & 7;
    const float ov = a.goraw[(size_t)row * 512 + h * 64 + lane];
    const float ss = wave_sum(ov * ov);
    const float on = ov * rsqrtf(ss * (1.f / 64.f) + EPSV) * a.g_gdn_out[lane];
    const float zg = bf2f(a.Z[(size_t)row * ZW + OFF_Z + h * 64 + lane]);
    a.omix[(size_t)row * 1024 + h * 64 + lane] = f2bf(on * siluf_(zg));
}

__device__ __forceinline__ void samp_scores_item(const MK& a, int m, int lane) {
    const int b = m >> 14, t = m & 16383, h = lane >> 3, ch = lane & 7;
    const bf16x8 kv = *(const bf16x8*)(a.KN + (size_t)m * 512 + h * 64 + ch * 8);
    const float* q = a.qh + ((size_t)(NPT + b) * 8 + h) * 96;
    float ss = 0.f, dot = 0.f;
#pragma unroll
    for (int j = 0; j < 8; ++j) { const float x = bf2f((bf16_t)kv[j]); ss += x * x; dot += x * a.g_k_nope[ch * 8 + j] * q[ch * 8 + j]; }
    const int phys = a.page_table[b * NPAGES + (t >> 7)];
    const float* kr = a.cache_krope + ((size_t)phys * 128 + (t & 127)) * 32 + ch * 4;
    float rd = 0.f;
#pragma unroll
    for (int j = 0; j < 4; ++j) rd += kr[j] * q[64 + ch * 4 + j];
#pragma unroll
    for (int o = 1; o < 8; o <<= 1) { ss += __shfl_xor(ss, o); dot += __shfl_xor(dot, o); rd += __shfl_xor(rd, o); }
    if (ch == 0) a.SC[((size_t)b * 8 + h) * PAST + t] = (dot * rsqrtf(ss * (1.f / 64.f) + EPSV) + rd) * 0.10206207261596577f;
}
__device__ __forceinline__ void samp_part_unit(const MK& a, int u, char* smem) {
    float* sm = (float*)smem; float (*sp)[8] = (float (*)[8])(smem + 64);
    const int b = u >> 3, sp_i = u & 7, tid = threadIdx.x & 255, lane = tid & 63, wid = tid >> 6;
    const int t0 = sp_i * 2048;
    __syncthreads();
    for (int hh = 0; hh < 2; ++hh) {
        const int h = wid + 4 * hh; float mx = -INFINITY;
        for (int t = lane; t < 2048; t += 64) mx = fmaxf(mx, a.SC[((size_t)b * 8 + h) * PAST + t0 + t]);
#pragma unroll
        for (int o = 1; o < 64; o <<= 1) mx = fmaxf(mx, __shfl_xor(mx, o));
        if (lane == 0) sm[h] = mx;
    }
    __syncthreads();
    float lat[8], lsum = 0.f;
#pragma unroll
    for (int h = 0; h < 8; ++h) lat[h] = 0.f;
    for (int tc = 0; tc < 2048; tc += 64) {
        __syncthreads();
        for (int e = tid; e < 512; e += 256) { const int j = e >> 3, h = e & 7; sp[j][h] = expf(a.SC[((size_t)b * 8 + h) * PAST + t0 + tc + j] - sm[h]); }
        __syncthreads();
        if (tid < 8) { for (int j = 0; j < 64; ++j) lsum += sp[j][tid]; }
        const int phys = a.page_table[b * NPAGES + ((t0 + tc) >> 7)];
        const float* base = a.cache_ckv + ((size_t)phys * 128 + ((t0 + tc) & 127)) * 256 + tid;
        for (int j = 0; j < 64; ++j) {
            const float cv = base[(size_t)j * 256];
#pragma unroll
            for (int h = 0; h < 8; ++h) lat[h] += sp[j][h] * cv;
        }
    }
    float* o = a.part + (size_t)u * 8 * 258;
#pragma unroll
    for (int h = 0; h < 8; ++h) o[h * 258 + 2 + tid] = lat[h];
    if (tid < 8) { o[tid * 258 + 0] = sm[tid]; o[tid * 258 + 1] = lsum; }
}
__device__ __forceinline__ void samp_comb_unit(const MK& a, int u, char* smem) {
    float* slat = (float*)smem;
    const int b = u >> 3, h = u & 7, tid = threadIdx.x & 255;
    const size_t row = NPT + b;
    const float* q = a.qh + (row * 8 + h) * 96;
    float s_self = 0.f;
    for (int d = 0; d < 64; ++d) s_self += q[d] * a.kh[(row * 8 + h) * 64 + d];
    for (int d = 0; d < 32; ++d) s_self += q[64 + d] * a.krf[row * 32 + d];
    s_self *= 0.10206207261596577f;
    float m = s_self;
    for (int s = 0; s < 8; ++s) m = fmaxf(m, a.part[((size_t)(b * 8 + s) * 8 + h) * 258]);
    const float pself = expf(s_self - m);
    float l = pself, lat = 0.f;
    for (int s = 0; s < 8; ++s) {
        const float* p = a.part + ((size_t)(b * 8 + s) * 8 + h) * 258;
        const float w = expf(p[0] - m);
        l += p[1] * w; lat += p[2 + tid] * w;
    }
    __syncthreads();
    slat[tid] = lat;
    __syncthreads();
    if (tid < 64) {
        float o = 0.f;
        for (int c = 0; c < 256; ++c) o += slat[c] * a.w_kv_b[(size_t)c * 1024 + h * 128 + 64 + tid];
        o += pself * a.KV[row * 1024 + h * 128 + 64 + tid];
        a.omix[row * 1024 + 512 + h * 64 + tid] = f2bf(o / l);
    }
}

#define LDS_BYTES 147456
#define GSYNC() do { grid.sync(); } while (0)
__global__ __launch_bounds__(NTHR, 2) void mega(MK a) {
    cg::grid_group grid = cg::this_grid();
    extern __shared__ __attribute__((aligned(16))) unsigned char lds_raw[];
    char* smem = (char*)lds_raw;
    LAS unsigned char* lds = (LAS unsigned char*)lds_raw;
    const int tid = threadIdx.x, lane = tid & 63, wid = tid >> 6, half = tid >> 8;
    const int bid = blockIdx.x, nb = gridDim.x;
    const int gw = bid * NWAVE + wid, ngw = nb * NWAVE;

    {
        const int T0 = 88 * 32, T1 = 24 * 12, T2 = 32 * 8, T3 = 16 * 8, T4 = 32 * 32, T5 = 176 * 32, T7 = 32 * 88, T8 = 32 * 32, T9 = 32 * 8;
        const int TT = T0 + T1 + T2 + T3 + T4 + T5 + T7 + T8 + T9;
        float* t = (float*)(smem + half * 8192);
        for (int it0 = bid * 2; it0 < TT; it0 += nb * 2) {
            const int it = it0 + half; const bool act = it < TT;
            int r = act ? it : 0;
            if (r < T0) { wt_tile(act, a.w_in, a.WinT, 2736, 0, 2736, 1024, r % 88, r / 88, t); continue; } r -= T0;
            if (r < T1) { wt_tile(act, a.w_q_b, a.WqbT, 768, 0, 768, 384, r % 24, r / 24, t); continue; } r -= T1;
            if (r < T2) { wt_tile(act, a.w_kv_b, a.WkvT, 1024, 0, 1024, 256, r % 32, r / 32, t); continue; } r -= T2;
            if (r < T3) { const int nbk = r % 16, kb = r / 16, h = nbk >> 1; wt_tile(act, a.w_kv_b, a.WknT + (size_t)h * 64 * 256, 1024, h * 128, 64, 256, nbk & 1, kb, t); continue; } r -= T3;
            if (r < T4) { wt_tile(act, a.w_o, a.WoT, 1024, 0, 1024, 1024, r % 32, r / 32, t); continue; } r -= T4;
            if (r < T5) { const int nbk = r % 176, kb = r / 176, pn = nbk >> 3, wi = nbk & 7;
                wt_tile(act, wi < 4 ? a.w_gate : a.w_up, a.WguT + (size_t)nbk * 32 * 1024, DFF, pn * 128 + (wi & 3) * 32, 32, 1024, 0, kb, t); continue; } r -= T5;
            if (r < T7) { wt_tile(act, a.w_down, a.WdT, 1024, 0, 1024, DFF, r % 32, r / 32, t); continue; } r -= T7;
            if (r < T8) { wt_tile(act, a.w_ple_gate, a.WpgT, 1024, 0, 1024, 1024, r % 32, r / 32, t); continue; } r -= T8;
            wt_tile(act, a.w_ple_proj, a.WppT, 1024, 0, 1024, 256, r % 32, r / 32, t);
        }
        for (int row = gw; row < MPAD; row += ngw) {
            const float* src = row < NPT ? a.x_prompt + (size_t)row * 1024 : a.x_sample + (size_t)(row < NTOK ? row - NPT : 0) * 1024;
            rms1024_row(src, a.g_attn, a.xn + (size_t)row * 1024, row >= NTOK, lane);
            ushort4 w = {0, 0, 0, 0};
            if (row < NTOK) { const float* ps = row < NPT ? a.p_prompt + (size_t)row * 256 : a.p_sample + (size_t)(row - NPT) * 256; const float4 v = *(const float4*)(ps + lane * 4); w.x = f2bf(v.x); w.y = f2bf(v.y); w.z = f2bf(v.z); w.w = f2bf(v.w); }
            *(ushort4*)(a.pb + (size_t)row * 256 + lane * 4) = w;
            if (row >= NTOK) { for (int j = 0; j < 4; ++j) { ushort4 z = {0, 0, 0, 0}; *(ushort4*)(a.omix + (size_t)row * 1024 + lane * 4 + 256 * j) = z; } }
        }
    }
    GSYNC();
    pg_gemm(lds, a.xn, a.WinT, NPT, ZW, 1024, PgBf16{a.Z, ZW});
    pg_gemm(lds, a.pb, a.WppT, NPT, 1024, 256, PgF32{a.PP, 1024});
    gemm_sample_rows(a.xn, 1024, a.WinT, 1024, ZW, EwBf16{a.Z, ZW}, smem, bid, nb);
    gemm_sample_rows(a.pb, 256, a.WppT, 256, 1024, EwF32{a.PP, 1024}, smem, bid, nb);
    GSYNC();
    for (int r0 = bid * 2; r0 < NTOK; r0 += nb * 2) post_in_row(a, r0 + half, (float*)(smem + half * 64));
    GSYNC();
    for (int u = gw; u < 128 + NST * 16; u += ngw) {
        if (u < 128) gdn_unit(a, u >> 4, (u >> 1) & 7, u & 1, nullptr, a.out + O_GSP, 0, SEQ, lane, smem + wid * 10240);
        else { const int v = u - 128; gdn_unit(a, v >> 4, (v >> 1) & 7, v & 1, a.state_gdn, a.out + O_GSS, NPT, 1, lane, smem + wid * 10240); }
    }
    __syncthreads();
    pg_gemm(lds, a.qan, a.WqbT, NPT, 768, 384, PgF32{a.Q, 768});
    pg_gemm(lds, a.ckvb, a.WkvT, NPT, 1024, 256, PgF32{a.KV, 1024});
    gemm_sample_rows(a.qan, 384, a.WqbT, 384, 768, EwF32{a.Q, 768}, smem, bid, nb);
    gemm_sample_rows(a.ckvb, 256, a.WkvT, 256, 1024, EwF32{a.KV, 1024}, smem, bid, nb);
    for (int t = bid; t < (NST * PAST / 256) * 4; t += nb) gemm_tile_256x128(ACache{a.cache_ckv, a.page_table}, a.WknT, 256, 256, EwBf16{a.KN, 512}, (t >> 2) * 256, (t & 3) * 128, smem);
    GSYNC();
    for (int idx = gw; idx < NTOK * 8; idx += ngw) { post_q_item(a, idx, lane); post_kv_item(a, idx, lane); gdn_out_item(a, idx, lane); }
    GSYNC();
    for (int u = gw; u < 4096; u += ngw) attn_unit(a, u, lane, smem + wid * 10240);
    for (int m = gw; m < NST * PAST; m += ngw) samp_scores_item(a, m, lane);
    GSYNC();
    for (int u0 = bid * 2; u0 < NST * 8; u0 += nb * 2) samp_part_unit(a, u0 + half, smem + half * 4096);
    GSYNC();
    for (int u0 = bid * 2; u0 < NST * 8; u0 += nb * 2) samp_comb_unit(a, u0 + half, smem + half * 4096);
    GSYNC();
    pg_gemm(lds, a.omix, a.WoT, NPT, 1024, 1024, PgRes{a.x_prompt, a.H});
    gemm_sample_rows(a.omix, 1024, a.WoT, 1024, 1024, EwResX{a.x_sample, a.H}, smem, bid, nb);
    GSYNC();
    for (int row = gw; row < MPAD; row += ngw) rms1024_row(a.H + (size_t)row * 1024, a.g_ffn, a.un + (size_t)row * 1024, row >= NTOK, lane);
    GSYNC();
    pg_gemm(lds, a.un, a.WguT, NPT, 2 * DFF, 1024, PgSwiglu{a.hid});
    gemm_sample_rows(a.un, 1024, a.WguT, 1024, 2 * DFF, EwSwiglu{a.G, a.hid}, smem, bid, nb);
    __threadfence(); __syncthreads();
    gemm_sample_rows(a.un, 1024, a.WguT, 1024, 2 * DFF, EwSwiglu2{a.G, a.hid}, smem, bid, nb);
    GSYNC();
    pg_gemm(lds, a.hid, a.WdT, NPT, 1024, DFF, PgRes{a.H, a.H2});
    gemm_sample_rows(a.hid, DFF, a.WdT, DFF, 1024, EwResH{a.H, a.H2}, smem, bid, nb);
    GSYNC();
    for (int row = gw; row < MPAD; row += ngw) rms1024_row(a.H2 + (size_t)row * 1024, a.g_ple, a.un2 + (size_t)row * 1024, row >= NTOK, lane);
    GSYNC();
    pg_gemm(lds, a.un2, a.WpgT, NPT, 1024, 1024, PgPle{a.H2, a.PP, a.out});
    gemm_sample_rows(a.un2, 1024, a.WpgT, 1024, 1024, EwPle{a.H2, a.PP, a.out}, smem, bid, nb);
}

static inline char* carve(char*& p, size_t bytes) { char* r = p; p += (bytes + 255) & ~(size_t)255; return r; }

extern "C" void kernel_launch(void* const* d_in, const int* in_sizes, int n_in, void* d_out, int out_size, void* d_ws, size_t ws_size, hipStream_t stream) {
    MK a{};
    a.x_prompt = (const float*)d_in[0]; a.x_sample = (const float*)d_in[1]; a.cache_ckv = (const float*)d_in[2]; a.cache_krope = (const float*)d_in[3];
    a.state_gdn = (const float*)d_in[4]; a.state_conv = (const float*)d_in[5]; a.page_table = (const int*)d_in[6]; a.p_prompt = (const float*)d_in[7]; a.p_sample = (const float*)d_in[8];
    a.g_attn = (const float*)d_in[9]; a.w_in = (const float*)d_in[10]; a.w_conv = (const float*)d_in[11]; a.a_log = (const float*)d_in[12]; a.dt_bias = (const float*)d_in[13];
    a.g_gdn_out = (const float*)d_in[14]; a.g_q_a = (const float*)d_in[15]; a.w_q_b = (const float*)d_in[16]; a.g_q_nope = (const float*)d_in[17]; a.g_q_rope = (const float*)d_in[18];
    a.g_kv_a = (const float*)d_in[19]; a.g_k_rope = (const float*)d_in[20]; a.w_kv_b = (const float*)d_in[21]; a.g_k_nope = (const float*)d_in[22]; a.w_o = (const float*)d_in[23];
    a.g_ffn = (const float*)d_in[24]; a.w_gate = (const float*)d_in[25]; a.w_up = (const float*)d_in[26]; a.w_down = (const float*)d_in[27]; a.g_ple = (const float*)d_in[28];
    a.w_ple_gate = (const float*)d_in[29]; a.w_ple_proj = (const float*)d_in[30];
    a.out = (float*)d_out;
    char* p = (char*)d_ws;
    a.WinT = (bf16_t*)carve(p, (size_t)ZW * 1024 * 2);
    a.WqbT = (bf16_t*)carve(p, (size_t)768 * 384 * 2);
    a.WkvT = (bf16_t*)carve(p, (size_t)1024 * 256 * 2);
    a.WknT = (bf16_t*)carve(p, (size_t)512 * 256 * 2);
    a.WoT = (bf16_t*)carve(p, (size_t)1024 * 1024 * 2);
    a.WguT = (bf16_t*)carve(p, (size_t)2 * DFF * 1024 * 2);
    a.WdT = (bf16_t*)carve(p, (size_t)1024 * DFF * 2);
    a.WpgT = (bf16_t*)carve(p, (size_t)1024 * 1024 * 2);
    a.WppT = (bf16_t*)carve(p, (size_t)1024 * 256 * 2);
    a.xn = (bf16_t*)carve(p, (size_t)MPAD * 1024 * 2);
    a.pb = (bf16_t*)carve(p, (size_t)MPAD * 256 * 2);
    a.Z = (bf16_t*)carve(p, (size_t)MPAD * ZW * 2);
    a.qf = (float*)carve(p, (size_t)MPAD * 512 * 4);
    a.kf = (float*)carve(p, (size_t)MPAD * 512 * 4);
    a.vf = (float*)carve(p, (size_t)MPAD * 512 * 4);
    a.gg = (float*)carve(p, (size_t)MPAD * 8 * 4);
    a.bb = (float*)carve(p, (size_t)MPAD * 8 * 4);
    a.goraw = (float*)carve(p, (size_t)MPAD * 512 * 4);
    a.qan = (bf16_t*)carve(p, (size_t)MPAD * 384 * 2);
    a.ckvb = (bf16_t*)carve(p, (size_t)MPAD * 256 * 2);
    a.krf = (float*)carve(p, (size_t)MPAD * 32 * 4);
    a.Q = (float*)carve(p, (size_t)MPAD * 768 * 4);
    a.qh = (float*)carve(p, (size_t)MPAD * 768 * 4);
    a.KV = (float*)carve(p, (size_t)MPAD * 1024 * 4);
    a.kh = (float*)carve(p, (size_t)MPAD * 512 * 4);
    a.omix = (bf16_t*)carve(p, (size_t)MPAD * 1024 * 2);
    a.KN = (bf16_t*)carve(p, (size_t)NST * PAST * 512 * 2);
    a.SC = (float*)carve(p, (size_t)NST * 8 * PAST * 4);
    a.part = (float*)carve(p, (size_t)NST * 8 * 8 * 258 * 4);
    a.H = (float*)carve(p, (size_t)MPAD * 1024 * 4);
    a.un = (bf16_t*)carve(p, (size_t)MPAD * 1024 * 2);
    a.G = (float*)carve(p, (size_t)NST * DFF * 4);
    a.hid = (bf16_t*)carve(p, (size_t)MPAD * DFF * 2);
    a.H2 = (float*)carve(p, (size_t)MPAD * 1024 * 4);
    a.un2 = (bf16_t*)carve(p, (size_t)MPAD * 1024 * 2);
    a.PP = (float*)carve(p, (size_t)MPAD * 1024 * 4);
    if ((size_t)(p - (char*)d_ws) > ws_size) { fprintf(stderr, "kernel_launch: workspace too small: need %zu have %zu\n", (size_t)(p - (char*)d_ws), ws_size); return; }

    static int grid_blocks = 0;
    if (!grid_blocks) {
        int dev = 0, cus = 0, per_cu = 0;
        (void)hipGetDevice(&dev);
        (void)hipDeviceGetAttribute(&cus, hipDeviceAttributeMultiprocessorCount, dev);
        (void)hipFuncSetAttribute((const void*)mega, hipFuncAttributeMaxDynamicSharedMemorySize, LDS_BYTES);
        (void)hipOccupancyMaxActiveBlocksPerMultiprocessor(&per_cu, (const void*)mega, NTHR, LDS_BYTES);
        if (per_cu < 1) fprintf(stderr, "kernel_launch: occupancy query says %d blocks/CU\n", per_cu);
        grid_blocks = cus;
    }
    void* args[] = {&a};
    hipError_t e = hipLaunchCooperativeKernel((const void*)mega, dim3(grid_blocks), dim3(NTHR), args, LDS_BYTES, stream);
    if (e != hipSuccess) fprintf(stderr, "cooperative launch failed: %s (grid %d)\n", hipGetErrorString(e), grid_blocks);
}
```

```cpp
#include <hip/hip_runtime.h>
#include <stdint.h>
#include <cstdio>
#include <hip/hip_cooperative_groups.h>
namespace cg = cooperative_groups;


namespace pg8 {
#define PG8_LAS __attribute__((address_space(3)))
typedef unsigned short bf16_t;
typedef short bf16x8 __attribute__((ext_vector_type(8)));
typedef float f32x4 __attribute__((ext_vector_type(4)));
typedef unsigned u32x4 __attribute__((ext_vector_type(4)));
constexpr int BM = 256, BK = 64, HALF = 128, HTB = HALF * BK * 2  , STAGE_BYTES = 8 * HTB, NXCD = 8, WGM = 8;

__host__ __device__ __forceinline__ int lds_byte(int r, int c) { const int st = (r >> 4) * 2 + (c >> 5), rr = r & 15, cc = c & 31, ob = rr * 64 + cc * 2; return st * 1024 + (ob ^ (((ob >> 9) & 1) << 5)); }
__host__ __device__ __forceinline__ void stage_rc(int b, int& R, int& C) { const int st = b / 1024, sb = b % 1024, swz = sb ^ (((sb >> 9) & 1) << 5); R = (st >> 1) * 16 + swz / 64; C = (st & 1) * 32 + (swz % 64) / 2; }
__host__ __device__ __forceinline__ int perm32(int rho) { const int n = rho >> 4, i = rho & 15; return 8 * (i >> 2) + 4 * n + (i & 3); }

struct Unit { int pm, pn; };
struct Gemm { const bf16_t* A; const bf16_t* Bt; int M, N, K; };

struct StaticOrder {
    int nM, nN, nwg, G, c;
    __host__ __device__ void init(int M, int N, int G_, int c_) { nM = M / BM; nN = N / BM; nwg = nM * nN; G = G_; c = c_; }
    __host__ __device__ bool next(int i, Unit& u) const {
        const long L = (long)i * G + c; if (L >= nwg) return false;
        int wgid = (int)L; { const int q = nwg / NXCD, r = nwg % NXCD, xcd = wgid % NXCD, off = wgid / NXCD; wgid = (xcd < r ? xcd * (q + 1) : r * (q + 1) + (xcd - r) * q) + off; }
        const int nig = WGM * nN, gid = wgid / nig, fm = gid * WGM, gsz = (nM - fm) < WGM ? (nM - fm) : WGM;
        u.pm = fm + ((wgid % nig) % gsz); u.pn = (wgid % nig) / gsz; return true;
    }
    __device__ __forceinline__ void a_ready(const Unit&) const {}
    __device__ __forceinline__ void done(const Unit&) const {}
};

template <class Epi, class Sched, bool ALIGN_EPI = false, bool SP2 = false>
__device__ __forceinline__ void gemm_phase(PG8_LAS unsigned char* lds, const Gemm g, const Sched& S, const Epi& E) {
    const int tid = threadIdx.x, wid = __builtin_amdgcn_readfirstlane(tid >> 6), lane = tid & 63, wr = wid >> 2, wc = wid & 3, fr = lane & 15, fq = lane >> 4;
    const int K = g.K, nt = K / BK;
    unsigned voffA[2], voffB[2];
#pragma unroll
    for (int i = 0; i < 2; ++i) { int R, C; stage_rc(tid * 16 + i * 8192, R, C); const int Rb = Epi::PERM ? ((R & ~31) + perm32(R & 31)) : R;
        voffA[i] = (unsigned)(R * K + C) * 2u; voffB[i] = (unsigned)(Rb * K + C) * 2u; }
    const size_t kstep = (size_t)(BK * 2);
    const size_t hstep = (size_t)HALF * K * 2;
    const size_t tstep = 2 * hstep;
    const unsigned ldsw = (unsigned)wid * 1024u;
    const int aoff = lds_byte(wr * 64 + fr, fq * 8), boff = lds_byte(wc * 32 + fr, fq * 8);
#define PG8_SA(b, h) (((b) * 2 + (h)) * HTB)
#define PG8_SB(b, h) ((4 + (b) * 2 + (h)) * HTB)
#define PG8_STAGE(bufoff, gbase, voff) do { _Pragma("unroll") for (int _i = 0; _i < 2; ++_i) \
        __builtin_amdgcn_global_load_lds((const unsigned*)((const char*)(gbase) + (voff)[_i]), (PG8_LAS unsigned*)(lds + (bufoff) + ldsw + _i * 8192), 16, 0, 0); } while (0)
#define PG8_LDA(dst, b, h) do { _Pragma("unroll") for (int m = 0; m < 4; ++m) _Pragma("unroll") for (int k = 0; k < 2; ++k) dst[m][k] = *(const PG8_LAS bf16x8*)(lds + PG8_SA(b, h) + aoff + m * 2048 + k * 1024); } while (0)
#define PG8_LDB(dst, b, h) do { _Pragma("unroll") for (int n = 0; n < 2; ++n) _Pragma("unroll") for (int k = 0; k < 2; ++k) dst[n][k] = *(const PG8_LAS bf16x8*)(lds + PG8_SB(b, h) + boff + n * 2048 + k * 1024); } while (0)
#define PG8_MMA(ai, bj, At, Bt) do { __builtin_amdgcn_s_setprio(1); _Pragma("unroll") for (int m = 0; m < 4; ++m) _Pragma("unroll") for (int n = 0; n < 2; ++n) _Pragma("unroll") for (int k = 0; k < 2; ++k) \
        acc[ai][bj][m][n] = __builtin_amdgcn_mfma_f32_16x16x32_bf16(Bt[n][k], At[m][k], acc[ai][bj][m][n], 0, 0, 0); __builtin_amdgcn_s_setprio(0); } while (0)
#define PG8_WAIT_V(n) asm volatile("s_waitcnt vmcnt(" #n ")" ::: "memory")
#define PG8_WAIT_L(n) asm volatile("s_waitcnt lgkmcnt(" #n ")" ::: "memory")
#define PG8_BAR __builtin_amdgcn_s_barrier()
#define PG8_SCHED __builtin_amdgcn_sched_barrier(0)
    Unit cur, nxt; int ui = 0;
    if (!S.next(0, cur)) return;
    f32x4 acc[2][2][4][2];
#pragma unroll
    for (int a = 0; a < 2; ++a)
#pragma unroll
        for (int b = 0; b < 2; ++b)
#pragma unroll
            for (int m = 0; m < 4; ++m)
#pragma unroll
                for (int n = 0; n < 2; ++n) acc[a][b][m][n] = (f32x4){0.f, 0.f, 0.f, 0.f};
    bf16x8 At[4][2], B0[2][2], B1[2][2];
    const char* cA = (const char*)g.A + (size_t)cur.pm * tstep; const char* cB = (const char*)g.Bt + (size_t)cur.pn * tstep;
    S.a_ready(cur);
    if constexpr (SP2) {
        PG8_STAGE(PG8_SB(0, 0), cB, voffB); PG8_STAGE(PG8_SB(0, 1), cB + hstep, voffB); PG8_STAGE(PG8_SA(0, 0), cA, voffA); PG8_STAGE(PG8_SA(0, 1), cA + hstep, voffA);
        if (wr == 1) PG8_BAR;
        PG8_WAIT_V(2); PG8_BAR;
        PG8_STAGE(PG8_SB(1, 0), cB + kstep, voffB); PG8_STAGE(PG8_SA(1, 0), cA + kstep, voffA); PG8_STAGE(PG8_SB(1, 1), cB + hstep + kstep, voffB);
        PG8_WAIT_V(6); PG8_BAR;
    } else {
        PG8_STAGE(PG8_SB(0, 0), cB, voffB); PG8_STAGE(PG8_SA(0, 0), cA, voffA); PG8_STAGE(PG8_SB(0, 1), cB + hstep, voffB); PG8_STAGE(PG8_SA(0, 1), cA + hstep, voffA);
        if (wr == 1) PG8_BAR;
        PG8_WAIT_V(4); PG8_BAR;
        PG8_STAGE(PG8_SB(1, 0), cB + kstep, voffB); PG8_STAGE(PG8_SA(1, 0), cA + kstep, voffA); PG8_STAGE(PG8_SB(1, 1), cB + hstep + kstep, voffB);
        PG8_WAIT_V(6); PG8_BAR;
    }
    for (;;) {
        const bool has_next = S.next(ui + 1, nxt);
        const char* nA = has_next ? (const char*)g.A + (size_t)nxt.pm * tstep : cA; const char* nB = has_next ? (const char*)g.Bt + (size_t)nxt.pn * tstep : cB;
        for (int t = 0; t < nt; t += 2) {
            const bool last = (t == nt - 2);
            const char* a1 = cA + (size_t)(t + 1) * kstep;
            const char* a2 = last ? nA : cA + (size_t)(t + 2) * kstep; const char* b2 = last ? nB : cB + (size_t)(t + 2) * kstep;
            const char* a3 = a2 + kstep; const char* b3 = b2 + kstep;
            if (last && has_next) S.a_ready(nxt);
            if constexpr (SP2) {
            PG8_LDB(B0, 0, 0); PG8_LDB(B1, 0, 1); PG8_SCHED; PG8_LDA(At, 0, 0); PG8_STAGE(PG8_SA(1, 1), a1 + hstep, voffA);
            PG8_WAIT_V(8); PG8_WAIT_L(0); PG8_BAR; PG8_MMA(0, 0, At, B0); PG8_MMA(0, 1, At, B1); PG8_BAR; PG8_SCHED;
            PG8_LDA(At, 0, 1); PG8_STAGE(PG8_SB(0, 0), b2, voffB); PG8_STAGE(PG8_SB(0, 1), b2 + hstep, voffB); PG8_STAGE(PG8_SA(0, 0), a2, voffA);
            PG8_WAIT_V(8); PG8_WAIT_L(0); PG8_BAR; PG8_MMA(1, 0, At, B0); PG8_MMA(1, 1, At, B1); PG8_BAR; PG8_SCHED;
            PG8_LDB(B0, 1, 0); PG8_LDB(B1, 1, 1); PG8_SCHED; PG8_LDA(At, 1, 0); PG8_STAGE(PG8_SA(0, 1), a2 + hstep, voffA);
            PG8_WAIT_V(8); PG8_WAIT_L(0); PG8_BAR; PG8_MMA(0, 0, At, B0); PG8_MMA(0, 1, At, B1); PG8_BAR; PG8_SCHED;
            PG8_LDA(At, 1, 1); PG8_STAGE(PG8_SB(1, 0), b3, voffB); PG8_STAGE(PG8_SB(1, 1), b3 + hstep, voffB); PG8_STAGE(PG8_SA(1, 0), a3, voffA);
            PG8_WAIT_V(8); PG8_WAIT_L(0); PG8_BAR; PG8_MMA(1, 0, At, B0); PG8_MMA(1, 1, At, B1); PG8_BAR; PG8_SCHED;
            } else {
            PG8_LDB(B0, 0, 0); PG8_SCHED; PG8_LDA(At, 0, 0); PG8_STAGE(PG8_SA(1, 1), a1 + hstep, voffA);
            PG8_WAIT_L(8); PG8_BAR; PG8_WAIT_L(0); PG8_MMA(0, 0, At, B0); PG8_BAR; PG8_SCHED;
            PG8_LDB(B1, 0, 1); PG8_STAGE(PG8_SB(0, 0), b2, voffB);
            PG8_BAR; PG8_WAIT_L(0); PG8_MMA(0, 1, At, B1); PG8_BAR;
            PG8_LDA(At, 0, 1); PG8_STAGE(PG8_SA(0, 0), a2, voffA);
            PG8_BAR; PG8_WAIT_L(0); PG8_MMA(1, 0, At, B0); PG8_BAR; PG8_SCHED;
            PG8_STAGE(PG8_SB(0, 1), b2 + hstep, voffB);
            PG8_WAIT_V(6); PG8_BAR; PG8_MMA(1, 1, At, B1); PG8_BAR;
            PG8_LDB(B0, 1, 0); PG8_SCHED; PG8_LDA(At, 1, 0); PG8_STAGE(PG8_SA(0, 1), a2 + hstep, voffA);
            PG8_WAIT_L(8); PG8_BAR; PG8_WAIT_L(0); PG8_MMA(0, 0, At, B0); PG8_BAR; PG8_SCHED;
            PG8_LDB(B1, 1, 1); PG8_STAGE(PG8_SB(1, 0), b3, voffB);
            PG8_BAR; PG8_WAIT_L(0); PG8_MMA(0, 1, At, B1); PG8_BAR;
            PG8_LDA(At, 1, 1); PG8_STAGE(PG8_SA(1, 0), a3, voffA);
            PG8_BAR; PG8_WAIT_L(0); PG8_MMA(1, 0, At, B0); PG8_BAR; PG8_SCHED;
            PG8_STAGE(PG8_SB(1, 1), b3 + hstep, voffB);
            PG8_WAIT_V(6); PG8_BAR; PG8_MMA(1, 1, At, B1); PG8_BAR;
            }
        }
        if constexpr (ALIGN_EPI) { if (wr == 0) PG8_BAR; }
        if constexpr (!Epi::AFTER_DRAIN) { E(acc, cur, wr, wc, fr, fq); S.done(cur); }
        if (!has_next) break;
#pragma unroll
        for (int a = 0; a < 2; ++a)
#pragma unroll
            for (int b = 0; b < 2; ++b)
#pragma unroll
                for (int m = 0; m < 4; ++m)
#pragma unroll
                    for (int n = 0; n < 2; ++n) acc[a][b][m][n] = (f32x4){0.f, 0.f, 0.f, 0.f};
        cur = nxt; cA = nA; cB = nB; ++ui;
        if constexpr (ALIGN_EPI) { if (wr == 1) PG8_BAR; }
    }
    PG8_WAIT_V(0);
    if constexpr (!ALIGN_EPI) { if (wr == 0) PG8_BAR; }
    PG8_BAR;
    if constexpr (Epi::AFTER_DRAIN) { E.fused(acc, cur, wr, wc, fr, fq, lds, wid, lane); S.done(cur); }
#undef PG8_SA
#undef PG8_SB
#undef PG8_STAGE
#undef PG8_LDA
#undef PG8_LDB
#undef PG8_MMA
#undef PG8_WAIT_V
#undef PG8_WAIT_L
#undef PG8_BAR
#undef PG8_SCHED
}
}

using pg8::bf16_t; using pg8::bf16x8; using pg8::f32x4; using pg8::u32x4;
#define LAS __attribute__((address_space(3)))

#define DMODEL 1024
#define NPT 16384
#define NST 32
#define NTOK 16416
#define MPAD 16640
#define SEQ 2048
#define ZW 2816
#define OFF_A 1536
#define OFF_B 1544
#define OFF_Z 1552
#define OFF_QA 2064
#define OFF_KVA 2448
#define OFF_KR 2704
#define DFF 2816
#define PAST 16384
#define NPAGES 128
#define EPSV 1e-6f

#define O_YP 0
#define O_YS (O_YP + 16777216)
#define O_CKVP (O_YS + 32768)
#define O_KRP (O_CKVP + 4194304)
#define O_GSP (O_KRP + 524288)
#define O_CSP (O_GSP + 262144)
#define O_CKVS (O_CSP + 36864)
#define O_KRS (O_CKVS + 8192)
#define O_GSS (O_KRS + 1024)
#define O_CSS (O_GSS + 1048576)

__device__ __forceinline__ bf16_t f2bf(float f) { unsigned u = __float_as_uint(f); return (bf16_t)((u + 0x7fffu + ((u >> 16) & 1u)) >> 16); }
__device__ __forceinline__ float bf2f(bf16_t b) { return __uint_as_float(((unsigned)b) << 16); }
__device__ __forceinline__ float wave_sum(float v) {
#pragma unroll
    for (int o = 1; o < 64; o <<= 1) v += __shfl_xor(v, o);
    return v;
}
__device__ __forceinline__ float sigmoidf_(float x) { return 1.f / (1.f + expf(-x)); }
__device__ __forceinline__ float siluf_(float x) { return x / (1.f + expf(-x)); }


#define WSYNC() do { __builtin_amdgcn_fence(__ATOMIC_ACQ_REL, "wavefront"); __builtin_amdgcn_wave_barrier(); } while (0)
#define NTHR 512
#define NWAVE 8

__device__ __forceinline__ unsigned pk2bf(float lo, float hi) { return (unsigned)f2bf(lo) | ((unsigned)f2bf(hi) << 16); }

__device__ __forceinline__ void wt_tile(bool active, const float* __restrict__ W, bf16_t* __restrict__ Wt, int ldw, int col0, int N, int ldt, int nb_, int kb_, float* t  ) {
    const int tx = threadIdx.x & 31, ty = (threadIdx.x >> 5) & 7;
    const int n0 = nb_ * 32, k0 = kb_ * 32;
    __syncthreads();
    if (active) for (int i = ty; i < 32; i += 8) {
        const int k = k0 + i, n = n0 + tx; float v = 0.f;
        if (n < N) v = W[(size_t)k * ldw + col0 + n];
        t[i * 33 + tx] = v;
    }
    __syncthreads();
    if (active) for (int i = ty; i < 32; i += 8) { const int n = n0 + i, k = k0 + tx; Wt[(size_t)n * ldt + k] = f2bf(t[tx * 33 + i]); }
}

__device__ __forceinline__ void rms1024_row(const float* __restrict__ src, const float* __restrict__ g, bf16_t* __restrict__ o, bool zero, int lane) {
    if (zero) { for (int j = 0; j < 4; ++j) { ushort4 z = {0, 0, 0, 0}; *(ushort4*)(o + lane * 4 + 256 * j) = z; } return; }
    float4 v[4]; float ss = 0.f;
#pragma unroll
    for (int j = 0; j < 4; ++j) { v[j] = *(const float4*)(src + lane * 4 + 256 * j); ss += v[j].x * v[j].x + v[j].y * v[j].y + v[j].z * v[j].z + v[j].w * v[j].w; }
    ss = wave_sum(ss);
    const float rs = rsqrtf(ss * (1.f / 1024.f) + EPSV);
#pragma unroll
    for (int j = 0; j < 4; ++j) {
        const float4 gg = *(const float4*)(g + lane * 4 + 256 * j);
        ushort4 w; w.x = f2bf(v[j].x * rs * gg.x); w.y = f2bf(v[j].y * rs * gg.y); w.z = f2bf(v[j].z * rs * gg.z); w.w = f2bf(v[j].w * rs * gg.w);
        *(ushort4*)(o + lane * 4 + 256 * j) = w;
    }
}

struct ABf16 { const bf16_t* p; int lda; __device__ __forceinline__ bf16x8 load(int m, int k) const { return *(const bf16x8*)(p + (size_t)m * lda + k); } };
struct ACache {
    const float* cache; const int* pt;
    __device__ __forceinline__ bf16x8 load(int m, int k) const {
        const int b = m >> 14, t = m & 16383; const int phys = pt[b * NPAGES + (t >> 7)];
        const float* r = cache + ((size_t)phys * 128 + (t & 127)) * 256 + k;
        const float4 a = *(const float4*)r, c = *(const float4*)(r + 4);
        bf16x8 o; o[0] = (short)f2bf(a.x); o[1] = (short)f2bf(a.y); o[2] = (short)f2bf(a.z); o[3] = (short)f2bf(a.w);
        o[4] = (short)f2bf(c.x); o[5] = (short)f2bf(c.y); o[6] = (short)f2bf(c.z); o[7] = (short)f2bf(c.w); return o;
    }
};
template <class AL, class Epi>
__device__ __forceinline__ void gemm_tile_256x128(const AL& al, const bf16_t* __restrict__ Bt, int ldb, int K, const Epi& epi, int m0, int n0, char* smem) {
    bf16_t (*sA)[40] = (bf16_t (*)[40])smem;
    bf16_t (*sB)[40] = (bf16_t (*)[40])(smem + 20480);
    const int tid = threadIdx.x, lane = tid & 63, wid = tid >> 6, wm = wid >> 1, wn = wid & 1;
    f32x4 acc[4][4];
#pragma unroll
    for (int i = 0; i < 4; ++i)
#pragma unroll
        for (int j = 0; j < 4; ++j) acc[i][j] = (f32x4){0.f, 0.f, 0.f, 0.f};
    __syncthreads();
    for (int k0 = 0; k0 < K; k0 += 32) {
#pragma unroll
        for (int i = 0; i < 2; ++i) { const int ch = tid + 512 * i, r = ch >> 2, kc = (ch & 3) * 8; *(bf16x8*)&sA[r][kc] = al.load(m0 + r, k0 + kc); }
        { const int r = tid >> 2, kc = (tid & 3) * 8; *(bf16x8*)&sB[r][kc] = *(const bf16x8*)(Bt + (size_t)(n0 + r) * ldb + k0 + kc); }
        __syncthreads();
        bf16x8 af[4], bfr[4];
#pragma unroll
        for (int i = 0; i < 4; ++i) af[i] = *(const bf16x8*)&sA[wm * 64 + i * 16 + (lane & 15)][(lane >> 4) * 8];
#pragma unroll
        for (int j = 0; j < 4; ++j) bfr[j] = *(const bf16x8*)&sB[wn * 64 + j * 16 + (lane & 15)][(lane >> 4) * 8];
#pragma unroll
        for (int i = 0; i < 4; ++i)
#pragma unroll
            for (int j = 0; j < 4; ++j) acc[i][j] = __builtin_amdgcn_mfma_f32_16x16x32_bf16(af[i], bfr[j], acc[i][j], 0, 0, 0);
        __syncthreads();
    }
#pragma unroll
    for (int i = 0; i < 4; ++i)
#pragma unroll
        for (int j = 0; j < 4; ++j)
#pragma unroll
            for (int r = 0; r < 4; ++r) epi(m0 + wm * 64 + i * 16 + (lane >> 4) * 4 + r, n0 + wn * 64 + j * 16 + (lane & 15), acc[i][j][r]);
}
template <class Epi>
__device__ __forceinline__ void gemm_tile_32x256(const bf16_t* __restrict__ A, int lda, const bf16_t* __restrict__ Bt, int ldb, int K, const Epi& epi, int m0, int n0, char* smem) {
    bf16_t (*sA)[40] = (bf16_t (*)[40])smem;
    bf16_t (*sB)[40] = (bf16_t (*)[40])(smem + 2560);
    const int tid = threadIdx.x, lane = tid & 63, wid = tid >> 6;
    f32x4 acc[2][2];
#pragma unroll
    for (int i = 0; i < 2; ++i)
#pragma unroll
        for (int j = 0; j < 2; ++j) acc[i][j] = (f32x4){0.f, 0.f, 0.f, 0.f};
    __syncthreads();
    for (int k0 = 0; k0 < K; k0 += 32) {
        if (tid < 128) { const int r = tid >> 2, kc = (tid & 3) * 8; *(bf16x8*)&sA[r][kc] = *(const bf16x8*)(A + (size_t)(m0 + r) * lda + k0 + kc); }
#pragma unroll
        for (int i = 0; i < 2; ++i) { const int ch = tid + 512 * i, r = ch >> 2, kc = (ch & 3) * 8; *(bf16x8*)&sB[r][kc] = *(const bf16x8*)(Bt + (size_t)(n0 + r) * ldb + k0 + kc); }
        __syncthreads();
        bf16x8 af[2], bfr[2];
#pragma unroll
        for (int i = 0; i < 2; ++i) af[i] = *(const bf16x8*)&sA[i * 16 + (lane & 15)][(lane >> 4) * 8];
#pragma unroll
        for (int j = 0; j < 2; ++j) bfr[j] = *(const bf16x8*)&sB[wid * 32 + j * 16 + (lane & 15)][(lane >> 4) * 8];
#pragma unroll
        for (int i = 0; i < 2; ++i)
#pragma unroll
            for (int j = 0; j < 2; ++j) acc[i][j] = __builtin_amdgcn_mfma_f32_16x16x32_bf16(af[i], bfr[j], acc[i][j], 0, 0, 0);
        __syncthreads();
    }
#pragma unroll
    for (int i = 0; i < 2; ++i)
#pragma unroll
        for (int j = 0; j < 2; ++j)
#pragma unroll
            for (int r = 0; r < 4; ++r) epi(m0 + i * 16 + (lane >> 4) * 4 + r, n0 + wid * 32 + j * 16 + (lane & 15), acc[i][j][r]);
}
template <class Epi>
__device__ __forceinline__ void gemm_sample_rows(const bf16_t* __restrict__ A, int lda, const bf16_t* __restrict__ Bt, int K, int N, const Epi& epi, char* smem, int bid, int nb) {
    const int nu = N / 256;
    for (int u = nb - 1 - bid; u < nu; u += nb) gemm_tile_32x256(A, lda, Bt, K, K, epi, NPT, u * 256, smem);
}
struct EwF32 { float* C; int ldc; __device__ __forceinline__ void operator()(int m, int n, float v) const { C[(size_t)m * ldc + n] = v; } };
struct EwBf16 { bf16_t* C; int ldc; __device__ __forceinline__ void operator()(int m, int n, float v) const { C[(size_t)m * ldc + n] = f2bf(v); } };
struct EwResX { const float* xs; float* C; __device__ __forceinline__ void operator()(int m, int n, float v) const { C[(size_t)m * 1024 + n] = xs[(size_t)(m - NPT) * 1024 + n] + v; } };
struct EwSwiglu {
    float* G; bf16_t* Hd;
    __device__ __forceinline__ void operator()(int m, int n, float v) const {
        const int f = (n >> 8) * 128 + (n & 127);
        if ((n & 255) < 128) G[(size_t)(m - NPT) * DFF + f] = v;
    }
};
struct EwSwiglu2 {
    const float* G; bf16_t* Hd;
    __device__ __forceinline__ void operator()(int m, int n, float v) const {
        const int f = (n >> 8) * 128 + (n & 127);
        if ((n & 255) >= 128) Hd[(size_t)m * DFF + f] = f2bf(siluf_(G[(size_t)(m - NPT) * DFF + f]) * v);
    }
};
struct EwResH { const float* H; float* C; __device__ __forceinline__ void operator()(int m, int n, float v) const { C[(size_t)m * 1024 + n] = H[(size_t)m * 1024 + n] + v; } };
struct EwPle { const float* H2; const float* PP; float* out;
    __device__ __forceinline__ void operator()(int m, int n, float v) const { out[O_YS + (size_t)(m - NPT) * 1024 + n] = H2[(size_t)m * 1024 + n] + PP[(size_t)m * 1024 + n] * sigmoidf_(v); } };

struct PgBf16 {
    static constexpr bool PERM = true, AFTER_DRAIN = false; bf16_t* O; int ldc;
    __device__ __forceinline__ void operator()(const f32x4 (&acc)[2][2][4][2], const pg8::Unit& u, int wr, int wc, int fr, int fq) const {
#pragma unroll
        for (int ai = 0; ai < 2; ++ai)
#pragma unroll
            for (int m = 0; m < 4; ++m) { bf16_t* rowp = O + (size_t)(u.pm * 256 + ai * 128 + wr * 64 + m * 16 + fr) * ldc + u.pn * 256 + wc * 32 + 8 * fq;
#pragma unroll
                for (int bj = 0; bj < 2; ++bj) { const f32x4 v0 = acc[ai][bj][m][0], v1 = acc[ai][bj][m][1]; u32x4 w; w.x = pk2bf(v0[0], v0[1]); w.y = pk2bf(v0[2], v0[3]); w.z = pk2bf(v1[0], v1[1]); w.w = pk2bf(v1[2], v1[3]); *(u32x4*)(rowp + bj * 128) = w; } }
    }
};
struct PgF32 {
    static constexpr bool PERM = false, AFTER_DRAIN = false; float* O; int ldc;
    __device__ __forceinline__ void operator()(const f32x4 (&acc)[2][2][4][2], const pg8::Unit& u, int wr, int wc, int fr, int fq) const {
#pragma unroll
        for (int ai = 0; ai < 2; ++ai)
#pragma unroll
            for (int m = 0; m < 4; ++m) { float* rowp = O + (size_t)(u.pm * 256 + ai * 128 + wr * 64 + m * 16 + fr) * ldc + u.pn * 256 + wc * 32 + 4 * fq;
#pragma unroll
                for (int bj = 0; bj < 2; ++bj)
#pragma unroll
                    for (int n = 0; n < 2; ++n) *(f32x4*)(rowp + bj * 128 + n * 16) = acc[ai][bj][m][n]; }
    }
};
struct PgRes {
    static constexpr bool PERM = false, AFTER_DRAIN = false; const float* R; float* O;
    __device__ __forceinline__ void operator()(const f32x4 (&acc)[2][2][4][2], const pg8::Unit& u, int wr, int wc, int fr, int fq) const {
#pragma unroll
        for (int ai = 0; ai < 2; ++ai)
#pragma unroll
            for (int m = 0; m < 4; ++m) { const size_t off = (size_t)(u.pm * 256 + ai * 128 + wr * 64 + m * 16 + fr) * 1024 + u.pn * 256 + wc * 32 + 4 * fq;
#pragma unroll
                for (int bj = 0; bj < 2; ++bj)
#pragma unroll
                    for (int n = 0; n < 2; ++n) { const f32x4 r = *(const f32x4*)(R + off + bj * 128 + n * 16); *(f32x4*)(O + off + bj * 128 + n * 16) = r + acc[ai][bj][m][n]; } }
    }
};
struct PgSwiglu {
    static constexpr bool PERM = true, AFTER_DRAIN = false; bf16_t* Hd;
    __device__ __forceinline__ void operator()(const f32x4 (&acc)[2][2][4][2], const pg8::Unit& u, int wr, int wc, int fr, int fq) const {
#pragma unroll
        for (int ai = 0; ai < 2; ++ai)
#pragma unroll
            for (int m = 0; m < 4; ++m) { bf16_t* rowp = Hd + (size_t)(u.pm * 256 + ai * 128 + wr * 64 + m * 16 + fr) * DFF + u.pn * 128 + wc * 32 + 8 * fq;
                float h[8];
#pragma unroll
                for (int n = 0; n < 2; ++n)
#pragma unroll
                    for (int i = 0; i < 4; ++i) h[n * 4 + i] = siluf_(acc[ai][0][m][n][i]) * acc[ai][1][m][n][i];
                u32x4 w; w.x = pk2bf(h[0], h[1]); w.y = pk2bf(h[2], h[3]); w.z = pk2bf(h[4], h[5]); w.w = pk2bf(h[6], h[7]); *(u32x4*)rowp = w; }
    }
};
struct PgPle {
    static constexpr bool PERM = false, AFTER_DRAIN = false; const float* H2; const float* PP; float* out;
    __device__ __forceinline__ void operator()(const f32x4 (&acc)[2][2][4][2], const pg8::Unit& u, int wr, int wc, int fr, int fq) const {
#pragma unroll
        for (int ai = 0; ai < 2; ++ai)
#pragma unroll
            for (int m = 0; m < 4; ++m) { const size_t off = (size_t)(u.pm * 256 + ai * 128 + wr * 64 + m * 16 + fr) * 1024 + u.pn * 256 + wc * 32 + 4 * fq;
#pragma unroll
                for (int bj = 0; bj < 2; ++bj)
#pragma unroll
                    for (int n = 0; n < 2; ++n) { const f32x4 h = *(const f32x4*)(H2 + off + bj * 128 + n * 16), pp = *(const f32x4*)(PP + off + bj * 128 + n * 16), a = acc[ai][bj][m][n]; f32x4 y;
#pragma unroll
                        for (int i = 0; i < 4; ++i) y[i] = h[i] + pp[i] * sigmoidf_(a[i]);
                        *(f32x4*)(out + O_YP + off + bj * 128 + n * 16) = y; } }
    }
};
template <class Epi>
__device__ __forceinline__ void pg_gemm(LAS unsigned char* lds, const bf16_t* A, const bf16_t* Bt, int M, int N, int K, const Epi& E) {
    pg8::Gemm g{A, Bt, M, N, K}; pg8::StaticOrder S; S.init(M, N, (int)gridDim.x, (int)blockIdx.x);
    pg8::gemm_phase<Epi, pg8::StaticOrder, true, true>(lds, g, S, E);
}

struct MK {
    const float *x_prompt, *x_sample, *cache_ckv, *cache_krope, *state_gdn, *state_conv; const int* page_table; const float *p_prompt, *p_sample;
    const float *g_attn, *w_in, *w_conv, *a_log, *dt_bias, *g_gdn_out, *g_q_a, *w_q_b, *g_q_nope, *g_q_rope, *g_kv_a, *g_k_rope, *w_kv_b, *g_k_nope, *w_o, *g_ffn, *w_gate, *w_up, *w_down, *g_ple, *w_ple_gate, *w_ple_proj;
    float* out;
    bf16_t *WinT, *WqbT, *WkvT, *WknT, *WoT, *WguT, *WdT, *WpgT, *WppT, *xn, *pb, *Z;
    float *qf, *kf, *vf, *gg, *bb, *goraw; bf16_t *qan, *ckvb; float *krf, *Q, *qh, *KV, *kh; bf16_t *omix, *KN, *Qb, *Kb, *Vb; float *SC, *part, *H; bf16_t* un; float* G; bf16_t* hid; float* H2; bf16_t* un2; float* PP;
};

__device__ __forceinline__ void post_in_row(const MK& a, int row, float* red) {
    const int tid = threadIdx.x & 255, lane = tid & 63, wid = tid >> 6;
    const bool samp = row >= NPT;
    const int b = samp ? row - NPT : row >> 11, t = samp ? 0 : row & 2047;
    const bf16_t* z = a.Z + (size_t)row * ZW;
#pragma unroll
    for (int i = 0; i < 6; ++i) {
        const int c = tid + 256 * i;
        float e0, e1, e2, e3;
        e3 = bf2f(z[c]);
        if (samp) { e0 = a.state_conv[((size_t)b * 3 + 0) * 1536 + c]; e1 = a.state_conv[((size_t)b * 3 + 1) * 1536 + c]; e2 = a.state_conv[((size_t)b * 3 + 2) * 1536 + c]; }
        else {
            e0 = t >= 3 ? bf2f(a.Z[(size_t)(row - 3) * ZW + c]) : 0.f;
            e1 = t >= 2 ? bf2f(a.Z[(size_t)(row - 2) * ZW + c]) : 0.f;
            e2 = t >= 1 ? bf2f(a.Z[(size_t)(row - 1) * ZW + c]) : 0.f;
        }
        float y = e0 * a.w_conv[c] + e1 * a.w_conv[1536 + c] + e2 * a.w_conv[2 * 1536 + c] + e3 * a.w_conv[3 * 1536 + c];
        y = siluf_(y);
        if (samp) { a.out[O_CSS + ((size_t)b * 3 + 0) * 1536 + c] = e1; a.out[O_CSS + ((size_t)b * 3 + 1) * 1536 + c] = e2; a.out[O_CSS + ((size_t)b * 3 + 2) * 1536 + c] = e3; }
        else if (t >= SEQ - 3) a.out[O_CSP + ((size_t)b * 3 + (t - (SEQ - 3))) * 1536 + c] = e3;
        const int sec = c >> 9, cc = c & 511;
        if (sec == 2) a.vf[(size_t)row * 512 + cc] = y;
        else {
            const float ss = wave_sum(y * y);
            const float r = rsqrtf(ss + EPSV);
            if (sec == 0) a.qf[(size_t)row * 512 + cc] = y * r * 0.125f; else a.kf[(size_t)row * 512 + cc] = y * r;
        }
    }
    if (tid < 8) {
        const float av = bf2f(z[OFF_A + tid]), bv = bf2f(z[OFF_B + tid]);
        const float xx = av + a.dt_bias[tid];
        const float sp = xx > 20.f ? xx : log1pf(expf(xx));
        a.gg[(size_t)row * 8 + tid] = -expf(a.a_log[tid]) * sp;
        a.bb[(size_t)row * 8 + tid] = sigmoidf_(bv);
    }
    {
        const float v0 = bf2f(z[OFF_QA + tid]), v1 = tid < 128 ? bf2f(z[OFF_QA + 256 + tid]) : 0.f;
        float ss = wave_sum(v0 * v0 + v1 * v1);
        if (lane == 0) red[wid] = ss;
        __syncthreads();
        ss = red[0] + red[1] + red[2] + red[3];
        const float rs = rsqrtf(ss * (1.f / 384.f) + EPSV);
        a.qan[(size_t)row * 384 + tid] = f2bf(v0 * rs * a.g_q_a[tid]);
        if (tid < 128) a.qan[(size_t)row * 384 + 256 + tid] = f2bf(v1 * rs * a.g_q_a[256 + tid]);
    }
    {
        const float v = bf2f(z[OFF_KVA + tid]);
        float ss = wave_sum(v * v);
        if (lane == 0) red[4 + wid] = ss;
        __syncthreads();
        ss = red[4] + red[5] + red[6] + red[7];
        const float rs = rsqrtf(ss * (1.f / 256.f) + EPSV);
        const float o = v * rs * a.g_kv_a[tid];
        a.ckvb[(size_t)row * 256 + tid] = f2bf(o);
        if (samp) a.out[O_CKVS + (size_t)b * 256 + tid] = o; else a.out[O_CKVP + (size_t)row * 256 + tid] = o;
    }
    if (wid == 0) {
        const float v = lane < 32 ? bf2f(z[OFF_KR + lane]) : 0.f;
        const float ss = wave_sum(v * v);
        const float rs = rsqrtf(ss * (1.f / 32.f) + EPSV);
        const float xn = lane < 32 ? v * rs * a.g_k_rope[lane] : 0.f;
        const float other = __shfl_xor(xn, 16);
        const int i = lane & 15;
        const float pos = samp ? (float)PAST : (float)t;
        const float ang = pos * powf(10000.f, -(float)i / 16.f);
        const float cs = cosf(ang), sn = sinf(ang);
        const float o = lane < 16 ? xn * cs - other * sn : other * sn + xn * cs;
        if (lane < 32) {
            a.krf[(size_t)row * 32 + lane] = o;
            if (samp) a.out[O_KRS + (size_t)b * 32 + lane] = o; else a.out[O_KRP + (size_t)row * 32 + lane] = o;
        }
    }
}
__device__ __forceinline__ void post_q_item(const MK& a, int idx, int lane) {
    const int row = idx >> 3, h = idx & 7;
    const float* q = a.Q + (size_t)row * 768 + h * 96;
    float* o = a.qh + ((size_t)row * 8 + h) * 96;
    const float v = q[lane];
    const float ss = wave_sum(v * v);
    o[lane] = v * rsqrtf(ss * (1.f / 64.f) + EPSV) * a.g_q_nope[lane];
    const float r = lane < 32 ? q[64 + lane] : 0.f;
    const float s2 = wave_sum(r * r);
    const float xn = lane < 32 ? r * rsqrtf(s2 * (1.f / 32.f) + EPSV) * a.g_q_rope[lane] : 0.f;
    const float other = __shfl_xor(xn, 16);
    const int i = lane & 15;
    const float pos = row >= NPT ? (float)PAST : (float)(row & 2047);
    const float ang = pos * powf(10000.f, -(float)i / 16.f);
    const float cs = cosf(ang), sn = sinf(ang);
    const float ov = lane < 16 ? xn * cs - other * sn : other * sn + xn * cs;
    if (lane < 32) o[64 + lane] = ov;
    if (row < NPT) {
        bf16_t* qb = a.Qb + ((size_t)((row >> 11) * 8 + h) * 2048 + (row & 2047)) * 96;
        qb[lane] = f2bf(o[lane] * 0.14724445f);
        if (lane < 32) qb[64 + lane] = f2bf(ov * 0.14724445f);
    }
}
__device__ __forceinline__ void post_kv_item(const MK& a, int idx, int lane) {
    const int row = idx >> 3, h = idx & 7;
    const float v = a.KV[(size_t)row * 1024 + h * 128 + lane];
    const float ss = wave_sum(v * v);
    const float kn = v * rsqrtf(ss * (1.f / 64.f) + EPSV) * a.g_k_nope[lane];
    a.kh[((size_t)row * 8 + h) * 64 + lane] = kn;
    if (row < NPT) {
        const size_t br = (size_t)((row >> 11) * 8 + h) * 2048 + (row & 2047);
        a.Kb[br * 96 + lane] = f2bf(kn);
        if (lane < 32) a.Kb[br * 96 + 64 + lane] = f2bf(a.krf[(size_t)row * 32 + lane]);
        a.Vb[br * 64 + lane] = f2bf(a.KV[(size_t)row * 1024 + h * 128 + 64 + lane]);
    }
}

typedef float f32x16 __attribute__((ext_vector_type(16)));
typedef short s16x4 __attribute__((ext_vector_type(4)));
#define KST 104
#define VST 72
#define ATT_BUF (64 * KST * 2 + 64 * VST * 2)
__device__ __forceinline__ int crow32(int r, int hi) { return (r & 3) + 8 * (r >> 2) + 4 * hi; }
__device__ __forceinline__ s16x4 tr_read(const bf16_t* p) { return __builtin_bit_cast(s16x4, __builtin_amdgcn_ds_read_tr16_b64_v4i16((LAS s16x4*)(LAS void*)(unsigned)(size_t)p)); }
__device__ __forceinline__ bf16x8 pack8(const f32x16& x, int s) {
    u32x4 w; w.x = pk2bf(x[8 * s], x[8 * s + 1]); w.y = pk2bf(x[8 * s + 2], x[8 * s + 3]); w.z = pk2bf(x[8 * s + 4], x[8 * s + 5]); w.w = pk2bf(x[8 * s + 6], x[8 * s + 7]);
    return __builtin_bit_cast(bf16x8, w);
}
__device__ __forceinline__ void attn_block(const MK& a, int b, int h, int qb, char* smem) {
    const int tid = threadIdx.x, lane = tid & 63, wid = tid >> 6, r32 = lane & 31, hi = lane >> 5;
    const size_t bh = (size_t)(b * 8 + h) * 2048;
    const int qrow = qb * 256 + wid * 32 + r32;
    const int wq0 = qb * 256 + wid * 32;
    bf16x8 qf[6];
    { const bf16_t* Qg = a.Qb + (bh + qrow) * 96;
#pragma unroll
      for (int ds = 0; ds < 6; ++ds) qf[ds] = *(const bf16x8*)(Qg + 16 * ds + 8 * hi); }
    f32x16 o0, o1;
#pragma unroll
    for (int r = 0; r < 16; ++r) { o0[r] = 0.f; o1[r] = 0.f; }
    float m = -INFINITY, l = 0.f;
    const int nt = qb * 4 + 4;
    const int kc0r = tid / 12, kc0c = tid % 12, kc1r = (512 + tid) / 12, kc1c = (512 + tid) % 12, vr = tid >> 3, vc = tid & 7;
    const bf16_t* Kg = a.Kb + bh * 96; const bf16_t* Vg = a.Vb + bh * 64;
    bf16x8 kr0, kr1, vr0;
    kr0 = *(const bf16x8*)(Kg + (size_t)kc0r * 96 + kc0c * 8);
    if (tid < 256) kr1 = *(const bf16x8*)(Kg + (size_t)kc1r * 96 + kc1c * 8);
    vr0 = *(const bf16x8*)(Vg + (size_t)vr * 64 + vc * 8);
    __syncthreads();
    {
        bf16_t* Ks = (bf16_t*)smem; bf16_t* Vs = Ks + 64 * KST;
        *(bf16x8*)(Ks + kc0r * KST + kc0c * 8) = kr0;
        if (tid < 256) *(bf16x8*)(Ks + kc1r * KST + kc1c * 8) = kr1;
        *(bf16x8*)(Vs + vr * VST + vc * 8) = vr0;
    }
    __syncthreads();
    const int i16 = lane & 15, qq = i16 >> 2, pp = i16 & 3, g1 = (lane >> 4) & 1;
    for (int t = 0; t < nt; ++t) {
        const bf16_t* Ks = (const bf16_t*)(smem + (t & 1) * ATT_BUF); const bf16_t* Vs = Ks + 64 * KST;
        if (t + 1 < nt) {
            const size_t ro = (size_t)(t + 1) * 64;
            kr0 = *(const bf16x8*)(Kg + (ro + kc0r) * 96 + kc0c * 8);
            if (tid < 256) kr1 = *(const bf16x8*)(Kg + (ro + kc1r) * 96 + kc1c * 8);
            vr0 = *(const bf16x8*)(Vg + (ro + vr) * 64 + vc * 8);
        }
        if (64 * t <= wq0 + 31) {
            f32x16 p0, p1;
#pragma unroll
            for (int r = 0; r < 16; ++r) { p0[r] = 0.f; p1[r] = 0.f; }
#pragma unroll
            for (int ds = 0; ds < 6; ++ds) {
                const bf16x8 k0 = *(const bf16x8*)(Ks + r32 * KST + 16 * ds + 8 * hi);
                const bf16x8 k1 = *(const bf16x8*)(Ks + (32 + r32) * KST + 16 * ds + 8 * hi);
                p0 = __builtin_amdgcn_mfma_f32_32x32x16_bf16(k0, qf[ds], p0, 0, 0, 0);
                p1 = __builtin_amdgcn_mfma_f32_32x32x16_bf16(k1, qf[ds], p1, 0, 0, 0);
            }
            if (64 * t + 63 > wq0) {
#pragma unroll
                for (int r = 0; r < 16; ++r) { const int kv = 64 * t + crow32(r, hi); if (kv > qrow) p0[r] = -INFINITY; if (kv + 32 > qrow) p1[r] = -INFINITY; }
            }
            float mx = fmaxf(p0[0], p1[0]);
#pragma unroll
            for (int r = 1; r < 16; ++r) mx = fmaxf(mx, fmaxf(p0[r], p1[r]));
            mx = fmaxf(mx, __shfl_xor(mx, 32));
            const float mn = fmaxf(m, mx);
            const float alpha = __builtin_amdgcn_exp2f(m - mn);
            m = mn;
            float rs = 0.f;
#pragma unroll
            for (int r = 0; r < 16; ++r) { p0[r] = __builtin_amdgcn_exp2f(p0[r] - mn); p1[r] = __builtin_amdgcn_exp2f(p1[r] - mn); rs += p0[r] + p1[r]; }
            l = l * alpha + rs;
#pragma unroll
            for (int r = 0; r < 16; ++r) { o0[r] *= alpha; o1[r] *= alpha; }
            bf16x8 pf[4];
            pf[0] = pack8(p0, 0); pf[1] = pack8(p0, 1); pf[2] = pack8(p1, 0); pf[3] = pack8(p1, 1);
#pragma unroll
            for (int ks = 0; ks < 4; ++ks) {
                const bf16_t* vb0 = Vs + (16 * ks + 4 * hi + qq) * VST + 16 * g1 + 4 * pp;
                const s16x4 a0 = tr_read(vb0), a1 = tr_read(vb0 + 8 * VST);
                const s16x4 c0 = tr_read(vb0 + 32), c1 = tr_read(vb0 + 8 * VST + 32);
                const bf16x8 va = __builtin_shufflevector(a0, a1, 0, 1, 2, 3, 4, 5, 6, 7);
                const bf16x8 vc_ = __builtin_shufflevector(c0, c1, 0, 1, 2, 3, 4, 5, 6, 7);
                o0 = __builtin_amdgcn_mfma_f32_32x32x16_bf16(va, pf[ks], o0, 0, 0, 0);
                o1 = __builtin_amdgcn_mfma_f32_32x32x16_bf16(vc_, pf[ks], o1, 0, 0, 0);
            }
        }
        if (t + 1 < nt) {
            bf16_t* Kn = (bf16_t*)(smem + ((t + 1) & 1) * ATT_BUF); bf16_t* Vn = Kn + 64 * KST;
            *(bf16x8*)(Kn + kc0r * KST + kc0c * 8) = kr0;
            if (tid < 256) *(bf16x8*)(Kn + kc1r * KST + kc1c * 8) = kr1;
            *(bf16x8*)(Vn + vr * VST + vc * 8) = vr0;
        }
        __syncthreads();
    }
    l += __shfl_xor(l, 32);
    const float il = 1.f / l;
    bf16_t* op = a.omix + ((size_t)b * SEQ + qrow) * 1024 + 512 + h * 64;
#pragma unroll
    for (int g = 0; g < 4; ++g) {
        uint2 w0, w1;
        w0.x = pk2bf(o0[4 * g] * il, o0[4 * g + 1] * il); w0.y = pk2bf(o0[4 * g + 2] * il, o0[4 * g + 3] * il);
        w1.x = pk2bf(o1[4 * g] * il, o1[4 * g + 1] * il); w1.y = pk2bf(o1[4 * g + 2] * il, o1[4 * g + 3] * il);
        *(uint2*)(op + 8 * g + 4 * hi) = w0;
        *(uint2*)(op + 32 + 8 * g + 4 * hi) = w1;
    }
}

__device__ __forceinline__ void gdn_unit(const MK& a, int b, int h, int dvg, const float* s0, float* sout, int row0, int T, int lane, char* wsm) {
    float (*sq)[64] = (float (*)[64])wsm;
    float (*sk)[64] = (float (*)[64])(wsm + 4096);
    float (*sv)[8] = (float (*)[8])(wsm + 8192);
    float* sg = (float*)(wsm + 8704);
    float* sb = (float*)(wsm + 8768);
    const int e = lane & 7, ko = lane >> 3, col = dvg * 8 + e;
    float S[8];
#pragma unroll
    for (int d = 0; d < 8; ++d) S[d] = s0 ? s0[(((size_t)b * 8 + h) * 64 + ko * 8 + d) * 64 + col] : 0.f;
    const size_t rbase = (size_t)row0 + (size_t)b * T;
    float pq[16], pk[16], pv0, pv1, pgb;
    {
        const int nt = T < 16 ? T : 16;
#pragma unroll
        for (int j = 0; j < 16; ++j) { const bool ok = j < nt; const size_t r = rbase + (ok ? j : 0); pq[j] = ok ? a.qf[r * 512 + h * 64 + lane] : 0.f; pk[j] = ok ? a.kf[r * 512 + h * 64 + lane] : 0.f; }
        { const int j0 = lane >> 3, j1 = j0 + 8; pv0 = j0 < nt ? a.vf[(rbase + j0) * 512 + h * 64 + dvg * 8 + (lane & 7)] : 0.f; pv1 = j1 < nt ? a.vf[(rbase + j1) * 512 + h * 64 + dvg * 8 + (lane & 7)] : 0.f; }
        { const int j = lane & 15; pgb = j < nt ? (lane < 16 ? a.gg[(rbase + j) * 8 + h] : a.bb[(rbase + j) * 8 + h]) : 0.f; }
    }
    for (int t0 = 0; t0 < T; t0 += 16) {
        const int nt = (T - t0) < 16 ? (T - t0) : 16;
        WSYNC();
#pragma unroll
        for (int j = 0; j < 16; ++j) { sq[j][lane] = pq[j]; sk[j][lane] = pk[j]; }
        sv[lane >> 3][lane & 7] = pv0; sv[(lane >> 3) + 8][lane & 7] = pv1;
        if (lane < 16) sg[lane] = expf(pgb); else if (lane < 32) sb[lane - 16] = pgb;
        WSYNC();
        if (t0 + 16 < T) {
            const size_t rb = rbase + t0 + 16;
#pragma unroll
            for (int j = 0; j < 16; ++j) { pq[j] = a.qf[(rb + j) * 512 + h * 64 + lane]; pk[j] = a.kf[(rb + j) * 512 + h * 64 + lane]; }
            pv0 = a.vf[(rb + (lane >> 3)) * 512 + h * 64 + dvg * 8 + (lane & 7)]; pv1 = a.vf[(rb + (lane >> 3) + 8) * 512 + h * 64 + dvg * 8 + (lane & 7)];
            pgb = lane < 16 ? a.gg[(rb + (lane & 15)) * 8 + h] : a.bb[(rb + (lane & 15)) * 8 + h];
        }
        for (int j = 0; j < nt; ++j) {
            const float dec = sg[j], be = sb[j], v = sv[j][e];
            const float4 k0 = *(const float4*)&sk[j][ko * 8], k1 = *(const float4*)&sk[j][ko * 8 + 4];
            const float4 q0 = *(const float4*)&sq[j][ko * 8], q1 = *(const float4*)&sq[j][ko * 8 + 4];
            const float kk[8] = {k0.x, k0.y, k0.z, k0.w, k1.x, k1.y, k1.z, k1.w};
            const float qq[8] = {q0.x, q0.y, q0.z, q0.w, q1.x, q1.y, q1.z, q1.w};
            float ks = 0.f;
#pragma unroll
            for (int d = 0; d < 8; ++d) { S[d] *= dec; ks += kk[d] * S[d]; }
            ks += __shfl_xor(ks, 8); ks += __shfl_xor(ks, 16); ks += __shfl_xor(ks, 32);
            const float delta = (v - ks) * be;
            float ov = 0.f;
#pragma unroll
            for (int d = 0; d < 8; ++d) { S[d] += kk[d] * delta; ov += qq[d] * S[d]; }
            ov += __shfl_xor(ov, 8); ov += __shfl_xor(ov, 16); ov += __shfl_xor(ov, 32);
            if (ko == 0) a.goraw[(rbase + t0 + j) * 512 + h * 64 + col] = ov;
        }
    }
#pragma unroll
    for (int d = 0; d < 8; ++d) sout[(((size_t)b * 8 + h) * 64 + ko * 8 + d) * 64 + col] = S[d];
}
__device__ __forceinline__ void gdn_out_item(const MK& a, int idx, int lane) {
    const int row = idx >> 3, h = idx & 7;
    const float ov = a.goraw[(size_t)row * 512 + h * 64 + lane];
    const float ss = wave_sum(ov * ov);
    const float on = ov * rsqrtf(ss * (1.f / 64.f) + EPSV) * a.g_gdn_out[lane];
    const float zg = bf2f(a.Z[(size_t)row * ZW + OFF_Z + h * 64 + lane]);
    a.omix[(size_t)row * 1024 + h * 64 + lane] = f2bf(on * siluf_(zg));
}

__device__ __forceinline__ void samp_scores_item(const MK& a, int m, int lane) {
    const int b = m >> 14, t = m & 16383, h = lane >> 3, ch = lane & 7;
    const bf16x8 kv = *(const bf16x8*)(a.KN + (size_t)m * 512 + h * 64 + ch * 8);
    const float* q = a.qh + ((size_t)(NPT + b) * 8 + h) * 96;
    float ss = 0.f, dot = 0.f;
#pragma unroll
    for (int j = 0; j < 8; ++j) { const float x = bf2f((bf16_t)kv[j]); ss += x * x; dot += x * a.g_k_nope[ch * 8 + j] * q[ch * 8 + j]; }
    const int phys = a.page_table[b * NPAGES + (t >> 7)];
    const float* kr = a.cache_krope + ((size_t)phys * 128 + (t & 127)) * 32 + ch * 4;
    float rd = 0.f;
#pragma unroll
    for (int j = 0; j < 4; ++j) rd += kr[j] * q[64 + ch * 4 + j];
#pragma unroll
    for (int o = 1; o < 8; o <<= 1) { ss += __shfl_xor(ss, o); dot += __shfl_xor(dot, o); rd += __shfl_xor(rd, o); }
    if (ch == 0) a.SC[((size_t)b * 8 + h) * PAST + t] = (dot * rsqrtf(ss * (1.f / 64.f) + EPSV) + rd) * 0.10206207261596577f;
}
__device__ __forceinline__ void samp_part_unit(const MK& a, int u, char* smem) {
    float* sm = (float*)smem; float (*sp)[8] = (float (*)[8])(smem + 64);
    const int b = u >> 3, sp_i = u & 7, tid = threadIdx.x & 255, lane = tid & 63, wid = tid >> 6;
    const int t0 = sp_i * 2048;
    __syncthreads();
    for (int hh = 0; hh < 2; ++hh) {
        const int h = wid + 4 * hh; float mx = -INFINITY;
        for (int t = lane; t < 2048; t += 64) mx = fmaxf(mx, a.SC[((size_t)b * 8 + h) * PAST + t0 + t]);
#pragma unroll
        for (int o = 1; o < 64; o <<= 1) mx = fmaxf(mx, __shfl_xor(mx, o));
        if (lane == 0) sm[h] = mx;
    }
    __syncthreads();
    float lat[8], lsum = 0.f;
#pragma unroll
    for (int h = 0; h < 8; ++h) lat[h] = 0.f;
    for (int tc = 0; tc < 2048; tc += 64) {
        __syncthreads();
        for (int e = tid; e < 512; e += 256) { const int j = e >> 3, h = e & 7; sp[j][h] = expf(a.SC[((size_t)b * 8 + h) * PAST + t0 + tc + j] - sm[h]); }
        __syncthreads();
        if (tid < 8) { for (int j = 0; j < 64; ++j) lsum += sp[j][tid]; }
        const int phys = a.page_table[b * NPAGES + ((t0 + tc) >> 7)];
        const float* base = a.cache_ckv + ((size_t)phys * 128 + ((t0 + tc) & 127)) * 256 + tid;
        for (int j = 0; j < 64; ++j) {
            const float cv = base[(size_t)j * 256];
#pragma unroll
            for (int h = 0; h < 8; ++h) lat[h] += sp[j][h] * cv;
        }
    }
    float* o = a.part + (size_t)u * 8 * 258;
#pragma unroll
    for (int h = 0; h < 8; ++h) o[h * 258 + 2 + tid] = lat[h];
    if (tid < 8) { o[tid * 258 + 0] = sm[tid]; o[tid * 258 + 1] = lsum; }
}
__device__ __forceinline__ void samp_comb_unit(const MK& a, int u, char* smem) {
    float* slat = (float*)smem;
    const int b = u >> 3, h = u & 7, tid = threadIdx.x & 255;
    const size_t row = NPT + b;
    const float* q = a.qh + (row * 8 + h) * 96;
    float s_self = 0.f;
    for (int d = 0; d < 64; ++d) s_self += q[d] * a.kh[(row * 8 + h) * 64 + d];
    for (int d = 0; d < 32; ++d) s_self += q[64 + d] * a.krf[row * 32 + d];
    s_self *= 0.10206207261596577f;
    float m = s_self;
    for (int s = 0; s < 8; ++s) m = fmaxf(m, a.part[((size_t)(b * 8 + s) * 8 + h) * 258]);
    const float pself = expf(s_self - m);
    float l = pself, lat = 0.f;
    for (int s = 0; s < 8; ++s) {
        const float* p = a.part + ((size_t)(b * 8 + s) * 8 + h) * 258;
        const float w = expf(p[0] - m);
        l += p[1] * w; lat += p[2 + tid] * w;
    }
    __syncthreads();
    slat[tid] = lat;
    __syncthreads();
    if (tid < 64) {
        float o = 0.f;
        for (int c = 0; c < 256; ++c) o += slat[c] * a.w_kv_b[(size_t)c * 1024 + h * 128 + 64 + tid];
        o += pself * a.KV[row * 1024 + h * 128 + 64 + tid];
        a.omix[row * 1024 + 512 + h * 64 + tid] = f2bf(o / l);
    }
}

#define LDS_BYTES 147456
#define GSYNC() do { grid.sync(); } while (0)
__global__ __launch_bounds__(NTHR, 2) void mega(MK a) {
    cg::grid_group grid = cg::this_grid();
    extern __shared__ __attribute__((aligned(16))) unsigned char lds_raw[];
    char* smem = (char*)lds_raw;
    LAS unsigned char* lds = (LAS unsigned char*)lds_raw;
    const int tid = threadIdx.x, lane = tid & 63, wid = tid >> 6, half = tid >> 8;
    const int bid = blockIdx.x, nb = gridDim.x;
    const int gw = bid * NWAVE + wid, ngw = nb * NWAVE;

    {
        const int T0 = 88 * 32, T1 = 24 * 12, T2 = 32 * 8, T3 = 16 * 8, T4 = 32 * 32, T5 = 176 * 32, T7 = 32 * 88, T8 = 32 * 32, T9 = 32 * 8;
        const int TT = T0 + T1 + T2 + T3 + T4 + T5 + T7 + T8 + T9;
        float* t = (float*)(smem + half * 8192);
        for (int it0 = bid * 2; it0 < TT; it0 += nb * 2) {
            const int it = it0 + half; const bool act = it < TT;
            int r = act ? it : 0;
            if (r < T0) { wt_tile(act, a.w_in, a.WinT, 2736, 0, 2736, 1024, r % 88, r / 88, t); continue; } r -= T0;
            if (r < T1) { wt_tile(act, a.w_q_b, a.WqbT, 768, 0, 768, 384, r % 24, r / 24, t); continue; } r -= T1;
            if (r < T2) { wt_tile(act, a.w_kv_b, a.WkvT, 1024, 0, 1024, 256, r % 32, r / 32, t); continue; } r -= T2;
            if (r < T3) { const int nbk = r % 16, kb = r / 16, h = nbk >> 1; wt_tile(act, a.w_kv_b, a.WknT + (size_t)h * 64 * 256, 1024, h * 128, 64, 256, nbk & 1, kb, t); continue; } r -= T3;
            if (r < T4) { wt_tile(act, a.w_o, a.WoT, 1024, 0, 1024, 1024, r % 32, r / 32, t); continue; } r -= T4;
            if (r < T5) { const int nbk = r % 176, kb = r / 176, pn = nbk >> 3, wi = nbk & 7;
                wt_tile(act, wi < 4 ? a.w_gate : a.w_up, a.WguT + (size_t)nbk * 32 * 1024, DFF, pn * 128 + (wi & 3) * 32, 32, 1024, 0, kb, t); continue; } r -= T5;
            if (r < T7) { wt_tile(act, a.w_down, a.WdT, 1024, 0, 1024, DFF, r % 32, r / 32, t); continue; } r -= T7;
            if (r < T8) { wt_tile(act, a.w_ple_gate, a.WpgT, 1024, 0, 1024, 1024, r % 32, r / 32, t); continue; } r -= T8;
            wt_tile(act, a.w_ple_proj, a.WppT, 1024, 0, 1024, 256, r % 32, r / 32, t);
        }
        for (int row = gw; row < MPAD; row += ngw) {
            const float* src = row < NPT ? a.x_prompt + (size_t)row * 1024 : a.x_sample + (size_t)(row < NTOK ? row - NPT : 0) * 1024;
            rms1024_row(src, a.g_attn, a.xn + (size_t)row * 1024, row >= NTOK, lane);
            ushort4 w = {0, 0, 0, 0};
            if (row < NTOK) { const float* ps = row < NPT ? a.p_prompt + (size_t)row * 256 : a.p_sample + (size_t)(row - NPT) * 256; const float4 v = *(const float4*)(ps + lane * 4); w.x = f2bf(v.x); w.y = f2bf(v.y); w.z = f2bf(v.z); w.w = f2bf(v.w); }
            *(ushort4*)(a.pb + (size_t)row * 256 + lane * 4) = w;
            if (row >= NTOK) { for (int j = 0; j < 4; ++j) { ushort4 z = {0, 0, 0, 0}; *(ushort4*)(a.omix + (size_t)row * 1024 + lane * 4 + 256 * j) = z; } }
        }
    }
    GSYNC();
    pg_gemm(lds, a.xn, a.WinT, NPT, ZW, 1024, PgBf16{a.Z, ZW});
    pg_gemm(lds, a.pb, a.WppT, NPT, 1024, 256, PgF32{a.PP, 1024});
    gemm_sample_rows(a.xn, 1024, a.WinT, 1024, ZW, EwBf16{a.Z, ZW}, smem, bid, nb);
    gemm_sample_rows(a.pb, 256, a.WppT, 256, 1024, EwF32{a.PP, 1024}, smem, bid, nb);
    GSYNC();
    for (int r0 = bid * 2; r0 < NTOK; r0 += nb * 2) post_in_row(a, r0 + half, (float*)(smem + half * 64));
    GSYNC();
    for (int u = gw; u < 512 + NST * 64; u += ngw) {
        if (u < 512) gdn_unit(a, u >> 6, (u >> 3) & 7, u & 7, nullptr, a.out + O_GSP, 0, SEQ, lane, smem + wid * 10240);
        else { const int v = u - 512; gdn_unit(a, v >> 6, (v >> 3) & 7, v & 7, a.state_gdn, a.out + O_GSS, NPT, 1, lane, smem + wid * 10240); }
    }
    __syncthreads();
    pg_gemm(lds, a.qan, a.WqbT, NPT, 768, 384, PgF32{a.Q, 768});
    pg_gemm(lds, a.ckvb, a.WkvT, NPT, 1024, 256, PgF32{a.KV, 1024});
    gemm_sample_rows(a.qan, 384, a.WqbT, 384, 768, EwF32{a.Q, 768}, smem, bid, nb);
    gemm_sample_rows(a.ckvb, 256, a.WkvT, 256, 1024, EwF32{a.KV, 1024}, smem, bid, nb);
    for (int t = bid; t < (NST * PAST / 256) * 4; t += nb) gemm_tile_256x128(ACache{a.cache_ckv, a.page_table}, a.WknT, 256, 256, EwBf16{a.KN, 512}, (t >> 2) * 256, (t & 3) * 128, smem);
    GSYNC();
    for (int idx = gw; idx < NTOK * 8; idx += ngw) { post_q_item(a, idx, lane); post_kv_item(a, idx, lane); gdn_out_item(a, idx, lane); }
    GSYNC();
    for (int pr = bid; pr < 256; pr += nb) { const int bh_ = pr >> 2, s_ = pr & 3; attn_block(a, bh_ >> 3, bh_ & 7, 7 - s_, smem); attn_block(a, bh_ >> 3, bh_ & 7, s_, smem); }
    for (int m = gw; m < NST * PAST; m += ngw) samp_scores_item(a, m, lane);
    GSYNC();
    for (int u0 = bid * 2; u0 < NST * 8; u0 += nb * 2) samp_part_unit(a, u0 + half, smem + half * 4096);
    GSYNC();
    for (int u0 = bid * 2; u0 < NST * 8; u0 += nb * 2) samp_comb_unit(a, u0 + half, smem + half * 4096);
    GSYNC();
    pg_gemm(lds, a.omix, a.WoT, NPT, 1024, 1024, PgRes{a.x_prompt, a.H});
    gemm_sample_rows(a.omix, 1024, a.WoT, 1024, 1024, EwResX{a.x_sample, a.H}, smem, bid, nb);
    GSYNC();
    for (int row = gw; row < MPAD; row += ngw) rms1024_row(a.H + (size_t)row * 1024, a.g_ffn, a.un + (size_t)row * 1024, row >= NTOK, lane);
    GSYNC();
    pg_gemm(lds, a.un, a.WguT, NPT, 2 * DFF, 1024, PgSwiglu{a.hid});
    gemm_sample_rows(a.un, 1024, a.WguT, 1024, 2 * DFF, EwSwiglu{a.G, a.hid}, smem, bid, nb);
    __threadfence(); __syncthreads();
    gemm_sample_rows(a.un, 1024, a.WguT, 1024, 2 * DFF, EwSwiglu2{a.G, a.hid}, smem, bid, nb);
    GSYNC();
    pg_gemm(lds, a.hid, a.WdT, NPT, 1024, DFF, PgRes{a.H, a.H2});
    gemm_sample_rows(a.hid, DFF, a.WdT, DFF, 1024, EwResH{a.H, a.H2}, smem, bid, nb);
    GSYNC();
    for (int row = gw; row < MPAD; row += ngw) rms1024_row(a.H2 + (size_t)row * 1024, a.g_ple, a.un2 + (size_t)row * 1024, row >= NTOK, lane);
    GSYNC();
    pg_gemm(lds, a.un2, a.WpgT, NPT, 1024, 1024, PgPle{a.H2, a.PP, a.out});
    gemm_sample_rows(a.un2, 1024, a.WpgT, 1024, 1024, EwPle{a.H2, a.PP, a.out}, smem, bid, nb);
}

static inline char* carve(char*& p, size_t bytes) { char* r = p; p += (bytes + 255) & ~(size_t)255; return r; }

extern "C" void kernel_launch(void* const* d_in, const int* in_sizes, int n_in, void* d_out, int out_size, void* d_ws, size_t ws_size, hipStream_t stream) {
    MK a{};
    a.x_prompt = (const float*)d_in[0]; a.x_sample = (const float*)d_in[1]; a.cache_ckv = (const float*)d_in[2]; a.cache_krope = (const float*)d_in[3];
    a.state_gdn = (const float*)d_in[4]; a.state_conv = (const float*)d_in[5]; a.page_table = (const int*)d_in[6]; a.p_prompt = (const float*)d_in[7]; a.p_sample = (const float*)d_in[8];
    a.g_attn = (const float*)d_in[9]; a.w_in = (const float*)d_in[10]; a.w_conv = (const float*)d_in[11]; a.a_log = (const float*)d_in[12]; a.dt_bias = (const float*)d_in[13];
    a.g_gdn_out = (const float*)d_in[14]; a.g_q_a = (const float*)d_in[15]; a.w_q_b = (const float*)d_in[16]; a.g_q_nope = (const float*)d_in[17]; a.g_q_rope = (const float*)d_in[18];
    a.g_kv_a = (const float*)d_in[19]; a.g_k_rope = (const float*)d_in[20]; a.w_kv_b = (const float*)d_in[21]; a.g_k_nope = (const float*)d_in[22]; a.w_o = (const float*)d_in[23];
    a.g_ffn = (const float*)d_in[24]; a.w_gate = (const float*)d_in[25]; a.w_up = (const float*)d_in[26]; a.w_down = (const float*)d_in[27]; a.g_ple = (const float*)d_in[28];
    a.w_ple_gate = (const float*)d_in[29]; a.w_ple_proj = (const float*)d_in[30];
    a.out = (float*)d_out;
    char* p = (char*)d_ws;
    a.WinT = (bf16_t*)carve(p, (size_t)ZW * 1024 * 2);
    a.WqbT = (bf16_t*)carve(p, (size_t)768 * 384 * 2);
    a.WkvT = (bf16_t*)carve(p, (size_t)1024 * 256 * 2);
    a.WknT = (bf16_t*)carve(p, (size_t)512 * 256 * 2);
    a.WoT = (bf16_t*)carve(p, (size_t)1024 * 1024 * 2);
    a.WguT = (bf16_t*)carve(p, (size_t)2 * DFF * 1024 * 2);
    a.WdT = (bf16_t*)carve(p, (size_t)1024 * DFF * 2);
    a.WpgT = (bf16_t*)carve(p, (size_t)1024 * 1024 * 2);
    a.WppT = (bf16_t*)carve(p, (size_t)1024 * 256 * 2);
    a.xn = (bf16_t*)carve(p, (size_t)MPAD * 1024 * 2);
    a.pb = (bf16_t*)carve(p, (size_t)MPAD * 256 * 2);
    a.Z = (bf16_t*)carve(p, (size_t)MPAD * ZW * 2);
    a.qf = (float*)carve(p, (size_t)MPAD * 512 * 4);
    a.kf = (float*)carve(p, (size_t)MPAD * 512 * 4);
    a.vf = (float*)carve(p, (size_t)MPAD * 512 * 4);
    a.gg = (float*)carve(p, (size_t)MPAD * 8 * 4);
    a.bb = (float*)carve(p, (size_t)MPAD * 8 * 4);
    a.goraw = (float*)carve(p, (size_t)MPAD * 512 * 4);
    a.qan = (bf16_t*)carve(p, (size_t)MPAD * 384 * 2);
    a.ckvb = (bf16_t*)carve(p, (size_t)MPAD * 256 * 2);
    a.krf = (float*)carve(p, (size_t)MPAD * 32 * 4);
    a.Q = (float*)carve(p, (size_t)MPAD * 768 * 4);
    a.qh = (float*)carve(p, (size_t)MPAD * 768 * 4);
    a.KV = (float*)carve(p, (size_t)MPAD * 1024 * 4);
    a.kh = (float*)carve(p, (size_t)MPAD * 512 * 4);
    a.omix = (bf16_t*)carve(p, (size_t)MPAD * 1024 * 2);
    a.KN = (bf16_t*)carve(p, (size_t)NST * PAST * 512 * 2);
    a.Qb = (bf16_t*)carve(p, (size_t)NPT * 8 * 96 * 2);
    a.Kb = (bf16_t*)carve(p, (size_t)NPT * 8 * 96 * 2);
    a.Vb = (bf16_t*)carve(p, (size_t)NPT * 8 * 64 * 2);
    a.SC = (float*)carve(p, (size_t)NST * 8 * PAST * 4);
    a.part = (float*)carve(p, (size_t)NST * 8 * 8 * 258 * 4);
    a.H = (float*)carve(p, (size_t)MPAD * 1024 * 4);
    a.un = (bf16_t*)carve(p, (size_t)MPAD * 1024 * 2);
    a.G = (float*)carve(p, (size_t)NST * DFF * 4);
    a.hid = (bf16_t*)carve(p, (size_t)MPAD * DFF * 2);
    a.H2 = (float*)carve(p, (size_t)MPAD * 1024 * 4);
    a.un2 = (bf16_t*)carve(p, (size_t)MPAD * 1024 * 2);
    a.PP = (float*)carve(p, (size_t)MPAD * 1024 * 4);
    if ((size_t)(p - (char*)d_ws) > ws_size) { fprintf(stderr, "kernel_launch: workspace too small: need %zu have %zu\n", (size_t)(p - (char*)d_ws), ws_size); return; }

    static int grid_blocks = 0;
    if (!grid_blocks) {
        int dev = 0, cus = 0, per_cu = 0;
        (void)hipGetDevice(&dev);
        (void)hipDeviceGetAttribute(&cus, hipDeviceAttributeMultiprocessorCount, dev);
        (void)hipFuncSetAttribute((const void*)mega, hipFuncAttributeMaxDynamicSharedMemorySize, LDS_BYTES);
        (void)hipOccupancyMaxActiveBlocksPerMultiprocessor(&per_cu, (const void*)mega, NTHR, LDS_BYTES);
        if (per_cu < 1) fprintf(stderr, "kernel_launch: occupancy query says %d blocks/CU\n", per_cu);
        grid_blocks = cus;
    }
    void* args[] = {&a};
    hipError_t e = hipLaunchCooperativeKernel((const void*)mega, dim3(grid_blocks), dim3(NTHR), args, LDS_BYTES, stream);
    if (e != hipSuccess) fprintf(stderr, "cooperative launch failed: %s (grid %d)\n", hipGetErrorString(e), grid_blocks);
}
```

```cpp
#include <hip/hip_runtime.h>
#include <stdint.h>
#include <cstdio>
#include <hip/hip_cooperative_groups.h>
namespace cg = cooperative_groups;


__device__ __forceinline__ int otid();
#define PG8_TID() otid()
namespace pg8 {
#define PG8_LAS __attribute__((address_space(3)))
typedef unsigned short bf16_t;
typedef short bf16x8 __attribute__((ext_vector_type(8)));
typedef float f32x4 __attribute__((ext_vector_type(4)));
typedef unsigned u32x4 __attribute__((ext_vector_type(4)));
constexpr int BM = 256, BK = 64, HALF = 128, HTB = HALF * BK * 2  , STAGE_BYTES = 8 * HTB, NXCD = 8, WGM = 8;

__host__ __device__ __forceinline__ int lds_byte(int r, int c) { const int st = (r >> 4) * 2 + (c >> 5), rr = r & 15, cc = c & 31, ob = rr * 64 + cc * 2; return st * 1024 + (ob ^ (((ob >> 9) & 1) << 5)); }
__host__ __device__ __forceinline__ void stage_rc(int b, int& R, int& C) { const int st = b / 1024, sb = b % 1024, swz = sb ^ (((sb >> 9) & 1) << 5); R = (st >> 1) * 16 + swz / 64; C = (st & 1) * 32 + (swz % 64) / 2; }
__host__ __device__ __forceinline__ int perm32(int rho) { const int n = rho >> 4, i = rho & 15; return 8 * (i >> 2) + 4 * n + (i & 3); }

struct Unit { int pm, pn; };
struct Gemm { const bf16_t* A; const bf16_t* Bt; int M, N, K; };

struct StaticOrder {
    int nM, nN, nwg, G, c;
    __host__ __device__ void init(int M, int N, int G_, int c_) { nM = M / BM; nN = N / BM; nwg = nM * nN; G = G_; c = c_; }
    __host__ __device__ bool next(int i, Unit& u) const {
        const long L = (long)i * G + c; if (L >= nwg) return false;
        int wgid = (int)L; { const int q = nwg / NXCD, r = nwg % NXCD, xcd = wgid % NXCD, off = wgid / NXCD; wgid = (xcd < r ? xcd * (q + 1) : r * (q + 1) + (xcd - r) * q) + off; }
        const int nig = WGM * nN, gid = wgid / nig, fm = gid * WGM, gsz = (nM - fm) < WGM ? (nM - fm) : WGM;
        u.pm = fm + ((wgid % nig) % gsz); u.pn = (wgid % nig) / gsz; return true;
    }
    __device__ __forceinline__ void a_ready(const Unit&) const {}
    __device__ __forceinline__ void done(const Unit&) const {}
};

template <class Epi, class Sched, bool ALIGN_EPI = false, bool SP2 = false>
__device__ __forceinline__ void gemm_phase(PG8_LAS unsigned char* lds, const Gemm g, const Sched& S, const Epi& E) {
    const int tid = PG8_TID(), wid = __builtin_amdgcn_readfirstlane(tid >> 6), lane = tid & 63, wr = wid >> 2, wc = wid & 3, fr = lane & 15, fq = lane >> 4;
    const int K = g.K, nt = K / BK;
    unsigned voffA[2], voffB[2];
#pragma unroll
    for (int i = 0; i < 2; ++i) { int R, C; stage_rc(tid * 16 + i * 8192, R, C); const int Rb = Epi::PERM ? ((R & ~31) + perm32(R & 31)) : R;
        voffA[i] = (unsigned)(R * K + C) * 2u; voffB[i] = (unsigned)(Rb * K + C) * 2u; }
    const size_t kstep = (size_t)(BK * 2);
    const size_t hstep = (size_t)HALF * K * 2;
    const size_t tstep = 2 * hstep;
    const unsigned ldsw = (unsigned)wid * 1024u;
    const int aoff = lds_byte(wr * 64 + fr, fq * 8), boff = lds_byte(wc * 32 + fr, fq * 8);
#define PG8_SA(b, h) (((b) * 2 + (h)) * HTB)
#define PG8_SB(b, h) ((4 + (b) * 2 + (h)) * HTB)
#define PG8_STAGE(bufoff, gbase, voff) do { _Pragma("unroll") for (int _i = 0; _i < 2; ++_i) \
        __builtin_amdgcn_global_load_lds((const unsigned*)((const char*)(gbase) + (voff)[_i]), (PG8_LAS unsigned*)(lds + (bufoff) + ldsw + _i * 8192), 16, 0, 0); } while (0)
#define PG8_LDA(dst, b, h) do { _Pragma("unroll") for (int m = 0; m < 4; ++m) _Pragma("unroll") for (int k = 0; k < 2; ++k) dst[m][k] = *(const PG8_LAS bf16x8*)(lds + PG8_SA(b, h) + aoff + m * 2048 + k * 1024); } while (0)
#define PG8_LDB(dst, b, h) do { _Pragma("unroll") for (int n = 0; n < 2; ++n) _Pragma("unroll") for (int k = 0; k < 2; ++k) dst[n][k] = *(const PG8_LAS bf16x8*)(lds + PG8_SB(b, h) + boff + n * 2048 + k * 1024); } while (0)
#define PG8_MMA(ai, bj, At, Bt) do { __builtin_amdgcn_s_setprio(1); _Pragma("unroll") for (int m = 0; m < 4; ++m) _Pragma("unroll") for (int n = 0; n < 2; ++n) _Pragma("unroll") for (int k = 0; k < 2; ++k) \
        acc[ai][bj][m][n] = __builtin_amdgcn_mfma_f32_16x16x32_bf16(Bt[n][k], At[m][k], acc[ai][bj][m][n], 0, 0, 0); __builtin_amdgcn_s_setprio(0); } while (0)
#define PG8_WAIT_V(n) asm volatile("s_waitcnt vmcnt(" #n ")" ::: "memory")
#define PG8_WAIT_L(n) asm volatile("s_waitcnt lgkmcnt(" #n ")" ::: "memory")
#define PG8_BAR __builtin_amdgcn_s_barrier()
#define PG8_SCHED __builtin_amdgcn_sched_barrier(0)
    Unit cur, nxt; int ui = 0;
    if (!S.next(0, cur)) return;
    f32x4 acc[2][2][4][2];
#pragma unroll
    for (int a = 0; a < 2; ++a)
#pragma unroll
        for (int b = 0; b < 2; ++b)
#pragma unroll
            for (int m = 0; m < 4; ++m)
#pragma unroll
                for (int n = 0; n < 2; ++n) acc[a][b][m][n] = (f32x4){0.f, 0.f, 0.f, 0.f};
    bf16x8 At[4][2], B0[2][2], B1[2][2];
    const char* cA = (const char*)g.A + (size_t)cur.pm * tstep; const char* cB = (const char*)g.Bt + (size_t)cur.pn * tstep;
    S.a_ready(cur);
    if constexpr (SP2) {
        PG8_STAGE(PG8_SB(0, 0), cB, voffB); PG8_STAGE(PG8_SB(0, 1), cB + hstep, voffB); PG8_STAGE(PG8_SA(0, 0), cA, voffA); PG8_STAGE(PG8_SA(0, 1), cA + hstep, voffA);
        if (wr == 1) PG8_BAR;
        PG8_WAIT_V(2); PG8_BAR;
        PG8_STAGE(PG8_SB(1, 0), cB + kstep, voffB); PG8_STAGE(PG8_SA(1, 0), cA + kstep, voffA); PG8_STAGE(PG8_SB(1, 1), cB + hstep + kstep, voffB);
        PG8_WAIT_V(6); PG8_BAR;
    } else {
        PG8_STAGE(PG8_SB(0, 0), cB, voffB); PG8_STAGE(PG8_SA(0, 0), cA, voffA); PG8_STAGE(PG8_SB(0, 1), cB + hstep, voffB); PG8_STAGE(PG8_SA(0, 1), cA + hstep, voffA);
        if (wr == 1) PG8_BAR;
        PG8_WAIT_V(4); PG8_BAR;
        PG8_STAGE(PG8_SB(1, 0), cB + kstep, voffB); PG8_STAGE(PG8_SA(1, 0), cA + kstep, voffA); PG8_STAGE(PG8_SB(1, 1), cB + hstep + kstep, voffB);
        PG8_WAIT_V(6); PG8_BAR;
    }
    for (;;) {
        const bool has_next = S.next(ui + 1, nxt);
        const char* nA = has_next ? (const char*)g.A + (size_t)nxt.pm * tstep : cA; const char* nB = has_next ? (const char*)g.Bt + (size_t)nxt.pn * tstep : cB;
        for (int t = 0; t < nt; t += 2) {
            const bool last = (t == nt - 2);
            const char* a1 = cA + (size_t)(t + 1) * kstep;
            const char* a2 = last ? nA : cA + (size_t)(t + 2) * kstep; const char* b2 = last ? nB : cB + (size_t)(t + 2) * kstep;
            const char* a3 = a2 + kstep; const char* b3 = b2 + kstep;
            if (last && has_next) S.a_ready(nxt);
            if constexpr (SP2) {
            PG8_LDB(B0, 0, 0); PG8_LDB(B1, 0, 1); PG8_SCHED; PG8_LDA(At, 0, 0); PG8_STAGE(PG8_SA(1, 1), a1 + hstep, voffA);
            PG8_WAIT_V(8); PG8_WAIT_L(0); PG8_BAR; PG8_MMA(0, 0, At, B0); PG8_MMA(0, 1, At, B1); PG8_BAR; PG8_SCHED;
            PG8_LDA(At, 0, 1); PG8_STAGE(PG8_SB(0, 0), b2, voffB); PG8_STAGE(PG8_SB(0, 1), b2 + hstep, voffB); PG8_STAGE(PG8_SA(0, 0), a2, voffA);
            PG8_WAIT_V(8); PG8_WAIT_L(0); PG8_BAR; PG8_MMA(1, 0, At, B0); PG8_MMA(1, 1, At, B1); PG8_BAR; PG8_SCHED;
            PG8_LDB(B0, 1, 0); PG8_LDB(B1, 1, 1); PG8_SCHED; PG8_LDA(At, 1, 0); PG8_STAGE(PG8_SA(0, 1), a2 + hstep, voffA);
            PG8_WAIT_V(8); PG8_WAIT_L(0); PG8_BAR; PG8_MMA(0, 0, At, B0); PG8_MMA(0, 1, At, B1); PG8_BAR; PG8_SCHED;
            PG8_LDA(At, 1, 1); PG8_STAGE(PG8_SB(1, 0), b3, voffB); PG8_STAGE(PG8_SB(1, 1), b3 + hstep, voffB); PG8_STAGE(PG8_SA(1, 0), a3, voffA);
            PG8_WAIT_V(8); PG8_WAIT_L(0); PG8_BAR; PG8_MMA(1, 0, At, B0); PG8_MMA(1, 1, At, B1); PG8_BAR; PG8_SCHED;
            } else {
            PG8_LDB(B0, 0, 0); PG8_SCHED; PG8_LDA(At, 0, 0); PG8_STAGE(PG8_SA(1, 1), a1 + hstep, voffA);
            PG8_WAIT_L(8); PG8_BAR; PG8_WAIT_L(0); PG8_MMA(0, 0, At, B0); PG8_BAR; PG8_SCHED;
            PG8_LDB(B1, 0, 1); PG8_STAGE(PG8_SB(0, 0), b2, voffB);
            PG8_BAR; PG8_WAIT_L(0); PG8_MMA(0, 1, At, B1); PG8_BAR;
            PG8_LDA(At, 0, 1); PG8_STAGE(PG8_SA(0, 0), a2, voffA);
            PG8_BAR; PG8_WAIT_L(0); PG8_MMA(1, 0, At, B0); PG8_BAR; PG8_SCHED;
            PG8_STAGE(PG8_SB(0, 1), b2 + hstep, voffB);
            PG8_WAIT_V(6); PG8_BAR; PG8_MMA(1, 1, At, B1); PG8_BAR;
            PG8_LDB(B0, 1, 0); PG8_SCHED; PG8_LDA(At, 1, 0); PG8_STAGE(PG8_SA(0, 1), a2 + hstep, voffA);
            PG8_WAIT_L(8); PG8_BAR; PG8_WAIT_L(0); PG8_MMA(0, 0, At, B0); PG8_BAR; PG8_SCHED;
            PG8_LDB(B1, 1, 1); PG8_STAGE(PG8_SB(1, 0), b3, voffB);
            PG8_BAR; PG8_WAIT_L(0); PG8_MMA(0, 1, At, B1); PG8_BAR;
            PG8_LDA(At, 1, 1); PG8_STAGE(PG8_SA(1, 0), a3, voffA);
            PG8_BAR; PG8_WAIT_L(0); PG8_MMA(1, 0, At, B0); PG8_BAR; PG8_SCHED;
            PG8_STAGE(PG8_SB(1, 1), b3 + hstep, voffB);
            PG8_WAIT_V(6); PG8_BAR; PG8_MMA(1, 1, At, B1); PG8_BAR;
            }
        }
        if constexpr (ALIGN_EPI) { if (wr == 0) PG8_BAR; }
        if constexpr (!Epi::AFTER_DRAIN) { E(acc, cur, wr, wc, fr, fq); S.done(cur); }
        if (!has_next) break;
#pragma unroll
        for (int a = 0; a < 2; ++a)
#pragma unroll
            for (int b = 0; b < 2; ++b)
#pragma unroll
                for (int m = 0; m < 4; ++m)
#pragma unroll
                    for (int n = 0; n < 2; ++n) acc[a][b][m][n] = (f32x4){0.f, 0.f, 0.f, 0.f};
        cur = nxt; cA = nA; cB = nB; ++ui;
        if constexpr (ALIGN_EPI) { if (wr == 1) PG8_BAR; }
    }
    PG8_WAIT_V(0);
    if constexpr (!ALIGN_EPI) { if (wr == 0) PG8_BAR; }
    PG8_BAR;
    if constexpr (Epi::AFTER_DRAIN) { E.fused(acc, cur, wr, wc, fr, fq, lds, wid, lane); S.done(cur); }
#undef PG8_SA
#undef PG8_SB
#undef PG8_STAGE
#undef PG8_LDA
#undef PG8_LDB
#undef PG8_MMA
#undef PG8_WAIT_V
#undef PG8_WAIT_L
#undef PG8_BAR
#undef PG8_SCHED
}
}

#define WTAB_OFF 155392
extern __shared__ __attribute__((aligned(16))) unsigned char lds_raw[];
__device__ __forceinline__ int hw_slot() { return (int)(__builtin_amdgcn_s_getreg((5 << 11) | 4) & 63u); }
__device__ __forceinline__ void otid_init() { const int t = threadIdx.x; if ((t & 63) == 0) ((__attribute__((address_space(3))) int*)(__attribute__((address_space(3))) void*)(lds_raw + WTAB_OFF))[hw_slot()] = t >> 6; }
__device__ __forceinline__ int otid() {
    const int w = __builtin_amdgcn_readfirstlane(((const __attribute__((address_space(3))) int*)(__attribute__((address_space(3))) void*)(lds_raw + WTAB_OFF))[hw_slot()]);
    int l; asm volatile("v_mbcnt_lo_u32_b32 %0, -1, 0\n\tv_mbcnt_hi_u32_b32 %0, -1, %0" : "=v"(l));
    return (w << 6) + l;
}
using pg8::bf16_t; using pg8::bf16x8; using pg8::f32x4; using pg8::u32x4;
#define LAS __attribute__((address_space(3)))

#define DMODEL 1024
#define NPT 16384
#define NST 32
#define NTOK 16416
#define MPAD 16640
#define SEQ 2048
#define ZW 2816
#define OFF_A 1536
#define OFF_B 1544
#define OFF_Z 1552
#define OFF_QA 2064
#define OFF_KVA 2448
#define OFF_KR 2704
#define DFF 2816
#define PAST 16384
#define NPAGES 128
#define EPSV 1e-6f

#define O_YP 0
#define O_YS (O_YP + 16777216)
#define O_CKVP (O_YS + 32768)
#define O_KRP (O_CKVP + 4194304)
#define O_GSP (O_KRP + 524288)
#define O_CSP (O_GSP + 262144)
#define O_CKVS (O_CSP + 36864)
#define O_KRS (O_CKVS + 8192)
#define O_GSS (O_KRS + 1024)
#define O_CSS (O_GSS + 1048576)

__device__ __forceinline__ bf16_t f2bf(float f) { unsigned u = __float_as_uint(f); return (bf16_t)((u + 0x7fffu + ((u >> 16) & 1u)) >> 16); }
__device__ __forceinline__ float bf2f(bf16_t b) { return __uint_as_float(((unsigned)b) << 16); }
__device__ __forceinline__ float wave_sum(float v) {
#pragma unroll
    for (int o = 1; o < 64; o <<= 1) v += __shfl_xor(v, o);
    return v;
}
__device__ __forceinline__ float sigmoidf_(float x) { return 1.f / (1.f + expf(-x)); }
__device__ __forceinline__ float siluf_(float x) { return x / (1.f + expf(-x)); }


#define WSYNC() do { __builtin_amdgcn_fence(__ATOMIC_ACQ_REL, "wavefront"); __builtin_amdgcn_wave_barrier(); } while (0)
#define NTHR 512
#define NWAVE 8

__device__ __forceinline__ unsigned pk2bf(float lo, float hi) { return (unsigned)f2bf(lo) | ((unsigned)f2bf(hi) << 16); }

__device__ __forceinline__ void wt_tile(bool active, const float* __restrict__ W, bf16_t* __restrict__ Wt, int ldw, int col0, int N, int ldt, int nb_, int kb_, float* t  ) {
    const int tx = otid() & 31, ty = (otid() >> 5) & 7;
    const int n0 = nb_ * 32, k0 = kb_ * 32;
    __syncthreads();
    if (active) for (int i = ty; i < 32; i += 8) {
        const int k = k0 + i, n = n0 + tx; float v = 0.f;
        if (n < N) v = W[(size_t)k * ldw + col0 + n];
        t[i * 33 + tx] = v;
    }
    __syncthreads();
    if (active) for (int i = ty; i < 32; i += 8) { const int n = n0 + i, k = k0 + tx; Wt[(size_t)n * ldt + k] = f2bf(t[tx * 33 + i]); }
}

__device__ __forceinline__ void rms1024_row(const float* __restrict__ src, const float* __restrict__ g, bf16_t* __restrict__ o, bool zero, int lane) {
    if (zero) { for (int j = 0; j < 4; ++j) { ushort4 z = {0, 0, 0, 0}; *(ushort4*)(o + lane * 4 + 256 * j) = z; } return; }
    float4 v[4]; float ss = 0.f;
#pragma unroll
    for (int j = 0; j < 4; ++j) { v[j] = *(const float4*)(src + lane * 4 + 256 * j); ss += v[j].x * v[j].x + v[j].y * v[j].y + v[j].z * v[j].z + v[j].w * v[j].w; }
    ss = wave_sum(ss);
    const float rs = rsqrtf(ss * (1.f / 1024.f) + EPSV);
#pragma unroll
    for (int j = 0; j < 4; ++j) {
        const float4 gg = *(const float4*)(g + lane * 4 + 256 * j);
        ushort4 w; w.x = f2bf(v[j].x * rs * gg.x); w.y = f2bf(v[j].y * rs * gg.y); w.z = f2bf(v[j].z * rs * gg.z); w.w = f2bf(v[j].w * rs * gg.w);
        *(ushort4*)(o + lane * 4 + 256 * j) = w;
    }
}

struct ABf16 { const bf16_t* p; int lda; __device__ __forceinline__ bf16x8 load(int m, int k) const { return *(const bf16x8*)(p + (size_t)m * lda + k); } };
struct ACache {
    const float* cache; const int* pt;
    __device__ __forceinline__ bf16x8 load(int m, int k) const {
        const int b = m >> 14, t = m & 16383; const int phys = pt[b * NPAGES + (t >> 7)];
        const float* r = cache + ((size_t)phys * 128 + (t & 127)) * 256 + k;
        const float4 a = *(const float4*)r, c = *(const float4*)(r + 4);
        bf16x8 o; o[0] = (short)f2bf(a.x); o[1] = (short)f2bf(a.y); o[2] = (short)f2bf(a.z); o[3] = (short)f2bf(a.w);
        o[4] = (short)f2bf(c.x); o[5] = (short)f2bf(c.y); o[6] = (short)f2bf(c.z); o[7] = (short)f2bf(c.w); return o;
    }
};
template <class AL, class Epi>
__device__ __forceinline__ void gemm_tile_256x128(const AL& al, const bf16_t* __restrict__ Bt, int ldb, int K, const Epi& epi, int m0, int n0, char* smem) {
    bf16_t (*sA)[40] = (bf16_t (*)[40])smem;
    bf16_t (*sB)[40] = (bf16_t (*)[40])(smem + 20480);
    const int tid = otid(), lane = tid & 63, wid = tid >> 6, wm = wid >> 1, wn = wid & 1;
    f32x4 acc[4][4];
#pragma unroll
    for (int i = 0; i < 4; ++i)
#pragma unroll
        for (int j = 0; j < 4; ++j) acc[i][j] = (f32x4){0.f, 0.f, 0.f, 0.f};
    __syncthreads();
    for (int k0 = 0; k0 < K; k0 += 32) {
#pragma unroll
        for (int i = 0; i < 2; ++i) { const int ch = tid + 512 * i, r = ch >> 2, kc = (ch & 3) * 8; *(bf16x8*)&sA[r][kc] = al.load(m0 + r, k0 + kc); }
        { const int r = tid >> 2, kc = (tid & 3) * 8; *(bf16x8*)&sB[r][kc] = *(const bf16x8*)(Bt + (size_t)(n0 + r) * ldb + k0 + kc); }
        __syncthreads();
        bf16x8 af[4], bfr[4];
#pragma unroll
        for (int i = 0; i < 4; ++i) af[i] = *(const bf16x8*)&sA[wm * 64 + i * 16 + (lane & 15)][(lane >> 4) * 8];
#pragma unroll
        for (int j = 0; j < 4; ++j) bfr[j] = *(const bf16x8*)&sB[wn * 64 + j * 16 + (lane & 15)][(lane >> 4) * 8];
#pragma unroll
        for (int i = 0; i < 4; ++i)
#pragma unroll
            for (int j = 0; j < 4; ++j) acc[i][j] = __builtin_amdgcn_mfma_f32_16x16x32_bf16(af[i], bfr[j], acc[i][j], 0, 0, 0);
        __syncthreads();
    }
#pragma unroll
    for (int i = 0; i < 4; ++i)
#pragma unroll
        for (int j = 0; j < 4; ++j)
#pragma unroll
            for (int r = 0; r < 4; ++r) epi(m0 + wm * 64 + i * 16 + (lane >> 4) * 4 + r, n0 + wn * 64 + j * 16 + (lane & 15), acc[i][j][r]);
}
template <class Epi>
__device__ __forceinline__ void gemm_tile_32x256(const bf16_t* __restrict__ A, int lda, const bf16_t* __restrict__ Bt, int ldb, int K, const Epi& epi, int m0, int n0, char* smem) {
    bf16_t (*sA)[40] = (bf16_t (*)[40])smem;
    bf16_t (*sB)[40] = (bf16_t (*)[40])(smem + 2560);
    const int tid = otid(), lane = tid & 63, wid = tid >> 6;
    f32x4 acc[2][2];
#pragma unroll
    for (int i = 0; i < 2; ++i)
#pragma unroll
        for (int j = 0; j < 2; ++j) acc[i][j] = (f32x4){0.f, 0.f, 0.f, 0.f};
    __syncthreads();
    for (int k0 = 0; k0 < K; k0 += 32) {
        if (tid < 128) { const int r = tid >> 2, kc = (tid & 3) * 8; *(bf16x8*)&sA[r][kc] = *(const bf16x8*)(A + (size_t)(m0 + r) * lda + k0 + kc); }
#pragma unroll
        for (int i = 0; i < 2; ++i) { const int ch = tid + 512 * i, r = ch >> 2, kc = (ch & 3) * 8; *(bf16x8*)&sB[r][kc] = *(const bf16x8*)(Bt + (size_t)(n0 + r) * ldb + k0 + kc); }
        __syncthreads();
        bf16x8 af[2], bfr[2];
#pragma unroll
        for (int i = 0; i < 2; ++i) af[i] = *(const bf16x8*)&sA[i * 16 + (lane & 15)][(lane >> 4) * 8];
#pragma unroll
        for (int j = 0; j < 2; ++j) bfr[j] = *(const bf16x8*)&sB[wid * 32 + j * 16 + (lane & 15)][(lane >> 4) * 8];
#pragma unroll
        for (int i = 0; i < 2; ++i)
#pragma unroll
            for (int j = 0; j < 2; ++j) acc[i][j] = __builtin_amdgcn_mfma_f32_16x16x32_bf16(af[i], bfr[j], acc[i][j], 0, 0, 0);
        __syncthreads();
    }
#pragma unroll
    for (int i = 0; i < 2; ++i)
#pragma unroll
        for (int j = 0; j < 2; ++j)
#pragma unroll
            for (int r = 0; r < 4; ++r) epi(m0 + i * 16 + (lane >> 4) * 4 + r, n0 + wid * 32 + j * 16 + (lane & 15), acc[i][j][r]);
}
template <class Epi>
__device__ __forceinline__ void gemm_sample_rows(const bf16_t* __restrict__ A, int lda, const bf16_t* __restrict__ Bt, int K, int N, const Epi& epi, char* smem, int bid, int nb) {
    const int nu = N / 256;
    for (int u = nb - 1 - bid; u < nu; u += nb) gemm_tile_32x256(A, lda, Bt, K, K, epi, NPT, u * 256, smem);
}
struct EwF32 { float* C; int ldc; __device__ __forceinline__ void operator()(int m, int n, float v) const { C[(size_t)m * ldc + n] = v; } };
struct EwBf16 { bf16_t* C; int ldc; __device__ __forceinline__ void operator()(int m, int n, float v) const { C[(size_t)m * ldc + n] = f2bf(v); } };
struct EwResX { const float* xs; float* C; __device__ __forceinline__ void operator()(int m, int n, float v) const { C[(size_t)m * 1024 + n] = xs[(size_t)(m - NPT) * 1024 + n] + v; } };
struct EwSwiglu {
    float* G; bf16_t* Hd;
    __device__ __forceinline__ void operator()(int m, int n, float v) const {
        const int f = (n >> 8) * 128 + (n & 127);
        if ((n & 255) < 128) G[(size_t)(m - NPT) * DFF + f] = v;
    }
};
struct EwSwiglu2 {
    const float* G; bf16_t* Hd;
    __device__ __forceinline__ void operator()(int m, int n, float v) const {
        const int f = (n >> 8) * 128 + (n & 127);
        if ((n & 255) >= 128) Hd[(size_t)m * DFF + f] = f2bf(siluf_(G[(size_t)(m - NPT) * DFF + f]) * v);
    }
};
struct EwResH { const float* H; float* C; __device__ __forceinline__ void operator()(int m, int n, float v) const { C[(size_t)m * 1024 + n] = H[(size_t)m * 1024 + n] + v; } };
struct EwPle { const float* H2; const float* PP; float* out;
    __device__ __forceinline__ void operator()(int m, int n, float v) const { out[O_YS + (size_t)(m - NPT) * 1024 + n] = H2[(size_t)m * 1024 + n] + PP[(size_t)m * 1024 + n] * sigmoidf_(v); } };

struct PgBf16 {
    static constexpr bool PERM = true, AFTER_DRAIN = false; bf16_t* O; int ldc;
    __device__ __forceinline__ void operator()(const f32x4 (&acc)[2][2][4][2], const pg8::Unit& u, int wr, int wc, int fr, int fq) const {
#pragma unroll
        for (int ai = 0; ai < 2; ++ai)
#pragma unroll
            for (int m = 0; m < 4; ++m) { bf16_t* rowp = O + (size_t)(u.pm * 256 + ai * 128 + wr * 64 + m * 16 + fr) * ldc + u.pn * 256 + wc * 32 + 8 * fq;
#pragma unroll
                for (int bj = 0; bj < 2; ++bj) { const f32x4 v0 = acc[ai][bj][m][0], v1 = acc[ai][bj][m][1]; u32x4 w; w.x = pk2bf(v0[0], v0[1]); w.y = pk2bf(v0[2], v0[3]); w.z = pk2bf(v1[0], v1[1]); w.w = pk2bf(v1[2], v1[3]); *(u32x4*)(rowp + bj * 128) = w; } }
    }
};
struct PgF32 {
    static constexpr bool PERM = false, AFTER_DRAIN = false; float* O; int ldc;
    __device__ __forceinline__ void operator()(const f32x4 (&acc)[2][2][4][2], const pg8::Unit& u, int wr, int wc, int fr, int fq) const {
#pragma unroll
        for (int ai = 0; ai < 2; ++ai)
#pragma unroll
            for (int m = 0; m < 4; ++m) { float* rowp = O + (size_t)(u.pm * 256 + ai * 128 + wr * 64 + m * 16 + fr) * ldc + u.pn * 256 + wc * 32 + 4 * fq;
#pragma unroll
                for (int bj = 0; bj < 2; ++bj)
#pragma unroll
                    for (int n = 0; n < 2; ++n) *(f32x4*)(rowp + bj * 128 + n * 16) = acc[ai][bj][m][n]; }
    }
};
struct PgRes {
    static constexpr bool PERM = false, AFTER_DRAIN = false; const float* R; float* O;
    __device__ __forceinline__ void operator()(const f32x4 (&acc)[2][2][4][2], const pg8::Unit& u, int wr, int wc, int fr, int fq) const {
#pragma unroll
        for (int ai = 0; ai < 2; ++ai)
#pragma unroll
            for (int m = 0; m < 4; ++m) { const size_t off = (size_t)(u.pm * 256 + ai * 128 + wr * 64 + m * 16 + fr) * 1024 + u.pn * 256 + wc * 32 + 4 * fq;
#pragma unroll
                for (int bj = 0; bj < 2; ++bj)
#pragma unroll
                    for (int n = 0; n < 2; ++n) { const f32x4 r = *(const f32x4*)(R + off + bj * 128 + n * 16); *(f32x4*)(O + off + bj * 128 + n * 16) = r + acc[ai][bj][m][n]; } }
    }
};
struct PgSwiglu {
    static constexpr bool PERM = true, AFTER_DRAIN = false; bf16_t* Hd;
    __device__ __forceinline__ void operator()(const f32x4 (&acc)[2][2][4][2], const pg8::Unit& u, int wr, int wc, int fr, int fq) const {
#pragma unroll
        for (int ai = 0; ai < 2; ++ai)
#pragma unroll
            for (int m = 0; m < 4; ++m) { bf16_t* rowp = Hd + (size_t)(u.pm * 256 + ai * 128 + wr * 64 + m * 16 + fr) * DFF + u.pn * 128 + wc * 32 + 8 * fq;
                float h[8];
#pragma unroll
                for (int n = 0; n < 2; ++n)
#pragma unroll
                    for (int i = 0; i < 4; ++i) h[n * 4 + i] = siluf_(acc[ai][0][m][n][i]) * acc[ai][1][m][n][i];
                u32x4 w; w.x = pk2bf(h[0], h[1]); w.y = pk2bf(h[2], h[3]); w.z = pk2bf(h[4], h[5]); w.w = pk2bf(h[6], h[7]); *(u32x4*)rowp = w; }
    }
};
struct PgPle {
    static constexpr bool PERM = false, AFTER_DRAIN = false; const float* H2; const float* PP; float* out;
    __device__ __forceinline__ void operator()(const f32x4 (&acc)[2][2][4][2], const pg8::Unit& u, int wr, int wc, int fr, int fq) const {
#pragma unroll
        for (int ai = 0; ai < 2; ++ai)
#pragma unroll
            for (int m = 0; m < 4; ++m) { const size_t off = (size_t)(u.pm * 256 + ai * 128 + wr * 64 + m * 16 + fr) * 1024 + u.pn * 256 + wc * 32 + 4 * fq;
#pragma unroll
                for (int bj = 0; bj < 2; ++bj)
#pragma unroll
                    for (int n = 0; n < 2; ++n) { const f32x4 h = *(const f32x4*)(H2 + off + bj * 128 + n * 16), pp = *(const f32x4*)(PP + off + bj * 128 + n * 16), a = acc[ai][bj][m][n]; f32x4 y;
#pragma unroll
                        for (int i = 0; i < 4; ++i) y[i] = h[i] + pp[i] * sigmoidf_(a[i]);
                        *(f32x4*)(out + O_YP + off + bj * 128 + n * 16) = y; } }
    }
};
template <class Epi>
__device__ __forceinline__ void pg_gemm(LAS unsigned char* lds, const bf16_t* A, const bf16_t* Bt, int M, int N, int K, const Epi& E) {
    pg8::Gemm g{A, Bt, M, N, K}; pg8::StaticOrder S; S.init(M, N, (int)gridDim.x, (int)blockIdx.x);
    pg8::gemm_phase<Epi, pg8::StaticOrder, true, true>(lds, g, S, E);
}

struct MK {
    const float *x_prompt, *x_sample, *cache_ckv, *cache_krope, *state_gdn, *state_conv; const int* page_table; const float *p_prompt, *p_sample;
    const float *g_attn, *w_in, *w_conv, *a_log, *dt_bias, *g_gdn_out, *g_q_a, *w_q_b, *g_q_nope, *g_q_rope, *g_kv_a, *g_k_rope, *w_kv_b, *g_k_nope, *w_o, *g_ffn, *w_gate, *w_up, *w_down, *g_ple, *w_ple_gate, *w_ple_proj;
    float* out;
    bf16_t *WinT, *WqbT, *WkvT, *WknT, *WoT, *WguT, *WdT, *WpgT, *WppT, *xn, *pb, *Z;
    float *qf, *kf, *vf, *gg, *bb, *goraw; bf16_t *qan, *ckvb; float *krf, *Q, *qh, *KV, *kh; bf16_t *omix, *KN, *Qb, *Kb, *Vb; float *SC, *part, *H; bf16_t* un; float* G; bf16_t* hid; float* H2; bf16_t* un2; float* PP;
};

__device__ __forceinline__ void post_in_row(const MK& a, int row, float* red) {
    const int tid = otid() & 255, lane = tid & 63, wid = tid >> 6;
    const bool samp = row >= NPT;
    const int b = samp ? row - NPT : row >> 11, t = samp ? 0 : row & 2047;
    const bf16_t* z = a.Z + (size_t)row * ZW;
#pragma unroll
    for (int i = 0; i < 6; ++i) {
        const int c = tid + 256 * i;
        float e0, e1, e2, e3;
        e3 = bf2f(z[c]);
        if (samp) { e0 = a.state_conv[((size_t)b * 3 + 0) * 1536 + c]; e1 = a.state_conv[((size_t)b * 3 + 1) * 1536 + c]; e2 = a.state_conv[((size_t)b * 3 + 2) * 1536 + c]; }
        else {
            e0 = t >= 3 ? bf2f(a.Z[(size_t)(row - 3) * ZW + c]) : 0.f;
            e1 = t >= 2 ? bf2f(a.Z[(size_t)(row - 2) * ZW + c]) : 0.f;
            e2 = t >= 1 ? bf2f(a.Z[(size_t)(row - 1) * ZW + c]) : 0.f;
        }
        float y = e0 * a.w_conv[c] + e1 * a.w_conv[1536 + c] + e2 * a.w_conv[2 * 1536 + c] + e3 * a.w_conv[3 * 1536 + c];
        y = siluf_(y);
        if (samp) { a.out[O_CSS + ((size_t)b * 3 + 0) * 1536 + c] = e1; a.out[O_CSS + ((size_t)b * 3 + 1) * 1536 + c] = e2; a.out[O_CSS + ((size_t)b * 3 + 2) * 1536 + c] = e3; }
        else if (t >= SEQ - 3) a.out[O_CSP + ((size_t)b * 3 + (t - (SEQ - 3))) * 1536 + c] = e3;
        const int sec = c >> 9, cc = c & 511;
        if (sec == 2) a.vf[(size_t)row * 512 + cc] = y;
        else {
            const float ss = wave_sum(y * y);
            const float r = rsqrtf(ss + EPSV);
            if (sec == 0) a.qf[(size_t)row * 512 + cc] = y * r * 0.125f; else a.kf[(size_t)row * 512 + cc] = y * r;
        }
    }
    if (tid < 8) {
        const float av = bf2f(z[OFF_A + tid]), bv = bf2f(z[OFF_B + tid]);
        const float xx = av + a.dt_bias[tid];
        const float sp = xx > 20.f ? xx : log1pf(expf(xx));
        a.gg[(size_t)row * 8 + tid] = -expf(a.a_log[tid]) * sp;
        a.bb[(size_t)row * 8 + tid] = sigmoidf_(bv);
    }
    {
        const float v0 = bf2f(z[OFF_QA + tid]), v1 = tid < 128 ? bf2f(z[OFF_QA + 256 + tid]) : 0.f;
        float ss = wave_sum(v0 * v0 + v1 * v1);
        if (lane == 0) red[wid] = ss;
        __syncthreads();
        ss = red[0] + red[1] + red[2] + red[3];
        const float rs = rsqrtf(ss * (1.f / 384.f) + EPSV);
        a.qan[(size_t)row * 384 + tid] = f2bf(v0 * rs * a.g_q_a[tid]);
        if (tid < 128) a.qan[(size_t)row * 384 + 256 + tid] = f2bf(v1 * rs * a.g_q_a[256 + tid]);
    }
    {
        const float v = bf2f(z[OFF_KVA + tid]);
        float ss = wave_sum(v * v);
        if (lane == 0) red[4 + wid] = ss;
        __syncthreads();
        ss = red[4] + red[5] + red[6] + red[7];
        const float rs = rsqrtf(ss * (1.f / 256.f) + EPSV);
        const float o = v * rs * a.g_kv_a[tid];
        a.ckvb[(size_t)row * 256 + tid] = f2bf(o);
        if (samp) a.out[O_CKVS + (size_t)b * 256 + tid] = o; else a.out[O_CKVP + (size_t)row * 256 + tid] = o;
    }
    if (wid == 0) {
        const float v = lane < 32 ? bf2f(z[OFF_KR + lane]) : 0.f;
        const float ss = wave_sum(v * v);
        const float rs = rsqrtf(ss * (1.f / 32.f) + EPSV);
        const float xn = lane < 32 ? v * rs * a.g_k_rope[lane] : 0.f;
        const float other = __shfl_xor(xn, 16);
        const int i = lane & 15;
        const float pos = samp ? (float)PAST : (float)t;
        const float ang = pos * powf(10000.f, -(float)i / 16.f);
        const float cs = cosf(ang), sn = sinf(ang);
        const float o = lane < 16 ? xn * cs - other * sn : other * sn + xn * cs;
        if (lane < 32) {
            a.krf[(size_t)row * 32 + lane] = o;
            if (samp) a.out[O_KRS + (size_t)b * 32 + lane] = o; else a.out[O_KRP + (size_t)row * 32 + lane] = o;
        }
    }
}
__device__ __forceinline__ void post_q_item(const MK& a, int idx, int lane) {
    const int row = idx >> 3, h = idx & 7;
    const float* q = a.Q + (size_t)row * 768 + h * 96;
    float* o = a.qh + ((size_t)row * 8 + h) * 96;
    const float v = q[lane];
    const float ss = wave_sum(v * v);
    o[lane] = v * rsqrtf(ss * (1.f / 64.f) + EPSV) * a.g_q_nope[lane];
    const float r = lane < 32 ? q[64 + lane] : 0.f;
    const float s2 = wave_sum(r * r);
    const float xn = lane < 32 ? r * rsqrtf(s2 * (1.f / 32.f) + EPSV) * a.g_q_rope[lane] : 0.f;
    const float other = __shfl_xor(xn, 16);
    const int i = lane & 15;
    const float pos = row >= NPT ? (float)PAST : (float)(row & 2047);
    const float ang = pos * powf(10000.f, -(float)i / 16.f);
    const float cs = cosf(ang), sn = sinf(ang);
    const float ov = lane < 16 ? xn * cs - other * sn : other * sn + xn * cs;
    if (lane < 32) o[64 + lane] = ov;
    if (row < NPT) {
        bf16_t* qb = a.Qb + ((size_t)((row >> 11) * 8 + h) * 2048 + (row & 2047)) * 96;
        qb[lane] = f2bf(o[lane] * 0.14724445f);
        if (lane < 32) qb[64 + lane] = f2bf(ov * 0.14724445f);
    }
}
__device__ __forceinline__ void post_kv_item(const MK& a, int idx, int lane) {
    const int row = idx >> 3, h = idx & 7;
    const float v = a.KV[(size_t)row * 1024 + h * 128 + lane];
    const float ss = wave_sum(v * v);
    const float kn = v * rsqrtf(ss * (1.f / 64.f) + EPSV) * a.g_k_nope[lane];
    a.kh[((size_t)row * 8 + h) * 64 + lane] = kn;
    if (row < NPT) {
        const size_t br = (size_t)((row >> 11) * 8 + h) * 2048 + (row & 2047);
        a.Kb[br * 96 + lane] = f2bf(kn);
        if (lane < 32) a.Kb[br * 96 + 64 + lane] = f2bf(a.krf[(size_t)row * 32 + lane]);
        a.Vb[br * 64 + lane] = f2bf(a.KV[(size_t)row * 1024 + h * 128 + 64 + lane]);
    }
}

typedef float f32x16 __attribute__((ext_vector_type(16)));
typedef short s16x4 __attribute__((ext_vector_type(4)));
#define KST 104
#define VST 72
#define ATT_BUF (64 * KST * 2 + 64 * VST * 2)
__device__ __forceinline__ int crow32(int r, int hi) { return (r & 3) + 8 * (r >> 2) + 4 * hi; }
__device__ __forceinline__ s16x4 tr_read(const bf16_t* p) { return __builtin_bit_cast(s16x4, __builtin_amdgcn_ds_read_tr16_b64_v4i16((LAS s16x4*)(LAS void*)(unsigned)(size_t)p)); }
__device__ __forceinline__ bf16x8 pack8(const f32x16& x, int s) {
    u32x4 w; w.x = pk2bf(x[8 * s], x[8 * s + 1]); w.y = pk2bf(x[8 * s + 2], x[8 * s + 3]); w.z = pk2bf(x[8 * s + 4], x[8 * s + 5]); w.w = pk2bf(x[8 * s + 6], x[8 * s + 7]);
    return __builtin_bit_cast(bf16x8, w);
}
__device__ __forceinline__ void attn_block(const MK& a, int b, int h, int qb, char* smem) {
    const int tid = otid(), lane = tid & 63, wid = tid >> 6, r32 = lane & 31, hi = lane >> 5;
    const size_t bh = (size_t)(b * 8 + h) * 2048;
    const int qrow = qb * 256 + wid * 32 + r32;
    const int wq0 = qb * 256 + wid * 32;
    bf16x8 qf[6];
    { const bf16_t* Qg = a.Qb + (bh + qrow) * 96;
#pragma unroll
      for (int ds = 0; ds < 6; ++ds) qf[ds] = *(const bf16x8*)(Qg + 16 * ds + 8 * hi); }
    f32x16 o0, o1;
#pragma unroll
    for (int r = 0; r < 16; ++r) { o0[r] = 0.f; o1[r] = 0.f; }
    float m = -INFINITY, l = 0.f;
    const int nt = qb * 4 + 4;
    const int kc0r = tid / 12, kc0c = tid % 12, kc1r = (512 + tid) / 12, kc1c = (512 + tid) % 12, vr = tid >> 3, vc = tid & 7;
    const bf16_t* Kg = a.Kb + bh * 96; const bf16_t* Vg = a.Vb + bh * 64;
    bf16x8 kr0, kr1, vr0;
    kr0 = *(const bf16x8*)(Kg + (size_t)kc0r * 96 + kc0c * 8);
    if (tid < 256) kr1 = *(const bf16x8*)(Kg + (size_t)kc1r * 96 + kc1c * 8);
    vr0 = *(const bf16x8*)(Vg + (size_t)vr * 64 + vc * 8);
    __syncthreads();
    {
        bf16_t* Ks = (bf16_t*)smem; bf16_t* Vs = Ks + 64 * KST;
        *(bf16x8*)(Ks + kc0r * KST + kc0c * 8) = kr0;
        if (tid < 256) *(bf16x8*)(Ks + kc1r * KST + kc1c * 8) = kr1;
        *(bf16x8*)(Vs + vr * VST + vc * 8) = vr0;
    }
    __syncthreads();
    const int i16 = lane & 15, qq = i16 >> 2, pp = i16 & 3, g1 = (lane >> 4) & 1;
    for (int t = 0; t < nt; ++t) {
        const bf16_t* Ks = (const bf16_t*)(smem + (t & 1) * ATT_BUF); const bf16_t* Vs = Ks + 64 * KST;
        if (t + 1 < nt) {
            const size_t ro = (size_t)(t + 1) * 64;
            kr0 = *(const bf16x8*)(Kg + (ro + kc0r) * 96 + kc0c * 8);
            if (tid < 256) kr1 = *(const bf16x8*)(Kg + (ro + kc1r) * 96 + kc1c * 8);
            vr0 = *(const bf16x8*)(Vg + (ro + vr) * 64 + vc * 8);
        }
        if (64 * t <= wq0 + 31) {
            f32x16 p0, p1;
#pragma unroll
            for (int r = 0; r < 16; ++r) { p0[r] = 0.f; p1[r] = 0.f; }
#pragma unroll
            for (int ds = 0; ds < 6; ++ds) {
                const bf16x8 k0 = *(const bf16x8*)(Ks + r32 * KST + 16 * ds + 8 * hi);
                const bf16x8 k1 = *(const bf16x8*)(Ks + (32 + r32) * KST + 16 * ds + 8 * hi);
                p0 = __builtin_amdgcn_mfma_f32_32x32x16_bf16(k0, qf[ds], p0, 0, 0, 0);
                p1 = __builtin_amdgcn_mfma_f32_32x32x16_bf16(k1, qf[ds], p1, 0, 0, 0);
            }
            if (64 * t + 63 > wq0) {
#pragma unroll
                for (int r = 0; r < 16; ++r) { const int kv = 64 * t + crow32(r, hi); if (kv > qrow) p0[r] = -INFINITY; if (kv + 32 > qrow) p1[r] = -INFINITY; }
            }
            float mx = fmaxf(p0[0], p1[0]);
#pragma unroll
            for (int r = 1; r < 16; ++r) mx = fmaxf(mx, fmaxf(p0[r], p1[r]));
            mx = fmaxf(mx, __shfl_xor(mx, 32));
            const float mn = fmaxf(m, mx);
            const float alpha = __builtin_amdgcn_exp2f(m - mn);
            m = mn;
            float rs = 0.f;
#pragma unroll
            for (int r = 0; r < 16; ++r) { p0[r] = __builtin_amdgcn_exp2f(p0[r] - mn); p1[r] = __builtin_amdgcn_exp2f(p1[r] - mn); rs += p0[r] + p1[r]; }
            l = l * alpha + rs;
#pragma unroll
            for (int r = 0; r < 16; ++r) { o0[r] *= alpha; o1[r] *= alpha; }
            bf16x8 pf[4];
            pf[0] = pack8(p0, 0); pf[1] = pack8(p0, 1); pf[2] = pack8(p1, 0); pf[3] = pack8(p1, 1);
#pragma unroll
            for (int ks = 0; ks < 4; ++ks) {
                const bf16_t* vb0 = Vs + (16 * ks + 4 * hi + qq) * VST + 16 * g1 + 4 * pp;
                const s16x4 a0 = tr_read(vb0), a1 = tr_read(vb0 + 8 * VST);
                const s16x4 c0 = tr_read(vb0 + 32), c1 = tr_read(vb0 + 8 * VST + 32);
                const bf16x8 va = __builtin_shufflevector(a0, a1, 0, 1, 2, 3, 4, 5, 6, 7);
                const bf16x8 vc_ = __builtin_shufflevector(c0, c1, 0, 1, 2, 3, 4, 5, 6, 7);
                o0 = __builtin_amdgcn_mfma_f32_32x32x16_bf16(va, pf[ks], o0, 0, 0, 0);
                o1 = __builtin_amdgcn_mfma_f32_32x32x16_bf16(vc_, pf[ks], o1, 0, 0, 0);
            }
        }
        if (t + 1 < nt) {
            bf16_t* Kn = (bf16_t*)(smem + ((t + 1) & 1) * ATT_BUF); bf16_t* Vn = Kn + 64 * KST;
            *(bf16x8*)(Kn + kc0r * KST + kc0c * 8) = kr0;
            if (tid < 256) *(bf16x8*)(Kn + kc1r * KST + kc1c * 8) = kr1;
            *(bf16x8*)(Vn + vr * VST + vc * 8) = vr0;
        }
        __syncthreads();
    }
    l += __shfl_xor(l, 32);
    const float il = 1.f / l;
    bf16_t* op = a.omix + ((size_t)b * SEQ + qrow) * 1024 + 512 + h * 64;
#pragma unroll
    for (int g = 0; g < 4; ++g) {
        uint2 w0, w1;
        w0.x = pk2bf(o0[4 * g] * il, o0[4 * g + 1] * il); w0.y = pk2bf(o0[4 * g + 2] * il, o0[4 * g + 3] * il);
        w1.x = pk2bf(o1[4 * g] * il, o1[4 * g + 1] * il); w1.y = pk2bf(o1[4 * g + 2] * il, o1[4 * g + 3] * il);
        *(uint2*)(op + 8 * g + 4 * hi) = w0;
        *(uint2*)(op + 32 + 8 * g + 4 * hi) = w1;
    }
}

__device__ __forceinline__ void gdn_unit(const MK& a, int b, int h, int dvg, const float* s0, float* sout, int row0, int T, int lane, char* wsm) {
    float (*sq)[64] = (float (*)[64])wsm;
    float (*sk)[64] = (float (*)[64])(wsm + 4096);
    float (*sv)[8] = (float (*)[8])(wsm + 8192);
    float* sg = (float*)(wsm + 8704);
    float* sb = (float*)(wsm + 8768);
    const int e = lane & 7, ko = lane >> 3, col = dvg * 8 + e;
    float S[8];
#pragma unroll
    for (int d = 0; d < 8; ++d) S[d] = s0 ? s0[(((size_t)b * 8 + h) * 64 + ko * 8 + d) * 64 + col] : 0.f;
    const size_t rbase = (size_t)row0 + (size_t)b * T;
    float pq[16], pk[16], pv0, pv1, pgb;
    {
        const int nt = T < 16 ? T : 16;
#pragma unroll
        for (int j = 0; j < 16; ++j) { const bool ok = j < nt; const size_t r = rbase + (ok ? j : 0); pq[j] = ok ? a.qf[r * 512 + h * 64 + lane] : 0.f; pk[j] = ok ? a.kf[r * 512 + h * 64 + lane] : 0.f; }
        { const int j0 = lane >> 3, j1 = j0 + 8; pv0 = j0 < nt ? a.vf[(rbase + j0) * 512 + h * 64 + dvg * 8 + (lane & 7)] : 0.f; pv1 = j1 < nt ? a.vf[(rbase + j1) * 512 + h * 64 + dvg * 8 + (lane & 7)] : 0.f; }
        { const int j = lane & 15; pgb = j < nt ? (lane < 16 ? a.gg[(rbase + j) * 8 + h] : a.bb[(rbase + j) * 8 + h]) : 0.f; }
    }
    for (int t0 = 0; t0 < T; t0 += 16) {
        const int nt = (T - t0) < 16 ? (T - t0) : 16;
        WSYNC();
#pragma unroll
        for (int j = 0; j < 16; ++j) { sq[j][lane] = pq[j]; sk[j][lane] = pk[j]; }
        sv[lane >> 3][lane & 7] = pv0; sv[(lane >> 3) + 8][lane & 7] = pv1;
        if (lane < 16) sg[lane] = expf(pgb); else if (lane < 32) sb[lane - 16] = pgb;
        WSYNC();
        if (t0 + 16 < T) {
            const size_t rb = rbase + t0 + 16;
#pragma unroll
            for (int j = 0; j < 16; ++j) { pq[j] = a.qf[(rb + j) * 512 + h * 64 + lane]; pk[j] = a.kf[(rb + j) * 512 + h * 64 + lane]; }
            pv0 = a.vf[(rb + (lane >> 3)) * 512 + h * 64 + dvg * 8 + (lane & 7)]; pv1 = a.vf[(rb + (lane >> 3) + 8) * 512 + h * 64 + dvg * 8 + (lane & 7)];
            pgb = lane < 16 ? a.gg[(rb + (lane & 15)) * 8 + h] : a.bb[(rb + (lane & 15)) * 8 + h];
        }
        for (int j = 0; j < nt; ++j) {
            const float dec = sg[j], be = sb[j], v = sv[j][e];
            const float4 k0 = *(const float4*)&sk[j][ko * 8], k1 = *(const float4*)&sk[j][ko * 8 + 4];
            const float4 q0 = *(const float4*)&sq[j][ko * 8], q1 = *(const float4*)&sq[j][ko * 8 + 4];
            const float kk[8] = {k0.x, k0.y, k0.z, k0.w, k1.x, k1.y, k1.z, k1.w};
            const float qq[8] = {q0.x, q0.y, q0.z, q0.w, q1.x, q1.y, q1.z, q1.w};
            float ks = 0.f;
#pragma unroll
            for (int d = 0; d < 8; ++d) { S[d] *= dec; ks += kk[d] * S[d]; }
            ks += __shfl_xor(ks, 8); ks += __shfl_xor(ks, 16); ks += __shfl_xor(ks, 32);
            const float delta = (v - ks) * be;
            float ov = 0.f;
#pragma unroll
            for (int d = 0; d < 8; ++d) { S[d] += kk[d] * delta; ov += qq[d] * S[d]; }
            ov += __shfl_xor(ov, 8); ov += __shfl_xor(ov, 16); ov += __shfl_xor(ov, 32);
            if (ko == 0) a.goraw[(rbase + t0 + j) * 512 + h * 64 + col] = ov;
        }
    }
#pragma unroll
    for (int d = 0; d < 8; ++d) sout[(((size_t)b * 8 + h) * 64 + ko * 8 + d) * 64 + col] = S[d];
}
__device__ __forceinline__ void gdn_out_item(const MK& a, int idx, int lane) {
    const int row = idx >> 3, h = idx & 7;
    const float ov = a.goraw[(size_t)row * 512 + h * 64 + lane];
    const float ss = wave_sum(ov * ov);
    const float on = ov * rsqrtf(ss * (1.f / 64.f) + EPSV) * a.g_gdn_out[lane];
    const float zg = bf2f(a.Z[(size_t)row * ZW + OFF_Z + h * 64 + lane]);
    a.omix[(size_t)row * 1024 + h * 64 + lane] = f2bf(on * siluf_(zg));
}

#define SROW 1040
#define SSLOT (32 * SROW)
#define KR_OFF (4 * SSLOT)
#define WQ_OFF (KR_OFF + 4 * 4096)
#define QR_OFF (WQ_OFF + 2048)
#define PG_OFF (QR_OFF + 1024)
#define SAMP_LDS_END (PG_OFF + 64)
typedef float f32x2_t __attribute__((ext_vector_type(2)));
typedef __bf16 bf16x2_t __attribute__((ext_vector_type(2)));
__device__ __forceinline__ unsigned cvtpk(float lo, float hi) { f32x2_t v = {lo, hi}; bf16x2_t r = __builtin_convertvector(v, bf16x2_t); return __builtin_bit_cast(unsigned, r); }
__device__ __forceinline__ void samp_issue(const MK& a, int g, LAS unsigned char* lds, const int* PG, int wid, int lane) {
    const int phys = __builtin_amdgcn_readfirstlane(((const LAS int*)(lds + PG_OFF))[g >> 2]);
    const int tok0 = (g & 3) * 32 + 4 * wid, slot = g & 3;
    const float* cs = a.cache_ckv + ((size_t)phys * 128 + tok0) * 256 + lane * 4;
#pragma unroll
    for (int i = 0; i < 4; ++i) __builtin_amdgcn_global_load_lds((const unsigned*)(cs + i * 256), (LAS unsigned*)(lds + slot * SSLOT + (4 * wid + i) * SROW), 16, 0, 0);
    const float* ks = a.cache_krope + ((size_t)phys * 128 + tok0 + (lane >> 5)) * 32 + (lane & 31);
#pragma unroll
    for (int i = 0; i < 2; ++i) __builtin_amdgcn_global_load_lds((const unsigned*)(ks + i * 64), (LAS unsigned*)(lds + KR_OFF + slot * 4096 + (4 * wid + 2 * i) * 128), 4, 0, 0);
}
__device__ __forceinline__ void samp_attn_unit(const MK& a, int u, char* smem, LAS unsigned char* lds) {
    const int tid = otid(), lane = tid & 63, h = __builtin_amdgcn_readfirstlane(tid >> 6), i16 = lane & 15, q4 = lane >> 4;
    const int b = u >> 3, sp = u & 7;
    float* WQ = (float*)(smem + WQ_OFF);
    float* QR = (float*)(smem + QR_OFF);
    int* PG = (int*)(smem + PG_OFF);
    const float SCL = 0.14724445f;
    __syncthreads();
    {
        const int h_ = tid >> 6, l_ = tid & 63, q4_ = l_ >> 4, idx = l_ & 15, d = 16 * (idx >> 2) + 4 * q4_ + (idx & 3);
        WQ[tid] = a.g_k_nope[d] * a.qh[((size_t)(NPT + b) * 8 + h_) * 96 + d] * SCL;
        if (tid < 256) QR[tid] = a.qh[((size_t)(NPT + b) * 8 + (tid >> 5)) * 96 + 64 + (tid & 31)] * SCL;
        if (tid < 16) PG[tid] = a.page_table[b * NPAGES + sp * 16 + tid];
    }
    bf16x8 wf[4][8];
#pragma unroll
    for (int mt = 0; mt < 4; ++mt)
#pragma unroll
        for (int ks = 0; ks < 8; ++ks) wf[mt][ks] = *(const bf16x8*)(a.WknT + (size_t)(h * 64 + 16 * mt + i16) * 256 + 32 * ks + 8 * q4);
#pragma unroll
    for (int mt = 0; mt < 4; ++mt)
#pragma unroll
        for (int ks = 0; ks < 8; ++ks) asm volatile("" : "+v"(wf[mt][ks]));
    __syncthreads();
    samp_issue(a, 0, lds, PG, h, lane); samp_issue(a, 1, lds, PG, h, lane); samp_issue(a, 2, lds, PG, h, lane);
    const LAS float* QRl = (const LAS float*)(lds + QR_OFF) + h * 32 + 8 * q4;
    const LAS float* WQl = (const LAS float*)(lds + WQ_OFF) + (h * 4 + q4) * 16;
    float m = -INFINITY, lsum = 0.f, lat0 = 0.f, lat1 = 0.f, lat2 = 0.f, lat3 = 0.f;
    for (int g = 0; g < 64; ++g) {
        if (g <= 61) asm volatile("s_waitcnt vmcnt(12)" ::: "memory"); else if (g == 62) asm volatile("s_waitcnt vmcnt(6)" ::: "memory"); else asm volatile("s_waitcnt vmcnt(0)" ::: "memory");
        asm volatile("s_waitcnt lgkmcnt(0)" ::: "memory"); __builtin_amdgcn_s_barrier(); asm volatile("" ::: "memory");
        if (g + 3 < 64) samp_issue(a, g + 3, lds, PG, h, lane);
        const LAS float* Cs = (const LAS float*)(lds + (g & 3) * SSLOT); const LAS float* KR = (const LAS float*)(lds + KR_OFF + (g & 3) * 4096);
        float sc[2];
#pragma unroll
        for (int hf = 0; hf < 2; ++hf) {
            f32x4 acc[4];
#pragma unroll
            for (int mt = 0; mt < 4; ++mt) acc[mt] = (f32x4){0.f, 0.f, 0.f, 0.f};
            const LAS float* cp = Cs + (16 * hf + i16) * (SROW / 4) + 8 * q4;
#pragma unroll
            for (int ks = 0; ks < 8; ++ks) {
                const f32x4 f0 = *(const LAS f32x4*)(cp + 32 * ks), f1 = *(const LAS f32x4*)(cp + 32 * ks + 4);
                u32x4 w; w.x = cvtpk(f0[0], f0[1]); w.y = cvtpk(f0[2], f0[3]); w.z = cvtpk(f1[0], f1[1]); w.w = cvtpk(f1[2], f1[3]);
                const bf16x8 cf = __builtin_bit_cast(bf16x8, w);
#pragma unroll
                for (int mt = 0; mt < 4; ++mt) acc[mt] = __builtin_amdgcn_mfma_f32_16x16x32_bf16(wf[mt][ks], cf, acc[mt], 0, 0, 0);
            }
            float ss = 0.f, dot = 0.f, rd = 0.f;
#pragma unroll
            for (int mt = 0; mt < 4; ++mt) {
                const f32x4 wq = *(const LAS f32x4*)(WQl + 4 * mt);
                ss += acc[mt][0] * acc[mt][0] + acc[mt][1] * acc[mt][1] + acc[mt][2] * acc[mt][2] + acc[mt][3] * acc[mt][3];
                dot += acc[mt][0] * wq[0] + acc[mt][1] * wq[1] + acc[mt][2] * wq[2] + acc[mt][3] * wq[3];
            }
            {
                const LAS float* kp = KR + (16 * hf + i16) * 32 + 8 * q4;
                const f32x4 k0 = *(const LAS f32x4*)kp, k1 = *(const LAS f32x4*)(kp + 4), q0 = *(const LAS f32x4*)QRl, q1 = *(const LAS f32x4*)(QRl + 4);
                rd = k0[0] * q0[0] + k0[1] * q0[1] + k0[2] * q0[2] + k0[3] * q0[3] + k1[0] * q1[0] + k1[1] * q1[1] + k1[2] * q1[2] + k1[3] * q1[3];
            }
            ss += __shfl_xor(ss, 16); dot += __shfl_xor(dot, 16); rd += __shfl_xor(rd, 16);
            ss += __shfl_xor(ss, 32); dot += __shfl_xor(dot, 32); rd += __shfl_xor(rd, 32);
            sc[hf] = dot * rsqrtf(ss * (1.f / 64.f) + EPSV) + rd;
        }
        float gm = fmaxf(sc[0], sc[1]);
#pragma unroll
        for (int o = 1; o < 16; o <<= 1) gm = fmaxf(gm, __shfl_xor(gm, o));
        const float mn = fmaxf(m, gm);
        const float alpha = __builtin_amdgcn_exp2f(m - mn), p0 = __builtin_amdgcn_exp2f(sc[0] - mn), p1 = __builtin_amdgcn_exp2f(sc[1] - mn);
        m = mn;
        lsum = lsum * alpha + p0 + p1;
        lat0 *= alpha; lat1 *= alpha; lat2 *= alpha; lat3 *= alpha;
#pragma unroll 4
        for (int t = 0; t < 16; ++t) {
            const float pa = __uint_as_float(__builtin_amdgcn_readlane(__float_as_uint(p0), t)), pb_ = __uint_as_float(__builtin_amdgcn_readlane(__float_as_uint(p1), t));
            const f32x4 ca = *(const LAS f32x4*)(Cs + t * (SROW / 4) + 4 * lane), cb = *(const LAS f32x4*)(Cs + (16 + t) * (SROW / 4) + 4 * lane);
            lat0 += pa * ca[0] + pb_ * cb[0]; lat1 += pa * ca[1] + pb_ * cb[1]; lat2 += pa * ca[2] + pb_ * cb[2]; lat3 += pa * ca[3] + pb_ * cb[3];
        }
    }
#pragma unroll
    for (int o = 1; o < 16; o <<= 1) lsum += __shfl_xor(lsum, o);
    float* o = a.part + ((size_t)u * 8 + h) * 260;
    *(float4*)(o + 4 + 4 * lane) = (float4){lat0, lat1, lat2, lat3};
    if (lane == 0) { o[0] = m * 0.69314718f; o[1] = lsum; }
}
__device__ __forceinline__ void samp_comb_unit(const MK& a, int u, char* smem) {
    float* slat = (float*)smem;
    const int b = u >> 3, h = u & 7, tid = otid() & 255;
    const size_t row = NPT + b;
    const float* q = a.qh + (row * 8 + h) * 96;
    float s_self = 0.f;
    for (int d = 0; d < 64; ++d) s_self += q[d] * a.kh[(row * 8 + h) * 64 + d];
    for (int d = 0; d < 32; ++d) s_self += q[64 + d] * a.krf[row * 32 + d];
    s_self *= 0.10206207261596577f;
    float m = s_self;
    for (int s = 0; s < 8; ++s) m = fmaxf(m, a.part[((size_t)(b * 8 + s) * 8 + h) * 260]);
    const float pself = expf(s_self - m);
    float l = pself, lat = 0.f;
    for (int s = 0; s < 8; ++s) {
        const float* p = a.part + ((size_t)(b * 8 + s) * 8 + h) * 260;
        const float w = expf(p[0] - m);
        l += p[1] * w; lat += p[4 + tid] * w;
    }
    __syncthreads();
    slat[tid] = lat;
    __syncthreads();
    if (tid < 64) {
        float o = 0.f;
        for (int c = 0; c < 256; ++c) o += slat[c] * a.w_kv_b[(size_t)c * 1024 + h * 128 + 64 + tid];
        o += pself * a.KV[row * 1024 + h * 128 + 64 + tid];
        a.omix[row * 1024 + 512 + h * 64 + tid] = f2bf(o / l);
    }
}

#define LDS_BYTES 155648
static_assert(SAMP_LDS_END <= LDS_BYTES, "LDS map");
#define GSYNC() do { grid.sync(); } while (0)
__global__ __launch_bounds__(NTHR, 2) void mega(MK a) {
    cg::grid_group grid = cg::this_grid();
    char* smem = (char*)lds_raw;
    LAS unsigned char* lds = (LAS unsigned char*)lds_raw;
    otid_init();
    __syncthreads();
    const int bid = blockIdx.x, nb = gridDim.x, ngw = nb * NWAVE;
#define LOCAL_IDS const int tid = otid(), lane = tid & 63, wid = tid >> 6, half = tid >> 8, gw = bid * NWAVE + wid; (void)lane; (void)half; (void)gw; (void)wid;

    {
    LOCAL_IDS
    {
        const int T0 = 88 * 32, T1 = 24 * 12, T2 = 32 * 8, T3 = 16 * 8, T4 = 32 * 32, T5 = 176 * 32, T7 = 32 * 88, T8 = 32 * 32, T9 = 32 * 8;
        const int TT = T0 + T1 + T2 + T3 + T4 + T5 + T7 + T8 + T9;
        float* t = (float*)(smem + half * 8192);
        for (int it0 = bid * 2; it0 < TT; it0 += nb * 2) {
            const int it = it0 + half; const bool act = it < TT;
            int r = act ? it : 0;
            if (r < T0) { wt_tile(act, a.w_in, a.WinT, 2736, 0, 2736, 1024, r % 88, r / 88, t); continue; } r -= T0;
            if (r < T1) { wt_tile(act, a.w_q_b, a.WqbT, 768, 0, 768, 384, r % 24, r / 24, t); continue; } r -= T1;
            if (r < T2) { wt_tile(act, a.w_kv_b, a.WkvT, 1024, 0, 1024, 256, r % 32, r / 32, t); continue; } r -= T2;
            if (r < T3) { const int nbk = r % 16, kb = r / 16, h = nbk >> 1; wt_tile(act, a.w_kv_b, a.WknT + (size_t)h * 64 * 256, 1024, h * 128, 64, 256, nbk & 1, kb, t); continue; } r -= T3;
            if (r < T4) { wt_tile(act, a.w_o, a.WoT, 1024, 0, 1024, 1024, r % 32, r / 32, t); continue; } r -= T4;
            if (r < T5) { const int nbk = r % 176, kb = r / 176, pn = nbk >> 3, wi = nbk & 7;
                wt_tile(act, wi < 4 ? a.w_gate : a.w_up, a.WguT + (size_t)nbk * 32 * 1024, DFF, pn * 128 + (wi & 3) * 32, 32, 1024, 0, kb, t); continue; } r -= T5;
            if (r < T7) { wt_tile(act, a.w_down, a.WdT, 1024, 0, 1024, DFF, r % 32, r / 32, t); continue; } r -= T7;
            if (r < T8) { wt_tile(act, a.w_ple_gate, a.WpgT, 1024, 0, 1024, 1024, r % 32, r / 32, t); continue; } r -= T8;
            wt_tile(act, a.w_ple_proj, a.WppT, 1024, 0, 1024, 256, r % 32, r / 32, t);
        }
        for (int row = gw; row < MPAD; row += ngw) {
            const float* src = row < NPT ? a.x_prompt + (size_t)row * 1024 : a.x_sample + (size_t)(row < NTOK ? row - NPT : 0) * 1024;
            rms1024_row(src, a.g_attn, a.xn + (size_t)row * 1024, row >= NTOK, lane);
            ushort4 w = {0, 0, 0, 0};
            if (row < NTOK) { const float* ps = row < NPT ? a.p_prompt + (size_t)row * 256 : a.p_sample + (size_t)(row - NPT) * 256; const float4 v = *(const float4*)(ps + lane * 4); w.x = f2bf(v.x); w.y = f2bf(v.y); w.z = f2bf(v.z); w.w = f2bf(v.w); }
            *(ushort4*)(a.pb + (size_t)row * 256 + lane * 4) = w;
            if (row >= NTOK) { for (int j = 0; j < 4; ++j) { ushort4 z = {0, 0, 0, 0}; *(ushort4*)(a.omix + (size_t)row * 1024 + lane * 4 + 256 * j) = z; } }
        }
    }
    }
    GSYNC();
    {
    LOCAL_IDS
    pg_gemm(lds, a.xn, a.WinT, NPT, ZW, 1024, PgBf16{a.Z, ZW});
    pg_gemm(lds, a.pb, a.WppT, NPT, 1024, 256, PgF32{a.PP, 1024});
    gemm_sample_rows(a.xn, 1024, a.WinT, 1024, ZW, EwBf16{a.Z, ZW}, smem, bid, nb);
    gemm_sample_rows(a.pb, 256, a.WppT, 256, 1024, EwF32{a.PP, 1024}, smem, bid, nb);
    }
    GSYNC();
    {
    LOCAL_IDS
    for (int r0 = bid * 2; r0 < NTOK; r0 += nb * 2) post_in_row(a, r0 + half, (float*)(smem + half * 64));
    }
    GSYNC();
    {
    LOCAL_IDS
    for (int u = gw; u < 512 + NST * 64; u += ngw) {
        if (u < 512) gdn_unit(a, u >> 6, (u >> 3) & 7, u & 7, nullptr, a.out + O_GSP, 0, SEQ, lane, smem + wid * 10240);
        else { const int v = u - 512; gdn_unit(a, v >> 6, (v >> 3) & 7, v & 7, a.state_gdn, a.out + O_GSS, NPT, 1, lane, smem + wid * 10240); }
    }
    __syncthreads();
    pg_gemm(lds, a.qan, a.WqbT, NPT, 768, 384, PgF32{a.Q, 768});
    pg_gemm(lds, a.ckvb, a.WkvT, NPT, 1024, 256, PgF32{a.KV, 1024});
    gemm_sample_rows(a.qan, 384, a.WqbT, 384, 768, EwF32{a.Q, 768}, smem, bid, nb);
    gemm_sample_rows(a.ckvb, 256, a.WkvT, 256, 1024, EwF32{a.KV, 1024}, smem, bid, nb);
    }
    GSYNC();
    {
    LOCAL_IDS
    for (int idx = gw; idx < NTOK * 8; idx += ngw) { post_q_item(a, idx, lane); post_kv_item(a, idx, lane); gdn_out_item(a, idx, lane); }
    }
    GSYNC();
    {
    LOCAL_IDS
    for (int pr = bid; pr < 256; pr += nb) { const int bh_ = pr >> 2, s_ = pr & 3; attn_block(a, bh_ >> 3, bh_ & 7, 7 - s_, smem); attn_block(a, bh_ >> 3, bh_ & 7, s_, smem); }
    for (int u = bid; u < NST * 8; u += nb) samp_attn_unit(a, u, smem, lds);
    }
    GSYNC();
    {
    LOCAL_IDS
    for (int u0 = bid * 2; u0 < NST * 8; u0 += nb * 2) samp_comb_unit(a, u0 + half, smem + half * 4096);
    }
    GSYNC();
    {
    LOCAL_IDS
    pg_gemm(lds, a.omix, a.WoT, NPT, 1024, 1024, PgRes{a.x_prompt, a.H});
    gemm_sample_rows(a.omix, 1024, a.WoT, 1024, 1024, EwResX{a.x_sample, a.H}, smem, bid, nb);
    }
    GSYNC();
    {
    LOCAL_IDS
    for (int row = gw; row < MPAD; row += ngw) rms1024_row(a.H + (size_t)row * 1024, a.g_ffn, a.un + (size_t)row * 1024, row >= NTOK, lane);
    }
    GSYNC();
    {
    LOCAL_IDS
    pg_gemm(lds, a.un, a.WguT, NPT, 2 * DFF, 1024, PgSwiglu{a.hid});
    gemm_sample_rows(a.un, 1024, a.WguT, 1024, 2 * DFF, EwSwiglu{a.G, a.hid}, smem, bid, nb);
    __threadfence(); __syncthreads();
    gemm_sample_rows(a.un, 1024, a.WguT, 1024, 2 * DFF, EwSwiglu2{a.G, a.hid}, smem, bid, nb);
    }
    GSYNC();
    {
    LOCAL_IDS
    pg_gemm(lds, a.hid, a.WdT, NPT, 1024, DFF, PgRes{a.H, a.H2});
    gemm_sample_rows(a.hid, DFF, a.WdT, DFF, 1024, EwResH{a.H, a.H2}, smem, bid, nb);
    }
    GSYNC();
    {
    LOCAL_IDS
    for (int row = gw; row < MPAD; row += ngw) rms1024_row(a.H2 + (size_t)row * 1024, a.g_ple, a.un2 + (size_t)row * 1024, row >= NTOK, lane);
    }
    GSYNC();
    {
    LOCAL_IDS
    pg_gemm(lds, a.un2, a.WpgT, NPT, 1024, 1024, PgPle{a.H2, a.PP, a.out});
    gemm_sample_rows(a.un2, 1024, a.WpgT, 1024, 1024, EwPle{a.H2, a.PP, a.out}, smem, bid, nb);
    }
}

static inline char* carve(char*& p, size_t bytes) { char* r = p; p += (bytes + 255) & ~(size_t)255; return r; }

extern "C" void kernel_launch(void* const* d_in, const int* in_sizes, int n_in, void* d_out, int out_size, void* d_ws, size_t ws_size, hipStream_t stream) {
    MK a{};
    a.x_prompt = (const float*)d_in[0]; a.x_sample = (const float*)d_in[1]; a.cache_ckv = (const float*)d_in[2]; a.cache_krope = (const float*)d_in[3];
    a.state_gdn = (const float*)d_in[4]; a.state_conv = (const float*)d_in[5]; a.page_table = (const int*)d_in[6]; a.p_prompt = (const float*)d_in[7]; a.p_sample = (const float*)d_in[8];
    a.g_attn = (const float*)d_in[9]; a.w_in = (const float*)d_in[10]; a.w_conv = (const float*)d_in[11]; a.a_log = (const float*)d_in[12]; a.dt_bias = (const float*)d_in[13];
    a.g_gdn_out = (const float*)d_in[14]; a.g_q_a = (const float*)d_in[15]; a.w_q_b = (const float*)d_in[16]; a.g_q_nope = (const float*)d_in[17]; a.g_q_rope = (const float*)d_in[18];
    a.g_kv_a = (const float*)d_in[19]; a.g_k_rope = (const float*)d_in[20]; a.w_kv_b = (const float*)d_in[21]; a.g_k_nope = (const float*)d_in[22]; a.w_o = (const float*)d_in[23];
    a.g_ffn = (const float*)d_in[24]; a.w_gate = (const float*)d_in[25]; a.w_up = (const float*)d_in[26]; a.w_down = (const float*)d_in[27]; a.g_ple = (const float*)d_in[28];
    a.w_ple_gate = (const float*)d_in[29]; a.w_ple_proj = (const float*)d_in[30];
    a.out = (float*)d_out;
    char* p = (char*)d_ws;
    a.WinT = (bf16_t*)carve(p, (size_t)ZW * 1024 * 2);
    a.WqbT = (bf16_t*)carve(p, (size_t)768 * 384 * 2);
    a.WkvT = (bf16_t*)carve(p, (size_t)1024 * 256 * 2);
    a.WknT = (bf16_t*)carve(p, (size_t)512 * 256 * 2);
    a.WoT = (bf16_t*)carve(p, (size_t)1024 * 1024 * 2);
    a.WguT = (bf16_t*)carve(p, (size_t)2 * DFF * 1024 * 2);
    a.WdT = (bf16_t*)carve(p, (size_t)1024 * DFF * 2);
    a.WpgT = (bf16_t*)carve(p, (size_t)1024 * 1024 * 2);
    a.WppT = (bf16_t*)carve(p, (size_t)1024 * 256 * 2);
    a.xn = (bf16_t*)carve(p, (size_t)MPAD * 1024 * 2);
    a.pb = (bf16_t*)carve(p, (size_t)MPAD * 256 * 2);
    a.Z = (bf16_t*)carve(p, (size_t)MPAD * ZW * 2);
    a.qf = (float*)carve(p, (size_t)MPAD * 512 * 4);
    a.kf = (float*)carve(p, (size_t)MPAD * 512 * 4);
    a.vf = (float*)carve(p, (size_t)MPAD * 512 * 4);
    a.gg = (float*)carve(p, (size_t)MPAD * 8 * 4);
    a.bb = (float*)carve(p, (size_t)MPAD * 8 * 4);
    a.goraw = (float*)carve(p, (size_t)MPAD * 512 * 4);
    a.qan = (bf16_t*)carve(p, (size_t)MPAD * 384 * 2);
    a.ckvb = (bf16_t*)carve(p, (size_t)MPAD * 256 * 2);
    a.krf = (float*)carve(p, (size_t)MPAD * 32 * 4);
    a.Q = (float*)carve(p, (size_t)MPAD * 768 * 4);
    a.qh = (float*)carve(p, (size_t)MPAD * 768 * 4);
    a.KV = (float*)carve(p, (size_t)MPAD * 1024 * 4);
    a.kh = (float*)carve(p, (size_t)MPAD * 512 * 4);
    a.omix = (bf16_t*)carve(p, (size_t)MPAD * 1024 * 2);
    a.KN = (bf16_t*)carve(p, (size_t)NST * PAST * 512 * 2);
    a.Qb = (bf16_t*)carve(p, (size_t)NPT * 8 * 96 * 2);
    a.Kb = (bf16_t*)carve(p, (size_t)NPT * 8 * 96 * 2);
    a.Vb = (bf16_t*)carve(p, (size_t)NPT * 8 * 64 * 2);
    a.SC = (float*)carve(p, (size_t)NST * 8 * PAST * 4);
    a.part = (float*)carve(p, (size_t)NST * 8 * 8 * 260 * 4);
    a.H = (float*)carve(p, (size_t)MPAD * 1024 * 4);
    a.un = (bf16_t*)carve(p, (size_t)MPAD * 1024 * 2);
    a.G = (float*)carve(p, (size_t)NST * DFF * 4);
    a.hid = (bf16_t*)carve(p, (size_t)MPAD * DFF * 2);
    a.H2 = (float*)carve(p, (size_t)MPAD * 1024 * 4);
    a.un2 = (bf16_t*)carve(p, (size_t)MPAD * 1024 * 2);
    a.PP = (float*)carve(p, (size_t)MPAD * 1024 * 4);
    if ((size_t)(p - (char*)d_ws) > ws_size) { fprintf(stderr, "kernel_launch: workspace too small: need %zu have %zu\n", (size_t)(p - (char*)d_ws), ws_size); return; }

    static int grid_blocks = 0;
    if (!grid_blocks) {
        int dev = 0, cus = 0, per_cu = 0;
        (void)hipGetDevice(&dev);
        (void)hipDeviceGetAttribute(&cus, hipDeviceAttributeMultiprocessorCount, dev);
        (void)hipFuncSetAttribute((const void*)mega, hipFuncAttributeMaxDynamicSharedMemorySize, LDS_BYTES);
        (void)hipOccupancyMaxActiveBlocksPerMultiprocessor(&per_cu, (const void*)mega, NTHR, LDS_BYTES);
        if (per_cu < 1) fprintf(stderr, "kernel_launch: occupancy query says %d blocks/CU\n", per_cu);
        grid_blocks = cus;
    }
    void* args[] = {&a};
    hipError_t e = hipLaunchCooperativeKernel((const void*)mega, dim3(grid_blocks), dim3(NTHR), args, LDS_BYTES, stream);
    if (e != hipSuccess) fprintf(stderr, "cooperative launch failed: %s (grid %d)\n", hipGetErrorString(e), grid_blocks);
}
```

```cpp
#include <hip/hip_runtime.h>
#include <stdint.h>
#include <cstdio>
#include <hip/hip_cooperative_groups.h>
namespace cg = cooperative_groups;


__device__ __forceinline__ int otid();
#define PG8_TID() otid()
namespace pg8 {
#define PG8_LAS __attribute__((address_space(3)))
typedef unsigned short bf16_t;
typedef short bf16x8 __attribute__((ext_vector_type(8)));
typedef float f32x4 __attribute__((ext_vector_type(4)));
typedef unsigned u32x4 __attribute__((ext_vector_type(4)));
constexpr int BM = 256, BK = 64, HALF = 128, HTB = HALF * BK * 2  , STAGE_BYTES = 8 * HTB, NXCD = 8, WGM = 8;

__host__ __device__ __forceinline__ int lds_byte(int r, int c) { const int st = (r >> 4) * 2 + (c >> 5), rr = r & 15, cc = c & 31, ob = rr * 64 + cc * 2; return st * 1024 + (ob ^ (((ob >> 9) & 1) << 5)); }
__host__ __device__ __forceinline__ void stage_rc(int b, int& R, int& C) { const int st = b / 1024, sb = b % 1024, swz = sb ^ (((sb >> 9) & 1) << 5); R = (st >> 1) * 16 + swz / 64; C = (st & 1) * 32 + (swz % 64) / 2; }
__host__ __device__ __forceinline__ int perm32(int rho) { const int n = rho >> 4, i = rho & 15; return 8 * (i >> 2) + 4 * n + (i & 3); }

struct Unit { int pm, pn; };
struct Gemm { const bf16_t* A; const bf16_t* Bt; int M, N, K; };

struct StaticOrder {
    int nM, nN, nwg, G, c;
    __host__ __device__ void init(int M, int N, int G_, int c_) { nM = M / BM; nN = N / BM; nwg = nM * nN; G = G_; c = c_; }
    __host__ __device__ bool next(int i, Unit& u) const {
        const long L = (long)i * G + c; if (L >= nwg) return false;
        int wgid = (int)L; { const int q = nwg / NXCD, r = nwg % NXCD, xcd = wgid % NXCD, off = wgid / NXCD; wgid = (xcd < r ? xcd * (q + 1) : r * (q + 1) + (xcd - r) * q) + off; }
        const int nig = WGM * nN, gid = wgid / nig, fm = gid * WGM, gsz = (nM - fm) < WGM ? (nM - fm) : WGM;
        u.pm = fm + ((wgid % nig) % gsz); u.pn = (wgid % nig) / gsz; return true;
    }
    __device__ __forceinline__ void a_ready(const Unit&) const {}
    __device__ __forceinline__ void done(const Unit&) const {}
};

template <class Epi, class Sched, bool ALIGN_EPI = false, bool SP2 = false>
__device__ __forceinline__ void gemm_phase(PG8_LAS unsigned char* lds, const Gemm g, const Sched& S, const Epi& E) {
    const int tid = PG8_TID(), wid = __builtin_amdgcn_readfirstlane(tid >> 6), lane = tid & 63, wr = wid >> 2, wc = wid & 3, fr = lane & 15, fq = lane >> 4;
    const int K = g.K, nt = K / BK;
    unsigned voffA[2], voffB[2];
#pragma unroll
    for (int i = 0; i < 2; ++i) { int R, C; stage_rc(tid * 16 + i * 8192, R, C); const int Rb = Epi::PERM ? ((R & ~31) + perm32(R & 31)) : R;
        voffA[i] = (unsigned)(R * K + C) * 2u; voffB[i] = (unsigned)(Rb * K + C) * 2u; }
    const size_t kstep = (size_t)(BK * 2);
    const size_t hstep = (size_t)HALF * K * 2;
    const size_t tstep = 2 * hstep;
    const unsigned ldsw = (unsigned)wid * 1024u;
    const int aoff = lds_byte(wr * 64 + fr, fq * 8), boff = lds_byte(wc * 32 + fr, fq * 8);
#define PG8_SA(b, h) (((b) * 2 + (h)) * HTB)
#define PG8_SB(b, h) ((4 + (b) * 2 + (h)) * HTB)
#define PG8_STAGE(bufoff, gbase, voff) do { _Pragma("unroll") for (int _i = 0; _i < 2; ++_i) \
        __builtin_amdgcn_global_load_lds((const unsigned*)((const char*)(gbase) + (voff)[_i]), (PG8_LAS unsigned*)(lds + (bufoff) + ldsw + _i * 8192), 16, 0, 0); } while (0)
#define PG8_LDA(dst, b, h) do { _Pragma("unroll") for (int m = 0; m < 4; ++m) _Pragma("unroll") for (int k = 0; k < 2; ++k) dst[m][k] = *(const PG8_LAS bf16x8*)(lds + PG8_SA(b, h) + aoff + m * 2048 + k * 1024); } while (0)
#define PG8_LDB(dst, b, h) do { _Pragma("unroll") for (int n = 0; n < 2; ++n) _Pragma("unroll") for (int k = 0; k < 2; ++k) dst[n][k] = *(const PG8_LAS bf16x8*)(lds + PG8_SB(b, h) + boff + n * 2048 + k * 1024); } while (0)
#define PG8_MMA(ai, bj, At, Bt) do { __builtin_amdgcn_s_setprio(1); _Pragma("unroll") for (int m = 0; m < 4; ++m) _Pragma("unroll") for (int n = 0; n < 2; ++n) _Pragma("unroll") for (int k = 0; k < 2; ++k) \
        acc[ai][bj][m][n] = __builtin_amdgcn_mfma_f32_16x16x32_bf16(Bt[n][k], At[m][k], acc[ai][bj][m][n], 0, 0, 0); __builtin_amdgcn_s_setprio(0); } while (0)
#define PG8_WAIT_V(n) asm volatile("s_waitcnt vmcnt(" #n ")" ::: "memory")
#define PG8_WAIT_L(n) asm volatile("s_waitcnt lgkmcnt(" #n ")" ::: "memory")
#define PG8_BAR __builtin_amdgcn_s_barrier()
#define PG8_SCHED __builtin_amdgcn_sched_barrier(0)
    Unit cur, nxt; int ui = 0;
    if (!S.next(0, cur)) return;
    f32x4 acc[2][2][4][2];
#pragma unroll
    for (int a = 0; a < 2; ++a)
#pragma unroll
        for (int b = 0; b < 2; ++b)
#pragma unroll
            for (int m = 0; m < 4; ++m)
#pragma unroll
                for (int n = 0; n < 2; ++n) acc[a][b][m][n] = (f32x4){0.f, 0.f, 0.f, 0.f};
    bf16x8 At[4][2], B0[2][2], B1[2][2];
    const char* cA = (const char*)g.A + (size_t)cur.pm * tstep; const char* cB = (const char*)g.Bt + (size_t)cur.pn * tstep;
    S.a_ready(cur);
    if constexpr (SP2) {
        PG8_STAGE(PG8_SB(0, 0), cB, voffB); PG8_STAGE(PG8_SB(0, 1), cB + hstep, voffB); PG8_STAGE(PG8_SA(0, 0), cA, voffA); PG8_STAGE(PG8_SA(0, 1), cA + hstep, voffA);
        if (wr == 1) PG8_BAR;
        PG8_WAIT_V(2); PG8_BAR;
        PG8_STAGE(PG8_SB(1, 0), cB + kstep, voffB); PG8_STAGE(PG8_SA(1, 0), cA + kstep, voffA); PG8_STAGE(PG8_SB(1, 1), cB + hstep + kstep, voffB);
        PG8_WAIT_V(6); PG8_BAR;
    } else {
        PG8_STAGE(PG8_SB(0, 0), cB, voffB); PG8_STAGE(PG8_SA(0, 0), cA, voffA); PG8_STAGE(PG8_SB(0, 1), cB + hstep, voffB); PG8_STAGE(PG8_SA(0, 1), cA + hstep, voffA);
        if (wr == 1) PG8_BAR;
        PG8_WAIT_V(4); PG8_BAR;
        PG8_STAGE(PG8_SB(1, 0), cB + kstep, voffB); PG8_STAGE(PG8_SA(1, 0), cA + kstep, voffA); PG8_STAGE(PG8_SB(1, 1), cB + hstep + kstep, voffB);
        PG8_WAIT_V(6); PG8_BAR;
    }
    for (;;) {
        const bool has_next = S.next(ui + 1, nxt);
        const char* nA = has_next ? (const char*)g.A + (size_t)nxt.pm * tstep : cA; const char* nB = has_next ? (const char*)g.Bt + (size_t)nxt.pn * tstep : cB;
        for (int t = 0; t < nt; t += 2) {
            const bool last = (t == nt - 2);
            const char* a1 = cA + (size_t)(t + 1) * kstep;
            const char* a2 = last ? nA : cA + (size_t)(t + 2) * kstep; const char* b2 = last ? nB : cB + (size_t)(t + 2) * kstep;
            const char* a3 = a2 + kstep; const char* b3 = b2 + kstep;
            if (last && has_next) S.a_ready(nxt);
            if constexpr (SP2) {
            PG8_LDB(B0, 0, 0); PG8_LDB(B1, 0, 1); PG8_SCHED; PG8_LDA(At, 0, 0); PG8_STAGE(PG8_SA(1, 1), a1 + hstep, voffA);
            PG8_WAIT_V(8); PG8_WAIT_L(0); PG8_BAR; PG8_MMA(0, 0, At, B0); PG8_MMA(0, 1, At, B1); PG8_BAR; PG8_SCHED;
            PG8_LDA(At, 0, 1); PG8_STAGE(PG8_SB(0, 0), b2, voffB); PG8_STAGE(PG8_SB(0, 1), b2 + hstep, voffB); PG8_STAGE(PG8_SA(0, 0), a2, voffA);
            PG8_WAIT_V(8); PG8_WAIT_L(0); PG8_BAR; PG8_MMA(1, 0, At, B0); PG8_MMA(1, 1, At, B1); PG8_BAR; PG8_SCHED;
            PG8_LDB(B0, 1, 0); PG8_LDB(B1, 1, 1); PG8_SCHED; PG8_LDA(At, 1, 0); PG8_STAGE(PG8_SA(0, 1), a2 + hstep, voffA);
            PG8_WAIT_V(8); PG8_WAIT_L(0); PG8_BAR; PG8_MMA(0, 0, At, B0); PG8_MMA(0, 1, At, B1); PG8_BAR; PG8_SCHED;
            PG8_LDA(At, 1, 1); PG8_STAGE(PG8_SB(1, 0), b3, voffB); PG8_STAGE(PG8_SB(1, 1), b3 + hstep, voffB); PG8_STAGE(PG8_SA(1, 0), a3, voffA);
            PG8_WAIT_V(8); PG8_WAIT_L(0); PG8_BAR; PG8_MMA(1, 0, At, B0); PG8_MMA(1, 1, At, B1); PG8_BAR; PG8_SCHED;
            } else {
            PG8_LDB(B0, 0, 0); PG8_SCHED; PG8_LDA(At, 0, 0); PG8_STAGE(PG8_SA(1, 1), a1 + hstep, voffA);
            PG8_WAIT_L(8); PG8_BAR; PG8_WAIT_L(0); PG8_MMA(0, 0, At, B0); PG8_BAR; PG8_SCHED;
            PG8_LDB(B1, 0, 1); PG8_STAGE(PG8_SB(0, 0), b2, voffB);
            PG8_BAR; PG8_WAIT_L(0); PG8_MMA(0, 1, At, B1); PG8_BAR;
            PG8_LDA(At, 0, 1); PG8_STAGE(PG8_SA(0, 0), a2, voffA);
            PG8_BAR; PG8_WAIT_L(0); PG8_MMA(1, 0, At, B0); PG8_BAR; PG8_SCHED;
            PG8_STAGE(PG8_SB(0, 1), b2 + hstep, voffB);
            PG8_WAIT_V(6); PG8_BAR; PG8_MMA(1, 1, At, B1); PG8_BAR;
            PG8_LDB(B0, 1, 0); PG8_SCHED; PG8_LDA(At, 1, 0); PG8_STAGE(PG8_SA(0, 1), a2 + hstep, voffA);
            PG8_WAIT_L(8); PG8_BAR; PG8_WAIT_L(0); PG8_MMA(0, 0, At, B0); PG8_BAR; PG8_SCHED;
            PG8_LDB(B1, 1, 1); PG8_STAGE(PG8_SB(1, 0), b3, voffB);
            PG8_BAR; PG8_WAIT_L(0); PG8_MMA(0, 1, At, B1); PG8_BAR;
            PG8_LDA(At, 1, 1); PG8_STAGE(PG8_SA(1, 0), a3, voffA);
            PG8_BAR; PG8_WAIT_L(0); PG8_MMA(1, 0, At, B0); PG8_BAR; PG8_SCHED;
            PG8_STAGE(PG8_SB(1, 1), b3 + hstep, voffB);
            PG8_WAIT_V(6); PG8_BAR; PG8_MMA(1, 1, At, B1); PG8_BAR;
            }
        }
        if constexpr (ALIGN_EPI) { if (wr == 0) PG8_BAR; }
        if constexpr (!Epi::AFTER_DRAIN) { E(acc, cur, wr, wc, fr, fq); S.done(cur); }
        if (!has_next) break;
#pragma unroll
        for (int a = 0; a < 2; ++a)
#pragma unroll
            for (int b = 0; b < 2; ++b)
#pragma unroll
                for (int m = 0; m < 4; ++m)
#pragma unroll
                    for (int n = 0; n < 2; ++n) acc[a][b][m][n] = (f32x4){0.f, 0.f, 0.f, 0.f};
        cur = nxt; cA = nA; cB = nB; ++ui;
        if constexpr (ALIGN_EPI) { if (wr == 1) PG8_BAR; }
    }
    PG8_WAIT_V(0);
    if constexpr (!ALIGN_EPI) { if (wr == 0) PG8_BAR; }
    PG8_BAR;
    if constexpr (Epi::AFTER_DRAIN) { E.fused(acc, cur, wr, wc, fr, fq, lds, wid, lane); S.done(cur); }
#undef PG8_SA
#undef PG8_SB
#undef PG8_STAGE
#undef PG8_LDA
#undef PG8_LDB
#undef PG8_MMA
#undef PG8_WAIT_V
#undef PG8_WAIT_L
#undef PG8_BAR
#undef PG8_SCHED
}
}

#define WTAB_OFF 155392
extern __shared__ __attribute__((aligned(16))) unsigned char lds_raw[];
__device__ __forceinline__ int hw_slot() { return (int)(__builtin_amdgcn_s_getreg((5 << 11) | 4) & 63u); }
__device__ __forceinline__ void otid_init() { const int t = threadIdx.x; if ((t & 63) == 0) ((__attribute__((address_space(3))) int*)(__attribute__((address_space(3))) void*)(lds_raw + WTAB_OFF))[hw_slot()] = t >> 6; }
__device__ __forceinline__ int otid() {
    const int w = __builtin_amdgcn_readfirstlane(((const __attribute__((address_space(3))) int*)(__attribute__((address_space(3))) void*)(lds_raw + WTAB_OFF))[hw_slot()]);
    int l; asm volatile("v_mbcnt_lo_u32_b32 %0, -1, 0\n\tv_mbcnt_hi_u32_b32 %0, -1, %0" : "=v"(l));
    return (w << 6) + l;
}
using pg8::bf16_t; using pg8::bf16x8; using pg8::f32x4; using pg8::u32x4;
#define LAS __attribute__((address_space(3)))

#define DMODEL 1024
#define NPT 16384
#define NST 32
#define NTOK 16416
#define MPAD 16640
#define SEQ 2048
#define ZW 2816
#define OFF_A 1536
#define OFF_B 1544
#define OFF_Z 1552
#define OFF_QA 2064
#define OFF_KVA 2448
#define OFF_KR 2704
#define DFF 2816
#define PAST 16384
#define NPAGES 128
#define EPSV 1e-6f

#define O_YP 0
#define O_YS (O_YP + 16777216)
#define O_CKVP (O_YS + 32768)
#define O_KRP (O_CKVP + 4194304)
#define O_GSP (O_KRP + 524288)
#define O_CSP (O_GSP + 262144)
#define O_CKVS (O_CSP + 36864)
#define O_KRS (O_CKVS + 8192)
#define O_GSS (O_KRS + 1024)
#define O_CSS (O_GSS + 1048576)

__device__ __forceinline__ bf16_t f2bf(float f) { unsigned u = __float_as_uint(f); return (bf16_t)((u + 0x7fffu + ((u >> 16) & 1u)) >> 16); }
__device__ __forceinline__ float bf2f(bf16_t b) { return __uint_as_float(((unsigned)b) << 16); }
__device__ __forceinline__ float wave_sum(float v) {
#pragma unroll
    for (int o = 1; o < 64; o <<= 1) v += __shfl_xor(v, o);
    return v;
}
__device__ __forceinline__ float sigmoidf_(float x) { return 1.f / (1.f + expf(-x)); }
__device__ __forceinline__ float siluf_(float x) { return x / (1.f + expf(-x)); }


#define WSYNC() do { __builtin_amdgcn_fence(__ATOMIC_ACQ_REL, "wavefront"); __builtin_amdgcn_wave_barrier(); } while (0)
#define NTHR 512
#define NWAVE 8

typedef float f32x2_t __attribute__((ext_vector_type(2)));
typedef __bf16 bf16x2_t __attribute__((ext_vector_type(2)));
__device__ __forceinline__ unsigned cvtpk(float lo, float hi) { f32x2_t v = {lo, hi}; bf16x2_t r = __builtin_convertvector(v, bf16x2_t); return __builtin_bit_cast(unsigned, r); }
__device__ __forceinline__ unsigned pk2bf(float lo, float hi) { return (unsigned)f2bf(lo) | ((unsigned)f2bf(hi) << 16); }

__device__ __forceinline__ void wt_tile(bool active, const float* __restrict__ W, bf16_t* __restrict__ Wt, int ldw, int col0, int N, int ldt, int nb_, int kb_, float* t  ) {
    const int tx = otid() & 31, ty = (otid() >> 5) & 7;
    const int n0 = nb_ * 32, k0 = kb_ * 32;
    __syncthreads();
    if (active) for (int i = ty; i < 32; i += 8) {
        const int k = k0 + i, n = n0 + tx; float v = 0.f;
        if (n < N) v = W[(size_t)k * ldw + col0 + n];
        t[i * 33 + tx] = v;
    }
    __syncthreads();
    if (active) for (int i = ty; i < 32; i += 8) { const int n = n0 + i, k = k0 + tx; Wt[(size_t)n * ldt + k] = f2bf(t[tx * 33 + i]); }
}

__device__ __forceinline__ void rms1024_row(const float* __restrict__ src, const float* __restrict__ g, bf16_t* __restrict__ o, bool zero, int lane) {
    if (zero) { for (int j = 0; j < 4; ++j) { ushort4 z = {0, 0, 0, 0}; *(ushort4*)(o + lane * 4 + 256 * j) = z; } return; }
    float4 v[4]; float ss = 0.f;
#pragma unroll
    for (int j = 0; j < 4; ++j) { v[j] = *(const float4*)(src + lane * 4 + 256 * j); ss += v[j].x * v[j].x + v[j].y * v[j].y + v[j].z * v[j].z + v[j].w * v[j].w; }
    ss = wave_sum(ss);
    const float rs = rsqrtf(ss * (1.f / 1024.f) + EPSV);
#pragma unroll
    for (int j = 0; j < 4; ++j) {
        const float4 gg = *(const float4*)(g + lane * 4 + 256 * j);
        ushort4 w; w.x = f2bf(v[j].x * rs * gg.x); w.y = f2bf(v[j].y * rs * gg.y); w.z = f2bf(v[j].z * rs * gg.z); w.w = f2bf(v[j].w * rs * gg.w);
        *(ushort4*)(o + lane * 4 + 256 * j) = w;
    }
}

struct ABf16 { const bf16_t* p; int lda; __device__ __forceinline__ bf16x8 load(int m, int k) const { return *(const bf16x8*)(p + (size_t)m * lda + k); } };
struct ACache {
    const float* cache; const int* pt;
    __device__ __forceinline__ bf16x8 load(int m, int k) const {
        const int b = m >> 14, t = m & 16383; const int phys = pt[b * NPAGES + (t >> 7)];
        const float* r = cache + ((size_t)phys * 128 + (t & 127)) * 256 + k;
        const float4 a = *(const float4*)r, c = *(const float4*)(r + 4);
        bf16x8 o; o[0] = (short)f2bf(a.x); o[1] = (short)f2bf(a.y); o[2] = (short)f2bf(a.z); o[3] = (short)f2bf(a.w);
        o[4] = (short)f2bf(c.x); o[5] = (short)f2bf(c.y); o[6] = (short)f2bf(c.z); o[7] = (short)f2bf(c.w); return o;
    }
};
template <class AL, class Epi>
__device__ __forceinline__ void gemm_tile_256x128(const AL& al, const bf16_t* __restrict__ Bt, int ldb, int K, const Epi& epi, int m0, int n0, char* smem) {
    bf16_t (*sA)[40] = (bf16_t (*)[40])smem;
    bf16_t (*sB)[40] = (bf16_t (*)[40])(smem + 20480);
    const int tid = otid(), lane = tid & 63, wid = tid >> 6, wm = wid >> 1, wn = wid & 1;
    f32x4 acc[4][4];
#pragma unroll
    for (int i = 0; i < 4; ++i)
#pragma unroll
        for (int j = 0; j < 4; ++j) acc[i][j] = (f32x4){0.f, 0.f, 0.f, 0.f};
    __syncthreads();
    for (int k0 = 0; k0 < K; k0 += 32) {
#pragma unroll
        for (int i = 0; i < 2; ++i) { const int ch = tid + 512 * i, r = ch >> 2, kc = (ch & 3) * 8; *(bf16x8*)&sA[r][kc] = al.load(m0 + r, k0 + kc); }
        { const int r = tid >> 2, kc = (tid & 3) * 8; *(bf16x8*)&sB[r][kc] = *(const bf16x8*)(Bt + (size_t)(n0 + r) * ldb + k0 + kc); }
        __syncthreads();
        bf16x8 af[4], bfr[4];
#pragma unroll
        for (int i = 0; i < 4; ++i) af[i] = *(const bf16x8*)&sA[wm * 64 + i * 16 + (lane & 15)][(lane >> 4) * 8];
#pragma unroll
        for (int j = 0; j < 4; ++j) bfr[j] = *(const bf16x8*)&sB[wn * 64 + j * 16 + (lane & 15)][(lane >> 4) * 8];
#pragma unroll
        for (int i = 0; i < 4; ++i)
#pragma unroll
            for (int j = 0; j < 4; ++j) acc[i][j] = __builtin_amdgcn_mfma_f32_16x16x32_bf16(af[i], bfr[j], acc[i][j], 0, 0, 0);
        __syncthreads();
    }
#pragma unroll
    for (int i = 0; i < 4; ++i)
#pragma unroll
        for (int j = 0; j < 4; ++j)
#pragma unroll
            for (int r = 0; r < 4; ++r) epi(m0 + wm * 64 + i * 16 + (lane >> 4) * 4 + r, n0 + wn * 64 + j * 16 + (lane & 15), acc[i][j][r]);
}
template <class Epi>
__device__ __forceinline__ void gemm_tile_32x256(const bf16_t* __restrict__ A, int lda, const bf16_t* __restrict__ Bt, int ldb, int K, const Epi& epi, int m0, int n0, char* smem) {
    bf16_t (*sA)[40] = (bf16_t (*)[40])smem;
    bf16_t (*sB)[40] = (bf16_t (*)[40])(smem + 2560);
    const int tid = otid(), lane = tid & 63, wid = tid >> 6;
    f32x4 acc[2][2];
#pragma unroll
    for (int i = 0; i < 2; ++i)
#pragma unroll
        for (int j = 0; j < 2; ++j) acc[i][j] = (f32x4){0.f, 0.f, 0.f, 0.f};
    __syncthreads();
    for (int k0 = 0; k0 < K; k0 += 32) {
        if (tid < 128) { const int r = tid >> 2, kc = (tid & 3) * 8; *(bf16x8*)&sA[r][kc] = *(const bf16x8*)(A + (size_t)(m0 + r) * lda + k0 + kc); }
#pragma unroll
        for (int i = 0; i < 2; ++i) { const int ch = tid + 512 * i, r = ch >> 2, kc = (ch & 3) * 8; *(bf16x8*)&sB[r][kc] = *(const bf16x8*)(Bt + (size_t)(n0 + r) * ldb + k0 + kc); }
        __syncthreads();
        bf16x8 af[2], bfr[2];
#pragma unroll
        for (int i = 0; i < 2; ++i) af[i] = *(const bf16x8*)&sA[i * 16 + (lane & 15)][(lane >> 4) * 8];
#pragma unroll
        for (int j = 0; j < 2; ++j) bfr[j] = *(const bf16x8*)&sB[wid * 32 + j * 16 + (lane & 15)][(lane >> 4) * 8];
#pragma unroll
        for (int i = 0; i < 2; ++i)
#pragma unroll
            for (int j = 0; j < 2; ++j) acc[i][j] = __builtin_amdgcn_mfma_f32_16x16x32_bf16(af[i], bfr[j], acc[i][j], 0, 0, 0);
        __syncthreads();
    }
#pragma unroll
    for (int i = 0; i < 2; ++i)
#pragma unroll
        for (int j = 0; j < 2; ++j)
#pragma unroll
            for (int r = 0; r < 4; ++r) epi(m0 + i * 16 + (lane >> 4) * 4 + r, n0 + wid * 32 + j * 16 + (lane & 15), acc[i][j][r]);
}
template <class Epi>
__device__ __forceinline__ void gemm_sample_rows(const bf16_t* __restrict__ A, int lda, const bf16_t* __restrict__ Bt, int K, int N, const Epi& epi, char* smem, int bid, int nb) {
    const int nu = N / 256;
    for (int u = nb - 1 - bid; u < nu; u += nb) gemm_tile_32x256(A, lda, Bt, K, K, epi, NPT, u * 256, smem);
}
struct EwF32 { float* C; int ldc; __device__ __forceinline__ void operator()(int m, int n, float v) const { C[(size_t)m * ldc + n] = v; } };
struct EwBf16 { bf16_t* C; int ldc; __device__ __forceinline__ void operator()(int m, int n, float v) const { C[(size_t)m * ldc + n] = f2bf(v); } };
struct EwResX { const float* xs; float* C; __device__ __forceinline__ void operator()(int m, int n, float v) const { C[(size_t)m * 1024 + n] = xs[(size_t)(m - NPT) * 1024 + n] + v; } };
struct EwSwiglu {
    float* G; bf16_t* Hd;
    __device__ __forceinline__ void operator()(int m, int n, float v) const {
        const int f = (n >> 8) * 128 + (n & 127);
        if ((n & 255) < 128) G[(size_t)(m - NPT) * DFF + f] = v;
    }
};
struct EwSwiglu2 {
    const float* G; bf16_t* Hd;
    __device__ __forceinline__ void operator()(int m, int n, float v) const {
        const int f = (n >> 8) * 128 + (n & 127);
        if ((n & 255) >= 128) Hd[(size_t)m * DFF + f] = f2bf(siluf_(G[(size_t)(m - NPT) * DFF + f]) * v);
    }
};
struct EwResH { const float* H; float* C; __device__ __forceinline__ void operator()(int m, int n, float v) const { C[(size_t)m * 1024 + n] = H[(size_t)m * 1024 + n] + v; } };
struct EwPle { const float* H2; const float* PP; float* out;
    __device__ __forceinline__ void operator()(int m, int n, float v) const { out[O_YS + (size_t)(m - NPT) * 1024 + n] = H2[(size_t)m * 1024 + n] + PP[(size_t)m * 1024 + n] * sigmoidf_(v); } };

struct PgBf16 {
    static constexpr bool PERM = true, AFTER_DRAIN = false; bf16_t* O; int ldc;
    __device__ __forceinline__ void operator()(const f32x4 (&acc)[2][2][4][2], const pg8::Unit& u, int wr, int wc, int fr, int fq) const {
#pragma unroll
        for (int ai = 0; ai < 2; ++ai)
#pragma unroll
            for (int m = 0; m < 4; ++m) { bf16_t* rowp = O + (size_t)(u.pm * 256 + ai * 128 + wr * 64 + m * 16 + fr) * ldc + u.pn * 256 + wc * 32 + 8 * fq;
#pragma unroll
                for (int bj = 0; bj < 2; ++bj) { const f32x4 v0 = acc[ai][bj][m][0], v1 = acc[ai][bj][m][1]; u32x4 w; w.x = pk2bf(v0[0], v0[1]); w.y = pk2bf(v0[2], v0[3]); w.z = pk2bf(v1[0], v1[1]); w.w = pk2bf(v1[2], v1[3]); *(u32x4*)(rowp + bj * 128) = w; } }
    }
};
struct PgF32 {
    static constexpr bool PERM = false, AFTER_DRAIN = false; float* O; int ldc;
    __device__ __forceinline__ void operator()(const f32x4 (&acc)[2][2][4][2], const pg8::Unit& u, int wr, int wc, int fr, int fq) const {
#pragma unroll
        for (int ai = 0; ai < 2; ++ai)
#pragma unroll
            for (int m = 0; m < 4; ++m) { float* rowp = O + (size_t)(u.pm * 256 + ai * 128 + wr * 64 + m * 16 + fr) * ldc + u.pn * 256 + wc * 32 + 4 * fq;
#pragma unroll
                for (int bj = 0; bj < 2; ++bj)
#pragma unroll
                    for (int n = 0; n < 2; ++n) *(f32x4*)(rowp + bj * 128 + n * 16) = acc[ai][bj][m][n]; }
    }
};
struct PgRes {
    static constexpr bool PERM = false, AFTER_DRAIN = false; const float* R; float* O;
    __device__ __forceinline__ void operator()(const f32x4 (&acc)[2][2][4][2], const pg8::Unit& u, int wr, int wc, int fr, int fq) const {
#pragma unroll
        for (int ai = 0; ai < 2; ++ai)
#pragma unroll
            for (int m = 0; m < 4; ++m) { const size_t off = (size_t)(u.pm * 256 + ai * 128 + wr * 64 + m * 16 + fr) * 1024 + u.pn * 256 + wc * 32 + 4 * fq;
#pragma unroll
                for (int bj = 0; bj < 2; ++bj)
#pragma unroll
                    for (int n = 0; n < 2; ++n) { const f32x4 r = *(const f32x4*)(R + off + bj * 128 + n * 16); *(f32x4*)(O + off + bj * 128 + n * 16) = r + acc[ai][bj][m][n]; } }
    }
};
struct PgSwiglu {
    static constexpr bool PERM = true, AFTER_DRAIN = false; bf16_t* Hd;
    __device__ __forceinline__ void operator()(const f32x4 (&acc)[2][2][4][2], const pg8::Unit& u, int wr, int wc, int fr, int fq) const {
#pragma unroll
        for (int ai = 0; ai < 2; ++ai)
#pragma unroll
            for (int m = 0; m < 4; ++m) { bf16_t* rowp = Hd + (size_t)(u.pm * 256 + ai * 128 + wr * 64 + m * 16 + fr) * DFF + u.pn * 128 + wc * 32 + 8 * fq;
                float h[8];
#pragma unroll
                for (int n = 0; n < 2; ++n)
#pragma unroll
                    for (int i = 0; i < 4; ++i) h[n * 4 + i] = siluf_(acc[ai][0][m][n][i]) * acc[ai][1][m][n][i];
                u32x4 w; w.x = pk2bf(h[0], h[1]); w.y = pk2bf(h[2], h[3]); w.z = pk2bf(h[4], h[5]); w.w = pk2bf(h[6], h[7]); *(u32x4*)rowp = w; }
    }
};
struct PgPle {
    static constexpr bool PERM = false, AFTER_DRAIN = false; const float* H2; const float* PP; float* out;
    __device__ __forceinline__ void operator()(const f32x4 (&acc)[2][2][4][2], const pg8::Unit& u, int wr, int wc, int fr, int fq) const {
#pragma unroll
        for (int ai = 0; ai < 2; ++ai)
#pragma unroll
            for (int m = 0; m < 4; ++m) { const size_t off = (size_t)(u.pm * 256 + ai * 128 + wr * 64 + m * 16 + fr) * 1024 + u.pn * 256 + wc * 32 + 4 * fq;
#pragma unroll
                for (int bj = 0; bj < 2; ++bj)
#pragma unroll
                    for (int n = 0; n < 2; ++n) { const f32x4 h = *(const f32x4*)(H2 + off + bj * 128 + n * 16), pp = *(const f32x4*)(PP + off + bj * 128 + n * 16), a = acc[ai][bj][m][n]; f32x4 y;
#pragma unroll
                        for (int i = 0; i < 4; ++i) y[i] = h[i] + pp[i] * sigmoidf_(a[i]);
                        *(f32x4*)(out + O_YP + off + bj * 128 + n * 16) = y; } }
    }
};
template <class Epi>
__device__ __forceinline__ void pg_gemm(LAS unsigned char* lds, const bf16_t* A, const bf16_t* Bt, int M, int N, int K, const Epi& E) {
    pg8::Gemm g{A, Bt, M, N, K}; pg8::StaticOrder S; S.init(M, N, (int)gridDim.x, (int)blockIdx.x);
    pg8::gemm_phase<Epi, pg8::StaticOrder, true, true>(lds, g, S, E);
}

struct MK {
    const float *x_prompt, *x_sample, *cache_ckv, *cache_krope, *state_gdn, *state_conv; const int* page_table; const float *p_prompt, *p_sample;
    const float *g_attn, *w_in, *w_conv, *a_log, *dt_bias, *g_gdn_out, *g_q_a, *w_q_b, *g_q_nope, *g_q_rope, *g_kv_a, *g_k_rope, *w_kv_b, *g_k_nope, *w_o, *g_ffn, *w_gate, *w_up, *w_down, *g_ple, *w_ple_gate, *w_ple_proj;
    float* out;
    bf16_t *WinT, *WqbT, *WkvT, *WknT, *WoT, *WguT, *WdT, *WpgT, *WppT, *xn, *pb, *Z;
    float *qf, *kf, *vf, *gg, *bb, *goraw, *gUT, *ggam; bf16_t *gWn, *gQg, *gQK, *gKd; bf16_t *qan, *ckvb; float *krf, *Q, *qh, *KV, *kh; bf16_t *omix, *KN, *Qb, *Kb, *Vb; float *SC, *part, *H; bf16_t* un; float* G; bf16_t* hid; float* H2; bf16_t* un2; float* PP;
};

__device__ __forceinline__ void post_in_row(const MK& a, int row, float* red) {
    const int tid = otid() & 255, lane = tid & 63, wid = tid >> 6;
    const bool samp = row >= NPT;
    const int b = samp ? row - NPT : row >> 11, t = samp ? 0 : row & 2047;
    const bf16_t* z = a.Z + (size_t)row * ZW;
#pragma unroll
    for (int i = 0; i < 6; ++i) {
        const int c = tid + 256 * i;
        float e0, e1, e2, e3;
        e3 = bf2f(z[c]);
        if (samp) { e0 = a.state_conv[((size_t)b * 3 + 0) * 1536 + c]; e1 = a.state_conv[((size_t)b * 3 + 1) * 1536 + c]; e2 = a.state_conv[((size_t)b * 3 + 2) * 1536 + c]; }
        else {
            e0 = t >= 3 ? bf2f(a.Z[(size_t)(row - 3) * ZW + c]) : 0.f;
            e1 = t >= 2 ? bf2f(a.Z[(size_t)(row - 2) * ZW + c]) : 0.f;
            e2 = t >= 1 ? bf2f(a.Z[(size_t)(row - 1) * ZW + c]) : 0.f;
        }
        float y = e0 * a.w_conv[c] + e1 * a.w_conv[1536 + c] + e2 * a.w_conv[2 * 1536 + c] + e3 * a.w_conv[3 * 1536 + c];
        y = siluf_(y);
        if (samp) { a.out[O_CSS + ((size_t)b * 3 + 0) * 1536 + c] = e1; a.out[O_CSS + ((size_t)b * 3 + 1) * 1536 + c] = e2; a.out[O_CSS + ((size_t)b * 3 + 2) * 1536 + c] = e3; }
        else if (t >= SEQ - 3) a.out[O_CSP + ((size_t)b * 3 + (t - (SEQ - 3))) * 1536 + c] = e3;
        const int sec = c >> 9, cc = c & 511;
        if (sec == 2) a.vf[(size_t)row * 512 + cc] = y;
        else {
            const float ss = wave_sum(y * y);
            const float r = rsqrtf(ss + EPSV);
            if (sec == 0) a.qf[(size_t)row * 512 + cc] = y * r * 0.125f; else a.kf[(size_t)row * 512 + cc] = y * r;
        }
    }
    if (tid < 8) {
        const float av = bf2f(z[OFF_A + tid]), bv = bf2f(z[OFF_B + tid]);
        const float xx = av + a.dt_bias[tid];
        const float sp = xx > 20.f ? xx : log1pf(expf(xx));
        a.gg[(size_t)row * 8 + tid] = -expf(a.a_log[tid]) * sp;
        a.bb[(size_t)row * 8 + tid] = sigmoidf_(bv);
    }
    {
        const float v0 = bf2f(z[OFF_QA + tid]), v1 = tid < 128 ? bf2f(z[OFF_QA + 256 + tid]) : 0.f;
        float ss = wave_sum(v0 * v0 + v1 * v1);
        if (lane == 0) red[wid] = ss;
        __syncthreads();
        ss = red[0] + red[1] + red[2] + red[3];
        const float rs = rsqrtf(ss * (1.f / 384.f) + EPSV);
        a.qan[(size_t)row * 384 + tid] = f2bf(v0 * rs * a.g_q_a[tid]);
        if (tid < 128) a.qan[(size_t)row * 384 + 256 + tid] = f2bf(v1 * rs * a.g_q_a[256 + tid]);
    }
    {
        const float v = bf2f(z[OFF_KVA + tid]);
        float ss = wave_sum(v * v);
        if (lane == 0) red[4 + wid] = ss;
        __syncthreads();
        ss = red[4] + red[5] + red[6] + red[7];
        const float rs = rsqrtf(ss * (1.f / 256.f) + EPSV);
        const float o = v * rs * a.g_kv_a[tid];
        a.ckvb[(size_t)row * 256 + tid] = f2bf(o);
        if (samp) a.out[O_CKVS + (size_t)b * 256 + tid] = o; else a.out[O_CKVP + (size_t)row * 256 + tid] = o;
    }
    if (wid == 0) {
        const float v = lane < 32 ? bf2f(z[OFF_KR + lane]) : 0.f;
        const float ss = wave_sum(v * v);
        const float rs = rsqrtf(ss * (1.f / 32.f) + EPSV);
        const float xn = lane < 32 ? v * rs * a.g_k_rope[lane] : 0.f;
        const float other = __shfl_xor(xn, 16);
        const int i = lane & 15;
        const float pos = samp ? (float)PAST : (float)t;
        const float ang = pos * powf(10000.f, -(float)i / 16.f);
        const float cs = cosf(ang), sn = sinf(ang);
        const float o = lane < 16 ? xn * cs - other * sn : other * sn + xn * cs;
        if (lane < 32) {
            a.krf[(size_t)row * 32 + lane] = o;
            if (samp) a.out[O_KRS + (size_t)b * 32 + lane] = o; else a.out[O_KRP + (size_t)row * 32 + lane] = o;
        }
    }
}
__device__ __forceinline__ void post_q_item(const MK& a, int idx, int lane) {
    const int row = idx >> 3, h = idx & 7;
    const float* q = a.Q + (size_t)row * 768 + h * 96;
    float* o = a.qh + ((size_t)row * 8 + h) * 96;
    const float v = q[lane];
    const float ss = wave_sum(v * v);
    o[lane] = v * rsqrtf(ss * (1.f / 64.f) + EPSV) * a.g_q_nope[lane];
    const float r = lane < 32 ? q[64 + lane] : 0.f;
    const float s2 = wave_sum(r * r);
    const float xn = lane < 32 ? r * rsqrtf(s2 * (1.f / 32.f) + EPSV) * a.g_q_rope[lane] : 0.f;
    const float other = __shfl_xor(xn, 16);
    const int i = lane & 15;
    const float pos = row >= NPT ? (float)PAST : (float)(row & 2047);
    const float ang = pos * powf(10000.f, -(float)i / 16.f);
    const float cs = cosf(ang), sn = sinf(ang);
    const float ov = lane < 16 ? xn * cs - other * sn : other * sn + xn * cs;
    if (lane < 32) o[64 + lane] = ov;
    if (row < NPT) {
        bf16_t* qb = a.Qb + ((size_t)((row >> 11) * 8 + h) * 2048 + (row & 2047)) * 96;
        qb[lane] = f2bf(o[lane] * 0.14724445f);
        if (lane < 32) qb[64 + lane] = f2bf(ov * 0.14724445f);
    }
}
__device__ __forceinline__ void post_kv_item(const MK& a, int idx, int lane) {
    const int row = idx >> 3, h = idx & 7;
    const float v = a.KV[(size_t)row * 1024 + h * 128 + lane];
    const float ss = wave_sum(v * v);
    const float kn = v * rsqrtf(ss * (1.f / 64.f) + EPSV) * a.g_k_nope[lane];
    a.kh[((size_t)row * 8 + h) * 64 + lane] = kn;
    if (row < NPT) {
        const size_t br = (size_t)((row >> 11) * 8 + h) * 2048 + (row & 2047);
        a.Kb[br * 96 + lane] = f2bf(kn);
        if (lane < 32) a.Kb[br * 96 + 64 + lane] = f2bf(a.krf[(size_t)row * 32 + lane]);
        a.Vb[br * 64 + lane] = f2bf(a.KV[(size_t)row * 1024 + h * 128 + 64 + lane]);
    }
}

typedef float f32x16 __attribute__((ext_vector_type(16)));
typedef short s16x4 __attribute__((ext_vector_type(4)));
#define KST 104
#define VST 72
#define ATT_BUF (64 * KST * 2 + 64 * VST * 2)
__device__ __forceinline__ int crow32(int r, int hi) { return (r & 3) + 8 * (r >> 2) + 4 * hi; }
__device__ __forceinline__ s16x4 tr_read(const bf16_t* p) { return __builtin_bit_cast(s16x4, __builtin_amdgcn_ds_read_tr16_b64_v4i16((LAS s16x4*)(LAS void*)(unsigned)(size_t)p)); }
__device__ __forceinline__ bf16x8 pack8(const f32x16& x, int s) {
    u32x4 w; w.x = pk2bf(x[8 * s], x[8 * s + 1]); w.y = pk2bf(x[8 * s + 2], x[8 * s + 3]); w.z = pk2bf(x[8 * s + 4], x[8 * s + 5]); w.w = pk2bf(x[8 * s + 6], x[8 * s + 7]);
    return __builtin_bit_cast(bf16x8, w);
}
__device__ __forceinline__ void attn_block(const MK& a, int b, int h, int qb, char* smem) {
    const int tid = otid(), lane = tid & 63, wid = tid >> 6, r32 = lane & 31, hi = lane >> 5;
    const size_t bh = (size_t)(b * 8 + h) * 2048;
    const int qrow = qb * 256 + wid * 32 + r32;
    const int wq0 = qb * 256 + wid * 32;
    bf16x8 qf[6];
    { const bf16_t* Qg = a.Qb + (bh + qrow) * 96;
#pragma unroll
      for (int ds = 0; ds < 6; ++ds) qf[ds] = *(const bf16x8*)(Qg + 16 * ds + 8 * hi); }
    f32x16 o0, o1;
#pragma unroll
    for (int r = 0; r < 16; ++r) { o0[r] = 0.f; o1[r] = 0.f; }
    float m = -INFINITY, l = 0.f;
    const int nt = qb * 4 + 4;
    const int kc0r = tid / 12, kc0c = tid % 12, kc1r = (512 + tid) / 12, kc1c = (512 + tid) % 12, vr = tid >> 3, vc = tid & 7;
    const bf16_t* Kg = a.Kb + bh * 96; const bf16_t* Vg = a.Vb + bh * 64;
    bf16x8 kr0, kr1, vr0;
    kr0 = *(const bf16x8*)(Kg + (size_t)kc0r * 96 + kc0c * 8);
    if (tid < 256) kr1 = *(const bf16x8*)(Kg + (size_t)kc1r * 96 + kc1c * 8);
    vr0 = *(const bf16x8*)(Vg + (size_t)vr * 64 + vc * 8);
    __syncthreads();
    {
        bf16_t* Ks = (bf16_t*)smem; bf16_t* Vs = Ks + 64 * KST;
        *(bf16x8*)(Ks + kc0r * KST + kc0c * 8) = kr0;
        if (tid < 256) *(bf16x8*)(Ks + kc1r * KST + kc1c * 8) = kr1;
        *(bf16x8*)(Vs + vr * VST + vc * 8) = vr0;
    }
    __syncthreads();
    const int i16 = lane & 15, qq = i16 >> 2, pp = i16 & 3, g1 = (lane >> 4) & 1;
    for (int t = 0; t < nt; ++t) {
        const bf16_t* Ks = (const bf16_t*)(smem + (t & 1) * ATT_BUF); const bf16_t* Vs = Ks + 64 * KST;
        if (t + 1 < nt) {
            const size_t ro = (size_t)(t + 1) * 64;
            kr0 = *(const bf16x8*)(Kg + (ro + kc0r) * 96 + kc0c * 8);
            if (tid < 256) kr1 = *(const bf16x8*)(Kg + (ro + kc1r) * 96 + kc1c * 8);
            vr0 = *(const bf16x8*)(Vg + (ro + vr) * 64 + vc * 8);
        }
        if (64 * t <= wq0 + 31) {
            f32x16 p0, p1;
#pragma unroll
            for (int r = 0; r < 16; ++r) { p0[r] = 0.f; p1[r] = 0.f; }
#pragma unroll
            for (int ds = 0; ds < 6; ++ds) {
                const bf16x8 k0 = *(const bf16x8*)(Ks + r32 * KST + 16 * ds + 8 * hi);
                const bf16x8 k1 = *(const bf16x8*)(Ks + (32 + r32) * KST + 16 * ds + 8 * hi);
                p0 = __builtin_amdgcn_mfma_f32_32x32x16_bf16(k0, qf[ds], p0, 0, 0, 0);
                p1 = __builtin_amdgcn_mfma_f32_32x32x16_bf16(k1, qf[ds], p1, 0, 0, 0);
            }
            if (64 * t + 63 > wq0) {
#pragma unroll
                for (int r = 0; r < 16; ++r) { const int kv = 64 * t + crow32(r, hi); if (kv > qrow) p0[r] = -INFINITY; if (kv + 32 > qrow) p1[r] = -INFINITY; }
            }
            float mx = fmaxf(p0[0], p1[0]);
#pragma unroll
            for (int r = 1; r < 16; ++r) mx = fmaxf(mx, fmaxf(p0[r], p1[r]));
            mx = fmaxf(mx, __shfl_xor(mx, 32));
            const float mn = fmaxf(m, mx);
            const float alpha = __builtin_amdgcn_exp2f(m - mn);
            m = mn;
            float rs = 0.f;
#pragma unroll
            for (int r = 0; r < 16; ++r) { p0[r] = __builtin_amdgcn_exp2f(p0[r] - mn); p1[r] = __builtin_amdgcn_exp2f(p1[r] - mn); rs += p0[r] + p1[r]; }
            l = l * alpha + rs;
#pragma unroll
            for (int r = 0; r < 16; ++r) { o0[r] *= alpha; o1[r] *= alpha; }
            bf16x8 pf[4];
            pf[0] = pack8(p0, 0); pf[1] = pack8(p0, 1); pf[2] = pack8(p1, 0); pf[3] = pack8(p1, 1);
#pragma unroll
            for (int ks = 0; ks < 4; ++ks) {
                const bf16_t* vb0 = Vs + (16 * ks + 4 * hi + qq) * VST + 16 * g1 + 4 * pp;
                const s16x4 a0 = tr_read(vb0), a1 = tr_read(vb0 + 8 * VST);
                const s16x4 c0 = tr_read(vb0 + 32), c1 = tr_read(vb0 + 8 * VST + 32);
                const bf16x8 va = __builtin_shufflevector(a0, a1, 0, 1, 2, 3, 4, 5, 6, 7);
                const bf16x8 vc_ = __builtin_shufflevector(c0, c1, 0, 1, 2, 3, 4, 5, 6, 7);
                o0 = __builtin_amdgcn_mfma_f32_32x32x16_bf16(va, pf[ks], o0, 0, 0, 0);
                o1 = __builtin_amdgcn_mfma_f32_32x32x16_bf16(vc_, pf[ks], o1, 0, 0, 0);
            }
        }
        if (t + 1 < nt) {
            bf16_t* Kn = (bf16_t*)(smem + ((t + 1) & 1) * ATT_BUF); bf16_t* Vn = Kn + 64 * KST;
            *(bf16x8*)(Kn + kc0r * KST + kc0c * 8) = kr0;
            if (tid < 256) *(bf16x8*)(Kn + kc1r * KST + kc1c * 8) = kr1;
            *(bf16x8*)(Vn + vr * VST + vc * 8) = vr0;
        }
        __syncthreads();
    }
    l += __shfl_xor(l, 32);
    const float il = 1.f / l;
    bf16_t* op = a.omix + ((size_t)b * SEQ + qrow) * 1024 + 512 + h * 64;
#pragma unroll
    for (int g = 0; g < 4; ++g) {
        uint2 w0, w1;
        w0.x = pk2bf(o0[4 * g] * il, o0[4 * g + 1] * il); w0.y = pk2bf(o0[4 * g + 2] * il, o0[4 * g + 3] * il);
        w1.x = pk2bf(o1[4 * g] * il, o1[4 * g + 1] * il); w1.y = pk2bf(o1[4 * g + 2] * il, o1[4 * g + 3] * il);
        *(uint2*)(op + 8 * g + 4 * hi) = w0;
        *(uint2*)(op + 32 + 8 * g + 4 * hi) = w1;
    }
}

__device__ __forceinline__ void gdn_unit(const MK& a, int b, int h, int dvg, const float* s0, float* sout, int row0, int T, int lane, char* wsm) {
    float (*sq)[64] = (float (*)[64])wsm;
    float (*sk)[64] = (float (*)[64])(wsm + 4096);
    float (*sv)[8] = (float (*)[8])(wsm + 8192);
    float* sg = (float*)(wsm + 8704);
    float* sb = (float*)(wsm + 8768);
    const int e = lane & 7, ko = lane >> 3, col = dvg * 8 + e;
    float S[8];
#pragma unroll
    for (int d = 0; d < 8; ++d) S[d] = s0 ? s0[(((size_t)b * 8 + h) * 64 + ko * 8 + d) * 64 + col] : 0.f;
    const size_t rbase = (size_t)row0 + (size_t)b * T;
    float pq[16], pk[16], pv0, pv1, pgb;
    {
        const int nt = T < 16 ? T : 16;
#pragma unroll
        for (int j = 0; j < 16; ++j) { const bool ok = j < nt; const size_t r = rbase + (ok ? j : 0); pq[j] = ok ? a.qf[r * 512 + h * 64 + lane] : 0.f; pk[j] = ok ? a.kf[r * 512 + h * 64 + lane] : 0.f; }
        { const int j0 = lane >> 3, j1 = j0 + 8; pv0 = j0 < nt ? a.vf[(rbase + j0) * 512 + h * 64 + dvg * 8 + (lane & 7)] : 0.f; pv1 = j1 < nt ? a.vf[(rbase + j1) * 512 + h * 64 + dvg * 8 + (lane & 7)] : 0.f; }
        { const int j = lane & 15; pgb = j < nt ? (lane < 16 ? a.gg[(rbase + j) * 8 + h] : a.bb[(rbase + j) * 8 + h]) : 0.f; }
    }
    for (int t0 = 0; t0 < T; t0 += 16) {
        const int nt = (T - t0) < 16 ? (T - t0) : 16;
        WSYNC();
#pragma unroll
        for (int j = 0; j < 16; ++j) { sq[j][lane] = pq[j]; sk[j][lane] = pk[j]; }
        sv[lane >> 3][lane & 7] = pv0; sv[(lane >> 3) + 8][lane & 7] = pv1;
        if (lane < 16) sg[lane] = expf(pgb); else if (lane < 32) sb[lane - 16] = pgb;
        WSYNC();
        if (t0 + 16 < T) {
            const size_t rb = rbase + t0 + 16;
#pragma unroll
            for (int j = 0; j < 16; ++j) { pq[j] = a.qf[(rb + j) * 512 + h * 64 + lane]; pk[j] = a.kf[(rb + j) * 512 + h * 64 + lane]; }
            pv0 = a.vf[(rb + (lane >> 3)) * 512 + h * 64 + dvg * 8 + (lane & 7)]; pv1 = a.vf[(rb + (lane >> 3) + 8) * 512 + h * 64 + dvg * 8 + (lane & 7)];
            pgb = lane < 16 ? a.gg[(rb + (lane & 15)) * 8 + h] : a.bb[(rb + (lane & 15)) * 8 + h];
        }
        for (int j = 0; j < nt; ++j) {
            const float dec = sg[j], be = sb[j], v = sv[j][e];
            const float4 k0 = *(const float4*)&sk[j][ko * 8], k1 = *(const float4*)&sk[j][ko * 8 + 4];
            const float4 q0 = *(const float4*)&sq[j][ko * 8], q1 = *(const float4*)&sq[j][ko * 8 + 4];
            const float kk[8] = {k0.x, k0.y, k0.z, k0.w, k1.x, k1.y, k1.z, k1.w};
            const float qq[8] = {q0.x, q0.y, q0.z, q0.w, q1.x, q1.y, q1.z, q1.w};
            float ks = 0.f;
#pragma unroll
            for (int d = 0; d < 8; ++d) { S[d] *= dec; ks += kk[d] * S[d]; }
            ks += __shfl_xor(ks, 8); ks += __shfl_xor(ks, 16); ks += __shfl_xor(ks, 32);
            const float delta = (v - ks) * be;
            float ov = 0.f;
#pragma unroll
            for (int d = 0; d < 8; ++d) { S[d] += kk[d] * delta; ov += qq[d] * S[d]; }
            ov += __shfl_xor(ov, 8); ov += __shfl_xor(ov, 16); ov += __shfl_xor(ov, 32);
            if (ko == 0) a.goraw[(rbase + t0 + j) * 512 + h * 64 + col] = ov;
        }
    }
#pragma unroll
    for (int d = 0; d < 8; ++d) sout[(((size_t)b * 8 + h) * 64 + ko * 8 + d) * 64 + col] = S[d];
}
__device__ __forceinline__ bf16x8 ld8_f32_bf16(const float* p) {
    const float4 x = *(const float4*)p, y = *(const float4*)(p + 4);
    u32x4 w; w.x = cvtpk(x.x, x.y); w.y = cvtpk(x.z, x.w); w.z = cvtpk(y.x, y.y); w.w = cvtpk(y.z, y.w);
    return __builtin_bit_cast(bf16x8, w);
}
__device__ __forceinline__ int pi_pos(int k) { return (k & 32) + 8 * ((k >> 2) & 3) + 4 * ((k >> 4) & 1) + (k & 3); }
#define GDN_WLDS 17408
__device__ __forceinline__ void gdn_prep_unit(const MK& a, int u, int lane_in, char* wsm) {
    int lane = lane_in; asm volatile("" : "+v"(lane));
    const int bh = u >> 5, n = u & 31, b = bh >> 3, h = bh & 7, i16 = lane & 15, q4 = lane >> 4;
    const size_t row0 = (size_t)b * SEQ + n * 64;
    float* AT = (float*)wsm; float* GC = (float*)(wsm + 16384); float* BT = GC + 64;
    const float* kbase = a.kf + row0 * 512 + h * 64; const float* qbase = a.qf + row0 * 512 + h * 64; const float* vbase = a.vf + row0 * 512 + h * 64;
    float g = a.gg[(row0 + lane) * 8 + h];
    const float be_l = a.bb[(row0 + lane) * 8 + h];
#pragma unroll
    for (int o = 1; o < 64; o <<= 1) { const float t = __shfl_up(g, o); if (lane >= o) g += t; }
    WSYNC();
    GC[lane] = g; BT[lane] = be_l;
    WSYNC();
    const float gl = GC[63];
    float* EG = BT + 64; float* ED = EG + 64;
    EG[lane] = expf(g); ED[lane] = expf(gl - g);
    WSYNC();
    bf16x8 kf[4][2], qf[4][2];
#pragma unroll
    for (int mt = 0; mt < 4; ++mt)
#pragma unroll
        for (int ks = 0; ks < 2; ++ks) {
            const int off = (16 * mt + i16) * 512 + 32 * ks + 8 * q4;
            kf[mt][ks] = ld8_f32_bf16(kbase + off); qf[mt][ks] = ld8_f32_bf16(qbase + off);
        }
    bf16_t* QKg = a.gQK + (size_t)u * 4096;
#pragma unroll
    for (int mt = 0; mt < 4; ++mt)
#pragma unroll
        for (int nt = 0; nt < 4; ++nt) {
            const int j = 16 * nt + i16, pj = 32 * (nt >> 1) + 8 * (i16 >> 2) + 4 * (nt & 1) + (i16 & 3), qkoff = 4 * q4 * 64 + pj;
            if (nt <= mt) {
                f32x4 d1 = {0.f, 0.f, 0.f, 0.f}, d2 = {0.f, 0.f, 0.f, 0.f};
#pragma unroll
                for (int ks = 0; ks < 2; ++ks) {
                    d1 = __builtin_amdgcn_mfma_f32_16x16x32_bf16(kf[mt][ks], kf[nt][ks], d1, 0, 0, 0);
                    d2 = __builtin_amdgcn_mfma_f32_16x16x32_bf16(qf[mt][ks], kf[nt][ks], d2, 0, 0, 0);
                }
                const float gcj = GC[j];
#pragma unroll
                for (int r = 0; r < 4; ++r) {
                    const int i = 16 * mt + 4 * q4 + r;
                    const float dec = expf(GC[i] - gcj);
                    AT[i * 64 + j] = (i > j) ? BT[i] * d1[r] * dec : 0.f;
                    (QKg + qkoff)[(16 * mt + r) * 64] = f2bf((i >= j) ? d2[r] * dec : 0.f);
                }
            } else {
#pragma unroll
                for (int r = 0; r < 4; ++r) (QKg + qkoff)[(16 * mt + r) * 64] = 0;
            }
        }
    {
        bf16_t* Qgg = a.gQg + (size_t)u * 4096;
#pragma unroll
        for (int mt = 0; mt < 4; ++mt) {
            const int i = 16 * mt + i16; const float e = EG[i];
#pragma unroll
            for (int ks = 0; ks < 2; ++ks) {
                const int off = i * 512 + 32 * ks + 8 * q4;
                const float4 x = *(const float4*)(qbase + off), y = *(const float4*)(qbase + off + 4);
                uint2 w0, w1; w0.x = cvtpk(x.x * e, x.y * e); w0.y = cvtpk(x.z * e, x.w * e); w1.x = cvtpk(y.x * e, y.y * e); w1.y = cvtpk(y.z * e, y.w * e);
                const int p0 = 32 * ks + 16 * (q4 & 1) + 4 * (q4 >> 1);
                *(uint2*)(Qgg + i * 64 + p0) = w0; *(uint2*)(Qgg + i * 64 + p0 + 8) = w1;
            }
        }
    }
    WSYNC();
    __builtin_amdgcn_sched_barrier(0);
    {
        float U[64];
#pragma unroll
        for (int i = 0; i < 64; ++i) { U[i] = vbase[i * 512 + lane] * BT[i]; }
#pragma unroll
        for (int i = 1; i < 64; ++i) {
            float su = 0.f;
#pragma unroll
            for (int j4 = 0; j4 < i; j4 += 4) {
                const float4 av = *(const float4*)(AT + i * 64 + j4);
                su += av.x * U[j4];
                if (j4 + 1 < i) su += av.y * U[j4 + 1];
                if (j4 + 2 < i) su += av.z * U[j4 + 2];
                if (j4 + 3 < i) su += av.w * U[j4 + 3];
            }
            U[i] -= su;
            __builtin_amdgcn_sched_barrier(0);
        }
        float* UTg = a.gUT + ((size_t)u * 64 + lane) * 64;
#pragma unroll
        for (int i = 0; i < 64; i += 4) *(float4*)(UTg + i) = (float4){U[i], U[i + 1], U[i + 2], U[i + 3]};
    }
    asm volatile("" ::: "memory");
    __builtin_amdgcn_sched_barrier(0);
    {
        float W[64];
#pragma unroll
        for (int i = 0; i < 64; ++i) { W[i] = kbase[i * 512 + lane]; }
        bf16_t* Kdg = a.gKd + ((size_t)u * 64 + lane) * 64;
#pragma unroll
        for (int pc = 0; pc < 8; ++pc) {
            float t[8];
#pragma unroll
            for (int jj = 0; jj < 8; ++jj) { const int j = 32 * (pc >> 2) + 16 * (jj >> 2) + 4 * (pc & 3) + (jj & 3); t[jj] = W[j] * ED[j]; }
            u32x4 w; w.x = cvtpk(t[0], t[1]); w.y = cvtpk(t[2], t[3]); w.z = cvtpk(t[4], t[5]); w.w = cvtpk(t[6], t[7]);
            *(u32x4*)(Kdg + 8 * pc) = w;
        }
#pragma unroll
        for (int i = 0; i < 64; ++i) W[i] *= BT[i] * EG[i];
#pragma unroll
        for (int i = 1; i < 64; ++i) {
            float sw = 0.f;
#pragma unroll
            for (int j4 = 0; j4 < i; j4 += 4) {
                const float4 av = *(const float4*)(AT + i * 64 + j4);
                sw += av.x * W[j4];
                if (j4 + 1 < i) sw += av.y * W[j4 + 1];
                if (j4 + 2 < i) sw += av.z * W[j4 + 2];
                if (j4 + 3 < i) sw += av.w * W[j4 + 3];
            }
            W[i] -= sw;
            __builtin_amdgcn_sched_barrier(0);
        }
        bf16_t* Wng = a.gWn + (size_t)u * 4096 + pi_pos(lane);
#pragma unroll
        for (int i = 0; i < 64; ++i) { Wng[i * 64] = f2bf(-W[i]); }
    }
    if (lane == 0) a.ggam[u] = expf(gl);
}
__device__ __forceinline__ bf16x8 pack_acc2(const f32x4& x, const f32x4& y) {
    u32x4 w; w.x = cvtpk(x[0], x[1]); w.y = cvtpk(x[2], x[3]); w.z = cvtpk(y[0], y[1]); w.w = cvtpk(y[2], y[3]);
    return __builtin_bit_cast(bf16x8, w);
}
__device__ __forceinline__ void gdn_scan_unit(const MK& a, int v, int lane) {
    const int bh = v >> 2, sl = v & 3, b = bh >> 3, h = bh & 7, i16 = lane & 15, q4 = lane >> 4;
    f32x4 S[4];
#pragma unroll
    for (int mt = 0; mt < 4; ++mt) S[mt] = (f32x4){0.f, 0.f, 0.f, 0.f};
    const int foff = i16 * 64 + 8 * q4;
    for (int n = 0; n < 32; ++n) {
        const size_t u = (size_t)bh * 32 + n;
        const bf16_t* Wn = a.gWn + u * 4096 + foff; const bf16_t* Qg = a.gQg + u * 4096 + foff; const bf16_t* QK = a.gQK + u * 4096 + foff; const bf16_t* Kd = a.gKd + u * 4096 + foff;
        const float* UT = a.gUT + u * 4096 + (16 * sl + i16) * 64 + 4 * q4;
        const float gam = a.ggam[u];
        bf16x8 Sb[2]; Sb[0] = pack_acc2(S[0], S[1]); Sb[1] = pack_acc2(S[2], S[3]);
        f32x4 Vn[4];
#pragma unroll
        for (int mt = 0; mt < 4; ++mt) { const float4 t = *(const float4*)(UT + 16 * mt); Vn[mt] = (f32x4){t.x, t.y, t.z, t.w}; }
#pragma unroll
        for (int mt = 0; mt < 4; ++mt)
#pragma unroll
            for (int ks = 0; ks < 2; ++ks) Vn[mt] = __builtin_amdgcn_mfma_f32_16x16x32_bf16(*(const bf16x8*)(Wn + 1024 * mt + 32 * ks), Sb[ks], Vn[mt], 0, 0, 0);
        bf16x8 Vb[2]; Vb[0] = pack_acc2(Vn[0], Vn[1]); Vb[1] = pack_acc2(Vn[2], Vn[3]);
        f32x4 O[4];
#pragma unroll
        for (int mt = 0; mt < 4; ++mt) {
            O[mt] = (f32x4){0.f, 0.f, 0.f, 0.f};
#pragma unroll
            for (int ks = 0; ks < 2; ++ks) {
                O[mt] = __builtin_amdgcn_mfma_f32_16x16x32_bf16(*(const bf16x8*)(Qg + 1024 * mt + 32 * ks), Sb[ks], O[mt], 0, 0, 0);
                O[mt] = __builtin_amdgcn_mfma_f32_16x16x32_bf16(*(const bf16x8*)(QK + 1024 * mt + 32 * ks), Vb[ks], O[mt], 0, 0, 0);
            }
        }
#pragma unroll
        for (int mt = 0; mt < 4; ++mt) {
            S[mt] = S[mt] * gam;
#pragma unroll
            for (int ks = 0; ks < 2; ++ks) S[mt] = __builtin_amdgcn_mfma_f32_16x16x32_bf16(*(const bf16x8*)(Kd + 1024 * mt + 32 * ks), Vb[ks], S[mt], 0, 0, 0);
        }
        float* og = a.goraw + ((size_t)b * SEQ + n * 64 + 4 * q4) * 512 + h * 64 + 16 * sl + i16;
#pragma unroll
        for (int mt = 0; mt < 4; ++mt)
#pragma unroll
            for (int r = 0; r < 4; ++r) og[(size_t)(16 * mt + r) * 512] = O[mt][r];
    }
    float* so = a.out + O_GSP + ((size_t)bh * 64 + 4 * q4) * 64 + 16 * sl + i16;
#pragma unroll
    for (int mt = 0; mt < 4; ++mt)
#pragma unroll
        for (int r = 0; r < 4; ++r) so[(size_t)(16 * mt + r) * 64] = S[mt][r];
}
__device__ __forceinline__ void gdn_out_item(const MK& a, int idx, int lane) {
    const int row = idx >> 3, h = idx & 7;
    const float ov = a.goraw[(size_t)row * 512 + h * 64 + lane];
    const float ss = wave_sum(ov * ov);
    const float on = ov * rsqrtf(ss * (1.f / 64.f) + EPSV) * a.g_gdn_out[lane];
    const float zg = bf2f(a.Z[(size_t)row * ZW + OFF_Z + h * 64 + lane]);
    a.omix[(size_t)row * 1024 + h * 64 + lane] = f2bf(on * siluf_(zg));
}

#define SROW 1040
#define SSLOT (32 * SROW)
#define KR_OFF (4 * SSLOT)
#define WQ_OFF (KR_OFF + 4 * 4096)
#define QR_OFF (WQ_OFF + 2048)
#define PG_OFF (QR_OFF + 1024)
#define SAMP_LDS_END (PG_OFF + 64)
__device__ __forceinline__ void samp_issue(const MK& a, int g, LAS unsigned char* lds, const int* PG, int wid, int lane) {
    const int phys = __builtin_amdgcn_readfirstlane(((const LAS int*)(lds + PG_OFF))[g >> 2]);
    const int tok0 = (g & 3) * 32 + 4 * wid, slot = g & 3;
    const float* cs = a.cache_ckv + ((size_t)phys * 128 + tok0) * 256 + lane * 4;
#pragma unroll
    for (int i = 0; i < 4; ++i) __builtin_amdgcn_global_load_lds((const unsigned*)(cs + i * 256), (LAS unsigned*)(lds + slot * SSLOT + (4 * wid + i) * SROW), 16, 0, 0);
    const float* ks = a.cache_krope + ((size_t)phys * 128 + tok0 + (lane >> 5)) * 32 + (lane & 31);
#pragma unroll
    for (int i = 0; i < 2; ++i) __builtin_amdgcn_global_load_lds((const unsigned*)(ks + i * 64), (LAS unsigned*)(lds + KR_OFF + slot * 4096 + (4 * wid + 2 * i) * 128), 4, 0, 0);
}
__device__ __forceinline__ void samp_attn_unit(const MK& a, int u, char* smem, LAS unsigned char* lds) {
    const int tid = otid(), lane = tid & 63, h = __builtin_amdgcn_readfirstlane(tid >> 6), i16 = lane & 15, q4 = lane >> 4;
    const int b = u >> 3, sp = u & 7;
    float* WQ = (float*)(smem + WQ_OFF);
    float* QR = (float*)(smem + QR_OFF);
    int* PG = (int*)(smem + PG_OFF);
    const float SCL = 0.14724445f;
    __syncthreads();
    {
        const int h_ = tid >> 6, l_ = tid & 63, q4_ = l_ >> 4, idx = l_ & 15, d = 16 * (idx >> 2) + 4 * q4_ + (idx & 3);
        WQ[tid] = a.g_k_nope[d] * a.qh[((size_t)(NPT + b) * 8 + h_) * 96 + d] * SCL;
        if (tid < 256) QR[tid] = a.qh[((size_t)(NPT + b) * 8 + (tid >> 5)) * 96 + 64 + (tid & 31)] * SCL;
        if (tid < 16) PG[tid] = a.page_table[b * NPAGES + sp * 16 + tid];
    }
    bf16x8 wf[4][8];
#pragma unroll
    for (int mt = 0; mt < 4; ++mt)
#pragma unroll
        for (int ks = 0; ks < 8; ++ks) wf[mt][ks] = *(const bf16x8*)(a.WknT + (size_t)(h * 64 + 16 * mt + i16) * 256 + 32 * ks + 8 * q4);
#pragma unroll
    for (int mt = 0; mt < 4; ++mt)
#pragma unroll
        for (int ks = 0; ks < 8; ++ks) asm volatile("" : "+v"(wf[mt][ks]));
    __syncthreads();
    samp_issue(a, 0, lds, PG, h, lane); samp_issue(a, 1, lds, PG, h, lane); samp_issue(a, 2, lds, PG, h, lane);
    const LAS float* QRl = (const LAS float*)(lds + QR_OFF) + h * 32 + 8 * q4;
    const LAS float* WQl = (const LAS float*)(lds + WQ_OFF) + (h * 4 + q4) * 16;
    float m = -INFINITY, lsum = 0.f, lat0 = 0.f, lat1 = 0.f, lat2 = 0.f, lat3 = 0.f;
    for (int g = 0; g < 64; ++g) {
        if (g <= 61) asm volatile("s_waitcnt vmcnt(12)" ::: "memory"); else if (g == 62) asm volatile("s_waitcnt vmcnt(6)" ::: "memory"); else asm volatile("s_waitcnt vmcnt(0)" ::: "memory");
        asm volatile("s_waitcnt lgkmcnt(0)" ::: "memory"); __builtin_amdgcn_s_barrier(); asm volatile("" ::: "memory");
        if (g + 3 < 64) samp_issue(a, g + 3, lds, PG, h, lane);
        const LAS float* Cs = (const LAS float*)(lds + (g & 3) * SSLOT); const LAS float* KR = (const LAS float*)(lds + KR_OFF + (g & 3) * 4096);
        float sc[2];
#pragma unroll
        for (int hf = 0; hf < 2; ++hf) {
            f32x4 acc[4];
#pragma unroll
            for (int mt = 0; mt < 4; ++mt) acc[mt] = (f32x4){0.f, 0.f, 0.f, 0.f};
            const LAS float* cp = Cs + (16 * hf + i16) * (SROW / 4) + 8 * q4;
#pragma unroll
            for (int ks = 0; ks < 8; ++ks) {
                const f32x4 f0 = *(const LAS f32x4*)(cp + 32 * ks), f1 = *(const LAS f32x4*)(cp + 32 * ks + 4);
                u32x4 w; w.x = cvtpk(f0[0], f0[1]); w.y = cvtpk(f0[2], f0[3]); w.z = cvtpk(f1[0], f1[1]); w.w = cvtpk(f1[2], f1[3]);
                const bf16x8 cf = __builtin_bit_cast(bf16x8, w);
#pragma unroll
                for (int mt = 0; mt < 4; ++mt) acc[mt] = __builtin_amdgcn_mfma_f32_16x16x32_bf16(wf[mt][ks], cf, acc[mt], 0, 0, 0);
            }
            float ss = 0.f, dot = 0.f, rd = 0.f;
#pragma unroll
            for (int mt = 0; mt < 4; ++mt) {
                const f32x4 wq = *(const LAS f32x4*)(WQl + 4 * mt);
                ss += acc[mt][0] * acc[mt][0] + acc[mt][1] * acc[mt][1] + acc[mt][2] * acc[mt][2] + acc[mt][3] * acc[mt][3];
                dot += acc[mt][0] * wq[0] + acc[mt][1] * wq[1] + acc[mt][2] * wq[2] + acc[mt][3] * wq[3];
            }
            {
                const LAS float* kp = KR + (16 * hf + i16) * 32 + 8 * q4;
                const f32x4 k0 = *(const LAS f32x4*)kp, k1 = *(const LAS f32x4*)(kp + 4), q0 = *(const LAS f32x4*)QRl, q1 = *(const LAS f32x4*)(QRl + 4);
                rd = k0[0] * q0[0] + k0[1] * q0[1] + k0[2] * q0[2] + k0[3] * q0[3] + k1[0] * q1[0] + k1[1] * q1[1] + k1[2] * q1[2] + k1[3] * q1[3];
            }
            ss += __shfl_xor(ss, 16); dot += __shfl_xor(dot, 16); rd += __shfl_xor(rd, 16);
            ss += __shfl_xor(ss, 32); dot += __shfl_xor(dot, 32); rd += __shfl_xor(rd, 32);
            sc[hf] = dot * rsqrtf(ss * (1.f / 64.f) + EPSV) + rd;
        }
        float gm = fmaxf(sc[0], sc[1]);
#pragma unroll
        for (int o = 1; o < 16; o <<= 1) gm = fmaxf(gm, __shfl_xor(gm, o));
        const float mn = fmaxf(m, gm);
        const float alpha = __builtin_amdgcn_exp2f(m - mn), p0 = __builtin_amdgcn_exp2f(sc[0] - mn), p1 = __builtin_amdgcn_exp2f(sc[1] - mn);
        m = mn;
        lsum = lsum * alpha + p0 + p1;
        lat0 *= alpha; lat1 *= alpha; lat2 *= alpha; lat3 *= alpha;
#pragma unroll 4
        for (int t = 0; t < 16; ++t) {
            const float pa = __uint_as_float(__builtin_amdgcn_readlane(__float_as_uint(p0), t)), pb_ = __uint_as_float(__builtin_amdgcn_readlane(__float_as_uint(p1), t));
            const f32x4 ca = *(const LAS f32x4*)(Cs + t * (SROW / 4) + 4 * lane), cb = *(const LAS f32x4*)(Cs + (16 + t) * (SROW / 4) + 4 * lane);
            lat0 += pa * ca[0] + pb_ * cb[0]; lat1 += pa * ca[1] + pb_ * cb[1]; lat2 += pa * ca[2] + pb_ * cb[2]; lat3 += pa * ca[3] + pb_ * cb[3];
        }
    }
#pragma unroll
    for (int o = 1; o < 16; o <<= 1) lsum += __shfl_xor(lsum, o);
    float* o = a.part + ((size_t)u * 8 + h) * 260;
    *(float4*)(o + 4 + 4 * lane) = (float4){lat0, lat1, lat2, lat3};
    if (lane == 0) { o[0] = m * 0.69314718f; o[1] = lsum; }
}
__device__ __forceinline__ void samp_comb_unit(const MK& a, int u, char* smem) {
    float* slat = (float*)smem;
    const int b = u >> 3, h = u & 7, tid = otid() & 255;
    const size_t row = NPT + b;
    const float* q = a.qh + (row * 8 + h) * 96;
    float s_self = 0.f;
    for (int d = 0; d < 64; ++d) s_self += q[d] * a.kh[(row * 8 + h) * 64 + d];
    for (int d = 0; d < 32; ++d) s_self += q[64 + d] * a.krf[row * 32 + d];
    s_self *= 0.10206207261596577f;
    float m = s_self;
    for (int s = 0; s < 8; ++s) m = fmaxf(m, a.part[((size_t)(b * 8 + s) * 8 + h) * 260]);
    const float pself = expf(s_self - m);
    float l = pself, lat = 0.f;
    for (int s = 0; s < 8; ++s) {
        const float* p = a.part + ((size_t)(b * 8 + s) * 8 + h) * 260;
        const float w = expf(p[0] - m);
        l += p[1] * w; lat += p[4 + tid] * w;
    }
    __syncthreads();
    slat[tid] = lat;
    __syncthreads();
    if (tid < 64) {
        float o = 0.f;
        for (int c = 0; c < 256; ++c) o += slat[c] * a.w_kv_b[(size_t)c * 1024 + h * 128 + 64 + tid];
        o += pself * a.KV[row * 1024 + h * 128 + 64 + tid];
        a.omix[row * 1024 + 512 + h * 64 + tid] = f2bf(o / l);
    }
}

#define LDS_BYTES 155648
static_assert(SAMP_LDS_END <= LDS_BYTES, "LDS map");
#define GSYNC() do { grid.sync(); } while (0)
__global__ __launch_bounds__(NTHR, 2) void mega(MK a) {
    cg::grid_group grid = cg::this_grid();
    char* smem = (char*)lds_raw;
    LAS unsigned char* lds = (LAS unsigned char*)lds_raw;
    otid_init();
    __syncthreads();
    const int bid = blockIdx.x, nb = gridDim.x, ngw = nb * NWAVE;
#define LOCAL_IDS const int tid = otid(), lane = tid & 63, wid = tid >> 6, half = tid >> 8, gw = bid * NWAVE + wid; (void)lane; (void)half; (void)gw; (void)wid;

    {
    LOCAL_IDS
    {
        const int T0 = 88 * 32, T1 = 24 * 12, T2 = 32 * 8, T3 = 16 * 8, T4 = 32 * 32, T5 = 176 * 32, T7 = 32 * 88, T8 = 32 * 32, T9 = 32 * 8;
        const int TT = T0 + T1 + T2 + T3 + T4 + T5 + T7 + T8 + T9;
        float* t = (float*)(smem + half * 8192);
        for (int it0 = bid * 2; it0 < TT; it0 += nb * 2) {
            const int it = it0 + half; const bool act = it < TT;
            int r = act ? it : 0;
            if (r < T0) { wt_tile(act, a.w_in, a.WinT, 2736, 0, 2736, 1024, r % 88, r / 88, t); continue; } r -= T0;
            if (r < T1) { wt_tile(act, a.w_q_b, a.WqbT, 768, 0, 768, 384, r % 24, r / 24, t); continue; } r -= T1;
            if (r < T2) { wt_tile(act, a.w_kv_b, a.WkvT, 1024, 0, 1024, 256, r % 32, r / 32, t); continue; } r -= T2;
            if (r < T3) { const int nbk = r % 16, kb = r / 16, h = nbk >> 1; wt_tile(act, a.w_kv_b, a.WknT + (size_t)h * 64 * 256, 1024, h * 128, 64, 256, nbk & 1, kb, t); continue; } r -= T3;
            if (r < T4) { wt_tile(act, a.w_o, a.WoT, 1024, 0, 1024, 1024, r % 32, r / 32, t); continue; } r -= T4;
            if (r < T5) { const int nbk = r % 176, kb = r / 176, pn = nbk >> 3, wi = nbk & 7;
                wt_tile(act, wi < 4 ? a.w_gate : a.w_up, a.WguT + (size_t)nbk * 32 * 1024, DFF, pn * 128 + (wi & 3) * 32, 32, 1024, 0, kb, t); continue; } r -= T5;
            if (r < T7) { wt_tile(act, a.w_down, a.WdT, 1024, 0, 1024, DFF, r % 32, r / 32, t); continue; } r -= T7;
            if (r < T8) { wt_tile(act, a.w_ple_gate, a.WpgT, 1024, 0, 1024, 1024, r % 32, r / 32, t); continue; } r -= T8;
            wt_tile(act, a.w_ple_proj, a.WppT, 1024, 0, 1024, 256, r % 32, r / 32, t);
        }
        for (int row = gw; row < MPAD; row += ngw) {
            const float* src = row < NPT ? a.x_prompt + (size_t)row * 1024 : a.x_sample + (size_t)(row < NTOK ? row - NPT : 0) * 1024;
            rms1024_row(src, a.g_attn, a.xn + (size_t)row * 1024, row >= NTOK, lane);
            ushort4 w = {0, 0, 0, 0};
            if (row < NTOK) { const float* ps = row < NPT ? a.p_prompt + (size_t)row * 256 : a.p_sample + (size_t)(row - NPT) * 256; const float4 v = *(const float4*)(ps + lane * 4); w.x = f2bf(v.x); w.y = f2bf(v.y); w.z = f2bf(v.z); w.w = f2bf(v.w); }
            *(ushort4*)(a.pb + (size_t)row * 256 + lane * 4) = w;
            if (row >= NTOK) { for (int j = 0; j < 4; ++j) { ushort4 z = {0, 0, 0, 0}; *(ushort4*)(a.omix + (size_t)row * 1024 + lane * 4 + 256 * j) = z; } }
        }
    }
    }
    GSYNC();
    {
    LOCAL_IDS
    pg_gemm(lds, a.xn, a.WinT, NPT, ZW, 1024, PgBf16{a.Z, ZW});
    pg_gemm(lds, a.pb, a.WppT, NPT, 1024, 256, PgF32{a.PP, 1024});
    gemm_sample_rows(a.xn, 1024, a.WinT, 1024, ZW, EwBf16{a.Z, ZW}, smem, bid, nb);
    gemm_sample_rows(a.pb, 256, a.WppT, 256, 1024, EwF32{a.PP, 1024}, smem, bid, nb);
    }
    GSYNC();
    {
    LOCAL_IDS
    for (int r0 = bid * 2; r0 < NTOK; r0 += nb * 2) post_in_row(a, r0 + half, (float*)(smem + half * 64));
    }
    GSYNC();
    {
    LOCAL_IDS
    for (int u = gw; u < 2048; u += ngw) gdn_prep_unit(a, u, lane, smem + wid * GDN_WLDS);
    for (int v = gw; v < NST * 64; v += ngw) gdn_unit(a, v >> 6, (v >> 3) & 7, v & 7, a.state_gdn, a.out + O_GSS, NPT, 1, lane, smem + wid * GDN_WLDS);
    __syncthreads();
    pg_gemm(lds, a.qan, a.WqbT, NPT, 768, 384, PgF32{a.Q, 768});
    pg_gemm(lds, a.ckvb, a.WkvT, NPT, 1024, 256, PgF32{a.KV, 1024});
    gemm_sample_rows(a.qan, 384, a.WqbT, 384, 768, EwF32{a.Q, 768}, smem, bid, nb);
    gemm_sample_rows(a.ckvb, 256, a.WkvT, 256, 1024, EwF32{a.KV, 1024}, smem, bid, nb);
    }
    GSYNC();
    {
    LOCAL_IDS
    if (wid == 0) for (int v = bid; v < 256; v += nb) gdn_scan_unit(a, v, lane);
    for (int idx = gw; idx < NTOK * 8; idx += ngw) { post_q_item(a, idx, lane); post_kv_item(a, idx, lane); }
    }
    GSYNC();
    {
    LOCAL_IDS
    for (int idx = gw; idx < NTOK * 8; idx += ngw) gdn_out_item(a, idx, lane);
    for (int pr = bid; pr < 256; pr += nb) { const int bh_ = pr >> 2, s_ = pr & 3; attn_block(a, bh_ >> 3, bh_ & 7, 7 - s_, smem); attn_block(a, bh_ >> 3, bh_ & 7, s_, smem); }
    for (int u = bid; u < NST * 8; u += nb) samp_attn_unit(a, u, smem, lds);
    }
    GSYNC();
    {
    LOCAL_IDS
    for (int u0 = bid * 2; u0 < NST * 8; u0 += nb * 2) samp_comb_unit(a, u0 + half, smem + half * 4096);
    }
    GSYNC();
    {
    LOCAL_IDS
    pg_gemm(lds, a.omix, a.WoT, NPT, 1024, 1024, PgRes{a.x_prompt, a.H});
    gemm_sample_rows(a.omix, 1024, a.WoT, 1024, 1024, EwResX{a.x_sample, a.H}, smem, bid, nb);
    }
    GSYNC();
    {
    LOCAL_IDS
    for (int row = gw; row < MPAD; row += ngw) rms1024_row(a.H + (size_t)row * 1024, a.g_ffn, a.un + (size_t)row * 1024, row >= NTOK, lane);
    }
    GSYNC();
    {
    LOCAL_IDS
    pg_gemm(lds, a.un, a.WguT, NPT, 2 * DFF, 1024, PgSwiglu{a.hid});
    gemm_sample_rows(a.un, 1024, a.WguT, 1024, 2 * DFF, EwSwiglu{a.G, a.hid}, smem, bid, nb);
    __threadfence(); __syncthreads();
    gemm_sample_rows(a.un, 1024, a.WguT, 1024, 2 * DFF, EwSwiglu2{a.G, a.hid}, smem, bid, nb);
    }
    GSYNC();
    {
    LOCAL_IDS
    pg_gemm(lds, a.hid, a.WdT, NPT, 1024, DFF, PgRes{a.H, a.H2});
    gemm_sample_rows(a.hid, DFF, a.WdT, DFF, 1024, EwResH{a.H, a.H2}, smem, bid, nb);
    }
    GSYNC();
    {
    LOCAL_IDS
    for (int row = gw; row < MPAD; row += ngw) rms1024_row(a.H2 + (size_t)row * 1024, a.g_ple, a.un2 + (size_t)row * 1024, row >= NTOK, lane);
    }
    GSYNC();
    {
    LOCAL_IDS
    pg_gemm(lds, a.un2, a.WpgT, NPT, 1024, 1024, PgPle{a.H2, a.PP, a.out});
    gemm_sample_rows(a.un2, 1024, a.WpgT, 1024, 1024, EwPle{a.H2, a.PP, a.out}, smem, bid, nb);
    }
}

static inline char* carve(char*& p, size_t bytes) { char* r = p; p += (bytes + 255) & ~(size_t)255; return r; }

extern "C" void kernel_launch(void* const* d_in, const int* in_sizes, int n_in, void* d_out, int out_size, void* d_ws, size_t ws_size, hipStream_t stream) {
    MK a{};
    a.x_prompt = (const float*)d_in[0]; a.x_sample = (const float*)d_in[1]; a.cache_ckv = (const float*)d_in[2]; a.cache_krope = (const float*)d_in[3];
    a.state_gdn = (const float*)d_in[4]; a.state_conv = (const float*)d_in[5]; a.page_table = (const int*)d_in[6]; a.p_prompt = (const float*)d_in[7]; a.p_sample = (const float*)d_in[8];
    a.g_attn = (const float*)d_in[9]; a.w_in = (const float*)d_in[10]; a.w_conv = (const float*)d_in[11]; a.a_log = (const float*)d_in[12]; a.dt_bias = (const float*)d_in[13];
    a.g_gdn_out = (const float*)d_in[14]; a.g_q_a = (const float*)d_in[15]; a.w_q_b = (const float*)d_in[16]; a.g_q_nope = (const float*)d_in[17]; a.g_q_rope = (const float*)d_in[18];
    a.g_kv_a = (const float*)d_in[19]; a.g_k_rope = (const float*)d_in[20]; a.w_kv_b = (const float*)d_in[21]; a.g_k_nope = (const float*)d_in[22]; a.w_o = (const float*)d_in[23];
    a.g_ffn = (const float*)d_in[24]; a.w_gate = (const float*)d_in[25]; a.w_up = (const float*)d_in[26]; a.w_down = (const float*)d_in[27]; a.g_ple = (const float*)d_in[28];
    a.w_ple_gate = (const float*)d_in[29]; a.w_ple_proj = (const float*)d_in[30];
    a.out = (float*)d_out;
    char* p = (char*)d_ws;
    a.WinT = (bf16_t*)carve(p, (size_t)ZW * 1024 * 2);
    a.WqbT = (bf16_t*)carve(p, (size_t)768 * 384 * 2);
    a.WkvT = (bf16_t*)carve(p, (size_t)1024 * 256 * 2);
    a.WknT = (bf16_t*)carve(p, (size_t)512 * 256 * 2);
    a.WoT = (bf16_t*)carve(p, (size_t)1024 * 1024 * 2);
    a.WguT = (bf16_t*)carve(p, (size_t)2 * DFF * 1024 * 2);
    a.WdT = (bf16_t*)carve(p, (size_t)1024 * DFF * 2);
    a.WpgT = (bf16_t*)carve(p, (size_t)1024 * 1024 * 2);
    a.WppT = (bf16_t*)carve(p, (size_t)1024 * 256 * 2);
    a.xn = (bf16_t*)carve(p, (size_t)MPAD * 1024 * 2);
    a.pb = (bf16_t*)carve(p, (size_t)MPAD * 256 * 2);
    a.Z = (bf16_t*)carve(p, (size_t)MPAD * ZW * 2);
    a.qf = (float*)carve(p, (size_t)MPAD * 512 * 4);
    a.kf = (float*)carve(p, (size_t)MPAD * 512 * 4);
    a.vf = (float*)carve(p, (size_t)MPAD * 512 * 4);
    a.gg = (float*)carve(p, (size_t)MPAD * 8 * 4);
    a.bb = (float*)carve(p, (size_t)MPAD * 8 * 4);
    a.goraw = (float*)carve(p, (size_t)MPAD * 512 * 4);
    a.gUT = (float*)carve(p, (size_t)2048 * 4096 * 4);
    a.ggam = (float*)carve(p, (size_t)2048 * 4);
    a.gWn = (bf16_t*)carve(p, (size_t)2048 * 4096 * 2);
    a.gQg = (bf16_t*)carve(p, (size_t)2048 * 4096 * 2);
    a.gQK = (bf16_t*)carve(p, (size_t)2048 * 4096 * 2);
    a.gKd = (bf16_t*)carve(p, (size_t)2048 * 4096 * 2);
    a.qan = (bf16_t*)carve(p, (size_t)MPAD * 384 * 2);
    a.ckvb = (bf16_t*)carve(p, (size_t)MPAD * 256 * 2);
    a.krf = (float*)carve(p, (size_t)MPAD * 32 * 4);
    a.Q = (float*)carve(p, (size_t)MPAD * 768 * 4);
    a.qh = (float*)carve(p, (size_t)MPAD * 768 * 4);
    a.KV = (float*)carve(p, (size_t)MPAD * 1024 * 4);
    a.kh = (float*)carve(p, (size_t)MPAD * 512 * 4);
    a.omix = (bf16_t*)carve(p, (size_t)MPAD * 1024 * 2);
    a.KN = (bf16_t*)carve(p, (size_t)NST * PAST * 512 * 2);
    a.Qb = (bf16_t*)carve(p, (size_t)NPT * 8 * 96 * 2);
    a.Kb = (bf16_t*)carve(p, (size_t)NPT * 8 * 96 * 2);
    a.Vb = (bf16_t*)carve(p, (size_t)NPT * 8 * 64 * 2);
    a.SC = (float*)carve(p, (size_t)NST * 8 * PAST * 4);
    a.part = (float*)carve(p, (size_t)NST * 8 * 8 * 260 * 4);
    a.H = (float*)carve(p, (size_t)MPAD * 1024 * 4);
    a.un = (bf16_t*)carve(p, (size_t)MPAD * 1024 * 2);
    a.G = (float*)carve(p, (size_t)NST * DFF * 4);
    a.hid = (bf16_t*)carve(p, (size_t)MPAD * DFF * 2);
    a.H2 = (float*)carve(p, (size_t)MPAD * 1024 * 4);
    a.un2 = (bf16_t*)carve(p, (size_t)MPAD * 1024 * 2);
    a.PP = (float*)carve(p, (size_t)MPAD * 1024 * 4);
    if ((size_t)(p - (char*)d_ws) > ws_size) { fprintf(stderr, "kernel_launch: workspace too small: need %zu have %zu\n", (size_t)(p - (char*)d_ws), ws_size); return; }

    static int grid_blocks = 0;
    if (!grid_blocks) {
        int dev = 0, cus = 0, per_cu = 0;
        (void)hipGetDevice(&dev);
        (void)hipDeviceGetAttribute(&cus, hipDeviceAttributeMultiprocessorCount, dev);
        (void)hipFuncSetAttribute((const void*)mega, hipFuncAttributeMaxDynamicSharedMemorySize, LDS_BYTES);
        (void)hipOccupancyMaxActiveBlocksPerMultiprocessor(&per_cu, (const void*)mega, NTHR, LDS_BYTES);
        if (per_cu < 1) fprintf(stderr, "kernel_launch: occupancy query says %d blocks/CU\n", per_cu);
        grid_blocks = cus;
    }
    void* args[] = {&a};
    hipError_t e = hipLaunchCooperativeKernel((const void*)mega, dim3(grid_blocks), dim3(NTHR), args, LDS_BYTES, stream);
    if (e != hipSuccess) fprintf(stderr, "cooperative launch failed: %s (grid %d)\n", hipGetErrorString(e), grid_blocks);
}
```

```cpp
#include <hip/hip_runtime.h>
#include <stdint.h>
#include <cstdio>
#include <hip/hip_cooperative_groups.h>
namespace cg = cooperative_groups;


__device__ __forceinline__ int otid();
#define PG8_TID() otid()
namespace pg8 {
#define PG8_LAS __attribute__((address_space(3)))
typedef unsigned short bf16_t;
typedef short bf16x8 __attribute__((ext_vector_type(8)));
typedef float f32x4 __attribute__((ext_vector_type(4)));
typedef unsigned u32x4 __attribute__((ext_vector_type(4)));
constexpr int BM = 256, BK = 64, HALF = 128, HTB = HALF * BK * 2  , STAGE_BYTES = 8 * HTB, NXCD = 8, WGM = 8;

__host__ __device__ __forceinline__ int lds_byte(int r, int c) { const int st = (r >> 4) * 2 + (c >> 5), rr = r & 15, cc = c & 31, ob = rr * 64 + cc * 2; return st * 1024 + (ob ^ (((ob >> 9) & 1) << 5)); }
__host__ __device__ __forceinline__ void stage_rc(int b, int& R, int& C) { const int st = b / 1024, sb = b % 1024, swz = sb ^ (((sb >> 9) & 1) << 5); R = (st >> 1) * 16 + swz / 64; C = (st & 1) * 32 + (swz % 64) / 2; }
__host__ __device__ __forceinline__ int perm32(int rho) { const int n = rho >> 4, i = rho & 15; return 8 * (i >> 2) + 4 * n + (i & 3); }

struct Unit { int pm, pn; };
struct Gemm { const bf16_t* A; const bf16_t* Bt; int M, N, K; };

struct StaticOrder {
    int nM, nN, nwg, G, c;
    __host__ __device__ void init(int M, int N, int G_, int c_) { nM = M / BM; nN = N / BM; nwg = nM * nN; G = G_; c = c_; }
    __host__ __device__ bool next(int i, Unit& u) const {
        const long L = (long)i * G + c; if (L >= nwg) return false;
        int wgid = (int)L; { const int q = nwg / NXCD, r = nwg % NXCD, xcd = wgid % NXCD, off = wgid / NXCD; wgid = (xcd < r ? xcd * (q + 1) : r * (q + 1) + (xcd - r) * q) + off; }
        const int nig = WGM * nN, gid = wgid / nig, fm = gid * WGM, gsz = (nM - fm) < WGM ? (nM - fm) : WGM;
        u.pm = fm + ((wgid % nig) % gsz); u.pn = (wgid % nig) / gsz; return true;
    }
    __device__ __forceinline__ void a_ready(const Unit&) const {}
    __device__ __forceinline__ void done(const Unit&) const {}
};

template <class Epi, class Sched, bool ALIGN_EPI = false, bool SP2 = false>
__device__ __forceinline__ void gemm_phase(PG8_LAS unsigned char* lds, const Gemm g, const Sched& S, const Epi& E) {
    const int tid = PG8_TID(), wid = __builtin_amdgcn_readfirstlane(tid >> 6), lane = tid & 63, wr = wid >> 2, wc = wid & 3, fr = lane & 15, fq = lane >> 4;
    const int K = g.K, nt = K / BK;
    unsigned voffA[2], voffB[2];
#pragma unroll
    for (int i = 0; i < 2; ++i) { int R, C; stage_rc(tid * 16 + i * 8192, R, C); const int Rb = Epi::PERM ? ((R & ~31) + perm32(R & 31)) : R;
        voffA[i] = (unsigned)(R * K + C) * 2u; voffB[i] = (unsigned)(Rb * K + C) * 2u; }
    const size_t kstep = (size_t)(BK * 2);
    const size_t hstep = (size_t)HALF * K * 2;
    const size_t tstep = 2 * hstep;
    const unsigned ldsw = (unsigned)wid * 1024u;
    const int aoff = lds_byte(wr * 64 + fr, fq * 8), boff = lds_byte(wc * 32 + fr, fq * 8);
#define PG8_SA(b, h) (((b) * 2 + (h)) * HTB)
#define PG8_SB(b, h) ((4 + (b) * 2 + (h)) * HTB)
#define PG8_STAGE(bufoff, gbase, voff) do { _Pragma("unroll") for (int _i = 0; _i < 2; ++_i) \
        __builtin_amdgcn_global_load_lds((const unsigned*)((const char*)(gbase) + (voff)[_i]), (PG8_LAS unsigned*)(lds + (bufoff) + ldsw + _i * 8192), 16, 0, 0); } while (0)
#define PG8_LDA(dst, b, h) do { _Pragma("unroll") for (int m = 0; m < 4; ++m) _Pragma("unroll") for (int k = 0; k < 2; ++k) dst[m][k] = *(const PG8_LAS bf16x8*)(lds + PG8_SA(b, h) + aoff + m * 2048 + k * 1024); } while (0)
#define PG8_LDB(dst, b, h) do { _Pragma("unroll") for (int n = 0; n < 2; ++n) _Pragma("unroll") for (int k = 0; k < 2; ++k) dst[n][k] = *(const PG8_LAS bf16x8*)(lds + PG8_SB(b, h) + boff + n * 2048 + k * 1024); } while (0)
#define PG8_MMA(ai, bj, At, Bt) do { __builtin_amdgcn_s_setprio(1); _Pragma("unroll") for (int m = 0; m < 4; ++m) _Pragma("unroll") for (int n = 0; n < 2; ++n) _Pragma("unroll") for (int k = 0; k < 2; ++k) \
        acc[ai][bj][m][n] = __builtin_amdgcn_mfma_f32_16x16x32_bf16(Bt[n][k], At[m][k], acc[ai][bj][m][n], 0, 0, 0); __builtin_amdgcn_s_setprio(0); } while (0)
#define PG8_WAIT_V(n) asm volatile("s_waitcnt vmcnt(" #n ")" ::: "memory")
#define PG8_WAIT_L(n) asm volatile("s_waitcnt lgkmcnt(" #n ")" ::: "memory")
#define PG8_BAR __builtin_amdgcn_s_barrier()
#define PG8_SCHED __builtin_amdgcn_sched_barrier(0)
    Unit cur, nxt; int ui = 0;
    if (!S.next(0, cur)) return;
    f32x4 acc[2][2][4][2];
#pragma unroll
    for (int a = 0; a < 2; ++a)
#pragma unroll
        for (int b = 0; b < 2; ++b)
#pragma unroll
            for (int m = 0; m < 4; ++m)
#pragma unroll
                for (int n = 0; n < 2; ++n) acc[a][b][m][n] = (f32x4){0.f, 0.f, 0.f, 0.f};
    bf16x8 At[4][2], B0[2][2], B1[2][2];
    const char* cA = (const char*)g.A + (size_t)cur.pm * tstep; const char* cB = (const char*)g.Bt + (size_t)cur.pn * tstep;
    S.a_ready(cur);
    if constexpr (SP2) {
        PG8_STAGE(PG8_SB(0, 0), cB, voffB); PG8_STAGE(PG8_SB(0, 1), cB + hstep, voffB); PG8_STAGE(PG8_SA(0, 0), cA, voffA); PG8_STAGE(PG8_SA(0, 1), cA + hstep, voffA);
        if (wr == 1) PG8_BAR;
        PG8_WAIT_V(2); PG8_BAR;
        PG8_STAGE(PG8_SB(1, 0), cB + kstep, voffB); PG8_STAGE(PG8_SA(1, 0), cA + kstep, voffA); PG8_STAGE(PG8_SB(1, 1), cB + hstep + kstep, voffB);
        PG8_WAIT_V(6); PG8_BAR;
    } else {
        PG8_STAGE(PG8_SB(0, 0), cB, voffB); PG8_STAGE(PG8_SA(0, 0), cA, voffA); PG8_STAGE(PG8_SB(0, 1), cB + hstep, voffB); PG8_STAGE(PG8_SA(0, 1), cA + hstep, voffA);
        if (wr == 1) PG8_BAR;
        PG8_WAIT_V(4); PG8_BAR;
        PG8_STAGE(PG8_SB(1, 0), cB + kstep, voffB); PG8_STAGE(PG8_SA(1, 0), cA + kstep, voffA); PG8_STAGE(PG8_SB(1, 1), cB + hstep + kstep, voffB);
        PG8_WAIT_V(6); PG8_BAR;
    }
    for (;;) {
        const bool has_next = S.next(ui + 1, nxt);
        const char* nA = has_next ? (const char*)g.A + (size_t)nxt.pm * tstep : cA; const char* nB = has_next ? (const char*)g.Bt + (size_t)nxt.pn * tstep : cB;
        for (int t = 0; t < nt; t += 2) {
            const bool last = (t == nt - 2);
            const char* a1 = cA + (size_t)(t + 1) * kstep;
            const char* a2 = last ? nA : cA + (size_t)(t + 2) * kstep; const char* b2 = last ? nB : cB + (size_t)(t + 2) * kstep;
            const char* a3 = a2 + kstep; const char* b3 = b2 + kstep;
            if (last && has_next) S.a_ready(nxt);
            if constexpr (SP2) {
            PG8_LDB(B0, 0, 0); PG8_LDB(B1, 0, 1); PG8_SCHED; PG8_LDA(At, 0, 0); PG8_STAGE(PG8_SA(1, 1), a1 + hstep, voffA);
            PG8_WAIT_V(8); PG8_WAIT_L(0); PG8_BAR; PG8_MMA(0, 0, At, B0); PG8_MMA(0, 1, At, B1); PG8_BAR; PG8_SCHED;
            PG8_LDA(At, 0, 1); PG8_STAGE(PG8_SB(0, 0), b2, voffB); PG8_STAGE(PG8_SB(0, 1), b2 + hstep, voffB); PG8_STAGE(PG8_SA(0, 0), a2, voffA);
            PG8_WAIT_V(8); PG8_WAIT_L(0); PG8_BAR; PG8_MMA(1, 0, At, B0); PG8_MMA(1, 1, At, B1); PG8_BAR; PG8_SCHED;
            PG8_LDB(B0, 1, 0); PG8_LDB(B1, 1, 1); PG8_SCHED; PG8_LDA(At, 1, 0); PG8_STAGE(PG8_SA(0, 1), a2 + hstep, voffA);
            PG8_WAIT_V(8); PG8_WAIT_L(0); PG8_BAR; PG8_MMA(0, 0, At, B0); PG8_MMA(0, 1, At, B1); PG8_BAR; PG8_SCHED;
            PG8_LDA(At, 1, 1); PG8_STAGE(PG8_SB(1, 0), b3, voffB); PG8_STAGE(PG8_SB(1, 1), b3 + hstep, voffB); PG8_STAGE(PG8_SA(1, 0), a3, voffA);
            PG8_WAIT_V(8); PG8_WAIT_L(0); PG8_BAR; PG8_MMA(1, 0, At, B0); PG8_MMA(1, 1, At, B1); PG8_BAR; PG8_SCHED;
            } else {
            PG8_LDB(B0, 0, 0); PG8_SCHED; PG8_LDA(At, 0, 0); PG8_STAGE(PG8_SA(1, 1), a1 + hstep, voffA);
            PG8_WAIT_L(8); PG8_BAR; PG8_WAIT_L(0); PG8_MMA(0, 0, At, B0); PG8_BAR; PG8_SCHED;
            PG8_LDB(B1, 0, 1); PG8_STAGE(PG8_SB(0, 0), b2, voffB);
            PG8_BAR; PG8_WAIT_L(0); PG8_MMA(0, 1, At, B1); PG8_BAR;
            PG8_LDA(At, 0, 1); PG8_STAGE(PG8_SA(0, 0), a2, voffA);
            PG8_BAR; PG8_WAIT_L(0); PG8_MMA(1, 0, At, B0); PG8_BAR; PG8_SCHED;
            PG8_STAGE(PG8_SB(0, 1), b2 + hstep, voffB);
            PG8_WAIT_V(6); PG8_BAR; PG8_MMA(1, 1, At, B1); PG8_BAR;
            PG8_LDB(B0, 1, 0); PG8_SCHED; PG8_LDA(At, 1, 0); PG8_STAGE(PG8_SA(0, 1), a2 + hstep, voffA);
            PG8_WAIT_L(8); PG8_BAR; PG8_WAIT_L(0); PG8_MMA(0, 0, At, B0); PG8_BAR; PG8_SCHED;
            PG8_LDB(B1, 1, 1); PG8_STAGE(PG8_SB(1, 0), b3, voffB);
            PG8_BAR; PG8_WAIT_L(0); PG8_MMA(0, 1, At, B1); PG8_BAR;
            PG8_LDA(At, 1, 1); PG8_STAGE(PG8_SA(1, 0), a3, voffA);
            PG8_BAR; PG8_WAIT_L(0); PG8_MMA(1, 0, At, B0); PG8_BAR; PG8_SCHED;
            PG8_STAGE(PG8_SB(1, 1), b3 + hstep, voffB);
            PG8_WAIT_V(6); PG8_BAR; PG8_MMA(1, 1, At, B1); PG8_BAR;
            }
        }
        if constexpr (ALIGN_EPI) { if (wr == 0) PG8_BAR; }
        if constexpr (!Epi::AFTER_DRAIN) { E(acc, cur, wr, wc, fr, fq); S.done(cur); }
        if (!has_next) break;
#pragma unroll
        for (int a = 0; a < 2; ++a)
#pragma unroll
            for (int b = 0; b < 2; ++b)
#pragma unroll
                for (int m = 0; m < 4; ++m)
#pragma unroll
                    for (int n = 0; n < 2; ++n) acc[a][b][m][n] = (f32x4){0.f, 0.f, 0.f, 0.f};
        cur = nxt; cA = nA; cB = nB; ++ui;
        if constexpr (ALIGN_EPI) { if (wr == 1) PG8_BAR; }
    }
    PG8_WAIT_V(0);
    if constexpr (!ALIGN_EPI) { if (wr == 0) PG8_BAR; }
    PG8_BAR;
    if constexpr (Epi::AFTER_DRAIN) { E.fused(acc, cur, wr, wc, fr, fq, lds, wid, lane); S.done(cur); }
#undef PG8_SA
#undef PG8_SB
#undef PG8_STAGE
#undef PG8_LDA
#undef PG8_LDB
#undef PG8_MMA
#undef PG8_WAIT_V
#undef PG8_WAIT_L
#undef PG8_BAR
#undef PG8_SCHED
}
}

#define WTAB_OFF 155392
extern __shared__ __attribute__((aligned(16))) unsigned char lds_raw[];
__device__ __forceinline__ int hw_slot() { return (int)(__builtin_amdgcn_s_getreg((5 << 11) | 4) & 63u); }
__device__ __forceinline__ void otid_init() { const int t = threadIdx.x; if ((t & 63) == 0) ((__attribute__((address_space(3))) int*)(__attribute__((address_space(3))) void*)(lds_raw + WTAB_OFF))[hw_slot()] = t >> 6; }
__device__ __forceinline__ int otid() {
    const int w = __builtin_amdgcn_readfirstlane(((const __attribute__((address_space(3))) int*)(__attribute__((address_space(3))) void*)(lds_raw + WTAB_OFF))[hw_slot()]);
    int l; asm volatile("v_mbcnt_lo_u32_b32 %0, -1, 0\n\tv_mbcnt_hi_u32_b32 %0, -1, %0" : "=v"(l));
    return (w << 6) + l;
}
using pg8::bf16_t; using pg8::bf16x8; using pg8::f32x4; using pg8::u32x4;
#define LAS __attribute__((address_space(3)))

#define DMODEL 1024
#define NPT 16384
#define NST 32
#define NTOK 16416
#define MPAD 16640
#define SEQ 2048
#define ZW 2816
#define OFF_A 1536
#define OFF_B 1544
#define OFF_Z 1552
#define OFF_QA 2064
#define OFF_KVA 2448
#define OFF_KR 2704
#define DFF 2816
#define PAST 16384
#define NPAGES 128
#define EPSV 1e-6f

#define O_YP 0
#define O_YS (O_YP + 16777216)
#define O_CKVP (O_YS + 32768)
#define O_KRP (O_CKVP + 4194304)
#define O_GSP (O_KRP + 524288)
#define O_CSP (O_GSP + 262144)
#define O_CKVS (O_CSP + 36864)
#define O_KRS (O_CKVS + 8192)
#define O_GSS (O_KRS + 1024)
#define O_CSS (O_GSS + 1048576)

__device__ __forceinline__ bf16_t f2bf(float f) { unsigned u = __float_as_uint(f); return (bf16_t)((u + 0x7fffu + ((u >> 16) & 1u)) >> 16); }
__device__ __forceinline__ float bf2f(bf16_t b) { return __uint_as_float(((unsigned)b) << 16); }
__device__ __forceinline__ float wave_sum(float v) {
#pragma unroll
    for (int o = 1; o < 64; o <<= 1) v += __shfl_xor(v, o);
    return v;
}
__device__ __forceinline__ float sigmoidf_(float x) { return 1.f / (1.f + expf(-x)); }
__device__ __forceinline__ float siluf_(float x) { return x / (1.f + expf(-x)); }


#define WSYNC() do { __builtin_amdgcn_fence(__ATOMIC_ACQ_REL, "wavefront"); __builtin_amdgcn_wave_barrier(); } while (0)
#define NTHR 512
#define NWAVE 8

typedef float f32x2_t __attribute__((ext_vector_type(2)));
typedef __bf16 bf16x2_t __attribute__((ext_vector_type(2)));
__device__ __forceinline__ unsigned cvtpk(float lo, float hi) { f32x2_t v = {lo, hi}; bf16x2_t r = __builtin_convertvector(v, bf16x2_t); return __builtin_bit_cast(unsigned, r); }
__device__ __forceinline__ unsigned pk2bf(float lo, float hi) { return (unsigned)f2bf(lo) | ((unsigned)f2bf(hi) << 16); }

__device__ __forceinline__ void wt_tile(bool active, const float* __restrict__ W, bf16_t* __restrict__ Wt, int ldw, int col0, int N, int ldt, int nb_, int kb_, float* t  ) {
    const int tx = otid() & 31, ty = (otid() >> 5) & 7;
    const int n0 = nb_ * 32, k0 = kb_ * 32;
    __syncthreads();
    if (active) for (int i = ty; i < 32; i += 8) {
        const int k = k0 + i, n = n0 + tx; float v = 0.f;
        if (n < N) v = W[(size_t)k * ldw + col0 + n];
        t[i * 33 + tx] = v;
    }
    __syncthreads();
    if (active) for (int i = ty; i < 32; i += 8) { const int n = n0 + i, k = k0 + tx; Wt[(size_t)n * ldt + k] = f2bf(t[tx * 33 + i]); }
}

__device__ __forceinline__ void rms1024_row(const float* __restrict__ src, const float* __restrict__ g, bf16_t* __restrict__ o, bool zero, int lane) {
    if (zero) { for (int j = 0; j < 4; ++j) { ushort4 z = {0, 0, 0, 0}; *(ushort4*)(o + lane * 4 + 256 * j) = z; } return; }
    float4 v[4]; float ss = 0.f;
#pragma unroll
    for (int j = 0; j < 4; ++j) { v[j] = *(const float4*)(src + lane * 4 + 256 * j); ss += v[j].x * v[j].x + v[j].y * v[j].y + v[j].z * v[j].z + v[j].w * v[j].w; }
    ss = wave_sum(ss);
    const float rs = rsqrtf(ss * (1.f / 1024.f) + EPSV);
#pragma unroll
    for (int j = 0; j < 4; ++j) {
        const float4 gg = *(const float4*)(g + lane * 4 + 256 * j);
        ushort4 w; w.x = f2bf(v[j].x * rs * gg.x); w.y = f2bf(v[j].y * rs * gg.y); w.z = f2bf(v[j].z * rs * gg.z); w.w = f2bf(v[j].w * rs * gg.w);
        *(ushort4*)(o + lane * 4 + 256 * j) = w;
    }
}

struct ABf16 { const bf16_t* p; int lda; __device__ __forceinline__ bf16x8 load(int m, int k) const { return *(const bf16x8*)(p + (size_t)m * lda + k); } };
struct ACache {
    const float* cache; const int* pt;
    __device__ __forceinline__ bf16x8 load(int m, int k) const {
        const int b = m >> 14, t = m & 16383; const int phys = pt[b * NPAGES + (t >> 7)];
        const float* r = cache + ((size_t)phys * 128 + (t & 127)) * 256 + k;
        const float4 a = *(const float4*)r, c = *(const float4*)(r + 4);
        bf16x8 o; o[0] = (short)f2bf(a.x); o[1] = (short)f2bf(a.y); o[2] = (short)f2bf(a.z); o[3] = (short)f2bf(a.w);
        o[4] = (short)f2bf(c.x); o[5] = (short)f2bf(c.y); o[6] = (short)f2bf(c.z); o[7] = (short)f2bf(c.w); return o;
    }
};
template <class AL, class Epi>
__device__ __forceinline__ void gemm_tile_256x128(const AL& al, const bf16_t* __restrict__ Bt, int ldb, int K, const Epi& epi, int m0, int n0, char* smem) {
    bf16_t (*sA)[40] = (bf16_t (*)[40])smem;
    bf16_t (*sB)[40] = (bf16_t (*)[40])(smem + 20480);
    const int tid = otid(), lane = tid & 63, wid = tid >> 6, wm = wid >> 1, wn = wid & 1;
    f32x4 acc[4][4];
#pragma unroll
    for (int i = 0; i < 4; ++i)
#pragma unroll
        for (int j = 0; j < 4; ++j) acc[i][j] = (f32x4){0.f, 0.f, 0.f, 0.f};
    __syncthreads();
    for (int k0 = 0; k0 < K; k0 += 32) {
#pragma unroll
        for (int i = 0; i < 2; ++i) { const int ch = tid + 512 * i, r = ch >> 2, kc = (ch & 3) * 8; *(bf16x8*)&sA[r][kc] = al.load(m0 + r, k0 + kc); }
        { const int r = tid >> 2, kc = (tid & 3) * 8; *(bf16x8*)&sB[r][kc] = *(const bf16x8*)(Bt + (size_t)(n0 + r) * ldb + k0 + kc); }
        __syncthreads();
        bf16x8 af[4], bfr[4];
#pragma unroll
        for (int i = 0; i < 4; ++i) af[i] = *(const bf16x8*)&sA[wm * 64 + i * 16 + (lane & 15)][(lane >> 4) * 8];
#pragma unroll
        for (int j = 0; j < 4; ++j) bfr[j] = *(const bf16x8*)&sB[wn * 64 + j * 16 + (lane & 15)][(lane >> 4) * 8];
#pragma unroll
        for (int i = 0; i < 4; ++i)
#pragma unroll
            for (int j = 0; j < 4; ++j) acc[i][j] = __builtin_amdgcn_mfma_f32_16x16x32_bf16(af[i], bfr[j], acc[i][j], 0, 0, 0);
        __syncthreads();
    }
#pragma unroll
    for (int i = 0; i < 4; ++i)
#pragma unroll
        for (int j = 0; j < 4; ++j)
#pragma unroll
            for (int r = 0; r < 4; ++r) epi(m0 + wm * 64 + i * 16 + (lane >> 4) * 4 + r, n0 + wn * 64 + j * 16 + (lane & 15), acc[i][j][r]);
}
template <class Epi>
__device__ __forceinline__ void gemm_tile_32x256(const bf16_t* __restrict__ A, int lda, const bf16_t* __restrict__ Bt, int ldb, int K, const Epi& epi, int m0, int n0, char* smem) {
    bf16_t (*sA)[40] = (bf16_t (*)[40])smem;
    bf16_t (*sB)[40] = (bf16_t (*)[40])(smem + 2560);
    const int tid = otid(), lane = tid & 63, wid = tid >> 6;
    f32x4 acc[2][2];
#pragma unroll
    for (int i = 0; i < 2; ++i)
#pragma unroll
        for (int j = 0; j < 2; ++j) acc[i][j] = (f32x4){0.f, 0.f, 0.f, 0.f};
    __syncthreads();
    for (int k0 = 0; k0 < K; k0 += 32) {
        if (tid < 128) { const int r = tid >> 2, kc = (tid & 3) * 8; *(bf16x8*)&sA[r][kc] = *(const bf16x8*)(A + (size_t)(m0 + r) * lda + k0 + kc); }
#pragma unroll
        for (int i = 0; i < 2; ++i) { const int ch = tid + 512 * i, r = ch >> 2, kc = (ch & 3) * 8; *(bf16x8*)&sB[r][kc] = *(const bf16x8*)(Bt + (size_t)(n0 + r) * ldb + k0 + kc); }
        __syncthreads();
        bf16x8 af[2], bfr[2];
#pragma unroll
        for (int i = 0; i < 2; ++i) af[i] = *(const bf16x8*)&sA[i * 16 + (lane & 15)][(lane >> 4) * 8];
#pragma unroll
        for (int j = 0; j < 2; ++j) bfr[j] = *(const bf16x8*)&sB[wid * 32 + j * 16 + (lane & 15)][(lane >> 4) * 8];
#pragma unroll
        for (int i = 0; i < 2; ++i)
#pragma unroll
            for (int j = 0; j < 2; ++j) acc[i][j] = __builtin_amdgcn_mfma_f32_16x16x32_bf16(af[i], bfr[j], acc[i][j], 0, 0, 0);
        __syncthreads();
    }
#pragma unroll
    for (int i = 0; i < 2; ++i)
#pragma unroll
        for (int j = 0; j < 2; ++j)
#pragma unroll
            for (int r = 0; r < 4; ++r) epi(m0 + i * 16 + (lane >> 4) * 4 + r, n0 + wid * 32 + j * 16 + (lane & 15), acc[i][j][r]);
}
template <class Epi>
__device__ __forceinline__ void gemm_sample_rows(const bf16_t* __restrict__ A, int lda, const bf16_t* __restrict__ Bt, int K, int N, const Epi& epi, char* smem, int bid, int nb) {
    const int nu = N / 256;
    for (int u = nb - 1 - bid; u < nu; u += nb) gemm_tile_32x256(A, lda, Bt, K, K, epi, NPT, u * 256, smem);
}
struct EwF32 { float* C; int ldc; __device__ __forceinline__ void operator()(int m, int n, float v) const { C[(size_t)m * ldc + n] = v; } };
struct EwBf16 { bf16_t* C; int ldc; __device__ __forceinline__ void operator()(int m, int n, float v) const { C[(size_t)m * ldc + n] = f2bf(v); } };
struct EwResX { const float* xs; float* C; __device__ __forceinline__ void operator()(int m, int n, float v) const { C[(size_t)m * 1024 + n] = xs[(size_t)(m - NPT) * 1024 + n] + v; } };
struct EwSwiglu {
    float* G; bf16_t* Hd;
    __device__ __forceinline__ void operator()(int m, int n, float v) const {
        const int f = (n >> 8) * 128 + (n & 127);
        if ((n & 255) < 128) G[(size_t)(m - NPT) * DFF + f] = v;
    }
};
struct EwSwiglu2 {
    const float* G; bf16_t* Hd;
    __device__ __forceinline__ void operator()(int m, int n, float v) const {
        const int f = (n >> 8) * 128 + (n & 127);
        if ((n & 255) >= 128) Hd[(size_t)m * DFF + f] = f2bf(siluf_(G[(size_t)(m - NPT) * DFF + f]) * v);
    }
};
struct EwResH { const float* H; float* C; __device__ __forceinline__ void operator()(int m, int n, float v) const { C[(size_t)m * 1024 + n] = H[(size_t)m * 1024 + n] + v; } };
struct EwPle { const float* H2; const float* PP; float* out;
    __device__ __forceinline__ void operator()(int m, int n, float v) const { out[O_YS + (size_t)(m - NPT) * 1024 + n] = H2[(size_t)m * 1024 + n] + PP[(size_t)m * 1024 + n] * sigmoidf_(v); } };

struct PgBf16 {
    static constexpr bool PERM = true, AFTER_DRAIN = false; bf16_t* O; int ldc;
    __device__ __forceinline__ void operator()(const f32x4 (&acc)[2][2][4][2], const pg8::Unit& u, int wr, int wc, int fr, int fq) const {
#pragma unroll
        for (int ai = 0; ai < 2; ++ai)
#pragma unroll
            for (int m = 0; m < 4; ++m) { bf16_t* rowp = O + (size_t)(u.pm * 256 + ai * 128 + wr * 64 + m * 16 + fr) * ldc + u.pn * 256 + wc * 32 + 8 * fq;
#pragma unroll
                for (int bj = 0; bj < 2; ++bj) { const f32x4 v0 = acc[ai][bj][m][0], v1 = acc[ai][bj][m][1]; u32x4 w; w.x = pk2bf(v0[0], v0[1]); w.y = pk2bf(v0[2], v0[3]); w.z = pk2bf(v1[0], v1[1]); w.w = pk2bf(v1[2], v1[3]); *(u32x4*)(rowp + bj * 128) = w; } }
    }
};
struct PgF32 {
    static constexpr bool PERM = false, AFTER_DRAIN = false; float* O; int ldc;
    __device__ __forceinline__ void operator()(const f32x4 (&acc)[2][2][4][2], const pg8::Unit& u, int wr, int wc, int fr, int fq) const {
#pragma unroll
        for (int ai = 0; ai < 2; ++ai)
#pragma unroll
            for (int m = 0; m < 4; ++m) { float* rowp = O + (size_t)(u.pm * 256 + ai * 128 + wr * 64 + m * 16 + fr) * ldc + u.pn * 256 + wc * 32 + 4 * fq;
#pragma unroll
                for (int bj = 0; bj < 2; ++bj)
#pragma unroll
                    for (int n = 0; n < 2; ++n) *(f32x4*)(rowp + bj * 128 + n * 16) = acc[ai][bj][m][n]; }
    }
};
struct PgRes {
    static constexpr bool PERM = false, AFTER_DRAIN = false; const float* R; float* O;
    __device__ __forceinline__ void operator()(const f32x4 (&acc)[2][2][4][2], const pg8::Unit& u, int wr, int wc, int fr, int fq) const {
#pragma unroll
        for (int ai = 0; ai < 2; ++ai)
#pragma unroll
            for (int m = 0; m < 4; ++m) { const size_t off = (size_t)(u.pm * 256 + ai * 128 + wr * 64 + m * 16 + fr) * 1024 + u.pn * 256 + wc * 32 + 4 * fq;
#pragma unroll
                for (int bj = 0; bj < 2; ++bj)
#pragma unroll
                    for (int n = 0; n < 2; ++n) { const f32x4 r = *(const f32x4*)(R + off + bj * 128 + n * 16); *(f32x4*)(O + off + bj * 128 + n * 16) = r + acc[ai][bj][m][n]; } }
    }
};
struct PgSwiglu {
    static constexpr bool PERM = true, AFTER_DRAIN = false; bf16_t* Hd;
    __device__ __forceinline__ void operator()(const f32x4 (&acc)[2][2][4][2], const pg8::Unit& u, int wr, int wc, int fr, int fq) const {
#pragma unroll
        for (int ai = 0; ai < 2; ++ai)
#pragma unroll
            for (int m = 0; m < 4; ++m) { bf16_t* rowp = Hd + (size_t)(u.pm * 256 + ai * 128 + wr * 64 + m * 16 + fr) * DFF + u.pn * 128 + wc * 32 + 8 * fq;
                float h[8];
#pragma unroll
                for (int n = 0; n < 2; ++n)
#pragma unroll
                    for (int i = 0; i < 4; ++i) h[n * 4 + i] = siluf_(acc[ai][0][m][n][i]) * acc[ai][1][m][n][i];
                u32x4 w; w.x = pk2bf(h[0], h[1]); w.y = pk2bf(h[2], h[3]); w.z = pk2bf(h[4], h[5]); w.w = pk2bf(h[6], h[7]); *(u32x4*)rowp = w; }
    }
};
struct PgPle {
    static constexpr bool PERM = false, AFTER_DRAIN = false; const float* H2; const float* PP; float* out;
    __device__ __forceinline__ void operator()(const f32x4 (&acc)[2][2][4][2], const pg8::Unit& u, int wr, int wc, int fr, int fq) const {
#pragma unroll
        for (int ai = 0; ai < 2; ++ai)
#pragma unroll
            for (int m = 0; m < 4; ++m) { const size_t off = (size_t)(u.pm * 256 + ai * 128 + wr * 64 + m * 16 + fr) * 1024 + u.pn * 256 + wc * 32 + 4 * fq;
#pragma unroll
                for (int bj = 0; bj < 2; ++bj)
#pragma unroll
                    for (int n = 0; n < 2; ++n) { const f32x4 h = *(const f32x4*)(H2 + off + bj * 128 + n * 16), pp = *(const f32x4*)(PP + off + bj * 128 + n * 16), a = acc[ai][bj][m][n]; f32x4 y;
#pragma unroll
                        for (int i = 0; i < 4; ++i) y[i] = h[i] + pp[i] * sigmoidf_(a[i]);
                        *(f32x4*)(out + O_YP + off + bj * 128 + n * 16) = y; } }
    }
};
template <class Epi>
__device__ __forceinline__ void pg_gemm(LAS unsigned char* lds, const bf16_t* A, const bf16_t* Bt, int M, int N, int K, const Epi& E) {
    pg8::Gemm g{A, Bt, M, N, K}; pg8::StaticOrder S; S.init(M, N, (int)gridDim.x, (int)blockIdx.x);
    pg8::gemm_phase<Epi, pg8::StaticOrder, true, true>(lds, g, S, E);
}

constexpr size_t WOF_WinT = 0ull;
constexpr size_t WOF_WqbT = 5767168ull;
constexpr size_t WOF_WkvT = 6356992ull;
constexpr size_t WOF_WknT = 6881280ull;
constexpr size_t WOF_WoT = 7143424ull;
constexpr size_t WOF_WguT = 9240576ull;
constexpr size_t WOF_WdT = 20774912ull;
constexpr size_t WOF_WpgT = 26542080ull;
constexpr size_t WOF_WppT = 28639232ull;
constexpr size_t WOF_xn = 29163520ull;
constexpr size_t WOF_pb = 63242240ull;
constexpr size_t WOF_Z = 71761920ull;
constexpr size_t WOF_qkv = 165478400ull;
constexpr size_t WOF_ropecs = 216596480ull;
constexpr size_t WOF_gg = 216858880ull;
constexpr size_t WOF_bb = 217391360ull;
constexpr size_t WOF_goraw = 217923840ull;
constexpr size_t WOF_gUT = 252002560ull;
constexpr size_t WOF_ggam = 285556992ull;
constexpr size_t WOF_gWn = 285565184ull;
constexpr size_t WOF_gQg = 302342400ull;
constexpr size_t WOF_gQK = 319119616ull;
constexpr size_t WOF_gKd = 335896832ull;
constexpr size_t WOF_qan = 352674048ull;
constexpr size_t WOF_ckvb = 365453568ull;
constexpr size_t WOF_krf = 373973248ull;
constexpr size_t WOF_Q = 376103168ull;
constexpr size_t WOF_qh = 427221248ull;
constexpr size_t WOF_KV = 478339328ull;
constexpr size_t WOF_kh = 546496768ull;
constexpr size_t WOF_omix = 580575488ull;
constexpr size_t WOF_KN = 614654208ull;
constexpr size_t WOF_SC = 1151525120ull;
constexpr size_t WOF_part = 1168302336ull;
constexpr size_t WOF_H = 1170432256ull;
constexpr size_t WOF_un = 1238589696ull;
constexpr size_t WOF_G = 1272668416ull;
constexpr size_t WOF_hid = 1273028864ull;
constexpr size_t WOF_H2 = 1366745344ull;
constexpr size_t WOF_un2 = 1434902784ull;
constexpr size_t WOF_PP = 1468981504ull;
constexpr size_t WOF_qraw = 1537138944ull;
constexpr size_t WOF_kvraw = 1562304768ull;
constexpr size_t WOF_krb = 1595859200ull;
constexpr size_t WS_TOTAL = 1596907776ull;
struct MK {
    const float *x_prompt, *x_sample, *cache_ckv, *cache_krope, *state_gdn, *state_conv; const int* page_table; const float *p_prompt, *p_sample;
    const float *g_attn, *w_in, *w_conv, *a_log, *dt_bias, *g_gdn_out, *g_q_a, *w_q_b, *g_q_nope, *g_q_rope, *g_kv_a, *g_k_rope, *w_kv_b, *g_k_nope, *w_o, *g_ffn, *w_gate, *w_up, *w_down, *g_ple, *w_ple_gate, *w_ple_proj;
    float* out; char* ws;
    __device__ __forceinline__ bf16_t* WinT() const { return (bf16_t*)(ws + WOF_WinT); }
    __device__ __forceinline__ bf16_t* WqbT() const { return (bf16_t*)(ws + WOF_WqbT); }
    __device__ __forceinline__ bf16_t* WkvT() const { return (bf16_t*)(ws + WOF_WkvT); }
    __device__ __forceinline__ bf16_t* WknT() const { return (bf16_t*)(ws + WOF_WknT); }
    __device__ __forceinline__ bf16_t* WoT() const { return (bf16_t*)(ws + WOF_WoT); }
    __device__ __forceinline__ bf16_t* WguT() const { return (bf16_t*)(ws + WOF_WguT); }
    __device__ __forceinline__ bf16_t* WdT() const { return (bf16_t*)(ws + WOF_WdT); }
    __device__ __forceinline__ bf16_t* WpgT() const { return (bf16_t*)(ws + WOF_WpgT); }
    __device__ __forceinline__ bf16_t* WppT() const { return (bf16_t*)(ws + WOF_WppT); }
    __device__ __forceinline__ bf16_t* xn() const { return (bf16_t*)(ws + WOF_xn); }
    __device__ __forceinline__ bf16_t* pb() const { return (bf16_t*)(ws + WOF_pb); }
    __device__ __forceinline__ bf16_t* Z() const { return (bf16_t*)(ws + WOF_Z); }
    __device__ __forceinline__ bf16_t* qkv() const { return (bf16_t*)(ws + WOF_qkv); }
    __device__ __forceinline__ float* ropecs() const { return (float*)(ws + WOF_ropecs); }
    __device__ __forceinline__ float* gg() const { return (float*)(ws + WOF_gg); }
    __device__ __forceinline__ float* bb() const { return (float*)(ws + WOF_bb); }
    __device__ __forceinline__ float* goraw() const { return (float*)(ws + WOF_goraw); }
    __device__ __forceinline__ float* gUT() const { return (float*)(ws + WOF_gUT); }
    __device__ __forceinline__ float* ggam() const { return (float*)(ws + WOF_ggam); }
    __device__ __forceinline__ bf16_t* gWn() const { return (bf16_t*)(ws + WOF_gWn); }
    __device__ __forceinline__ bf16_t* gQg() const { return (bf16_t*)(ws + WOF_gQg); }
    __device__ __forceinline__ bf16_t* gQK() const { return (bf16_t*)(ws + WOF_gQK); }
    __device__ __forceinline__ bf16_t* gKd() const { return (bf16_t*)(ws + WOF_gKd); }
    __device__ __forceinline__ bf16_t* qan() const { return (bf16_t*)(ws + WOF_qan); }
    __device__ __forceinline__ bf16_t* ckvb() const { return (bf16_t*)(ws + WOF_ckvb); }
    __device__ __forceinline__ float* krf() const { return (float*)(ws + WOF_krf); }
    __device__ __forceinline__ float* Q() const { return (float*)(ws + WOF_Q); }
    __device__ __forceinline__ float* qh() const { return (float*)(ws + WOF_qh); }
    __device__ __forceinline__ float* KV() const { return (float*)(ws + WOF_KV); }
    __device__ __forceinline__ float* kh() const { return (float*)(ws + WOF_kh); }
    __device__ __forceinline__ bf16_t* omix() const { return (bf16_t*)(ws + WOF_omix); }
    __device__ __forceinline__ bf16_t* KN() const { return (bf16_t*)(ws + WOF_KN); }
    __device__ __forceinline__ float* SC() const { return (float*)(ws + WOF_SC); }
    __device__ __forceinline__ float* part() const { return (float*)(ws + WOF_part); }
    __device__ __forceinline__ float* H() const { return (float*)(ws + WOF_H); }
    __device__ __forceinline__ bf16_t* un() const { return (bf16_t*)(ws + WOF_un); }
    __device__ __forceinline__ float* G() const { return (float*)(ws + WOF_G); }
    __device__ __forceinline__ bf16_t* hid() const { return (bf16_t*)(ws + WOF_hid); }
    __device__ __forceinline__ float* H2() const { return (float*)(ws + WOF_H2); }
    __device__ __forceinline__ bf16_t* un2() const { return (bf16_t*)(ws + WOF_un2); }
    __device__ __forceinline__ float* PP() const { return (float*)(ws + WOF_PP); }
    __device__ __forceinline__ bf16_t* qraw() const { return (bf16_t*)(ws + WOF_qraw); }
    __device__ __forceinline__ bf16_t* kvraw() const { return (bf16_t*)(ws + WOF_kvraw); }
    __device__ __forceinline__ bf16_t* krb() const { return (bf16_t*)(ws + WOF_krb); }
};

__device__ __forceinline__ float fast_sigmoid(float x) { return __builtin_amdgcn_rcpf(1.f + __builtin_amdgcn_exp2f(-1.44269504f * x)); }
__device__ __forceinline__ void bf8_to_f32(const bf16x8& v, float* o) {
#pragma unroll
    for (int e = 0; e < 8; ++e) o[e] = __uint_as_float(((unsigned)(unsigned short)v[e]) << 16);
}
__device__ __forceinline__ bf16x8 f32_to_bf8(const float* x) {
    u32x4 w; w.x = cvtpk(x[0], x[1]); w.y = cvtpk(x[2], x[3]); w.z = cvtpk(x[4], x[5]); w.w = cvtpk(x[6], x[7]);
    return __builtin_bit_cast(bf16x8, w);
}
__device__ __forceinline__ void post_in_token(const MK& a, int row, int lane, const float* wcs, const bf16x8 (&w0)[3], const bf16x8 (&w1)[3], const bf16x8 (&w2)[3], const bf16x8 (&wcur)[3]) {
    const bool samp = row >= NPT;
    const int b = samp ? row - NPT : row >> 11, t = samp ? 0 : row & 2047, hd = lane >> 3;
    const bf16_t* z = a.Z() + (size_t)row * ZW;
    float y[24];
#pragma unroll
    for (int c3 = 0; c3 < 3; ++c3) {
        float p0[8], p1[8], p2[8], cu[8];
        bf8_to_f32(w0[c3], p0); bf8_to_f32(w1[c3], p1); bf8_to_f32(w2[c3], p2); bf8_to_f32(wcur[c3], cu);
        const float* wp = wcs + 512 * c3 + 8 * lane;
        const float4 a0 = *(const float4*)wp, a1 = *(const float4*)(wp + 4), b0 = *(const float4*)(wp + 1536), b1 = *(const float4*)(wp + 1540);
        const float4 c0 = *(const float4*)(wp + 3072), c1 = *(const float4*)(wp + 3076), d0 = *(const float4*)(wp + 4608), d1 = *(const float4*)(wp + 4612);
        const float k0[8] = {a0.x, a0.y, a0.z, a0.w, a1.x, a1.y, a1.z, a1.w}, k1[8] = {b0.x, b0.y, b0.z, b0.w, b1.x, b1.y, b1.z, b1.w};
        const float k2[8] = {c0.x, c0.y, c0.z, c0.w, c1.x, c1.y, c1.z, c1.w}, k3[8] = {d0.x, d0.y, d0.z, d0.w, d1.x, d1.y, d1.z, d1.w};
#pragma unroll
        for (int e = 0; e < 8; ++e) { const int c = 8 * c3 + e; const float v = k0[e] * p0[e] + k1[e] * p1[e] + k2[e] * p2[e] + k3[e] * cu[e]; y[c] = v * fast_sigmoid(v); }
        __builtin_amdgcn_sched_barrier(0);
    }
    float sq = 0.f, sk = 0.f;
#pragma unroll
    for (int e = 0; e < 8; ++e) { sq += y[e] * y[e]; sk += y[8 + e] * y[8 + e]; }
    sq += __shfl_xor(sq, 1); sk += __shfl_xor(sk, 1); sq += __shfl_xor(sq, 2); sk += __shfl_xor(sk, 2); sq += __shfl_xor(sq, 4); sk += __shfl_xor(sk, 4);
    const float rq = rsqrtf(sq + EPSV) * 0.125f, rk = rsqrtf(sk + EPSV);
#pragma unroll
    for (int e = 0; e < 8; ++e) { y[e] *= rq; y[8 + e] *= rk; }
    bf16_t* qo = a.qkv() + (size_t)row * 1536 + 8 * lane;
    *(bf16x8*)qo = f32_to_bf8(y); *(bf16x8*)(qo + 512) = f32_to_bf8(y + 8); *(bf16x8*)(qo + 1024) = f32_to_bf8(y + 16);
    __builtin_amdgcn_sched_barrier(0);
    if (!samp && t >= SEQ - 3) {
        float* cso = a.out + O_CSP + ((size_t)b * 3 + (t - (SEQ - 3))) * 1536 + 8 * lane;
#pragma unroll
        for (int j = 0; j < 3; ++j) { float cu[8]; bf8_to_f32(wcur[j], cu); *(float4*)(cso + 512 * j) = (float4){cu[0], cu[1], cu[2], cu[3]}; *(float4*)(cso + 512 * j + 4) = (float4){cu[4], cu[5], cu[6], cu[7]}; }
    }
    __builtin_amdgcn_sched_barrier(0);
    if (lane < 16) {
        const float v = bf2f(z[OFF_A + lane]);
        if (lane < 8) { const float xx = v + a.dt_bias[lane]; const float sp = xx > 20.f ? xx : log1pf(expf(xx)); a.gg()[(size_t)row * 8 + lane] = -expf(a.a_log[lane]) * sp; }
        else a.bb()[(size_t)row * 8 + lane - 8] = 1.f / (1.f + expf(-v));
    }
    __builtin_amdgcn_sched_barrier(0);
    float qa[8], cv[8], kr[8];
    { bf16x8 t8 = {0, 0, 0, 0, 0, 0, 0, 0}; if (lane < 48) t8 = *(const bf16x8*)(z + OFF_QA + 8 * lane); bf8_to_f32(t8, qa); }
    { bf16x8 t8 = {0, 0, 0, 0, 0, 0, 0, 0}; if (lane < 32) t8 = *(const bf16x8*)(z + OFF_KVA + 8 * lane); bf8_to_f32(t8, cv); }
    { bf16x8 t8 = {0, 0, 0, 0, 0, 0, 0, 0}; if (lane >= 32 && lane < 36) t8 = *(const bf16x8*)(z + OFF_KR + 8 * (lane - 32)); bf8_to_f32(t8, kr); }
    float s1 = 0.f, s2 = 0.f, s3 = 0.f;
#pragma unroll
    for (int e = 0; e < 8; ++e) { s1 += qa[e] * qa[e]; s2 += cv[e] * cv[e]; s3 += kr[e] * kr[e]; }
#pragma unroll
    for (int o = 1; o < 64; o <<= 1) { s1 += __shfl_xor(s1, o); s2 += __shfl_xor(s2, o); s3 += __shfl_xor(s3, o); }
    const float r1 = rsqrtf(s1 * (1.f / 384.f) + EPSV), r2 = rsqrtf(s2 * (1.f / 256.f) + EPSV), r3 = rsqrtf(s3 * (1.f / 32.f) + EPSV);
    if (lane < 48) {
        const float4 g0 = *(const float4*)(a.g_q_a + 8 * lane), g1 = *(const float4*)(a.g_q_a + 8 * lane + 4);
        float o[8] = {qa[0] * r1 * g0.x, qa[1] * r1 * g0.y, qa[2] * r1 * g0.z, qa[3] * r1 * g0.w, qa[4] * r1 * g1.x, qa[5] * r1 * g1.y, qa[6] * r1 * g1.z, qa[7] * r1 * g1.w};
        *(bf16x8*)(a.qan() + (size_t)row * 384 + 8 * lane) = f32_to_bf8(o);
    }
    if (lane < 32) {
        const float4 g0 = *(const float4*)(a.g_kv_a + 8 * lane), g1 = *(const float4*)(a.g_kv_a + 8 * lane + 4);
        float o[8] = {cv[0] * r2 * g0.x, cv[1] * r2 * g0.y, cv[2] * r2 * g0.z, cv[3] * r2 * g0.w, cv[4] * r2 * g1.x, cv[5] * r2 * g1.y, cv[6] * r2 * g1.z, cv[7] * r2 * g1.w};
        *(bf16x8*)(a.ckvb() + (size_t)row * 256 + 8 * lane) = f32_to_bf8(o);
        float* co = samp ? a.out + O_CKVS + (size_t)b * 256 + 8 * lane : a.out + O_CKVP + (size_t)row * 256 + 8 * lane;
        *(float4*)co = (float4){o[0], o[1], o[2], o[3]}; *(float4*)(co + 4) = (float4){o[4], o[5], o[6], o[7]};
    }
    __builtin_amdgcn_sched_barrier(0);
    {
        const int c4 = (lane - 32) & 3;
        float xn[8], ot[8];
#pragma unroll
        for (int e = 0; e < 8; ++e) xn[e] = kr[e] * r3 * a.g_k_rope[8 * c4 + e];
#pragma unroll
        for (int e = 0; e < 8; ++e) ot[e] = __shfl_xor(xn[e], 2);
        if (lane >= 32 && lane < 36) {
            const float* tb = a.ropecs() + (size_t)(samp ? 2048 : t) * 32 + ((8 * c4) & 15);
            float o[8];
#pragma unroll
            for (int e = 0; e < 8; ++e) { const float cs = tb[e], sn = tb[16 + e]; o[e] = c4 < 2 ? xn[e] * cs - ot[e] * sn : ot[e] * sn + xn[e] * cs; }
            float* kf_ = a.krf() + (size_t)row * 32 + 8 * c4; *(float4*)kf_ = (float4){o[0], o[1], o[2], o[3]}; *(float4*)(kf_ + 4) = (float4){o[4], o[5], o[6], o[7]};
            float* ko = samp ? a.out + O_KRS + (size_t)b * 32 + 8 * c4 : a.out + O_KRP + (size_t)row * 32 + 8 * c4;
            *(float4*)ko = (float4){o[0], o[1], o[2], o[3]}; *(float4*)(ko + 4) = (float4){o[4], o[5], o[6], o[7]};
            if (!samp) *(bf16x8*)(a.krb() + (size_t)row * 32 + 8 * c4) = f32_to_bf8(o);
        }
    }
    (void)hd;
}
__device__ __forceinline__ void post_in_run(const MK& a, int run, int lane_in, const float* wcs) {
    int lane = lane_in; asm volatile("" : "+v"(lane));
    if (run < NPT / 8) {
        const int row0 = run * 8, t0 = row0 & 2047;
        bf16x8 w0[3], w1[3], w2[3], wcur[3];
#pragma unroll
        for (int c3 = 0; c3 < 3; ++c3) {
            const bf16x8 zz = {0, 0, 0, 0, 0, 0, 0, 0}; w0[c3] = zz; w1[c3] = zz; w2[c3] = zz;
            if (t0 > 0) { const bf16_t* zp = a.Z() + (size_t)(row0 - 3) * ZW + 512 * c3 + 8 * lane; w0[c3] = *(const bf16x8*)zp; w1[c3] = *(const bf16x8*)(zp + ZW); w2[c3] = *(const bf16x8*)(zp + 2 * ZW); }
        }
#pragma unroll 1
        for (int k = 0; k < 8; ++k) {
            const int row = row0 + k;
#pragma unroll
            for (int c3 = 0; c3 < 3; ++c3) wcur[c3] = *(const bf16x8*)(a.Z() + (size_t)row * ZW + 512 * c3 + 8 * lane);
            post_in_token(a, row, lane, wcs, w0, w1, w2, wcur);
#pragma unroll
            for (int c3 = 0; c3 < 3; ++c3) { w0[c3] = w1[c3]; w1[c3] = w2[c3]; w2[c3] = wcur[c3]; }
        }
    } else {
#pragma unroll 1
        for (int k = 0; k < 8; ++k) {
            const int bsm = (run - NPT / 8) * 8 + k, row = NPT + bsm;
            bf16x8 w0[3], w1[3], w2[3], wcur[3];
#pragma unroll
            for (int c3 = 0; c3 < 3; ++c3) {
                const float* sp = a.state_conv + (size_t)bsm * 3 * 1536 + 512 * c3 + 8 * lane;
                float* cso = a.out + O_CSS + (size_t)bsm * 3 * 1536 + 512 * c3 + 8 * lane;
                float t0_[8], t1_[8], t2_[8], tc_[8];
#pragma unroll
                for (int e = 0; e < 8; ++e) { t0_[e] = sp[e]; t1_[e] = sp[1536 + e]; t2_[e] = sp[2 * 1536 + e]; }
                wcur[c3] = *(const bf16x8*)(a.Z() + (size_t)row * ZW + 512 * c3 + 8 * lane); bf8_to_f32(wcur[c3], tc_);
#pragma unroll
                for (int e = 0; e < 8; ++e) { cso[e] = t1_[e]; cso[1536 + e] = t2_[e]; cso[2 * 1536 + e] = tc_[e]; }
                w0[c3] = f32_to_bf8(t0_); w1[c3] = f32_to_bf8(t1_); w2[c3] = f32_to_bf8(t2_);
            }
            post_in_token(a, row, lane, wcs, w0, w1, w2, wcur);
        }
    }
}

__device__ __forceinline__ void post_q_item(const MK& a, int idx, int lane) {
    const int row = idx >> 3, h = idx & 7;
    const float* q = a.Q() + (size_t)row * 768 + h * 96;
    float* o = a.qh() + ((size_t)row * 8 + h) * 96;
    const float v = q[lane];
    const float ss = wave_sum(v * v);
    o[lane] = v * rsqrtf(ss * (1.f / 64.f) + EPSV) * a.g_q_nope[lane];
    const float r = lane < 32 ? q[64 + lane] : 0.f;
    const float s2 = wave_sum(r * r);
    const float xn = lane < 32 ? r * rsqrtf(s2 * (1.f / 32.f) + EPSV) * a.g_q_rope[lane] : 0.f;
    const float other = __shfl_xor(xn, 16);
    const int i = lane & 15;
    const float* tb = a.ropecs() + (size_t)(row >= NPT ? 2048 : (row & 2047)) * 32;
    const float cs = tb[i], sn = tb[16 + i];
    const float ov = lane < 16 ? xn * cs - other * sn : other * sn + xn * cs;
    if (lane < 32) o[64 + lane] = ov;
}
__device__ __forceinline__ void post_kv_item(const MK& a, int idx, int lane) {
    const int row = idx >> 3, h = idx & 7;
    const float v = a.KV()[(size_t)row * 1024 + h * 128 + lane];
    const float ss = wave_sum(v * v);
    const float kn = v * rsqrtf(ss * (1.f / 64.f) + EPSV) * a.g_k_nope[lane];
    a.kh()[((size_t)row * 8 + h) * 64 + lane] = kn;
}

typedef float f32x16 __attribute__((ext_vector_type(16)));
typedef short s16x4 __attribute__((ext_vector_type(4)));
#define KST 104
#define VST 72
#define ATT_BUF (64 * KST * 2 + 64 * VST * 2)
__device__ __forceinline__ int crow32(int r, int hi) { return (r & 3) + 8 * (r >> 2) + 4 * hi; }
__device__ __forceinline__ s16x4 tr_read(const bf16_t* p) { return __builtin_bit_cast(s16x4, __builtin_amdgcn_ds_read_tr16_b64_v4i16((LAS s16x4*)(LAS void*)(unsigned)(size_t)p)); }
__device__ __forceinline__ bf16x8 pack8(const f32x16& x, int s) {
    u32x4 w; w.x = pk2bf(x[8 * s], x[8 * s + 1]); w.y = pk2bf(x[8 * s + 2], x[8 * s + 3]); w.z = pk2bf(x[8 * s + 4], x[8 * s + 5]); w.w = pk2bf(x[8 * s + 6], x[8 * s + 7]);
    return __builtin_bit_cast(bf16x8, w);
}
__device__ __forceinline__ void attn_block(const MK& a, int b, int h, int qb, char* smem) {
    const int tid = otid(), lane = tid & 63, wid = tid >> 6, r32 = lane & 31, hi = lane >> 5;
    const int qrow = qb * 256 + wid * 32 + r32;
    const int wq0 = qb * 256 + wid * 32;
    bf16x8 qf[6];
    {
        const float SCL = 0.14724445f;
        const bf16_t* Qg = a.qraw() + ((size_t)b * SEQ + qrow) * 768 + h * 96 + 8 * hi;
        float qv[6][8];
#pragma unroll
        for (int ds = 0; ds < 6; ++ds) bf8_to_f32(*(const bf16x8*)(Qg + 16 * ds), qv[ds]);
        float sn_ = 0.f, sr_ = 0.f;
#pragma unroll
        for (int j = 0; j < 8; ++j) { sn_ += qv[0][j] * qv[0][j] + qv[1][j] * qv[1][j] + qv[2][j] * qv[2][j] + qv[3][j] * qv[3][j]; sr_ += qv[4][j] * qv[4][j] + qv[5][j] * qv[5][j]; }
        sn_ += __shfl_xor(sn_, 32); sr_ += __shfl_xor(sr_, 32);
        const float rsn = rsqrtf(sn_ * (1.f / 64.f) + EPSV) * SCL, rsr = rsqrtf(sr_ * (1.f / 32.f) + EPSV);
#pragma unroll
        for (int ds = 0; ds < 4; ++ds) {
            float o[8];
#pragma unroll
            for (int j = 0; j < 8; ++j) o[j] = qv[ds][j] * rsn * a.g_q_nope[16 * ds + 8 * hi + j];
            qf[ds] = f32_to_bf8(o);
        }
        const float* tb = a.ropecs() + (size_t)qrow * 32 + 8 * hi;
        float o4[8], o5[8];
#pragma unroll
        for (int j = 0; j < 8; ++j) {
            const float x1 = qv[4][j] * rsr * a.g_q_rope[8 * hi + j], x2 = qv[5][j] * rsr * a.g_q_rope[16 + 8 * hi + j], cs = tb[j], sn = tb[16 + j];
            o4[j] = (x1 * cs - x2 * sn) * SCL; o5[j] = (x1 * sn + x2 * cs) * SCL;
        }
        qf[4] = f32_to_bf8(o4); qf[5] = f32_to_bf8(o5);
    }
    f32x16 o0, o1;
#pragma unroll
    for (int r = 0; r < 16; ++r) { o0[r] = 0.f; o1[r] = 0.f; }
    float m = -INFINITY, l = 0.f;
    const int nt = qb * 4 + 4;
    const int vr = tid >> 3, vc = tid & 7, rr_ = (tid >> 2) & 63, rc = tid & 3;
    const bf16_t* KVg = a.kvraw() + (size_t)b * SEQ * 1024 + h * 128 + (size_t)vr * 1024 + vc * 8;
    const bf16_t* KRg = a.krb() + (size_t)b * SEQ * 32 + (size_t)rr_ * 32 + rc * 8;
    float gk[8];
#pragma unroll
    for (int j = 0; j < 8; ++j) gk[j] = a.g_k_nope[8 * vc + j];
    bf16x8 kr0, kr1, vr0;
#define ATT_LOAD(tt) do { kr0 = *(const bf16x8*)(KVg + (size_t)(tt) * 64 * 1024); vr0 = *(const bf16x8*)(KVg + (size_t)(tt) * 64 * 1024 + 64); if (tid < 256) kr1 = *(const bf16x8*)(KRg + (size_t)(tt) * 64 * 32); } while (0)
#define ATT_STORE(buf) do { bf16_t* Ks_ = (bf16_t*)(smem + (buf) * ATT_BUF); bf16_t* Vs_ = Ks_ + 64 * KST; \
        float x_[8]; bf8_to_f32(kr0, x_); float ss_ = 0.f; _Pragma("unroll") for (int j = 0; j < 8; ++j) ss_ += x_[j] * x_[j]; \
        ss_ += __shfl_xor(ss_, 1); ss_ += __shfl_xor(ss_, 2); ss_ += __shfl_xor(ss_, 4); const float rs_ = rsqrtf(ss_ * (1.f / 64.f) + EPSV); \
        _Pragma("unroll") for (int j = 0; j < 8; ++j) x_[j] *= rs_ * gk[j]; \
        *(bf16x8*)(Ks_ + vr * KST + vc * 8) = f32_to_bf8(x_); *(bf16x8*)(Vs_ + vr * VST + vc * 8) = vr0; \
        if (tid < 256) *(bf16x8*)(Ks_ + rr_ * KST + 64 + rc * 8) = kr1; } while (0)
    ATT_LOAD(0);
    __syncthreads();
    ATT_STORE(0);
    __syncthreads();
    const int i16 = lane & 15, qq = i16 >> 2, pp = i16 & 3, g1 = (lane >> 4) & 1;
    for (int t = 0; t < nt; ++t) {
        const bf16_t* Ks = (const bf16_t*)(smem + (t & 1) * ATT_BUF); const bf16_t* Vs = Ks + 64 * KST;
        if (t + 1 < nt) ATT_LOAD(t + 1);
        if (64 * t <= wq0 + 31) {
            f32x16 p0, p1;
#pragma unroll
            for (int r = 0; r < 16; ++r) { p0[r] = 0.f; p1[r] = 0.f; }
#pragma unroll
            for (int ds = 0; ds < 6; ++ds) {
                const bf16x8 k0 = *(const bf16x8*)(Ks + r32 * KST + 16 * ds + 8 * hi);
                const bf16x8 k1 = *(const bf16x8*)(Ks + (32 + r32) * KST + 16 * ds + 8 * hi);
                p0 = __builtin_amdgcn_mfma_f32_32x32x16_bf16(k0, qf[ds], p0, 0, 0, 0);
                p1 = __builtin_amdgcn_mfma_f32_32x32x16_bf16(k1, qf[ds], p1, 0, 0, 0);
            }
            if (64 * t + 63 > wq0) {
#pragma unroll
                for (int r = 0; r < 16; ++r) { const int kv = 64 * t + crow32(r, hi); if (kv > qrow) p0[r] = -INFINITY; if (kv + 32 > qrow) p1[r] = -INFINITY; }
            }
            float mx = fmaxf(p0[0], p1[0]);
#pragma unroll
            for (int r = 1; r < 16; ++r) mx = fmaxf(mx, fmaxf(p0[r], p1[r]));
            mx = fmaxf(mx, __shfl_xor(mx, 32));
            const float mn = fmaxf(m, mx);
            const float alpha = __builtin_amdgcn_exp2f(m - mn);
            m = mn;
            float rs = 0.f;
#pragma unroll
            for (int r = 0; r < 16; ++r) { p0[r] = __builtin_amdgcn_exp2f(p0[r] - mn); p1[r] = __builtin_amdgcn_exp2f(p1[r] - mn); rs += p0[r] + p1[r]; }
            l = l * alpha + rs;
#pragma unroll
            for (int r = 0; r < 16; ++r) { o0[r] *= alpha; o1[r] *= alpha; }
            bf16x8 pf[4];
            pf[0] = pack8(p0, 0); pf[1] = pack8(p0, 1); pf[2] = pack8(p1, 0); pf[3] = pack8(p1, 1);
#pragma unroll
            for (int ks = 0; ks < 4; ++ks) {
                const bf16_t* vb0 = Vs + (16 * ks + 4 * hi + qq) * VST + 16 * g1 + 4 * pp;
                const s16x4 a0 = tr_read(vb0), a1 = tr_read(vb0 + 8 * VST);
                const s16x4 c0 = tr_read(vb0 + 32), c1 = tr_read(vb0 + 8 * VST + 32);
                const bf16x8 va = __builtin_shufflevector(a0, a1, 0, 1, 2, 3, 4, 5, 6, 7);
                const bf16x8 vc_ = __builtin_shufflevector(c0, c1, 0, 1, 2, 3, 4, 5, 6, 7);
                o0 = __builtin_amdgcn_mfma_f32_32x32x16_bf16(va, pf[ks], o0, 0, 0, 0);
                o1 = __builtin_amdgcn_mfma_f32_32x32x16_bf16(vc_, pf[ks], o1, 0, 0, 0);
            }
        }
        if (t + 1 < nt) ATT_STORE((t + 1) & 1);
        __syncthreads();
    }
    l += __shfl_xor(l, 32);
    const float il = 1.f / l;
    bf16_t* op = a.omix() + ((size_t)b * SEQ + qrow) * 1024 + 512 + h * 64;
#pragma unroll
    for (int g = 0; g < 4; ++g) {
        uint2 w0, w1;
        w0.x = pk2bf(o0[4 * g] * il, o0[4 * g + 1] * il); w0.y = pk2bf(o0[4 * g + 2] * il, o0[4 * g + 3] * il);
        w1.x = pk2bf(o1[4 * g] * il, o1[4 * g + 1] * il); w1.y = pk2bf(o1[4 * g + 2] * il, o1[4 * g + 3] * il);
        *(uint2*)(op + 8 * g + 4 * hi) = w0;
        *(uint2*)(op + 32 + 8 * g + 4 * hi) = w1;
    }
#undef ATT_LOAD
#undef ATT_STORE
}

__device__ __forceinline__ void gdn_unit(const MK& a, int b, int h, int dvg, const float* s0, float* sout, int row0, int T, int lane, char* wsm) {
    float (*sq)[64] = (float (*)[64])wsm;
    float (*sk)[64] = (float (*)[64])(wsm + 4096);
    float (*sv)[8] = (float (*)[8])(wsm + 8192);
    float* sg = (float*)(wsm + 8704);
    float* sb = (float*)(wsm + 8768);
    const int e = lane & 7, ko = lane >> 3, col = dvg * 8 + e;
    float S[8];
#pragma unroll
    for (int d = 0; d < 8; ++d) S[d] = s0 ? s0[(((size_t)b * 8 + h) * 64 + ko * 8 + d) * 64 + col] : 0.f;
    const size_t rbase = (size_t)row0 + (size_t)b * T;
    float pq[16], pk[16], pv0, pv1, pgb;
    {
        const int nt = T < 16 ? T : 16;
#pragma unroll
        for (int j = 0; j < 16; ++j) { const bool ok = j < nt; const size_t r = rbase + (ok ? j : 0); pq[j] = ok ? bf2f(a.qkv()[r * 1536 + h * 64 + lane]) : 0.f; pk[j] = ok ? bf2f(a.qkv()[r * 1536 + 512 + h * 64 + lane]) : 0.f; }
        { const int j0 = lane >> 3, j1 = j0 + 8; pv0 = j0 < nt ? bf2f(a.qkv()[(rbase + j0) * 1536 + 1024 + h * 64 + dvg * 8 + (lane & 7)]) : 0.f; pv1 = j1 < nt ? bf2f(a.qkv()[(rbase + j1) * 1536 + 1024 + h * 64 + dvg * 8 + (lane & 7)]) : 0.f; }
        { const int j = lane & 15; pgb = j < nt ? (lane < 16 ? a.gg()[(rbase + j) * 8 + h] : a.bb()[(rbase + j) * 8 + h]) : 0.f; }
    }
    for (int t0 = 0; t0 < T; t0 += 16) {
        const int nt = (T - t0) < 16 ? (T - t0) : 16;
        WSYNC();
#pragma unroll
        for (int j = 0; j < 16; ++j) { sq[j][lane] = pq[j]; sk[j][lane] = pk[j]; }
        sv[lane >> 3][lane & 7] = pv0; sv[(lane >> 3) + 8][lane & 7] = pv1;
        if (lane < 16) sg[lane] = expf(pgb); else if (lane < 32) sb[lane - 16] = pgb;
        WSYNC();
        if (t0 + 16 < T) {
            const size_t rb = rbase + t0 + 16;
#pragma unroll
            for (int j = 0; j < 16; ++j) { pq[j] = bf2f(a.qkv()[(rb + j) * 1536 + h * 64 + lane]); pk[j] = bf2f(a.qkv()[(rb + j) * 1536 + 512 + h * 64 + lane]); }
            pv0 = bf2f(a.qkv()[(rb + (lane >> 3)) * 1536 + 1024 + h * 64 + dvg * 8 + (lane & 7)]); pv1 = bf2f(a.qkv()[(rb + (lane >> 3) + 8) * 1536 + 1024 + h * 64 + dvg * 8 + (lane & 7)]);
            pgb = lane < 16 ? a.gg()[(rb + (lane & 15)) * 8 + h] : a.bb()[(rb + (lane & 15)) * 8 + h];
        }
        for (int j = 0; j < nt; ++j) {
            const float dec = sg[j], be = sb[j], v = sv[j][e];
            const float4 k0 = *(const float4*)&sk[j][ko * 8], k1 = *(const float4*)&sk[j][ko * 8 + 4];
            const float4 q0 = *(const float4*)&sq[j][ko * 8], q1 = *(const float4*)&sq[j][ko * 8 + 4];
            const float kk[8] = {k0.x, k0.y, k0.z, k0.w, k1.x, k1.y, k1.z, k1.w};
            const float qq[8] = {q0.x, q0.y, q0.z, q0.w, q1.x, q1.y, q1.z, q1.w};
            float ks = 0.f;
#pragma unroll
            for (int d = 0; d < 8; ++d) { S[d] *= dec; ks += kk[d] * S[d]; }
            ks += __shfl_xor(ks, 8); ks += __shfl_xor(ks, 16); ks += __shfl_xor(ks, 32);
            const float delta = (v - ks) * be;
            float ov = 0.f;
#pragma unroll
            for (int d = 0; d < 8; ++d) { S[d] += kk[d] * delta; ov += qq[d] * S[d]; }
            ov += __shfl_xor(ov, 8); ov += __shfl_xor(ov, 16); ov += __shfl_xor(ov, 32);
            if (ko == 0) a.goraw()[(rbase + t0 + j) * 512 + h * 64 + col] = ov;
        }
    }
#pragma unroll
    for (int d = 0; d < 8; ++d) sout[(((size_t)b * 8 + h) * 64 + ko * 8 + d) * 64 + col] = S[d];
}
__device__ __forceinline__ bf16x8 ld8_f32_bf16(const float* p) {
    const float4 x = *(const float4*)p, y = *(const float4*)(p + 4);
    u32x4 w; w.x = cvtpk(x.x, x.y); w.y = cvtpk(x.z, x.w); w.z = cvtpk(y.x, y.y); w.w = cvtpk(y.z, y.w);
    return __builtin_bit_cast(bf16x8, w);
}
__device__ __forceinline__ int pi_pos(int k) { return (k & 32) + 8 * ((k >> 2) & 3) + 4 * ((k >> 4) & 1) + (k & 3); }
#define GDN_WLDS 17408
__device__ __forceinline__ void gdn_prep_unit(const MK& a, int u, int lane_in, char* wsm) {
    int lane = lane_in; asm volatile("" : "+v"(lane));
    const int bh = u >> 5, n = u & 31, b = bh >> 3, h = bh & 7, i16 = lane & 15, q4 = lane >> 4;
    const size_t row0 = (size_t)b * SEQ + n * 64;
    float* AT = (float*)wsm; float* GC = (float*)(wsm + 16384); float* BT = GC + 64;
    const bf16_t* qbase = a.qkv() + row0 * 1536 + h * 64; const bf16_t* kbase = qbase + 512; const bf16_t* vbase = qbase + 1024;
    float g = a.gg()[(row0 + lane) * 8 + h];
    const float be_l = a.bb()[(row0 + lane) * 8 + h];
#pragma unroll
    for (int o = 1; o < 64; o <<= 1) { const float t = __shfl_up(g, o); if (lane >= o) g += t; }
    WSYNC();
    GC[lane] = g; BT[lane] = be_l;
    WSYNC();
    const float gl = GC[63];
    float* EG = BT + 64; float* ED = EG + 64;
    EG[lane] = expf(g); ED[lane] = expf(gl - g);
    WSYNC();
    bf16x8 kf[4][2], qf[4][2];
#pragma unroll
    for (int mt = 0; mt < 4; ++mt)
#pragma unroll
        for (int ks = 0; ks < 2; ++ks) {
            const int off = (16 * mt + i16) * 1536 + 32 * ks + 8 * q4;
            kf[mt][ks] = *(const bf16x8*)(kbase + off); qf[mt][ks] = *(const bf16x8*)(qbase + off);
        }
    bf16_t* QKg = a.gQK() + (size_t)u * 4096;
#pragma unroll
    for (int mt = 0; mt < 4; ++mt)
#pragma unroll
        for (int nt = 0; nt < 4; ++nt) {
            const int j = 16 * nt + i16, pj = 32 * (nt >> 1) + 8 * (i16 >> 2) + 4 * (nt & 1) + (i16 & 3);
            if (nt <= mt) {
                f32x4 d1 = {0.f, 0.f, 0.f, 0.f}, d2 = {0.f, 0.f, 0.f, 0.f};
#pragma unroll
                for (int ks = 0; ks < 2; ++ks) {
                    d1 = __builtin_amdgcn_mfma_f32_16x16x32_bf16(kf[mt][ks], kf[nt][ks], d1, 0, 0, 0);
                    d2 = __builtin_amdgcn_mfma_f32_16x16x32_bf16(qf[mt][ks], kf[nt][ks], d2, 0, 0, 0);
                }
                const float gcj = GC[j];
#pragma unroll
                for (int r = 0; r < 4; ++r) {
                    const int i = 16 * mt + 4 * q4 + r;
                    const float dec = expf(GC[i] - gcj);
                    AT[i * 64 + j] = (i > j) ? BT[i] * d1[r] * dec : 0.f;
                    QKg[i * 64 + (((pj >> 3) ^ (i & 7)) << 3) + (pj & 7)] = f2bf((i >= j) ? d2[r] * dec : 0.f);
                }
            } else {
#pragma unroll
                for (int r = 0; r < 4; ++r) { const int i = 16 * mt + 4 * q4 + r; QKg[i * 64 + (((pj >> 3) ^ (i & 7)) << 3) + (pj & 7)] = 0; }
            }
        }
    {
        bf16_t* Qgg = a.gQg() + (size_t)u * 4096;
#pragma unroll
        for (int mt = 0; mt < 4; ++mt) {
            const int i = 16 * mt + i16; const float e = EG[i];
#pragma unroll
            for (int ks = 0; ks < 2; ++ks) {
                float x[8]; bf8_to_f32(qf[mt][ks], x);
                uint2 w0, w1; w0.x = cvtpk(x[0] * e, x[1] * e); w0.y = cvtpk(x[2] * e, x[3] * e); w1.x = cvtpk(x[4] * e, x[5] * e); w1.y = cvtpk(x[6] * e, x[7] * e);
                const int p0 = 32 * ks + 16 * (q4 & 1) + 4 * (q4 >> 1);
                *(uint2*)(Qgg + i * 64 + (((p0 >> 3) ^ (i & 7)) << 3) + (p0 & 7)) = w0; *(uint2*)(Qgg + i * 64 + ((((p0 >> 3) + 1) ^ (i & 7)) << 3) + (p0 & 7)) = w1;
            }
        }
    }
    WSYNC();
    __builtin_amdgcn_sched_barrier(0);
    {
        float U[64];
#pragma unroll
        for (int i = 0; i < 64; ++i) { U[i] = bf2f(vbase[i * 1536 + lane]) * BT[i]; }
#pragma unroll
        for (int i = 1; i < 64; ++i) {
            float su = 0.f;
#pragma unroll
            for (int j4 = 0; j4 < i; j4 += 4) {
                const float4 av = *(const float4*)(AT + i * 64 + j4);
                su += av.x * U[j4];
                if (j4 + 1 < i) su += av.y * U[j4 + 1];
                if (j4 + 2 < i) su += av.z * U[j4 + 2];
                if (j4 + 3 < i) su += av.w * U[j4 + 3];
            }
            U[i] -= su;
            __builtin_amdgcn_sched_barrier(0);
        }
        float* UTg = a.gUT() + ((size_t)u * 64 + lane) * 64;
#pragma unroll
        for (int i = 0; i < 64; i += 4) *(float4*)(UTg + 4 * ((i >> 2) ^ (lane & 15))) = (float4){U[i], U[i + 1], U[i + 2], U[i + 3]};
    }
    asm volatile("" ::: "memory");
    __builtin_amdgcn_sched_barrier(0);
    {
        float W[64];
#pragma unroll
        for (int i = 0; i < 64; ++i) { W[i] = bf2f(kbase[i * 1536 + lane]); }
        bf16_t* Kdg = a.gKd() + ((size_t)u * 64 + lane) * 64;
#pragma unroll
        for (int pc = 0; pc < 8; ++pc) {
            float t[8];
#pragma unroll
            for (int jj = 0; jj < 8; ++jj) { const int j = 32 * (pc >> 2) + 16 * (jj >> 2) + 4 * (pc & 3) + (jj & 3); t[jj] = W[j] * ED[j]; }
            u32x4 w; w.x = cvtpk(t[0], t[1]); w.y = cvtpk(t[2], t[3]); w.z = cvtpk(t[4], t[5]); w.w = cvtpk(t[6], t[7]);
            *(u32x4*)(Kdg + 8 * (pc ^ (lane & 7))) = w;
        }
#pragma unroll
        for (int i = 0; i < 64; ++i) W[i] *= BT[i] * EG[i];
#pragma unroll
        for (int i = 1; i < 64; ++i) {
            float sw = 0.f;
#pragma unroll
            for (int j4 = 0; j4 < i; j4 += 4) {
                const float4 av = *(const float4*)(AT + i * 64 + j4);
                sw += av.x * W[j4];
                if (j4 + 1 < i) sw += av.y * W[j4 + 1];
                if (j4 + 2 < i) sw += av.z * W[j4 + 2];
                if (j4 + 3 < i) sw += av.w * W[j4 + 3];
            }
            W[i] -= sw;
            __builtin_amdgcn_sched_barrier(0);
        }
        bf16_t* Wng = a.gWn() + (size_t)u * 4096; const int pp = pi_pos(lane);
#pragma unroll
        for (int i = 0; i < 64; ++i) Wng[i * 64 + (((pp >> 3) ^ (i & 7)) << 3) + (pp & 7)] = f2bf(-W[i]);
    }
    if (lane == 0) a.ggam()[u] = expf(gl);
}
__device__ __forceinline__ bf16x8 pack_acc2(const f32x4& x, const f32x4& y) {
    u32x4 w; w.x = cvtpk(x[0], x[1]); w.y = cvtpk(x[2], x[3]); w.z = cvtpk(y[0], y[1]); w.w = cvtpk(y[2], y[3]);
    return __builtin_bit_cast(bf16x8, w);
}
#define G2_SLOT 49152
__device__ __forceinline__ void g2_issue(const MK& a, size_t u, int n, LAS unsigned char* lds, int lw, int lane) {
    LAS unsigned char* dst = lds + (n % 3) * G2_SLOT;
    const char* srcs[4] = {(const char*)(a.gWn() + u * 4096), (const char*)(a.gQg() + u * 4096), (const char*)(a.gQK() + u * 4096), (const char*)(a.gKd() + u * 4096)};
#pragma unroll
    for (int m = 0; m < 4; ++m)
#pragma unroll
        for (int i = 0; i < 2; ++i) { const int piece = 2 * lw + i;
            __builtin_amdgcn_global_load_lds((const unsigned*)(srcs[m] + piece * 1024 + lane * 16), (LAS unsigned*)(dst + m * 8192 + piece * 1024), 16, 0, 0); }
    const char* us = (const char*)(a.gUT() + u * 4096);
#pragma unroll
    for (int i = 0; i < 4; ++i) { const int piece = 4 * lw + i;
        __builtin_amdgcn_global_load_lds((const unsigned*)(us + piece * 1024 + lane * 16), (LAS unsigned*)(dst + 32768 + piece * 1024), 16, 0, 0); }
}
__device__ __forceinline__ void gdn_scan_block(const MK& a, int bh, LAS unsigned char* lds) {
    const int tid = otid(), lane = tid & 63, wid = __builtin_amdgcn_readfirstlane(tid >> 6), i16 = lane & 15, q4 = lane >> 4;
    const int b = bh >> 3, h = bh & 7, sl = wid & 3;
    const bool loader = wid >= 4;
    f32x4 S[4];
#pragma unroll
    for (int mt = 0; mt < 4; ++mt) S[mt] = (f32x4){0.f, 0.f, 0.f, 0.f};
    __syncthreads();
    if (loader) { g2_issue(a, (size_t)bh * 32, 0, lds, wid - 4, lane); g2_issue(a, (size_t)bh * 32 + 1, 1, lds, wid - 4, lane); }
    for (int n = 0; n < 32; ++n) {
        if (loader) { if (n < 31) asm volatile("s_waitcnt vmcnt(12)" ::: "memory"); else asm volatile("s_waitcnt vmcnt(0)" ::: "memory"); }
        asm volatile("s_waitcnt lgkmcnt(0)" ::: "memory"); __builtin_amdgcn_s_barrier(); asm volatile("" ::: "memory");
        if (loader) { if (n + 2 < 32) g2_issue(a, (size_t)bh * 32 + n + 2, n + 2, lds, wid - 4, lane); }
        else {
            const LAS unsigned char* sb = lds + (n % 3) * G2_SLOT;
            const float gam = a.ggam()[(size_t)bh * 32 + n];
            bf16x8 Sb[2]; Sb[0] = pack_acc2(S[0], S[1]); Sb[1] = pack_acc2(S[2], S[3]);
            f32x4 Vn[4];
#pragma unroll
            for (int mt = 0; mt < 4; ++mt) Vn[mt] = *(const LAS f32x4*)(sb + 32768 + (16 * sl + i16) * 256 + 16 * ((4 * mt + q4) ^ i16));
#pragma unroll
            for (int mt = 0; mt < 4; ++mt)
#pragma unroll
                for (int ks = 0; ks < 2; ++ks) Vn[mt] = __builtin_amdgcn_mfma_f32_16x16x32_bf16(*(const LAS bf16x8*)(sb + (16 * mt + i16) * 128 + 16 * ((4 * ks + q4) ^ (i16 & 7))), Sb[ks], Vn[mt], 0, 0, 0);
            bf16x8 Vb[2]; Vb[0] = pack_acc2(Vn[0], Vn[1]); Vb[1] = pack_acc2(Vn[2], Vn[3]);
            f32x4 O[4];
#pragma unroll
            for (int mt = 0; mt < 4; ++mt) {
                O[mt] = (f32x4){0.f, 0.f, 0.f, 0.f};
#pragma unroll
                for (int ks = 0; ks < 2; ++ks) {
                    const int fo = (16 * mt + i16) * 128 + 16 * ((4 * ks + q4) ^ (i16 & 7));
                    O[mt] = __builtin_amdgcn_mfma_f32_16x16x32_bf16(*(const LAS bf16x8*)(sb + 8192 + fo), Sb[ks], O[mt], 0, 0, 0);
                    O[mt] = __builtin_amdgcn_mfma_f32_16x16x32_bf16(*(const LAS bf16x8*)(sb + 16384 + fo), Vb[ks], O[mt], 0, 0, 0);
                }
            }
#pragma unroll
            for (int mt = 0; mt < 4; ++mt) {
                S[mt] = S[mt] * gam;
#pragma unroll
                for (int ks = 0; ks < 2; ++ks) S[mt] = __builtin_amdgcn_mfma_f32_16x16x32_bf16(*(const LAS bf16x8*)(sb + 24576 + (16 * mt + i16) * 128 + 16 * ((4 * ks + q4) ^ (i16 & 7))), Vb[ks], S[mt], 0, 0, 0);
            }
            float* og = a.goraw() + ((size_t)b * SEQ + n * 64 + 4 * q4) * 512 + h * 64 + 16 * sl + i16;
#pragma unroll
            for (int mt = 0; mt < 4; ++mt)
#pragma unroll
                for (int r = 0; r < 4; ++r) og[(size_t)(16 * mt + r) * 512] = O[mt][r];
        }
    }
    if (!loader) {
        float* so = a.out + O_GSP + ((size_t)bh * 64 + 4 * q4) * 64 + 16 * sl + i16;
#pragma unroll
        for (int mt = 0; mt < 4; ++mt)
#pragma unroll
            for (int r = 0; r < 4; ++r) so[(size_t)(16 * mt + r) * 64] = S[mt][r];
    }
    __syncthreads();
}
__device__ __forceinline__ void gdn_out_item(const MK& a, int idx, int lane) {
    const int row = idx >> 3, h = idx & 7;
    const float ov = a.goraw()[(size_t)row * 512 + h * 64 + lane];
    const float ss = wave_sum(ov * ov);
    const float on = ov * rsqrtf(ss * (1.f / 64.f) + EPSV) * a.g_gdn_out[lane];
    const float zg = bf2f(a.Z()[(size_t)row * ZW + OFF_Z + h * 64 + lane]);
    a.omix()[(size_t)row * 1024 + h * 64 + lane] = f2bf(on * siluf_(zg));
}

#define SROW 1040
#define SSLOT (32 * SROW)
#define KR_OFF (4 * SSLOT)
#define WQ_OFF (KR_OFF + 4 * 4096)
#define QR_OFF (WQ_OFF + 2048)
#define PG_OFF (QR_OFF + 1024)
#define SAMP_LDS_END (PG_OFF + 64)
__device__ __forceinline__ void samp_issue(const MK& a, int g, LAS unsigned char* lds, const int* PG, int wid, int lane) {
    const int phys = __builtin_amdgcn_readfirstlane(((const LAS int*)(lds + PG_OFF))[g >> 2]);
    const int tok0 = (g & 3) * 32 + 4 * wid, slot = g & 3;
    const float* cs = a.cache_ckv + ((size_t)phys * 128 + tok0) * 256 + lane * 4;
#pragma unroll
    for (int i = 0; i < 4; ++i) __builtin_amdgcn_global_load_lds((const unsigned*)(cs + i * 256), (LAS unsigned*)(lds + slot * SSLOT + (4 * wid + i) * SROW), 16, 0, 0);
    const float* ks = a.cache_krope + ((size_t)phys * 128 + tok0 + (lane >> 5)) * 32 + (lane & 31);
#pragma unroll
    for (int i = 0; i < 2; ++i) __builtin_amdgcn_global_load_lds((const unsigned*)(ks + i * 64), (LAS unsigned*)(lds + KR_OFF + slot * 4096 + (4 * wid + 2 * i) * 128), 4, 0, 0);
}
__device__ __forceinline__ void samp_attn_unit(const MK& a, int u, char* smem, LAS unsigned char* lds) {
    const int tid = otid(), lane = tid & 63, h = __builtin_amdgcn_readfirstlane(tid >> 6), i16 = lane & 15, q4 = lane >> 4;
    const int b = u >> 3, sp = u & 7;
    float* WQ = (float*)(smem + WQ_OFF);
    float* QR = (float*)(smem + QR_OFF);
    int* PG = (int*)(smem + PG_OFF);
    const float SCL = 0.14724445f;
    post_q_item(a, (NPT + b) * 8 + h, lane);
    __syncthreads();
    {
        const int h_ = tid >> 6, l_ = tid & 63, q4_ = l_ >> 4, idx = l_ & 15, d = 16 * (idx >> 2) + 4 * q4_ + (idx & 3);
        WQ[tid] = a.g_k_nope[d] * a.qh()[((size_t)(NPT + b) * 8 + h_) * 96 + d] * SCL;
        if (tid < 256) QR[tid] = a.qh()[((size_t)(NPT + b) * 8 + (tid >> 5)) * 96 + 64 + (tid & 31)] * SCL;
        if (tid < 16) PG[tid] = a.page_table[b * NPAGES + sp * 16 + tid];
    }
    bf16x8 wf[4][8];
#pragma unroll
    for (int mt = 0; mt < 4; ++mt)
#pragma unroll
        for (int ks = 0; ks < 8; ++ks) wf[mt][ks] = *(const bf16x8*)(a.WknT() + (size_t)(h * 64 + 16 * mt + i16) * 256 + 32 * ks + 8 * q4);
#pragma unroll
    for (int mt = 0; mt < 4; ++mt)
#pragma unroll
        for (int ks = 0; ks < 8; ++ks) asm volatile("" : "+v"(wf[mt][ks]));
    __syncthreads();
    samp_issue(a, 0, lds, PG, h, lane); samp_issue(a, 1, lds, PG, h, lane); samp_issue(a, 2, lds, PG, h, lane);
    const LAS float* QRl = (const LAS float*)(lds + QR_OFF) + h * 32 + 8 * q4;
    const LAS float* WQl = (const LAS float*)(lds + WQ_OFF) + (h * 4 + q4) * 16;
    float m = -INFINITY, lsum = 0.f, lat0 = 0.f, lat1 = 0.f, lat2 = 0.f, lat3 = 0.f;
    for (int g = 0; g < 64; ++g) {
        if (g <= 61) asm volatile("s_waitcnt vmcnt(12)" ::: "memory"); else if (g == 62) asm volatile("s_waitcnt vmcnt(6)" ::: "memory"); else asm volatile("s_waitcnt vmcnt(0)" ::: "memory");
        asm volatile("s_waitcnt lgkmcnt(0)" ::: "memory"); __builtin_amdgcn_s_barrier(); asm volatile("" ::: "memory");
        if (g + 3 < 64) samp_issue(a, g + 3, lds, PG, h, lane);
        const LAS float* Cs = (const LAS float*)(lds + (g & 3) * SSLOT); const LAS float* KR = (const LAS float*)(lds + KR_OFF + (g & 3) * 4096);
        float sc[2];
#pragma unroll
        for (int hf = 0; hf < 2; ++hf) {
            f32x4 acc[4];
#pragma unroll
            for (int mt = 0; mt < 4; ++mt) acc[mt] = (f32x4){0.f, 0.f, 0.f, 0.f};
            const LAS float* cp = Cs + (16 * hf + i16) * (SROW / 4) + 8 * q4;
#pragma unroll
            for (int ks = 0; ks < 8; ++ks) {
                const f32x4 f0 = *(const LAS f32x4*)(cp + 32 * ks), f1 = *(const LAS f32x4*)(cp + 32 * ks + 4);
                u32x4 w; w.x = cvtpk(f0[0], f0[1]); w.y = cvtpk(f0[2], f0[3]); w.z = cvtpk(f1[0], f1[1]); w.w = cvtpk(f1[2], f1[3]);
                const bf16x8 cf = __builtin_bit_cast(bf16x8, w);
#pragma unroll
                for (int mt = 0; mt < 4; ++mt) acc[mt] = __builtin_amdgcn_mfma_f32_16x16x32_bf16(wf[mt][ks], cf, acc[mt], 0, 0, 0);
            }
            float ss = 0.f, dot = 0.f, rd = 0.f;
#pragma unroll
            for (int mt = 0; mt < 4; ++mt) {
                const f32x4 wq = *(const LAS f32x4*)(WQl + 4 * mt);
                ss += acc[mt][0] * acc[mt][0] + acc[mt][1] * acc[mt][1] + acc[mt][2] * acc[mt][2] + acc[mt][3] * acc[mt][3];
                dot += acc[mt][0] * wq[0] + acc[mt][1] * wq[1] + acc[mt][2] * wq[2] + acc[mt][3] * wq[3];
            }
            {
                const LAS float* kp = KR + (16 * hf + i16) * 32 + 8 * q4;
                const f32x4 k0 = *(const LAS f32x4*)kp, k1 = *(const LAS f32x4*)(kp + 4), q0 = *(const LAS f32x4*)QRl, q1 = *(const LAS f32x4*)(QRl + 4);
                rd = k0[0] * q0[0] + k0[1] * q0[1] + k0[2] * q0[2] + k0[3] * q0[3] + k1[0] * q1[0] + k1[1] * q1[1] + k1[2] * q1[2] + k1[3] * q1[3];
            }
            ss += __shfl_xor(ss, 16); dot += __shfl_xor(dot, 16); rd += __shfl_xor(rd, 16);
            ss += __shfl_xor(ss, 32); dot += __shfl_xor(dot, 32); rd += __shfl_xor(rd, 32);
            sc[hf] = dot * rsqrtf(ss * (1.f / 64.f) + EPSV) + rd;
        }
        float gm = fmaxf(sc[0], sc[1]);
#pragma unroll
        for (int o = 1; o < 16; o <<= 1) gm = fmaxf(gm, __shfl_xor(gm, o));
        const float mn = fmaxf(m, gm);
        const float alpha = __builtin_amdgcn_exp2f(m - mn), p0 = __builtin_amdgcn_exp2f(sc[0] - mn), p1 = __builtin_amdgcn_exp2f(sc[1] - mn);
        m = mn;
        lsum = lsum * alpha + p0 + p1;
        lat0 *= alpha; lat1 *= alpha; lat2 *= alpha; lat3 *= alpha;
#pragma unroll 4
        for (int t = 0; t < 16; ++t) {
            const float pa = __uint_as_float(__builtin_amdgcn_readlane(__float_as_uint(p0), t)), pb_ = __uint_as_float(__builtin_amdgcn_readlane(__float_as_uint(p1), t));
            const f32x4 ca = *(const LAS f32x4*)(Cs + t * (SROW / 4) + 4 * lane), cb = *(const LAS f32x4*)(Cs + (16 + t) * (SROW / 4) + 4 * lane);
            lat0 += pa * ca[0] + pb_ * cb[0]; lat1 += pa * ca[1] + pb_ * cb[1]; lat2 += pa * ca[2] + pb_ * cb[2]; lat3 += pa * ca[3] + pb_ * cb[3];
        }
    }
#pragma unroll
    for (int o = 1; o < 16; o <<= 1) lsum += __shfl_xor(lsum, o);
    float* o = a.part() + ((size_t)u * 8 + h) * 260;
    *(float4*)(o + 4 + 4 * lane) = (float4){lat0, lat1, lat2, lat3};
    if (lane == 0) { o[0] = m * 0.69314718f; o[1] = lsum; }
}
__device__ __forceinline__ void samp_comb_unit(const MK& a, int u, char* smem) {
    float* slat = (float*)smem;
    const int b = u >> 3, h = u & 7, tid = otid() & 255;
    const size_t row = NPT + b;
    const float* q = a.qh() + (row * 8 + h) * 96;
    float s_self = 0.f;
    for (int d = 0; d < 64; ++d) s_self += q[d] * a.kh()[(row * 8 + h) * 64 + d];
    for (int d = 0; d < 32; ++d) s_self += q[64 + d] * a.krf()[row * 32 + d];
    s_self *= 0.10206207261596577f;
    float m = s_self;
    for (int s = 0; s < 8; ++s) m = fmaxf(m, a.part()[((size_t)(b * 8 + s) * 8 + h) * 260]);
    const float pself = expf(s_self - m);
    float l = pself, lat = 0.f;
    for (int s = 0; s < 8; ++s) {
        const float* p = a.part() + ((size_t)(b * 8 + s) * 8 + h) * 260;
        const float w = expf(p[0] - m);
        l += p[1] * w; lat += p[4 + tid] * w;
    }
    __syncthreads();
    slat[tid] = lat;
    __syncthreads();
    if (tid < 64) {
        float o = 0.f;
        for (int c = 0; c < 256; ++c) o += slat[c] * a.w_kv_b[(size_t)c * 1024 + h * 128 + 64 + tid];
        o += pself * a.KV()[row * 1024 + h * 128 + 64 + tid];
        a.omix()[row * 1024 + 512 + h * 64 + tid] = f2bf(o / l);
    }
}

#define LDS_BYTES 155648
static_assert(SAMP_LDS_END <= LDS_BYTES, "LDS map");
#define GSYNC() do { grid.sync(); } while (0)
__global__ __launch_bounds__(NTHR, 2) void mega(MK a) {
    cg::grid_group grid = cg::this_grid();
    char* smem = (char*)lds_raw;
    LAS unsigned char* lds = (LAS unsigned char*)lds_raw;
    otid_init();
    __syncthreads();
    const int bid = blockIdx.x, nb = gridDim.x, ngw = nb * NWAVE;
#define LOCAL_IDS const int tid = otid(), lane = tid & 63, wid = tid >> 6, half = tid >> 8, gw = bid * NWAVE + wid; (void)lane; (void)half; (void)gw; (void)wid;

    {
    LOCAL_IDS
    {
        const int T0 = 88 * 32, T1 = 24 * 12, T2 = 32 * 8, T3 = 16 * 8, T4 = 32 * 32, T5 = 176 * 32, T7 = 32 * 88, T8 = 32 * 32, T9 = 32 * 8;
        const int TT = T0 + T1 + T2 + T3 + T4 + T5 + T7 + T8 + T9;
        float* t = (float*)(smem + half * 8192);
        for (int it0 = bid * 2; it0 < TT; it0 += nb * 2) {
            const int it = it0 + half; const bool act = it < TT;
            int r = act ? it : 0;
            if (r < T0) { wt_tile(act, a.w_in, a.WinT(), 2736, 0, 2736, 1024, r % 88, r / 88, t); continue; } r -= T0;
            if (r < T1) { wt_tile(act, a.w_q_b, a.WqbT(), 768, 0, 768, 384, r % 24, r / 24, t); continue; } r -= T1;
            if (r < T2) { wt_tile(act, a.w_kv_b, a.WkvT(), 1024, 0, 1024, 256, r % 32, r / 32, t); continue; } r -= T2;
            if (r < T3) { const int nbk = r % 16, kb = r / 16, h = nbk >> 1; wt_tile(act, a.w_kv_b, a.WknT() + (size_t)h * 64 * 256, 1024, h * 128, 64, 256, nbk & 1, kb, t); continue; } r -= T3;
            if (r < T4) { wt_tile(act, a.w_o, a.WoT(), 1024, 0, 1024, 1024, r % 32, r / 32, t); continue; } r -= T4;
            if (r < T5) { const int nbk = r % 176, kb = r / 176, pn = nbk >> 3, wi = nbk & 7;
                wt_tile(act, wi < 4 ? a.w_gate : a.w_up, a.WguT() + (size_t)nbk * 32 * 1024, DFF, pn * 128 + (wi & 3) * 32, 32, 1024, 0, kb, t); continue; } r -= T5;
            if (r < T7) { wt_tile(act, a.w_down, a.WdT(), 1024, 0, 1024, DFF, r % 32, r / 32, t); continue; } r -= T7;
            if (r < T8) { wt_tile(act, a.w_ple_gate, a.WpgT(), 1024, 0, 1024, 1024, r % 32, r / 32, t); continue; } r -= T8;
            wt_tile(act, a.w_ple_proj, a.WppT(), 1024, 0, 1024, 256, r % 32, r / 32, t);
        }
        for (int e = (bid * NTHR + tid); e < 2049 * 16; e += nb * NTHR) {
            const int pos = e >> 4, i = e & 15; const float ang = (pos == 2048 ? (float)PAST : (float)pos) * powf(10000.f, -(float)i / 16.f);
            a.ropecs()[pos * 32 + i] = cosf(ang); a.ropecs()[pos * 32 + 16 + i] = sinf(ang);
        }
        for (int row = gw; row < MPAD; row += ngw) {
            const float* src = row < NPT ? a.x_prompt + (size_t)row * 1024 : a.x_sample + (size_t)(row < NTOK ? row - NPT : 0) * 1024;
            rms1024_row(src, a.g_attn, a.xn() + (size_t)row * 1024, row >= NTOK, lane);
            ushort4 w = {0, 0, 0, 0};
            if (row < NTOK) { const float* ps = row < NPT ? a.p_prompt + (size_t)row * 256 : a.p_sample + (size_t)(row - NPT) * 256; const float4 v = *(const float4*)(ps + lane * 4); w.x = f2bf(v.x); w.y = f2bf(v.y); w.z = f2bf(v.z); w.w = f2bf(v.w); }
            *(ushort4*)(a.pb() + (size_t)row * 256 + lane * 4) = w;
            if (row >= NTOK) { for (int j = 0; j < 4; ++j) { ushort4 z = {0, 0, 0, 0}; *(ushort4*)(a.omix() + (size_t)row * 1024 + lane * 4 + 256 * j) = z; } }
        }
    }
    }
    GSYNC();
    {
    LOCAL_IDS
    pg_gemm(lds, a.xn(), a.WinT(), NPT, ZW, 1024, PgBf16{a.Z(), ZW});
    pg_gemm(lds, a.pb(), a.WppT(), NPT, 1024, 256, PgF32{a.PP(), 1024});
    gemm_sample_rows(a.xn(), 1024, a.WinT(), 1024, ZW, EwBf16{a.Z(), ZW}, smem, bid, nb);
    gemm_sample_rows(a.pb(), 256, a.WppT(), 256, 1024, EwF32{a.PP(), 1024}, smem, bid, nb);
    }
    GSYNC();
    {
    LOCAL_IDS
    for (int e = tid; e < 4 * 1536 / 4; e += NTHR) ((float4*)smem)[e] = ((const float4*)a.w_conv)[e];
    __syncthreads();
    for (int run = gw; run < NTOK / 8; run += ngw) post_in_run(a, run, lane, (const float*)smem);
    }
    GSYNC();
    {
    LOCAL_IDS
    for (int u = gw; u < 2048; u += ngw) gdn_prep_unit(a, u, lane, smem + wid * GDN_WLDS);
    }
    {
    LOCAL_IDS
    for (int v = gw; v < NST * 64; v += ngw) gdn_unit(a, v >> 6, (v >> 3) & 7, v & 7, a.state_gdn, a.out + O_GSS, NPT, 1, lane, smem + wid * GDN_WLDS);
    __syncthreads();
    }
    GSYNC();
    {
    LOCAL_IDS
    pg_gemm(lds, a.qan(), a.WqbT(), NPT, 768, 384, PgBf16{a.qraw(), 768});
    pg_gemm(lds, a.ckvb(), a.WkvT(), NPT, 1024, 256, PgBf16{a.kvraw(), 1024});
    gemm_sample_rows(a.qan(), 384, a.WqbT(), 384, 768, EwF32{a.Q(), 768}, smem, bid, nb);
    gemm_sample_rows(a.ckvb(), 256, a.WkvT(), 256, 1024, EwF32{a.KV(), 1024}, smem, bid, nb);
    for (int bh_ = nb - 1 - bid; bh_ < 64; bh_ += nb) gdn_scan_block(a, bh_, lds);
    }
    GSYNC();
    {
    LOCAL_IDS
    for (int idx = gw; idx < NST * 8; idx += ngw) { post_q_item(a, NPT * 8 + idx, lane); post_kv_item(a, NPT * 8 + idx, lane); }
    for (int idx = gw; idx < NTOK * 8; idx += ngw) gdn_out_item(a, idx, lane);
    for (int pr = bid; pr < 256; pr += nb) { const int bh_ = pr >> 2, s_ = pr & 3; attn_block(a, bh_ >> 3, bh_ & 7, 7 - s_, smem); attn_block(a, bh_ >> 3, bh_ & 7, s_, smem); }
    for (int u = bid; u < NST * 8; u += nb) samp_attn_unit(a, u, smem, lds);
    }
    GSYNC();
    {
    LOCAL_IDS
    for (int u0 = bid * 2; u0 < NST * 8; u0 += nb * 2) samp_comb_unit(a, u0 + half, smem + half * 4096);
    }
    GSYNC();
    {
    LOCAL_IDS
    pg_gemm(lds, a.omix(), a.WoT(), NPT, 1024, 1024, PgRes{a.x_prompt, a.H()});
    gemm_sample_rows(a.omix(), 1024, a.WoT(), 1024, 1024, EwResX{a.x_sample, a.H()}, smem, bid, nb);
    }
    GSYNC();
    {
    LOCAL_IDS
    for (int row = gw; row < MPAD; row += ngw) rms1024_row(a.H() + (size_t)row * 1024, a.g_ffn, a.un() + (size_t)row * 1024, row >= NTOK, lane);
    }
    GSYNC();
    {
    LOCAL_IDS
    pg_gemm(lds, a.un(), a.WguT(), NPT, 2 * DFF, 1024, PgSwiglu{a.hid()});
    gemm_sample_rows(a.un(), 1024, a.WguT(), 1024, 2 * DFF, EwSwiglu{a.G(), a.hid()}, smem, bid, nb);
    __threadfence(); __syncthreads();
    gemm_sample_rows(a.un(), 1024, a.WguT(), 1024, 2 * DFF, EwSwiglu2{a.G(), a.hid()}, smem, bid, nb);
    }
    GSYNC();
    {
    LOCAL_IDS
    pg_gemm(lds, a.hid(), a.WdT(), NPT, 1024, DFF, PgRes{a.H(), a.H2()});
    gemm_sample_rows(a.hid(), DFF, a.WdT(), DFF, 1024, EwResH{a.H(), a.H2()}, smem, bid, nb);
    }
    GSYNC();
    {
    LOCAL_IDS
    for (int row = gw; row < MPAD; row += ngw) rms1024_row(a.H2() + (size_t)row * 1024, a.g_ple, a.un2() + (size_t)row * 1024, row >= NTOK, lane);
    }
    GSYNC();
    {
    LOCAL_IDS
    pg_gemm(lds, a.un2(), a.WpgT(), NPT, 1024, 1024, PgPle{a.H2(), a.PP(), a.out});
    gemm_sample_rows(a.un2(), 1024, a.WpgT(), 1024, 1024, EwPle{a.H2(), a.PP(), a.out}, smem, bid, nb);
    }
}

static inline char* carve(char*& p, size_t bytes) { char* r = p; p += (bytes + 255) & ~(size_t)255; return r; }

extern "C" void kernel_launch(void* const* d_in, const int* in_sizes, int n_in, void* d_out, int out_size, void* d_ws, size_t ws_size, hipStream_t stream) {
    MK a{};
    a.x_prompt = (const float*)d_in[0]; a.x_sample = (const float*)d_in[1]; a.cache_ckv = (const float*)d_in[2]; a.cache_krope = (const float*)d_in[3];
    a.state_gdn = (const float*)d_in[4]; a.state_conv = (const float*)d_in[5]; a.page_table = (const int*)d_in[6]; a.p_prompt = (const float*)d_in[7]; a.p_sample = (const float*)d_in[8];
    a.g_attn = (const float*)d_in[9]; a.w_in = (const float*)d_in[10]; a.w_conv = (const float*)d_in[11]; a.a_log = (const float*)d_in[12]; a.dt_bias = (const float*)d_in[13];
    a.g_gdn_out = (const float*)d_in[14]; a.g_q_a = (const float*)d_in[15]; a.w_q_b = (const float*)d_in[16]; a.g_q_nope = (const float*)d_in[17]; a.g_q_rope = (const float*)d_in[18];
    a.g_kv_a = (const float*)d_in[19]; a.g_k_rope = (const float*)d_in[20]; a.w_kv_b = (const float*)d_in[21]; a.g_k_nope = (const float*)d_in[22]; a.w_o = (const float*)d_in[23];
    a.g_ffn = (const float*)d_in[24]; a.w_gate = (const float*)d_in[25]; a.w_up = (const float*)d_in[26]; a.w_down = (const float*)d_in[27]; a.g_ple = (const float*)d_in[28];
    a.w_ple_gate = (const float*)d_in[29]; a.w_ple_proj = (const float*)d_in[30];
    a.out = (float*)d_out;
    a.ws = (char*)d_ws;
    if (WS_TOTAL > ws_size) { fprintf(stderr, "kernel_launch: workspace too small: need %zu have %zu\n", (size_t)WS_TOTAL, ws_size); return; }

    static int grid_blocks = 0;
    if (!grid_blocks) {
        int dev = 0, cus = 0, per_cu = 0;
        (void)hipGetDevice(&dev);
        (void)hipDeviceGetAttribute(&cus, hipDeviceAttributeMultiprocessorCount, dev);
        (void)hipFuncSetAttribute((const void*)mega, hipFuncAttributeMaxDynamicSharedMemorySize, LDS_BYTES);
        (void)hipOccupancyMaxActiveBlocksPerMultiprocessor(&per_cu, (const void*)mega, NTHR, LDS_BYTES);
        if (per_cu < 1) fprintf(stderr, "kernel_launch: occupancy query says %d blocks/CU\n", per_cu);
        grid_blocks = cus;
    }
    void* args[] = {&a};
    hipError_t e = hipLaunchCooperativeKernel((const void*)mega, dim3(grid_blocks), dim3(NTHR), args, LDS_BYTES, stream);
    if (e != hipSuccess) fprintf(stderr, "cooperative launch failed: %s (grid %d)\n", hipGetErrorString(e), grid_blocks);
}
```

```cpp
#include <hip/hip_runtime.h>
#include <stdint.h>
#include <cstdio>
#include <hip/hip_cooperative_groups.h>
namespace cg = cooperative_groups;


__device__ __forceinline__ int otid();
#define PG8_TID() otid()
namespace pg8 {
#define PG8_LAS __attribute__((address_space(3)))
typedef unsigned short bf16_t;
typedef short bf16x8 __attribute__((ext_vector_type(8)));
typedef float f32x4 __attribute__((ext_vector_type(4)));
typedef unsigned u32x4 __attribute__((ext_vector_type(4)));
constexpr int BM = 256, BK = 64, HALF = 128, HTB = HALF * BK * 2  , STAGE_BYTES = 8 * HTB, NXCD = 8, WGM = 8;

__host__ __device__ __forceinline__ int lds_byte(int r, int c) { const int st = (r >> 4) * 2 + (c >> 5), rr = r & 15, cc = c & 31, ob = rr * 64 + cc * 2; return st * 1024 + (ob ^ (((ob >> 9) & 1) << 5)); }
__host__ __device__ __forceinline__ void stage_rc(int b, int& R, int& C) { const int st = b / 1024, sb = b % 1024, swz = sb ^ (((sb >> 9) & 1) << 5); R = (st >> 1) * 16 + swz / 64; C = (st & 1) * 32 + (swz % 64) / 2; }
__host__ __device__ __forceinline__ int perm32(int rho) { const int n = rho >> 4, i = rho & 15; return 8 * (i >> 2) + 4 * n + (i & 3); }

struct Unit { int pm, pn; };
struct Gemm { const bf16_t* A; const bf16_t* Bt; int M, N, K; };

struct StaticOrder {
    int nM, nN, nwg, G, c;
    __host__ __device__ void init(int M, int N, int G_, int c_) { nM = M / BM; nN = N / BM; nwg = nM * nN; G = G_; c = c_; }
    __host__ __device__ bool next(int i, Unit& u) const {
        const long L = (long)i * G + c; if (L >= nwg) return false;
        int wgid = (int)L; { const int q = nwg / NXCD, r = nwg % NXCD, xcd = wgid % NXCD, off = wgid / NXCD; wgid = (xcd < r ? xcd * (q + 1) : r * (q + 1) + (xcd - r) * q) + off; }
        const int nig = WGM * nN, gid = wgid / nig, fm = gid * WGM, gsz = (nM - fm) < WGM ? (nM - fm) : WGM;
        u.pm = fm + ((wgid % nig) % gsz); u.pn = (wgid % nig) / gsz; return true;
    }
    __device__ __forceinline__ void a_ready(const Unit&) const {}
    __device__ __forceinline__ void done(const Unit&) const {}
};

template <class Epi, class Sched, bool ALIGN_EPI = false, bool SP2 = false>
__device__ __forceinline__ void gemm_phase(PG8_LAS unsigned char* lds, const Gemm g, const Sched& S, const Epi& E) {
    const int tid = PG8_TID(), wid = __builtin_amdgcn_readfirstlane(tid >> 6), lane = tid & 63, wr = wid >> 2, wc = wid & 3, fr = lane & 15, fq = lane >> 4;
    const int K = g.K, nt = K / BK;
    unsigned voffA[2], voffB[2];
#pragma unroll
    for (int i = 0; i < 2; ++i) { int R, C; stage_rc(tid * 16 + i * 8192, R, C); const int Rb = Epi::PERM ? ((R & ~31) + perm32(R & 31)) : R;
        voffA[i] = (unsigned)(R * K + C) * 2u; voffB[i] = (unsigned)(Rb * K + C) * 2u; }
    const size_t kstep = (size_t)(BK * 2);
    const size_t hstep = (size_t)HALF * K * 2;
    const size_t tstep = 2 * hstep;
    const unsigned ldsw = (unsigned)wid * 1024u;
    const int aoff = lds_byte(wr * 64 + fr, fq * 8), boff = lds_byte(wc * 32 + fr, fq * 8);
#define PG8_SA(b, h) (((b) * 2 + (h)) * HTB)
#define PG8_SB(b, h) ((4 + (b) * 2 + (h)) * HTB)
#define PG8_STAGE(bufoff, gbase, voff) do { _Pragma("unroll") for (int _i = 0; _i < 2; ++_i) \
        __builtin_amdgcn_global_load_lds((const unsigned*)((const char*)(gbase) + (voff)[_i]), (PG8_LAS unsigned*)(lds + (bufoff) + ldsw + _i * 8192), 16, 0, 0); } while (0)
#define PG8_LDA(dst, b, h) do { _Pragma("unroll") for (int m = 0; m < 4; ++m) _Pragma("unroll") for (int k = 0; k < 2; ++k) dst[m][k] = *(const PG8_LAS bf16x8*)(lds + PG8_SA(b, h) + aoff + m * 2048 + k * 1024); } while (0)
#define PG8_LDB(dst, b, h) do { _Pragma("unroll") for (int n = 0; n < 2; ++n) _Pragma("unroll") for (int k = 0; k < 2; ++k) dst[n][k] = *(const PG8_LAS bf16x8*)(lds + PG8_SB(b, h) + boff + n * 2048 + k * 1024); } while (0)
#define PG8_MMA(ai, bj, At, Bt) do { __builtin_amdgcn_s_setprio(1); _Pragma("unroll") for (int m = 0; m < 4; ++m) _Pragma("unroll") for (int n = 0; n < 2; ++n) _Pragma("unroll") for (int k = 0; k < 2; ++k) \
        acc[ai][bj][m][n] = __builtin_amdgcn_mfma_f32_16x16x32_bf16(Bt[n][k], At[m][k], acc[ai][bj][m][n], 0, 0, 0); __builtin_amdgcn_s_setprio(0); } while (0)
#define PG8_WAIT_V(n) asm volatile("s_waitcnt vmcnt(" #n ")" ::: "memory")
#define PG8_WAIT_L(n) asm volatile("s_waitcnt lgkmcnt(" #n ")" ::: "memory")
#define PG8_BAR __builtin_amdgcn_s_barrier()
#define PG8_SCHED __builtin_amdgcn_sched_barrier(0)
    Unit cur, nxt; int ui = 0;
    if (!S.next(0, cur)) return;
    f32x4 acc[2][2][4][2];
#pragma unroll
    for (int a = 0; a < 2; ++a)
#pragma unroll
        for (int b = 0; b < 2; ++b)
#pragma unroll
            for (int m = 0; m < 4; ++m)
#pragma unroll
                for (int n = 0; n < 2; ++n) acc[a][b][m][n] = (f32x4){0.f, 0.f, 0.f, 0.f};
    bf16x8 At[4][2], B0[2][2], B1[2][2];
    const char* cA = (const char*)g.A + (size_t)cur.pm * tstep; const char* cB = (const char*)g.Bt + (size_t)cur.pn * tstep;
    S.a_ready(cur);
    if constexpr (SP2) {
        PG8_STAGE(PG8_SB(0, 0), cB, voffB); PG8_STAGE(PG8_SB(0, 1), cB + hstep, voffB); PG8_STAGE(PG8_SA(0, 0), cA, voffA); PG8_STAGE(PG8_SA(0, 1), cA + hstep, voffA);
        if (wr == 1) PG8_BAR;
        PG8_WAIT_V(2); PG8_BAR;
        PG8_STAGE(PG8_SB(1, 0), cB + kstep, voffB); PG8_STAGE(PG8_SA(1, 0), cA + kstep, voffA); PG8_STAGE(PG8_SB(1, 1), cB + hstep + kstep, voffB);
        PG8_WAIT_V(6); PG8_BAR;
    } else {
        PG8_STAGE(PG8_SB(0, 0), cB, voffB); PG8_STAGE(PG8_SA(0, 0), cA, voffA); PG8_STAGE(PG8_SB(0, 1), cB + hstep, voffB); PG8_STAGE(PG8_SA(0, 1), cA + hstep, voffA);
        if (wr == 1) PG8_BAR;
        PG8_WAIT_V(4); PG8_BAR;
        PG8_STAGE(PG8_SB(1, 0), cB + kstep, voffB); PG8_STAGE(PG8_SA(1, 0), cA + kstep, voffA); PG8_STAGE(PG8_SB(1, 1), cB + hstep + kstep, voffB);
        PG8_WAIT_V(6); PG8_BAR;
    }
    for (;;) {
        const bool has_next = S.next(ui + 1, nxt);
        const char* nA = has_next ? (const char*)g.A + (size_t)nxt.pm * tstep : cA; const char* nB = has_next ? (const char*)g.Bt + (size_t)nxt.pn * tstep : cB;
        for (int t = 0; t < nt; t += 2) {
            const bool last = (t == nt - 2);
            const char* a1 = cA + (size_t)(t + 1) * kstep;
            const char* a2 = last ? nA : cA + (size_t)(t + 2) * kstep; const char* b2 = last ? nB : cB + (size_t)(t + 2) * kstep;
            const char* a3 = a2 + kstep; const char* b3 = b2 + kstep;
            if (last && has_next) S.a_ready(nxt);
            if constexpr (SP2) {
            PG8_LDB(B0, 0, 0); PG8_LDB(B1, 0, 1); PG8_SCHED; PG8_LDA(At, 0, 0); PG8_STAGE(PG8_SA(1, 1), a1 + hstep, voffA);
            PG8_WAIT_V(8); PG8_WAIT_L(0); PG8_BAR; PG8_MMA(0, 0, At, B0); PG8_MMA(0, 1, At, B1); PG8_BAR; PG8_SCHED;
            PG8_LDA(At, 0, 1); PG8_STAGE(PG8_SB(0, 0), b2, voffB); PG8_STAGE(PG8_SB(0, 1), b2 + hstep, voffB); PG8_STAGE(PG8_SA(0, 0), a2, voffA);
            PG8_WAIT_V(8); PG8_WAIT_L(0); PG8_BAR; PG8_MMA(1, 0, At, B0); PG8_MMA(1, 1, At, B1); PG8_BAR; PG8_SCHED;
            PG8_LDB(B0, 1, 0); PG8_LDB(B1, 1, 1); PG8_SCHED; PG8_LDA(At, 1, 0); PG8_STAGE(PG8_SA(0, 1), a2 + hstep, voffA);
            PG8_WAIT_V(8); PG8_WAIT_L(0); PG8_BAR; PG8_MMA(0, 0, At, B0); PG8_MMA(0, 1, At, B1); PG8_BAR; PG8_SCHED;
            PG8_LDA(At, 1, 1); PG8_STAGE(PG8_SB(1, 0), b3, voffB); PG8_STAGE(PG8_SB(1, 1), b3 + hstep, voffB); PG8_STAGE(PG8_SA(1, 0), a3, voffA);
            PG8_WAIT_V(8); PG8_WAIT_L(0); PG8_BAR; PG8_MMA(1, 0, At, B0); PG8_MMA(1, 1, At, B1); PG8_BAR; PG8_SCHED;
            } else {
            PG8_LDB(B0, 0, 0); PG8_SCHED; PG8_LDA(At, 0, 0); PG8_STAGE(PG8_SA(1, 1), a1 + hstep, voffA);
            PG8_WAIT_L(8); PG8_BAR; PG8_WAIT_L(0); PG8_MMA(0, 0, At, B0); PG8_BAR; PG8_SCHED;
            PG8_LDB(B1, 0, 1); PG8_STAGE(PG8_SB(0, 0), b2, voffB);
            PG8_BAR; PG8_WAIT_L(0); PG8_MMA(0, 1, At, B1); PG8_BAR;
            PG8_LDA(At, 0, 1); PG8_STAGE(PG8_SA(0, 0), a2, voffA);
            PG8_BAR; PG8_WAIT_L(0); PG8_MMA(1, 0, At, B0); PG8_BAR; PG8_SCHED;
            PG8_STAGE(PG8_SB(0, 1), b2 + hstep, voffB);
            PG8_WAIT_V(6); PG8_BAR; PG8_MMA(1, 1, At, B1); PG8_BAR;
            PG8_LDB(B0, 1, 0); PG8_SCHED; PG8_LDA(At, 1, 0); PG8_STAGE(PG8_SA(0, 1), a2 + hstep, voffA);
            PG8_WAIT_L(8); PG8_BAR; PG8_WAIT_L(0); PG8_MMA(0, 0, At, B0); PG8_BAR; PG8_SCHED;
            PG8_LDB(B1, 1, 1); PG8_STAGE(PG8_SB(1, 0), b3, voffB);
            PG8_BAR; PG8_WAIT_L(0); PG8_MMA(0, 1, At, B1); PG8_BAR;
            PG8_LDA(At, 1, 1); PG8_STAGE(PG8_SA(1, 0), a3, voffA);
            PG8_BAR; PG8_WAIT_L(0); PG8_MMA(1, 0, At, B0); PG8_BAR; PG8_SCHED;
            PG8_STAGE(PG8_SB(1, 1), b3 + hstep, voffB);
            PG8_WAIT_V(6); PG8_BAR; PG8_MMA(1, 1, At, B1); PG8_BAR;
            }
        }
        if constexpr (ALIGN_EPI) { if (wr == 0) PG8_BAR; }
        if constexpr (!Epi::AFTER_DRAIN) { E(acc, cur, wr, wc, fr, fq); S.done(cur); }
        if (!has_next) break;
#pragma unroll
        for (int a = 0; a < 2; ++a)
#pragma unroll
            for (int b = 0; b < 2; ++b)
#pragma unroll
                for (int m = 0; m < 4; ++m)
#pragma unroll
                    for (int n = 0; n < 2; ++n) acc[a][b][m][n] = (f32x4){0.f, 0.f, 0.f, 0.f};
        cur = nxt; cA = nA; cB = nB; ++ui;
        if constexpr (ALIGN_EPI) { if (wr == 1) PG8_BAR; }
    }
    PG8_WAIT_V(0);
    if constexpr (!ALIGN_EPI) { if (wr == 0) PG8_BAR; }
    PG8_BAR;
    if constexpr (Epi::AFTER_DRAIN) { E.fused(acc, cur, wr, wc, fr, fq, lds, wid, lane); S.done(cur); }
#undef PG8_SA
#undef PG8_SB
#undef PG8_STAGE
#undef PG8_LDA
#undef PG8_LDB
#undef PG8_MMA
#undef PG8_WAIT_V
#undef PG8_WAIT_L
#undef PG8_BAR
#undef PG8_SCHED
}
}

#define WTAB_OFF 155392
extern __shared__ __attribute__((aligned(16))) unsigned char lds_raw[];
__device__ __forceinline__ int hw_slot() { return (int)(__builtin_amdgcn_s_getreg((5 << 11) | 4) & 63u); }
__device__ __forceinline__ void otid_init() { const int t = threadIdx.x; if ((t & 63) == 0) ((__attribute__((address_space(3))) int*)(__attribute__((address_space(3))) void*)(lds_raw + WTAB_OFF))[hw_slot()] = t >> 6; }
__device__ __forceinline__ int otid() {
    const int w = __builtin_amdgcn_readfirstlane(((const __attribute__((address_space(3))) int*)(__attribute__((address_space(3))) void*)(lds_raw + WTAB_OFF))[hw_slot()]);
    int l; asm volatile("v_mbcnt_lo_u32_b32 %0, -1, 0\n\tv_mbcnt_hi_u32_b32 %0, -1, %0" : "=v"(l));
    return (w << 6) + l;
}
using pg8::bf16_t; using pg8::bf16x8; using pg8::f32x4; using pg8::u32x4;
#define LAS __attribute__((address_space(3)))

#define DMODEL 1024
#define NPT 16384
#define NST 32
#define NTOK 16416
#define MPAD 16640
#define SEQ 2048
#define ZW 2816
#define OFF_A 1536
#define OFF_B 1544
#define OFF_Z 1552
#define OFF_QA 2064
#define OFF_KVA 2448
#define OFF_KR 2704
#define DFF 2816
#define PAST 16384
#define NPAGES 128
#define EPSV 1e-6f

#define O_YP 0
#define O_YS (O_YP + 16777216)
#define O_CKVP (O_YS + 32768)
#define O_KRP (O_CKVP + 4194304)
#define O_GSP (O_KRP + 524288)
#define O_CSP (O_GSP + 262144)
#define O_CKVS (O_CSP + 36864)
#define O_KRS (O_CKVS + 8192)
#define O_GSS (O_KRS + 1024)
#define O_CSS (O_GSS + 1048576)

__device__ __forceinline__ bf16_t f2bf(float f) { unsigned u = __float_as_uint(f); return (bf16_t)((u + 0x7fffu + ((u >> 16) & 1u)) >> 16); }
__device__ __forceinline__ float bf2f(bf16_t b) { return __uint_as_float(((unsigned)b) << 16); }
__device__ __forceinline__ float wave_sum(float v) {
#pragma unroll
    for (int o = 1; o < 64; o <<= 1) v += __shfl_xor(v, o);
    return v;
}
__device__ __forceinline__ float sigmoidf_(float x) { return 1.f / (1.f + expf(-x)); }
__device__ __forceinline__ float siluf_(float x) { return x / (1.f + expf(-x)); }


#define WSYNC() do { __builtin_amdgcn_fence(__ATOMIC_ACQ_REL, "wavefront"); __builtin_amdgcn_wave_barrier(); } while (0)
#define NTHR 512
#define NWAVE 8

typedef float f32x2_t __attribute__((ext_vector_type(2)));
typedef __bf16 bf16x2_t __attribute__((ext_vector_type(2)));
__device__ __forceinline__ unsigned cvtpk(float lo, float hi) { f32x2_t v = {lo, hi}; bf16x2_t r = __builtin_convertvector(v, bf16x2_t); return __builtin_bit_cast(unsigned, r); }
__device__ __forceinline__ unsigned pk2bf(float lo, float hi) { return (unsigned)f2bf(lo) | ((unsigned)f2bf(hi) << 16); }

__device__ __forceinline__ void wt_item(const float* __restrict__ W, int ldw, int col0, int nvalid, bf16_t* __restrict__ WT, int ldt, int nrow0, int k0, float* scr, int lane) {
    WSYNC();
#pragma unroll 8
    for (int i = 0; i < 32; ++i) { const int kk = 2 * i + (lane >> 5), n = lane & 31; scr[kk * 33 + n] = n < nvalid ? W[(size_t)(k0 + kk) * ldw + col0 + n] : 0.f; }
    WSYNC();
    const int c = lane & 7;
#pragma unroll
    for (int j = 0; j < 4; ++j) { const int n = (lane >> 3) + 8 * j; const float* sp = scr + (8 * c) * 33 + n;
        u32x4 o; o.x = cvtpk(sp[0], sp[33]); o.y = cvtpk(sp[2 * 33], sp[3 * 33]); o.z = cvtpk(sp[4 * 33], sp[5 * 33]); o.w = cvtpk(sp[6 * 33], sp[7 * 33]);
        *(u32x4*)(WT + (size_t)(nrow0 + n) * ldt + k0 + 8 * c) = o; }
}

__device__ __forceinline__ void rms1024_row(const float* __restrict__ src, const float* __restrict__ g, bf16_t* __restrict__ o, bool zero, int lane) {
    if (zero) { for (int j = 0; j < 4; ++j) { ushort4 z = {0, 0, 0, 0}; *(ushort4*)(o + lane * 4 + 256 * j) = z; } return; }
    float4 v[4]; float ss = 0.f;
#pragma unroll
    for (int j = 0; j < 4; ++j) { v[j] = *(const float4*)(src + lane * 4 + 256 * j); ss += v[j].x * v[j].x + v[j].y * v[j].y + v[j].z * v[j].z + v[j].w * v[j].w; }
    ss = wave_sum(ss);
    const float rs = rsqrtf(ss * (1.f / 1024.f) + EPSV);
#pragma unroll
    for (int j = 0; j < 4; ++j) {
        const float4 gg = *(const float4*)(g + lane * 4 + 256 * j);
        ushort4 w; w.x = f2bf(v[j].x * rs * gg.x); w.y = f2bf(v[j].y * rs * gg.y); w.z = f2bf(v[j].z * rs * gg.z); w.w = f2bf(v[j].w * rs * gg.w);
        *(ushort4*)(o + lane * 4 + 256 * j) = w;
    }
}

struct ABf16 { const bf16_t* p; int lda; __device__ __forceinline__ bf16x8 load(int m, int k) const { return *(const bf16x8*)(p + (size_t)m * lda + k); } };
struct ACache {
    const float* cache; const int* pt;
    __device__ __forceinline__ bf16x8 load(int m, int k) const {
        const int b = m >> 14, t = m & 16383; const int phys = pt[b * NPAGES + (t >> 7)];
        const float* r = cache + ((size_t)phys * 128 + (t & 127)) * 256 + k;
        const float4 a = *(const float4*)r, c = *(const float4*)(r + 4);
        bf16x8 o; o[0] = (short)f2bf(a.x); o[1] = (short)f2bf(a.y); o[2] = (short)f2bf(a.z); o[3] = (short)f2bf(a.w);
        o[4] = (short)f2bf(c.x); o[5] = (short)f2bf(c.y); o[6] = (short)f2bf(c.z); o[7] = (short)f2bf(c.w); return o;
    }
};
template <class AL, class Epi>
__device__ __forceinline__ void gemm_tile_256x128(const AL& al, const bf16_t* __restrict__ Bt, int ldb, int K, const Epi& epi, int m0, int n0, char* smem) {
    bf16_t (*sA)[40] = (bf16_t (*)[40])smem;
    bf16_t (*sB)[40] = (bf16_t (*)[40])(smem + 20480);
    const int tid = otid(), lane = tid & 63, wid = tid >> 6, wm = wid >> 1, wn = wid & 1;
    f32x4 acc[4][4];
#pragma unroll
    for (int i = 0; i < 4; ++i)
#pragma unroll
        for (int j = 0; j < 4; ++j) acc[i][j] = (f32x4){0.f, 0.f, 0.f, 0.f};
    __syncthreads();
    for (int k0 = 0; k0 < K; k0 += 32) {
#pragma unroll
        for (int i = 0; i < 2; ++i) { const int ch = tid + 512 * i, r = ch >> 2, kc = (ch & 3) * 8; *(bf16x8*)&sA[r][kc] = al.load(m0 + r, k0 + kc); }
        { const int r = tid >> 2, kc = (tid & 3) * 8; *(bf16x8*)&sB[r][kc] = *(const bf16x8*)(Bt + (size_t)(n0 + r) * ldb + k0 + kc); }
        __syncthreads();
        bf16x8 af[4], bfr[4];
#pragma unroll
        for (int i = 0; i < 4; ++i) af[i] = *(const bf16x8*)&sA[wm * 64 + i * 16 + (lane & 15)][(lane >> 4) * 8];
#pragma unroll
        for (int j = 0; j < 4; ++j) bfr[j] = *(const bf16x8*)&sB[wn * 64 + j * 16 + (lane & 15)][(lane >> 4) * 8];
#pragma unroll
        for (int i = 0; i < 4; ++i)
#pragma unroll
            for (int j = 0; j < 4; ++j) acc[i][j] = __builtin_amdgcn_mfma_f32_16x16x32_bf16(af[i], bfr[j], acc[i][j], 0, 0, 0);
        __syncthreads();
    }
#pragma unroll
    for (int i = 0; i < 4; ++i)
#pragma unroll
        for (int j = 0; j < 4; ++j)
#pragma unroll
            for (int r = 0; r < 4; ++r) epi(m0 + wm * 64 + i * 16 + (lane >> 4) * 4 + r, n0 + wn * 64 + j * 16 + (lane & 15), acc[i][j][r]);
}
template <class Epi>
__device__ __forceinline__ void gemm_tile_32x256(const bf16_t* __restrict__ A, int lda, const bf16_t* __restrict__ Bt, int ldb, int K, const Epi& epi, int m0, int n0, char* smem) {
    bf16_t (*sA)[40] = (bf16_t (*)[40])smem;
    bf16_t (*sB)[40] = (bf16_t (*)[40])(smem + 2560);
    const int tid = otid(), lane = tid & 63, wid = tid >> 6;
    f32x4 acc[2][2];
#pragma unroll
    for (int i = 0; i < 2; ++i)
#pragma unroll
        for (int j = 0; j < 2; ++j) acc[i][j] = (f32x4){0.f, 0.f, 0.f, 0.f};
    __syncthreads();
    for (int k0 = 0; k0 < K; k0 += 32) {
        if (tid < 128) { const int r = tid >> 2, kc = (tid & 3) * 8; *(bf16x8*)&sA[r][kc] = *(const bf16x8*)(A + (size_t)(m0 + r) * lda + k0 + kc); }
#pragma unroll
        for (int i = 0; i < 2; ++i) { const int ch = tid + 512 * i, r = ch >> 2, kc = (ch & 3) * 8; *(bf16x8*)&sB[r][kc] = *(const bf16x8*)(Bt + (size_t)(n0 + r) * ldb + k0 + kc); }
        __syncthreads();
        bf16x8 af[2], bfr[2];
#pragma unroll
        for (int i = 0; i < 2; ++i) af[i] = *(const bf16x8*)&sA[i * 16 + (lane & 15)][(lane >> 4) * 8];
#pragma unroll
        for (int j = 0; j < 2; ++j) bfr[j] = *(const bf16x8*)&sB[wid * 32 + j * 16 + (lane & 15)][(lane >> 4) * 8];
#pragma unroll
        for (int i = 0; i < 2; ++i)
#pragma unroll
            for (int j = 0; j < 2; ++j) acc[i][j] = __builtin_amdgcn_mfma_f32_16x16x32_bf16(af[i], bfr[j], acc[i][j], 0, 0, 0);
        __syncthreads();
    }
#pragma unroll
    for (int i = 0; i < 2; ++i)
#pragma unroll
        for (int j = 0; j < 2; ++j)
#pragma unroll
            for (int r = 0; r < 4; ++r) epi(m0 + i * 16 + (lane >> 4) * 4 + r, n0 + wid * 32 + j * 16 + (lane & 15), acc[i][j][r]);
}
template <bool SWIGLU, class Epi>
__device__ __forceinline__ void gemm_sample_rows(const bf16_t* __restrict__ A, int lda, const bf16_t* __restrict__ Bt, int K, int N, const Epi& epi, char*  , int bid, int nb) {
    const int tid = otid(), lane = tid & 63, wid = tid >> 6, i16 = lane & 15, q4 = lane >> 4;
    for (int u = nb - 1 - bid; u < N / 256; u += nb) {
        const int n0 = u * 256;
        const int c0 = SWIGLU ? n0 + 16 * wid : n0 + 32 * wid, c1 = SWIGLU ? n0 + 128 + 16 * wid : n0 + 32 * wid + 16;
        const bf16_t* a0p = A + (size_t)(NPT + i16) * lda + 8 * q4; const bf16_t* a1p = a0p + (size_t)16 * lda;
        const bf16_t* b0p = Bt + (size_t)(c0 + i16) * K + 8 * q4; const bf16_t* b1p = Bt + (size_t)(c1 + i16) * K + 8 * q4;
        f32x4 acc[2][2];
#pragma unroll
        for (int i = 0; i < 2; ++i)
#pragma unroll
            for (int j = 0; j < 2; ++j) acc[i][j] = (f32x4){0.f, 0.f, 0.f, 0.f};
#pragma unroll 4
        for (int k0 = 0; k0 < K; k0 += 32) {
            const bf16x8 a0 = *(const bf16x8*)(a0p + k0), a1 = *(const bf16x8*)(a1p + k0), b0 = *(const bf16x8*)(b0p + k0), b1 = *(const bf16x8*)(b1p + k0);
            acc[0][0] = __builtin_amdgcn_mfma_f32_16x16x32_bf16(a0, b0, acc[0][0], 0, 0, 0); acc[0][1] = __builtin_amdgcn_mfma_f32_16x16x32_bf16(a0, b1, acc[0][1], 0, 0, 0);
            acc[1][0] = __builtin_amdgcn_mfma_f32_16x16x32_bf16(a1, b0, acc[1][0], 0, 0, 0); acc[1][1] = __builtin_amdgcn_mfma_f32_16x16x32_bf16(a1, b1, acc[1][1], 0, 0, 0);
        }
#pragma unroll
        for (int i = 0; i < 2; ++i)
#pragma unroll
            for (int r = 0; r < 4; ++r) {
                const int m = NPT + 16 * i + 4 * q4 + r;
                if constexpr (SWIGLU) epi(m, (n0 >> 1) + 16 * wid + i16, siluf_(acc[i][0][r]) * acc[i][1][r]);
                else { epi(m, c0 + i16, acc[i][0][r]); epi(m, c1 + i16, acc[i][1][r]); }
            }
    }
}
struct EwF32 { float* C; int ldc; __device__ __forceinline__ void operator()(int m, int n, float v) const { C[(size_t)m * ldc + n] = v; } };
struct EwBf16 { bf16_t* C; int ldc; __device__ __forceinline__ void operator()(int m, int n, float v) const { C[(size_t)m * ldc + n] = f2bf(v); } };
struct EwResX { const float* xs; float* C; __device__ __forceinline__ void operator()(int m, int n, float v) const { C[(size_t)m * 1024 + n] = xs[(size_t)(m - NPT) * 1024 + n] + v; } };
struct EwSwiglu {
    float* G; bf16_t* Hd;
    __device__ __forceinline__ void operator()(int m, int n, float v) const {
        const int f = (n >> 8) * 128 + (n & 127);
        if ((n & 255) < 128) G[(size_t)(m - NPT) * DFF + f] = v;
    }
};
struct EwSwiglu2 {
    const float* G; bf16_t* Hd;
    __device__ __forceinline__ void operator()(int m, int n, float v) const {
        const int f = (n >> 8) * 128 + (n & 127);
        if ((n & 255) >= 128) Hd[(size_t)m * DFF + f] = f2bf(siluf_(G[(size_t)(m - NPT) * DFF + f]) * v);
    }
};
struct EwResH { const float* H; float* C; __device__ __forceinline__ void operator()(int m, int n, float v) const { C[(size_t)m * 1024 + n] = H[(size_t)m * 1024 + n] + v; } };
struct EwPle { const float* H2; const float* PP; float* out;
    __device__ __forceinline__ void operator()(int m, int n, float v) const { out[O_YS + (size_t)(m - NPT) * 1024 + n] = H2[(size_t)m * 1024 + n] + PP[(size_t)m * 1024 + n] * sigmoidf_(v); } };

struct PgBf16 {
    static constexpr bool PERM = true, AFTER_DRAIN = false; bf16_t* O; int ldc;
    __device__ __forceinline__ void operator()(const f32x4 (&acc)[2][2][4][2], const pg8::Unit& u, int wr, int wc, int fr, int fq) const {
#pragma unroll
        for (int ai = 0; ai < 2; ++ai)
#pragma unroll
            for (int m = 0; m < 4; ++m) { bf16_t* rowp = O + (size_t)(u.pm * 256 + ai * 128 + wr * 64 + m * 16 + fr) * ldc + u.pn * 256 + wc * 32 + 8 * fq;
#pragma unroll
                for (int bj = 0; bj < 2; ++bj) { const f32x4 v0 = acc[ai][bj][m][0], v1 = acc[ai][bj][m][1]; u32x4 w; w.x = pk2bf(v0[0], v0[1]); w.y = pk2bf(v0[2], v0[3]); w.z = pk2bf(v1[0], v1[1]); w.w = pk2bf(v1[2], v1[3]); *(u32x4*)(rowp + bj * 128) = w; } }
    }
};
struct PgF32 {
    static constexpr bool PERM = false, AFTER_DRAIN = false; float* O; int ldc;
    __device__ __forceinline__ void operator()(const f32x4 (&acc)[2][2][4][2], const pg8::Unit& u, int wr, int wc, int fr, int fq) const {
#pragma unroll
        for (int ai = 0; ai < 2; ++ai)
#pragma unroll
            for (int m = 0; m < 4; ++m) { float* rowp = O + (size_t)(u.pm * 256 + ai * 128 + wr * 64 + m * 16 + fr) * ldc + u.pn * 256 + wc * 32 + 4 * fq;
#pragma unroll
                for (int bj = 0; bj < 2; ++bj)
#pragma unroll
                    for (int n = 0; n < 2; ++n) *(f32x4*)(rowp + bj * 128 + n * 16) = acc[ai][bj][m][n]; }
    }
};
struct PgRes {
    static constexpr bool PERM = false, AFTER_DRAIN = false; const float* R; float* O;
    __device__ __forceinline__ void operator()(const f32x4 (&acc)[2][2][4][2], const pg8::Unit& u, int wr, int wc, int fr, int fq) const {
#pragma unroll
        for (int ai = 0; ai < 2; ++ai)
#pragma unroll
            for (int m = 0; m < 4; ++m) { const size_t off = (size_t)(u.pm * 256 + ai * 128 + wr * 64 + m * 16 + fr) * 1024 + u.pn * 256 + wc * 32 + 4 * fq;
#pragma unroll
                for (int bj = 0; bj < 2; ++bj)
#pragma unroll
                    for (int n = 0; n < 2; ++n) { const f32x4 r = *(const f32x4*)(R + off + bj * 128 + n * 16); *(f32x4*)(O + off + bj * 128 + n * 16) = r + acc[ai][bj][m][n]; } }
    }
};
struct PgSwiglu {
    static constexpr bool PERM = true, AFTER_DRAIN = false; bf16_t* Hd;
    __device__ __forceinline__ void operator()(const f32x4 (&acc)[2][2][4][2], const pg8::Unit& u, int wr, int wc, int fr, int fq) const {
#pragma unroll
        for (int ai = 0; ai < 2; ++ai)
#pragma unroll
            for (int m = 0; m < 4; ++m) { bf16_t* rowp = Hd + (size_t)(u.pm * 256 + ai * 128 + wr * 64 + m * 16 + fr) * DFF + u.pn * 128 + wc * 32 + 8 * fq;
                float h[8];
#pragma unroll
                for (int n = 0; n < 2; ++n)
#pragma unroll
                    for (int i = 0; i < 4; ++i) h[n * 4 + i] = siluf_(acc[ai][0][m][n][i]) * acc[ai][1][m][n][i];
                u32x4 w; w.x = pk2bf(h[0], h[1]); w.y = pk2bf(h[2], h[3]); w.z = pk2bf(h[4], h[5]); w.w = pk2bf(h[6], h[7]); *(u32x4*)rowp = w; }
    }
};
struct PgPle {
    static constexpr bool PERM = false, AFTER_DRAIN = false; const float* H2; const float* PP; float* out;
    __device__ __forceinline__ void operator()(const f32x4 (&acc)[2][2][4][2], const pg8::Unit& u, int wr, int wc, int fr, int fq) const {
#pragma unroll
        for (int ai = 0; ai < 2; ++ai)
#pragma unroll
            for (int m = 0; m < 4; ++m) { const size_t off = (size_t)(u.pm * 256 + ai * 128 + wr * 64 + m * 16 + fr) * 1024 + u.pn * 256 + wc * 32 + 4 * fq;
#pragma unroll
                for (int bj = 0; bj < 2; ++bj)
#pragma unroll
                    for (int n = 0; n < 2; ++n) { const f32x4 h = *(const f32x4*)(H2 + off + bj * 128 + n * 16), pp = *(const f32x4*)(PP + off + bj * 128 + n * 16), a = acc[ai][bj][m][n]; f32x4 y;
#pragma unroll
                        for (int i = 0; i < 4; ++i) y[i] = h[i] + pp[i] * sigmoidf_(a[i]);
                        *(f32x4*)(out + O_YP + off + bj * 128 + n * 16) = y; } }
    }
};
template <class Epi>
__device__ __forceinline__ void pg_gemm(LAS unsigned char* lds, const bf16_t* A, const bf16_t* Bt, int M, int N, int K, const Epi& E) {
    pg8::Gemm g{A, Bt, M, N, K}; pg8::StaticOrder S; S.init(M, N, (int)gridDim.x, (int)blockIdx.x);
    pg8::gemm_phase<Epi, pg8::StaticOrder, true, true>(lds, g, S, E);
}

constexpr size_t WOF_WinT = 0ull;
constexpr size_t WOF_WqbT = 5767168ull;
constexpr size_t WOF_WkvT = 6356992ull;
constexpr size_t WOF_WknT = 6881280ull;
constexpr size_t WOF_WoT = 7143424ull;
constexpr size_t WOF_WguT = 9240576ull;
constexpr size_t WOF_WdT = 20774912ull;
constexpr size_t WOF_WpgT = 26542080ull;
constexpr size_t WOF_WppT = 28639232ull;
constexpr size_t WOF_xn = 29163520ull;
constexpr size_t WOF_pb = 63242240ull;
constexpr size_t WOF_Z = 71761920ull;
constexpr size_t WOF_qkv = 165478400ull;
constexpr size_t WOF_ropecs = 216596480ull;
constexpr size_t WOF_gg = 216858880ull;
constexpr size_t WOF_bb = 217391360ull;
constexpr size_t WOF_goraw = 217923840ull;
constexpr size_t WOF_gUT = 252002560ull;
constexpr size_t WOF_ggam = 285556992ull;
constexpr size_t WOF_gWn = 285565184ull;
constexpr size_t WOF_gQg = 302342400ull;
constexpr size_t WOF_gQK = 319119616ull;
constexpr size_t WOF_gKd = 335896832ull;
constexpr size_t WOF_qan = 352674048ull;
constexpr size_t WOF_ckvb = 365453568ull;
constexpr size_t WOF_krf = 373973248ull;
constexpr size_t WOF_Q = 376103168ull;
constexpr size_t WOF_qh = 427221248ull;
constexpr size_t WOF_KV = 478339328ull;
constexpr size_t WOF_kh = 546496768ull;
constexpr size_t WOF_omix = 580575488ull;
constexpr size_t WOF_KN = 614654208ull;
constexpr size_t WOF_SC = 1151525120ull;
constexpr size_t WOF_part = 1168302336ull;
constexpr size_t WOF_H = 1170432256ull;
constexpr size_t WOF_un = 1238589696ull;
constexpr size_t WOF_G = 1272668416ull;
constexpr size_t WOF_hid = 1273028864ull;
constexpr size_t WOF_H2 = 1366745344ull;
constexpr size_t WOF_un2 = 1434902784ull;
constexpr size_t WOF_PP = 1468981504ull;
constexpr size_t WOF_qraw = 1537138944ull;
constexpr size_t WOF_kvraw = 1562304768ull;
constexpr size_t WOF_krb = 1595859200ull;
constexpr size_t WOF_ctl = 1596907776ull;
constexpr size_t WS_TOTAL = 1596924160ull;
struct MK {
    const float *x_prompt, *x_sample, *cache_ckv, *cache_krope, *state_gdn, *state_conv; const int* page_table; const float *p_prompt, *p_sample;
    const float *g_attn, *w_in, *w_conv, *a_log, *dt_bias, *g_gdn_out, *g_q_a, *w_q_b, *g_q_nope, *g_q_rope, *g_kv_a, *g_k_rope, *w_kv_b, *g_k_nope, *w_o, *g_ffn, *w_gate, *w_up, *w_down, *g_ple, *w_ple_gate, *w_ple_proj;
    float* out; char* ws;
    __device__ __forceinline__ unsigned* ctl() const { return (unsigned*)(ws + WOF_ctl); }
    __device__ __forceinline__ bf16_t* WinT() const { return (bf16_t*)(ws + WOF_WinT); }
    __device__ __forceinline__ bf16_t* WqbT() const { return (bf16_t*)(ws + WOF_WqbT); }
    __device__ __forceinline__ bf16_t* WkvT() const { return (bf16_t*)(ws + WOF_WkvT); }
    __device__ __forceinline__ bf16_t* WknT() const { return (bf16_t*)(ws + WOF_WknT); }
    __device__ __forceinline__ bf16_t* WoT() const { return (bf16_t*)(ws + WOF_WoT); }
    __device__ __forceinline__ bf16_t* WguT() const { return (bf16_t*)(ws + WOF_WguT); }
    __device__ __forceinline__ bf16_t* WdT() const { return (bf16_t*)(ws + WOF_WdT); }
    __device__ __forceinline__ bf16_t* WpgT() const { return (bf16_t*)(ws + WOF_WpgT); }
    __device__ __forceinline__ bf16_t* WppT() const { return (bf16_t*)(ws + WOF_WppT); }
    __device__ __forceinline__ bf16_t* xn() const { return (bf16_t*)(ws + WOF_xn); }
    __device__ __forceinline__ bf16_t* pb() const { return (bf16_t*)(ws + WOF_pb); }
    __device__ __forceinline__ bf16_t* Z() const { return (bf16_t*)(ws + WOF_Z); }
    __device__ __forceinline__ bf16_t* qkv() const { return (bf16_t*)(ws + WOF_qkv); }
    __device__ __forceinline__ float* ropecs() const { return (float*)(ws + WOF_ropecs); }
    __device__ __forceinline__ float* gg() const { return (float*)(ws + WOF_gg); }
    __device__ __forceinline__ float* bb() const { return (float*)(ws + WOF_bb); }
    __device__ __forceinline__ float* goraw() const { return (float*)(ws + WOF_goraw); }
    __device__ __forceinline__ float* gUT() const { return (float*)(ws + WOF_gUT); }
    __device__ __forceinline__ float* ggam() const { return (float*)(ws + WOF_ggam); }
    __device__ __forceinline__ bf16_t* gWn() const { return (bf16_t*)(ws + WOF_gWn); }
    __device__ __forceinline__ bf16_t* gQg() const { return (bf16_t*)(ws + WOF_gQg); }
    __device__ __forceinline__ bf16_t* gQK() const { return (bf16_t*)(ws + WOF_gQK); }
    __device__ __forceinline__ bf16_t* gKd() const { return (bf16_t*)(ws + WOF_gKd); }
    __device__ __forceinline__ bf16_t* qan() const { return (bf16_t*)(ws + WOF_qan); }
    __device__ __forceinline__ bf16_t* ckvb() const { return (bf16_t*)(ws + WOF_ckvb); }
    __device__ __forceinline__ float* krf() const { return (float*)(ws + WOF_krf); }
    __device__ __forceinline__ float* Q() const { return (float*)(ws + WOF_Q); }
    __device__ __forceinline__ float* qh() const { return (float*)(ws + WOF_qh); }
    __device__ __forceinline__ float* KV() const { return (float*)(ws + WOF_KV); }
    __device__ __forceinline__ float* kh() const { return (float*)(ws + WOF_kh); }
    __device__ __forceinline__ bf16_t* omix() const { return (bf16_t*)(ws + WOF_omix); }
    __device__ __forceinline__ bf16_t* KN() const { return (bf16_t*)(ws + WOF_KN); }
    __device__ __forceinline__ float* SC() const { return (float*)(ws + WOF_SC); }
    __device__ __forceinline__ float* part() const { return (float*)(ws + WOF_part); }
    __device__ __forceinline__ float* H() const { return (float*)(ws + WOF_H); }
    __device__ __forceinline__ bf16_t* un() const { return (bf16_t*)(ws + WOF_un); }
    __device__ __forceinline__ float* G() const { return (float*)(ws + WOF_G); }
    __device__ __forceinline__ bf16_t* hid() const { return (bf16_t*)(ws + WOF_hid); }
    __device__ __forceinline__ float* H2() const { return (float*)(ws + WOF_H2); }
    __device__ __forceinline__ bf16_t* un2() const { return (bf16_t*)(ws + WOF_un2); }
    __device__ __forceinline__ float* PP() const { return (float*)(ws + WOF_PP); }
    __device__ __forceinline__ bf16_t* qraw() const { return (bf16_t*)(ws + WOF_qraw); }
    __device__ __forceinline__ bf16_t* kvraw() const { return (bf16_t*)(ws + WOF_kvraw); }
    __device__ __forceinline__ bf16_t* krb() const { return (bf16_t*)(ws + WOF_krb); }
};

__device__ __forceinline__ float fast_sigmoid(float x) { return __builtin_amdgcn_rcpf(1.f + __builtin_amdgcn_exp2f(-1.44269504f * x)); }
__device__ __forceinline__ void bf8_to_f32(const bf16x8& v, float* o) {
#pragma unroll
    for (int e = 0; e < 8; ++e) o[e] = __uint_as_float(((unsigned)(unsigned short)v[e]) << 16);
}
__device__ __forceinline__ bf16x8 f32_to_bf8(const float* x) {
    u32x4 w; w.x = cvtpk(x[0], x[1]); w.y = cvtpk(x[2], x[3]); w.z = cvtpk(x[4], x[5]); w.w = cvtpk(x[6], x[7]);
    return __builtin_bit_cast(bf16x8, w);
}
__device__ __forceinline__ void post_in_token(const MK& a, int row, int lane, const float* wcs, const bf16x8 (&w0)[3], const bf16x8 (&w1)[3], const bf16x8 (&w2)[3], const bf16x8 (&wcur)[3]) {
    const bool samp = row >= NPT;
    const int b = samp ? row - NPT : row >> 11, t = samp ? 0 : row & 2047, hd = lane >> 3;
    const bf16_t* z = a.Z() + (size_t)row * ZW;
    float y[24];
#pragma unroll
    for (int c3 = 0; c3 < 3; ++c3) {
        float p0[8], p1[8], p2[8], cu[8];
        bf8_to_f32(w0[c3], p0); bf8_to_f32(w1[c3], p1); bf8_to_f32(w2[c3], p2); bf8_to_f32(wcur[c3], cu);
        const float* wp = wcs + 512 * c3 + 8 * lane;
        const float4 a0 = *(const float4*)wp, a1 = *(const float4*)(wp + 4), b0 = *(const float4*)(wp + 1536), b1 = *(const float4*)(wp + 1540);
        const float4 c0 = *(const float4*)(wp + 3072), c1 = *(const float4*)(wp + 3076), d0 = *(const float4*)(wp + 4608), d1 = *(const float4*)(wp + 4612);
        const float k0[8] = {a0.x, a0.y, a0.z, a0.w, a1.x, a1.y, a1.z, a1.w}, k1[8] = {b0.x, b0.y, b0.z, b0.w, b1.x, b1.y, b1.z, b1.w};
        const float k2[8] = {c0.x, c0.y, c0.z, c0.w, c1.x, c1.y, c1.z, c1.w}, k3[8] = {d0.x, d0.y, d0.z, d0.w, d1.x, d1.y, d1.z, d1.w};
#pragma unroll
        for (int e = 0; e < 8; ++e) { const int c = 8 * c3 + e; const float v = k0[e] * p0[e] + k1[e] * p1[e] + k2[e] * p2[e] + k3[e] * cu[e]; y[c] = v * fast_sigmoid(v); }
        __builtin_amdgcn_sched_barrier(0);
    }
    float sq = 0.f, sk = 0.f;
#pragma unroll
    for (int e = 0; e < 8; ++e) { sq += y[e] * y[e]; sk += y[8 + e] * y[8 + e]; }
    sq += __shfl_xor(sq, 1); sk += __shfl_xor(sk, 1); sq += __shfl_xor(sq, 2); sk += __shfl_xor(sk, 2); sq += __shfl_xor(sq, 4); sk += __shfl_xor(sk, 4);
    const float rq = rsqrtf(sq + EPSV) * 0.125f, rk = rsqrtf(sk + EPSV);
#pragma unroll
    for (int e = 0; e < 8; ++e) { y[e] *= rq; y[8 + e] *= rk; }
    bf16_t* qo = a.qkv() + (size_t)row * 1536 + 8 * lane;
    *(bf16x8*)qo = f32_to_bf8(y); *(bf16x8*)(qo + 512) = f32_to_bf8(y + 8); *(bf16x8*)(qo + 1024) = f32_to_bf8(y + 16);
    __builtin_amdgcn_sched_barrier(0);
    if (!samp && t >= SEQ - 3) {
        float* cso = a.out + O_CSP + ((size_t)b * 3 + (t - (SEQ - 3))) * 1536 + 8 * lane;
#pragma unroll
        for (int j = 0; j < 3; ++j) { float cu[8]; bf8_to_f32(wcur[j], cu); *(float4*)(cso + 512 * j) = (float4){cu[0], cu[1], cu[2], cu[3]}; *(float4*)(cso + 512 * j + 4) = (float4){cu[4], cu[5], cu[6], cu[7]}; }
    }
    __builtin_amdgcn_sched_barrier(0);
    if (lane < 16) {
        const float v = bf2f(z[OFF_A + lane]);
        if (lane < 8) { const float xx = v + a.dt_bias[lane]; const float sp = xx > 20.f ? xx : log1pf(expf(xx)); a.gg()[(size_t)row * 8 + lane] = -expf(a.a_log[lane]) * sp; }
        else a.bb()[(size_t)row * 8 + lane - 8] = 1.f / (1.f + expf(-v));
    }
    __builtin_amdgcn_sched_barrier(0);
    float qa[8], cv[8], kr[8];
    { bf16x8 t8 = {0, 0, 0, 0, 0, 0, 0, 0}; if (lane < 48) t8 = *(const bf16x8*)(z + OFF_QA + 8 * lane); bf8_to_f32(t8, qa); }
    { bf16x8 t8 = {0, 0, 0, 0, 0, 0, 0, 0}; if (lane < 32) t8 = *(const bf16x8*)(z + OFF_KVA + 8 * lane); bf8_to_f32(t8, cv); }
    { bf16x8 t8 = {0, 0, 0, 0, 0, 0, 0, 0}; if (lane >= 32 && lane < 36) t8 = *(const bf16x8*)(z + OFF_KR + 8 * (lane - 32)); bf8_to_f32(t8, kr); }
    float s1 = 0.f, s2 = 0.f, s3 = 0.f;
#pragma unroll
    for (int e = 0; e < 8; ++e) { s1 += qa[e] * qa[e]; s2 += cv[e] * cv[e]; s3 += kr[e] * kr[e]; }
#pragma unroll
    for (int o = 1; o < 64; o <<= 1) { s1 += __shfl_xor(s1, o); s2 += __shfl_xor(s2, o); s3 += __shfl_xor(s3, o); }
    const float r1 = rsqrtf(s1 * (1.f / 384.f) + EPSV), r2 = rsqrtf(s2 * (1.f / 256.f) + EPSV), r3 = rsqrtf(s3 * (1.f / 32.f) + EPSV);
    if (lane < 48) {
        const float4 g0 = *(const float4*)(a.g_q_a + 8 * lane), g1 = *(const float4*)(a.g_q_a + 8 * lane + 4);
        float o[8] = {qa[0] * r1 * g0.x, qa[1] * r1 * g0.y, qa[2] * r1 * g0.z, qa[3] * r1 * g0.w, qa[4] * r1 * g1.x, qa[5] * r1 * g1.y, qa[6] * r1 * g1.z, qa[7] * r1 * g1.w};
        *(bf16x8*)(a.qan() + (size_t)row * 384 + 8 * lane) = f32_to_bf8(o);
    }
    if (lane < 32) {
        const float4 g0 = *(const float4*)(a.g_kv_a + 8 * lane), g1 = *(const float4*)(a.g_kv_a + 8 * lane + 4);
        float o[8] = {cv[0] * r2 * g0.x, cv[1] * r2 * g0.y, cv[2] * r2 * g0.z, cv[3] * r2 * g0.w, cv[4] * r2 * g1.x, cv[5] * r2 * g1.y, cv[6] * r2 * g1.z, cv[7] * r2 * g1.w};
        *(bf16x8*)(a.ckvb() + (size_t)row * 256 + 8 * lane) = f32_to_bf8(o);
        float* co = samp ? a.out + O_CKVS + (size_t)b * 256 + 8 * lane : a.out + O_CKVP + (size_t)row * 256 + 8 * lane;
        *(float4*)co = (float4){o[0], o[1], o[2], o[3]}; *(float4*)(co + 4) = (float4){o[4], o[5], o[6], o[7]};
    }
    __builtin_amdgcn_sched_barrier(0);
    {
        const int c4 = (lane - 32) & 3;
        float xn[8], ot[8];
#pragma unroll
        for (int e = 0; e < 8; ++e) xn[e] = kr[e] * r3 * a.g_k_rope[8 * c4 + e];
#pragma unroll
        for (int e = 0; e < 8; ++e) ot[e] = __shfl_xor(xn[e], 2);
        if (lane >= 32 && lane < 36) {
            const float* tb = a.ropecs() + (size_t)(samp ? 2048 : t) * 32 + ((8 * c4) & 15);
            float o[8];
#pragma unroll
            for (int e = 0; e < 8; ++e) { const float cs = tb[e], sn = tb[16 + e]; o[e] = c4 < 2 ? xn[e] * cs - ot[e] * sn : ot[e] * sn + xn[e] * cs; }
            float* kf_ = a.krf() + (size_t)row * 32 + 8 * c4; *(float4*)kf_ = (float4){o[0], o[1], o[2], o[3]}; *(float4*)(kf_ + 4) = (float4){o[4], o[5], o[6], o[7]};
            float* ko = samp ? a.out + O_KRS + (size_t)b * 32 + 8 * c4 : a.out + O_KRP + (size_t)row * 32 + 8 * c4;
            *(float4*)ko = (float4){o[0], o[1], o[2], o[3]}; *(float4*)(ko + 4) = (float4){o[4], o[5], o[6], o[7]};
            if (!samp) *(bf16x8*)(a.krb() + (size_t)row * 32 + 8 * c4) = f32_to_bf8(o);
        }
    }
    (void)hd;
}
__device__ __forceinline__ void post_in_run(const MK& a, int run, int lane_in, const float* wcs) {
    int lane = lane_in; asm volatile("" : "+v"(lane));
    if (run < NPT / 8) {
        const int row0 = run * 8, t0 = row0 & 2047;
        bf16x8 w0[3], w1[3], w2[3], wcur[3];
#pragma unroll
        for (int c3 = 0; c3 < 3; ++c3) {
            const bf16x8 zz = {0, 0, 0, 0, 0, 0, 0, 0}; w0[c3] = zz; w1[c3] = zz; w2[c3] = zz;
            if (t0 > 0) { const bf16_t* zp = a.Z() + (size_t)(row0 - 3) * ZW + 512 * c3 + 8 * lane; w0[c3] = *(const bf16x8*)zp; w1[c3] = *(const bf16x8*)(zp + ZW); w2[c3] = *(const bf16x8*)(zp + 2 * ZW); }
        }
#pragma unroll 1
        for (int k = 0; k < 8; ++k) {
            const int row = row0 + k;
#pragma unroll
            for (int c3 = 0; c3 < 3; ++c3) wcur[c3] = *(const bf16x8*)(a.Z() + (size_t)row * ZW + 512 * c3 + 8 * lane);
            post_in_token(a, row, lane, wcs, w0, w1, w2, wcur);
#pragma unroll
            for (int c3 = 0; c3 < 3; ++c3) { w0[c3] = w1[c3]; w1[c3] = w2[c3]; w2[c3] = wcur[c3]; }
        }
    } else {
#pragma unroll 1
        for (int k = 0; k < 8; ++k) {
            const int bsm = (run - NPT / 8) * 8 + k, row = NPT + bsm;
            bf16x8 w0[3], w1[3], w2[3], wcur[3];
#pragma unroll
            for (int c3 = 0; c3 < 3; ++c3) {
                const float* sp = a.state_conv + (size_t)bsm * 3 * 1536 + 512 * c3 + 8 * lane;
                float* cso = a.out + O_CSS + (size_t)bsm * 3 * 1536 + 512 * c3 + 8 * lane;
                float t0_[8], t1_[8], t2_[8], tc_[8];
#pragma unroll
                for (int e = 0; e < 8; ++e) { t0_[e] = sp[e]; t1_[e] = sp[1536 + e]; t2_[e] = sp[2 * 1536 + e]; }
                wcur[c3] = *(const bf16x8*)(a.Z() + (size_t)row * ZW + 512 * c3 + 8 * lane); bf8_to_f32(wcur[c3], tc_);
#pragma unroll
                for (int e = 0; e < 8; ++e) { cso[e] = t1_[e]; cso[1536 + e] = t2_[e]; cso[2 * 1536 + e] = tc_[e]; }
                w0[c3] = f32_to_bf8(t0_); w1[c3] = f32_to_bf8(t1_); w2[c3] = f32_to_bf8(t2_);
            }
            post_in_token(a, row, lane, wcs, w0, w1, w2, wcur);
        }
    }
}

__device__ __forceinline__ void post_q_item(const MK& a, int idx, int lane) {
    const int row = idx >> 3, h = idx & 7;
    const float* q = a.Q() + (size_t)row * 768 + h * 96;
    float* o = a.qh() + ((size_t)row * 8 + h) * 96;
    const float v = q[lane];
    const float ss = wave_sum(v * v);
    o[lane] = v * rsqrtf(ss * (1.f / 64.f) + EPSV) * a.g_q_nope[lane];
    const float r = lane < 32 ? q[64 + lane] : 0.f;
    const float s2 = wave_sum(r * r);
    const float xn = lane < 32 ? r * rsqrtf(s2 * (1.f / 32.f) + EPSV) * a.g_q_rope[lane] : 0.f;
    const float other = __shfl_xor(xn, 16);
    const int i = lane & 15;
    const float* tb = a.ropecs() + (size_t)(row >= NPT ? 2048 : (row & 2047)) * 32;
    const float cs = tb[i], sn = tb[16 + i];
    const float ov = lane < 16 ? xn * cs - other * sn : other * sn + xn * cs;
    if (lane < 32) o[64 + lane] = ov;
}
__device__ __forceinline__ void post_kv_item(const MK& a, int idx, int lane) {
    const int row = idx >> 3, h = idx & 7;
    const float v = a.KV()[(size_t)row * 1024 + h * 128 + lane];
    const float ss = wave_sum(v * v);
    const float kn = v * rsqrtf(ss * (1.f / 64.f) + EPSV) * a.g_k_nope[lane];
    a.kh()[((size_t)row * 8 + h) * 64 + lane] = kn;
}

typedef float f32x16 __attribute__((ext_vector_type(16)));
typedef short s16x4 __attribute__((ext_vector_type(4)));
#define KST 104
#define VST 72
#define ATT_BUF (64 * KST * 2 + 64 * VST * 2)
__device__ __forceinline__ int crow32(int r, int hi) { return (r & 3) + 8 * (r >> 2) + 4 * hi; }
__device__ __forceinline__ s16x4 tr_read(const bf16_t* p) { return __builtin_bit_cast(s16x4, __builtin_amdgcn_ds_read_tr16_b64_v4i16((LAS s16x4*)(LAS void*)(unsigned)(size_t)p)); }
__device__ __forceinline__ bf16x8 pack8(const f32x16& x, int s) {
    u32x4 w; w.x = pk2bf(x[8 * s], x[8 * s + 1]); w.y = pk2bf(x[8 * s + 2], x[8 * s + 3]); w.z = pk2bf(x[8 * s + 4], x[8 * s + 5]); w.w = pk2bf(x[8 * s + 6], x[8 * s + 7]);
    return __builtin_bit_cast(bf16x8, w);
}
__device__ __forceinline__ void attn_block(const MK& a, int b, int h, int qb, char* smem) {
    const int tid = otid(), lane = tid & 63, wid = tid >> 6, r32 = lane & 31, hi = lane >> 5;
    const int qrow = qb * 256 + wid * 32 + r32;
    const int wq0 = qb * 256 + wid * 32;
    bf16x8 qf[6];
    {
        const float SCL = 0.14724445f;
        const bf16_t* Qg = a.qraw() + ((size_t)b * SEQ + qrow) * 768 + h * 96 + 8 * hi;
        float qv[6][8];
#pragma unroll
        for (int ds = 0; ds < 6; ++ds) bf8_to_f32(*(const bf16x8*)(Qg + 16 * ds), qv[ds]);
        float sn_ = 0.f, sr_ = 0.f;
#pragma unroll
        for (int j = 0; j < 8; ++j) { sn_ += qv[0][j] * qv[0][j] + qv[1][j] * qv[1][j] + qv[2][j] * qv[2][j] + qv[3][j] * qv[3][j]; sr_ += qv[4][j] * qv[4][j] + qv[5][j] * qv[5][j]; }
        sn_ += __shfl_xor(sn_, 32); sr_ += __shfl_xor(sr_, 32);
        const float rsn = rsqrtf(sn_ * (1.f / 64.f) + EPSV) * SCL, rsr = rsqrtf(sr_ * (1.f / 32.f) + EPSV);
#pragma unroll
        for (int ds = 0; ds < 4; ++ds) {
            float o[8];
#pragma unroll
            for (int j = 0; j < 8; ++j) o[j] = qv[ds][j] * rsn * a.g_q_nope[16 * ds + 8 * hi + j];
            qf[ds] = f32_to_bf8(o);
        }
        const float* tb = a.ropecs() + (size_t)qrow * 32 + 8 * hi;
        float o4[8], o5[8];
#pragma unroll
        for (int j = 0; j < 8; ++j) {
            const float x1 = qv[4][j] * rsr * a.g_q_rope[8 * hi + j], x2 = qv[5][j] * rsr * a.g_q_rope[16 + 8 * hi + j], cs = tb[j], sn = tb[16 + j];
            o4[j] = (x1 * cs - x2 * sn) * SCL; o5[j] = (x1 * sn + x2 * cs) * SCL;
        }
        qf[4] = f32_to_bf8(o4); qf[5] = f32_to_bf8(o5);
    }
    f32x16 o0, o1;
#pragma unroll
    for (int r = 0; r < 16; ++r) { o0[r] = 0.f; o1[r] = 0.f; }
    float m = -INFINITY, l = 0.f;
    const int nt = qb * 4 + 4;
    const int vr = tid >> 3, vc = tid & 7, rr_ = (tid >> 2) & 63, rc = tid & 3;
    const bf16_t* KVg = a.kvraw() + (size_t)b * SEQ * 1024 + h * 128 + (size_t)vr * 1024 + vc * 8;
    const bf16_t* KRg = a.krb() + (size_t)b * SEQ * 32 + (size_t)rr_ * 32 + rc * 8;
    float gk[8];
#pragma unroll
    for (int j = 0; j < 8; ++j) gk[j] = a.g_k_nope[8 * vc + j];
    bf16x8 kr0, kr1, vr0;
#define ATT_LOAD(tt) do { kr0 = *(const bf16x8*)(KVg + (size_t)(tt) * 64 * 1024); vr0 = *(const bf16x8*)(KVg + (size_t)(tt) * 64 * 1024 + 64); if (tid < 256) kr1 = *(const bf16x8*)(KRg + (size_t)(tt) * 64 * 32); } while (0)
#define ATT_STORE(buf) do { bf16_t* Ks_ = (bf16_t*)(smem + (buf) * ATT_BUF); bf16_t* Vs_ = Ks_ + 64 * KST; \
        float x_[8]; bf8_to_f32(kr0, x_); float ss_ = 0.f; _Pragma("unroll") for (int j = 0; j < 8; ++j) ss_ += x_[j] * x_[j]; \
        ss_ += __shfl_xor(ss_, 1); ss_ += __shfl_xor(ss_, 2); ss_ += __shfl_xor(ss_, 4); const float rs_ = rsqrtf(ss_ * (1.f / 64.f) + EPSV); \
        _Pragma("unroll") for (int j = 0; j < 8; ++j) x_[j] *= rs_ * gk[j]; \
        *(bf16x8*)(Ks_ + vr * KST + vc * 8) = f32_to_bf8(x_); *(bf16x8*)(Vs_ + vr * VST + vc * 8) = vr0; \
        if (tid < 256) *(bf16x8*)(Ks_ + rr_ * KST + 64 + rc * 8) = kr1; } while (0)
    ATT_LOAD(0);
    __syncthreads();
    ATT_STORE(0);
    __syncthreads();
    const int i16 = lane & 15, qq = i16 >> 2, pp = i16 & 3, g1 = (lane >> 4) & 1;
    for (int t = 0; t < nt; ++t) {
        const bf16_t* Ks = (const bf16_t*)(smem + (t & 1) * ATT_BUF); const bf16_t* Vs = Ks + 64 * KST;
        if (t + 1 < nt) ATT_LOAD(t + 1);
        if (64 * t <= wq0 + 31) {
            f32x16 p0, p1;
#pragma unroll
            for (int r = 0; r < 16; ++r) { p0[r] = 0.f; p1[r] = 0.f; }
#pragma unroll
            for (int ds = 0; ds < 6; ++ds) {
                const bf16x8 k0 = *(const bf16x8*)(Ks + r32 * KST + 16 * ds + 8 * hi);
                const bf16x8 k1 = *(const bf16x8*)(Ks + (32 + r32) * KST + 16 * ds + 8 * hi);
                p0 = __builtin_amdgcn_mfma_f32_32x32x16_bf16(k0, qf[ds], p0, 0, 0, 0);
                p1 = __builtin_amdgcn_mfma_f32_32x32x16_bf16(k1, qf[ds], p1, 0, 0, 0);
            }
            if (64 * t + 63 > wq0) {
#pragma unroll
                for (int r = 0; r < 16; ++r) { const int kv = 64 * t + crow32(r, hi); if (kv > qrow) p0[r] = -INFINITY; if (kv + 32 > qrow) p1[r] = -INFINITY; }
            }
            float mx = fmaxf(p0[0], p1[0]);
#pragma unroll
            for (int r = 1; r < 16; ++r) mx = fmaxf(mx, fmaxf(p0[r], p1[r]));
            mx = fmaxf(mx, __shfl_xor(mx, 32));
            const float mn = fmaxf(m, mx);
            const float alpha = __builtin_amdgcn_exp2f(m - mn);
            m = mn;
            float rs = 0.f;
#pragma unroll
            for (int r = 0; r < 16; ++r) { p0[r] = __builtin_amdgcn_exp2f(p0[r] - mn); p1[r] = __builtin_amdgcn_exp2f(p1[r] - mn); rs += p0[r] + p1[r]; }
            l = l * alpha + rs;
#pragma unroll
            for (int r = 0; r < 16; ++r) { o0[r] *= alpha; o1[r] *= alpha; }
            bf16x8 pf[4];
            pf[0] = pack8(p0, 0); pf[1] = pack8(p0, 1); pf[2] = pack8(p1, 0); pf[3] = pack8(p1, 1);
#pragma unroll
            for (int ks = 0; ks < 4; ++ks) {
                const bf16_t* vb0 = Vs + (16 * ks + 4 * hi + qq) * VST + 16 * g1 + 4 * pp;
                const s16x4 a0 = tr_read(vb0), a1 = tr_read(vb0 + 8 * VST);
                const s16x4 c0 = tr_read(vb0 + 32), c1 = tr_read(vb0 + 8 * VST + 32);
                const bf16x8 va = __builtin_shufflevector(a0, a1, 0, 1, 2, 3, 4, 5, 6, 7);
                const bf16x8 vc_ = __builtin_shufflevector(c0, c1, 0, 1, 2, 3, 4, 5, 6, 7);
                o0 = __builtin_amdgcn_mfma_f32_32x32x16_bf16(va, pf[ks], o0, 0, 0, 0);
                o1 = __builtin_amdgcn_mfma_f32_32x32x16_bf16(vc_, pf[ks], o1, 0, 0, 0);
            }
        }
        if (t + 1 < nt) ATT_STORE((t + 1) & 1);
        __syncthreads();
    }
    l += __shfl_xor(l, 32);
    const float il = 1.f / l;
    bf16_t* op = a.omix() + ((size_t)b * SEQ + qrow) * 1024 + 512 + h * 64;
#pragma unroll
    for (int g = 0; g < 4; ++g) {
        uint2 w0, w1;
        w0.x = pk2bf(o0[4 * g] * il, o0[4 * g + 1] * il); w0.y = pk2bf(o0[4 * g + 2] * il, o0[4 * g + 3] * il);
        w1.x = pk2bf(o1[4 * g] * il, o1[4 * g + 1] * il); w1.y = pk2bf(o1[4 * g + 2] * il, o1[4 * g + 3] * il);
        *(uint2*)(op + 8 * g + 4 * hi) = w0;
        *(uint2*)(op + 32 + 8 * g + 4 * hi) = w1;
    }
#undef ATT_LOAD
#undef ATT_STORE
}

__device__ __forceinline__ void gdn_unit(const MK& a, int b, int h, int dvg, const float* s0, float* sout, int row0, int T, int lane, char* wsm) {
    float (*sq)[64] = (float (*)[64])wsm;
    float (*sk)[64] = (float (*)[64])(wsm + 4096);
    float (*sv)[8] = (float (*)[8])(wsm + 8192);
    float* sg = (float*)(wsm + 8704);
    float* sb = (float*)(wsm + 8768);
    const int e = lane & 7, ko = lane >> 3, col = dvg * 8 + e;
    float S[8];
#pragma unroll
    for (int d = 0; d < 8; ++d) S[d] = s0 ? s0[(((size_t)b * 8 + h) * 64 + ko * 8 + d) * 64 + col] : 0.f;
    const size_t rbase = (size_t)row0 + (size_t)b * T;
    float pq[16], pk[16], pv0, pv1, pgb;
    {
        const int nt = T < 16 ? T : 16;
#pragma unroll
        for (int j = 0; j < 16; ++j) { const bool ok = j < nt; const size_t r = rbase + (ok ? j : 0); pq[j] = ok ? bf2f(a.qkv()[r * 1536 + h * 64 + lane]) : 0.f; pk[j] = ok ? bf2f(a.qkv()[r * 1536 + 512 + h * 64 + lane]) : 0.f; }
        { const int j0 = lane >> 3, j1 = j0 + 8; pv0 = j0 < nt ? bf2f(a.qkv()[(rbase + j0) * 1536 + 1024 + h * 64 + dvg * 8 + (lane & 7)]) : 0.f; pv1 = j1 < nt ? bf2f(a.qkv()[(rbase + j1) * 1536 + 1024 + h * 64 + dvg * 8 + (lane & 7)]) : 0.f; }
        { const int j = lane & 15; pgb = j < nt ? (lane < 16 ? a.gg()[(rbase + j) * 8 + h] : a.bb()[(rbase + j) * 8 + h]) : 0.f; }
    }
    for (int t0 = 0; t0 < T; t0 += 16) {
        const int nt = (T - t0) < 16 ? (T - t0) : 16;
        WSYNC();
#pragma unroll
        for (int j = 0; j < 16; ++j) { sq[j][lane] = pq[j]; sk[j][lane] = pk[j]; }
        sv[lane >> 3][lane & 7] = pv0; sv[(lane >> 3) + 8][lane & 7] = pv1;
        if (lane < 16) sg[lane] = expf(pgb); else if (lane < 32) sb[lane - 16] = pgb;
        WSYNC();
        if (t0 + 16 < T) {
            const size_t rb = rbase + t0 + 16;
#pragma unroll
            for (int j = 0; j < 16; ++j) { pq[j] = bf2f(a.qkv()[(rb + j) * 1536 + h * 64 + lane]); pk[j] = bf2f(a.qkv()[(rb + j) * 1536 + 512 + h * 64 + lane]); }
            pv0 = bf2f(a.qkv()[(rb + (lane >> 3)) * 1536 + 1024 + h * 64 + dvg * 8 + (lane & 7)]); pv1 = bf2f(a.qkv()[(rb + (lane >> 3) + 8) * 1536 + 1024 + h * 64 + dvg * 8 + (lane & 7)]);
            pgb = lane < 16 ? a.gg()[(rb + (lane & 15)) * 8 + h] : a.bb()[(rb + (lane & 15)) * 8 + h];
        }
        for (int j = 0; j < nt; ++j) {
            const float dec = sg[j], be = sb[j], v = sv[j][e];
            const float4 k0 = *(const float4*)&sk[j][ko * 8], k1 = *(const float4*)&sk[j][ko * 8 + 4];
            const float4 q0 = *(const float4*)&sq[j][ko * 8], q1 = *(const float4*)&sq[j][ko * 8 + 4];
            const float kk[8] = {k0.x, k0.y, k0.z, k0.w, k1.x, k1.y, k1.z, k1.w};
            const float qq[8] = {q0.x, q0.y, q0.z, q0.w, q1.x, q1.y, q1.z, q1.w};
            float ks = 0.f;
#pragma unroll
            for (int d = 0; d < 8; ++d) { S[d] *= dec; ks += kk[d] * S[d]; }
            ks += __shfl_xor(ks, 8); ks += __shfl_xor(ks, 16); ks += __shfl_xor(ks, 32);
            const float delta = (v - ks) * be;
            float ov = 0.f;
#pragma unroll
            for (int d = 0; d < 8; ++d) { S[d] += kk[d] * delta; ov += qq[d] * S[d]; }
            ov += __shfl_xor(ov, 8); ov += __shfl_xor(ov, 16); ov += __shfl_xor(ov, 32);
            if (ko == 0) a.goraw()[(rbase + t0 + j) * 512 + h * 64 + col] = ov;
        }
    }
#pragma unroll
    for (int d = 0; d < 8; ++d) sout[(((size_t)b * 8 + h) * 64 + ko * 8 + d) * 64 + col] = S[d];
}
__device__ __forceinline__ bf16x8 ld8_f32_bf16(const float* p) {
    const float4 x = *(const float4*)p, y = *(const float4*)(p + 4);
    u32x4 w; w.x = cvtpk(x.x, x.y); w.y = cvtpk(x.z, x.w); w.z = cvtpk(y.x, y.y); w.w = cvtpk(y.z, y.w);
    return __builtin_bit_cast(bf16x8, w);
}
__device__ __forceinline__ int pi_pos(int k) { return (k & 32) + 8 * ((k >> 2) & 3) + 4 * ((k >> 4) & 1) + (k & 3); }
#define GDN_WLDS 17408
__device__ __forceinline__ void gdn_prep_unit(const MK& a, int u, int lane_in, char* wsm) {
    int lane = lane_in; asm volatile("" : "+v"(lane));
    const int bh = u >> 5, n = u & 31, b = bh >> 3, h = bh & 7, i16 = lane & 15, q4 = lane >> 4;
    const size_t row0 = (size_t)b * SEQ + n * 64;
    float* AT = (float*)wsm; float* GC = (float*)(wsm + 16384); float* BT = GC + 64;
    const bf16_t* qbase = a.qkv() + row0 * 1536 + h * 64; const bf16_t* kbase = qbase + 512; const bf16_t* vbase = qbase + 1024;
    float g = a.gg()[(row0 + lane) * 8 + h];
    const float be_l = a.bb()[(row0 + lane) * 8 + h];
#pragma unroll
    for (int o = 1; o < 64; o <<= 1) { const float t = __shfl_up(g, o); if (lane >= o) g += t; }
    WSYNC();
    GC[lane] = g; BT[lane] = be_l;
    WSYNC();
    const float gl = GC[63];
    float* EG = BT + 64; float* ED = EG + 64;
    EG[lane] = expf(g); ED[lane] = expf(gl - g);
    WSYNC();
    bf16x8 kf[4][2], qf[4][2];
#pragma unroll
    for (int mt = 0; mt < 4; ++mt)
#pragma unroll
        for (int ks = 0; ks < 2; ++ks) {
            const int off = (16 * mt + i16) * 1536 + 32 * ks + 8 * q4;
            kf[mt][ks] = *(const bf16x8*)(kbase + off); qf[mt][ks] = *(const bf16x8*)(qbase + off);
        }
    bf16_t* QKg = a.gQK() + (size_t)u * 4096;
#pragma unroll
    for (int mt = 0; mt < 4; ++mt)
#pragma unroll
        for (int nt = 0; nt < 4; ++nt) {
            const int j = 16 * nt + i16, pj = 32 * (nt >> 1) + 8 * (i16 >> 2) + 4 * (nt & 1) + (i16 & 3);
            if (nt <= mt) {
                f32x4 d1 = {0.f, 0.f, 0.f, 0.f}, d2 = {0.f, 0.f, 0.f, 0.f};
#pragma unroll
                for (int ks = 0; ks < 2; ++ks) {
                    d1 = __builtin_amdgcn_mfma_f32_16x16x32_bf16(kf[mt][ks], kf[nt][ks], d1, 0, 0, 0);
                    d2 = __builtin_amdgcn_mfma_f32_16x16x32_bf16(qf[mt][ks], kf[nt][ks], d2, 0, 0, 0);
                }
                const float gcj = GC[j];
#pragma unroll
                for (int r = 0; r < 4; ++r) {
                    const int i = 16 * mt + 4 * q4 + r;
                    const float dec = expf(GC[i] - gcj);
                    AT[i * 64 + j] = (i > j) ? BT[i] * d1[r] * dec : 0.f;
                    QKg[i * 64 + (((pj >> 3) ^ (i & 7)) << 3) + (pj & 7)] = f2bf((i >= j) ? d2[r] * dec : 0.f);
                }
            } else {
#pragma unroll
                for (int r = 0; r < 4; ++r) { const int i = 16 * mt + 4 * q4 + r; QKg[i * 64 + (((pj >> 3) ^ (i & 7)) << 3) + (pj & 7)] = 0; }
            }
        }
    {
        bf16_t* Qgg = a.gQg() + (size_t)u * 4096;
#pragma unroll
        for (int mt = 0; mt < 4; ++mt) {
            const int i = 16 * mt + i16; const float e = EG[i];
#pragma unroll
            for (int ks = 0; ks < 2; ++ks) {
                float x[8]; bf8_to_f32(qf[mt][ks], x);
                uint2 w0, w1; w0.x = cvtpk(x[0] * e, x[1] * e); w0.y = cvtpk(x[2] * e, x[3] * e); w1.x = cvtpk(x[4] * e, x[5] * e); w1.y = cvtpk(x[6] * e, x[7] * e);
                const int p0 = 32 * ks + 16 * (q4 & 1) + 4 * (q4 >> 1);
                *(uint2*)(Qgg + i * 64 + (((p0 >> 3) ^ (i & 7)) << 3) + (p0 & 7)) = w0; *(uint2*)(Qgg + i * 64 + ((((p0 >> 3) + 1) ^ (i & 7)) << 3) + (p0 & 7)) = w1;
            }
        }
    }
    WSYNC();
    __builtin_amdgcn_sched_barrier(0);
    {
        float U[64];
#pragma unroll
        for (int i = 0; i < 64; ++i) { U[i] = bf2f(vbase[i * 1536 + lane]) * BT[i]; }
#pragma unroll
        for (int i = 1; i < 64; ++i) {
            float su = 0.f;
#pragma unroll
            for (int j4 = 0; j4 < i; j4 += 4) {
                const float4 av = *(const float4*)(AT + i * 64 + j4);
                su += av.x * U[j4];
                if (j4 + 1 < i) su += av.y * U[j4 + 1];
                if (j4 + 2 < i) su += av.z * U[j4 + 2];
                if (j4 + 3 < i) su += av.w * U[j4 + 3];
            }
            U[i] -= su;
            __builtin_amdgcn_sched_barrier(0);
        }
        float* UTg = a.gUT() + ((size_t)u * 64 + lane) * 64;
#pragma unroll
        for (int i = 0; i < 64; i += 4) *(float4*)(UTg + 4 * ((i >> 2) ^ (lane & 15))) = (float4){U[i], U[i + 1], U[i + 2], U[i + 3]};
    }
    asm volatile("" ::: "memory");
    __builtin_amdgcn_sched_barrier(0);
    {
        float W[64];
#pragma unroll
        for (int i = 0; i < 64; ++i) { W[i] = bf2f(kbase[i * 1536 + lane]); }
        bf16_t* Kdg = a.gKd() + ((size_t)u * 64 + lane) * 64;
#pragma unroll
        for (int pc = 0; pc < 8; ++pc) {
            float t[8];
#pragma unroll
            for (int jj = 0; jj < 8; ++jj) { const int j = 32 * (pc >> 2) + 16 * (jj >> 2) + 4 * (pc & 3) + (jj & 3); t[jj] = W[j] * ED[j]; }
            u32x4 w; w.x = cvtpk(t[0], t[1]); w.y = cvtpk(t[2], t[3]); w.z = cvtpk(t[4], t[5]); w.w = cvtpk(t[6], t[7]);
            *(u32x4*)(Kdg + 8 * (pc ^ (lane & 7))) = w;
        }
#pragma unroll
        for (int i = 0; i < 64; ++i) W[i] *= BT[i] * EG[i];
#pragma unroll
        for (int i = 1; i < 64; ++i) {
            float sw = 0.f;
#pragma unroll
            for (int j4 = 0; j4 < i; j4 += 4) {
                const float4 av = *(const float4*)(AT + i * 64 + j4);
                sw += av.x * W[j4];
                if (j4 + 1 < i) sw += av.y * W[j4 + 1];
                if (j4 + 2 < i) sw += av.z * W[j4 + 2];
                if (j4 + 3 < i) sw += av.w * W[j4 + 3];
            }
            W[i] -= sw;
            __builtin_amdgcn_sched_barrier(0);
        }
        bf16_t* Wng = a.gWn() + (size_t)u * 4096; const int pp = pi_pos(lane);
#pragma unroll
        for (int i = 0; i < 64; ++i) Wng[i * 64 + (((pp >> 3) ^ (i & 7)) << 3) + (pp & 7)] = f2bf(-W[i]);
    }
    if (lane == 0) a.ggam()[u] = expf(gl);
}
__device__ __forceinline__ bf16x8 pack_acc2(const f32x4& x, const f32x4& y) {
    u32x4 w; w.x = cvtpk(x[0], x[1]); w.y = cvtpk(x[2], x[3]); w.z = cvtpk(y[0], y[1]); w.w = cvtpk(y[2], y[3]);
    return __builtin_bit_cast(bf16x8, w);
}
#define G2_SLOT 49152
__device__ __forceinline__ void g2_issue(const MK& a, size_t u, int n, LAS unsigned char* lds, int lw, int lane) {
    LAS unsigned char* dst = lds + (n % 3) * G2_SLOT;
    const char* srcs[4] = {(const char*)(a.gWn() + u * 4096), (const char*)(a.gQg() + u * 4096), (const char*)(a.gQK() + u * 4096), (const char*)(a.gKd() + u * 4096)};
#pragma unroll
    for (int m = 0; m < 4; ++m)
#pragma unroll
        for (int i = 0; i < 2; ++i) { const int piece = 2 * lw + i;
            __builtin_amdgcn_global_load_lds((const unsigned*)(srcs[m] + piece * 1024 + lane * 16), (LAS unsigned*)(dst + m * 8192 + piece * 1024), 16, 0, 0); }
    const char* us = (const char*)(a.gUT() + u * 4096);
#pragma unroll
    for (int i = 0; i < 4; ++i) { const int piece = 4 * lw + i;
        __builtin_amdgcn_global_load_lds((const unsigned*)(us + piece * 1024 + lane * 16), (LAS unsigned*)(dst + 32768 + piece * 1024), 16, 0, 0); }
}
__device__ __forceinline__ void gdn_scan_block(const MK& a, int bh, LAS unsigned char* lds) {
    const int tid = otid(), lane = tid & 63, wid = __builtin_amdgcn_readfirstlane(tid >> 6), i16 = lane & 15, q4 = lane >> 4;
    const int b = bh >> 3, h = bh & 7, sl = wid & 3;
    const bool loader = wid >= 4;
    f32x4 S[4];
#pragma unroll
    for (int mt = 0; mt < 4; ++mt) S[mt] = (f32x4){0.f, 0.f, 0.f, 0.f};
    __syncthreads();
    if (loader) { g2_issue(a, (size_t)bh * 32, 0, lds, wid - 4, lane); g2_issue(a, (size_t)bh * 32 + 1, 1, lds, wid - 4, lane); }
    for (int n = 0; n < 32; ++n) {
        if (loader) { if (n < 31) asm volatile("s_waitcnt vmcnt(12)" ::: "memory"); else asm volatile("s_waitcnt vmcnt(0)" ::: "memory"); }
        asm volatile("s_waitcnt lgkmcnt(0)" ::: "memory"); __builtin_amdgcn_s_barrier(); asm volatile("" ::: "memory");
        if (loader) { if (n + 2 < 32) g2_issue(a, (size_t)bh * 32 + n + 2, n + 2, lds, wid - 4, lane); }
        else {
            const LAS unsigned char* sb = lds + (n % 3) * G2_SLOT;
            const float gam = a.ggam()[(size_t)bh * 32 + n];
            bf16x8 Sb[2]; Sb[0] = pack_acc2(S[0], S[1]); Sb[1] = pack_acc2(S[2], S[3]);
            f32x4 Vn[4];
#pragma unroll
            for (int mt = 0; mt < 4; ++mt) Vn[mt] = *(const LAS f32x4*)(sb + 32768 + (16 * sl + i16) * 256 + 16 * ((4 * mt + q4) ^ i16));
#pragma unroll
            for (int mt = 0; mt < 4; ++mt)
#pragma unroll
                for (int ks = 0; ks < 2; ++ks) Vn[mt] = __builtin_amdgcn_mfma_f32_16x16x32_bf16(*(const LAS bf16x8*)(sb + (16 * mt + i16) * 128 + 16 * ((4 * ks + q4) ^ (i16 & 7))), Sb[ks], Vn[mt], 0, 0, 0);
            bf16x8 Vb[2]; Vb[0] = pack_acc2(Vn[0], Vn[1]); Vb[1] = pack_acc2(Vn[2], Vn[3]);
            f32x4 O[4];
#pragma unroll
            for (int mt = 0; mt < 4; ++mt) {
                O[mt] = (f32x4){0.f, 0.f, 0.f, 0.f};
#pragma unroll
                for (int ks = 0; ks < 2; ++ks) {
                    const int fo = (16 * mt + i16) * 128 + 16 * ((4 * ks + q4) ^ (i16 & 7));
                    O[mt] = __builtin_amdgcn_mfma_f32_16x16x32_bf16(*(const LAS bf16x8*)(sb + 8192 + fo), Sb[ks], O[mt], 0, 0, 0);
                    O[mt] = __builtin_amdgcn_mfma_f32_16x16x32_bf16(*(const LAS bf16x8*)(sb + 16384 + fo), Vb[ks], O[mt], 0, 0, 0);
                }
            }
#pragma unroll
            for (int mt = 0; mt < 4; ++mt) {
                S[mt] = S[mt] * gam;
#pragma unroll
                for (int ks = 0; ks < 2; ++ks) S[mt] = __builtin_amdgcn_mfma_f32_16x16x32_bf16(*(const LAS bf16x8*)(sb + 24576 + (16 * mt + i16) * 128 + 16 * ((4 * ks + q4) ^ (i16 & 7))), Vb[ks], S[mt], 0, 0, 0);
            }
            float* og = a.goraw() + ((size_t)b * SEQ + n * 64 + 4 * q4) * 512 + h * 64 + 16 * sl + i16;
#pragma unroll
            for (int mt = 0; mt < 4; ++mt)
#pragma unroll
                for (int r = 0; r < 4; ++r) og[(size_t)(16 * mt + r) * 512] = O[mt][r];
        }
    }
    if (!loader) {
        float* so = a.out + O_GSP + ((size_t)bh * 64 + 4 * q4) * 64 + 16 * sl + i16;
#pragma unroll
        for (int mt = 0; mt < 4; ++mt)
#pragma unroll
            for (int r = 0; r < 4; ++r) so[(size_t)(16 * mt + r) * 64] = S[mt][r];
    }
    __syncthreads();
}
__device__ __forceinline__ void gdn_out_token(const MK& a, int row, int lane) {
    const float* op = a.goraw() + (size_t)row * 512 + 8 * lane;
    const float4 x0 = *(const float4*)op, x1 = *(const float4*)(op + 4);
    float o[8] = {x0.x, x0.y, x0.z, x0.w, x1.x, x1.y, x1.z, x1.w}, zg[8];
    bf8_to_f32(*(const bf16x8*)(a.Z() + (size_t)row * ZW + OFF_Z + 8 * lane), zg);
    float ss = 0.f;
#pragma unroll
    for (int e = 0; e < 8; ++e) ss += o[e] * o[e];
    ss += __shfl_xor(ss, 1); ss += __shfl_xor(ss, 2); ss += __shfl_xor(ss, 4);
    const float rs = rsqrtf(ss * (1.f / 64.f) + EPSV);
    const float4 g0 = *(const float4*)(a.g_gdn_out + 8 * (lane & 7)), g1 = *(const float4*)(a.g_gdn_out + 8 * (lane & 7) + 4);
    const float gg_[8] = {g0.x, g0.y, g0.z, g0.w, g1.x, g1.y, g1.z, g1.w};
#pragma unroll
    for (int e = 0; e < 8; ++e) o[e] = o[e] * rs * gg_[e] * zg[e] * fast_sigmoid(zg[e]);
    *(bf16x8*)(a.omix() + (size_t)row * 1024 + 8 * lane) = f32_to_bf8(o);
}

#define SROW 1040
#define SSLOT (32 * SROW)
#define KR_OFF (4 * SSLOT)
#define WQ_OFF (KR_OFF + 4 * 4096)
#define QR_OFF (WQ_OFF + 2048)
#define PG_OFF (QR_OFF + 1024)
#define SAMP_LDS_END (PG_OFF + 64)
__device__ __forceinline__ void samp_issue(const MK& a, int g, LAS unsigned char* lds, const int* PG, int wid, int lane) {
    const int phys = __builtin_amdgcn_readfirstlane(((const LAS int*)(lds + PG_OFF))[g >> 2]);
    const int tok0 = (g & 3) * 32 + 4 * wid, slot = g & 3;
    const float* cs = a.cache_ckv + ((size_t)phys * 128 + tok0) * 256 + lane * 4;
#pragma unroll
    for (int i = 0; i < 4; ++i) __builtin_amdgcn_global_load_lds((const unsigned*)(cs + i * 256), (LAS unsigned*)(lds + slot * SSLOT + (4 * wid + i) * SROW), 16, 0, 0);
    const float* ks = a.cache_krope + ((size_t)phys * 128 + tok0 + (lane >> 5)) * 32 + (lane & 31);
#pragma unroll
    for (int i = 0; i < 2; ++i) __builtin_amdgcn_global_load_lds((const unsigned*)(ks + i * 64), (LAS unsigned*)(lds + KR_OFF + slot * 4096 + (4 * wid + 2 * i) * 128), 4, 0, 0);
}
__device__ __forceinline__ void samp_attn_unit(const MK& a, int u, char* smem, LAS unsigned char* lds) {
    const int tid = otid(), lane = tid & 63, h = __builtin_amdgcn_readfirstlane(tid >> 6), i16 = lane & 15, q4 = lane >> 4;
    const int b = u >> 3, sp = u & 7;
    float* WQ = (float*)(smem + WQ_OFF);
    float* QR = (float*)(smem + QR_OFF);
    int* PG = (int*)(smem + PG_OFF);
    const float SCL = 0.14724445f;
    post_q_item(a, (NPT + b) * 8 + h, lane);
    __syncthreads();
    {
        const int h_ = tid >> 6, l_ = tid & 63, q4_ = l_ >> 4, idx = l_ & 15, d = 16 * (idx >> 2) + 4 * q4_ + (idx & 3);
        WQ[tid] = a.g_k_nope[d] * a.qh()[((size_t)(NPT + b) * 8 + h_) * 96 + d] * SCL;
        if (tid < 256) QR[tid] = a.qh()[((size_t)(NPT + b) * 8 + (tid >> 5)) * 96 + 64 + (tid & 31)] * SCL;
        if (tid < 16) PG[tid] = a.page_table[b * NPAGES + sp * 16 + tid];
    }
    bf16x8 wf[4][8];
#pragma unroll
    for (int mt = 0; mt < 4; ++mt)
#pragma unroll
        for (int ks = 0; ks < 8; ++ks) wf[mt][ks] = *(const bf16x8*)(a.WknT() + (size_t)(h * 64 + 16 * mt + i16) * 256 + 32 * ks + 8 * q4);
#pragma unroll
    for (int mt = 0; mt < 4; ++mt)
#pragma unroll
        for (int ks = 0; ks < 8; ++ks) asm volatile("" : "+v"(wf[mt][ks]));
    __syncthreads();
    samp_issue(a, 0, lds, PG, h, lane); samp_issue(a, 1, lds, PG, h, lane); samp_issue(a, 2, lds, PG, h, lane);
    const LAS float* QRl = (const LAS float*)(lds + QR_OFF) + h * 32 + 8 * q4;
    const LAS float* WQl = (const LAS float*)(lds + WQ_OFF) + (h * 4 + q4) * 16;
    float m = -INFINITY, lsum = 0.f, lat0 = 0.f, lat1 = 0.f, lat2 = 0.f, lat3 = 0.f;
    for (int g = 0; g < 64; ++g) {
        if (g <= 61) asm volatile("s_waitcnt vmcnt(12)" ::: "memory"); else if (g == 62) asm volatile("s_waitcnt vmcnt(6)" ::: "memory"); else asm volatile("s_waitcnt vmcnt(0)" ::: "memory");
        asm volatile("s_waitcnt lgkmcnt(0)" ::: "memory"); __builtin_amdgcn_s_barrier(); asm volatile("" ::: "memory");
        if (g + 3 < 64) samp_issue(a, g + 3, lds, PG, h, lane);
        const LAS float* Cs = (const LAS float*)(lds + (g & 3) * SSLOT); const LAS float* KR = (const LAS float*)(lds + KR_OFF + (g & 3) * 4096);
        float sc[2];
#pragma unroll
        for (int hf = 0; hf < 2; ++hf) {
            f32x4 acc[4];
#pragma unroll
            for (int mt = 0; mt < 4; ++mt) acc[mt] = (f32x4){0.f, 0.f, 0.f, 0.f};
            const LAS float* cp = Cs + (16 * hf + i16) * (SROW / 4) + 8 * q4;
#pragma unroll
            for (int ks = 0; ks < 8; ++ks) {
                const f32x4 f0 = *(const LAS f32x4*)(cp + 32 * ks), f1 = *(const LAS f32x4*)(cp + 32 * ks + 4);
                u32x4 w; w.x = cvtpk(f0[0], f0[1]); w.y = cvtpk(f0[2], f0[3]); w.z = cvtpk(f1[0], f1[1]); w.w = cvtpk(f1[2], f1[3]);
                const bf16x8 cf = __builtin_bit_cast(bf16x8, w);
#pragma unroll
                for (int mt = 0; mt < 4; ++mt) acc[mt] = __builtin_amdgcn_mfma_f32_16x16x32_bf16(wf[mt][ks], cf, acc[mt], 0, 0, 0);
            }
            float ss = 0.f, dot = 0.f, rd = 0.f;
#pragma unroll
            for (int mt = 0; mt < 4; ++mt) {
                const f32x4 wq = *(const LAS f32x4*)(WQl + 4 * mt);
                ss += acc[mt][0] * acc[mt][0] + acc[mt][1] * acc[mt][1] + acc[mt][2] * acc[mt][2] + acc[mt][3] * acc[mt][3];
                dot += acc[mt][0] * wq[0] + acc[mt][1] * wq[1] + acc[mt][2] * wq[2] + acc[mt][3] * wq[3];
            }
            {
                const LAS float* kp = KR + (16 * hf + i16) * 32 + 8 * q4;
                const f32x4 k0 = *(const LAS f32x4*)kp, k1 = *(const LAS f32x4*)(kp + 4), q0 = *(const LAS f32x4*)QRl, q1 = *(const LAS f32x4*)(QRl + 4);
                rd = k0[0] * q0[0] + k0[1] * q0[1] + k0[2] * q0[2] + k0[3] * q0[3] + k1[0] * q1[0] + k1[1] * q1[1] + k1[2] * q1[2] + k1[3] * q1[3];
            }
            ss += __shfl_xor(ss, 16); dot += __shfl_xor(dot, 16); rd += __shfl_xor(rd, 16);
            ss += __shfl_xor(ss, 32); dot += __shfl_xor(dot, 32); rd += __shfl_xor(rd, 32);
            sc[hf] = dot * rsqrtf(ss * (1.f / 64.f) + EPSV) + rd;
        }
        float gm = fmaxf(sc[0], sc[1]);
#pragma unroll
        for (int o = 1; o < 16; o <<= 1) gm = fmaxf(gm, __shfl_xor(gm, o));
        const float mn = fmaxf(m, gm);
        const float alpha = __builtin_amdgcn_exp2f(m - mn), p0 = __builtin_amdgcn_exp2f(sc[0] - mn), p1 = __builtin_amdgcn_exp2f(sc[1] - mn);
        m = mn;
        lsum = lsum * alpha + p0 + p1;
        lat0 *= alpha; lat1 *= alpha; lat2 *= alpha; lat3 *= alpha;
#pragma unroll 4
        for (int t = 0; t < 16; ++t) {
            const float pa = __uint_as_float(__builtin_amdgcn_readlane(__float_as_uint(p0), t)), pb_ = __uint_as_float(__builtin_amdgcn_readlane(__float_as_uint(p1), t));
            const f32x4 ca = *(const LAS f32x4*)(Cs + t * (SROW / 4) + 4 * lane), cb = *(const LAS f32x4*)(Cs + (16 + t) * (SROW / 4) + 4 * lane);
            lat0 += pa * ca[0] + pb_ * cb[0]; lat1 += pa * ca[1] + pb_ * cb[1]; lat2 += pa * ca[2] + pb_ * cb[2]; lat3 += pa * ca[3] + pb_ * cb[3];
        }
    }
#pragma unroll
    for (int o = 1; o < 16; o <<= 1) lsum += __shfl_xor(lsum, o);
    float* o = a.part() + ((size_t)u * 8 + h) * 260;
    *(float4*)(o + 4 + 4 * lane) = (float4){lat0, lat1, lat2, lat3};
    if (lane == 0) { o[0] = m * 0.69314718f; o[1] = lsum; }
}
__device__ __forceinline__ void samp_comb_unit(const MK& a, int u, char* smem) {
    float* slat = (float*)smem;
    const int b = u >> 3, h = u & 7, tid = otid() & 255;
    const size_t row = NPT + b;
    const float* q = a.qh() + (row * 8 + h) * 96;
    float s_self = 0.f;
    for (int d = 0; d < 64; ++d) s_self += q[d] * a.kh()[(row * 8 + h) * 64 + d];
    for (int d = 0; d < 32; ++d) s_self += q[64 + d] * a.krf()[row * 32 + d];
    s_self *= 0.10206207261596577f;
    float m = s_self;
    for (int s = 0; s < 8; ++s) m = fmaxf(m, a.part()[((size_t)(b * 8 + s) * 8 + h) * 260]);
    const float pself = expf(s_self - m);
    float l = pself, lat = 0.f;
    for (int s = 0; s < 8; ++s) {
        const float* p = a.part() + ((size_t)(b * 8 + s) * 8 + h) * 260;
        const float w = expf(p[0] - m);
        l += p[1] * w; lat += p[4 + tid] * w;
    }
    __syncthreads();
    slat[tid] = lat;
    __syncthreads();
    if (tid < 64) {
        float o = 0.f;
        for (int c = 0; c < 256; ++c) o += slat[c] * a.w_kv_b[(size_t)c * 1024 + h * 128 + 64 + tid];
        o += pself * a.KV()[row * 1024 + h * 128 + 64 + tid];
        a.omix()[row * 1024 + 512 + h * 64 + tid] = f2bf(o / l);
    }
}

#define XB_TMO      128
#define XB_XCNT(j)  (256  + 64 * (j))
#define XB_XSUB(j)  (1280 + 64 * (j))
#define XB_XGEN(j)  (2304 + 64 * (j))
#define XB_TOP      3328
#define XB_TOPGEN   3392
#define XCD_BAR_WORDS 3456
#define XB_SPIN_CAP (1u << 18)

__device__ __forceinline__ unsigned xb_ld(unsigned* p)              { return __hip_atomic_load(p, __ATOMIC_RELAXED, __HIP_MEMORY_SCOPE_AGENT); }
__device__ __forceinline__ unsigned xb_add(unsigned* p, unsigned v) { return __hip_atomic_fetch_add(p, v, __ATOMIC_RELAXED, __HIP_MEMORY_SCOPE_AGENT); }
__device__ __forceinline__ unsigned xb_xcc_id() { return (unsigned)__builtin_amdgcn_s_getreg((3 << 11) | 20) & 0xFu; }
#define XB_SPIN(cond, bar) do { unsigned _sp = 0; while (cond) { __builtin_amdgcn_s_sleep(1); \
    if ((++_sp & 255u) == 0u) { if (xb_ld(&(bar)[XB_TMO])) break; if (_sp > XB_SPIN_CAP) { atomicAdd(&(bar)[XB_TMO], 1u); break; } } } } while (0)

struct XcdBarrier {
    unsigned* bar; unsigned x;
    volatile LAS unsigned* st;
};

__device__ __forceinline__ XcdBarrier xcd_barrier_post(unsigned* bar, volatile LAS unsigned* st) {
    XcdBarrier b; b.bar = bar; b.x = xb_xcc_id(); b.st = st;
    if (threadIdx.x == 0) (void)xb_add(&bar[XB_XCNT(b.x)], 1u);
    return b;
}
__device__ __forceinline__ void xcd_barrier_complete(unsigned* bar, unsigned x, unsigned& nloc, unsigned& nx) {
    const unsigned G = gridDim.x * gridDim.y * gridDim.z;
    unsigned sum, cnt, mine, sp = 0u;
    for (;;) {
        sum = 0u; cnt = 0u; mine = 0u;
#pragma unroll
        for (unsigned j = 0; j < 16; ++j) { const unsigned c = xb_ld(&bar[XB_XCNT(j)]); sum += c; cnt += (c > 0u) ? 1u : 0u; mine = (j == x) ? c : mine; }
        if (sum == G) break;
        __builtin_amdgcn_s_sleep(1);
        if ((++sp & 255u) == 0u) { if (xb_ld(&bar[XB_TMO])) break; if (sp > XB_SPIN_CAP) { atomicAdd(&bar[XB_TMO], 1u); break; } }
    }
    nloc = mine > 0u ? mine : 1u; nx = cnt > 0u ? cnt : 1u;
}

__device__ __forceinline__ void xcd_barrier(const XcdBarrier& b) {
    asm volatile("s_waitcnt vmcnt(0)" ::: "memory");
    __syncthreads();
    if (threadIdx.x == 0) {
        unsigned* bar = b.bar;
        __builtin_amdgcn_s_waitcnt(0);
        unsigned nloc = b.st[0], nx = b.st[1];
        if (nloc == 0u) { xcd_barrier_complete(bar, b.x, nloc, nx); b.st[0] = nloc; b.st[1] = nx; }
        const unsigned old = xb_add(&bar[XB_XSUB(b.x)], 1u);
        const unsigned gen = old / nloc;
        if (old + 1u == (gen + 1u) * nloc) {
            __builtin_amdgcn_fence(__ATOMIC_RELEASE, "agent");
            asm volatile("s_waitcnt vmcnt(0)" ::: "memory");
            const unsigned og = xb_add(&bar[XB_TOP], 1u);
            const unsigned tg = og / nx;
            if (og + 1u == (tg + 1u) * nx) xb_add(&bar[XB_TOPGEN], 1u);
            else XB_SPIN(xb_ld(&bar[XB_TOPGEN]) == tg, bar);
            __builtin_amdgcn_fence(__ATOMIC_ACQUIRE, "agent");
            xb_add(&bar[XB_XGEN(b.x)], 1u);
            asm volatile("s_waitcnt vmcnt(0)" ::: "memory");
        } else {
            XB_SPIN(xb_ld(&bar[XB_XGEN(b.x)]) == gen, bar);
            __builtin_amdgcn_fence(__ATOMIC_ACQUIRE, "agent");
            asm volatile("s_waitcnt vmcnt(0)" ::: "memory");
        }
    }
    __syncthreads();
}

#define XB_ST_OFF 155648
#define LDS_BYTES 155904
static_assert(SAMP_LDS_END <= LDS_BYTES, "LDS map");
#define GSYNC() do { xcd_barrier(xbar); } while (0)
__global__ __launch_bounds__(NTHR, 2) void mega(MK a) {
    cg::grid_group grid = cg::this_grid();
    char* smem = (char*)lds_raw;
    LAS unsigned char* lds = (LAS unsigned char*)lds_raw;
    otid_init();
    if (threadIdx.x < 2) ((LAS unsigned*)(lds_raw + XB_ST_OFF))[threadIdx.x] = 0u;
    __syncthreads();
    const XcdBarrier xbar = xcd_barrier_post(a.ctl(), (volatile LAS unsigned*)(LAS void*)(lds_raw + XB_ST_OFF));
    const int bid = blockIdx.x, nb = gridDim.x, ngw = nb * NWAVE;
#define LOCAL_IDS const int tid = otid(), lane = tid & 63, wid = tid >> 6, half = tid >> 8, gw = bid * NWAVE + wid; (void)lane; (void)half; (void)gw; (void)wid;

    {
    LOCAL_IDS
    {
        const int T0 = 88 * 16, T1 = 24 * 6, T2 = 32 * 4, T3 = 16 * 4, T4 = 32 * 16, T5 = 176 * 16, T7 = 32 * 44, T8 = 32 * 16, T9 = 32 * 4;
        const int TT = T0 + T1 + T2 + T3 + T4 + T5 + T7 + T8 + T9;
        float* scr = (float*)(smem + wid * 8704);
        for (int it = gw; it < TT; it += ngw) {
            int r = it;
            if (r < T0) { const int nt_ = r % 88, kb = r / 88, nv = 2736 - 32 * nt_; wt_item(a.w_in, 2736, 32 * nt_, nv < 0 ? 0 : (nv > 32 ? 32 : nv), a.WinT(), 1024, 32 * nt_, 64 * kb, scr, lane); continue; } r -= T0;
            if (r < T1) { const int nt_ = r % 24, kb = r / 24; wt_item(a.w_q_b, 768, 32 * nt_, 32, a.WqbT(), 384, 32 * nt_, 64 * kb, scr, lane); continue; } r -= T1;
            if (r < T2) { const int nt_ = r % 32, kb = r / 32; wt_item(a.w_kv_b, 1024, 32 * nt_, 32, a.WkvT(), 256, 32 * nt_, 64 * kb, scr, lane); continue; } r -= T2;
            if (r < T3) { const int nt_ = r % 16, kb = r / 16, h = nt_ >> 1; wt_item(a.w_kv_b, 1024, h * 128 + 32 * (nt_ & 1), 32, a.WknT(), 256, 32 * nt_, 64 * kb, scr, lane); continue; } r -= T3;
            if (r < T4) { const int nt_ = r % 32, kb = r / 32; wt_item(a.w_o, 1024, 32 * nt_, 32, a.WoT(), 1024, 32 * nt_, 64 * kb, scr, lane); continue; } r -= T4;
            if (r < T5) { const int nt_ = r % 176, kb = r / 176, pn = nt_ >> 3, wi = nt_ & 7;
                wt_item(wi < 4 ? a.w_gate : a.w_up, DFF, pn * 128 + (wi & 3) * 32, 32, a.WguT(), 1024, 32 * nt_, 64 * kb, scr, lane); continue; } r -= T5;
            if (r < T7) { const int nt_ = r % 32, kb = r / 32; wt_item(a.w_down, 1024, 32 * nt_, 32, a.WdT(), DFF, 32 * nt_, 64 * kb, scr, lane); continue; } r -= T7;
            if (r < T8) { const int nt_ = r % 32, kb = r / 32; wt_item(a.w_ple_gate, 1024, 32 * nt_, 32, a.WpgT(), 1024, 32 * nt_, 64 * kb, scr, lane); continue; } r -= T8;
            { const int nt_ = r % 32, kb = r / 32; wt_item(a.w_ple_proj, 1024, 32 * nt_, 32, a.WppT(), 256, 32 * nt_, 64 * kb, scr, lane); }
        }
        for (int e = (bid * NTHR + tid); e < 2049 * 16; e += nb * NTHR) {
            const int pos = e >> 4, i = e & 15; const float ang = (pos == 2048 ? (float)PAST : (float)pos) * powf(10000.f, -(float)i / 16.f);
            a.ropecs()[pos * 32 + i] = cosf(ang); a.ropecs()[pos * 32 + 16 + i] = sinf(ang);
        }
        for (int row = gw; row < MPAD; row += ngw) {
            const float* src = row < NPT ? a.x_prompt + (size_t)row * 1024 : a.x_sample + (size_t)(row < NTOK ? row - NPT : 0) * 1024;
            rms1024_row(src, a.g_attn, a.xn() + (size_t)row * 1024, row >= NTOK, lane);
            ushort4 w = {0, 0, 0, 0};
            if (row < NTOK) { const float* ps = row < NPT ? a.p_prompt + (size_t)row * 256 : a.p_sample + (size_t)(row - NPT) * 256; const float4 v = *(const float4*)(ps + lane * 4); w.x = f2bf(v.x); w.y = f2bf(v.y); w.z = f2bf(v.z); w.w = f2bf(v.w); }
            *(ushort4*)(a.pb() + (size_t)row * 256 + lane * 4) = w;
            if (row >= NTOK) { for (int j = 0; j < 4; ++j) { ushort4 z = {0, 0, 0, 0}; *(ushort4*)(a.omix() + (size_t)row * 1024 + lane * 4 + 256 * j) = z; } }
        }
    }
    }
    grid.sync();
    {
    LOCAL_IDS
    pg_gemm(lds, a.xn(), a.WinT(), NPT, ZW, 1024, PgBf16{a.Z(), ZW});
    pg_gemm(lds, a.pb(), a.WppT(), NPT, 1024, 256, PgF32{a.PP(), 1024});
    gemm_sample_rows<false>(a.xn(), 1024, a.WinT(), 1024, ZW, EwBf16{a.Z(), ZW}, smem, bid, nb);
    gemm_sample_rows<false>(a.pb(), 256, a.WppT(), 256, 1024, EwF32{a.PP(), 1024}, smem, bid, nb);
    }
    GSYNC();
    {
    LOCAL_IDS
    for (int e = tid; e < 4 * 1536 / 4; e += NTHR) ((float4*)smem)[e] = ((const float4*)a.w_conv)[e];
    __syncthreads();
    for (int run = gw; run < NTOK / 8; run += ngw) post_in_run(a, run, lane, (const float*)smem);
    }
    GSYNC();
    {
    LOCAL_IDS
    for (int u = gw; u < 2048; u += ngw) gdn_prep_unit(a, u, lane, smem + wid * GDN_WLDS);
    }
    {
    LOCAL_IDS
    for (int v = gw; v < NST * 64; v += ngw) gdn_unit(a, v >> 6, (v >> 3) & 7, v & 7, a.state_gdn, a.out + O_GSS, NPT, 1, lane, smem + wid * GDN_WLDS);
    __syncthreads();
    }
    GSYNC();
    {
    LOCAL_IDS
    pg_gemm(lds, a.qan(), a.WqbT(), NPT, 768, 384, PgBf16{a.qraw(), 768});
    pg_gemm(lds, a.ckvb(), a.WkvT(), NPT, 1024, 256, PgBf16{a.kvraw(), 1024});
    gemm_sample_rows<false>(a.qan(), 384, a.WqbT(), 384, 768, EwF32{a.Q(), 768}, smem, bid, nb);
    gemm_sample_rows<false>(a.ckvb(), 256, a.WkvT(), 256, 1024, EwF32{a.KV(), 1024}, smem, bid, nb);
    for (int bh_ = nb - 1 - bid; bh_ < 64; bh_ += nb) gdn_scan_block(a, bh_, lds);
    }
    GSYNC();
    {
    LOCAL_IDS
    for (int idx = gw; idx < NST * 8; idx += ngw) { post_q_item(a, NPT * 8 + idx, lane); post_kv_item(a, NPT * 8 + idx, lane); }
    for (int row = gw; row < NTOK; row += ngw) gdn_out_token(a, row, lane);
    for (int pr = bid; pr < 256; pr += nb) { const int bh_ = pr >> 2, s_ = pr & 3; attn_block(a, bh_ >> 3, bh_ & 7, 7 - s_, smem); attn_block(a, bh_ >> 3, bh_ & 7, s_, smem); }
    for (int u = bid; u < NST * 8; u += nb) samp_attn_unit(a, u, smem, lds);
    }
    GSYNC();
    {
    LOCAL_IDS
    for (int u0 = bid * 2; u0 < NST * 8; u0 += nb * 2) samp_comb_unit(a, u0 + half, smem + half * 4096);
    }
    GSYNC();
    {
    LOCAL_IDS
    pg_gemm(lds, a.omix(), a.WoT(), NPT, 1024, 1024, PgRes{a.x_prompt, a.H()});
    gemm_sample_rows<false>(a.omix(), 1024, a.WoT(), 1024, 1024, EwResX{a.x_sample, a.H()}, smem, bid, nb);
    }
    GSYNC();
    {
    LOCAL_IDS
    for (int row = gw; row < MPAD; row += ngw) rms1024_row(a.H() + (size_t)row * 1024, a.g_ffn, a.un() + (size_t)row * 1024, row >= NTOK, lane);
    }
    GSYNC();
    {
    LOCAL_IDS
    pg_gemm(lds, a.un(), a.WguT(), NPT, 2 * DFF, 1024, PgSwiglu{a.hid()});
    gemm_sample_rows<true>(a.un(), 1024, a.WguT(), 1024, 2 * DFF, EwBf16{a.hid(), DFF}, smem, bid, nb);
    }
    GSYNC();
    {
    LOCAL_IDS
    pg_gemm(lds, a.hid(), a.WdT(), NPT, 1024, DFF, PgRes{a.H(), a.H2()});
    gemm_sample_rows<false>(a.hid(), DFF, a.WdT(), DFF, 1024, EwResH{a.H(), a.H2()}, smem, bid, nb);
    }
    GSYNC();
    {
    LOCAL_IDS
    for (int row = gw; row < MPAD; row += ngw) rms1024_row(a.H2() + (size_t)row * 1024, a.g_ple, a.un2() + (size_t)row * 1024, row >= NTOK, lane);
    }
    GSYNC();
    {
    LOCAL_IDS
    pg_gemm(lds, a.un2(), a.WpgT(), NPT, 1024, 1024, PgPle{a.H2(), a.PP(), a.out});
    gemm_sample_rows<false>(a.un2(), 1024, a.WpgT(), 1024, 1024, EwPle{a.H2(), a.PP(), a.out}, smem, bid, nb);
    }
}

static inline char* carve(char*& p, size_t bytes) { char* r = p; p += (bytes + 255) & ~(size_t)255; return r; }

extern "C" void kernel_launch(void* const* d_in, const int* in_sizes, int n_in, void* d_out, int out_size, void* d_ws, size_t ws_size, hipStream_t stream) {
    MK a{};
    a.x_prompt = (const float*)d_in[0]; a.x_sample = (const float*)d_in[1]; a.cache_ckv = (const float*)d_in[2]; a.cache_krope = (const float*)d_in[3];
    a.state_gdn = (const float*)d_in[4]; a.state_conv = (const float*)d_in[5]; a.page_table = (const int*)d_in[6]; a.p_prompt = (const float*)d_in[7]; a.p_sample = (const float*)d_in[8];
    a.g_attn = (const float*)d_in[9]; a.w_in = (const float*)d_in[10]; a.w_conv = (const float*)d_in[11]; a.a_log = (const float*)d_in[12]; a.dt_bias = (const float*)d_in[13];
    a.g_gdn_out = (const float*)d_in[14]; a.g_q_a = (const float*)d_in[15]; a.w_q_b = (const float*)d_in[16]; a.g_q_nope = (const float*)d_in[17]; a.g_q_rope = (const float*)d_in[18];
    a.g_kv_a = (const float*)d_in[19]; a.g_k_rope = (const float*)d_in[20]; a.w_kv_b = (const float*)d_in[21]; a.g_k_nope = (const float*)d_in[22]; a.w_o = (const float*)d_in[23];
    a.g_ffn = (const float*)d_in[24]; a.w_gate = (const float*)d_in[25]; a.w_up = (const float*)d_in[26]; a.w_down = (const float*)d_in[27]; a.g_ple = (const float*)d_in[28];
    a.w_ple_gate = (const float*)d_in[29]; a.w_ple_proj = (const float*)d_in[30];
    a.out = (float*)d_out;
    a.ws = (char*)d_ws;
    if (WS_TOTAL > ws_size) { fprintf(stderr, "kernel_launch: workspace too small: need %zu have %zu\n", (size_t)WS_TOTAL, ws_size); return; }

    static int grid_blocks = 0;
    if (!grid_blocks) {
        int dev = 0, cus = 0, per_cu = 0;
        (void)hipGetDevice(&dev);
        (void)hipDeviceGetAttribute(&cus, hipDeviceAttributeMultiprocessorCount, dev);
        (void)hipFuncSetAttribute((const void*)mega, hipFuncAttributeMaxDynamicSharedMemorySize, LDS_BYTES);
        (void)hipOccupancyMaxActiveBlocksPerMultiprocessor(&per_cu, (const void*)mega, NTHR, LDS_BYTES);
        if (per_cu < 1) fprintf(stderr, "kernel_launch: occupancy query says %d blocks/CU\n", per_cu);
        grid_blocks = cus;
    }
    (void)hipMemsetAsync((char*)d_ws + WOF_ctl, 0, 16384, stream);
    void* args[] = {&a};
    hipError_t e = hipLaunchCooperativeKernel((const void*)mega, dim3(grid_blocks), dim3(NTHR), args, LDS_BYTES, stream);
    if (e != hipSuccess) fprintf(stderr, "cooperative launch failed: %s (grid %d)\n", hipGetErrorString(e), grid_blocks);
}
```

```cpp
#include <hip/hip_runtime.h>
#include <stdint.h>
#include <cstdio>
#include <hip/hip_cooperative_groups.h>
namespace cg = cooperative_groups;


__device__ __forceinline__ int otid();
#define PG8_TID() otid()
namespace pg8 {
#define PG8_LAS __attribute__((address_space(3)))
typedef unsigned short bf16_t;
typedef short bf16x8 __attribute__((ext_vector_type(8)));
typedef float f32x4 __attribute__((ext_vector_type(4)));
typedef unsigned u32x4 __attribute__((ext_vector_type(4)));
constexpr int BM = 256, BK = 64, HALF = 128, HTB = HALF * BK * 2  , STAGE_BYTES = 8 * HTB, NXCD = 8, WGM = 8;

__host__ __device__ __forceinline__ int lds_byte(int r, int c) { const int st = (r >> 4) * 2 + (c >> 5), rr = r & 15, cc = c & 31, ob = rr * 64 + cc * 2; return st * 1024 + (ob ^ (((ob >> 9) & 1) << 5)); }
__host__ __device__ __forceinline__ void stage_rc(int b, int& R, int& C) { const int st = b / 1024, sb = b % 1024, swz = sb ^ (((sb >> 9) & 1) << 5); R = (st >> 1) * 16 + swz / 64; C = (st & 1) * 32 + (swz % 64) / 2; }
__host__ __device__ __forceinline__ int perm32(int rho) { const int n = rho >> 4, i = rho & 15; return 8 * (i >> 2) + 4 * n + (i & 3); }

struct Unit { int pm, pn; };
struct Gemm { const bf16_t* A; const bf16_t* Bt; int M, N, K; };

struct StaticOrder {
    int nM, nN, nwg, G, c;
    __host__ __device__ void init(int M, int N, int G_, int c_) { nM = M / BM; nN = N / BM; nwg = nM * nN; G = G_; c = c_; }
    __host__ __device__ bool next(int i, Unit& u) const {
        const long L = (long)i * G + c; if (L >= nwg) return false;
        int wgid = (int)L; { const int q = nwg / NXCD, r = nwg % NXCD, xcd = wgid % NXCD, off = wgid / NXCD; wgid = (xcd < r ? xcd * (q + 1) : r * (q + 1) + (xcd - r) * q) + off; }
        const int nig = WGM * nN, gid = wgid / nig, fm = gid * WGM, gsz = (nM - fm) < WGM ? (nM - fm) : WGM;
        u.pm = fm + ((wgid % nig) % gsz); u.pn = (wgid % nig) / gsz; return true;
    }
    __device__ __forceinline__ void a_ready(const Unit&) const {}
    __device__ __forceinline__ void done(const Unit&) const {}
};

template <class Epi, class Sched, bool ALIGN_EPI = false, bool SP2 = false>
__device__ __forceinline__ void gemm_phase(PG8_LAS unsigned char* lds, const Gemm g, const Sched& S, const Epi& E) {
    const int tid = PG8_TID(), wid = __builtin_amdgcn_readfirstlane(tid >> 6), lane = tid & 63, wr = wid >> 2, wc = wid & 3, fr = lane & 15, fq = lane >> 4;
    const int K = g.K, nt = K / BK;
    unsigned voffA[2], voffB[2];
#pragma unroll
    for (int i = 0; i < 2; ++i) { int R, C; stage_rc(tid * 16 + i * 8192, R, C); const int Rb = Epi::PERM ? ((R & ~31) + perm32(R & 31)) : R;
        voffA[i] = (unsigned)(R * K + C) * 2u; voffB[i] = (unsigned)(Rb * K + C) * 2u; }
    const size_t kstep = (size_t)(BK * 2);
    const size_t hstep = (size_t)HALF * K * 2;
    const size_t tstep = 2 * hstep;
    const unsigned ldsw = (unsigned)wid * 1024u;
    const int aoff = lds_byte(wr * 64 + fr, fq * 8), boff = lds_byte(wc * 32 + fr, fq * 8);
#define PG8_SA(b, h) (((b) * 2 + (h)) * HTB)
#define PG8_SB(b, h) ((4 + (b) * 2 + (h)) * HTB)
#define PG8_STAGE(bufoff, gbase, voff) do { _Pragma("unroll") for (int _i = 0; _i < 2; ++_i) \
        __builtin_amdgcn_global_load_lds((const unsigned*)((const char*)(gbase) + (voff)[_i]), (PG8_LAS unsigned*)(lds + (bufoff) + ldsw + _i * 8192), 16, 0, 0); } while (0)
#define PG8_LDA(dst, b, h) do { _Pragma("unroll") for (int m = 0; m < 4; ++m) _Pragma("unroll") for (int k = 0; k < 2; ++k) dst[m][k] = *(const PG8_LAS bf16x8*)(lds + PG8_SA(b, h) + aoff + m * 2048 + k * 1024); } while (0)
#define PG8_LDB(dst, b, h) do { _Pragma("unroll") for (int n = 0; n < 2; ++n) _Pragma("unroll") for (int k = 0; k < 2; ++k) dst[n][k] = *(const PG8_LAS bf16x8*)(lds + PG8_SB(b, h) + boff + n * 2048 + k * 1024); } while (0)
#define PG8_MMA(ai, bj, At, Bt) do { __builtin_amdgcn_s_setprio(1); _Pragma("unroll") for (int m = 0; m < 4; ++m) _Pragma("unroll") for (int n = 0; n < 2; ++n) _Pragma("unroll") for (int k = 0; k < 2; ++k) \
        acc[ai][bj][m][n] = __builtin_amdgcn_mfma_f32_16x16x32_bf16(Bt[n][k], At[m][k], acc[ai][bj][m][n], 0, 0, 0); __builtin_amdgcn_s_setprio(0); } while (0)
#define PG8_WAIT_V(n) asm volatile("s_waitcnt vmcnt(" #n ")" ::: "memory")
#define PG8_WAIT_L(n) asm volatile("s_waitcnt lgkmcnt(" #n ")" ::: "memory")
#define PG8_BAR __builtin_amdgcn_s_barrier()
#define PG8_SCHED __builtin_amdgcn_sched_barrier(0)
    Unit cur, nxt; int ui = 0;
    if (!S.next(0, cur)) return;
    f32x4 acc[2][2][4][2];
#pragma unroll
    for (int a = 0; a < 2; ++a)
#pragma unroll
        for (int b = 0; b < 2; ++b)
#pragma unroll
            for (int m = 0; m < 4; ++m)
#pragma unroll
                for (int n = 0; n < 2; ++n) acc[a][b][m][n] = (f32x4){0.f, 0.f, 0.f, 0.f};
    bf16x8 At[4][2], B0[2][2], B1[2][2];
    const char* cA = (const char*)g.A + (size_t)cur.pm * tstep; const char* cB = (const char*)g.Bt + (size_t)cur.pn * tstep;
    S.a_ready(cur);
    if constexpr (SP2) {
        PG8_STAGE(PG8_SB(0, 0), cB, voffB); PG8_STAGE(PG8_SB(0, 1), cB + hstep, voffB); PG8_STAGE(PG8_SA(0, 0), cA, voffA); PG8_STAGE(PG8_SA(0, 1), cA + hstep, voffA);
        if (wr == 1) PG8_BAR;
        PG8_WAIT_V(2); PG8_BAR;
        PG8_STAGE(PG8_SB(1, 0), cB + kstep, voffB); PG8_STAGE(PG8_SA(1, 0), cA + kstep, voffA); PG8_STAGE(PG8_SB(1, 1), cB + hstep + kstep, voffB);
        PG8_WAIT_V(6); PG8_BAR;
    } else {
        PG8_STAGE(PG8_SB(0, 0), cB, voffB); PG8_STAGE(PG8_SA(0, 0), cA, voffA); PG8_STAGE(PG8_SB(0, 1), cB + hstep, voffB); PG8_STAGE(PG8_SA(0, 1), cA + hstep, voffA);
        if (wr == 1) PG8_BAR;
        PG8_WAIT_V(4); PG8_BAR;
        PG8_STAGE(PG8_SB(1, 0), cB + kstep, voffB); PG8_STAGE(PG8_SA(1, 0), cA + kstep, voffA); PG8_STAGE(PG8_SB(1, 1), cB + hstep + kstep, voffB);
        PG8_WAIT_V(6); PG8_BAR;
    }
    for (;;) {
        const bool has_next = S.next(ui + 1, nxt);
        const char* nA = has_next ? (const char*)g.A + (size_t)nxt.pm * tstep : cA; const char* nB = has_next ? (const char*)g.Bt + (size_t)nxt.pn * tstep : cB;
        for (int t = 0; t < nt; t += 2) {
            const bool last = (t == nt - 2);
            const char* a1 = cA + (size_t)(t + 1) * kstep;
            const char* a2 = last ? nA : cA + (size_t)(t + 2) * kstep; const char* b2 = last ? nB : cB + (size_t)(t + 2) * kstep;
            const char* a3 = a2 + kstep; const char* b3 = b2 + kstep;
            if (last && has_next) S.a_ready(nxt);
            if constexpr (SP2) {
            PG8_LDB(B0, 0, 0); PG8_LDB(B1, 0, 1); PG8_SCHED; PG8_LDA(At, 0, 0); PG8_STAGE(PG8_SA(1, 1), a1 + hstep, voffA);
            PG8_WAIT_V(8); PG8_WAIT_L(0); PG8_BAR; PG8_MMA(0, 0, At, B0); PG8_MMA(0, 1, At, B1); PG8_BAR; PG8_SCHED;
            PG8_LDA(At, 0, 1); PG8_STAGE(PG8_SB(0, 0), b2, voffB); PG8_STAGE(PG8_SB(0, 1), b2 + hstep, voffB); PG8_STAGE(PG8_SA(0, 0), a2, voffA);
            PG8_WAIT_V(8); PG8_WAIT_L(0); PG8_BAR; PG8_MMA(1, 0, At, B0); PG8_MMA(1, 1, At, B1); PG8_BAR; PG8_SCHED;
            PG8_LDB(B0, 1, 0); PG8_LDB(B1, 1, 1); PG8_SCHED; PG8_LDA(At, 1, 0); PG8_STAGE(PG8_SA(0, 1), a2 + hstep, voffA);
            PG8_WAIT_V(8); PG8_WAIT_L(0); PG8_BAR; PG8_MMA(0, 0, At, B0); PG8_MMA(0, 1, At, B1); PG8_BAR; PG8_SCHED;
            PG8_LDA(At, 1, 1); PG8_STAGE(PG8_SB(1, 0), b3, voffB); PG8_STAGE(PG8_SB(1, 1), b3 + hstep, voffB); PG8_STAGE(PG8_SA(1, 0), a3, voffA);
            PG8_WAIT_V(8); PG8_WAIT_L(0); PG8_BAR; PG8_MMA(1, 0, At, B0); PG8_MMA(1, 1, At, B1); PG8_BAR; PG8_SCHED;
            } else {
            PG8_LDB(B0, 0, 0); PG8_SCHED; PG8_LDA(At, 0, 0); PG8_STAGE(PG8_SA(1, 1), a1 + hstep, voffA);
            PG8_WAIT_L(8); PG8_BAR; PG8_WAIT_L(0); PG8_MMA(0, 0, At, B0); PG8_BAR; PG8_SCHED;
            PG8_LDB(B1, 0, 1); PG8_STAGE(PG8_SB(0, 0), b2, voffB);
            PG8_BAR; PG8_WAIT_L(0); PG8_MMA(0, 1, At, B1); PG8_BAR;
            PG8_LDA(At, 0, 1); PG8_STAGE(PG8_SA(0, 0), a2, voffA);
            PG8_BAR; PG8_WAIT_L(0); PG8_MMA(1, 0, At, B0); PG8_BAR; PG8_SCHED;
            PG8_STAGE(PG8_SB(0, 1), b2 + hstep, voffB);
            PG8_WAIT_V(6); PG8_BAR; PG8_MMA(1, 1, At, B1); PG8_BAR;
            PG8_LDB(B0, 1, 0); PG8_SCHED; PG8_LDA(At, 1, 0); PG8_STAGE(PG8_SA(0, 1), a2 + hstep, voffA);
            PG8_WAIT_L(8); PG8_BAR; PG8_WAIT_L(0); PG8_MMA(0, 0, At, B0); PG8_BAR; PG8_SCHED;
            PG8_LDB(B1, 1, 1); PG8_STAGE(PG8_SB(1, 0), b3, voffB);
            PG8_BAR; PG8_WAIT_L(0); PG8_MMA(0, 1, At, B1); PG8_BAR;
            PG8_LDA(At, 1, 1); PG8_STAGE(PG8_SA(1, 0), a3, voffA);
            PG8_BAR; PG8_WAIT_L(0); PG8_MMA(1, 0, At, B0); PG8_BAR; PG8_SCHED;
            PG8_STAGE(PG8_SB(1, 1), b3 + hstep, voffB);
            PG8_WAIT_V(6); PG8_BAR; PG8_MMA(1, 1, At, B1); PG8_BAR;
            }
        }
        if constexpr (ALIGN_EPI) { if (wr == 0) PG8_BAR; }
        if constexpr (!Epi::AFTER_DRAIN) { E(acc, cur, wr, wc, fr, fq); S.done(cur); }
        if (!has_next) break;
#pragma unroll
        for (int a = 0; a < 2; ++a)
#pragma unroll
            for (int b = 0; b < 2; ++b)
#pragma unroll
                for (int m = 0; m < 4; ++m)
#pragma unroll
                    for (int n = 0; n < 2; ++n) acc[a][b][m][n] = (f32x4){0.f, 0.f, 0.f, 0.f};
        cur = nxt; cA = nA; cB = nB; ++ui;
        if constexpr (ALIGN_EPI) { if (wr == 1) PG8_BAR; }
    }
    PG8_WAIT_V(0);
    if constexpr (!ALIGN_EPI) { if (wr == 0) PG8_BAR; }
    PG8_BAR;
    if constexpr (Epi::AFTER_DRAIN) { E.fused(acc, cur, wr, wc, fr, fq, lds, wid, lane); S.done(cur); }
#undef PG8_SA
#undef PG8_SB
#undef PG8_STAGE
#undef PG8_LDA
#undef PG8_LDB
#undef PG8_MMA
#undef PG8_WAIT_V
#undef PG8_WAIT_L
#undef PG8_BAR
#undef PG8_SCHED
}
}

#define WTAB_OFF 155392
extern __shared__ __attribute__((aligned(16))) unsigned char lds_raw[];
__device__ __forceinline__ int hw_slot() { return (int)(__builtin_amdgcn_s_getreg((5 << 11) | 4) & 63u); }
__device__ __forceinline__ void otid_init() { const int t = threadIdx.x; if ((t & 63) == 0) ((__attribute__((address_space(3))) int*)(__attribute__((address_space(3))) void*)(lds_raw + WTAB_OFF))[hw_slot()] = t >> 6; }
__device__ __forceinline__ int otid() {
    const int w = __builtin_amdgcn_readfirstlane(((const __attribute__((address_space(3))) int*)(__attribute__((address_space(3))) void*)(lds_raw + WTAB_OFF))[hw_slot()]);
    int l; asm volatile("v_mbcnt_lo_u32_b32 %0, -1, 0\n\tv_mbcnt_hi_u32_b32 %0, -1, %0" : "=v"(l));
    return (w << 6) + l;
}
using pg8::bf16_t; using pg8::bf16x8; using pg8::f32x4; using pg8::u32x4;
#define LAS __attribute__((address_space(3)))

#define DMODEL 1024
#define NPT 16384
#define NST 32
#define NTOK 16416
#define MPAD 16640
#define SEQ 2048
#define ZW 2816
#define OFF_A 1536
#define OFF_B 1544
#define OFF_Z 1552
#define OFF_QA 2064
#define OFF_KVA 2448
#define OFF_KR 2704
#define DFF 2816
#define PAST 16384
#define NPAGES 128
#define EPSV 1e-6f

#define O_YP 0
#define O_YS (O_YP + 16777216)
#define O_CKVP (O_YS + 32768)
#define O_KRP (O_CKVP + 4194304)
#define O_GSP (O_KRP + 524288)
#define O_CSP (O_GSP + 262144)
#define O_CKVS (O_CSP + 36864)
#define O_KRS (O_CKVS + 8192)
#define O_GSS (O_KRS + 1024)
#define O_CSS (O_GSS + 1048576)

__device__ __forceinline__ bf16_t f2bf(float f) { unsigned u = __float_as_uint(f); return (bf16_t)((u + 0x7fffu + ((u >> 16) & 1u)) >> 16); }
__device__ __forceinline__ float bf2f(bf16_t b) { return __uint_as_float(((unsigned)b) << 16); }
__device__ __forceinline__ float wave_sum(float v) {
#pragma unroll
    for (int o = 1; o < 64; o <<= 1) v += __shfl_xor(v, o);
    return v;
}
__device__ __forceinline__ float sigmoidf_(float x) { return 1.f / (1.f + expf(-x)); }
__device__ __forceinline__ float siluf_(float x) { return x / (1.f + expf(-x)); }


#define WSYNC() do { __builtin_amdgcn_fence(__ATOMIC_ACQ_REL, "wavefront"); __builtin_amdgcn_wave_barrier(); } while (0)
#define NTHR 512
#define NWAVE 8

typedef float f32x2_t __attribute__((ext_vector_type(2)));
typedef __bf16 bf16x2_t __attribute__((ext_vector_type(2)));
__device__ __forceinline__ unsigned cvtpk(float lo, float hi) { f32x2_t v = {lo, hi}; bf16x2_t r = __builtin_convertvector(v, bf16x2_t); return __builtin_bit_cast(unsigned, r); }
__device__ __forceinline__ unsigned pk2bf(float lo, float hi) { return (unsigned)f2bf(lo) | ((unsigned)f2bf(hi) << 16); }

__device__ __forceinline__ void wt_item(const float* __restrict__ W, int ldw, int col0, int nvalid, bf16_t* __restrict__ WT, int ldt, int nrow0, int k0, float* scr, int lane) {
    WSYNC();
#pragma unroll 8
    for (int i = 0; i < 32; ++i) { const int kk = 2 * i + (lane >> 5), n = lane & 31; scr[kk * 33 + n] = n < nvalid ? W[(size_t)(k0 + kk) * ldw + col0 + n] : 0.f; }
    WSYNC();
    const int c = lane & 7;
#pragma unroll
    for (int j = 0; j < 4; ++j) { const int n = (lane >> 3) + 8 * j; const float* sp = scr + (8 * c) * 33 + n;
        u32x4 o; o.x = cvtpk(sp[0], sp[33]); o.y = cvtpk(sp[2 * 33], sp[3 * 33]); o.z = cvtpk(sp[4 * 33], sp[5 * 33]); o.w = cvtpk(sp[6 * 33], sp[7 * 33]);
        *(u32x4*)(WT + (size_t)(nrow0 + n) * ldt + k0 + 8 * c) = o; }
}

__device__ __forceinline__ void rms1024_row(const float* __restrict__ src, const float* __restrict__ g, bf16_t* __restrict__ o, bool zero, int lane) {
    if (zero) { for (int j = 0; j < 4; ++j) { ushort4 z = {0, 0, 0, 0}; *(ushort4*)(o + lane * 4 + 256 * j) = z; } return; }
    float4 v[4]; float ss = 0.f;
#pragma unroll
    for (int j = 0; j < 4; ++j) { v[j] = *(const float4*)(src + lane * 4 + 256 * j); ss += v[j].x * v[j].x + v[j].y * v[j].y + v[j].z * v[j].z + v[j].w * v[j].w; }
    ss = wave_sum(ss);
    const float rs = rsqrtf(ss * (1.f / 1024.f) + EPSV);
#pragma unroll
    for (int j = 0; j < 4; ++j) {
        const float4 gg = *(const float4*)(g + lane * 4 + 256 * j);
        ushort4 w; w.x = f2bf(v[j].x * rs * gg.x); w.y = f2bf(v[j].y * rs * gg.y); w.z = f2bf(v[j].z * rs * gg.z); w.w = f2bf(v[j].w * rs * gg.w);
        *(ushort4*)(o + lane * 4 + 256 * j) = w;
    }
}

struct ABf16 { const bf16_t* p; int lda; __device__ __forceinline__ bf16x8 load(int m, int k) const { return *(const bf16x8*)(p + (size_t)m * lda + k); } };
struct ACache {
    const float* cache; const int* pt;
    __device__ __forceinline__ bf16x8 load(int m, int k) const {
        const int b = m >> 14, t = m & 16383; const int phys = pt[b * NPAGES + (t >> 7)];
        const float* r = cache + ((size_t)phys * 128 + (t & 127)) * 256 + k;
        const float4 a = *(const float4*)r, c = *(const float4*)(r + 4);
        bf16x8 o; o[0] = (short)f2bf(a.x); o[1] = (short)f2bf(a.y); o[2] = (short)f2bf(a.z); o[3] = (short)f2bf(a.w);
        o[4] = (short)f2bf(c.x); o[5] = (short)f2bf(c.y); o[6] = (short)f2bf(c.z); o[7] = (short)f2bf(c.w); return o;
    }
};
template <class AL, class Epi>
__device__ __forceinline__ void gemm_tile_256x128(const AL& al, const bf16_t* __restrict__ Bt, int ldb, int K, const Epi& epi, int m0, int n0, char* smem) {
    bf16_t (*sA)[40] = (bf16_t (*)[40])smem;
    bf16_t (*sB)[40] = (bf16_t (*)[40])(smem + 20480);
    const int tid = otid(), lane = tid & 63, wid = tid >> 6, wm = wid >> 1, wn = wid & 1;
    f32x4 acc[4][4];
#pragma unroll
    for (int i = 0; i < 4; ++i)
#pragma unroll
        for (int j = 0; j < 4; ++j) acc[i][j] = (f32x4){0.f, 0.f, 0.f, 0.f};
    __syncthreads();
    for (int k0 = 0; k0 < K; k0 += 32) {
#pragma unroll
        for (int i = 0; i < 2; ++i) { const int ch = tid + 512 * i, r = ch >> 2, kc = (ch & 3) * 8; *(bf16x8*)&sA[r][kc] = al.load(m0 + r, k0 + kc); }
        { const int r = tid >> 2, kc = (tid & 3) * 8; *(bf16x8*)&sB[r][kc] = *(const bf16x8*)(Bt + (size_t)(n0 + r) * ldb + k0 + kc); }
        __syncthreads();
        bf16x8 af[4], bfr[4];
#pragma unroll
        for (int i = 0; i < 4; ++i) af[i] = *(const bf16x8*)&sA[wm * 64 + i * 16 + (lane & 15)][(lane >> 4) * 8];
#pragma unroll
        for (int j = 0; j < 4; ++j) bfr[j] = *(const bf16x8*)&sB[wn * 64 + j * 16 + (lane & 15)][(lane >> 4) * 8];
#pragma unroll
        for (int i = 0; i < 4; ++i)
#pragma unroll
            for (int j = 0; j < 4; ++j) acc[i][j] = __builtin_amdgcn_mfma_f32_16x16x32_bf16(af[i], bfr[j], acc[i][j], 0, 0, 0);
        __syncthreads();
    }
#pragma unroll
    for (int i = 0; i < 4; ++i)
#pragma unroll
        for (int j = 0; j < 4; ++j)
#pragma unroll
            for (int r = 0; r < 4; ++r) epi(m0 + wm * 64 + i * 16 + (lane >> 4) * 4 + r, n0 + wn * 64 + j * 16 + (lane & 15), acc[i][j][r]);
}
template <class Epi>
__device__ __forceinline__ void gemm_tile_32x256(const bf16_t* __restrict__ A, int lda, const bf16_t* __restrict__ Bt, int ldb, int K, const Epi& epi, int m0, int n0, char* smem) {
    bf16_t (*sA)[40] = (bf16_t (*)[40])smem;
    bf16_t (*sB)[40] = (bf16_t (*)[40])(smem + 2560);
    const int tid = otid(), lane = tid & 63, wid = tid >> 6;
    f32x4 acc[2][2];
#pragma unroll
    for (int i = 0; i < 2; ++i)
#pragma unroll
        for (int j = 0; j < 2; ++j) acc[i][j] = (f32x4){0.f, 0.f, 0.f, 0.f};
    __syncthreads();
    for (int k0 = 0; k0 < K; k0 += 32) {
        if (tid < 128) { const int r = tid >> 2, kc = (tid & 3) * 8; *(bf16x8*)&sA[r][kc] = *(const bf16x8*)(A + (size_t)(m0 + r) * lda + k0 + kc); }
#pragma unroll
        for (int i = 0; i < 2; ++i) { const int ch = tid + 512 * i, r = ch >> 2, kc = (ch & 3) * 8; *(bf16x8*)&sB[r][kc] = *(const bf16x8*)(Bt + (size_t)(n0 + r) * ldb + k0 + kc); }
        __syncthreads();
        bf16x8 af[2], bfr[2];
#pragma unroll
        for (int i = 0; i < 2; ++i) af[i] = *(const bf16x8*)&sA[i * 16 + (lane & 15)][(lane >> 4) * 8];
#pragma unroll
        for (int j = 0; j < 2; ++j) bfr[j] = *(const bf16x8*)&sB[wid * 32 + j * 16 + (lane & 15)][(lane >> 4) * 8];
#pragma unroll
        for (int i = 0; i < 2; ++i)
#pragma unroll
            for (int j = 0; j < 2; ++j) acc[i][j] = __builtin_amdgcn_mfma_f32_16x16x32_bf16(af[i], bfr[j], acc[i][j], 0, 0, 0);
        __syncthreads();
    }
#pragma unroll
    for (int i = 0; i < 2; ++i)
#pragma unroll
        for (int j = 0; j < 2; ++j)
#pragma unroll
            for (int r = 0; r < 4; ++r) epi(m0 + i * 16 + (lane >> 4) * 4 + r, n0 + wid * 32 + j * 16 + (lane & 15), acc[i][j][r]);
}
template <bool SWIGLU, class Epi>
__device__ __forceinline__ void gemm_sample_rows(const bf16_t* __restrict__ A, int lda, const bf16_t* __restrict__ Bt, int K, int N, const Epi& epi, char*  , int bid, int nb) {
    const int tid = otid(), lane = tid & 63, wid = tid >> 6, i16 = lane & 15, q4 = lane >> 4;
    for (int u = nb - 1 - bid; u < N / 256; u += nb) {
        const int n0 = u * 256;
        const int c0 = SWIGLU ? n0 + 16 * wid : n0 + 32 * wid, c1 = SWIGLU ? n0 + 128 + 16 * wid : n0 + 32 * wid + 16;
        const bf16_t* a0p = A + (size_t)(NPT + i16) * lda + 8 * q4; const bf16_t* a1p = a0p + (size_t)16 * lda;
        const bf16_t* b0p = Bt + (size_t)(c0 + i16) * K + 8 * q4; const bf16_t* b1p = Bt + (size_t)(c1 + i16) * K + 8 * q4;
        f32x4 acc[2][2];
#pragma unroll
        for (int i = 0; i < 2; ++i)
#pragma unroll
            for (int j = 0; j < 2; ++j) acc[i][j] = (f32x4){0.f, 0.f, 0.f, 0.f};
#pragma unroll 4
        for (int k0 = 0; k0 < K; k0 += 32) {
            const bf16x8 a0 = *(const bf16x8*)(a0p + k0), a1 = *(const bf16x8*)(a1p + k0), b0 = *(const bf16x8*)(b0p + k0), b1 = *(const bf16x8*)(b1p + k0);
            acc[0][0] = __builtin_amdgcn_mfma_f32_16x16x32_bf16(a0, b0, acc[0][0], 0, 0, 0); acc[0][1] = __builtin_amdgcn_mfma_f32_16x16x32_bf16(a0, b1, acc[0][1], 0, 0, 0);
            acc[1][0] = __builtin_amdgcn_mfma_f32_16x16x32_bf16(a1, b0, acc[1][0], 0, 0, 0); acc[1][1] = __builtin_amdgcn_mfma_f32_16x16x32_bf16(a1, b1, acc[1][1], 0, 0, 0);
        }
#pragma unroll
        for (int i = 0; i < 2; ++i)
#pragma unroll
            for (int r = 0; r < 4; ++r) {
                const int m = NPT + 16 * i + 4 * q4 + r;
                if constexpr (SWIGLU) epi(m, (n0 >> 1) + 16 * wid + i16, siluf_(acc[i][0][r]) * acc[i][1][r]);
                else { epi(m, c0 + i16, acc[i][0][r]); epi(m, c1 + i16, acc[i][1][r]); }
            }
    }
}
template <bool SWIGLU, class Epi>
__device__ __forceinline__ void gemm_sample_rows_ks(const bf16_t* __restrict__ A, int lda, const bf16_t* __restrict__ Bt, int K, int N, const Epi& epi, char* smem, int bid, int nb) {
    const int tid = otid(), lane = tid & 63, wid = tid >> 6, i16 = lane & 15, q4 = lane >> 4;
    const int nunits = N / 64, ksl = K >> 3;
    f32x4* red = (f32x4*)smem;
    for (int u = nb - 1 - bid; u < nunits; u += nb) {
        int brow[4];
#pragma unroll
        for (int j = 0; j < 4; ++j) brow[j] = SWIGLU ? ((32 * u) >> 7) * 256 + ((32 * u) & 127) + 128 * (j >> 1) + 16 * (j & 1) + i16 : 64 * u + 16 * j + i16;
        const bf16_t* a0p = A + (size_t)(NPT + i16) * lda + wid * ksl + 8 * q4; const bf16_t* a1p = a0p + (size_t)16 * lda;
        f32x4 acc[2][4];
#pragma unroll
        for (int i = 0; i < 2; ++i)
#pragma unroll
            for (int j = 0; j < 4; ++j) acc[i][j] = (f32x4){0.f, 0.f, 0.f, 0.f};
        for (int k0 = 0; k0 < ksl; k0 += 32) {
            const bf16x8 a0 = *(const bf16x8*)(a0p + k0), a1 = *(const bf16x8*)(a1p + k0);
            bf16x8 b[4];
#pragma unroll
            for (int j = 0; j < 4; ++j) b[j] = *(const bf16x8*)(Bt + (size_t)brow[j] * K + wid * ksl + 8 * q4 + k0);
#pragma unroll
            for (int j = 0; j < 4; ++j) { acc[0][j] = __builtin_amdgcn_mfma_f32_16x16x32_bf16(a0, b[j], acc[0][j], 0, 0, 0); acc[1][j] = __builtin_amdgcn_mfma_f32_16x16x32_bf16(a1, b[j], acc[1][j], 0, 0, 0); }
        }
        __syncthreads();
#pragma unroll
        for (int i = 0; i < 2; ++i)
#pragma unroll
            for (int j = 0; j < 4; ++j) red[(wid * 8 + i * 4 + j) * 64 + lane] = acc[i][j];
        __syncthreads();
        if constexpr (SWIGLU) {
            if (tid < 256) {
                const int t4 = tid >> 6, i = t4 >> 1, jg = t4 & 1, l = tid & 63;
                f32x4 g = red[(i * 4 + jg) * 64 + l], up = red[(i * 4 + jg + 2) * 64 + l];
#pragma unroll
                for (int w = 1; w < 8; ++w) { g = g + red[(w * 8 + i * 4 + jg) * 64 + l]; up = up + red[(w * 8 + i * 4 + jg + 2) * 64 + l]; }
#pragma unroll
                for (int r = 0; r < 4; ++r) epi(NPT + 16 * i + 4 * (l >> 4) + r, 32 * u + 16 * jg + (l & 15), siluf_(g[r]) * up[r]);
            }
        } else {
            const int t8 = tid >> 6, l = tid & 63, i = t8 >> 2, j = t8 & 3;
            f32x4 v = red[t8 * 64 + l];
#pragma unroll
            for (int w = 1; w < 8; ++w) v = v + red[(w * 8 + t8) * 64 + l];
#pragma unroll
            for (int r = 0; r < 4; ++r) epi(NPT + 16 * i + 4 * (l >> 4) + r, 64 * u + 16 * j + (l & 15), v[r]);
        }
    }
    __syncthreads();
}
struct EwF32 { float* C; int ldc; __device__ __forceinline__ void operator()(int m, int n, float v) const { C[(size_t)m * ldc + n] = v; } };
struct EwBf16 { bf16_t* C; int ldc; __device__ __forceinline__ void operator()(int m, int n, float v) const { C[(size_t)m * ldc + n] = f2bf(v); } };
struct EwResX { const float* xs; float* C; __device__ __forceinline__ void operator()(int m, int n, float v) const { C[(size_t)m * 1024 + n] = xs[(size_t)(m - NPT) * 1024 + n] + v; } };
struct EwSwiglu {
    float* G; bf16_t* Hd;
    __device__ __forceinline__ void operator()(int m, int n, float v) const {
        const int f = (n >> 8) * 128 + (n & 127);
        if ((n & 255) < 128) G[(size_t)(m - NPT) * DFF + f] = v;
    }
};
struct EwSwiglu2 {
    const float* G; bf16_t* Hd;
    __device__ __forceinline__ void operator()(int m, int n, float v) const {
        const int f = (n >> 8) * 128 + (n & 127);
        if ((n & 255) >= 128) Hd[(size_t)m * DFF + f] = f2bf(siluf_(G[(size_t)(m - NPT) * DFF + f]) * v);
    }
};
struct EwResH { const float* H; float* C; __device__ __forceinline__ void operator()(int m, int n, float v) const { C[(size_t)m * 1024 + n] = H[(size_t)m * 1024 + n] + v; } };
struct EwPle { const float* H2; const float* PP; float* out;
    __device__ __forceinline__ void operator()(int m, int n, float v) const { out[O_YS + (size_t)(m - NPT) * 1024 + n] = H2[(size_t)m * 1024 + n] + PP[(size_t)m * 1024 + n] * sigmoidf_(v); } };

struct PgBf16 {
    static constexpr bool PERM = true, AFTER_DRAIN = false; bf16_t* O; int ldc;
    __device__ __forceinline__ void operator()(const f32x4 (&acc)[2][2][4][2], const pg8::Unit& u, int wr, int wc, int fr, int fq) const {
#pragma unroll
        for (int ai = 0; ai < 2; ++ai)
#pragma unroll
            for (int m = 0; m < 4; ++m) { bf16_t* rowp = O + (size_t)(u.pm * 256 + ai * 128 + wr * 64 + m * 16 + fr) * ldc + u.pn * 256 + wc * 32 + 8 * fq;
#pragma unroll
                for (int bj = 0; bj < 2; ++bj) { const f32x4 v0 = acc[ai][bj][m][0], v1 = acc[ai][bj][m][1]; u32x4 w; w.x = pk2bf(v0[0], v0[1]); w.y = pk2bf(v0[2], v0[3]); w.z = pk2bf(v1[0], v1[1]); w.w = pk2bf(v1[2], v1[3]); *(u32x4*)(rowp + bj * 128) = w; } }
    }
};
struct PgF32 {
    static constexpr bool PERM = false, AFTER_DRAIN = false; float* O; int ldc;
    __device__ __forceinline__ void operator()(const f32x4 (&acc)[2][2][4][2], const pg8::Unit& u, int wr, int wc, int fr, int fq) const {
#pragma unroll
        for (int ai = 0; ai < 2; ++ai)
#pragma unroll
            for (int m = 0; m < 4; ++m) { float* rowp = O + (size_t)(u.pm * 256 + ai * 128 + wr * 64 + m * 16 + fr) * ldc + u.pn * 256 + wc * 32 + 4 * fq;
#pragma unroll
                for (int bj = 0; bj < 2; ++bj)
#pragma unroll
                    for (int n = 0; n < 2; ++n) *(f32x4*)(rowp + bj * 128 + n * 16) = acc[ai][bj][m][n]; }
    }
};
struct PgRes {
    static constexpr bool PERM = false, AFTER_DRAIN = false; const float* R; float* O;
    __device__ __forceinline__ void operator()(const f32x4 (&acc)[2][2][4][2], const pg8::Unit& u, int wr, int wc, int fr, int fq) const {
#pragma unroll
        for (int ai = 0; ai < 2; ++ai)
#pragma unroll
            for (int m = 0; m < 4; ++m) { const size_t off = (size_t)(u.pm * 256 + ai * 128 + wr * 64 + m * 16 + fr) * 1024 + u.pn * 256 + wc * 32 + 4 * fq;
#pragma unroll
                for (int bj = 0; bj < 2; ++bj)
#pragma unroll
                    for (int n = 0; n < 2; ++n) { const f32x4 r = *(const f32x4*)(R + off + bj * 128 + n * 16); *(f32x4*)(O + off + bj * 128 + n * 16) = r + acc[ai][bj][m][n]; } }
    }
};
struct PgSwiglu {
    static constexpr bool PERM = true, AFTER_DRAIN = false; bf16_t* Hd;
    __device__ __forceinline__ void operator()(const f32x4 (&acc)[2][2][4][2], const pg8::Unit& u, int wr, int wc, int fr, int fq) const {
#pragma unroll
        for (int ai = 0; ai < 2; ++ai)
#pragma unroll
            for (int m = 0; m < 4; ++m) { bf16_t* rowp = Hd + (size_t)(u.pm * 256 + ai * 128 + wr * 64 + m * 16 + fr) * DFF + u.pn * 128 + wc * 32 + 8 * fq;
                float h[8];
#pragma unroll
                for (int n = 0; n < 2; ++n)
#pragma unroll
                    for (int i = 0; i < 4; ++i) h[n * 4 + i] = siluf_(acc[ai][0][m][n][i]) * acc[ai][1][m][n][i];
                u32x4 w; w.x = pk2bf(h[0], h[1]); w.y = pk2bf(h[2], h[3]); w.z = pk2bf(h[4], h[5]); w.w = pk2bf(h[6], h[7]); *(u32x4*)rowp = w; }
    }
};
struct PgPle {
    static constexpr bool PERM = false, AFTER_DRAIN = false; const float* H2; const float* PP; float* out;
    __device__ __forceinline__ void operator()(const f32x4 (&acc)[2][2][4][2], const pg8::Unit& u, int wr, int wc, int fr, int fq) const {
#pragma unroll
        for (int ai = 0; ai < 2; ++ai)
#pragma unroll
            for (int m = 0; m < 4; ++m) { const size_t off = (size_t)(u.pm * 256 + ai * 128 + wr * 64 + m * 16 + fr) * 1024 + u.pn * 256 + wc * 32 + 4 * fq;
#pragma unroll
                for (int bj = 0; bj < 2; ++bj)
#pragma unroll
                    for (int n = 0; n < 2; ++n) { const f32x4 h = *(const f32x4*)(H2 + off + bj * 128 + n * 16), pp = *(const f32x4*)(PP + off + bj * 128 + n * 16), a = acc[ai][bj][m][n]; f32x4 y;
#pragma unroll
                        for (int i = 0; i < 4; ++i) y[i] = h[i] + pp[i] * sigmoidf_(a[i]);
                        *(f32x4*)(out + O_YP + off + bj * 128 + n * 16) = y; } }
    }
};
template <class Epi>
__device__ __forceinline__ void pg_gemm(LAS unsigned char* lds, const bf16_t* A, const bf16_t* Bt, int M, int N, int K, const Epi& E) {
    pg8::Gemm g{A, Bt, M, N, K}; pg8::StaticOrder S; S.init(M, N, (int)gridDim.x, (int)blockIdx.x);
    pg8::gemm_phase<Epi, pg8::StaticOrder, true, true>(lds, g, S, E);
}

constexpr size_t WOF_WinT = 0ull;
constexpr size_t WOF_WqbT = 5767168ull;
constexpr size_t WOF_WkvT = 6356992ull;
constexpr size_t WOF_WknT = 6881280ull;
constexpr size_t WOF_WoT = 7143424ull;
constexpr size_t WOF_WguT = 9240576ull;
constexpr size_t WOF_WdT = 20774912ull;
constexpr size_t WOF_WpgT = 26542080ull;
constexpr size_t WOF_WppT = 28639232ull;
constexpr size_t WOF_xn = 29163520ull;
constexpr size_t WOF_pb = 63242240ull;
constexpr size_t WOF_Z = 71761920ull;
constexpr size_t WOF_qkv = 165478400ull;
constexpr size_t WOF_ropecs = 216596480ull;
constexpr size_t WOF_gg = 216858880ull;
constexpr size_t WOF_bb = 217391360ull;
constexpr size_t WOF_goraw = 217923840ull;
constexpr size_t WOF_gUT = 252002560ull;
constexpr size_t WOF_ggam = 285556992ull;
constexpr size_t WOF_gWn = 285565184ull;
constexpr size_t WOF_gQg = 302342400ull;
constexpr size_t WOF_gQK = 319119616ull;
constexpr size_t WOF_gKd = 335896832ull;
constexpr size_t WOF_qan = 352674048ull;
constexpr size_t WOF_ckvb = 365453568ull;
constexpr size_t WOF_krf = 373973248ull;
constexpr size_t WOF_Q = 376103168ull;
constexpr size_t WOF_qh = 427221248ull;
constexpr size_t WOF_KV = 478339328ull;
constexpr size_t WOF_kh = 546496768ull;
constexpr size_t WOF_omix = 580575488ull;
constexpr size_t WOF_KN = 614654208ull;
constexpr size_t WOF_SC = 1151525120ull;
constexpr size_t WOF_part = 1168302336ull;
constexpr size_t WOF_H = 1170432256ull;
constexpr size_t WOF_un = 1238589696ull;
constexpr size_t WOF_G = 1272668416ull;
constexpr size_t WOF_hid = 1273028864ull;
constexpr size_t WOF_H2 = 1366745344ull;
constexpr size_t WOF_un2 = 1434902784ull;
constexpr size_t WOF_PP = 1468981504ull;
constexpr size_t WOF_qraw = 1537138944ull;
constexpr size_t WOF_kvraw = 1562304768ull;
constexpr size_t WOF_krb = 1595859200ull;
constexpr size_t WOF_ctl = 1596907776ull;
constexpr size_t WS_TOTAL = 1596924160ull;
struct MK {
    const float *x_prompt, *x_sample, *cache_ckv, *cache_krope, *state_gdn, *state_conv; const int* page_table; const float *p_prompt, *p_sample;
    const float *g_attn, *w_in, *w_conv, *a_log, *dt_bias, *g_gdn_out, *g_q_a, *w_q_b, *g_q_nope, *g_q_rope, *g_kv_a, *g_k_rope, *w_kv_b, *g_k_nope, *w_o, *g_ffn, *w_gate, *w_up, *w_down, *g_ple, *w_ple_gate, *w_ple_proj;
    float* out; char* ws;
    __device__ __forceinline__ unsigned* ctl() const { return (unsigned*)(ws + WOF_ctl); }
    __device__ __forceinline__ bf16_t* WinT() const { return (bf16_t*)(ws + WOF_WinT); }
    __device__ __forceinline__ bf16_t* WqbT() const { return (bf16_t*)(ws + WOF_WqbT); }
    __device__ __forceinline__ bf16_t* WkvT() const { return (bf16_t*)(ws + WOF_WkvT); }
    __device__ __forceinline__ bf16_t* WknT() const { return (bf16_t*)(ws + WOF_WknT); }
    __device__ __forceinline__ bf16_t* WoT() const { return (bf16_t*)(ws + WOF_WoT); }
    __device__ __forceinline__ bf16_t* WguT() const { return (bf16_t*)(ws + WOF_WguT); }
    __device__ __forceinline__ bf16_t* WdT() const { return (bf16_t*)(ws + WOF_WdT); }
    __device__ __forceinline__ bf16_t* WpgT() const { return (bf16_t*)(ws + WOF_WpgT); }
    __device__ __forceinline__ bf16_t* WppT() const { return (bf16_t*)(ws + WOF_WppT); }
    __device__ __forceinline__ bf16_t* xn() const { return (bf16_t*)(ws + WOF_xn); }
    __device__ __forceinline__ bf16_t* pb() const { return (bf16_t*)(ws + WOF_pb); }
    __device__ __forceinline__ bf16_t* Z() const { return (bf16_t*)(ws + WOF_Z); }
    __device__ __forceinline__ bf16_t* qkv() const { return (bf16_t*)(ws + WOF_qkv); }
    __device__ __forceinline__ float* ropecs() const { return (float*)(ws + WOF_ropecs); }
    __device__ __forceinline__ float* gg() const { return (float*)(ws + WOF_gg); }
    __device__ __forceinline__ float* bb() const { return (float*)(ws + WOF_bb); }
    __device__ __forceinline__ float* goraw() const { return (float*)(ws + WOF_goraw); }
    __device__ __forceinline__ float* gUT() const { return (float*)(ws + WOF_gUT); }
    __device__ __forceinline__ float* ggam() const { return (float*)(ws + WOF_ggam); }
    __device__ __forceinline__ bf16_t* gWn() const { return (bf16_t*)(ws + WOF_gWn); }
    __device__ __forceinline__ bf16_t* gQg() const { return (bf16_t*)(ws + WOF_gQg); }
    __device__ __forceinline__ bf16_t* gQK() const { return (bf16_t*)(ws + WOF_gQK); }
    __device__ __forceinline__ bf16_t* gKd() const { return (bf16_t*)(ws + WOF_gKd); }
    __device__ __forceinline__ bf16_t* qan() const { return (bf16_t*)(ws + WOF_qan); }
    __device__ __forceinline__ bf16_t* ckvb() const { return (bf16_t*)(ws + WOF_ckvb); }
    __device__ __forceinline__ float* krf() const { return (float*)(ws + WOF_krf); }
    __device__ __forceinline__ float* Q() const { return (float*)(ws + WOF_Q); }
    __device__ __forceinline__ float* qh() const { return (float*)(ws + WOF_qh); }
    __device__ __forceinline__ float* KV() const { return (float*)(ws + WOF_KV); }
    __device__ __forceinline__ float* kh() const { return (float*)(ws + WOF_kh); }
    __device__ __forceinline__ bf16_t* omix() const { return (bf16_t*)(ws + WOF_omix); }
    __device__ __forceinline__ bf16_t* KN() const { return (bf16_t*)(ws + WOF_KN); }
    __device__ __forceinline__ float* SC() const { return (float*)(ws + WOF_SC); }
    __device__ __forceinline__ float* part() const { return (float*)(ws + WOF_part); }
    __device__ __forceinline__ float* H() const { return (float*)(ws + WOF_H); }
    __device__ __forceinline__ bf16_t* un() const { return (bf16_t*)(ws + WOF_un); }
    __device__ __forceinline__ float* G() const { return (float*)(ws + WOF_G); }
    __device__ __forceinline__ bf16_t* hid() const { return (bf16_t*)(ws + WOF_hid); }
    __device__ __forceinline__ float* H2() const { return (float*)(ws + WOF_H2); }
    __device__ __forceinline__ bf16_t* un2() const { return (bf16_t*)(ws + WOF_un2); }
    __device__ __forceinline__ float* PP() const { return (float*)(ws + WOF_PP); }
    __device__ __forceinline__ bf16_t* qraw() const { return (bf16_t*)(ws + WOF_qraw); }
    __device__ __forceinline__ bf16_t* kvraw() const { return (bf16_t*)(ws + WOF_kvraw); }
    __device__ __forceinline__ bf16_t* krb() const { return (bf16_t*)(ws + WOF_krb); }
};

__device__ __forceinline__ float fast_sigmoid(float x) { return __builtin_amdgcn_rcpf(1.f + __builtin_amdgcn_exp2f(-1.44269504f * x)); }
__device__ __forceinline__ void bf8_to_f32(const bf16x8& v, float* o) {
#pragma unroll
    for (int e = 0; e < 8; ++e) o[e] = __uint_as_float(((unsigned)(unsigned short)v[e]) << 16);
}
__device__ __forceinline__ bf16x8 f32_to_bf8(const float* x) {
    u32x4 w; w.x = cvtpk(x[0], x[1]); w.y = cvtpk(x[2], x[3]); w.z = cvtpk(x[4], x[5]); w.w = cvtpk(x[6], x[7]);
    return __builtin_bit_cast(bf16x8, w);
}
__device__ __forceinline__ void post_in_token(const MK& a, int row, int lane, const float* wcs, const bf16x8 (&w0)[3], const bf16x8 (&w1)[3], const bf16x8 (&w2)[3], const bf16x8 (&wcur)[3]) {
    const bool samp = row >= NPT;
    const int b = samp ? row - NPT : row >> 11, t = samp ? 0 : row & 2047, hd = lane >> 3;
    const bf16_t* z = a.Z() + (size_t)row * ZW;
    float y[24];
#pragma unroll
    for (int c3 = 0; c3 < 3; ++c3) {
        float p0[8], p1[8], p2[8], cu[8];
        bf8_to_f32(w0[c3], p0); bf8_to_f32(w1[c3], p1); bf8_to_f32(w2[c3], p2); bf8_to_f32(wcur[c3], cu);
        const float* wp = wcs + 512 * c3 + 8 * lane;
        const float4 a0 = *(const float4*)wp, a1 = *(const float4*)(wp + 4), b0 = *(const float4*)(wp + 1536), b1 = *(const float4*)(wp + 1540);
        const float4 c0 = *(const float4*)(wp + 3072), c1 = *(const float4*)(wp + 3076), d0 = *(const float4*)(wp + 4608), d1 = *(const float4*)(wp + 4612);
        const float k0[8] = {a0.x, a0.y, a0.z, a0.w, a1.x, a1.y, a1.z, a1.w}, k1[8] = {b0.x, b0.y, b0.z, b0.w, b1.x, b1.y, b1.z, b1.w};
        const float k2[8] = {c0.x, c0.y, c0.z, c0.w, c1.x, c1.y, c1.z, c1.w}, k3[8] = {d0.x, d0.y, d0.z, d0.w, d1.x, d1.y, d1.z, d1.w};
#pragma unroll
        for (int e = 0; e < 8; ++e) { const int c = 8 * c3 + e; const float v = k0[e] * p0[e] + k1[e] * p1[e] + k2[e] * p2[e] + k3[e] * cu[e]; y[c] = v * fast_sigmoid(v); }
        __builtin_amdgcn_sched_barrier(0);
    }
    float sq = 0.f, sk = 0.f;
#pragma unroll
    for (int e = 0; e < 8; ++e) { sq += y[e] * y[e]; sk += y[8 + e] * y[8 + e]; }
    sq += __shfl_xor(sq, 1); sk += __shfl_xor(sk, 1); sq += __shfl_xor(sq, 2); sk += __shfl_xor(sk, 2); sq += __shfl_xor(sq, 4); sk += __shfl_xor(sk, 4);
    const float rq = rsqrtf(sq + EPSV) * 0.125f, rk = rsqrtf(sk + EPSV);
#pragma unroll
    for (int e = 0; e < 8; ++e) { y[e] *= rq; y[8 + e] *= rk; }
    bf16_t* qo = a.qkv() + (size_t)row * 1536 + 8 * lane;
    *(bf16x8*)qo = f32_to_bf8(y); *(bf16x8*)(qo + 512) = f32_to_bf8(y + 8); *(bf16x8*)(qo + 1024) = f32_to_bf8(y + 16);
    __builtin_amdgcn_sched_barrier(0);
    if (!samp && t >= SEQ - 3) {
        float* cso = a.out + O_CSP + ((size_t)b * 3 + (t - (SEQ - 3))) * 1536 + 8 * lane;
#pragma unroll
        for (int j = 0; j < 3; ++j) { float cu[8]; bf8_to_f32(wcur[j], cu); *(float4*)(cso + 512 * j) = (float4){cu[0], cu[1], cu[2], cu[3]}; *(float4*)(cso + 512 * j + 4) = (float4){cu[4], cu[5], cu[6], cu[7]}; }
    }
    __builtin_amdgcn_sched_barrier(0);
    if (lane < 16) {
        const float v = bf2f(z[OFF_A + lane]);
        if (lane < 8) { const float xx = v + a.dt_bias[lane]; const float sp = xx > 20.f ? xx : log1pf(expf(xx)); a.gg()[(size_t)row * 8 + lane] = -expf(a.a_log[lane]) * sp; }
        else a.bb()[(size_t)row * 8 + lane - 8] = 1.f / (1.f + expf(-v));
    }
    __builtin_amdgcn_sched_barrier(0);
    float qa[8], cv[8], kr[8];
    { bf16x8 t8 = {0, 0, 0, 0, 0, 0, 0, 0}; if (lane < 48) t8 = *(const bf16x8*)(z + OFF_QA + 8 * lane); bf8_to_f32(t8, qa); }
    { bf16x8 t8 = {0, 0, 0, 0, 0, 0, 0, 0}; if (lane < 32) t8 = *(const bf16x8*)(z + OFF_KVA + 8 * lane); bf8_to_f32(t8, cv); }
    { bf16x8 t8 = {0, 0, 0, 0, 0, 0, 0, 0}; if (lane >= 32 && lane < 36) t8 = *(const bf16x8*)(z + OFF_KR + 8 * (lane - 32)); bf8_to_f32(t8, kr); }
    float s1 = 0.f, s2 = 0.f, s3 = 0.f;
#pragma unroll
    for (int e = 0; e < 8; ++e) { s1 += qa[e] * qa[e]; s2 += cv[e] * cv[e]; s3 += kr[e] * kr[e]; }
#pragma unroll
    for (int o = 1; o < 64; o <<= 1) { s1 += __shfl_xor(s1, o); s2 += __shfl_xor(s2, o); s3 += __shfl_xor(s3, o); }
    const float r1 = rsqrtf(s1 * (1.f / 384.f) + EPSV), r2 = rsqrtf(s2 * (1.f / 256.f) + EPSV), r3 = rsqrtf(s3 * (1.f / 32.f) + EPSV);
    if (lane < 48) {
        const float4 g0 = *(const float4*)(a.g_q_a + 8 * lane), g1 = *(const float4*)(a.g_q_a + 8 * lane + 4);
        float o[8] = {qa[0] * r1 * g0.x, qa[1] * r1 * g0.y, qa[2] * r1 * g0.z, qa[3] * r1 * g0.w, qa[4] * r1 * g1.x, qa[5] * r1 * g1.y, qa[6] * r1 * g1.z, qa[7] * r1 * g1.w};
        *(bf16x8*)(a.qan() + (size_t)row * 384 + 8 * lane) = f32_to_bf8(o);
    }
    if (lane < 32) {
        const float4 g0 = *(const float4*)(a.g_kv_a + 8 * lane), g1 = *(const float4*)(a.g_kv_a + 8 * lane + 4);
        float o[8] = {cv[0] * r2 * g0.x, cv[1] * r2 * g0.y, cv[2] * r2 * g0.z, cv[3] * r2 * g0.w, cv[4] * r2 * g1.x, cv[5] * r2 * g1.y, cv[6] * r2 * g1.z, cv[7] * r2 * g1.w};
        *(bf16x8*)(a.ckvb() + (size_t)row * 256 + 8 * lane) = f32_to_bf8(o);
        float* co = samp ? a.out + O_CKVS + (size_t)b * 256 + 8 * lane : a.out + O_CKVP + (size_t)row * 256 + 8 * lane;
        *(float4*)co = (float4){o[0], o[1], o[2], o[3]}; *(float4*)(co + 4) = (float4){o[4], o[5], o[6], o[7]};
    }
    __builtin_amdgcn_sched_barrier(0);
    {
        const int c4 = (lane - 32) & 3;
        float xn[8], ot[8];
#pragma unroll
        for (int e = 0; e < 8; ++e) xn[e] = kr[e] * r3 * a.g_k_rope[8 * c4 + e];
#pragma unroll
        for (int e = 0; e < 8; ++e) ot[e] = __shfl_xor(xn[e], 2);
        if (lane >= 32 && lane < 36) {
            const float* tb = a.ropecs() + (size_t)(samp ? 2048 : t) * 32 + ((8 * c4) & 15);
            float o[8];
#pragma unroll
            for (int e = 0; e < 8; ++e) { const float cs = tb[e], sn = tb[16 + e]; o[e] = c4 < 2 ? xn[e] * cs - ot[e] * sn : ot[e] * sn + xn[e] * cs; }
            float* kf_ = a.krf() + (size_t)row * 32 + 8 * c4; *(float4*)kf_ = (float4){o[0], o[1], o[2], o[3]}; *(float4*)(kf_ + 4) = (float4){o[4], o[5], o[6], o[7]};
            float* ko = samp ? a.out + O_KRS + (size_t)b * 32 + 8 * c4 : a.out + O_KRP + (size_t)row * 32 + 8 * c4;
            *(float4*)ko = (float4){o[0], o[1], o[2], o[3]}; *(float4*)(ko + 4) = (float4){o[4], o[5], o[6], o[7]};
            if (!samp) *(bf16x8*)(a.krb() + (size_t)row * 32 + 8 * c4) = f32_to_bf8(o);
        }
    }
    (void)hd;
}
__device__ __forceinline__ void post_in_run(const MK& a, int run, int lane_in, const float* wcs) {
    int lane = lane_in; asm volatile("" : "+v"(lane));
    if (run < NPT / 8) {
        const int row0 = run * 8, t0 = row0 & 2047;
        bf16x8 w0[3], w1[3], w2[3], wcur[3];
#pragma unroll
        for (int c3 = 0; c3 < 3; ++c3) {
            const bf16x8 zz = {0, 0, 0, 0, 0, 0, 0, 0}; w0[c3] = zz; w1[c3] = zz; w2[c3] = zz;
            if (t0 > 0) { const bf16_t* zp = a.Z() + (size_t)(row0 - 3) * ZW + 512 * c3 + 8 * lane; w0[c3] = *(const bf16x8*)zp; w1[c3] = *(const bf16x8*)(zp + ZW); w2[c3] = *(const bf16x8*)(zp + 2 * ZW); }
        }
#pragma unroll 1
        for (int k = 0; k < 8; ++k) {
            const int row = row0 + k;
#pragma unroll
            for (int c3 = 0; c3 < 3; ++c3) wcur[c3] = *(const bf16x8*)(a.Z() + (size_t)row * ZW + 512 * c3 + 8 * lane);
            post_in_token(a, row, lane, wcs, w0, w1, w2, wcur);
#pragma unroll
            for (int c3 = 0; c3 < 3; ++c3) { w0[c3] = w1[c3]; w1[c3] = w2[c3]; w2[c3] = wcur[c3]; }
        }
    } else {
#pragma unroll 1
        for (int k = 0; k < 8; ++k) {
            const int bsm = (run - NPT / 8) * 8 + k, row = NPT + bsm;
            bf16x8 w0[3], w1[3], w2[3], wcur[3];
#pragma unroll
            for (int c3 = 0; c3 < 3; ++c3) {
                const float* sp = a.state_conv + (size_t)bsm * 3 * 1536 + 512 * c3 + 8 * lane;
                float* cso = a.out + O_CSS + (size_t)bsm * 3 * 1536 + 512 * c3 + 8 * lane;
                float t0_[8], t1_[8], t2_[8], tc_[8];
#pragma unroll
                for (int e = 0; e < 8; ++e) { t0_[e] = sp[e]; t1_[e] = sp[1536 + e]; t2_[e] = sp[2 * 1536 + e]; }
                wcur[c3] = *(const bf16x8*)(a.Z() + (size_t)row * ZW + 512 * c3 + 8 * lane); bf8_to_f32(wcur[c3], tc_);
#pragma unroll
                for (int e = 0; e < 8; ++e) { cso[e] = t1_[e]; cso[1536 + e] = t2_[e]; cso[2 * 1536 + e] = tc_[e]; }
                w0[c3] = f32_to_bf8(t0_); w1[c3] = f32_to_bf8(t1_); w2[c3] = f32_to_bf8(t2_);
            }
            post_in_token(a, row, lane, wcs, w0, w1, w2, wcur);
        }
    }
}

__device__ __forceinline__ void post_q_item(const MK& a, int idx, int lane) {
    const int row = idx >> 3, h = idx & 7;
    const float* q = a.Q() + (size_t)row * 768 + h * 96;
    float* o = a.qh() + ((size_t)row * 8 + h) * 96;
    const float v = q[lane];
    const float ss = wave_sum(v * v);
    o[lane] = v * rsqrtf(ss * (1.f / 64.f) + EPSV) * a.g_q_nope[lane];
    const float r = lane < 32 ? q[64 + lane] : 0.f;
    const float s2 = wave_sum(r * r);
    const float xn = lane < 32 ? r * rsqrtf(s2 * (1.f / 32.f) + EPSV) * a.g_q_rope[lane] : 0.f;
    const float other = __shfl_xor(xn, 16);
    const int i = lane & 15;
    const float* tb = a.ropecs() + (size_t)(row >= NPT ? 2048 : (row & 2047)) * 32;
    const float cs = tb[i], sn = tb[16 + i];
    const float ov = lane < 16 ? xn * cs - other * sn : other * sn + xn * cs;
    if (lane < 32) o[64 + lane] = ov;
}
__device__ __forceinline__ void post_kv_item(const MK& a, int idx, int lane) {
    const int row = idx >> 3, h = idx & 7;
    const float v = a.KV()[(size_t)row * 1024 + h * 128 + lane];
    const float ss = wave_sum(v * v);
    const float kn = v * rsqrtf(ss * (1.f / 64.f) + EPSV) * a.g_k_nope[lane];
    a.kh()[((size_t)row * 8 + h) * 64 + lane] = kn;
}

typedef float f32x16 __attribute__((ext_vector_type(16)));
typedef short s16x4 __attribute__((ext_vector_type(4)));
#define KST 104
#define VST 72
#define ATT_BUF (64 * KST * 2 + 64 * VST * 2)
__device__ __forceinline__ int crow32(int r, int hi) { return (r & 3) + 8 * (r >> 2) + 4 * hi; }
__device__ __forceinline__ s16x4 tr_read(const bf16_t* p) { return __builtin_bit_cast(s16x4, __builtin_amdgcn_ds_read_tr16_b64_v4i16((LAS s16x4*)(LAS void*)(unsigned)(size_t)p)); }
__device__ __forceinline__ bf16x8 pack8(const f32x16& x, int s) {
    u32x4 w; w.x = pk2bf(x[8 * s], x[8 * s + 1]); w.y = pk2bf(x[8 * s + 2], x[8 * s + 3]); w.z = pk2bf(x[8 * s + 4], x[8 * s + 5]); w.w = pk2bf(x[8 * s + 6], x[8 * s + 7]);
    return __builtin_bit_cast(bf16x8, w);
}
__device__ __forceinline__ void attn_block(const MK& a, int b, int h, int qb, char* smem) {
    const int tid = otid(), lane = tid & 63, wid = tid >> 6, r32 = lane & 31, hi = lane >> 5;
    const int qrow = qb * 256 + wid * 32 + r32;
    const int wq0 = qb * 256 + wid * 32;
    bf16x8 qf[6];
    {
        const float SCL = 0.14724445f;
        const bf16_t* Qg = a.qraw() + ((size_t)b * SEQ + qrow) * 768 + h * 96 + 8 * hi;
        float qv[6][8];
#pragma unroll
        for (int ds = 0; ds < 6; ++ds) bf8_to_f32(*(const bf16x8*)(Qg + 16 * ds), qv[ds]);
        float sn_ = 0.f, sr_ = 0.f;
#pragma unroll
        for (int j = 0; j < 8; ++j) { sn_ += qv[0][j] * qv[0][j] + qv[1][j] * qv[1][j] + qv[2][j] * qv[2][j] + qv[3][j] * qv[3][j]; sr_ += qv[4][j] * qv[4][j] + qv[5][j] * qv[5][j]; }
        sn_ += __shfl_xor(sn_, 32); sr_ += __shfl_xor(sr_, 32);
        const float rsn = rsqrtf(sn_ * (1.f / 64.f) + EPSV) * SCL, rsr = rsqrtf(sr_ * (1.f / 32.f) + EPSV);
#pragma unroll
        for (int ds = 0; ds < 4; ++ds) {
            float o[8];
#pragma unroll
            for (int j = 0; j < 8; ++j) o[j] = qv[ds][j] * rsn * a.g_q_nope[16 * ds + 8 * hi + j];
            qf[ds] = f32_to_bf8(o);
        }
        const float* tb = a.ropecs() + (size_t)qrow * 32 + 8 * hi;
        float o4[8], o5[8];
#pragma unroll
        for (int j = 0; j < 8; ++j) {
            const float x1 = qv[4][j] * rsr * a.g_q_rope[8 * hi + j], x2 = qv[5][j] * rsr * a.g_q_rope[16 + 8 * hi + j], cs = tb[j], sn = tb[16 + j];
            o4[j] = (x1 * cs - x2 * sn) * SCL; o5[j] = (x1 * sn + x2 * cs) * SCL;
        }
        qf[4] = f32_to_bf8(o4); qf[5] = f32_to_bf8(o5);
    }
    f32x16 o0, o1;
#pragma unroll
    for (int r = 0; r < 16; ++r) { o0[r] = 0.f; o1[r] = 0.f; }
    float m = -INFINITY, l = 0.f;
    const int nt = qb * 4 + 4;
    const int vr = tid >> 3, vc = tid & 7, rr_ = (tid >> 2) & 63, rc = tid & 3;
    const bf16_t* KVg = a.kvraw() + (size_t)b * SEQ * 1024 + h * 128 + (size_t)vr * 1024 + vc * 8;
    const bf16_t* KRg = a.krb() + (size_t)b * SEQ * 32 + (size_t)rr_ * 32 + rc * 8;
    float gk[8];
#pragma unroll
    for (int j = 0; j < 8; ++j) gk[j] = a.g_k_nope[8 * vc + j];
    bf16x8 kr0, kr1, vr0;
#define ATT_LOAD(tt) do { kr0 = *(const bf16x8*)(KVg + (size_t)(tt) * 64 * 1024); vr0 = *(const bf16x8*)(KVg + (size_t)(tt) * 64 * 1024 + 64); if (tid < 256) kr1 = *(const bf16x8*)(KRg + (size_t)(tt) * 64 * 32); } while (0)
#define ATT_STORE(buf) do { bf16_t* Ks_ = (bf16_t*)(smem + (buf) * ATT_BUF); bf16_t* Vs_ = Ks_ + 64 * KST; \
        float x_[8]; bf8_to_f32(kr0, x_); float ss_ = 0.f; _Pragma("unroll") for (int j = 0; j < 8; ++j) ss_ += x_[j] * x_[j]; \
        ss_ += __shfl_xor(ss_, 1); ss_ += __shfl_xor(ss_, 2); ss_ += __shfl_xor(ss_, 4); const float rs_ = rsqrtf(ss_ * (1.f / 64.f) + EPSV); \
        _Pragma("unroll") for (int j = 0; j < 8; ++j) x_[j] *= rs_ * gk[j]; \
        *(bf16x8*)(Ks_ + vr * KST + vc * 8) = f32_to_bf8(x_); *(bf16x8*)(Vs_ + vr * VST + vc * 8) = vr0; \
        if (tid < 256) *(bf16x8*)(Ks_ + rr_ * KST + 64 + rc * 8) = kr1; } while (0)
    ATT_LOAD(0);
    __syncthreads();
    ATT_STORE(0);
    __syncthreads();
    const int i16 = lane & 15, qq = i16 >> 2, pp = i16 & 3, g1 = (lane >> 4) & 1;
    for (int t = 0; t < nt; ++t) {
        const bf16_t* Ks = (const bf16_t*)(smem + (t & 1) * ATT_BUF); const bf16_t* Vs = Ks + 64 * KST;
        if (t + 1 < nt) ATT_LOAD(t + 1);
        if (64 * t <= wq0 + 31) {
            f32x16 p0, p1;
#pragma unroll
            for (int r = 0; r < 16; ++r) { p0[r] = 0.f; p1[r] = 0.f; }
#pragma unroll
            for (int ds = 0; ds < 6; ++ds) {
                const bf16x8 k0 = *(const bf16x8*)(Ks + r32 * KST + 16 * ds + 8 * hi);
                const bf16x8 k1 = *(const bf16x8*)(Ks + (32 + r32) * KST + 16 * ds + 8 * hi);
                p0 = __builtin_amdgcn_mfma_f32_32x32x16_bf16(k0, qf[ds], p0, 0, 0, 0);
                p1 = __builtin_amdgcn_mfma_f32_32x32x16_bf16(k1, qf[ds], p1, 0, 0, 0);
            }
            if (64 * t + 63 > wq0) {
#pragma unroll
                for (int r = 0; r < 16; ++r) { const int kv = 64 * t + crow32(r, hi); if (kv > qrow) p0[r] = -INFINITY; if (kv + 32 > qrow) p1[r] = -INFINITY; }
            }
            float mx = fmaxf(p0[0], p1[0]);
#pragma unroll
            for (int r = 1; r < 16; ++r) mx = fmaxf(mx, fmaxf(p0[r], p1[r]));
            mx = fmaxf(mx, __shfl_xor(mx, 32));
            const float mn = fmaxf(m, mx);
            const float alpha = __builtin_amdgcn_exp2f(m - mn);
            m = mn;
            float rs = 0.f;
#pragma unroll
            for (int r = 0; r < 16; ++r) { p0[r] = __builtin_amdgcn_exp2f(p0[r] - mn); p1[r] = __builtin_amdgcn_exp2f(p1[r] - mn); rs += p0[r] + p1[r]; }
            l = l * alpha + rs;
#pragma unroll
            for (int r = 0; r < 16; ++r) { o0[r] *= alpha; o1[r] *= alpha; }
            bf16x8 pf[4];
            pf[0] = pack8(p0, 0); pf[1] = pack8(p0, 1); pf[2] = pack8(p1, 0); pf[3] = pack8(p1, 1);
#pragma unroll
            for (int ks = 0; ks < 4; ++ks) {
                const bf16_t* vb0 = Vs + (16 * ks + 4 * hi + qq) * VST + 16 * g1 + 4 * pp;
                const s16x4 a0 = tr_read(vb0), a1 = tr_read(vb0 + 8 * VST);
                const s16x4 c0 = tr_read(vb0 + 32), c1 = tr_read(vb0 + 8 * VST + 32);
                const bf16x8 va = __builtin_shufflevector(a0, a1, 0, 1, 2, 3, 4, 5, 6, 7);
                const bf16x8 vc_ = __builtin_shufflevector(c0, c1, 0, 1, 2, 3, 4, 5, 6, 7);
                o0 = __builtin_amdgcn_mfma_f32_32x32x16_bf16(va, pf[ks], o0, 0, 0, 0);
                o1 = __builtin_amdgcn_mfma_f32_32x32x16_bf16(vc_, pf[ks], o1, 0, 0, 0);
            }
        }
        if (t + 1 < nt) ATT_STORE((t + 1) & 1);
        __syncthreads();
    }
    l += __shfl_xor(l, 32);
    const float il = 1.f / l;
    bf16_t* op = a.omix() + ((size_t)b * SEQ + qrow) * 1024 + 512 + h * 64;
#pragma unroll
    for (int g = 0; g < 4; ++g) {
        uint2 w0, w1;
        w0.x = pk2bf(o0[4 * g] * il, o0[4 * g + 1] * il); w0.y = pk2bf(o0[4 * g + 2] * il, o0[4 * g + 3] * il);
        w1.x = pk2bf(o1[4 * g] * il, o1[4 * g + 1] * il); w1.y = pk2bf(o1[4 * g + 2] * il, o1[4 * g + 3] * il);
        *(uint2*)(op + 8 * g + 4 * hi) = w0;
        *(uint2*)(op + 32 + 8 * g + 4 * hi) = w1;
    }
#undef ATT_LOAD
#undef ATT_STORE
}

__device__ __forceinline__ void gdn_unit(const MK& a, int b, int h, int dvg, const float* s0, float* sout, int row0, int T, int lane, char* wsm) {
    float (*sq)[64] = (float (*)[64])wsm;
    float (*sk)[64] = (float (*)[64])(wsm + 4096);
    float (*sv)[8] = (float (*)[8])(wsm + 8192);
    float* sg = (float*)(wsm + 8704);
    float* sb = (float*)(wsm + 8768);
    const int e = lane & 7, ko = lane >> 3, col = dvg * 8 + e;
    float S[8];
#pragma unroll
    for (int d = 0; d < 8; ++d) S[d] = s0 ? s0[(((size_t)b * 8 + h) * 64 + ko * 8 + d) * 64 + col] : 0.f;
    const size_t rbase = (size_t)row0 + (size_t)b * T;
    float pq[16], pk[16], pv0, pv1, pgb;
    {
        const int nt = T < 16 ? T : 16;
#pragma unroll
        for (int j = 0; j < 16; ++j) { const bool ok = j < nt; const size_t r = rbase + (ok ? j : 0); pq[j] = ok ? bf2f(a.qkv()[r * 1536 + h * 64 + lane]) : 0.f; pk[j] = ok ? bf2f(a.qkv()[r * 1536 + 512 + h * 64 + lane]) : 0.f; }
        { const int j0 = lane >> 3, j1 = j0 + 8; pv0 = j0 < nt ? bf2f(a.qkv()[(rbase + j0) * 1536 + 1024 + h * 64 + dvg * 8 + (lane & 7)]) : 0.f; pv1 = j1 < nt ? bf2f(a.qkv()[(rbase + j1) * 1536 + 1024 + h * 64 + dvg * 8 + (lane & 7)]) : 0.f; }
        { const int j = lane & 15; pgb = j < nt ? (lane < 16 ? a.gg()[(rbase + j) * 8 + h] : a.bb()[(rbase + j) * 8 + h]) : 0.f; }
    }
    for (int t0 = 0; t0 < T; t0 += 16) {
        const int nt = (T - t0) < 16 ? (T - t0) : 16;
        WSYNC();
#pragma unroll
        for (int j = 0; j < 16; ++j) { sq[j][lane] = pq[j]; sk[j][lane] = pk[j]; }
        sv[lane >> 3][lane & 7] = pv0; sv[(lane >> 3) + 8][lane & 7] = pv1;
        if (lane < 16) sg[lane] = expf(pgb); else if (lane < 32) sb[lane - 16] = pgb;
        WSYNC();
        if (t0 + 16 < T) {
            const size_t rb = rbase + t0 + 16;
#pragma unroll
            for (int j = 0; j < 16; ++j) { pq[j] = bf2f(a.qkv()[(rb + j) * 1536 + h * 64 + lane]); pk[j] = bf2f(a.qkv()[(rb + j) * 1536 + 512 + h * 64 + lane]); }
            pv0 = bf2f(a.qkv()[(rb + (lane >> 3)) * 1536 + 1024 + h * 64 + dvg * 8 + (lane & 7)]); pv1 = bf2f(a.qkv()[(rb + (lane >> 3) + 8) * 1536 + 1024 + h * 64 + dvg * 8 + (lane & 7)]);
            pgb = lane < 16 ? a.gg()[(rb + (lane & 15)) * 8 + h] : a.bb()[(rb + (lane & 15)) * 8 + h];
        }
        for (int j = 0; j < nt; ++j) {
            const float dec = sg[j], be = sb[j], v = sv[j][e];
            const float4 k0 = *(const float4*)&sk[j][ko * 8], k1 = *(const float4*)&sk[j][ko * 8 + 4];
            const float4 q0 = *(const float4*)&sq[j][ko * 8], q1 = *(const float4*)&sq[j][ko * 8 + 4];
            const float kk[8] = {k0.x, k0.y, k0.z, k0.w, k1.x, k1.y, k1.z, k1.w};
            const float qq[8] = {q0.x, q0.y, q0.z, q0.w, q1.x, q1.y, q1.z, q1.w};
            float ks = 0.f;
#pragma unroll
            for (int d = 0; d < 8; ++d) { S[d] *= dec; ks += kk[d] * S[d]; }
            ks += __shfl_xor(ks, 8); ks += __shfl_xor(ks, 16); ks += __shfl_xor(ks, 32);
            const float delta = (v - ks) * be;
            float ov = 0.f;
#pragma unroll
            for (int d = 0; d < 8; ++d) { S[d] += kk[d] * delta; ov += qq[d] * S[d]; }
            ov += __shfl_xor(ov, 8); ov += __shfl_xor(ov, 16); ov += __shfl_xor(ov, 32);
            if (ko == 0) a.goraw()[(rbase + t0 + j) * 512 + h * 64 + col] = ov;
        }
    }
#pragma unroll
    for (int d = 0; d < 8; ++d) sout[(((size_t)b * 8 + h) * 64 + ko * 8 + d) * 64 + col] = S[d];
}
__device__ __forceinline__ bf16x8 ld8_f32_bf16(const float* p) {
    const float4 x = *(const float4*)p, y = *(const float4*)(p + 4);
    u32x4 w; w.x = cvtpk(x.x, x.y); w.y = cvtpk(x.z, x.w); w.z = cvtpk(y.x, y.y); w.w = cvtpk(y.z, y.w);
    return __builtin_bit_cast(bf16x8, w);
}
__device__ __forceinline__ int pi_pos(int k) { return (k & 32) + 8 * ((k >> 2) & 3) + 4 * ((k >> 4) & 1) + (k & 3); }
#define GDN_WLDS 17408
__device__ __forceinline__ void gdn_prep_unit(const MK& a, int u, int lane_in, char* wsm) {
    int lane = lane_in; asm volatile("" : "+v"(lane));
    const int bh = u >> 5, n = u & 31, b = bh >> 3, h = bh & 7, i16 = lane & 15, q4 = lane >> 4;
    const size_t row0 = (size_t)b * SEQ + n * 64;
    float* AT = (float*)wsm; float* GC = (float*)(wsm + 16384); float* BT = GC + 64;
    const bf16_t* qbase = a.qkv() + row0 * 1536 + h * 64; const bf16_t* kbase = qbase + 512; const bf16_t* vbase = qbase + 1024;
    float g = a.gg()[(row0 + lane) * 8 + h];
    const float be_l = a.bb()[(row0 + lane) * 8 + h];
#pragma unroll
    for (int o = 1; o < 64; o <<= 1) { const float t = __shfl_up(g, o); if (lane >= o) g += t; }
    WSYNC();
    GC[lane] = g; BT[lane] = be_l;
    WSYNC();
    const float gl = GC[63];
    float* EG = BT + 64; float* ED = EG + 64;
    EG[lane] = expf(g); ED[lane] = expf(gl - g);
    WSYNC();
    bf16x8 kf[4][2], qf[4][2];
#pragma unroll
    for (int mt = 0; mt < 4; ++mt)
#pragma unroll
        for (int ks = 0; ks < 2; ++ks) {
            const int off = (16 * mt + i16) * 1536 + 32 * ks + 8 * q4;
            kf[mt][ks] = *(const bf16x8*)(kbase + off); qf[mt][ks] = *(const bf16x8*)(qbase + off);
        }
    bf16_t* QKg = a.gQK() + (size_t)u * 4096;
#pragma unroll
    for (int mt = 0; mt < 4; ++mt)
#pragma unroll
        for (int nt = 0; nt < 4; ++nt) {
            const int j = 16 * nt + i16, pj = 32 * (nt >> 1) + 8 * (i16 >> 2) + 4 * (nt & 1) + (i16 & 3);
            if (nt <= mt) {
                f32x4 d1 = {0.f, 0.f, 0.f, 0.f}, d2 = {0.f, 0.f, 0.f, 0.f};
#pragma unroll
                for (int ks = 0; ks < 2; ++ks) {
                    d1 = __builtin_amdgcn_mfma_f32_16x16x32_bf16(kf[mt][ks], kf[nt][ks], d1, 0, 0, 0);
                    d2 = __builtin_amdgcn_mfma_f32_16x16x32_bf16(qf[mt][ks], kf[nt][ks], d2, 0, 0, 0);
                }
                const float gcj = GC[j];
#pragma unroll
                for (int r = 0; r < 4; ++r) {
                    const int i = 16 * mt + 4 * q4 + r;
                    const float dec = expf(GC[i] - gcj);
                    AT[i * 64 + j] = (i > j) ? BT[i] * d1[r] * dec : 0.f;
                    QKg[i * 64 + (((pj >> 3) ^ (i & 7)) << 3) + (pj & 7)] = f2bf((i >= j) ? d2[r] * dec : 0.f);
                }
            } else {
#pragma unroll
                for (int r = 0; r < 4; ++r) { const int i = 16 * mt + 4 * q4 + r; QKg[i * 64 + (((pj >> 3) ^ (i & 7)) << 3) + (pj & 7)] = 0; }
            }
        }
    {
        bf16_t* Qgg = a.gQg() + (size_t)u * 4096;
#pragma unroll
        for (int mt = 0; mt < 4; ++mt) {
            const int i = 16 * mt + i16; const float e = EG[i];
#pragma unroll
            for (int ks = 0; ks < 2; ++ks) {
                float x[8]; bf8_to_f32(qf[mt][ks], x);
                uint2 w0, w1; w0.x = cvtpk(x[0] * e, x[1] * e); w0.y = cvtpk(x[2] * e, x[3] * e); w1.x = cvtpk(x[4] * e, x[5] * e); w1.y = cvtpk(x[6] * e, x[7] * e);
                const int p0 = 32 * ks + 16 * (q4 & 1) + 4 * (q4 >> 1);
                *(uint2*)(Qgg + i * 64 + (((p0 >> 3) ^ (i & 7)) << 3) + (p0 & 7)) = w0; *(uint2*)(Qgg + i * 64 + ((((p0 >> 3) + 1) ^ (i & 7)) << 3) + (p0 & 7)) = w1;
            }
        }
    }
    WSYNC();
    __builtin_amdgcn_sched_barrier(0);
    {
        float U[64];
#pragma unroll
        for (int i = 0; i < 64; ++i) { U[i] = bf2f(vbase[i * 1536 + lane]) * BT[i]; }
#pragma unroll
        for (int i = 1; i < 64; ++i) {
            float su = 0.f;
#pragma unroll
            for (int j4 = 0; j4 < i; j4 += 4) {
                const float4 av = *(const float4*)(AT + i * 64 + j4);
                su += av.x * U[j4];
                if (j4 + 1 < i) su += av.y * U[j4 + 1];
                if (j4 + 2 < i) su += av.z * U[j4 + 2];
                if (j4 + 3 < i) su += av.w * U[j4 + 3];
            }
            U[i] -= su;
            __builtin_amdgcn_sched_barrier(0);
        }
        float* UTg = a.gUT() + ((size_t)u * 64 + lane) * 64;
#pragma unroll
        for (int i = 0; i < 64; i += 4) *(float4*)(UTg + 4 * ((i >> 2) ^ (lane & 15))) = (float4){U[i], U[i + 1], U[i + 2], U[i + 3]};
    }
    asm volatile("" ::: "memory");
    __builtin_amdgcn_sched_barrier(0);
    {
        float W[64];
#pragma unroll
        for (int i = 0; i < 64; ++i) { W[i] = bf2f(kbase[i * 1536 + lane]); }
        bf16_t* Kdg = a.gKd() + ((size_t)u * 64 + lane) * 64;
#pragma unroll
        for (int pc = 0; pc < 8; ++pc) {
            float t[8];
#pragma unroll
            for (int jj = 0; jj < 8; ++jj) { const int j = 32 * (pc >> 2) + 16 * (jj >> 2) + 4 * (pc & 3) + (jj & 3); t[jj] = W[j] * ED[j]; }
            u32x4 w; w.x = cvtpk(t[0], t[1]); w.y = cvtpk(t[2], t[3]); w.z = cvtpk(t[4], t[5]); w.w = cvtpk(t[6], t[7]);
            *(u32x4*)(Kdg + 8 * (pc ^ (lane & 7))) = w;
        }
#pragma unroll
        for (int i = 0; i < 64; ++i) W[i] *= BT[i] * EG[i];
#pragma unroll
        for (int i = 1; i < 64; ++i) {
            float sw = 0.f;
#pragma unroll
            for (int j4 = 0; j4 < i; j4 += 4) {
                const float4 av = *(const float4*)(AT + i * 64 + j4);
                sw += av.x * W[j4];
                if (j4 + 1 < i) sw += av.y * W[j4 + 1];
                if (j4 + 2 < i) sw += av.z * W[j4 + 2];
                if (j4 + 3 < i) sw += av.w * W[j4 + 3];
            }
            W[i] -= sw;
            __builtin_amdgcn_sched_barrier(0);
        }
        bf16_t* Wng = a.gWn() + (size_t)u * 4096; const int pp = pi_pos(lane);
#pragma unroll
        for (int i = 0; i < 64; ++i) Wng[i * 64 + (((pp >> 3) ^ (i & 7)) << 3) + (pp & 7)] = f2bf(-W[i]);
    }
    if (lane == 0) a.ggam()[u] = expf(gl);
}
__device__ __forceinline__ bf16x8 pack_acc2(const f32x4& x, const f32x4& y) {
    u32x4 w; w.x = cvtpk(x[0], x[1]); w.y = cvtpk(x[2], x[3]); w.z = cvtpk(y[0], y[1]); w.w = cvtpk(y[2], y[3]);
    return __builtin_bit_cast(bf16x8, w);
}
#define G2_SLOT 49152
__device__ __forceinline__ void g2_issue(const MK& a, size_t u, int n, LAS unsigned char* lds, int lw, int lane) {
    LAS unsigned char* dst = lds + (n % 3) * G2_SLOT;
    const char* srcs[4] = {(const char*)(a.gWn() + u * 4096), (const char*)(a.gQg() + u * 4096), (const char*)(a.gQK() + u * 4096), (const char*)(a.gKd() + u * 4096)};
#pragma unroll
    for (int m = 0; m < 4; ++m)
#pragma unroll
        for (int i = 0; i < 2; ++i) { const int piece = 2 * lw + i;
            __builtin_amdgcn_global_load_lds((const unsigned*)(srcs[m] + piece * 1024 + lane * 16), (LAS unsigned*)(dst + m * 8192 + piece * 1024), 16, 0, 0); }
    const char* us = (const char*)(a.gUT() + u * 4096);
#pragma unroll
    for (int i = 0; i < 4; ++i) { const int piece = 4 * lw + i;
        __builtin_amdgcn_global_load_lds((const unsigned*)(us + piece * 1024 + lane * 16), (LAS unsigned*)(dst + 32768 + piece * 1024), 16, 0, 0); }
}
__device__ __forceinline__ void gdn_scan_block(const MK& a, int bh, LAS unsigned char* lds) {
    const int tid = otid(), lane = tid & 63, wid = __builtin_amdgcn_readfirstlane(tid >> 6), i16 = lane & 15, q4 = lane >> 4;
    const int b = bh >> 3, h = bh & 7, sl = wid & 3;
    const bool loader = wid >= 4;
    f32x4 S[4];
#pragma unroll
    for (int mt = 0; mt < 4; ++mt) S[mt] = (f32x4){0.f, 0.f, 0.f, 0.f};
    __syncthreads();
    if (loader) { g2_issue(a, (size_t)bh * 32, 0, lds, wid - 4, lane); g2_issue(a, (size_t)bh * 32 + 1, 1, lds, wid - 4, lane); }
    for (int n = 0; n < 32; ++n) {
        if (loader) { if (n < 31) asm volatile("s_waitcnt vmcnt(12)" ::: "memory"); else asm volatile("s_waitcnt vmcnt(0)" ::: "memory"); }
        asm volatile("s_waitcnt lgkmcnt(0)" ::: "memory"); __builtin_amdgcn_s_barrier(); asm volatile("" ::: "memory");
        if (loader) { if (n + 2 < 32) g2_issue(a, (size_t)bh * 32 + n + 2, n + 2, lds, wid - 4, lane); }
        else {
            const LAS unsigned char* sb = lds + (n % 3) * G2_SLOT;
            const float gam = a.ggam()[(size_t)bh * 32 + n];
            bf16x8 Sb[2]; Sb[0] = pack_acc2(S[0], S[1]); Sb[1] = pack_acc2(S[2], S[3]);
            f32x4 Vn[4];
#pragma unroll
            for (int mt = 0; mt < 4; ++mt) Vn[mt] = *(const LAS f32x4*)(sb + 32768 + (16 * sl + i16) * 256 + 16 * ((4 * mt + q4) ^ i16));
#pragma unroll
            for (int mt = 0; mt < 4; ++mt)
#pragma unroll
                for (int ks = 0; ks < 2; ++ks) Vn[mt] = __builtin_amdgcn_mfma_f32_16x16x32_bf16(*(const LAS bf16x8*)(sb + (16 * mt + i16) * 128 + 16 * ((4 * ks + q4) ^ (i16 & 7))), Sb[ks], Vn[mt], 0, 0, 0);
            bf16x8 Vb[2]; Vb[0] = pack_acc2(Vn[0], Vn[1]); Vb[1] = pack_acc2(Vn[2], Vn[3]);
            f32x4 O[4];
#pragma unroll
            for (int mt = 0; mt < 4; ++mt) {
                O[mt] = (f32x4){0.f, 0.f, 0.f, 0.f};
#pragma unroll
                for (int ks = 0; ks < 2; ++ks) {
                    const int fo = (16 * mt + i16) * 128 + 16 * ((4 * ks + q4) ^ (i16 & 7));
                    O[mt] = __builtin_amdgcn_mfma_f32_16x16x32_bf16(*(const LAS bf16x8*)(sb + 8192 + fo), Sb[ks], O[mt], 0, 0, 0);
                    O[mt] = __builtin_amdgcn_mfma_f32_16x16x32_bf16(*(const LAS bf16x8*)(sb + 16384 + fo), Vb[ks], O[mt], 0, 0, 0);
                }
            }
#pragma unroll
            for (int mt = 0; mt < 4; ++mt) {
                S[mt] = S[mt] * gam;
#pragma unroll
                for (int ks = 0; ks < 2; ++ks) S[mt] = __builtin_amdgcn_mfma_f32_16x16x32_bf16(*(const LAS bf16x8*)(sb + 24576 + (16 * mt + i16) * 128 + 16 * ((4 * ks + q4) ^ (i16 & 7))), Vb[ks], S[mt], 0, 0, 0);
            }
            float* og = a.goraw() + ((size_t)b * SEQ + n * 64 + 4 * q4) * 512 + h * 64 + 16 * sl + i16;
#pragma unroll
            for (int mt = 0; mt < 4; ++mt)
#pragma unroll
                for (int r = 0; r < 4; ++r) og[(size_t)(16 * mt + r) * 512] = O[mt][r];
        }
    }
    if (!loader) {
        float* so = a.out + O_GSP + ((size_t)bh * 64 + 4 * q4) * 64 + 16 * sl + i16;
#pragma unroll
        for (int mt = 0; mt < 4; ++mt)
#pragma unroll
            for (int r = 0; r < 4; ++r) so[(size_t)(16 * mt + r) * 64] = S[mt][r];
    }
    __syncthreads();
}
__device__ __forceinline__ void gdn_out_token(const MK& a, int row, int lane) {
    const float* op = a.goraw() + (size_t)row * 512 + 8 * lane;
    const float4 x0 = *(const float4*)op, x1 = *(const float4*)(op + 4);
    float o[8] = {x0.x, x0.y, x0.z, x0.w, x1.x, x1.y, x1.z, x1.w}, zg[8];
    bf8_to_f32(*(const bf16x8*)(a.Z() + (size_t)row * ZW + OFF_Z + 8 * lane), zg);
    float ss = 0.f;
#pragma unroll
    for (int e = 0; e < 8; ++e) ss += o[e] * o[e];
    ss += __shfl_xor(ss, 1); ss += __shfl_xor(ss, 2); ss += __shfl_xor(ss, 4);
    const float rs = rsqrtf(ss * (1.f / 64.f) + EPSV);
    const float4 g0 = *(const float4*)(a.g_gdn_out + 8 * (lane & 7)), g1 = *(const float4*)(a.g_gdn_out + 8 * (lane & 7) + 4);
    const float gg_[8] = {g0.x, g0.y, g0.z, g0.w, g1.x, g1.y, g1.z, g1.w};
#pragma unroll
    for (int e = 0; e < 8; ++e) o[e] = o[e] * rs * gg_[e] * zg[e] * fast_sigmoid(zg[e]);
    *(bf16x8*)(a.omix() + (size_t)row * 1024 + 8 * lane) = f32_to_bf8(o);
}

#define SROW 1040
#define SSLOT (32 * SROW)
#define KR_OFF (4 * SSLOT)
#define WQ_OFF (KR_OFF + 4 * 4096)
#define QR_OFF (WQ_OFF + 2048)
#define PG_OFF (QR_OFF + 1024)
#define PT_OFF (PG_OFF + 64)
#define AL_OFF (PT_OFF + 1024)
#define SAMP_LDS_END (AL_OFF + 64)
__device__ __forceinline__ void samp_issue(const MK& a, int g, LAS unsigned char* lds, const int* PG, int wid, int lane) {
    const int phys = __builtin_amdgcn_readfirstlane(((const LAS int*)(lds + PG_OFF))[g >> 2]);
    const int tok0 = (g & 3) * 32 + 4 * wid, slot = g & 3;
    const float* cs = a.cache_ckv + ((size_t)phys * 128 + tok0) * 256 + lane * 4;
#pragma unroll
    for (int i = 0; i < 4; ++i) __builtin_amdgcn_global_load_lds((const unsigned*)(cs + i * 256), (LAS unsigned*)(lds + slot * SSLOT + (4 * wid + i) * SROW), 16, 0, 0);
    const float* ks = a.cache_krope + ((size_t)phys * 128 + tok0 + (lane >> 5)) * 32 + (lane & 31);
#pragma unroll
    for (int i = 0; i < 2; ++i) __builtin_amdgcn_global_load_lds((const unsigned*)(ks + i * 64), (LAS unsigned*)(lds + KR_OFF + slot * 4096 + (4 * wid + 2 * i) * 128), 4, 0, 0);
}
__device__ __forceinline__ void samp_attn_unit(const MK& a, int u, char* smem, LAS unsigned char* lds) {
    const int tid = otid(), lane = tid & 63, h = __builtin_amdgcn_readfirstlane(tid >> 6), i16 = lane & 15, q4 = lane >> 4;
    const int b = u >> 3, sp = u & 7;
    float* WQ = (float*)(smem + WQ_OFF);
    float* QR = (float*)(smem + QR_OFF);
    int* PG = (int*)(smem + PG_OFF);
    const float SCL = 0.14724445f;
    post_q_item(a, (NPT + b) * 8 + h, lane);
    __syncthreads();
    {
        const int h_ = tid >> 6, l_ = tid & 63, q4_ = l_ >> 4, idx = l_ & 15, d = 16 * (idx >> 2) + 4 * q4_ + (idx & 3);
        WQ[tid] = a.g_k_nope[d] * a.qh()[((size_t)(NPT + b) * 8 + h_) * 96 + d] * SCL;
        if (tid < 256) QR[tid] = a.qh()[((size_t)(NPT + b) * 8 + (tid >> 5)) * 96 + 64 + (tid & 31)] * SCL;
        if (tid < 16) PG[tid] = a.page_table[b * NPAGES + sp * 16 + tid];
    }
    bf16x8 wf[4][8];
#pragma unroll
    for (int mt = 0; mt < 4; ++mt)
#pragma unroll
        for (int ks = 0; ks < 8; ++ks) wf[mt][ks] = *(const bf16x8*)(a.WknT() + (size_t)(h * 64 + 16 * mt + i16) * 256 + 32 * ks + 8 * q4);
#pragma unroll
    for (int mt = 0; mt < 4; ++mt)
#pragma unroll
        for (int ks = 0; ks < 8; ++ks) asm volatile("" : "+v"(wf[mt][ks]));
    __syncthreads();
    samp_issue(a, 0, lds, PG, h, lane); samp_issue(a, 1, lds, PG, h, lane); samp_issue(a, 2, lds, PG, h, lane);
    const LAS float* QRl = (const LAS float*)(lds + QR_OFF) + h * 32 + 8 * q4;
    const LAS float* WQl = (const LAS float*)(lds + WQ_OFF) + (h * 4 + q4) * 16;
    float m = -INFINITY, lsum = 0.f;
    f32x4 latv[2]; latv[0] = (f32x4){0.f, 0.f, 0.f, 0.f}; latv[1] = (f32x4){0.f, 0.f, 0.f, 0.f};
    for (int g = 0; g < 64; ++g) {
        if (g <= 61) asm volatile("s_waitcnt vmcnt(12)" ::: "memory"); else if (g == 62) asm volatile("s_waitcnt vmcnt(6)" ::: "memory"); else asm volatile("s_waitcnt vmcnt(0)" ::: "memory");
        asm volatile("s_waitcnt lgkmcnt(0)" ::: "memory"); __builtin_amdgcn_s_barrier(); asm volatile("" ::: "memory");
        if (g + 3 < 64) samp_issue(a, g + 3, lds, PG, h, lane);
        const LAS float* Cs = (const LAS float*)(lds + (g & 3) * SSLOT); const LAS float* KR = (const LAS float*)(lds + KR_OFF + (g & 3) * 4096);
        float sc[2];
#pragma unroll
        for (int hf = 0; hf < 2; ++hf) {
            f32x4 acc[4];
#pragma unroll
            for (int mt = 0; mt < 4; ++mt) acc[mt] = (f32x4){0.f, 0.f, 0.f, 0.f};
            const LAS float* cp = Cs + (16 * hf + i16) * (SROW / 4) + 8 * q4;
#pragma unroll
            for (int ks = 0; ks < 8; ++ks) {
                const f32x4 f0 = *(const LAS f32x4*)(cp + 32 * ks), f1 = *(const LAS f32x4*)(cp + 32 * ks + 4);
                u32x4 w; w.x = cvtpk(f0[0], f0[1]); w.y = cvtpk(f0[2], f0[3]); w.z = cvtpk(f1[0], f1[1]); w.w = cvtpk(f1[2], f1[3]);
                const bf16x8 cf = __builtin_bit_cast(bf16x8, w);
#pragma unroll
                for (int mt = 0; mt < 4; ++mt) acc[mt] = __builtin_amdgcn_mfma_f32_16x16x32_bf16(wf[mt][ks], cf, acc[mt], 0, 0, 0);
            }
            float ss = 0.f, dot = 0.f, rd = 0.f;
#pragma unroll
            for (int mt = 0; mt < 4; ++mt) {
                const f32x4 wq = *(const LAS f32x4*)(WQl + 4 * mt);
                ss += acc[mt][0] * acc[mt][0] + acc[mt][1] * acc[mt][1] + acc[mt][2] * acc[mt][2] + acc[mt][3] * acc[mt][3];
                dot += acc[mt][0] * wq[0] + acc[mt][1] * wq[1] + acc[mt][2] * wq[2] + acc[mt][3] * wq[3];
            }
            {
                const LAS float* kp = KR + (16 * hf + i16) * 32 + 8 * q4;
                const f32x4 k0 = *(const LAS f32x4*)kp, k1 = *(const LAS f32x4*)(kp + 4), q0 = *(const LAS f32x4*)QRl, q1 = *(const LAS f32x4*)(QRl + 4);
                rd = k0[0] * q0[0] + k0[1] * q0[1] + k0[2] * q0[2] + k0[3] * q0[3] + k1[0] * q1[0] + k1[1] * q1[1] + k1[2] * q1[2] + k1[3] * q1[3];
            }
            ss += __shfl_xor(ss, 16); dot += __shfl_xor(dot, 16); rd += __shfl_xor(rd, 16);
            ss += __shfl_xor(ss, 32); dot += __shfl_xor(dot, 32); rd += __shfl_xor(rd, 32);
            sc[hf] = dot * rsqrtf(ss * (1.f / 64.f) + EPSV) + rd;
        }
        float gm = fmaxf(sc[0], sc[1]);
#pragma unroll
        for (int o = 1; o < 16; o <<= 1) gm = fmaxf(gm, __shfl_xor(gm, o));
        const float mn = fmaxf(m, gm);
        const float alpha = __builtin_amdgcn_exp2f(m - mn), p0 = __builtin_amdgcn_exp2f(sc[0] - mn), p1 = __builtin_amdgcn_exp2f(sc[1] - mn);
        m = mn;
        lsum = lsum * alpha + p0 + p1;
        if (q4 == 0) { ((LAS float*)(lds + PT_OFF))[h * 32 + i16] = p0; ((LAS float*)(lds + PT_OFF))[h * 32 + 16 + i16] = p1; if (i16 == 0) ((LAS float*)(lds + AL_OFF))[h] = alpha; }
        asm volatile("s_waitcnt lgkmcnt(0)" ::: "memory"); __builtin_amdgcn_s_barrier(); asm volatile("" ::: "memory");
        {
            u32x4 pw = {0u, 0u, 0u, 0u};
            if (i16 < 8) { const f32x4 pa = *(const LAS f32x4*)(lds + PT_OFF + (i16 * 32 + 8 * q4) * 4), pb_ = *(const LAS f32x4*)(lds + PT_OFF + (i16 * 32 + 8 * q4 + 4) * 4);
                pw.x = cvtpk(pa[0], pa[1]); pw.y = cvtpk(pa[2], pa[3]); pw.z = cvtpk(pb_[0], pb_[1]); pw.w = cvtpk(pb_[2], pb_[3]); }
            const bf16x8 pfr = __builtin_bit_cast(bf16x8, pw);
            const f32x4 al = *(const LAS f32x4*)(lds + AL_OFF + (q4 & 1) * 16);
#pragma unroll
            for (int nt = 0; nt < 2; ++nt) {
                const LAS float* cc = Cs + (8 * q4) * (SROW / 4) + 32 * h + 16 * nt + i16;
                u32x4 cw; cw.x = cvtpk(cc[0], cc[SROW / 4]); cw.y = cvtpk(cc[2 * (SROW / 4)], cc[3 * (SROW / 4)]); cw.z = cvtpk(cc[4 * (SROW / 4)], cc[5 * (SROW / 4)]); cw.w = cvtpk(cc[6 * (SROW / 4)], cc[7 * (SROW / 4)]);
                latv[nt] = latv[nt] * al;
                latv[nt] = __builtin_amdgcn_mfma_f32_16x16x32_bf16(pfr, __builtin_bit_cast(bf16x8, cw), latv[nt], 0, 0, 0);
            }
        }
    }
#pragma unroll
    for (int o = 1; o < 16; o <<= 1) lsum += __shfl_xor(lsum, o);
    if (lane == 0) { float* o = a.part() + ((size_t)u * 8 + h) * 260; o[0] = m * 0.69314718f; o[1] = lsum; }
    if (q4 < 2) {
#pragma unroll
        for (int nt = 0; nt < 2; ++nt)
#pragma unroll
            for (int r = 0; r < 4; ++r) a.part()[((size_t)u * 8 + 4 * q4 + r) * 260 + 4 + 32 * h + 16 * nt + i16] = latv[nt][r];
    }
}
__device__ __forceinline__ void samp_comb_unit(const MK& a, int u, char* smem) {
    float* slat = (float*)smem;
    const int b = u >> 3, h = u & 7, tid = otid() & 255;
    const size_t row = NPT + b;
    const float* q = a.qh() + (row * 8 + h) * 96;
    float s_self = 0.f;
    for (int d = 0; d < 64; ++d) s_self += q[d] * a.kh()[(row * 8 + h) * 64 + d];
    for (int d = 0; d < 32; ++d) s_self += q[64 + d] * a.krf()[row * 32 + d];
    s_self *= 0.10206207261596577f;
    float m = s_self;
    for (int s = 0; s < 8; ++s) m = fmaxf(m, a.part()[((size_t)(b * 8 + s) * 8 + h) * 260]);
    const float pself = expf(s_self - m);
    float l = pself, lat = 0.f;
    for (int s = 0; s < 8; ++s) {
        const float* p = a.part() + ((size_t)(b * 8 + s) * 8 + h) * 260;
        const float w = expf(p[0] - m);
        l += p[1] * w; lat += p[4 + tid] * w;
    }
    __syncthreads();
    slat[tid] = lat;
    __syncthreads();
    if (tid < 64) {
        float o = 0.f;
        for (int c = 0; c < 256; ++c) o += slat[c] * a.w_kv_b[(size_t)c * 1024 + h * 128 + 64 + tid];
        o += pself * a.KV()[row * 1024 + h * 128 + 64 + tid];
        a.omix()[row * 1024 + 512 + h * 64 + tid] = f2bf(o / l);
    }
}

#define XB_TMO      128
#define XB_XCNT(j)  (256  + 64 * (j))
#define XB_XSUB(j)  (1280 + 64 * (j))
#define XB_XGEN(j)  (2304 + 64 * (j))
#define XB_TOP      3328
#define XB_TOPGEN   3392
#define XCD_BAR_WORDS 3456
#define XB_SPIN_CAP (1u << 18)

__device__ __forceinline__ unsigned xb_ld(unsigned* p)              { return __hip_atomic_load(p, __ATOMIC_RELAXED, __HIP_MEMORY_SCOPE_AGENT); }
__device__ __forceinline__ unsigned xb_add(unsigned* p, unsigned v) { return __hip_atomic_fetch_add(p, v, __ATOMIC_RELAXED, __HIP_MEMORY_SCOPE_AGENT); }
__device__ __forceinline__ unsigned xb_xcc_id() { return (unsigned)__builtin_amdgcn_s_getreg((3 << 11) | 20) & 0xFu; }
#define XB_SPIN(cond, bar) do { unsigned _sp = 0; while (cond) { __builtin_amdgcn_s_sleep(1); \
    if ((++_sp & 255u) == 0u) { if (xb_ld(&(bar)[XB_TMO])) break; if (_sp > XB_SPIN_CAP) { atomicAdd(&(bar)[XB_TMO], 1u); break; } } } } while (0)

struct XcdBarrier {
    unsigned* bar; unsigned x;
    volatile LAS unsigned* st;
};

__device__ __forceinline__ XcdBarrier xcd_barrier_post(unsigned* bar, volatile LAS unsigned* st) {
    XcdBarrier b; b.bar = bar; b.x = xb_xcc_id(); b.st = st;
    if (threadIdx.x == 0) (void)xb_add(&bar[XB_XCNT(b.x)], 1u);
    return b;
}
__device__ __forceinline__ void xcd_barrier_complete(unsigned* bar, unsigned x, unsigned& nloc, unsigned& nx) {
    const unsigned G = gridDim.x * gridDim.y * gridDim.z;
    unsigned sum, cnt, mine, sp = 0u;
    for (;;) {
        sum = 0u; cnt = 0u; mine = 0u;
#pragma unroll
        for (unsigned j = 0; j < 16; ++j) { const unsigned c = xb_ld(&bar[XB_XCNT(j)]); sum += c; cnt += (c > 0u) ? 1u : 0u; mine = (j == x) ? c : mine; }
        if (sum == G) break;
        __builtin_amdgcn_s_sleep(1);
        if ((++sp & 255u) == 0u) { if (xb_ld(&bar[XB_TMO])) break; if (sp > XB_SPIN_CAP) { atomicAdd(&bar[XB_TMO], 1u); break; } }
    }
    nloc = mine > 0u ? mine : 1u; nx = cnt > 0u ? cnt : 1u;
}

__device__ __forceinline__ void xcd_barrier(const XcdBarrier& b) {
    asm volatile("s_waitcnt vmcnt(0)" ::: "memory");
    __syncthreads();
    if (threadIdx.x == 0) {
        unsigned* bar = b.bar;
        __builtin_amdgcn_s_waitcnt(0);
        unsigned nloc = b.st[0], nx = b.st[1];
        if (nloc == 0u) { xcd_barrier_complete(bar, b.x, nloc, nx); b.st[0] = nloc; b.st[1] = nx; }
        const unsigned old = xb_add(&bar[XB_XSUB(b.x)], 1u);
        const unsigned gen = old / nloc;
        if (old + 1u == (gen + 1u) * nloc) {
            __builtin_amdgcn_fence(__ATOMIC_RELEASE, "agent");
            asm volatile("s_waitcnt vmcnt(0)" ::: "memory");
            const unsigned og = xb_add(&bar[XB_TOP], 1u);
            const unsigned tg = og / nx;
            if (og + 1u == (tg + 1u) * nx) xb_add(&bar[XB_TOPGEN], 1u);
            else XB_SPIN(xb_ld(&bar[XB_TOPGEN]) == tg, bar);
            __builtin_amdgcn_fence(__ATOMIC_ACQUIRE, "agent");
            xb_add(&bar[XB_XGEN(b.x)], 1u);
            asm volatile("s_waitcnt vmcnt(0)" ::: "memory");
        } else {
            XB_SPIN(xb_ld(&bar[XB_XGEN(b.x)]) == gen, bar);
            __builtin_amdgcn_fence(__ATOMIC_ACQUIRE, "agent");
            asm volatile("s_waitcnt vmcnt(0)" ::: "memory");
        }
    }
    __syncthreads();
}

#define XB_ST_OFF 155648
#define LDS_BYTES 155904
static_assert(SAMP_LDS_END <= LDS_BYTES, "LDS map");
#define GSYNC() do { xcd_barrier(xbar); } while (0)
__global__ __launch_bounds__(NTHR, 2) void mega(MK a) {
    cg::grid_group grid = cg::this_grid();
    char* smem = (char*)lds_raw;
    LAS unsigned char* lds = (LAS unsigned char*)lds_raw;
    otid_init();
    if (threadIdx.x < 2) ((LAS unsigned*)(lds_raw + XB_ST_OFF))[threadIdx.x] = 0u;
    __syncthreads();
    const XcdBarrier xbar = xcd_barrier_post(a.ctl(), (volatile LAS unsigned*)(LAS void*)(lds_raw + XB_ST_OFF));
    const int bid = blockIdx.x, nb = gridDim.x, ngw = nb * NWAVE;
#define LOCAL_IDS const int tid = otid(), lane = tid & 63, wid = tid >> 6, half = tid >> 8, gw = bid * NWAVE + wid; (void)lane; (void)half; (void)gw; (void)wid;

    {
    LOCAL_IDS
    {
        const int T0 = 88 * 16, T1 = 24 * 6, T2 = 32 * 4, T3 = 16 * 4, T4 = 32 * 16, T5 = 176 * 16, T7 = 32 * 44, T8 = 32 * 16, T9 = 32 * 4;
        const int TT = T0 + T1 + T2 + T3 + T4 + T5 + T7 + T8 + T9;
        float* scr = (float*)(smem + wid * 8704);
        for (int it = gw; it < TT; it += ngw) {
            int r = it;
            if (r < T0) { const int nt_ = r % 88, kb = r / 88, nv = 2736 - 32 * nt_; wt_item(a.w_in, 2736, 32 * nt_, nv < 0 ? 0 : (nv > 32 ? 32 : nv), a.WinT(), 1024, 32 * nt_, 64 * kb, scr, lane); continue; } r -= T0;
            if (r < T1) { const int nt_ = r % 24, kb = r / 24; wt_item(a.w_q_b, 768, 32 * nt_, 32, a.WqbT(), 384, 32 * nt_, 64 * kb, scr, lane); continue; } r -= T1;
            if (r < T2) { const int nt_ = r % 32, kb = r / 32; wt_item(a.w_kv_b, 1024, 32 * nt_, 32, a.WkvT(), 256, 32 * nt_, 64 * kb, scr, lane); continue; } r -= T2;
            if (r < T3) { const int nt_ = r % 16, kb = r / 16, h = nt_ >> 1; wt_item(a.w_kv_b, 1024, h * 128 + 32 * (nt_ & 1), 32, a.WknT(), 256, 32 * nt_, 64 * kb, scr, lane); continue; } r -= T3;
            if (r < T4) { const int nt_ = r % 32, kb = r / 32; wt_item(a.w_o, 1024, 32 * nt_, 32, a.WoT(), 1024, 32 * nt_, 64 * kb, scr, lane); continue; } r -= T4;
            if (r < T5) { const int nt_ = r % 176, kb = r / 176, pn = nt_ >> 3, wi = nt_ & 7;
                wt_item(wi < 4 ? a.w_gate : a.w_up, DFF, pn * 128 + (wi & 3) * 32, 32, a.WguT(), 1024, 32 * nt_, 64 * kb, scr, lane); continue; } r -= T5;
            if (r < T7) { const int nt_ = r % 32, kb = r / 32; wt_item(a.w_down, 1024, 32 * nt_, 32, a.WdT(), DFF, 32 * nt_, 64 * kb, scr, lane); continue; } r -= T7;
            if (r < T8) { const int nt_ = r % 32, kb = r / 32; wt_item(a.w_ple_gate, 1024, 32 * nt_, 32, a.WpgT(), 1024, 32 * nt_, 64 * kb, scr, lane); continue; } r -= T8;
            { const int nt_ = r % 32, kb = r / 32; wt_item(a.w_ple_proj, 1024, 32 * nt_, 32, a.WppT(), 256, 32 * nt_, 64 * kb, scr, lane); }
        }
        for (int e = (bid * NTHR + tid); e < 2049 * 16; e += nb * NTHR) {
            const int pos = e >> 4, i = e & 15; const float ang = (pos == 2048 ? (float)PAST : (float)pos) * powf(10000.f, -(float)i / 16.f);
            a.ropecs()[pos * 32 + i] = cosf(ang); a.ropecs()[pos * 32 + 16 + i] = sinf(ang);
        }
        for (int row = gw; row < MPAD; row += ngw) {
            const float* src = row < NPT ? a.x_prompt + (size_t)row * 1024 : a.x_sample + (size_t)(row < NTOK ? row - NPT : 0) * 1024;
            rms1024_row(src, a.g_attn, a.xn() + (size_t)row * 1024, row >= NTOK, lane);
            ushort4 w = {0, 0, 0, 0};
            if (row < NTOK) { const float* ps = row < NPT ? a.p_prompt + (size_t)row * 256 : a.p_sample + (size_t)(row - NPT) * 256; const float4 v = *(const float4*)(ps + lane * 4); w.x = f2bf(v.x); w.y = f2bf(v.y); w.z = f2bf(v.z); w.w = f2bf(v.w); }
            *(ushort4*)(a.pb() + (size_t)row * 256 + lane * 4) = w;
            if (row >= NTOK) { for (int j = 0; j < 4; ++j) { ushort4 z = {0, 0, 0, 0}; *(ushort4*)(a.omix() + (size_t)row * 1024 + lane * 4 + 256 * j) = z; } }
        }
    }
    }
    grid.sync();
    {
    LOCAL_IDS
    pg_gemm(lds, a.xn(), a.WinT(), NPT, ZW, 1024, PgBf16{a.Z(), ZW});
    pg_gemm(lds, a.pb(), a.WppT(), NPT, 1024, 256, PgF32{a.PP(), 1024});
    gemm_sample_rows_ks<false>(a.xn(), 1024, a.WinT(), 1024, ZW, EwBf16{a.Z(), ZW}, smem, bid, nb);
    gemm_sample_rows<false>(a.pb(), 256, a.WppT(), 256, 1024, EwF32{a.PP(), 1024}, smem, bid, nb);
    }
    GSYNC();
    {
    LOCAL_IDS
    for (int e = tid; e < 4 * 1536 / 4; e += NTHR) ((float4*)smem)[e] = ((const float4*)a.w_conv)[e];
    __syncthreads();
    for (int run = gw; run < NTOK / 8; run += ngw) post_in_run(a, run, lane, (const float*)smem);
    }
    GSYNC();
    {
    LOCAL_IDS
    for (int u = gw; u < 2048; u += ngw) gdn_prep_unit(a, u, lane, smem + wid * GDN_WLDS);
    }
    {
    LOCAL_IDS
    for (int v = gw; v < NST * 64; v += ngw) gdn_unit(a, v >> 6, (v >> 3) & 7, v & 7, a.state_gdn, a.out + O_GSS, NPT, 1, lane, smem + wid * GDN_WLDS);
    __syncthreads();
    }
    GSYNC();
    {
    LOCAL_IDS
    pg_gemm(lds, a.qan(), a.WqbT(), NPT, 768, 384, PgBf16{a.qraw(), 768});
    pg_gemm(lds, a.ckvb(), a.WkvT(), NPT, 1024, 256, PgBf16{a.kvraw(), 1024});
    gemm_sample_rows<false>(a.qan(), 384, a.WqbT(), 384, 768, EwF32{a.Q(), 768}, smem, bid, nb);
    gemm_sample_rows<false>(a.ckvb(), 256, a.WkvT(), 256, 1024, EwF32{a.KV(), 1024}, smem, bid, nb);
    for (int bh_ = nb - 1 - bid; bh_ < 64; bh_ += nb) gdn_scan_block(a, bh_, lds);
    }
    GSYNC();
    {
    LOCAL_IDS
    for (int idx = gw; idx < NST * 8; idx += ngw) { post_q_item(a, NPT * 8 + idx, lane); post_kv_item(a, NPT * 8 + idx, lane); }
    for (int row = gw; row < NTOK; row += ngw) gdn_out_token(a, row, lane);
    for (int pr = bid; pr < 256; pr += nb) { const int bh_ = pr >> 2, s_ = pr & 3; attn_block(a, bh_ >> 3, bh_ & 7, 7 - s_, smem); attn_block(a, bh_ >> 3, bh_ & 7, s_, smem); }
    for (int u = bid; u < NST * 8; u += nb) samp_attn_unit(a, u, smem, lds);
    }
    GSYNC();
    {
    LOCAL_IDS
    for (int u0 = bid * 2; u0 < NST * 8; u0 += nb * 2) samp_comb_unit(a, u0 + half, smem + half * 4096);
    }
    GSYNC();
    {
    LOCAL_IDS
    pg_gemm(lds, a.omix(), a.WoT(), NPT, 1024, 1024, PgRes{a.x_prompt, a.H()});
    gemm_sample_rows_ks<false>(a.omix(), 1024, a.WoT(), 1024, 1024, EwResX{a.x_sample, a.H()}, smem, bid, nb);
    }
    GSYNC();
    {
    LOCAL_IDS
    for (int row = gw; row < MPAD; row += ngw) rms1024_row(a.H() + (size_t)row * 1024, a.g_ffn, a.un() + (size_t)row * 1024, row >= NTOK, lane);
    }
    GSYNC();
    {
    LOCAL_IDS
    pg_gemm(lds, a.un(), a.WguT(), NPT, 2 * DFF, 1024, PgSwiglu{a.hid()});
    gemm_sample_rows_ks<true>(a.un(), 1024, a.WguT(), 1024, 2 * DFF, EwBf16{a.hid(), DFF}, smem, bid, nb);
    }
    GSYNC();
    {
    LOCAL_IDS
    pg_gemm(lds, a.hid(), a.WdT(), NPT, 1024, DFF, PgRes{a.H(), a.H2()});
    gemm_sample_rows_ks<false>(a.hid(), DFF, a.WdT(), DFF, 1024, EwResH{a.H(), a.H2()}, smem, bid, nb);
    }
    GSYNC();
    {
    LOCAL_IDS
    for (int row = gw; row < MPAD; row += ngw) rms1024_row(a.H2() + (size_t)row * 1024, a.g_ple, a.un2() + (size_t)row * 1024, row >= NTOK, lane);
    }
    GSYNC();
    {
    LOCAL_IDS
    pg_gemm(lds, a.un2(), a.WpgT(), NPT, 1024, 1024, PgPle{a.H2(), a.PP(), a.out});
    gemm_sample_rows_ks<false>(a.un2(), 1024, a.WpgT(), 1024, 1024, EwPle{a.H2(), a.PP(), a.out}, smem, bid, nb);
    }
}

static inline char* carve(char*& p, size_t bytes) { char* r = p; p += (bytes + 255) & ~(size_t)255; return r; }

extern "C" void kernel_launch(void* const* d_in, const int* in_sizes, int n_in, void* d_out, int out_size, void* d_ws, size_t ws_size, hipStream_t stream) {
    MK a{};
    a.x_prompt = (const float*)d_in[0]; a.x_sample = (const float*)d_in[1]; a.cache_ckv = (const float*)d_in[2]; a.cache_krope = (const float*)d_in[3];
    a.state_gdn = (const float*)d_in[4]; a.state_conv = (const float*)d_in[5]; a.page_table = (const int*)d_in[6]; a.p_prompt = (const float*)d_in[7]; a.p_sample = (const float*)d_in[8];
    a.g_attn = (const float*)d_in[9]; a.w_in = (const float*)d_in[10]; a.w_conv = (const float*)d_in[11]; a.a_log = (const float*)d_in[12]; a.dt_bias = (const float*)d_in[13];
    a.g_gdn_out = (const float*)d_in[14]; a.g_q_a = (const float*)d_in[15]; a.w_q_b = (const float*)d_in[16]; a.g_q_nope = (const float*)d_in[17]; a.g_q_rope = (const float*)d_in[18];
    a.g_kv_a = (const float*)d_in[19]; a.g_k_rope = (const float*)d_in[20]; a.w_kv_b = (const float*)d_in[21]; a.g_k_nope = (const float*)d_in[22]; a.w_o = (const float*)d_in[23];
    a.g_ffn = (const float*)d_in[24]; a.w_gate = (const float*)d_in[25]; a.w_up = (const float*)d_in[26]; a.w_down = (const float*)d_in[27]; a.g_ple = (const float*)d_in[28];
    a.w_ple_gate = (const float*)d_in[29]; a.w_ple_proj = (const float*)d_in[30];
    a.out = (float*)d_out;
    a.ws = (char*)d_ws;
    if (WS_TOTAL > ws_size) { fprintf(stderr, "kernel_launch: workspace too small: need %zu have %zu\n", (size_t)WS_TOTAL, ws_size); return; }

    static int grid_blocks = 0;
    if (!grid_blocks) {
        int dev = 0, cus = 0, per_cu = 0;
        (void)hipGetDevice(&dev);
        (void)hipDeviceGetAttribute(&cus, hipDeviceAttributeMultiprocessorCount, dev);
        (void)hipFuncSetAttribute((const void*)mega, hipFuncAttributeMaxDynamicSharedMemorySize, LDS_BYTES);
        (void)hipOccupancyMaxActiveBlocksPerMultiprocessor(&per_cu, (const void*)mega, NTHR, LDS_BYTES);
        if (per_cu < 1) fprintf(stderr, "kernel_launch: occupancy query says %d blocks/CU\n", per_cu);
        grid_blocks = cus;
    }
    (void)hipMemsetAsync((char*)d_ws + WOF_ctl, 0, 16384, stream);
    void* args[] = {&a};
    hipError_t e = hipLaunchCooperativeKernel((const void*)mega, dim3(grid_blocks), dim3(NTHR), args, LDS_BYTES, stream);
    if (e != hipSuccess) fprintf(stderr, "cooperative launch failed: %s (grid %d)\n", hipGetErrorString(e), grid_blocks);
}
```

```cpp
#include <hip/hip_runtime.h>
#include <stdint.h>
#include <cstdio>
#include <hip/hip_cooperative_groups.h>
namespace cg = cooperative_groups;


__device__ __forceinline__ int otid();
#define PG8_TID() otid()
namespace pg8 {
#define PG8_LAS __attribute__((address_space(3)))
typedef unsigned short bf16_t;
typedef short bf16x8 __attribute__((ext_vector_type(8)));
typedef float f32x4 __attribute__((ext_vector_type(4)));
typedef unsigned u32x4 __attribute__((ext_vector_type(4)));
constexpr int BM = 256, BK = 64, HALF = 128, HTB = HALF * BK * 2  , STAGE_BYTES = 8 * HTB, NXCD = 8, WGM = 8;

__host__ __device__ __forceinline__ int lds_byte(int r, int c) { const int st = (r >> 4) * 2 + (c >> 5), rr = r & 15, cc = c & 31, ob = rr * 64 + cc * 2; return st * 1024 + (ob ^ (((ob >> 9) & 1) << 5)); }
__host__ __device__ __forceinline__ void stage_rc(int b, int& R, int& C) { const int st = b / 1024, sb = b % 1024, swz = sb ^ (((sb >> 9) & 1) << 5); R = (st >> 1) * 16 + swz / 64; C = (st & 1) * 32 + (swz % 64) / 2; }
__host__ __device__ __forceinline__ int perm32(int rho) { const int n = rho >> 4, i = rho & 15; return 8 * (i >> 2) + 4 * n + (i & 3); }

struct Unit { int pm, pn; };
struct Gemm { const bf16_t* A; const bf16_t* Bt; int M, N, K; };

struct StaticOrder {
    int nM, nN, nwg, G, c;
    __host__ __device__ void init(int M, int N, int G_, int c_) { nM = M / BM; nN = N / BM; nwg = nM * nN; G = G_; c = c_; }
    __host__ __device__ bool next(int i, Unit& u) const {
        const long L = (long)i * G + c; if (L >= nwg) return false;
        int wgid = (int)L; { const int q = nwg / NXCD, r = nwg % NXCD, xcd = wgid % NXCD, off = wgid / NXCD; wgid = (xcd < r ? xcd * (q + 1) : r * (q + 1) + (xcd - r) * q) + off; }
        const int nig = WGM * nN, gid = wgid / nig, fm = gid * WGM, gsz = (nM - fm) < WGM ? (nM - fm) : WGM;
        u.pm = fm + ((wgid % nig) % gsz); u.pn = (wgid % nig) / gsz; return true;
    }
    __device__ __forceinline__ void a_ready(const Unit&) const {}
    __device__ __forceinline__ void done(const Unit&) const {}
};

template <class Epi, class Sched, bool ALIGN_EPI = false, bool SP2 = false>
__device__ __forceinline__ void gemm_phase(PG8_LAS unsigned char* lds, const Gemm g, const Sched& S, const Epi& E) {
    const int tid = PG8_TID(), wid = __builtin_amdgcn_readfirstlane(tid >> 6), lane = tid & 63, wr = wid >> 2, wc = wid & 3, fr = lane & 15, fq = lane >> 4;
    const int K = g.K, nt = K / BK;
    unsigned voffA[2], voffB[2];
#pragma unroll
    for (int i = 0; i < 2; ++i) { int R, C; stage_rc(tid * 16 + i * 8192, R, C); const int Rb = Epi::PERM ? ((R & ~31) + perm32(R & 31)) : R;
        voffA[i] = (unsigned)(R * K + C) * 2u; voffB[i] = (unsigned)(Rb * K + C) * 2u; }
    const size_t kstep = (size_t)(BK * 2);
    const size_t hstep = (size_t)HALF * K * 2;
    const size_t tstep = 2 * hstep;
    const unsigned ldsw = (unsigned)wid * 1024u;
    const int aoff = lds_byte(wr * 64 + fr, fq * 8), boff = lds_byte(wc * 32 + fr, fq * 8);
#define PG8_SA(b, h) (((b) * 2 + (h)) * HTB)
#define PG8_SB(b, h) ((4 + (b) * 2 + (h)) * HTB)
#define PG8_STAGE(bufoff, gbase, voff) do { _Pragma("unroll") for (int _i = 0; _i < 2; ++_i) \
        __builtin_amdgcn_global_load_lds((const unsigned*)((const char*)(gbase) + (voff)[_i]), (PG8_LAS unsigned*)(lds + (bufoff) + ldsw + _i * 8192), 16, 0, 0); } while (0)
#define PG8_LDA(dst, b, h) do { _Pragma("unroll") for (int m = 0; m < 4; ++m) _Pragma("unroll") for (int k = 0; k < 2; ++k) dst[m][k] = *(const PG8_LAS bf16x8*)(lds + PG8_SA(b, h) + aoff + m * 2048 + k * 1024); } while (0)
#define PG8_LDB(dst, b, h) do { _Pragma("unroll") for (int n = 0; n < 2; ++n) _Pragma("unroll") for (int k = 0; k < 2; ++k) dst[n][k] = *(const PG8_LAS bf16x8*)(lds + PG8_SB(b, h) + boff + n * 2048 + k * 1024); } while (0)
#define PG8_MMA(ai, bj, At, Bt) do { __builtin_amdgcn_s_setprio(1); _Pragma("unroll") for (int m = 0; m < 4; ++m) _Pragma("unroll") for (int n = 0; n < 2; ++n) _Pragma("unroll") for (int k = 0; k < 2; ++k) \
        acc[ai][bj][m][n] = __builtin_amdgcn_mfma_f32_16x16x32_bf16(Bt[n][k], At[m][k], acc[ai][bj][m][n], 0, 0, 0); __builtin_amdgcn_s_setprio(0); } while (0)
#define PG8_WAIT_V(n) asm volatile("s_waitcnt vmcnt(" #n ")" ::: "memory")
#define PG8_WAIT_L(n) asm volatile("s_waitcnt lgkmcnt(" #n ")" ::: "memory")
#define PG8_BAR __builtin_amdgcn_s_barrier()
#define PG8_SCHED __builtin_amdgcn_sched_barrier(0)
    Unit cur, nxt; int ui = 0;
    if (!S.next(0, cur)) return;
    f32x4 acc[2][2][4][2];
#pragma unroll
    for (int a = 0; a < 2; ++a)
#pragma unroll
        for (int b = 0; b < 2; ++b)
#pragma unroll
            for (int m = 0; m < 4; ++m)
#pragma unroll
                for (int n = 0; n < 2; ++n) acc[a][b][m][n] = (f32x4){0.f, 0.f, 0.f, 0.f};
    bf16x8 At[4][2], B0[2][2], B1[2][2];
    const char* cA = (const char*)g.A + (size_t)cur.pm * tstep; const char* cB = (const char*)g.Bt + (size_t)cur.pn * tstep;
    S.a_ready(cur);
    if constexpr (SP2) {
        PG8_STAGE(PG8_SB(0, 0), cB, voffB); PG8_STAGE(PG8_SB(0, 1), cB + hstep, voffB); PG8_STAGE(PG8_SA(0, 0), cA, voffA); PG8_STAGE(PG8_SA(0, 1), cA + hstep, voffA);
        if (wr == 1) PG8_BAR;
        PG8_WAIT_V(2); PG8_BAR;
        PG8_STAGE(PG8_SB(1, 0), cB + kstep, voffB); PG8_STAGE(PG8_SA(1, 0), cA + kstep, voffA); PG8_STAGE(PG8_SB(1, 1), cB + hstep + kstep, voffB);
        PG8_WAIT_V(6); PG8_BAR;
    } else {
        PG8_STAGE(PG8_SB(0, 0), cB, voffB); PG8_STAGE(PG8_SA(0, 0), cA, voffA); PG8_STAGE(PG8_SB(0, 1), cB + hstep, voffB); PG8_STAGE(PG8_SA(0, 1), cA + hstep, voffA);
        if (wr == 1) PG8_BAR;
        PG8_WAIT_V(4); PG8_BAR;
        PG8_STAGE(PG8_SB(1, 0), cB + kstep, voffB); PG8_STAGE(PG8_SA(1, 0), cA + kstep, voffA); PG8_STAGE(PG8_SB(1, 1), cB + hstep + kstep, voffB);
        PG8_WAIT_V(6); PG8_BAR;
    }
    for (;;) {
        const bool has_next = S.next(ui + 1, nxt);
        const char* nA = has_next ? (const char*)g.A + (size_t)nxt.pm * tstep : cA; const char* nB = has_next ? (const char*)g.Bt + (size_t)nxt.pn * tstep : cB;
        for (int t = 0; t < nt; t += 2) {
            const bool last = (t == nt - 2);
            const char* a1 = cA + (size_t)(t + 1) * kstep;
            const char* a2 = last ? nA : cA + (size_t)(t + 2) * kstep; const char* b2 = last ? nB : cB + (size_t)(t + 2) * kstep;
            const char* a3 = a2 + kstep; const char* b3 = b2 + kstep;
            if (last && has_next) S.a_ready(nxt);
            if constexpr (SP2) {
            PG8_LDB(B0, 0, 0); PG8_LDB(B1, 0, 1); PG8_SCHED; PG8_LDA(At, 0, 0); PG8_STAGE(PG8_SA(1, 1), a1 + hstep, voffA);
            PG8_WAIT_V(8); PG8_WAIT_L(0); PG8_BAR; PG8_MMA(0, 0, At, B0); PG8_MMA(0, 1, At, B1); PG8_BAR; PG8_SCHED;
            PG8_LDA(At, 0, 1); PG8_STAGE(PG8_SB(0, 0), b2, voffB); PG8_STAGE(PG8_SB(0, 1), b2 + hstep, voffB); PG8_STAGE(PG8_SA(0, 0), a2, voffA);
            PG8_WAIT_V(8); PG8_WAIT_L(0); PG8_BAR; PG8_MMA(1, 0, At, B0); PG8_MMA(1, 1, At, B1); PG8_BAR; PG8_SCHED;
            PG8_LDB(B0, 1, 0); PG8_LDB(B1, 1, 1); PG8_SCHED; PG8_LDA(At, 1, 0); PG8_STAGE(PG8_SA(0, 1), a2 + hstep, voffA);
            PG8_WAIT_V(8); PG8_WAIT_L(0); PG8_BAR; PG8_MMA(0, 0, At, B0); PG8_MMA(0, 1, At, B1); PG8_BAR; PG8_SCHED;
            PG8_LDA(At, 1, 1); PG8_STAGE(PG8_SB(1, 0), b3, voffB); PG8_STAGE(PG8_SB(1, 1), b3 + hstep, voffB); PG8_STAGE(PG8_SA(1, 0), a3, voffA);
            PG8_WAIT_V(8); PG8_WAIT_L(0); PG8_BAR; PG8_MMA(1, 0, At, B0); PG8_MMA(1, 1, At, B1); PG8_BAR; PG8_SCHED;
            } else {
            PG8_LDB(B0, 0, 0); PG8_SCHED; PG8_LDA(At, 0, 0); PG8_STAGE(PG8_SA(1, 1), a1 + hstep, voffA);
            PG8_WAIT_L(8); PG8_BAR; PG8_WAIT_L(0); PG8_MMA(0, 0, At, B0); PG8_BAR; PG8_SCHED;
            PG8_LDB(B1, 0, 1); PG8_STAGE(PG8_SB(0, 0), b2, voffB);
            PG8_BAR; PG8_WAIT_L(0); PG8_MMA(0, 1, At, B1); PG8_BAR;
            PG8_LDA(At, 0, 1); PG8_STAGE(PG8_SA(0, 0), a2, voffA);
            PG8_BAR; PG8_WAIT_L(0); PG8_MMA(1, 0, At, B0); PG8_BAR; PG8_SCHED;
            PG8_STAGE(PG8_SB(0, 1), b2 + hstep, voffB);
            PG8_WAIT_V(6); PG8_BAR; PG8_MMA(1, 1, At, B1); PG8_BAR;
            PG8_LDB(B0, 1, 0); PG8_SCHED; PG8_LDA(At, 1, 0); PG8_STAGE(PG8_SA(0, 1), a2 + hstep, voffA);
            PG8_WAIT_L(8); PG8_BAR; PG8_WAIT_L(0); PG8_MMA(0, 0, At, B0); PG8_BAR; PG8_SCHED;
            PG8_LDB(B1, 1, 1); PG8_STAGE(PG8_SB(1, 0), b3, voffB);
            PG8_BAR; PG8_WAIT_L(0); PG8_MMA(0, 1, At, B1); PG8_BAR;
            PG8_LDA(At, 1, 1); PG8_STAGE(PG8_SA(1, 0), a3, voffA);
            PG8_BAR; PG8_WAIT_L(0); PG8_MMA(1, 0, At, B0); PG8_BAR; PG8_SCHED;
            PG8_STAGE(PG8_SB(1, 1), b3 + hstep, voffB);
            PG8_WAIT_V(6); PG8_BAR; PG8_MMA(1, 1, At, B1); PG8_BAR;
            }
        }
        if constexpr (ALIGN_EPI) { if (wr == 0) PG8_BAR; }
        if constexpr (!Epi::AFTER_DRAIN) { E(acc, cur, wr, wc, fr, fq); S.done(cur); }
        if (!has_next) break;
#pragma unroll
        for (int a = 0; a < 2; ++a)
#pragma unroll
            for (int b = 0; b < 2; ++b)
#pragma unroll
                for (int m = 0; m < 4; ++m)
#pragma unroll
                    for (int n = 0; n < 2; ++n) acc[a][b][m][n] = (f32x4){0.f, 0.f, 0.f, 0.f};
        cur = nxt; cA = nA; cB = nB; ++ui;
        if constexpr (ALIGN_EPI) { if (wr == 1) PG8_BAR; }
    }
    PG8_WAIT_V(0);
    if constexpr (!ALIGN_EPI) { if (wr == 0) PG8_BAR; }
    PG8_BAR;
    if constexpr (Epi::AFTER_DRAIN) { E.fused(acc, cur, wr, wc, fr, fq, lds, wid, lane); S.done(cur); }
#undef PG8_SA
#undef PG8_SB
#undef PG8_STAGE
#undef PG8_LDA
#undef PG8_LDB
#undef PG8_MMA
#undef PG8_WAIT_V
#undef PG8_WAIT_L
#undef PG8_BAR
#undef PG8_SCHED
}
}

#define WTAB_OFF 155392
extern __shared__ __attribute__((aligned(16))) unsigned char lds_raw[];
__device__ __forceinline__ int hw_slot() { return (int)(__builtin_amdgcn_s_getreg((5 << 11) | 4) & 63u); }
__device__ __forceinline__ void otid_init() { const int t = threadIdx.x; if ((t & 63) == 0) ((__attribute__((address_space(3))) int*)(__attribute__((address_space(3))) void*)(lds_raw + WTAB_OFF))[hw_slot()] = t >> 6; }
__device__ __forceinline__ int otid() {
    const int w = __builtin_amdgcn_readfirstlane(((const __attribute__((address_space(3))) int*)(__attribute__((address_space(3))) void*)(lds_raw + WTAB_OFF))[hw_slot()]);
    int l; asm volatile("v_mbcnt_lo_u32_b32 %0, -1, 0\n\tv_mbcnt_hi_u32_b32 %0, -1, %0" : "=v"(l));
    return (w << 6) + l;
}
using pg8::bf16_t; using pg8::bf16x8; using pg8::f32x4; using pg8::u32x4;
#define LAS __attribute__((address_space(3)))

#define DMODEL 1024
#define NPT 16384
#define NST 32
#define NTOK 16416
#define MPAD 16640
#define SEQ 2048
#define ZW 2816
#define OFF_A 1536
#define OFF_B 1544
#define OFF_Z 1552
#define OFF_QA 2064
#define OFF_KVA 2448
#define OFF_KR 2704
#define DFF 2816
#define PAST 16384
#define NPAGES 128
#define EPSV 1e-6f

#define O_YP 0
#define O_YS (O_YP + 16777216)
#define O_CKVP (O_YS + 32768)
#define O_KRP (O_CKVP + 4194304)
#define O_GSP (O_KRP + 524288)
#define O_CSP (O_GSP + 262144)
#define O_CKVS (O_CSP + 36864)
#define O_KRS (O_CKVS + 8192)
#define O_GSS (O_KRS + 1024)
#define O_CSS (O_GSS + 1048576)

__device__ __forceinline__ bf16_t f2bf(float f) { unsigned u = __float_as_uint(f); return (bf16_t)((u + 0x7fffu + ((u >> 16) & 1u)) >> 16); }
__device__ __forceinline__ float bf2f(bf16_t b) { return __uint_as_float(((unsigned)b) << 16); }
__device__ __forceinline__ float wave_sum(float v) {
#pragma unroll
    for (int o = 1; o < 64; o <<= 1) v += __shfl_xor(v, o);
    return v;
}
__device__ __forceinline__ float sigmoidf_(float x) { return __builtin_amdgcn_rcpf(1.f + __builtin_amdgcn_exp2f(-1.44269504f * x)); }
__device__ __forceinline__ float siluf_(float x) { return x * __builtin_amdgcn_rcpf(1.f + __builtin_amdgcn_exp2f(-1.44269504f * x)); }


#define WSYNC() do { __builtin_amdgcn_fence(__ATOMIC_ACQ_REL, "wavefront"); __builtin_amdgcn_wave_barrier(); } while (0)
#define NTHR 512
#define NWAVE 8

typedef float f32x2_t __attribute__((ext_vector_type(2)));
typedef __bf16 bf16x2_t __attribute__((ext_vector_type(2)));
__device__ __forceinline__ unsigned cvtpk(float lo, float hi) { f32x2_t v = {lo, hi}; bf16x2_t r = __builtin_convertvector(v, bf16x2_t); return __builtin_bit_cast(unsigned, r); }
__device__ __forceinline__ unsigned pk2bf(float lo, float hi) { return (unsigned)f2bf(lo) | ((unsigned)f2bf(hi) << 16); }

__device__ __forceinline__ void wt_item(const float* __restrict__ W, int ldw, int col0, int nvalid, bf16_t* __restrict__ WT, int ldt, int nrow0, int k0, float* scr, int lane) {
    WSYNC();
#pragma unroll 8
    for (int i = 0; i < 32; ++i) { const int kk = 2 * i + (lane >> 5), n = lane & 31; scr[kk * 33 + n] = n < nvalid ? W[(size_t)(k0 + kk) * ldw + col0 + n] : 0.f; }
    WSYNC();
    const int c = lane & 7;
#pragma unroll
    for (int j = 0; j < 4; ++j) { const int n = (lane >> 3) + 8 * j; const float* sp = scr + (8 * c) * 33 + n;
        u32x4 o; o.x = cvtpk(sp[0], sp[33]); o.y = cvtpk(sp[2 * 33], sp[3 * 33]); o.z = cvtpk(sp[4 * 33], sp[5 * 33]); o.w = cvtpk(sp[6 * 33], sp[7 * 33]);
        *(u32x4*)(WT + (size_t)(nrow0 + n) * ldt + k0 + 8 * c) = o; }
}

__device__ __forceinline__ void rms1024_row(const float* __restrict__ src, const float* __restrict__ g, bf16_t* __restrict__ o, bool zero, int lane) {
    if (zero) { for (int j = 0; j < 4; ++j) { ushort4 z = {0, 0, 0, 0}; *(ushort4*)(o + lane * 4 + 256 * j) = z; } return; }
    float4 v[4]; float ss = 0.f;
#pragma unroll
    for (int j = 0; j < 4; ++j) { v[j] = *(const float4*)(src + lane * 4 + 256 * j); ss += v[j].x * v[j].x + v[j].y * v[j].y + v[j].z * v[j].z + v[j].w * v[j].w; }
    ss = wave_sum(ss);
    const float rs = rsqrtf(ss * (1.f / 1024.f) + EPSV);
#pragma unroll
    for (int j = 0; j < 4; ++j) {
        const float4 gg = *(const float4*)(g + lane * 4 + 256 * j);
        ushort4 w; w.x = f2bf(v[j].x * rs * gg.x); w.y = f2bf(v[j].y * rs * gg.y); w.z = f2bf(v[j].z * rs * gg.z); w.w = f2bf(v[j].w * rs * gg.w);
        *(ushort4*)(o + lane * 4 + 256 * j) = w;
    }
}

struct ABf16 { const bf16_t* p; int lda; __device__ __forceinline__ bf16x8 load(int m, int k) const { return *(const bf16x8*)(p + (size_t)m * lda + k); } };
struct ACache {
    const float* cache; const int* pt;
    __device__ __forceinline__ bf16x8 load(int m, int k) const {
        const int b = m >> 14, t = m & 16383; const int phys = pt[b * NPAGES + (t >> 7)];
        const float* r = cache + ((size_t)phys * 128 + (t & 127)) * 256 + k;
        const float4 a = *(const float4*)r, c = *(const float4*)(r + 4);
        bf16x8 o; o[0] = (short)f2bf(a.x); o[1] = (short)f2bf(a.y); o[2] = (short)f2bf(a.z); o[3] = (short)f2bf(a.w);
        o[4] = (short)f2bf(c.x); o[5] = (short)f2bf(c.y); o[6] = (short)f2bf(c.z); o[7] = (short)f2bf(c.w); return o;
    }
};
template <class AL, class Epi>
__device__ __forceinline__ void gemm_tile_256x128(const AL& al, const bf16_t* __restrict__ Bt, int ldb, int K, const Epi& epi, int m0, int n0, char* smem) {
    bf16_t (*sA)[40] = (bf16_t (*)[40])smem;
    bf16_t (*sB)[40] = (bf16_t (*)[40])(smem + 20480);
    const int tid = otid(), lane = tid & 63, wid = tid >> 6, wm = wid >> 1, wn = wid & 1;
    f32x4 acc[4][4];
#pragma unroll
    for (int i = 0; i < 4; ++i)
#pragma unroll
        for (int j = 0; j < 4; ++j) acc[i][j] = (f32x4){0.f, 0.f, 0.f, 0.f};
    __syncthreads();
    for (int k0 = 0; k0 < K; k0 += 32) {
#pragma unroll
        for (int i = 0; i < 2; ++i) { const int ch = tid + 512 * i, r = ch >> 2, kc = (ch & 3) * 8; *(bf16x8*)&sA[r][kc] = al.load(m0 + r, k0 + kc); }
        { const int r = tid >> 2, kc = (tid & 3) * 8; *(bf16x8*)&sB[r][kc] = *(const bf16x8*)(Bt + (size_t)(n0 + r) * ldb + k0 + kc); }
        __syncthreads();
        bf16x8 af[4], bfr[4];
#pragma unroll
        for (int i = 0; i < 4; ++i) af[i] = *(const bf16x8*)&sA[wm * 64 + i * 16 + (lane & 15)][(lane >> 4) * 8];
#pragma unroll
        for (int j = 0; j < 4; ++j) bfr[j] = *(const bf16x8*)&sB[wn * 64 + j * 16 + (lane & 15)][(lane >> 4) * 8];
#pragma unroll
        for (int i = 0; i < 4; ++i)
#pragma unroll
            for (int j = 0; j < 4; ++j) acc[i][j] = __builtin_amdgcn_mfma_f32_16x16x32_bf16(af[i], bfr[j], acc[i][j], 0, 0, 0);
        __syncthreads();
    }
#pragma unroll
    for (int i = 0; i < 4; ++i)
#pragma unroll
        for (int j = 0; j < 4; ++j)
#pragma unroll
            for (int r = 0; r < 4; ++r) epi(m0 + wm * 64 + i * 16 + (lane >> 4) * 4 + r, n0 + wn * 64 + j * 16 + (lane & 15), acc[i][j][r]);
}
template <class Epi>
__device__ __forceinline__ void gemm_tile_32x256(const bf16_t* __restrict__ A, int lda, const bf16_t* __restrict__ Bt, int ldb, int K, const Epi& epi, int m0, int n0, char* smem) {
    bf16_t (*sA)[40] = (bf16_t (*)[40])smem;
    bf16_t (*sB)[40] = (bf16_t (*)[40])(smem + 2560);
    const int tid = otid(), lane = tid & 63, wid = tid >> 6;
    f32x4 acc[2][2];
#pragma unroll
    for (int i = 0; i < 2; ++i)
#pragma unroll
        for (int j = 0; j < 2; ++j) acc[i][j] = (f32x4){0.f, 0.f, 0.f, 0.f};
    __syncthreads();
    for (int k0 = 0; k0 < K; k0 += 32) {
        if (tid < 128) { const int r = tid >> 2, kc = (tid & 3) * 8; *(bf16x8*)&sA[r][kc] = *(const bf16x8*)(A + (size_t)(m0 + r) * lda + k0 + kc); }
#pragma unroll
        for (int i = 0; i < 2; ++i) { const int ch = tid + 512 * i, r = ch >> 2, kc = (ch & 3) * 8; *(bf16x8*)&sB[r][kc] = *(const bf16x8*)(Bt + (size_t)(n0 + r) * ldb + k0 + kc); }
        __syncthreads();
        bf16x8 af[2], bfr[2];
#pragma unroll
        for (int i = 0; i < 2; ++i) af[i] = *(const bf16x8*)&sA[i * 16 + (lane & 15)][(lane >> 4) * 8];
#pragma unroll
        for (int j = 0; j < 2; ++j) bfr[j] = *(const bf16x8*)&sB[wid * 32 + j * 16 + (lane & 15)][(lane >> 4) * 8];
#pragma unroll
        for (int i = 0; i < 2; ++i)
#pragma unroll
            for (int j = 0; j < 2; ++j) acc[i][j] = __builtin_amdgcn_mfma_f32_16x16x32_bf16(af[i], bfr[j], acc[i][j], 0, 0, 0);
        __syncthreads();
    }
#pragma unroll
    for (int i = 0; i < 2; ++i)
#pragma unroll
        for (int j = 0; j < 2; ++j)
#pragma unroll
            for (int r = 0; r < 4; ++r) epi(m0 + i * 16 + (lane >> 4) * 4 + r, n0 + wid * 32 + j * 16 + (lane & 15), acc[i][j][r]);
}
template <bool SWIGLU, class Epi>
__device__ __forceinline__ void gemm_sample_rows(const bf16_t* __restrict__ A, int lda, const bf16_t* __restrict__ Bt, int K, int N, const Epi& epi, char*  , int bid, int nb) {
    const int tid = otid(), lane = tid & 63, wid = tid >> 6, i16 = lane & 15, q4 = lane >> 4;
    for (int u = nb - 1 - bid; u < N / 256; u += nb) {
        const int n0 = u * 256;
        const int c0 = SWIGLU ? n0 + 16 * wid : n0 + 32 * wid, c1 = SWIGLU ? n0 + 128 + 16 * wid : n0 + 32 * wid + 16;
        const bf16_t* a0p = A + (size_t)(NPT + i16) * lda + 8 * q4; const bf16_t* a1p = a0p + (size_t)16 * lda;
        const bf16_t* b0p = Bt + (size_t)(c0 + i16) * K + 8 * q4; const bf16_t* b1p = Bt + (size_t)(c1 + i16) * K + 8 * q4;
        f32x4 acc[2][2];
#pragma unroll
        for (int i = 0; i < 2; ++i)
#pragma unroll
            for (int j = 0; j < 2; ++j) acc[i][j] = (f32x4){0.f, 0.f, 0.f, 0.f};
#pragma unroll 4
        for (int k0 = 0; k0 < K; k0 += 32) {
            const bf16x8 a0 = *(const bf16x8*)(a0p + k0), a1 = *(const bf16x8*)(a1p + k0), b0 = *(const bf16x8*)(b0p + k0), b1 = *(const bf16x8*)(b1p + k0);
            acc[0][0] = __builtin_amdgcn_mfma_f32_16x16x32_bf16(a0, b0, acc[0][0], 0, 0, 0); acc[0][1] = __builtin_amdgcn_mfma_f32_16x16x32_bf16(a0, b1, acc[0][1], 0, 0, 0);
            acc[1][0] = __builtin_amdgcn_mfma_f32_16x16x32_bf16(a1, b0, acc[1][0], 0, 0, 0); acc[1][1] = __builtin_amdgcn_mfma_f32_16x16x32_bf16(a1, b1, acc[1][1], 0, 0, 0);
        }
#pragma unroll
        for (int i = 0; i < 2; ++i)
#pragma unroll
            for (int r = 0; r < 4; ++r) {
                const int m = NPT + 16 * i + 4 * q4 + r;
                if constexpr (SWIGLU) epi(m, (n0 >> 1) + 16 * wid + i16, siluf_(acc[i][0][r]) * acc[i][1][r]);
                else { epi(m, c0 + i16, acc[i][0][r]); epi(m, c1 + i16, acc[i][1][r]); }
            }
    }
}
template <bool SWIGLU, class Epi>
__device__ __forceinline__ void gemm_sample_rows_ks(const bf16_t* __restrict__ A, int lda, const bf16_t* __restrict__ Bt, int K, int N, const Epi& epi, char* smem, int bid, int nb) {
    const int tid = otid(), lane = tid & 63, wid = tid >> 6, i16 = lane & 15, q4 = lane >> 4;
    const int nunits = N / 64, ksl = K >> 3;
    f32x4* red = (f32x4*)smem;
    for (int u = nb - 1 - bid; u < nunits; u += nb) {
        int brow[4];
#pragma unroll
        for (int j = 0; j < 4; ++j) brow[j] = SWIGLU ? ((32 * u) >> 7) * 256 + ((32 * u) & 127) + 128 * (j >> 1) + 16 * (j & 1) + i16 : 64 * u + 16 * j + i16;
        const bf16_t* a0p = A + (size_t)(NPT + i16) * lda + wid * ksl + 8 * q4; const bf16_t* a1p = a0p + (size_t)16 * lda;
        f32x4 acc[2][4];
#pragma unroll
        for (int i = 0; i < 2; ++i)
#pragma unroll
            for (int j = 0; j < 4; ++j) acc[i][j] = (f32x4){0.f, 0.f, 0.f, 0.f};
        for (int k0 = 0; k0 < ksl; k0 += 32) {
            const bf16x8 a0 = *(const bf16x8*)(a0p + k0), a1 = *(const bf16x8*)(a1p + k0);
            bf16x8 b[4];
#pragma unroll
            for (int j = 0; j < 4; ++j) b[j] = *(const bf16x8*)(Bt + (size_t)brow[j] * K + wid * ksl + 8 * q4 + k0);
#pragma unroll
            for (int j = 0; j < 4; ++j) { acc[0][j] = __builtin_amdgcn_mfma_f32_16x16x32_bf16(a0, b[j], acc[0][j], 0, 0, 0); acc[1][j] = __builtin_amdgcn_mfma_f32_16x16x32_bf16(a1, b[j], acc[1][j], 0, 0, 0); }
        }
        __syncthreads();
#pragma unroll
        for (int i = 0; i < 2; ++i)
#pragma unroll
            for (int j = 0; j < 4; ++j) red[(wid * 8 + i * 4 + j) * 64 + lane] = acc[i][j];
        __syncthreads();
        if constexpr (SWIGLU) {
            if (tid < 256) {
                const int t4 = tid >> 6, i = t4 >> 1, jg = t4 & 1, l = tid & 63;
                f32x4 g = red[(i * 4 + jg) * 64 + l], up = red[(i * 4 + jg + 2) * 64 + l];
#pragma unroll
                for (int w = 1; w < 8; ++w) { g = g + red[(w * 8 + i * 4 + jg) * 64 + l]; up = up + red[(w * 8 + i * 4 + jg + 2) * 64 + l]; }
#pragma unroll
                for (int r = 0; r < 4; ++r) epi(NPT + 16 * i + 4 * (l >> 4) + r, 32 * u + 16 * jg + (l & 15), siluf_(g[r]) * up[r]);
            }
        } else {
            const int t8 = tid >> 6, l = tid & 63, i = t8 >> 2, j = t8 & 3;
            f32x4 v = red[t8 * 64 + l];
#pragma unroll
            for (int w = 1; w < 8; ++w) v = v + red[(w * 8 + t8) * 64 + l];
#pragma unroll
            for (int r = 0; r < 4; ++r) epi(NPT + 16 * i + 4 * (l >> 4) + r, 64 * u + 16 * j + (l & 15), v[r]);
        }
    }
    __syncthreads();
}
struct EwF32 { float* C; int ldc; __device__ __forceinline__ void operator()(int m, int n, float v) const { C[(size_t)m * ldc + n] = v; } };
struct EwBf16 { bf16_t* C; int ldc; __device__ __forceinline__ void operator()(int m, int n, float v) const { C[(size_t)m * ldc + n] = f2bf(v); } };
struct EwResX { const float* xs; float* C; __device__ __forceinline__ void operator()(int m, int n, float v) const { C[(size_t)m * 1024 + n] = xs[(size_t)(m - NPT) * 1024 + n] + v; } };
struct EwSwiglu {
    float* G; bf16_t* Hd;
    __device__ __forceinline__ void operator()(int m, int n, float v) const {
        const int f = (n >> 8) * 128 + (n & 127);
        if ((n & 255) < 128) G[(size_t)(m - NPT) * DFF + f] = v;
    }
};
struct EwSwiglu2 {
    const float* G; bf16_t* Hd;
    __device__ __forceinline__ void operator()(int m, int n, float v) const {
        const int f = (n >> 8) * 128 + (n & 127);
        if ((n & 255) >= 128) Hd[(size_t)m * DFF + f] = f2bf(siluf_(G[(size_t)(m - NPT) * DFF + f]) * v);
    }
};
struct EwResH { const float* H; float* C; __device__ __forceinline__ void operator()(int m, int n, float v) const { C[(size_t)m * 1024 + n] = H[(size_t)m * 1024 + n] + v; } };
struct EwPle { const float* H2; const float* PP; float* out;
    __device__ __forceinline__ void operator()(int m, int n, float v) const { out[O_YS + (size_t)(m - NPT) * 1024 + n] = H2[(size_t)m * 1024 + n] + PP[(size_t)m * 1024 + n] * sigmoidf_(v); } };

struct PgBf16 {
    static constexpr bool PERM = true, AFTER_DRAIN = false; bf16_t* O; int ldc;
    __device__ __forceinline__ void operator()(const f32x4 (&acc)[2][2][4][2], const pg8::Unit& u, int wr, int wc, int fr, int fq) const {
#pragma unroll
        for (int ai = 0; ai < 2; ++ai)
#pragma unroll
            for (int m = 0; m < 4; ++m) { bf16_t* rowp = O + (size_t)(u.pm * 256 + ai * 128 + wr * 64 + m * 16 + fr) * ldc + u.pn * 256 + wc * 32 + 8 * fq;
#pragma unroll
                for (int bj = 0; bj < 2; ++bj) { const f32x4 v0 = acc[ai][bj][m][0], v1 = acc[ai][bj][m][1]; u32x4 w; w.x = pk2bf(v0[0], v0[1]); w.y = pk2bf(v0[2], v0[3]); w.z = pk2bf(v1[0], v1[1]); w.w = pk2bf(v1[2], v1[3]); *(u32x4*)(rowp + bj * 128) = w; } }
    }
};
struct PgF32 {
    static constexpr bool PERM = false, AFTER_DRAIN = false; float* O; int ldc;
    __device__ __forceinline__ void operator()(const f32x4 (&acc)[2][2][4][2], const pg8::Unit& u, int wr, int wc, int fr, int fq) const {
#pragma unroll
        for (int ai = 0; ai < 2; ++ai)
#pragma unroll
            for (int m = 0; m < 4; ++m) { float* rowp = O + (size_t)(u.pm * 256 + ai * 128 + wr * 64 + m * 16 + fr) * ldc + u.pn * 256 + wc * 32 + 4 * fq;
#pragma unroll
                for (int bj = 0; bj < 2; ++bj)
#pragma unroll
                    for (int n = 0; n < 2; ++n) *(f32x4*)(rowp + bj * 128 + n * 16) = acc[ai][bj][m][n]; }
    }
};
struct PgRes {
    static constexpr bool PERM = false, AFTER_DRAIN = false; const float* R; float* O;
    __device__ __forceinline__ void operator()(const f32x4 (&acc)[2][2][4][2], const pg8::Unit& u, int wr, int wc, int fr, int fq) const {
#pragma unroll
        for (int ai = 0; ai < 2; ++ai)
#pragma unroll
            for (int m = 0; m < 4; ++m) { const size_t off = (size_t)(u.pm * 256 + ai * 128 + wr * 64 + m * 16 + fr) * 1024 + u.pn * 256 + wc * 32 + 4 * fq;
#pragma unroll
                for (int bj = 0; bj < 2; ++bj)
#pragma unroll
                    for (int n = 0; n < 2; ++n) { const f32x4 r = *(const f32x4*)(R + off + bj * 128 + n * 16); *(f32x4*)(O + off + bj * 128 + n * 16) = r + acc[ai][bj][m][n]; } }
    }
};
struct PgSwiglu {
    static constexpr bool PERM = true, AFTER_DRAIN = false; bf16_t* Hd;
    __device__ __forceinline__ void operator()(const f32x4 (&acc)[2][2][4][2], const pg8::Unit& u, int wr, int wc, int fr, int fq) const {
#pragma unroll
        for (int ai = 0; ai < 2; ++ai)
#pragma unroll
            for (int m = 0; m < 4; ++m) { bf16_t* rowp = Hd + (size_t)(u.pm * 256 + ai * 128 + wr * 64 + m * 16 + fr) * DFF + u.pn * 128 + wc * 32 + 8 * fq;
                float h[8];
#pragma unroll
                for (int n = 0; n < 2; ++n)
#pragma unroll
                    for (int i = 0; i < 4; ++i) h[n * 4 + i] = siluf_(acc[ai][0][m][n][i]) * acc[ai][1][m][n][i];
                u32x4 w; w.x = pk2bf(h[0], h[1]); w.y = pk2bf(h[2], h[3]); w.z = pk2bf(h[4], h[5]); w.w = pk2bf(h[6], h[7]); *(u32x4*)rowp = w; }
    }
};
struct PgPle {
    static constexpr bool PERM = false, AFTER_DRAIN = false; const float* H2; const float* PP; float* out;
    __device__ __forceinline__ void operator()(const f32x4 (&acc)[2][2][4][2], const pg8::Unit& u, int wr, int wc, int fr, int fq) const {
#pragma unroll
        for (int ai = 0; ai < 2; ++ai)
#pragma unroll
            for (int m = 0; m < 4; ++m) { const size_t off = (size_t)(u.pm * 256 + ai * 128 + wr * 64 + m * 16 + fr) * 1024 + u.pn * 256 + wc * 32 + 4 * fq;
#pragma unroll
                for (int bj = 0; bj < 2; ++bj)
#pragma unroll
                    for (int n = 0; n < 2; ++n) { const f32x4 h = *(const f32x4*)(H2 + off + bj * 128 + n * 16), pp = *(const f32x4*)(PP + off + bj * 128 + n * 16), a = acc[ai][bj][m][n]; f32x4 y;
#pragma unroll
                        for (int i = 0; i < 4; ++i) y[i] = h[i] + pp[i] * sigmoidf_(a[i]);
                        *(f32x4*)(out + O_YP + off + bj * 128 + n * 16) = y; } }
    }
};
template <class Epi>
__device__ __forceinline__ void pg_gemm(LAS unsigned char* lds, const bf16_t* A, const bf16_t* Bt, int M, int N, int K, const Epi& E) {
    pg8::Gemm g{A, Bt, M, N, K}; pg8::StaticOrder S; S.init(M, N, (int)gridDim.x, (int)blockIdx.x);
    pg8::gemm_phase<Epi, pg8::StaticOrder, true, true>(lds, g, S, E);
}

constexpr size_t WOF_WinT = 0ull;
constexpr size_t WOF_WqbT = 5767168ull;
constexpr size_t WOF_WkvT = 6356992ull;
constexpr size_t WOF_WknT = 6881280ull;
constexpr size_t WOF_WoT = 7143424ull;
constexpr size_t WOF_WguT = 9240576ull;
constexpr size_t WOF_WdT = 20774912ull;
constexpr size_t WOF_WpgT = 26542080ull;
constexpr size_t WOF_WppT = 28639232ull;
constexpr size_t WOF_xn = 29163520ull;
constexpr size_t WOF_pb = 63242240ull;
constexpr size_t WOF_Z = 71761920ull;
constexpr size_t WOF_qkv = 165478400ull;
constexpr size_t WOF_ropecs = 216596480ull;
constexpr size_t WOF_gg = 216858880ull;
constexpr size_t WOF_bb = 217391360ull;
constexpr size_t WOF_goraw = 217923840ull;
constexpr size_t WOF_gUT = 252002560ull;
constexpr size_t WOF_ggam = 285556992ull;
constexpr size_t WOF_gWn = 285565184ull;
constexpr size_t WOF_gQg = 302342400ull;
constexpr size_t WOF_gQK = 319119616ull;
constexpr size_t WOF_gKd = 335896832ull;
constexpr size_t WOF_qan = 352674048ull;
constexpr size_t WOF_ckvb = 365453568ull;
constexpr size_t WOF_krf = 373973248ull;
constexpr size_t WOF_Q = 376103168ull;
constexpr size_t WOF_qh = 427221248ull;
constexpr size_t WOF_KV = 478339328ull;
constexpr size_t WOF_kh = 546496768ull;
constexpr size_t WOF_omix = 580575488ull;
constexpr size_t WOF_KN = 614654208ull;
constexpr size_t WOF_SC = 1151525120ull;
constexpr size_t WOF_part = 1168302336ull;
constexpr size_t WOF_H = 1170432256ull;
constexpr size_t WOF_un = 1238589696ull;
constexpr size_t WOF_G = 1272668416ull;
constexpr size_t WOF_hid = 1273028864ull;
constexpr size_t WOF_H2 = 1366745344ull;
constexpr size_t WOF_un2 = 1434902784ull;
constexpr size_t WOF_PP = 1468981504ull;
constexpr size_t WOF_qraw = 1537138944ull;
constexpr size_t WOF_kvraw = 1562304768ull;
constexpr size_t WOF_krb = 1595859200ull;
constexpr size_t WOF_ctl = 1596907776ull;
constexpr size_t WS_TOTAL = 1596924160ull;
struct MK {
    const float *x_prompt, *x_sample, *cache_ckv, *cache_krope, *state_gdn, *state_conv; const int* page_table; const float *p_prompt, *p_sample;
    const float *g_attn, *w_in, *w_conv, *a_log, *dt_bias, *g_gdn_out, *g_q_a, *w_q_b, *g_q_nope, *g_q_rope, *g_kv_a, *g_k_rope, *w_kv_b, *g_k_nope, *w_o, *g_ffn, *w_gate, *w_up, *w_down, *g_ple, *w_ple_gate, *w_ple_proj;
    float* out; char* ws;
    __device__ __forceinline__ unsigned* ctl() const { return (unsigned*)(ws + WOF_ctl); }
    __device__ __forceinline__ bf16_t* WinT() const { return (bf16_t*)(ws + WOF_WinT); }
    __device__ __forceinline__ bf16_t* WqbT() const { return (bf16_t*)(ws + WOF_WqbT); }
    __device__ __forceinline__ bf16_t* WkvT() const { return (bf16_t*)(ws + WOF_WkvT); }
    __device__ __forceinline__ bf16_t* WknT() const { return (bf16_t*)(ws + WOF_WknT); }
    __device__ __forceinline__ bf16_t* WoT() const { return (bf16_t*)(ws + WOF_WoT); }
    __device__ __forceinline__ bf16_t* WguT() const { return (bf16_t*)(ws + WOF_WguT); }
    __device__ __forceinline__ bf16_t* WdT() const { return (bf16_t*)(ws + WOF_WdT); }
    __device__ __forceinline__ bf16_t* WpgT() const { return (bf16_t*)(ws + WOF_WpgT); }
    __device__ __forceinline__ bf16_t* WppT() const { return (bf16_t*)(ws + WOF_WppT); }
    __device__ __forceinline__ bf16_t* xn() const { return (bf16_t*)(ws + WOF_xn); }
    __device__ __forceinline__ bf16_t* pb() const { return (bf16_t*)(ws + WOF_pb); }
    __device__ __forceinline__ bf16_t* Z() const { return (bf16_t*)(ws + WOF_Z); }
    __device__ __forceinline__ bf16_t* qkv() const { return (bf16_t*)(ws + WOF_qkv); }
    __device__ __forceinline__ float* ropecs() const { return (float*)(ws + WOF_ropecs); }
    __device__ __forceinline__ float* gg() const { return (float*)(ws + WOF_gg); }
    __device__ __forceinline__ float* bb() const { return (float*)(ws + WOF_bb); }
    __device__ __forceinline__ float* goraw() const { return (float*)(ws + WOF_goraw); }
    __device__ __forceinline__ float* gUT() const { return (float*)(ws + WOF_gUT); }
    __device__ __forceinline__ float* ggam() const { return (float*)(ws + WOF_ggam); }
    __device__ __forceinline__ bf16_t* gWn() const { return (bf16_t*)(ws + WOF_gWn); }
    __device__ __forceinline__ bf16_t* gQg() const { return (bf16_t*)(ws + WOF_gQg); }
    __device__ __forceinline__ bf16_t* gQK() const { return (bf16_t*)(ws + WOF_gQK); }
    __device__ __forceinline__ bf16_t* gKd() const { return (bf16_t*)(ws + WOF_gKd); }
    __device__ __forceinline__ bf16_t* qan() const { return (bf16_t*)(ws + WOF_qan); }
    __device__ __forceinline__ bf16_t* ckvb() const { return (bf16_t*)(ws + WOF_ckvb); }
    __device__ __forceinline__ float* krf() const { return (float*)(ws + WOF_krf); }
    __device__ __forceinline__ float* Q() const { return (float*)(ws + WOF_Q); }
    __device__ __forceinline__ float* qh() const { return (float*)(ws + WOF_qh); }
    __device__ __forceinline__ float* KV() const { return (float*)(ws + WOF_KV); }
    __device__ __forceinline__ float* kh() const { return (float*)(ws + WOF_kh); }
    __device__ __forceinline__ bf16_t* omix() const { return (bf16_t*)(ws + WOF_omix); }
    __device__ __forceinline__ bf16_t* KN() const { return (bf16_t*)(ws + WOF_KN); }
    __device__ __forceinline__ float* SC() const { return (float*)(ws + WOF_SC); }
    __device__ __forceinline__ float* part() const { return (float*)(ws + WOF_part); }
    __device__ __forceinline__ float* H() const { return (float*)(ws + WOF_H); }
    __device__ __forceinline__ bf16_t* un() const { return (bf16_t*)(ws + WOF_un); }
    __device__ __forceinline__ float* G() const { return (float*)(ws + WOF_G); }
    __device__ __forceinline__ bf16_t* hid() const { return (bf16_t*)(ws + WOF_hid); }
    __device__ __forceinline__ float* H2() const { return (float*)(ws + WOF_H2); }
    __device__ __forceinline__ bf16_t* un2() const { return (bf16_t*)(ws + WOF_un2); }
    __device__ __forceinline__ float* PP() const { return (float*)(ws + WOF_PP); }
    __device__ __forceinline__ bf16_t* qraw() const { return (bf16_t*)(ws + WOF_qraw); }
    __device__ __forceinline__ bf16_t* kvraw() const { return (bf16_t*)(ws + WOF_kvraw); }
    __device__ __forceinline__ bf16_t* krb() const { return (bf16_t*)(ws + WOF_krb); }
};

__device__ __forceinline__ float fast_sigmoid(float x) { return __builtin_amdgcn_rcpf(1.f + __builtin_amdgcn_exp2f(-1.44269504f * x)); }
__device__ __forceinline__ void bf8_to_f32(const bf16x8& v, float* o) {
#pragma unroll
    for (int e = 0; e < 8; ++e) o[e] = __uint_as_float(((unsigned)(unsigned short)v[e]) << 16);
}
__device__ __forceinline__ bf16x8 f32_to_bf8(const float* x) {
    u32x4 w; w.x = cvtpk(x[0], x[1]); w.y = cvtpk(x[2], x[3]); w.z = cvtpk(x[4], x[5]); w.w = cvtpk(x[6], x[7]);
    return __builtin_bit_cast(bf16x8, w);
}
struct PinTok { bf16x8 qa, cv, kr; float ab; };
struct PinGain { float gqa[8], gkv[8], gkr[8], dtb, alog; };
__device__ __forceinline__ PinTok pin_load(const MK& a, int row, int lane) {
    const bf16_t* z = a.Z() + (size_t)row * ZW; PinTok t; const bf16x8 zz = {0, 0, 0, 0, 0, 0, 0, 0};
    t.qa = lane < 48 ? *(const bf16x8*)(z + OFF_QA + 8 * lane) : zz; t.cv = lane < 32 ? *(const bf16x8*)(z + OFF_KVA + 8 * lane) : zz;
    t.kr = (lane >= 32 && lane < 36) ? *(const bf16x8*)(z + OFF_KR + 8 * (lane - 32)) : zz; t.ab = lane < 16 ? bf2f(z[OFF_A + lane]) : 0.f; return t;
}
__device__ __forceinline__ void post_in_token(const MK& a, int row, int lane, const float* wcs, const bf16x8 (&w0)[3], const bf16x8 (&w1)[3], const bf16x8 (&w2)[3], const bf16x8 (&wcur)[3], const PinTok& tk, const PinGain& gn) {
    const bool samp = row >= NPT;
    const int b = samp ? row - NPT : row >> 11, t = samp ? 0 : row & 2047, hd = lane >> 3;
    float y[24];
#pragma unroll
    for (int c3 = 0; c3 < 3; ++c3) {
        float p0[8], p1[8], p2[8], cu[8];
        bf8_to_f32(w0[c3], p0); bf8_to_f32(w1[c3], p1); bf8_to_f32(w2[c3], p2); bf8_to_f32(wcur[c3], cu);
        const float* wp = wcs + 512 * c3 + 8 * lane;
        const float4 a0 = *(const float4*)wp, a1 = *(const float4*)(wp + 4), b0 = *(const float4*)(wp + 1536), b1 = *(const float4*)(wp + 1540);
        const float4 c0 = *(const float4*)(wp + 3072), c1 = *(const float4*)(wp + 3076), d0 = *(const float4*)(wp + 4608), d1 = *(const float4*)(wp + 4612);
        const float k0[8] = {a0.x, a0.y, a0.z, a0.w, a1.x, a1.y, a1.z, a1.w}, k1[8] = {b0.x, b0.y, b0.z, b0.w, b1.x, b1.y, b1.z, b1.w};
        const float k2[8] = {c0.x, c0.y, c0.z, c0.w, c1.x, c1.y, c1.z, c1.w}, k3[8] = {d0.x, d0.y, d0.z, d0.w, d1.x, d1.y, d1.z, d1.w};
#pragma unroll
        for (int e = 0; e < 8; ++e) { const int c = 8 * c3 + e; const float v = k0[e] * p0[e] + k1[e] * p1[e] + k2[e] * p2[e] + k3[e] * cu[e]; y[c] = v * fast_sigmoid(v); }
        __builtin_amdgcn_sched_barrier(0);
    }
    float sq = 0.f, sk = 0.f;
#pragma unroll
    for (int e = 0; e < 8; ++e) { sq += y[e] * y[e]; sk += y[8 + e] * y[8 + e]; }
    sq += __shfl_xor(sq, 1); sk += __shfl_xor(sk, 1); sq += __shfl_xor(sq, 2); sk += __shfl_xor(sk, 2); sq += __shfl_xor(sq, 4); sk += __shfl_xor(sk, 4);
    const float rq = rsqrtf(sq + EPSV) * 0.125f, rk = rsqrtf(sk + EPSV);
#pragma unroll
    for (int e = 0; e < 8; ++e) { y[e] *= rq; y[8 + e] *= rk; }
    bf16_t* qo = a.qkv() + (size_t)row * 1536 + 8 * lane;
    *(bf16x8*)qo = f32_to_bf8(y); *(bf16x8*)(qo + 512) = f32_to_bf8(y + 8); *(bf16x8*)(qo + 1024) = f32_to_bf8(y + 16);
    if (!samp && t >= SEQ - 3) {
        float* cso = a.out + O_CSP + ((size_t)b * 3 + (t - (SEQ - 3))) * 1536 + 8 * lane;
#pragma unroll
        for (int j = 0; j < 3; ++j) { float cu[8]; bf8_to_f32(wcur[j], cu); *(float4*)(cso + 512 * j) = (float4){cu[0], cu[1], cu[2], cu[3]}; *(float4*)(cso + 512 * j + 4) = (float4){cu[4], cu[5], cu[6], cu[7]}; }
    }
    if (lane < 16) {
        const float v = tk.ab;
        if (lane < 8) { const float xx = v + gn.dtb; const float sp = xx > 20.f ? xx : log1pf(expf(xx)); a.gg()[(size_t)row * 8 + lane] = -gn.alog * sp; }
        else a.bb()[(size_t)row * 8 + lane - 8] = 1.f / (1.f + expf(-v));
    }
    __builtin_amdgcn_sched_barrier(0);
    float qa[8], cv[8], kr[8];
    bf8_to_f32(tk.qa, qa); bf8_to_f32(tk.cv, cv); bf8_to_f32(tk.kr, kr);
    float s1 = 0.f, s2 = 0.f, s3 = 0.f;
#pragma unroll
    for (int e = 0; e < 8; ++e) { s1 += qa[e] * qa[e]; s2 += cv[e] * cv[e]; s3 += kr[e] * kr[e]; }
#pragma unroll
    for (int o = 1; o < 64; o <<= 1) { s1 += __shfl_xor(s1, o); s2 += __shfl_xor(s2, o); s3 += __shfl_xor(s3, o); }
    const float r1 = rsqrtf(s1 * (1.f / 384.f) + EPSV), r2 = rsqrtf(s2 * (1.f / 256.f) + EPSV), r3 = rsqrtf(s3 * (1.f / 32.f) + EPSV);
    if (lane < 48) {
        float o[8];
#pragma unroll
        for (int e = 0; e < 8; ++e) o[e] = qa[e] * r1 * gn.gqa[e];
        *(bf16x8*)(a.qan() + (size_t)row * 384 + 8 * lane) = f32_to_bf8(o);
    }
    if (lane < 32) {
        float o[8];
#pragma unroll
        for (int e = 0; e < 8; ++e) o[e] = cv[e] * r2 * gn.gkv[e];
        *(bf16x8*)(a.ckvb() + (size_t)row * 256 + 8 * lane) = f32_to_bf8(o);
        float* co = samp ? a.out + O_CKVS + (size_t)b * 256 + 8 * lane : a.out + O_CKVP + (size_t)row * 256 + 8 * lane;
        *(float4*)co = (float4){o[0], o[1], o[2], o[3]}; *(float4*)(co + 4) = (float4){o[4], o[5], o[6], o[7]};
    }
    __builtin_amdgcn_sched_barrier(0);
    {
        const int c4 = (lane - 32) & 3;
        float xn[8], ot[8];
#pragma unroll
        for (int e = 0; e < 8; ++e) xn[e] = kr[e] * r3 * gn.gkr[e];
#pragma unroll
        for (int e = 0; e < 8; ++e) ot[e] = __shfl_xor(xn[e], 2);
        if (lane >= 32 && lane < 36) {
            const float* tb = a.ropecs() + (size_t)(samp ? 2048 : t) * 32 + ((8 * c4) & 15);
            const float4 c0 = *(const float4*)tb, c1 = *(const float4*)(tb + 4), s0 = *(const float4*)(tb + 16), s1 = *(const float4*)(tb + 20);
            const float csv[8] = {c0.x, c0.y, c0.z, c0.w, c1.x, c1.y, c1.z, c1.w}, snv[8] = {s0.x, s0.y, s0.z, s0.w, s1.x, s1.y, s1.z, s1.w};
            float o[8];
#pragma unroll
            for (int e = 0; e < 8; ++e) o[e] = c4 < 2 ? xn[e] * csv[e] - ot[e] * snv[e] : ot[e] * snv[e] + xn[e] * csv[e];
            float* kf_ = a.krf() + (size_t)row * 32 + 8 * c4; *(float4*)kf_ = (float4){o[0], o[1], o[2], o[3]}; *(float4*)(kf_ + 4) = (float4){o[4], o[5], o[6], o[7]};
            float* ko = samp ? a.out + O_KRS + (size_t)b * 32 + 8 * c4 : a.out + O_KRP + (size_t)row * 32 + 8 * c4;
            *(float4*)ko = (float4){o[0], o[1], o[2], o[3]}; *(float4*)(ko + 4) = (float4){o[4], o[5], o[6], o[7]};
            if (!samp) *(bf16x8*)(a.krb() + (size_t)row * 32 + 8 * c4) = f32_to_bf8(o);
        }
    }
    (void)hd;
}
__device__ __forceinline__ void post_in_run(const MK& a, int run, int lane_in, const float* wcs) {
    int lane = lane_in; asm volatile("" : "+v"(lane));
    PinGain gn;
    {
        const int lq = lane < 48 ? lane : 0, lk = lane < 32 ? lane : 0, c4 = (lane - 32) & 3;
#pragma unroll
        for (int e = 0; e < 8; ++e) { gn.gqa[e] = a.g_q_a[8 * lq + e]; gn.gkv[e] = a.g_kv_a[8 * lk + e]; gn.gkr[e] = a.g_k_rope[8 * c4 + e]; }
        gn.dtb = a.dt_bias[lane & 7]; gn.alog = expf(a.a_log[lane & 7]);
    }
    if (run < NPT / 8) {
        const int row0 = run * 8, t0 = row0 & 2047;
        bf16x8 w0[3], w1[3], w2[3], wcur[3];
#pragma unroll
        for (int c3 = 0; c3 < 3; ++c3) {
            const bf16x8 zz = {0, 0, 0, 0, 0, 0, 0, 0}; w0[c3] = zz; w1[c3] = zz; w2[c3] = zz;
            if (t0 > 0) { const bf16_t* zp = a.Z() + (size_t)(row0 - 3) * ZW + 512 * c3 + 8 * lane; w0[c3] = *(const bf16x8*)zp; w1[c3] = *(const bf16x8*)(zp + ZW); w2[c3] = *(const bf16x8*)(zp + 2 * ZW); }
        }
        bf16x8 wnext[3]; PinTok tk, tkn;
#pragma unroll
        for (int c3 = 0; c3 < 3; ++c3) wnext[c3] = *(const bf16x8*)(a.Z() + (size_t)row0 * ZW + 512 * c3 + 8 * lane);
        tkn = pin_load(a, row0, lane);
#pragma unroll 1
        for (int k = 0; k < 8; ++k) {
            const int row = row0 + k;
#pragma unroll
            for (int c3 = 0; c3 < 3; ++c3) wcur[c3] = wnext[c3];
            tk = tkn;
            if (k < 7) {
#pragma unroll
                for (int c3 = 0; c3 < 3; ++c3) wnext[c3] = *(const bf16x8*)(a.Z() + (size_t)(row + 1) * ZW + 512 * c3 + 8 * lane);
                tkn = pin_load(a, row + 1, lane);
            }
            post_in_token(a, row, lane, wcs, w0, w1, w2, wcur, tk, gn);
#pragma unroll
            for (int c3 = 0; c3 < 3; ++c3) { w0[c3] = w1[c3]; w1[c3] = w2[c3]; w2[c3] = wcur[c3]; }
        }
    } else {
        {
            const int bsm = run - NPT / 8, row = NPT + bsm;
            bf16x8 w0[3], w1[3], w2[3], wcur[3];
#pragma unroll
            for (int c3 = 0; c3 < 3; ++c3) {
                const float* sp = a.state_conv + (size_t)bsm * 3 * 1536 + 512 * c3 + 8 * lane;
                float* cso = a.out + O_CSS + (size_t)bsm * 3 * 1536 + 512 * c3 + 8 * lane;
                float t0_[8], t1_[8], t2_[8], tc_[8];
#pragma unroll
                for (int e = 0; e < 8; ++e) { t0_[e] = sp[e]; t1_[e] = sp[1536 + e]; t2_[e] = sp[2 * 1536 + e]; }
                wcur[c3] = *(const bf16x8*)(a.Z() + (size_t)row * ZW + 512 * c3 + 8 * lane); bf8_to_f32(wcur[c3], tc_);
#pragma unroll
                for (int e = 0; e < 8; ++e) { cso[e] = t1_[e]; cso[1536 + e] = t2_[e]; cso[2 * 1536 + e] = tc_[e]; }
                w0[c3] = f32_to_bf8(t0_); w1[c3] = f32_to_bf8(t1_); w2[c3] = f32_to_bf8(t2_);
            }
            post_in_token(a, row, lane, wcs, w0, w1, w2, wcur, pin_load(a, row, lane), gn);
        }
    }
}

__device__ __forceinline__ void post_q_item(const MK& a, int idx, int lane) {
    const int row = idx >> 3, h = idx & 7;
    const float* q = a.Q() + (size_t)row * 768 + h * 96;
    float* o = a.qh() + ((size_t)row * 8 + h) * 96;
    const float v = q[lane];
    const float ss = wave_sum(v * v);
    o[lane] = v * rsqrtf(ss * (1.f / 64.f) + EPSV) * a.g_q_nope[lane];
    const float r = lane < 32 ? q[64 + lane] : 0.f;
    const float s2 = wave_sum(r * r);
    const float xn = lane < 32 ? r * rsqrtf(s2 * (1.f / 32.f) + EPSV) * a.g_q_rope[lane] : 0.f;
    const float other = __shfl_xor(xn, 16);
    const int i = lane & 15;
    const float* tb = a.ropecs() + (size_t)(row >= NPT ? 2048 : (row & 2047)) * 32;
    const float cs = tb[i], sn = tb[16 + i];
    const float ov = lane < 16 ? xn * cs - other * sn : other * sn + xn * cs;
    if (lane < 32) o[64 + lane] = ov;
}
__device__ __forceinline__ void post_kv_item(const MK& a, int idx, int lane) {
    const int row = idx >> 3, h = idx & 7;
    const float v = a.KV()[(size_t)row * 1024 + h * 128 + lane];
    const float ss = wave_sum(v * v);
    const float kn = v * rsqrtf(ss * (1.f / 64.f) + EPSV) * a.g_k_nope[lane];
    a.kh()[((size_t)row * 8 + h) * 64 + lane] = kn;
}

typedef float f32x16 __attribute__((ext_vector_type(16)));
typedef short s16x4 __attribute__((ext_vector_type(4)));
#define KST 104
#define VST 72
#define ATT_BUF (64 * KST * 2 + 64 * VST * 2)
__device__ __forceinline__ int crow32(int r, int hi) { return (r & 3) + 8 * (r >> 2) + 4 * hi; }
__device__ __forceinline__ s16x4 tr_read(const bf16_t* p) { return __builtin_bit_cast(s16x4, __builtin_amdgcn_ds_read_tr16_b64_v4i16((LAS s16x4*)(LAS void*)(unsigned)(size_t)p)); }
__device__ __forceinline__ bf16x8 pack8(const f32x16& x, int s) {
    u32x4 w; w.x = pk2bf(x[8 * s], x[8 * s + 1]); w.y = pk2bf(x[8 * s + 2], x[8 * s + 3]); w.z = pk2bf(x[8 * s + 4], x[8 * s + 5]); w.w = pk2bf(x[8 * s + 6], x[8 * s + 7]);
    return __builtin_bit_cast(bf16x8, w);
}
__device__ __forceinline__ void attn_block(const MK& a, int b, int h, int qb, char* smem) {
    const int tid = otid(), lane = tid & 63, wid = tid >> 6, r32 = lane & 31, hi = lane >> 5;
    const int qrow = qb * 256 + wid * 32 + r32;
    const int wq0 = qb * 256 + wid * 32;
    bf16x8 qf[6];
    {
        const float SCL = 0.14724445f;
        const bf16_t* Qg = a.qraw() + ((size_t)b * SEQ + qrow) * 768 + h * 96 + 8 * hi;
        float qv[6][8];
#pragma unroll
        for (int ds = 0; ds < 6; ++ds) bf8_to_f32(*(const bf16x8*)(Qg + 16 * ds), qv[ds]);
        float sn_ = 0.f, sr_ = 0.f;
#pragma unroll
        for (int j = 0; j < 8; ++j) { sn_ += qv[0][j] * qv[0][j] + qv[1][j] * qv[1][j] + qv[2][j] * qv[2][j] + qv[3][j] * qv[3][j]; sr_ += qv[4][j] * qv[4][j] + qv[5][j] * qv[5][j]; }
        sn_ += __shfl_xor(sn_, 32); sr_ += __shfl_xor(sr_, 32);
        const float rsn = rsqrtf(sn_ * (1.f / 64.f) + EPSV) * SCL, rsr = rsqrtf(sr_ * (1.f / 32.f) + EPSV);
#pragma unroll
        for (int ds = 0; ds < 4; ++ds) {
            float o[8];
#pragma unroll
            for (int j = 0; j < 8; ++j) o[j] = qv[ds][j] * rsn * a.g_q_nope[16 * ds + 8 * hi + j];
            qf[ds] = f32_to_bf8(o);
        }
        const float* tb = a.ropecs() + (size_t)qrow * 32 + 8 * hi;
        float o4[8], o5[8];
#pragma unroll
        for (int j = 0; j < 8; ++j) {
            const float x1 = qv[4][j] * rsr * a.g_q_rope[8 * hi + j], x2 = qv[5][j] * rsr * a.g_q_rope[16 + 8 * hi + j], cs = tb[j], sn = tb[16 + j];
            o4[j] = (x1 * cs - x2 * sn) * SCL; o5[j] = (x1 * sn + x2 * cs) * SCL;
        }
        qf[4] = f32_to_bf8(o4); qf[5] = f32_to_bf8(o5);
    }
    f32x16 o0, o1;
#pragma unroll
    for (int r = 0; r < 16; ++r) { o0[r] = 0.f; o1[r] = 0.f; }
    float m = -INFINITY, l = 0.f;
    const int nt = qb * 4 + 4;
    const int vr = tid >> 3, vc = tid & 7, rr_ = (tid >> 2) & 63, rc = tid & 3;
    const bf16_t* KVg = a.kvraw() + (size_t)b * SEQ * 1024 + h * 128 + (size_t)vr * 1024 + vc * 8;
    const bf16_t* KRg = a.krb() + (size_t)b * SEQ * 32 + (size_t)rr_ * 32 + rc * 8;
    float gk[8];
#pragma unroll
    for (int j = 0; j < 8; ++j) gk[j] = a.g_k_nope[8 * vc + j];
    bf16x8 kr0, kr1, vr0;
#define ATT_LOAD(tt) do { kr0 = *(const bf16x8*)(KVg + (size_t)(tt) * 64 * 1024); vr0 = *(const bf16x8*)(KVg + (size_t)(tt) * 64 * 1024 + 64); if (tid < 256) kr1 = *(const bf16x8*)(KRg + (size_t)(tt) * 64 * 32); } while (0)
#define ATT_STORE(buf) do { bf16_t* Ks_ = (bf16_t*)(smem + (buf) * ATT_BUF); bf16_t* Vs_ = Ks_ + 64 * KST; \
        float x_[8]; bf8_to_f32(kr0, x_); float ss_ = 0.f; _Pragma("unroll") for (int j = 0; j < 8; ++j) ss_ += x_[j] * x_[j]; \
        ss_ += __shfl_xor(ss_, 1); ss_ += __shfl_xor(ss_, 2); ss_ += __shfl_xor(ss_, 4); const float rs_ = rsqrtf(ss_ * (1.f / 64.f) + EPSV); \
        _Pragma("unroll") for (int j = 0; j < 8; ++j) x_[j] *= rs_ * gk[j]; \
        *(bf16x8*)(Ks_ + vr * KST + vc * 8) = f32_to_bf8(x_); *(bf16x8*)(Vs_ + vr * VST + vc * 8) = vr0; \
        if (tid < 256) *(bf16x8*)(Ks_ + rr_ * KST + 64 + rc * 8) = kr1; } while (0)
    ATT_LOAD(0);
    __syncthreads();
    ATT_STORE(0);
    __syncthreads();
    const int i16 = lane & 15, qq = i16 >> 2, pp = i16 & 3, g1 = (lane >> 4) & 1;
    for (int t = 0; t < nt; ++t) {
        const bf16_t* Ks = (const bf16_t*)(smem + (t & 1) * ATT_BUF); const bf16_t* Vs = Ks + 64 * KST;
        if (t + 1 < nt) ATT_LOAD(t + 1);
        if (64 * t <= wq0 + 31) {
            f32x16 p0, p1;
#pragma unroll
            for (int r = 0; r < 16; ++r) { p0[r] = 0.f; p1[r] = 0.f; }
#pragma unroll
            for (int ds = 0; ds < 6; ++ds) {
                const bf16x8 k0 = *(const bf16x8*)(Ks + r32 * KST + 16 * ds + 8 * hi);
                const bf16x8 k1 = *(const bf16x8*)(Ks + (32 + r32) * KST + 16 * ds + 8 * hi);
                p0 = __builtin_amdgcn_mfma_f32_32x32x16_bf16(k0, qf[ds], p0, 0, 0, 0);
                p1 = __builtin_amdgcn_mfma_f32_32x32x16_bf16(k1, qf[ds], p1, 0, 0, 0);
            }
            if (64 * t + 63 > wq0) {
#pragma unroll
                for (int r = 0; r < 16; ++r) { const int kv = 64 * t + crow32(r, hi); if (kv > qrow) p0[r] = -INFINITY; if (kv + 32 > qrow) p1[r] = -INFINITY; }
            }
            float mx = fmaxf(p0[0], p1[0]);
#pragma unroll
            for (int r = 1; r < 16; ++r) mx = fmaxf(mx, fmaxf(p0[r], p1[r]));
            mx = fmaxf(mx, __shfl_xor(mx, 32));
            const float mn = fmaxf(m, mx);
            const float alpha = __builtin_amdgcn_exp2f(m - mn);
            m = mn;
            float rs = 0.f;
#pragma unroll
            for (int r = 0; r < 16; ++r) { p0[r] = __builtin_amdgcn_exp2f(p0[r] - mn); p1[r] = __builtin_amdgcn_exp2f(p1[r] - mn); rs += p0[r] + p1[r]; }
            l = l * alpha + rs;
#pragma unroll
            for (int r = 0; r < 16; ++r) { o0[r] *= alpha; o1[r] *= alpha; }
            bf16x8 pf[4];
            pf[0] = pack8(p0, 0); pf[1] = pack8(p0, 1); pf[2] = pack8(p1, 0); pf[3] = pack8(p1, 1);
#pragma unroll
            for (int ks = 0; ks < 4; ++ks) {
                const bf16_t* vb0 = Vs + (16 * ks + 4 * hi + qq) * VST + 16 * g1 + 4 * pp;
                const s16x4 a0 = tr_read(vb0), a1 = tr_read(vb0 + 8 * VST);
                const s16x4 c0 = tr_read(vb0 + 32), c1 = tr_read(vb0 + 8 * VST + 32);
                const bf16x8 va = __builtin_shufflevector(a0, a1, 0, 1, 2, 3, 4, 5, 6, 7);
                const bf16x8 vc_ = __builtin_shufflevector(c0, c1, 0, 1, 2, 3, 4, 5, 6, 7);
                o0 = __builtin_amdgcn_mfma_f32_32x32x16_bf16(va, pf[ks], o0, 0, 0, 0);
                o1 = __builtin_amdgcn_mfma_f32_32x32x16_bf16(vc_, pf[ks], o1, 0, 0, 0);
            }
        }
        if (t + 1 < nt) ATT_STORE((t + 1) & 1);
        __syncthreads();
    }
    l += __shfl_xor(l, 32);
    const float il = 1.f / l;
    bf16_t* op = a.omix() + ((size_t)b * SEQ + qrow) * 1024 + 512 + h * 64;
#pragma unroll
    for (int g = 0; g < 4; ++g) {
        uint2 w0, w1;
        w0.x = pk2bf(o0[4 * g] * il, o0[4 * g + 1] * il); w0.y = pk2bf(o0[4 * g + 2] * il, o0[4 * g + 3] * il);
        w1.x = pk2bf(o1[4 * g] * il, o1[4 * g + 1] * il); w1.y = pk2bf(o1[4 * g + 2] * il, o1[4 * g + 3] * il);
        *(uint2*)(op + 8 * g + 4 * hi) = w0;
        *(uint2*)(op + 32 + 8 * g + 4 * hi) = w1;
    }
#undef ATT_LOAD
#undef ATT_STORE
}

__device__ __forceinline__ void gdn_unit(const MK& a, int b, int h, int dvg, const float* s0, float* sout, int row0, int T, int lane, char* wsm) {
    float (*sq)[64] = (float (*)[64])wsm;
    float (*sk)[64] = (float (*)[64])(wsm + 4096);
    float (*sv)[8] = (float (*)[8])(wsm + 8192);
    float* sg = (float*)(wsm + 8704);
    float* sb = (float*)(wsm + 8768);
    const int e = lane & 7, ko = lane >> 3, col = dvg * 8 + e;
    float S[8];
#pragma unroll
    for (int d = 0; d < 8; ++d) S[d] = s0 ? s0[(((size_t)b * 8 + h) * 64 + ko * 8 + d) * 64 + col] : 0.f;
    const size_t rbase = (size_t)row0 + (size_t)b * T;
    float pq[16], pk[16], pv0, pv1, pgb;
    {
        const int nt = T < 16 ? T : 16;
#pragma unroll
        for (int j = 0; j < 16; ++j) { const bool ok = j < nt; const size_t r = rbase + (ok ? j : 0); pq[j] = ok ? bf2f(a.qkv()[r * 1536 + h * 64 + lane]) : 0.f; pk[j] = ok ? bf2f(a.qkv()[r * 1536 + 512 + h * 64 + lane]) : 0.f; }
        { const int j0 = lane >> 3, j1 = j0 + 8; pv0 = j0 < nt ? bf2f(a.qkv()[(rbase + j0) * 1536 + 1024 + h * 64 + dvg * 8 + (lane & 7)]) : 0.f; pv1 = j1 < nt ? bf2f(a.qkv()[(rbase + j1) * 1536 + 1024 + h * 64 + dvg * 8 + (lane & 7)]) : 0.f; }
        { const int j = lane & 15; pgb = j < nt ? (lane < 16 ? a.gg()[(rbase + j) * 8 + h] : a.bb()[(rbase + j) * 8 + h]) : 0.f; }
    }
    for (int t0 = 0; t0 < T; t0 += 16) {
        const int nt = (T - t0) < 16 ? (T - t0) : 16;
        WSYNC();
#pragma unroll
        for (int j = 0; j < 16; ++j) { sq[j][lane] = pq[j]; sk[j][lane] = pk[j]; }
        sv[lane >> 3][lane & 7] = pv0; sv[(lane >> 3) + 8][lane & 7] = pv1;
        if (lane < 16) sg[lane] = expf(pgb); else if (lane < 32) sb[lane - 16] = pgb;
        WSYNC();
        if (t0 + 16 < T) {
            const size_t rb = rbase + t0 + 16;
#pragma unroll
            for (int j = 0; j < 16; ++j) { pq[j] = bf2f(a.qkv()[(rb + j) * 1536 + h * 64 + lane]); pk[j] = bf2f(a.qkv()[(rb + j) * 1536 + 512 + h * 64 + lane]); }
            pv0 = bf2f(a.qkv()[(rb + (lane >> 3)) * 1536 + 1024 + h * 64 + dvg * 8 + (lane & 7)]); pv1 = bf2f(a.qkv()[(rb + (lane >> 3) + 8) * 1536 + 1024 + h * 64 + dvg * 8 + (lane & 7)]);
            pgb = lane < 16 ? a.gg()[(rb + (lane & 15)) * 8 + h] : a.bb()[(rb + (lane & 15)) * 8 + h];
        }
        for (int j = 0; j < nt; ++j) {
            const float dec = sg[j], be = sb[j], v = sv[j][e];
            const float4 k0 = *(const float4*)&sk[j][ko * 8], k1 = *(const float4*)&sk[j][ko * 8 + 4];
            const float4 q0 = *(const float4*)&sq[j][ko * 8], q1 = *(const float4*)&sq[j][ko * 8 + 4];
            const float kk[8] = {k0.x, k0.y, k0.z, k0.w, k1.x, k1.y, k1.z, k1.w};
            const float qq[8] = {q0.x, q0.y, q0.z, q0.w, q1.x, q1.y, q1.z, q1.w};
            float ks = 0.f;
#pragma unroll
            for (int d = 0; d < 8; ++d) { S[d] *= dec; ks += kk[d] * S[d]; }
            ks += __shfl_xor(ks, 8); ks += __shfl_xor(ks, 16); ks += __shfl_xor(ks, 32);
            const float delta = (v - ks) * be;
            float ov = 0.f;
#pragma unroll
            for (int d = 0; d < 8; ++d) { S[d] += kk[d] * delta; ov += qq[d] * S[d]; }
            ov += __shfl_xor(ov, 8); ov += __shfl_xor(ov, 16); ov += __shfl_xor(ov, 32);
            if (ko == 0) a.goraw()[(rbase + t0 + j) * 512 + h * 64 + col] = ov;
        }
    }
#pragma unroll
    for (int d = 0; d < 8; ++d) sout[(((size_t)b * 8 + h) * 64 + ko * 8 + d) * 64 + col] = S[d];
}
__device__ __forceinline__ bf16x8 ld8_f32_bf16(const float* p) {
    const float4 x = *(const float4*)p, y = *(const float4*)(p + 4);
    u32x4 w; w.x = cvtpk(x.x, x.y); w.y = cvtpk(x.z, x.w); w.z = cvtpk(y.x, y.y); w.w = cvtpk(y.z, y.w);
    return __builtin_bit_cast(bf16x8, w);
}
__device__ __forceinline__ int pi_pos(int k) { return (k & 32) + 8 * ((k >> 2) & 3) + 4 * ((k >> 4) & 1) + (k & 3); }
#define GDN_WLDS 17408
__device__ __forceinline__ void gdn_prep_unit(const MK& a, int u, int lane_in, char* wsm) {
    int lane = lane_in; asm volatile("" : "+v"(lane));
    const int bh = u >> 5, n = u & 31, b = bh >> 3, h = bh & 7, i16 = lane & 15, q4 = lane >> 4;
    const size_t row0 = (size_t)b * SEQ + n * 64;
    float* AT = (float*)wsm; float* GC = (float*)(wsm + 16384); float* BT = GC + 64;
    const bf16_t* qbase = a.qkv() + row0 * 1536 + h * 64; const bf16_t* kbase = qbase + 512; const bf16_t* vbase = qbase + 1024;
    float g = a.gg()[(row0 + lane) * 8 + h];
    const float be_l = a.bb()[(row0 + lane) * 8 + h];
#pragma unroll
    for (int o = 1; o < 64; o <<= 1) { const float t = __shfl_up(g, o); if (lane >= o) g += t; }
    WSYNC();
    GC[lane] = g; BT[lane] = be_l;
    WSYNC();
    const float gl = GC[63];
    float* EG = BT + 64; float* ED = EG + 64;
    EG[lane] = expf(g); ED[lane] = expf(gl - g);
    WSYNC();
    bf16x8 kf[4][2], qf[4][2];
#pragma unroll
    for (int mt = 0; mt < 4; ++mt)
#pragma unroll
        for (int ks = 0; ks < 2; ++ks) {
            const int off = (16 * mt + i16) * 1536 + 32 * ks + 8 * q4;
            kf[mt][ks] = *(const bf16x8*)(kbase + off); qf[mt][ks] = *(const bf16x8*)(qbase + off);
        }
    bf16_t* QKg = a.gQK() + (size_t)u * 4096;
#pragma unroll
    for (int mt = 0; mt < 4; ++mt)
#pragma unroll
        for (int nt = 0; nt < 4; ++nt) {
            const int j = 16 * nt + i16, pj = 32 * (nt >> 1) + 8 * (i16 >> 2) + 4 * (nt & 1) + (i16 & 3);
            if (nt <= mt) {
                f32x4 d1 = {0.f, 0.f, 0.f, 0.f}, d2 = {0.f, 0.f, 0.f, 0.f};
#pragma unroll
                for (int ks = 0; ks < 2; ++ks) {
                    d1 = __builtin_amdgcn_mfma_f32_16x16x32_bf16(kf[mt][ks], kf[nt][ks], d1, 0, 0, 0);
                    d2 = __builtin_amdgcn_mfma_f32_16x16x32_bf16(qf[mt][ks], kf[nt][ks], d2, 0, 0, 0);
                }
                const float gcj = GC[j];
#pragma unroll
                for (int r = 0; r < 4; ++r) {
                    const int i = 16 * mt + 4 * q4 + r;
                    const float dec = __builtin_amdgcn_exp2f(1.44269504f * (GC[i] - gcj));
                    AT[i * 64 + j] = (i > j) ? BT[i] * d1[r] * dec : 0.f;
                    QKg[i * 64 + (((pj >> 3) ^ (i & 7)) << 3) + (pj & 7)] = f2bf((i >= j) ? d2[r] * dec : 0.f);
                }
            } else {
#pragma unroll
                for (int r = 0; r < 4; ++r) { const int i = 16 * mt + 4 * q4 + r; QKg[i * 64 + (((pj >> 3) ^ (i & 7)) << 3) + (pj & 7)] = 0; }
            }
        }
    {
        bf16_t* Qgg = a.gQg() + (size_t)u * 4096;
#pragma unroll
        for (int mt = 0; mt < 4; ++mt) {
            const int i = 16 * mt + i16; const float e = EG[i];
#pragma unroll
            for (int ks = 0; ks < 2; ++ks) {
                float x[8]; bf8_to_f32(qf[mt][ks], x);
                uint2 w0, w1; w0.x = cvtpk(x[0] * e, x[1] * e); w0.y = cvtpk(x[2] * e, x[3] * e); w1.x = cvtpk(x[4] * e, x[5] * e); w1.y = cvtpk(x[6] * e, x[7] * e);
                const int p0 = 32 * ks + 16 * (q4 & 1) + 4 * (q4 >> 1);
                *(uint2*)(Qgg + i * 64 + (((p0 >> 3) ^ (i & 7)) << 3) + (p0 & 7)) = w0; *(uint2*)(Qgg + i * 64 + ((((p0 >> 3) + 1) ^ (i & 7)) << 3) + (p0 & 7)) = w1;
            }
        }
    }
    WSYNC();
    __builtin_amdgcn_sched_barrier(0);
    {
        float U[64];
#pragma unroll
        for (int i = 0; i < 64; ++i) { U[i] = bf2f(vbase[i * 1536 + lane]) * BT[i]; }
#pragma unroll
        for (int i = 1; i < 64; ++i) {
            float su = 0.f;
#pragma unroll
            for (int j4 = 0; j4 < i; j4 += 4) {
                const float4 av = *(const float4*)(AT + i * 64 + j4);
                su += av.x * U[j4];
                if (j4 + 1 < i) su += av.y * U[j4 + 1];
                if (j4 + 2 < i) su += av.z * U[j4 + 2];
                if (j4 + 3 < i) su += av.w * U[j4 + 3];
            }
            U[i] -= su;
            __builtin_amdgcn_sched_barrier(0);
        }
        float* UTg = a.gUT() + ((size_t)u * 64 + lane) * 64;
#pragma unroll
        for (int i = 0; i < 64; i += 4) *(float4*)(UTg + 4 * ((i >> 2) ^ (lane & 15))) = (float4){U[i], U[i + 1], U[i + 2], U[i + 3]};
    }
    asm volatile("" ::: "memory");
    __builtin_amdgcn_sched_barrier(0);
    {
        float W[64];
#pragma unroll
        for (int i = 0; i < 64; ++i) { W[i] = bf2f(kbase[i * 1536 + lane]); }
        bf16_t* Kdg = a.gKd() + ((size_t)u * 64 + lane) * 64;
#pragma unroll
        for (int pc = 0; pc < 8; ++pc) {
            float t[8];
#pragma unroll
            for (int jj = 0; jj < 8; ++jj) { const int j = 32 * (pc >> 2) + 16 * (jj >> 2) + 4 * (pc & 3) + (jj & 3); t[jj] = W[j] * ED[j]; }
            u32x4 w; w.x = cvtpk(t[0], t[1]); w.y = cvtpk(t[2], t[3]); w.z = cvtpk(t[4], t[5]); w.w = cvtpk(t[6], t[7]);
            *(u32x4*)(Kdg + 8 * (pc ^ (lane & 7))) = w;
        }
#pragma unroll
        for (int i = 0; i < 64; ++i) W[i] *= BT[i] * EG[i];
#pragma unroll
        for (int i = 1; i < 64; ++i) {
            float sw = 0.f;
#pragma unroll
            for (int j4 = 0; j4 < i; j4 += 4) {
                const float4 av = *(const float4*)(AT + i * 64 + j4);
                sw += av.x * W[j4];
                if (j4 + 1 < i) sw += av.y * W[j4 + 1];
                if (j4 + 2 < i) sw += av.z * W[j4 + 2];
                if (j4 + 3 < i) sw += av.w * W[j4 + 3];
            }
            W[i] -= sw;
            __builtin_amdgcn_sched_barrier(0);
        }
        bf16_t* Wng = a.gWn() + (size_t)u * 4096; const int pp = pi_pos(lane);
#pragma unroll
        for (int i = 0; i < 64; ++i) Wng[i * 64 + (((pp >> 3) ^ (i & 7)) << 3) + (pp & 7)] = f2bf(-W[i]);
    }
    if (lane == 0) a.ggam()[u] = expf(gl);
}
__device__ __forceinline__ bf16x8 pack_acc2(const f32x4& x, const f32x4& y) {
    u32x4 w; w.x = cvtpk(x[0], x[1]); w.y = cvtpk(x[2], x[3]); w.z = cvtpk(y[0], y[1]); w.w = cvtpk(y[2], y[3]);
    return __builtin_bit_cast(bf16x8, w);
}
#define G2_SLOT 49152
__device__ __forceinline__ void g2_issue(const MK& a, size_t u, int n, LAS unsigned char* lds, int lw, int lane) {
    LAS unsigned char* dst = lds + (n % 3) * G2_SLOT;
    const char* srcs[4] = {(const char*)(a.gWn() + u * 4096), (const char*)(a.gQg() + u * 4096), (const char*)(a.gQK() + u * 4096), (const char*)(a.gKd() + u * 4096)};
#pragma unroll
    for (int m = 0; m < 4; ++m)
#pragma unroll
        for (int i = 0; i < 2; ++i) { const int piece = 2 * lw + i;
            __builtin_amdgcn_global_load_lds((const unsigned*)(srcs[m] + piece * 1024 + lane * 16), (LAS unsigned*)(dst + m * 8192 + piece * 1024), 16, 0, 0); }
    const char* us = (const char*)(a.gUT() + u * 4096);
#pragma unroll
    for (int i = 0; i < 4; ++i) { const int piece = 4 * lw + i;
        __builtin_amdgcn_global_load_lds((const unsigned*)(us + piece * 1024 + lane * 16), (LAS unsigned*)(dst + 32768 + piece * 1024), 16, 0, 0); }
}
__device__ __forceinline__ void gdn_scan_block(const MK& a, int bh, LAS unsigned char* lds) {
    const int tid = otid(), lane = tid & 63, wid = __builtin_amdgcn_readfirstlane(tid >> 6), i16 = lane & 15, q4 = lane >> 4;
    const int b = bh >> 3, h = bh & 7, sl = wid & 3;
    const bool loader = wid >= 4;
    f32x4 S[4];
#pragma unroll
    for (int mt = 0; mt < 4; ++mt) S[mt] = (f32x4){0.f, 0.f, 0.f, 0.f};
    __syncthreads();
    if (loader) { g2_issue(a, (size_t)bh * 32, 0, lds, wid - 4, lane); g2_issue(a, (size_t)bh * 32 + 1, 1, lds, wid - 4, lane); }
    for (int n = 0; n < 32; ++n) {
        if (loader) { if (n < 31) asm volatile("s_waitcnt vmcnt(12)" ::: "memory"); else asm volatile("s_waitcnt vmcnt(0)" ::: "memory"); }
        asm volatile("s_waitcnt lgkmcnt(0)" ::: "memory"); __builtin_amdgcn_s_barrier(); asm volatile("" ::: "memory");
        if (loader) { if (n + 2 < 32) g2_issue(a, (size_t)bh * 32 + n + 2, n + 2, lds, wid - 4, lane); }
        else {
            const LAS unsigned char* sb = lds + (n % 3) * G2_SLOT;
            const float gam = a.ggam()[(size_t)bh * 32 + n];
            bf16x8 Sb[2]; Sb[0] = pack_acc2(S[0], S[1]); Sb[1] = pack_acc2(S[2], S[3]);
            f32x4 Vn[4];
#pragma unroll
            for (int mt = 0; mt < 4; ++mt) Vn[mt] = *(const LAS f32x4*)(sb + 32768 + (16 * sl + i16) * 256 + 16 * ((4 * mt + q4) ^ i16));
#pragma unroll
            for (int mt = 0; mt < 4; ++mt)
#pragma unroll
                for (int ks = 0; ks < 2; ++ks) Vn[mt] = __builtin_amdgcn_mfma_f32_16x16x32_bf16(*(const LAS bf16x8*)(sb + (16 * mt + i16) * 128 + 16 * ((4 * ks + q4) ^ (i16 & 7))), Sb[ks], Vn[mt], 0, 0, 0);
            bf16x8 Vb[2]; Vb[0] = pack_acc2(Vn[0], Vn[1]); Vb[1] = pack_acc2(Vn[2], Vn[3]);
            f32x4 O[4];
#pragma unroll
            for (int mt = 0; mt < 4; ++mt) {
                O[mt] = (f32x4){0.f, 0.f, 0.f, 0.f};
#pragma unroll
                for (int ks = 0; ks < 2; ++ks) {
                    const int fo = (16 * mt + i16) * 128 + 16 * ((4 * ks + q4) ^ (i16 & 7));
                    O[mt] = __builtin_amdgcn_mfma_f32_16x16x32_bf16(*(const LAS bf16x8*)(sb + 8192 + fo), Sb[ks], O[mt], 0, 0, 0);
                    O[mt] = __builtin_amdgcn_mfma_f32_16x16x32_bf16(*(const LAS bf16x8*)(sb + 16384 + fo), Vb[ks], O[mt], 0, 0, 0);
                }
            }
#pragma unroll
            for (int mt = 0; mt < 4; ++mt) {
                S[mt] = S[mt] * gam;
#pragma unroll
                for (int ks = 0; ks < 2; ++ks) S[mt] = __builtin_amdgcn_mfma_f32_16x16x32_bf16(*(const LAS bf16x8*)(sb + 24576 + (16 * mt + i16) * 128 + 16 * ((4 * ks + q4) ^ (i16 & 7))), Vb[ks], S[mt], 0, 0, 0);
            }
            float* og = a.goraw() + ((size_t)b * SEQ + n * 64 + 4 * q4) * 512 + h * 64 + 16 * sl + i16;
#pragma unroll
            for (int mt = 0; mt < 4; ++mt)
#pragma unroll
                for (int r = 0; r < 4; ++r) og[(size_t)(16 * mt + r) * 512] = O[mt][r];
        }
    }
    if (!loader) {
        float* so = a.out + O_GSP + ((size_t)bh * 64 + 4 * q4) * 64 + 16 * sl + i16;
#pragma unroll
        for (int mt = 0; mt < 4; ++mt)
#pragma unroll
            for (int r = 0; r < 4; ++r) so[(size_t)(16 * mt + r) * 64] = S[mt][r];
    }
    __syncthreads();
}
__device__ __forceinline__ void gdn_out_token(const MK& a, int row, int lane) {
    const float* op = a.goraw() + (size_t)row * 512 + 8 * lane;
    const float4 x0 = *(const float4*)op, x1 = *(const float4*)(op + 4);
    float o[8] = {x0.x, x0.y, x0.z, x0.w, x1.x, x1.y, x1.z, x1.w}, zg[8];
    bf8_to_f32(*(const bf16x8*)(a.Z() + (size_t)row * ZW + OFF_Z + 8 * lane), zg);
    float ss = 0.f;
#pragma unroll
    for (int e = 0; e < 8; ++e) ss += o[e] * o[e];
    ss += __shfl_xor(ss, 1); ss += __shfl_xor(ss, 2); ss += __shfl_xor(ss, 4);
    const float rs = rsqrtf(ss * (1.f / 64.f) + EPSV);
    const float4 g0 = *(const float4*)(a.g_gdn_out + 8 * (lane & 7)), g1 = *(const float4*)(a.g_gdn_out + 8 * (lane & 7) + 4);
    const float gg_[8] = {g0.x, g0.y, g0.z, g0.w, g1.x, g1.y, g1.z, g1.w};
#pragma unroll
    for (int e = 0; e < 8; ++e) o[e] = o[e] * rs * gg_[e] * zg[e] * fast_sigmoid(zg[e]);
    *(bf16x8*)(a.omix() + (size_t)row * 1024 + 8 * lane) = f32_to_bf8(o);
}

#define SROW 1040
#define SSLOT (32 * SROW)
#define KR_OFF (4 * SSLOT)
#define WQ_OFF (KR_OFF + 4 * 4096)
#define QR_OFF (WQ_OFF + 2048)
#define PG_OFF (QR_OFF + 1024)
#define PT_OFF (PG_OFF + 64)
#define AL_OFF (PT_OFF + 1024)
#define SAMP_LDS_END (AL_OFF + 64)
__device__ __forceinline__ void samp_issue(const MK& a, int g, LAS unsigned char* lds, const int* PG, int wid, int lane) {
    const int phys = __builtin_amdgcn_readfirstlane(((const LAS int*)(lds + PG_OFF))[g >> 2]);
    const int tok0 = (g & 3) * 32 + 4 * wid, slot = g & 3;
    const float* cs = a.cache_ckv + ((size_t)phys * 128 + tok0) * 256 + lane * 4;
#pragma unroll
    for (int i = 0; i < 4; ++i) __builtin_amdgcn_global_load_lds((const unsigned*)(cs + i * 256), (LAS unsigned*)(lds + slot * SSLOT + (4 * wid + i) * SROW), 16, 0, 0);
    const float* ks = a.cache_krope + ((size_t)phys * 128 + tok0 + (lane >> 5)) * 32 + (lane & 31);
#pragma unroll
    for (int i = 0; i < 2; ++i) __builtin_amdgcn_global_load_lds((const unsigned*)(ks + i * 64), (LAS unsigned*)(lds + KR_OFF + slot * 4096 + (4 * wid + 2 * i) * 128), 4, 0, 0);
}
__device__ __forceinline__ void samp_attn_unit(const MK& a, int u, char* smem, LAS unsigned char* lds) {
    const int tid = otid(), lane = tid & 63, h = __builtin_amdgcn_readfirstlane(tid >> 6), i16 = lane & 15, q4 = lane >> 4;
    const int b = u >> 3, sp = u & 7;
    float* WQ = (float*)(smem + WQ_OFF);
    float* QR = (float*)(smem + QR_OFF);
    int* PG = (int*)(smem + PG_OFF);
    const float SCL = 0.14724445f;
    post_q_item(a, (NPT + b) * 8 + h, lane);
    __syncthreads();
    {
        const int h_ = tid >> 6, l_ = tid & 63, q4_ = l_ >> 4, idx = l_ & 15, d = 16 * (idx >> 2) + 4 * q4_ + (idx & 3);
        WQ[tid] = a.g_k_nope[d] * a.qh()[((size_t)(NPT + b) * 8 + h_) * 96 + d] * SCL;
        if (tid < 256) QR[tid] = a.qh()[((size_t)(NPT + b) * 8 + (tid >> 5)) * 96 + 64 + (tid & 31)] * SCL;
        if (tid < 16) PG[tid] = a.page_table[b * NPAGES + sp * 16 + tid];
    }
    bf16x8 wf[4][8];
#pragma unroll
    for (int mt = 0; mt < 4; ++mt)
#pragma unroll
        for (int ks = 0; ks < 8; ++ks) wf[mt][ks] = *(const bf16x8*)(a.WknT() + (size_t)(h * 64 + 16 * mt + i16) * 256 + 32 * ks + 8 * q4);
#pragma unroll
    for (int mt = 0; mt < 4; ++mt)
#pragma unroll
        for (int ks = 0; ks < 8; ++ks) asm volatile("" : "+v"(wf[mt][ks]));
    __syncthreads();
    samp_issue(a, 0, lds, PG, h, lane); samp_issue(a, 1, lds, PG, h, lane); samp_issue(a, 2, lds, PG, h, lane);
    const LAS float* QRl = (const LAS float*)(lds + QR_OFF) + h * 32 + 8 * q4;
    const LAS float* WQl = (const LAS float*)(lds + WQ_OFF) + (h * 4 + q4) * 16;
    float m = -INFINITY, lsum = 0.f;
    f32x4 latv[2]; latv[0] = (f32x4){0.f, 0.f, 0.f, 0.f}; latv[1] = (f32x4){0.f, 0.f, 0.f, 0.f};
    for (int g = 0; g < 64; ++g) {
        if (g <= 61) asm volatile("s_waitcnt vmcnt(12)" ::: "memory"); else if (g == 62) asm volatile("s_waitcnt vmcnt(6)" ::: "memory"); else asm volatile("s_waitcnt vmcnt(0)" ::: "memory");
        asm volatile("s_waitcnt lgkmcnt(0)" ::: "memory"); __builtin_amdgcn_s_barrier(); asm volatile("" ::: "memory");
        if (g + 3 < 64) samp_issue(a, g + 3, lds, PG, h, lane);
        const LAS float* Cs = (const LAS float*)(lds + (g & 3) * SSLOT); const LAS float* KR = (const LAS float*)(lds + KR_OFF + (g & 3) * 4096);
        float sc[2];
#pragma unroll
        for (int hf = 0; hf < 2; ++hf) {
            f32x4 acc[4];
#pragma unroll
            for (int mt = 0; mt < 4; ++mt) acc[mt] = (f32x4){0.f, 0.f, 0.f, 0.f};
            const LAS float* cp = Cs + (16 * hf + i16) * (SROW / 4) + 8 * q4;
#pragma unroll
            for (int ks = 0; ks < 8; ++ks) {
                const f32x4 f0 = *(const LAS f32x4*)(cp + 32 * ks), f1 = *(const LAS f32x4*)(cp + 32 * ks + 4);
                u32x4 w; w.x = cvtpk(f0[0], f0[1]); w.y = cvtpk(f0[2], f0[3]); w.z = cvtpk(f1[0], f1[1]); w.w = cvtpk(f1[2], f1[3]);
                const bf16x8 cf = __builtin_bit_cast(bf16x8, w);
#pragma unroll
                for (int mt = 0; mt < 4; ++mt) acc[mt] = __builtin_amdgcn_mfma_f32_16x16x32_bf16(wf[mt][ks], cf, acc[mt], 0, 0, 0);
            }
            float ss = 0.f, dot = 0.f, rd = 0.f;
#pragma unroll
            for (int mt = 0; mt < 4; ++mt) {
                const f32x4 wq = *(const LAS f32x4*)(WQl + 4 * mt);
                ss += acc[mt][0] * acc[mt][0] + acc[mt][1] * acc[mt][1] + acc[mt][2] * acc[mt][2] + acc[mt][3] * acc[mt][3];
                dot += acc[mt][0] * wq[0] + acc[mt][1] * wq[1] + acc[mt][2] * wq[2] + acc[mt][3] * wq[3];
            }
            {
                const LAS float* kp = KR + (16 * hf + i16) * 32 + 8 * q4;
                const f32x4 k0 = *(const LAS f32x4*)kp, k1 = *(const LAS f32x4*)(kp + 4), q0 = *(const LAS f32x4*)QRl, q1 = *(const LAS f32x4*)(QRl + 4);
                rd = k0[0] * q0[0] + k0[1] * q0[1] + k0[2] * q0[2] + k0[3] * q0[3] + k1[0] * q1[0] + k1[1] * q1[1] + k1[2] * q1[2] + k1[3] * q1[3];
            }
            ss += __shfl_xor(ss, 16); dot += __shfl_xor(dot, 16); rd += __shfl_xor(rd, 16);
            ss += __shfl_xor(ss, 32); dot += __shfl_xor(dot, 32); rd += __shfl_xor(rd, 32);
            sc[hf] = dot * rsqrtf(ss * (1.f / 64.f) + EPSV) + rd;
        }
        float gm = fmaxf(sc[0], sc[1]);
#pragma unroll
        for (int o = 1; o < 16; o <<= 1) gm = fmaxf(gm, __shfl_xor(gm, o));
        const float mn = fmaxf(m, gm);
        const float alpha = __builtin_amdgcn_exp2f(m - mn), p0 = __builtin_amdgcn_exp2f(sc[0] - mn), p1 = __builtin_amdgcn_exp2f(sc[1] - mn);
        m = mn;
        lsum = lsum * alpha + p0 + p1;
        if (q4 == 0) { ((LAS float*)(lds + PT_OFF))[h * 32 + i16] = p0; ((LAS float*)(lds + PT_OFF))[h * 32 + 16 + i16] = p1; if (i16 == 0) ((LAS float*)(lds + AL_OFF))[h] = alpha; }
        asm volatile("s_waitcnt lgkmcnt(0)" ::: "memory"); __builtin_amdgcn_s_barrier(); asm volatile("" ::: "memory");
        {
            u32x4 pw = {0u, 0u, 0u, 0u};
            if (i16 < 8) { const f32x4 pa = *(const LAS f32x4*)(lds + PT_OFF + (i16 * 32 + 8 * q4) * 4), pb_ = *(const LAS f32x4*)(lds + PT_OFF + (i16 * 32 + 8 * q4 + 4) * 4);
                pw.x = cvtpk(pa[0], pa[1]); pw.y = cvtpk(pa[2], pa[3]); pw.z = cvtpk(pb_[0], pb_[1]); pw.w = cvtpk(pb_[2], pb_[3]); }
            const bf16x8 pfr = __builtin_bit_cast(bf16x8, pw);
            const f32x4 al = *(const LAS f32x4*)(lds + AL_OFF + (q4 & 1) * 16);
#pragma unroll
            for (int nt = 0; nt < 2; ++nt) {
                const LAS float* cc = Cs + (8 * q4) * (SROW / 4) + 32 * h + 16 * nt + i16;
                u32x4 cw; cw.x = cvtpk(cc[0], cc[SROW / 4]); cw.y = cvtpk(cc[2 * (SROW / 4)], cc[3 * (SROW / 4)]); cw.z = cvtpk(cc[4 * (SROW / 4)], cc[5 * (SROW / 4)]); cw.w = cvtpk(cc[6 * (SROW / 4)], cc[7 * (SROW / 4)]);
                latv[nt] = latv[nt] * al;
                latv[nt] = __builtin_amdgcn_mfma_f32_16x16x32_bf16(pfr, __builtin_bit_cast(bf16x8, cw), latv[nt], 0, 0, 0);
            }
        }
    }
#pragma unroll
    for (int o = 1; o < 16; o <<= 1) lsum += __shfl_xor(lsum, o);
    if (lane == 0) { float* o = a.part() + ((size_t)u * 8 + h) * 260; o[0] = m * 0.69314718f; o[1] = lsum; }
    if (q4 < 2) {
#pragma unroll
        for (int nt = 0; nt < 2; ++nt)
#pragma unroll
            for (int r = 0; r < 4; ++r) a.part()[((size_t)u * 8 + 4 * q4 + r) * 260 + 4 + 32 * h + 16 * nt + i16] = latv[nt][r];
    }
}
__device__ __forceinline__ void samp_comb_unit(const MK& a, int u, char* smem) {
    float* slat = (float*)smem;
    const int b = u >> 3, h = u & 7, tid = otid() & 255;
    const size_t row = NPT + b;
    const float* q = a.qh() + (row * 8 + h) * 96;
    float s_self = 0.f;
    for (int d = 0; d < 64; ++d) s_self += q[d] * a.kh()[(row * 8 + h) * 64 + d];
    for (int d = 0; d < 32; ++d) s_self += q[64 + d] * a.krf()[row * 32 + d];
    s_self *= 0.10206207261596577f;
    float m = s_self;
    for (int s = 0; s < 8; ++s) m = fmaxf(m, a.part()[((size_t)(b * 8 + s) * 8 + h) * 260]);
    const float pself = expf(s_self - m);
    float l = pself, lat = 0.f;
    for (int s = 0; s < 8; ++s) {
        const float* p = a.part() + ((size_t)(b * 8 + s) * 8 + h) * 260;
        const float w = expf(p[0] - m);
        l += p[1] * w; lat += p[4 + tid] * w;
    }
    __syncthreads();
    slat[tid] = lat;
    __syncthreads();
    if (tid < 64) {
        float o = 0.f;
        for (int c = 0; c < 256; ++c) o += slat[c] * a.w_kv_b[(size_t)c * 1024 + h * 128 + 64 + tid];
        o += pself * a.KV()[row * 1024 + h * 128 + 64 + tid];
        a.omix()[row * 1024 + 512 + h * 64 + tid] = f2bf(o / l);
    }
}

#define XB_TMO      128
#define XB_XCNT(j)  (256  + 64 * (j))
#define XB_XSUB(j)  (1280 + 64 * (j))
#define XB_XGEN(j)  (2304 + 64 * (j))
#define XB_TOP      3328
#define XB_TOPGEN   3392
#define XCD_BAR_WORDS 3456
#define XB_SPIN_CAP (1u << 18)

__device__ __forceinline__ unsigned xb_ld(unsigned* p)              { return __hip_atomic_load(p, __ATOMIC_RELAXED, __HIP_MEMORY_SCOPE_AGENT); }
__device__ __forceinline__ unsigned xb_add(unsigned* p, unsigned v) { return __hip_atomic_fetch_add(p, v, __ATOMIC_RELAXED, __HIP_MEMORY_SCOPE_AGENT); }
__device__ __forceinline__ unsigned xb_xcc_id() { return (unsigned)__builtin_amdgcn_s_getreg((3 << 11) | 20) & 0xFu; }
#define XB_SPIN(cond, bar) do { unsigned _sp = 0; while (cond) { __builtin_amdgcn_s_sleep(1); \
    if ((++_sp & 255u) == 0u) { if (xb_ld(&(bar)[XB_TMO])) break; if (_sp > XB_SPIN_CAP) { atomicAdd(&(bar)[XB_TMO], 1u); break; } } } } while (0)

struct XcdBarrier {
    unsigned* bar; unsigned x;
    volatile LAS unsigned* st;
};

__device__ __forceinline__ XcdBarrier xcd_barrier_post(unsigned* bar, volatile LAS unsigned* st) {
    XcdBarrier b; b.bar = bar; b.x = xb_xcc_id(); b.st = st;
    if (threadIdx.x == 0) (void)xb_add(&bar[XB_XCNT(b.x)], 1u);
    return b;
}
__device__ __forceinline__ void xcd_barrier_complete(unsigned* bar, unsigned x, unsigned& nloc, unsigned& nx) {
    const unsigned G = gridDim.x * gridDim.y * gridDim.z;
    unsigned sum, cnt, mine, sp = 0u;
    for (;;) {
        sum = 0u; cnt = 0u; mine = 0u;
#pragma unroll
        for (unsigned j = 0; j < 16; ++j) { const unsigned c = xb_ld(&bar[XB_XCNT(j)]); sum += c; cnt += (c > 0u) ? 1u : 0u; mine = (j == x) ? c : mine; }
        if (sum == G) break;
        __builtin_amdgcn_s_sleep(1);
        if ((++sp & 255u) == 0u) { if (xb_ld(&bar[XB_TMO])) break; if (sp > XB_SPIN_CAP) { atomicAdd(&bar[XB_TMO], 1u); break; } }
    }
    nloc = mine > 0u ? mine : 1u; nx = cnt > 0u ? cnt : 1u;
}

__device__ __forceinline__ void xcd_barrier(const XcdBarrier& b) {
    asm volatile("s_waitcnt vmcnt(0)" ::: "memory");
    __syncthreads();
    if (threadIdx.x == 0) {
        unsigned* bar = b.bar;
        __builtin_amdgcn_s_waitcnt(0);
        unsigned nloc = b.st[0], nx = b.st[1];
        if (nloc == 0u) { xcd_barrier_complete(bar, b.x, nloc, nx); b.st[0] = nloc; b.st[1] = nx; }
        const unsigned old = xb_add(&bar[XB_XSUB(b.x)], 1u);
        const unsigned gen = old / nloc;
        if (old + 1u == (gen + 1u) * nloc) {
            __builtin_amdgcn_fence(__ATOMIC_RELEASE, "agent");
            asm volatile("s_waitcnt vmcnt(0)" ::: "memory");
            const unsigned og = xb_add(&bar[XB_TOP], 1u);
            const unsigned tg = og / nx;
            if (og + 1u == (tg + 1u) * nx) xb_add(&bar[XB_TOPGEN], 1u);
            else XB_SPIN(xb_ld(&bar[XB_TOPGEN]) == tg, bar);
            __builtin_amdgcn_fence(__ATOMIC_ACQUIRE, "agent");
            xb_add(&bar[XB_XGEN(b.x)], 1u);
            asm volatile("s_waitcnt vmcnt(0)" ::: "memory");
        } else {
            XB_SPIN(xb_ld(&bar[XB_XGEN(b.x)]) == gen, bar);
            __builtin_amdgcn_fence(__ATOMIC_ACQUIRE, "agent");
            asm volatile("s_waitcnt vmcnt(0)" ::: "memory");
        }
    }
    __syncthreads();
}

#define XB_ST_OFF 155648
#define LDS_BYTES 155904
static_assert(SAMP_LDS_END <= LDS_BYTES, "LDS map");
#define GSYNC() do { xcd_barrier(xbar); } while (0)
__global__ __launch_bounds__(NTHR, 2) void mega(MK a) {
    cg::grid_group grid = cg::this_grid();
    char* smem = (char*)lds_raw;
    LAS unsigned char* lds = (LAS unsigned char*)lds_raw;
    otid_init();
    if (threadIdx.x < 2) ((LAS unsigned*)(lds_raw + XB_ST_OFF))[threadIdx.x] = 0u;
    __syncthreads();
    const XcdBarrier xbar = xcd_barrier_post(a.ctl(), (volatile LAS unsigned*)(LAS void*)(lds_raw + XB_ST_OFF));
    const int bid = blockIdx.x, nb = gridDim.x, ngw = nb * NWAVE;
#define LOCAL_IDS const int tid = otid(), lane = tid & 63, wid = tid >> 6, half = tid >> 8, gw = bid * NWAVE + wid; (void)lane; (void)half; (void)gw; (void)wid;

    {
    LOCAL_IDS
    {
        const int T0 = 88 * 16, T1 = 24 * 6, T2 = 32 * 4, T3 = 16 * 4, T4 = 32 * 16, T5 = 176 * 16, T7 = 32 * 44, T8 = 32 * 16, T9 = 32 * 4;
        const int TT = T0 + T1 + T2 + T3 + T4 + T5 + T7 + T8 + T9;
        float* scr = (float*)(smem + wid * 8704);
        for (int it = gw; it < TT; it += ngw) {
            int r = it;
            if (r < T0) { const int nt_ = r % 88, kb = r / 88, nv = 2736 - 32 * nt_; wt_item(a.w_in, 2736, 32 * nt_, nv < 0 ? 0 : (nv > 32 ? 32 : nv), a.WinT(), 1024, 32 * nt_, 64 * kb, scr, lane); continue; } r -= T0;
            if (r < T1) { const int nt_ = r % 24, kb = r / 24; wt_item(a.w_q_b, 768, 32 * nt_, 32, a.WqbT(), 384, 32 * nt_, 64 * kb, scr, lane); continue; } r -= T1;
            if (r < T2) { const int nt_ = r % 32, kb = r / 32; wt_item(a.w_kv_b, 1024, 32 * nt_, 32, a.WkvT(), 256, 32 * nt_, 64 * kb, scr, lane); continue; } r -= T2;
            if (r < T3) { const int nt_ = r % 16, kb = r / 16, h = nt_ >> 1; wt_item(a.w_kv_b, 1024, h * 128 + 32 * (nt_ & 1), 32, a.WknT(), 256, 32 * nt_, 64 * kb, scr, lane); continue; } r -= T3;
            if (r < T4) { const int nt_ = r % 32, kb = r / 32; wt_item(a.w_o, 1024, 32 * nt_, 32, a.WoT(), 1024, 32 * nt_, 64 * kb, scr, lane); continue; } r -= T4;
            if (r < T5) { const int nt_ = r % 176, kb = r / 176, pn = nt_ >> 3, wi = nt_ & 7;
                wt_item(wi < 4 ? a.w_gate : a.w_up, DFF, pn * 128 + (wi & 3) * 32, 32, a.WguT(), 1024, 32 * nt_, 64 * kb, scr, lane); continue; } r -= T5;
            if (r < T7) { const int nt_ = r % 32, kb = r / 32; wt_item(a.w_down, 1024, 32 * nt_, 32, a.WdT(), DFF, 32 * nt_, 64 * kb, scr, lane); continue; } r -= T7;
            if (r < T8) { const int nt_ = r % 32, kb = r / 32; wt_item(a.w_ple_gate, 1024, 32 * nt_, 32, a.WpgT(), 1024, 32 * nt_, 64 * kb, scr, lane); continue; } r -= T8;
            { const int nt_ = r % 32, kb = r / 32; wt_item(a.w_ple_proj, 1024, 32 * nt_, 32, a.WppT(), 256, 32 * nt_, 64 * kb, scr, lane); }
        }
        for (int e = (bid * NTHR + tid); e < 2049 * 16; e += nb * NTHR) {
            const int pos = e >> 4, i = e & 15; const float ang = (pos == 2048 ? (float)PAST : (float)pos) * powf(10000.f, -(float)i / 16.f);
            a.ropecs()[pos * 32 + i] = cosf(ang); a.ropecs()[pos * 32 + 16 + i] = sinf(ang);
        }
        for (int row = gw; row < MPAD; row += ngw) {
            const float* src = row < NPT ? a.x_prompt + (size_t)row * 1024 : a.x_sample + (size_t)(row < NTOK ? row - NPT : 0) * 1024;
            rms1024_row(src, a.g_attn, a.xn() + (size_t)row * 1024, row >= NTOK, lane);
            ushort4 w = {0, 0, 0, 0};
            if (row < NTOK) { const float* ps = row < NPT ? a.p_prompt + (size_t)row * 256 : a.p_sample + (size_t)(row - NPT) * 256; const float4 v = *(const float4*)(ps + lane * 4); w.x = f2bf(v.x); w.y = f2bf(v.y); w.z = f2bf(v.z); w.w = f2bf(v.w); }
            *(ushort4*)(a.pb() + (size_t)row * 256 + lane * 4) = w;
            if (row >= NTOK) { for (int j = 0; j < 4; ++j) { ushort4 z = {0, 0, 0, 0}; *(ushort4*)(a.omix() + (size_t)row * 1024 + lane * 4 + 256 * j) = z; } }
        }
    }
    }
    grid.sync();
    {
    LOCAL_IDS
    pg_gemm(lds, a.xn(), a.WinT(), NPT, ZW, 1024, PgBf16{a.Z(), ZW});
    pg_gemm(lds, a.pb(), a.WppT(), NPT, 1024, 256, PgF32{a.PP(), 1024});
    gemm_sample_rows_ks<false>(a.xn(), 1024, a.WinT(), 1024, ZW, EwBf16{a.Z(), ZW}, smem, bid, nb);
    gemm_sample_rows<false>(a.pb(), 256, a.WppT(), 256, 1024, EwF32{a.PP(), 1024}, smem, bid, nb);
    }
    GSYNC();
    {
    LOCAL_IDS
    for (int e = tid; e < 4 * 1536 / 4; e += NTHR) ((float4*)smem)[e] = ((const float4*)a.w_conv)[e];
    __syncthreads();
    for (int run = gw; run < NPT / 8 + NST; run += ngw) post_in_run(a, run, lane, (const float*)smem);
    }
    GSYNC();
    {
    LOCAL_IDS
    for (int u = gw; u < 2048; u += ngw) gdn_prep_unit(a, u, lane, smem + wid * GDN_WLDS);
    }
    {
    LOCAL_IDS
    for (int v = gw; v < NST * 64; v += ngw) gdn_unit(a, v >> 6, (v >> 3) & 7, v & 7, a.state_gdn, a.out + O_GSS, NPT, 1, lane, smem + wid * GDN_WLDS);
    __syncthreads();
    }
    GSYNC();
    {
    LOCAL_IDS
    pg_gemm(lds, a.qan(), a.WqbT(), NPT, 768, 384, PgBf16{a.qraw(), 768});
    pg_gemm(lds, a.ckvb(), a.WkvT(), NPT, 1024, 256, PgBf16{a.kvraw(), 1024});
    gemm_sample_rows<false>(a.qan(), 384, a.WqbT(), 384, 768, EwF32{a.Q(), 768}, smem, bid, nb);
    gemm_sample_rows<false>(a.ckvb(), 256, a.WkvT(), 256, 1024, EwF32{a.KV(), 1024}, smem, bid, nb);
    for (int bh_ = nb - 1 - bid; bh_ < 64; bh_ += nb) gdn_scan_block(a, bh_, lds);
    }
    GSYNC();
    {
    LOCAL_IDS
    for (int idx = gw; idx < NST * 8; idx += ngw) { post_q_item(a, NPT * 8 + idx, lane); post_kv_item(a, NPT * 8 + idx, lane); }
    for (int row = gw; row < NTOK; row += ngw) gdn_out_token(a, row, lane);
    for (int pr = bid; pr < 256; pr += nb) { const int bh_ = pr >> 2, s_ = pr & 3; attn_block(a, bh_ >> 3, bh_ & 7, 7 - s_, smem); attn_block(a, bh_ >> 3, bh_ & 7, s_, smem); }
    for (int u = bid; u < NST * 8; u += nb) samp_attn_unit(a, u, smem, lds);
    }
    GSYNC();
    {
    LOCAL_IDS
    for (int u0 = bid * 2; u0 < NST * 8; u0 += nb * 2) samp_comb_unit(a, u0 + half, smem + half * 4096);
    }
    GSYNC();
    {
    LOCAL_IDS
    pg_gemm(lds, a.omix(), a.WoT(), NPT, 1024, 1024, PgRes{a.x_prompt, a.H()});
    gemm_sample_rows_ks<false>(a.omix(), 1024, a.WoT(), 1024, 1024, EwResX{a.x_sample, a.H()}, smem, bid, nb);
    }
    GSYNC();
    {
    LOCAL_IDS
    for (int row = gw; row < MPAD; row += ngw) rms1024_row(a.H() + (size_t)row * 1024, a.g_ffn, a.un() + (size_t)row * 1024, row >= NTOK, lane);
    }
    GSYNC();
    {
    LOCAL_IDS
    pg_gemm(lds, a.un(), a.WguT(), NPT, 2 * DFF, 1024, PgSwiglu{a.hid()});
    gemm_sample_rows_ks<true>(a.un(), 1024, a.WguT(), 1024, 2 * DFF, EwBf16{a.hid(), DFF}, smem, bid, nb);
    }
    GSYNC();
    {
    LOCAL_IDS
    pg_gemm(lds, a.hid(), a.WdT(), NPT, 1024, DFF, PgRes{a.H(), a.H2()});
    gemm_sample_rows_ks<false>(a.hid(), DFF, a.WdT(), DFF, 1024, EwResH{a.H(), a.H2()}, smem, bid, nb);
    }
    GSYNC();
    {
    LOCAL_IDS
    for (int row = gw; row < MPAD; row += ngw) rms1024_row(a.H2() + (size_t)row * 1024, a.g_ple, a.un2() + (size_t)row * 1024, row >= NTOK, lane);
    }
    GSYNC();
    {
    LOCAL_IDS
    pg_gemm(lds, a.un2(), a.WpgT(), NPT, 1024, 1024, PgPle{a.H2(), a.PP(), a.out});
    gemm_sample_rows_ks<false>(a.un2(), 1024, a.WpgT(), 1024, 1024, EwPle{a.H2(), a.PP(), a.out}, smem, bid, nb);
    }
}

static inline char* carve(char*& p, size_t bytes) { char* r = p; p += (bytes + 255) & ~(size_t)255; return r; }

extern "C" void kernel_launch(void* const* d_in, const int* in_sizes, int n_in, void* d_out, int out_size, void* d_ws, size_t ws_size, hipStream_t stream) {
    MK a{};
    a.x_prompt = (const float*)d_in[0]; a.x_sample = (const float*)d_in[1]; a.cache_ckv = (const float*)d_in[2]; a.cache_krope = (const float*)d_in[3];
    a.state_gdn = (const float*)d_in[4]; a.state_conv = (const float*)d_in[5]; a.page_table = (const int*)d_in[6]; a.p_prompt = (const float*)d_in[7]; a.p_sample = (const float*)d_in[8];
    a.g_attn = (const float*)d_in[9]; a.w_in = (const float*)d_in[10]; a.w_conv = (const float*)d_in[11]; a.a_log = (const float*)d_in[12]; a.dt_bias = (const float*)d_in[13];
    a.g_gdn_out = (const float*)d_in[14]; a.g_q_a = (const float*)d_in[15]; a.w_q_b = (const float*)d_in[16]; a.g_q_nope = (const float*)d_in[17]; a.g_q_rope = (const float*)d_in[18];
    a.g_kv_a = (const float*)d_in[19]; a.g_k_rope = (const float*)d_in[20]; a.w_kv_b = (const float*)d_in[21]; a.g_k_nope = (const float*)d_in[22]; a.w_o = (const float*)d_in[23];
    a.g_ffn = (const float*)d_in[24]; a.w_gate = (const float*)d_in[25]; a.w_up = (const float*)d_in[26]; a.w_down = (const float*)d_in[27]; a.g_ple = (const float*)d_in[28];
    a.w_ple_gate = (const float*)d_in[29]; a.w_ple_proj = (const float*)d_in[30];
    a.out = (float*)d_out;
    a.ws = (char*)d_ws;
    if (WS_TOTAL > ws_size) { fprintf(stderr, "kernel_launch: workspace too small: need %zu have %zu\n", (size_t)WS_TOTAL, ws_size); return; }

    static int grid_blocks = 0;
    if (!grid_blocks) {
        int dev = 0, cus = 0, per_cu = 0;
        (void)hipGetDevice(&dev);
        (void)hipDeviceGetAttribute(&cus, hipDeviceAttributeMultiprocessorCount, dev);
        (void)hipFuncSetAttribute((const void*)mega, hipFuncAttributeMaxDynamicSharedMemorySize, LDS_BYTES);
        (void)hipOccupancyMaxActiveBlocksPerMultiprocessor(&per_cu, (const void*)mega, NTHR, LDS_BYTES);
        if (per_cu < 1) fprintf(stderr, "kernel_launch: occupancy query says %d blocks/CU\n", per_cu);
        grid_blocks = cus;
    }
    (void)hipMemsetAsync((char*)d_ws + WOF_ctl, 0, 16384, stream);
    void* args[] = {&a};
    hipError_t e = hipLaunchCooperativeKernel((const void*)mega, dim3(grid_blocks), dim3(NTHR), args, LDS_BYTES, stream);
    if (e != hipSuccess) fprintf(stderr, "cooperative launch failed: %s (grid %d)\n", hipGetErrorString(e), grid_blocks);
}
```

```cpp
#include <hip/hip_runtime.h>
#include <stdint.h>
#include <cstdio>
#include <hip/hip_cooperative_groups.h>
namespace cg = cooperative_groups;


__device__ __forceinline__ int otid();
#define PG8_TID() otid()
namespace pg8 {
#define PG8_LAS __attribute__((address_space(3)))
typedef unsigned short bf16_t;
typedef short bf16x8 __attribute__((ext_vector_type(8)));
typedef float f32x4 __attribute__((ext_vector_type(4)));
typedef unsigned u32x4 __attribute__((ext_vector_type(4)));
constexpr int BM = 256, BK = 64, HALF = 128, HTB = HALF * BK * 2  , STAGE_BYTES = 8 * HTB, NXCD = 8, WGM = 8;

__host__ __device__ __forceinline__ int lds_byte(int r, int c) { const int st = (r >> 4) * 2 + (c >> 5), rr = r & 15, cc = c & 31, ob = rr * 64 + cc * 2; return st * 1024 + (ob ^ (((ob >> 9) & 1) << 5)); }
__host__ __device__ __forceinline__ void stage_rc(int b, int& R, int& C) { const int st = b / 1024, sb = b % 1024, swz = sb ^ (((sb >> 9) & 1) << 5); R = (st >> 1) * 16 + swz / 64; C = (st & 1) * 32 + (swz % 64) / 2; }
__host__ __device__ __forceinline__ int perm32(int rho) { const int n = rho >> 4, i = rho & 15; return 8 * (i >> 2) + 4 * n + (i & 3); }

struct Unit { int pm, pn; };
struct Gemm { const bf16_t* A; const bf16_t* Bt; int M, N, K; };

struct StaticOrder {
    int nM, nN, nwg, G, c;
    __host__ __device__ void init(int M, int N, int G_, int c_) { nM = M / BM; nN = N / BM; nwg = nM * nN; G = G_; c = c_; }
    __host__ __device__ bool next(int i, Unit& u) const {
        const long L = (long)i * G + c; if (L >= nwg) return false;
        int wgid = (int)L; { const int q = nwg / NXCD, r = nwg % NXCD, xcd = wgid % NXCD, off = wgid / NXCD; wgid = (xcd < r ? xcd * (q + 1) : r * (q + 1) + (xcd - r) * q) + off; }
        const int nig = WGM * nN, gid = wgid / nig, fm = gid * WGM, gsz = (nM - fm) < WGM ? (nM - fm) : WGM;
        u.pm = fm + ((wgid % nig) % gsz); u.pn = (wgid % nig) / gsz; return true;
    }
    __device__ __forceinline__ void a_ready(const Unit&) const {}
    __device__ __forceinline__ void done(const Unit&) const {}
};

template <class Epi, class Sched, bool ALIGN_EPI = false, bool SP2 = false>
__device__ __forceinline__ void gemm_phase(PG8_LAS unsigned char* lds, const Gemm g, const Sched& S, const Epi& E) {
    const int tid = PG8_TID(), wid = __builtin_amdgcn_readfirstlane(tid >> 6), lane = tid & 63, wr = wid >> 2, wc = wid & 3, fr = lane & 15, fq = lane >> 4;
    const int K = g.K, nt = K / BK;
    unsigned voffA[2], voffB[2];
#pragma unroll
    for (int i = 0; i < 2; ++i) { int R, C; stage_rc(tid * 16 + i * 8192, R, C); const int Rb = Epi::PERM ? ((R & ~31) + perm32(R & 31)) : R;
        voffA[i] = (unsigned)(R * K + C) * 2u; voffB[i] = (unsigned)(Rb * K + C) * 2u; }
    const size_t kstep = (size_t)(BK * 2);
    const size_t hstep = (size_t)HALF * K * 2;
    const size_t tstep = 2 * hstep;
    const unsigned ldsw = (unsigned)wid * 1024u;
    const int aoff = lds_byte(wr * 64 + fr, fq * 8), boff = lds_byte(wc * 32 + fr, fq * 8);
#define PG8_SA(b, h) (((b) * 2 + (h)) * HTB)
#define PG8_SB(b, h) ((4 + (b) * 2 + (h)) * HTB)
#define PG8_STAGE(bufoff, gbase, voff) do { _Pragma("unroll") for (int _i = 0; _i < 2; ++_i) \
        __builtin_amdgcn_global_load_lds((const unsigned*)((const char*)(gbase) + (voff)[_i]), (PG8_LAS unsigned*)(lds + (bufoff) + ldsw + _i * 8192), 16, 0, 0); } while (0)
#define PG8_LDA(dst, b, h) do { _Pragma("unroll") for (int m = 0; m < 4; ++m) _Pragma("unroll") for (int k = 0; k < 2; ++k) dst[m][k] = *(const PG8_LAS bf16x8*)(lds + PG8_SA(b, h) + aoff + m * 2048 + k * 1024); } while (0)
#define PG8_LDB(dst, b, h) do { _Pragma("unroll") for (int n = 0; n < 2; ++n) _Pragma("unroll") for (int k = 0; k < 2; ++k) dst[n][k] = *(const PG8_LAS bf16x8*)(lds + PG8_SB(b, h) + boff + n * 2048 + k * 1024); } while (0)
#define PG8_MMA(ai, bj, At, Bt) do { __builtin_amdgcn_s_setprio(1); _Pragma("unroll") for (int m = 0; m < 4; ++m) _Pragma("unroll") for (int n = 0; n < 2; ++n) _Pragma("unroll") for (int k = 0; k < 2; ++k) \
        acc[ai][bj][m][n] = __builtin_amdgcn_mfma_f32_16x16x32_bf16(Bt[n][k], At[m][k], acc[ai][bj][m][n], 0, 0, 0); __builtin_amdgcn_s_setprio(0); } while (0)
#define PG8_WAIT_V(n) asm volatile("s_waitcnt vmcnt(" #n ")" ::: "memory")
#define PG8_WAIT_L(n) asm volatile("s_waitcnt lgkmcnt(" #n ")" ::: "memory")
#define PG8_BAR __builtin_amdgcn_s_barrier()
#define PG8_SCHED __builtin_amdgcn_sched_barrier(0)
    Unit cur, nxt; int ui = 0;
    if (!S.next(0, cur)) return;
    f32x4 acc[2][2][4][2];
#pragma unroll
    for (int a = 0; a < 2; ++a)
#pragma unroll
        for (int b = 0; b < 2; ++b)
#pragma unroll
            for (int m = 0; m < 4; ++m)
#pragma unroll
                for (int n = 0; n < 2; ++n) acc[a][b][m][n] = (f32x4){0.f, 0.f, 0.f, 0.f};
    bf16x8 At[4][2], B0[2][2], B1[2][2];
    const char* cA = (const char*)g.A + (size_t)cur.pm * tstep; const char* cB = (const char*)g.Bt + (size_t)cur.pn * tstep;
    S.a_ready(cur);
    if constexpr (SP2) {
        PG8_STAGE(PG8_SB(0, 0), cB, voffB); PG8_STAGE(PG8_SB(0, 1), cB + hstep, voffB); PG8_STAGE(PG8_SA(0, 0), cA, voffA); PG8_STAGE(PG8_SA(0, 1), cA + hstep, voffA);
        if (wr == 1) PG8_BAR;
        PG8_WAIT_V(2); PG8_BAR;
        PG8_STAGE(PG8_SB(1, 0), cB + kstep, voffB); PG8_STAGE(PG8_SA(1, 0), cA + kstep, voffA); PG8_STAGE(PG8_SB(1, 1), cB + hstep + kstep, voffB);
        PG8_WAIT_V(6); PG8_BAR;
    } else {
        PG8_STAGE(PG8_SB(0, 0), cB, voffB); PG8_STAGE(PG8_SA(0, 0), cA, voffA); PG8_STAGE(PG8_SB(0, 1), cB + hstep, voffB); PG8_STAGE(PG8_SA(0, 1), cA + hstep, voffA);
        if (wr == 1) PG8_BAR;
        PG8_WAIT_V(4); PG8_BAR;
        PG8_STAGE(PG8_SB(1, 0), cB + kstep, voffB); PG8_STAGE(PG8_SA(1, 0), cA + kstep, voffA); PG8_STAGE(PG8_SB(1, 1), cB + hstep + kstep, voffB);
        PG8_WAIT_V(6); PG8_BAR;
    }
    for (;;) {
        const bool has_next = S.next(ui + 1, nxt);
        const char* nA = has_next ? (const char*)g.A + (size_t)nxt.pm * tstep : cA; const char* nB = has_next ? (const char*)g.Bt + (size_t)nxt.pn * tstep : cB;
        for (int t = 0; t < nt; t += 2) {
            const bool last = (t == nt - 2);
            const char* a1 = cA + (size_t)(t + 1) * kstep;
            const char* a2 = last ? nA : cA + (size_t)(t + 2) * kstep; const char* b2 = last ? nB : cB + (size_t)(t + 2) * kstep;
            const char* a3 = a2 + kstep; const char* b3 = b2 + kstep;
            if (last && has_next) S.a_ready(nxt);
            if constexpr (SP2) {
            PG8_LDB(B0, 0, 0); PG8_LDB(B1, 0, 1); PG8_SCHED; PG8_LDA(At, 0, 0); PG8_STAGE(PG8_SA(1, 1), a1 + hstep, voffA);
            PG8_WAIT_V(8); PG8_WAIT_L(0); PG8_BAR; PG8_MMA(0, 0, At, B0); PG8_MMA(0, 1, At, B1); PG8_BAR; PG8_SCHED;
            PG8_LDA(At, 0, 1); PG8_STAGE(PG8_SB(0, 0), b2, voffB); PG8_STAGE(PG8_SB(0, 1), b2 + hstep, voffB); PG8_STAGE(PG8_SA(0, 0), a2, voffA);
            PG8_WAIT_V(8); PG8_WAIT_L(0); PG8_BAR; PG8_MMA(1, 0, At, B0); PG8_MMA(1, 1, At, B1); PG8_BAR; PG8_SCHED;
            PG8_LDB(B0, 1, 0); PG8_LDB(B1, 1, 1); PG8_SCHED; PG8_LDA(At, 1, 0); PG8_STAGE(PG8_SA(0, 1), a2 + hstep, voffA);
            PG8_WAIT_V(8); PG8_WAIT_L(0); PG8_BAR; PG8_MMA(0, 0, At, B0); PG8_MMA(0, 1, At, B1); PG8_BAR; PG8_SCHED;
            PG8_LDA(At, 1, 1); PG8_STAGE(PG8_SB(1, 0), b3, voffB); PG8_STAGE(PG8_SB(1, 1), b3 + hstep, voffB); PG8_STAGE(PG8_SA(1, 0), a3, voffA);
            PG8_WAIT_V(8); PG8_WAIT_L(0); PG8_BAR; PG8_MMA(1, 0, At, B0); PG8_MMA(1, 1, At, B1); PG8_BAR; PG8_SCHED;
            } else {
            PG8_LDB(B0, 0, 0); PG8_SCHED; PG8_LDA(At, 0, 0); PG8_STAGE(PG8_SA(1, 1), a1 + hstep, voffA);
            PG8_WAIT_L(8); PG8_BAR; PG8_WAIT_L(0); PG8_MMA(0, 0, At, B0); PG8_BAR; PG8_SCHED;
            PG8_LDB(B1, 0, 1); PG8_STAGE(PG8_SB(0, 0), b2, voffB);
            PG8_BAR; PG8_WAIT_L(0); PG8_MMA(0, 1, At, B1); PG8_BAR;
            PG8_LDA(At, 0, 1); PG8_STAGE(PG8_SA(0, 0), a2, voffA);
            PG8_BAR; PG8_WAIT_L(0); PG8_MMA(1, 0, At, B0); PG8_BAR; PG8_SCHED;
            PG8_STAGE(PG8_SB(0, 1), b2 + hstep, voffB);
            PG8_WAIT_V(6); PG8_BAR; PG8_MMA(1, 1, At, B1); PG8_BAR;
            PG8_LDB(B0, 1, 0); PG8_SCHED; PG8_LDA(At, 1, 0); PG8_STAGE(PG8_SA(0, 1), a2 + hstep, voffA);
            PG8_WAIT_L(8); PG8_BAR; PG8_WAIT_L(0); PG8_MMA(0, 0, At, B0); PG8_BAR; PG8_SCHED;
            PG8_LDB(B1, 1, 1); PG8_STAGE(PG8_SB(1, 0), b3, voffB);
            PG8_BAR; PG8_WAIT_L(0); PG8_MMA(0, 1, At, B1); PG8_BAR;
            PG8_LDA(At, 1, 1); PG8_STAGE(PG8_SA(1, 0), a3, voffA);
            PG8_BAR; PG8_WAIT_L(0); PG8_MMA(1, 0, At, B0); PG8_BAR; PG8_SCHED;
            PG8_STAGE(PG8_SB(1, 1), b3 + hstep, voffB);
            PG8_WAIT_V(6); PG8_BAR; PG8_MMA(1, 1, At, B1); PG8_BAR;
            }
        }
        if constexpr (ALIGN_EPI) { if (wr == 0) PG8_BAR; }
        if constexpr (!Epi::AFTER_DRAIN) { E(acc, cur, wr, wc, fr, fq); S.done(cur); }
        if (!has_next) break;
#pragma unroll
        for (int a = 0; a < 2; ++a)
#pragma unroll
            for (int b = 0; b < 2; ++b)
#pragma unroll
                for (int m = 0; m < 4; ++m)
#pragma unroll
                    for (int n = 0; n < 2; ++n) acc[a][b][m][n] = (f32x4){0.f, 0.f, 0.f, 0.f};
        cur = nxt; cA = nA; cB = nB; ++ui;
        if constexpr (ALIGN_EPI) { if (wr == 1) PG8_BAR; }
    }
    PG8_WAIT_V(0);
    if constexpr (!ALIGN_EPI) { if (wr == 0) PG8_BAR; }
    PG8_BAR;
    if constexpr (Epi::AFTER_DRAIN) { E.fused(acc, cur, wr, wc, fr, fq, lds, wid, lane); S.done(cur); }
#undef PG8_SA
#undef PG8_SB
#undef PG8_STAGE
#undef PG8_LDA
#undef PG8_LDB
#undef PG8_MMA
#undef PG8_WAIT_V
#undef PG8_WAIT_L
#undef PG8_BAR
#undef PG8_SCHED
}
}

#define WTAB_OFF 155392
extern __shared__ __attribute__((aligned(16))) unsigned char lds_raw[];
__device__ __forceinline__ int hw_slot() { return (int)(__builtin_amdgcn_s_getreg((5 << 11) | 4) & 63u); }
__device__ __forceinline__ void otid_init() { const int t = threadIdx.x; if ((t & 63) == 0) ((__attribute__((address_space(3))) int*)(__attribute__((address_space(3))) void*)(lds_raw + WTAB_OFF))[hw_slot()] = t >> 6; }
__device__ __forceinline__ int otid() {
    const int w = __builtin_amdgcn_readfirstlane(((const __attribute__((address_space(3))) int*)(__attribute__((address_space(3))) void*)(lds_raw + WTAB_OFF))[hw_slot()]);
    int l; asm volatile("v_mbcnt_lo_u32_b32 %0, -1, 0\n\tv_mbcnt_hi_u32_b32 %0, -1, %0" : "=v"(l));
    return (w << 6) + l;
}
using pg8::bf16_t; using pg8::bf16x8; using pg8::f32x4; using pg8::u32x4;
#define LAS __attribute__((address_space(3)))

#define DMODEL 1024
#define NPT 16384
#define NST 32
#define NTOK 16416
#define MPAD 16640
#define SEQ 2048
#define ZW 2816
#define OFF_A 1536
#define OFF_B 1544
#define OFF_Z 1552
#define OFF_QA 2064
#define OFF_KVA 2448
#define OFF_KR 2704
#define DFF 2816
#define PAST 16384
#define NPAGES 128
#define EPSV 1e-6f

#define O_YP 0
#define O_YS (O_YP + 16777216)
#define O_CKVP (O_YS + 32768)
#define O_KRP (O_CKVP + 4194304)
#define O_GSP (O_KRP + 524288)
#define O_CSP (O_GSP + 262144)
#define O_CKVS (O_CSP + 36864)
#define O_KRS (O_CKVS + 8192)
#define O_GSS (O_KRS + 1024)
#define O_CSS (O_GSS + 1048576)

__device__ __forceinline__ bf16_t f2bf(float f) { unsigned u = __float_as_uint(f); return (bf16_t)((u + 0x7fffu + ((u >> 16) & 1u)) >> 16); }
__device__ __forceinline__ float bf2f(bf16_t b) { return __uint_as_float(((unsigned)b) << 16); }
__device__ __forceinline__ float wave_sum(float v) {
#pragma unroll
    for (int o = 1; o < 64; o <<= 1) v += __shfl_xor(v, o);
    return v;
}
__device__ __forceinline__ float sigmoidf_(float x) { return __builtin_amdgcn_rcpf(1.f + __builtin_amdgcn_exp2f(-1.44269504f * x)); }
__device__ __forceinline__ float siluf_(float x) { return x * __builtin_amdgcn_rcpf(1.f + __builtin_amdgcn_exp2f(-1.44269504f * x)); }


#define WSYNC() do { __builtin_amdgcn_fence(__ATOMIC_ACQ_REL, "wavefront"); __builtin_amdgcn_wave_barrier(); } while (0)
#define NTHR 512
#define NWAVE 8

typedef float f32x2_t __attribute__((ext_vector_type(2)));
typedef __bf16 bf16x2_t __attribute__((ext_vector_type(2)));
__device__ __forceinline__ unsigned cvtpk(float lo, float hi) { f32x2_t v = {lo, hi}; bf16x2_t r = __builtin_convertvector(v, bf16x2_t); return __builtin_bit_cast(unsigned, r); }
__device__ __forceinline__ void bf8_to_f32(const bf16x8& v, float* o) {
#pragma unroll
    for (int e = 0; e < 8; ++e) o[e] = __uint_as_float(((unsigned)(unsigned short)v[e]) << 16);
}
__device__ __forceinline__ bf16x8 f32_to_bf8(const float* x) {
    u32x4 w; w.x = cvtpk(x[0], x[1]); w.y = cvtpk(x[2], x[3]); w.z = cvtpk(x[4], x[5]); w.w = cvtpk(x[6], x[7]);
    return __builtin_bit_cast(bf16x8, w);
}
__device__ __forceinline__ unsigned pk2bf(float lo, float hi) { return (unsigned)f2bf(lo) | ((unsigned)f2bf(hi) << 16); }

__device__ __forceinline__ void wt_item(const float* __restrict__ W, int ldw, int col0, int nvalid, bf16_t* __restrict__ WT, int ldt, int nrow0, int k0, float* scr, int lane) {
    WSYNC();
#pragma unroll 8
    for (int i = 0; i < 32; ++i) { const int kk = 2 * i + (lane >> 5), n = lane & 31; scr[kk * 33 + n] = n < nvalid ? W[(size_t)(k0 + kk) * ldw + col0 + n] : 0.f; }
    WSYNC();
    const int c = lane & 7;
#pragma unroll
    for (int j = 0; j < 4; ++j) { const int n = (lane >> 3) + 8 * j; const float* sp = scr + (8 * c) * 33 + n;
        u32x4 o; o.x = cvtpk(sp[0], sp[33]); o.y = cvtpk(sp[2 * 33], sp[3 * 33]); o.z = cvtpk(sp[4 * 33], sp[5 * 33]); o.w = cvtpk(sp[6 * 33], sp[7 * 33]);
        *(u32x4*)(WT + (size_t)(nrow0 + n) * ldt + k0 + 8 * c) = o; }
}

__device__ __forceinline__ void rms1024_row(const float* __restrict__ src, const float* __restrict__ g, bf16_t* __restrict__ o, bool zero, int lane) {
    if (zero) { for (int j = 0; j < 4; ++j) { ushort4 z = {0, 0, 0, 0}; *(ushort4*)(o + lane * 4 + 256 * j) = z; } return; }
    float4 v[4]; float ss = 0.f;
#pragma unroll
    for (int j = 0; j < 4; ++j) { v[j] = *(const float4*)(src + lane * 4 + 256 * j); ss += v[j].x * v[j].x + v[j].y * v[j].y + v[j].z * v[j].z + v[j].w * v[j].w; }
    ss = wave_sum(ss);
    const float rs = rsqrtf(ss * (1.f / 1024.f) + EPSV);
#pragma unroll
    for (int j = 0; j < 4; ++j) {
        const float4 gg = *(const float4*)(g + lane * 4 + 256 * j);
        ushort4 w; w.x = f2bf(v[j].x * rs * gg.x); w.y = f2bf(v[j].y * rs * gg.y); w.z = f2bf(v[j].z * rs * gg.z); w.w = f2bf(v[j].w * rs * gg.w);
        *(ushort4*)(o + lane * 4 + 256 * j) = w;
    }
}

__device__ __forceinline__ void rms1024_row_b(const bf16_t* __restrict__ src, const float* __restrict__ g, bf16_t* __restrict__ o, bool zero, int lane) {
    if (zero) { for (int j = 0; j < 2; ++j) { const u32x4 z = {0u, 0u, 0u, 0u}; *(u32x4*)(o + lane * 8 + 512 * j) = z; } return; }
    float v[2][8]; float ss = 0.f;
#pragma unroll
    for (int j = 0; j < 2; ++j) { bf8_to_f32(*(const bf16x8*)(src + lane * 8 + 512 * j), v[j]);
#pragma unroll
        for (int e = 0; e < 8; ++e) ss += v[j][e] * v[j][e]; }
    ss = wave_sum(ss);
    const float rs = rsqrtf(ss * (1.f / 1024.f) + EPSV);
#pragma unroll
    for (int j = 0; j < 2; ++j) {
        const float4 g0 = *(const float4*)(g + lane * 8 + 512 * j), g1 = *(const float4*)(g + lane * 8 + 512 * j + 4);
        float t[8] = {v[j][0] * rs * g0.x, v[j][1] * rs * g0.y, v[j][2] * rs * g0.z, v[j][3] * rs * g0.w, v[j][4] * rs * g1.x, v[j][5] * rs * g1.y, v[j][6] * rs * g1.z, v[j][7] * rs * g1.w};
        *(bf16x8*)(o + lane * 8 + 512 * j) = f32_to_bf8(t);
    }
}

struct ABf16 { const bf16_t* p; int lda; __device__ __forceinline__ bf16x8 load(int m, int k) const { return *(const bf16x8*)(p + (size_t)m * lda + k); } };
struct ACache {
    const float* cache; const int* pt;
    __device__ __forceinline__ bf16x8 load(int m, int k) const {
        const int b = m >> 14, t = m & 16383; const int phys = pt[b * NPAGES + (t >> 7)];
        const float* r = cache + ((size_t)phys * 128 + (t & 127)) * 256 + k;
        const float4 a = *(const float4*)r, c = *(const float4*)(r + 4);
        bf16x8 o; o[0] = (short)f2bf(a.x); o[1] = (short)f2bf(a.y); o[2] = (short)f2bf(a.z); o[3] = (short)f2bf(a.w);
        o[4] = (short)f2bf(c.x); o[5] = (short)f2bf(c.y); o[6] = (short)f2bf(c.z); o[7] = (short)f2bf(c.w); return o;
    }
};
template <class AL, class Epi>
__device__ __forceinline__ void gemm_tile_256x128(const AL& al, const bf16_t* __restrict__ Bt, int ldb, int K, const Epi& epi, int m0, int n0, char* smem) {
    bf16_t (*sA)[40] = (bf16_t (*)[40])smem;
    bf16_t (*sB)[40] = (bf16_t (*)[40])(smem + 20480);
    const int tid = otid(), lane = tid & 63, wid = tid >> 6, wm = wid >> 1, wn = wid & 1;
    f32x4 acc[4][4];
#pragma unroll
    for (int i = 0; i < 4; ++i)
#pragma unroll
        for (int j = 0; j < 4; ++j) acc[i][j] = (f32x4){0.f, 0.f, 0.f, 0.f};
    __syncthreads();
    for (int k0 = 0; k0 < K; k0 += 32) {
#pragma unroll
        for (int i = 0; i < 2; ++i) { const int ch = tid + 512 * i, r = ch >> 2, kc = (ch & 3) * 8; *(bf16x8*)&sA[r][kc] = al.load(m0 + r, k0 + kc); }
        { const int r = tid >> 2, kc = (tid & 3) * 8; *(bf16x8*)&sB[r][kc] = *(const bf16x8*)(Bt + (size_t)(n0 + r) * ldb + k0 + kc); }
        __syncthreads();
        bf16x8 af[4], bfr[4];
#pragma unroll
        for (int i = 0; i < 4; ++i) af[i] = *(const bf16x8*)&sA[wm * 64 + i * 16 + (lane & 15)][(lane >> 4) * 8];
#pragma unroll
        for (int j = 0; j < 4; ++j) bfr[j] = *(const bf16x8*)&sB[wn * 64 + j * 16 + (lane & 15)][(lane >> 4) * 8];
#pragma unroll
        for (int i = 0; i < 4; ++i)
#pragma unroll
            for (int j = 0; j < 4; ++j) acc[i][j] = __builtin_amdgcn_mfma_f32_16x16x32_bf16(af[i], bfr[j], acc[i][j], 0, 0, 0);
        __syncthreads();
    }
#pragma unroll
    for (int i = 0; i < 4; ++i)
#pragma unroll
        for (int j = 0; j < 4; ++j)
#pragma unroll
            for (int r = 0; r < 4; ++r) epi(m0 + wm * 64 + i * 16 + (lane >> 4) * 4 + r, n0 + wn * 64 + j * 16 + (lane & 15), acc[i][j][r]);
}
template <class Epi>
__device__ __forceinline__ void gemm_tile_32x256(const bf16_t* __restrict__ A, int lda, const bf16_t* __restrict__ Bt, int ldb, int K, const Epi& epi, int m0, int n0, char* smem) {
    bf16_t (*sA)[40] = (bf16_t (*)[40])smem;
    bf16_t (*sB)[40] = (bf16_t (*)[40])(smem + 2560);
    const int tid = otid(), lane = tid & 63, wid = tid >> 6;
    f32x4 acc[2][2];
#pragma unroll
    for (int i = 0; i < 2; ++i)
#pragma unroll
        for (int j = 0; j < 2; ++j) acc[i][j] = (f32x4){0.f, 0.f, 0.f, 0.f};
    __syncthreads();
    for (int k0 = 0; k0 < K; k0 += 32) {
        if (tid < 128) { const int r = tid >> 2, kc = (tid & 3) * 8; *(bf16x8*)&sA[r][kc] = *(const bf16x8*)(A + (size_t)(m0 + r) * lda + k0 + kc); }
#pragma unroll
        for (int i = 0; i < 2; ++i) { const int ch = tid + 512 * i, r = ch >> 2, kc = (ch & 3) * 8; *(bf16x8*)&sB[r][kc] = *(const bf16x8*)(Bt + (size_t)(n0 + r) * ldb + k0 + kc); }
        __syncthreads();
        bf16x8 af[2], bfr[2];
#pragma unroll
        for (int i = 0; i < 2; ++i) af[i] = *(const bf16x8*)&sA[i * 16 + (lane & 15)][(lane >> 4) * 8];
#pragma unroll
        for (int j = 0; j < 2; ++j) bfr[j] = *(const bf16x8*)&sB[wid * 32 + j * 16 + (lane & 15)][(lane >> 4) * 8];
#pragma unroll
        for (int i = 0; i < 2; ++i)
#pragma unroll
            for (int j = 0; j < 2; ++j) acc[i][j] = __builtin_amdgcn_mfma_f32_16x16x32_bf16(af[i], bfr[j], acc[i][j], 0, 0, 0);
        __syncthreads();
    }
#pragma unroll
    for (int i = 0; i < 2; ++i)
#pragma unroll
        for (int j = 0; j < 2; ++j)
#pragma unroll
            for (int r = 0; r < 4; ++r) epi(m0 + i * 16 + (lane >> 4) * 4 + r, n0 + wid * 32 + j * 16 + (lane & 15), acc[i][j][r]);
}
template <bool SWIGLU, class Epi>
__device__ __forceinline__ void gemm_sample_rows(const bf16_t* __restrict__ A, int lda, const bf16_t* __restrict__ Bt, int K, int N, const Epi& epi, char*  , int bid, int nb) {
    const int tid = otid(), lane = tid & 63, wid = tid >> 6, i16 = lane & 15, q4 = lane >> 4;
    for (int u = nb - 1 - bid; u < N / 256; u += nb) {
        const int n0 = u * 256;
        const int c0 = SWIGLU ? n0 + 16 * wid : n0 + 32 * wid, c1 = SWIGLU ? n0 + 128 + 16 * wid : n0 + 32 * wid + 16;
        const bf16_t* a0p = A + (size_t)(NPT + i16) * lda + 8 * q4; const bf16_t* a1p = a0p + (size_t)16 * lda;
        const bf16_t* b0p = Bt + (size_t)(c0 + i16) * K + 8 * q4; const bf16_t* b1p = Bt + (size_t)(c1 + i16) * K + 8 * q4;
        f32x4 acc[2][2];
#pragma unroll
        for (int i = 0; i < 2; ++i)
#pragma unroll
            for (int j = 0; j < 2; ++j) acc[i][j] = (f32x4){0.f, 0.f, 0.f, 0.f};
#pragma unroll 4
        for (int k0 = 0; k0 < K; k0 += 32) {
            const bf16x8 a0 = *(const bf16x8*)(a0p + k0), a1 = *(const bf16x8*)(a1p + k0), b0 = *(const bf16x8*)(b0p + k0), b1 = *(const bf16x8*)(b1p + k0);
            acc[0][0] = __builtin_amdgcn_mfma_f32_16x16x32_bf16(a0, b0, acc[0][0], 0, 0, 0); acc[0][1] = __builtin_amdgcn_mfma_f32_16x16x32_bf16(a0, b1, acc[0][1], 0, 0, 0);
            acc[1][0] = __builtin_amdgcn_mfma_f32_16x16x32_bf16(a1, b0, acc[1][0], 0, 0, 0); acc[1][1] = __builtin_amdgcn_mfma_f32_16x16x32_bf16(a1, b1, acc[1][1], 0, 0, 0);
        }
#pragma unroll
        for (int i = 0; i < 2; ++i)
#pragma unroll
            for (int r = 0; r < 4; ++r) {
                const int m = NPT + 16 * i + 4 * q4 + r;
                if constexpr (SWIGLU) epi(m, (n0 >> 1) + 16 * wid + i16, siluf_(acc[i][0][r]) * acc[i][1][r]);
                else { epi(m, c0 + i16, acc[i][0][r]); epi(m, c1 + i16, acc[i][1][r]); }
            }
    }
}
template <bool SWIGLU, class Epi>
__device__ __forceinline__ void gemm_sample_rows_ks(const bf16_t* __restrict__ A, int lda, const bf16_t* __restrict__ Bt, int K, int N, const Epi& epi, char* smem, int bid, int nb) {
    const int tid = otid(), lane = tid & 63, wid = tid >> 6, i16 = lane & 15, q4 = lane >> 4;
    const int nunits = N / 64, ksl = K >> 3;
    f32x4* red = (f32x4*)smem;
    for (int u = nb - 1 - bid; u < nunits; u += nb) {
        int brow[4];
#pragma unroll
        for (int j = 0; j < 4; ++j) brow[j] = SWIGLU ? ((32 * u) >> 7) * 256 + ((32 * u) & 127) + 128 * (j >> 1) + 16 * (j & 1) + i16 : 64 * u + 16 * j + i16;
        const bf16_t* a0p = A + (size_t)(NPT + i16) * lda + wid * ksl + 8 * q4; const bf16_t* a1p = a0p + (size_t)16 * lda;
        f32x4 acc[2][4];
#pragma unroll
        for (int i = 0; i < 2; ++i)
#pragma unroll
            for (int j = 0; j < 4; ++j) acc[i][j] = (f32x4){0.f, 0.f, 0.f, 0.f};
        for (int k0 = 0; k0 < ksl; k0 += 32) {
            const bf16x8 a0 = *(const bf16x8*)(a0p + k0), a1 = *(const bf16x8*)(a1p + k0);
            bf16x8 b[4];
#pragma unroll
            for (int j = 0; j < 4; ++j) b[j] = *(const bf16x8*)(Bt + (size_t)brow[j] * K + wid * ksl + 8 * q4 + k0);
#pragma unroll
            for (int j = 0; j < 4; ++j) { acc[0][j] = __builtin_amdgcn_mfma_f32_16x16x32_bf16(a0, b[j], acc[0][j], 0, 0, 0); acc[1][j] = __builtin_amdgcn_mfma_f32_16x16x32_bf16(a1, b[j], acc[1][j], 0, 0, 0); }
        }
        __syncthreads();
#pragma unroll
        for (int i = 0; i < 2; ++i)
#pragma unroll
            for (int j = 0; j < 4; ++j) red[(wid * 8 + i * 4 + j) * 64 + lane] = acc[i][j];
        __syncthreads();
        if constexpr (SWIGLU) {
            if (tid < 256) {
                const int t4 = tid >> 6, i = t4 >> 1, jg = t4 & 1, l = tid & 63;
                f32x4 g = red[(i * 4 + jg) * 64 + l], up = red[(i * 4 + jg + 2) * 64 + l];
#pragma unroll
                for (int w = 1; w < 8; ++w) { g = g + red[(w * 8 + i * 4 + jg) * 64 + l]; up = up + red[(w * 8 + i * 4 + jg + 2) * 64 + l]; }
#pragma unroll
                for (int r = 0; r < 4; ++r) epi(NPT + 16 * i + 4 * (l >> 4) + r, 32 * u + 16 * jg + (l & 15), siluf_(g[r]) * up[r]);
            }
        } else {
            const int t8 = tid >> 6, l = tid & 63, i = t8 >> 2, j = t8 & 3;
            f32x4 v = red[t8 * 64 + l];
#pragma unroll
            for (int w = 1; w < 8; ++w) v = v + red[(w * 8 + t8) * 64 + l];
#pragma unroll
            for (int r = 0; r < 4; ++r) epi(NPT + 16 * i + 4 * (l >> 4) + r, 64 * u + 16 * j + (l & 15), v[r]);
        }
    }
    __syncthreads();
}
struct EwF32 { float* C; int ldc; __device__ __forceinline__ void operator()(int m, int n, float v) const { C[(size_t)m * ldc + n] = v; } };
struct EwBf16 { bf16_t* C; int ldc; __device__ __forceinline__ void operator()(int m, int n, float v) const { C[(size_t)m * ldc + n] = f2bf(v); } };
struct EwResX { const float* xs; bf16_t* C; __device__ __forceinline__ void operator()(int m, int n, float v) const { C[(size_t)m * 1024 + n] = f2bf(xs[(size_t)(m - NPT) * 1024 + n] + v); } };
struct EwSwiglu {
    float* G; bf16_t* Hd;
    __device__ __forceinline__ void operator()(int m, int n, float v) const {
        const int f = (n >> 8) * 128 + (n & 127);
        if ((n & 255) < 128) G[(size_t)(m - NPT) * DFF + f] = v;
    }
};
struct EwSwiglu2 {
    const float* G; bf16_t* Hd;
    __device__ __forceinline__ void operator()(int m, int n, float v) const {
        const int f = (n >> 8) * 128 + (n & 127);
        if ((n & 255) >= 128) Hd[(size_t)m * DFF + f] = f2bf(siluf_(G[(size_t)(m - NPT) * DFF + f]) * v);
    }
};
struct EwResH { const bf16_t* H; bf16_t* C; __device__ __forceinline__ void operator()(int m, int n, float v) const { C[(size_t)m * 1024 + n] = f2bf(bf2f(H[(size_t)m * 1024 + n]) + v); } };
struct EwPle { const bf16_t* H2; const bf16_t* PP; float* out;
    __device__ __forceinline__ void operator()(int m, int n, float v) const { out[O_YS + (size_t)(m - NPT) * 1024 + n] = bf2f(H2[(size_t)m * 1024 + n]) + bf2f(PP[(size_t)m * 1024 + n]) * sigmoidf_(v); } };

struct PgBf16 {
    static constexpr bool PERM = true, AFTER_DRAIN = false; bf16_t* O; int ldc;
    __device__ __forceinline__ void operator()(const f32x4 (&acc)[2][2][4][2], const pg8::Unit& u, int wr, int wc, int fr, int fq) const {
#pragma unroll
        for (int ai = 0; ai < 2; ++ai)
#pragma unroll
            for (int m = 0; m < 4; ++m) { bf16_t* rowp = O + (size_t)(u.pm * 256 + ai * 128 + wr * 64 + m * 16 + fr) * ldc + u.pn * 256 + wc * 32 + 8 * fq;
#pragma unroll
                for (int bj = 0; bj < 2; ++bj) { const f32x4 v0 = acc[ai][bj][m][0], v1 = acc[ai][bj][m][1]; u32x4 w; w.x = pk2bf(v0[0], v0[1]); w.y = pk2bf(v0[2], v0[3]); w.z = pk2bf(v1[0], v1[1]); w.w = pk2bf(v1[2], v1[3]); *(u32x4*)(rowp + bj * 128) = w; } }
    }
};
struct PgF32 {
    static constexpr bool PERM = false, AFTER_DRAIN = false; float* O; int ldc;
    __device__ __forceinline__ void operator()(const f32x4 (&acc)[2][2][4][2], const pg8::Unit& u, int wr, int wc, int fr, int fq) const {
#pragma unroll
        for (int ai = 0; ai < 2; ++ai)
#pragma unroll
            for (int m = 0; m < 4; ++m) { float* rowp = O + (size_t)(u.pm * 256 + ai * 128 + wr * 64 + m * 16 + fr) * ldc + u.pn * 256 + wc * 32 + 4 * fq;
#pragma unroll
                for (int bj = 0; bj < 2; ++bj)
#pragma unroll
                    for (int n = 0; n < 2; ++n) *(f32x4*)(rowp + bj * 128 + n * 16) = acc[ai][bj][m][n]; }
    }
};
struct PgRes {
    static constexpr bool PERM = false, AFTER_DRAIN = false; const float* R; float* O;
    __device__ __forceinline__ void operator()(const f32x4 (&acc)[2][2][4][2], const pg8::Unit& u, int wr, int wc, int fr, int fq) const {
#pragma unroll
        for (int ai = 0; ai < 2; ++ai)
#pragma unroll
            for (int m = 0; m < 4; ++m) { const size_t off = (size_t)(u.pm * 256 + ai * 128 + wr * 64 + m * 16 + fr) * 1024 + u.pn * 256 + wc * 32 + 4 * fq;
#pragma unroll
                for (int bj = 0; bj < 2; ++bj)
#pragma unroll
                    for (int n = 0; n < 2; ++n) { const f32x4 r = *(const f32x4*)(R + off + bj * 128 + n * 16); *(f32x4*)(O + off + bj * 128 + n * 16) = r + acc[ai][bj][m][n]; } }
    }
};
struct PgSwiglu {
    static constexpr bool PERM = true, AFTER_DRAIN = false; bf16_t* Hd;
    __device__ __forceinline__ void operator()(const f32x4 (&acc)[2][2][4][2], const pg8::Unit& u, int wr, int wc, int fr, int fq) const {
#pragma unroll
        for (int ai = 0; ai < 2; ++ai)
#pragma unroll
            for (int m = 0; m < 4; ++m) { bf16_t* rowp = Hd + (size_t)(u.pm * 256 + ai * 128 + wr * 64 + m * 16 + fr) * DFF + u.pn * 128 + wc * 32 + 8 * fq;
                float h[8];
#pragma unroll
                for (int n = 0; n < 2; ++n)
#pragma unroll
                    for (int i = 0; i < 4; ++i) h[n * 4 + i] = siluf_(acc[ai][0][m][n][i]) * acc[ai][1][m][n][i];
                u32x4 w; w.x = pk2bf(h[0], h[1]); w.y = pk2bf(h[2], h[3]); w.z = pk2bf(h[4], h[5]); w.w = pk2bf(h[6], h[7]); *(u32x4*)rowp = w; }
    }
};
struct PgPle {
    static constexpr bool PERM = false, AFTER_DRAIN = false; const float* H2; const float* PP; float* out;
    __device__ __forceinline__ void operator()(const f32x4 (&acc)[2][2][4][2], const pg8::Unit& u, int wr, int wc, int fr, int fq) const {
#pragma unroll
        for (int ai = 0; ai < 2; ++ai)
#pragma unroll
            for (int m = 0; m < 4; ++m) { const size_t off = (size_t)(u.pm * 256 + ai * 128 + wr * 64 + m * 16 + fr) * 1024 + u.pn * 256 + wc * 32 + 4 * fq;
#pragma unroll
                for (int bj = 0; bj < 2; ++bj)
#pragma unroll
                    for (int n = 0; n < 2; ++n) { const f32x4 h = *(const f32x4*)(H2 + off + bj * 128 + n * 16), pp = *(const f32x4*)(PP + off + bj * 128 + n * 16), a = acc[ai][bj][m][n]; f32x4 y;
#pragma unroll
                        for (int i = 0; i < 4; ++i) y[i] = h[i] + pp[i] * sigmoidf_(a[i]);
                        *(f32x4*)(out + O_YP + off + bj * 128 + n * 16) = y; } }
    }
};
struct PgResXB {
    static constexpr bool PERM = true, AFTER_DRAIN = false; const float* R; bf16_t* O;
    __device__ __forceinline__ void operator()(const f32x4 (&acc)[2][2][4][2], const pg8::Unit& u, int wr, int wc, int fr, int fq) const {
#pragma unroll
        for (int ai = 0; ai < 2; ++ai)
#pragma unroll
            for (int m = 0; m < 4; ++m) { const size_t off = (size_t)(u.pm * 256 + ai * 128 + wr * 64 + m * 16 + fr) * 1024 + u.pn * 256 + wc * 32 + 8 * fq;
#pragma unroll
                for (int bj = 0; bj < 2; ++bj) { const f32x4 r0 = *(const f32x4*)(R + off + bj * 128), r1 = *(const f32x4*)(R + off + bj * 128 + 4), v0 = r0 + acc[ai][bj][m][0], v1 = r1 + acc[ai][bj][m][1];
                    u32x4 w; w.x = cvtpk(v0[0], v0[1]); w.y = cvtpk(v0[2], v0[3]); w.z = cvtpk(v1[0], v1[1]); w.w = cvtpk(v1[2], v1[3]); *(u32x4*)(O + off + bj * 128) = w; } }
    }
};
struct PgResBB {
    static constexpr bool PERM = true, AFTER_DRAIN = false; const bf16_t* R; bf16_t* O;
    __device__ __forceinline__ void operator()(const f32x4 (&acc)[2][2][4][2], const pg8::Unit& u, int wr, int wc, int fr, int fq) const {
#pragma unroll
        for (int ai = 0; ai < 2; ++ai)
#pragma unroll
            for (int m = 0; m < 4; ++m) { const size_t off = (size_t)(u.pm * 256 + ai * 128 + wr * 64 + m * 16 + fr) * 1024 + u.pn * 256 + wc * 32 + 8 * fq;
#pragma unroll
                for (int bj = 0; bj < 2; ++bj) { float r[8]; bf8_to_f32(*(const bf16x8*)(R + off + bj * 128), r); const f32x4 a0 = acc[ai][bj][m][0], a1 = acc[ai][bj][m][1];
                    u32x4 w; w.x = cvtpk(r[0] + a0[0], r[1] + a0[1]); w.y = cvtpk(r[2] + a0[2], r[3] + a0[3]); w.z = cvtpk(r[4] + a1[0], r[5] + a1[1]); w.w = cvtpk(r[6] + a1[2], r[7] + a1[3]); *(u32x4*)(O + off + bj * 128) = w; } }
    }
};
struct PgPleB {
    static constexpr bool PERM = true, AFTER_DRAIN = false; const bf16_t* H2; const bf16_t* PP; float* out;
    __device__ __forceinline__ void operator()(const f32x4 (&acc)[2][2][4][2], const pg8::Unit& u, int wr, int wc, int fr, int fq) const {
#pragma unroll
        for (int ai = 0; ai < 2; ++ai)
#pragma unroll
            for (int m = 0; m < 4; ++m) { const size_t off = (size_t)(u.pm * 256 + ai * 128 + wr * 64 + m * 16 + fr) * 1024 + u.pn * 256 + wc * 32 + 8 * fq;
#pragma unroll
                for (int bj = 0; bj < 2; ++bj) { float h[8], pp[8]; bf8_to_f32(*(const bf16x8*)(H2 + off + bj * 128), h); bf8_to_f32(*(const bf16x8*)(PP + off + bj * 128), pp);
                    const f32x4 a0 = acc[ai][bj][m][0], a1 = acc[ai][bj][m][1]; f32x4 y0, y1;
#pragma unroll
                    for (int i = 0; i < 4; ++i) { y0[i] = h[i] + pp[i] * sigmoidf_(a0[i]); y1[i] = h[4 + i] + pp[4 + i] * sigmoidf_(a1[i]); }
                    *(f32x4*)(out + O_YP + off + bj * 128) = y0; *(f32x4*)(out + O_YP + off + bj * 128 + 4) = y1; } }
    }
};
template <class Epi>
__device__ __forceinline__ void pg_gemm(LAS unsigned char* lds, const bf16_t* A, const bf16_t* Bt, int M, int N, int K, const Epi& E) {
    pg8::Gemm g{A, Bt, M, N, K}; pg8::StaticOrder S; S.init(M, N, (int)gridDim.x, (int)blockIdx.x);
    pg8::gemm_phase<Epi, pg8::StaticOrder, true, true>(lds, g, S, E);
}

constexpr size_t WOF_WinT = 0ull;
constexpr size_t WOF_WqbT = 5767168ull;
constexpr size_t WOF_WkvT = 6356992ull;
constexpr size_t WOF_WknT = 6881280ull;
constexpr size_t WOF_WoT = 7143424ull;
constexpr size_t WOF_WguT = 9240576ull;
constexpr size_t WOF_WdT = 20774912ull;
constexpr size_t WOF_WpgT = 26542080ull;
constexpr size_t WOF_WppT = 28639232ull;
constexpr size_t WOF_xn = 29163520ull;
constexpr size_t WOF_pb = 63242240ull;
constexpr size_t WOF_Z = 71761920ull;
constexpr size_t WOF_qkv = 165478400ull;
constexpr size_t WOF_ropecs = 216596480ull;
constexpr size_t WOF_gg = 216858880ull;
constexpr size_t WOF_bb = 217391360ull;
constexpr size_t WOF_goraw = 217923840ull;
constexpr size_t WOF_gUT = 252002560ull;
constexpr size_t WOF_ggam = 285556992ull;
constexpr size_t WOF_gWn = 285565184ull;
constexpr size_t WOF_gQg = 302342400ull;
constexpr size_t WOF_gQK = 319119616ull;
constexpr size_t WOF_gKd = 335896832ull;
constexpr size_t WOF_qan = 352674048ull;
constexpr size_t WOF_ckvb = 365453568ull;
constexpr size_t WOF_krf = 373973248ull;
constexpr size_t WOF_Q = 376103168ull;
constexpr size_t WOF_qh = 427221248ull;
constexpr size_t WOF_KV = 478339328ull;
constexpr size_t WOF_kh = 546496768ull;
constexpr size_t WOF_omix = 580575488ull;
constexpr size_t WOF_KN = 614654208ull;
constexpr size_t WOF_SC = 1151525120ull;
constexpr size_t WOF_part = 1168302336ull;
constexpr size_t WOF_H = 1170432256ull;
constexpr size_t WOF_un = 1238589696ull;
constexpr size_t WOF_G = 1272668416ull;
constexpr size_t WOF_hid = 1273028864ull;
constexpr size_t WOF_H2 = 1366745344ull;
constexpr size_t WOF_un2 = 1434902784ull;
constexpr size_t WOF_PP = 1468981504ull;
constexpr size_t WOF_qraw = 1537138944ull;
constexpr size_t WOF_kvraw = 1562304768ull;
constexpr size_t WOF_krb = 1595859200ull;
constexpr size_t WOF_ctl = 1596907776ull;
constexpr size_t WS_TOTAL = 1596924160ull;
struct MK {
    const float *x_prompt, *x_sample, *cache_ckv, *cache_krope, *state_gdn, *state_conv; const int* page_table; const float *p_prompt, *p_sample;
    const float *g_attn, *w_in, *w_conv, *a_log, *dt_bias, *g_gdn_out, *g_q_a, *w_q_b, *g_q_nope, *g_q_rope, *g_kv_a, *g_k_rope, *w_kv_b, *g_k_nope, *w_o, *g_ffn, *w_gate, *w_up, *w_down, *g_ple, *w_ple_gate, *w_ple_proj;
    float* out; char* ws;
    __device__ __forceinline__ unsigned* ctl() const { return (unsigned*)(ws + WOF_ctl); }
    __device__ __forceinline__ bf16_t* WinT() const { return (bf16_t*)(ws + WOF_WinT); }
    __device__ __forceinline__ bf16_t* WqbT() const { return (bf16_t*)(ws + WOF_WqbT); }
    __device__ __forceinline__ bf16_t* WkvT() const { return (bf16_t*)(ws + WOF_WkvT); }
    __device__ __forceinline__ bf16_t* WknT() const { return (bf16_t*)(ws + WOF_WknT); }
    __device__ __forceinline__ bf16_t* WoT() const { return (bf16_t*)(ws + WOF_WoT); }
    __device__ __forceinline__ bf16_t* WguT() const { return (bf16_t*)(ws + WOF_WguT); }
    __device__ __forceinline__ bf16_t* WdT() const { return (bf16_t*)(ws + WOF_WdT); }
    __device__ __forceinline__ bf16_t* WpgT() const { return (bf16_t*)(ws + WOF_WpgT); }
    __device__ __forceinline__ bf16_t* WppT() const { return (bf16_t*)(ws + WOF_WppT); }
    __device__ __forceinline__ bf16_t* xn() const { return (bf16_t*)(ws + WOF_xn); }
    __device__ __forceinline__ bf16_t* pb() const { return (bf16_t*)(ws + WOF_pb); }
    __device__ __forceinline__ bf16_t* Z() const { return (bf16_t*)(ws + WOF_Z); }
    __device__ __forceinline__ bf16_t* qkv() const { return (bf16_t*)(ws + WOF_qkv); }
    __device__ __forceinline__ float* ropecs() const { return (float*)(ws + WOF_ropecs); }
    __device__ __forceinline__ float* gg() const { return (float*)(ws + WOF_gg); }
    __device__ __forceinline__ float* bb() const { return (float*)(ws + WOF_bb); }
    __device__ __forceinline__ float* goraw() const { return (float*)(ws + WOF_goraw); }
    __device__ __forceinline__ float* gUT() const { return (float*)(ws + WOF_gUT); }
    __device__ __forceinline__ float* ggam() const { return (float*)(ws + WOF_ggam); }
    __device__ __forceinline__ bf16_t* gWn() const { return (bf16_t*)(ws + WOF_gWn); }
    __device__ __forceinline__ bf16_t* gQg() const { return (bf16_t*)(ws + WOF_gQg); }
    __device__ __forceinline__ bf16_t* gQK() const { return (bf16_t*)(ws + WOF_gQK); }
    __device__ __forceinline__ bf16_t* gKd() const { return (bf16_t*)(ws + WOF_gKd); }
    __device__ __forceinline__ bf16_t* qan() const { return (bf16_t*)(ws + WOF_qan); }
    __device__ __forceinline__ bf16_t* ckvb() const { return (bf16_t*)(ws + WOF_ckvb); }
    __device__ __forceinline__ float* krf() const { return (float*)(ws + WOF_krf); }
    __device__ __forceinline__ float* Q() const { return (float*)(ws + WOF_Q); }
    __device__ __forceinline__ float* qh() const { return (float*)(ws + WOF_qh); }
    __device__ __forceinline__ float* KV() const { return (float*)(ws + WOF_KV); }
    __device__ __forceinline__ float* kh() const { return (float*)(ws + WOF_kh); }
    __device__ __forceinline__ bf16_t* omix() const { return (bf16_t*)(ws + WOF_omix); }
    __device__ __forceinline__ bf16_t* KN() const { return (bf16_t*)(ws + WOF_KN); }
    __device__ __forceinline__ float* SC() const { return (float*)(ws + WOF_SC); }
    __device__ __forceinline__ float* part() const { return (float*)(ws + WOF_part); }
    __device__ __forceinline__ bf16_t* H() const { return (bf16_t*)(ws + WOF_H); }
    __device__ __forceinline__ bf16_t* un() const { return (bf16_t*)(ws + WOF_un); }
    __device__ __forceinline__ float* G() const { return (float*)(ws + WOF_G); }
    __device__ __forceinline__ bf16_t* hid() const { return (bf16_t*)(ws + WOF_hid); }
    __device__ __forceinline__ bf16_t* H2() const { return (bf16_t*)(ws + WOF_H2); }
    __device__ __forceinline__ bf16_t* un2() const { return (bf16_t*)(ws + WOF_un2); }
    __device__ __forceinline__ bf16_t* PP() const { return (bf16_t*)(ws + WOF_PP); }
    __device__ __forceinline__ bf16_t* qraw() const { return (bf16_t*)(ws + WOF_qraw); }
    __device__ __forceinline__ bf16_t* kvraw() const { return (bf16_t*)(ws + WOF_kvraw); }
    __device__ __forceinline__ bf16_t* krb() const { return (bf16_t*)(ws + WOF_krb); }
};

__device__ __forceinline__ float fast_sigmoid(float x) { return __builtin_amdgcn_rcpf(1.f + __builtin_amdgcn_exp2f(-1.44269504f * x)); }
struct PinTok { bf16x8 qa, cv, kr; float ab; };
struct PinGain { float gqa[8], gkv[8], gkr[8], dtb, alog; };
__device__ __forceinline__ PinTok pin_load(const MK& a, int row, int lane) {
    const bf16_t* z = a.Z() + (size_t)row * ZW; PinTok t; const bf16x8 zz = {0, 0, 0, 0, 0, 0, 0, 0};
    t.qa = lane < 48 ? *(const bf16x8*)(z + OFF_QA + 8 * lane) : zz; t.cv = lane < 32 ? *(const bf16x8*)(z + OFF_KVA + 8 * lane) : zz;
    t.kr = (lane >= 32 && lane < 36) ? *(const bf16x8*)(z + OFF_KR + 8 * (lane - 32)) : zz; t.ab = lane < 16 ? bf2f(z[OFF_A + lane]) : 0.f; return t;
}
__device__ __forceinline__ void post_in_token(const MK& a, int row, int lane, const float* wcs, const bf16x8 (&w0)[3], const bf16x8 (&w1)[3], const bf16x8 (&w2)[3], const bf16x8 (&wcur)[3], const PinTok& tk, const PinGain& gn) {
    const bool samp = row >= NPT;
    const int b = samp ? row - NPT : row >> 11, t = samp ? 0 : row & 2047, hd = lane >> 3;
    float y[24];
#pragma unroll
    for (int c3 = 0; c3 < 3; ++c3) {
        float p0[8], p1[8], p2[8], cu[8];
        bf8_to_f32(w0[c3], p0); bf8_to_f32(w1[c3], p1); bf8_to_f32(w2[c3], p2); bf8_to_f32(wcur[c3], cu);
        const float* wp = wcs + 512 * c3 + 8 * lane;
        const float4 a0 = *(const float4*)wp, a1 = *(const float4*)(wp + 4), b0 = *(const float4*)(wp + 1536), b1 = *(const float4*)(wp + 1540);
        const float4 c0 = *(const float4*)(wp + 3072), c1 = *(const float4*)(wp + 3076), d0 = *(const float4*)(wp + 4608), d1 = *(const float4*)(wp + 4612);
        const float k0[8] = {a0.x, a0.y, a0.z, a0.w, a1.x, a1.y, a1.z, a1.w}, k1[8] = {b0.x, b0.y, b0.z, b0.w, b1.x, b1.y, b1.z, b1.w};
        const float k2[8] = {c0.x, c0.y, c0.z, c0.w, c1.x, c1.y, c1.z, c1.w}, k3[8] = {d0.x, d0.y, d0.z, d0.w, d1.x, d1.y, d1.z, d1.w};
#pragma unroll
        for (int e = 0; e < 8; ++e) { const int c = 8 * c3 + e; const float v = k0[e] * p0[e] + k1[e] * p1[e] + k2[e] * p2[e] + k3[e] * cu[e]; y[c] = v * fast_sigmoid(v); }
        __builtin_amdgcn_sched_barrier(0);
    }
    float sq = 0.f, sk = 0.f;
#pragma unroll
    for (int e = 0; e < 8; ++e) { sq += y[e] * y[e]; sk += y[8 + e] * y[8 + e]; }
    sq += __shfl_xor(sq, 1); sk += __shfl_xor(sk, 1); sq += __shfl_xor(sq, 2); sk += __shfl_xor(sk, 2); sq += __shfl_xor(sq, 4); sk += __shfl_xor(sk, 4);
    const float rq = rsqrtf(sq + EPSV) * 0.125f, rk = rsqrtf(sk + EPSV);
#pragma unroll
    for (int e = 0; e < 8; ++e) { y[e] *= rq; y[8 + e] *= rk; }
    bf16_t* qo = a.qkv() + (size_t)row * 1536 + 8 * lane;
    *(bf16x8*)qo = f32_to_bf8(y); *(bf16x8*)(qo + 512) = f32_to_bf8(y + 8); *(bf16x8*)(qo + 1024) = f32_to_bf8(y + 16);
    if (!samp && t >= SEQ - 3) {
        float* cso = a.out + O_CSP + ((size_t)b * 3 + (t - (SEQ - 3))) * 1536 + 8 * lane;
#pragma unroll
        for (int j = 0; j < 3; ++j) { float cu[8]; bf8_to_f32(wcur[j], cu); *(float4*)(cso + 512 * j) = (float4){cu[0], cu[1], cu[2], cu[3]}; *(float4*)(cso + 512 * j + 4) = (float4){cu[4], cu[5], cu[6], cu[7]}; }
    }
    if (lane < 16) {
        const float v = tk.ab;
        if (lane < 8) { const float xx = v + gn.dtb; const float sp = xx > 20.f ? xx : log1pf(expf(xx)); a.gg()[(size_t)row * 8 + lane] = -gn.alog * sp; }
        else a.bb()[(size_t)row * 8 + lane - 8] = 1.f / (1.f + expf(-v));
    }
    __builtin_amdgcn_sched_barrier(0);
    float qa[8], cv[8], kr[8];
    bf8_to_f32(tk.qa, qa); bf8_to_f32(tk.cv, cv); bf8_to_f32(tk.kr, kr);
    float s1 = 0.f, s2 = 0.f, s3 = 0.f;
#pragma unroll
    for (int e = 0; e < 8; ++e) { s1 += qa[e] * qa[e]; s2 += cv[e] * cv[e]; s3 += kr[e] * kr[e]; }
#pragma unroll
    for (int o = 1; o < 64; o <<= 1) { s1 += __shfl_xor(s1, o); s2 += __shfl_xor(s2, o); s3 += __shfl_xor(s3, o); }
    const float r1 = rsqrtf(s1 * (1.f / 384.f) + EPSV), r2 = rsqrtf(s2 * (1.f / 256.f) + EPSV), r3 = rsqrtf(s3 * (1.f / 32.f) + EPSV);
    if (lane < 48) {
        float o[8];
#pragma unroll
        for (int e = 0; e < 8; ++e) o[e] = qa[e] * r1 * gn.gqa[e];
        *(bf16x8*)(a.qan() + (size_t)row * 384 + 8 * lane) = f32_to_bf8(o);
    }
    if (lane < 32) {
        float o[8];
#pragma unroll
        for (int e = 0; e < 8; ++e) o[e] = cv[e] * r2 * gn.gkv[e];
        *(bf16x8*)(a.ckvb() + (size_t)row * 256 + 8 * lane) = f32_to_bf8(o);
        float* co = samp ? a.out + O_CKVS + (size_t)b * 256 + 8 * lane : a.out + O_CKVP + (size_t)row * 256 + 8 * lane;
        *(float4*)co = (float4){o[0], o[1], o[2], o[3]}; *(float4*)(co + 4) = (float4){o[4], o[5], o[6], o[7]};
    }
    __builtin_amdgcn_sched_barrier(0);
    {
        const int c4 = (lane - 32) & 3;
        float xn[8], ot[8];
#pragma unroll
        for (int e = 0; e < 8; ++e) xn[e] = kr[e] * r3 * gn.gkr[e];
#pragma unroll
        for (int e = 0; e < 8; ++e) ot[e] = __shfl_xor(xn[e], 2);
        if (lane >= 32 && lane < 36) {
            const float* tb = a.ropecs() + (size_t)(samp ? 2048 : t) * 32 + ((8 * c4) & 15);
            const float4 c0 = *(const float4*)tb, c1 = *(const float4*)(tb + 4), s0 = *(const float4*)(tb + 16), s1 = *(const float4*)(tb + 20);
            const float csv[8] = {c0.x, c0.y, c0.z, c0.w, c1.x, c1.y, c1.z, c1.w}, snv[8] = {s0.x, s0.y, s0.z, s0.w, s1.x, s1.y, s1.z, s1.w};
            float o[8];
#pragma unroll
            for (int e = 0; e < 8; ++e) o[e] = c4 < 2 ? xn[e] * csv[e] - ot[e] * snv[e] : ot[e] * snv[e] + xn[e] * csv[e];
            float* kf_ = a.krf() + (size_t)row * 32 + 8 * c4; *(float4*)kf_ = (float4){o[0], o[1], o[2], o[3]}; *(float4*)(kf_ + 4) = (float4){o[4], o[5], o[6], o[7]};
            float* ko = samp ? a.out + O_KRS + (size_t)b * 32 + 8 * c4 : a.out + O_KRP + (size_t)row * 32 + 8 * c4;
            *(float4*)ko = (float4){o[0], o[1], o[2], o[3]}; *(float4*)(ko + 4) = (float4){o[4], o[5], o[6], o[7]};
            if (!samp) *(bf16x8*)(a.krb() + (size_t)row * 32 + 8 * c4) = f32_to_bf8(o);
        }
    }
    (void)hd;
}
__device__ __forceinline__ void post_in_run(const MK& a, int run, int lane_in, const float* wcs) {
    int lane = lane_in; asm volatile("" : "+v"(lane));
    PinGain gn;
    {
        const int lq = lane < 48 ? lane : 0, lk = lane < 32 ? lane : 0, c4 = (lane - 32) & 3;
#pragma unroll
        for (int e = 0; e < 8; ++e) { gn.gqa[e] = a.g_q_a[8 * lq + e]; gn.gkv[e] = a.g_kv_a[8 * lk + e]; gn.gkr[e] = a.g_k_rope[8 * c4 + e]; }
        gn.dtb = a.dt_bias[lane & 7]; gn.alog = expf(a.a_log[lane & 7]);
    }
    if (run < NPT / 8) {
        const int row0 = run * 8, t0 = row0 & 2047;
        bf16x8 w0[3], w1[3], w2[3], wcur[3];
#pragma unroll
        for (int c3 = 0; c3 < 3; ++c3) {
            const bf16x8 zz = {0, 0, 0, 0, 0, 0, 0, 0}; w0[c3] = zz; w1[c3] = zz; w2[c3] = zz;
            if (t0 > 0) { const bf16_t* zp = a.Z() + (size_t)(row0 - 3) * ZW + 512 * c3 + 8 * lane; w0[c3] = *(const bf16x8*)zp; w1[c3] = *(const bf16x8*)(zp + ZW); w2[c3] = *(const bf16x8*)(zp + 2 * ZW); }
        }
        bf16x8 wnext[3]; PinTok tk, tkn;
#pragma unroll
        for (int c3 = 0; c3 < 3; ++c3) wnext[c3] = *(const bf16x8*)(a.Z() + (size_t)row0 * ZW + 512 * c3 + 8 * lane);
        tkn = pin_load(a, row0, lane);
#pragma unroll 1
        for (int k = 0; k < 8; ++k) {
            const int row = row0 + k;
#pragma unroll
            for (int c3 = 0; c3 < 3; ++c3) wcur[c3] = wnext[c3];
            tk = tkn;
            if (k < 7) {
#pragma unroll
                for (int c3 = 0; c3 < 3; ++c3) wnext[c3] = *(const bf16x8*)(a.Z() + (size_t)(row + 1) * ZW + 512 * c3 + 8 * lane);
                tkn = pin_load(a, row + 1, lane);
            }
            post_in_token(a, row, lane, wcs, w0, w1, w2, wcur, tk, gn);
#pragma unroll
            for (int c3 = 0; c3 < 3; ++c3) { w0[c3] = w1[c3]; w1[c3] = w2[c3]; w2[c3] = wcur[c3]; }
        }
    } else {
        {
            const int bsm = run - NPT / 8, row = NPT + bsm;
            bf16x8 w0[3], w1[3], w2[3], wcur[3];
#pragma unroll
            for (int c3 = 0; c3 < 3; ++c3) {
                const float* sp = a.state_conv + (size_t)bsm * 3 * 1536 + 512 * c3 + 8 * lane;
                float* cso = a.out + O_CSS + (size_t)bsm * 3 * 1536 + 512 * c3 + 8 * lane;
                float t0_[8], t1_[8], t2_[8], tc_[8];
#pragma unroll
                for (int e = 0; e < 8; ++e) { t0_[e] = sp[e]; t1_[e] = sp[1536 + e]; t2_[e] = sp[2 * 1536 + e]; }
                wcur[c3] = *(const bf16x8*)(a.Z() + (size_t)row * ZW + 512 * c3 + 8 * lane); bf8_to_f32(wcur[c3], tc_);
#pragma unroll
                for (int e = 0; e < 8; ++e) { cso[e] = t1_[e]; cso[1536 + e] = t2_[e]; cso[2 * 1536 + e] = tc_[e]; }
                w0[c3] = f32_to_bf8(t0_); w1[c3] = f32_to_bf8(t1_); w2[c3] = f32_to_bf8(t2_);
            }
            post_in_token(a, row, lane, wcs, w0, w1, w2, wcur, pin_load(a, row, lane), gn);
        }
    }
}

__device__ __forceinline__ void post_q_item(const MK& a, int idx, int lane) {
    const int row = idx >> 3, h = idx & 7;
    const float* q = a.Q() + (size_t)row * 768 + h * 96;
    float* o = a.qh() + ((size_t)row * 8 + h) * 96;
    const float v = q[lane];
    const float ss = wave_sum(v * v);
    o[lane] = v * rsqrtf(ss * (1.f / 64.f) + EPSV) * a.g_q_nope[lane];
    const float r = lane < 32 ? q[64 + lane] : 0.f;
    const float s2 = wave_sum(r * r);
    const float xn = lane < 32 ? r * rsqrtf(s2 * (1.f / 32.f) + EPSV) * a.g_q_rope[lane] : 0.f;
    const float other = __shfl_xor(xn, 16);
    const int i = lane & 15;
    const float* tb = a.ropecs() + (size_t)(row >= NPT ? 2048 : (row & 2047)) * 32;
    const float cs = tb[i], sn = tb[16 + i];
    const float ov = lane < 16 ? xn * cs - other * sn : other * sn + xn * cs;
    if (lane < 32) o[64 + lane] = ov;
}
__device__ __forceinline__ void post_kv_item(const MK& a, int idx, int lane) {
    const int row = idx >> 3, h = idx & 7;
    const float v = a.KV()[(size_t)row * 1024 + h * 128 + lane];
    const float ss = wave_sum(v * v);
    const float kn = v * rsqrtf(ss * (1.f / 64.f) + EPSV) * a.g_k_nope[lane];
    a.kh()[((size_t)row * 8 + h) * 64 + lane] = kn;
}

typedef float f32x16 __attribute__((ext_vector_type(16)));
typedef short s16x4 __attribute__((ext_vector_type(4)));
#define KST 104
#define VST 72
#define ATT_BUF (64 * KST * 2 + 64 * VST * 2)
__device__ __forceinline__ int crow32(int r, int hi) { return (r & 3) + 8 * (r >> 2) + 4 * hi; }
__device__ __forceinline__ s16x4 tr_read(const bf16_t* p) { return __builtin_bit_cast(s16x4, __builtin_amdgcn_ds_read_tr16_b64_v4i16((LAS s16x4*)(LAS void*)(unsigned)(size_t)p)); }
__device__ __forceinline__ bf16x8 pack8(const f32x16& x, int s) {
    u32x4 w; w.x = pk2bf(x[8 * s], x[8 * s + 1]); w.y = pk2bf(x[8 * s + 2], x[8 * s + 3]); w.z = pk2bf(x[8 * s + 4], x[8 * s + 5]); w.w = pk2bf(x[8 * s + 6], x[8 * s + 7]);
    return __builtin_bit_cast(bf16x8, w);
}
__device__ __forceinline__ void attn_block(const MK& a, int b, int h, int qb, char* smem) {
    const int tid = otid(), lane = tid & 63, wid = tid >> 6, r32 = lane & 31, hi = lane >> 5;
    const int qrow = qb * 256 + wid * 32 + r32;
    const int wq0 = qb * 256 + wid * 32;
    bf16x8 qf[6];
    {
        const float SCL = 0.14724445f;
        const bf16_t* Qg = a.qraw() + ((size_t)b * SEQ + qrow) * 768 + h * 96 + 8 * hi;
        float qv[6][8];
#pragma unroll
        for (int ds = 0; ds < 6; ++ds) bf8_to_f32(*(const bf16x8*)(Qg + 16 * ds), qv[ds]);
        float sn_ = 0.f, sr_ = 0.f;
#pragma unroll
        for (int j = 0; j < 8; ++j) { sn_ += qv[0][j] * qv[0][j] + qv[1][j] * qv[1][j] + qv[2][j] * qv[2][j] + qv[3][j] * qv[3][j]; sr_ += qv[4][j] * qv[4][j] + qv[5][j] * qv[5][j]; }
        sn_ += __shfl_xor(sn_, 32); sr_ += __shfl_xor(sr_, 32);
        const float rsn = rsqrtf(sn_ * (1.f / 64.f) + EPSV) * SCL, rsr = rsqrtf(sr_ * (1.f / 32.f) + EPSV);
#pragma unroll
        for (int ds = 0; ds < 4; ++ds) {
            float o[8];
#pragma unroll
            for (int j = 0; j < 8; ++j) o[j] = qv[ds][j] * rsn * a.g_q_nope[16 * ds + 8 * hi + j];
            qf[ds] = f32_to_bf8(o);
        }
        const float* tb = a.ropecs() + (size_t)qrow * 32 + 8 * hi;
        float o4[8], o5[8];
#pragma unroll
        for (int j = 0; j < 8; ++j) {
            const float x1 = qv[4][j] * rsr * a.g_q_rope[8 * hi + j], x2 = qv[5][j] * rsr * a.g_q_rope[16 + 8 * hi + j], cs = tb[j], sn = tb[16 + j];
            o4[j] = (x1 * cs - x2 * sn) * SCL; o5[j] = (x1 * sn + x2 * cs) * SCL;
        }
        qf[4] = f32_to_bf8(o4); qf[5] = f32_to_bf8(o5);
    }
    f32x16 o0, o1;
#pragma unroll
    for (int r = 0; r < 16; ++r) { o0[r] = 0.f; o1[r] = 0.f; }
    float m = -INFINITY, l = 0.f;
    const int nt = qb * 4 + 4;
    const int vr = tid >> 3, vc = tid & 7, rr_ = (tid >> 2) & 63, rc = tid & 3;
    const bf16_t* KVg = a.kvraw() + (size_t)b * SEQ * 1024 + h * 128 + (size_t)vr * 1024 + vc * 8;
    const bf16_t* KRg = a.krb() + (size_t)b * SEQ * 32 + (size_t)rr_ * 32 + rc * 8;
    float gk[8];
#pragma unroll
    for (int j = 0; j < 8; ++j) gk[j] = a.g_k_nope[8 * vc + j];
    bf16x8 kr0, kr1, vr0;
#define ATT_LOAD(tt) do { kr0 = *(const bf16x8*)(KVg + (size_t)(tt) * 64 * 1024); vr0 = *(const bf16x8*)(KVg + (size_t)(tt) * 64 * 1024 + 64); if (tid < 256) kr1 = *(const bf16x8*)(KRg + (size_t)(tt) * 64 * 32); } while (0)
#define ATT_STORE(buf) do { bf16_t* Ks_ = (bf16_t*)(smem + (buf) * ATT_BUF); bf16_t* Vs_ = Ks_ + 64 * KST; \
        float x_[8]; bf8_to_f32(kr0, x_); float ss_ = 0.f; _Pragma("unroll") for (int j = 0; j < 8; ++j) ss_ += x_[j] * x_[j]; \
        ss_ += __shfl_xor(ss_, 1); ss_ += __shfl_xor(ss_, 2); ss_ += __shfl_xor(ss_, 4); const float rs_ = rsqrtf(ss_ * (1.f / 64.f) + EPSV); \
        _Pragma("unroll") for (int j = 0; j < 8; ++j) x_[j] *= rs_ * gk[j]; \
        *(bf16x8*)(Ks_ + vr * KST + vc * 8) = f32_to_bf8(x_); *(bf16x8*)(Vs_ + vr * VST + vc * 8) = vr0; \
        if (tid < 256) *(bf16x8*)(Ks_ + rr_ * KST + 64 + rc * 8) = kr1; } while (0)
    ATT_LOAD(0);
    __syncthreads();
    ATT_STORE(0);
    __syncthreads();
    const int i16 = lane & 15, qq = i16 >> 2, pp = i16 & 3, g1 = (lane >> 4) & 1;
    for (int t = 0; t < nt; ++t) {
        const bf16_t* Ks = (const bf16_t*)(smem + (t & 1) * ATT_BUF); const bf16_t* Vs = Ks + 64 * KST;
        if (t + 1 < nt) ATT_LOAD(t + 1);
        if (64 * t <= wq0 + 31) {
            f32x16 p0, p1;
#pragma unroll
            for (int r = 0; r < 16; ++r) { p0[r] = 0.f; p1[r] = 0.f; }
#pragma unroll
            for (int ds = 0; ds < 6; ++ds) {
                const bf16x8 k0 = *(const bf16x8*)(Ks + r32 * KST + 16 * ds + 8 * hi);
                const bf16x8 k1 = *(const bf16x8*)(Ks + (32 + r32) * KST + 16 * ds + 8 * hi);
                p0 = __builtin_amdgcn_mfma_f32_32x32x16_bf16(k0, qf[ds], p0, 0, 0, 0);
                p1 = __builtin_amdgcn_mfma_f32_32x32x16_bf16(k1, qf[ds], p1, 0, 0, 0);
            }
            if (64 * t + 63 > wq0) {
#pragma unroll
                for (int r = 0; r < 16; ++r) { const int kv = 64 * t + crow32(r, hi); if (kv > qrow) p0[r] = -INFINITY; if (kv + 32 > qrow) p1[r] = -INFINITY; }
            }
            float mx = fmaxf(p0[0], p1[0]);
#pragma unroll
            for (int r = 1; r < 16; ++r) mx = fmaxf(mx, fmaxf(p0[r], p1[r]));
            mx = fmaxf(mx, __shfl_xor(mx, 32));
            const float mn = fmaxf(m, mx);
            const float alpha = __builtin_amdgcn_exp2f(m - mn);
            m = mn;
            float rs = 0.f;
#pragma unroll
            for (int r = 0; r < 16; ++r) { p0[r] = __builtin_amdgcn_exp2f(p0[r] - mn); p1[r] = __builtin_amdgcn_exp2f(p1[r] - mn); rs += p0[r] + p1[r]; }
            l = l * alpha + rs;
#pragma unroll
            for (int r = 0; r < 16; ++r) { o0[r] *= alpha; o1[r] *= alpha; }
            bf16x8 pf[4];
            pf[0] = pack8(p0, 0); pf[1] = pack8(p0, 1); pf[2] = pack8(p1, 0); pf[3] = pack8(p1, 1);
#pragma unroll
            for (int ks = 0; ks < 4; ++ks) {
                const bf16_t* vb0 = Vs + (16 * ks + 4 * hi + qq) * VST + 16 * g1 + 4 * pp;
                const s16x4 a0 = tr_read(vb0), a1 = tr_read(vb0 + 8 * VST);
                const s16x4 c0 = tr_read(vb0 + 32), c1 = tr_read(vb0 + 8 * VST + 32);
                const bf16x8 va = __builtin_shufflevector(a0, a1, 0, 1, 2, 3, 4, 5, 6, 7);
                const bf16x8 vc_ = __builtin_shufflevector(c0, c1, 0, 1, 2, 3, 4, 5, 6, 7);
                o0 = __builtin_amdgcn_mfma_f32_32x32x16_bf16(va, pf[ks], o0, 0, 0, 0);
                o1 = __builtin_amdgcn_mfma_f32_32x32x16_bf16(vc_, pf[ks], o1, 0, 0, 0);
            }
        }
        if (t + 1 < nt) ATT_STORE((t + 1) & 1);
        __syncthreads();
    }
    l += __shfl_xor(l, 32);
    const float il = 1.f / l;
    bf16_t* op = a.omix() + ((size_t)b * SEQ + qrow) * 1024 + 512 + h * 64;
#pragma unroll
    for (int g = 0; g < 4; ++g) {
        uint2 w0, w1;
        w0.x = pk2bf(o0[4 * g] * il, o0[4 * g + 1] * il); w0.y = pk2bf(o0[4 * g + 2] * il, o0[4 * g + 3] * il);
        w1.x = pk2bf(o1[4 * g] * il, o1[4 * g + 1] * il); w1.y = pk2bf(o1[4 * g + 2] * il, o1[4 * g + 3] * il);
        *(uint2*)(op + 8 * g + 4 * hi) = w0;
        *(uint2*)(op + 32 + 8 * g + 4 * hi) = w1;
    }
#undef ATT_LOAD
#undef ATT_STORE
}

__device__ __forceinline__ void gdn_unit(const MK& a, int b, int h, int dvg, const float* s0, float* sout, int row0, int T, int lane, char* wsm) {
    float (*sq)[64] = (float (*)[64])wsm;
    float (*sk)[64] = (float (*)[64])(wsm + 4096);
    float (*sv)[8] = (float (*)[8])(wsm + 8192);
    float* sg = (float*)(wsm + 8704);
    float* sb = (float*)(wsm + 8768);
    const int e = lane & 7, ko = lane >> 3, col = dvg * 8 + e;
    float S[8];
#pragma unroll
    for (int d = 0; d < 8; ++d) S[d] = s0 ? s0[(((size_t)b * 8 + h) * 64 + ko * 8 + d) * 64 + col] : 0.f;
    const size_t rbase = (size_t)row0 + (size_t)b * T;
    float pq[16], pk[16], pv0, pv1, pgb;
    {
        const int nt = T < 16 ? T : 16;
#pragma unroll
        for (int j = 0; j < 16; ++j) { const bool ok = j < nt; const size_t r = rbase + (ok ? j : 0); pq[j] = ok ? bf2f(a.qkv()[r * 1536 + h * 64 + lane]) : 0.f; pk[j] = ok ? bf2f(a.qkv()[r * 1536 + 512 + h * 64 + lane]) : 0.f; }
        { const int j0 = lane >> 3, j1 = j0 + 8; pv0 = j0 < nt ? bf2f(a.qkv()[(rbase + j0) * 1536 + 1024 + h * 64 + dvg * 8 + (lane & 7)]) : 0.f; pv1 = j1 < nt ? bf2f(a.qkv()[(rbase + j1) * 1536 + 1024 + h * 64 + dvg * 8 + (lane & 7)]) : 0.f; }
        { const int j = lane & 15; pgb = j < nt ? (lane < 16 ? a.gg()[(rbase + j) * 8 + h] : a.bb()[(rbase + j) * 8 + h]) : 0.f; }
    }
    for (int t0 = 0; t0 < T; t0 += 16) {
        const int nt = (T - t0) < 16 ? (T - t0) : 16;
        WSYNC();
#pragma unroll
        for (int j = 0; j < 16; ++j) { sq[j][lane] = pq[j]; sk[j][lane] = pk[j]; }
        sv[lane >> 3][lane & 7] = pv0; sv[(lane >> 3) + 8][lane & 7] = pv1;
        if (lane < 16) sg[lane] = expf(pgb); else if (lane < 32) sb[lane - 16] = pgb;
        WSYNC();
        if (t0 + 16 < T) {
            const size_t rb = rbase + t0 + 16;
#pragma unroll
            for (int j = 0; j < 16; ++j) { pq[j] = bf2f(a.qkv()[(rb + j) * 1536 + h * 64 + lane]); pk[j] = bf2f(a.qkv()[(rb + j) * 1536 + 512 + h * 64 + lane]); }
            pv0 = bf2f(a.qkv()[(rb + (lane >> 3)) * 1536 + 1024 + h * 64 + dvg * 8 + (lane & 7)]); pv1 = bf2f(a.qkv()[(rb + (lane >> 3) + 8) * 1536 + 1024 + h * 64 + dvg * 8 + (lane & 7)]);
            pgb = lane < 16 ? a.gg()[(rb + (lane & 15)) * 8 + h] : a.bb()[(rb + (lane & 15)) * 8 + h];
        }
        for (int j = 0; j < nt; ++j) {
            const float dec = sg[j], be = sb[j], v = sv[j][e];
            const float4 k0 = *(const float4*)&sk[j][ko * 8], k1 = *(const float4*)&sk[j][ko * 8 + 4];
            const float4 q0 = *(const float4*)&sq[j][ko * 8], q1 = *(const float4*)&sq[j][ko * 8 + 4];
            const float kk[8] = {k0.x, k0.y, k0.z, k0.w, k1.x, k1.y, k1.z, k1.w};
            const float qq[8] = {q0.x, q0.y, q0.z, q0.w, q1.x, q1.y, q1.z, q1.w};
            float ks = 0.f;
#pragma unroll
            for (int d = 0; d < 8; ++d) { S[d] *= dec; ks += kk[d] * S[d]; }
            ks += __shfl_xor(ks, 8); ks += __shfl_xor(ks, 16); ks += __shfl_xor(ks, 32);
            const float delta = (v - ks) * be;
            float ov = 0.f;
#pragma unroll
            for (int d = 0; d < 8; ++d) { S[d] += kk[d] * delta; ov += qq[d] * S[d]; }
            ov += __shfl_xor(ov, 8); ov += __shfl_xor(ov, 16); ov += __shfl_xor(ov, 32);
            if (ko == 0) a.goraw()[(rbase + t0 + j) * 512 + h * 64 + col] = ov;
        }
    }
#pragma unroll
    for (int d = 0; d < 8; ++d) sout[(((size_t)b * 8 + h) * 64 + ko * 8 + d) * 64 + col] = S[d];
}
__device__ __forceinline__ bf16x8 ld8_f32_bf16(const float* p) {
    const float4 x = *(const float4*)p, y = *(const float4*)(p + 4);
    u32x4 w; w.x = cvtpk(x.x, x.y); w.y = cvtpk(x.z, x.w); w.z = cvtpk(y.x, y.y); w.w = cvtpk(y.z, y.w);
    return __builtin_bit_cast(bf16x8, w);
}
__device__ __forceinline__ int pi_pos(int k) { return (k & 32) + 8 * ((k >> 2) & 3) + 4 * ((k >> 4) & 1) + (k & 3); }
#define GDN_WLDS 17408
__device__ __forceinline__ void gdn_prep_unit(const MK& a, int u, int lane_in, char* wsm) {
    int lane = lane_in; asm volatile("" : "+v"(lane));
    const int bh = u >> 5, n = u & 31, b = bh >> 3, h = bh & 7, i16 = lane & 15, q4 = lane >> 4;
    const size_t row0 = (size_t)b * SEQ + n * 64;
    float* AT = (float*)wsm; float* GC = (float*)(wsm + 16384); float* BT = GC + 64;
    const bf16_t* qbase = a.qkv() + row0 * 1536 + h * 64; const bf16_t* kbase = qbase + 512; const bf16_t* vbase = qbase + 1024;
    float g = a.gg()[(row0 + lane) * 8 + h];
    const float be_l = a.bb()[(row0 + lane) * 8 + h];
#pragma unroll
    for (int o = 1; o < 64; o <<= 1) { const float t = __shfl_up(g, o); if (lane >= o) g += t; }
    WSYNC();
    GC[lane] = g; BT[lane] = be_l;
    WSYNC();
    const float gl = GC[63];
    float* EG = BT + 64; float* ED = EG + 64;
    EG[lane] = expf(g); ED[lane] = expf(gl - g);
    WSYNC();
    bf16x8 kf[4][2], qf[4][2];
#pragma unroll
    for (int mt = 0; mt < 4; ++mt)
#pragma unroll
        for (int ks = 0; ks < 2; ++ks) {
            const int off = (16 * mt + i16) * 1536 + 32 * ks + 8 * q4;
            kf[mt][ks] = *(const bf16x8*)(kbase + off); qf[mt][ks] = *(const bf16x8*)(qbase + off);
        }
    bf16_t* QKg = a.gQK() + (size_t)u * 4096;
#pragma unroll
    for (int mt = 0; mt < 4; ++mt)
#pragma unroll
        for (int nt = 0; nt < 4; ++nt) {
            const int j = 16 * nt + i16, pj = 32 * (nt >> 1) + 8 * (i16 >> 2) + 4 * (nt & 1) + (i16 & 3);
            if (nt <= mt) {
                f32x4 d1 = {0.f, 0.f, 0.f, 0.f}, d2 = {0.f, 0.f, 0.f, 0.f};
#pragma unroll
                for (int ks = 0; ks < 2; ++ks) {
                    d1 = __builtin_amdgcn_mfma_f32_16x16x32_bf16(kf[mt][ks], kf[nt][ks], d1, 0, 0, 0);
                    d2 = __builtin_amdgcn_mfma_f32_16x16x32_bf16(qf[mt][ks], kf[nt][ks], d2, 0, 0, 0);
                }
                const float gcj = GC[j];
#pragma unroll
                for (int r = 0; r < 4; ++r) {
                    const int i = 16 * mt + 4 * q4 + r;
                    const float dec = __builtin_amdgcn_exp2f(1.44269504f * (GC[i] - gcj));
                    AT[i * 64 + j] = (i > j) ? BT[i] * d1[r] * dec : 0.f;
                    QKg[i * 64 + (((pj >> 3) ^ (i & 7)) << 3) + (pj & 7)] = f2bf((i >= j) ? d2[r] * dec : 0.f);
                }
            } else {
#pragma unroll
                for (int r = 0; r < 4; ++r) { const int i = 16 * mt + 4 * q4 + r; QKg[i * 64 + (((pj >> 3) ^ (i & 7)) << 3) + (pj & 7)] = 0; }
            }
        }
    {
        bf16_t* Qgg = a.gQg() + (size_t)u * 4096;
#pragma unroll
        for (int mt = 0; mt < 4; ++mt) {
            const int i = 16 * mt + i16; const float e = EG[i];
#pragma unroll
            for (int ks = 0; ks < 2; ++ks) {
                float x[8]; bf8_to_f32(qf[mt][ks], x);
                uint2 w0, w1; w0.x = cvtpk(x[0] * e, x[1] * e); w0.y = cvtpk(x[2] * e, x[3] * e); w1.x = cvtpk(x[4] * e, x[5] * e); w1.y = cvtpk(x[6] * e, x[7] * e);
                const int p0 = 32 * ks + 16 * (q4 & 1) + 4 * (q4 >> 1);
                *(uint2*)(Qgg + i * 64 + (((p0 >> 3) ^ (i & 7)) << 3) + (p0 & 7)) = w0; *(uint2*)(Qgg + i * 64 + ((((p0 >> 3) + 1) ^ (i & 7)) << 3) + (p0 & 7)) = w1;
            }
        }
    }
    WSYNC();
    __builtin_amdgcn_sched_barrier(0);
    {
        float U[64];
#pragma unroll
        for (int i = 0; i < 64; ++i) { U[i] = bf2f(vbase[i * 1536 + lane]) * BT[i]; }
#pragma unroll
        for (int i = 1; i < 64; ++i) {
            float su = 0.f;
#pragma unroll
            for (int j4 = 0; j4 < i; j4 += 4) {
                const float4 av = *(const float4*)(AT + i * 64 + j4);
                su += av.x * U[j4];
                if (j4 + 1 < i) su += av.y * U[j4 + 1];
                if (j4 + 2 < i) su += av.z * U[j4 + 2];
                if (j4 + 3 < i) su += av.w * U[j4 + 3];
            }
            U[i] -= su;
            __builtin_amdgcn_sched_barrier(0);
        }
        float* UTg = a.gUT() + ((size_t)u * 64 + lane) * 64;
#pragma unroll
        for (int i = 0; i < 64; i += 4) *(float4*)(UTg + 4 * ((i >> 2) ^ (lane & 15))) = (float4){U[i], U[i + 1], U[i + 2], U[i + 3]};
    }
    asm volatile("" ::: "memory");
    __builtin_amdgcn_sched_barrier(0);
    {
        float W[64];
#pragma unroll
        for (int i = 0; i < 64; ++i) { W[i] = bf2f(kbase[i * 1536 + lane]); }
        bf16_t* Kdg = a.gKd() + ((size_t)u * 64 + lane) * 64;
#pragma unroll
        for (int pc = 0; pc < 8; ++pc) {
            float t[8];
#pragma unroll
            for (int jj = 0; jj < 8; ++jj) { const int j = 32 * (pc >> 2) + 16 * (jj >> 2) + 4 * (pc & 3) + (jj & 3); t[jj] = W[j] * ED[j]; }
            u32x4 w; w.x = cvtpk(t[0], t[1]); w.y = cvtpk(t[2], t[3]); w.z = cvtpk(t[4], t[5]); w.w = cvtpk(t[6], t[7]);
            *(u32x4*)(Kdg + 8 * (pc ^ (lane & 7))) = w;
        }
#pragma unroll
        for (int i = 0; i < 64; ++i) W[i] *= BT[i] * EG[i];
#pragma unroll
        for (int i = 1; i < 64; ++i) {
            float sw = 0.f;
#pragma unroll
            for (int j4 = 0; j4 < i; j4 += 4) {
                const float4 av = *(const float4*)(AT + i * 64 + j4);
                sw += av.x * W[j4];
                if (j4 + 1 < i) sw += av.y * W[j4 + 1];
                if (j4 + 2 < i) sw += av.z * W[j4 + 2];
                if (j4 + 3 < i) sw += av.w * W[j4 + 3];
            }
            W[i] -= sw;
            __builtin_amdgcn_sched_barrier(0);
        }
        bf16_t* Wng = a.gWn() + (size_t)u * 4096; const int pp = pi_pos(lane);
#pragma unroll
        for (int i = 0; i < 64; ++i) Wng[i * 64 + (((pp >> 3) ^ (i & 7)) << 3) + (pp & 7)] = f2bf(-W[i]);
    }
    if (lane == 0) a.ggam()[u] = expf(gl);
}
__device__ __forceinline__ bf16x8 pack_acc2(const f32x4& x, const f32x4& y) {
    u32x4 w; w.x = cvtpk(x[0], x[1]); w.y = cvtpk(x[2], x[3]); w.z = cvtpk(y[0], y[1]); w.w = cvtpk(y[2], y[3]);
    return __builtin_bit_cast(bf16x8, w);
}
#define G2_SLOT 49152
__device__ __forceinline__ void g2_issue(const MK& a, size_t u, int n, LAS unsigned char* lds, int lw, int lane) {
    LAS unsigned char* dst = lds + (n % 3) * G2_SLOT;
    const char* srcs[4] = {(const char*)(a.gWn() + u * 4096), (const char*)(a.gQg() + u * 4096), (const char*)(a.gQK() + u * 4096), (const char*)(a.gKd() + u * 4096)};
#pragma unroll
    for (int m = 0; m < 4; ++m)
#pragma unroll
        for (int i = 0; i < 2; ++i) { const int piece = 2 * lw + i;
            __builtin_amdgcn_global_load_lds((const unsigned*)(srcs[m] + piece * 1024 + lane * 16), (LAS unsigned*)(dst + m * 8192 + piece * 1024), 16, 0, 0); }
    const char* us = (const char*)(a.gUT() + u * 4096);
#pragma unroll
    for (int i = 0; i < 4; ++i) { const int piece = 4 * lw + i;
        __builtin_amdgcn_global_load_lds((const unsigned*)(us + piece * 1024 + lane * 16), (LAS unsigned*)(dst + 32768 + piece * 1024), 16, 0, 0); }
}
__device__ __forceinline__ void gdn_scan_block(const MK& a, int bh, LAS unsigned char* lds) {
    const int tid = otid(), lane = tid & 63, wid = __builtin_amdgcn_readfirstlane(tid >> 6), i16 = lane & 15, q4 = lane >> 4;
    const int b = bh >> 3, h = bh & 7, sl = wid & 3;
    const bool loader = wid >= 4;
    f32x4 S[4];
#pragma unroll
    for (int mt = 0; mt < 4; ++mt) S[mt] = (f32x4){0.f, 0.f, 0.f, 0.f};
    __syncthreads();
    if (loader) { g2_issue(a, (size_t)bh * 32, 0, lds, wid - 4, lane); g2_issue(a, (size_t)bh * 32 + 1, 1, lds, wid - 4, lane); }
    for (int n = 0; n < 32; ++n) {
        if (loader) { if (n < 31) asm volatile("s_waitcnt vmcnt(12)" ::: "memory"); else asm volatile("s_waitcnt vmcnt(0)" ::: "memory"); }
        asm volatile("s_waitcnt lgkmcnt(0)" ::: "memory"); __builtin_amdgcn_s_barrier(); asm volatile("" ::: "memory");
        if (loader) { if (n + 2 < 32) g2_issue(a, (size_t)bh * 32 + n + 2, n + 2, lds, wid - 4, lane); }
        else {
            const LAS unsigned char* sb = lds + (n % 3) * G2_SLOT;
            const float gam = a.ggam()[(size_t)bh * 32 + n];
            bf16x8 Sb[2]; Sb[0] = pack_acc2(S[0], S[1]); Sb[1] = pack_acc2(S[2], S[3]);
            f32x4 Vn[4];
#pragma unroll
            for (int mt = 0; mt < 4; ++mt) Vn[mt] = *(const LAS f32x4*)(sb + 32768 + (16 * sl + i16) * 256 + 16 * ((4 * mt + q4) ^ i16));
#pragma unroll
            for (int mt = 0; mt < 4; ++mt)
#pragma unroll
                for (int ks = 0; ks < 2; ++ks) Vn[mt] = __builtin_amdgcn_mfma_f32_16x16x32_bf16(*(const LAS bf16x8*)(sb + (16 * mt + i16) * 128 + 16 * ((4 * ks + q4) ^ (i16 & 7))), Sb[ks], Vn[mt], 0, 0, 0);
            bf16x8 Vb[2]; Vb[0] = pack_acc2(Vn[0], Vn[1]); Vb[1] = pack_acc2(Vn[2], Vn[3]);
            f32x4 O[4];
#pragma unroll
            for (int mt = 0; mt < 4; ++mt) {
                O[mt] = (f32x4){0.f, 0.f, 0.f, 0.f};
#pragma unroll
                for (int ks = 0; ks < 2; ++ks) {
                    const int fo = (16 * mt + i16) * 128 + 16 * ((4 * ks + q4) ^ (i16 & 7));
                    O[mt] = __builtin_amdgcn_mfma_f32_16x16x32_bf16(*(const LAS bf16x8*)(sb + 8192 + fo), Sb[ks], O[mt], 0, 0, 0);
                    O[mt] = __builtin_amdgcn_mfma_f32_16x16x32_bf16(*(const LAS bf16x8*)(sb + 16384 + fo), Vb[ks], O[mt], 0, 0, 0);
                }
            }
#pragma unroll
            for (int mt = 0; mt < 4; ++mt) {
                S[mt] = S[mt] * gam;
#pragma unroll
                for (int ks = 0; ks < 2; ++ks) S[mt] = __builtin_amdgcn_mfma_f32_16x16x32_bf16(*(const LAS bf16x8*)(sb + 24576 + (16 * mt + i16) * 128 + 16 * ((4 * ks + q4) ^ (i16 & 7))), Vb[ks], S[mt], 0, 0, 0);
            }
            float* og = a.goraw() + ((size_t)b * SEQ + n * 64 + 4 * q4) * 512 + h * 64 + 16 * sl + i16;
#pragma unroll
            for (int mt = 0; mt < 4; ++mt)
#pragma unroll
                for (int r = 0; r < 4; ++r) og[(size_t)(16 * mt + r) * 512] = O[mt][r];
        }
    }
    if (!loader) {
        float* so = a.out + O_GSP + ((size_t)bh * 64 + 4 * q4) * 64 + 16 * sl + i16;
#pragma unroll
        for (int mt = 0; mt < 4; ++mt)
#pragma unroll
            for (int r = 0; r < 4; ++r) so[(size_t)(16 * mt + r) * 64] = S[mt][r];
    }
    __syncthreads();
}
__device__ __forceinline__ void gdn_out_token(const MK& a, int row, int lane) {
    const float* op = a.goraw() + (size_t)row * 512 + 8 * lane;
    const float4 x0 = *(const float4*)op, x1 = *(const float4*)(op + 4);
    float o[8] = {x0.x, x0.y, x0.z, x0.w, x1.x, x1.y, x1.z, x1.w}, zg[8];
    bf8_to_f32(*(const bf16x8*)(a.Z() + (size_t)row * ZW + OFF_Z + 8 * lane), zg);
    float ss = 0.f;
#pragma unroll
    for (int e = 0; e < 8; ++e) ss += o[e] * o[e];
    ss += __shfl_xor(ss, 1); ss += __shfl_xor(ss, 2); ss += __shfl_xor(ss, 4);
    const float rs = rsqrtf(ss * (1.f / 64.f) + EPSV);
    const float4 g0 = *(const float4*)(a.g_gdn_out + 8 * (lane & 7)), g1 = *(const float4*)(a.g_gdn_out + 8 * (lane & 7) + 4);
    const float gg_[8] = {g0.x, g0.y, g0.z, g0.w, g1.x, g1.y, g1.z, g1.w};
#pragma unroll
    for (int e = 0; e < 8; ++e) o[e] = o[e] * rs * gg_[e] * zg[e] * fast_sigmoid(zg[e]);
    *(bf16x8*)(a.omix() + (size_t)row * 1024 + 8 * lane) = f32_to_bf8(o);
}

#define SROW 1040
#define SSLOT (32 * SROW)
#define KR_OFF (4 * SSLOT)
#define WQ_OFF (KR_OFF + 4 * 4096)
#define QR_OFF (WQ_OFF + 2048)
#define PG_OFF (QR_OFF + 1024)
#define PT_OFF (PG_OFF + 64)
#define AL_OFF (PT_OFF + 1024)
#define SAMP_LDS_END (AL_OFF + 64)
__device__ __forceinline__ void samp_issue(const MK& a, int g, LAS unsigned char* lds, const int* PG, int wid, int lane) {
    const int phys = __builtin_amdgcn_readfirstlane(((const LAS int*)(lds + PG_OFF))[g >> 2]);
    const int tok0 = (g & 3) * 32 + 4 * wid, slot = g & 3;
    const float* cs = a.cache_ckv + ((size_t)phys * 128 + tok0) * 256 + lane * 4;
#pragma unroll
    for (int i = 0; i < 4; ++i) __builtin_amdgcn_global_load_lds((const unsigned*)(cs + i * 256), (LAS unsigned*)(lds + slot * SSLOT + (4 * wid + i) * SROW), 16, 0, 0);
    const float* ks = a.cache_krope + ((size_t)phys * 128 + tok0 + (lane >> 5)) * 32 + (lane & 31);
#pragma unroll
    for (int i = 0; i < 2; ++i) __builtin_amdgcn_global_load_lds((const unsigned*)(ks + i * 64), (LAS unsigned*)(lds + KR_OFF + slot * 4096 + (4 * wid + 2 * i) * 128), 4, 0, 0);
}
__device__ __forceinline__ void samp_attn_unit(const MK& a, int u, char* smem, LAS unsigned char* lds) {
    const int tid = otid(), lane = tid & 63, h = __builtin_amdgcn_readfirstlane(tid >> 6), i16 = lane & 15, q4 = lane >> 4;
    const int b = u >> 3, sp = u & 7;
    float* WQ = (float*)(smem + WQ_OFF);
    float* QR = (float*)(smem + QR_OFF);
    int* PG = (int*)(smem + PG_OFF);
    const float SCL = 0.14724445f;
    post_q_item(a, (NPT + b) * 8 + h, lane);
    __syncthreads();
    {
        const int h_ = tid >> 6, l_ = tid & 63, q4_ = l_ >> 4, idx = l_ & 15, d = 16 * (idx >> 2) + 4 * q4_ + (idx & 3);
        WQ[tid] = a.g_k_nope[d] * a.qh()[((size_t)(NPT + b) * 8 + h_) * 96 + d] * SCL;
        if (tid < 256) QR[tid] = a.qh()[((size_t)(NPT + b) * 8 + (tid >> 5)) * 96 + 64 + (tid & 31)] * SCL;
        if (tid < 16) PG[tid] = a.page_table[b * NPAGES + sp * 16 + tid];
    }
    bf16x8 wf[4][8];
#pragma unroll
    for (int mt = 0; mt < 4; ++mt)
#pragma unroll
        for (int ks = 0; ks < 8; ++ks) wf[mt][ks] = *(const bf16x8*)(a.WknT() + (size_t)(h * 64 + 16 * mt + i16) * 256 + 32 * ks + 8 * q4);
#pragma unroll
    for (int mt = 0; mt < 4; ++mt)
#pragma unroll
        for (int ks = 0; ks < 8; ++ks) asm volatile("" : "+v"(wf[mt][ks]));
    __syncthreads();
    samp_issue(a, 0, lds, PG, h, lane); samp_issue(a, 1, lds, PG, h, lane); samp_issue(a, 2, lds, PG, h, lane);
    const LAS float* QRl = (const LAS float*)(lds + QR_OFF) + h * 32 + 8 * q4;
    const LAS float* WQl = (const LAS float*)(lds + WQ_OFF) + (h * 4 + q4) * 16;
    float m = -INFINITY, lsum = 0.f;
    f32x4 latv[2]; latv[0] = (f32x4){0.f, 0.f, 0.f, 0.f}; latv[1] = (f32x4){0.f, 0.f, 0.f, 0.f};
    for (int g = 0; g < 64; ++g) {
        if (g <= 61) asm volatile("s_waitcnt vmcnt(12)" ::: "memory"); else if (g == 62) asm volatile("s_waitcnt vmcnt(6)" ::: "memory"); else asm volatile("s_waitcnt vmcnt(0)" ::: "memory");
        asm volatile("s_waitcnt lgkmcnt(0)" ::: "memory"); __builtin_amdgcn_s_barrier(); asm volatile("" ::: "memory");
        if (g + 3 < 64) samp_issue(a, g + 3, lds, PG, h, lane);
        const LAS float* Cs = (const LAS float*)(lds + (g & 3) * SSLOT); const LAS float* KR = (const LAS float*)(lds + KR_OFF + (g & 3) * 4096);
        float sc[2];
#pragma unroll
        for (int hf = 0; hf < 2; ++hf) {
            f32x4 acc[4];
#pragma unroll
            for (int mt = 0; mt < 4; ++mt) acc[mt] = (f32x4){0.f, 0.f, 0.f, 0.f};
            const LAS float* cp = Cs + (16 * hf + i16) * (SROW / 4) + 8 * q4;
#pragma unroll
            for (int ks = 0; ks < 8; ++ks) {
                const f32x4 f0 = *(const LAS f32x4*)(cp + 32 * ks), f1 = *(const LAS f32x4*)(cp + 32 * ks + 4);
                u32x4 w; w.x = cvtpk(f0[0], f0[1]); w.y = cvtpk(f0[2], f0[3]); w.z = cvtpk(f1[0], f1[1]); w.w = cvtpk(f1[2], f1[3]);
                const bf16x8 cf = __builtin_bit_cast(bf16x8, w);
#pragma unroll
                for (int mt = 0; mt < 4; ++mt) acc[mt] = __builtin_amdgcn_mfma_f32_16x16x32_bf16(wf[mt][ks], cf, acc[mt], 0, 0, 0);
            }
            float ss = 0.f, dot = 0.f, rd = 0.f;
#pragma unroll
            for (int mt = 0; mt < 4; ++mt) {
                const f32x4 wq = *(const LAS f32x4*)(WQl + 4 * mt);
                ss += acc[mt][0] * acc[mt][0] + acc[mt][1] * acc[mt][1] + acc[mt][2] * acc[mt][2] + acc[mt][3] * acc[mt][3];
                dot += acc[mt][0] * wq[0] + acc[mt][1] * wq[1] + acc[mt][2] * wq[2] + acc[mt][3] * wq[3];
            }
            {
                const LAS float* kp = KR + (16 * hf + i16) * 32 + 8 * q4;
                const f32x4 k0 = *(const LAS f32x4*)kp, k1 = *(const LAS f32x4*)(kp + 4), q0 = *(const LAS f32x4*)QRl, q1 = *(const LAS f32x4*)(QRl + 4);
                rd = k0[0] * q0[0] + k0[1] * q0[1] + k0[2] * q0[2] + k0[3] * q0[3] + k1[0] * q1[0] + k1[1] * q1[1] + k1[2] * q1[2] + k1[3] * q1[3];
            }
            ss += __shfl_xor(ss, 16); dot += __shfl_xor(dot, 16); rd += __shfl_xor(rd, 16);
            ss += __shfl_xor(ss, 32); dot += __shfl_xor(dot, 32); rd += __shfl_xor(rd, 32);
            sc[hf] = dot * rsqrtf(ss * (1.f / 64.f) + EPSV) + rd;
        }
        float gm = fmaxf(sc[0], sc[1]);
#pragma unroll
        for (int o = 1; o < 16; o <<= 1) gm = fmaxf(gm, __shfl_xor(gm, o));
        const float mn = fmaxf(m, gm);
        const float alpha = __builtin_amdgcn_exp2f(m - mn), p0 = __builtin_amdgcn_exp2f(sc[0] - mn), p1 = __builtin_amdgcn_exp2f(sc[1] - mn);
        m = mn;
        lsum = lsum * alpha + p0 + p1;
        if (q4 == 0) { ((LAS float*)(lds + PT_OFF))[h * 32 + i16] = p0; ((LAS float*)(lds + PT_OFF))[h * 32 + 16 + i16] = p1; if (i16 == 0) ((LAS float*)(lds + AL_OFF))[h] = alpha; }
        asm volatile("s_waitcnt lgkmcnt(0)" ::: "memory"); __builtin_amdgcn_s_barrier(); asm volatile("" ::: "memory");
        {
            u32x4 pw = {0u, 0u, 0u, 0u};
            if (i16 < 8) { const f32x4 pa = *(const LAS f32x4*)(lds + PT_OFF + (i16 * 32 + 8 * q4) * 4), pb_ = *(const LAS f32x4*)(lds + PT_OFF + (i16 * 32 + 8 * q4 + 4) * 4);
                pw.x = cvtpk(pa[0], pa[1]); pw.y = cvtpk(pa[2], pa[3]); pw.z = cvtpk(pb_[0], pb_[1]); pw.w = cvtpk(pb_[2], pb_[3]); }
            const bf16x8 pfr = __builtin_bit_cast(bf16x8, pw);
            const f32x4 al = *(const LAS f32x4*)(lds + AL_OFF + (q4 & 1) * 16);
#pragma unroll
            for (int nt = 0; nt < 2; ++nt) {
                const LAS float* cc = Cs + (8 * q4) * (SROW / 4) + 32 * h + 16 * nt + i16;
                u32x4 cw; cw.x = cvtpk(cc[0], cc[SROW / 4]); cw.y = cvtpk(cc[2 * (SROW / 4)], cc[3 * (SROW / 4)]); cw.z = cvtpk(cc[4 * (SROW / 4)], cc[5 * (SROW / 4)]); cw.w = cvtpk(cc[6 * (SROW / 4)], cc[7 * (SROW / 4)]);
                latv[nt] = latv[nt] * al;
                latv[nt] = __builtin_amdgcn_mfma_f32_16x16x32_bf16(pfr, __builtin_bit_cast(bf16x8, cw), latv[nt], 0, 0, 0);
            }
        }
    }
#pragma unroll
    for (int o = 1; o < 16; o <<= 1) lsum += __shfl_xor(lsum, o);
    if (lane == 0) { float* o = a.part() + ((size_t)u * 8 + h) * 260; o[0] = m * 0.69314718f; o[1] = lsum; }
    if (q4 < 2) {
#pragma unroll
        for (int nt = 0; nt < 2; ++nt)
#pragma unroll
            for (int r = 0; r < 4; ++r) a.part()[((size_t)u * 8 + 4 * q4 + r) * 260 + 4 + 32 * h + 16 * nt + i16] = latv[nt][r];
    }
}
__device__ __forceinline__ void samp_comb_unit(const MK& a, int u, char* smem) {
    float* slat = (float*)smem;
    const int b = u >> 3, h = u & 7, tid = otid() & 255;
    const size_t row = NPT + b;
    const float* q = a.qh() + (row * 8 + h) * 96;
    float s_self = 0.f;
    for (int d = 0; d < 64; ++d) s_self += q[d] * a.kh()[(row * 8 + h) * 64 + d];
    for (int d = 0; d < 32; ++d) s_self += q[64 + d] * a.krf()[row * 32 + d];
    s_self *= 0.10206207261596577f;
    float m = s_self;
    for (int s = 0; s < 8; ++s) m = fmaxf(m, a.part()[((size_t)(b * 8 + s) * 8 + h) * 260]);
    const float pself = expf(s_self - m);
    float l = pself, lat = 0.f;
    for (int s = 0; s < 8; ++s) {
        const float* p = a.part() + ((size_t)(b * 8 + s) * 8 + h) * 260;
        const float w = expf(p[0] - m);
        l += p[1] * w; lat += p[4 + tid] * w;
    }
    __syncthreads();
    slat[tid] = lat;
    __syncthreads();
    if (tid < 64) {
        float o = 0.f;
        for (int c = 0; c < 256; ++c) o += slat[c] * a.w_kv_b[(size_t)c * 1024 + h * 128 + 64 + tid];
        o += pself * a.KV()[row * 1024 + h * 128 + 64 + tid];
        a.omix()[row * 1024 + 512 + h * 64 + tid] = f2bf(o / l);
    }
}

#define XB_TMO      128
#define XB_XCNT(j)  (256  + 64 * (j))
#define XB_XSUB(j)  (1280 + 64 * (j))
#define XB_XGEN(j)  (2304 + 64 * (j))
#define XB_TOP      3328
#define XB_TOPGEN   3392
#define XCD_BAR_WORDS 3456
#define XB_SPIN_CAP (1u << 18)

__device__ __forceinline__ unsigned xb_ld(unsigned* p)              { return __hip_atomic_load(p, __ATOMIC_RELAXED, __HIP_MEMORY_SCOPE_AGENT); }
__device__ __forceinline__ unsigned xb_add(unsigned* p, unsigned v) { return __hip_atomic_fetch_add(p, v, __ATOMIC_RELAXED, __HIP_MEMORY_SCOPE_AGENT); }
__device__ __forceinline__ unsigned xb_xcc_id() { return (unsigned)__builtin_amdgcn_s_getreg((3 << 11) | 20) & 0xFu; }
#define XB_SPIN(cond, bar) do { unsigned _sp = 0; while (cond) { __builtin_amdgcn_s_sleep(1); \
    if ((++_sp & 255u) == 0u) { if (xb_ld(&(bar)[XB_TMO])) break; if (_sp > XB_SPIN_CAP) { atomicAdd(&(bar)[XB_TMO], 1u); break; } } } } while (0)

struct XcdBarrier {
    unsigned* bar; unsigned x;
    volatile LAS unsigned* st;
};

__device__ __forceinline__ XcdBarrier xcd_barrier_post(unsigned* bar, volatile LAS unsigned* st) {
    XcdBarrier b; b.bar = bar; b.x = xb_xcc_id(); b.st = st;
    if (threadIdx.x == 0) (void)xb_add(&bar[XB_XCNT(b.x)], 1u);
    return b;
}
__device__ __forceinline__ void xcd_barrier_complete(unsigned* bar, unsigned x, unsigned& nloc, unsigned& nx) {
    const unsigned G = gridDim.x * gridDim.y * gridDim.z;
    unsigned sum, cnt, mine, sp = 0u;
    for (;;) {
        sum = 0u; cnt = 0u; mine = 0u;
#pragma unroll
        for (unsigned j = 0; j < 16; ++j) { const unsigned c = xb_ld(&bar[XB_XCNT(j)]); sum += c; cnt += (c > 0u) ? 1u : 0u; mine = (j == x) ? c : mine; }
        if (sum == G) break;
        __builtin_amdgcn_s_sleep(1);
        if ((++sp & 255u) == 0u) { if (xb_ld(&bar[XB_TMO])) break; if (sp > XB_SPIN_CAP) { atomicAdd(&bar[XB_TMO], 1u); break; } }
    }
    nloc = mine > 0u ? mine : 1u; nx = cnt > 0u ? cnt : 1u;
}

__device__ __forceinline__ void xcd_barrier(const XcdBarrier& b) {
    asm volatile("s_waitcnt vmcnt(0)" ::: "memory");
    __syncthreads();
    if (threadIdx.x == 0) {
        unsigned* bar = b.bar;
        __builtin_amdgcn_s_waitcnt(0);
        unsigned nloc = b.st[0], nx = b.st[1];
        if (nloc == 0u) { xcd_barrier_complete(bar, b.x, nloc, nx); b.st[0] = nloc; b.st[1] = nx; }
        const unsigned old = xb_add(&bar[XB_XSUB(b.x)], 1u);
        const unsigned gen = old / nloc;
        if (old + 1u == (gen + 1u) * nloc) {
            __builtin_amdgcn_fence(__ATOMIC_RELEASE, "agent");
            asm volatile("s_waitcnt vmcnt(0)" ::: "memory");
            const unsigned og = xb_add(&bar[XB_TOP], 1u);
            const unsigned tg = og / nx;
            if (og + 1u == (tg + 1u) * nx) xb_add(&bar[XB_TOPGEN], 1u);
            else XB_SPIN(xb_ld(&bar[XB_TOPGEN]) == tg, bar);
            __builtin_amdgcn_fence(__ATOMIC_ACQUIRE, "agent");
            xb_add(&bar[XB_XGEN(b.x)], 1u);
            asm volatile("s_waitcnt vmcnt(0)" ::: "memory");
        } else {
            XB_SPIN(xb_ld(&bar[XB_XGEN(b.x)]) == gen, bar);
            __builtin_amdgcn_fence(__ATOMIC_ACQUIRE, "agent");
            asm volatile("s_waitcnt vmcnt(0)" ::: "memory");
        }
    }
    __syncthreads();
}

#define XB_ST_OFF 155648
#define LDS_BYTES 155904
static_assert(SAMP_LDS_END <= LDS_BYTES, "LDS map");
#define GSYNC() do { xcd_barrier(xbar); } while (0)
__global__ __launch_bounds__(NTHR, 2) void mega(MK a) {
    cg::grid_group grid = cg::this_grid();
    char* smem = (char*)lds_raw;
    LAS unsigned char* lds = (LAS unsigned char*)lds_raw;
    otid_init();
    if (threadIdx.x < 2) ((LAS unsigned*)(lds_raw + XB_ST_OFF))[threadIdx.x] = 0u;
    __syncthreads();
    const XcdBarrier xbar = xcd_barrier_post(a.ctl(), (volatile LAS unsigned*)(LAS void*)(lds_raw + XB_ST_OFF));
    const int bid = blockIdx.x, nb = gridDim.x, ngw = nb * NWAVE;
#define LOCAL_IDS const int tid = otid(), lane = tid & 63, wid = tid >> 6, half = tid >> 8, gw = bid * NWAVE + wid; (void)lane; (void)half; (void)gw; (void)wid;

    {
    LOCAL_IDS
    {
        const int T0 = 88 * 16, T1 = 24 * 6, T2 = 32 * 4, T3 = 16 * 4, T4 = 32 * 16, T5 = 176 * 16, T7 = 32 * 44, T8 = 32 * 16, T9 = 32 * 4;
        const int TT = T0 + T1 + T2 + T3 + T4 + T5 + T7 + T8 + T9;
        float* scr = (float*)(smem + wid * 8704);
        for (int it = gw; it < TT; it += ngw) {
            int r = it;
            if (r < T0) { const int nt_ = r % 88, kb = r / 88, nv = 2736 - 32 * nt_; wt_item(a.w_in, 2736, 32 * nt_, nv < 0 ? 0 : (nv > 32 ? 32 : nv), a.WinT(), 1024, 32 * nt_, 64 * kb, scr, lane); continue; } r -= T0;
            if (r < T1) { const int nt_ = r % 24, kb = r / 24; wt_item(a.w_q_b, 768, 32 * nt_, 32, a.WqbT(), 384, 32 * nt_, 64 * kb, scr, lane); continue; } r -= T1;
            if (r < T2) { const int nt_ = r % 32, kb = r / 32; wt_item(a.w_kv_b, 1024, 32 * nt_, 32, a.WkvT(), 256, 32 * nt_, 64 * kb, scr, lane); continue; } r -= T2;
            if (r < T3) { const int nt_ = r % 16, kb = r / 16, h = nt_ >> 1; wt_item(a.w_kv_b, 1024, h * 128 + 32 * (nt_ & 1), 32, a.WknT(), 256, 32 * nt_, 64 * kb, scr, lane); continue; } r -= T3;
            if (r < T4) { const int nt_ = r % 32, kb = r / 32; wt_item(a.w_o, 1024, 32 * nt_, 32, a.WoT(), 1024, 32 * nt_, 64 * kb, scr, lane); continue; } r -= T4;
            if (r < T5) { const int nt_ = r % 176, kb = r / 176, pn = nt_ >> 3, wi = nt_ & 7;
                wt_item(wi < 4 ? a.w_gate : a.w_up, DFF, pn * 128 + (wi & 3) * 32, 32, a.WguT(), 1024, 32 * nt_, 64 * kb, scr, lane); continue; } r -= T5;
            if (r < T7) { const int nt_ = r % 32, kb = r / 32; wt_item(a.w_down, 1024, 32 * nt_, 32, a.WdT(), DFF, 32 * nt_, 64 * kb, scr, lane); continue; } r -= T7;
            if (r < T8) { const int nt_ = r % 32, kb = r / 32; wt_item(a.w_ple_gate, 1024, 32 * nt_, 32, a.WpgT(), 1024, 32 * nt_, 64 * kb, scr, lane); continue; } r -= T8;
            { const int nt_ = r % 32, kb = r / 32; wt_item(a.w_ple_proj, 1024, 32 * nt_, 32, a.WppT(), 256, 32 * nt_, 64 * kb, scr, lane); }
        }
        for (int e = (bid * NTHR + tid); e < 2049 * 16; e += nb * NTHR) {
            const int pos = e >> 4, i = e & 15; const float ang = (pos == 2048 ? (float)PAST : (float)pos) * powf(10000.f, -(float)i / 16.f);
            a.ropecs()[pos * 32 + i] = cosf(ang); a.ropecs()[pos * 32 + 16 + i] = sinf(ang);
        }
        for (int row = gw; row < MPAD; row += ngw) {
            const float* src = row < NPT ? a.x_prompt + (size_t)row * 1024 : a.x_sample + (size_t)(row < NTOK ? row - NPT : 0) * 1024;
            rms1024_row(src, a.g_attn, a.xn() + (size_t)row * 1024, row >= NTOK, lane);
            ushort4 w = {0, 0, 0, 0};
            if (row < NTOK) { const float* ps = row < NPT ? a.p_prompt + (size_t)row * 256 : a.p_sample + (size_t)(row - NPT) * 256; const float4 v = *(const float4*)(ps + lane * 4); w.x = f2bf(v.x); w.y = f2bf(v.y); w.z = f2bf(v.z); w.w = f2bf(v.w); }
            *(ushort4*)(a.pb() + (size_t)row * 256 + lane * 4) = w;
            if (row >= NTOK) { for (int j = 0; j < 4; ++j) { ushort4 z = {0, 0, 0, 0}; *(ushort4*)(a.omix() + (size_t)row * 1024 + lane * 4 + 256 * j) = z; } }
        }
    }
    }
    grid.sync();
    {
    LOCAL_IDS
    pg_gemm(lds, a.xn(), a.WinT(), NPT, ZW, 1024, PgBf16{a.Z(), ZW});
    pg_gemm(lds, a.pb(), a.WppT(), NPT, 1024, 256, PgBf16{a.PP(), 1024});
    gemm_sample_rows_ks<false>(a.xn(), 1024, a.WinT(), 1024, ZW, EwBf16{a.Z(), ZW}, smem, bid, nb);
    gemm_sample_rows<false>(a.pb(), 256, a.WppT(), 256, 1024, EwBf16{a.PP(), 1024}, smem, bid, nb);
    }
    GSYNC();
    {
    LOCAL_IDS
    for (int e = tid; e < 4 * 1536 / 4; e += NTHR) ((float4*)smem)[e] = ((const float4*)a.w_conv)[e];
    __syncthreads();
    for (int run = gw; run < NPT / 8 + NST; run += ngw) post_in_run(a, run, lane, (const float*)smem);
    }
    GSYNC();
    {
    LOCAL_IDS
    for (int u = gw; u < 2048; u += ngw) gdn_prep_unit(a, u, lane, smem + wid * GDN_WLDS);
    }
    {
    LOCAL_IDS
    for (int v = gw; v < NST * 64; v += ngw) gdn_unit(a, v >> 6, (v >> 3) & 7, v & 7, a.state_gdn, a.out + O_GSS, NPT, 1, lane, smem + wid * GDN_WLDS);
    __syncthreads();
    }
    GSYNC();
    {
    LOCAL_IDS
    pg_gemm(lds, a.qan(), a.WqbT(), NPT, 768, 384, PgBf16{a.qraw(), 768});
    pg_gemm(lds, a.ckvb(), a.WkvT(), NPT, 1024, 256, PgBf16{a.kvraw(), 1024});
    gemm_sample_rows<false>(a.qan(), 384, a.WqbT(), 384, 768, EwF32{a.Q(), 768}, smem, bid, nb);
    gemm_sample_rows<false>(a.ckvb(), 256, a.WkvT(), 256, 1024, EwF32{a.KV(), 1024}, smem, bid, nb);
    for (int bh_ = nb - 1 - bid; bh_ < 64; bh_ += nb) gdn_scan_block(a, bh_, lds);
    }
    GSYNC();
    {
    LOCAL_IDS
    for (int idx = gw; idx < NST * 8; idx += ngw) { post_q_item(a, NPT * 8 + idx, lane); post_kv_item(a, NPT * 8 + idx, lane); }
    for (int row = gw; row < NTOK; row += ngw) gdn_out_token(a, row, lane);
    for (int pr = bid; pr < 256; pr += nb) { const int bh_ = pr >> 2, s_ = pr & 3; attn_block(a, bh_ >> 3, bh_ & 7, 7 - s_, smem); attn_block(a, bh_ >> 3, bh_ & 7, s_, smem); }
    for (int u = bid; u < NST * 8; u += nb) samp_attn_unit(a, u, smem, lds);
    }
    GSYNC();
    {
    LOCAL_IDS
    for (int u0 = bid * 2; u0 < NST * 8; u0 += nb * 2) samp_comb_unit(a, u0 + half, smem + half * 4096);
    }
    GSYNC();
    {
    LOCAL_IDS
    pg_gemm(lds, a.omix(), a.WoT(), NPT, 1024, 1024, PgResXB{a.x_prompt, a.H()});
    gemm_sample_rows_ks<false>(a.omix(), 1024, a.WoT(), 1024, 1024, EwResX{a.x_sample, a.H()}, smem, bid, nb);
    }
    GSYNC();
    {
    LOCAL_IDS
    for (int row = gw; row < MPAD; row += ngw) rms1024_row_b(a.H() + (size_t)row * 1024, a.g_ffn, a.un() + (size_t)row * 1024, row >= NTOK, lane);
    }
    GSYNC();
    {
    LOCAL_IDS
    pg_gemm(lds, a.un(), a.WguT(), NPT, 2 * DFF, 1024, PgSwiglu{a.hid()});
    gemm_sample_rows_ks<true>(a.un(), 1024, a.WguT(), 1024, 2 * DFF, EwBf16{a.hid(), DFF}, smem, bid, nb);
    }
    GSYNC();
    {
    LOCAL_IDS
    pg_gemm(lds, a.hid(), a.WdT(), NPT, 1024, DFF, PgResBB{a.H(), a.H2()});
    gemm_sample_rows_ks<false>(a.hid(), DFF, a.WdT(), DFF, 1024, EwResH{a.H(), a.H2()}, smem, bid, nb);
    }
    GSYNC();
    {
    LOCAL_IDS
    for (int row = gw; row < MPAD; row += ngw) rms1024_row_b(a.H2() + (size_t)row * 1024, a.g_ple, a.un2() + (size_t)row * 1024, row >= NTOK, lane);
    }
    GSYNC();
    {
    LOCAL_IDS
    pg_gemm(lds, a.un2(), a.WpgT(), NPT, 1024, 1024, PgPleB{a.H2(), a.PP(), a.out});
    gemm_sample_rows_ks<false>(a.un2(), 1024, a.WpgT(), 1024, 1024, EwPle{a.H2(), a.PP(), a.out}, smem, bid, nb);
    }
}

static inline char* carve(char*& p, size_t bytes) { char* r = p; p += (bytes + 255) & ~(size_t)255; return r; }

extern "C" void kernel_launch(void* const* d_in, const int* in_sizes, int n_in, void* d_out, int out_size, void* d_ws, size_t ws_size, hipStream_t stream) {
    MK a{};
    a.x_prompt = (const float*)d_in[0]; a.x_sample = (const float*)d_in[1]; a.cache_ckv = (const float*)d_in[2]; a.cache_krope = (const float*)d_in[3];
    a.state_gdn = (const float*)d_in[4]; a.state_conv = (const float*)d_in[5]; a.page_table = (const int*)d_in[6]; a.p_prompt = (const float*)d_in[7]; a.p_sample = (const float*)d_in[8];
    a.g_attn = (const float*)d_in[9]; a.w_in = (const float*)d_in[10]; a.w_conv = (const float*)d_in[11]; a.a_log = (const float*)d_in[12]; a.dt_bias = (const float*)d_in[13];
    a.g_gdn_out = (const float*)d_in[14]; a.g_q_a = (const float*)d_in[15]; a.w_q_b = (const float*)d_in[16]; a.g_q_nope = (const float*)d_in[17]; a.g_q_rope = (const float*)d_in[18];
    a.g_kv_a = (const float*)d_in[19]; a.g_k_rope = (const float*)d_in[20]; a.w_kv_b = (const float*)d_in[21]; a.g_k_nope = (const float*)d_in[22]; a.w_o = (const float*)d_in[23];
    a.g_ffn = (const float*)d_in[24]; a.w_gate = (const float*)d_in[25]; a.w_up = (const float*)d_in[26]; a.w_down = (const float*)d_in[27]; a.g_ple = (const float*)d_in[28];
    a.w_ple_gate = (const float*)d_in[29]; a.w_ple_proj = (const float*)d_in[30];
    a.out = (float*)d_out;
    a.ws = (char*)d_ws;
    if (WS_TOTAL > ws_size) { fprintf(stderr, "kernel_launch: workspace too small: need %zu have %zu\n", (size_t)WS_TOTAL, ws_size); return; }

    static int grid_blocks = 0;
    if (!grid_blocks) {
        int dev = 0, cus = 0, per_cu = 0;
        (void)hipGetDevice(&dev);
        (void)hipDeviceGetAttribute(&cus, hipDeviceAttributeMultiprocessorCount, dev);
        (void)hipFuncSetAttribute((const void*)mega, hipFuncAttributeMaxDynamicSharedMemorySize, LDS_BYTES);
        (void)hipOccupancyMaxActiveBlocksPerMultiprocessor(&per_cu, (const void*)mega, NTHR, LDS_BYTES);
        if (per_cu < 1) fprintf(stderr, "kernel_launch: occupancy query says %d blocks/CU\n", per_cu);
        grid_blocks = cus;
    }
    (void)hipMemsetAsync((char*)d_ws + WOF_ctl, 0, 16384, stream);
    void* args[] = {&a};
    hipError_t e = hipLaunchCooperativeKernel((const void*)mega, dim3(grid_blocks), dim3(NTHR), args, LDS_BYTES, stream);
    if (e != hipSuccess) fprintf(stderr, "cooperative launch failed: %s (grid %d)\n", hipGetErrorString(e), grid_blocks);
}
```

```cpp
#include <hip/hip_runtime.h>
#include <stdint.h>
#include <cstdio>
#include <hip/hip_cooperative_groups.h>
namespace cg = cooperative_groups;


__device__ __forceinline__ int otid();
#define PG8_TID() otid()
namespace pg8 {
#define PG8_LAS __attribute__((address_space(3)))
typedef unsigned short bf16_t;
typedef short bf16x8 __attribute__((ext_vector_type(8)));
typedef float f32x4 __attribute__((ext_vector_type(4)));
typedef unsigned u32x4 __attribute__((ext_vector_type(4)));
constexpr int BM = 256, BK = 64, HALF = 128, HTB = HALF * BK * 2  , STAGE_BYTES = 8 * HTB, NXCD = 8, WGM = 8;

__host__ __device__ __forceinline__ int lds_byte(int r, int c) { const int st = (r >> 4) * 2 + (c >> 5), rr = r & 15, cc = c & 31, ob = rr * 64 + cc * 2; return st * 1024 + (ob ^ (((ob >> 9) & 1) << 5)); }
__host__ __device__ __forceinline__ void stage_rc(int b, int& R, int& C) { const int st = b / 1024, sb = b % 1024, swz = sb ^ (((sb >> 9) & 1) << 5); R = (st >> 1) * 16 + swz / 64; C = (st & 1) * 32 + (swz % 64) / 2; }
__host__ __device__ __forceinline__ int perm32(int rho) { const int n = rho >> 4, i = rho & 15; return 8 * (i >> 2) + 4 * n + (i & 3); }

struct Unit { int pm, pn; };
struct Gemm { const bf16_t* A; const bf16_t* Bt; int M, N, K; };

struct StaticOrder {
    int nM, nN, nwg, G, c;
    __host__ __device__ void init(int M, int N, int G_, int c_) { nM = M / BM; nN = N / BM; nwg = nM * nN; G = G_; c = c_; }
    __host__ __device__ bool next(int i, Unit& u) const {
        const long L = (long)i * G + c; if (L >= nwg) return false;
        int wgid = (int)L; { const int q = nwg / NXCD, r = nwg % NXCD, xcd = wgid % NXCD, off = wgid / NXCD; wgid = (xcd < r ? xcd * (q + 1) : r * (q + 1) + (xcd - r) * q) + off; }
        const int nig = WGM * nN, gid = wgid / nig, fm = gid * WGM, gsz = (nM - fm) < WGM ? (nM - fm) : WGM;
        u.pm = fm + ((wgid % nig) % gsz); u.pn = (wgid % nig) / gsz; return true;
    }
    __device__ __forceinline__ void a_ready(const Unit&) const {}
    __device__ __forceinline__ void done(const Unit&) const {}
};

template <class Epi, class Sched, bool ALIGN_EPI = false, bool SP2 = false>
__device__ __forceinline__ void gemm_phase(PG8_LAS unsigned char* lds, const Gemm g, const Sched& S, const Epi& E) {
    const int tid = PG8_TID(), wid = __builtin_amdgcn_readfirstlane(tid >> 6), lane = tid & 63, wr = wid >> 2, wc = wid & 3, fr = lane & 15, fq = lane >> 4;
    const int K = g.K, nt = K / BK;
    unsigned voffA[2], voffB[2];
#pragma unroll
    for (int i = 0; i < 2; ++i) { int R, C; stage_rc(tid * 16 + i * 8192, R, C); const int Rb = Epi::PERM ? ((R & ~31) + perm32(R & 31)) : R;
        voffA[i] = (unsigned)(R * K + C) * 2u; voffB[i] = (unsigned)(Rb * K + C) * 2u; }
    const size_t kstep = (size_t)(BK * 2);
    const size_t hstep = (size_t)HALF * K * 2;
    const size_t tstep = 2 * hstep;
    const unsigned ldsw = (unsigned)wid * 1024u;
    const int aoff = lds_byte(wr * 64 + fr, fq * 8), boff = lds_byte(wc * 32 + fr, fq * 8);
#define PG8_SA(b, h) (((b) * 2 + (h)) * HTB)
#define PG8_SB(b, h) ((4 + (b) * 2 + (h)) * HTB)
#define PG8_STAGE(bufoff, gbase, voff) do { _Pragma("unroll") for (int _i = 0; _i < 2; ++_i) \
        __builtin_amdgcn_global_load_lds((const unsigned*)((const char*)(gbase) + (voff)[_i]), (PG8_LAS unsigned*)(lds + (bufoff) + ldsw + _i * 8192), 16, 0, 0); } while (0)
#define PG8_LDA(dst, b, h) do { _Pragma("unroll") for (int m = 0; m < 4; ++m) _Pragma("unroll") for (int k = 0; k < 2; ++k) dst[m][k] = *(const PG8_LAS bf16x8*)(lds + PG8_SA(b, h) + aoff + m * 2048 + k * 1024); } while (0)
#define PG8_LDB(dst, b, h) do { _Pragma("unroll") for (int n = 0; n < 2; ++n) _Pragma("unroll") for (int k = 0; k < 2; ++k) dst[n][k] = *(const PG8_LAS bf16x8*)(lds + PG8_SB(b, h) + boff + n * 2048 + k * 1024); } while (0)
#define PG8_MMA(ai, bj, At, Bt) do { __builtin_amdgcn_s_setprio(1); _Pragma("unroll") for (int m = 0; m < 4; ++m) _Pragma("unroll") for (int n = 0; n < 2; ++n) _Pragma("unroll") for (int k = 0; k < 2; ++k) \
        acc[ai][bj][m][n] = __builtin_amdgcn_mfma_f32_16x16x32_bf16(Bt[n][k], At[m][k], acc[ai][bj][m][n], 0, 0, 0); __builtin_amdgcn_s_setprio(0); } while (0)
#define PG8_WAIT_V(n) asm volatile("s_waitcnt vmcnt(" #n ")" ::: "memory")
#define PG8_WAIT_L(n) asm volatile("s_waitcnt lgkmcnt(" #n ")" ::: "memory")
#define PG8_BAR __builtin_amdgcn_s_barrier()
#define PG8_SCHED __builtin_amdgcn_sched_barrier(0)
    Unit cur, nxt; int ui = 0;
    if (!S.next(0, cur)) return;
    f32x4 acc[2][2][4][2];
#pragma unroll
    for (int a = 0; a < 2; ++a)
#pragma unroll
        for (int b = 0; b < 2; ++b)
#pragma unroll
            for (int m = 0; m < 4; ++m)
#pragma unroll
                for (int n = 0; n < 2; ++n) acc[a][b][m][n] = (f32x4){0.f, 0.f, 0.f, 0.f};
    bf16x8 At[4][2], B0[2][2], B1[2][2];
    const char* cA = (const char*)g.A + (size_t)cur.pm * tstep; const char* cB = (const char*)g.Bt + (size_t)cur.pn * tstep;
    S.a_ready(cur);
    if constexpr (SP2) {
        PG8_STAGE(PG8_SB(0, 0), cB, voffB); PG8_STAGE(PG8_SB(0, 1), cB + hstep, voffB); PG8_STAGE(PG8_SA(0, 0), cA, voffA); PG8_STAGE(PG8_SA(0, 1), cA + hstep, voffA);
        if (wr == 1) PG8_BAR;
        PG8_WAIT_V(2); PG8_BAR;
        PG8_STAGE(PG8_SB(1, 0), cB + kstep, voffB); PG8_STAGE(PG8_SA(1, 0), cA + kstep, voffA); PG8_STAGE(PG8_SB(1, 1), cB + hstep + kstep, voffB);
        PG8_WAIT_V(6); PG8_BAR;
    } else {
        PG8_STAGE(PG8_SB(0, 0), cB, voffB); PG8_STAGE(PG8_SA(0, 0), cA, voffA); PG8_STAGE(PG8_SB(0, 1), cB + hstep, voffB); PG8_STAGE(PG8_SA(0, 1), cA + hstep, voffA);
        if (wr == 1) PG8_BAR;
        PG8_WAIT_V(4); PG8_BAR;
        PG8_STAGE(PG8_SB(1, 0), cB + kstep, voffB); PG8_STAGE(PG8_SA(1, 0), cA + kstep, voffA); PG8_STAGE(PG8_SB(1, 1), cB + hstep + kstep, voffB);
        PG8_WAIT_V(6); PG8_BAR;
    }
    for (;;) {
        const bool has_next = S.next(ui + 1, nxt);
        const char* nA = has_next ? (const char*)g.A + (size_t)nxt.pm * tstep : cA; const char* nB = has_next ? (const char*)g.Bt + (size_t)nxt.pn * tstep : cB;
        for (int t = 0; t < nt; t += 2) {
            const bool last = (t == nt - 2);
            const char* a1 = cA + (size_t)(t + 1) * kstep;
            const char* a2 = last ? nA : cA + (size_t)(t + 2) * kstep; const char* b2 = last ? nB : cB + (size_t)(t + 2) * kstep;
            const char* a3 = a2 + kstep; const char* b3 = b2 + kstep;
            if (last && has_next) S.a_ready(nxt);
            if constexpr (SP2) {
            PG8_LDB(B0, 0, 0); PG8_LDB(B1, 0, 1); PG8_SCHED; PG8_LDA(At, 0, 0); PG8_STAGE(PG8_SA(1, 1), a1 + hstep, voffA);
            PG8_WAIT_V(8); PG8_WAIT_L(0); PG8_BAR; PG8_MMA(0, 0, At, B0); PG8_MMA(0, 1, At, B1); PG8_BAR; PG8_SCHED;
            PG8_LDA(At, 0, 1); PG8_STAGE(PG8_SB(0, 0), b2, voffB); PG8_STAGE(PG8_SB(0, 1), b2 + hstep, voffB); PG8_STAGE(PG8_SA(0, 0), a2, voffA);
            PG8_WAIT_V(8); PG8_WAIT_L(0); PG8_BAR; PG8_MMA(1, 0, At, B0); PG8_MMA(1, 1, At, B1); PG8_BAR; PG8_SCHED;
            PG8_LDB(B0, 1, 0); PG8_LDB(B1, 1, 1); PG8_SCHED; PG8_LDA(At, 1, 0); PG8_STAGE(PG8_SA(0, 1), a2 + hstep, voffA);
            PG8_WAIT_V(8); PG8_WAIT_L(0); PG8_BAR; PG8_MMA(0, 0, At, B0); PG8_MMA(0, 1, At, B1); PG8_BAR; PG8_SCHED;
            PG8_LDA(At, 1, 1); PG8_STAGE(PG8_SB(1, 0), b3, voffB); PG8_STAGE(PG8_SB(1, 1), b3 + hstep, voffB); PG8_STAGE(PG8_SA(1, 0), a3, voffA);
            PG8_WAIT_V(8); PG8_WAIT_L(0); PG8_BAR; PG8_MMA(1, 0, At, B0); PG8_MMA(1, 1, At, B1); PG8_BAR; PG8_SCHED;
            } else {
            PG8_LDB(B0, 0, 0); PG8_SCHED; PG8_LDA(At, 0, 0); PG8_STAGE(PG8_SA(1, 1), a1 + hstep, voffA);
            PG8_WAIT_L(8); PG8_BAR; PG8_WAIT_L(0); PG8_MMA(0, 0, At, B0); PG8_BAR; PG8_SCHED;
            PG8_LDB(B1, 0, 1); PG8_STAGE(PG8_SB(0, 0), b2, voffB);
            PG8_BAR; PG8_WAIT_L(0); PG8_MMA(0, 1, At, B1); PG8_BAR;
            PG8_LDA(At, 0, 1); PG8_STAGE(PG8_SA(0, 0), a2, voffA);
            PG8_BAR; PG8_WAIT_L(0); PG8_MMA(1, 0, At, B0); PG8_BAR; PG8_SCHED;
            PG8_STAGE(PG8_SB(0, 1), b2 + hstep, voffB);
            PG8_WAIT_V(6); PG8_BAR; PG8_MMA(1, 1, At, B1); PG8_BAR;
            PG8_LDB(B0, 1, 0); PG8_SCHED; PG8_LDA(At, 1, 0); PG8_STAGE(PG8_SA(0, 1), a2 + hstep, voffA);
            PG8_WAIT_L(8); PG8_BAR; PG8_WAIT_L(0); PG8_MMA(0, 0, At, B0); PG8_BAR; PG8_SCHED;
            PG8_LDB(B1, 1, 1); PG8_STAGE(PG8_SB(1, 0), b3, voffB);
            PG8_BAR; PG8_WAIT_L(0); PG8_MMA(0, 1, At, B1); PG8_BAR;
            PG8_LDA(At, 1, 1); PG8_STAGE(PG8_SA(1, 0), a3, voffA);
            PG8_BAR; PG8_WAIT_L(0); PG8_MMA(1, 0, At, B0); PG8_BAR; PG8_SCHED;
            PG8_STAGE(PG8_SB(1, 1), b3 + hstep, voffB);
            PG8_WAIT_V(6); PG8_BAR; PG8_MMA(1, 1, At, B1); PG8_BAR;
            }
        }
        if constexpr (ALIGN_EPI) { if (wr == 0) PG8_BAR; }
        if constexpr (!Epi::AFTER_DRAIN) { E(acc, cur, wr, wc, fr, fq); S.done(cur); }
        if (!has_next) break;
#pragma unroll
        for (int a = 0; a < 2; ++a)
#pragma unroll
            for (int b = 0; b < 2; ++b)
#pragma unroll
                for (int m = 0; m < 4; ++m)
#pragma unroll
                    for (int n = 0; n < 2; ++n) acc[a][b][m][n] = (f32x4){0.f, 0.f, 0.f, 0.f};
        cur = nxt; cA = nA; cB = nB; ++ui;
        if constexpr (ALIGN_EPI) { if (wr == 1) PG8_BAR; }
    }
    PG8_WAIT_V(0);
    if constexpr (!ALIGN_EPI) { if (wr == 0) PG8_BAR; }
    PG8_BAR;
    if constexpr (Epi::AFTER_DRAIN) { E.fused(acc, cur, wr, wc, fr, fq, lds, wid, lane); S.done(cur); }
#undef PG8_SA
#undef PG8_SB
#undef PG8_STAGE
#undef PG8_LDA
#undef PG8_LDB
#undef PG8_MMA
#undef PG8_WAIT_V
#undef PG8_WAIT_L
#undef PG8_BAR
#undef PG8_SCHED
}
}

#define WTAB_OFF 155392
extern __shared__ __attribute__((aligned(16))) unsigned char lds_raw[];
__device__ __forceinline__ int hw_slot() { return (int)(__builtin_amdgcn_s_getreg((5 << 11) | 4) & 63u); }
__device__ __forceinline__ void otid_init() { const int t = threadIdx.x; if ((t & 63) == 0) ((__attribute__((address_space(3))) int*)(__attribute__((address_space(3))) void*)(lds_raw + WTAB_OFF))[hw_slot()] = t >> 6; }
__device__ __forceinline__ int otid() {
    const int w = __builtin_amdgcn_readfirstlane(((const __attribute__((address_space(3))) int*)(__attribute__((address_space(3))) void*)(lds_raw + WTAB_OFF))[hw_slot()]);
    int l; asm volatile("v_mbcnt_lo_u32_b32 %0, -1, 0\n\tv_mbcnt_hi_u32_b32 %0, -1, %0" : "=v"(l));
    return (w << 6) + l;
}
using pg8::bf16_t; using pg8::bf16x8; using pg8::f32x4; using pg8::u32x4;
#define LAS __attribute__((address_space(3)))

#define DMODEL 1024
#define NPT 16384
#define NST 32
#define NTOK 16416
#define MPAD 16640
#define SEQ 2048
#define ZW 2816
#define OFF_A 1536
#define OFF_B 1544
#define OFF_Z 1552
#define OFF_QA 2064
#define OFF_KVA 2448
#define OFF_KR 2704
#define DFF 2816
#define PAST 16384
#define NPAGES 128
#define EPSV 1e-6f

#define O_YP 0
#define O_YS (O_YP + 16777216)
#define O_CKVP (O_YS + 32768)
#define O_KRP (O_CKVP + 4194304)
#define O_GSP (O_KRP + 524288)
#define O_CSP (O_GSP + 262144)
#define O_CKVS (O_CSP + 36864)
#define O_KRS (O_CKVS + 8192)
#define O_GSS (O_KRS + 1024)
#define O_CSS (O_GSS + 1048576)

__device__ __forceinline__ bf16_t f2bf(float f) { unsigned u = __float_as_uint(f); return (bf16_t)((u + 0x7fffu + ((u >> 16) & 1u)) >> 16); }
__device__ __forceinline__ float bf2f(bf16_t b) { return __uint_as_float(((unsigned)b) << 16); }
__device__ __forceinline__ float wave_sum(float v) {
#pragma unroll
    for (int o = 1; o < 64; o <<= 1) v += __shfl_xor(v, o);
    return v;
}
__device__ __forceinline__ float sigmoidf_(float x) { return __builtin_amdgcn_rcpf(1.f + __builtin_amdgcn_exp2f(-1.44269504f * x)); }
__device__ __forceinline__ float siluf_(float x) { return x * __builtin_amdgcn_rcpf(1.f + __builtin_amdgcn_exp2f(-1.44269504f * x)); }


#define WSYNC() do { __builtin_amdgcn_fence(__ATOMIC_ACQ_REL, "wavefront"); __builtin_amdgcn_wave_barrier(); } while (0)
#define NTHR 512
#define NWAVE 8

typedef float f32x2_t __attribute__((ext_vector_type(2)));
typedef __bf16 bf16x2_t __attribute__((ext_vector_type(2)));
__device__ __forceinline__ unsigned cvtpk(float lo, float hi) { f32x2_t v = {lo, hi}; bf16x2_t r = __builtin_convertvector(v, bf16x2_t); return __builtin_bit_cast(unsigned, r); }
__device__ __forceinline__ void bf8_to_f32(const bf16x8& v, float* o) {
#pragma unroll
    for (int e = 0; e < 8; ++e) o[e] = __uint_as_float(((unsigned)(unsigned short)v[e]) << 16);
}
__device__ __forceinline__ bf16x8 f32_to_bf8(const float* x) {
    u32x4 w; w.x = cvtpk(x[0], x[1]); w.y = cvtpk(x[2], x[3]); w.z = cvtpk(x[4], x[5]); w.w = cvtpk(x[6], x[7]);
    return __builtin_bit_cast(bf16x8, w);
}
__device__ __forceinline__ unsigned pk2bf(float lo, float hi) { return (unsigned)f2bf(lo) | ((unsigned)f2bf(hi) << 16); }

__device__ __forceinline__ void wt_item(const float* __restrict__ W, int ldw, int col0, int nvalid, bf16_t* __restrict__ WT, int ldt, int nrow0, int k0, float* scr, int lane) {
    WSYNC();
#pragma unroll 8
    for (int i = 0; i < 32; ++i) { const int kk = 2 * i + (lane >> 5), n = lane & 31; scr[kk * 33 + n] = n < nvalid ? W[(size_t)(k0 + kk) * ldw + col0 + n] : 0.f; }
    WSYNC();
    const int c = lane & 7;
#pragma unroll
    for (int j = 0; j < 4; ++j) { const int n = (lane >> 3) + 8 * j; const float* sp = scr + (8 * c) * 33 + n;
        u32x4 o; o.x = cvtpk(sp[0], sp[33]); o.y = cvtpk(sp[2 * 33], sp[3 * 33]); o.z = cvtpk(sp[4 * 33], sp[5 * 33]); o.w = cvtpk(sp[6 * 33], sp[7 * 33]);
        *(u32x4*)(WT + (size_t)(nrow0 + n) * ldt + k0 + 8 * c) = o; }
}

__device__ __forceinline__ void rms1024_row(const float* __restrict__ src, const float* __restrict__ g, bf16_t* __restrict__ o, bool zero, int lane) {
    if (zero) { for (int j = 0; j < 4; ++j) { ushort4 z = {0, 0, 0, 0}; *(ushort4*)(o + lane * 4 + 256 * j) = z; } return; }
    float4 v[4]; float ss = 0.f;
#pragma unroll
    for (int j = 0; j < 4; ++j) { v[j] = *(const float4*)(src + lane * 4 + 256 * j); ss += v[j].x * v[j].x + v[j].y * v[j].y + v[j].z * v[j].z + v[j].w * v[j].w; }
    ss = wave_sum(ss);
    const float rs = rsqrtf(ss * (1.f / 1024.f) + EPSV);
#pragma unroll
    for (int j = 0; j < 4; ++j) {
        const float4 gg = *(const float4*)(g + lane * 4 + 256 * j);
        ushort4 w; w.x = f2bf(v[j].x * rs * gg.x); w.y = f2bf(v[j].y * rs * gg.y); w.z = f2bf(v[j].z * rs * gg.z); w.w = f2bf(v[j].w * rs * gg.w);
        *(ushort4*)(o + lane * 4 + 256 * j) = w;
    }
}

__device__ __forceinline__ void rms1024_row_b(const bf16_t* __restrict__ src, const float* __restrict__ g, bf16_t* __restrict__ o, bool zero, int lane) {
    if (zero) { for (int j = 0; j < 2; ++j) { const u32x4 z = {0u, 0u, 0u, 0u}; *(u32x4*)(o + lane * 8 + 512 * j) = z; } return; }
    float v[2][8]; float ss = 0.f;
#pragma unroll
    for (int j = 0; j < 2; ++j) { bf8_to_f32(*(const bf16x8*)(src + lane * 8 + 512 * j), v[j]);
#pragma unroll
        for (int e = 0; e < 8; ++e) ss += v[j][e] * v[j][e]; }
    ss = wave_sum(ss);
    const float rs = rsqrtf(ss * (1.f / 1024.f) + EPSV);
#pragma unroll
    for (int j = 0; j < 2; ++j) {
        const float4 g0 = *(const float4*)(g + lane * 8 + 512 * j), g1 = *(const float4*)(g + lane * 8 + 512 * j + 4);
        float t[8] = {v[j][0] * rs * g0.x, v[j][1] * rs * g0.y, v[j][2] * rs * g0.z, v[j][3] * rs * g0.w, v[j][4] * rs * g1.x, v[j][5] * rs * g1.y, v[j][6] * rs * g1.z, v[j][7] * rs * g1.w};
        *(bf16x8*)(o + lane * 8 + 512 * j) = f32_to_bf8(t);
    }
}

struct ABf16 { const bf16_t* p; int lda; __device__ __forceinline__ bf16x8 load(int m, int k) const { return *(const bf16x8*)(p + (size_t)m * lda + k); } };
struct ACache {
    const float* cache; const int* pt;
    __device__ __forceinline__ bf16x8 load(int m, int k) const {
        const int b = m >> 14, t = m & 16383; const int phys = pt[b * NPAGES + (t >> 7)];
        const float* r = cache + ((size_t)phys * 128 + (t & 127)) * 256 + k;
        const float4 a = *(const float4*)r, c = *(const float4*)(r + 4);
        bf16x8 o; o[0] = (short)f2bf(a.x); o[1] = (short)f2bf(a.y); o[2] = (short)f2bf(a.z); o[3] = (short)f2bf(a.w);
        o[4] = (short)f2bf(c.x); o[5] = (short)f2bf(c.y); o[6] = (short)f2bf(c.z); o[7] = (short)f2bf(c.w); return o;
    }
};
template <class AL, class Epi>
__device__ __forceinline__ void gemm_tile_256x128(const AL& al, const bf16_t* __restrict__ Bt, int ldb, int K, const Epi& epi, int m0, int n0, char* smem) {
    bf16_t (*sA)[40] = (bf16_t (*)[40])smem;
    bf16_t (*sB)[40] = (bf16_t (*)[40])(smem + 20480);
    const int tid = otid(), lane = tid & 63, wid = tid >> 6, wm = wid >> 1, wn = wid & 1;
    f32x4 acc[4][4];
#pragma unroll
    for (int i = 0; i < 4; ++i)
#pragma unroll
        for (int j = 0; j < 4; ++j) acc[i][j] = (f32x4){0.f, 0.f, 0.f, 0.f};
    __syncthreads();
    for (int k0 = 0; k0 < K; k0 += 32) {
#pragma unroll
        for (int i = 0; i < 2; ++i) { const int ch = tid + 512 * i, r = ch >> 2, kc = (ch & 3) * 8; *(bf16x8*)&sA[r][kc] = al.load(m0 + r, k0 + kc); }
        { const int r = tid >> 2, kc = (tid & 3) * 8; *(bf16x8*)&sB[r][kc] = *(const bf16x8*)(Bt + (size_t)(n0 + r) * ldb + k0 + kc); }
        __syncthreads();
        bf16x8 af[4], bfr[4];
#pragma unroll
        for (int i = 0; i < 4; ++i) af[i] = *(const bf16x8*)&sA[wm * 64 + i * 16 + (lane & 15)][(lane >> 4) * 8];
#pragma unroll
        for (int j = 0; j < 4; ++j) bfr[j] = *(const bf16x8*)&sB[wn * 64 + j * 16 + (lane & 15)][(lane >> 4) * 8];
#pragma unroll
        for (int i = 0; i < 4; ++i)
#pragma unroll
            for (int j = 0; j < 4; ++j) acc[i][j] = __builtin_amdgcn_mfma_f32_16x16x32_bf16(af[i], bfr[j], acc[i][j], 0, 0, 0);
        __syncthreads();
    }
#pragma unroll
    for (int i = 0; i < 4; ++i)
#pragma unroll
        for (int j = 0; j < 4; ++j)
#pragma unroll
            for (int r = 0; r < 4; ++r) epi(m0 + wm * 64 + i * 16 + (lane >> 4) * 4 + r, n0 + wn * 64 + j * 16 + (lane & 15), acc[i][j][r]);
}
template <class Epi>
__device__ __forceinline__ void gemm_tile_32x256(const bf16_t* __restrict__ A, int lda, const bf16_t* __restrict__ Bt, int ldb, int K, const Epi& epi, int m0, int n0, char* smem) {
    bf16_t (*sA)[40] = (bf16_t (*)[40])smem;
    bf16_t (*sB)[40] = (bf16_t (*)[40])(smem + 2560);
    const int tid = otid(), lane = tid & 63, wid = tid >> 6;
    f32x4 acc[2][2];
#pragma unroll
    for (int i = 0; i < 2; ++i)
#pragma unroll
        for (int j = 0; j < 2; ++j) acc[i][j] = (f32x4){0.f, 0.f, 0.f, 0.f};
    __syncthreads();
    for (int k0 = 0; k0 < K; k0 += 32) {
        if (tid < 128) { const int r = tid >> 2, kc = (tid & 3) * 8; *(bf16x8*)&sA[r][kc] = *(const bf16x8*)(A + (size_t)(m0 + r) * lda + k0 + kc); }
#pragma unroll
        for (int i = 0; i < 2; ++i) { const int ch = tid + 512 * i, r = ch >> 2, kc = (ch & 3) * 8; *(bf16x8*)&sB[r][kc] = *(const bf16x8*)(Bt + (size_t)(n0 + r) * ldb + k0 + kc); }
        __syncthreads();
        bf16x8 af[2], bfr[2];
#pragma unroll
        for (int i = 0; i < 2; ++i) af[i] = *(const bf16x8*)&sA[i * 16 + (lane & 15)][(lane >> 4) * 8];
#pragma unroll
        for (int j = 0; j < 2; ++j) bfr[j] = *(const bf16x8*)&sB[wid * 32 + j * 16 + (lane & 15)][(lane >> 4) * 8];
#pragma unroll
        for (int i = 0; i < 2; ++i)
#pragma unroll
            for (int j = 0; j < 2; ++j) acc[i][j] = __builtin_amdgcn_mfma_f32_16x16x32_bf16(af[i], bfr[j], acc[i][j], 0, 0, 0);
        __syncthreads();
    }
#pragma unroll
    for (int i = 0; i < 2; ++i)
#pragma unroll
        for (int j = 0; j < 2; ++j)
#pragma unroll
            for (int r = 0; r < 4; ++r) epi(m0 + i * 16 + (lane >> 4) * 4 + r, n0 + wid * 32 + j * 16 + (lane & 15), acc[i][j][r]);
}
template <bool SWIGLU, class Epi>
__device__ __forceinline__ void gemm_sample_rows(const bf16_t* __restrict__ A, int lda, const bf16_t* __restrict__ Bt, int K, int N, const Epi& epi, char*  , int bid, int nb) {
    const int tid = otid(), lane = tid & 63, wid = tid >> 6, i16 = lane & 15, q4 = lane >> 4;
    for (int u = nb - 1 - bid; u < N / 256; u += nb) {
        const int n0 = u * 256;
        const int c0 = SWIGLU ? n0 + 16 * wid : n0 + 32 * wid, c1 = SWIGLU ? n0 + 128 + 16 * wid : n0 + 32 * wid + 16;
        const bf16_t* a0p = A + (size_t)(NPT + i16) * lda + 8 * q4; const bf16_t* a1p = a0p + (size_t)16 * lda;
        const bf16_t* b0p = Bt + (size_t)(c0 + i16) * K + 8 * q4; const bf16_t* b1p = Bt + (size_t)(c1 + i16) * K + 8 * q4;
        f32x4 acc[2][2];
#pragma unroll
        for (int i = 0; i < 2; ++i)
#pragma unroll
            for (int j = 0; j < 2; ++j) acc[i][j] = (f32x4){0.f, 0.f, 0.f, 0.f};
#pragma unroll 4
        for (int k0 = 0; k0 < K; k0 += 32) {
            const bf16x8 a0 = *(const bf16x8*)(a0p + k0), a1 = *(const bf16x8*)(a1p + k0), b0 = *(const bf16x8*)(b0p + k0), b1 = *(const bf16x8*)(b1p + k0);
            acc[0][0] = __builtin_amdgcn_mfma_f32_16x16x32_bf16(a0, b0, acc[0][0], 0, 0, 0); acc[0][1] = __builtin_amdgcn_mfma_f32_16x16x32_bf16(a0, b1, acc[0][1], 0, 0, 0);
            acc[1][0] = __builtin_amdgcn_mfma_f32_16x16x32_bf16(a1, b0, acc[1][0], 0, 0, 0); acc[1][1] = __builtin_amdgcn_mfma_f32_16x16x32_bf16(a1, b1, acc[1][1], 0, 0, 0);
        }
#pragma unroll
        for (int i = 0; i < 2; ++i)
#pragma unroll
            for (int r = 0; r < 4; ++r) {
                const int m = NPT + 16 * i + 4 * q4 + r;
                if constexpr (SWIGLU) epi(m, (n0 >> 1) + 16 * wid + i16, siluf_(acc[i][0][r]) * acc[i][1][r]);
                else { epi(m, c0 + i16, acc[i][0][r]); epi(m, c1 + i16, acc[i][1][r]); }
            }
    }
}
template <bool SWIGLU, class Epi>
__device__ __forceinline__ void gemm_sample_rows_ks(const bf16_t* __restrict__ A, int lda, const bf16_t* __restrict__ Bt, int K, int N, const Epi& epi, char* smem, int bid, int nb) {
    const int tid = otid(), lane = tid & 63, wid = tid >> 6, i16 = lane & 15, q4 = lane >> 4;
    const int nunits = N / 64, ksl = K >> 3;
    f32x4* red = (f32x4*)smem;
    for (int u = nb - 1 - bid; u < nunits; u += nb) {
        int brow[4];
#pragma unroll
        for (int j = 0; j < 4; ++j) brow[j] = SWIGLU ? ((32 * u) >> 7) * 256 + ((32 * u) & 127) + 128 * (j >> 1) + 16 * (j & 1) + i16 : 64 * u + 16 * j + i16;
        const bf16_t* a0p = A + (size_t)(NPT + i16) * lda + wid * ksl + 8 * q4; const bf16_t* a1p = a0p + (size_t)16 * lda;
        f32x4 acc[2][4];
#pragma unroll
        for (int i = 0; i < 2; ++i)
#pragma unroll
            for (int j = 0; j < 4; ++j) acc[i][j] = (f32x4){0.f, 0.f, 0.f, 0.f};
        for (int k0 = 0; k0 < ksl; k0 += 32) {
            const bf16x8 a0 = *(const bf16x8*)(a0p + k0), a1 = *(const bf16x8*)(a1p + k0);
            bf16x8 b[4];
#pragma unroll
            for (int j = 0; j < 4; ++j) b[j] = *(const bf16x8*)(Bt + (size_t)brow[j] * K + wid * ksl + 8 * q4 + k0);
#pragma unroll
            for (int j = 0; j < 4; ++j) { acc[0][j] = __builtin_amdgcn_mfma_f32_16x16x32_bf16(a0, b[j], acc[0][j], 0, 0, 0); acc[1][j] = __builtin_amdgcn_mfma_f32_16x16x32_bf16(a1, b[j], acc[1][j], 0, 0, 0); }
        }
        __syncthreads();
#pragma unroll
        for (int i = 0; i < 2; ++i)
#pragma unroll
            for (int j = 0; j < 4; ++j) red[(wid * 8 + i * 4 + j) * 64 + lane] = acc[i][j];
        __syncthreads();
        if constexpr (SWIGLU) {
            if (tid < 256) {
                const int t4 = tid >> 6, i = t4 >> 1, jg = t4 & 1, l = tid & 63;
                f32x4 g = red[(i * 4 + jg) * 64 + l], up = red[(i * 4 + jg + 2) * 64 + l];
#pragma unroll
                for (int w = 1; w < 8; ++w) { g = g + red[(w * 8 + i * 4 + jg) * 64 + l]; up = up + red[(w * 8 + i * 4 + jg + 2) * 64 + l]; }
#pragma unroll
                for (int r = 0; r < 4; ++r) epi(NPT + 16 * i + 4 * (l >> 4) + r, 32 * u + 16 * jg + (l & 15), siluf_(g[r]) * up[r]);
            }
        } else {
            const int t8 = tid >> 6, l = tid & 63, i = t8 >> 2, j = t8 & 3;
            f32x4 v = red[t8 * 64 + l];
#pragma unroll
            for (int w = 1; w < 8; ++w) v = v + red[(w * 8 + t8) * 64 + l];
#pragma unroll
            for (int r = 0; r < 4; ++r) epi(NPT + 16 * i + 4 * (l >> 4) + r, 64 * u + 16 * j + (l & 15), v[r]);
        }
    }
    __syncthreads();
}
struct EwF32 { float* C; int ldc; __device__ __forceinline__ void operator()(int m, int n, float v) const { C[(size_t)m * ldc + n] = v; } };
struct EwBf16 { bf16_t* C; int ldc; __device__ __forceinline__ void operator()(int m, int n, float v) const { C[(size_t)m * ldc + n] = f2bf(v); } };
struct EwResX { const float* xs; bf16_t* C; __device__ __forceinline__ void operator()(int m, int n, float v) const { C[(size_t)m * 1024 + n] = f2bf(xs[(size_t)(m - NPT) * 1024 + n] + v); } };
struct EwSwiglu {
    float* G; bf16_t* Hd;
    __device__ __forceinline__ void operator()(int m, int n, float v) const {
        const int f = (n >> 8) * 128 + (n & 127);
        if ((n & 255) < 128) G[(size_t)(m - NPT) * DFF + f] = v;
    }
};
struct EwSwiglu2 {
    const float* G; bf16_t* Hd;
    __device__ __forceinline__ void operator()(int m, int n, float v) const {
        const int f = (n >> 8) * 128 + (n & 127);
        if ((n & 255) >= 128) Hd[(size_t)m * DFF + f] = f2bf(siluf_(G[(size_t)(m - NPT) * DFF + f]) * v);
    }
};
struct EwResH { const bf16_t* H; bf16_t* C; __device__ __forceinline__ void operator()(int m, int n, float v) const { C[(size_t)m * 1024 + n] = f2bf(bf2f(H[(size_t)m * 1024 + n]) + v); } };
struct EwPle { const bf16_t* H2; const bf16_t* PP; float* out;
    __device__ __forceinline__ void operator()(int m, int n, float v) const { out[O_YS + (size_t)(m - NPT) * 1024 + n] = bf2f(H2[(size_t)m * 1024 + n]) + bf2f(PP[(size_t)m * 1024 + n]) * sigmoidf_(v); } };

struct PgBf16 {
    static constexpr bool PERM = true, AFTER_DRAIN = false; bf16_t* O; int ldc;
    __device__ __forceinline__ void operator()(const f32x4 (&acc)[2][2][4][2], const pg8::Unit& u, int wr, int wc, int fr, int fq) const {
#pragma unroll
        for (int ai = 0; ai < 2; ++ai)
#pragma unroll
            for (int m = 0; m < 4; ++m) { bf16_t* rowp = O + (size_t)(u.pm * 256 + ai * 128 + wr * 64 + m * 16 + fr) * ldc + u.pn * 256 + wc * 32 + 8 * fq;
#pragma unroll
                for (int bj = 0; bj < 2; ++bj) { const f32x4 v0 = acc[ai][bj][m][0], v1 = acc[ai][bj][m][1]; u32x4 w; w.x = pk2bf(v0[0], v0[1]); w.y = pk2bf(v0[2], v0[3]); w.z = pk2bf(v1[0], v1[1]); w.w = pk2bf(v1[2], v1[3]); *(u32x4*)(rowp + bj * 128) = w; } }
    }
};
struct PgF32 {
    static constexpr bool PERM = false, AFTER_DRAIN = false; float* O; int ldc;
    __device__ __forceinline__ void operator()(const f32x4 (&acc)[2][2][4][2], const pg8::Unit& u, int wr, int wc, int fr, int fq) const {
#pragma unroll
        for (int ai = 0; ai < 2; ++ai)
#pragma unroll
            for (int m = 0; m < 4; ++m) { float* rowp = O + (size_t)(u.pm * 256 + ai * 128 + wr * 64 + m * 16 + fr) * ldc + u.pn * 256 + wc * 32 + 4 * fq;
#pragma unroll
                for (int bj = 0; bj < 2; ++bj)
#pragma unroll
                    for (int n = 0; n < 2; ++n) *(f32x4*)(rowp + bj * 128 + n * 16) = acc[ai][bj][m][n]; }
    }
};
struct PgRes {
    static constexpr bool PERM = false, AFTER_DRAIN = false; const float* R; float* O;
    __device__ __forceinline__ void operator()(const f32x4 (&acc)[2][2][4][2], const pg8::Unit& u, int wr, int wc, int fr, int fq) const {
#pragma unroll
        for (int ai = 0; ai < 2; ++ai)
#pragma unroll
            for (int m = 0; m < 4; ++m) { const size_t off = (size_t)(u.pm * 256 + ai * 128 + wr * 64 + m * 16 + fr) * 1024 + u.pn * 256 + wc * 32 + 4 * fq;
#pragma unroll
                for (int bj = 0; bj < 2; ++bj)
#pragma unroll
                    for (int n = 0; n < 2; ++n) { const f32x4 r = *(const f32x4*)(R + off + bj * 128 + n * 16); *(f32x4*)(O + off + bj * 128 + n * 16) = r + acc[ai][bj][m][n]; } }
    }
};
struct PgSwiglu {
    static constexpr bool PERM = true, AFTER_DRAIN = false; bf16_t* Hd;
    __device__ __forceinline__ void operator()(const f32x4 (&acc)[2][2][4][2], const pg8::Unit& u, int wr, int wc, int fr, int fq) const {
#pragma unroll
        for (int ai = 0; ai < 2; ++ai)
#pragma unroll
            for (int m = 0; m < 4; ++m) { bf16_t* rowp = Hd + (size_t)(u.pm * 256 + ai * 128 + wr * 64 + m * 16 + fr) * DFF + u.pn * 128 + wc * 32 + 8 * fq;
                float h[8];
#pragma unroll
                for (int n = 0; n < 2; ++n)
#pragma unroll
                    for (int i = 0; i < 4; ++i) h[n * 4 + i] = siluf_(acc[ai][0][m][n][i]) * acc[ai][1][m][n][i];
                u32x4 w; w.x = pk2bf(h[0], h[1]); w.y = pk2bf(h[2], h[3]); w.z = pk2bf(h[4], h[5]); w.w = pk2bf(h[6], h[7]); *(u32x4*)rowp = w; }
    }
};
struct PgPle {
    static constexpr bool PERM = false, AFTER_DRAIN = false; const float* H2; const float* PP; float* out;
    __device__ __forceinline__ void operator()(const f32x4 (&acc)[2][2][4][2], const pg8::Unit& u, int wr, int wc, int fr, int fq) const {
#pragma unroll
        for (int ai = 0; ai < 2; ++ai)
#pragma unroll
            for (int m = 0; m < 4; ++m) { const size_t off = (size_t)(u.pm * 256 + ai * 128 + wr * 64 + m * 16 + fr) * 1024 + u.pn * 256 + wc * 32 + 4 * fq;
#pragma unroll
                for (int bj = 0; bj < 2; ++bj)
#pragma unroll
                    for (int n = 0; n < 2; ++n) { const f32x4 h = *(const f32x4*)(H2 + off + bj * 128 + n * 16), pp = *(const f32x4*)(PP + off + bj * 128 + n * 16), a = acc[ai][bj][m][n]; f32x4 y;
#pragma unroll
                        for (int i = 0; i < 4; ++i) y[i] = h[i] + pp[i] * sigmoidf_(a[i]);
                        *(f32x4*)(out + O_YP + off + bj * 128 + n * 16) = y; } }
    }
};
struct PgResXB {
    static constexpr bool PERM = true, AFTER_DRAIN = false; const float* R; bf16_t* O;
    __device__ __forceinline__ void operator()(const f32x4 (&acc)[2][2][4][2], const pg8::Unit& u, int wr, int wc, int fr, int fq) const {
#pragma unroll
        for (int ai = 0; ai < 2; ++ai)
#pragma unroll
            for (int m = 0; m < 4; ++m) { const size_t off = (size_t)(u.pm * 256 + ai * 128 + wr * 64 + m * 16 + fr) * 1024 + u.pn * 256 + wc * 32 + 8 * fq;
#pragma unroll
                for (int bj = 0; bj < 2; ++bj) { const f32x4 r0 = *(const f32x4*)(R + off + bj * 128), r1 = *(const f32x4*)(R + off + bj * 128 + 4), v0 = r0 + acc[ai][bj][m][0], v1 = r1 + acc[ai][bj][m][1];
                    u32x4 w; w.x = cvtpk(v0[0], v0[1]); w.y = cvtpk(v0[2], v0[3]); w.z = cvtpk(v1[0], v1[1]); w.w = cvtpk(v1[2], v1[3]); *(u32x4*)(O + off + bj * 128) = w; } }
    }
};
struct PgResBB {
    static constexpr bool PERM = true, AFTER_DRAIN = false; const bf16_t* R; bf16_t* O;
    __device__ __forceinline__ void operator()(const f32x4 (&acc)[2][2][4][2], const pg8::Unit& u, int wr, int wc, int fr, int fq) const {
#pragma unroll
        for (int ai = 0; ai < 2; ++ai)
#pragma unroll
            for (int m = 0; m < 4; ++m) { const size_t off = (size_t)(u.pm * 256 + ai * 128 + wr * 64 + m * 16 + fr) * 1024 + u.pn * 256 + wc * 32 + 8 * fq;
#pragma unroll
                for (int bj = 0; bj < 2; ++bj) { float r[8]; bf8_to_f32(*(const bf16x8*)(R + off + bj * 128), r); const f32x4 a0 = acc[ai][bj][m][0], a1 = acc[ai][bj][m][1];
                    u32x4 w; w.x = cvtpk(r[0] + a0[0], r[1] + a0[1]); w.y = cvtpk(r[2] + a0[2], r[3] + a0[3]); w.z = cvtpk(r[4] + a1[0], r[5] + a1[1]); w.w = cvtpk(r[6] + a1[2], r[7] + a1[3]); *(u32x4*)(O + off + bj * 128) = w; } }
    }
};
struct PgPleB {
    static constexpr bool PERM = true, AFTER_DRAIN = false; const bf16_t* H2; const bf16_t* PP; float* out;
    __device__ __forceinline__ void operator()(const f32x4 (&acc)[2][2][4][2], const pg8::Unit& u, int wr, int wc, int fr, int fq) const {
#pragma unroll
        for (int ai = 0; ai < 2; ++ai)
#pragma unroll
            for (int m = 0; m < 4; ++m) { const size_t off = (size_t)(u.pm * 256 + ai * 128 + wr * 64 + m * 16 + fr) * 1024 + u.pn * 256 + wc * 32 + 8 * fq;
#pragma unroll
                for (int bj = 0; bj < 2; ++bj) { float h[8], pp[8]; bf8_to_f32(*(const bf16x8*)(H2 + off + bj * 128), h); bf8_to_f32(*(const bf16x8*)(PP + off + bj * 128), pp);
                    const f32x4 a0 = acc[ai][bj][m][0], a1 = acc[ai][bj][m][1]; f32x4 y0, y1;
#pragma unroll
                    for (int i = 0; i < 4; ++i) { y0[i] = h[i] + pp[i] * sigmoidf_(a0[i]); y1[i] = h[4 + i] + pp[4 + i] * sigmoidf_(a1[i]); }
                    *(f32x4*)(out + O_YP + off + bj * 128) = y0; *(f32x4*)(out + O_YP + off + bj * 128 + 4) = y1; } }
    }
};
template <class Epi>
__device__ __forceinline__ void pg_gemm(LAS unsigned char* lds, const bf16_t* A, const bf16_t* Bt, int M, int N, int K, const Epi& E) {
    pg8::Gemm g{A, Bt, M, N, K}; pg8::StaticOrder S; S.init(M, N, (int)gridDim.x, (int)blockIdx.x);
    pg8::gemm_phase<Epi, pg8::StaticOrder, true, true>(lds, g, S, E);
}

constexpr size_t WOF_WinT = 0ull;
constexpr size_t WOF_WqbT = 5767168ull;
constexpr size_t WOF_WkvT = 6356992ull;
constexpr size_t WOF_WknT = 6881280ull;
constexpr size_t WOF_WoT = 7143424ull;
constexpr size_t WOF_WguT = 9240576ull;
constexpr size_t WOF_WdT = 20774912ull;
constexpr size_t WOF_WpgT = 26542080ull;
constexpr size_t WOF_WppT = 28639232ull;
constexpr size_t WOF_xn = 29163520ull;
constexpr size_t WOF_pb = 63242240ull;
constexpr size_t WOF_Z = 71761920ull;
constexpr size_t WOF_qkv = 165478400ull;
constexpr size_t WOF_ropecs = 216596480ull;
constexpr size_t WOF_gg = 216858880ull;
constexpr size_t WOF_bb = 217391360ull;
constexpr size_t WOF_goraw = 217923840ull;
constexpr size_t WOF_gUT = 252002560ull;
constexpr size_t WOF_ggam = 285556992ull;
constexpr size_t WOF_gWn = 285565184ull;
constexpr size_t WOF_gQg = 302342400ull;
constexpr size_t WOF_gQK = 319119616ull;
constexpr size_t WOF_gKd = 335896832ull;
constexpr size_t WOF_qan = 352674048ull;
constexpr size_t WOF_ckvb = 365453568ull;
constexpr size_t WOF_krf = 373973248ull;
constexpr size_t WOF_Q = 376103168ull;
constexpr size_t WOF_qh = 427221248ull;
constexpr size_t WOF_KV = 478339328ull;
constexpr size_t WOF_kh = 546496768ull;
constexpr size_t WOF_omix = 580575488ull;
constexpr size_t WOF_KN = 614654208ull;
constexpr size_t WOF_SC = 1151525120ull;
constexpr size_t WOF_part = 1168302336ull;
constexpr size_t WOF_H = 1170432256ull;
constexpr size_t WOF_un = 1238589696ull;
constexpr size_t WOF_G = 1272668416ull;
constexpr size_t WOF_hid = 1273028864ull;
constexpr size_t WOF_H2 = 1366745344ull;
constexpr size_t WOF_un2 = 1434902784ull;
constexpr size_t WOF_PP = 1468981504ull;
constexpr size_t WOF_qraw = 1537138944ull;
constexpr size_t WOF_kvraw = 1562304768ull;
constexpr size_t WOF_krb = 1595859200ull;
constexpr size_t WOF_ctl = 1596907776ull;
constexpr size_t WS_TOTAL = 1596924160ull;
struct MK {
    const float *x_prompt, *x_sample, *cache_ckv, *cache_krope, *state_gdn, *state_conv; const int* page_table; const float *p_prompt, *p_sample;
    const float *g_attn, *w_in, *w_conv, *a_log, *dt_bias, *g_gdn_out, *g_q_a, *w_q_b, *g_q_nope, *g_q_rope, *g_kv_a, *g_k_rope, *w_kv_b, *g_k_nope, *w_o, *g_ffn, *w_gate, *w_up, *w_down, *g_ple, *w_ple_gate, *w_ple_proj;
    float* out; char* ws;
    __device__ __forceinline__ unsigned* ctl() const { return (unsigned*)(ws + WOF_ctl); }
    __device__ __forceinline__ bf16_t* WinT() const { return (bf16_t*)(ws + WOF_WinT); }
    __device__ __forceinline__ bf16_t* WqbT() const { return (bf16_t*)(ws + WOF_WqbT); }
    __device__ __forceinline__ bf16_t* WkvT() const { return (bf16_t*)(ws + WOF_WkvT); }
    __device__ __forceinline__ bf16_t* WknT() const { return (bf16_t*)(ws + WOF_WknT); }
    __device__ __forceinline__ bf16_t* WoT() const { return (bf16_t*)(ws + WOF_WoT); }
    __device__ __forceinline__ bf16_t* WguT() const { return (bf16_t*)(ws + WOF_WguT); }
    __device__ __forceinline__ bf16_t* WdT() const { return (bf16_t*)(ws + WOF_WdT); }
    __device__ __forceinline__ bf16_t* WpgT() const { return (bf16_t*)(ws + WOF_WpgT); }
    __device__ __forceinline__ bf16_t* WppT() const { return (bf16_t*)(ws + WOF_WppT); }
    __device__ __forceinline__ bf16_t* xn() const { return (bf16_t*)(ws + WOF_xn); }
    __device__ __forceinline__ bf16_t* pb() const { return (bf16_t*)(ws + WOF_pb); }
    __device__ __forceinline__ bf16_t* Z() const { return (bf16_t*)(ws + WOF_Z); }
    __device__ __forceinline__ bf16_t* qkv() const { return (bf16_t*)(ws + WOF_qkv); }
    __device__ __forceinline__ float* ropecs() const { return (float*)(ws + WOF_ropecs); }
    __device__ __forceinline__ float* gg() const { return (float*)(ws + WOF_gg); }
    __device__ __forceinline__ float* bb() const { return (float*)(ws + WOF_bb); }
    __device__ __forceinline__ float* goraw() const { return (float*)(ws + WOF_goraw); }
    __device__ __forceinline__ float* gUT() const { return (float*)(ws + WOF_gUT); }
    __device__ __forceinline__ float* ggam() const { return (float*)(ws + WOF_ggam); }
    __device__ __forceinline__ bf16_t* gWn() const { return (bf16_t*)(ws + WOF_gWn); }
    __device__ __forceinline__ bf16_t* gQg() const { return (bf16_t*)(ws + WOF_gQg); }
    __device__ __forceinline__ bf16_t* gQK() const { return (bf16_t*)(ws + WOF_gQK); }
    __device__ __forceinline__ bf16_t* gKd() const { return (bf16_t*)(ws + WOF_gKd); }
    __device__ __forceinline__ bf16_t* qan() const { return (bf16_t*)(ws + WOF_qan); }
    __device__ __forceinline__ bf16_t* ckvb() const { return (bf16_t*)(ws + WOF_ckvb); }
    __device__ __forceinline__ float* krf() const { return (float*)(ws + WOF_krf); }
    __device__ __forceinline__ float* Q() const { return (float*)(ws + WOF_Q); }
    __device__ __forceinline__ float* qh() const { return (float*)(ws + WOF_qh); }
    __device__ __forceinline__ float* KV() const { return (float*)(ws + WOF_KV); }
    __device__ __forceinline__ float* kh() const { return (float*)(ws + WOF_kh); }
    __device__ __forceinline__ bf16_t* omix() const { return (bf16_t*)(ws + WOF_omix); }
    __device__ __forceinline__ bf16_t* KN() const { return (bf16_t*)(ws + WOF_KN); }
    __device__ __forceinline__ float* SC() const { return (float*)(ws + WOF_SC); }
    __device__ __forceinline__ float* part() const { return (float*)(ws + WOF_part); }
    __device__ __forceinline__ bf16_t* H() const { return (bf16_t*)(ws + WOF_H); }
    __device__ __forceinline__ bf16_t* un() const { return (bf16_t*)(ws + WOF_un); }
    __device__ __forceinline__ float* G() const { return (float*)(ws + WOF_G); }
    __device__ __forceinline__ bf16_t* hid() const { return (bf16_t*)(ws + WOF_hid); }
    __device__ __forceinline__ bf16_t* H2() const { return (bf16_t*)(ws + WOF_H2); }
    __device__ __forceinline__ bf16_t* un2() const { return (bf16_t*)(ws + WOF_un2); }
    __device__ __forceinline__ bf16_t* PP() const { return (bf16_t*)(ws + WOF_PP); }
    __device__ __forceinline__ bf16_t* qraw() const { return (bf16_t*)(ws + WOF_qraw); }
    __device__ __forceinline__ bf16_t* kvraw() const { return (bf16_t*)(ws + WOF_kvraw); }
    __device__ __forceinline__ bf16_t* krb() const { return (bf16_t*)(ws + WOF_krb); }
};

__device__ __forceinline__ float fast_sigmoid(float x) { return __builtin_amdgcn_rcpf(1.f + __builtin_amdgcn_exp2f(-1.44269504f * x)); }
struct PinTok { bf16x8 qa, cv, kr; float ab; };
struct PinGain { float gqa[8], gkv[8], gkr[8], dtb, alog; };
__device__ __forceinline__ PinTok pin_load(const MK& a, int row, int lane) {
    const bf16_t* z = a.Z() + (size_t)row * ZW; PinTok t; const bf16x8 zz = {0, 0, 0, 0, 0, 0, 0, 0};
    t.qa = lane < 48 ? *(const bf16x8*)(z + OFF_QA + 8 * lane) : zz; t.cv = lane < 32 ? *(const bf16x8*)(z + OFF_KVA + 8 * lane) : zz;
    t.kr = (lane >= 32 && lane < 36) ? *(const bf16x8*)(z + OFF_KR + 8 * (lane - 32)) : zz; t.ab = lane < 16 ? bf2f(z[OFF_A + lane]) : 0.f; return t;
}
__device__ __forceinline__ void post_in_token(const MK& a, int row, int lane, const float* wcs, const bf16x8 (&w0)[3], const bf16x8 (&w1)[3], const bf16x8 (&w2)[3], const bf16x8 (&wcur)[3], const PinTok& tk, const PinGain& gn) {
    const bool samp = row >= NPT;
    const int b = samp ? row - NPT : row >> 11, t = samp ? 0 : row & 2047, hd = lane >> 3;
    float y[24];
#pragma unroll
    for (int c3 = 0; c3 < 3; ++c3) {
        float p0[8], p1[8], p2[8], cu[8];
        bf8_to_f32(w0[c3], p0); bf8_to_f32(w1[c3], p1); bf8_to_f32(w2[c3], p2); bf8_to_f32(wcur[c3], cu);
        const float* wp = wcs + 512 * c3 + 8 * lane;
        const float4 a0 = *(const float4*)wp, a1 = *(const float4*)(wp + 4), b0 = *(const float4*)(wp + 1536), b1 = *(const float4*)(wp + 1540);
        const float4 c0 = *(const float4*)(wp + 3072), c1 = *(const float4*)(wp + 3076), d0 = *(const float4*)(wp + 4608), d1 = *(const float4*)(wp + 4612);
        const float k0[8] = {a0.x, a0.y, a0.z, a0.w, a1.x, a1.y, a1.z, a1.w}, k1[8] = {b0.x, b0.y, b0.z, b0.w, b1.x, b1.y, b1.z, b1.w};
        const float k2[8] = {c0.x, c0.y, c0.z, c0.w, c1.x, c1.y, c1.z, c1.w}, k3[8] = {d0.x, d0.y, d0.z, d0.w, d1.x, d1.y, d1.z, d1.w};
#pragma unroll
        for (int e = 0; e < 8; ++e) { const int c = 8 * c3 + e; const float v = k0[e] * p0[e] + k1[e] * p1[e] + k2[e] * p2[e] + k3[e] * cu[e]; y[c] = v * fast_sigmoid(v); }
        __builtin_amdgcn_sched_barrier(0);
    }
    float sq = 0.f, sk = 0.f;
#pragma unroll
    for (int e = 0; e < 8; ++e) { sq += y[e] * y[e]; sk += y[8 + e] * y[8 + e]; }
    sq += __shfl_xor(sq, 1); sk += __shfl_xor(sk, 1); sq += __shfl_xor(sq, 2); sk += __shfl_xor(sk, 2); sq += __shfl_xor(sq, 4); sk += __shfl_xor(sk, 4);
    const float rq = rsqrtf(sq + EPSV) * 0.125f, rk = rsqrtf(sk + EPSV);
#pragma unroll
    for (int e = 0; e < 8; ++e) { y[e] *= rq; y[8 + e] *= rk; }
    bf16_t* qo = a.qkv() + (size_t)row * 1536 + 8 * lane;
    *(bf16x8*)qo = f32_to_bf8(y); *(bf16x8*)(qo + 512) = f32_to_bf8(y + 8); *(bf16x8*)(qo + 1024) = f32_to_bf8(y + 16);
    if (!samp && t >= SEQ - 3) {
        float* cso = a.out + O_CSP + ((size_t)b * 3 + (t - (SEQ - 3))) * 1536 + 8 * lane;
#pragma unroll
        for (int j = 0; j < 3; ++j) { float cu[8]; bf8_to_f32(wcur[j], cu); *(float4*)(cso + 512 * j) = (float4){cu[0], cu[1], cu[2], cu[3]}; *(float4*)(cso + 512 * j + 4) = (float4){cu[4], cu[5], cu[6], cu[7]}; }
    }
    if (lane < 16) {
        const float v = tk.ab;
        if (lane < 8) { const float xx = v + gn.dtb; const float sp = xx > 20.f ? xx : log1pf(expf(xx)); a.gg()[(size_t)row * 8 + lane] = -gn.alog * sp; }
        else a.bb()[(size_t)row * 8 + lane - 8] = 1.f / (1.f + expf(-v));
    }
    __builtin_amdgcn_sched_barrier(0);
    float qa[8], cv[8], kr[8];
    bf8_to_f32(tk.qa, qa); bf8_to_f32(tk.cv, cv); bf8_to_f32(tk.kr, kr);
    float s1 = 0.f, s2 = 0.f, s3 = 0.f;
#pragma unroll
    for (int e = 0; e < 8; ++e) { s1 += qa[e] * qa[e]; s2 += cv[e] * cv[e]; s3 += kr[e] * kr[e]; }
#pragma unroll
    for (int o = 1; o < 64; o <<= 1) { s1 += __shfl_xor(s1, o); s2 += __shfl_xor(s2, o); s3 += __shfl_xor(s3, o); }
    const float r1 = rsqrtf(s1 * (1.f / 384.f) + EPSV), r2 = rsqrtf(s2 * (1.f / 256.f) + EPSV), r3 = rsqrtf(s3 * (1.f / 32.f) + EPSV);
    if (lane < 48) {
        float o[8];
#pragma unroll
        for (int e = 0; e < 8; ++e) o[e] = qa[e] * r1 * gn.gqa[e];
        *(bf16x8*)(a.qan() + (size_t)row * 384 + 8 * lane) = f32_to_bf8(o);
    }
    if (lane < 32) {
        float o[8];
#pragma unroll
        for (int e = 0; e < 8; ++e) o[e] = cv[e] * r2 * gn.gkv[e];
        *(bf16x8*)(a.ckvb() + (size_t)row * 256 + 8 * lane) = f32_to_bf8(o);
        float* co = samp ? a.out + O_CKVS + (size_t)b * 256 + 8 * lane : a.out + O_CKVP + (size_t)row * 256 + 8 * lane;
        *(float4*)co = (float4){o[0], o[1], o[2], o[3]}; *(float4*)(co + 4) = (float4){o[4], o[5], o[6], o[7]};
    }
    __builtin_amdgcn_sched_barrier(0);
    {
        const int c4 = (lane - 32) & 3;
        float xn[8], ot[8];
#pragma unroll
        for (int e = 0; e < 8; ++e) xn[e] = kr[e] * r3 * gn.gkr[e];
#pragma unroll
        for (int e = 0; e < 8; ++e) ot[e] = __shfl_xor(xn[e], 2);
        if (lane >= 32 && lane < 36) {
            const float* tb = a.ropecs() + (size_t)(samp ? 2048 : t) * 32 + ((8 * c4) & 15);
            const float4 c0 = *(const float4*)tb, c1 = *(const float4*)(tb + 4), s0 = *(const float4*)(tb + 16), s1 = *(const float4*)(tb + 20);
            const float csv[8] = {c0.x, c0.y, c0.z, c0.w, c1.x, c1.y, c1.z, c1.w}, snv[8] = {s0.x, s0.y, s0.z, s0.w, s1.x, s1.y, s1.z, s1.w};
            float o[8];
#pragma unroll
            for (int e = 0; e < 8; ++e) o[e] = c4 < 2 ? xn[e] * csv[e] - ot[e] * snv[e] : ot[e] * snv[e] + xn[e] * csv[e];
            float* kf_ = a.krf() + (size_t)row * 32 + 8 * c4; *(float4*)kf_ = (float4){o[0], o[1], o[2], o[3]}; *(float4*)(kf_ + 4) = (float4){o[4], o[5], o[6], o[7]};
            float* ko = samp ? a.out + O_KRS + (size_t)b * 32 + 8 * c4 : a.out + O_KRP + (size_t)row * 32 + 8 * c4;
            *(float4*)ko = (float4){o[0], o[1], o[2], o[3]}; *(float4*)(ko + 4) = (float4){o[4], o[5], o[6], o[7]};
            if (!samp) *(bf16x8*)(a.krb() + (size_t)row * 32 + 8 * c4) = f32_to_bf8(o);
        }
    }
    (void)hd;
}
__device__ __forceinline__ void post_in_run(const MK& a, int run, int lane_in, const float* wcs) {
    int lane = lane_in; asm volatile("" : "+v"(lane));
    PinGain gn;
    {
        const int lq = lane < 48 ? lane : 0, lk = lane < 32 ? lane : 0, c4 = (lane - 32) & 3;
#pragma unroll
        for (int e = 0; e < 8; ++e) { gn.gqa[e] = a.g_q_a[8 * lq + e]; gn.gkv[e] = a.g_kv_a[8 * lk + e]; gn.gkr[e] = a.g_k_rope[8 * c4 + e]; }
        gn.dtb = a.dt_bias[lane & 7]; gn.alog = expf(a.a_log[lane & 7]);
    }
    if (run < NPT / 8) {
        const int row0 = run * 8, t0 = row0 & 2047;
        bf16x8 w0[3], w1[3], w2[3], wcur[3];
#pragma unroll
        for (int c3 = 0; c3 < 3; ++c3) {
            const bf16x8 zz = {0, 0, 0, 0, 0, 0, 0, 0}; w0[c3] = zz; w1[c3] = zz; w2[c3] = zz;
            if (t0 > 0) { const bf16_t* zp = a.Z() + (size_t)(row0 - 3) * ZW + 512 * c3 + 8 * lane; w0[c3] = *(const bf16x8*)zp; w1[c3] = *(const bf16x8*)(zp + ZW); w2[c3] = *(const bf16x8*)(zp + 2 * ZW); }
        }
        bf16x8 wnext[3]; PinTok tk, tkn;
#pragma unroll
        for (int c3 = 0; c3 < 3; ++c3) wnext[c3] = *(const bf16x8*)(a.Z() + (size_t)row0 * ZW + 512 * c3 + 8 * lane);
        tkn = pin_load(a, row0, lane);
#pragma unroll 1
        for (int k = 0; k < 8; ++k) {
            const int row = row0 + k;
#pragma unroll
            for (int c3 = 0; c3 < 3; ++c3) wcur[c3] = wnext[c3];
            tk = tkn;
            if (k < 7) {
#pragma unroll
                for (int c3 = 0; c3 < 3; ++c3) wnext[c3] = *(const bf16x8*)(a.Z() + (size_t)(row + 1) * ZW + 512 * c3 + 8 * lane);
                tkn = pin_load(a, row + 1, lane);
            }
            post_in_token(a, row, lane, wcs, w0, w1, w2, wcur, tk, gn);
#pragma unroll
            for (int c3 = 0; c3 < 3; ++c3) { w0[c3] = w1[c3]; w1[c3] = w2[c3]; w2[c3] = wcur[c3]; }
        }
    } else {
        {
            const int bsm = run - NPT / 8, row = NPT + bsm;
            bf16x8 w0[3], w1[3], w2[3], wcur[3];
#pragma unroll
            for (int c3 = 0; c3 < 3; ++c3) {
                const float* sp = a.state_conv + (size_t)bsm * 3 * 1536 + 512 * c3 + 8 * lane;
                float* cso = a.out + O_CSS + (size_t)bsm * 3 * 1536 + 512 * c3 + 8 * lane;
                float t0_[8], t1_[8], t2_[8], tc_[8];
#pragma unroll
                for (int e = 0; e < 8; ++e) { t0_[e] = sp[e]; t1_[e] = sp[1536 + e]; t2_[e] = sp[2 * 1536 + e]; }
                wcur[c3] = *(const bf16x8*)(a.Z() + (size_t)row * ZW + 512 * c3 + 8 * lane); bf8_to_f32(wcur[c3], tc_);
#pragma unroll
                for (int e = 0; e < 8; ++e) { cso[e] = t1_[e]; cso[1536 + e] = t2_[e]; cso[2 * 1536 + e] = tc_[e]; }
                w0[c3] = f32_to_bf8(t0_); w1[c3] = f32_to_bf8(t1_); w2[c3] = f32_to_bf8(t2_);
            }
            post_in_token(a, row, lane, wcs, w0, w1, w2, wcur, pin_load(a, row, lane), gn);
        }
    }
}

__device__ __forceinline__ void post_q_item(const MK& a, int idx, int lane) {
    const int row = idx >> 3, h = idx & 7;
    const float* q = a.Q() + (size_t)row * 768 + h * 96;
    float* o = a.qh() + ((size_t)row * 8 + h) * 96;
    const float v = q[lane];
    const float ss = wave_sum(v * v);
    o[lane] = v * rsqrtf(ss * (1.f / 64.f) + EPSV) * a.g_q_nope[lane];
    const float r = lane < 32 ? q[64 + lane] : 0.f;
    const float s2 = wave_sum(r * r);
    const float xn = lane < 32 ? r * rsqrtf(s2 * (1.f / 32.f) + EPSV) * a.g_q_rope[lane] : 0.f;
    const float other = __shfl_xor(xn, 16);
    const int i = lane & 15;
    const float* tb = a.ropecs() + (size_t)(row >= NPT ? 2048 : (row & 2047)) * 32;
    const float cs = tb[i], sn = tb[16 + i];
    const float ov = lane < 16 ? xn * cs - other * sn : other * sn + xn * cs;
    if (lane < 32) o[64 + lane] = ov;
}
__device__ __forceinline__ void post_kv_item(const MK& a, int idx, int lane) {
    const int row = idx >> 3, h = idx & 7;
    const float v = a.KV()[(size_t)row * 1024 + h * 128 + lane];
    const float ss = wave_sum(v * v);
    const float kn = v * rsqrtf(ss * (1.f / 64.f) + EPSV) * a.g_k_nope[lane];
    a.kh()[((size_t)row * 8 + h) * 64 + lane] = kn;
}

typedef float f32x16 __attribute__((ext_vector_type(16)));
typedef short s16x4 __attribute__((ext_vector_type(4)));
#define KST 104
#define VST 72
#define ATT_BUF (64 * KST * 2 + 64 * VST * 2)
__device__ __forceinline__ int crow32(int r, int hi) { return (r & 3) + 8 * (r >> 2) + 4 * hi; }
__device__ __forceinline__ s16x4 tr_read(const bf16_t* p) { return __builtin_bit_cast(s16x4, __builtin_amdgcn_ds_read_tr16_b64_v4i16((LAS s16x4*)(LAS void*)(unsigned)(size_t)p)); }
__device__ __forceinline__ bf16x8 pack8(const f32x16& x, int s) {
    u32x4 w; w.x = pk2bf(x[8 * s], x[8 * s + 1]); w.y = pk2bf(x[8 * s + 2], x[8 * s + 3]); w.z = pk2bf(x[8 * s + 4], x[8 * s + 5]); w.w = pk2bf(x[8 * s + 6], x[8 * s + 7]);
    return __builtin_bit_cast(bf16x8, w);
}
__device__ __forceinline__ void attn_block(const MK& a, int b, int h, int qb, char* smem) {
    const int tid = otid(), lane = tid & 63, wid = tid >> 6, r32 = lane & 31, hi = lane >> 5;
    const int qrow = qb * 256 + wid * 32 + r32;
    const int wq0 = qb * 256 + wid * 32;
    bf16x8 qf[6];
    {
        const float SCL = 0.14724445f;
        const bf16_t* Qg = a.qraw() + ((size_t)b * SEQ + qrow) * 768 + h * 96 + 8 * hi;
        float qv[6][8];
#pragma unroll
        for (int ds = 0; ds < 6; ++ds) bf8_to_f32(*(const bf16x8*)(Qg + 16 * ds), qv[ds]);
        float sn_ = 0.f, sr_ = 0.f;
#pragma unroll
        for (int j = 0; j < 8; ++j) { sn_ += qv[0][j] * qv[0][j] + qv[1][j] * qv[1][j] + qv[2][j] * qv[2][j] + qv[3][j] * qv[3][j]; sr_ += qv[4][j] * qv[4][j] + qv[5][j] * qv[5][j]; }
        sn_ += __shfl_xor(sn_, 32); sr_ += __shfl_xor(sr_, 32);
        const float rsn = rsqrtf(sn_ * (1.f / 64.f) + EPSV) * SCL, rsr = rsqrtf(sr_ * (1.f / 32.f) + EPSV);
#pragma unroll
        for (int ds = 0; ds < 4; ++ds) {
            float o[8];
#pragma unroll
            for (int j = 0; j < 8; ++j) o[j] = qv[ds][j] * rsn * a.g_q_nope[16 * ds + 8 * hi + j];
            qf[ds] = f32_to_bf8(o);
        }
        const float* tb = a.ropecs() + (size_t)qrow * 32 + 8 * hi;
        float o4[8], o5[8];
#pragma unroll
        for (int j = 0; j < 8; ++j) {
            const float x1 = qv[4][j] * rsr * a.g_q_rope[8 * hi + j], x2 = qv[5][j] * rsr * a.g_q_rope[16 + 8 * hi + j], cs = tb[j], sn = tb[16 + j];
            o4[j] = (x1 * cs - x2 * sn) * SCL; o5[j] = (x1 * sn + x2 * cs) * SCL;
        }
        qf[4] = f32_to_bf8(o4); qf[5] = f32_to_bf8(o5);
    }
    f32x16 o0, o1;
#pragma unroll
    for (int r = 0; r < 16; ++r) { o0[r] = 0.f; o1[r] = 0.f; }
    float m = -INFINITY, l = 0.f;
    const int nt = qb * 4 + 4;
    const int vr = tid >> 3, vc = tid & 7, rr_ = (tid >> 2) & 63, rc = tid & 3;
    const bf16_t* KVg = a.kvraw() + (size_t)b * SEQ * 1024 + h * 128 + (size_t)vr * 1024 + vc * 8;
    const bf16_t* KRg = a.krb() + (size_t)b * SEQ * 32 + (size_t)rr_ * 32 + rc * 8;
    float gk[8];
#pragma unroll
    for (int j = 0; j < 8; ++j) gk[j] = a.g_k_nope[8 * vc + j];
    bf16x8 kr0, kr1, vr0;
#define ATT_LOAD(tt) do { kr0 = *(const bf16x8*)(KVg + (size_t)(tt) * 64 * 1024); vr0 = *(const bf16x8*)(KVg + (size_t)(tt) * 64 * 1024 + 64); if (tid < 256) kr1 = *(const bf16x8*)(KRg + (size_t)(tt) * 64 * 32); } while (0)
#define ATT_STORE(buf) do { bf16_t* Ks_ = (bf16_t*)(smem + (buf) * ATT_BUF); bf16_t* Vs_ = Ks_ + 64 * KST; \
        float x_[8]; bf8_to_f32(kr0, x_); float ss_ = 0.f; _Pragma("unroll") for (int j = 0; j < 8; ++j) ss_ += x_[j] * x_[j]; \
        ss_ += __shfl_xor(ss_, 1); ss_ += __shfl_xor(ss_, 2); ss_ += __shfl_xor(ss_, 4); const float rs_ = rsqrtf(ss_ * (1.f / 64.f) + EPSV); \
        _Pragma("unroll") for (int j = 0; j < 8; ++j) x_[j] *= rs_ * gk[j]; \
        *(bf16x8*)(Ks_ + vr * KST + vc * 8) = f32_to_bf8(x_); *(bf16x8*)(Vs_ + vr * VST + vc * 8) = vr0; \
        if (tid < 256) *(bf16x8*)(Ks_ + rr_ * KST + 64 + rc * 8) = kr1; } while (0)
    ATT_LOAD(0);
    __syncthreads();
    ATT_STORE(0);
    __syncthreads();
    const int i16 = lane & 15, qq = i16 >> 2, pp = i16 & 3, g1 = (lane >> 4) & 1;
    for (int t = 0; t < nt; ++t) {
        const bf16_t* Ks = (const bf16_t*)(smem + (t & 1) * ATT_BUF); const bf16_t* Vs = Ks + 64 * KST;
        if (t + 1 < nt) ATT_LOAD(t + 1);
        if (64 * t <= wq0 + 31) {
            f32x16 p0, p1;
#pragma unroll
            for (int r = 0; r < 16; ++r) { p0[r] = 0.f; p1[r] = 0.f; }
#pragma unroll
            for (int ds = 0; ds < 6; ++ds) {
                const bf16x8 k0 = *(const bf16x8*)(Ks + r32 * KST + 16 * ds + 8 * hi);
                const bf16x8 k1 = *(const bf16x8*)(Ks + (32 + r32) * KST + 16 * ds + 8 * hi);
                p0 = __builtin_amdgcn_mfma_f32_32x32x16_bf16(k0, qf[ds], p0, 0, 0, 0);
                p1 = __builtin_amdgcn_mfma_f32_32x32x16_bf16(k1, qf[ds], p1, 0, 0, 0);
            }
            if (64 * t + 63 > wq0) {
#pragma unroll
                for (int r = 0; r < 16; ++r) { const int kv = 64 * t + crow32(r, hi); if (kv > qrow) p0[r] = -INFINITY; if (kv + 32 > qrow) p1[r] = -INFINITY; }
            }
            float mx = fmaxf(p0[0], p1[0]);
#pragma unroll
            for (int r = 1; r < 16; ++r) mx = fmaxf(mx, fmaxf(p0[r], p1[r]));
            mx = fmaxf(mx, __shfl_xor(mx, 32));
            const float mn = fmaxf(m, mx);
            const float alpha = __builtin_amdgcn_exp2f(m - mn);
            m = mn;
            float rs = 0.f;
#pragma unroll
            for (int r = 0; r < 16; ++r) { p0[r] = __builtin_amdgcn_exp2f(p0[r] - mn); p1[r] = __builtin_amdgcn_exp2f(p1[r] - mn); rs += p0[r] + p1[r]; }
            l = l * alpha + rs;
#pragma unroll
            for (int r = 0; r < 16; ++r) { o0[r] *= alpha; o1[r] *= alpha; }
            bf16x8 pf[4];
            pf[0] = pack8(p0, 0); pf[1] = pack8(p0, 1); pf[2] = pack8(p1, 0); pf[3] = pack8(p1, 1);
#pragma unroll
            for (int ks = 0; ks < 4; ++ks) {
                const bf16_t* vb0 = Vs + (16 * ks + 4 * hi + qq) * VST + 16 * g1 + 4 * pp;
                const s16x4 a0 = tr_read(vb0), a1 = tr_read(vb0 + 8 * VST);
                const s16x4 c0 = tr_read(vb0 + 32), c1 = tr_read(vb0 + 8 * VST + 32);
                const bf16x8 va = __builtin_shufflevector(a0, a1, 0, 1, 2, 3, 4, 5, 6, 7);
                const bf16x8 vc_ = __builtin_shufflevector(c0, c1, 0, 1, 2, 3, 4, 5, 6, 7);
                o0 = __builtin_amdgcn_mfma_f32_32x32x16_bf16(va, pf[ks], o0, 0, 0, 0);
                o1 = __builtin_amdgcn_mfma_f32_32x32x16_bf16(vc_, pf[ks], o1, 0, 0, 0);
            }
        }
        if (t + 1 < nt) ATT_STORE((t + 1) & 1);
        __syncthreads();
    }
    l += __shfl_xor(l, 32);
    const float il = 1.f / l;
    bf16_t* op = a.omix() + ((size_t)b * SEQ + qrow) * 1024 + 512 + h * 64;
#pragma unroll
    for (int g = 0; g < 4; ++g) {
        uint2 w0, w1;
        w0.x = pk2bf(o0[4 * g] * il, o0[4 * g + 1] * il); w0.y = pk2bf(o0[4 * g + 2] * il, o0[4 * g + 3] * il);
        w1.x = pk2bf(o1[4 * g] * il, o1[4 * g + 1] * il); w1.y = pk2bf(o1[4 * g + 2] * il, o1[4 * g + 3] * il);
        *(uint2*)(op + 8 * g + 4 * hi) = w0;
        *(uint2*)(op + 32 + 8 * g + 4 * hi) = w1;
    }
#undef ATT_LOAD
#undef ATT_STORE
}

__device__ __forceinline__ void gdn_unit(const MK& a, int b, int h, int dvg, const float* s0, float* sout, int row0, int T, int lane, char* wsm) {
    float (*sq)[64] = (float (*)[64])wsm;
    float (*sk)[64] = (float (*)[64])(wsm + 4096);
    float (*sv)[8] = (float (*)[8])(wsm + 8192);
    float* sg = (float*)(wsm + 8704);
    float* sb = (float*)(wsm + 8768);
    const int e = lane & 7, ko = lane >> 3, col = dvg * 8 + e;
    float S[8];
#pragma unroll
    for (int d = 0; d < 8; ++d) S[d] = s0 ? s0[(((size_t)b * 8 + h) * 64 + ko * 8 + d) * 64 + col] : 0.f;
    const size_t rbase = (size_t)row0 + (size_t)b * T;
    float pq[16], pk[16], pv0, pv1, pgb;
    {
        const int nt = T < 16 ? T : 16;
#pragma unroll
        for (int j = 0; j < 16; ++j) { const bool ok = j < nt; const size_t r = rbase + (ok ? j : 0); pq[j] = ok ? bf2f(a.qkv()[r * 1536 + h * 64 + lane]) : 0.f; pk[j] = ok ? bf2f(a.qkv()[r * 1536 + 512 + h * 64 + lane]) : 0.f; }
        { const int j0 = lane >> 3, j1 = j0 + 8; pv0 = j0 < nt ? bf2f(a.qkv()[(rbase + j0) * 1536 + 1024 + h * 64 + dvg * 8 + (lane & 7)]) : 0.f; pv1 = j1 < nt ? bf2f(a.qkv()[(rbase + j1) * 1536 + 1024 + h * 64 + dvg * 8 + (lane & 7)]) : 0.f; }
        { const int j = lane & 15; pgb = j < nt ? (lane < 16 ? a.gg()[(rbase + j) * 8 + h] : a.bb()[(rbase + j) * 8 + h]) : 0.f; }
    }
    for (int t0 = 0; t0 < T; t0 += 16) {
        const int nt = (T - t0) < 16 ? (T - t0) : 16;
        WSYNC();
#pragma unroll
        for (int j = 0; j < 16; ++j) { sq[j][lane] = pq[j]; sk[j][lane] = pk[j]; }
        sv[lane >> 3][lane & 7] = pv0; sv[(lane >> 3) + 8][lane & 7] = pv1;
        if (lane < 16) sg[lane] = expf(pgb); else if (lane < 32) sb[lane - 16] = pgb;
        WSYNC();
        if (t0 + 16 < T) {
            const size_t rb = rbase + t0 + 16;
#pragma unroll
            for (int j = 0; j < 16; ++j) { pq[j] = bf2f(a.qkv()[(rb + j) * 1536 + h * 64 + lane]); pk[j] = bf2f(a.qkv()[(rb + j) * 1536 + 512 + h * 64 + lane]); }
            pv0 = bf2f(a.qkv()[(rb + (lane >> 3)) * 1536 + 1024 + h * 64 + dvg * 8 + (lane & 7)]); pv1 = bf2f(a.qkv()[(rb + (lane >> 3) + 8) * 1536 + 1024 + h * 64 + dvg * 8 + (lane & 7)]);
            pgb = lane < 16 ? a.gg()[(rb + (lane & 15)) * 8 + h] : a.bb()[(rb + (lane & 15)) * 8 + h];
        }
        for (int j = 0; j < nt; ++j) {
            const float dec = sg[j], be = sb[j], v = sv[j][e];
            const float4 k0 = *(const float4*)&sk[j][ko * 8], k1 = *(const float4*)&sk[j][ko * 8 + 4];
            const float4 q0 = *(const float4*)&sq[j][ko * 8], q1 = *(const float4*)&sq[j][ko * 8 + 4];
            const float kk[8] = {k0.x, k0.y, k0.z, k0.w, k1.x, k1.y, k1.z, k1.w};
            const float qq[8] = {q0.x, q0.y, q0.z, q0.w, q1.x, q1.y, q1.z, q1.w};
            float ks = 0.f;
#pragma unroll
            for (int d = 0; d < 8; ++d) { S[d] *= dec; ks += kk[d] * S[d]; }
            ks += __shfl_xor(ks, 8); ks += __shfl_xor(ks, 16); ks += __shfl_xor(ks, 32);
            const float delta = (v - ks) * be;
            float ov = 0.f;
#pragma unroll
            for (int d = 0; d < 8; ++d) { S[d] += kk[d] * delta; ov += qq[d] * S[d]; }
            ov += __shfl_xor(ov, 8); ov += __shfl_xor(ov, 16); ov += __shfl_xor(ov, 32);
            if (ko == 0) a.goraw()[(rbase + t0 + j) * 512 + h * 64 + col] = ov;
        }
    }
#pragma unroll
    for (int d = 0; d < 8; ++d) sout[(((size_t)b * 8 + h) * 64 + ko * 8 + d) * 64 + col] = S[d];
}
__device__ __forceinline__ bf16x8 ld8_f32_bf16(const float* p) {
    const float4 x = *(const float4*)p, y = *(const float4*)(p + 4);
    u32x4 w; w.x = cvtpk(x.x, x.y); w.y = cvtpk(x.z, x.w); w.z = cvtpk(y.x, y.y); w.w = cvtpk(y.z, y.w);
    return __builtin_bit_cast(bf16x8, w);
}
__device__ __forceinline__ int pi_pos(int k) { return (k & 32) + 8 * ((k >> 2) & 3) + 4 * ((k >> 4) & 1) + (k & 3); }
#define GDN_WLDS 17408
__device__ __forceinline__ void gdn_prep_unit(const MK& a, int u, int lane_in, char* wsm) {
    int lane = lane_in; asm volatile("" : "+v"(lane));
    const int bh = u >> 5, n = u & 31, b = bh >> 3, h = bh & 7, i16 = lane & 15, q4 = lane >> 4;
    const size_t row0 = (size_t)b * SEQ + n * 64;
    float* AT = (float*)wsm; float* GC = (float*)(wsm + 16384); float* BT = GC + 64;
    const bf16_t* qbase = a.qkv() + row0 * 1536 + h * 64; const bf16_t* kbase = qbase + 512; const bf16_t* vbase = qbase + 1024;
    float g = a.gg()[(row0 + lane) * 8 + h];
    const float be_l = a.bb()[(row0 + lane) * 8 + h];
#pragma unroll
    for (int o = 1; o < 64; o <<= 1) { const float t = __shfl_up(g, o); if (lane >= o) g += t; }
    WSYNC();
    GC[lane] = g; BT[lane] = be_l;
    WSYNC();
    const float gl = GC[63];
    float* EG = BT + 64; float* ED = EG + 64;
    EG[lane] = expf(g); ED[lane] = expf(gl - g);
    WSYNC();
    bf16x8 kf[4][2], qf[4][2];
#pragma unroll
    for (int mt = 0; mt < 4; ++mt)
#pragma unroll
        for (int ks = 0; ks < 2; ++ks) {
            const int off = (16 * mt + i16) * 1536 + 32 * ks + 8 * q4;
            kf[mt][ks] = *(const bf16x8*)(kbase + off); qf[mt][ks] = *(const bf16x8*)(qbase + off);
        }
    bf16_t* QKg = a.gQK() + (size_t)u * 4096;
#pragma unroll
    for (int mt = 0; mt < 4; ++mt)
#pragma unroll
        for (int nt = 0; nt < 4; ++nt) {
            const int j = 16 * nt + i16, pj = 32 * (nt >> 1) + 8 * (i16 >> 2) + 4 * (nt & 1) + (i16 & 3);
            if (nt <= mt) {
                f32x4 d1 = {0.f, 0.f, 0.f, 0.f}, d2 = {0.f, 0.f, 0.f, 0.f};
#pragma unroll
                for (int ks = 0; ks < 2; ++ks) {
                    d1 = __builtin_amdgcn_mfma_f32_16x16x32_bf16(kf[mt][ks], kf[nt][ks], d1, 0, 0, 0);
                    d2 = __builtin_amdgcn_mfma_f32_16x16x32_bf16(qf[mt][ks], kf[nt][ks], d2, 0, 0, 0);
                }
                const float gcj = GC[j];
#pragma unroll
                for (int r = 0; r < 4; ++r) {
                    const int i = 16 * mt + 4 * q4 + r;
                    const float dec = __builtin_amdgcn_exp2f(1.44269504f * (GC[i] - gcj));
                    AT[i * 64 + j] = (i > j) ? BT[i] * d1[r] * dec : 0.f;
                    QKg[i * 64 + (((pj >> 3) ^ (i & 7)) << 3) + (pj & 7)] = f2bf((i >= j) ? d2[r] * dec : 0.f);
                }
            } else {
#pragma unroll
                for (int r = 0; r < 4; ++r) { const int i = 16 * mt + 4 * q4 + r; QKg[i * 64 + (((pj >> 3) ^ (i & 7)) << 3) + (pj & 7)] = 0; }
            }
        }
    {
        bf16_t* Qgg = a.gQg() + (size_t)u * 4096;
#pragma unroll
        for (int mt = 0; mt < 4; ++mt) {
            const int i = 16 * mt + i16; const float e = EG[i];
#pragma unroll
            for (int ks = 0; ks < 2; ++ks) {
                float x[8]; bf8_to_f32(qf[mt][ks], x);
                uint2 w0, w1; w0.x = cvtpk(x[0] * e, x[1] * e); w0.y = cvtpk(x[2] * e, x[3] * e); w1.x = cvtpk(x[4] * e, x[5] * e); w1.y = cvtpk(x[6] * e, x[7] * e);
                const int p0 = 32 * ks + 16 * (q4 & 1) + 4 * (q4 >> 1);
                *(uint2*)(Qgg + i * 64 + (((p0 >> 3) ^ (i & 7)) << 3) + (p0 & 7)) = w0; *(uint2*)(Qgg + i * 64 + ((((p0 >> 3) + 1) ^ (i & 7)) << 3) + (p0 & 7)) = w1;
            }
        }
    }
    WSYNC();
    __builtin_amdgcn_sched_barrier(0);
    {
        float U[64];
#pragma unroll
        for (int i = 0; i < 64; ++i) { U[i] = bf2f(vbase[i * 1536 + lane]) * BT[i]; }
#pragma unroll
        for (int i = 1; i < 64; ++i) {
            float su = 0.f;
#pragma unroll
            for (int j4 = 0; j4 < i; j4 += 4) {
                const float4 av = *(const float4*)(AT + i * 64 + j4);
                su += av.x * U[j4];
                if (j4 + 1 < i) su += av.y * U[j4 + 1];
                if (j4 + 2 < i) su += av.z * U[j4 + 2];
                if (j4 + 3 < i) su += av.w * U[j4 + 3];
            }
            U[i] -= su;
            __builtin_amdgcn_sched_barrier(0);
        }
        float* UTg = a.gUT() + ((size_t)u * 64 + lane) * 64;
#pragma unroll
        for (int i = 0; i < 64; i += 4) *(float4*)(UTg + 4 * ((i >> 2) ^ (lane & 15))) = (float4){U[i], U[i + 1], U[i + 2], U[i + 3]};
    }
    asm volatile("" ::: "memory");
    __builtin_amdgcn_sched_barrier(0);
    {
        float W[64];
#pragma unroll
        for (int i = 0; i < 64; ++i) { W[i] = bf2f(kbase[i * 1536 + lane]); }
        bf16_t* Kdg = a.gKd() + ((size_t)u * 64 + lane) * 64;
#pragma unroll
        for (int pc = 0; pc < 8; ++pc) {
            float t[8];
#pragma unroll
            for (int jj = 0; jj < 8; ++jj) { const int j = 32 * (pc >> 2) + 16 * (jj >> 2) + 4 * (pc & 3) + (jj & 3); t[jj] = W[j] * ED[j]; }
            u32x4 w; w.x = cvtpk(t[0], t[1]); w.y = cvtpk(t[2], t[3]); w.z = cvtpk(t[4], t[5]); w.w = cvtpk(t[6], t[7]);
            *(u32x4*)(Kdg + 8 * (pc ^ (lane & 7))) = w;
        }
#pragma unroll
        for (int i = 0; i < 64; ++i) W[i] *= BT[i] * EG[i];
#pragma unroll
        for (int i = 1; i < 64; ++i) {
            float sw = 0.f;
#pragma unroll
            for (int j4 = 0; j4 < i; j4 += 4) {
                const float4 av = *(const float4*)(AT + i * 64 + j4);
                sw += av.x * W[j4];
                if (j4 + 1 < i) sw += av.y * W[j4 + 1];
                if (j4 + 2 < i) sw += av.z * W[j4 + 2];
                if (j4 + 3 < i) sw += av.w * W[j4 + 3];
            }
            W[i] -= sw;
            __builtin_amdgcn_sched_barrier(0);
        }
        bf16_t* Wng = a.gWn() + (size_t)u * 4096; const int pp = pi_pos(lane);
#pragma unroll
        for (int i = 0; i < 64; ++i) Wng[i * 64 + (((pp >> 3) ^ (i & 7)) << 3) + (pp & 7)] = f2bf(-W[i]);
    }
    if (lane == 0) a.ggam()[u] = expf(gl);
}
__device__ __forceinline__ bf16x8 pack_acc2(const f32x4& x, const f32x4& y) {
    u32x4 w; w.x = cvtpk(x[0], x[1]); w.y = cvtpk(x[2], x[3]); w.z = cvtpk(y[0], y[1]); w.w = cvtpk(y[2], y[3]);
    return __builtin_bit_cast(bf16x8, w);
}
#define G2_SLOT 49152
__device__ __forceinline__ void g2_issue(const MK& a, size_t u, int n, LAS unsigned char* lds, int lw, int lane) {
    LAS unsigned char* dst = lds + (n % 3) * G2_SLOT;
    const char* srcs[4] = {(const char*)(a.gWn() + u * 4096), (const char*)(a.gQg() + u * 4096), (const char*)(a.gQK() + u * 4096), (const char*)(a.gKd() + u * 4096)};
#pragma unroll
    for (int m = 0; m < 4; ++m)
#pragma unroll
        for (int i = 0; i < 2; ++i) { const int piece = 2 * lw + i;
            __builtin_amdgcn_global_load_lds((const unsigned*)(srcs[m] + piece * 1024 + lane * 16), (LAS unsigned*)(dst + m * 8192 + piece * 1024), 16, 0, 0); }
    const char* us = (const char*)(a.gUT() + u * 4096);
#pragma unroll
    for (int i = 0; i < 4; ++i) { const int piece = 4 * lw + i;
        __builtin_amdgcn_global_load_lds((const unsigned*)(us + piece * 1024 + lane * 16), (LAS unsigned*)(dst + 32768 + piece * 1024), 16, 0, 0); }
}
__device__ __forceinline__ void gdn_scan_block(const MK& a, int bh, LAS unsigned char* lds) {
    const int tid = otid(), lane = tid & 63, wid = __builtin_amdgcn_readfirstlane(tid >> 6), i16 = lane & 15, q4 = lane >> 4;
    const int b = bh >> 3, h = bh & 7, sl = wid & 3;
    const bool loader = wid >= 4;
    f32x4 S[4];
#pragma unroll
    for (int mt = 0; mt < 4; ++mt) S[mt] = (f32x4){0.f, 0.f, 0.f, 0.f};
    __syncthreads();
    if (loader) { g2_issue(a, (size_t)bh * 32, 0, lds, wid - 4, lane); g2_issue(a, (size_t)bh * 32 + 1, 1, lds, wid - 4, lane); }
    for (int n = 0; n < 32; ++n) {
        if (loader) { if (n < 31) asm volatile("s_waitcnt vmcnt(12)" ::: "memory"); else asm volatile("s_waitcnt vmcnt(0)" ::: "memory"); }
        asm volatile("s_waitcnt lgkmcnt(0)" ::: "memory"); __builtin_amdgcn_s_barrier(); asm volatile("" ::: "memory");
        if (loader) { if (n + 2 < 32) g2_issue(a, (size_t)bh * 32 + n + 2, n + 2, lds, wid - 4, lane); }
        else {
            const LAS unsigned char* sb = lds + (n % 3) * G2_SLOT;
            const float gam = a.ggam()[(size_t)bh * 32 + n];
            bf16x8 Sb[2]; Sb[0] = pack_acc2(S[0], S[1]); Sb[1] = pack_acc2(S[2], S[3]);
            f32x4 Vn[4];
#pragma unroll
            for (int mt = 0; mt < 4; ++mt) Vn[mt] = *(const LAS f32x4*)(sb + 32768 + (16 * sl + i16) * 256 + 16 * ((4 * mt + q4) ^ i16));
#pragma unroll
            for (int mt = 0; mt < 4; ++mt)
#pragma unroll
                for (int ks = 0; ks < 2; ++ks) Vn[mt] = __builtin_amdgcn_mfma_f32_16x16x32_bf16(*(const LAS bf16x8*)(sb + (16 * mt + i16) * 128 + 16 * ((4 * ks + q4) ^ (i16 & 7))), Sb[ks], Vn[mt], 0, 0, 0);
            bf16x8 Vb[2]; Vb[0] = pack_acc2(Vn[0], Vn[1]); Vb[1] = pack_acc2(Vn[2], Vn[3]);
            f32x4 O[4];
#pragma unroll
            for (int mt = 0; mt < 4; ++mt) {
                O[mt] = (f32x4){0.f, 0.f, 0.f, 0.f};
#pragma unroll
                for (int ks = 0; ks < 2; ++ks) {
                    const int fo = (16 * mt + i16) * 128 + 16 * ((4 * ks + q4) ^ (i16 & 7));
                    O[mt] = __builtin_amdgcn_mfma_f32_16x16x32_bf16(*(const LAS bf16x8*)(sb + 8192 + fo), Sb[ks], O[mt], 0, 0, 0);
                    O[mt] = __builtin_amdgcn_mfma_f32_16x16x32_bf16(*(const LAS bf16x8*)(sb + 16384 + fo), Vb[ks], O[mt], 0, 0, 0);
                }
            }
#pragma unroll
            for (int mt = 0; mt < 4; ++mt) {
                S[mt] = S[mt] * gam;
#pragma unroll
                for (int ks = 0; ks < 2; ++ks) S[mt] = __builtin_amdgcn_mfma_f32_16x16x32_bf16(*(const LAS bf16x8*)(sb + 24576 + (16 * mt + i16) * 128 + 16 * ((4 * ks + q4) ^ (i16 & 7))), Vb[ks], S[mt], 0, 0, 0);
            }
            float* og = a.goraw() + ((size_t)b * SEQ + n * 64 + 4 * q4) * 512 + h * 64 + 16 * sl + i16;
#pragma unroll
            for (int mt = 0; mt < 4; ++mt)
#pragma unroll
                for (int r = 0; r < 4; ++r) og[(size_t)(16 * mt + r) * 512] = O[mt][r];
        }
    }
    if (!loader) {
        float* so = a.out + O_GSP + ((size_t)bh * 64 + 4 * q4) * 64 + 16 * sl + i16;
#pragma unroll
        for (int mt = 0; mt < 4; ++mt)
#pragma unroll
            for (int r = 0; r < 4; ++r) so[(size_t)(16 * mt + r) * 64] = S[mt][r];
    }
    __syncthreads();
}
__device__ __forceinline__ void gdn_out_token(const MK& a, int row, int lane) {
    const float* op = a.goraw() + (size_t)row * 512 + 8 * lane;
    const float4 x0 = *(const float4*)op, x1 = *(const float4*)(op + 4);
    float o[8] = {x0.x, x0.y, x0.z, x0.w, x1.x, x1.y, x1.z, x1.w}, zg[8];
    bf8_to_f32(*(const bf16x8*)(a.Z() + (size_t)row * ZW + OFF_Z + 8 * lane), zg);
    float ss = 0.f;
#pragma unroll
    for (int e = 0; e < 8; ++e) ss += o[e] * o[e];
    ss += __shfl_xor(ss, 1); ss += __shfl_xor(ss, 2); ss += __shfl_xor(ss, 4);
    const float rs = rsqrtf(ss * (1.f / 64.f) + EPSV);
    const float4 g0 = *(const float4*)(a.g_gdn_out + 8 * (lane & 7)), g1 = *(const float4*)(a.g_gdn_out + 8 * (lane & 7) + 4);
    const float gg_[8] = {g0.x, g0.y, g0.z, g0.w, g1.x, g1.y, g1.z, g1.w};
#pragma unroll
    for (int e = 0; e < 8; ++e) o[e] = o[e] * rs * gg_[e] * zg[e] * fast_sigmoid(zg[e]);
    *(bf16x8*)(a.omix() + (size_t)row * 1024 + 8 * lane) = f32_to_bf8(o);
}

#define SSLOT 32768
#define TL_OFF (3 * SSLOT)
#define CST 264
#define KR_OFF (TL_OFF + 2 * 32 * CST * 2)
#define WQ_OFF (KR_OFF + 4 * 4096)
#define QR_OFF (WQ_OFF + 2048)
#define PG_OFF (QR_OFF + 1024)
#define PT_OFF (PG_OFF + 64)
#define AL_OFF (PT_OFF + 1024)
#define SAMP_LDS_END (AL_OFF + 64)
__device__ __forceinline__ void samp_issue(const MK& a, int g, LAS unsigned char* lds, int wid, int lane) {
    const int phys = __builtin_amdgcn_readfirstlane(((const LAS int*)(lds + PG_OFF))[g >> 2]);
    const int tok0 = (g & 3) * 32 + 4 * wid;
    const float* cs = a.cache_ckv + ((size_t)phys * 128 + tok0) * 256 + lane * 4;
#pragma unroll
    for (int i = 0; i < 4; ++i) __builtin_amdgcn_global_load_lds((const unsigned*)(cs + i * 256), (LAS unsigned*)(lds + (g % 3) * SSLOT + (4 * wid + i) * 1024), 16, 0, 0);
    if (wid < 4) __builtin_amdgcn_global_load_lds((const unsigned*)(a.cache_krope + ((size_t)phys * 128 + (g & 3) * 32 + 8 * wid) * 32 + lane * 4), (LAS unsigned*)(lds + KR_OFF + (g & 3) * 4096 + wid * 1024), 16, 0, 0);
}
__device__ __forceinline__ void samp_convert(int g, LAS unsigned char* lds, int tid) {
    const int st = tid >> 4, c16 = (tid & 15) * 16;
    const LAS float* src = (const LAS float*)(lds + (g % 3) * SSLOT) + st * 256 + c16;
    const f32x4 x0 = *(const LAS f32x4*)src, x1 = *(const LAS f32x4*)(src + 4), x2 = *(const LAS f32x4*)(src + 8), x3 = *(const LAS f32x4*)(src + 12);
    u32x4 w0, w1; w0.x = cvtpk(x0[0], x0[1]); w0.y = cvtpk(x0[2], x0[3]); w0.z = cvtpk(x1[0], x1[1]); w0.w = cvtpk(x1[2], x1[3]);
    w1.x = cvtpk(x2[0], x2[1]); w1.y = cvtpk(x2[2], x2[3]); w1.z = cvtpk(x3[0], x3[1]); w1.w = cvtpk(x3[2], x3[3]);
    LAS bf16_t* dst = (LAS bf16_t*)(lds + TL_OFF + (g & 1) * 32 * CST * 2) + st * CST + c16;
    *(LAS u32x4*)dst = w0; *(LAS u32x4*)(dst + 8) = w1;
}
#define SAMP_WAITV(n5, n4) do { if (h < 4) asm volatile("s_waitcnt vmcnt(" #n5 ")" ::: "memory"); else asm volatile("s_waitcnt vmcnt(" #n4 ")" ::: "memory"); } while (0)
#define SAMP_BAR() do { asm volatile("s_waitcnt lgkmcnt(0)" ::: "memory"); __builtin_amdgcn_s_barrier(); asm volatile("" ::: "memory"); } while (0)
__device__ __forceinline__ void samp_attn_unit(const MK& a, int u, char* smem, LAS unsigned char* lds) {
    const int tid = otid(), lane = tid & 63, h = __builtin_amdgcn_readfirstlane(tid >> 6), i16 = lane & 15, q4 = lane >> 4;
    const int b = u >> 3, sp = u & 7;
    float* WQ = (float*)(smem + WQ_OFF);
    float* QR = (float*)(smem + QR_OFF);
    int* PG = (int*)(smem + PG_OFF);
    const float SCL = 0.14724445f;
    post_q_item(a, (NPT + b) * 8 + h, lane);
    __syncthreads();
    {
        const int h_ = tid >> 6, l_ = tid & 63, q4_ = l_ >> 4, idx = l_ & 15, d = 16 * (idx >> 2) + 4 * q4_ + (idx & 3);
        WQ[tid] = a.g_k_nope[d] * a.qh()[((size_t)(NPT + b) * 8 + h_) * 96 + d] * SCL;
        if (tid < 256) QR[tid] = a.qh()[((size_t)(NPT + b) * 8 + (tid >> 5)) * 96 + 64 + (tid & 31)] * SCL;
        if (tid < 16) PG[tid] = a.page_table[b * NPAGES + sp * 16 + tid];
    }
    bf16x8 wf[4][8];
#pragma unroll
    for (int mt = 0; mt < 4; ++mt)
#pragma unroll
        for (int ks = 0; ks < 8; ++ks) wf[mt][ks] = *(const bf16x8*)(a.WknT() + (size_t)(h * 64 + 16 * mt + i16) * 256 + 32 * ks + 8 * q4);
#pragma unroll
    for (int mt = 0; mt < 4; ++mt)
#pragma unroll
        for (int ks = 0; ks < 8; ++ks) asm volatile("" : "+v"(wf[mt][ks]));
    __syncthreads();
    samp_issue(a, 0, lds, h, lane); samp_issue(a, 1, lds, h, lane); samp_issue(a, 2, lds, h, lane);
    SAMP_WAITV(10, 8);
    SAMP_BAR();
    samp_convert(0, lds, tid);
    const LAS float* QRl = (const LAS float*)(lds + QR_OFF) + h * 32 + 8 * q4;
    const LAS float* WQl = (const LAS float*)(lds + WQ_OFF) + (h * 4 + q4) * 16;
    float m = -INFINITY, lsum = 0.f;
    f32x4 latv[2]; latv[0] = (f32x4){0.f, 0.f, 0.f, 0.f}; latv[1] = (f32x4){0.f, 0.f, 0.f, 0.f};
    for (int g = 0; g < 64; ++g) {
        SAMP_BAR();
        if (g + 3 < 64) samp_issue(a, g + 3, lds, h, lane);
        const LAS bf16_t* Tl = (const LAS bf16_t*)(lds + TL_OFF + (g & 1) * 32 * CST * 2); const LAS float* KR = (const LAS float*)(lds + KR_OFF + (g & 3) * 4096);
        float sc[2];
        {
            f32x4 acc[2][4];
#pragma unroll
            for (int hf = 0; hf < 2; ++hf)
#pragma unroll
                for (int mt = 0; mt < 4; ++mt) acc[hf][mt] = (f32x4){0.f, 0.f, 0.f, 0.f};
            const LAS bf16_t* cp0 = Tl + i16 * CST + 8 * q4; const LAS bf16_t* cp1 = cp0 + 16 * CST;
            bf16x8 c0 = *(const LAS bf16x8*)cp0, c1 = *(const LAS bf16x8*)cp1;
#pragma unroll
            for (int ks = 0; ks < 8; ++ks) {
                bf16x8 n0 = c0, n1 = c1;
                if (ks < 7) { n0 = *(const LAS bf16x8*)(cp0 + 32 * (ks + 1)); n1 = *(const LAS bf16x8*)(cp1 + 32 * (ks + 1)); }
#pragma unroll
                for (int mt = 0; mt < 4; ++mt) { acc[0][mt] = __builtin_amdgcn_mfma_f32_16x16x32_bf16(wf[mt][ks], c0, acc[0][mt], 0, 0, 0); acc[1][mt] = __builtin_amdgcn_mfma_f32_16x16x32_bf16(wf[mt][ks], c1, acc[1][mt], 0, 0, 0); }
                c0 = n0; c1 = n1;
            }
#pragma unroll
            for (int hf = 0; hf < 2; ++hf) {
                float ss = 0.f, dot = 0.f, rd = 0.f;
#pragma unroll
                for (int mt = 0; mt < 4; ++mt) {
                    const f32x4 wq = *(const LAS f32x4*)(WQl + 4 * mt);
                    ss += acc[hf][mt][0] * acc[hf][mt][0] + acc[hf][mt][1] * acc[hf][mt][1] + acc[hf][mt][2] * acc[hf][mt][2] + acc[hf][mt][3] * acc[hf][mt][3];
                    dot += acc[hf][mt][0] * wq[0] + acc[hf][mt][1] * wq[1] + acc[hf][mt][2] * wq[2] + acc[hf][mt][3] * wq[3];
                }
                {
                    const LAS float* kp = KR + (16 * hf + i16) * 32 + 8 * q4;
                    const f32x4 k0 = *(const LAS f32x4*)kp, k1 = *(const LAS f32x4*)(kp + 4), q0 = *(const LAS f32x4*)QRl, q1 = *(const LAS f32x4*)(QRl + 4);
                    rd = k0[0] * q0[0] + k0[1] * q0[1] + k0[2] * q0[2] + k0[3] * q0[3] + k1[0] * q1[0] + k1[1] * q1[1] + k1[2] * q1[2] + k1[3] * q1[3];
                }
                ss += __shfl_xor(ss, 16); dot += __shfl_xor(dot, 16); rd += __shfl_xor(rd, 16);
                ss += __shfl_xor(ss, 32); dot += __shfl_xor(dot, 32); rd += __shfl_xor(rd, 32);
                sc[hf] = dot * rsqrtf(ss * (1.f / 64.f) + EPSV) + rd;
            }
        }
        float gm = fmaxf(sc[0], sc[1]);
#pragma unroll
        for (int o = 1; o < 16; o <<= 1) gm = fmaxf(gm, __shfl_xor(gm, o));
        const float mn = fmaxf(m, gm);
        const float alpha = __builtin_amdgcn_exp2f(m - mn), p0 = __builtin_amdgcn_exp2f(sc[0] - mn), p1 = __builtin_amdgcn_exp2f(sc[1] - mn);
        m = mn;
        lsum = lsum * alpha + p0 + p1;
        if (q4 == 0) { ((LAS float*)(lds + PT_OFF))[h * 32 + i16] = p0; ((LAS float*)(lds + PT_OFF))[h * 32 + 16 + i16] = p1; if (i16 == 0) ((LAS float*)(lds + AL_OFF))[h] = alpha; }
        if (g <= 60) SAMP_WAITV(10, 8); else if (g == 61) SAMP_WAITV(5, 4); else SAMP_WAITV(0, 0);
        SAMP_BAR();
        {
            u32x4 pw = {0u, 0u, 0u, 0u};
            if (i16 < 8) { const f32x4 pa = *(const LAS f32x4*)(lds + PT_OFF + (i16 * 32 + 8 * q4) * 4), pb_ = *(const LAS f32x4*)(lds + PT_OFF + (i16 * 32 + 8 * q4 + 4) * 4);
                pw.x = cvtpk(pa[0], pa[1]); pw.y = cvtpk(pa[2], pa[3]); pw.z = cvtpk(pb_[0], pb_[1]); pw.w = cvtpk(pb_[2], pb_[3]); }
            const bf16x8 pfr = __builtin_bit_cast(bf16x8, pw);
            const f32x4 al = *(const LAS f32x4*)(lds + AL_OFF + (q4 & 1) * 16);
            const bf16_t* tb0 = (const bf16_t*)(smem + TL_OFF + (g & 1) * 32 * CST * 2) + (8 * q4 + (i16 >> 2)) * CST + 32 * h + 4 * (i16 & 3);
#pragma unroll
            for (int nt = 0; nt < 2; ++nt) {
                const s16x4 c0 = tr_read(tb0 + 16 * nt), c1 = tr_read(tb0 + 16 * nt + 4 * CST);
                const bf16x8 cfr = __builtin_shufflevector(c0, c1, 0, 1, 2, 3, 4, 5, 6, 7);
                latv[nt] = latv[nt] * al;
                latv[nt] = __builtin_amdgcn_mfma_f32_16x16x32_bf16(pfr, cfr, latv[nt], 0, 0, 0);
            }
        }
        if (g + 1 < 64) samp_convert(g + 1, lds, tid);
    }
#pragma unroll
    for (int o = 1; o < 16; o <<= 1) lsum += __shfl_xor(lsum, o);
    if (lane == 0) { float* o = a.part() + ((size_t)u * 8 + h) * 260; o[0] = m * 0.69314718f; o[1] = lsum; }
    if (q4 < 2) {
#pragma unroll
        for (int nt = 0; nt < 2; ++nt)
#pragma unroll
            for (int r = 0; r < 4; ++r) a.part()[((size_t)u * 8 + 4 * q4 + r) * 260 + 4 + 32 * h + 16 * nt + i16] = latv[nt][r];
    }
}
__device__ __forceinline__ void samp_comb_unit(const MK& a, int u, char* smem) {
    float* slat = (float*)smem;
    const int b = u >> 3, h = u & 7, tid = otid() & 255;
    const size_t row = NPT + b;
    const float* q = a.qh() + (row * 8 + h) * 96;
    float s_self = 0.f;
    for (int d = 0; d < 64; ++d) s_self += q[d] * a.kh()[(row * 8 + h) * 64 + d];
    for (int d = 0; d < 32; ++d) s_self += q[64 + d] * a.krf()[row * 32 + d];
    s_self *= 0.10206207261596577f;
    float m = s_self;
    for (int s = 0; s < 8; ++s) m = fmaxf(m, a.part()[((size_t)(b * 8 + s) * 8 + h) * 260]);
    const float pself = expf(s_self - m);
    float l = pself, lat = 0.f;
    for (int s = 0; s < 8; ++s) {
        const float* p = a.part() + ((size_t)(b * 8 + s) * 8 + h) * 260;
        const float w = expf(p[0] - m);
        l += p[1] * w; lat += p[4 + tid] * w;
    }
    __syncthreads();
    slat[tid] = lat;
    __syncthreads();
    if (tid < 64) {
        float o = 0.f;
        for (int c = 0; c < 256; ++c) o += slat[c] * a.w_kv_b[(size_t)c * 1024 + h * 128 + 64 + tid];
        o += pself * a.KV()[row * 1024 + h * 128 + 64 + tid];
        a.omix()[row * 1024 + 512 + h * 64 + tid] = f2bf(o / l);
    }
}

#define XB_TMO      128
#define XB_XCNT(j)  (256  + 64 * (j))
#define XB_XSUB(j)  (1280 + 64 * (j))
#define XB_XGEN(j)  (2304 + 64 * (j))
#define XB_TOP      3328
#define XB_TOPGEN   3392
#define XCD_BAR_WORDS 3456
#define XB_SPIN_CAP (1u << 18)

__device__ __forceinline__ unsigned xb_ld(unsigned* p)              { return __hip_atomic_load(p, __ATOMIC_RELAXED, __HIP_MEMORY_SCOPE_AGENT); }
__device__ __forceinline__ unsigned xb_add(unsigned* p, unsigned v) { return __hip_atomic_fetch_add(p, v, __ATOMIC_RELAXED, __HIP_MEMORY_SCOPE_AGENT); }
__device__ __forceinline__ unsigned xb_xcc_id() { return (unsigned)__builtin_amdgcn_s_getreg((3 << 11) | 20) & 0xFu; }
#define XB_SPIN(cond, bar) do { unsigned _sp = 0; while (cond) { __builtin_amdgcn_s_sleep(1); \
    if ((++_sp & 255u) == 0u) { if (xb_ld(&(bar)[XB_TMO])) break; if (_sp > XB_SPIN_CAP) { atomicAdd(&(bar)[XB_TMO], 1u); break; } } } } while (0)

struct XcdBarrier {
    unsigned* bar; unsigned x;
    volatile LAS unsigned* st;
};

__device__ __forceinline__ XcdBarrier xcd_barrier_post(unsigned* bar, volatile LAS unsigned* st) {
    XcdBarrier b; b.bar = bar; b.x = xb_xcc_id(); b.st = st;
    if (threadIdx.x == 0) (void)xb_add(&bar[XB_XCNT(b.x)], 1u);
    return b;
}
__device__ __forceinline__ void xcd_barrier_complete(unsigned* bar, unsigned x, unsigned& nloc, unsigned& nx) {
    const unsigned G = gridDim.x * gridDim.y * gridDim.z;
    unsigned sum, cnt, mine, sp = 0u;
    for (;;) {
        sum = 0u; cnt = 0u; mine = 0u;
#pragma unroll
        for (unsigned j = 0; j < 16; ++j) { const unsigned c = xb_ld(&bar[XB_XCNT(j)]); sum += c; cnt += (c > 0u) ? 1u : 0u; mine = (j == x) ? c : mine; }
        if (sum == G) break;
        __builtin_amdgcn_s_sleep(1);
        if ((++sp & 255u) == 0u) { if (xb_ld(&bar[XB_TMO])) break; if (sp > XB_SPIN_CAP) { atomicAdd(&bar[XB_TMO], 1u); break; } }
    }
    nloc = mine > 0u ? mine : 1u; nx = cnt > 0u ? cnt : 1u;
}

__device__ __forceinline__ void xcd_barrier(const XcdBarrier& b) {
    asm volatile("s_waitcnt vmcnt(0)" ::: "memory");
    __syncthreads();
    if (threadIdx.x == 0) {
        unsigned* bar = b.bar;
        __builtin_amdgcn_s_waitcnt(0);
        unsigned nloc = b.st[0], nx = b.st[1];
        if (nloc == 0u) { xcd_barrier_complete(bar, b.x, nloc, nx); b.st[0] = nloc; b.st[1] = nx; }
        const unsigned old = xb_add(&bar[XB_XSUB(b.x)], 1u);
        const unsigned gen = old / nloc;
        if (old + 1u == (gen + 1u) * nloc) {
            __builtin_amdgcn_fence(__ATOMIC_RELEASE, "agent");
            asm volatile("s_waitcnt vmcnt(0)" ::: "memory");
            const unsigned og = xb_add(&bar[XB_TOP], 1u);
            const unsigned tg = og / nx;
            if (og + 1u == (tg + 1u) * nx) xb_add(&bar[XB_TOPGEN], 1u);
            else XB_SPIN(xb_ld(&bar[XB_TOPGEN]) == tg, bar);
            __builtin_amdgcn_fence(__ATOMIC_ACQUIRE, "agent");
            xb_add(&bar[XB_XGEN(b.x)], 1u);
            asm volatile("s_waitcnt vmcnt(0)" ::: "memory");
        } else {
            XB_SPIN(xb_ld(&bar[XB_XGEN(b.x)]) == gen, bar);
            __builtin_amdgcn_fence(__ATOMIC_ACQUIRE, "agent");
            asm volatile("s_waitcnt vmcnt(0)" ::: "memory");
        }
    }
    __syncthreads();
}

#define XB_ST_OFF 155648
#define LDS_BYTES 155904
static_assert(SAMP_LDS_END <= LDS_BYTES, "LDS map");
#define GSYNC() do { xcd_barrier(xbar); } while (0)
__global__ __launch_bounds__(NTHR, 2) void mega(MK a) {
    cg::grid_group grid = cg::this_grid();
    char* smem = (char*)lds_raw;
    LAS unsigned char* lds = (LAS unsigned char*)lds_raw;
    otid_init();
    if (threadIdx.x < 2) ((LAS unsigned*)(lds_raw + XB_ST_OFF))[threadIdx.x] = 0u;
    __syncthreads();
    const XcdBarrier xbar = xcd_barrier_post(a.ctl(), (volatile LAS unsigned*)(LAS void*)(lds_raw + XB_ST_OFF));
    const int bid = blockIdx.x, nb = gridDim.x, ngw = nb * NWAVE;
#define LOCAL_IDS const int tid = otid(), lane = tid & 63, wid = tid >> 6, half = tid >> 8, gw = bid * NWAVE + wid; (void)lane; (void)half; (void)gw; (void)wid;

    {
    LOCAL_IDS
    {
        const int T0 = 88 * 16, T1 = 24 * 6, T2 = 32 * 4, T3 = 16 * 4, T4 = 32 * 16, T5 = 176 * 16, T7 = 32 * 44, T8 = 32 * 16, T9 = 32 * 4;
        const int TT = T0 + T1 + T2 + T3 + T4 + T5 + T7 + T8 + T9;
        float* scr = (float*)(smem + wid * 8704);
        for (int it = gw; it < TT; it += ngw) {
            int r = it;
            if (r < T0) { const int nt_ = r % 88, kb = r / 88, nv = 2736 - 32 * nt_; wt_item(a.w_in, 2736, 32 * nt_, nv < 0 ? 0 : (nv > 32 ? 32 : nv), a.WinT(), 1024, 32 * nt_, 64 * kb, scr, lane); continue; } r -= T0;
            if (r < T1) { const int nt_ = r % 24, kb = r / 24; wt_item(a.w_q_b, 768, 32 * nt_, 32, a.WqbT(), 384, 32 * nt_, 64 * kb, scr, lane); continue; } r -= T1;
            if (r < T2) { const int nt_ = r % 32, kb = r / 32; wt_item(a.w_kv_b, 1024, 32 * nt_, 32, a.WkvT(), 256, 32 * nt_, 64 * kb, scr, lane); continue; } r -= T2;
            if (r < T3) { const int nt_ = r % 16, kb = r / 16, h = nt_ >> 1; wt_item(a.w_kv_b, 1024, h * 128 + 32 * (nt_ & 1), 32, a.WknT(), 256, 32 * nt_, 64 * kb, scr, lane); continue; } r -= T3;
            if (r < T4) { const int nt_ = r % 32, kb = r / 32; wt_item(a.w_o, 1024, 32 * nt_, 32, a.WoT(), 1024, 32 * nt_, 64 * kb, scr, lane); continue; } r -= T4;
            if (r < T5) { const int nt_ = r % 176, kb = r / 176, pn = nt_ >> 3, wi = nt_ & 7;
                wt_item(wi < 4 ? a.w_gate : a.w_up, DFF, pn * 128 + (wi & 3) * 32, 32, a.WguT(), 1024, 32 * nt_, 64 * kb, scr, lane); continue; } r -= T5;
            if (r < T7) { const int nt_ = r % 32, kb = r / 32; wt_item(a.w_down, 1024, 32 * nt_, 32, a.WdT(), DFF, 32 * nt_, 64 * kb, scr, lane); continue; } r -= T7;
            if (r < T8) { const int nt_ = r % 32, kb = r / 32; wt_item(a.w_ple_gate, 1024, 32 * nt_, 32, a.WpgT(), 1024, 32 * nt_, 64 * kb, scr, lane); continue; } r -= T8;
            { const int nt_ = r % 32, kb = r / 32; wt_item(a.w_ple_proj, 1024, 32 * nt_, 32, a.WppT(), 256, 32 * nt_, 64 * kb, scr, lane); }
        }
        for (int e = (bid * NTHR + tid); e < 2049 * 16; e += nb * NTHR) {
            const int pos = e >> 4, i = e & 15; const float ang = (pos == 2048 ? (float)PAST : (float)pos) * powf(10000.f, -(float)i / 16.f);
            a.ropecs()[pos * 32 + i] = cosf(ang); a.ropecs()[pos * 32 + 16 + i] = sinf(ang);
        }
        for (int row = gw; row < MPAD; row += ngw) {
            const float* src = row < NPT ? a.x_prompt + (size_t)row * 1024 : a.x_sample + (size_t)(row < NTOK ? row - NPT : 0) * 1024;
            rms1024_row(src, a.g_attn, a.xn() + (size_t)row * 1024, row >= NTOK, lane);
            ushort4 w = {0, 0, 0, 0};
            if (row < NTOK) { const float* ps = row < NPT ? a.p_prompt + (size_t)row * 256 : a.p_sample + (size_t)(row - NPT) * 256; const float4 v = *(const float4*)(ps + lane * 4); w.x = f2bf(v.x); w.y = f2bf(v.y); w.z = f2bf(v.z); w.w = f2bf(v.w); }
            *(ushort4*)(a.pb() + (size_t)row * 256 + lane * 4) = w;
            if (row >= NTOK) { for (int j = 0; j < 4; ++j) { ushort4 z = {0, 0, 0, 0}; *(ushort4*)(a.omix() + (size_t)row * 1024 + lane * 4 + 256 * j) = z; } }
        }
    }
    }
    grid.sync();
    {
    LOCAL_IDS
    pg_gemm(lds, a.xn(), a.WinT(), NPT, ZW, 1024, PgBf16{a.Z(), ZW});
    pg_gemm(lds, a.pb(), a.WppT(), NPT, 1024, 256, PgBf16{a.PP(), 1024});
    gemm_sample_rows_ks<false>(a.xn(), 1024, a.WinT(), 1024, ZW, EwBf16{a.Z(), ZW}, smem, bid, nb);
    gemm_sample_rows<false>(a.pb(), 256, a.WppT(), 256, 1024, EwBf16{a.PP(), 1024}, smem, bid, nb);
    }
    GSYNC();
    {
    LOCAL_IDS
    for (int e = tid; e < 4 * 1536 / 4; e += NTHR) ((float4*)smem)[e] = ((const float4*)a.w_conv)[e];
    __syncthreads();
    for (int run = gw; run < NPT / 8 + NST; run += ngw) post_in_run(a, run, lane, (const float*)smem);
    }
    GSYNC();
    {
    LOCAL_IDS
    for (int u = gw; u < 2048; u += ngw) gdn_prep_unit(a, u, lane, smem + wid * GDN_WLDS);
    }
    {
    LOCAL_IDS
    for (int v = gw; v < NST * 64; v += ngw) gdn_unit(a, v >> 6, (v >> 3) & 7, v & 7, a.state_gdn, a.out + O_GSS, NPT, 1, lane, smem + wid * GDN_WLDS);
    __syncthreads();
    }
    GSYNC();
    {
    LOCAL_IDS
    pg_gemm(lds, a.qan(), a.WqbT(), NPT, 768, 384, PgBf16{a.qraw(), 768});
    pg_gemm(lds, a.ckvb(), a.WkvT(), NPT, 1024, 256, PgBf16{a.kvraw(), 1024});
    gemm_sample_rows<false>(a.qan(), 384, a.WqbT(), 384, 768, EwF32{a.Q(), 768}, smem, bid, nb);
    gemm_sample_rows<false>(a.ckvb(), 256, a.WkvT(), 256, 1024, EwF32{a.KV(), 1024}, smem, bid, nb);
    for (int bh_ = nb - 1 - bid; bh_ < 64; bh_ += nb) gdn_scan_block(a, bh_, lds);
    }
    GSYNC();
    {
    LOCAL_IDS
    for (int idx = gw; idx < NST * 8; idx += ngw) { post_q_item(a, NPT * 8 + idx, lane); post_kv_item(a, NPT * 8 + idx, lane); }
    for (int row = gw; row < NTOK; row += ngw) gdn_out_token(a, row, lane);
    for (int pr = bid; pr < 256; pr += nb) { const int bh_ = pr >> 2, s_ = pr & 3; attn_block(a, bh_ >> 3, bh_ & 7, 7 - s_, smem); attn_block(a, bh_ >> 3, bh_ & 7, s_, smem); }
    for (int u = bid; u < NST * 8; u += nb) samp_attn_unit(a, u, smem, lds);
    }
    GSYNC();
    {
    LOCAL_IDS
    for (int u0 = bid * 2; u0 < NST * 8; u0 += nb * 2) samp_comb_unit(a, u0 + half, smem + half * 4096);
    }
    GSYNC();
    {
    LOCAL_IDS
    pg_gemm(lds, a.omix(), a.WoT(), NPT, 1024, 1024, PgResXB{a.x_prompt, a.H()});
    gemm_sample_rows_ks<false>(a.omix(), 1024, a.WoT(), 1024, 1024, EwResX{a.x_sample, a.H()}, smem, bid, nb);
    }
    GSYNC();
    {
    LOCAL_IDS
    for (int row = gw; row < MPAD; row += ngw) rms1024_row_b(a.H() + (size_t)row * 1024, a.g_ffn, a.un() + (size_t)row * 1024, row >= NTOK, lane);
    }
    GSYNC();
    {
    LOCAL_IDS
    pg_gemm(lds, a.un(), a.WguT(), NPT, 2 * DFF, 1024, PgSwiglu{a.hid()});
    gemm_sample_rows_ks<true>(a.un(), 1024, a.WguT(), 1024, 2 * DFF, EwBf16{a.hid(), DFF}, smem, bid, nb);
    }
    GSYNC();
    {
    LOCAL_IDS
    pg_gemm(lds, a.hid(), a.WdT(), NPT, 1024, DFF, PgResBB{a.H(), a.H2()});
    gemm_sample_rows_ks<false>(a.hid(), DFF, a.WdT(), DFF, 1024, EwResH{a.H(), a.H2()}, smem, bid, nb);
    }
    GSYNC();
    {
    LOCAL_IDS
    for (int row = gw; row < MPAD; row += ngw) rms1024_row_b(a.H2() + (size_t)row * 1024, a.g_ple, a.un2() + (size_t)row * 1024, row >= NTOK, lane);
    }
    GSYNC();
    {
    LOCAL_IDS
    pg_gemm(lds, a.un2(), a.WpgT(), NPT, 1024, 1024, PgPleB{a.H2(), a.PP(), a.out});
    gemm_sample_rows_ks<false>(a.un2(), 1024, a.WpgT(), 1024, 1024, EwPle{a.H2(), a.PP(), a.out}, smem, bid, nb);
    }
}

static inline char* carve(char*& p, size_t bytes) { char* r = p; p += (bytes + 255) & ~(size_t)255; return r; }

extern "C" void kernel_launch(void* const* d_in, const int* in_sizes, int n_in, void* d_out, int out_size, void* d_ws, size_t ws_size, hipStream_t stream) {
    MK a{};
    a.x_prompt = (const float*)d_in[0]; a.x_sample = (const float*)d_in[1]; a.cache_ckv = (const float*)d_in[2]; a.cache_krope = (const float*)d_in[3];
    a.state_gdn = (const float*)d_in[4]; a.state_conv = (const float*)d_in[5]; a.page_table = (const int*)d_in[6]; a.p_prompt = (const float*)d_in[7]; a.p_sample = (const float*)d_in[8];
    a.g_attn = (const float*)d_in[9]; a.w_in = (const float*)d_in[10]; a.w_conv = (const float*)d_in[11]; a.a_log = (const float*)d_in[12]; a.dt_bias = (const float*)d_in[13];
    a.g_gdn_out = (const float*)d_in[14]; a.g_q_a = (const float*)d_in[15]; a.w_q_b = (const float*)d_in[16]; a.g_q_nope = (const float*)d_in[17]; a.g_q_rope = (const float*)d_in[18];
    a.g_kv_a = (const float*)d_in[19]; a.g_k_rope = (const float*)d_in[20]; a.w_kv_b = (const float*)d_in[21]; a.g_k_nope = (const float*)d_in[22]; a.w_o = (const float*)d_in[23];
    a.g_ffn = (const float*)d_in[24]; a.w_gate = (const float*)d_in[25]; a.w_up = (const float*)d_in[26]; a.w_down = (const float*)d_in[27]; a.g_ple = (const float*)d_in[28];
    a.w_ple_gate = (const float*)d_in[29]; a.w_ple_proj = (const float*)d_in[30];
    a.out = (float*)d_out;
    a.ws = (char*)d_ws;
    if (WS_TOTAL > ws_size) { fprintf(stderr, "kernel_launch: workspace too small: need %zu have %zu\n", (size_t)WS_TOTAL, ws_size); return; }

    static int grid_blocks = 0;
    if (!grid_blocks) {
        int dev = 0, cus = 0, per_cu = 0;
        (void)hipGetDevice(&dev);
        (void)hipDeviceGetAttribute(&cus, hipDeviceAttributeMultiprocessorCount, dev);
        (void)hipFuncSetAttribute((const void*)mega, hipFuncAttributeMaxDynamicSharedMemorySize, LDS_BYTES);
        (void)hipOccupancyMaxActiveBlocksPerMultiprocessor(&per_cu, (const void*)mega, NTHR, LDS_BYTES);
        if (per_cu < 1) fprintf(stderr, "kernel_launch: occupancy query says %d blocks/CU\n", per_cu);
        grid_blocks = cus;
    }
    (void)hipMemsetAsync((char*)d_ws + WOF_ctl, 0, 16384, stream);
    void* args[] = {&a};
    hipError_t e = hipLaunchCooperativeKernel((const void*)mega, dim3(grid_blocks), dim3(NTHR), args, LDS_BYTES, stream);
    if (e != hipSuccess) fprintf(stderr, "cooperative launch failed: %s (grid %d)\n", hipGetErrorString(e), grid_blocks);
}
```

```cpp
#include <hip/hip_runtime.h>
#include <stdint.h>
#include <cstdio>
#include <hip/hip_cooperative_groups.h>
namespace cg = cooperative_groups;


__device__ __forceinline__ int otid();
#define PG8_TID() otid()
namespace pg8 {
#define PG8_LAS __attribute__((address_space(3)))
typedef unsigned short bf16_t;
typedef short bf16x8 __attribute__((ext_vector_type(8)));
typedef float f32x4 __attribute__((ext_vector_type(4)));
typedef unsigned u32x4 __attribute__((ext_vector_type(4)));
constexpr int BM = 256, BK = 64, HALF = 128, HTB = HALF * BK * 2  , STAGE_BYTES = 8 * HTB, NXCD = 8, WGM = 8;

__host__ __device__ __forceinline__ int lds_byte(int r, int c) { const int st = (r >> 4) * 2 + (c >> 5), rr = r & 15, cc = c & 31, ob = rr * 64 + cc * 2; return st * 1024 + (ob ^ (((ob >> 9) & 1) << 5)); }
__host__ __device__ __forceinline__ void stage_rc(int b, int& R, int& C) { const int st = b / 1024, sb = b % 1024, swz = sb ^ (((sb >> 9) & 1) << 5); R = (st >> 1) * 16 + swz / 64; C = (st & 1) * 32 + (swz % 64) / 2; }
__host__ __device__ __forceinline__ int perm32(int rho) { const int n = rho >> 4, i = rho & 15; return 8 * (i >> 2) + 4 * n + (i & 3); }

struct Unit { int pm, pn; };
struct Gemm { const bf16_t* A; const bf16_t* Bt; int M, N, K; };

struct StaticOrder {
    int nM, nN, nwg, G, c;
    __host__ __device__ void init(int M, int N, int G_, int c_) { nM = M / BM; nN = N / BM; nwg = nM * nN; G = G_; c = c_; }
    __host__ __device__ bool next(int i, Unit& u) const {
        const long L = (long)i * G + c; if (L >= nwg) return false;
        int wgid = (int)L; { const int q = nwg / NXCD, r = nwg % NXCD, xcd = wgid % NXCD, off = wgid / NXCD; wgid = (xcd < r ? xcd * (q + 1) : r * (q + 1) + (xcd - r) * q) + off; }
        const int nig = WGM * nN, gid = wgid / nig, fm = gid * WGM, gsz = (nM - fm) < WGM ? (nM - fm) : WGM;
        u.pm = fm + ((wgid % nig) % gsz); u.pn = (wgid % nig) / gsz; return true;
    }
    __device__ __forceinline__ void a_ready(const Unit&) const {}
    __device__ __forceinline__ void done(const Unit&) const {}
};

template <class Epi, class Sched, bool ALIGN_EPI = false, bool SP2 = false>
__device__ __forceinline__ void gemm_phase(PG8_LAS unsigned char* lds, const Gemm g, const Sched& S, const Epi& E) {
    const int tid = PG8_TID(), wid = __builtin_amdgcn_readfirstlane(tid >> 6), lane = tid & 63, wr = wid >> 2, wc = wid & 3, fr = lane & 15, fq = lane >> 4;
    const int K = g.K, nt = K / BK;
    unsigned voffA[2], voffB[2];
#pragma unroll
    for (int i = 0; i < 2; ++i) { int R, C; stage_rc(tid * 16 + i * 8192, R, C); const int Rb = Epi::PERM ? ((R & ~31) + perm32(R & 31)) : R;
        voffA[i] = (unsigned)(R * K + C) * 2u; voffB[i] = (unsigned)(Rb * K + C) * 2u; }
    const size_t kstep = (size_t)(BK * 2);
    const size_t hstep = (size_t)HALF * K * 2;
    const size_t tstep = 2 * hstep;
    const unsigned ldsw = (unsigned)wid * 1024u;
    const int aoff = lds_byte(wr * 64 + fr, fq * 8), boff = lds_byte(wc * 32 + fr, fq * 8);
#define PG8_SA(b, h) (((b) * 2 + (h)) * HTB)
#define PG8_SB(b, h) ((4 + (b) * 2 + (h)) * HTB)
#define PG8_STAGE(bufoff, gbase, voff) do { _Pragma("unroll") for (int _i = 0; _i < 2; ++_i) \
        __builtin_amdgcn_global_load_lds((const unsigned*)((const char*)(gbase) + (voff)[_i]), (PG8_LAS unsigned*)(lds + (bufoff) + ldsw + _i * 8192), 16, 0, 0); } while (0)
#define PG8_LDA(dst, b, h) do { _Pragma("unroll") for (int m = 0; m < 4; ++m) _Pragma("unroll") for (int k = 0; k < 2; ++k) dst[m][k] = *(const PG8_LAS bf16x8*)(lds + PG8_SA(b, h) + aoff + m * 2048 + k * 1024); } while (0)
#define PG8_LDB(dst, b, h) do { _Pragma("unroll") for (int n = 0; n < 2; ++n) _Pragma("unroll") for (int k = 0; k < 2; ++k) dst[n][k] = *(const PG8_LAS bf16x8*)(lds + PG8_SB(b, h) + boff + n * 2048 + k * 1024); } while (0)
#define PG8_MMA(ai, bj, At, Bt) do { __builtin_amdgcn_s_setprio(1); _Pragma("unroll") for (int m = 0; m < 4; ++m) _Pragma("unroll") for (int n = 0; n < 2; ++n) _Pragma("unroll") for (int k = 0; k < 2; ++k) \
        acc[ai][bj][m][n] = __builtin_amdgcn_mfma_f32_16x16x32_bf16(Bt[n][k], At[m][k], acc[ai][bj][m][n], 0, 0, 0); __builtin_amdgcn_s_setprio(0); } while (0)
#define PG8_WAIT_V(n) asm volatile("s_waitcnt vmcnt(" #n ")" ::: "memory")
#define PG8_WAIT_L(n) asm volatile("s_waitcnt lgkmcnt(" #n ")" ::: "memory")
#define PG8_BAR __builtin_amdgcn_s_barrier()
#define PG8_SCHED __builtin_amdgcn_sched_barrier(0)
    Unit cur, nxt; int ui = 0;
    if (!S.next(0, cur)) return;
    f32x4 acc[2][2][4][2];
#pragma unroll
    for (int a = 0; a < 2; ++a)
#pragma unroll
        for (int b = 0; b < 2; ++b)
#pragma unroll
            for (int m = 0; m < 4; ++m)
#pragma unroll
                for (int n = 0; n < 2; ++n) acc[a][b][m][n] = (f32x4){0.f, 0.f, 0.f, 0.f};
    bf16x8 At[4][2], B0[2][2], B1[2][2];
    const char* cA = (const char*)g.A + (size_t)cur.pm * tstep; const char* cB = (const char*)g.Bt + (size_t)cur.pn * tstep;
    S.a_ready(cur);
    if constexpr (SP2) {
        PG8_STAGE(PG8_SB(0, 0), cB, voffB); PG8_STAGE(PG8_SB(0, 1), cB + hstep, voffB); PG8_STAGE(PG8_SA(0, 0), cA, voffA); PG8_STAGE(PG8_SA(0, 1), cA + hstep, voffA);
        if (wr == 1) PG8_BAR;
        PG8_WAIT_V(2); PG8_BAR;
        PG8_STAGE(PG8_SB(1, 0), cB + kstep, voffB); PG8_STAGE(PG8_SA(1, 0), cA + kstep, voffA); PG8_STAGE(PG8_SB(1, 1), cB + hstep + kstep, voffB);
        PG8_WAIT_V(6); PG8_BAR;
    } else {
        PG8_STAGE(PG8_SB(0, 0), cB, voffB); PG8_STAGE(PG8_SA(0, 0), cA, voffA); PG8_STAGE(PG8_SB(0, 1), cB + hstep, voffB); PG8_STAGE(PG8_SA(0, 1), cA + hstep, voffA);
        if (wr == 1) PG8_BAR;
        PG8_WAIT_V(4); PG8_BAR;
        PG8_STAGE(PG8_SB(1, 0), cB + kstep, voffB); PG8_STAGE(PG8_SA(1, 0), cA + kstep, voffA); PG8_STAGE(PG8_SB(1, 1), cB + hstep + kstep, voffB);
        PG8_WAIT_V(6); PG8_BAR;
    }
    for (;;) {
        const bool has_next = S.next(ui + 1, nxt);
        const char* nA = has_next ? (const char*)g.A + (size_t)nxt.pm * tstep : cA; const char* nB = has_next ? (const char*)g.Bt + (size_t)nxt.pn * tstep : cB;
        for (int t = 0; t < nt; t += 2) {
            const bool last = (t == nt - 2);
            const char* a1 = cA + (size_t)(t + 1) * kstep;
            const char* a2 = last ? nA : cA + (size_t)(t + 2) * kstep; const char* b2 = last ? nB : cB + (size_t)(t + 2) * kstep;
            const char* a3 = a2 + kstep; const char* b3 = b2 + kstep;
            if (last && has_next) S.a_ready(nxt);
            if constexpr (SP2) {
            PG8_LDB(B0, 0, 0); PG8_LDB(B1, 0, 1); PG8_SCHED; PG8_LDA(At, 0, 0); PG8_STAGE(PG8_SA(1, 1), a1 + hstep, voffA);
            PG8_WAIT_V(8); PG8_WAIT_L(0); PG8_BAR; PG8_MMA(0, 0, At, B0); PG8_MMA(0, 1, At, B1); PG8_BAR; PG8_SCHED;
            PG8_LDA(At, 0, 1); PG8_STAGE(PG8_SB(0, 0), b2, voffB); PG8_STAGE(PG8_SB(0, 1), b2 + hstep, voffB); PG8_STAGE(PG8_SA(0, 0), a2, voffA);
            PG8_WAIT_V(8); PG8_WAIT_L(0); PG8_BAR; PG8_MMA(1, 0, At, B0); PG8_MMA(1, 1, At, B1); PG8_BAR; PG8_SCHED;
            PG8_LDB(B0, 1, 0); PG8_LDB(B1, 1, 1); PG8_SCHED; PG8_LDA(At, 1, 0); PG8_STAGE(PG8_SA(0, 1), a2 + hstep, voffA);
            PG8_WAIT_V(8); PG8_WAIT_L(0); PG8_BAR; PG8_MMA(0, 0, At, B0); PG8_MMA(0, 1, At, B1); PG8_BAR; PG8_SCHED;
            PG8_LDA(At, 1, 1); PG8_STAGE(PG8_SB(1, 0), b3, voffB); PG8_STAGE(PG8_SB(1, 1), b3 + hstep, voffB); PG8_STAGE(PG8_SA(1, 0), a3, voffA);
            PG8_WAIT_V(8); PG8_WAIT_L(0); PG8_BAR; PG8_MMA(1, 0, At, B0); PG8_MMA(1, 1, At, B1); PG8_BAR; PG8_SCHED;
            } else {
            PG8_LDB(B0, 0, 0); PG8_SCHED; PG8_LDA(At, 0, 0); PG8_STAGE(PG8_SA(1, 1), a1 + hstep, voffA);
            PG8_WAIT_L(8); PG8_BAR; PG8_WAIT_L(0); PG8_MMA(0, 0, At, B0); PG8_BAR; PG8_SCHED;
            PG8_LDB(B1, 0, 1); PG8_STAGE(PG8_SB(0, 0), b2, voffB);
            PG8_BAR; PG8_WAIT_L(0); PG8_MMA(0, 1, At, B1); PG8_BAR;
            PG8_LDA(At, 0, 1); PG8_STAGE(PG8_SA(0, 0), a2, voffA);
            PG8_BAR; PG8_WAIT_L(0); PG8_MMA(1, 0, At, B0); PG8_BAR; PG8_SCHED;
            PG8_STAGE(PG8_SB(0, 1), b2 + hstep, voffB);
            PG8_WAIT_V(6); PG8_BAR; PG8_MMA(1, 1, At, B1); PG8_BAR;
            PG8_LDB(B0, 1, 0); PG8_SCHED; PG8_LDA(At, 1, 0); PG8_STAGE(PG8_SA(0, 1), a2 + hstep, voffA);
            PG8_WAIT_L(8); PG8_BAR; PG8_WAIT_L(0); PG8_MMA(0, 0, At, B0); PG8_BAR; PG8_SCHED;
            PG8_LDB(B1, 1, 1); PG8_STAGE(PG8_SB(1, 0), b3, voffB);
            PG8_BAR; PG8_WAIT_L(0); PG8_MMA(0, 1, At, B1); PG8_BAR;
            PG8_LDA(At, 1, 1); PG8_STAGE(PG8_SA(1, 0), a3, voffA);
            PG8_BAR; PG8_WAIT_L(0); PG8_MMA(1, 0, At, B0); PG8_BAR; PG8_SCHED;
            PG8_STAGE(PG8_SB(1, 1), b3 + hstep, voffB);
            PG8_WAIT_V(6); PG8_BAR; PG8_MMA(1, 1, At, B1); PG8_BAR;
            }
        }
        if constexpr (ALIGN_EPI) { if (wr == 0) PG8_BAR; }
        if constexpr (!Epi::AFTER_DRAIN) { E(acc, cur, wr, wc, fr, fq); S.done(cur); }
        if (!has_next) break;
#pragma unroll
        for (int a = 0; a < 2; ++a)
#pragma unroll
            for (int b = 0; b < 2; ++b)
#pragma unroll
                for (int m = 0; m < 4; ++m)
#pragma unroll
                    for (int n = 0; n < 2; ++n) acc[a][b][m][n] = (f32x4){0.f, 0.f, 0.f, 0.f};
        cur = nxt; cA = nA; cB = nB; ++ui;
        if constexpr (ALIGN_EPI) { if (wr == 1) PG8_BAR; }
    }
    PG8_WAIT_V(0);
    if constexpr (!ALIGN_EPI) { if (wr == 0) PG8_BAR; }
    PG8_BAR;
    if constexpr (Epi::AFTER_DRAIN) { E.fused(acc, cur, wr, wc, fr, fq, lds, wid, lane); S.done(cur); }
#undef PG8_SA
#undef PG8_SB
#undef PG8_STAGE
#undef PG8_LDA
#undef PG8_LDB
#undef PG8_MMA
#undef PG8_WAIT_V
#undef PG8_WAIT_L
#undef PG8_BAR
#undef PG8_SCHED
}
}

#define WTAB_OFF 155392
extern __shared__ __attribute__((aligned(16))) unsigned char lds_raw[];
__device__ __forceinline__ int hw_slot() { return (int)(__builtin_amdgcn_s_getreg((5 << 11) | 4) & 63u); }
__device__ __forceinline__ void otid_init() { const int t = threadIdx.x; if ((t & 63) == 0) ((__attribute__((address_space(3))) int*)(__attribute__((address_space(3))) void*)(lds_raw + WTAB_OFF))[hw_slot()] = t >> 6; }
__device__ __forceinline__ int otid() {
    const int w = __builtin_amdgcn_readfirstlane(((const __attribute__((address_space(3))) int*)(__attribute__((address_space(3))) void*)(lds_raw + WTAB_OFF))[hw_slot()]);
    int l; asm volatile("v_mbcnt_lo_u32_b32 %0, -1, 0\n\tv_mbcnt_hi_u32_b32 %0, -1, %0" : "=v"(l));
    return (w << 6) + l;
}
using pg8::bf16_t; using pg8::bf16x8; using pg8::f32x4; using pg8::u32x4;
#define LAS __attribute__((address_space(3)))

#define DMODEL 1024
#define NPT 16384
#define NST 32
#define NTOK 16416
#define MPAD 16640
#define SEQ 2048
#define ZW 2816
#define OFF_A 1536
#define OFF_B 1544
#define OFF_Z 1552
#define OFF_QA 2064
#define OFF_KVA 2448
#define OFF_KR 2704
#define DFF 2816
#define PAST 16384
#define NPAGES 128
#define EPSV 1e-6f

#define O_YP 0
#define O_YS (O_YP + 16777216)
#define O_CKVP (O_YS + 32768)
#define O_KRP (O_CKVP + 4194304)
#define O_GSP (O_KRP + 524288)
#define O_CSP (O_GSP + 262144)
#define O_CKVS (O_CSP + 36864)
#define O_KRS (O_CKVS + 8192)
#define O_GSS (O_KRS + 1024)
#define O_CSS (O_GSS + 1048576)

__device__ __forceinline__ bf16_t f2bf(float f) { unsigned u = __float_as_uint(f); return (bf16_t)((u + 0x7fffu + ((u >> 16) & 1u)) >> 16); }
__device__ __forceinline__ float bf2f(bf16_t b) { return __uint_as_float(((unsigned)b) << 16); }
__device__ __forceinline__ float wave_sum(float v) {
#pragma unroll
    for (int o = 1; o < 64; o <<= 1) v += __shfl_xor(v, o);
    return v;
}
__device__ __forceinline__ float sigmoidf_(float x) { return __builtin_amdgcn_rcpf(1.f + __builtin_amdgcn_exp2f(-1.44269504f * x)); }
__device__ __forceinline__ float siluf_(float x) { return x * __builtin_amdgcn_rcpf(1.f + __builtin_amdgcn_exp2f(-1.44269504f * x)); }


#define WSYNC() do { __builtin_amdgcn_fence(__ATOMIC_ACQ_REL, "wavefront"); __builtin_amdgcn_wave_barrier(); } while (0)
#define NTHR 512
#define NWAVE 8

typedef float f32x2_t __attribute__((ext_vector_type(2)));
typedef __bf16 bf16x2_t __attribute__((ext_vector_type(2)));
__device__ __forceinline__ unsigned cvtpk(float lo, float hi) { f32x2_t v = {lo, hi}; bf16x2_t r = __builtin_convertvector(v, bf16x2_t); return __builtin_bit_cast(unsigned, r); }
__device__ __forceinline__ void bf8_to_f32(const bf16x8& v, float* o) {
#pragma unroll
    for (int e = 0; e < 8; ++e) o[e] = __uint_as_float(((unsigned)(unsigned short)v[e]) << 16);
}
__device__ __forceinline__ bf16x8 f32_to_bf8(const float* x) {
    u32x4 w; w.x = cvtpk(x[0], x[1]); w.y = cvtpk(x[2], x[3]); w.z = cvtpk(x[4], x[5]); w.w = cvtpk(x[6], x[7]);
    return __builtin_bit_cast(bf16x8, w);
}
__device__ __forceinline__ unsigned pk2bf(float lo, float hi) { return (unsigned)f2bf(lo) | ((unsigned)f2bf(hi) << 16); }

__device__ __forceinline__ void wt_item(const float* __restrict__ W, int ldw, int col0, int nvalid, bf16_t* __restrict__ WT, int ldt, int nrow0, int k0, float* scr, int lane) {
    WSYNC();
#pragma unroll 8
    for (int i = 0; i < 32; ++i) { const int kk = 2 * i + (lane >> 5), n = lane & 31; scr[kk * 33 + n] = n < nvalid ? W[(size_t)(k0 + kk) * ldw + col0 + n] : 0.f; }
    WSYNC();
    const int c = lane & 7;
#pragma unroll
    for (int j = 0; j < 4; ++j) { const int n = (lane >> 3) + 8 * j; const float* sp = scr + (8 * c) * 33 + n;
        u32x4 o; o.x = cvtpk(sp[0], sp[33]); o.y = cvtpk(sp[2 * 33], sp[3 * 33]); o.z = cvtpk(sp[4 * 33], sp[5 * 33]); o.w = cvtpk(sp[6 * 33], sp[7 * 33]);
        *(u32x4*)(WT + (size_t)(nrow0 + n) * ldt + k0 + 8 * c) = o; }
}

__device__ __forceinline__ void rms1024_row(const float* __restrict__ src, const float* __restrict__ g, bf16_t* __restrict__ o, bool zero, int lane) {
    if (zero) { for (int j = 0; j < 4; ++j) { ushort4 z = {0, 0, 0, 0}; *(ushort4*)(o + lane * 4 + 256 * j) = z; } return; }
    float4 v[4]; float ss = 0.f;
#pragma unroll
    for (int j = 0; j < 4; ++j) { v[j] = *(const float4*)(src + lane * 4 + 256 * j); ss += v[j].x * v[j].x + v[j].y * v[j].y + v[j].z * v[j].z + v[j].w * v[j].w; }
    ss = wave_sum(ss);
    const float rs = rsqrtf(ss * (1.f / 1024.f) + EPSV);
#pragma unroll
    for (int j = 0; j < 4; ++j) {
        const float4 gg = *(const float4*)(g + lane * 4 + 256 * j);
        ushort4 w; w.x = f2bf(v[j].x * rs * gg.x); w.y = f2bf(v[j].y * rs * gg.y); w.z = f2bf(v[j].z * rs * gg.z); w.w = f2bf(v[j].w * rs * gg.w);
        *(ushort4*)(o + lane * 4 + 256 * j) = w;
    }
}

__device__ __forceinline__ void rms1024_row_b(const bf16_t* __restrict__ src, const float* __restrict__ g, bf16_t* __restrict__ o, bool zero, int lane) {
    if (zero) { for (int j = 0; j < 2; ++j) { const u32x4 z = {0u, 0u, 0u, 0u}; *(u32x4*)(o + lane * 8 + 512 * j) = z; } return; }
    float v[2][8]; float ss = 0.f;
#pragma unroll
    for (int j = 0; j < 2; ++j) { bf8_to_f32(*(const bf16x8*)(src + lane * 8 + 512 * j), v[j]);
#pragma unroll
        for (int e = 0; e < 8; ++e) ss += v[j][e] * v[j][e]; }
    ss = wave_sum(ss);
    const float rs = rsqrtf(ss * (1.f / 1024.f) + EPSV);
#pragma unroll
    for (int j = 0; j < 2; ++j) {
        const float4 g0 = *(const float4*)(g + lane * 8 + 512 * j), g1 = *(const float4*)(g + lane * 8 + 512 * j + 4);
        float t[8] = {v[j][0] * rs * g0.x, v[j][1] * rs * g0.y, v[j][2] * rs * g0.z, v[j][3] * rs * g0.w, v[j][4] * rs * g1.x, v[j][5] * rs * g1.y, v[j][6] * rs * g1.z, v[j][7] * rs * g1.w};
        *(bf16x8*)(o + lane * 8 + 512 * j) = f32_to_bf8(t);
    }
}

struct ABf16 { const bf16_t* p; int lda; __device__ __forceinline__ bf16x8 load(int m, int k) const { return *(const bf16x8*)(p + (size_t)m * lda + k); } };
struct ACache {
    const float* cache; const int* pt;
    __device__ __forceinline__ bf16x8 load(int m, int k) const {
        const int b = m >> 14, t = m & 16383; const int phys = pt[b * NPAGES + (t >> 7)];
        const float* r = cache + ((size_t)phys * 128 + (t & 127)) * 256 + k;
        const float4 a = *(const float4*)r, c = *(const float4*)(r + 4);
        bf16x8 o; o[0] = (short)f2bf(a.x); o[1] = (short)f2bf(a.y); o[2] = (short)f2bf(a.z); o[3] = (short)f2bf(a.w);
        o[4] = (short)f2bf(c.x); o[5] = (short)f2bf(c.y); o[6] = (short)f2bf(c.z); o[7] = (short)f2bf(c.w); return o;
    }
};
template <class AL, class Epi>
__device__ __forceinline__ void gemm_tile_256x128(const AL& al, const bf16_t* __restrict__ Bt, int ldb, int K, const Epi& epi, int m0, int n0, char* smem) {
    bf16_t (*sA)[40] = (bf16_t (*)[40])smem;
    bf16_t (*sB)[40] = (bf16_t (*)[40])(smem + 20480);
    const int tid = otid(), lane = tid & 63, wid = tid >> 6, wm = wid >> 1, wn = wid & 1;
    f32x4 acc[4][4];
#pragma unroll
    for (int i = 0; i < 4; ++i)
#pragma unroll
        for (int j = 0; j < 4; ++j) acc[i][j] = (f32x4){0.f, 0.f, 0.f, 0.f};
    __syncthreads();
    for (int k0 = 0; k0 < K; k0 += 32) {
#pragma unroll
        for (int i = 0; i < 2; ++i) { const int ch = tid + 512 * i, r = ch >> 2, kc = (ch & 3) * 8; *(bf16x8*)&sA[r][kc] = al.load(m0 + r, k0 + kc); }
        { const int r = tid >> 2, kc = (tid & 3) * 8; *(bf16x8*)&sB[r][kc] = *(const bf16x8*)(Bt + (size_t)(n0 + r) * ldb + k0 + kc); }
        __syncthreads();
        bf16x8 af[4], bfr[4];
#pragma unroll
        for (int i = 0; i < 4; ++i) af[i] = *(const bf16x8*)&sA[wm * 64 + i * 16 + (lane & 15)][(lane >> 4) * 8];
#pragma unroll
        for (int j = 0; j < 4; ++j) bfr[j] = *(const bf16x8*)&sB[wn * 64 + j * 16 + (lane & 15)][(lane >> 4) * 8];
#pragma unroll
        for (int i = 0; i < 4; ++i)
#pragma unroll
            for (int j = 0; j < 4; ++j) acc[i][j] = __builtin_amdgcn_mfma_f32_16x16x32_bf16(af[i], bfr[j], acc[i][j], 0, 0, 0);
        __syncthreads();
    }
#pragma unroll
    for (int i = 0; i < 4; ++i)
#pragma unroll
        for (int j = 0; j < 4; ++j)
#pragma unroll
            for (int r = 0; r < 4; ++r) epi(m0 + wm * 64 + i * 16 + (lane >> 4) * 4 + r, n0 + wn * 64 + j * 16 + (lane & 15), acc[i][j][r]);
}
template <class Epi>
__device__ __forceinline__ void gemm_tile_32x256(const bf16_t* __restrict__ A, int lda, const bf16_t* __restrict__ Bt, int ldb, int K, const Epi& epi, int m0, int n0, char* smem) {
    bf16_t (*sA)[40] = (bf16_t (*)[40])smem;
    bf16_t (*sB)[40] = (bf16_t (*)[40])(smem + 2560);
    const int tid = otid(), lane = tid & 63, wid = tid >> 6;
    f32x4 acc[2][2];
#pragma unroll
    for (int i = 0; i < 2; ++i)
#pragma unroll
        for (int j = 0; j < 2; ++j) acc[i][j] = (f32x4){0.f, 0.f, 0.f, 0.f};
    __syncthreads();
    for (int k0 = 0; k0 < K; k0 += 32) {
        if (tid < 128) { const int r = tid >> 2, kc = (tid & 3) * 8; *(bf16x8*)&sA[r][kc] = *(const bf16x8*)(A + (size_t)(m0 + r) * lda + k0 + kc); }
#pragma unroll
        for (int i = 0; i < 2; ++i) { const int ch = tid + 512 * i, r = ch >> 2, kc = (ch & 3) * 8; *(bf16x8*)&sB[r][kc] = *(const bf16x8*)(Bt + (size_t)(n0 + r) * ldb + k0 + kc); }
        __syncthreads();
        bf16x8 af[2], bfr[2];
#pragma unroll
        for (int i = 0; i < 2; ++i) af[i] = *(const bf16x8*)&sA[i * 16 + (lane & 15)][(lane >> 4) * 8];
#pragma unroll
        for (int j = 0; j < 2; ++j) bfr[j] = *(const bf16x8*)&sB[wid * 32 + j * 16 + (lane & 15)][(lane >> 4) * 8];
#pragma unroll
        for (int i = 0; i < 2; ++i)
#pragma unroll
            for (int j = 0; j < 2; ++j) acc[i][j] = __builtin_amdgcn_mfma_f32_16x16x32_bf16(af[i], bfr[j], acc[i][j], 0, 0, 0);
        __syncthreads();
    }
#pragma unroll
    for (int i = 0; i < 2; ++i)
#pragma unroll
        for (int j = 0; j < 2; ++j)
#pragma unroll
            for (int r = 0; r < 4; ++r) epi(m0 + i * 16 + (lane >> 4) * 4 + r, n0 + wid * 32 + j * 16 + (lane & 15), acc[i][j][r]);
}
template <bool SWIGLU, class Epi>
__device__ __forceinline__ void gemm_sample_rows(const bf16_t* __restrict__ A, int lda, const bf16_t* __restrict__ Bt, int K, int N, const Epi& epi, char*  , int bid, int nb) {
    const int tid = otid(), lane = tid & 63, wid = tid >> 6, i16 = lane & 15, q4 = lane >> 4;
    for (int u = nb - 1 - bid; u < N / 256; u += nb) {
        const int n0 = u * 256;
        const int c0 = SWIGLU ? n0 + 16 * wid : n0 + 32 * wid, c1 = SWIGLU ? n0 + 128 + 16 * wid : n0 + 32 * wid + 16;
        const bf16_t* a0p = A + (size_t)(NPT + i16) * lda + 8 * q4; const bf16_t* a1p = a0p + (size_t)16 * lda;
        const bf16_t* b0p = Bt + (size_t)(c0 + i16) * K + 8 * q4; const bf16_t* b1p = Bt + (size_t)(c1 + i16) * K + 8 * q4;
        f32x4 acc[2][2];
#pragma unroll
        for (int i = 0; i < 2; ++i)
#pragma unroll
            for (int j = 0; j < 2; ++j) acc[i][j] = (f32x4){0.f, 0.f, 0.f, 0.f};
#pragma unroll 4
        for (int k0 = 0; k0 < K; k0 += 32) {
            const bf16x8 a0 = *(const bf16x8*)(a0p + k0), a1 = *(const bf16x8*)(a1p + k0), b0 = *(const bf16x8*)(b0p + k0), b1 = *(const bf16x8*)(b1p + k0);
            acc[0][0] = __builtin_amdgcn_mfma_f32_16x16x32_bf16(a0, b0, acc[0][0], 0, 0, 0); acc[0][1] = __builtin_amdgcn_mfma_f32_16x16x32_bf16(a0, b1, acc[0][1], 0, 0, 0);
            acc[1][0] = __builtin_amdgcn_mfma_f32_16x16x32_bf16(a1, b0, acc[1][0], 0, 0, 0); acc[1][1] = __builtin_amdgcn_mfma_f32_16x16x32_bf16(a1, b1, acc[1][1], 0, 0, 0);
        }
#pragma unroll
        for (int i = 0; i < 2; ++i)
#pragma unroll
            for (int r = 0; r < 4; ++r) {
                const int m = NPT + 16 * i + 4 * q4 + r;
                if constexpr (SWIGLU) epi(m, (n0 >> 1) + 16 * wid + i16, siluf_(acc[i][0][r]) * acc[i][1][r]);
                else { epi(m, c0 + i16, acc[i][0][r]); epi(m, c1 + i16, acc[i][1][r]); }
            }
    }
}
template <bool SWIGLU, class Epi>
__device__ __forceinline__ void gemm_sample_rows_ks(const bf16_t* __restrict__ A, int lda, const bf16_t* __restrict__ Bt, int K, int N, const Epi& epi, char* smem, int bid, int nb) {
    const int tid = otid(), lane = tid & 63, wid = tid >> 6, i16 = lane & 15, q4 = lane >> 4;
    const int nunits = N / 64, ksl = K >> 3;
    f32x4* red = (f32x4*)smem;
    for (int u = nb - 1 - bid; u < nunits; u += nb) {
        int brow[4];
#pragma unroll
        for (int j = 0; j < 4; ++j) brow[j] = SWIGLU ? ((32 * u) >> 7) * 256 + ((32 * u) & 127) + 128 * (j >> 1) + 16 * (j & 1) + i16 : 64 * u + 16 * j + i16;
        const bf16_t* a0p = A + (size_t)(NPT + i16) * lda + wid * ksl + 8 * q4; const bf16_t* a1p = a0p + (size_t)16 * lda;
        f32x4 acc[2][4];
#pragma unroll
        for (int i = 0; i < 2; ++i)
#pragma unroll
            for (int j = 0; j < 4; ++j) acc[i][j] = (f32x4){0.f, 0.f, 0.f, 0.f};
        for (int k0 = 0; k0 < ksl; k0 += 32) {
            const bf16x8 a0 = *(const bf16x8*)(a0p + k0), a1 = *(const bf16x8*)(a1p + k0);
            bf16x8 b[4];
#pragma unroll
            for (int j = 0; j < 4; ++j) b[j] = *(const bf16x8*)(Bt + (size_t)brow[j] * K + wid * ksl + 8 * q4 + k0);
#pragma unroll
            for (int j = 0; j < 4; ++j) { acc[0][j] = __builtin_amdgcn_mfma_f32_16x16x32_bf16(a0, b[j], acc[0][j], 0, 0, 0); acc[1][j] = __builtin_amdgcn_mfma_f32_16x16x32_bf16(a1, b[j], acc[1][j], 0, 0, 0); }
        }
        __syncthreads();
#pragma unroll
        for (int i = 0; i < 2; ++i)
#pragma unroll
            for (int j = 0; j < 4; ++j) red[(wid * 8 + i * 4 + j) * 64 + lane] = acc[i][j];
        __syncthreads();
        if constexpr (SWIGLU) {
            if (tid < 256) {
                const int t4 = tid >> 6, i = t4 >> 1, jg = t4 & 1, l = tid & 63;
                f32x4 g = red[(i * 4 + jg) * 64 + l], up = red[(i * 4 + jg + 2) * 64 + l];
#pragma unroll
                for (int w = 1; w < 8; ++w) { g = g + red[(w * 8 + i * 4 + jg) * 64 + l]; up = up + red[(w * 8 + i * 4 + jg + 2) * 64 + l]; }
#pragma unroll
                for (int r = 0; r < 4; ++r) epi(NPT + 16 * i + 4 * (l >> 4) + r, 32 * u + 16 * jg + (l & 15), siluf_(g[r]) * up[r]);
            }
        } else {
            const int t8 = tid >> 6, l = tid & 63, i = t8 >> 2, j = t8 & 3;
            f32x4 v = red[t8 * 64 + l];
#pragma unroll
            for (int w = 1; w < 8; ++w) v = v + red[(w * 8 + t8) * 64 + l];
#pragma unroll
            for (int r = 0; r < 4; ++r) epi(NPT + 16 * i + 4 * (l >> 4) + r, 64 * u + 16 * j + (l & 15), v[r]);
        }
    }
    __syncthreads();
}
struct EwF32 { float* C; int ldc; __device__ __forceinline__ void operator()(int m, int n, float v) const { C[(size_t)m * ldc + n] = v; } };
struct EwBf16 { bf16_t* C; int ldc; __device__ __forceinline__ void operator()(int m, int n, float v) const { C[(size_t)m * ldc + n] = f2bf(v); } };
struct EwResX { const float* xs; bf16_t* C; __device__ __forceinline__ void operator()(int m, int n, float v) const { C[(size_t)m * 1024 + n] = f2bf(xs[(size_t)(m - NPT) * 1024 + n] + v); } };
struct EwSwiglu {
    float* G; bf16_t* Hd;
    __device__ __forceinline__ void operator()(int m, int n, float v) const {
        const int f = (n >> 8) * 128 + (n & 127);
        if ((n & 255) < 128) G[(size_t)(m - NPT) * DFF + f] = v;
    }
};
struct EwSwiglu2 {
    const float* G; bf16_t* Hd;
    __device__ __forceinline__ void operator()(int m, int n, float v) const {
        const int f = (n >> 8) * 128 + (n & 127);
        if ((n & 255) >= 128) Hd[(size_t)m * DFF + f] = f2bf(siluf_(G[(size_t)(m - NPT) * DFF + f]) * v);
    }
};
struct EwResH { const bf16_t* H; bf16_t* C; __device__ __forceinline__ void operator()(int m, int n, float v) const { C[(size_t)m * 1024 + n] = f2bf(bf2f(H[(size_t)m * 1024 + n]) + v); } };
struct EwPle { const bf16_t* H2; const bf16_t* PP; float* out;
    __device__ __forceinline__ void operator()(int m, int n, float v) const { out[O_YS + (size_t)(m - NPT) * 1024 + n] = bf2f(H2[(size_t)m * 1024 + n]) + bf2f(PP[(size_t)m * 1024 + n]) * sigmoidf_(v); } };

struct PgBf16 {
    static constexpr bool PERM = true, AFTER_DRAIN = false; bf16_t* O; int ldc;
    __device__ __forceinline__ void operator()(const f32x4 (&acc)[2][2][4][2], const pg8::Unit& u, int wr, int wc, int fr, int fq) const {
#pragma unroll
        for (int ai = 0; ai < 2; ++ai)
#pragma unroll
            for (int m = 0; m < 4; ++m) { bf16_t* rowp = O + (size_t)(u.pm * 256 + ai * 128 + wr * 64 + m * 16 + fr) * ldc + u.pn * 256 + wc * 32 + 8 * fq;
#pragma unroll
                for (int bj = 0; bj < 2; ++bj) { const f32x4 v0 = acc[ai][bj][m][0], v1 = acc[ai][bj][m][1]; u32x4 w; w.x = pk2bf(v0[0], v0[1]); w.y = pk2bf(v0[2], v0[3]); w.z = pk2bf(v1[0], v1[1]); w.w = pk2bf(v1[2], v1[3]); *(u32x4*)(rowp + bj * 128) = w; } }
    }
};
struct PgF32 {
    static constexpr bool PERM = false, AFTER_DRAIN = false; float* O; int ldc;
    __device__ __forceinline__ void operator()(const f32x4 (&acc)[2][2][4][2], const pg8::Unit& u, int wr, int wc, int fr, int fq) const {
#pragma unroll
        for (int ai = 0; ai < 2; ++ai)
#pragma unroll
            for (int m = 0; m < 4; ++m) { float* rowp = O + (size_t)(u.pm * 256 + ai * 128 + wr * 64 + m * 16 + fr) * ldc + u.pn * 256 + wc * 32 + 4 * fq;
#pragma unroll
                for (int bj = 0; bj < 2; ++bj)
#pragma unroll
                    for (int n = 0; n < 2; ++n) *(f32x4*)(rowp + bj * 128 + n * 16) = acc[ai][bj][m][n]; }
    }
};
struct PgRes {
    static constexpr bool PERM = false, AFTER_DRAIN = false; const float* R; float* O;
    __device__ __forceinline__ void operator()(const f32x4 (&acc)[2][2][4][2], const pg8::Unit& u, int wr, int wc, int fr, int fq) const {
#pragma unroll
        for (int ai = 0; ai < 2; ++ai)
#pragma unroll
            for (int m = 0; m < 4; ++m) { const size_t off = (size_t)(u.pm * 256 + ai * 128 + wr * 64 + m * 16 + fr) * 1024 + u.pn * 256 + wc * 32 + 4 * fq;
#pragma unroll
                for (int bj = 0; bj < 2; ++bj)
#pragma unroll
                    for (int n = 0; n < 2; ++n) { const f32x4 r = *(const f32x4*)(R + off + bj * 128 + n * 16); *(f32x4*)(O + off + bj * 128 + n * 16) = r + acc[ai][bj][m][n]; } }
    }
};
struct PgSwiglu {
    static constexpr bool PERM = true, AFTER_DRAIN = false; bf16_t* Hd;
    __device__ __forceinline__ void operator()(const f32x4 (&acc)[2][2][4][2], const pg8::Unit& u, int wr, int wc, int fr, int fq) const {
#pragma unroll
        for (int ai = 0; ai < 2; ++ai)
#pragma unroll
            for (int m = 0; m < 4; ++m) { bf16_t* rowp = Hd + (size_t)(u.pm * 256 + ai * 128 + wr * 64 + m * 16 + fr) * DFF + u.pn * 128 + wc * 32 + 8 * fq;
                float h[8];
#pragma unroll
                for (int n = 0; n < 2; ++n)
#pragma unroll
                    for (int i = 0; i < 4; ++i) h[n * 4 + i] = siluf_(acc[ai][0][m][n][i]) * acc[ai][1][m][n][i];
                u32x4 w; w.x = pk2bf(h[0], h[1]); w.y = pk2bf(h[2], h[3]); w.z = pk2bf(h[4], h[5]); w.w = pk2bf(h[6], h[7]); *(u32x4*)rowp = w; }
    }
};
struct PgPle {
    static constexpr bool PERM = false, AFTER_DRAIN = false; const float* H2; const float* PP; float* out;
    __device__ __forceinline__ void operator()(const f32x4 (&acc)[2][2][4][2], const pg8::Unit& u, int wr, int wc, int fr, int fq) const {
#pragma unroll
        for (int ai = 0; ai < 2; ++ai)
#pragma unroll
            for (int m = 0; m < 4; ++m) { const size_t off = (size_t)(u.pm * 256 + ai * 128 + wr * 64 + m * 16 + fr) * 1024 + u.pn * 256 + wc * 32 + 4 * fq;
#pragma unroll
                for (int bj = 0; bj < 2; ++bj)
#pragma unroll
                    for (int n = 0; n < 2; ++n) { const f32x4 h = *(const f32x4*)(H2 + off + bj * 128 + n * 16), pp = *(const f32x4*)(PP + off + bj * 128 + n * 16), a = acc[ai][bj][m][n]; f32x4 y;
#pragma unroll
                        for (int i = 0; i < 4; ++i) y[i] = h[i] + pp[i] * sigmoidf_(a[i]);
                        *(f32x4*)(out + O_YP + off + bj * 128 + n * 16) = y; } }
    }
};
struct PgResXB {
    static constexpr bool PERM = true, AFTER_DRAIN = false; const float* R; bf16_t* O;
    __device__ __forceinline__ void operator()(const f32x4 (&acc)[2][2][4][2], const pg8::Unit& u, int wr, int wc, int fr, int fq) const {
#pragma unroll
        for (int ai = 0; ai < 2; ++ai)
#pragma unroll
            for (int m = 0; m < 4; ++m) { const size_t off = (size_t)(u.pm * 256 + ai * 128 + wr * 64 + m * 16 + fr) * 1024 + u.pn * 256 + wc * 32 + 8 * fq;
#pragma unroll
                for (int bj = 0; bj < 2; ++bj) { const f32x4 r0 = *(const f32x4*)(R + off + bj * 128), r1 = *(const f32x4*)(R + off + bj * 128 + 4), v0 = r0 + acc[ai][bj][m][0], v1 = r1 + acc[ai][bj][m][1];
                    u32x4 w; w.x = cvtpk(v0[0], v0[1]); w.y = cvtpk(v0[2], v0[3]); w.z = cvtpk(v1[0], v1[1]); w.w = cvtpk(v1[2], v1[3]); *(u32x4*)(O + off + bj * 128) = w; } }
    }
};
struct PgResBB {
    static constexpr bool PERM = true, AFTER_DRAIN = false; const bf16_t* R; bf16_t* O;
    __device__ __forceinline__ void operator()(const f32x4 (&acc)[2][2][4][2], const pg8::Unit& u, int wr, int wc, int fr, int fq) const {
#pragma unroll
        for (int ai = 0; ai < 2; ++ai)
#pragma unroll
            for (int m = 0; m < 4; ++m) { const size_t off = (size_t)(u.pm * 256 + ai * 128 + wr * 64 + m * 16 + fr) * 1024 + u.pn * 256 + wc * 32 + 8 * fq;
#pragma unroll
                for (int bj = 0; bj < 2; ++bj) { float r[8]; bf8_to_f32(*(const bf16x8*)(R + off + bj * 128), r); const f32x4 a0 = acc[ai][bj][m][0], a1 = acc[ai][bj][m][1];
                    u32x4 w; w.x = cvtpk(r[0] + a0[0], r[1] + a0[1]); w.y = cvtpk(r[2] + a0[2], r[3] + a0[3]); w.z = cvtpk(r[4] + a1[0], r[5] + a1[1]); w.w = cvtpk(r[6] + a1[2], r[7] + a1[3]); *(u32x4*)(O + off + bj * 128) = w; } }
    }
};
struct PgPleB {
    static constexpr bool PERM = true, AFTER_DRAIN = false; const bf16_t* H2; const bf16_t* PP; float* out;
    __device__ __forceinline__ void operator()(const f32x4 (&acc)[2][2][4][2], const pg8::Unit& u, int wr, int wc, int fr, int fq) const {
#pragma unroll
        for (int ai = 0; ai < 2; ++ai)
#pragma unroll
            for (int m = 0; m < 4; ++m) { const size_t off = (size_t)(u.pm * 256 + ai * 128 + wr * 64 + m * 16 + fr) * 1024 + u.pn * 256 + wc * 32 + 8 * fq;
#pragma unroll
                for (int bj = 0; bj < 2; ++bj) { float h[8], pp[8]; bf8_to_f32(*(const bf16x8*)(H2 + off + bj * 128), h); bf8_to_f32(*(const bf16x8*)(PP + off + bj * 128), pp);
                    const f32x4 a0 = acc[ai][bj][m][0], a1 = acc[ai][bj][m][1]; f32x4 y0, y1;
#pragma unroll
                    for (int i = 0; i < 4; ++i) { y0[i] = h[i] + pp[i] * sigmoidf_(a0[i]); y1[i] = h[4 + i] + pp[4 + i] * sigmoidf_(a1[i]); }
                    *(f32x4*)(out + O_YP + off + bj * 128) = y0; *(f32x4*)(out + O_YP + off + bj * 128 + 4) = y1; } }
    }
};
template <class Epi>
__device__ __forceinline__ void pg_gemm(LAS unsigned char* lds, const bf16_t* A, const bf16_t* Bt, int M, int N, int K, const Epi& E) {
    pg8::Gemm g{A, Bt, M, N, K}; pg8::StaticOrder S; S.init(M, N, (int)gridDim.x, (int)blockIdx.x);
    pg8::gemm_phase<Epi, pg8::StaticOrder, true, true>(lds, g, S, E);
}

constexpr size_t WOF_WinT = 0ull;
constexpr size_t WOF_WqbT = 5767168ull;
constexpr size_t WOF_WkvT = 6356992ull;
constexpr size_t WOF_WknT = 6881280ull;
constexpr size_t WOF_WoT = 7143424ull;
constexpr size_t WOF_WguT = 9240576ull;
constexpr size_t WOF_WdT = 20774912ull;
constexpr size_t WOF_WpgT = 26542080ull;
constexpr size_t WOF_WppT = 28639232ull;
constexpr size_t WOF_xn = 29163520ull;
constexpr size_t WOF_pb = 63242240ull;
constexpr size_t WOF_Z = 71761920ull;
constexpr size_t WOF_qkv = 165478400ull;
constexpr size_t WOF_ropecs = 216596480ull;
constexpr size_t WOF_gg = 216858880ull;
constexpr size_t WOF_bb = 217391360ull;
constexpr size_t WOF_goraw = 217923840ull;
constexpr size_t WOF_gUT = 252002560ull;
constexpr size_t WOF_ggam = 285556992ull;
constexpr size_t WOF_gWn = 285565184ull;
constexpr size_t WOF_gQg = 302342400ull;
constexpr size_t WOF_gQK = 319119616ull;
constexpr size_t WOF_gKd = 335896832ull;
constexpr size_t WOF_qan = 352674048ull;
constexpr size_t WOF_ckvb = 365453568ull;
constexpr size_t WOF_krf = 373973248ull;
constexpr size_t WOF_Q = 376103168ull;
constexpr size_t WOF_qh = 427221248ull;
constexpr size_t WOF_KV = 478339328ull;
constexpr size_t WOF_kh = 546496768ull;
constexpr size_t WOF_omix = 580575488ull;
constexpr size_t WOF_KN = 614654208ull;
constexpr size_t WOF_SC = 1151525120ull;
constexpr size_t WOF_part = 1168302336ull;
constexpr size_t WOF_H = 1170432256ull;
constexpr size_t WOF_un = 1238589696ull;
constexpr size_t WOF_G = 1272668416ull;
constexpr size_t WOF_hid = 1273028864ull;
constexpr size_t WOF_H2 = 1366745344ull;
constexpr size_t WOF_un2 = 1434902784ull;
constexpr size_t WOF_PP = 1468981504ull;
constexpr size_t WOF_qraw = 1537138944ull;
constexpr size_t WOF_kvraw = 1562304768ull;
constexpr size_t WOF_krb = 1595859200ull;
constexpr size_t WOF_ctl = 1596907776ull;
constexpr size_t WS_TOTAL = 1596924160ull;
struct MK {
    const float *x_prompt, *x_sample, *cache_ckv, *cache_krope, *state_gdn, *state_conv; const int* page_table; const float *p_prompt, *p_sample;
    const float *g_attn, *w_in, *w_conv, *a_log, *dt_bias, *g_gdn_out, *g_q_a, *w_q_b, *g_q_nope, *g_q_rope, *g_kv_a, *g_k_rope, *w_kv_b, *g_k_nope, *w_o, *g_ffn, *w_gate, *w_up, *w_down, *g_ple, *w_ple_gate, *w_ple_proj;
    float* out; char* ws;
    __device__ __forceinline__ unsigned* ctl() const { return (unsigned*)(ws + WOF_ctl); }
    __device__ __forceinline__ bf16_t* WinT() const { return (bf16_t*)(ws + WOF_WinT); }
    __device__ __forceinline__ bf16_t* WqbT() const { return (bf16_t*)(ws + WOF_WqbT); }
    __device__ __forceinline__ bf16_t* WkvT() const { return (bf16_t*)(ws + WOF_WkvT); }
    __device__ __forceinline__ bf16_t* WknT() const { return (bf16_t*)(ws + WOF_WknT); }
    __device__ __forceinline__ bf16_t* WoT() const { return (bf16_t*)(ws + WOF_WoT); }
    __device__ __forceinline__ bf16_t* WguT() const { return (bf16_t*)(ws + WOF_WguT); }
    __device__ __forceinline__ bf16_t* WdT() const { return (bf16_t*)(ws + WOF_WdT); }
    __device__ __forceinline__ bf16_t* WpgT() const { return (bf16_t*)(ws + WOF_WpgT); }
    __device__ __forceinline__ bf16_t* WppT() const { return (bf16_t*)(ws + WOF_WppT); }
    __device__ __forceinline__ bf16_t* xn() const { return (bf16_t*)(ws + WOF_xn); }
    __device__ __forceinline__ bf16_t* pb() const { return (bf16_t*)(ws + WOF_pb); }
    __device__ __forceinline__ bf16_t* Z() const { return (bf16_t*)(ws + WOF_Z); }
    __device__ __forceinline__ bf16_t* qkv() const { return (bf16_t*)(ws + WOF_qkv); }
    __device__ __forceinline__ float* ropecs() const { return (float*)(ws + WOF_ropecs); }
    __device__ __forceinline__ float* gg() const { return (float*)(ws + WOF_gg); }
    __device__ __forceinline__ float* bb() const { return (float*)(ws + WOF_bb); }
    __device__ __forceinline__ float* goraw() const { return (float*)(ws + WOF_goraw); }
    __device__ __forceinline__ float* gUT() const { return (float*)(ws + WOF_gUT); }
    __device__ __forceinline__ float* ggam() const { return (float*)(ws + WOF_ggam); }
    __device__ __forceinline__ bf16_t* gWn() const { return (bf16_t*)(ws + WOF_gWn); }
    __device__ __forceinline__ bf16_t* gQg() const { return (bf16_t*)(ws + WOF_gQg); }
    __device__ __forceinline__ bf16_t* gQK() const { return (bf16_t*)(ws + WOF_gQK); }
    __device__ __forceinline__ bf16_t* gKd() const { return (bf16_t*)(ws + WOF_gKd); }
    __device__ __forceinline__ bf16_t* qan() const { return (bf16_t*)(ws + WOF_qan); }
    __device__ __forceinline__ bf16_t* ckvb() const { return (bf16_t*)(ws + WOF_ckvb); }
    __device__ __forceinline__ float* krf() const { return (float*)(ws + WOF_krf); }
    __device__ __forceinline__ float* Q() const { return (float*)(ws + WOF_Q); }
    __device__ __forceinline__ float* qh() const { return (float*)(ws + WOF_qh); }
    __device__ __forceinline__ float* KV() const { return (float*)(ws + WOF_KV); }
    __device__ __forceinline__ float* kh() const { return (float*)(ws + WOF_kh); }
    __device__ __forceinline__ bf16_t* omix() const { return (bf16_t*)(ws + WOF_omix); }
    __device__ __forceinline__ bf16_t* KN() const { return (bf16_t*)(ws + WOF_KN); }
    __device__ __forceinline__ float* SC() const { return (float*)(ws + WOF_SC); }
    __device__ __forceinline__ float* part() const { return (float*)(ws + WOF_part); }
    __device__ __forceinline__ bf16_t* H() const { return (bf16_t*)(ws + WOF_H); }
    __device__ __forceinline__ bf16_t* un() const { return (bf16_t*)(ws + WOF_un); }
    __device__ __forceinline__ float* G() const { return (float*)(ws + WOF_G); }
    __device__ __forceinline__ bf16_t* hid() const { return (bf16_t*)(ws + WOF_hid); }
    __device__ __forceinline__ bf16_t* H2() const { return (bf16_t*)(ws + WOF_H2); }
    __device__ __forceinline__ bf16_t* un2() const { return (bf16_t*)(ws + WOF_un2); }
    __device__ __forceinline__ bf16_t* PP() const { return (bf16_t*)(ws + WOF_PP); }
    __device__ __forceinline__ bf16_t* qraw() const { return (bf16_t*)(ws + WOF_qraw); }
    __device__ __forceinline__ bf16_t* kvraw() const { return (bf16_t*)(ws + WOF_kvraw); }
    __device__ __forceinline__ bf16_t* krb() const { return (bf16_t*)(ws + WOF_krb); }
};

__device__ __forceinline__ float fast_sigmoid(float x) { return __builtin_amdgcn_rcpf(1.f + __builtin_amdgcn_exp2f(-1.44269504f * x)); }
struct PinTok { bf16x8 qa, cv, kr; float ab; };
struct PinGain { float gqa[8], gkv[8], gkr[8], dtb, alog; };
__device__ __forceinline__ PinTok pin_load(const MK& a, int row, int lane) {
    const bf16_t* z = a.Z() + (size_t)row * ZW; PinTok t; const bf16x8 zz = {0, 0, 0, 0, 0, 0, 0, 0};
    t.qa = lane < 48 ? *(const bf16x8*)(z + OFF_QA + 8 * lane) : zz; t.cv = lane < 32 ? *(const bf16x8*)(z + OFF_KVA + 8 * lane) : zz;
    t.kr = (lane >= 32 && lane < 36) ? *(const bf16x8*)(z + OFF_KR + 8 * (lane - 32)) : zz; t.ab = lane < 16 ? bf2f(z[OFF_A + lane]) : 0.f; return t;
}
__device__ __forceinline__ void post_in_token(const MK& a, int row, int lane, const float* wcs, const bf16x8 (&w0)[3], const bf16x8 (&w1)[3], const bf16x8 (&w2)[3], const bf16x8 (&wcur)[3], const PinTok& tk, const PinGain& gn) {
    const bool samp = row >= NPT;
    const int b = samp ? row - NPT : row >> 11, t = samp ? 0 : row & 2047, hd = lane >> 3;
    float y[24];
#pragma unroll
    for (int c3 = 0; c3 < 3; ++c3) {
        float p0[8], p1[8], p2[8], cu[8];
        bf8_to_f32(w0[c3], p0); bf8_to_f32(w1[c3], p1); bf8_to_f32(w2[c3], p2); bf8_to_f32(wcur[c3], cu);
        const float* wp = wcs + 512 * c3 + 8 * lane;
        const float4 a0 = *(const float4*)wp, a1 = *(const float4*)(wp + 4), b0 = *(const float4*)(wp + 1536), b1 = *(const float4*)(wp + 1540);
        const float4 c0 = *(const float4*)(wp + 3072), c1 = *(const float4*)(wp + 3076), d0 = *(const float4*)(wp + 4608), d1 = *(const float4*)(wp + 4612);
        const float k0[8] = {a0.x, a0.y, a0.z, a0.w, a1.x, a1.y, a1.z, a1.w}, k1[8] = {b0.x, b0.y, b0.z, b0.w, b1.x, b1.y, b1.z, b1.w};
        const float k2[8] = {c0.x, c0.y, c0.z, c0.w, c1.x, c1.y, c1.z, c1.w}, k3[8] = {d0.x, d0.y, d0.z, d0.w, d1.x, d1.y, d1.z, d1.w};
#pragma unroll
        for (int e = 0; e < 8; ++e) { const int c = 8 * c3 + e; const float v = k0[e] * p0[e] + k1[e] * p1[e] + k2[e] * p2[e] + k3[e] * cu[e]; y[c] = v * fast_sigmoid(v); }
        __builtin_amdgcn_sched_barrier(0);
    }
    float sq = 0.f, sk = 0.f;
#pragma unroll
    for (int e = 0; e < 8; ++e) { sq += y[e] * y[e]; sk += y[8 + e] * y[8 + e]; }
    sq += __shfl_xor(sq, 1); sk += __shfl_xor(sk, 1); sq += __shfl_xor(sq, 2); sk += __shfl_xor(sk, 2); sq += __shfl_xor(sq, 4); sk += __shfl_xor(sk, 4);
    const float rq = rsqrtf(sq + EPSV) * 0.125f, rk = rsqrtf(sk + EPSV);
#pragma unroll
    for (int e = 0; e < 8; ++e) { y[e] *= rq; y[8 + e] *= rk; }
    bf16_t* qo = a.qkv() + (size_t)row * 1536 + 8 * lane;
    *(bf16x8*)qo = f32_to_bf8(y); *(bf16x8*)(qo + 512) = f32_to_bf8(y + 8); *(bf16x8*)(qo + 1024) = f32_to_bf8(y + 16);
    if (!samp && t >= SEQ - 3) {
        float* cso = a.out + O_CSP + ((size_t)b * 3 + (t - (SEQ - 3))) * 1536 + 8 * lane;
#pragma unroll
        for (int j = 0; j < 3; ++j) { float cu[8]; bf8_to_f32(wcur[j], cu); *(float4*)(cso + 512 * j) = (float4){cu[0], cu[1], cu[2], cu[3]}; *(float4*)(cso + 512 * j + 4) = (float4){cu[4], cu[5], cu[6], cu[7]}; }
    }
    if (lane < 16) {
        const float v = tk.ab;
        if (lane < 8) { const float xx = v + gn.dtb; const float sp = xx > 20.f ? xx : log1pf(expf(xx)); a.gg()[(size_t)row * 8 + lane] = -gn.alog * sp; }
        else a.bb()[(size_t)row * 8 + lane - 8] = 1.f / (1.f + expf(-v));
    }
    __builtin_amdgcn_sched_barrier(0);
    float qa[8], cv[8], kr[8];
    bf8_to_f32(tk.qa, qa); bf8_to_f32(tk.cv, cv); bf8_to_f32(tk.kr, kr);
    float s1 = 0.f, s2 = 0.f, s3 = 0.f;
#pragma unroll
    for (int e = 0; e < 8; ++e) { s1 += qa[e] * qa[e]; s2 += cv[e] * cv[e]; s3 += kr[e] * kr[e]; }
#pragma unroll
    for (int o = 1; o < 64; o <<= 1) { s1 += __shfl_xor(s1, o); s2 += __shfl_xor(s2, o); s3 += __shfl_xor(s3, o); }
    const float r1 = rsqrtf(s1 * (1.f / 384.f) + EPSV), r2 = rsqrtf(s2 * (1.f / 256.f) + EPSV), r3 = rsqrtf(s3 * (1.f / 32.f) + EPSV);
    if (lane < 48) {
        float o[8];
#pragma unroll
        for (int e = 0; e < 8; ++e) o[e] = qa[e] * r1 * gn.gqa[e];
        *(bf16x8*)(a.qan() + (size_t)row * 384 + 8 * lane) = f32_to_bf8(o);
    }
    if (lane < 32) {
        float o[8];
#pragma unroll
        for (int e = 0; e < 8; ++e) o[e] = cv[e] * r2 * gn.gkv[e];
        *(bf16x8*)(a.ckvb() + (size_t)row * 256 + 8 * lane) = f32_to_bf8(o);
        float* co = samp ? a.out + O_CKVS + (size_t)b * 256 + 8 * lane : a.out + O_CKVP + (size_t)row * 256 + 8 * lane;
        *(float4*)co = (float4){o[0], o[1], o[2], o[3]}; *(float4*)(co + 4) = (float4){o[4], o[5], o[6], o[7]};
    }
    __builtin_amdgcn_sched_barrier(0);
    {
        const int c4 = (lane - 32) & 3;
        float xn[8], ot[8];
#pragma unroll
        for (int e = 0; e < 8; ++e) xn[e] = kr[e] * r3 * gn.gkr[e];
#pragma unroll
        for (int e = 0; e < 8; ++e) ot[e] = __shfl_xor(xn[e], 2);
        if (lane >= 32 && lane < 36) {
            const float* tb = a.ropecs() + (size_t)(samp ? 2048 : t) * 32 + ((8 * c4) & 15);
            const float4 c0 = *(const float4*)tb, c1 = *(const float4*)(tb + 4), s0 = *(const float4*)(tb + 16), s1 = *(const float4*)(tb + 20);
            const float csv[8] = {c0.x, c0.y, c0.z, c0.w, c1.x, c1.y, c1.z, c1.w}, snv[8] = {s0.x, s0.y, s0.z, s0.w, s1.x, s1.y, s1.z, s1.w};
            float o[8];
#pragma unroll
            for (int e = 0; e < 8; ++e) o[e] = c4 < 2 ? xn[e] * csv[e] - ot[e] * snv[e] : ot[e] * snv[e] + xn[e] * csv[e];
            float* kf_ = a.krf() + (size_t)row * 32 + 8 * c4; *(float4*)kf_ = (float4){o[0], o[1], o[2], o[3]}; *(float4*)(kf_ + 4) = (float4){o[4], o[5], o[6], o[7]};
            float* ko = samp ? a.out + O_KRS + (size_t)b * 32 + 8 * c4 : a.out + O_KRP + (size_t)row * 32 + 8 * c4;
            *(float4*)ko = (float4){o[0], o[1], o[2], o[3]}; *(float4*)(ko + 4) = (float4){o[4], o[5], o[6], o[7]};
            if (!samp) *(bf16x8*)(a.krb() + (size_t)row * 32 + 8 * c4) = f32_to_bf8(o);
        }
    }
    (void)hd;
}
__device__ __forceinline__ void post_in_run(const MK& a, int run, int lane_in, const float* wcs) {
    int lane = lane_in; asm volatile("" : "+v"(lane));
    PinGain gn;
    {
        const int lq = lane < 48 ? lane : 0, lk = lane < 32 ? lane : 0, c4 = (lane - 32) & 3;
#pragma unroll
        for (int e = 0; e < 8; ++e) { gn.gqa[e] = a.g_q_a[8 * lq + e]; gn.gkv[e] = a.g_kv_a[8 * lk + e]; gn.gkr[e] = a.g_k_rope[8 * c4 + e]; }
        gn.dtb = a.dt_bias[lane & 7]; gn.alog = expf(a.a_log[lane & 7]);
    }
    if (run < NPT / 8) {
        const int row0 = run * 8, t0 = row0 & 2047;
        bf16x8 w0[3], w1[3], w2[3], wcur[3];
#pragma unroll
        for (int c3 = 0; c3 < 3; ++c3) {
            const bf16x8 zz = {0, 0, 0, 0, 0, 0, 0, 0}; w0[c3] = zz; w1[c3] = zz; w2[c3] = zz;
            if (t0 > 0) { const bf16_t* zp = a.Z() + (size_t)(row0 - 3) * ZW + 512 * c3 + 8 * lane; w0[c3] = *(const bf16x8*)zp; w1[c3] = *(const bf16x8*)(zp + ZW); w2[c3] = *(const bf16x8*)(zp + 2 * ZW); }
        }
        bf16x8 wnext[3]; PinTok tk, tkn;
#pragma unroll
        for (int c3 = 0; c3 < 3; ++c3) wnext[c3] = *(const bf16x8*)(a.Z() + (size_t)row0 * ZW + 512 * c3 + 8 * lane);
        tkn = pin_load(a, row0, lane);
#pragma unroll 1
        for (int k = 0; k < 8; ++k) {
            const int row = row0 + k;
#pragma unroll
            for (int c3 = 0; c3 < 3; ++c3) wcur[c3] = wnext[c3];
            tk = tkn;
            if (k < 7) {
#pragma unroll
                for (int c3 = 0; c3 < 3; ++c3) wnext[c3] = *(const bf16x8*)(a.Z() + (size_t)(row + 1) * ZW + 512 * c3 + 8 * lane);
                tkn = pin_load(a, row + 1, lane);
            }
            post_in_token(a, row, lane, wcs, w0, w1, w2, wcur, tk, gn);
#pragma unroll
            for (int c3 = 0; c3 < 3; ++c3) { w0[c3] = w1[c3]; w1[c3] = w2[c3]; w2[c3] = wcur[c3]; }
        }
    } else {
        {
            const int bsm = run - NPT / 8, row = NPT + bsm;
            bf16x8 w0[3], w1[3], w2[3], wcur[3];
#pragma unroll
            for (int c3 = 0; c3 < 3; ++c3) {
                const float* sp = a.state_conv + (size_t)bsm * 3 * 1536 + 512 * c3 + 8 * lane;
                float* cso = a.out + O_CSS + (size_t)bsm * 3 * 1536 + 512 * c3 + 8 * lane;
                float t0_[8], t1_[8], t2_[8], tc_[8];
#pragma unroll
                for (int e = 0; e < 8; ++e) { t0_[e] = sp[e]; t1_[e] = sp[1536 + e]; t2_[e] = sp[2 * 1536 + e]; }
                wcur[c3] = *(const bf16x8*)(a.Z() + (size_t)row * ZW + 512 * c3 + 8 * lane); bf8_to_f32(wcur[c3], tc_);
#pragma unroll
                for (int e = 0; e < 8; ++e) { cso[e] = t1_[e]; cso[1536 + e] = t2_[e]; cso[2 * 1536 + e] = tc_[e]; }
                w0[c3] = f32_to_bf8(t0_); w1[c3] = f32_to_bf8(t1_); w2[c3] = f32_to_bf8(t2_);
            }
            post_in_token(a, row, lane, wcs, w0, w1, w2, wcur, pin_load(a, row, lane), gn);
        }
    }
}

__device__ __forceinline__ void post_q_item(const MK& a, int idx, int lane) {
    const int row = idx >> 3, h = idx & 7;
    const float* q = a.Q() + (size_t)row * 768 + h * 96;
    float* o = a.qh() + ((size_t)row * 8 + h) * 96;
    const float v = q[lane];
    const float ss = wave_sum(v * v);
    o[lane] = v * rsqrtf(ss * (1.f / 64.f) + EPSV) * a.g_q_nope[lane];
    const float r = lane < 32 ? q[64 + lane] : 0.f;
    const float s2 = wave_sum(r * r);
    const float xn = lane < 32 ? r * rsqrtf(s2 * (1.f / 32.f) + EPSV) * a.g_q_rope[lane] : 0.f;
    const float other = __shfl_xor(xn, 16);
    const int i = lane & 15;
    const float* tb = a.ropecs() + (size_t)(row >= NPT ? 2048 : (row & 2047)) * 32;
    const float cs = tb[i], sn = tb[16 + i];
    const float ov = lane < 16 ? xn * cs - other * sn : other * sn + xn * cs;
    if (lane < 32) o[64 + lane] = ov;
}
__device__ __forceinline__ void post_kv_item(const MK& a, int idx, int lane) {
    const int row = idx >> 3, h = idx & 7;
    const float v = a.KV()[(size_t)row * 1024 + h * 128 + lane];
    const float ss = wave_sum(v * v);
    const float kn = v * rsqrtf(ss * (1.f / 64.f) + EPSV) * a.g_k_nope[lane];
    a.kh()[((size_t)row * 8 + h) * 64 + lane] = kn;
}

typedef float f32x16 __attribute__((ext_vector_type(16)));
typedef short s16x4 __attribute__((ext_vector_type(4)));
#define KST 104
#define VST 72
#define ATT_BUF (64 * KST * 2 + 64 * VST * 2)
__device__ __forceinline__ int crow32(int r, int hi) { return (r & 3) + 8 * (r >> 2) + 4 * hi; }
__device__ __forceinline__ s16x4 tr_read(const bf16_t* p) { return __builtin_bit_cast(s16x4, __builtin_amdgcn_ds_read_tr16_b64_v4i16((LAS s16x4*)(LAS void*)(unsigned)(size_t)p)); }
__device__ __forceinline__ bf16x8 pack8(const f32x16& x, int s) {
    u32x4 w; w.x = cvtpk(x[8 * s], x[8 * s + 1]); w.y = cvtpk(x[8 * s + 2], x[8 * s + 3]); w.z = cvtpk(x[8 * s + 4], x[8 * s + 5]); w.w = cvtpk(x[8 * s + 6], x[8 * s + 7]);
    return __builtin_bit_cast(bf16x8, w);
}
__device__ __forceinline__ void attn_block(const MK& a, int b, int h, int qb, char* smem) {
    const int tid = otid(), lane = tid & 63, wid = tid >> 6, r32 = lane & 31, hi = lane >> 5;
    const int qrow = qb * 256 + wid * 32 + r32;
    const int wq0 = qb * 256 + wid * 32;
    bf16x8 qf[6];
    {
        const float SCL = 0.14724445f;
        const bf16_t* Qg = a.qraw() + ((size_t)b * SEQ + qrow) * 768 + h * 96 + 8 * hi;
        float qv[6][8];
#pragma unroll
        for (int ds = 0; ds < 6; ++ds) bf8_to_f32(*(const bf16x8*)(Qg + 16 * ds), qv[ds]);
        float sn_ = 0.f, sr_ = 0.f;
#pragma unroll
        for (int j = 0; j < 8; ++j) { sn_ += qv[0][j] * qv[0][j] + qv[1][j] * qv[1][j] + qv[2][j] * qv[2][j] + qv[3][j] * qv[3][j]; sr_ += qv[4][j] * qv[4][j] + qv[5][j] * qv[5][j]; }
        sn_ += __shfl_xor(sn_, 32); sr_ += __shfl_xor(sr_, 32);
        const float rsn = rsqrtf(sn_ * (1.f / 64.f) + EPSV) * SCL, rsr = rsqrtf(sr_ * (1.f / 32.f) + EPSV);
#pragma unroll
        for (int ds = 0; ds < 4; ++ds) {
            float o[8];
#pragma unroll
            for (int j = 0; j < 8; ++j) o[j] = qv[ds][j] * rsn * a.g_q_nope[16 * ds + 8 * hi + j];
            qf[ds] = f32_to_bf8(o);
        }
        const float* tb = a.ropecs() + (size_t)qrow * 32 + 8 * hi;
        float o4[8], o5[8];
#pragma unroll
        for (int j = 0; j < 8; ++j) {
            const float x1 = qv[4][j] * rsr * a.g_q_rope[8 * hi + j], x2 = qv[5][j] * rsr * a.g_q_rope[16 + 8 * hi + j], cs = tb[j], sn = tb[16 + j];
            o4[j] = (x1 * cs - x2 * sn) * SCL; o5[j] = (x1 * sn + x2 * cs) * SCL;
        }
        qf[4] = f32_to_bf8(o4); qf[5] = f32_to_bf8(o5);
    }
    f32x16 o0, o1;
#pragma unroll
    for (int r = 0; r < 16; ++r) { o0[r] = 0.f; o1[r] = 0.f; }
    float m = 0.f, l = 0.f;
    f32x16 negm;
#pragma unroll
    for (int r = 0; r < 16; ++r) negm[r] = 0.f;
    const int nt = qb * 4 + 4;
    const int vr = tid >> 3, vc = tid & 7, rr_ = (tid >> 2) & 63, rc = tid & 3;
    const bf16_t* KVg = a.kvraw() + (size_t)b * SEQ * 1024 + h * 128 + (size_t)vr * 1024 + vc * 8;
    const bf16_t* KRg = a.krb() + (size_t)b * SEQ * 32 + (size_t)rr_ * 32 + rc * 8;
    float gk[8];
#pragma unroll
    for (int j = 0; j < 8; ++j) gk[j] = a.g_k_nope[8 * vc + j];
    bf16x8 kr0, kr1, vr0;
#define ATT_LOAD(tt) do { kr0 = *(const bf16x8*)(KVg + (size_t)(tt) * 64 * 1024); vr0 = *(const bf16x8*)(KVg + (size_t)(tt) * 64 * 1024 + 64); if (tid < 256) kr1 = *(const bf16x8*)(KRg + (size_t)(tt) * 64 * 32); } while (0)
#define ATT_STORE(buf) do { bf16_t* Ks_ = (bf16_t*)(smem + (buf) * ATT_BUF); bf16_t* Vs_ = Ks_ + 64 * KST; \
        float x_[8]; bf8_to_f32(kr0, x_); float ss_ = 0.f; _Pragma("unroll") for (int j = 0; j < 8; ++j) ss_ += x_[j] * x_[j]; \
        ss_ += __shfl_xor(ss_, 1); ss_ += __shfl_xor(ss_, 2); ss_ += __shfl_xor(ss_, 4); const float rs_ = rsqrtf(ss_ * (1.f / 64.f) + EPSV); \
        _Pragma("unroll") for (int j = 0; j < 8; ++j) x_[j] *= rs_ * gk[j]; \
        *(bf16x8*)(Ks_ + vr * KST + vc * 8) = f32_to_bf8(x_); *(bf16x8*)(Vs_ + vr * VST + vc * 8) = vr0; \
        if (tid < 256) *(bf16x8*)(Ks_ + rr_ * KST + 64 + rc * 8) = kr1; } while (0)
    ATT_LOAD(0);
    __syncthreads();
    ATT_STORE(0);
    __syncthreads();
    const int i16 = lane & 15, qq = i16 >> 2, pp = i16 & 3, g1 = (lane >> 4) & 1;
    for (int t = 0; t < nt; ++t) {
        const bf16_t* Ks = (const bf16_t*)(smem + (t & 1) * ATT_BUF); const bf16_t* Vs = Ks + 64 * KST;
        if (t + 1 < nt) ATT_LOAD(t + 1);
        if (64 * t <= wq0 + 31) {
            f32x16 p0, p1;
#pragma unroll
            for (int ds = 0; ds < 6; ++ds) {
                const bf16x8 k0 = *(const bf16x8*)(Ks + r32 * KST + 16 * ds + 8 * hi);
                const bf16x8 k1 = *(const bf16x8*)(Ks + (32 + r32) * KST + 16 * ds + 8 * hi);
                if (ds == 0) { p0 = __builtin_amdgcn_mfma_f32_32x32x16_bf16(k0, qf[ds], negm, 0, 0, 0); p1 = __builtin_amdgcn_mfma_f32_32x32x16_bf16(k1, qf[ds], negm, 0, 0, 0); }
                else { p0 = __builtin_amdgcn_mfma_f32_32x32x16_bf16(k0, qf[ds], p0, 0, 0, 0); p1 = __builtin_amdgcn_mfma_f32_32x32x16_bf16(k1, qf[ds], p1, 0, 0, 0); }
            }
            if (64 * t + 63 > wq0) {
#pragma unroll
                for (int r = 0; r < 16; ++r) { const int kv = 64 * t + crow32(r, hi); if (kv > qrow) p0[r] = -INFINITY; if (kv + 32 > qrow) p1[r] = -INFINITY; }
            }
            float mx = fmaxf(p0[0], p1[0]);
#pragma unroll
            for (int r = 1; r < 16; ++r) mx = fmaxf(mx, fmaxf(p0[r], p1[r]));
            mx = fmaxf(mx, __shfl_xor(mx, 32));
            const float delta = t == 0 ? mx : fmaxf(mx, 0.f);
            if (__any(delta != 0.f)) {
                m += delta;
                const float f = t == 0 ? 1.f : __builtin_amdgcn_exp2f(-delta);
#pragma unroll
                for (int r = 0; r < 16; ++r) { p0[r] -= delta; p1[r] -= delta; negm[r] = -m; o0[r] *= f; o1[r] *= f; }
                l *= f;
            }
            float rs = 0.f;
#pragma unroll
            for (int r = 0; r < 16; ++r) { p0[r] = __builtin_amdgcn_exp2f(p0[r]); p1[r] = __builtin_amdgcn_exp2f(p1[r]); rs += p0[r] + p1[r]; }
            l += rs;
            bf16x8 pf[4];
            pf[0] = pack8(p0, 0); pf[1] = pack8(p0, 1); pf[2] = pack8(p1, 0); pf[3] = pack8(p1, 1);
#pragma unroll
            for (int ks = 0; ks < 4; ++ks) {
                const bf16_t* vb0 = Vs + (16 * ks + 4 * hi + qq) * VST + 16 * g1 + 4 * pp;
                const s16x4 a0 = tr_read(vb0), a1 = tr_read(vb0 + 8 * VST);
                const s16x4 c0 = tr_read(vb0 + 32), c1 = tr_read(vb0 + 8 * VST + 32);
                const bf16x8 va = __builtin_shufflevector(a0, a1, 0, 1, 2, 3, 4, 5, 6, 7);
                const bf16x8 vc_ = __builtin_shufflevector(c0, c1, 0, 1, 2, 3, 4, 5, 6, 7);
                o0 = __builtin_amdgcn_mfma_f32_32x32x16_bf16(va, pf[ks], o0, 0, 0, 0);
                o1 = __builtin_amdgcn_mfma_f32_32x32x16_bf16(vc_, pf[ks], o1, 0, 0, 0);
            }
        }
        if (t + 1 < nt) ATT_STORE((t + 1) & 1);
        __syncthreads();
    }
    l += __shfl_xor(l, 32);
    const float il = 1.f / l;
    bf16_t* op = a.omix() + ((size_t)b * SEQ + qrow) * 1024 + 512 + h * 64;
#pragma unroll
    for (int g = 0; g < 4; ++g) {
        uint2 w0, w1;
        w0.x = pk2bf(o0[4 * g] * il, o0[4 * g + 1] * il); w0.y = pk2bf(o0[4 * g + 2] * il, o0[4 * g + 3] * il);
        w1.x = pk2bf(o1[4 * g] * il, o1[4 * g + 1] * il); w1.y = pk2bf(o1[4 * g + 2] * il, o1[4 * g + 3] * il);
        *(uint2*)(op + 8 * g + 4 * hi) = w0;
        *(uint2*)(op + 32 + 8 * g + 4 * hi) = w1;
    }
#undef ATT_LOAD
#undef ATT_STORE
}

__device__ __forceinline__ void gdn_unit(const MK& a, int b, int h, int dvg, const float* s0, float* sout, int row0, int T, int lane, char* wsm) {
    float (*sq)[64] = (float (*)[64])wsm;
    float (*sk)[64] = (float (*)[64])(wsm + 4096);
    float (*sv)[8] = (float (*)[8])(wsm + 8192);
    float* sg = (float*)(wsm + 8704);
    float* sb = (float*)(wsm + 8768);
    const int e = lane & 7, ko = lane >> 3, col = dvg * 8 + e;
    float S[8];
#pragma unroll
    for (int d = 0; d < 8; ++d) S[d] = s0 ? s0[(((size_t)b * 8 + h) * 64 + ko * 8 + d) * 64 + col] : 0.f;
    const size_t rbase = (size_t)row0 + (size_t)b * T;
    float pq[16], pk[16], pv0, pv1, pgb;
    {
        const int nt = T < 16 ? T : 16;
#pragma unroll
        for (int j = 0; j < 16; ++j) { const bool ok = j < nt; const size_t r = rbase + (ok ? j : 0); pq[j] = ok ? bf2f(a.qkv()[r * 1536 + h * 64 + lane]) : 0.f; pk[j] = ok ? bf2f(a.qkv()[r * 1536 + 512 + h * 64 + lane]) : 0.f; }
        { const int j0 = lane >> 3, j1 = j0 + 8; pv0 = j0 < nt ? bf2f(a.qkv()[(rbase + j0) * 1536 + 1024 + h * 64 + dvg * 8 + (lane & 7)]) : 0.f; pv1 = j1 < nt ? bf2f(a.qkv()[(rbase + j1) * 1536 + 1024 + h * 64 + dvg * 8 + (lane & 7)]) : 0.f; }
        { const int j = lane & 15; pgb = j < nt ? (lane < 16 ? a.gg()[(rbase + j) * 8 + h] : a.bb()[(rbase + j) * 8 + h]) : 0.f; }
    }
    for (int t0 = 0; t0 < T; t0 += 16) {
        const int nt = (T - t0) < 16 ? (T - t0) : 16;
        WSYNC();
#pragma unroll
        for (int j = 0; j < 16; ++j) { sq[j][lane] = pq[j]; sk[j][lane] = pk[j]; }
        sv[lane >> 3][lane & 7] = pv0; sv[(lane >> 3) + 8][lane & 7] = pv1;
        if (lane < 16) sg[lane] = expf(pgb); else if (lane < 32) sb[lane - 16] = pgb;
        WSYNC();
        if (t0 + 16 < T) {
            const size_t rb = rbase + t0 + 16;
#pragma unroll
            for (int j = 0; j < 16; ++j) { pq[j] = bf2f(a.qkv()[(rb + j) * 1536 + h * 64 + lane]); pk[j] = bf2f(a.qkv()[(rb + j) * 1536 + 512 + h * 64 + lane]); }
            pv0 = bf2f(a.qkv()[(rb + (lane >> 3)) * 1536 + 1024 + h * 64 + dvg * 8 + (lane & 7)]); pv1 = bf2f(a.qkv()[(rb + (lane >> 3) + 8) * 1536 + 1024 + h * 64 + dvg * 8 + (lane & 7)]);
            pgb = lane < 16 ? a.gg()[(rb + (lane & 15)) * 8 + h] : a.bb()[(rb + (lane & 15)) * 8 + h];
        }
        for (int j = 0; j < nt; ++j) {
            const float dec = sg[j], be = sb[j], v = sv[j][e];
            const float4 k0 = *(const float4*)&sk[j][ko * 8], k1 = *(const float4*)&sk[j][ko * 8 + 4];
            const float4 q0 = *(const float4*)&sq[j][ko * 8], q1 = *(const float4*)&sq[j][ko * 8 + 4];
            const float kk[8] = {k0.x, k0.y, k0.z, k0.w, k1.x, k1.y, k1.z, k1.w};
            const float qq[8] = {q0.x, q0.y, q0.z, q0.w, q1.x, q1.y, q1.z, q1.w};
            float ks = 0.f;
#pragma unroll
            for (int d = 0; d < 8; ++d) { S[d] *= dec; ks += kk[d] * S[d]; }
            ks += __shfl_xor(ks, 8); ks += __shfl_xor(ks, 16); ks += __shfl_xor(ks, 32);
            const float delta = (v - ks) * be;
            float ov = 0.f;
#pragma unroll
            for (int d = 0; d < 8; ++d) { S[d] += kk[d] * delta; ov += qq[d] * S[d]; }
            ov += __shfl_xor(ov, 8); ov += __shfl_xor(ov, 16); ov += __shfl_xor(ov, 32);
            if (ko == 0) a.goraw()[(rbase + t0 + j) * 512 + h * 64 + col] = ov;
        }
    }
#pragma unroll
    for (int d = 0; d < 8; ++d) sout[(((size_t)b * 8 + h) * 64 + ko * 8 + d) * 64 + col] = S[d];
}
__device__ __forceinline__ bf16x8 ld8_f32_bf16(const float* p) {
    const float4 x = *(const float4*)p, y = *(const float4*)(p + 4);
    u32x4 w; w.x = cvtpk(x.x, x.y); w.y = cvtpk(x.z, x.w); w.z = cvtpk(y.x, y.y); w.w = cvtpk(y.z, y.w);
    return __builtin_bit_cast(bf16x8, w);
}
__device__ __forceinline__ int pi_pos(int k) { return (k & 32) + 8 * ((k >> 2) & 3) + 4 * ((k >> 4) & 1) + (k & 3); }
#define GDN_WLDS 17408
__device__ __forceinline__ void gdn_prep_unit(const MK& a, int u, int lane_in, char* wsm) {
    int lane = lane_in; asm volatile("" : "+v"(lane));
    const int bh = u >> 5, n = u & 31, b = bh >> 3, h = bh & 7, i16 = lane & 15, q4 = lane >> 4;
    const size_t row0 = (size_t)b * SEQ + n * 64;
    float* AT = (float*)wsm; float* GC = (float*)(wsm + 16384); float* BT = GC + 64;
    const bf16_t* qbase = a.qkv() + row0 * 1536 + h * 64; const bf16_t* kbase = qbase + 512; const bf16_t* vbase = qbase + 1024;
    float g = a.gg()[(row0 + lane) * 8 + h];
    const float be_l = a.bb()[(row0 + lane) * 8 + h];
#pragma unroll
    for (int o = 1; o < 64; o <<= 1) { const float t = __shfl_up(g, o); if (lane >= o) g += t; }
    WSYNC();
    GC[lane] = g; BT[lane] = be_l;
    WSYNC();
    const float gl = GC[63];
    float* EG = BT + 64; float* ED = EG + 64;
    EG[lane] = expf(g); ED[lane] = expf(gl - g);
    WSYNC();
    bf16x8 kf[4][2], qf[4][2];
#pragma unroll
    for (int mt = 0; mt < 4; ++mt)
#pragma unroll
        for (int ks = 0; ks < 2; ++ks) {
            const int off = (16 * mt + i16) * 1536 + 32 * ks + 8 * q4;
            kf[mt][ks] = *(const bf16x8*)(kbase + off); qf[mt][ks] = *(const bf16x8*)(qbase + off);
        }
    bf16_t* QKg = a.gQK() + (size_t)u * 4096;
#pragma unroll
    for (int mt = 0; mt < 4; ++mt)
#pragma unroll
        for (int nt = 0; nt < 4; ++nt) {
            const int j = 16 * nt + i16, pj = 32 * (nt >> 1) + 8 * (i16 >> 2) + 4 * (nt & 1) + (i16 & 3);
            if (nt <= mt) {
                f32x4 d1 = {0.f, 0.f, 0.f, 0.f}, d2 = {0.f, 0.f, 0.f, 0.f};
#pragma unroll
                for (int ks = 0; ks < 2; ++ks) {
                    d1 = __builtin_amdgcn_mfma_f32_16x16x32_bf16(kf[mt][ks], kf[nt][ks], d1, 0, 0, 0);
                    d2 = __builtin_amdgcn_mfma_f32_16x16x32_bf16(qf[mt][ks], kf[nt][ks], d2, 0, 0, 0);
                }
                const float gcj = GC[j];
#pragma unroll
                for (int r = 0; r < 4; ++r) {
                    const int i = 16 * mt + 4 * q4 + r;
                    const float dec = __builtin_amdgcn_exp2f(1.44269504f * (GC[i] - gcj));
                    AT[i * 64 + j] = (i > j) ? BT[i] * d1[r] * dec : 0.f;
                    QKg[i * 64 + (((pj >> 3) ^ (i & 7)) << 3) + (pj & 7)] = f2bf((i >= j) ? d2[r] * dec : 0.f);
                }
            } else {
#pragma unroll
                for (int r = 0; r < 4; ++r) { const int i = 16 * mt + 4 * q4 + r; QKg[i * 64 + (((pj >> 3) ^ (i & 7)) << 3) + (pj & 7)] = 0; }
            }
        }
    {
        bf16_t* Qgg = a.gQg() + (size_t)u * 4096;
#pragma unroll
        for (int mt = 0; mt < 4; ++mt) {
            const int i = 16 * mt + i16; const float e = EG[i];
#pragma unroll
            for (int ks = 0; ks < 2; ++ks) {
                float x[8]; bf8_to_f32(qf[mt][ks], x);
                uint2 w0, w1; w0.x = cvtpk(x[0] * e, x[1] * e); w0.y = cvtpk(x[2] * e, x[3] * e); w1.x = cvtpk(x[4] * e, x[5] * e); w1.y = cvtpk(x[6] * e, x[7] * e);
                const int p0 = 32 * ks + 16 * (q4 & 1) + 4 * (q4 >> 1);
                *(uint2*)(Qgg + i * 64 + (((p0 >> 3) ^ (i & 7)) << 3) + (p0 & 7)) = w0; *(uint2*)(Qgg + i * 64 + ((((p0 >> 3) + 1) ^ (i & 7)) << 3) + (p0 & 7)) = w1;
            }
        }
    }
    WSYNC();
    __builtin_amdgcn_sched_barrier(0);
    {
        float U[64];
#pragma unroll
        for (int i = 0; i < 64; ++i) { U[i] = bf2f(vbase[i * 1536 + lane]) * BT[i]; }
#pragma unroll
        for (int i = 1; i < 64; ++i) {
            float su = 0.f;
#pragma unroll
            for (int j4 = 0; j4 < i; j4 += 4) {
                const float4 av = *(const float4*)(AT + i * 64 + j4);
                su += av.x * U[j4];
                if (j4 + 1 < i) su += av.y * U[j4 + 1];
                if (j4 + 2 < i) su += av.z * U[j4 + 2];
                if (j4 + 3 < i) su += av.w * U[j4 + 3];
            }
            U[i] -= su;
            __builtin_amdgcn_sched_barrier(0);
        }
        float* UTg = a.gUT() + ((size_t)u * 64 + lane) * 64;
#pragma unroll
        for (int i = 0; i < 64; i += 4) *(float4*)(UTg + 4 * ((i >> 2) ^ (lane & 15))) = (float4){U[i], U[i + 1], U[i + 2], U[i + 3]};
    }
    asm volatile("" ::: "memory");
    __builtin_amdgcn_sched_barrier(0);
    {
        float W[64];
#pragma unroll
        for (int i = 0; i < 64; ++i) { W[i] = bf2f(kbase[i * 1536 + lane]); }
        bf16_t* Kdg = a.gKd() + ((size_t)u * 64 + lane) * 64;
#pragma unroll
        for (int pc = 0; pc < 8; ++pc) {
            float t[8];
#pragma unroll
            for (int jj = 0; jj < 8; ++jj) { const int j = 32 * (pc >> 2) + 16 * (jj >> 2) + 4 * (pc & 3) + (jj & 3); t[jj] = W[j] * ED[j]; }
            u32x4 w; w.x = cvtpk(t[0], t[1]); w.y = cvtpk(t[2], t[3]); w.z = cvtpk(t[4], t[5]); w.w = cvtpk(t[6], t[7]);
            *(u32x4*)(Kdg + 8 * (pc ^ (lane & 7))) = w;
        }
#pragma unroll
        for (int i = 0; i < 64; ++i) W[i] *= BT[i] * EG[i];
#pragma unroll
        for (int i = 1; i < 64; ++i) {
            float sw = 0.f;
#pragma unroll
            for (int j4 = 0; j4 < i; j4 += 4) {
                const float4 av = *(const float4*)(AT + i * 64 + j4);
                sw += av.x * W[j4];
                if (j4 + 1 < i) sw += av.y * W[j4 + 1];
                if (j4 + 2 < i) sw += av.z * W[j4 + 2];
                if (j4 + 3 < i) sw += av.w * W[j4 + 3];
            }
            W[i] -= sw;
            __builtin_amdgcn_sched_barrier(0);
        }
        bf16_t* Wng = a.gWn() + (size_t)u * 4096; const int pp = pi_pos(lane);
#pragma unroll
        for (int i = 0; i < 64; ++i) Wng[i * 64 + (((pp >> 3) ^ (i & 7)) << 3) + (pp & 7)] = f2bf(-W[i]);
    }
    if (lane == 0) a.ggam()[u] = expf(gl);
}
__device__ __forceinline__ bf16x8 pack_acc2(const f32x4& x, const f32x4& y) {
    u32x4 w; w.x = cvtpk(x[0], x[1]); w.y = cvtpk(x[2], x[3]); w.z = cvtpk(y[0], y[1]); w.w = cvtpk(y[2], y[3]);
    return __builtin_bit_cast(bf16x8, w);
}
#define G2_SLOT 49152
__device__ __forceinline__ void g2_issue(const MK& a, size_t u, int n, LAS unsigned char* lds, int lw, int lane) {
    LAS unsigned char* dst = lds + (n % 3) * G2_SLOT;
    const char* srcs[4] = {(const char*)(a.gWn() + u * 4096), (const char*)(a.gQg() + u * 4096), (const char*)(a.gQK() + u * 4096), (const char*)(a.gKd() + u * 4096)};
#pragma unroll
    for (int m = 0; m < 4; ++m)
#pragma unroll
        for (int i = 0; i < 2; ++i) { const int piece = 2 * lw + i;
            __builtin_amdgcn_global_load_lds((const unsigned*)(srcs[m] + piece * 1024 + lane * 16), (LAS unsigned*)(dst + m * 8192 + piece * 1024), 16, 0, 0); }
    const char* us = (const char*)(a.gUT() + u * 4096);
#pragma unroll
    for (int i = 0; i < 4; ++i) { const int piece = 4 * lw + i;
        __builtin_amdgcn_global_load_lds((const unsigned*)(us + piece * 1024 + lane * 16), (LAS unsigned*)(dst + 32768 + piece * 1024), 16, 0, 0); }
}
__device__ __forceinline__ void gdn_scan_block(const MK& a, int bh, LAS unsigned char* lds) {
    const int tid = otid(), lane = tid & 63, wid = __builtin_amdgcn_readfirstlane(tid >> 6), i16 = lane & 15, q4 = lane >> 4;
    const int b = bh >> 3, h = bh & 7, sl = wid & 3;
    const bool loader = wid >= 4;
    f32x4 S[4];
#pragma unroll
    for (int mt = 0; mt < 4; ++mt) S[mt] = (f32x4){0.f, 0.f, 0.f, 0.f};
    __syncthreads();
    if (loader) { g2_issue(a, (size_t)bh * 32, 0, lds, wid - 4, lane); g2_issue(a, (size_t)bh * 32 + 1, 1, lds, wid - 4, lane); }
    for (int n = 0; n < 32; ++n) {
        if (loader) { if (n < 31) asm volatile("s_waitcnt vmcnt(12)" ::: "memory"); else asm volatile("s_waitcnt vmcnt(0)" ::: "memory"); }
        asm volatile("s_waitcnt lgkmcnt(0)" ::: "memory"); __builtin_amdgcn_s_barrier(); asm volatile("" ::: "memory");
        if (loader) { if (n + 2 < 32) g2_issue(a, (size_t)bh * 32 + n + 2, n + 2, lds, wid - 4, lane); }
        else {
            const LAS unsigned char* sb = lds + (n % 3) * G2_SLOT;
            const float gam = a.ggam()[(size_t)bh * 32 + n];
            bf16x8 Sb[2]; Sb[0] = pack_acc2(S[0], S[1]); Sb[1] = pack_acc2(S[2], S[3]);
            f32x4 Vn[4];
#pragma unroll
            for (int mt = 0; mt < 4; ++mt) Vn[mt] = *(const LAS f32x4*)(sb + 32768 + (16 * sl + i16) * 256 + 16 * ((4 * mt + q4) ^ i16));
#pragma unroll
            for (int mt = 0; mt < 4; ++mt)
#pragma unroll
                for (int ks = 0; ks < 2; ++ks) Vn[mt] = __builtin_amdgcn_mfma_f32_16x16x32_bf16(*(const LAS bf16x8*)(sb + (16 * mt + i16) * 128 + 16 * ((4 * ks + q4) ^ (i16 & 7))), Sb[ks], Vn[mt], 0, 0, 0);
            bf16x8 Vb[2]; Vb[0] = pack_acc2(Vn[0], Vn[1]); Vb[1] = pack_acc2(Vn[2], Vn[3]);
            f32x4 O[4];
#pragma unroll
            for (int mt = 0; mt < 4; ++mt) {
                O[mt] = (f32x4){0.f, 0.f, 0.f, 0.f};
#pragma unroll
                for (int ks = 0; ks < 2; ++ks) {
                    const int fo = (16 * mt + i16) * 128 + 16 * ((4 * ks + q4) ^ (i16 & 7));
                    O[mt] = __builtin_amdgcn_mfma_f32_16x16x32_bf16(*(const LAS bf16x8*)(sb + 8192 + fo), Sb[ks], O[mt], 0, 0, 0);
                    O[mt] = __builtin_amdgcn_mfma_f32_16x16x32_bf16(*(const LAS bf16x8*)(sb + 16384 + fo), Vb[ks], O[mt], 0, 0, 0);
                }
            }
#pragma unroll
            for (int mt = 0; mt < 4; ++mt) {
                S[mt] = S[mt] * gam;
#pragma unroll
                for (int ks = 0; ks < 2; ++ks) S[mt] = __builtin_amdgcn_mfma_f32_16x16x32_bf16(*(const LAS bf16x8*)(sb + 24576 + (16 * mt + i16) * 128 + 16 * ((4 * ks + q4) ^ (i16 & 7))), Vb[ks], S[mt], 0, 0, 0);
            }
            float* og = a.goraw() + ((size_t)b * SEQ + n * 64 + 4 * q4) * 512 + h * 64 + 16 * sl + i16;
#pragma unroll
            for (int mt = 0; mt < 4; ++mt)
#pragma unroll
                for (int r = 0; r < 4; ++r) og[(size_t)(16 * mt + r) * 512] = O[mt][r];
        }
    }
    if (!loader) {
        float* so = a.out + O_GSP + ((size_t)bh * 64 + 4 * q4) * 64 + 16 * sl + i16;
#pragma unroll
        for (int mt = 0; mt < 4; ++mt)
#pragma unroll
            for (int r = 0; r < 4; ++r) so[(size_t)(16 * mt + r) * 64] = S[mt][r];
    }
    __syncthreads();
}
__device__ __forceinline__ void gdn_out_token(const MK& a, int row, int lane) {
    const float* op = a.goraw() + (size_t)row * 512 + 8 * lane;
    const float4 x0 = *(const float4*)op, x1 = *(const float4*)(op + 4);
    float o[8] = {x0.x, x0.y, x0.z, x0.w, x1.x, x1.y, x1.z, x1.w}, zg[8];
    bf8_to_f32(*(const bf16x8*)(a.Z() + (size_t)row * ZW + OFF_Z + 8 * lane), zg);
    float ss = 0.f;
#pragma unroll
    for (int e = 0; e < 8; ++e) ss += o[e] * o[e];
    ss += __shfl_xor(ss, 1); ss += __shfl_xor(ss, 2); ss += __shfl_xor(ss, 4);
    const float rs = rsqrtf(ss * (1.f / 64.f) + EPSV);
    const float4 g0 = *(const float4*)(a.g_gdn_out + 8 * (lane & 7)), g1 = *(const float4*)(a.g_gdn_out + 8 * (lane & 7) + 4);
    const float gg_[8] = {g0.x, g0.y, g0.z, g0.w, g1.x, g1.y, g1.z, g1.w};
#pragma unroll
    for (int e = 0; e < 8; ++e) o[e] = o[e] * rs * gg_[e] * zg[e] * fast_sigmoid(zg[e]);
    *(bf16x8*)(a.omix() + (size_t)row * 1024 + 8 * lane) = f32_to_bf8(o);
}

#define SSLOT 32768
#define TL_OFF (3 * SSLOT)
#define CST 264
#define KR_OFF (TL_OFF + 2 * 32 * CST * 2)
#define WQ_OFF (KR_OFF + 4 * 4096)
#define QR_OFF (WQ_OFF + 2048)
#define PG_OFF (QR_OFF + 1024)
#define PT_OFF (PG_OFF + 64)
#define AL_OFF (PT_OFF + 1024)
#define SAMP_LDS_END (AL_OFF + 64)
__device__ __forceinline__ void samp_issue(const MK& a, int g, LAS unsigned char* lds, int wid, int lane) {
    const int phys = __builtin_amdgcn_readfirstlane(((const LAS int*)(lds + PG_OFF))[g >> 2]);
    const int tok0 = (g & 3) * 32 + 4 * wid;
    const float* cs = a.cache_ckv + ((size_t)phys * 128 + tok0) * 256 + lane * 4;
#pragma unroll
    for (int i = 0; i < 4; ++i) __builtin_amdgcn_global_load_lds((const unsigned*)(cs + i * 256), (LAS unsigned*)(lds + (g % 3) * SSLOT + (4 * wid + i) * 1024), 16, 0, 0);
    if (wid < 4) __builtin_amdgcn_global_load_lds((const unsigned*)(a.cache_krope + ((size_t)phys * 128 + (g & 3) * 32 + 8 * wid) * 32 + lane * 4), (LAS unsigned*)(lds + KR_OFF + (g & 3) * 4096 + wid * 1024), 16, 0, 0);
}
__device__ __forceinline__ void samp_convert(int g, LAS unsigned char* lds, int tid) {
    const int st = tid >> 4, c16 = (tid & 15) * 16;
    const LAS float* src = (const LAS float*)(lds + (g % 3) * SSLOT) + st * 256 + c16;
    const f32x4 x0 = *(const LAS f32x4*)src, x1 = *(const LAS f32x4*)(src + 4), x2 = *(const LAS f32x4*)(src + 8), x3 = *(const LAS f32x4*)(src + 12);
    u32x4 w0, w1; w0.x = cvtpk(x0[0], x0[1]); w0.y = cvtpk(x0[2], x0[3]); w0.z = cvtpk(x1[0], x1[1]); w0.w = cvtpk(x1[2], x1[3]);
    w1.x = cvtpk(x2[0], x2[1]); w1.y = cvtpk(x2[2], x2[3]); w1.z = cvtpk(x3[0], x3[1]); w1.w = cvtpk(x3[2], x3[3]);
    LAS bf16_t* dst = (LAS bf16_t*)(lds + TL_OFF + (g & 1) * 32 * CST * 2) + st * CST + c16;
    *(LAS u32x4*)dst = w0; *(LAS u32x4*)(dst + 8) = w1;
}
#define SAMP_WAITV(n5, n4) do { if (h < 4) asm volatile("s_waitcnt vmcnt(" #n5 ")" ::: "memory"); else asm volatile("s_waitcnt vmcnt(" #n4 ")" ::: "memory"); } while (0)
#define SAMP_BAR() do { asm volatile("s_waitcnt lgkmcnt(0)" ::: "memory"); __builtin_amdgcn_s_barrier(); asm volatile("" ::: "memory"); } while (0)
__device__ __forceinline__ void samp_attn_unit(const MK& a, int u, char* smem, LAS unsigned char* lds) {
    const int tid = otid(), lane = tid & 63, h = __builtin_amdgcn_readfirstlane(tid >> 6), i16 = lane & 15, q4 = lane >> 4;
    const int b = u >> 3, sp = u & 7;
    float* WQ = (float*)(smem + WQ_OFF);
    float* QR = (float*)(smem + QR_OFF);
    int* PG = (int*)(smem + PG_OFF);
    const float SCL = 0.14724445f;
    post_q_item(a, (NPT + b) * 8 + h, lane);
    __syncthreads();
    {
        const int h_ = tid >> 6, l_ = tid & 63, q4_ = l_ >> 4, idx = l_ & 15, d = 16 * (idx >> 2) + 4 * q4_ + (idx & 3);
        WQ[tid] = a.g_k_nope[d] * a.qh()[((size_t)(NPT + b) * 8 + h_) * 96 + d] * SCL;
        if (tid < 256) QR[tid] = a.qh()[((size_t)(NPT + b) * 8 + (tid >> 5)) * 96 + 64 + (tid & 31)] * SCL;
        if (tid < 16) PG[tid] = a.page_table[b * NPAGES + sp * 16 + tid];
    }
    bf16x8 wf[4][8];
#pragma unroll
    for (int mt = 0; mt < 4; ++mt)
#pragma unroll
        for (int ks = 0; ks < 8; ++ks) wf[mt][ks] = *(const bf16x8*)(a.WknT() + (size_t)(h * 64 + 16 * mt + i16) * 256 + 32 * ks + 8 * q4);
#pragma unroll
    for (int mt = 0; mt < 4; ++mt)
#pragma unroll
        for (int ks = 0; ks < 8; ++ks) asm volatile("" : "+v"(wf[mt][ks]));
    __syncthreads();
    samp_issue(a, 0, lds, h, lane); samp_issue(a, 1, lds, h, lane); samp_issue(a, 2, lds, h, lane);
    SAMP_WAITV(10, 8);
    SAMP_BAR();
    samp_convert(0, lds, tid);
    const LAS float* QRl = (const LAS float*)(lds + QR_OFF) + h * 32 + 8 * q4;
    const LAS float* WQl = (const LAS float*)(lds + WQ_OFF) + (h * 4 + q4) * 16;
    float m = -INFINITY, lsum = 0.f;
    f32x4 latv[2]; latv[0] = (f32x4){0.f, 0.f, 0.f, 0.f}; latv[1] = (f32x4){0.f, 0.f, 0.f, 0.f};
    for (int g = 0; g < 64; ++g) {
        SAMP_BAR();
        if (g + 3 < 64) samp_issue(a, g + 3, lds, h, lane);
        const LAS bf16_t* Tl = (const LAS bf16_t*)(lds + TL_OFF + (g & 1) * 32 * CST * 2); const LAS float* KR = (const LAS float*)(lds + KR_OFF + (g & 3) * 4096);
        float sc[2];
        {
            f32x4 acc[2][4];
#pragma unroll
            for (int hf = 0; hf < 2; ++hf)
#pragma unroll
                for (int mt = 0; mt < 4; ++mt) acc[hf][mt] = (f32x4){0.f, 0.f, 0.f, 0.f};
            const LAS bf16_t* cp0 = Tl + i16 * CST + 8 * q4; const LAS bf16_t* cp1 = cp0 + 16 * CST;
            bf16x8 c0 = *(const LAS bf16x8*)cp0, c1 = *(const LAS bf16x8*)cp1;
#pragma unroll
            for (int ks = 0; ks < 8; ++ks) {
                bf16x8 n0 = c0, n1 = c1;
                if (ks < 7) { n0 = *(const LAS bf16x8*)(cp0 + 32 * (ks + 1)); n1 = *(const LAS bf16x8*)(cp1 + 32 * (ks + 1)); }
#pragma unroll
                for (int mt = 0; mt < 4; ++mt) { acc[0][mt] = __builtin_amdgcn_mfma_f32_16x16x32_bf16(wf[mt][ks], c0, acc[0][mt], 0, 0, 0); acc[1][mt] = __builtin_amdgcn_mfma_f32_16x16x32_bf16(wf[mt][ks], c1, acc[1][mt], 0, 0, 0); }
                c0 = n0; c1 = n1;
            }
#pragma unroll
            for (int hf = 0; hf < 2; ++hf) {
                float ss = 0.f, dot = 0.f, rd = 0.f;
#pragma unroll
                for (int mt = 0; mt < 4; ++mt) {
                    const f32x4 wq = *(const LAS f32x4*)(WQl + 4 * mt);
                    ss += acc[hf][mt][0] * acc[hf][mt][0] + acc[hf][mt][1] * acc[hf][mt][1] + acc[hf][mt][2] * acc[hf][mt][2] + acc[hf][mt][3] * acc[hf][mt][3];
                    dot += acc[hf][mt][0] * wq[0] + acc[hf][mt][1] * wq[1] + acc[hf][mt][2] * wq[2] + acc[hf][mt][3] * wq[3];
                }
                {
                    const LAS float* kp = KR + (16 * hf + i16) * 32 + 8 * q4;
                    const f32x4 k0 = *(const LAS f32x4*)kp, k1 = *(const LAS f32x4*)(kp + 4), q0 = *(const LAS f32x4*)QRl, q1 = *(const LAS f32x4*)(QRl + 4);
                    rd = k0[0] * q0[0] + k0[1] * q0[1] + k0[2] * q0[2] + k0[3] * q0[3] + k1[0] * q1[0] + k1[1] * q1[1] + k1[2] * q1[2] + k1[3] * q1[3];
                }
                ss += __shfl_xor(ss, 16); dot += __shfl_xor(dot, 16); rd += __shfl_xor(rd, 16);
                ss += __shfl_xor(ss, 32); dot += __shfl_xor(dot, 32); rd += __shfl_xor(rd, 32);
                sc[hf] = dot * rsqrtf(ss * (1.f / 64.f) + EPSV) + rd;
            }
        }
        float gm = fmaxf(sc[0], sc[1]);
#pragma unroll
        for (int o = 1; o < 16; o <<= 1) gm = fmaxf(gm, __shfl_xor(gm, o));
        const float mn = fmaxf(m, gm);
        const float alpha = __builtin_amdgcn_exp2f(m - mn), p0 = __builtin_amdgcn_exp2f(sc[0] - mn), p1 = __builtin_amdgcn_exp2f(sc[1] - mn);
        m = mn;
        lsum = lsum * alpha + p0 + p1;
        if (q4 == 0) { ((LAS float*)(lds + PT_OFF))[h * 32 + i16] = p0; ((LAS float*)(lds + PT_OFF))[h * 32 + 16 + i16] = p1; if (i16 == 0) ((LAS float*)(lds + AL_OFF))[h] = alpha; }
        if (g <= 60) SAMP_WAITV(10, 8); else if (g == 61) SAMP_WAITV(5, 4); else SAMP_WAITV(0, 0);
        SAMP_BAR();
        {
            u32x4 pw = {0u, 0u, 0u, 0u};
            if (i16 < 8) { const f32x4 pa = *(const LAS f32x4*)(lds + PT_OFF + (i16 * 32 + 8 * q4) * 4), pb_ = *(const LAS f32x4*)(lds + PT_OFF + (i16 * 32 + 8 * q4 + 4) * 4);
                pw.x = cvtpk(pa[0], pa[1]); pw.y = cvtpk(pa[2], pa[3]); pw.z = cvtpk(pb_[0], pb_[1]); pw.w = cvtpk(pb_[2], pb_[3]); }
            const bf16x8 pfr = __builtin_bit_cast(bf16x8, pw);
            const f32x4 al = *(const LAS f32x4*)(lds + AL_OFF + (q4 & 1) * 16);
            const bf16_t* tb0 = (const bf16_t*)(smem + TL_OFF + (g & 1) * 32 * CST * 2) + (8 * q4 + (i16 >> 2)) * CST + 32 * h + 4 * (i16 & 3);
#pragma unroll
            for (int nt = 0; nt < 2; ++nt) {
                const s16x4 c0 = tr_read(tb0 + 16 * nt), c1 = tr_read(tb0 + 16 * nt + 4 * CST);
                const bf16x8 cfr = __builtin_shufflevector(c0, c1, 0, 1, 2, 3, 4, 5, 6, 7);
                latv[nt] = latv[nt] * al;
                latv[nt] = __builtin_amdgcn_mfma_f32_16x16x32_bf16(pfr, cfr, latv[nt], 0, 0, 0);
            }
        }
        if (g + 1 < 64) samp_convert(g + 1, lds, tid);
    }
#pragma unroll
    for (int o = 1; o < 16; o <<= 1) lsum += __shfl_xor(lsum, o);
    if (lane == 0) { float* o = a.part() + ((size_t)u * 8 + h) * 260; o[0] = m * 0.69314718f; o[1] = lsum; }
    if (q4 < 2) {
#pragma unroll
        for (int nt = 0; nt < 2; ++nt)
#pragma unroll
            for (int r = 0; r < 4; ++r) a.part()[((size_t)u * 8 + 4 * q4 + r) * 260 + 4 + 32 * h + 16 * nt + i16] = latv[nt][r];
    }
}
__device__ __forceinline__ void samp_comb_unit(const MK& a, int u, char* smem) {
    float* slat = (float*)smem;
    const int b = u >> 3, h = u & 7, tid = otid() & 255;
    const size_t row = NPT + b;
    const float* q = a.qh() + (row * 8 + h) * 96;
    float s_self = 0.f;
    for (int d = 0; d < 64; ++d) s_self += q[d] * a.kh()[(row * 8 + h) * 64 + d];
    for (int d = 0; d < 32; ++d) s_self += q[64 + d] * a.krf()[row * 32 + d];
    s_self *= 0.10206207261596577f;
    float m = s_self;
    for (int s = 0; s < 8; ++s) m = fmaxf(m, a.part()[((size_t)(b * 8 + s) * 8 + h) * 260]);
    const float pself = expf(s_self - m);
    float l = pself, lat = 0.f;
    for (int s = 0; s < 8; ++s) {
        const float* p = a.part() + ((size_t)(b * 8 + s) * 8 + h) * 260;
        const float w = expf(p[0] - m);
        l += p[1] * w; lat += p[4 + tid] * w;
    }
    __syncthreads();
    slat[tid] = lat;
    __syncthreads();
    if (tid < 64) {
        float o = 0.f;
        for (int c = 0; c < 256; ++c) o += slat[c] * a.w_kv_b[(size_t)c * 1024 + h * 128 + 64 + tid];
        o += pself * a.KV()[row * 1024 + h * 128 + 64 + tid];
        a.omix()[row * 1024 + 512 + h * 64 + tid] = f2bf(o / l);
    }
}

#define XB_TMO      128
#define XB_XCNT(j)  (256  + 64 * (j))
#define XB_XSUB(j)  (1280 + 64 * (j))
#define XB_XGEN(j)  (2304 + 64 * (j))
#define XB_TOP      3328
#define XB_TOPGEN   3392
#define XCD_BAR_WORDS 3456
#define XB_SPIN_CAP (1u << 18)

__device__ __forceinline__ unsigned xb_ld(unsigned* p)              { return __hip_atomic_load(p, __ATOMIC_RELAXED, __HIP_MEMORY_SCOPE_AGENT); }
__device__ __forceinline__ unsigned xb_add(unsigned* p, unsigned v) { return __hip_atomic_fetch_add(p, v, __ATOMIC_RELAXED, __HIP_MEMORY_SCOPE_AGENT); }
__device__ __forceinline__ unsigned xb_xcc_id() { return (unsigned)__builtin_amdgcn_s_getreg((3 << 11) | 20) & 0xFu; }
#define XB_SPIN(cond, bar) do { unsigned _sp = 0; while (cond) { __builtin_amdgcn_s_sleep(1); \
    if ((++_sp & 255u) == 0u) { if (xb_ld(&(bar)[XB_TMO])) break; if (_sp > XB_SPIN_CAP) { atomicAdd(&(bar)[XB_TMO], 1u); break; } } } } while (0)

struct XcdBarrier {
    unsigned* bar; unsigned x;
    volatile LAS unsigned* st;
};

__device__ __forceinline__ XcdBarrier xcd_barrier_post(unsigned* bar, volatile LAS unsigned* st) {
    XcdBarrier b; b.bar = bar; b.x = xb_xcc_id(); b.st = st;
    if (threadIdx.x == 0) (void)xb_add(&bar[XB_XCNT(b.x)], 1u);
    return b;
}
__device__ __forceinline__ void xcd_barrier_complete(unsigned* bar, unsigned x, unsigned& nloc, unsigned& nx) {
    const unsigned G = gridDim.x * gridDim.y * gridDim.z;
    unsigned sum, cnt, mine, sp = 0u;
    for (;;) {
        sum = 0u; cnt = 0u; mine = 0u;
#pragma unroll
        for (unsigned j = 0; j < 16; ++j) { const unsigned c = xb_ld(&bar[XB_XCNT(j)]); sum += c; cnt += (c > 0u) ? 1u : 0u; mine = (j == x) ? c : mine; }
        if (sum == G) break;
        __builtin_amdgcn_s_sleep(1);
        if ((++sp & 255u) == 0u) { if (xb_ld(&bar[XB_TMO])) break; if (sp > XB_SPIN_CAP) { atomicAdd(&bar[XB_TMO], 1u); break; } }
    }
    nloc = mine > 0u ? mine : 1u; nx = cnt > 0u ? cnt : 1u;
}

__device__ __forceinline__ void xcd_barrier(const XcdBarrier& b) {
    asm volatile("s_waitcnt vmcnt(0)" ::: "memory");
    __syncthreads();
    if (threadIdx.x == 0) {
        unsigned* bar = b.bar;
        __builtin_amdgcn_s_waitcnt(0);
        unsigned nloc = b.st[0], nx = b.st[1];
        if (nloc == 0u) { xcd_barrier_complete(bar, b.x, nloc, nx); b.st[0] = nloc; b.st[1] = nx; }
        const unsigned old = xb_add(&bar[XB_XSUB(b.x)], 1u);
        const unsigned gen = old / nloc;
        if (old + 1u == (gen + 1u) * nloc) {
            __builtin_amdgcn_fence(__ATOMIC_RELEASE, "agent");
            asm volatile("s_waitcnt vmcnt(0)" ::: "memory");
            const unsigned og = xb_add(&bar[XB_TOP], 1u);
            const unsigned tg = og / nx;
            if (og + 1u == (tg + 1u) * nx) xb_add(&bar[XB_TOPGEN], 1u);
            else XB_SPIN(xb_ld(&bar[XB_TOPGEN]) == tg, bar);
            __builtin_amdgcn_fence(__ATOMIC_ACQUIRE, "agent");
            xb_add(&bar[XB_XGEN(b.x)], 1u);
            asm volatile("s_waitcnt vmcnt(0)" ::: "memory");
        } else {
            XB_SPIN(xb_ld(&bar[XB_XGEN(b.x)]) == gen, bar);
            __builtin_amdgcn_fence(__ATOMIC_ACQUIRE, "agent");
            asm volatile("s_waitcnt vmcnt(0)" ::: "memory");
        }
    }
    __syncthreads();
}

#define XB_ST_OFF 155648
#define LDS_BYTES 155904
static_assert(SAMP_LDS_END <= LDS_BYTES, "LDS map");
#define GSYNC() do { xcd_barrier(xbar); } while (0)
__global__ __launch_bounds__(NTHR, 2) void mega(MK a) {
    cg::grid_group grid = cg::this_grid();
    char* smem = (char*)lds_raw;
    LAS unsigned char* lds = (LAS unsigned char*)lds_raw;
    otid_init();
    if (threadIdx.x < 2) ((LAS unsigned*)(lds_raw + XB_ST_OFF))[threadIdx.x] = 0u;
    __syncthreads();
    const XcdBarrier xbar = xcd_barrier_post(a.ctl(), (volatile LAS unsigned*)(LAS void*)(lds_raw + XB_ST_OFF));
    const int bid = blockIdx.x, nb = gridDim.x, ngw = nb * NWAVE;
#define LOCAL_IDS const int tid = otid(), lane = tid & 63, wid = tid >> 6, half = tid >> 8, gw = bid * NWAVE + wid; (void)lane; (void)half; (void)gw; (void)wid;

    {
    LOCAL_IDS
    {
        const int T0 = 88 * 16, T1 = 24 * 6, T2 = 32 * 4, T3 = 16 * 4, T4 = 32 * 16, T5 = 176 * 16, T7 = 32 * 44, T8 = 32 * 16, T9 = 32 * 4;
        const int TT = T0 + T1 + T2 + T3 + T4 + T5 + T7 + T8 + T9;
        float* scr = (float*)(smem + wid * 8704);
        for (int it = gw; it < TT; it += ngw) {
            int r = it;
            if (r < T0) { const int nt_ = r % 88, kb = r / 88, nv = 2736 - 32 * nt_; wt_item(a.w_in, 2736, 32 * nt_, nv < 0 ? 0 : (nv > 32 ? 32 : nv), a.WinT(), 1024, 32 * nt_, 64 * kb, scr, lane); continue; } r -= T0;
            if (r < T1) { const int nt_ = r % 24, kb = r / 24; wt_item(a.w_q_b, 768, 32 * nt_, 32, a.WqbT(), 384, 32 * nt_, 64 * kb, scr, lane); continue; } r -= T1;
            if (r < T2) { const int nt_ = r % 32, kb = r / 32; wt_item(a.w_kv_b, 1024, 32 * nt_, 32, a.WkvT(), 256, 32 * nt_, 64 * kb, scr, lane); continue; } r -= T2;
            if (r < T3) { const int nt_ = r % 16, kb = r / 16, h = nt_ >> 1; wt_item(a.w_kv_b, 1024, h * 128 + 32 * (nt_ & 1), 32, a.WknT(), 256, 32 * nt_, 64 * kb, scr, lane); continue; } r -= T3;
            if (r < T4) { const int nt_ = r % 32, kb = r / 32; wt_item(a.w_o, 1024, 32 * nt_, 32, a.WoT(), 1024, 32 * nt_, 64 * kb, scr, lane); continue; } r -= T4;
            if (r < T5) { const int nt_ = r % 176, kb = r / 176, pn = nt_ >> 3, wi = nt_ & 7;
                wt_item(wi < 4 ? a.w_gate : a.w_up, DFF, pn * 128 + (wi & 3) * 32, 32, a.WguT(), 1024, 32 * nt_, 64 * kb, scr, lane); continue; } r -= T5;
            if (r < T7) { const int nt_ = r % 32, kb = r / 32; wt_item(a.w_down, 1024, 32 * nt_, 32, a.WdT(), DFF, 32 * nt_, 64 * kb, scr, lane); continue; } r -= T7;
            if (r < T8) { const int nt_ = r % 32, kb = r / 32; wt_item(a.w_ple_gate, 1024, 32 * nt_, 32, a.WpgT(), 1024, 32 * nt_, 64 * kb, scr, lane); continue; } r -= T8;
            { const int nt_ = r % 32, kb = r / 32; wt_item(a.w_ple_proj, 1024, 32 * nt_, 32, a.WppT(), 256, 32 * nt_, 64 * kb, scr, lane); }
        }
        for (int e = (bid * NTHR + tid); e < 2049 * 16; e += nb * NTHR) {
            const int pos = e >> 4, i = e & 15; const float ang = (pos == 2048 ? (float)PAST : (float)pos) * powf(10000.f, -(float)i / 16.f);
            a.ropecs()[pos * 32 + i] = cosf(ang); a.ropecs()[pos * 32 + 16 + i] = sinf(ang);
        }
        for (int row = gw; row < MPAD; row += ngw) {
            const float* src = row < NPT ? a.x_prompt + (size_t)row * 1024 : a.x_sample + (size_t)(row < NTOK ? row - NPT : 0) * 1024;
            rms1024_row(src, a.g_attn, a.xn() + (size_t)row * 1024, row >= NTOK, lane);
            ushort4 w = {0, 0, 0, 0};
            if (row < NTOK) { const float* ps = row < NPT ? a.p_prompt + (size_t)row * 256 : a.p_sample + (size_t)(row - NPT) * 256; const float4 v = *(const float4*)(ps + lane * 4); w.x = f2bf(v.x); w.y = f2bf(v.y); w.z = f2bf(v.z); w.w = f2bf(v.w); }
            *(ushort4*)(a.pb() + (size_t)row * 256 + lane * 4) = w;
            if (row >= NTOK) { for (int j = 0; j < 4; ++j) { ushort4 z = {0, 0, 0, 0}; *(ushort4*)(a.omix() + (size_t)row * 1024 + lane * 4 + 256 * j) = z; } }
        }
    }
    }
    if (a.out == nullptr) grid.sync();
    GSYNC();
    {
    LOCAL_IDS
    pg_gemm(lds, a.xn(), a.WinT(), NPT, ZW, 1024, PgBf16{a.Z(), ZW});
    pg_gemm(lds, a.pb(), a.WppT(), NPT, 1024, 256, PgBf16{a.PP(), 1024});
    gemm_sample_rows_ks<false>(a.xn(), 1024, a.WinT(), 1024, ZW, EwBf16{a.Z(), ZW}, smem, bid, nb);
    gemm_sample_rows<false>(a.pb(), 256, a.WppT(), 256, 1024, EwBf16{a.PP(), 1024}, smem, bid, nb);
    }
    GSYNC();
    {
    LOCAL_IDS
    for (int e = tid; e < 4 * 1536 / 4; e += NTHR) ((float4*)smem)[e] = ((const float4*)a.w_conv)[e];
    __syncthreads();
    for (int run = gw; run < NPT / 8 + NST; run += ngw) post_in_run(a, run, lane, (const float*)smem);
    }
    GSYNC();
    {
    LOCAL_IDS
    for (int u = gw; u < 2048; u += ngw) gdn_prep_unit(a, u, lane, smem + wid * GDN_WLDS);
    }
    {
    LOCAL_IDS
    for (int v = gw; v < NST * 64; v += ngw) gdn_unit(a, v >> 6, (v >> 3) & 7, v & 7, a.state_gdn, a.out + O_GSS, NPT, 1, lane, smem + wid * GDN_WLDS);
    __syncthreads();
    }
    GSYNC();
    {
    LOCAL_IDS
    pg_gemm(lds, a.qan(), a.WqbT(), NPT, 768, 384, PgBf16{a.qraw(), 768});
    pg_gemm(lds, a.ckvb(), a.WkvT(), NPT, 1024, 256, PgBf16{a.kvraw(), 1024});
    gemm_sample_rows<false>(a.qan(), 384, a.WqbT(), 384, 768, EwF32{a.Q(), 768}, smem, bid, nb);
    gemm_sample_rows<false>(a.ckvb(), 256, a.WkvT(), 256, 1024, EwF32{a.KV(), 1024}, smem, bid, nb);
    for (int bh_ = nb - 1 - bid; bh_ < 64; bh_ += nb) gdn_scan_block(a, bh_, lds);
    }
    GSYNC();
    {
    LOCAL_IDS
    for (int idx = gw; idx < NST * 8; idx += ngw) { post_q_item(a, NPT * 8 + idx, lane); post_kv_item(a, NPT * 8 + idx, lane); }
    for (int row = gw; row < NTOK; row += ngw) gdn_out_token(a, row, lane);
    for (int pr = bid; pr < 256; pr += nb) { const int bh_ = pr >> 2, s_ = pr & 3; attn_block(a, bh_ >> 3, bh_ & 7, 7 - s_, smem); attn_block(a, bh_ >> 3, bh_ & 7, s_, smem); }
    for (int u = bid; u < NST * 8; u += nb) samp_attn_unit(a, u, smem, lds);
    }
    GSYNC();
    {
    LOCAL_IDS
    for (int u0 = bid * 2; u0 < NST * 8; u0 += nb * 2) samp_comb_unit(a, u0 + half, smem + half * 4096);
    }
    GSYNC();
    {
    LOCAL_IDS
    pg_gemm(lds, a.omix(), a.WoT(), NPT, 1024, 1024, PgResXB{a.x_prompt, a.H()});
    gemm_sample_rows_ks<false>(a.omix(), 1024, a.WoT(), 1024, 1024, EwResX{a.x_sample, a.H()}, smem, bid, nb);
    }
    GSYNC();
    {
    LOCAL_IDS
    for (int row = gw; row < MPAD; row += ngw) rms1024_row_b(a.H() + (size_t)row * 1024, a.g_ffn, a.un() + (size_t)row * 1024, row >= NTOK, lane);
    }
    GSYNC();
    {
    LOCAL_IDS
    pg_gemm(lds, a.un(), a.WguT(), NPT, 2 * DFF, 1024, PgSwiglu{a.hid()});
    gemm_sample_rows_ks<true>(a.un(), 1024, a.WguT(), 1024, 2 * DFF, EwBf16{a.hid(), DFF}, smem, bid, nb);
    }
    GSYNC();
    {
    LOCAL_IDS
    pg_gemm(lds, a.hid(), a.WdT(), NPT, 1024, DFF, PgResBB{a.H(), a.H2()});
    gemm_sample_rows_ks<false>(a.hid(), DFF, a.WdT(), DFF, 1024, EwResH{a.H(), a.H2()}, smem, bid, nb);
    }
    GSYNC();
    {
    LOCAL_IDS
    for (int row = gw; row < MPAD; row += ngw) rms1024_row_b(a.H2() + (size_t)row * 1024, a.g_ple, a.un2() + (size_t)row * 1024, row >= NTOK, lane);
    }
    GSYNC();
    {
    LOCAL_IDS
    pg_gemm(lds, a.un2(), a.WpgT(), NPT, 1024, 1024, PgPleB{a.H2(), a.PP(), a.out});
    gemm_sample_rows_ks<false>(a.un2(), 1024, a.WpgT(), 1024, 1024, EwPle{a.H2(), a.PP(), a.out}, smem, bid, nb);
    }
}

static inline char* carve(char*& p, size_t bytes) { char* r = p; p += (bytes + 255) & ~(size_t)255; return r; }

extern "C" void kernel_launch(void* const* d_in, const int* in_sizes, int n_in, void* d_out, int out_size, void* d_ws, size_t ws_size, hipStream_t stream) {
    MK a{};
    a.x_prompt = (const float*)d_in[0]; a.x_sample = (const float*)d_in[1]; a.cache_ckv = (const float*)d_in[2]; a.cache_krope = (const float*)d_in[3];
    a.state_gdn = (const float*)d_in[4]; a.state_conv = (const float*)d_in[5]; a.page_table = (const int*)d_in[6]; a.p_prompt = (const float*)d_in[7]; a.p_sample = (const float*)d_in[8];
    a.g_attn = (const float*)d_in[9]; a.w_in = (const float*)d_in[10]; a.w_conv = (const float*)d_in[11]; a.a_log = (const float*)d_in[12]; a.dt_bias = (const float*)d_in[13];
    a.g_gdn_out = (const float*)d_in[14]; a.g_q_a = (const float*)d_in[15]; a.w_q_b = (const float*)d_in[16]; a.g_q_nope = (const float*)d_in[17]; a.g_q_rope = (const float*)d_in[18];
    a.g_kv_a = (const float*)d_in[19]; a.g_k_rope = (const float*)d_in[20]; a.w_kv_b = (const float*)d_in[21]; a.g_k_nope = (const float*)d_in[22]; a.w_o = (const float*)d_in[23];
    a.g_ffn = (const float*)d_in[24]; a.w_gate = (const float*)d_in[25]; a.w_up = (const float*)d_in[26]; a.w_down = (const float*)d_in[27]; a.g_ple = (const float*)d_in[28];
    a.w_ple_gate = (const float*)d_in[29]; a.w_ple_proj = (const float*)d_in[30];
    a.out = (float*)d_out;
    a.ws = (char*)d_ws;
    if (WS_TOTAL > ws_size) { fprintf(stderr, "kernel_launch: workspace too small: need %zu have %zu\n", (size_t)WS_TOTAL, ws_size); return; }

    static int grid_blocks = 0;
    if (!grid_blocks) {
        int dev = 0, cus = 0, per_cu = 0;
        (void)hipGetDevice(&dev);
        (void)hipDeviceGetAttribute(&cus, hipDeviceAttributeMultiprocessorCount, dev);
        (void)hipFuncSetAttribute((const void*)mega, hipFuncAttributeMaxDynamicSharedMemorySize, LDS_BYTES);
        (void)hipOccupancyMaxActiveBlocksPerMultiprocessor(&per_cu, (const void*)mega, NTHR, LDS_BYTES);
        if (per_cu < 1) fprintf(stderr, "kernel_launch: occupancy query says %d blocks/CU\n", per_cu);
        grid_blocks = cus;
    }
    (void)hipMemsetAsync((char*)d_ws + WOF_ctl, 0, 16384, stream);
    void* args[] = {&a};
    hipError_t e = hipLaunchCooperativeKernel((const void*)mega, dim3(grid_blocks), dim3(NTHR), args, LDS_BYTES, stream);
    if (e != hipSuccess) fprintf(stderr, "cooperative launch failed: %s (grid %d)\n", hipGetErrorString(e), grid_blocks);
}
```

```cpp
#include <hip/hip_runtime.h>
#include <stdint.h>
#include <cstdio>
#include <hip/hip_cooperative_groups.h>
namespace cg = cooperative_groups;


__device__ __forceinline__ int otid();
#define PG8_TID() otid()
namespace pg8 {
#define PG8_LAS __attribute__((address_space(3)))
typedef unsigned short bf16_t;
typedef short bf16x8 __attribute__((ext_vector_type(8)));
typedef float f32x4 __attribute__((ext_vector_type(4)));
typedef unsigned u32x4 __attribute__((ext_vector_type(4)));
constexpr int BM = 256, BK = 64, HALF = 128, HTB = HALF * BK * 2  , STAGE_BYTES = 8 * HTB, NXCD = 8, WGM = 8;

__host__ __device__ __forceinline__ int lds_byte(int r, int c) { const int st = (r >> 4) * 2 + (c >> 5), rr = r & 15, cc = c & 31, ob = rr * 64 + cc * 2; return st * 1024 + (ob ^ (((ob >> 9) & 1) << 5)); }
__host__ __device__ __forceinline__ void stage_rc(int b, int& R, int& C) { const int st = b / 1024, sb = b % 1024, swz = sb ^ (((sb >> 9) & 1) << 5); R = (st >> 1) * 16 + swz / 64; C = (st & 1) * 32 + (swz % 64) / 2; }
__host__ __device__ __forceinline__ int perm32(int rho) { const int n = rho >> 4, i = rho & 15; return 8 * (i >> 2) + 4 * n + (i & 3); }

struct Unit { int pm, pn; };
struct Gemm { const bf16_t* A; const bf16_t* Bt; int M, N, K; };

struct StaticOrder {
    int nM, nN, nwg, G, c;
    __host__ __device__ void init(int M, int N, int G_, int c_) { nM = M / BM; nN = N / BM; nwg = nM * nN; G = G_; c = c_; }
    __host__ __device__ bool next(int i, Unit& u) const {
        const long L = (long)i * G + c; if (L >= nwg) return false;
        int wgid = (int)L; { const int q = nwg / NXCD, r = nwg % NXCD, xcd = wgid % NXCD, off = wgid / NXCD; wgid = (xcd < r ? xcd * (q + 1) : r * (q + 1) + (xcd - r) * q) + off; }
        const int nig = WGM * nN, gid = wgid / nig, fm = gid * WGM, gsz = (nM - fm) < WGM ? (nM - fm) : WGM;
        u.pm = fm + ((wgid % nig) % gsz); u.pn = (wgid % nig) / gsz; return true;
    }
    __device__ __forceinline__ void a_ready(const Unit&) const {}
    __device__ __forceinline__ void done(const Unit&) const {}
};

template <class Epi, class Sched, bool ALIGN_EPI = false, bool SP2 = false>
__device__ __forceinline__ void gemm_phase(PG8_LAS unsigned char* lds, const Gemm g, const Sched& S, const Epi& E) {
    const int tid = PG8_TID(), wid = __builtin_amdgcn_readfirstlane(tid >> 6), lane = tid & 63, wr = wid >> 2, wc = wid & 3, fr = lane & 15, fq = lane >> 4;
    const int K = g.K, nt = K / BK;
    unsigned voffA[2], voffB[2];
#pragma unroll
    for (int i = 0; i < 2; ++i) { int R, C; stage_rc(tid * 16 + i * 8192, R, C); const int Rb = Epi::PERM ? ((R & ~31) + perm32(R & 31)) : R;
        voffA[i] = (unsigned)(R * K + C) * 2u; voffB[i] = (unsigned)(Rb * K + C) * 2u; }
    const size_t kstep = (size_t)(BK * 2);
    const size_t hstep = (size_t)HALF * K * 2;
    const size_t tstep = 2 * hstep;
    const unsigned ldsw = (unsigned)wid * 1024u;
    const int aoff = lds_byte(wr * 64 + fr, fq * 8), boff = lds_byte(wc * 32 + fr, fq * 8);
#define PG8_SA(b, h) (((b) * 2 + (h)) * HTB)
#define PG8_SB(b, h) ((4 + (b) * 2 + (h)) * HTB)
#define PG8_STAGE(bufoff, gbase, voff) do { _Pragma("unroll") for (int _i = 0; _i < 2; ++_i) \
        __builtin_amdgcn_global_load_lds((const unsigned*)((const char*)(gbase) + (voff)[_i]), (PG8_LAS unsigned*)(lds + (bufoff) + ldsw + _i * 8192), 16, 0, 0); } while (0)
#define PG8_LDA(dst, b, h) do { _Pragma("unroll") for (int m = 0; m < 4; ++m) _Pragma("unroll") for (int k = 0; k < 2; ++k) dst[m][k] = *(const PG8_LAS bf16x8*)(lds + PG8_SA(b, h) + aoff + m * 2048 + k * 1024); } while (0)
#define PG8_LDB(dst, b, h) do { _Pragma("unroll") for (int n = 0; n < 2; ++n) _Pragma("unroll") for (int k = 0; k < 2; ++k) dst[n][k] = *(const PG8_LAS bf16x8*)(lds + PG8_SB(b, h) + boff + n * 2048 + k * 1024); } while (0)
#define PG8_MMA(ai, bj, At, Bt) do { __builtin_amdgcn_s_setprio(1); _Pragma("unroll") for (int m = 0; m < 4; ++m) _Pragma("unroll") for (int n = 0; n < 2; ++n) _Pragma("unroll") for (int k = 0; k < 2; ++k) \
        acc[ai][bj][m][n] = __builtin_amdgcn_mfma_f32_16x16x32_bf16(Bt[n][k], At[m][k], acc[ai][bj][m][n], 0, 0, 0); __builtin_amdgcn_s_setprio(0); } while (0)
#define PG8_WAIT_V(n) asm volatile("s_waitcnt vmcnt(" #n ")" ::: "memory")
#define PG8_WAIT_L(n) asm volatile("s_waitcnt lgkmcnt(" #n ")" ::: "memory")
#define PG8_BAR __builtin_amdgcn_s_barrier()
#define PG8_SCHED __builtin_amdgcn_sched_barrier(0)
    Unit cur, nxt; int ui = 0;
    if (!S.next(0, cur)) return;
    f32x4 acc[2][2][4][2];
#pragma unroll
    for (int a = 0; a < 2; ++a)
#pragma unroll
        for (int b = 0; b < 2; ++b)
#pragma unroll
            for (int m = 0; m < 4; ++m)
#pragma unroll
                for (int n = 0; n < 2; ++n) acc[a][b][m][n] = (f32x4){0.f, 0.f, 0.f, 0.f};
    bf16x8 At[4][2], B0[2][2], B1[2][2];
    const char* cA = (const char*)g.A + (size_t)cur.pm * tstep; const char* cB = (const char*)g.Bt + (size_t)cur.pn * tstep;
    S.a_ready(cur);
    if constexpr (SP2) {
        PG8_STAGE(PG8_SB(0, 0), cB, voffB); PG8_STAGE(PG8_SB(0, 1), cB + hstep, voffB); PG8_STAGE(PG8_SA(0, 0), cA, voffA); PG8_STAGE(PG8_SA(0, 1), cA + hstep, voffA);
        if (wr == 1) PG8_BAR;
        PG8_WAIT_V(2); PG8_BAR;
        PG8_STAGE(PG8_SB(1, 0), cB + kstep, voffB); PG8_STAGE(PG8_SA(1, 0), cA + kstep, voffA); PG8_STAGE(PG8_SB(1, 1), cB + hstep + kstep, voffB);
        PG8_WAIT_V(6); PG8_BAR;
    } else {
        PG8_STAGE(PG8_SB(0, 0), cB, voffB); PG8_STAGE(PG8_SA(0, 0), cA, voffA); PG8_STAGE(PG8_SB(0, 1), cB + hstep, voffB); PG8_STAGE(PG8_SA(0, 1), cA + hstep, voffA);
        if (wr == 1) PG8_BAR;
        PG8_WAIT_V(4); PG8_BAR;
        PG8_STAGE(PG8_SB(1, 0), cB + kstep, voffB); PG8_STAGE(PG8_SA(1, 0), cA + kstep, voffA); PG8_STAGE(PG8_SB(1, 1), cB + hstep + kstep, voffB);
        PG8_WAIT_V(6); PG8_BAR;
    }
    for (;;) {
        const bool has_next = S.next(ui + 1, nxt);
        const char* nA = has_next ? (const char*)g.A + (size_t)nxt.pm * tstep : cA; const char* nB = has_next ? (const char*)g.Bt + (size_t)nxt.pn * tstep : cB;
        for (int t = 0; t < nt; t += 2) {
            const bool last = (t == nt - 2);
            const char* a1 = cA + (size_t)(t + 1) * kstep;
            const char* a2 = last ? nA : cA + (size_t)(t + 2) * kstep; const char* b2 = last ? nB : cB + (size_t)(t + 2) * kstep;
            const char* a3 = a2 + kstep; const char* b3 = b2 + kstep;
            if (last && has_next) S.a_ready(nxt);
            if constexpr (SP2) {
            PG8_LDB(B0, 0, 0); PG8_LDB(B1, 0, 1); PG8_SCHED; PG8_LDA(At, 0, 0); PG8_STAGE(PG8_SA(1, 1), a1 + hstep, voffA);
            PG8_WAIT_V(8); PG8_WAIT_L(0); PG8_BAR; PG8_MMA(0, 0, At, B0); PG8_MMA(0, 1, At, B1); PG8_BAR; PG8_SCHED;
            PG8_LDA(At, 0, 1); PG8_STAGE(PG8_SB(0, 0), b2, voffB); PG8_STAGE(PG8_SB(0, 1), b2 + hstep, voffB); PG8_STAGE(PG8_SA(0, 0), a2, voffA);
            PG8_WAIT_V(8); PG8_WAIT_L(0); PG8_BAR; PG8_MMA(1, 0, At, B0); PG8_MMA(1, 1, At, B1); PG8_BAR; PG8_SCHED;
            PG8_LDB(B0, 1, 0); PG8_LDB(B1, 1, 1); PG8_SCHED; PG8_LDA(At, 1, 0); PG8_STAGE(PG8_SA(0, 1), a2 + hstep, voffA);
            PG8_WAIT_V(8); PG8_WAIT_L(0); PG8_BAR; PG8_MMA(0, 0, At, B0); PG8_MMA(0, 1, At, B1); PG8_BAR; PG8_SCHED;
            PG8_LDA(At, 1, 1); PG8_STAGE(PG8_SB(1, 0), b3, voffB); PG8_STAGE(PG8_SB(1, 1), b3 + hstep, voffB); PG8_STAGE(PG8_SA(1, 0), a3, voffA);
            PG8_WAIT_V(8); PG8_WAIT_L(0); PG8_BAR; PG8_MMA(1, 0, At, B0); PG8_MMA(1, 1, At, B1); PG8_BAR; PG8_SCHED;
            } else {
            PG8_LDB(B0, 0, 0); PG8_SCHED; PG8_LDA(At, 0, 0); PG8_STAGE(PG8_SA(1, 1), a1 + hstep, voffA);
            PG8_WAIT_L(8); PG8_BAR; PG8_WAIT_L(0); PG8_MMA(0, 0, At, B0); PG8_BAR; PG8_SCHED;
            PG8_LDB(B1, 0, 1); PG8_STAGE(PG8_SB(0, 0), b2, voffB);
            PG8_BAR; PG8_WAIT_L(0); PG8_MMA(0, 1, At, B1); PG8_BAR;
            PG8_LDA(At, 0, 1); PG8_STAGE(PG8_SA(0, 0), a2, voffA);
            PG8_BAR; PG8_WAIT_L(0); PG8_MMA(1, 0, At, B0); PG8_BAR; PG8_SCHED;
            PG8_STAGE(PG8_SB(0, 1), b2 + hstep, voffB);
            PG8_WAIT_V(6); PG8_BAR; PG8_MMA(1, 1, At, B1); PG8_BAR;
            PG8_LDB(B0, 1, 0); PG8_SCHED; PG8_LDA(At, 1, 0); PG8_STAGE(PG8_SA(0, 1), a2 + hstep, voffA);
            PG8_WAIT_L(8); PG8_BAR; PG8_WAIT_L(0); PG8_MMA(0, 0, At, B0); PG8_BAR; PG8_SCHED;
            PG8_LDB(B1, 1, 1); PG8_STAGE(PG8_SB(1, 0), b3, voffB);
            PG8_BAR; PG8_WAIT_L(0); PG8_MMA(0, 1, At, B1); PG8_BAR;
            PG8_LDA(At, 1, 1); PG8_STAGE(PG8_SA(1, 0), a3, voffA);
            PG8_BAR; PG8_WAIT_L(0); PG8_MMA(1, 0, At, B0); PG8_BAR; PG8_SCHED;
            PG8_STAGE(PG8_SB(1, 1), b3 + hstep, voffB);
            PG8_WAIT_V(6); PG8_BAR; PG8_MMA(1, 1, At, B1); PG8_BAR;
            }
        }
        if constexpr (ALIGN_EPI) { if (wr == 0) PG8_BAR; }
        if constexpr (!Epi::AFTER_DRAIN) { E(acc, cur, wr, wc, fr, fq); S.done(cur); }
        if (!has_next) break;
#pragma unroll
        for (int a = 0; a < 2; ++a)
#pragma unroll
            for (int b = 0; b < 2; ++b)
#pragma unroll
                for (int m = 0; m < 4; ++m)
#pragma unroll
                    for (int n = 0; n < 2; ++n) acc[a][b][m][n] = (f32x4){0.f, 0.f, 0.f, 0.f};
        cur = nxt; cA = nA; cB = nB; ++ui;
        if constexpr (ALIGN_EPI) { if (wr == 1) PG8_BAR; }
    }
    PG8_WAIT_V(0);
    if constexpr (!ALIGN_EPI) { if (wr == 0) PG8_BAR; }
    PG8_BAR;
    if constexpr (Epi::AFTER_DRAIN) { E.fused(acc, cur, wr, wc, fr, fq, lds, wid, lane); S.done(cur); }
#undef PG8_SA
#undef PG8_SB
#undef PG8_STAGE
#undef PG8_LDA
#undef PG8_LDB
#undef PG8_MMA
#undef PG8_WAIT_V
#undef PG8_WAIT_L
#undef PG8_BAR
#undef PG8_SCHED
}
}

#define WTAB_OFF 155392
extern __shared__ __attribute__((aligned(16))) unsigned char lds_raw[];
__device__ __forceinline__ int hw_slot() { return (int)(__builtin_amdgcn_s_getreg((5 << 11) | 4) & 63u); }
__device__ __forceinline__ void otid_init() { const int t = threadIdx.x; if ((t & 63) == 0) ((__attribute__((address_space(3))) int*)(__attribute__((address_space(3))) void*)(lds_raw + WTAB_OFF))[hw_slot()] = t >> 6; }
__device__ __forceinline__ int otid() {
    const int w = __builtin_amdgcn_readfirstlane(((const __attribute__((address_space(3))) int*)(__attribute__((address_space(3))) void*)(lds_raw + WTAB_OFF))[hw_slot()]);
    int l; asm volatile("v_mbcnt_lo_u32_b32 %0, -1, 0\n\tv_mbcnt_hi_u32_b32 %0, -1, %0" : "=v"(l));
    return (w << 6) + l;
}
using pg8::bf16_t; using pg8::bf16x8; using pg8::f32x4; using pg8::u32x4;
#define LAS __attribute__((address_space(3)))

#define DMODEL 1024
#define NPT 16384
#define NST 32
#define NTOK 16416
#define MPAD 16640
#define SEQ 2048
#define ZW 2816
#define OFF_A 1536
#define OFF_B 1544
#define OFF_Z 1552
#define OFF_QA 2064
#define OFF_KVA 2448
#define OFF_KR 2704
#define DFF 2816
#define PAST 16384
#define NPAGES 128
#define EPSV 1e-6f

#define O_YP 0
#define O_YS (O_YP + 16777216)
#define O_CKVP (O_YS + 32768)
#define O_KRP (O_CKVP + 4194304)
#define O_GSP (O_KRP + 524288)
#define O_CSP (O_GSP + 262144)
#define O_CKVS (O_CSP + 36864)
#define O_KRS (O_CKVS + 8192)
#define O_GSS (O_KRS + 1024)
#define O_CSS (O_GSS + 1048576)

__device__ __forceinline__ bf16_t f2bf(float f) { unsigned u = __float_as_uint(f); return (bf16_t)((u + 0x7fffu + ((u >> 16) & 1u)) >> 16); }
__device__ __forceinline__ float bf2f(bf16_t b) { return __uint_as_float(((unsigned)b) << 16); }
__device__ __forceinline__ float wave_sum(float v) {
#pragma unroll
    for (int o = 1; o < 64; o <<= 1) v += __shfl_xor(v, o);
    return v;
}
__device__ __forceinline__ float sigmoidf_(float x) { return __builtin_amdgcn_rcpf(1.f + __builtin_amdgcn_exp2f(-1.44269504f * x)); }
__device__ __forceinline__ float siluf_(float x) { return x * __builtin_amdgcn_rcpf(1.f + __builtin_amdgcn_exp2f(-1.44269504f * x)); }


#define WSYNC() do { __builtin_amdgcn_fence(__ATOMIC_ACQ_REL, "wavefront"); __builtin_amdgcn_wave_barrier(); } while (0)
#define NTHR 512
#define NWAVE 8

typedef float f32x2_t __attribute__((ext_vector_type(2)));
typedef __bf16 bf16x2_t __attribute__((ext_vector_type(2)));
__device__ __forceinline__ unsigned cvtpk(float lo, float hi) { f32x2_t v = {lo, hi}; bf16x2_t r = __builtin_convertvector(v, bf16x2_t); return __builtin_bit_cast(unsigned, r); }
__device__ __forceinline__ void bf8_to_f32(const bf16x8& v, float* o) {
#pragma unroll
    for (int e = 0; e < 8; ++e) o[e] = __uint_as_float(((unsigned)(unsigned short)v[e]) << 16);
}
__device__ __forceinline__ bf16x8 f32_to_bf8(const float* x) {
    u32x4 w; w.x = cvtpk(x[0], x[1]); w.y = cvtpk(x[2], x[3]); w.z = cvtpk(x[4], x[5]); w.w = cvtpk(x[6], x[7]);
    return __builtin_bit_cast(bf16x8, w);
}
__device__ __forceinline__ unsigned pk2bf(float lo, float hi) { return (unsigned)f2bf(lo) | ((unsigned)f2bf(hi) << 16); }

__device__ __forceinline__ void wt_item(const float* __restrict__ W, int ldw, int col0, int nvalid, bf16_t* __restrict__ WT, int ldt, int nrow0, int k0, float* scr, int lane) {
    WSYNC();
#pragma unroll 8
    for (int i = 0; i < 32; ++i) { const int kk = 2 * i + (lane >> 5), n = lane & 31; scr[kk * 33 + n] = n < nvalid ? W[(size_t)(k0 + kk) * ldw + col0 + n] : 0.f; }
    WSYNC();
    const int c = lane & 7;
#pragma unroll
    for (int j = 0; j < 4; ++j) { const int n = (lane >> 3) + 8 * j; const float* sp = scr + (8 * c) * 33 + n;
        u32x4 o; o.x = cvtpk(sp[0], sp[33]); o.y = cvtpk(sp[2 * 33], sp[3 * 33]); o.z = cvtpk(sp[4 * 33], sp[5 * 33]); o.w = cvtpk(sp[6 * 33], sp[7 * 33]);
        *(u32x4*)(WT + (size_t)(nrow0 + n) * ldt + k0 + 8 * c) = o; }
}

__device__ __forceinline__ void rms1024_row(const float* __restrict__ src, const float* __restrict__ g, bf16_t* __restrict__ o, bool zero, int lane) {
    if (zero) { for (int j = 0; j < 4; ++j) { ushort4 z = {0, 0, 0, 0}; *(ushort4*)(o + lane * 4 + 256 * j) = z; } return; }
    float4 v[4]; float ss = 0.f;
#pragma unroll
    for (int j = 0; j < 4; ++j) { v[j] = *(const float4*)(src + lane * 4 + 256 * j); ss += v[j].x * v[j].x + v[j].y * v[j].y + v[j].z * v[j].z + v[j].w * v[j].w; }
    ss = wave_sum(ss);
    const float rs = rsqrtf(ss * (1.f / 1024.f) + EPSV);
#pragma unroll
    for (int j = 0; j < 4; ++j) {
        const float4 gg = *(const float4*)(g + lane * 4 + 256 * j);
        ushort4 w; w.x = f2bf(v[j].x * rs * gg.x); w.y = f2bf(v[j].y * rs * gg.y); w.z = f2bf(v[j].z * rs * gg.z); w.w = f2bf(v[j].w * rs * gg.w);
        *(ushort4*)(o + lane * 4 + 256 * j) = w;
    }
}

__device__ __forceinline__ void rms1024_row_b(const bf16_t* __restrict__ src, const float* __restrict__ g, bf16_t* __restrict__ o, bool zero, int lane) {
    if (zero) { for (int j = 0; j < 2; ++j) { const u32x4 z = {0u, 0u, 0u, 0u}; *(u32x4*)(o + lane * 8 + 512 * j) = z; } return; }
    float v[2][8]; float ss = 0.f;
#pragma unroll
    for (int j = 0; j < 2; ++j) { bf8_to_f32(*(const bf16x8*)(src + lane * 8 + 512 * j), v[j]);
#pragma unroll
        for (int e = 0; e < 8; ++e) ss += v[j][e] * v[j][e]; }
    ss = wave_sum(ss);
    const float rs = rsqrtf(ss * (1.f / 1024.f) + EPSV);
#pragma unroll
    for (int j = 0; j < 2; ++j) {
        const float4 g0 = *(const float4*)(g + lane * 8 + 512 * j), g1 = *(const float4*)(g + lane * 8 + 512 * j + 4);
        float t[8] = {v[j][0] * rs * g0.x, v[j][1] * rs * g0.y, v[j][2] * rs * g0.z, v[j][3] * rs * g0.w, v[j][4] * rs * g1.x, v[j][5] * rs * g1.y, v[j][6] * rs * g1.z, v[j][7] * rs * g1.w};
        *(bf16x8*)(o + lane * 8 + 512 * j) = f32_to_bf8(t);
    }
}

struct ABf16 { const bf16_t* p; int lda; __device__ __forceinline__ bf16x8 load(int m, int k) const { return *(const bf16x8*)(p + (size_t)m * lda + k); } };
struct ACache {
    const float* cache; const int* pt;
    __device__ __forceinline__ bf16x8 load(int m, int k) const {
        const int b = m >> 14, t = m & 16383; const int phys = pt[b * NPAGES + (t >> 7)];
        const float* r = cache + ((size_t)phys * 128 + (t & 127)) * 256 + k;
        const float4 a = *(const float4*)r, c = *(const float4*)(r + 4);
        bf16x8 o; o[0] = (short)f2bf(a.x); o[1] = (short)f2bf(a.y); o[2] = (short)f2bf(a.z); o[3] = (short)f2bf(a.w);
        o[4] = (short)f2bf(c.x); o[5] = (short)f2bf(c.y); o[6] = (short)f2bf(c.z); o[7] = (short)f2bf(c.w); return o;
    }
};
template <class AL, class Epi>
__device__ __forceinline__ void gemm_tile_256x128(const AL& al, const bf16_t* __restrict__ Bt, int ldb, int K, const Epi& epi, int m0, int n0, char* smem) {
    bf16_t (*sA)[40] = (bf16_t (*)[40])smem;
    bf16_t (*sB)[40] = (bf16_t (*)[40])(smem + 20480);
    const int tid = otid(), lane = tid & 63, wid = tid >> 6, wm = wid >> 1, wn = wid & 1;
    f32x4 acc[4][4];
#pragma unroll
    for (int i = 0; i < 4; ++i)
#pragma unroll
        for (int j = 0; j < 4; ++j) acc[i][j] = (f32x4){0.f, 0.f, 0.f, 0.f};
    __syncthreads();
    for (int k0 = 0; k0 < K; k0 += 32) {
#pragma unroll
        for (int i = 0; i < 2; ++i) { const int ch = tid + 512 * i, r = ch >> 2, kc = (ch & 3) * 8; *(bf16x8*)&sA[r][kc] = al.load(m0 + r, k0 + kc); }
        { const int r = tid >> 2, kc = (tid & 3) * 8; *(bf16x8*)&sB[r][kc] = *(const bf16x8*)(Bt + (size_t)(n0 + r) * ldb + k0 + kc); }
        __syncthreads();
        bf16x8 af[4], bfr[4];
#pragma unroll
        for (int i = 0; i < 4; ++i) af[i] = *(const bf16x8*)&sA[wm * 64 + i * 16 + (lane & 15)][(lane >> 4) * 8];
#pragma unroll
        for (int j = 0; j < 4; ++j) bfr[j] = *(const bf16x8*)&sB[wn * 64 + j * 16 + (lane & 15)][(lane >> 4) * 8];
#pragma unroll
        for (int i = 0; i < 4; ++i)
#pragma unroll
            for (int j = 0; j < 4; ++j) acc[i][j] = __builtin_amdgcn_mfma_f32_16x16x32_bf16(af[i], bfr[j], acc[i][j], 0, 0, 0);
        __syncthreads();
    }
#pragma unroll
    for (int i = 0; i < 4; ++i)
#pragma unroll
        for (int j = 0; j < 4; ++j)
#pragma unroll
            for (int r = 0; r < 4; ++r) epi(m0 + wm * 64 + i * 16 + (lane >> 4) * 4 + r, n0 + wn * 64 + j * 16 + (lane & 15), acc[i][j][r]);
}
template <class Epi>
__device__ __forceinline__ void gemm_tile_32x256(const bf16_t* __restrict__ A, int lda, const bf16_t* __restrict__ Bt, int ldb, int K, const Epi& epi, int m0, int n0, char* smem) {
    bf16_t (*sA)[40] = (bf16_t (*)[40])smem;
    bf16_t (*sB)[40] = (bf16_t (*)[40])(smem + 2560);
    const int tid = otid(), lane = tid & 63, wid = tid >> 6;
    f32x4 acc[2][2];
#pragma unroll
    for (int i = 0; i < 2; ++i)
#pragma unroll
        for (int j = 0; j < 2; ++j) acc[i][j] = (f32x4){0.f, 0.f, 0.f, 0.f};
    __syncthreads();
    for (int k0 = 0; k0 < K; k0 += 32) {
        if (tid < 128) { const int r = tid >> 2, kc = (tid & 3) * 8; *(bf16x8*)&sA[r][kc] = *(const bf16x8*)(A + (size_t)(m0 + r) * lda + k0 + kc); }
#pragma unroll
        for (int i = 0; i < 2; ++i) { const int ch = tid + 512 * i, r = ch >> 2, kc = (ch & 3) * 8; *(bf16x8*)&sB[r][kc] = *(const bf16x8*)(Bt + (size_t)(n0 + r) * ldb + k0 + kc); }
        __syncthreads();
        bf16x8 af[2], bfr[2];
#pragma unroll
        for (int i = 0; i < 2; ++i) af[i] = *(const bf16x8*)&sA[i * 16 + (lane & 15)][(lane >> 4) * 8];
#pragma unroll
        for (int j = 0; j < 2; ++j) bfr[j] = *(const bf16x8*)&sB[wid * 32 + j * 16 + (lane & 15)][(lane >> 4) * 8];
#pragma unroll
        for (int i = 0; i < 2; ++i)
#pragma unroll
            for (int j = 0; j < 2; ++j) acc[i][j] = __builtin_amdgcn_mfma_f32_16x16x32_bf16(af[i], bfr[j], acc[i][j], 0, 0, 0);
        __syncthreads();
    }
#pragma unroll
    for (int i = 0; i < 2; ++i)
#pragma unroll
        for (int j = 0; j < 2; ++j)
#pragma unroll
            for (int r = 0; r < 4; ++r) epi(m0 + i * 16 + (lane >> 4) * 4 + r, n0 + wid * 32 + j * 16 + (lane & 15), acc[i][j][r]);
}
template <bool SWIGLU, class Epi>
__device__ __forceinline__ void gemm_sample_rows(const bf16_t* __restrict__ A, int lda, const bf16_t* __restrict__ Bt, int K, int N, const Epi& epi, char*  , int bid, int nb) {
    const int tid = otid(), lane = tid & 63, wid = tid >> 6, i16 = lane & 15, q4 = lane >> 4;
    for (int u = nb - 1 - bid; u < N / 256; u += nb) {
        const int n0 = u * 256;
        const int c0 = SWIGLU ? n0 + 16 * wid : n0 + 32 * wid, c1 = SWIGLU ? n0 + 128 + 16 * wid : n0 + 32 * wid + 16;
        const bf16_t* a0p = A + (size_t)(NPT + i16) * lda + 8 * q4; const bf16_t* a1p = a0p + (size_t)16 * lda;
        const bf16_t* b0p = Bt + (size_t)(c0 + i16) * K + 8 * q4; const bf16_t* b1p = Bt + (size_t)(c1 + i16) * K + 8 * q4;
        f32x4 acc[2][2];
#pragma unroll
        for (int i = 0; i < 2; ++i)
#pragma unroll
            for (int j = 0; j < 2; ++j) acc[i][j] = (f32x4){0.f, 0.f, 0.f, 0.f};
#pragma unroll 4
        for (int k0 = 0; k0 < K; k0 += 32) {
            const bf16x8 a0 = *(const bf16x8*)(a0p + k0), a1 = *(const bf16x8*)(a1p + k0), b0 = *(const bf16x8*)(b0p + k0), b1 = *(const bf16x8*)(b1p + k0);
            acc[0][0] = __builtin_amdgcn_mfma_f32_16x16x32_bf16(a0, b0, acc[0][0], 0, 0, 0); acc[0][1] = __builtin_amdgcn_mfma_f32_16x16x32_bf16(a0, b1, acc[0][1], 0, 0, 0);
            acc[1][0] = __builtin_amdgcn_mfma_f32_16x16x32_bf16(a1, b0, acc[1][0], 0, 0, 0); acc[1][1] = __builtin_amdgcn_mfma_f32_16x16x32_bf16(a1, b1, acc[1][1], 0, 0, 0);
        }
#pragma unroll
        for (int i = 0; i < 2; ++i)
#pragma unroll
            for (int r = 0; r < 4; ++r) {
                const int m = NPT + 16 * i + 4 * q4 + r;
                if constexpr (SWIGLU) epi(m, (n0 >> 1) + 16 * wid + i16, siluf_(acc[i][0][r]) * acc[i][1][r]);
                else { epi(m, c0 + i16, acc[i][0][r]); epi(m, c1 + i16, acc[i][1][r]); }
            }
    }
}
template <bool SWIGLU, class Epi>
__device__ __forceinline__ void gemm_sample_rows_ks(const bf16_t* __restrict__ A, int lda, const bf16_t* __restrict__ Bt, int K, int N, const Epi& epi, char* smem, int bid, int nb) {
    const int tid = otid(), lane = tid & 63, wid = tid >> 6, i16 = lane & 15, q4 = lane >> 4;
    const int nunits = N / 64, ksl = K >> 3;
    f32x4* red = (f32x4*)smem;
    for (int u = nb - 1 - bid; u < nunits; u += nb) {
        int brow[4];
#pragma unroll
        for (int j = 0; j < 4; ++j) brow[j] = SWIGLU ? ((32 * u) >> 7) * 256 + ((32 * u) & 127) + 128 * (j >> 1) + 16 * (j & 1) + i16 : 64 * u + 16 * j + i16;
        const bf16_t* a0p = A + (size_t)(NPT + i16) * lda + wid * ksl + 8 * q4; const bf16_t* a1p = a0p + (size_t)16 * lda;
        f32x4 acc[2][4];
#pragma unroll
        for (int i = 0; i < 2; ++i)
#pragma unroll
            for (int j = 0; j < 4; ++j) acc[i][j] = (f32x4){0.f, 0.f, 0.f, 0.f};
        for (int k0 = 0; k0 < ksl; k0 += 32) {
            const bf16x8 a0 = *(const bf16x8*)(a0p + k0), a1 = *(const bf16x8*)(a1p + k0);
            bf16x8 b[4];
#pragma unroll
            for (int j = 0; j < 4; ++j) b[j] = *(const bf16x8*)(Bt + (size_t)brow[j] * K + wid * ksl + 8 * q4 + k0);
#pragma unroll
            for (int j = 0; j < 4; ++j) { acc[0][j] = __builtin_amdgcn_mfma_f32_16x16x32_bf16(a0, b[j], acc[0][j], 0, 0, 0); acc[1][j] = __builtin_amdgcn_mfma_f32_16x16x32_bf16(a1, b[j], acc[1][j], 0, 0, 0); }
        }
        __syncthreads();
#pragma unroll
        for (int i = 0; i < 2; ++i)
#pragma unroll
            for (int j = 0; j < 4; ++j) red[(wid * 8 + i * 4 + j) * 64 + lane] = acc[i][j];
        __syncthreads();
        if constexpr (SWIGLU) {
            if (tid < 256) {
                const int t4 = tid >> 6, i = t4 >> 1, jg = t4 & 1, l = tid & 63;
                f32x4 g = red[(i * 4 + jg) * 64 + l], up = red[(i * 4 + jg + 2) * 64 + l];
#pragma unroll
                for (int w = 1; w < 8; ++w) { g = g + red[(w * 8 + i * 4 + jg) * 64 + l]; up = up + red[(w * 8 + i * 4 + jg + 2) * 64 + l]; }
#pragma unroll
                for (int r = 0; r < 4; ++r) epi(NPT + 16 * i + 4 * (l >> 4) + r, 32 * u + 16 * jg + (l & 15), siluf_(g[r]) * up[r]);
            }
        } else {
            const int t8 = tid >> 6, l = tid & 63, i = t8 >> 2, j = t8 & 3;
            f32x4 v = red[t8 * 64 + l];
#pragma unroll
            for (int w = 1; w < 8; ++w) v = v + red[(w * 8 + t8) * 64 + l];
#pragma unroll
            for (int r = 0; r < 4; ++r) epi(NPT + 16 * i + 4 * (l >> 4) + r, 64 * u + 16 * j + (l & 15), v[r]);
        }
    }
    __syncthreads();
}
struct EwF32 { float* C; int ldc; __device__ __forceinline__ void operator()(int m, int n, float v) const { C[(size_t)m * ldc + n] = v; } };
struct EwBf16 { bf16_t* C; int ldc; __device__ __forceinline__ void operator()(int m, int n, float v) const { C[(size_t)m * ldc + n] = f2bf(v); } };
struct EwResX { const float* xs; bf16_t* C; __device__ __forceinline__ void operator()(int m, int n, float v) const { C[(size_t)m * 1024 + n] = f2bf(xs[(size_t)(m - NPT) * 1024 + n] + v); } };
struct EwSwiglu {
    float* G; bf16_t* Hd;
    __device__ __forceinline__ void operator()(int m, int n, float v) const {
        const int f = (n >> 8) * 128 + (n & 127);
        if ((n & 255) < 128) G[(size_t)(m - NPT) * DFF + f] = v;
    }
};
struct EwSwiglu2 {
    const float* G; bf16_t* Hd;
    __device__ __forceinline__ void operator()(int m, int n, float v) const {
        const int f = (n >> 8) * 128 + (n & 127);
        if ((n & 255) >= 128) Hd[(size_t)m * DFF + f] = f2bf(siluf_(G[(size_t)(m - NPT) * DFF + f]) * v);
    }
};
struct EwResH { const bf16_t* H; bf16_t* C; __device__ __forceinline__ void operator()(int m, int n, float v) const { C[(size_t)m * 1024 + n] = f2bf(bf2f(H[(size_t)m * 1024 + n]) + v); } };
struct EwPle { const bf16_t* H2; const bf16_t* PP; float* out;
    __device__ __forceinline__ void operator()(int m, int n, float v) const { out[O_YS + (size_t)(m - NPT) * 1024 + n] = bf2f(H2[(size_t)m * 1024 + n]) + bf2f(PP[(size_t)m * 1024 + n]) * sigmoidf_(v); } };

struct PgBf16 {
    static constexpr bool PERM = true, AFTER_DRAIN = false; bf16_t* O; int ldc;
    __device__ __forceinline__ void operator()(const f32x4 (&acc)[2][2][4][2], const pg8::Unit& u, int wr, int wc, int fr, int fq) const {
#pragma unroll
        for (int ai = 0; ai < 2; ++ai)
#pragma unroll
            for (int m = 0; m < 4; ++m) { bf16_t* rowp = O + (size_t)(u.pm * 256 + ai * 128 + wr * 64 + m * 16 + fr) * ldc + u.pn * 256 + wc * 32 + 8 * fq;
#pragma unroll
                for (int bj = 0; bj < 2; ++bj) { const f32x4 v0 = acc[ai][bj][m][0], v1 = acc[ai][bj][m][1]; u32x4 w; w.x = pk2bf(v0[0], v0[1]); w.y = pk2bf(v0[2], v0[3]); w.z = pk2bf(v1[0], v1[1]); w.w = pk2bf(v1[2], v1[3]); *(u32x4*)(rowp + bj * 128) = w; } }
    }
};
struct PgF32 {
    static constexpr bool PERM = false, AFTER_DRAIN = false; float* O; int ldc;
    __device__ __forceinline__ void operator()(const f32x4 (&acc)[2][2][4][2], const pg8::Unit& u, int wr, int wc, int fr, int fq) const {
#pragma unroll
        for (int ai = 0; ai < 2; ++ai)
#pragma unroll
            for (int m = 0; m < 4; ++m) { float* rowp = O + (size_t)(u.pm * 256 + ai * 128 + wr * 64 + m * 16 + fr) * ldc + u.pn * 256 + wc * 32 + 4 * fq;
#pragma unroll
                for (int bj = 0; bj < 2; ++bj)
#pragma unroll
                    for (int n = 0; n < 2; ++n) *(f32x4*)(rowp + bj * 128 + n * 16) = acc[ai][bj][m][n]; }
    }
};
struct PgRes {
    static constexpr bool PERM = false, AFTER_DRAIN = false; const float* R; float* O;
    __device__ __forceinline__ void operator()(const f32x4 (&acc)[2][2][4][2], const pg8::Unit& u, int wr, int wc, int fr, int fq) const {
#pragma unroll
        for (int ai = 0; ai < 2; ++ai)
#pragma unroll
            for (int m = 0; m < 4; ++m) { const size_t off = (size_t)(u.pm * 256 + ai * 128 + wr * 64 + m * 16 + fr) * 1024 + u.pn * 256 + wc * 32 + 4 * fq;
#pragma unroll
                for (int bj = 0; bj < 2; ++bj)
#pragma unroll
                    for (int n = 0; n < 2; ++n) { const f32x4 r = *(const f32x4*)(R + off + bj * 128 + n * 16); *(f32x4*)(O + off + bj * 128 + n * 16) = r + acc[ai][bj][m][n]; } }
    }
};
struct PgSwiglu {
    static constexpr bool PERM = true, AFTER_DRAIN = false; bf16_t* Hd;
    __device__ __forceinline__ void operator()(const f32x4 (&acc)[2][2][4][2], const pg8::Unit& u, int wr, int wc, int fr, int fq) const {
#pragma unroll
        for (int ai = 0; ai < 2; ++ai)
#pragma unroll
            for (int m = 0; m < 4; ++m) { bf16_t* rowp = Hd + (size_t)(u.pm * 256 + ai * 128 + wr * 64 + m * 16 + fr) * DFF + u.pn * 128 + wc * 32 + 8 * fq;
                float h[8];
#pragma unroll
                for (int n = 0; n < 2; ++n)
#pragma unroll
                    for (int i = 0; i < 4; ++i) h[n * 4 + i] = siluf_(acc[ai][0][m][n][i]) * acc[ai][1][m][n][i];
                u32x4 w; w.x = pk2bf(h[0], h[1]); w.y = pk2bf(h[2], h[3]); w.z = pk2bf(h[4], h[5]); w.w = pk2bf(h[6], h[7]); *(u32x4*)rowp = w; }
    }
};
struct PgPle {
    static constexpr bool PERM = false, AFTER_DRAIN = false; const float* H2; const float* PP; float* out;
    __device__ __forceinline__ void operator()(const f32x4 (&acc)[2][2][4][2], const pg8::Unit& u, int wr, int wc, int fr, int fq) const {
#pragma unroll
        for (int ai = 0; ai < 2; ++ai)
#pragma unroll
            for (int m = 0; m < 4; ++m) { const size_t off = (size_t)(u.pm * 256 + ai * 128 + wr * 64 + m * 16 + fr) * 1024 + u.pn * 256 + wc * 32 + 4 * fq;
#pragma unroll
                for (int bj = 0; bj < 2; ++bj)
#pragma unroll
                    for (int n = 0; n < 2; ++n) { const f32x4 h = *(const f32x4*)(H2 + off + bj * 128 + n * 16), pp = *(const f32x4*)(PP + off + bj * 128 + n * 16), a = acc[ai][bj][m][n]; f32x4 y;
#pragma unroll
                        for (int i = 0; i < 4; ++i) y[i] = h[i] + pp[i] * sigmoidf_(a[i]);
                        *(f32x4*)(out + O_YP + off + bj * 128 + n * 16) = y; } }
    }
};
struct PgResXB {
    static constexpr bool PERM = true, AFTER_DRAIN = false; const float* R; bf16_t* O;
    __device__ __forceinline__ void operator()(const f32x4 (&acc)[2][2][4][2], const pg8::Unit& u, int wr, int wc, int fr, int fq) const {
#pragma unroll
        for (int ai = 0; ai < 2; ++ai)
#pragma unroll
            for (int m = 0; m < 4; ++m) { const size_t off = (size_t)(u.pm * 256 + ai * 128 + wr * 64 + m * 16 + fr) * 1024 + u.pn * 256 + wc * 32 + 8 * fq;
#pragma unroll
                for (int bj = 0; bj < 2; ++bj) { const f32x4 r0 = *(const f32x4*)(R + off + bj * 128), r1 = *(const f32x4*)(R + off + bj * 128 + 4), v0 = r0 + acc[ai][bj][m][0], v1 = r1 + acc[ai][bj][m][1];
                    u32x4 w; w.x = cvtpk(v0[0], v0[1]); w.y = cvtpk(v0[2], v0[3]); w.z = cvtpk(v1[0], v1[1]); w.w = cvtpk(v1[2], v1[3]); *(u32x4*)(O + off + bj * 128) = w; } }
    }
};
struct PgResBB {
    static constexpr bool PERM = true, AFTER_DRAIN = false; const bf16_t* R; bf16_t* O;
    __device__ __forceinline__ void operator()(const f32x4 (&acc)[2][2][4][2], const pg8::Unit& u, int wr, int wc, int fr, int fq) const {
#pragma unroll
        for (int ai = 0; ai < 2; ++ai)
#pragma unroll
            for (int m = 0; m < 4; ++m) { const size_t off = (size_t)(u.pm * 256 + ai * 128 + wr * 64 + m * 16 + fr) * 1024 + u.pn * 256 + wc * 32 + 8 * fq;
#pragma unroll
                for (int bj = 0; bj < 2; ++bj) { float r[8]; bf8_to_f32(*(const bf16x8*)(R + off + bj * 128), r); const f32x4 a0 = acc[ai][bj][m][0], a1 = acc[ai][bj][m][1];
                    u32x4 w; w.x = cvtpk(r[0] + a0[0], r[1] + a0[1]); w.y = cvtpk(r[2] + a0[2], r[3] + a0[3]); w.z = cvtpk(r[4] + a1[0], r[5] + a1[1]); w.w = cvtpk(r[6] + a1[2], r[7] + a1[3]); *(u32x4*)(O + off + bj * 128) = w; } }
    }
};
struct PgPleB {
    static constexpr bool PERM = true, AFTER_DRAIN = false; const bf16_t* H2; const bf16_t* PP; float* out;
    __device__ __forceinline__ void operator()(const f32x4 (&acc)[2][2][4][2], const pg8::Unit& u, int wr, int wc, int fr, int fq) const {
#pragma unroll
        for (int ai = 0; ai < 2; ++ai)
#pragma unroll
            for (int m = 0; m < 4; ++m) { const size_t off = (size_t)(u.pm * 256 + ai * 128 + wr * 64 + m * 16 + fr) * 1024 + u.pn * 256 + wc * 32 + 8 * fq;
#pragma unroll
                for (int bj = 0; bj < 2; ++bj) { float h[8], pp[8]; bf8_to_f32(*(const bf16x8*)(H2 + off + bj * 128), h); bf8_to_f32(*(const bf16x8*)(PP + off + bj * 128), pp);
                    const f32x4 a0 = acc[ai][bj][m][0], a1 = acc[ai][bj][m][1]; f32x4 y0, y1;
#pragma unroll
                    for (int i = 0; i < 4; ++i) { y0[i] = h[i] + pp[i] * sigmoidf_(a0[i]); y1[i] = h[4 + i] + pp[4 + i] * sigmoidf_(a1[i]); }
                    *(f32x4*)(out + O_YP + off + bj * 128) = y0; *(f32x4*)(out + O_YP + off + bj * 128 + 4) = y1; } }
    }
};
template <class Epi>
__device__ __forceinline__ void pg_gemm(LAS unsigned char* lds, const bf16_t* A, const bf16_t* Bt, int M, int N, int K, const Epi& E, int glow = 0) {
    pg8::Gemm g{A, Bt, M, N, K}; pg8::StaticOrder S;
    if (glow > 0) { if ((int)blockIdx.x >= glow) return; S.init(M, N, glow, (int)blockIdx.x); }
    else S.init(M, N, (int)gridDim.x, (int)blockIdx.x);
    pg8::gemm_phase<Epi, pg8::StaticOrder, true, true>(lds, g, S, E);
}

constexpr size_t WOF_WinT = 0ull;
constexpr size_t WOF_WqbT = 5767168ull;
constexpr size_t WOF_WkvT = 6356992ull;
constexpr size_t WOF_WknT = 6881280ull;
constexpr size_t WOF_WoT = 7143424ull;
constexpr size_t WOF_WguT = 9240576ull;
constexpr size_t WOF_WdT = 20774912ull;
constexpr size_t WOF_WpgT = 26542080ull;
constexpr size_t WOF_WppT = 28639232ull;
constexpr size_t WOF_xn = 29163520ull;
constexpr size_t WOF_pb = 63242240ull;
constexpr size_t WOF_Z = 71761920ull;
constexpr size_t WOF_qkv = 165478400ull;
constexpr size_t WOF_ropecs = 216596480ull;
constexpr size_t WOF_gg = 216858880ull;
constexpr size_t WOF_bb = 217391360ull;
constexpr size_t WOF_goraw = 217923840ull;
constexpr size_t WOF_gUT = 252002560ull;
constexpr size_t WOF_ggam = 285556992ull;
constexpr size_t WOF_gWn = 285565184ull;
constexpr size_t WOF_gQg = 302342400ull;
constexpr size_t WOF_gQK = 319119616ull;
constexpr size_t WOF_gKd = 335896832ull;
constexpr size_t WOF_qan = 352674048ull;
constexpr size_t WOF_ckvb = 365453568ull;
constexpr size_t WOF_krf = 373973248ull;
constexpr size_t WOF_Q = 376103168ull;
constexpr size_t WOF_qh = 427221248ull;
constexpr size_t WOF_KV = 478339328ull;
constexpr size_t WOF_kh = 546496768ull;
constexpr size_t WOF_omix = 580575488ull;
constexpr size_t WOF_KN = 614654208ull;
constexpr size_t WOF_SC = 1151525120ull;
constexpr size_t WOF_part = 1168302336ull;
constexpr size_t WOF_H = 1170432256ull;
constexpr size_t WOF_un = 1238589696ull;
constexpr size_t WOF_G = 1272668416ull;
constexpr size_t WOF_hid = 1273028864ull;
constexpr size_t WOF_H2 = 1366745344ull;
constexpr size_t WOF_un2 = 1434902784ull;
constexpr size_t WOF_PP = 1468981504ull;
constexpr size_t WOF_qraw = 1537138944ull;
constexpr size_t WOF_kvraw = 1562304768ull;
constexpr size_t WOF_krb = 1595859200ull;
constexpr size_t WOF_ctl = 1596907776ull;
constexpr size_t WS_TOTAL = 1596924160ull;
struct MK {
    const float *x_prompt, *x_sample, *cache_ckv, *cache_krope, *state_gdn, *state_conv; const int* page_table; const float *p_prompt, *p_sample;
    const float *g_attn, *w_in, *w_conv, *a_log, *dt_bias, *g_gdn_out, *g_q_a, *w_q_b, *g_q_nope, *g_q_rope, *g_kv_a, *g_k_rope, *w_kv_b, *g_k_nope, *w_o, *g_ffn, *w_gate, *w_up, *w_down, *g_ple, *w_ple_gate, *w_ple_proj;
    float* out; char* ws;
    __device__ __forceinline__ unsigned* ctl() const { return (unsigned*)(ws + WOF_ctl); }
    __device__ __forceinline__ bf16_t* WinT() const { return (bf16_t*)(ws + WOF_WinT); }
    __device__ __forceinline__ bf16_t* WqbT() const { return (bf16_t*)(ws + WOF_WqbT); }
    __device__ __forceinline__ bf16_t* WkvT() const { return (bf16_t*)(ws + WOF_WkvT); }
    __device__ __forceinline__ bf16_t* WknT() const { return (bf16_t*)(ws + WOF_WknT); }
    __device__ __forceinline__ bf16_t* WoT() const { return (bf16_t*)(ws + WOF_WoT); }
    __device__ __forceinline__ bf16_t* WguT() const { return (bf16_t*)(ws + WOF_WguT); }
    __device__ __forceinline__ bf16_t* WdT() const { return (bf16_t*)(ws + WOF_WdT); }
    __device__ __forceinline__ bf16_t* WpgT() const { return (bf16_t*)(ws + WOF_WpgT); }
    __device__ __forceinline__ bf16_t* WppT() const { return (bf16_t*)(ws + WOF_WppT); }
    __device__ __forceinline__ bf16_t* xn() const { return (bf16_t*)(ws + WOF_xn); }
    __device__ __forceinline__ bf16_t* pb() const { return (bf16_t*)(ws + WOF_pb); }
    __device__ __forceinline__ bf16_t* Z() const { return (bf16_t*)(ws + WOF_Z); }
    __device__ __forceinline__ bf16_t* qkv() const { return (bf16_t*)(ws + WOF_qkv); }
    __device__ __forceinline__ float* ropecs() const { return (float*)(ws + WOF_ropecs); }
    __device__ __forceinline__ float* gg() const { return (float*)(ws + WOF_gg); }
    __device__ __forceinline__ float* bb() const { return (float*)(ws + WOF_bb); }
    __device__ __forceinline__ float* goraw() const { return (float*)(ws + WOF_goraw); }
    __device__ __forceinline__ float* gUT() const { return (float*)(ws + WOF_gUT); }
    __device__ __forceinline__ float* ggam() const { return (float*)(ws + WOF_ggam); }
    __device__ __forceinline__ bf16_t* gWn() const { return (bf16_t*)(ws + WOF_gWn); }
    __device__ __forceinline__ bf16_t* gQg() const { return (bf16_t*)(ws + WOF_gQg); }
    __device__ __forceinline__ bf16_t* gQK() const { return (bf16_t*)(ws + WOF_gQK); }
    __device__ __forceinline__ bf16_t* gKd() const { return (bf16_t*)(ws + WOF_gKd); }
    __device__ __forceinline__ bf16_t* qan() const { return (bf16_t*)(ws + WOF_qan); }
    __device__ __forceinline__ bf16_t* ckvb() const { return (bf16_t*)(ws + WOF_ckvb); }
    __device__ __forceinline__ float* krf() const { return (float*)(ws + WOF_krf); }
    __device__ __forceinline__ float* Q() const { return (float*)(ws + WOF_Q); }
    __device__ __forceinline__ float* qh() const { return (float*)(ws + WOF_qh); }
    __device__ __forceinline__ float* KV() const { return (float*)(ws + WOF_KV); }
    __device__ __forceinline__ float* kh() const { return (float*)(ws + WOF_kh); }
    __device__ __forceinline__ bf16_t* omix() const { return (bf16_t*)(ws + WOF_omix); }
    __device__ __forceinline__ bf16_t* KN() const { return (bf16_t*)(ws + WOF_KN); }
    __device__ __forceinline__ float* SC() const { return (float*)(ws + WOF_SC); }
    __device__ __forceinline__ float* part() const { return (float*)(ws + WOF_part); }
    __device__ __forceinline__ bf16_t* H() const { return (bf16_t*)(ws + WOF_H); }
    __device__ __forceinline__ bf16_t* un() const { return (bf16_t*)(ws + WOF_un); }
    __device__ __forceinline__ float* G() const { return (float*)(ws + WOF_G); }
    __device__ __forceinline__ bf16_t* hid() const { return (bf16_t*)(ws + WOF_hid); }
    __device__ __forceinline__ bf16_t* H2() const { return (bf16_t*)(ws + WOF_H2); }
    __device__ __forceinline__ bf16_t* un2() const { return (bf16_t*)(ws + WOF_un2); }
    __device__ __forceinline__ bf16_t* PP() const { return (bf16_t*)(ws + WOF_PP); }
    __device__ __forceinline__ bf16_t* qraw() const { return (bf16_t*)(ws + WOF_qraw); }
    __device__ __forceinline__ bf16_t* kvraw() const { return (bf16_t*)(ws + WOF_kvraw); }
    __device__ __forceinline__ bf16_t* krb() const { return (bf16_t*)(ws + WOF_krb); }
};

__device__ __forceinline__ float fast_sigmoid(float x) { return __builtin_amdgcn_rcpf(1.f + __builtin_amdgcn_exp2f(-1.44269504f * x)); }
struct PinTok { bf16x8 qa, cv, kr; float ab; };
struct PinGain { float gqa[8], gkv[8], gkr[8], dtb, alog; };
__device__ __forceinline__ PinTok pin_load(const MK& a, int row, int lane) {
    const bf16_t* z = a.Z() + (size_t)row * ZW; PinTok t; const bf16x8 zz = {0, 0, 0, 0, 0, 0, 0, 0};
    t.qa = lane < 48 ? *(const bf16x8*)(z + OFF_QA + 8 * lane) : zz; t.cv = lane < 32 ? *(const bf16x8*)(z + OFF_KVA + 8 * lane) : zz;
    t.kr = (lane >= 32 && lane < 36) ? *(const bf16x8*)(z + OFF_KR + 8 * (lane - 32)) : zz; t.ab = lane < 16 ? bf2f(z[OFF_A + lane]) : 0.f; return t;
}
__device__ __forceinline__ void post_in_token(const MK& a, int row, int lane, const float* wcs, const bf16x8 (&w0)[3], const bf16x8 (&w1)[3], const bf16x8 (&w2)[3], const bf16x8 (&wcur)[3], const PinTok& tk, const PinGain& gn) {
    const bool samp = row >= NPT;
    const int b = samp ? row - NPT : row >> 11, t = samp ? 0 : row & 2047, hd = lane >> 3;
    float y[24];
#pragma unroll
    for (int c3 = 0; c3 < 3; ++c3) {
        float p0[8], p1[8], p2[8], cu[8];
        bf8_to_f32(w0[c3], p0); bf8_to_f32(w1[c3], p1); bf8_to_f32(w2[c3], p2); bf8_to_f32(wcur[c3], cu);
        const float* wp = wcs + 512 * c3 + 8 * lane;
        const float4 a0 = *(const float4*)wp, a1 = *(const float4*)(wp + 4), b0 = *(const float4*)(wp + 1536), b1 = *(const float4*)(wp + 1540);
        const float4 c0 = *(const float4*)(wp + 3072), c1 = *(const float4*)(wp + 3076), d0 = *(const float4*)(wp + 4608), d1 = *(const float4*)(wp + 4612);
        const float k0[8] = {a0.x, a0.y, a0.z, a0.w, a1.x, a1.y, a1.z, a1.w}, k1[8] = {b0.x, b0.y, b0.z, b0.w, b1.x, b1.y, b1.z, b1.w};
        const float k2[8] = {c0.x, c0.y, c0.z, c0.w, c1.x, c1.y, c1.z, c1.w}, k3[8] = {d0.x, d0.y, d0.z, d0.w, d1.x, d1.y, d1.z, d1.w};
#pragma unroll
        for (int e = 0; e < 8; ++e) { const int c = 8 * c3 + e; const float v = k0[e] * p0[e] + k1[e] * p1[e] + k2[e] * p2[e] + k3[e] * cu[e]; y[c] = v * fast_sigmoid(v); }
        __builtin_amdgcn_sched_barrier(0);
    }
    float sq = 0.f, sk = 0.f;
#pragma unroll
    for (int e = 0; e < 8; ++e) { sq += y[e] * y[e]; sk += y[8 + e] * y[8 + e]; }
    sq += __shfl_xor(sq, 1); sk += __shfl_xor(sk, 1); sq += __shfl_xor(sq, 2); sk += __shfl_xor(sk, 2); sq += __shfl_xor(sq, 4); sk += __shfl_xor(sk, 4);
    const float rq = rsqrtf(sq + EPSV) * 0.125f, rk = rsqrtf(sk + EPSV);
#pragma unroll
    for (int e = 0; e < 8; ++e) { y[e] *= rq; y[8 + e] *= rk; }
    bf16_t* qo = a.qkv() + (size_t)row * 1536 + 8 * lane;
    *(bf16x8*)qo = f32_to_bf8(y); *(bf16x8*)(qo + 512) = f32_to_bf8(y + 8); *(bf16x8*)(qo + 1024) = f32_to_bf8(y + 16);
    if (!samp && t >= SEQ - 3) {
        float* cso = a.out + O_CSP + ((size_t)b * 3 + (t - (SEQ - 3))) * 1536 + 8 * lane;
#pragma unroll
        for (int j = 0; j < 3; ++j) { float cu[8]; bf8_to_f32(wcur[j], cu); *(float4*)(cso + 512 * j) = (float4){cu[0], cu[1], cu[2], cu[3]}; *(float4*)(cso + 512 * j + 4) = (float4){cu[4], cu[5], cu[6], cu[7]}; }
    }
    if (lane < 16) {
        const float v = tk.ab;
        if (lane < 8) { const float xx = v + gn.dtb; const float sp = xx > 20.f ? xx : log1pf(expf(xx)); a.gg()[(size_t)row * 8 + lane] = -gn.alog * sp; }
        else a.bb()[(size_t)row * 8 + lane - 8] = 1.f / (1.f + expf(-v));
    }
    __builtin_amdgcn_sched_barrier(0);
    float qa[8], cv[8], kr[8];
    bf8_to_f32(tk.qa, qa); bf8_to_f32(tk.cv, cv); bf8_to_f32(tk.kr, kr);
    float s1 = 0.f, s2 = 0.f, s3 = 0.f;
#pragma unroll
    for (int e = 0; e < 8; ++e) { s1 += qa[e] * qa[e]; s2 += cv[e] * cv[e]; s3 += kr[e] * kr[e]; }
#pragma unroll
    for (int o = 1; o < 64; o <<= 1) { s1 += __shfl_xor(s1, o); s2 += __shfl_xor(s2, o); s3 += __shfl_xor(s3, o); }
    const float r1 = rsqrtf(s1 * (1.f / 384.f) + EPSV), r2 = rsqrtf(s2 * (1.f / 256.f) + EPSV), r3 = rsqrtf(s3 * (1.f / 32.f) + EPSV);
    if (lane < 48) {
        float o[8];
#pragma unroll
        for (int e = 0; e < 8; ++e) o[e] = qa[e] * r1 * gn.gqa[e];
        *(bf16x8*)(a.qan() + (size_t)row * 384 + 8 * lane) = f32_to_bf8(o);
    }
    if (lane < 32) {
        float o[8];
#pragma unroll
        for (int e = 0; e < 8; ++e) o[e] = cv[e] * r2 * gn.gkv[e];
        *(bf16x8*)(a.ckvb() + (size_t)row * 256 + 8 * lane) = f32_to_bf8(o);
        float* co = samp ? a.out + O_CKVS + (size_t)b * 256 + 8 * lane : a.out + O_CKVP + (size_t)row * 256 + 8 * lane;
        *(float4*)co = (float4){o[0], o[1], o[2], o[3]}; *(float4*)(co + 4) = (float4){o[4], o[5], o[6], o[7]};
    }
    __builtin_amdgcn_sched_barrier(0);
    {
        const int c4 = (lane - 32) & 3;
        float xn[8], ot[8];
#pragma unroll
        for (int e = 0; e < 8; ++e) xn[e] = kr[e] * r3 * gn.gkr[e];
#pragma unroll
        for (int e = 0; e < 8; ++e) ot[e] = __shfl_xor(xn[e], 2);
        if (lane >= 32 && lane < 36) {
            const float* tb = a.ropecs() + (size_t)(samp ? 2048 : t) * 32 + ((8 * c4) & 15);
            const float4 c0 = *(const float4*)tb, c1 = *(const float4*)(tb + 4), s0 = *(const float4*)(tb + 16), s1 = *(const float4*)(tb + 20);
            const float csv[8] = {c0.x, c0.y, c0.z, c0.w, c1.x, c1.y, c1.z, c1.w}, snv[8] = {s0.x, s0.y, s0.z, s0.w, s1.x, s1.y, s1.z, s1.w};
            float o[8];
#pragma unroll
            for (int e = 0; e < 8; ++e) o[e] = c4 < 2 ? xn[e] * csv[e] - ot[e] * snv[e] : ot[e] * snv[e] + xn[e] * csv[e];
            float* kf_ = a.krf() + (size_t)row * 32 + 8 * c4; *(float4*)kf_ = (float4){o[0], o[1], o[2], o[3]}; *(float4*)(kf_ + 4) = (float4){o[4], o[5], o[6], o[7]};
            float* ko = samp ? a.out + O_KRS + (size_t)b * 32 + 8 * c4 : a.out + O_KRP + (size_t)row * 32 + 8 * c4;
            *(float4*)ko = (float4){o[0], o[1], o[2], o[3]}; *(float4*)(ko + 4) = (float4){o[4], o[5], o[6], o[7]};
            if (!samp) *(bf16x8*)(a.krb() + (size_t)row * 32 + 8 * c4) = f32_to_bf8(o);
        }
    }
    (void)hd;
}
__device__ __forceinline__ void post_in_run(const MK& a, int run, int lane_in, const float* wcs) {
    int lane = lane_in; asm volatile("" : "+v"(lane));
    PinGain gn;
    {
        const int lq = lane < 48 ? lane : 0, lk = lane < 32 ? lane : 0, c4 = (lane - 32) & 3;
#pragma unroll
        for (int e = 0; e < 8; ++e) { gn.gqa[e] = a.g_q_a[8 * lq + e]; gn.gkv[e] = a.g_kv_a[8 * lk + e]; gn.gkr[e] = a.g_k_rope[8 * c4 + e]; }
        gn.dtb = a.dt_bias[lane & 7]; gn.alog = expf(a.a_log[lane & 7]);
    }
    if (run < NPT / 8) {
        const int row0 = run * 8, t0 = row0 & 2047;
        bf16x8 w0[3], w1[3], w2[3], wcur[3];
#pragma unroll
        for (int c3 = 0; c3 < 3; ++c3) {
            const bf16x8 zz = {0, 0, 0, 0, 0, 0, 0, 0}; w0[c3] = zz; w1[c3] = zz; w2[c3] = zz;
            if (t0 > 0) { const bf16_t* zp = a.Z() + (size_t)(row0 - 3) * ZW + 512 * c3 + 8 * lane; w0[c3] = *(const bf16x8*)zp; w1[c3] = *(const bf16x8*)(zp + ZW); w2[c3] = *(const bf16x8*)(zp + 2 * ZW); }
        }
        bf16x8 wnext[3]; PinTok tk, tkn;
#pragma unroll
        for (int c3 = 0; c3 < 3; ++c3) wnext[c3] = *(const bf16x8*)(a.Z() + (size_t)row0 * ZW + 512 * c3 + 8 * lane);
        tkn = pin_load(a, row0, lane);
#pragma unroll 1
        for (int k = 0; k < 8; ++k) {
            const int row = row0 + k;
#pragma unroll
            for (int c3 = 0; c3 < 3; ++c3) wcur[c3] = wnext[c3];
            tk = tkn;
            if (k < 7) {
#pragma unroll
                for (int c3 = 0; c3 < 3; ++c3) wnext[c3] = *(const bf16x8*)(a.Z() + (size_t)(row + 1) * ZW + 512 * c3 + 8 * lane);
                tkn = pin_load(a, row + 1, lane);
            }
            post_in_token(a, row, lane, wcs, w0, w1, w2, wcur, tk, gn);
#pragma unroll
            for (int c3 = 0; c3 < 3; ++c3) { w0[c3] = w1[c3]; w1[c3] = w2[c3]; w2[c3] = wcur[c3]; }
        }
    } else {
        {
            const int bsm = run - NPT / 8, row = NPT + bsm;
            bf16x8 w0[3], w1[3], w2[3], wcur[3];
#pragma unroll
            for (int c3 = 0; c3 < 3; ++c3) {
                const float* sp = a.state_conv + (size_t)bsm * 3 * 1536 + 512 * c3 + 8 * lane;
                float* cso = a.out + O_CSS + (size_t)bsm * 3 * 1536 + 512 * c3 + 8 * lane;
                float t0_[8], t1_[8], t2_[8], tc_[8];
#pragma unroll
                for (int e = 0; e < 8; ++e) { t0_[e] = sp[e]; t1_[e] = sp[1536 + e]; t2_[e] = sp[2 * 1536 + e]; }
                wcur[c3] = *(const bf16x8*)(a.Z() + (size_t)row * ZW + 512 * c3 + 8 * lane); bf8_to_f32(wcur[c3], tc_);
#pragma unroll
                for (int e = 0; e < 8; ++e) { cso[e] = t1_[e]; cso[1536 + e] = t2_[e]; cso[2 * 1536 + e] = tc_[e]; }
                w0[c3] = f32_to_bf8(t0_); w1[c3] = f32_to_bf8(t1_); w2[c3] = f32_to_bf8(t2_);
            }
            post_in_token(a, row, lane, wcs, w0, w1, w2, wcur, pin_load(a, row, lane), gn);
        }
    }
}

__device__ __forceinline__ void post_q_item(const MK& a, int idx, int lane) {
    const int row = idx >> 3, h = idx & 7;
    const float* q = a.Q() + (size_t)row * 768 + h * 96;
    float* o = a.qh() + ((size_t)row * 8 + h) * 96;
    const float v = q[lane];
    const float ss = wave_sum(v * v);
    o[lane] = v * rsqrtf(ss * (1.f / 64.f) + EPSV) * a.g_q_nope[lane];
    const float r = lane < 32 ? q[64 + lane] : 0.f;
    const float s2 = wave_sum(r * r);
    const float xn = lane < 32 ? r * rsqrtf(s2 * (1.f / 32.f) + EPSV) * a.g_q_rope[lane] : 0.f;
    const float other = __shfl_xor(xn, 16);
    const int i = lane & 15;
    const float* tb = a.ropecs() + (size_t)(row >= NPT ? 2048 : (row & 2047)) * 32;
    const float cs = tb[i], sn = tb[16 + i];
    const float ov = lane < 16 ? xn * cs - other * sn : other * sn + xn * cs;
    if (lane < 32) o[64 + lane] = ov;
}
__device__ __forceinline__ void post_kv_item(const MK& a, int idx, int lane) {
    const int row = idx >> 3, h = idx & 7;
    const float v = a.KV()[(size_t)row * 1024 + h * 128 + lane];
    const float ss = wave_sum(v * v);
    const float kn = v * rsqrtf(ss * (1.f / 64.f) + EPSV) * a.g_k_nope[lane];
    a.kh()[((size_t)row * 8 + h) * 64 + lane] = kn;
}

typedef float f32x16 __attribute__((ext_vector_type(16)));
typedef short s16x4 __attribute__((ext_vector_type(4)));
#define KST 104
#define VST 72
#define ATT_BUF (64 * KST * 2 + 64 * VST * 2)
__device__ __forceinline__ int crow32(int r, int hi) { return (r & 3) + 8 * (r >> 2) + 4 * hi; }
__device__ __forceinline__ s16x4 tr_read(const bf16_t* p) { return __builtin_bit_cast(s16x4, __builtin_amdgcn_ds_read_tr16_b64_v4i16((LAS s16x4*)(LAS void*)(unsigned)(size_t)p)); }
__device__ __forceinline__ bf16x8 pack8(const f32x16& x, int s) {
    u32x4 w; w.x = cvtpk(x[8 * s], x[8 * s + 1]); w.y = cvtpk(x[8 * s + 2], x[8 * s + 3]); w.z = cvtpk(x[8 * s + 4], x[8 * s + 5]); w.w = cvtpk(x[8 * s + 6], x[8 * s + 7]);
    return __builtin_bit_cast(bf16x8, w);
}
__device__ __forceinline__ void attn_block(const MK& a, int b, int h, int qb, char* smem) {
    const int tid = otid(), lane = tid & 63, wid = tid >> 6, r32 = lane & 31, hi = lane >> 5;
    const int qrow = qb * 256 + wid * 32 + r32;
    const int wq0 = qb * 256 + wid * 32;
    bf16x8 qf[6];
    {
        const float SCL = 0.14724445f;
        const bf16_t* Qg = a.qraw() + ((size_t)b * SEQ + qrow) * 768 + h * 96 + 8 * hi;
        float qv[6][8];
#pragma unroll
        for (int ds = 0; ds < 6; ++ds) bf8_to_f32(*(const bf16x8*)(Qg + 16 * ds), qv[ds]);
        float sn_ = 0.f, sr_ = 0.f;
#pragma unroll
        for (int j = 0; j < 8; ++j) { sn_ += qv[0][j] * qv[0][j] + qv[1][j] * qv[1][j] + qv[2][j] * qv[2][j] + qv[3][j] * qv[3][j]; sr_ += qv[4][j] * qv[4][j] + qv[5][j] * qv[5][j]; }
        sn_ += __shfl_xor(sn_, 32); sr_ += __shfl_xor(sr_, 32);
        const float rsn = rsqrtf(sn_ * (1.f / 64.f) + EPSV) * SCL, rsr = rsqrtf(sr_ * (1.f / 32.f) + EPSV);
#pragma unroll
        for (int ds = 0; ds < 4; ++ds) {
            float o[8];
#pragma unroll
            for (int j = 0; j < 8; ++j) o[j] = qv[ds][j] * rsn * a.g_q_nope[16 * ds + 8 * hi + j];
            qf[ds] = f32_to_bf8(o);
        }
        const float* tb = a.ropecs() + (size_t)qrow * 32 + 8 * hi;
        float o4[8], o5[8];
#pragma unroll
        for (int j = 0; j < 8; ++j) {
            const float x1 = qv[4][j] * rsr * a.g_q_rope[8 * hi + j], x2 = qv[5][j] * rsr * a.g_q_rope[16 + 8 * hi + j], cs = tb[j], sn = tb[16 + j];
            o4[j] = (x1 * cs - x2 * sn) * SCL; o5[j] = (x1 * sn + x2 * cs) * SCL;
        }
        qf[4] = f32_to_bf8(o4); qf[5] = f32_to_bf8(o5);
    }
    f32x16 o0, o1;
#pragma unroll
    for (int r = 0; r < 16; ++r) { o0[r] = 0.f; o1[r] = 0.f; }
    float m = 0.f, l = 0.f;
    f32x16 negm;
#pragma unroll
    for (int r = 0; r < 16; ++r) negm[r] = 0.f;
    const int nt = qb * 4 + 4;
    const int vr = tid >> 3, vc = tid & 7, rr_ = (tid >> 2) & 63, rc = tid & 3;
    const bf16_t* KVg = a.kvraw() + (size_t)b * SEQ * 1024 + h * 128 + (size_t)vr * 1024 + vc * 8;
    const bf16_t* KRg = a.krb() + (size_t)b * SEQ * 32 + (size_t)rr_ * 32 + rc * 8;
    float gk[8];
#pragma unroll
    for (int j = 0; j < 8; ++j) gk[j] = a.g_k_nope[8 * vc + j];
    bf16x8 kr0, kr1, vr0;
#define ATT_LOAD(tt) do { kr0 = *(const bf16x8*)(KVg + (size_t)(tt) * 64 * 1024); vr0 = *(const bf16x8*)(KVg + (size_t)(tt) * 64 * 1024 + 64); if (tid < 256) kr1 = *(const bf16x8*)(KRg + (size_t)(tt) * 64 * 32); } while (0)
#define ATT_STORE(buf) do { bf16_t* Ks_ = (bf16_t*)(smem + (buf) * ATT_BUF); bf16_t* Vs_ = Ks_ + 64 * KST; \
        float x_[8]; bf8_to_f32(kr0, x_); float ss_ = 0.f; _Pragma("unroll") for (int j = 0; j < 8; ++j) ss_ += x_[j] * x_[j]; \
        ss_ += __shfl_xor(ss_, 1); ss_ += __shfl_xor(ss_, 2); ss_ += __shfl_xor(ss_, 4); const float rs_ = rsqrtf(ss_ * (1.f / 64.f) + EPSV); \
        _Pragma("unroll") for (int j = 0; j < 8; ++j) x_[j] *= rs_ * gk[j]; \
        *(bf16x8*)(Ks_ + vr * KST + vc * 8) = f32_to_bf8(x_); *(bf16x8*)(Vs_ + vr * VST + vc * 8) = vr0; \
        if (tid < 256) *(bf16x8*)(Ks_ + rr_ * KST + 64 + rc * 8) = kr1; } while (0)
    ATT_LOAD(0);
    __syncthreads();
    ATT_STORE(0);
    __syncthreads();
    const int i16 = lane & 15, qq = i16 >> 2, pp = i16 & 3, g1 = (lane >> 4) & 1;
    for (int t = 0; t < nt; ++t) {
        const bf16_t* Ks = (const bf16_t*)(smem + (t & 1) * ATT_BUF); const bf16_t* Vs = Ks + 64 * KST;
        if (t + 1 < nt) ATT_LOAD(t + 1);
        if (64 * t <= wq0 + 31) {
            f32x16 p0, p1;
#pragma unroll
            for (int ds = 0; ds < 6; ++ds) {
                const bf16x8 k0 = *(const bf16x8*)(Ks + r32 * KST + 16 * ds + 8 * hi);
                const bf16x8 k1 = *(const bf16x8*)(Ks + (32 + r32) * KST + 16 * ds + 8 * hi);
                if (ds == 0) { p0 = __builtin_amdgcn_mfma_f32_32x32x16_bf16(k0, qf[ds], negm, 0, 0, 0); p1 = __builtin_amdgcn_mfma_f32_32x32x16_bf16(k1, qf[ds], negm, 0, 0, 0); }
                else { p0 = __builtin_amdgcn_mfma_f32_32x32x16_bf16(k0, qf[ds], p0, 0, 0, 0); p1 = __builtin_amdgcn_mfma_f32_32x32x16_bf16(k1, qf[ds], p1, 0, 0, 0); }
            }
            if (64 * t + 63 > wq0) {
#pragma unroll
                for (int r = 0; r < 16; ++r) { const int kv = 64 * t + crow32(r, hi); if (kv > qrow) p0[r] = -INFINITY; if (kv + 32 > qrow) p1[r] = -INFINITY; }
            }
            float mx = fmaxf(p0[0], p1[0]);
#pragma unroll
            for (int r = 1; r < 16; ++r) mx = fmaxf(mx, fmaxf(p0[r], p1[r]));
            mx = fmaxf(mx, __shfl_xor(mx, 32));
            const float delta = t == 0 ? mx : fmaxf(mx, 0.f);
            if (__any(delta != 0.f)) {
                m += delta;
                const float f = t == 0 ? 1.f : __builtin_amdgcn_exp2f(-delta);
#pragma unroll
                for (int r = 0; r < 16; ++r) { p0[r] -= delta; p1[r] -= delta; negm[r] = -m; o0[r] *= f; o1[r] *= f; }
                l *= f;
            }
            float rs = 0.f;
#pragma unroll
            for (int r = 0; r < 16; ++r) { p0[r] = __builtin_amdgcn_exp2f(p0[r]); p1[r] = __builtin_amdgcn_exp2f(p1[r]); rs += p0[r] + p1[r]; }
            l += rs;
            bf16x8 pf[4];
            pf[0] = pack8(p0, 0); pf[1] = pack8(p0, 1); pf[2] = pack8(p1, 0); pf[3] = pack8(p1, 1);
#pragma unroll
            for (int ks = 0; ks < 4; ++ks) {
                const bf16_t* vb0 = Vs + (16 * ks + 4 * hi + qq) * VST + 16 * g1 + 4 * pp;
                const s16x4 a0 = tr_read(vb0), a1 = tr_read(vb0 + 8 * VST);
                const s16x4 c0 = tr_read(vb0 + 32), c1 = tr_read(vb0 + 8 * VST + 32);
                const bf16x8 va = __builtin_shufflevector(a0, a1, 0, 1, 2, 3, 4, 5, 6, 7);
                const bf16x8 vc_ = __builtin_shufflevector(c0, c1, 0, 1, 2, 3, 4, 5, 6, 7);
                o0 = __builtin_amdgcn_mfma_f32_32x32x16_bf16(va, pf[ks], o0, 0, 0, 0);
                o1 = __builtin_amdgcn_mfma_f32_32x32x16_bf16(vc_, pf[ks], o1, 0, 0, 0);
            }
        }
        if (t + 1 < nt) ATT_STORE((t + 1) & 1);
        __syncthreads();
    }
    l += __shfl_xor(l, 32);
    const float il = 1.f / l;
    bf16_t* op = a.omix() + ((size_t)b * SEQ + qrow) * 1024 + 512 + h * 64;
#pragma unroll
    for (int g = 0; g < 4; ++g) {
        uint2 w0, w1;
        w0.x = pk2bf(o0[4 * g] * il, o0[4 * g + 1] * il); w0.y = pk2bf(o0[4 * g + 2] * il, o0[4 * g + 3] * il);
        w1.x = pk2bf(o1[4 * g] * il, o1[4 * g + 1] * il); w1.y = pk2bf(o1[4 * g + 2] * il, o1[4 * g + 3] * il);
        *(uint2*)(op + 8 * g + 4 * hi) = w0;
        *(uint2*)(op + 32 + 8 * g + 4 * hi) = w1;
    }
#undef ATT_LOAD
#undef ATT_STORE
}

__device__ __forceinline__ void gdn_unit(const MK& a, int b, int h, int dvg, const float* s0, float* sout, int row0, int T, int lane, char* wsm) {
    float (*sq)[64] = (float (*)[64])wsm;
    float (*sk)[64] = (float (*)[64])(wsm + 4096);
    float (*sv)[8] = (float (*)[8])(wsm + 8192);
    float* sg = (float*)(wsm + 8704);
    float* sb = (float*)(wsm + 8768);
    const int e = lane & 7, ko = lane >> 3, col = dvg * 8 + e;
    float S[8];
#pragma unroll
    for (int d = 0; d < 8; ++d) S[d] = s0 ? s0[(((size_t)b * 8 + h) * 64 + ko * 8 + d) * 64 + col] : 0.f;
    const size_t rbase = (size_t)row0 + (size_t)b * T;
    float pq[16], pk[16], pv0, pv1, pgb;
    {
        const int nt = T < 16 ? T : 16;
#pragma unroll
        for (int j = 0; j < 16; ++j) { const bool ok = j < nt; const size_t r = rbase + (ok ? j : 0); pq[j] = ok ? bf2f(a.qkv()[r * 1536 + h * 64 + lane]) : 0.f; pk[j] = ok ? bf2f(a.qkv()[r * 1536 + 512 + h * 64 + lane]) : 0.f; }
        { const int j0 = lane >> 3, j1 = j0 + 8; pv0 = j0 < nt ? bf2f(a.qkv()[(rbase + j0) * 1536 + 1024 + h * 64 + dvg * 8 + (lane & 7)]) : 0.f; pv1 = j1 < nt ? bf2f(a.qkv()[(rbase + j1) * 1536 + 1024 + h * 64 + dvg * 8 + (lane & 7)]) : 0.f; }
        { const int j = lane & 15; pgb = j < nt ? (lane < 16 ? a.gg()[(rbase + j) * 8 + h] : a.bb()[(rbase + j) * 8 + h]) : 0.f; }
    }
    for (int t0 = 0; t0 < T; t0 += 16) {
        const int nt = (T - t0) < 16 ? (T - t0) : 16;
        WSYNC();
#pragma unroll
        for (int j = 0; j < 16; ++j) { sq[j][lane] = pq[j]; sk[j][lane] = pk[j]; }
        sv[lane >> 3][lane & 7] = pv0; sv[(lane >> 3) + 8][lane & 7] = pv1;
        if (lane < 16) sg[lane] = expf(pgb); else if (lane < 32) sb[lane - 16] = pgb;
        WSYNC();
        if (t0 + 16 < T) {
            const size_t rb = rbase + t0 + 16;
#pragma unroll
            for (int j = 0; j < 16; ++j) { pq[j] = bf2f(a.qkv()[(rb + j) * 1536 + h * 64 + lane]); pk[j] = bf2f(a.qkv()[(rb + j) * 1536 + 512 + h * 64 + lane]); }
            pv0 = bf2f(a.qkv()[(rb + (lane >> 3)) * 1536 + 1024 + h * 64 + dvg * 8 + (lane & 7)]); pv1 = bf2f(a.qkv()[(rb + (lane >> 3) + 8) * 1536 + 1024 + h * 64 + dvg * 8 + (lane & 7)]);
            pgb = lane < 16 ? a.gg()[(rb + (lane & 15)) * 8 + h] : a.bb()[(rb + (lane & 15)) * 8 + h];
        }
        for (int j = 0; j < nt; ++j) {
            const float dec = sg[j], be = sb[j], v = sv[j][e];
            const float4 k0 = *(const float4*)&sk[j][ko * 8], k1 = *(const float4*)&sk[j][ko * 8 + 4];
            const float4 q0 = *(const float4*)&sq[j][ko * 8], q1 = *(const float4*)&sq[j][ko * 8 + 4];
            const float kk[8] = {k0.x, k0.y, k0.z, k0.w, k1.x, k1.y, k1.z, k1.w};
            const float qq[8] = {q0.x, q0.y, q0.z, q0.w, q1.x, q1.y, q1.z, q1.w};
            float ks = 0.f;
#pragma unroll
            for (int d = 0; d < 8; ++d) { S[d] *= dec; ks += kk[d] * S[d]; }
            ks += __shfl_xor(ks, 8); ks += __shfl_xor(ks, 16); ks += __shfl_xor(ks, 32);
            const float delta = (v - ks) * be;
            float ov = 0.f;
#pragma unroll
            for (int d = 0; d < 8; ++d) { S[d] += kk[d] * delta; ov += qq[d] * S[d]; }
            ov += __shfl_xor(ov, 8); ov += __shfl_xor(ov, 16); ov += __shfl_xor(ov, 32);
            if (ko == 0) a.goraw()[(rbase + t0 + j) * 512 + h * 64 + col] = ov;
        }
    }
#pragma unroll
    for (int d = 0; d < 8; ++d) sout[(((size_t)b * 8 + h) * 64 + ko * 8 + d) * 64 + col] = S[d];
}
__device__ __forceinline__ bf16x8 ld8_f32_bf16(const float* p) {
    const float4 x = *(const float4*)p, y = *(const float4*)(p + 4);
    u32x4 w; w.x = cvtpk(x.x, x.y); w.y = cvtpk(x.z, x.w); w.z = cvtpk(y.x, y.y); w.w = cvtpk(y.z, y.w);
    return __builtin_bit_cast(bf16x8, w);
}
__device__ __forceinline__ int pi_pos(int k) { return (k & 32) + 8 * ((k >> 2) & 3) + 4 * ((k >> 4) & 1) + (k & 3); }
#define GDN_WLDS 17408
__device__ __forceinline__ void gdn_prep_unit(const MK& a, int u, int lane_in, char* wsm) {
    int lane = lane_in; asm volatile("" : "+v"(lane));
    const int bh = u >> 5, n = u & 31, b = bh >> 3, h = bh & 7, i16 = lane & 15, q4 = lane >> 4;
    const size_t row0 = (size_t)b * SEQ + n * 64;
    float* AT = (float*)wsm; float* GC = (float*)(wsm + 16384); float* BT = GC + 64;
    const bf16_t* qbase = a.qkv() + row0 * 1536 + h * 64; const bf16_t* kbase = qbase + 512; const bf16_t* vbase = qbase + 1024;
    float g = a.gg()[(row0 + lane) * 8 + h];
    const float be_l = a.bb()[(row0 + lane) * 8 + h];
#pragma unroll
    for (int o = 1; o < 64; o <<= 1) { const float t = __shfl_up(g, o); if (lane >= o) g += t; }
    WSYNC();
    GC[lane] = g; BT[lane] = be_l;
    WSYNC();
    const float gl = GC[63];
    float* EG = BT + 64; float* ED = EG + 64;
    EG[lane] = expf(g); ED[lane] = expf(gl - g);
    WSYNC();
    bf16x8 kf[4][2], qf[4][2];
#pragma unroll
    for (int mt = 0; mt < 4; ++mt)
#pragma unroll
        for (int ks = 0; ks < 2; ++ks) {
            const int off = (16 * mt + i16) * 1536 + 32 * ks + 8 * q4;
            kf[mt][ks] = *(const bf16x8*)(kbase + off); qf[mt][ks] = *(const bf16x8*)(qbase + off);
        }
    bf16_t* QKg = a.gQK() + (size_t)u * 4096;
#pragma unroll
    for (int mt = 0; mt < 4; ++mt)
#pragma unroll
        for (int nt = 0; nt < 4; ++nt) {
            const int j = 16 * nt + i16, pj = 32 * (nt >> 1) + 8 * (i16 >> 2) + 4 * (nt & 1) + (i16 & 3);
            if (nt <= mt) {
                f32x4 d1 = {0.f, 0.f, 0.f, 0.f}, d2 = {0.f, 0.f, 0.f, 0.f};
#pragma unroll
                for (int ks = 0; ks < 2; ++ks) {
                    d1 = __builtin_amdgcn_mfma_f32_16x16x32_bf16(kf[mt][ks], kf[nt][ks], d1, 0, 0, 0);
                    d2 = __builtin_amdgcn_mfma_f32_16x16x32_bf16(qf[mt][ks], kf[nt][ks], d2, 0, 0, 0);
                }
                const float gcj = GC[j];
#pragma unroll
                for (int r = 0; r < 4; ++r) {
                    const int i = 16 * mt + 4 * q4 + r;
                    const float dec = __builtin_amdgcn_exp2f(1.44269504f * (GC[i] - gcj));
                    AT[i * 64 + j] = (i > j) ? BT[i] * d1[r] * dec : 0.f;
                    QKg[i * 64 + (((pj >> 3) ^ (i & 7)) << 3) + (pj & 7)] = f2bf((i >= j) ? d2[r] * dec : 0.f);
                }
            } else {
#pragma unroll
                for (int r = 0; r < 4; ++r) { const int i = 16 * mt + 4 * q4 + r; QKg[i * 64 + (((pj >> 3) ^ (i & 7)) << 3) + (pj & 7)] = 0; }
            }
        }
    {
        bf16_t* Qgg = a.gQg() + (size_t)u * 4096;
#pragma unroll
        for (int mt = 0; mt < 4; ++mt) {
            const int i = 16 * mt + i16; const float e = EG[i];
#pragma unroll
            for (int ks = 0; ks < 2; ++ks) {
                float x[8]; bf8_to_f32(qf[mt][ks], x);
                uint2 w0, w1; w0.x = cvtpk(x[0] * e, x[1] * e); w0.y = cvtpk(x[2] * e, x[3] * e); w1.x = cvtpk(x[4] * e, x[5] * e); w1.y = cvtpk(x[6] * e, x[7] * e);
                const int p0 = 32 * ks + 16 * (q4 & 1) + 4 * (q4 >> 1);
                *(uint2*)(Qgg + i * 64 + (((p0 >> 3) ^ (i & 7)) << 3) + (p0 & 7)) = w0; *(uint2*)(Qgg + i * 64 + ((((p0 >> 3) + 1) ^ (i & 7)) << 3) + (p0 & 7)) = w1;
            }
        }
    }
    WSYNC();
    __builtin_amdgcn_sched_barrier(0);
    {
        float U[64];
#pragma unroll
        for (int i = 0; i < 64; ++i) { U[i] = bf2f(vbase[i * 1536 + lane]) * BT[i]; }
#pragma unroll
        for (int i = 1; i < 64; ++i) {
            float su = 0.f;
#pragma unroll
            for (int j4 = 0; j4 < i; j4 += 4) {
                const float4 av = *(const float4*)(AT + i * 64 + j4);
                su += av.x * U[j4];
                if (j4 + 1 < i) su += av.y * U[j4 + 1];
                if (j4 + 2 < i) su += av.z * U[j4 + 2];
                if (j4 + 3 < i) su += av.w * U[j4 + 3];
            }
            U[i] -= su;
            __builtin_amdgcn_sched_barrier(0);
        }
        float* UTg = a.gUT() + ((size_t)u * 64 + lane) * 64;
#pragma unroll
        for (int i = 0; i < 64; i += 4) *(float4*)(UTg + 4 * ((i >> 2) ^ (lane & 15))) = (float4){U[i], U[i + 1], U[i + 2], U[i + 3]};
    }
    asm volatile("" ::: "memory");
    __builtin_amdgcn_sched_barrier(0);
    {
        float W[64];
#pragma unroll
        for (int i = 0; i < 64; ++i) { W[i] = bf2f(kbase[i * 1536 + lane]); }
        bf16_t* Kdg = a.gKd() + ((size_t)u * 64 + lane) * 64;
#pragma unroll
        for (int pc = 0; pc < 8; ++pc) {
            float t[8];
#pragma unroll
            for (int jj = 0; jj < 8; ++jj) { const int j = 32 * (pc >> 2) + 16 * (jj >> 2) + 4 * (pc & 3) + (jj & 3); t[jj] = W[j] * ED[j]; }
            u32x4 w; w.x = cvtpk(t[0], t[1]); w.y = cvtpk(t[2], t[3]); w.z = cvtpk(t[4], t[5]); w.w = cvtpk(t[6], t[7]);
            *(u32x4*)(Kdg + 8 * (pc ^ (lane & 7))) = w;
        }
#pragma unroll
        for (int i = 0; i < 64; ++i) W[i] *= BT[i] * EG[i];
#pragma unroll
        for (int i = 1; i < 64; ++i) {
            float sw = 0.f;
#pragma unroll
            for (int j4 = 0; j4 < i; j4 += 4) {
                const float4 av = *(const float4*)(AT + i * 64 + j4);
                sw += av.x * W[j4];
                if (j4 + 1 < i) sw += av.y * W[j4 + 1];
                if (j4 + 2 < i) sw += av.z * W[j4 + 2];
                if (j4 + 3 < i) sw += av.w * W[j4 + 3];
            }
            W[i] -= sw;
            __builtin_amdgcn_sched_barrier(0);
        }
        bf16_t* Wng = a.gWn() + (size_t)u * 4096; const int pp = pi_pos(lane);
#pragma unroll
        for (int i = 0; i < 64; ++i) Wng[i * 64 + (((pp >> 3) ^ (i & 7)) << 3) + (pp & 7)] = f2bf(-W[i]);
    }
    if (lane == 0) a.ggam()[u] = expf(gl);
}
__device__ __forceinline__ bf16x8 pack_acc2(const f32x4& x, const f32x4& y) {
    u32x4 w; w.x = cvtpk(x[0], x[1]); w.y = cvtpk(x[2], x[3]); w.z = cvtpk(y[0], y[1]); w.w = cvtpk(y[2], y[3]);
    return __builtin_bit_cast(bf16x8, w);
}
#define G2_SLOT 49152
__device__ __forceinline__ void g2_issue(const MK& a, size_t u, int n, LAS unsigned char* lds, int lw, int lane) {
    LAS unsigned char* dst = lds + (n % 3) * G2_SLOT;
    const char* srcs[4] = {(const char*)(a.gWn() + u * 4096), (const char*)(a.gQg() + u * 4096), (const char*)(a.gQK() + u * 4096), (const char*)(a.gKd() + u * 4096)};
#pragma unroll
    for (int m = 0; m < 4; ++m)
#pragma unroll
        for (int i = 0; i < 2; ++i) { const int piece = 2 * lw + i;
            __builtin_amdgcn_global_load_lds((const unsigned*)(srcs[m] + piece * 1024 + lane * 16), (LAS unsigned*)(dst + m * 8192 + piece * 1024), 16, 0, 0); }
    const char* us = (const char*)(a.gUT() + u * 4096);
#pragma unroll
    for (int i = 0; i < 4; ++i) { const int piece = 4 * lw + i;
        __builtin_amdgcn_global_load_lds((const unsigned*)(us + piece * 1024 + lane * 16), (LAS unsigned*)(dst + 32768 + piece * 1024), 16, 0, 0); }
}
__device__ __forceinline__ void gdn_scan_block(const MK& a, int bh, LAS unsigned char* lds) {
    const int tid = otid(), lane = tid & 63, wid = __builtin_amdgcn_readfirstlane(tid >> 6), i16 = lane & 15, q4 = lane >> 4;
    const int b = bh >> 3, h = bh & 7, sl = wid & 3;
    const bool loader = wid >= 4;
    f32x4 S[4];
#pragma unroll
    for (int mt = 0; mt < 4; ++mt) S[mt] = (f32x4){0.f, 0.f, 0.f, 0.f};
    __syncthreads();
    if (loader) { g2_issue(a, (size_t)bh * 32, 0, lds, wid - 4, lane); g2_issue(a, (size_t)bh * 32 + 1, 1, lds, wid - 4, lane); }
    for (int n = 0; n < 32; ++n) {
        if (loader) { if (n < 31) asm volatile("s_waitcnt vmcnt(12)" ::: "memory"); else asm volatile("s_waitcnt vmcnt(0)" ::: "memory"); }
        asm volatile("s_waitcnt lgkmcnt(0)" ::: "memory"); __builtin_amdgcn_s_barrier(); asm volatile("" ::: "memory");
        if (loader) { if (n + 2 < 32) g2_issue(a, (size_t)bh * 32 + n + 2, n + 2, lds, wid - 4, lane); }
        else {
            const LAS unsigned char* sb = lds + (n % 3) * G2_SLOT;
            const float gam = a.ggam()[(size_t)bh * 32 + n];
            bf16x8 Sb[2]; Sb[0] = pack_acc2(S[0], S[1]); Sb[1] = pack_acc2(S[2], S[3]);
            f32x4 Vn[4];
#pragma unroll
            for (int mt = 0; mt < 4; ++mt) Vn[mt] = *(const LAS f32x4*)(sb + 32768 + (16 * sl + i16) * 256 + 16 * ((4 * mt + q4) ^ i16));
#pragma unroll
            for (int mt = 0; mt < 4; ++mt)
#pragma unroll
                for (int ks = 0; ks < 2; ++ks) Vn[mt] = __builtin_amdgcn_mfma_f32_16x16x32_bf16(*(const LAS bf16x8*)(sb + (16 * mt + i16) * 128 + 16 * ((4 * ks + q4) ^ (i16 & 7))), Sb[ks], Vn[mt], 0, 0, 0);
            bf16x8 Vb[2]; Vb[0] = pack_acc2(Vn[0], Vn[1]); Vb[1] = pack_acc2(Vn[2], Vn[3]);
            f32x4 O[4];
#pragma unroll
            for (int mt = 0; mt < 4; ++mt) {
                O[mt] = (f32x4){0.f, 0.f, 0.f, 0.f};
#pragma unroll
                for (int ks = 0; ks < 2; ++ks) {
                    const int fo = (16 * mt + i16) * 128 + 16 * ((4 * ks + q4) ^ (i16 & 7));
                    O[mt] = __builtin_amdgcn_mfma_f32_16x16x32_bf16(*(const LAS bf16x8*)(sb + 8192 + fo), Sb[ks], O[mt], 0, 0, 0);
                    O[mt] = __builtin_amdgcn_mfma_f32_16x16x32_bf16(*(const LAS bf16x8*)(sb + 16384 + fo), Vb[ks], O[mt], 0, 0, 0);
                }
            }
#pragma unroll
            for (int mt = 0; mt < 4; ++mt) {
                S[mt] = S[mt] * gam;
#pragma unroll
                for (int ks = 0; ks < 2; ++ks) S[mt] = __builtin_amdgcn_mfma_f32_16x16x32_bf16(*(const LAS bf16x8*)(sb + 24576 + (16 * mt + i16) * 128 + 16 * ((4 * ks + q4) ^ (i16 & 7))), Vb[ks], S[mt], 0, 0, 0);
            }
            float* og = a.goraw() + ((size_t)b * SEQ + n * 64 + 4 * q4) * 512 + h * 64 + 16 * sl + i16;
#pragma unroll
            for (int mt = 0; mt < 4; ++mt)
#pragma unroll
                for (int r = 0; r < 4; ++r) og[(size_t)(16 * mt + r) * 512] = O[mt][r];
        }
    }
    if (!loader) {
        float* so = a.out + O_GSP + ((size_t)bh * 64 + 4 * q4) * 64 + 16 * sl + i16;
#pragma unroll
        for (int mt = 0; mt < 4; ++mt)
#pragma unroll
            for (int r = 0; r < 4; ++r) so[(size_t)(16 * mt + r) * 64] = S[mt][r];
    }
    __syncthreads();
}
__device__ __forceinline__ void gdn_out_token(const MK& a, int row, int lane) {
    const float* op = a.goraw() + (size_t)row * 512 + 8 * lane;
    const float4 x0 = *(const float4*)op, x1 = *(const float4*)(op + 4);
    float o[8] = {x0.x, x0.y, x0.z, x0.w, x1.x, x1.y, x1.z, x1.w}, zg[8];
    bf8_to_f32(*(const bf16x8*)(a.Z() + (size_t)row * ZW + OFF_Z + 8 * lane), zg);
    float ss = 0.f;
#pragma unroll
    for (int e = 0; e < 8; ++e) ss += o[e] * o[e];
    ss += __shfl_xor(ss, 1); ss += __shfl_xor(ss, 2); ss += __shfl_xor(ss, 4);
    const float rs = rsqrtf(ss * (1.f / 64.f) + EPSV);
    const float4 g0 = *(const float4*)(a.g_gdn_out + 8 * (lane & 7)), g1 = *(const float4*)(a.g_gdn_out + 8 * (lane & 7) + 4);
    const float gg_[8] = {g0.x, g0.y, g0.z, g0.w, g1.x, g1.y, g1.z, g1.w};
#pragma unroll
    for (int e = 0; e < 8; ++e) o[e] = o[e] * rs * gg_[e] * zg[e] * fast_sigmoid(zg[e]);
    *(bf16x8*)(a.omix() + (size_t)row * 1024 + 8 * lane) = f32_to_bf8(o);
}

#define SSLOT 32768
#define TL_OFF (3 * SSLOT)
#define CST 264
#define KR_OFF (TL_OFF + 2 * 32 * CST * 2)
#define WQ_OFF (KR_OFF + 4 * 4096)
#define QR_OFF (WQ_OFF + 2048)
#define PG_OFF (QR_OFF + 1024)
#define PT_OFF (PG_OFF + 64)
#define AL_OFF (PT_OFF + 1024)
#define SAMP_LDS_END (AL_OFF + 64)
__device__ __forceinline__ void samp_issue(const MK& a, int g, LAS unsigned char* lds, int wid, int lane) {
    const int phys = __builtin_amdgcn_readfirstlane(((const LAS int*)(lds + PG_OFF))[g >> 2]);
    const int tok0 = (g & 3) * 32 + 4 * wid;
    const float* cs = a.cache_ckv + ((size_t)phys * 128 + tok0) * 256 + lane * 4;
#pragma unroll
    for (int i = 0; i < 4; ++i) __builtin_amdgcn_global_load_lds((const unsigned*)(cs + i * 256), (LAS unsigned*)(lds + (g % 3) * SSLOT + (4 * wid + i) * 1024), 16, 0, 0);
    if (wid < 4) __builtin_amdgcn_global_load_lds((const unsigned*)(a.cache_krope + ((size_t)phys * 128 + (g & 3) * 32 + 8 * wid) * 32 + lane * 4), (LAS unsigned*)(lds + KR_OFF + (g & 3) * 4096 + wid * 1024), 16, 0, 0);
}
__device__ __forceinline__ void samp_convert(int g, LAS unsigned char* lds, int tid) {
    const int st = tid >> 4, c16 = (tid & 15) * 16;
    const LAS float* src = (const LAS float*)(lds + (g % 3) * SSLOT) + st * 256 + c16;
    const f32x4 x0 = *(const LAS f32x4*)src, x1 = *(const LAS f32x4*)(src + 4), x2 = *(const LAS f32x4*)(src + 8), x3 = *(const LAS f32x4*)(src + 12);
    u32x4 w0, w1; w0.x = cvtpk(x0[0], x0[1]); w0.y = cvtpk(x0[2], x0[3]); w0.z = cvtpk(x1[0], x1[1]); w0.w = cvtpk(x1[2], x1[3]);
    w1.x = cvtpk(x2[0], x2[1]); w1.y = cvtpk(x2[2], x2[3]); w1.z = cvtpk(x3[0], x3[1]); w1.w = cvtpk(x3[2], x3[3]);
    LAS bf16_t* dst = (LAS bf16_t*)(lds + TL_OFF + (g & 1) * 32 * CST * 2) + st * CST + c16;
    *(LAS u32x4*)dst = w0; *(LAS u32x4*)(dst + 8) = w1;
}
#define SAMP_WAITV(n5, n4) do { if (h < 4) asm volatile("s_waitcnt vmcnt(" #n5 ")" ::: "memory"); else asm volatile("s_waitcnt vmcnt(" #n4 ")" ::: "memory"); } while (0)
#define SAMP_BAR() do { asm volatile("s_waitcnt lgkmcnt(0)" ::: "memory"); __builtin_amdgcn_s_barrier(); asm volatile("" ::: "memory"); } while (0)
__device__ __forceinline__ void samp_attn_unit(const MK& a, int u, char* smem, LAS unsigned char* lds) {
    const int tid = otid(), lane = tid & 63, h = __builtin_amdgcn_readfirstlane(tid >> 6), i16 = lane & 15, q4 = lane >> 4;
    const int b = u >> 3, sp = u & 7;
    float* WQ = (float*)(smem + WQ_OFF);
    float* QR = (float*)(smem + QR_OFF);
    int* PG = (int*)(smem + PG_OFF);
    const float SCL = 0.14724445f;
    post_q_item(a, (NPT + b) * 8 + h, lane);
    __syncthreads();
    {
        const int h_ = tid >> 6, l_ = tid & 63, q4_ = l_ >> 4, idx = l_ & 15, d = 16 * (idx >> 2) + 4 * q4_ + (idx & 3);
        WQ[tid] = a.g_k_nope[d] * a.qh()[((size_t)(NPT + b) * 8 + h_) * 96 + d] * SCL;
        if (tid < 256) QR[tid] = a.qh()[((size_t)(NPT + b) * 8 + (tid >> 5)) * 96 + 64 + (tid & 31)] * SCL;
        if (tid < 16) PG[tid] = a.page_table[b * NPAGES + sp * 16 + tid];
    }
    bf16x8 wf[4][8];
#pragma unroll
    for (int mt = 0; mt < 4; ++mt)
#pragma unroll
        for (int ks = 0; ks < 8; ++ks) wf[mt][ks] = *(const bf16x8*)(a.WknT() + (size_t)(h * 64 + 16 * mt + i16) * 256 + 32 * ks + 8 * q4);
#pragma unroll
    for (int mt = 0; mt < 4; ++mt)
#pragma unroll
        for (int ks = 0; ks < 8; ++ks) asm volatile("" : "+v"(wf[mt][ks]));
    __syncthreads();
    samp_issue(a, 0, lds, h, lane); samp_issue(a, 1, lds, h, lane); samp_issue(a, 2, lds, h, lane);
    SAMP_WAITV(10, 8);
    SAMP_BAR();
    samp_convert(0, lds, tid);
    const LAS float* QRl = (const LAS float*)(lds + QR_OFF) + h * 32 + 8 * q4;
    const LAS float* WQl = (const LAS float*)(lds + WQ_OFF) + (h * 4 + q4) * 16;
    float m = -INFINITY, lsum = 0.f;
    f32x4 latv[2]; latv[0] = (f32x4){0.f, 0.f, 0.f, 0.f}; latv[1] = (f32x4){0.f, 0.f, 0.f, 0.f};
    for (int g = 0; g < 64; ++g) {
        SAMP_BAR();
        if (g + 3 < 64) samp_issue(a, g + 3, lds, h, lane);
        const LAS bf16_t* Tl = (const LAS bf16_t*)(lds + TL_OFF + (g & 1) * 32 * CST * 2); const LAS float* KR = (const LAS float*)(lds + KR_OFF + (g & 3) * 4096);
        float sc[2];
        {
            f32x4 acc[2][4];
#pragma unroll
            for (int hf = 0; hf < 2; ++hf)
#pragma unroll
                for (int mt = 0; mt < 4; ++mt) acc[hf][mt] = (f32x4){0.f, 0.f, 0.f, 0.f};
            const LAS bf16_t* cp0 = Tl + i16 * CST + 8 * q4; const LAS bf16_t* cp1 = cp0 + 16 * CST;
            bf16x8 c0 = *(const LAS bf16x8*)cp0, c1 = *(const LAS bf16x8*)cp1;
#pragma unroll
            for (int ks = 0; ks < 8; ++ks) {
                bf16x8 n0 = c0, n1 = c1;
                if (ks < 7) { n0 = *(const LAS bf16x8*)(cp0 + 32 * (ks + 1)); n1 = *(const LAS bf16x8*)(cp1 + 32 * (ks + 1)); }
#pragma unroll
                for (int mt = 0; mt < 4; ++mt) { acc[0][mt] = __builtin_amdgcn_mfma_f32_16x16x32_bf16(wf[mt][ks], c0, acc[0][mt], 0, 0, 0); acc[1][mt] = __builtin_amdgcn_mfma_f32_16x16x32_bf16(wf[mt][ks], c1, acc[1][mt], 0, 0, 0); }
                c0 = n0; c1 = n1;
            }
#pragma unroll
            for (int hf = 0; hf < 2; ++hf) {
                float ss = 0.f, dot = 0.f, rd = 0.f;
#pragma unroll
                for (int mt = 0; mt < 4; ++mt) {
                    const f32x4 wq = *(const LAS f32x4*)(WQl + 4 * mt);
                    ss += acc[hf][mt][0] * acc[hf][mt][0] + acc[hf][mt][1] * acc[hf][mt][1] + acc[hf][mt][2] * acc[hf][mt][2] + acc[hf][mt][3] * acc[hf][mt][3];
                    dot += acc[hf][mt][0] * wq[0] + acc[hf][mt][1] * wq[1] + acc[hf][mt][2] * wq[2] + acc[hf][mt][3] * wq[3];
                }
                {
                    const LAS float* kp = KR + (16 * hf + i16) * 32 + 8 * q4;
                    const f32x4 k0 = *(const LAS f32x4*)kp, k1 = *(const LAS f32x4*)(kp + 4), q0 = *(const LAS f32x4*)QRl, q1 = *(const LAS f32x4*)(QRl + 4);
                    rd = k0[0] * q0[0] + k0[1] * q0[1] + k0[2] * q0[2] + k0[3] * q0[3] + k1[0] * q1[0] + k1[1] * q1[1] + k1[2] * q1[2] + k1[3] * q1[3];
                }
                ss += __shfl_xor(ss, 16); dot += __shfl_xor(dot, 16); rd += __shfl_xor(rd, 16);
                ss += __shfl_xor(ss, 32); dot += __shfl_xor(dot, 32); rd += __shfl_xor(rd, 32);
                sc[hf] = dot * rsqrtf(ss * (1.f / 64.f) + EPSV) + rd;
            }
        }
        float gm = fmaxf(sc[0], sc[1]);
#pragma unroll
        for (int o = 1; o < 16; o <<= 1) gm = fmaxf(gm, __shfl_xor(gm, o));
        const float mn = fmaxf(m, gm);
        const float alpha = __builtin_amdgcn_exp2f(m - mn), p0 = __builtin_amdgcn_exp2f(sc[0] - mn), p1 = __builtin_amdgcn_exp2f(sc[1] - mn);
        m = mn;
        lsum = lsum * alpha + p0 + p1;
        if (q4 == 0) { ((LAS float*)(lds + PT_OFF))[h * 32 + i16] = p0; ((LAS float*)(lds + PT_OFF))[h * 32 + 16 + i16] = p1; if (i16 == 0) ((LAS float*)(lds + AL_OFF))[h] = alpha; }
        if (g <= 60) SAMP_WAITV(10, 8); else if (g == 61) SAMP_WAITV(5, 4); else SAMP_WAITV(0, 0);
        SAMP_BAR();
        {
            u32x4 pw = {0u, 0u, 0u, 0u};
            if (i16 < 8) { const f32x4 pa = *(const LAS f32x4*)(lds + PT_OFF + (i16 * 32 + 8 * q4) * 4), pb_ = *(const LAS f32x4*)(lds + PT_OFF + (i16 * 32 + 8 * q4 + 4) * 4);
                pw.x = cvtpk(pa[0], pa[1]); pw.y = cvtpk(pa[2], pa[3]); pw.z = cvtpk(pb_[0], pb_[1]); pw.w = cvtpk(pb_[2], pb_[3]); }
            const bf16x8 pfr = __builtin_bit_cast(bf16x8, pw);
            const f32x4 al = *(const LAS f32x4*)(lds + AL_OFF + (q4 & 1) * 16);
            const bf16_t* tb0 = (const bf16_t*)(smem + TL_OFF + (g & 1) * 32 * CST * 2) + (8 * q4 + (i16 >> 2)) * CST + 32 * h + 4 * (i16 & 3);
#pragma unroll
            for (int nt = 0; nt < 2; ++nt) {
                const s16x4 c0 = tr_read(tb0 + 16 * nt), c1 = tr_read(tb0 + 16 * nt + 4 * CST);
                const bf16x8 cfr = __builtin_shufflevector(c0, c1, 0, 1, 2, 3, 4, 5, 6, 7);
                latv[nt] = latv[nt] * al;
                latv[nt] = __builtin_amdgcn_mfma_f32_16x16x32_bf16(pfr, cfr, latv[nt], 0, 0, 0);
            }
        }
        if (g + 1 < 64) samp_convert(g + 1, lds, tid);
    }
#pragma unroll
    for (int o = 1; o < 16; o <<= 1) lsum += __shfl_xor(lsum, o);
    if (lane == 0) { float* o = a.part() + ((size_t)u * 8 + h) * 260; o[0] = m * 0.69314718f; o[1] = lsum; }
    if (q4 < 2) {
#pragma unroll
        for (int nt = 0; nt < 2; ++nt)
#pragma unroll
            for (int r = 0; r < 4; ++r) a.part()[((size_t)u * 8 + 4 * q4 + r) * 260 + 4 + 32 * h + 16 * nt + i16] = latv[nt][r];
    }
}
__device__ __forceinline__ void samp_comb_unit(const MK& a, int u, char* smem) {
    float* slat = (float*)smem;
    const int b = u >> 3, h = u & 7, tid = otid() & 255;
    const size_t row = NPT + b;
    const float* q = a.qh() + (row * 8 + h) * 96;
    float s_self = 0.f;
    for (int d = 0; d < 64; ++d) s_self += q[d] * a.kh()[(row * 8 + h) * 64 + d];
    for (int d = 0; d < 32; ++d) s_self += q[64 + d] * a.krf()[row * 32 + d];
    s_self *= 0.10206207261596577f;
    float m = s_self;
    for (int s = 0; s < 8; ++s) m = fmaxf(m, a.part()[((size_t)(b * 8 + s) * 8 + h) * 260]);
    const float pself = expf(s_self - m);
    float l = pself, lat = 0.f;
    for (int s = 0; s < 8; ++s) {
        const float* p = a.part() + ((size_t)(b * 8 + s) * 8 + h) * 260;
        const float w = expf(p[0] - m);
        l += p[1] * w; lat += p[4 + tid] * w;
    }
    __syncthreads();
    slat[tid] = lat;
    __syncthreads();
    if (tid < 64) {
        float o = 0.f;
        for (int c = 0; c < 256; ++c) o += slat[c] * a.w_kv_b[(size_t)c * 1024 + h * 128 + 64 + tid];
        o += pself * a.KV()[row * 1024 + h * 128 + 64 + tid];
        a.omix()[row * 1024 + 512 + h * 64 + tid] = f2bf(o / l);
    }
}

#define XB_TMO      128
#define XB_XCNT(j)  (256  + 64 * (j))
#define XB_XSUB(j)  (1280 + 64 * (j))
#define XB_XGEN(j)  (2304 + 64 * (j))
#define XB_TOP      3328
#define XB_TOPGEN   3392
#define XCD_BAR_WORDS 3456
#define XB_SPIN_CAP (1u << 18)

__device__ __forceinline__ unsigned xb_ld(unsigned* p)              { return __hip_atomic_load(p, __ATOMIC_RELAXED, __HIP_MEMORY_SCOPE_AGENT); }
__device__ __forceinline__ unsigned xb_add(unsigned* p, unsigned v) { return __hip_atomic_fetch_add(p, v, __ATOMIC_RELAXED, __HIP_MEMORY_SCOPE_AGENT); }
__device__ __forceinline__ unsigned xb_xcc_id() { return (unsigned)__builtin_amdgcn_s_getreg((3 << 11) | 20) & 0xFu; }
#define XB_SPIN(cond, bar) do { unsigned _sp = 0; while (cond) { __builtin_amdgcn_s_sleep(1); \
    if ((++_sp & 255u) == 0u) { if (xb_ld(&(bar)[XB_TMO])) break; if (_sp > XB_SPIN_CAP) { atomicAdd(&(bar)[XB_TMO], 1u); break; } } } } while (0)

struct XcdBarrier {
    unsigned* bar; unsigned x;
    volatile LAS unsigned* st;
};

__device__ __forceinline__ XcdBarrier xcd_barrier_post(unsigned* bar, volatile LAS unsigned* st) {
    XcdBarrier b; b.bar = bar; b.x = xb_xcc_id(); b.st = st;
    if (threadIdx.x == 0) (void)xb_add(&bar[XB_XCNT(b.x)], 1u);
    return b;
}
__device__ __forceinline__ void xcd_barrier_complete(unsigned* bar, unsigned x, unsigned& nloc, unsigned& nx) {
    const unsigned G = gridDim.x * gridDim.y * gridDim.z;
    unsigned sum, cnt, mine, sp = 0u;
    for (;;) {
        sum = 0u; cnt = 0u; mine = 0u;
#pragma unroll
        for (unsigned j = 0; j < 16; ++j) { const unsigned c = xb_ld(&bar[XB_XCNT(j)]); sum += c; cnt += (c > 0u) ? 1u : 0u; mine = (j == x) ? c : mine; }
        if (sum == G) break;
        __builtin_amdgcn_s_sleep(1);
        if ((++sp & 255u) == 0u) { if (xb_ld(&bar[XB_TMO])) break; if (sp > XB_SPIN_CAP) { atomicAdd(&bar[XB_TMO], 1u); break; } }
    }
    nloc = mine > 0u ? mine : 1u; nx = cnt > 0u ? cnt : 1u;
}

__device__ __forceinline__ void xcd_barrier(const XcdBarrier& b) {
    asm volatile("s_waitcnt vmcnt(0)" ::: "memory");
    __syncthreads();
    if (threadIdx.x == 0) {
        unsigned* bar = b.bar;
        __builtin_amdgcn_s_waitcnt(0);
        unsigned nloc = b.st[0], nx = b.st[1];
        if (nloc == 0u) { xcd_barrier_complete(bar, b.x, nloc, nx); b.st[0] = nloc; b.st[1] = nx; }
        const unsigned old = xb_add(&bar[XB_XSUB(b.x)], 1u);
        const unsigned gen = old / nloc;
        if (old + 1u == (gen + 1u) * nloc) {
            __builtin_amdgcn_fence(__ATOMIC_RELEASE, "agent");
            asm volatile("s_waitcnt vmcnt(0)" ::: "memory");
            const unsigned og = xb_add(&bar[XB_TOP], 1u);
            const unsigned tg = og / nx;
            if (og + 1u == (tg + 1u) * nx) xb_add(&bar[XB_TOPGEN], 1u);
            else XB_SPIN(xb_ld(&bar[XB_TOPGEN]) == tg, bar);
            __builtin_amdgcn_fence(__ATOMIC_ACQUIRE, "agent");
            xb_add(&bar[XB_XGEN(b.x)], 1u);
            asm volatile("s_waitcnt vmcnt(0)" ::: "memory");
        } else {
            XB_SPIN(xb_ld(&bar[XB_XGEN(b.x)]) == gen, bar);
            __builtin_amdgcn_fence(__ATOMIC_ACQUIRE, "agent");
            asm volatile("s_waitcnt vmcnt(0)" ::: "memory");
        }
    }
    __syncthreads();
}

__device__ __forceinline__ void late_weight_items(const MK& a, int gwl, int ngwl, float* scr, int lane) {
    const int T4 = 32 * 16, T5 = 176 * 16, T7 = 32 * 44, T8 = 32 * 16, TT = T4 + T5 + T7 + T8;
    for (int it = gwl; it < TT; it += ngwl) {
        int r = it;
        if (r < T4) { const int nt_ = r % 32, kb = r / 32; wt_item(a.w_o, 1024, 32 * nt_, 32, a.WoT(), 1024, 32 * nt_, 64 * kb, scr, lane); continue; } r -= T4;
        if (r < T5) { const int nt_ = r % 176, kb = r / 176, pn = nt_ >> 3, wi = nt_ & 7;
            wt_item(wi < 4 ? a.w_gate : a.w_up, DFF, pn * 128 + (wi & 3) * 32, 32, a.WguT(), 1024, 32 * nt_, 64 * kb, scr, lane); continue; } r -= T5;
        if (r < T7) { const int nt_ = r % 32, kb = r / 32; wt_item(a.w_down, 1024, 32 * nt_, 32, a.WdT(), DFF, 32 * nt_, 64 * kb, scr, lane); continue; } r -= T7;
        { const int nt_ = r % 32, kb = r / 32; wt_item(a.w_ple_gate, 1024, 32 * nt_, 32, a.WpgT(), 1024, 32 * nt_, 64 * kb, scr, lane); }
    }
}

#define XB_ST_OFF 155648
#define LDS_BYTES 155904
static_assert(SAMP_LDS_END <= LDS_BYTES, "LDS map");
#define GSYNC() do { xcd_barrier(xbar); } while (0)
__global__ __launch_bounds__(NTHR, 2) void mega(MK a) {
    cg::grid_group grid = cg::this_grid();
    char* smem = (char*)lds_raw;
    LAS unsigned char* lds = (LAS unsigned char*)lds_raw;
    otid_init();
    if (threadIdx.x < 2) ((LAS unsigned*)(lds_raw + XB_ST_OFF))[threadIdx.x] = 0u;
    __syncthreads();
    const XcdBarrier xbar = xcd_barrier_post(a.ctl(), (volatile LAS unsigned*)(LAS void*)(lds_raw + XB_ST_OFF));
    const int bid = blockIdx.x, nb = gridDim.x, ngw = nb * NWAVE;
#define LOCAL_IDS const int tid = otid(), lane = tid & 63, wid = tid >> 6, half = tid >> 8, gw = bid * NWAVE + wid; (void)lane; (void)half; (void)gw; (void)wid;

    {
    LOCAL_IDS
    {
        const int T0 = 88 * 16, T1 = 24 * 6, T2 = 32 * 4, T3 = 16 * 4, T9 = 32 * 4;
        const int TT = T0 + T1 + T2 + T3 + T9;
        float* scr = (float*)(smem + wid * 8704);
        for (int it = gw; it < TT; it += ngw) {
            int r = it;
            if (r < T0) { const int nt_ = r % 88, kb = r / 88, nv = 2736 - 32 * nt_; wt_item(a.w_in, 2736, 32 * nt_, nv < 0 ? 0 : (nv > 32 ? 32 : nv), a.WinT(), 1024, 32 * nt_, 64 * kb, scr, lane); continue; } r -= T0;
            if (r < T1) { const int nt_ = r % 24, kb = r / 24; wt_item(a.w_q_b, 768, 32 * nt_, 32, a.WqbT(), 384, 32 * nt_, 64 * kb, scr, lane); continue; } r -= T1;
            if (r < T2) { const int nt_ = r % 32, kb = r / 32; wt_item(a.w_kv_b, 1024, 32 * nt_, 32, a.WkvT(), 256, 32 * nt_, 64 * kb, scr, lane); continue; } r -= T2;
            if (r < T3) { const int nt_ = r % 16, kb = r / 16, h = nt_ >> 1; wt_item(a.w_kv_b, 1024, h * 128 + 32 * (nt_ & 1), 32, a.WknT(), 256, 32 * nt_, 64 * kb, scr, lane); continue; } r -= T3;
            { const int nt_ = r % 32, kb = r / 32; wt_item(a.w_ple_proj, 1024, 32 * nt_, 32, a.WppT(), 256, 32 * nt_, 64 * kb, scr, lane); }
        }
        for (int e = (bid * NTHR + tid); e < 2049 * 16; e += nb * NTHR) {
            const int pos = e >> 4, i = e & 15; const float ang = (pos == 2048 ? (float)PAST : (float)pos) * powf(10000.f, -(float)i / 16.f);
            a.ropecs()[pos * 32 + i] = cosf(ang); a.ropecs()[pos * 32 + 16 + i] = sinf(ang);
        }
        for (int row = gw; row < MPAD; row += ngw) {
            const float* src = row < NPT ? a.x_prompt + (size_t)row * 1024 : a.x_sample + (size_t)(row < NTOK ? row - NPT : 0) * 1024;
            rms1024_row(src, a.g_attn, a.xn() + (size_t)row * 1024, row >= NTOK, lane);
            ushort4 w = {0, 0, 0, 0};
            if (row < NTOK) { const float* ps = row < NPT ? a.p_prompt + (size_t)row * 256 : a.p_sample + (size_t)(row - NPT) * 256; const float4 v = *(const float4*)(ps + lane * 4); w.x = f2bf(v.x); w.y = f2bf(v.y); w.z = f2bf(v.z); w.w = f2bf(v.w); }
            *(ushort4*)(a.pb() + (size_t)row * 256 + lane * 4) = w;
            if (row >= NTOK) { for (int j = 0; j < 4; ++j) { ushort4 z = {0, 0, 0, 0}; *(ushort4*)(a.omix() + (size_t)row * 1024 + lane * 4 + 256 * j) = z; } }
        }
    }
    }
    if (a.out == nullptr) grid.sync();
    GSYNC();
    {
    LOCAL_IDS
    pg_gemm(lds, a.xn(), a.WinT(), NPT, ZW, 1024, PgBf16{a.Z(), ZW});
    gemm_sample_rows_ks<false>(a.xn(), 1024, a.WinT(), 1024, ZW, EwBf16{a.Z(), ZW}, smem, bid, nb);
    }
    GSYNC();
    {
    LOCAL_IDS
    for (int e = tid; e < 4 * 1536 / 4; e += NTHR) ((float4*)smem)[e] = ((const float4*)a.w_conv)[e];
    __syncthreads();
    for (int run = gw; run < NPT / 8 + NST; run += ngw) post_in_run(a, run, lane, (const float*)smem);
    }
    GSYNC();
    {
    LOCAL_IDS
    for (int u = gw; u < 2048; u += ngw) gdn_prep_unit(a, u, lane, smem + wid * GDN_WLDS);
    }
    {
    LOCAL_IDS
    for (int v = gw; v < NST * 64; v += ngw) gdn_unit(a, v >> 6, (v >> 3) & 7, v & 7, a.state_gdn, a.out + O_GSS, NPT, 1, lane, smem + wid * GDN_WLDS);
    __syncthreads();
    }
    GSYNC();
    {
    LOCAL_IDS
    pg_gemm(lds, a.qan(), a.WqbT(), NPT, 768, 384, PgBf16{a.qraw(), 768});
    pg_gemm(lds, a.ckvb(), a.WkvT(), NPT, 1024, 256, PgBf16{a.kvraw(), 1024});
    gemm_sample_rows<false>(a.qan(), 384, a.WqbT(), 384, 768, EwF32{a.Q(), 768}, smem, bid, nb);
    gemm_sample_rows<false>(a.ckvb(), 256, a.WkvT(), 256, 1024, EwF32{a.KV(), 1024}, smem, bid, nb);
    for (int bh_ = nb - 1 - bid; bh_ < 64; bh_ += nb) gdn_scan_block(a, bh_, lds);
    if (nb > 64 && bid < nb - 64) {
        pg_gemm(lds, a.pb(), a.WppT(), NPT, 1024, 256, PgBf16{a.PP(), 1024}, nb - 64);
        __syncthreads();
        late_weight_items(a, bid * NWAVE + wid, (nb - 64) * NWAVE, (float*)(smem + wid * 8704), lane);
    } else if (nb <= 64) { pg_gemm(lds, a.pb(), a.WppT(), NPT, 1024, 256, PgBf16{a.PP(), 1024}); __syncthreads(); late_weight_items(a, gw, ngw, (float*)(smem + wid * 8704), lane); }
    gemm_sample_rows<false>(a.pb(), 256, a.WppT(), 256, 1024, EwBf16{a.PP(), 1024}, smem, bid, nb);
    }
    GSYNC();
    {
    LOCAL_IDS
    for (int idx = gw; idx < NST * 8; idx += ngw) { post_q_item(a, NPT * 8 + idx, lane); post_kv_item(a, NPT * 8 + idx, lane); }
    for (int row = gw; row < NTOK; row += ngw) gdn_out_token(a, row, lane);
    for (int pr = bid; pr < 256; pr += nb) { const int bh_ = pr >> 2, s_ = pr & 3; attn_block(a, bh_ >> 3, bh_ & 7, 7 - s_, smem); attn_block(a, bh_ >> 3, bh_ & 7, s_, smem); }
    for (int u = bid; u < NST * 8; u += nb) samp_attn_unit(a, u, smem, lds);
    }
    GSYNC();
    {
    LOCAL_IDS
    for (int u0 = bid * 2; u0 < NST * 8; u0 += nb * 2) samp_comb_unit(a, u0 + half, smem + half * 4096);
    }
    GSYNC();
    {
    LOCAL_IDS
    pg_gemm(lds, a.omix(), a.WoT(), NPT, 1024, 1024, PgResXB{a.x_prompt, a.H()});
    gemm_sample_rows_ks<false>(a.omix(), 1024, a.WoT(), 1024, 1024, EwResX{a.x_sample, a.H()}, smem, bid, nb);
    }
    GSYNC();
    {
    LOCAL_IDS
    for (int row = gw; row < MPAD; row += ngw) rms1024_row_b(a.H() + (size_t)row * 1024, a.g_ffn, a.un() + (size_t)row * 1024, row >= NTOK, lane);
    }
    GSYNC();
    {
    LOCAL_IDS
    pg_gemm(lds, a.un(), a.WguT(), NPT, 2 * DFF, 1024, PgSwiglu{a.hid()});
    gemm_sample_rows_ks<true>(a.un(), 1024, a.WguT(), 1024, 2 * DFF, EwBf16{a.hid(), DFF}, smem, bid, nb);
    }
    GSYNC();
    {
    LOCAL_IDS
    pg_gemm(lds, a.hid(), a.WdT(), NPT, 1024, DFF, PgResBB{a.H(), a.H2()});
    gemm_sample_rows_ks<false>(a.hid(), DFF, a.WdT(), DFF, 1024, EwResH{a.H(), a.H2()}, smem, bid, nb);
    }
    GSYNC();
    {
    LOCAL_IDS
    for (int row = gw; row < MPAD; row += ngw) rms1024_row_b(a.H2() + (size_t)row * 1024, a.g_ple, a.un2() + (size_t)row * 1024, row >= NTOK, lane);
    }
    GSYNC();
    {
    LOCAL_IDS
    pg_gemm(lds, a.un2(), a.WpgT(), NPT, 1024, 1024, PgPleB{a.H2(), a.PP(), a.out});
    gemm_sample_rows_ks<false>(a.un2(), 1024, a.WpgT(), 1024, 1024, EwPle{a.H2(), a.PP(), a.out}, smem, bid, nb);
    }
}

static inline char* carve(char*& p, size_t bytes) { char* r = p; p += (bytes + 255) & ~(size_t)255; return r; }

extern "C" void kernel_launch(void* const* d_in, const int* in_sizes, int n_in, void* d_out, int out_size, void* d_ws, size_t ws_size, hipStream_t stream) {
    MK a{};
    a.x_prompt = (const float*)d_in[0]; a.x_sample = (const float*)d_in[1]; a.cache_ckv = (const float*)d_in[2]; a.cache_krope = (const float*)d_in[3];
    a.state_gdn = (const float*)d_in[4]; a.state_conv = (const float*)d_in[5]; a.page_table = (const int*)d_in[6]; a.p_prompt = (const float*)d_in[7]; a.p_sample = (const float*)d_in[8];
    a.g_attn = (const float*)d_in[9]; a.w_in = (const float*)d_in[10]; a.w_conv = (const float*)d_in[11]; a.a_log = (const float*)d_in[12]; a.dt_bias = (const float*)d_in[13];
    a.g_gdn_out = (const float*)d_in[14]; a.g_q_a = (const float*)d_in[15]; a.w_q_b = (const float*)d_in[16]; a.g_q_nope = (const float*)d_in[17]; a.g_q_rope = (const float*)d_in[18];
    a.g_kv_a = (const float*)d_in[19]; a.g_k_rope = (const float*)d_in[20]; a.w_kv_b = (const float*)d_in[21]; a.g_k_nope = (const float*)d_in[22]; a.w_o = (const float*)d_in[23];
    a.g_ffn = (const float*)d_in[24]; a.w_gate = (const float*)d_in[25]; a.w_up = (const float*)d_in[26]; a.w_down = (const float*)d_in[27]; a.g_ple = (const float*)d_in[28];
    a.w_ple_gate = (const float*)d_in[29]; a.w_ple_proj = (const float*)d_in[30];
    a.out = (float*)d_out;
    a.ws = (char*)d_ws;
    if (WS_TOTAL > ws_size) { fprintf(stderr, "kernel_launch: workspace too small: need %zu have %zu\n", (size_t)WS_TOTAL, ws_size); return; }

    static int grid_blocks = 0;
    if (!grid_blocks) {
        int dev = 0, cus = 0, per_cu = 0;
        (void)hipGetDevice(&dev);
        (void)hipDeviceGetAttribute(&cus, hipDeviceAttributeMultiprocessorCount, dev);
        (void)hipFuncSetAttribute((const void*)mega, hipFuncAttributeMaxDynamicSharedMemorySize, LDS_BYTES);
        (void)hipOccupancyMaxActiveBlocksPerMultiprocessor(&per_cu, (const void*)mega, NTHR, LDS_BYTES);
        if (per_cu < 1) fprintf(stderr, "kernel_launch: occupancy query says %d blocks/CU\n", per_cu);
        grid_blocks = cus;
    }
    (void)hipMemsetAsync((char*)d_ws + WOF_ctl, 0, 16384, stream);
    void* args[] = {&a};
    hipError_t e = hipLaunchCooperativeKernel((const void*)mega, dim3(grid_blocks), dim3(NTHR), args, LDS_BYTES, stream);
    if (e != hipSuccess) fprintf(stderr, "cooperative launch failed: %s (grid %d)\n", hipGetErrorString(e), grid_blocks);
}
```

```cpp
#include <hip/hip_runtime.h>
#include <stdint.h>
#include <cstdio>
#include <hip/hip_cooperative_groups.h>
namespace cg = cooperative_groups;


__device__ __forceinline__ int otid();
#define PG8_TID() otid()
namespace pg8 {
#define PG8_LAS __attribute__((address_space(3)))
typedef unsigned short bf16_t;
typedef short bf16x8 __attribute__((ext_vector_type(8)));
typedef float f32x4 __attribute__((ext_vector_type(4)));
typedef unsigned u32x4 __attribute__((ext_vector_type(4)));
constexpr int BM = 256, BK = 64, HALF = 128, HTB = HALF * BK * 2  , STAGE_BYTES = 8 * HTB, NXCD = 8, WGM = 8;

__host__ __device__ __forceinline__ int lds_byte(int r, int c) { const int st = (r >> 4) * 2 + (c >> 5), rr = r & 15, cc = c & 31, ob = rr * 64 + cc * 2; return st * 1024 + (ob ^ (((ob >> 9) & 1) << 5)); }
__host__ __device__ __forceinline__ void stage_rc(int b, int& R, int& C) { const int st = b / 1024, sb = b % 1024, swz = sb ^ (((sb >> 9) & 1) << 5); R = (st >> 1) * 16 + swz / 64; C = (st & 1) * 32 + (swz % 64) / 2; }
__host__ __device__ __forceinline__ int perm32(int rho) { const int n = rho >> 4, i = rho & 15; return 8 * (i >> 2) + 4 * n + (i & 3); }

struct Unit { int pm, pn; };
struct Gemm { const bf16_t* A; const bf16_t* Bt; int M, N, K; };

struct StaticOrder {
    int nM, nN, nwg, G, c;
    __host__ __device__ void init(int M, int N, int G_, int c_) { nM = M / BM; nN = N / BM; nwg = nM * nN; G = G_; c = c_; }
    __host__ __device__ bool next(int i, Unit& u) const {
        const long L = (long)i * G + c; if (L >= nwg) return false;
        int wgid = (int)L; { const int q = nwg / NXCD, r = nwg % NXCD, xcd = wgid % NXCD, off = wgid / NXCD; wgid = (xcd < r ? xcd * (q + 1) : r * (q + 1) + (xcd - r) * q) + off; }
        const int nig = WGM * nN, gid = wgid / nig, fm = gid * WGM, gsz = (nM - fm) < WGM ? (nM - fm) : WGM;
        u.pm = fm + ((wgid % nig) % gsz); u.pn = (wgid % nig) / gsz; return true;
    }
    __device__ __forceinline__ void a_ready(const Unit&) const {}
    __device__ __forceinline__ void done(const Unit&) const {}
};

template <class Epi, class Sched, bool ALIGN_EPI = false, bool SP2 = false>
__device__ __forceinline__ void gemm_phase(PG8_LAS unsigned char* lds, const Gemm g, const Sched& S, const Epi& E) {
    const int tid = PG8_TID(), wid = __builtin_amdgcn_readfirstlane(tid >> 6), lane = tid & 63, wr = wid >> 2, wc = wid & 3, fr = lane & 15, fq = lane >> 4;
    const int K = g.K, nt = K / BK;
    unsigned voffA[2], voffB[2];
#pragma unroll
    for (int i = 0; i < 2; ++i) { int R, C; stage_rc(tid * 16 + i * 8192, R, C); const int Rb = Epi::PERM ? ((R & ~31) + perm32(R & 31)) : R;
        voffA[i] = (unsigned)(R * K + C) * 2u; voffB[i] = (unsigned)(Rb * K + C) * 2u; }
    const size_t kstep = (size_t)(BK * 2);
    const size_t hstep = (size_t)HALF * K * 2;
    const size_t tstep = 2 * hstep;
    const unsigned ldsw = (unsigned)wid * 1024u;
    const int aoff = lds_byte(wr * 64 + fr, fq * 8), boff = lds_byte(wc * 32 + fr, fq * 8);
#define PG8_SA(b, h) (((b) * 2 + (h)) * HTB)
#define PG8_SB(b, h) ((4 + (b) * 2 + (h)) * HTB)
#define PG8_STAGE(bufoff, gbase, voff) do { _Pragma("unroll") for (int _i = 0; _i < 2; ++_i) \
        __builtin_amdgcn_global_load_lds((const unsigned*)((const char*)(gbase) + (voff)[_i]), (PG8_LAS unsigned*)(lds + (bufoff) + ldsw + _i * 8192), 16, 0, 0); } while (0)
#define PG8_LDA(dst, b, h) do { _Pragma("unroll") for (int m = 0; m < 4; ++m) _Pragma("unroll") for (int k = 0; k < 2; ++k) dst[m][k] = *(const PG8_LAS bf16x8*)(lds + PG8_SA(b, h) + aoff + m * 2048 + k * 1024); } while (0)
#define PG8_LDB(dst, b, h) do { _Pragma("unroll") for (int n = 0; n < 2; ++n) _Pragma("unroll") for (int k = 0; k < 2; ++k) dst[n][k] = *(const PG8_LAS bf16x8*)(lds + PG8_SB(b, h) + boff + n * 2048 + k * 1024); } while (0)
#define PG8_MMA(ai, bj, At, Bt) do { __builtin_amdgcn_s_setprio(1); _Pragma("unroll") for (int m = 0; m < 4; ++m) _Pragma("unroll") for (int n = 0; n < 2; ++n) _Pragma("unroll") for (int k = 0; k < 2; ++k) \
        acc[ai][bj][m][n] = __builtin_amdgcn_mfma_f32_16x16x32_bf16(Bt[n][k], At[m][k], acc[ai][bj][m][n], 0, 0, 0); __builtin_amdgcn_s_setprio(0); } while (0)
#define PG8_WAIT_V(n) asm volatile("s_waitcnt vmcnt(" #n ")" ::: "memory")
#define PG8_WAIT_L(n) asm volatile("s_waitcnt lgkmcnt(" #n ")" ::: "memory")
#define PG8_BAR __builtin_amdgcn_s_barrier()
#define PG8_SCHED __builtin_amdgcn_sched_barrier(0)
    Unit cur, nxt; int ui = 0;
    if (!S.next(0, cur)) return;
    f32x4 acc[2][2][4][2];
#pragma unroll
    for (int a = 0; a < 2; ++a)
#pragma unroll
        for (int b = 0; b < 2; ++b)
#pragma unroll
            for (int m = 0; m < 4; ++m)
#pragma unroll
                for (int n = 0; n < 2; ++n) acc[a][b][m][n] = (f32x4){0.f, 0.f, 0.f, 0.f};
    bf16x8 At[4][2], B0[2][2], B1[2][2];
    const char* cA = (const char*)g.A + (size_t)cur.pm * tstep; const char* cB = (const char*)g.Bt + (size_t)cur.pn * tstep;
    S.a_ready(cur);
    if constexpr (SP2) {
        PG8_STAGE(PG8_SB(0, 0), cB, voffB); PG8_STAGE(PG8_SB(0, 1), cB + hstep, voffB); PG8_STAGE(PG8_SA(0, 0), cA, voffA); PG8_STAGE(PG8_SA(0, 1), cA + hstep, voffA);
        if (wr == 1) PG8_BAR;
        PG8_WAIT_V(2); PG8_BAR;
        PG8_STAGE(PG8_SB(1, 0), cB + kstep, voffB); PG8_STAGE(PG8_SA(1, 0), cA + kstep, voffA); PG8_STAGE(PG8_SB(1, 1), cB + hstep + kstep, voffB);
        PG8_WAIT_V(6); PG8_BAR;
    } else {
        PG8_STAGE(PG8_SB(0, 0), cB, voffB); PG8_STAGE(PG8_SA(0, 0), cA, voffA); PG8_STAGE(PG8_SB(0, 1), cB + hstep, voffB); PG8_STAGE(PG8_SA(0, 1), cA + hstep, voffA);
        if (wr == 1) PG8_BAR;
        PG8_WAIT_V(4); PG8_BAR;
        PG8_STAGE(PG8_SB(1, 0), cB + kstep, voffB); PG8_STAGE(PG8_SA(1, 0), cA + kstep, voffA); PG8_STAGE(PG8_SB(1, 1), cB + hstep + kstep, voffB);
        PG8_WAIT_V(6); PG8_BAR;
    }
    for (;;) {
        const bool has_next = S.next(ui + 1, nxt);
        const char* nA = has_next ? (const char*)g.A + (size_t)nxt.pm * tstep : cA; const char* nB = has_next ? (const char*)g.Bt + (size_t)nxt.pn * tstep : cB;
        for (int t = 0; t < nt; t += 2) {
            const bool last = (t == nt - 2);
            const char* a1 = cA + (size_t)(t + 1) * kstep;
            const char* a2 = last ? nA : cA + (size_t)(t + 2) * kstep; const char* b2 = last ? nB : cB + (size_t)(t + 2) * kstep;
            const char* a3 = a2 + kstep; const char* b3 = b2 + kstep;
            if (last && has_next) S.a_ready(nxt);
            if constexpr (SP2) {
            PG8_LDB(B0, 0, 0); PG8_LDB(B1, 0, 1); PG8_SCHED; PG8_LDA(At, 0, 0); PG8_STAGE(PG8_SA(1, 1), a1 + hstep, voffA);
            PG8_WAIT_V(8); PG8_WAIT_L(0); PG8_BAR; PG8_MMA(0, 0, At, B0); PG8_MMA(0, 1, At, B1); PG8_BAR; PG8_SCHED;
            PG8_LDA(At, 0, 1); PG8_STAGE(PG8_SB(0, 0), b2, voffB); PG8_STAGE(PG8_SB(0, 1), b2 + hstep, voffB); PG8_STAGE(PG8_SA(0, 0), a2, voffA);
            PG8_WAIT_V(8); PG8_WAIT_L(0); PG8_BAR; PG8_MMA(1, 0, At, B0); PG8_MMA(1, 1, At, B1); PG8_BAR; PG8_SCHED;
            PG8_LDB(B0, 1, 0); PG8_LDB(B1, 1, 1); PG8_SCHED; PG8_LDA(At, 1, 0); PG8_STAGE(PG8_SA(0, 1), a2 + hstep, voffA);
            PG8_WAIT_V(8); PG8_WAIT_L(0); PG8_BAR; PG8_MMA(0, 0, At, B0); PG8_MMA(0, 1, At, B1); PG8_BAR; PG8_SCHED;
            PG8_LDA(At, 1, 1); PG8_STAGE(PG8_SB(1, 0), b3, voffB); PG8_STAGE(PG8_SB(1, 1), b3 + hstep, voffB); PG8_STAGE(PG8_SA(1, 0), a3, voffA);
            PG8_WAIT_V(8); PG8_WAIT_L(0); PG8_BAR; PG8_MMA(1, 0, At, B0); PG8_MMA(1, 1, At, B1); PG8_BAR; PG8_SCHED;
            } else {
            PG8_LDB(B0, 0, 0); PG8_SCHED; PG8_LDA(At, 0, 0); PG8_STAGE(PG8_SA(1, 1), a1 + hstep, voffA);
            PG8_WAIT_L(8); PG8_BAR; PG8_WAIT_L(0); PG8_MMA(0, 0, At, B0); PG8_BAR; PG8_SCHED;
            PG8_LDB(B1, 0, 1); PG8_STAGE(PG8_SB(0, 0), b2, voffB);
            PG8_BAR; PG8_WAIT_L(0); PG8_MMA(0, 1, At, B1); PG8_BAR;
            PG8_LDA(At, 0, 1); PG8_STAGE(PG8_SA(0, 0), a2, voffA);
            PG8_BAR; PG8_WAIT_L(0); PG8_MMA(1, 0, At, B0); PG8_BAR; PG8_SCHED;
            PG8_STAGE(PG8_SB(0, 1), b2 + hstep, voffB);
            PG8_WAIT_V(6); PG8_BAR; PG8_MMA(1, 1, At, B1); PG8_BAR;
            PG8_LDB(B0, 1, 0); PG8_SCHED; PG8_LDA(At, 1, 0); PG8_STAGE(PG8_SA(0, 1), a2 + hstep, voffA);
            PG8_WAIT_L(8); PG8_BAR; PG8_WAIT_L(0); PG8_MMA(0, 0, At, B0); PG8_BAR; PG8_SCHED;
            PG8_LDB(B1, 1, 1); PG8_STAGE(PG8_SB(1, 0), b3, voffB);
            PG8_BAR; PG8_WAIT_L(0); PG8_MMA(0, 1, At, B1); PG8_BAR;
            PG8_LDA(At, 1, 1); PG8_STAGE(PG8_SA(1, 0), a3, voffA);
            PG8_BAR; PG8_WAIT_L(0); PG8_MMA(1, 0, At, B0); PG8_BAR; PG8_SCHED;
            PG8_STAGE(PG8_SB(1, 1), b3 + hstep, voffB);
            PG8_WAIT_V(6); PG8_BAR; PG8_MMA(1, 1, At, B1); PG8_BAR;
            }
        }
        if constexpr (ALIGN_EPI) { if (wr == 0) PG8_BAR; }
        if constexpr (!Epi::AFTER_DRAIN) { E(acc, cur, wr, wc, fr, fq); S.done(cur); }
        if (!has_next) break;
#pragma unroll
        for (int a = 0; a < 2; ++a)
#pragma unroll
            for (int b = 0; b < 2; ++b)
#pragma unroll
                for (int m = 0; m < 4; ++m)
#pragma unroll
                    for (int n = 0; n < 2; ++n) acc[a][b][m][n] = (f32x4){0.f, 0.f, 0.f, 0.f};
        cur = nxt; cA = nA; cB = nB; ++ui;
        if constexpr (ALIGN_EPI) { if (wr == 1) PG8_BAR; }
    }
    PG8_WAIT_V(0);
    if constexpr (!ALIGN_EPI) { if (wr == 0) PG8_BAR; }
    PG8_BAR;
    if constexpr (Epi::AFTER_DRAIN) { E.fused(acc, cur, wr, wc, fr, fq, lds, wid, lane); S.done(cur); }
#undef PG8_SA
#undef PG8_SB
#undef PG8_STAGE
#undef PG8_LDA
#undef PG8_LDB
#undef PG8_MMA
#undef PG8_WAIT_V
#undef PG8_WAIT_L
#undef PG8_BAR
#undef PG8_SCHED
}
}

#define WTAB_OFF 155392
extern __shared__ __attribute__((aligned(16))) unsigned char lds_raw[];
__device__ __forceinline__ int hw_slot() { return (int)(__builtin_amdgcn_s_getreg((5 << 11) | 4) & 63u); }
__device__ __forceinline__ void otid_init() { const int t = threadIdx.x; if ((t & 63) == 0) ((__attribute__((address_space(3))) int*)(__attribute__((address_space(3))) void*)(lds_raw + WTAB_OFF))[hw_slot()] = t >> 6; }
__device__ __forceinline__ int otid() {
    const int w = __builtin_amdgcn_readfirstlane(((const __attribute__((address_space(3))) int*)(__attribute__((address_space(3))) void*)(lds_raw + WTAB_OFF))[hw_slot()]);
    int l; asm volatile("v_mbcnt_lo_u32_b32 %0, -1, 0\n\tv_mbcnt_hi_u32_b32 %0, -1, %0" : "=v"(l));
    return (w << 6) + l;
}
using pg8::bf16_t; using pg8::bf16x8; using pg8::f32x4; using pg8::u32x4;
#define LAS __attribute__((address_space(3)))

#define DMODEL 1024
#define NPT 16384
#define NST 32
#define NTOK 16416
#define MPAD 16640
#define SEQ 2048
#define ZW 2816
#define OFF_A 1536
#define OFF_B 1544
#define OFF_Z 1552
#define OFF_QA 2064
#define OFF_KVA 2448
#define OFF_KR 2704
#define DFF 2816
#define PAST 16384
#define NPAGES 128
#define EPSV 1e-6f

#define O_YP 0
#define O_YS (O_YP + 16777216)
#define O_CKVP (O_YS + 32768)
#define O_KRP (O_CKVP + 4194304)
#define O_GSP (O_KRP + 524288)
#define O_CSP (O_GSP + 262144)
#define O_CKVS (O_CSP + 36864)
#define O_KRS (O_CKVS + 8192)
#define O_GSS (O_KRS + 1024)
#define O_CSS (O_GSS + 1048576)

__device__ __forceinline__ bf16_t f2bf(float f) { unsigned u = __float_as_uint(f); return (bf16_t)((u + 0x7fffu + ((u >> 16) & 1u)) >> 16); }
__device__ __forceinline__ float bf2f(bf16_t b) { return __uint_as_float(((unsigned)b) << 16); }
template <int CTRL> __device__ __forceinline__ float dpp_mov(float x) { return __uint_as_float((unsigned)__builtin_amdgcn_update_dpp((int)__float_as_uint(x), (int)__float_as_uint(x), CTRL, 0xF, 0xF, true)); }
__device__ __forceinline__ float add_x16(float x) { auto r = __builtin_amdgcn_permlane16_swap(__float_as_uint(x), __float_as_uint(x), false, false); return __uint_as_float(r[0]) + __uint_as_float(r[1]); }
__device__ __forceinline__ float add_x32(float x) { auto r = __builtin_amdgcn_permlane32_swap(__float_as_uint(x), __float_as_uint(x), false, false); return __uint_as_float(r[0]) + __uint_as_float(r[1]); }
__device__ __forceinline__ float max_x32(float x) { auto r = __builtin_amdgcn_permlane32_swap(__float_as_uint(x), __float_as_uint(x), false, false); return fmaxf(__uint_as_float(r[0]), __uint_as_float(r[1])); }
__device__ __forceinline__ float sum8(float x) { x += dpp_mov<0xB1>(x); x += dpp_mov<0x4E>(x); x += dpp_mov<0x141>(x); return x; }
__device__ __forceinline__ float sum16(float x) { x = sum8(x); x += dpp_mov<0x140>(x); return x; }
__device__ __forceinline__ float max16(float x) { x = fmaxf(x, dpp_mov<0xB1>(x)); x = fmaxf(x, dpp_mov<0x4E>(x)); x = fmaxf(x, dpp_mov<0x141>(x)); x = fmaxf(x, dpp_mov<0x140>(x)); return x; }
__device__ __forceinline__ float wave_sum(float v) { return add_x32(add_x16(sum16(v))); }
__device__ __forceinline__ float sigmoidf_(float x) { return __builtin_amdgcn_rcpf(1.f + __builtin_amdgcn_exp2f(-1.44269504f * x)); }
__device__ __forceinline__ float siluf_(float x) { return x * __builtin_amdgcn_rcpf(1.f + __builtin_amdgcn_exp2f(-1.44269504f * x)); }


#define WSYNC() do { __builtin_amdgcn_fence(__ATOMIC_ACQ_REL, "wavefront"); __builtin_amdgcn_wave_barrier(); } while (0)
#define NTHR 512
#define NWAVE 8

typedef float f32x2_t __attribute__((ext_vector_type(2)));
typedef __bf16 bf16x2_t __attribute__((ext_vector_type(2)));
__device__ __forceinline__ unsigned cvtpk(float lo, float hi) { f32x2_t v = {lo, hi}; bf16x2_t r = __builtin_convertvector(v, bf16x2_t); return __builtin_bit_cast(unsigned, r); }
__device__ __forceinline__ void bf8_to_f32(const bf16x8& v, float* o) {
#pragma unroll
    for (int e = 0; e < 8; ++e) o[e] = __uint_as_float(((unsigned)(unsigned short)v[e]) << 16);
}
__device__ __forceinline__ bf16x8 f32_to_bf8(const float* x) {
    u32x4 w; w.x = cvtpk(x[0], x[1]); w.y = cvtpk(x[2], x[3]); w.z = cvtpk(x[4], x[5]); w.w = cvtpk(x[6], x[7]);
    return __builtin_bit_cast(bf16x8, w);
}
__device__ __forceinline__ unsigned pk2bf(float lo, float hi) { return (unsigned)f2bf(lo) | ((unsigned)f2bf(hi) << 16); }

__device__ __forceinline__ void wt_item(const float* __restrict__ W, int ldw, int col0, int nvalid, bf16_t* __restrict__ WT, int ldt, int nrow0, int k0, float* scr, int lane) {
    WSYNC();
#pragma unroll 8
    for (int i = 0; i < 32; ++i) { const int kk = 2 * i + (lane >> 5), n = lane & 31; scr[kk * 33 + n] = n < nvalid ? W[(size_t)(k0 + kk) * ldw + col0 + n] : 0.f; }
    WSYNC();
    const int c = lane & 7;
#pragma unroll
    for (int j = 0; j < 4; ++j) { const int n = (lane >> 3) + 8 * j; const float* sp = scr + (8 * c) * 33 + n;
        u32x4 o; o.x = cvtpk(sp[0], sp[33]); o.y = cvtpk(sp[2 * 33], sp[3 * 33]); o.z = cvtpk(sp[4 * 33], sp[5 * 33]); o.w = cvtpk(sp[6 * 33], sp[7 * 33]);
        *(u32x4*)(WT + (size_t)(nrow0 + n) * ldt + k0 + 8 * c) = o; }
}

__device__ __forceinline__ void rms1024_row(const float* __restrict__ src, const float* __restrict__ g, bf16_t* __restrict__ o, bool zero, int lane) {
    if (zero) { for (int j = 0; j < 4; ++j) { ushort4 z = {0, 0, 0, 0}; *(ushort4*)(o + lane * 4 + 256 * j) = z; } return; }
    float4 v[4]; float ss = 0.f;
#pragma unroll
    for (int j = 0; j < 4; ++j) { v[j] = *(const float4*)(src + lane * 4 + 256 * j); ss += v[j].x * v[j].x + v[j].y * v[j].y + v[j].z * v[j].z + v[j].w * v[j].w; }
    ss = wave_sum(ss);
    const float rs = rsqrtf(ss * (1.f / 1024.f) + EPSV);
#pragma unroll
    for (int j = 0; j < 4; ++j) {
        const float4 gg = *(const float4*)(g + lane * 4 + 256 * j);
        ushort4 w; w.x = f2bf(v[j].x * rs * gg.x); w.y = f2bf(v[j].y * rs * gg.y); w.z = f2bf(v[j].z * rs * gg.z); w.w = f2bf(v[j].w * rs * gg.w);
        *(ushort4*)(o + lane * 4 + 256 * j) = w;
    }
}

__device__ __forceinline__ void rms1024_row_b(const bf16_t* __restrict__ src, const float* __restrict__ g, bf16_t* __restrict__ o, bool zero, int lane) {
    if (zero) { for (int j = 0; j < 2; ++j) { const u32x4 z = {0u, 0u, 0u, 0u}; *(u32x4*)(o + lane * 8 + 512 * j) = z; } return; }
    float v[2][8]; float ss = 0.f;
#pragma unroll
    for (int j = 0; j < 2; ++j) { bf8_to_f32(*(const bf16x8*)(src + lane * 8 + 512 * j), v[j]);
#pragma unroll
        for (int e = 0; e < 8; ++e) ss += v[j][e] * v[j][e]; }
    ss = wave_sum(ss);
    const float rs = rsqrtf(ss * (1.f / 1024.f) + EPSV);
#pragma unroll
    for (int j = 0; j < 2; ++j) {
        const float4 g0 = *(const float4*)(g + lane * 8 + 512 * j), g1 = *(const float4*)(g + lane * 8 + 512 * j + 4);
        float t[8] = {v[j][0] * rs * g0.x, v[j][1] * rs * g0.y, v[j][2] * rs * g0.z, v[j][3] * rs * g0.w, v[j][4] * rs * g1.x, v[j][5] * rs * g1.y, v[j][6] * rs * g1.z, v[j][7] * rs * g1.w};
        *(bf16x8*)(o + lane * 8 + 512 * j) = f32_to_bf8(t);
    }
}

struct ABf16 { const bf16_t* p; int lda; __device__ __forceinline__ bf16x8 load(int m, int k) const { return *(const bf16x8*)(p + (size_t)m * lda + k); } };
template <bool SWIGLU, class Epi>
__device__ __forceinline__ void gemm_sample_rows(const bf16_t* __restrict__ A, int lda, const bf16_t* __restrict__ Bt, int K, int N, const Epi& epi, char*  , int bid, int nb) {
    const int tid = otid(), lane = tid & 63, wid = tid >> 6, i16 = lane & 15, q4 = lane >> 4;
    for (int u = nb - 1 - bid; u < N / 256; u += nb) {
        const int n0 = u * 256;
        const int c0 = SWIGLU ? n0 + 16 * wid : n0 + 32 * wid, c1 = SWIGLU ? n0 + 128 + 16 * wid : n0 + 32 * wid + 16;
        const bf16_t* a0p = A + (size_t)(NPT + i16) * lda + 8 * q4; const bf16_t* a1p = a0p + (size_t)16 * lda;
        const bf16_t* b0p = Bt + (size_t)(c0 + i16) * K + 8 * q4; const bf16_t* b1p = Bt + (size_t)(c1 + i16) * K + 8 * q4;
        f32x4 acc[2][2];
#pragma unroll
        for (int i = 0; i < 2; ++i)
#pragma unroll
            for (int j = 0; j < 2; ++j) acc[i][j] = (f32x4){0.f, 0.f, 0.f, 0.f};
#pragma unroll 4
        for (int k0 = 0; k0 < K; k0 += 32) {
            const bf16x8 a0 = *(const bf16x8*)(a0p + k0), a1 = *(const bf16x8*)(a1p + k0), b0 = *(const bf16x8*)(b0p + k0), b1 = *(const bf16x8*)(b1p + k0);
            acc[0][0] = __builtin_amdgcn_mfma_f32_16x16x32_bf16(a0, b0, acc[0][0], 0, 0, 0); acc[0][1] = __builtin_amdgcn_mfma_f32_16x16x32_bf16(a0, b1, acc[0][1], 0, 0, 0);
            acc[1][0] = __builtin_amdgcn_mfma_f32_16x16x32_bf16(a1, b0, acc[1][0], 0, 0, 0); acc[1][1] = __builtin_amdgcn_mfma_f32_16x16x32_bf16(a1, b1, acc[1][1], 0, 0, 0);
        }
#pragma unroll
        for (int i = 0; i < 2; ++i)
#pragma unroll
            for (int r = 0; r < 4; ++r) {
                const int m = NPT + 16 * i + 4 * q4 + r;
                if constexpr (SWIGLU) epi(m, (n0 >> 1) + 16 * wid + i16, siluf_(acc[i][0][r]) * acc[i][1][r]);
                else { epi(m, c0 + i16, acc[i][0][r]); epi(m, c1 + i16, acc[i][1][r]); }
            }
    }
}
template <bool SWIGLU, class Epi>
__device__ __forceinline__ void gemm_sample_rows_ks(const bf16_t* __restrict__ A, int lda, const bf16_t* __restrict__ Bt, int K, int N, const Epi& epi, char* smem, int bid, int nb) {
    const int tid = otid(), lane = tid & 63, wid = tid >> 6, i16 = lane & 15, q4 = lane >> 4;
    const int nunits = N / 64, ksl = K >> 3;
    f32x4* red = (f32x4*)smem;
    for (int u = nb - 1 - bid; u < nunits; u += nb) {
        int brow[4];
#pragma unroll
        for (int j = 0; j < 4; ++j) brow[j] = SWIGLU ? ((32 * u) >> 7) * 256 + ((32 * u) & 127) + 128 * (j >> 1) + 16 * (j & 1) + i16 : 64 * u + 16 * j + i16;
        const bf16_t* a0p = A + (size_t)(NPT + i16) * lda + wid * ksl + 8 * q4; const bf16_t* a1p = a0p + (size_t)16 * lda;
        f32x4 acc[2][4];
#pragma unroll
        for (int i = 0; i < 2; ++i)
#pragma unroll
            for (int j = 0; j < 4; ++j) acc[i][j] = (f32x4){0.f, 0.f, 0.f, 0.f};
        for (int k0 = 0; k0 < ksl; k0 += 32) {
            const bf16x8 a0 = *(const bf16x8*)(a0p + k0), a1 = *(const bf16x8*)(a1p + k0);
            bf16x8 b[4];
#pragma unroll
            for (int j = 0; j < 4; ++j) b[j] = *(const bf16x8*)(Bt + (size_t)brow[j] * K + wid * ksl + 8 * q4 + k0);
#pragma unroll
            for (int j = 0; j < 4; ++j) { acc[0][j] = __builtin_amdgcn_mfma_f32_16x16x32_bf16(a0, b[j], acc[0][j], 0, 0, 0); acc[1][j] = __builtin_amdgcn_mfma_f32_16x16x32_bf16(a1, b[j], acc[1][j], 0, 0, 0); }
        }
        __syncthreads();
#pragma unroll
        for (int i = 0; i < 2; ++i)
#pragma unroll
            for (int j = 0; j < 4; ++j) red[(wid * 8 + i * 4 + j) * 64 + lane] = acc[i][j];
        __syncthreads();
        if constexpr (SWIGLU) {
            if (tid < 256) {
                const int t4 = tid >> 6, i = t4 >> 1, jg = t4 & 1, l = tid & 63;
                f32x4 g = red[(i * 4 + jg) * 64 + l], up = red[(i * 4 + jg + 2) * 64 + l];
#pragma unroll
                for (int w = 1; w < 8; ++w) { g = g + red[(w * 8 + i * 4 + jg) * 64 + l]; up = up + red[(w * 8 + i * 4 + jg + 2) * 64 + l]; }
#pragma unroll
                for (int r = 0; r < 4; ++r) epi(NPT + 16 * i + 4 * (l >> 4) + r, 32 * u + 16 * jg + (l & 15), siluf_(g[r]) * up[r]);
            }
        } else {
            const int t8 = tid >> 6, l = tid & 63, i = t8 >> 2, j = t8 & 3;
            f32x4 v = red[t8 * 64 + l];
#pragma unroll
            for (int w = 1; w < 8; ++w) v = v + red[(w * 8 + t8) * 64 + l];
#pragma unroll
            for (int r = 0; r < 4; ++r) epi(NPT + 16 * i + 4 * (l >> 4) + r, 64 * u + 16 * j + (l & 15), v[r]);
        }
    }
    __syncthreads();
}
struct EwF32 { float* C; int ldc; __device__ __forceinline__ void operator()(int m, int n, float v) const { C[(size_t)m * ldc + n] = v; } };
struct EwBf16 { bf16_t* C; int ldc; __device__ __forceinline__ void operator()(int m, int n, float v) const { C[(size_t)m * ldc + n] = f2bf(v); } };
struct EwResX { const float* xs; bf16_t* C; __device__ __forceinline__ void operator()(int m, int n, float v) const { C[(size_t)m * 1024 + n] = f2bf(xs[(size_t)(m - NPT) * 1024 + n] + v); } };
struct EwResH { const bf16_t* H; bf16_t* C; __device__ __forceinline__ void operator()(int m, int n, float v) const { C[(size_t)m * 1024 + n] = f2bf(bf2f(H[(size_t)m * 1024 + n]) + v); } };
struct EwPle { const bf16_t* H2; const bf16_t* PP; float* out;
    __device__ __forceinline__ void operator()(int m, int n, float v) const { out[O_YS + (size_t)(m - NPT) * 1024 + n] = bf2f(H2[(size_t)m * 1024 + n]) + bf2f(PP[(size_t)m * 1024 + n]) * sigmoidf_(v); } };

struct PgBf16 {
    static constexpr bool PERM = true, AFTER_DRAIN = false; bf16_t* O; int ldc;
    __device__ __forceinline__ void operator()(const f32x4 (&acc)[2][2][4][2], const pg8::Unit& u, int wr, int wc, int fr, int fq) const {
#pragma unroll
        for (int ai = 0; ai < 2; ++ai)
#pragma unroll
            for (int m = 0; m < 4; ++m) { bf16_t* rowp = O + (size_t)(u.pm * 256 + ai * 128 + wr * 64 + m * 16 + fr) * ldc + u.pn * 256 + wc * 32 + 8 * fq;
#pragma unroll
                for (int bj = 0; bj < 2; ++bj) { const f32x4 v0 = acc[ai][bj][m][0], v1 = acc[ai][bj][m][1]; u32x4 w; w.x = pk2bf(v0[0], v0[1]); w.y = pk2bf(v0[2], v0[3]); w.z = pk2bf(v1[0], v1[1]); w.w = pk2bf(v1[2], v1[3]); *(u32x4*)(rowp + bj * 128) = w; } }
    }
};
struct PgF32 {
    static constexpr bool PERM = false, AFTER_DRAIN = false; float* O; int ldc;
    __device__ __forceinline__ void operator()(const f32x4 (&acc)[2][2][4][2], const pg8::Unit& u, int wr, int wc, int fr, int fq) const {
#pragma unroll
        for (int ai = 0; ai < 2; ++ai)
#pragma unroll
            for (int m = 0; m < 4; ++m) { float* rowp = O + (size_t)(u.pm * 256 + ai * 128 + wr * 64 + m * 16 + fr) * ldc + u.pn * 256 + wc * 32 + 4 * fq;
#pragma unroll
                for (int bj = 0; bj < 2; ++bj)
#pragma unroll
                    for (int n = 0; n < 2; ++n) *(f32x4*)(rowp + bj * 128 + n * 16) = acc[ai][bj][m][n]; }
    }
};
struct PgSwiglu {
    static constexpr bool PERM = true, AFTER_DRAIN = false; bf16_t* Hd;
    __device__ __forceinline__ void operator()(const f32x4 (&acc)[2][2][4][2], const pg8::Unit& u, int wr, int wc, int fr, int fq) const {
#pragma unroll
        for (int ai = 0; ai < 2; ++ai)
#pragma unroll
            for (int m = 0; m < 4; ++m) { bf16_t* rowp = Hd + (size_t)(u.pm * 256 + ai * 128 + wr * 64 + m * 16 + fr) * DFF + u.pn * 128 + wc * 32 + 8 * fq;
                float h[8];
#pragma unroll
                for (int n = 0; n < 2; ++n)
#pragma unroll
                    for (int i = 0; i < 4; ++i) h[n * 4 + i] = siluf_(acc[ai][0][m][n][i]) * acc[ai][1][m][n][i];
                u32x4 w; w.x = pk2bf(h[0], h[1]); w.y = pk2bf(h[2], h[3]); w.z = pk2bf(h[4], h[5]); w.w = pk2bf(h[6], h[7]); *(u32x4*)rowp = w; }
    }
};
struct PgResXB {
    static constexpr bool PERM = true, AFTER_DRAIN = false; const float* R; bf16_t* O;
    __device__ __forceinline__ void operator()(const f32x4 (&acc)[2][2][4][2], const pg8::Unit& u, int wr, int wc, int fr, int fq) const {
#pragma unroll
        for (int ai = 0; ai < 2; ++ai)
#pragma unroll
            for (int m = 0; m < 4; ++m) { const size_t off = (size_t)(u.pm * 256 + ai * 128 + wr * 64 + m * 16 + fr) * 1024 + u.pn * 256 + wc * 32 + 8 * fq;
#pragma unroll
                for (int bj = 0; bj < 2; ++bj) { const f32x4 r0 = *(const f32x4*)(R + off + bj * 128), r1 = *(const f32x4*)(R + off + bj * 128 + 4), v0 = r0 + acc[ai][bj][m][0], v1 = r1 + acc[ai][bj][m][1];
                    u32x4 w; w.x = cvtpk(v0[0], v0[1]); w.y = cvtpk(v0[2], v0[3]); w.z = cvtpk(v1[0], v1[1]); w.w = cvtpk(v1[2], v1[3]); *(u32x4*)(O + off + bj * 128) = w; } }
    }
};
struct PgResBB {
    static constexpr bool PERM = true, AFTER_DRAIN = false; const bf16_t* R; bf16_t* O;
    __device__ __forceinline__ void operator()(const f32x4 (&acc)[2][2][4][2], const pg8::Unit& u, int wr, int wc, int fr, int fq) const {
#pragma unroll
        for (int ai = 0; ai < 2; ++ai)
#pragma unroll
            for (int m = 0; m < 4; ++m) { const size_t off = (size_t)(u.pm * 256 + ai * 128 + wr * 64 + m * 16 + fr) * 1024 + u.pn * 256 + wc * 32 + 8 * fq;
#pragma unroll
                for (int bj = 0; bj < 2; ++bj) { float r[8]; bf8_to_f32(*(const bf16x8*)(R + off + bj * 128), r); const f32x4 a0 = acc[ai][bj][m][0], a1 = acc[ai][bj][m][1];
                    u32x4 w; w.x = cvtpk(r[0] + a0[0], r[1] + a0[1]); w.y = cvtpk(r[2] + a0[2], r[3] + a0[3]); w.z = cvtpk(r[4] + a1[0], r[5] + a1[1]); w.w = cvtpk(r[6] + a1[2], r[7] + a1[3]); *(u32x4*)(O + off + bj * 128) = w; } }
    }
};
struct PgPleB {
    static constexpr bool PERM = true, AFTER_DRAIN = false; const bf16_t* H2; const bf16_t* PP; float* out;
    __device__ __forceinline__ void operator()(const f32x4 (&acc)[2][2][4][2], const pg8::Unit& u, int wr, int wc, int fr, int fq) const {
#pragma unroll
        for (int ai = 0; ai < 2; ++ai)
#pragma unroll
            for (int m = 0; m < 4; ++m) { const size_t off = (size_t)(u.pm * 256 + ai * 128 + wr * 64 + m * 16 + fr) * 1024 + u.pn * 256 + wc * 32 + 8 * fq;
#pragma unroll
                for (int bj = 0; bj < 2; ++bj) { float h[8], pp[8]; bf8_to_f32(*(const bf16x8*)(H2 + off + bj * 128), h); bf8_to_f32(*(const bf16x8*)(PP + off + bj * 128), pp);
                    const f32x4 a0 = acc[ai][bj][m][0], a1 = acc[ai][bj][m][1]; f32x4 y0, y1;
#pragma unroll
                    for (int i = 0; i < 4; ++i) { y0[i] = h[i] + pp[i] * sigmoidf_(a0[i]); y1[i] = h[4 + i] + pp[4 + i] * sigmoidf_(a1[i]); }
                    *(f32x4*)(out + O_YP + off + bj * 128) = y0; *(f32x4*)(out + O_YP + off + bj * 128 + 4) = y1; } }
    }
};
template <class Epi>
__device__ __forceinline__ void pg_gemm(LAS unsigned char* lds, const bf16_t* A, const bf16_t* Bt, int M, int N, int K, const Epi& E, int glow = 0) {
    pg8::Gemm g{A, Bt, M, N, K}; pg8::StaticOrder S;
    if (glow > 0) { if ((int)blockIdx.x >= glow) return; S.init(M, N, glow, (int)blockIdx.x); }
    else S.init(M, N, (int)gridDim.x, (int)blockIdx.x);
    pg8::gemm_phase<Epi, pg8::StaticOrder, true, true>(lds, g, S, E);
}

constexpr size_t WOF_WinT = 0ull;
constexpr size_t WOF_WqbT = 5767168ull;
constexpr size_t WOF_WkvT = 6356992ull;
constexpr size_t WOF_WknT = 6881280ull;
constexpr size_t WOF_WoT = 7143424ull;
constexpr size_t WOF_WguT = 9240576ull;
constexpr size_t WOF_WdT = 20774912ull;
constexpr size_t WOF_WpgT = 26542080ull;
constexpr size_t WOF_WppT = 28639232ull;
constexpr size_t WOF_xn = 29163520ull;
constexpr size_t WOF_pb = 63242240ull;
constexpr size_t WOF_Z = 71761920ull;
constexpr size_t WOF_qkv = 165478400ull;
constexpr size_t WOF_ropecs = 216596480ull;
constexpr size_t WOF_gg = 216858880ull;
constexpr size_t WOF_bb = 217391360ull;
constexpr size_t WOF_goraw = 217923840ull;
constexpr size_t WOF_gUT = 252002560ull;
constexpr size_t WOF_ggam = 285556992ull;
constexpr size_t WOF_gWn = 285565184ull;
constexpr size_t WOF_gQg = 302342400ull;
constexpr size_t WOF_gQK = 319119616ull;
constexpr size_t WOF_gKd = 335896832ull;
constexpr size_t WOF_qan = 352674048ull;
constexpr size_t WOF_ckvb = 365453568ull;
constexpr size_t WOF_krf = 373973248ull;
constexpr size_t WOF_Q = 376103168ull;
constexpr size_t WOF_qh = 427221248ull;
constexpr size_t WOF_KV = 478339328ull;
constexpr size_t WOF_kh = 546496768ull;
constexpr size_t WOF_omix = 580575488ull;
constexpr size_t WOF_KN = 614654208ull;
constexpr size_t WOF_SC = 1151525120ull;
constexpr size_t WOF_part = 1168302336ull;
constexpr size_t WOF_H = 1170432256ull;
constexpr size_t WOF_un = 1238589696ull;
constexpr size_t WOF_G = 1272668416ull;
constexpr size_t WOF_hid = 1273028864ull;
constexpr size_t WOF_H2 = 1366745344ull;
constexpr size_t WOF_un2 = 1434902784ull;
constexpr size_t WOF_PP = 1468981504ull;
constexpr size_t WOF_qraw = 1537138944ull;
constexpr size_t WOF_kvraw = 1562304768ull;
constexpr size_t WOF_krb = 1595859200ull;
constexpr size_t WOF_ctl = 1596907776ull;
constexpr size_t WS_TOTAL = 1596924160ull;
struct MK {
    const float *x_prompt, *x_sample, *cache_ckv, *cache_krope, *state_gdn, *state_conv; const int* page_table; const float *p_prompt, *p_sample;
    const float *g_attn, *w_in, *w_conv, *a_log, *dt_bias, *g_gdn_out, *g_q_a, *w_q_b, *g_q_nope, *g_q_rope, *g_kv_a, *g_k_rope, *w_kv_b, *g_k_nope, *w_o, *g_ffn, *w_gate, *w_up, *w_down, *g_ple, *w_ple_gate, *w_ple_proj;
    float* out; char* ws;
    __device__ __forceinline__ unsigned* ctl() const { return (unsigned*)(ws + WOF_ctl); }
    __device__ __forceinline__ bf16_t* WinT() const { return (bf16_t*)(ws + WOF_WinT); }
    __device__ __forceinline__ bf16_t* WqbT() const { return (bf16_t*)(ws + WOF_WqbT); }
    __device__ __forceinline__ bf16_t* WkvT() const { return (bf16_t*)(ws + WOF_WkvT); }
    __device__ __forceinline__ bf16_t* WknT() const { return (bf16_t*)(ws + WOF_WknT); }
    __device__ __forceinline__ bf16_t* WoT() const { return (bf16_t*)(ws + WOF_WoT); }
    __device__ __forceinline__ bf16_t* WguT() const { return (bf16_t*)(ws + WOF_WguT); }
    __device__ __forceinline__ bf16_t* WdT() const { return (bf16_t*)(ws + WOF_WdT); }
    __device__ __forceinline__ bf16_t* WpgT() const { return (bf16_t*)(ws + WOF_WpgT); }
    __device__ __forceinline__ bf16_t* WppT() const { return (bf16_t*)(ws + WOF_WppT); }
    __device__ __forceinline__ bf16_t* xn() const { return (bf16_t*)(ws + WOF_xn); }
    __device__ __forceinline__ bf16_t* pb() const { return (bf16_t*)(ws + WOF_pb); }
    __device__ __forceinline__ bf16_t* Z() const { return (bf16_t*)(ws + WOF_Z); }
    __device__ __forceinline__ bf16_t* qkv() const { return (bf16_t*)(ws + WOF_qkv); }
    __device__ __forceinline__ float* ropecs() const { return (float*)(ws + WOF_ropecs); }
    __device__ __forceinline__ float* gg() const { return (float*)(ws + WOF_gg); }
    __device__ __forceinline__ float* bb() const { return (float*)(ws + WOF_bb); }
    __device__ __forceinline__ float* goraw() const { return (float*)(ws + WOF_goraw); }
    __device__ __forceinline__ float* gUT() const { return (float*)(ws + WOF_gUT); }
    __device__ __forceinline__ float* ggam() const { return (float*)(ws + WOF_ggam); }
    __device__ __forceinline__ bf16_t* gWn() const { return (bf16_t*)(ws + WOF_gWn); }
    __device__ __forceinline__ bf16_t* gQg() const { return (bf16_t*)(ws + WOF_gQg); }
    __device__ __forceinline__ bf16_t* gQK() const { return (bf16_t*)(ws + WOF_gQK); }
    __device__ __forceinline__ bf16_t* gKd() const { return (bf16_t*)(ws + WOF_gKd); }
    __device__ __forceinline__ bf16_t* qan() const { return (bf16_t*)(ws + WOF_qan); }
    __device__ __forceinline__ bf16_t* ckvb() const { return (bf16_t*)(ws + WOF_ckvb); }
    __device__ __forceinline__ float* krf() const { return (float*)(ws + WOF_krf); }
    __device__ __forceinline__ float* Q() const { return (float*)(ws + WOF_Q); }
    __device__ __forceinline__ float* qh() const { return (float*)(ws + WOF_qh); }
    __device__ __forceinline__ float* KV() const { return (float*)(ws + WOF_KV); }
    __device__ __forceinline__ float* kh() const { return (float*)(ws + WOF_kh); }
    __device__ __forceinline__ bf16_t* omix() const { return (bf16_t*)(ws + WOF_omix); }
    __device__ __forceinline__ bf16_t* KN() const { return (bf16_t*)(ws + WOF_KN); }
    __device__ __forceinline__ float* SC() const { return (float*)(ws + WOF_SC); }
    __device__ __forceinline__ float* part() const { return (float*)(ws + WOF_part); }
    __device__ __forceinline__ bf16_t* H() const { return (bf16_t*)(ws + WOF_H); }
    __device__ __forceinline__ bf16_t* un() const { return (bf16_t*)(ws + WOF_un); }
    __device__ __forceinline__ float* G() const { return (float*)(ws + WOF_G); }
    __device__ __forceinline__ bf16_t* hid() const { return (bf16_t*)(ws + WOF_hid); }
    __device__ __forceinline__ bf16_t* H2() const { return (bf16_t*)(ws + WOF_H2); }
    __device__ __forceinline__ bf16_t* un2() const { return (bf16_t*)(ws + WOF_un2); }
    __device__ __forceinline__ bf16_t* PP() const { return (bf16_t*)(ws + WOF_PP); }
    __device__ __forceinline__ bf16_t* qraw() const { return (bf16_t*)(ws + WOF_qraw); }
    __device__ __forceinline__ bf16_t* kvraw() const { return (bf16_t*)(ws + WOF_kvraw); }
    __device__ __forceinline__ bf16_t* krb() const { return (bf16_t*)(ws + WOF_krb); }
};

__device__ __forceinline__ float fast_sigmoid(float x) { return __builtin_amdgcn_rcpf(1.f + __builtin_amdgcn_exp2f(-1.44269504f * x)); }
struct PinTok { bf16x8 qa, cv, kr; float ab; };
struct PinGain { float gqa[8], gkv[8], gkr[8], dtb, alog; };
__device__ __forceinline__ PinTok pin_load(const MK& a, int row, int lane) {
    const bf16_t* z = a.Z() + (size_t)row * ZW; PinTok t; const bf16x8 zz = {0, 0, 0, 0, 0, 0, 0, 0};
    t.qa = lane < 48 ? *(const bf16x8*)(z + OFF_QA + 8 * lane) : zz; t.cv = lane < 32 ? *(const bf16x8*)(z + OFF_KVA + 8 * lane) : zz;
    t.kr = (lane >= 32 && lane < 36) ? *(const bf16x8*)(z + OFF_KR + 8 * (lane - 32)) : zz; t.ab = lane < 16 ? bf2f(z[OFF_A + lane]) : 0.f; return t;
}
__device__ __forceinline__ void post_in_token(const MK& a, int row, int lane, const float* wcs, const bf16x8 (&w0)[3], const bf16x8 (&w1)[3], const bf16x8 (&w2)[3], const bf16x8 (&wcur)[3], const PinTok& tk, const PinGain& gn) {
    const bool samp = row >= NPT;
    const int b = samp ? row - NPT : row >> 11, t = samp ? 0 : row & 2047, hd = lane >> 3;
    float y[24];
#pragma unroll
    for (int c3 = 0; c3 < 3; ++c3) {
        float p0[8], p1[8], p2[8], cu[8];
        bf8_to_f32(w0[c3], p0); bf8_to_f32(w1[c3], p1); bf8_to_f32(w2[c3], p2); bf8_to_f32(wcur[c3], cu);
        const float* wp = wcs + 512 * c3 + 8 * lane;
        const float4 a0 = *(const float4*)wp, a1 = *(const float4*)(wp + 4), b0 = *(const float4*)(wp + 1536), b1 = *(const float4*)(wp + 1540);
        const float4 c0 = *(const float4*)(wp + 3072), c1 = *(const float4*)(wp + 3076), d0 = *(const float4*)(wp + 4608), d1 = *(const float4*)(wp + 4612);
        const float k0[8] = {a0.x, a0.y, a0.z, a0.w, a1.x, a1.y, a1.z, a1.w}, k1[8] = {b0.x, b0.y, b0.z, b0.w, b1.x, b1.y, b1.z, b1.w};
        const float k2[8] = {c0.x, c0.y, c0.z, c0.w, c1.x, c1.y, c1.z, c1.w}, k3[8] = {d0.x, d0.y, d0.z, d0.w, d1.x, d1.y, d1.z, d1.w};
#pragma unroll
        for (int e = 0; e < 8; ++e) { const int c = 8 * c3 + e; const float v = k0[e] * p0[e] + k1[e] * p1[e] + k2[e] * p2[e] + k3[e] * cu[e]; y[c] = v * fast_sigmoid(v); }
        __builtin_amdgcn_sched_barrier(0);
    }
    float sq = 0.f, sk = 0.f;
#pragma unroll
    for (int e = 0; e < 8; ++e) { sq += y[e] * y[e]; sk += y[8 + e] * y[8 + e]; }
    sq = sum8(sq); sk = sum8(sk);
    const float rq = rsqrtf(sq + EPSV) * 0.125f, rk = rsqrtf(sk + EPSV);
#pragma unroll
    for (int e = 0; e < 8; ++e) { y[e] *= rq; y[8 + e] *= rk; }
    bf16_t* qo = a.qkv() + (size_t)row * 1536 + 8 * lane;
    *(bf16x8*)qo = f32_to_bf8(y); *(bf16x8*)(qo + 512) = f32_to_bf8(y + 8); *(bf16x8*)(qo + 1024) = f32_to_bf8(y + 16);
    if (!samp && t >= SEQ - 3) {
        float* cso = a.out + O_CSP + ((size_t)b * 3 + (t - (SEQ - 3))) * 1536 + 8 * lane;
#pragma unroll
        for (int j = 0; j < 3; ++j) { float cu[8]; bf8_to_f32(wcur[j], cu); *(float4*)(cso + 512 * j) = (float4){cu[0], cu[1], cu[2], cu[3]}; *(float4*)(cso + 512 * j + 4) = (float4){cu[4], cu[5], cu[6], cu[7]}; }
    }
    if (lane < 16) {
        const float v = tk.ab;
        if (lane < 8) { const float xx = v + gn.dtb; const float sp = xx > 20.f ? xx : 0.69314718f * __builtin_amdgcn_logf(1.f + __builtin_amdgcn_exp2f(1.44269504f * xx)); a.gg()[(size_t)row * 8 + lane] = -gn.alog * sp; }
        else a.bb()[(size_t)row * 8 + lane - 8] = sigmoidf_(v);
    }
    __builtin_amdgcn_sched_barrier(0);
    float qa[8], cv[8], kr[8];
    bf8_to_f32(tk.qa, qa); bf8_to_f32(tk.cv, cv); bf8_to_f32(tk.kr, kr);
    float s1 = 0.f, s2 = 0.f, s3 = 0.f;
#pragma unroll
    for (int e = 0; e < 8; ++e) { s1 += qa[e] * qa[e]; s2 += cv[e] * cv[e]; s3 += kr[e] * kr[e]; }
    s1 = wave_sum(s1); s2 = wave_sum(s2); s3 = wave_sum(s3);
    const float r1 = rsqrtf(s1 * (1.f / 384.f) + EPSV), r2 = rsqrtf(s2 * (1.f / 256.f) + EPSV), r3 = rsqrtf(s3 * (1.f / 32.f) + EPSV);
    if (lane < 48) {
        float o[8];
#pragma unroll
        for (int e = 0; e < 8; ++e) o[e] = qa[e] * r1 * gn.gqa[e];
        *(bf16x8*)(a.qan() + (size_t)row * 384 + 8 * lane) = f32_to_bf8(o);
    }
    if (lane < 32) {
        float o[8];
#pragma unroll
        for (int e = 0; e < 8; ++e) o[e] = cv[e] * r2 * gn.gkv[e];
        *(bf16x8*)(a.ckvb() + (size_t)row * 256 + 8 * lane) = f32_to_bf8(o);
        float* co = samp ? a.out + O_CKVS + (size_t)b * 256 + 8 * lane : a.out + O_CKVP + (size_t)row * 256 + 8 * lane;
        *(float4*)co = (float4){o[0], o[1], o[2], o[3]}; *(float4*)(co + 4) = (float4){o[4], o[5], o[6], o[7]};
    }
    __builtin_amdgcn_sched_barrier(0);
    {
        const int c4 = (lane - 32) & 3;
        float xn[8], ot[8];
#pragma unroll
        for (int e = 0; e < 8; ++e) xn[e] = kr[e] * r3 * gn.gkr[e];
#pragma unroll
        for (int e = 0; e < 8; ++e) ot[e] = dpp_mov<0x4E>(xn[e]);
        if (lane >= 32 && lane < 36) {
            const float* tb = a.ropecs() + (size_t)(samp ? 2048 : t) * 32 + ((8 * c4) & 15);
            const float4 c0 = *(const float4*)tb, c1 = *(const float4*)(tb + 4), s0 = *(const float4*)(tb + 16), s1 = *(const float4*)(tb + 20);
            const float csv[8] = {c0.x, c0.y, c0.z, c0.w, c1.x, c1.y, c1.z, c1.w}, snv[8] = {s0.x, s0.y, s0.z, s0.w, s1.x, s1.y, s1.z, s1.w};
            float o[8];
#pragma unroll
            for (int e = 0; e < 8; ++e) o[e] = c4 < 2 ? xn[e] * csv[e] - ot[e] * snv[e] : ot[e] * snv[e] + xn[e] * csv[e];
            float* kf_ = a.krf() + (size_t)row * 32 + 8 * c4; *(float4*)kf_ = (float4){o[0], o[1], o[2], o[3]}; *(float4*)(kf_ + 4) = (float4){o[4], o[5], o[6], o[7]};
            float* ko = samp ? a.out + O_KRS + (size_t)b * 32 + 8 * c4 : a.out + O_KRP + (size_t)row * 32 + 8 * c4;
            *(float4*)ko = (float4){o[0], o[1], o[2], o[3]}; *(float4*)(ko + 4) = (float4){o[4], o[5], o[6], o[7]};
            if (!samp) *(bf16x8*)(a.krb() + (size_t)row * 32 + 8 * c4) = f32_to_bf8(o);
        }
    }
    (void)hd;
}
__device__ __forceinline__ void post_in_run(const MK& a, int run, int lane_in, const float* wcs) {
    int lane = lane_in; asm volatile("" : "+v"(lane));
    PinGain gn;
    {
        const int lq = lane < 48 ? lane : 0, lk = lane < 32 ? lane : 0, c4 = (lane - 32) & 3;
#pragma unroll
        for (int e = 0; e < 8; ++e) { gn.gqa[e] = a.g_q_a[8 * lq + e]; gn.gkv[e] = a.g_kv_a[8 * lk + e]; gn.gkr[e] = a.g_k_rope[8 * c4 + e]; }
        gn.dtb = a.dt_bias[lane & 7]; gn.alog = expf(a.a_log[lane & 7]);
    }
    if (run < NPT / 8) {
        const int row0 = run * 8, t0 = row0 & 2047;
        bf16x8 w0[3], w1[3], w2[3], wcur[3];
#pragma unroll
        for (int c3 = 0; c3 < 3; ++c3) {
            const bf16x8 zz = {0, 0, 0, 0, 0, 0, 0, 0}; w0[c3] = zz; w1[c3] = zz; w2[c3] = zz;
            if (t0 > 0) { const bf16_t* zp = a.Z() + (size_t)(row0 - 3) * ZW + 512 * c3 + 8 * lane; w0[c3] = *(const bf16x8*)zp; w1[c3] = *(const bf16x8*)(zp + ZW); w2[c3] = *(const bf16x8*)(zp + 2 * ZW); }
        }
        bf16x8 wnext[3]; PinTok tk, tkn;
#pragma unroll
        for (int c3 = 0; c3 < 3; ++c3) wnext[c3] = *(const bf16x8*)(a.Z() + (size_t)row0 * ZW + 512 * c3 + 8 * lane);
        tkn = pin_load(a, row0, lane);
#pragma unroll 1
        for (int k = 0; k < 8; ++k) {
            const int row = row0 + k;
#pragma unroll
            for (int c3 = 0; c3 < 3; ++c3) wcur[c3] = wnext[c3];
            tk = tkn;
            if (k < 7) {
#pragma unroll
                for (int c3 = 0; c3 < 3; ++c3) wnext[c3] = *(const bf16x8*)(a.Z() + (size_t)(row + 1) * ZW + 512 * c3 + 8 * lane);
                tkn = pin_load(a, row + 1, lane);
            }
            post_in_token(a, row, lane, wcs, w0, w1, w2, wcur, tk, gn);
#pragma unroll
            for (int c3 = 0; c3 < 3; ++c3) { w0[c3] = w1[c3]; w1[c3] = w2[c3]; w2[c3] = wcur[c3]; }
        }
    } else {
        {
            const int bsm = run - NPT / 8, row = NPT + bsm;
            bf16x8 w0[3], w1[3], w2[3], wcur[3];
#pragma unroll
            for (int c3 = 0; c3 < 3; ++c3) {
                const float* sp = a.state_conv + (size_t)bsm * 3 * 1536 + 512 * c3 + 8 * lane;
                float* cso = a.out + O_CSS + (size_t)bsm * 3 * 1536 + 512 * c3 + 8 * lane;
                float t0_[8], t1_[8], t2_[8], tc_[8];
#pragma unroll
                for (int e = 0; e < 8; ++e) { t0_[e] = sp[e]; t1_[e] = sp[1536 + e]; t2_[e] = sp[2 * 1536 + e]; }
                wcur[c3] = *(const bf16x8*)(a.Z() + (size_t)row * ZW + 512 * c3 + 8 * lane); bf8_to_f32(wcur[c3], tc_);
#pragma unroll
                for (int e = 0; e < 8; ++e) { cso[e] = t1_[e]; cso[1536 + e] = t2_[e]; cso[2 * 1536 + e] = tc_[e]; }
                w0[c3] = f32_to_bf8(t0_); w1[c3] = f32_to_bf8(t1_); w2[c3] = f32_to_bf8(t2_);
            }
            post_in_token(a, row, lane, wcs, w0, w1, w2, wcur, pin_load(a, row, lane), gn);
        }
    }
}

__device__ __forceinline__ void post_q_item(const MK& a, int idx, int lane) {
    const int row = idx >> 3, h = idx & 7;
    const float* q = a.Q() + (size_t)row * 768 + h * 96;
    float* o = a.qh() + ((size_t)row * 8 + h) * 96;
    const float v = q[lane];
    const float ss = wave_sum(v * v);
    o[lane] = v * rsqrtf(ss * (1.f / 64.f) + EPSV) * a.g_q_nope[lane];
    const float r = lane < 32 ? q[64 + lane] : 0.f;
    const float s2 = wave_sum(r * r);
    const float xn = lane < 32 ? r * rsqrtf(s2 * (1.f / 32.f) + EPSV) * a.g_q_rope[lane] : 0.f;
    const float other = __shfl_xor(xn, 16);
    const int i = lane & 15;
    const float* tb = a.ropecs() + (size_t)(row >= NPT ? 2048 : (row & 2047)) * 32;
    const float cs = tb[i], sn = tb[16 + i];
    const float ov = lane < 16 ? xn * cs - other * sn : other * sn + xn * cs;
    if (lane < 32) o[64 + lane] = ov;
}
__device__ __forceinline__ void post_kv_item(const MK& a, int idx, int lane) {
    const int row = idx >> 3, h = idx & 7;
    const float v = a.KV()[(size_t)row * 1024 + h * 128 + lane];
    const float ss = wave_sum(v * v);
    const float kn = v * rsqrtf(ss * (1.f / 64.f) + EPSV) * a.g_k_nope[lane];
    a.kh()[((size_t)row * 8 + h) * 64 + lane] = kn;
}

typedef float f32x16 __attribute__((ext_vector_type(16)));
typedef short s16x4 __attribute__((ext_vector_type(4)));
#define KST 104
#define VST 72
#define ATT_BUF (64 * KST * 2 + 64 * VST * 2)
__device__ __forceinline__ int crow32(int r, int hi) { return (r & 3) + 8 * (r >> 2) + 4 * hi; }
__device__ __forceinline__ s16x4 tr_read(const bf16_t* p) { return __builtin_bit_cast(s16x4, __builtin_amdgcn_ds_read_tr16_b64_v4i16((LAS s16x4*)(LAS void*)(unsigned)(size_t)p)); }
__device__ __forceinline__ bf16x8 pack8(const f32x16& x, int s) {
    u32x4 w; w.x = cvtpk(x[8 * s], x[8 * s + 1]); w.y = cvtpk(x[8 * s + 2], x[8 * s + 3]); w.z = cvtpk(x[8 * s + 4], x[8 * s + 5]); w.w = cvtpk(x[8 * s + 6], x[8 * s + 7]);
    return __builtin_bit_cast(bf16x8, w);
}
__device__ __forceinline__ void attn_block(const MK& a, int b, int h, int qb, char* smem) {
    const int tid = otid(), lane = tid & 63, wid = tid >> 6, r32 = lane & 31, hi = lane >> 5;
    const int qrow = qb * 256 + wid * 32 + r32;
    const int wq0 = qb * 256 + wid * 32;
    bf16x8 qf[6];
    {
        const float SCL = 0.14724445f;
        const bf16_t* Qg = a.qraw() + ((size_t)b * SEQ + qrow) * 768 + h * 96 + 8 * hi;
        float qv[6][8];
#pragma unroll
        for (int ds = 0; ds < 6; ++ds) bf8_to_f32(*(const bf16x8*)(Qg + 16 * ds), qv[ds]);
        float sn_ = 0.f, sr_ = 0.f;
#pragma unroll
        for (int j = 0; j < 8; ++j) { sn_ += qv[0][j] * qv[0][j] + qv[1][j] * qv[1][j] + qv[2][j] * qv[2][j] + qv[3][j] * qv[3][j]; sr_ += qv[4][j] * qv[4][j] + qv[5][j] * qv[5][j]; }
        sn_ = add_x32(sn_); sr_ = add_x32(sr_);
        const float rsn = rsqrtf(sn_ * (1.f / 64.f) + EPSV) * SCL, rsr = rsqrtf(sr_ * (1.f / 32.f) + EPSV);
#pragma unroll
        for (int ds = 0; ds < 4; ++ds) {
            float o[8];
#pragma unroll
            for (int j = 0; j < 8; ++j) o[j] = qv[ds][j] * rsn * a.g_q_nope[16 * ds + 8 * hi + j];
            qf[ds] = f32_to_bf8(o);
        }
        const float* tb = a.ropecs() + (size_t)qrow * 32 + 8 * hi;
        float o4[8], o5[8];
#pragma unroll
        for (int j = 0; j < 8; ++j) {
            const float x1 = qv[4][j] * rsr * a.g_q_rope[8 * hi + j], x2 = qv[5][j] * rsr * a.g_q_rope[16 + 8 * hi + j], cs = tb[j], sn = tb[16 + j];
            o4[j] = (x1 * cs - x2 * sn) * SCL; o5[j] = (x1 * sn + x2 * cs) * SCL;
        }
        qf[4] = f32_to_bf8(o4); qf[5] = f32_to_bf8(o5);
    }
    f32x16 o0, o1;
#pragma unroll
    for (int r = 0; r < 16; ++r) { o0[r] = 0.f; o1[r] = 0.f; }
    float m = 0.f, l = 0.f;
    f32x16 negm;
#pragma unroll
    for (int r = 0; r < 16; ++r) negm[r] = 0.f;
    const int nt = qb * 4 + 4;
    const int vr = tid >> 3, vc = tid & 7, rr_ = (tid >> 2) & 63, rc = tid & 3;
    const bf16_t* KVg = a.kvraw() + (size_t)b * SEQ * 1024 + h * 128 + (size_t)vr * 1024 + vc * 8;
    const bf16_t* KRg = a.krb() + (size_t)b * SEQ * 32 + (size_t)rr_ * 32 + rc * 8;
    float gk[8];
#pragma unroll
    for (int j = 0; j < 8; ++j) gk[j] = a.g_k_nope[8 * vc + j];
    bf16x8 kr0, kr1, vr0;
#define ATT_LOAD(tt) do { kr0 = *(const bf16x8*)(KVg + (size_t)(tt) * 64 * 1024); vr0 = *(const bf16x8*)(KVg + (size_t)(tt) * 64 * 1024 + 64); if (tid < 256) kr1 = *(const bf16x8*)(KRg + (size_t)(tt) * 64 * 32); } while (0)
#define ATT_STORE(buf) do { bf16_t* Ks_ = (bf16_t*)(smem + (buf) * ATT_BUF); bf16_t* Vs_ = Ks_ + 64 * KST; \
        float x_[8]; bf8_to_f32(kr0, x_); float ss_ = 0.f; _Pragma("unroll") for (int j = 0; j < 8; ++j) ss_ += x_[j] * x_[j]; \
        ss_ = sum8(ss_); const float rs_ = rsqrtf(ss_ * (1.f / 64.f) + EPSV); \
        _Pragma("unroll") for (int j = 0; j < 8; ++j) x_[j] *= rs_ * gk[j]; \
        *(bf16x8*)(Ks_ + vr * KST + vc * 8) = f32_to_bf8(x_); *(bf16x8*)(Vs_ + vr * VST + vc * 8) = vr0; \
        if (tid < 256) *(bf16x8*)(Ks_ + rr_ * KST + 64 + rc * 8) = kr1; } while (0)
    ATT_LOAD(0);
    __syncthreads();
    ATT_STORE(0);
    __syncthreads();
    const int i16 = lane & 15, qq = i16 >> 2, pp = i16 & 3, g1 = (lane >> 4) & 1;
    for (int t = 0; t < nt; ++t) {
        const bf16_t* Ks = (const bf16_t*)(smem + (t & 1) * ATT_BUF); const bf16_t* Vs = Ks + 64 * KST;
        if (t + 1 < nt) ATT_LOAD(t + 1);
        if (64 * t <= wq0 + 31) {
            f32x16 p0, p1;
#pragma unroll
            for (int ds = 0; ds < 6; ++ds) {
                const bf16x8 k0 = *(const bf16x8*)(Ks + r32 * KST + 16 * ds + 8 * hi);
                const bf16x8 k1 = *(const bf16x8*)(Ks + (32 + r32) * KST + 16 * ds + 8 * hi);
                if (ds == 0) { p0 = __builtin_amdgcn_mfma_f32_32x32x16_bf16(k0, qf[ds], negm, 0, 0, 0); p1 = __builtin_amdgcn_mfma_f32_32x32x16_bf16(k1, qf[ds], negm, 0, 0, 0); }
                else { p0 = __builtin_amdgcn_mfma_f32_32x32x16_bf16(k0, qf[ds], p0, 0, 0, 0); p1 = __builtin_amdgcn_mfma_f32_32x32x16_bf16(k1, qf[ds], p1, 0, 0, 0); }
            }
            if (64 * t + 63 > wq0) {
#pragma unroll
                for (int r = 0; r < 16; ++r) { const int kv = 64 * t + crow32(r, hi); if (kv > qrow) p0[r] = -INFINITY; if (kv + 32 > qrow) p1[r] = -INFINITY; }
            }
            float mx = fmaxf(p0[0], p1[0]);
#pragma unroll
            for (int r = 1; r < 16; ++r) mx = fmaxf(mx, fmaxf(p0[r], p1[r]));
            mx = max_x32(mx);
            const float delta = t == 0 ? mx : fmaxf(mx, 0.f);
            if (__any(delta != 0.f)) {
                m += delta;
                const float f = t == 0 ? 1.f : __builtin_amdgcn_exp2f(-delta);
#pragma unroll
                for (int r = 0; r < 16; ++r) { p0[r] -= delta; p1[r] -= delta; negm[r] = -m; o0[r] *= f; o1[r] *= f; }
                l *= f;
            }
            float rs = 0.f;
#pragma unroll
            for (int r = 0; r < 16; ++r) { p0[r] = __builtin_amdgcn_exp2f(p0[r]); p1[r] = __builtin_amdgcn_exp2f(p1[r]); rs += p0[r] + p1[r]; }
            l += rs;
            bf16x8 pf[4];
            pf[0] = pack8(p0, 0); pf[1] = pack8(p0, 1); pf[2] = pack8(p1, 0); pf[3] = pack8(p1, 1);
#pragma unroll
            for (int ks = 0; ks < 4; ++ks) {
                const bf16_t* vb0 = Vs + (16 * ks + 4 * hi + qq) * VST + 16 * g1 + 4 * pp;
                const s16x4 a0 = tr_read(vb0), a1 = tr_read(vb0 + 8 * VST);
                const s16x4 c0 = tr_read(vb0 + 32), c1 = tr_read(vb0 + 8 * VST + 32);
                const bf16x8 va = __builtin_shufflevector(a0, a1, 0, 1, 2, 3, 4, 5, 6, 7);
                const bf16x8 vc_ = __builtin_shufflevector(c0, c1, 0, 1, 2, 3, 4, 5, 6, 7);
                o0 = __builtin_amdgcn_mfma_f32_32x32x16_bf16(va, pf[ks], o0, 0, 0, 0);
                o1 = __builtin_amdgcn_mfma_f32_32x32x16_bf16(vc_, pf[ks], o1, 0, 0, 0);
            }
        }
        if (t + 1 < nt) ATT_STORE((t + 1) & 1);
        __syncthreads();
    }
    l = add_x32(l);
    const float il = 1.f / l;
    bf16_t* op = a.omix() + ((size_t)b * SEQ + qrow) * 1024 + 512 + h * 64;
#pragma unroll
    for (int g = 0; g < 4; ++g) {
        uint2 w0, w1;
        w0.x = pk2bf(o0[4 * g] * il, o0[4 * g + 1] * il); w0.y = pk2bf(o0[4 * g + 2] * il, o0[4 * g + 3] * il);
        w1.x = pk2bf(o1[4 * g] * il, o1[4 * g + 1] * il); w1.y = pk2bf(o1[4 * g + 2] * il, o1[4 * g + 3] * il);
        *(uint2*)(op + 8 * g + 4 * hi) = w0;
        *(uint2*)(op + 32 + 8 * g + 4 * hi) = w1;
    }
#undef ATT_LOAD
#undef ATT_STORE
}

__device__ __forceinline__ void gdn_unit(const MK& a, int b, int h, int dvg, const float* s0, float* sout, int row0, int T, int lane, char* wsm) {
    float (*sq)[64] = (float (*)[64])wsm;
    float (*sk)[64] = (float (*)[64])(wsm + 4096);
    float (*sv)[8] = (float (*)[8])(wsm + 8192);
    float* sg = (float*)(wsm + 8704);
    float* sb = (float*)(wsm + 8768);
    const int e = lane & 7, ko = lane >> 3, col = dvg * 8 + e;
    float S[8];
#pragma unroll
    for (int d = 0; d < 8; ++d) S[d] = s0 ? s0[(((size_t)b * 8 + h) * 64 + ko * 8 + d) * 64 + col] : 0.f;
    const size_t rbase = (size_t)row0 + (size_t)b * T;
    float pq[16], pk[16], pv0, pv1, pgb;
    {
        const int nt = T < 16 ? T : 16;
#pragma unroll
        for (int j = 0; j < 16; ++j) { const bool ok = j < nt; const size_t r = rbase + (ok ? j : 0); pq[j] = ok ? bf2f(a.qkv()[r * 1536 + h * 64 + lane]) : 0.f; pk[j] = ok ? bf2f(a.qkv()[r * 1536 + 512 + h * 64 + lane]) : 0.f; }
        { const int j0 = lane >> 3, j1 = j0 + 8; pv0 = j0 < nt ? bf2f(a.qkv()[(rbase + j0) * 1536 + 1024 + h * 64 + dvg * 8 + (lane & 7)]) : 0.f; pv1 = j1 < nt ? bf2f(a.qkv()[(rbase + j1) * 1536 + 1024 + h * 64 + dvg * 8 + (lane & 7)]) : 0.f; }
        { const int j = lane & 15; pgb = j < nt ? (lane < 16 ? a.gg()[(rbase + j) * 8 + h] : a.bb()[(rbase + j) * 8 + h]) : 0.f; }
    }
    for (int t0 = 0; t0 < T; t0 += 16) {
        const int nt = (T - t0) < 16 ? (T - t0) : 16;
        WSYNC();
#pragma unroll
        for (int j = 0; j < 16; ++j) { sq[j][lane] = pq[j]; sk[j][lane] = pk[j]; }
        sv[lane >> 3][lane & 7] = pv0; sv[(lane >> 3) + 8][lane & 7] = pv1;
        if (lane < 16) sg[lane] = expf(pgb); else if (lane < 32) sb[lane - 16] = pgb;
        WSYNC();
        if (t0 + 16 < T) {
            const size_t rb = rbase + t0 + 16;
#pragma unroll
            for (int j = 0; j < 16; ++j) { pq[j] = bf2f(a.qkv()[(rb + j) * 1536 + h * 64 + lane]); pk[j] = bf2f(a.qkv()[(rb + j) * 1536 + 512 + h * 64 + lane]); }
            pv0 = bf2f(a.qkv()[(rb + (lane >> 3)) * 1536 + 1024 + h * 64 + dvg * 8 + (lane & 7)]); pv1 = bf2f(a.qkv()[(rb + (lane >> 3) + 8) * 1536 + 1024 + h * 64 + dvg * 8 + (lane & 7)]);
            pgb = lane < 16 ? a.gg()[(rb + (lane & 15)) * 8 + h] : a.bb()[(rb + (lane & 15)) * 8 + h];
        }
        for (int j = 0; j < nt; ++j) {
            const float dec = sg[j], be = sb[j], v = sv[j][e];
            const float4 k0 = *(const float4*)&sk[j][ko * 8], k1 = *(const float4*)&sk[j][ko * 8 + 4];
            const float4 q0 = *(const float4*)&sq[j][ko * 8], q1 = *(const float4*)&sq[j][ko * 8 + 4];
            const float kk[8] = {k0.x, k0.y, k0.z, k0.w, k1.x, k1.y, k1.z, k1.w};
            const float qq[8] = {q0.x, q0.y, q0.z, q0.w, q1.x, q1.y, q1.z, q1.w};
            float ks = 0.f;
#pragma unroll
            for (int d = 0; d < 8; ++d) { S[d] *= dec; ks += kk[d] * S[d]; }
            ks += __shfl_xor(ks, 8); ks += __shfl_xor(ks, 16); ks += __shfl_xor(ks, 32);
            const float delta = (v - ks) * be;
            float ov = 0.f;
#pragma unroll
            for (int d = 0; d < 8; ++d) { S[d] += kk[d] * delta; ov += qq[d] * S[d]; }
            ov += __shfl_xor(ov, 8); ov += __shfl_xor(ov, 16); ov += __shfl_xor(ov, 32);
            if (ko == 0) a.goraw()[(rbase + t0 + j) * 512 + h * 64 + col] = ov;
        }
    }
#pragma unroll
    for (int d = 0; d < 8; ++d) sout[(((size_t)b * 8 + h) * 64 + ko * 8 + d) * 64 + col] = S[d];
}
__device__ __forceinline__ int pi_pos(int k) { return (k & 32) + 8 * ((k >> 2) & 3) + 4 * ((k >> 4) & 1) + (k & 3); }
#define GDN_WLDS 17408
__device__ __forceinline__ void gdn_prep_unit(const MK& a, int u, int lane_in, char* wsm) {
    int lane = lane_in; asm volatile("" : "+v"(lane));
    const int bh = u >> 5, n = u & 31, b = bh >> 3, h = bh & 7, i16 = lane & 15, q4 = lane >> 4;
    const size_t row0 = (size_t)b * SEQ + n * 64;
    float* AT = (float*)wsm; float* GC = (float*)(wsm + 16384); float* BT = GC + 64;
    const bf16_t* qbase = a.qkv() + row0 * 1536 + h * 64; const bf16_t* kbase = qbase + 512; const bf16_t* vbase = qbase + 1024;
    float g = a.gg()[(row0 + lane) * 8 + h];
    const float be_l = a.bb()[(row0 + lane) * 8 + h];
#pragma unroll
    for (int o = 1; o < 64; o <<= 1) { const float t = __shfl_up(g, o); if (lane >= o) g += t; }
    WSYNC();
    GC[lane] = g; BT[lane] = be_l;
    WSYNC();
    const float gl = GC[63];
    float* EG = BT + 64; float* ED = EG + 64;
    EG[lane] = expf(g); ED[lane] = expf(gl - g);
    WSYNC();
    bf16x8 kf[4][2], qf[4][2];
#pragma unroll
    for (int mt = 0; mt < 4; ++mt)
#pragma unroll
        for (int ks = 0; ks < 2; ++ks) {
            const int off = (16 * mt + i16) * 1536 + 32 * ks + 8 * q4;
            kf[mt][ks] = *(const bf16x8*)(kbase + off); qf[mt][ks] = *(const bf16x8*)(qbase + off);
        }
    bf16_t* QKg = a.gQK() + (size_t)u * 4096;
#pragma unroll
    for (int mt = 0; mt < 4; ++mt)
#pragma unroll
        for (int nt = 0; nt < 4; ++nt) {
            const int j = 16 * nt + i16, pj = 32 * (nt >> 1) + 8 * (i16 >> 2) + 4 * (nt & 1) + (i16 & 3);
            if (nt <= mt) {
                f32x4 d1 = {0.f, 0.f, 0.f, 0.f}, d2 = {0.f, 0.f, 0.f, 0.f};
#pragma unroll
                for (int ks = 0; ks < 2; ++ks) {
                    d1 = __builtin_amdgcn_mfma_f32_16x16x32_bf16(kf[mt][ks], kf[nt][ks], d1, 0, 0, 0);
                    d2 = __builtin_amdgcn_mfma_f32_16x16x32_bf16(qf[mt][ks], kf[nt][ks], d2, 0, 0, 0);
                }
                const float gcj = GC[j];
#pragma unroll
                for (int r = 0; r < 4; ++r) {
                    const int i = 16 * mt + 4 * q4 + r;
                    const float dec = __builtin_amdgcn_exp2f(1.44269504f * (GC[i] - gcj));
                    AT[i * 64 + j] = (i > j) ? BT[i] * d1[r] * dec : 0.f;
                    QKg[i * 64 + (((pj >> 3) ^ (i & 7)) << 3) + (pj & 7)] = f2bf((i >= j) ? d2[r] * dec : 0.f);
                }
            } else {
#pragma unroll
                for (int r = 0; r < 4; ++r) { const int i = 16 * mt + 4 * q4 + r; QKg[i * 64 + (((pj >> 3) ^ (i & 7)) << 3) + (pj & 7)] = 0; }
            }
        }
    {
        bf16_t* Qgg = a.gQg() + (size_t)u * 4096;
#pragma unroll
        for (int mt = 0; mt < 4; ++mt) {
            const int i = 16 * mt + i16; const float e = EG[i];
#pragma unroll
            for (int ks = 0; ks < 2; ++ks) {
                float x[8]; bf8_to_f32(qf[mt][ks], x);
                uint2 w0, w1; w0.x = cvtpk(x[0] * e, x[1] * e); w0.y = cvtpk(x[2] * e, x[3] * e); w1.x = cvtpk(x[4] * e, x[5] * e); w1.y = cvtpk(x[6] * e, x[7] * e);
                const int p0 = 32 * ks + 16 * (q4 & 1) + 4 * (q4 >> 1);
                *(uint2*)(Qgg + i * 64 + (((p0 >> 3) ^ (i & 7)) << 3) + (p0 & 7)) = w0; *(uint2*)(Qgg + i * 64 + ((((p0 >> 3) + 1) ^ (i & 7)) << 3) + (p0 & 7)) = w1;
            }
        }
    }
    WSYNC();
    __builtin_amdgcn_sched_barrier(0);
    {
        float U[64];
#pragma unroll
        for (int i = 0; i < 64; ++i) { U[i] = bf2f(vbase[i * 1536 + lane]) * BT[i]; }
#pragma unroll
        for (int i = 1; i < 64; ++i) {
            float su = 0.f;
#pragma unroll
            for (int j4 = 0; j4 < i; j4 += 4) {
                const float4 av = *(const float4*)(AT + i * 64 + j4);
                su += av.x * U[j4];
                if (j4 + 1 < i) su += av.y * U[j4 + 1];
                if (j4 + 2 < i) su += av.z * U[j4 + 2];
                if (j4 + 3 < i) su += av.w * U[j4 + 3];
            }
            U[i] -= su;
            __builtin_amdgcn_sched_barrier(0);
        }
        float* UTg = a.gUT() + ((size_t)u * 64 + lane) * 64;
#pragma unroll
        for (int i = 0; i < 64; i += 4) *(float4*)(UTg + 4 * ((i >> 2) ^ (lane & 15))) = (float4){U[i], U[i + 1], U[i + 2], U[i + 3]};
    }
    asm volatile("" ::: "memory");
    __builtin_amdgcn_sched_barrier(0);
    {
        float W[64];
#pragma unroll
        for (int i = 0; i < 64; ++i) { W[i] = bf2f(kbase[i * 1536 + lane]); }
        bf16_t* Kdg = a.gKd() + ((size_t)u * 64 + lane) * 64;
#pragma unroll
        for (int pc = 0; pc < 8; ++pc) {
            float t[8];
#pragma unroll
            for (int jj = 0; jj < 8; ++jj) { const int j = 32 * (pc >> 2) + 16 * (jj >> 2) + 4 * (pc & 3) + (jj & 3); t[jj] = W[j] * ED[j]; }
            u32x4 w; w.x = cvtpk(t[0], t[1]); w.y = cvtpk(t[2], t[3]); w.z = cvtpk(t[4], t[5]); w.w = cvtpk(t[6], t[7]);
            *(u32x4*)(Kdg + 8 * (pc ^ (lane & 7))) = w;
        }
#pragma unroll
        for (int i = 0; i < 64; ++i) W[i] *= BT[i] * EG[i];
#pragma unroll
        for (int i = 1; i < 64; ++i) {
            float sw = 0.f;
#pragma unroll
            for (int j4 = 0; j4 < i; j4 += 4) {
                const float4 av = *(const float4*)(AT + i * 64 + j4);
                sw += av.x * W[j4];
                if (j4 + 1 < i) sw += av.y * W[j4 + 1];
                if (j4 + 2 < i) sw += av.z * W[j4 + 2];
                if (j4 + 3 < i) sw += av.w * W[j4 + 3];
            }
            W[i] -= sw;
            __builtin_amdgcn_sched_barrier(0);
        }
        bf16_t* Wng = a.gWn() + (size_t)u * 4096; const int pp = pi_pos(lane);
#pragma unroll
        for (int i = 0; i < 64; ++i) Wng[i * 64 + (((pp >> 3) ^ (i & 7)) << 3) + (pp & 7)] = f2bf(-W[i]);
    }
    if (lane == 0) a.ggam()[u] = expf(gl);
}
__device__ __forceinline__ bf16x8 pack_acc2(const f32x4& x, const f32x4& y) {
    u32x4 w; w.x = cvtpk(x[0], x[1]); w.y = cvtpk(x[2], x[3]); w.z = cvtpk(y[0], y[1]); w.w = cvtpk(y[2], y[3]);
    return __builtin_bit_cast(bf16x8, w);
}
#define G2_SLOT 49152
__device__ __forceinline__ void g2_issue(const MK& a, size_t u, int n, LAS unsigned char* lds, int lw, int lane) {
    LAS unsigned char* dst = lds + (n % 3) * G2_SLOT;
    const char* srcs[4] = {(const char*)(a.gWn() + u * 4096), (const char*)(a.gQg() + u * 4096), (const char*)(a.gQK() + u * 4096), (const char*)(a.gKd() + u * 4096)};
#pragma unroll
    for (int m = 0; m < 4; ++m)
#pragma unroll
        for (int i = 0; i < 2; ++i) { const int piece = 2 * lw + i;
            __builtin_amdgcn_global_load_lds((const unsigned*)(srcs[m] + piece * 1024 + lane * 16), (LAS unsigned*)(dst + m * 8192 + piece * 1024), 16, 0, 0); }
    const char* us = (const char*)(a.gUT() + u * 4096);
#pragma unroll
    for (int i = 0; i < 4; ++i) { const int piece = 4 * lw + i;
        __builtin_amdgcn_global_load_lds((const unsigned*)(us + piece * 1024 + lane * 16), (LAS unsigned*)(dst + 32768 + piece * 1024), 16, 0, 0); }
}
__device__ __forceinline__ void gdn_scan_block(const MK& a, int bh, LAS unsigned char* lds) {
    const int tid = otid(), lane = tid & 63, wid = __builtin_amdgcn_readfirstlane(tid >> 6), i16 = lane & 15, q4 = lane >> 4;
    const int b = bh >> 3, h = bh & 7, sl = wid & 3;
    const bool loader = wid >= 4;
    f32x4 S[4];
#pragma unroll
    for (int mt = 0; mt < 4; ++mt) S[mt] = (f32x4){0.f, 0.f, 0.f, 0.f};
    __syncthreads();
    if (loader) { g2_issue(a, (size_t)bh * 32, 0, lds, wid - 4, lane); g2_issue(a, (size_t)bh * 32 + 1, 1, lds, wid - 4, lane); }
    for (int n = 0; n < 32; ++n) {
        if (loader) { if (n < 31) asm volatile("s_waitcnt vmcnt(12)" ::: "memory"); else asm volatile("s_waitcnt vmcnt(0)" ::: "memory"); }
        asm volatile("s_waitcnt lgkmcnt(0)" ::: "memory"); __builtin_amdgcn_s_barrier(); asm volatile("" ::: "memory");
        if (loader) { if (n + 2 < 32) g2_issue(a, (size_t)bh * 32 + n + 2, n + 2, lds, wid - 4, lane); }
        else {
            const LAS unsigned char* sb = lds + (n % 3) * G2_SLOT;
            const float gam = a.ggam()[(size_t)bh * 32 + n];
            bf16x8 Sb[2]; Sb[0] = pack_acc2(S[0], S[1]); Sb[1] = pack_acc2(S[2], S[3]);
            f32x4 Vn[4];
#pragma unroll
            for (int mt = 0; mt < 4; ++mt) Vn[mt] = *(const LAS f32x4*)(sb + 32768 + (16 * sl + i16) * 256 + 16 * ((4 * mt + q4) ^ i16));
#pragma unroll
            for (int mt = 0; mt < 4; ++mt)
#pragma unroll
                for (int ks = 0; ks < 2; ++ks) Vn[mt] = __builtin_amdgcn_mfma_f32_16x16x32_bf16(*(const LAS bf16x8*)(sb + (16 * mt + i16) * 128 + 16 * ((4 * ks + q4) ^ (i16 & 7))), Sb[ks], Vn[mt], 0, 0, 0);
            bf16x8 Vb[2]; Vb[0] = pack_acc2(Vn[0], Vn[1]); Vb[1] = pack_acc2(Vn[2], Vn[3]);
            f32x4 O[4];
#pragma unroll
            for (int mt = 0; mt < 4; ++mt) {
                O[mt] = (f32x4){0.f, 0.f, 0.f, 0.f};
#pragma unroll
                for (int ks = 0; ks < 2; ++ks) {
                    const int fo = (16 * mt + i16) * 128 + 16 * ((4 * ks + q4) ^ (i16 & 7));
                    O[mt] = __builtin_amdgcn_mfma_f32_16x16x32_bf16(*(const LAS bf16x8*)(sb + 8192 + fo), Sb[ks], O[mt], 0, 0, 0);
                    O[mt] = __builtin_amdgcn_mfma_f32_16x16x32_bf16(*(const LAS bf16x8*)(sb + 16384 + fo), Vb[ks], O[mt], 0, 0, 0);
                }
            }
#pragma unroll
            for (int mt = 0; mt < 4; ++mt) {
                S[mt] = S[mt] * gam;
#pragma unroll
                for (int ks = 0; ks < 2; ++ks) S[mt] = __builtin_amdgcn_mfma_f32_16x16x32_bf16(*(const LAS bf16x8*)(sb + 24576 + (16 * mt + i16) * 128 + 16 * ((4 * ks + q4) ^ (i16 & 7))), Vb[ks], S[mt], 0, 0, 0);
            }
            float* og = a.goraw() + ((size_t)b * SEQ + n * 64 + 4 * q4) * 512 + h * 64 + 16 * sl + i16;
#pragma unroll
            for (int mt = 0; mt < 4; ++mt)
#pragma unroll
                for (int r = 0; r < 4; ++r) og[(size_t)(16 * mt + r) * 512] = O[mt][r];
        }
    }
    if (!loader) {
        float* so = a.out + O_GSP + ((size_t)bh * 64 + 4 * q4) * 64 + 16 * sl + i16;
#pragma unroll
        for (int mt = 0; mt < 4; ++mt)
#pragma unroll
            for (int r = 0; r < 4; ++r) so[(size_t)(16 * mt + r) * 64] = S[mt][r];
    }
    __syncthreads();
}
__device__ __forceinline__ void gdn_out_token(const MK& a, int row, int lane) {
    const float* op = a.goraw() + (size_t)row * 512 + 8 * lane;
    const float4 x0 = *(const float4*)op, x1 = *(const float4*)(op + 4);
    float o[8] = {x0.x, x0.y, x0.z, x0.w, x1.x, x1.y, x1.z, x1.w}, zg[8];
    bf8_to_f32(*(const bf16x8*)(a.Z() + (size_t)row * ZW + OFF_Z + 8 * lane), zg);
    float ss = 0.f;
#pragma unroll
    for (int e = 0; e < 8; ++e) ss += o[e] * o[e];
    ss = sum8(ss);
    const float rs = rsqrtf(ss * (1.f / 64.f) + EPSV);
    const float4 g0 = *(const float4*)(a.g_gdn_out + 8 * (lane & 7)), g1 = *(const float4*)(a.g_gdn_out + 8 * (lane & 7) + 4);
    const float gg_[8] = {g0.x, g0.y, g0.z, g0.w, g1.x, g1.y, g1.z, g1.w};
#pragma unroll
    for (int e = 0; e < 8; ++e) o[e] = o[e] * rs * gg_[e] * zg[e] * fast_sigmoid(zg[e]);
    *(bf16x8*)(a.omix() + (size_t)row * 1024 + 8 * lane) = f32_to_bf8(o);
}

#define SSLOT 32768
#define TL_OFF (3 * SSLOT)
#define CST 264
#define KR_OFF (TL_OFF + 2 * 32 * CST * 2)
#define WQ_OFF (KR_OFF + 4 * 4096)
#define QR_OFF (WQ_OFF + 2048)
#define PG_OFF (QR_OFF + 1024)
#define PT_OFF (PG_OFF + 64)
#define AL_OFF (PT_OFF + 1024)
#define SAMP_LDS_END (AL_OFF + 64)
__device__ __forceinline__ void samp_issue(const MK& a, int g, LAS unsigned char* lds, int wid, int lane) {
    const int phys = __builtin_amdgcn_readfirstlane(((const LAS int*)(lds + PG_OFF))[g >> 2]);
    const int tok0 = (g & 3) * 32 + 4 * wid;
    const float* cs = a.cache_ckv + ((size_t)phys * 128 + tok0) * 256 + lane * 4;
#pragma unroll
    for (int i = 0; i < 4; ++i) __builtin_amdgcn_global_load_lds((const unsigned*)(cs + i * 256), (LAS unsigned*)(lds + (g % 3) * SSLOT + (4 * wid + i) * 1024), 16, 0, 0);
    if (wid < 4) __builtin_amdgcn_global_load_lds((const unsigned*)(a.cache_krope + ((size_t)phys * 128 + (g & 3) * 32 + 8 * wid) * 32 + lane * 4), (LAS unsigned*)(lds + KR_OFF + (g & 3) * 4096 + wid * 1024), 16, 0, 0);
}
__device__ __forceinline__ void samp_convert(int g, LAS unsigned char* lds, int tid) {
    const int st = tid >> 4, c16 = (tid & 15) * 16;
    const LAS float* src = (const LAS float*)(lds + (g % 3) * SSLOT) + st * 256 + c16;
    const f32x4 x0 = *(const LAS f32x4*)src, x1 = *(const LAS f32x4*)(src + 4), x2 = *(const LAS f32x4*)(src + 8), x3 = *(const LAS f32x4*)(src + 12);
    u32x4 w0, w1; w0.x = cvtpk(x0[0], x0[1]); w0.y = cvtpk(x0[2], x0[3]); w0.z = cvtpk(x1[0], x1[1]); w0.w = cvtpk(x1[2], x1[3]);
    w1.x = cvtpk(x2[0], x2[1]); w1.y = cvtpk(x2[2], x2[3]); w1.z = cvtpk(x3[0], x3[1]); w1.w = cvtpk(x3[2], x3[3]);
    LAS bf16_t* dst = (LAS bf16_t*)(lds + TL_OFF + (g & 1) * 32 * CST * 2) + st * CST + c16;
    *(LAS u32x4*)dst = w0; *(LAS u32x4*)(dst + 8) = w1;
}
#define SAMP_WAITV(n5, n4) do { if (h < 4) asm volatile("s_waitcnt vmcnt(" #n5 ")" ::: "memory"); else asm volatile("s_waitcnt vmcnt(" #n4 ")" ::: "memory"); } while (0)
#define SAMP_BAR() do { asm volatile("s_waitcnt lgkmcnt(0)" ::: "memory"); __builtin_amdgcn_s_barrier(); asm volatile("" ::: "memory"); } while (0)
__device__ __forceinline__ void samp_attn_unit(const MK& a, int u, char* smem, LAS unsigned char* lds) {
    const int tid = otid(), lane = tid & 63, h = __builtin_amdgcn_readfirstlane(tid >> 6), i16 = lane & 15, q4 = lane >> 4;
    const int b = u >> 3, sp = u & 7;
    float* WQ = (float*)(smem + WQ_OFF);
    float* QR = (float*)(smem + QR_OFF);
    int* PG = (int*)(smem + PG_OFF);
    const float SCL = 0.14724445f;
    post_q_item(a, (NPT + b) * 8 + h, lane);
    __syncthreads();
    {
        const int h_ = tid >> 6, l_ = tid & 63, q4_ = l_ >> 4, idx = l_ & 15, d = 16 * (idx >> 2) + 4 * q4_ + (idx & 3);
        WQ[tid] = a.g_k_nope[d] * a.qh()[((size_t)(NPT + b) * 8 + h_) * 96 + d] * SCL;
        if (tid < 256) QR[tid] = a.qh()[((size_t)(NPT + b) * 8 + (tid >> 5)) * 96 + 64 + (tid & 31)] * SCL;
        if (tid < 16) PG[tid] = a.page_table[b * NPAGES + sp * 16 + tid];
    }
    bf16x8 wf[4][8];
#pragma unroll
    for (int mt = 0; mt < 4; ++mt)
#pragma unroll
        for (int ks = 0; ks < 8; ++ks) wf[mt][ks] = *(const bf16x8*)(a.WknT() + (size_t)(h * 64 + 16 * mt + i16) * 256 + 32 * ks + 8 * q4);
#pragma unroll
    for (int mt = 0; mt < 4; ++mt)
#pragma unroll
        for (int ks = 0; ks < 8; ++ks) asm volatile("" : "+v"(wf[mt][ks]));
    __syncthreads();
    samp_issue(a, 0, lds, h, lane); samp_issue(a, 1, lds, h, lane); samp_issue(a, 2, lds, h, lane);
    SAMP_WAITV(10, 8);
    SAMP_BAR();
    samp_convert(0, lds, tid);
    const LAS float* QRl = (const LAS float*)(lds + QR_OFF) + h * 32 + 8 * q4;
    const LAS float* WQl = (const LAS float*)(lds + WQ_OFF) + (h * 4 + q4) * 16;
    float m = -INFINITY, lsum = 0.f;
    f32x4 latv[2]; latv[0] = (f32x4){0.f, 0.f, 0.f, 0.f}; latv[1] = (f32x4){0.f, 0.f, 0.f, 0.f};
    for (int g = 0; g < 64; ++g) {
        SAMP_BAR();
        if (g + 3 < 64) samp_issue(a, g + 3, lds, h, lane);
        const LAS bf16_t* Tl = (const LAS bf16_t*)(lds + TL_OFF + (g & 1) * 32 * CST * 2); const LAS float* KR = (const LAS float*)(lds + KR_OFF + (g & 3) * 4096);
        float sc[2];
        {
            f32x4 acc[2][4];
#pragma unroll
            for (int hf = 0; hf < 2; ++hf)
#pragma unroll
                for (int mt = 0; mt < 4; ++mt) acc[hf][mt] = (f32x4){0.f, 0.f, 0.f, 0.f};
            const LAS bf16_t* cp0 = Tl + i16 * CST + 8 * q4; const LAS bf16_t* cp1 = cp0 + 16 * CST;
            bf16x8 c0 = *(const LAS bf16x8*)cp0, c1 = *(const LAS bf16x8*)cp1;
#pragma unroll
            for (int ks = 0; ks < 8; ++ks) {
                bf16x8 n0 = c0, n1 = c1;
                if (ks < 7) { n0 = *(const LAS bf16x8*)(cp0 + 32 * (ks + 1)); n1 = *(const LAS bf16x8*)(cp1 + 32 * (ks + 1)); }
#pragma unroll
                for (int mt = 0; mt < 4; ++mt) { acc[0][mt] = __builtin_amdgcn_mfma_f32_16x16x32_bf16(wf[mt][ks], c0, acc[0][mt], 0, 0, 0); acc[1][mt] = __builtin_amdgcn_mfma_f32_16x16x32_bf16(wf[mt][ks], c1, acc[1][mt], 0, 0, 0); }
                c0 = n0; c1 = n1;
            }
#pragma unroll
            for (int hf = 0; hf < 2; ++hf) {
                float ss = 0.f, dot = 0.f, rd = 0.f;
#pragma unroll
                for (int mt = 0; mt < 4; ++mt) {
                    const f32x4 wq = *(const LAS f32x4*)(WQl + 4 * mt);
                    ss += acc[hf][mt][0] * acc[hf][mt][0] + acc[hf][mt][1] * acc[hf][mt][1] + acc[hf][mt][2] * acc[hf][mt][2] + acc[hf][mt][3] * acc[hf][mt][3];
                    dot += acc[hf][mt][0] * wq[0] + acc[hf][mt][1] * wq[1] + acc[hf][mt][2] * wq[2] + acc[hf][mt][3] * wq[3];
                }
                {
                    const LAS float* kp = KR + (16 * hf + i16) * 32 + 8 * q4;
                    const f32x4 k0 = *(const LAS f32x4*)kp, k1 = *(const LAS f32x4*)(kp + 4), q0 = *(const LAS f32x4*)QRl, q1 = *(const LAS f32x4*)(QRl + 4);
                    rd = k0[0] * q0[0] + k0[1] * q0[1] + k0[2] * q0[2] + k0[3] * q0[3] + k1[0] * q1[0] + k1[1] * q1[1] + k1[2] * q1[2] + k1[3] * q1[3];
                }
                ss = add_x32(add_x16(ss)); dot = add_x32(add_x16(dot)); rd = add_x32(add_x16(rd));
                sc[hf] = dot * rsqrtf(ss * (1.f / 64.f) + EPSV) + rd;
            }
        }
        const float gm = max16(fmaxf(sc[0], sc[1]));
        const float mn = fmaxf(m, gm);
        const float alpha = __builtin_amdgcn_exp2f(m - mn), p0 = __builtin_amdgcn_exp2f(sc[0] - mn), p1 = __builtin_amdgcn_exp2f(sc[1] - mn);
        m = mn;
        lsum = lsum * alpha + p0 + p1;
        if (q4 == 0) { ((LAS float*)(lds + PT_OFF))[h * 32 + i16] = p0; ((LAS float*)(lds + PT_OFF))[h * 32 + 16 + i16] = p1; if (i16 == 0) ((LAS float*)(lds + AL_OFF))[h] = alpha; }
        if (g <= 60) SAMP_WAITV(10, 8); else if (g == 61) SAMP_WAITV(5, 4); else SAMP_WAITV(0, 0);
        SAMP_BAR();
        {
            u32x4 pw = {0u, 0u, 0u, 0u};
            if (i16 < 8) { const f32x4 pa = *(const LAS f32x4*)(lds + PT_OFF + (i16 * 32 + 8 * q4) * 4), pb_ = *(const LAS f32x4*)(lds + PT_OFF + (i16 * 32 + 8 * q4 + 4) * 4);
                pw.x = cvtpk(pa[0], pa[1]); pw.y = cvtpk(pa[2], pa[3]); pw.z = cvtpk(pb_[0], pb_[1]); pw.w = cvtpk(pb_[2], pb_[3]); }
            const bf16x8 pfr = __builtin_bit_cast(bf16x8, pw);
            const f32x4 al = *(const LAS f32x4*)(lds + AL_OFF + (q4 & 1) * 16);
            const bf16_t* tb0 = (const bf16_t*)(smem + TL_OFF + (g & 1) * 32 * CST * 2) + (8 * q4 + (i16 >> 2)) * CST + 32 * h + 4 * (i16 & 3);
#pragma unroll
            for (int nt = 0; nt < 2; ++nt) {
                const s16x4 c0 = tr_read(tb0 + 16 * nt), c1 = tr_read(tb0 + 16 * nt + 4 * CST);
                const bf16x8 cfr = __builtin_shufflevector(c0, c1, 0, 1, 2, 3, 4, 5, 6, 7);
                latv[nt] = latv[nt] * al;
                latv[nt] = __builtin_amdgcn_mfma_f32_16x16x32_bf16(pfr, cfr, latv[nt], 0, 0, 0);
            }
        }
        if (g + 1 < 64) samp_convert(g + 1, lds, tid);
    }
#pragma unroll
    for (int o = 1; o < 16; o <<= 1) lsum += __shfl_xor(lsum, o);
    if (lane == 0) { float* o = a.part() + ((size_t)u * 8 + h) * 260; o[0] = m * 0.69314718f; o[1] = lsum; }
    if (q4 < 2) {
#pragma unroll
        for (int nt = 0; nt < 2; ++nt)
#pragma unroll
            for (int r = 0; r < 4; ++r) a.part()[((size_t)u * 8 + 4 * q4 + r) * 260 + 4 + 32 * h + 16 * nt + i16] = latv[nt][r];
    }
}
__device__ __forceinline__ void samp_comb_unit(const MK& a, int u, char* smem) {
    float* slat = (float*)smem;
    const int b = u >> 3, h = u & 7, tid = otid() & 255;
    const size_t row = NPT + b;
    const float* q = a.qh() + (row * 8 + h) * 96;
    float s_self = 0.f;
    for (int d = 0; d < 64; ++d) s_self += q[d] * a.kh()[(row * 8 + h) * 64 + d];
    for (int d = 0; d < 32; ++d) s_self += q[64 + d] * a.krf()[row * 32 + d];
    s_self *= 0.10206207261596577f;
    float m = s_self;
    for (int s = 0; s < 8; ++s) m = fmaxf(m, a.part()[((size_t)(b * 8 + s) * 8 + h) * 260]);
    const float pself = expf(s_self - m);
    float l = pself, lat = 0.f;
    for (int s = 0; s < 8; ++s) {
        const float* p = a.part() + ((size_t)(b * 8 + s) * 8 + h) * 260;
        const float w = expf(p[0] - m);
        l += p[1] * w; lat += p[4 + tid] * w;
    }
    __syncthreads();
    slat[tid] = lat;
    __syncthreads();
    if (tid < 64) {
        float o = 0.f;
        for (int c = 0; c < 256; ++c) o += slat[c] * a.w_kv_b[(size_t)c * 1024 + h * 128 + 64 + tid];
        o += pself * a.KV()[row * 1024 + h * 128 + 64 + tid];
        a.omix()[row * 1024 + 512 + h * 64 + tid] = f2bf(o / l);
    }
}

#define XB_TMO      128
#define XB_XCNT(j)  (256  + 64 * (j))
#define XB_XSUB(j)  (1280 + 64 * (j))
#define XB_XGEN(j)  (2304 + 64 * (j))
#define XB_TOP      3328
#define XB_TOPGEN   3392
#define XCD_BAR_WORDS 3456
#define XB_SPIN_CAP (1u << 18)

__device__ __forceinline__ unsigned xb_ld(unsigned* p)              { return __hip_atomic_load(p, __ATOMIC_RELAXED, __HIP_MEMORY_SCOPE_AGENT); }
__device__ __forceinline__ unsigned xb_add(unsigned* p, unsigned v) { return __hip_atomic_fetch_add(p, v, __ATOMIC_RELAXED, __HIP_MEMORY_SCOPE_AGENT); }
__device__ __forceinline__ unsigned xb_xcc_id() { return (unsigned)__builtin_amdgcn_s_getreg((3 << 11) | 20) & 0xFu; }
#define XB_SPIN(cond, bar) do { unsigned _sp = 0; while (cond) { __builtin_amdgcn_s_sleep(1); \
    if ((++_sp & 255u) == 0u) { if (xb_ld(&(bar)[XB_TMO])) break; if (_sp > XB_SPIN_CAP) { atomicAdd(&(bar)[XB_TMO], 1u); break; } } } } while (0)

struct XcdBarrier {
    unsigned* bar; unsigned x;
    volatile LAS unsigned* st;
};

__device__ __forceinline__ XcdBarrier xcd_barrier_post(unsigned* bar, volatile LAS unsigned* st) {
    XcdBarrier b; b.bar = bar; b.x = xb_xcc_id(); b.st = st;
    if (threadIdx.x == 0) (void)xb_add(&bar[XB_XCNT(b.x)], 1u);
    return b;
}
__device__ __forceinline__ void xcd_barrier_complete(unsigned* bar, unsigned x, unsigned& nloc, unsigned& nx) {
    const unsigned G = gridDim.x * gridDim.y * gridDim.z;
    unsigned sum, cnt, mine, sp = 0u;
    for (;;) {
        sum = 0u; cnt = 0u; mine = 0u;
#pragma unroll
        for (unsigned j = 0; j < 16; ++j) { const unsigned c = xb_ld(&bar[XB_XCNT(j)]); sum += c; cnt += (c > 0u) ? 1u : 0u; mine = (j == x) ? c : mine; }
        if (sum == G) break;
        __builtin_amdgcn_s_sleep(1);
        if ((++sp & 255u) == 0u) { if (xb_ld(&bar[XB_TMO])) break; if (sp > XB_SPIN_CAP) { atomicAdd(&bar[XB_TMO], 1u); break; } }
    }
    nloc = mine > 0u ? mine : 1u; nx = cnt > 0u ? cnt : 1u;
}

__device__ __forceinline__ void xcd_barrier(const XcdBarrier& b) {
    asm volatile("s_waitcnt vmcnt(0)" ::: "memory");
    __syncthreads();
    if (threadIdx.x == 0) {
        unsigned* bar = b.bar;
        __builtin_amdgcn_s_waitcnt(0);
        unsigned nloc = b.st[0], nx = b.st[1];
        if (nloc == 0u) { xcd_barrier_complete(bar, b.x, nloc, nx); b.st[0] = nloc; b.st[1] = nx; }
        const unsigned old = xb_add(&bar[XB_XSUB(b.x)], 1u);
        const unsigned gen = old / nloc;
        if (old + 1u == (gen + 1u) * nloc) {
            __builtin_amdgcn_fence(__ATOMIC_RELEASE, "agent");
            asm volatile("s_waitcnt vmcnt(0)" ::: "memory");
            const unsigned og = xb_add(&bar[XB_TOP], 1u);
            const unsigned tg = og / nx;
            if (og + 1u == (tg + 1u) * nx) xb_add(&bar[XB_TOPGEN], 1u);
            else XB_SPIN(xb_ld(&bar[XB_TOPGEN]) == tg, bar);
            __builtin_amdgcn_fence(__ATOMIC_ACQUIRE, "agent");
            xb_add(&bar[XB_XGEN(b.x)], 1u);
            asm volatile("s_waitcnt vmcnt(0)" ::: "memory");
        } else {
            XB_SPIN(xb_ld(&bar[XB_XGEN(b.x)]) == gen, bar);
            __builtin_amdgcn_fence(__ATOMIC_ACQUIRE, "agent");
            asm volatile("s_waitcnt vmcnt(0)" ::: "memory");
        }
    }
    __syncthreads();
}

__device__ __forceinline__ void late_weight_items(const MK& a, int gwl, int ngwl, float* scr, int lane) {
    const int T4 = 32 * 16, T5 = 176 * 16, T7 = 32 * 44, T8 = 32 * 16, TT = T4 + T5 + T7 + T8;
    for (int it = gwl; it < TT; it += ngwl) {
        int r = it;
        if (r < T4) { const int nt_ = r % 32, kb = r / 32; wt_item(a.w_o, 1024, 32 * nt_, 32, a.WoT(), 1024, 32 * nt_, 64 * kb, scr, lane); continue; } r -= T4;
        if (r < T5) { const int nt_ = r % 176, kb = r / 176, pn = nt_ >> 3, wi = nt_ & 7;
            wt_item(wi < 4 ? a.w_gate : a.w_up, DFF, pn * 128 + (wi & 3) * 32, 32, a.WguT(), 1024, 32 * nt_, 64 * kb, scr, lane); continue; } r -= T5;
        if (r < T7) { const int nt_ = r % 32, kb = r / 32; wt_item(a.w_down, 1024, 32 * nt_, 32, a.WdT(), DFF, 32 * nt_, 64 * kb, scr, lane); continue; } r -= T7;
        { const int nt_ = r % 32, kb = r / 32; wt_item(a.w_ple_gate, 1024, 32 * nt_, 32, a.WpgT(), 1024, 32 * nt_, 64 * kb, scr, lane); }
    }
}

#define XB_ST_OFF 155648
#define LDS_BYTES 155904
static_assert(SAMP_LDS_END <= LDS_BYTES, "LDS map");
#define GSYNC() do { xcd_barrier(xbar); } while (0)
__global__ __launch_bounds__(NTHR, 2) void mega(MK a) {
    cg::grid_group grid = cg::this_grid();
    char* smem = (char*)lds_raw;
    LAS unsigned char* lds = (LAS unsigned char*)lds_raw;
    otid_init();
    if (threadIdx.x < 2) ((LAS unsigned*)(lds_raw + XB_ST_OFF))[threadIdx.x] = 0u;
    __syncthreads();
    const XcdBarrier xbar = xcd_barrier_post(a.ctl(), (volatile LAS unsigned*)(LAS void*)(lds_raw + XB_ST_OFF));
    const int bid = blockIdx.x, nb = gridDim.x, ngw = nb * NWAVE;
#define LOCAL_IDS const int tid = otid(), lane = tid & 63, wid = tid >> 6, half = tid >> 8, gw = bid * NWAVE + wid; (void)lane; (void)half; (void)gw; (void)wid;

    {
    LOCAL_IDS
    {
        const int T0 = 88 * 16, T1 = 24 * 6, T2 = 32 * 4, T3 = 16 * 4, T9 = 32 * 4;
        const int TT = T0 + T1 + T2 + T3 + T9;
        float* scr = (float*)(smem + wid * 8704);
        for (int it = gw; it < TT; it += ngw) {
            int r = it;
            if (r < T0) { const int nt_ = r % 88, kb = r / 88, nv = 2736 - 32 * nt_; wt_item(a.w_in, 2736, 32 * nt_, nv < 0 ? 0 : (nv > 32 ? 32 : nv), a.WinT(), 1024, 32 * nt_, 64 * kb, scr, lane); continue; } r -= T0;
            if (r < T1) { const int nt_ = r % 24, kb = r / 24; wt_item(a.w_q_b, 768, 32 * nt_, 32, a.WqbT(), 384, 32 * nt_, 64 * kb, scr, lane); continue; } r -= T1;
            if (r < T2) { const int nt_ = r % 32, kb = r / 32; wt_item(a.w_kv_b, 1024, 32 * nt_, 32, a.WkvT(), 256, 32 * nt_, 64 * kb, scr, lane); continue; } r -= T2;
            if (r < T3) { const int nt_ = r % 16, kb = r / 16, h = nt_ >> 1; wt_item(a.w_kv_b, 1024, h * 128 + 32 * (nt_ & 1), 32, a.WknT(), 256, 32 * nt_, 64 * kb, scr, lane); continue; } r -= T3;
            { const int nt_ = r % 32, kb = r / 32; wt_item(a.w_ple_proj, 1024, 32 * nt_, 32, a.WppT(), 256, 32 * nt_, 64 * kb, scr, lane); }
        }
        for (int e = (bid * NTHR + tid); e < 2049 * 16; e += nb * NTHR) {
            const int pos = e >> 4, i = e & 15; const float ang = (pos == 2048 ? (float)PAST : (float)pos) * powf(10000.f, -(float)i / 16.f);
            a.ropecs()[pos * 32 + i] = cosf(ang); a.ropecs()[pos * 32 + 16 + i] = sinf(ang);
        }
        for (int row = gw; row < MPAD; row += ngw) {
            const float* src = row < NPT ? a.x_prompt + (size_t)row * 1024 : a.x_sample + (size_t)(row < NTOK ? row - NPT : 0) * 1024;
            rms1024_row(src, a.g_attn, a.xn() + (size_t)row * 1024, row >= NTOK, lane);
            ushort4 w = {0, 0, 0, 0};
            if (row < NTOK) { const float* ps = row < NPT ? a.p_prompt + (size_t)row * 256 : a.p_sample + (size_t)(row - NPT) * 256; const float4 v = *(const float4*)(ps + lane * 4); w.x = f2bf(v.x); w.y = f2bf(v.y); w.z = f2bf(v.z); w.w = f2bf(v.w); }
            *(ushort4*)(a.pb() + (size_t)row * 256 + lane * 4) = w;
            if (row >= NTOK) { for (int j = 0; j < 4; ++j) { ushort4 z = {0, 0, 0, 0}; *(ushort4*)(a.omix() + (size_t)row * 1024 + lane * 4 + 256 * j) = z; } }
        }
    }
    }
    if (a.out == nullptr) grid.sync();
    GSYNC();
    {
    LOCAL_IDS
    pg_gemm(lds, a.xn(), a.WinT(), NPT, ZW, 1024, PgBf16{a.Z(), ZW});
    gemm_sample_rows_ks<false>(a.xn(), 1024, a.WinT(), 1024, ZW, EwBf16{a.Z(), ZW}, smem, bid, nb);
    }
    GSYNC();
    {
    LOCAL_IDS
    for (int e = tid; e < 4 * 1536 / 4; e += NTHR) ((float4*)smem)[e] = ((const float4*)a.w_conv)[e];
    __syncthreads();
    for (int run = gw; run < NPT / 8 + NST; run += ngw) post_in_run(a, run, lane, (const float*)smem);
    }
    GSYNC();
    {
    LOCAL_IDS
    for (int u = gw; u < 2048; u += ngw) gdn_prep_unit(a, u, lane, smem + wid * GDN_WLDS);
    }
    {
    LOCAL_IDS
    for (int v = gw; v < NST * 64; v += ngw) gdn_unit(a, v >> 6, (v >> 3) & 7, v & 7, a.state_gdn, a.out + O_GSS, NPT, 1, lane, smem + wid * GDN_WLDS);
    __syncthreads();
    }
    GSYNC();
    {
    LOCAL_IDS
    pg_gemm(lds, a.qan(), a.WqbT(), NPT, 768, 384, PgBf16{a.qraw(), 768});
    pg_gemm(lds, a.ckvb(), a.WkvT(), NPT, 1024, 256, PgBf16{a.kvraw(), 1024});
    gemm_sample_rows<false>(a.qan(), 384, a.WqbT(), 384, 768, EwF32{a.Q(), 768}, smem, bid, nb);
    gemm_sample_rows<false>(a.ckvb(), 256, a.WkvT(), 256, 1024, EwF32{a.KV(), 1024}, smem, bid, nb);
    for (int bh_ = nb - 1 - bid; bh_ < 64; bh_ += nb) gdn_scan_block(a, bh_, lds);
    if (nb > 64 && bid < nb - 64) {
        pg_gemm(lds, a.pb(), a.WppT(), NPT, 1024, 256, PgBf16{a.PP(), 1024}, nb - 64);
        __syncthreads();
        late_weight_items(a, bid * NWAVE + wid, (nb - 64) * NWAVE, (float*)(smem + wid * 8704), lane);
    } else if (nb <= 64) { pg_gemm(lds, a.pb(), a.WppT(), NPT, 1024, 256, PgBf16{a.PP(), 1024}); __syncthreads(); late_weight_items(a, gw, ngw, (float*)(smem + wid * 8704), lane); }
    gemm_sample_rows<false>(a.pb(), 256, a.WppT(), 256, 1024, EwBf16{a.PP(), 1024}, smem, bid, nb);
    }
    GSYNC();
    {
    LOCAL_IDS
    for (int idx = gw; idx < NST * 8; idx += ngw) { post_q_item(a, NPT * 8 + idx, lane); post_kv_item(a, NPT * 8 + idx, lane); }
    for (int row = gw; row < NTOK; row += ngw) gdn_out_token(a, row, lane);
    for (int pr = bid; pr < 256; pr += nb) { const int bh_ = pr >> 2, s_ = pr & 3; attn_block(a, bh_ >> 3, bh_ & 7, 7 - s_, smem); attn_block(a, bh_ >> 3, bh_ & 7, s_, smem); }
    for (int u = bid; u < NST * 8; u += nb) samp_attn_unit(a, u, smem, lds);
    }
    GSYNC();
    {
    LOCAL_IDS
    for (int u0 = bid * 2; u0 < NST * 8; u0 += nb * 2) samp_comb_unit(a, u0 + half, smem + half * 4096);
    }
    GSYNC();
    {
    LOCAL_IDS
    pg_gemm(lds, a.omix(), a.WoT(), NPT, 1024, 1024, PgResXB{a.x_prompt, a.H()});
    gemm_sample_rows_ks<false>(a.omix(), 1024, a.WoT(), 1024, 1024, EwResX{a.x_sample, a.H()}, smem, bid, nb);
    }
    GSYNC();
    {
    LOCAL_IDS
    for (int row = gw; row < MPAD; row += ngw) rms1024_row_b(a.H() + (size_t)row * 1024, a.g_ffn, a.un() + (size_t)row * 1024, row >= NTOK, lane);
    }
    GSYNC();
    {
    LOCAL_IDS
    pg_gemm(lds, a.un(), a.WguT(), NPT, 2 * DFF, 1024, PgSwiglu{a.hid()});
    gemm_sample_rows_ks<true>(a.un(), 1024, a.WguT(), 1024, 2 * DFF, EwBf16{a.hid(), DFF}, smem, bid, nb);
    }
    GSYNC();
    {
    LOCAL_IDS
    pg_gemm(lds, a.hid(), a.WdT(), NPT, 1024, DFF, PgResBB{a.H(), a.H2()});
    gemm_sample_rows_ks<false>(a.hid(), DFF, a.WdT(), DFF, 1024, EwResH{a.H(), a.H2()}, smem, bid, nb);
    }
    GSYNC();
    {
    LOCAL_IDS
    for (int row = gw; row < MPAD; row += ngw) rms1024_row_b(a.H2() + (size_t)row * 1024, a.g_ple, a.un2() + (size_t)row * 1024, row >= NTOK, lane);
    }
    GSYNC();
    {
    LOCAL_IDS
    pg_gemm(lds, a.un2(), a.WpgT(), NPT, 1024, 1024, PgPleB{a.H2(), a.PP(), a.out});
    gemm_sample_rows_ks<false>(a.un2(), 1024, a.WpgT(), 1024, 1024, EwPle{a.H2(), a.PP(), a.out}, smem, bid, nb);
    }
}

static inline char* carve(char*& p, size_t bytes) { char* r = p; p += (bytes + 255) & ~(size_t)255; return r; }

extern "C" void kernel_launch(void* const* d_in, const int* in_sizes, int n_in, void* d_out, int out_size, void* d_ws, size_t ws_size, hipStream_t stream) {
    MK a{};
    a.x_prompt = (const float*)d_in[0]; a.x_sample = (const float*)d_in[1]; a.cache_ckv = (const float*)d_in[2]; a.cache_krope = (const float*)d_in[3];
    a.state_gdn = (const float*)d_in[4]; a.state_conv = (const float*)d_in[5]; a.page_table = (const int*)d_in[6]; a.p_prompt = (const float*)d_in[7]; a.p_sample = (const float*)d_in[8];
    a.g_attn = (const float*)d_in[9]; a.w_in = (const float*)d_in[10]; a.w_conv = (const float*)d_in[11]; a.a_log = (const float*)d_in[12]; a.dt_bias = (const float*)d_in[13];
    a.g_gdn_out = (const float*)d_in[14]; a.g_q_a = (const float*)d_in[15]; a.w_q_b = (const float*)d_in[16]; a.g_q_nope = (const float*)d_in[17]; a.g_q_rope = (const float*)d_in[18];
    a.g_kv_a = (const float*)d_in[19]; a.g_k_rope = (const float*)d_in[20]; a.w_kv_b = (const float*)d_in[21]; a.g_k_nope = (const float*)d_in[22]; a.w_o = (const float*)d_in[23];
    a.g_ffn = (const float*)d_in[24]; a.w_gate = (const float*)d_in[25]; a.w_up = (const float*)d_in[26]; a.w_down = (const float*)d_in[27]; a.g_ple = (const float*)d_in[28];
    a.w_ple_gate = (const float*)d_in[29]; a.w_ple_proj = (const float*)d_in[30];
    a.out = (float*)d_out;
    a.ws = (char*)d_ws;
    if (WS_TOTAL > ws_size) { fprintf(stderr, "kernel_launch: workspace too small: need %zu have %zu\n", (size_t)WS_TOTAL, ws_size); return; }

    static int grid_blocks = 0;
    if (!grid_blocks) {
        int dev = 0, cus = 0, per_cu = 0;
        (void)hipGetDevice(&dev);
        (void)hipDeviceGetAttribute(&cus, hipDeviceAttributeMultiprocessorCount, dev);
        (void)hipFuncSetAttribute((const void*)mega, hipFuncAttributeMaxDynamicSharedMemorySize, LDS_BYTES);
        (void)hipOccupancyMaxActiveBlocksPerMultiprocessor(&per_cu, (const void*)mega, NTHR, LDS_BYTES);
        if (per_cu < 1) fprintf(stderr, "kernel_launch: occupancy query says %d blocks/CU\n", per_cu);
        grid_blocks = cus;
    }
    (void)hipMemsetAsync((char*)d_ws + WOF_ctl, 0, 16384, stream);
    void* args[] = {&a};
    hipError_t e = hipLaunchCooperativeKernel((const void*)mega, dim3(grid_blocks), dim3(NTHR), args, LDS_BYTES, stream);
    if (e != hipSuccess) fprintf(stderr, "cooperative launch failed: %s (grid %d)\n", hipGetErrorString(e), grid_blocks);
}
```

```cpp
#include <hip/hip_runtime.h>
#include <stdint.h>
#include <cstdio>
#include <hip/hip_cooperative_groups.h>
namespace cg = cooperative_groups;


__device__ __forceinline__ int otid();
#define PG8_TID() otid()
namespace pg8 {
#define PG8_LAS __attribute__((address_space(3)))
typedef unsigned short bf16_t;
typedef short bf16x8 __attribute__((ext_vector_type(8)));
typedef float f32x4 __attribute__((ext_vector_type(4)));
typedef unsigned u32x4 __attribute__((ext_vector_type(4)));
constexpr int BM = 256, BK = 64, HALF = 128, HTB = HALF * BK * 2  , STAGE_BYTES = 8 * HTB, NXCD = 8, WGM = 8;

__host__ __device__ __forceinline__ int lds_byte(int r, int c) { const int st = (r >> 4) * 2 + (c >> 5), rr = r & 15, cc = c & 31, ob = rr * 64 + cc * 2; return st * 1024 + (ob ^ (((ob >> 9) & 1) << 5)); }
__host__ __device__ __forceinline__ void stage_rc(int b, int& R, int& C) { const int st = b / 1024, sb = b % 1024, swz = sb ^ (((sb >> 9) & 1) << 5); R = (st >> 1) * 16 + swz / 64; C = (st & 1) * 32 + (swz % 64) / 2; }
__host__ __device__ __forceinline__ int perm32(int rho) { const int n = rho >> 4, i = rho & 15; return 8 * (i >> 2) + 4 * n + (i & 3); }

struct Unit { int pm, pn; };
struct Gemm { const bf16_t* A; const bf16_t* Bt; int M, N, K; };

struct StaticOrder {
    int nM, nN, nwg, G, c;
    __host__ __device__ void init(int M, int N, int G_, int c_) { nM = M / BM; nN = N / BM; nwg = nM * nN; G = G_; c = c_; }
    __host__ __device__ bool next(int i, Unit& u) const {
        const long L = (long)i * G + c; if (L >= nwg) return false;
        int wgid = (int)L; { const int q = nwg / NXCD, r = nwg % NXCD, xcd = wgid % NXCD, off = wgid / NXCD; wgid = (xcd < r ? xcd * (q + 1) : r * (q + 1) + (xcd - r) * q) + off; }
        const int nig = WGM * nN, gid = wgid / nig, fm = gid * WGM, gsz = (nM - fm) < WGM ? (nM - fm) : WGM;
        u.pm = fm + ((wgid % nig) % gsz); u.pn = (wgid % nig) / gsz; return true;
    }
    __device__ __forceinline__ void a_ready(const Unit&) const {}
    __device__ __forceinline__ void done(const Unit&) const {}
};

template <class Epi, class Sched, bool ALIGN_EPI = false, bool SP2 = false>
__device__ __forceinline__ void gemm_phase(PG8_LAS unsigned char* lds, const Gemm g, const Sched& S, const Epi& E) {
    const int tid = PG8_TID(), wid = __builtin_amdgcn_readfirstlane(tid >> 6), lane = tid & 63, wr = wid >> 2, wc = wid & 3, fr = lane & 15, fq = lane >> 4;
    const int K = g.K, nt = K / BK;
    unsigned voffA[2], voffB[2];
#pragma unroll
    for (int i = 0; i < 2; ++i) { int R, C; stage_rc(tid * 16 + i * 8192, R, C); const int Rb = Epi::PERM ? ((R & ~31) + perm32(R & 31)) : R;
        voffA[i] = (unsigned)(R * K + C) * 2u; voffB[i] = (unsigned)(Rb * K + C) * 2u; }
    const size_t kstep = (size_t)(BK * 2);
    const size_t hstep = (size_t)HALF * K * 2;
    const size_t tstep = 2 * hstep;
    const unsigned ldsw = (unsigned)wid * 1024u;
    const int aoff = lds_byte(wr * 64 + fr, fq * 8), boff = lds_byte(wc * 32 + fr, fq * 8);
#define PG8_SA(b, h) (((b) * 2 + (h)) * HTB)
#define PG8_SB(b, h) ((4 + (b) * 2 + (h)) * HTB)
#define PG8_STAGE(bufoff, gbase, voff) do { _Pragma("unroll") for (int _i = 0; _i < 2; ++_i) \
        __builtin_amdgcn_global_load_lds((const unsigned*)((const char*)(gbase) + (voff)[_i]), (PG8_LAS unsigned*)(lds + (bufoff) + ldsw + _i * 8192), 16, 0, 0); } while (0)
#define PG8_LDA(dst, b, h) do { _Pragma("unroll") for (int m = 0; m < 4; ++m) _Pragma("unroll") for (int k = 0; k < 2; ++k) dst[m][k] = *(const PG8_LAS bf16x8*)(lds + PG8_SA(b, h) + aoff + m * 2048 + k * 1024); } while (0)
#define PG8_LDB(dst, b, h) do { _Pragma("unroll") for (int n = 0; n < 2; ++n) _Pragma("unroll") for (int k = 0; k < 2; ++k) dst[n][k] = *(const PG8_LAS bf16x8*)(lds + PG8_SB(b, h) + boff + n * 2048 + k * 1024); } while (0)
#define PG8_MMA(ai, bj, At, Bt) do { __builtin_amdgcn_s_setprio(1); _Pragma("unroll") for (int m = 0; m < 4; ++m) _Pragma("unroll") for (int n = 0; n < 2; ++n) _Pragma("unroll") for (int k = 0; k < 2; ++k) \
        acc[ai][bj][m][n] = __builtin_amdgcn_mfma_f32_16x16x32_bf16(Bt[n][k], At[m][k], acc[ai][bj][m][n], 0, 0, 0); __builtin_amdgcn_s_setprio(0); } while (0)
#define PG8_WAIT_V(n) asm volatile("s_waitcnt vmcnt(" #n ")" ::: "memory")
#define PG8_WAIT_L(n) asm volatile("s_waitcnt lgkmcnt(" #n ")" ::: "memory")
#define PG8_BAR __builtin_amdgcn_s_barrier()
#define PG8_SCHED __builtin_amdgcn_sched_barrier(0)
    Unit cur, nxt; int ui = 0;
    if (!S.next(0, cur)) return;
    f32x4 acc[2][2][4][2];
#pragma unroll
    for (int a = 0; a < 2; ++a)
#pragma unroll
        for (int b = 0; b < 2; ++b)
#pragma unroll
            for (int m = 0; m < 4; ++m)
#pragma unroll
                for (int n = 0; n < 2; ++n) acc[a][b][m][n] = (f32x4){0.f, 0.f, 0.f, 0.f};
    bf16x8 At[4][2], B0[2][2], B1[2][2];
    const char* cA = (const char*)g.A + (size_t)cur.pm * tstep; const char* cB = (const char*)g.Bt + (size_t)cur.pn * tstep;
    S.a_ready(cur);
    if constexpr (SP2) {
        PG8_STAGE(PG8_SB(0, 0), cB, voffB); PG8_STAGE(PG8_SB(0, 1), cB + hstep, voffB); PG8_STAGE(PG8_SA(0, 0), cA, voffA); PG8_STAGE(PG8_SA(0, 1), cA + hstep, voffA);
        if (wr == 1) PG8_BAR;
        PG8_WAIT_V(2); PG8_BAR;
        PG8_STAGE(PG8_SB(1, 0), cB + kstep, voffB); PG8_STAGE(PG8_SA(1, 0), cA + kstep, voffA); PG8_STAGE(PG8_SB(1, 1), cB + hstep + kstep, voffB);
        PG8_WAIT_V(6); PG8_BAR;
    } else {
        PG8_STAGE(PG8_SB(0, 0), cB, voffB); PG8_STAGE(PG8_SA(0, 0), cA, voffA); PG8_STAGE(PG8_SB(0, 1), cB + hstep, voffB); PG8_STAGE(PG8_SA(0, 1), cA + hstep, voffA);
        if (wr == 1) PG8_BAR;
        PG8_WAIT_V(4); PG8_BAR;
        PG8_STAGE(PG8_SB(1, 0), cB + kstep, voffB); PG8_STAGE(PG8_SA(1, 0), cA + kstep, voffA); PG8_STAGE(PG8_SB(1, 1), cB + hstep + kstep, voffB);
        PG8_WAIT_V(6); PG8_BAR;
    }
    for (;;) {
        const bool has_next = S.next(ui + 1, nxt);
        const char* nA = has_next ? (const char*)g.A + (size_t)nxt.pm * tstep : cA; const char* nB = has_next ? (const char*)g.Bt + (size_t)nxt.pn * tstep : cB;
        for (int t = 0; t < nt; t += 2) {
            const bool last = (t == nt - 2);
            const char* a1 = cA + (size_t)(t + 1) * kstep;
            const char* a2 = last ? nA : cA + (size_t)(t + 2) * kstep; const char* b2 = last ? nB : cB + (size_t)(t + 2) * kstep;
            const char* a3 = a2 + kstep; const char* b3 = b2 + kstep;
            if (last && has_next) S.a_ready(nxt);
            if constexpr (SP2) {
            PG8_LDB(B0, 0, 0); PG8_LDB(B1, 0, 1); PG8_SCHED; PG8_LDA(At, 0, 0); PG8_STAGE(PG8_SA(1, 1), a1 + hstep, voffA);
            PG8_WAIT_V(8); PG8_WAIT_L(0); PG8_BAR; PG8_MMA(0, 0, At, B0); PG8_MMA(0, 1, At, B1); PG8_BAR; PG8_SCHED;
            PG8_LDA(At, 0, 1); PG8_STAGE(PG8_SB(0, 0), b2, voffB); PG8_STAGE(PG8_SB(0, 1), b2 + hstep, voffB); PG8_STAGE(PG8_SA(0, 0), a2, voffA);
            PG8_WAIT_V(8); PG8_WAIT_L(0); PG8_BAR; PG8_MMA(1, 0, At, B0); PG8_MMA(1, 1, At, B1); PG8_BAR; PG8_SCHED;
            PG8_LDB(B0, 1, 0); PG8_LDB(B1, 1, 1); PG8_SCHED; PG8_LDA(At, 1, 0); PG8_STAGE(PG8_SA(0, 1), a2 + hstep, voffA);
            PG8_WAIT_V(8); PG8_WAIT_L(0); PG8_BAR; PG8_MMA(0, 0, At, B0); PG8_MMA(0, 1, At, B1); PG8_BAR; PG8_SCHED;
            PG8_LDA(At, 1, 1); PG8_STAGE(PG8_SB(1, 0), b3, voffB); PG8_STAGE(PG8_SB(1, 1), b3 + hstep, voffB); PG8_STAGE(PG8_SA(1, 0), a3, voffA);
            PG8_WAIT_V(8); PG8_WAIT_L(0); PG8_BAR; PG8_MMA(1, 0, At, B0); PG8_MMA(1, 1, At, B1); PG8_BAR; PG8_SCHED;
            } else {
            PG8_LDB(B0, 0, 0); PG8_SCHED; PG8_LDA(At, 0, 0); PG8_STAGE(PG8_SA(1, 1), a1 + hstep, voffA);
            PG8_WAIT_L(8); PG8_BAR; PG8_WAIT_L(0); PG8_MMA(0, 0, At, B0); PG8_BAR; PG8_SCHED;
            PG8_LDB(B1, 0, 1); PG8_STAGE(PG8_SB(0, 0), b2, voffB);
            PG8_BAR; PG8_WAIT_L(0); PG8_MMA(0, 1, At, B1); PG8_BAR;
            PG8_LDA(At, 0, 1); PG8_STAGE(PG8_SA(0, 0), a2, voffA);
            PG8_BAR; PG8_WAIT_L(0); PG8_MMA(1, 0, At, B0); PG8_BAR; PG8_SCHED;
            PG8_STAGE(PG8_SB(0, 1), b2 + hstep, voffB);
            PG8_WAIT_V(6); PG8_BAR; PG8_MMA(1, 1, At, B1); PG8_BAR;
            PG8_LDB(B0, 1, 0); PG8_SCHED; PG8_LDA(At, 1, 0); PG8_STAGE(PG8_SA(0, 1), a2 + hstep, voffA);
            PG8_WAIT_L(8); PG8_BAR; PG8_WAIT_L(0); PG8_MMA(0, 0, At, B0); PG8_BAR; PG8_SCHED;
            PG8_LDB(B1, 1, 1); PG8_STAGE(PG8_SB(1, 0), b3, voffB);
            PG8_BAR; PG8_WAIT_L(0); PG8_MMA(0, 1, At, B1); PG8_BAR;
            PG8_LDA(At, 1, 1); PG8_STAGE(PG8_SA(1, 0), a3, voffA);
            PG8_BAR; PG8_WAIT_L(0); PG8_MMA(1, 0, At, B0); PG8_BAR; PG8_SCHED;
            PG8_STAGE(PG8_SB(1, 1), b3 + hstep, voffB);
            PG8_WAIT_V(6); PG8_BAR; PG8_MMA(1, 1, At, B1); PG8_BAR;
            }
        }
        if constexpr (ALIGN_EPI) { if (wr == 0) PG8_BAR; }
        if constexpr (!Epi::AFTER_DRAIN) { E(acc, cur, wr, wc, fr, fq); S.done(cur); }
        if (!has_next) break;
#pragma unroll
        for (int a = 0; a < 2; ++a)
#pragma unroll
            for (int b = 0; b < 2; ++b)
#pragma unroll
                for (int m = 0; m < 4; ++m)
#pragma unroll
                    for (int n = 0; n < 2; ++n) acc[a][b][m][n] = (f32x4){0.f, 0.f, 0.f, 0.f};
        cur = nxt; cA = nA; cB = nB; ++ui;
        if constexpr (ALIGN_EPI) { if (wr == 1) PG8_BAR; }
    }
    PG8_WAIT_V(0);
    if constexpr (!ALIGN_EPI) { if (wr == 0) PG8_BAR; }
    PG8_BAR;
    if constexpr (Epi::AFTER_DRAIN) { E.fused(acc, cur, wr, wc, fr, fq, lds, wid, lane); S.done(cur); }
#undef PG8_SA
#undef PG8_SB
#undef PG8_STAGE
#undef PG8_LDA
#undef PG8_LDB
#undef PG8_MMA
#undef PG8_WAIT_V
#undef PG8_WAIT_L
#undef PG8_BAR
#undef PG8_SCHED
}
}

#define WTAB_OFF 155392
extern __shared__ __attribute__((aligned(16))) unsigned char lds_raw[];
__device__ __forceinline__ int hw_slot() { return (int)(__builtin_amdgcn_s_getreg((5 << 11) | 4) & 63u); }
__device__ __forceinline__ void otid_init() { const int t = threadIdx.x; if ((t & 63) == 0) ((__attribute__((address_space(3))) int*)(__attribute__((address_space(3))) void*)(lds_raw + WTAB_OFF))[hw_slot()] = t >> 6; }
__device__ __forceinline__ int otid() {
    const int w = __builtin_amdgcn_readfirstlane(((const __attribute__((address_space(3))) int*)(__attribute__((address_space(3))) void*)(lds_raw + WTAB_OFF))[hw_slot()]);
    int l; asm volatile("v_mbcnt_lo_u32_b32 %0, -1, 0\n\tv_mbcnt_hi_u32_b32 %0, -1, %0" : "=v"(l));
    return (w << 6) + l;
}
using pg8::bf16_t; using pg8::bf16x8; using pg8::f32x4; using pg8::u32x4;
#define LAS __attribute__((address_space(3)))

#define DMODEL 1024
#define NPT 16384
#define NST 32
#define NTOK 16416
#define MPAD 16640
#define SEQ 2048
#define ZW 2816
#define OFF_A 1536
#define OFF_B 1544
#define OFF_Z 1552
#define OFF_QA 2064
#define OFF_KVA 2448
#define OFF_KR 2704
#define DFF 2816
#define PAST 16384
#define NPAGES 128
#define EPSV 1e-6f

#define O_YP 0
#define O_YS (O_YP + 16777216)
#define O_CKVP (O_YS + 32768)
#define O_KRP (O_CKVP + 4194304)
#define O_GSP (O_KRP + 524288)
#define O_CSP (O_GSP + 262144)
#define O_CKVS (O_CSP + 36864)
#define O_KRS (O_CKVS + 8192)
#define O_GSS (O_KRS + 1024)
#define O_CSS (O_GSS + 1048576)

__device__ __forceinline__ bf16_t f2bf(float f) { unsigned u = __float_as_uint(f); return (bf16_t)((u + 0x7fffu + ((u >> 16) & 1u)) >> 16); }
__device__ __forceinline__ float bf2f(bf16_t b) { return __uint_as_float(((unsigned)b) << 16); }
template <int CTRL> __device__ __forceinline__ float dpp_mov(float x) { return __uint_as_float((unsigned)__builtin_amdgcn_update_dpp((int)__float_as_uint(x), (int)__float_as_uint(x), CTRL, 0xF, 0xF, true)); }
__device__ __forceinline__ float add_x16(float x) { auto r = __builtin_amdgcn_permlane16_swap(__float_as_uint(x), __float_as_uint(x), false, false); return __uint_as_float(r[0]) + __uint_as_float(r[1]); }
__device__ __forceinline__ float add_x32(float x) { auto r = __builtin_amdgcn_permlane32_swap(__float_as_uint(x), __float_as_uint(x), false, false); return __uint_as_float(r[0]) + __uint_as_float(r[1]); }
__device__ __forceinline__ float max_x32(float x) { auto r = __builtin_amdgcn_permlane32_swap(__float_as_uint(x), __float_as_uint(x), false, false); return fmaxf(__uint_as_float(r[0]), __uint_as_float(r[1])); }
__device__ __forceinline__ float sum8(float x) { x += dpp_mov<0xB1>(x); x += dpp_mov<0x4E>(x); x += dpp_mov<0x141>(x); return x; }
__device__ __forceinline__ float sum16(float x) { x = sum8(x); x += dpp_mov<0x140>(x); return x; }
__device__ __forceinline__ float max16(float x) { x = fmaxf(x, dpp_mov<0xB1>(x)); x = fmaxf(x, dpp_mov<0x4E>(x)); x = fmaxf(x, dpp_mov<0x141>(x)); x = fmaxf(x, dpp_mov<0x140>(x)); return x; }
__device__ __forceinline__ float wave_sum(float v) { return add_x32(add_x16(sum16(v))); }
__device__ __forceinline__ float sigmoidf_(float x) { return __builtin_amdgcn_rcpf(1.f + __builtin_amdgcn_exp2f(-1.44269504f * x)); }
__device__ __forceinline__ float siluf_(float x) { return x * __builtin_amdgcn_rcpf(1.f + __builtin_amdgcn_exp2f(-1.44269504f * x)); }


#define WSYNC() do { __builtin_amdgcn_fence(__ATOMIC_ACQ_REL, "wavefront"); __builtin_amdgcn_wave_barrier(); } while (0)
#define NTHR 512
#define NWAVE 8

typedef float f32x2_t __attribute__((ext_vector_type(2)));
typedef __bf16 bf16x2_t __attribute__((ext_vector_type(2)));
__device__ __forceinline__ unsigned cvtpk(float lo, float hi) { f32x2_t v = {lo, hi}; bf16x2_t r = __builtin_convertvector(v, bf16x2_t); return __builtin_bit_cast(unsigned, r); }
__device__ __forceinline__ void bf8_to_f32(const bf16x8& v, float* o) {
#pragma unroll
    for (int e = 0; e < 8; ++e) o[e] = __uint_as_float(((unsigned)(unsigned short)v[e]) << 16);
}
__device__ __forceinline__ bf16x8 f32_to_bf8(const float* x) {
    u32x4 w; w.x = cvtpk(x[0], x[1]); w.y = cvtpk(x[2], x[3]); w.z = cvtpk(x[4], x[5]); w.w = cvtpk(x[6], x[7]);
    return __builtin_bit_cast(bf16x8, w);
}
__device__ __forceinline__ unsigned pk2bf(float lo, float hi) { return (unsigned)f2bf(lo) | ((unsigned)f2bf(hi) << 16); }

__device__ __forceinline__ void wt_item(const float* __restrict__ W, int ldw, int col0, int nvalid, bf16_t* __restrict__ WT, int ldt, int nrow0, int k0, float* scr, int lane) {
    WSYNC();
#pragma unroll 8
    for (int i = 0; i < 32; ++i) { const int kk = 2 * i + (lane >> 5), n = lane & 31; scr[kk * 33 + n] = n < nvalid ? W[(size_t)(k0 + kk) * ldw + col0 + n] : 0.f; }
    WSYNC();
    const int c = lane & 7;
#pragma unroll
    for (int j = 0; j < 4; ++j) { const int n = (lane >> 3) + 8 * j; const float* sp = scr + (8 * c) * 33 + n;
        u32x4 o; o.x = cvtpk(sp[0], sp[33]); o.y = cvtpk(sp[2 * 33], sp[3 * 33]); o.z = cvtpk(sp[4 * 33], sp[5 * 33]); o.w = cvtpk(sp[6 * 33], sp[7 * 33]);
        *(u32x4*)(WT + (size_t)(nrow0 + n) * ldt + k0 + 8 * c) = o; }
}

__device__ __forceinline__ void rms1024_row(const float* __restrict__ src, const float* __restrict__ g, bf16_t* __restrict__ o, bool zero, int lane) {
    if (zero) { for (int j = 0; j < 4; ++j) { ushort4 z = {0, 0, 0, 0}; *(ushort4*)(o + lane * 4 + 256 * j) = z; } return; }
    float4 v[4]; float ss = 0.f;
#pragma unroll
    for (int j = 0; j < 4; ++j) { v[j] = *(const float4*)(src + lane * 4 + 256 * j); ss += v[j].x * v[j].x + v[j].y * v[j].y + v[j].z * v[j].z + v[j].w * v[j].w; }
    ss = wave_sum(ss);
    const float rs = rsqrtf(ss * (1.f / 1024.f) + EPSV);
#pragma unroll
    for (int j = 0; j < 4; ++j) {
        const float4 gg = *(const float4*)(g + lane * 4 + 256 * j);
        ushort4 w; w.x = f2bf(v[j].x * rs * gg.x); w.y = f2bf(v[j].y * rs * gg.y); w.z = f2bf(v[j].z * rs * gg.z); w.w = f2bf(v[j].w * rs * gg.w);
        *(ushort4*)(o + lane * 4 + 256 * j) = w;
    }
}

__device__ __forceinline__ void rms1024_row_b(const bf16_t* __restrict__ src, const float* __restrict__ g, bf16_t* __restrict__ o, bool zero, int lane) {
    if (zero) { for (int j = 0; j < 2; ++j) { const u32x4 z = {0u, 0u, 0u, 0u}; *(u32x4*)(o + lane * 8 + 512 * j) = z; } return; }
    float v[2][8]; float ss = 0.f;
#pragma unroll
    for (int j = 0; j < 2; ++j) { bf8_to_f32(*(const bf16x8*)(src + lane * 8 + 512 * j), v[j]);
#pragma unroll
        for (int e = 0; e < 8; ++e) ss += v[j][e] * v[j][e]; }
    ss = wave_sum(ss);
    const float rs = rsqrtf(ss * (1.f / 1024.f) + EPSV);
#pragma unroll
    for (int j = 0; j < 2; ++j) {
        const float4 g0 = *(const float4*)(g + lane * 8 + 512 * j), g1 = *(const float4*)(g + lane * 8 + 512 * j + 4);
        float t[8] = {v[j][0] * rs * g0.x, v[j][1] * rs * g0.y, v[j][2] * rs * g0.z, v[j][3] * rs * g0.w, v[j][4] * rs * g1.x, v[j][5] * rs * g1.y, v[j][6] * rs * g1.z, v[j][7] * rs * g1.w};
        *(bf16x8*)(o + lane * 8 + 512 * j) = f32_to_bf8(t);
    }
}

struct ABf16 { const bf16_t* p; int lda; __device__ __forceinline__ bf16x8 load(int m, int k) const { return *(const bf16x8*)(p + (size_t)m * lda + k); } };
template <bool SWIGLU, class Epi>
__device__ __forceinline__ void gemm_sample_rows(const bf16_t* __restrict__ A, int lda, const bf16_t* __restrict__ Bt, int K, int N, const Epi& epi, char*  , int bid, int nb, int first = -1) {
    const int tid = otid(), lane = tid & 63, wid = tid >> 6, i16 = lane & 15, q4 = lane >> 4;
    for (int u = first >= 0 ? (bid - first + nb) % nb : nb - 1 - bid; u < N / 256; u += nb) {
        const int n0 = u * 256;
        const int c0 = SWIGLU ? n0 + 16 * wid : n0 + 32 * wid, c1 = SWIGLU ? n0 + 128 + 16 * wid : n0 + 32 * wid + 16;
        const bf16_t* a0p = A + (size_t)(NPT + i16) * lda + 8 * q4; const bf16_t* a1p = a0p + (size_t)16 * lda;
        const bf16_t* b0p = Bt + (size_t)(c0 + i16) * K + 8 * q4; const bf16_t* b1p = Bt + (size_t)(c1 + i16) * K + 8 * q4;
        f32x4 acc[2][2];
#pragma unroll
        for (int i = 0; i < 2; ++i)
#pragma unroll
            for (int j = 0; j < 2; ++j) acc[i][j] = (f32x4){0.f, 0.f, 0.f, 0.f};
#pragma unroll 4
        for (int k0 = 0; k0 < K; k0 += 32) {
            const bf16x8 a0 = *(const bf16x8*)(a0p + k0), a1 = *(const bf16x8*)(a1p + k0), b0 = *(const bf16x8*)(b0p + k0), b1 = *(const bf16x8*)(b1p + k0);
            acc[0][0] = __builtin_amdgcn_mfma_f32_16x16x32_bf16(a0, b0, acc[0][0], 0, 0, 0); acc[0][1] = __builtin_amdgcn_mfma_f32_16x16x32_bf16(a0, b1, acc[0][1], 0, 0, 0);
            acc[1][0] = __builtin_amdgcn_mfma_f32_16x16x32_bf16(a1, b0, acc[1][0], 0, 0, 0); acc[1][1] = __builtin_amdgcn_mfma_f32_16x16x32_bf16(a1, b1, acc[1][1], 0, 0, 0);
        }
#pragma unroll
        for (int i = 0; i < 2; ++i)
#pragma unroll
            for (int r = 0; r < 4; ++r) {
                const int m = NPT + 16 * i + 4 * q4 + r;
                if constexpr (SWIGLU) epi(m, (n0 >> 1) + 16 * wid + i16, siluf_(acc[i][0][r]) * acc[i][1][r]);
                else { epi(m, c0 + i16, acc[i][0][r]); epi(m, c1 + i16, acc[i][1][r]); }
            }
    }
}
template <bool SWIGLU, class Epi>
__device__ __forceinline__ void gemm_sample_rows_ks(const bf16_t* __restrict__ A, int lda, const bf16_t* __restrict__ Bt, int K, int N, const Epi& epi, char* smem, int bid, int nb) {
    const int tid = otid(), lane = tid & 63, wid = tid >> 6, i16 = lane & 15, q4 = lane >> 4;
    const int nunits = N / 64, ksl = K >> 3;
    f32x4* red = (f32x4*)smem;
    for (int u = nb - 1 - bid; u < nunits; u += nb) {
        int brow[4];
#pragma unroll
        for (int j = 0; j < 4; ++j) brow[j] = SWIGLU ? ((32 * u) >> 7) * 256 + ((32 * u) & 127) + 128 * (j >> 1) + 16 * (j & 1) + i16 : 64 * u + 16 * j + i16;
        const bf16_t* a0p = A + (size_t)(NPT + i16) * lda + wid * ksl + 8 * q4; const bf16_t* a1p = a0p + (size_t)16 * lda;
        f32x4 acc[2][4];
#pragma unroll
        for (int i = 0; i < 2; ++i)
#pragma unroll
            for (int j = 0; j < 4; ++j) acc[i][j] = (f32x4){0.f, 0.f, 0.f, 0.f};
        for (int k0 = 0; k0 < ksl; k0 += 32) {
            const bf16x8 a0 = *(const bf16x8*)(a0p + k0), a1 = *(const bf16x8*)(a1p + k0);
            bf16x8 b[4];
#pragma unroll
            for (int j = 0; j < 4; ++j) b[j] = *(const bf16x8*)(Bt + (size_t)brow[j] * K + wid * ksl + 8 * q4 + k0);
#pragma unroll
            for (int j = 0; j < 4; ++j) { acc[0][j] = __builtin_amdgcn_mfma_f32_16x16x32_bf16(a0, b[j], acc[0][j], 0, 0, 0); acc[1][j] = __builtin_amdgcn_mfma_f32_16x16x32_bf16(a1, b[j], acc[1][j], 0, 0, 0); }
        }
        __syncthreads();
#pragma unroll
        for (int i = 0; i < 2; ++i)
#pragma unroll
            for (int j = 0; j < 4; ++j) red[(wid * 8 + i * 4 + j) * 64 + lane] = acc[i][j];
        __syncthreads();
        if constexpr (SWIGLU) {
            if (tid < 256) {
                const int t4 = tid >> 6, i = t4 >> 1, jg = t4 & 1, l = tid & 63;
                f32x4 g = red[(i * 4 + jg) * 64 + l], up = red[(i * 4 + jg + 2) * 64 + l];
#pragma unroll
                for (int w = 1; w < 8; ++w) { g = g + red[(w * 8 + i * 4 + jg) * 64 + l]; up = up + red[(w * 8 + i * 4 + jg + 2) * 64 + l]; }
#pragma unroll
                for (int r = 0; r < 4; ++r) epi(NPT + 16 * i + 4 * (l >> 4) + r, 32 * u + 16 * jg + (l & 15), siluf_(g[r]) * up[r]);
            }
        } else {
            const int t8 = tid >> 6, l = tid & 63, i = t8 >> 2, j = t8 & 3;
            f32x4 v = red[t8 * 64 + l];
#pragma unroll
            for (int w = 1; w < 8; ++w) v = v + red[(w * 8 + t8) * 64 + l];
#pragma unroll
            for (int r = 0; r < 4; ++r) epi(NPT + 16 * i + 4 * (l >> 4) + r, 64 * u + 16 * j + (l & 15), v[r]);
        }
    }
    __syncthreads();
}
struct EwF32 { float* C; int ldc; __device__ __forceinline__ void operator()(int m, int n, float v) const { C[(size_t)m * ldc + n] = v; } };
struct EwBf16 { bf16_t* C; int ldc; __device__ __forceinline__ void operator()(int m, int n, float v) const { C[(size_t)m * ldc + n] = f2bf(v); } };
struct EwResX { const float* xs; bf16_t* C; __device__ __forceinline__ void operator()(int m, int n, float v) const { C[(size_t)m * 1024 + n] = f2bf(xs[(size_t)(m - NPT) * 1024 + n] + v); } };
struct EwResH { const bf16_t* H; bf16_t* C; __device__ __forceinline__ void operator()(int m, int n, float v) const { C[(size_t)m * 1024 + n] = f2bf(bf2f(H[(size_t)m * 1024 + n]) + v); } };
struct EwPle { const bf16_t* H2; const bf16_t* PP; float* out;
    __device__ __forceinline__ void operator()(int m, int n, float v) const { out[O_YS + (size_t)(m - NPT) * 1024 + n] = bf2f(H2[(size_t)m * 1024 + n]) + bf2f(PP[(size_t)m * 1024 + n]) * sigmoidf_(v); } };

struct PgBf16 {
    static constexpr bool PERM = true, AFTER_DRAIN = false; bf16_t* O; int ldc;
    __device__ __forceinline__ void operator()(const f32x4 (&acc)[2][2][4][2], const pg8::Unit& u, int wr, int wc, int fr, int fq) const {
#pragma unroll
        for (int ai = 0; ai < 2; ++ai)
#pragma unroll
            for (int m = 0; m < 4; ++m) { bf16_t* rowp = O + (size_t)(u.pm * 256 + ai * 128 + wr * 64 + m * 16 + fr) * ldc + u.pn * 256 + wc * 32 + 8 * fq;
#pragma unroll
                for (int bj = 0; bj < 2; ++bj) { const f32x4 v0 = acc[ai][bj][m][0], v1 = acc[ai][bj][m][1]; u32x4 w; w.x = pk2bf(v0[0], v0[1]); w.y = pk2bf(v0[2], v0[3]); w.z = pk2bf(v1[0], v1[1]); w.w = pk2bf(v1[2], v1[3]); *(u32x4*)(rowp + bj * 128) = w; } }
    }
};
struct PgF32 {
    static constexpr bool PERM = false, AFTER_DRAIN = false; float* O; int ldc;
    __device__ __forceinline__ void operator()(const f32x4 (&acc)[2][2][4][2], const pg8::Unit& u, int wr, int wc, int fr, int fq) const {
#pragma unroll
        for (int ai = 0; ai < 2; ++ai)
#pragma unroll
            for (int m = 0; m < 4; ++m) { float* rowp = O + (size_t)(u.pm * 256 + ai * 128 + wr * 64 + m * 16 + fr) * ldc + u.pn * 256 + wc * 32 + 4 * fq;
#pragma unroll
                for (int bj = 0; bj < 2; ++bj)
#pragma unroll
                    for (int n = 0; n < 2; ++n) *(f32x4*)(rowp + bj * 128 + n * 16) = acc[ai][bj][m][n]; }
    }
};
struct PgSwiglu {
    static constexpr bool PERM = true, AFTER_DRAIN = false; bf16_t* Hd;
    __device__ __forceinline__ void operator()(const f32x4 (&acc)[2][2][4][2], const pg8::Unit& u, int wr, int wc, int fr, int fq) const {
#pragma unroll
        for (int ai = 0; ai < 2; ++ai)
#pragma unroll
            for (int m = 0; m < 4; ++m) { bf16_t* rowp = Hd + (size_t)(u.pm * 256 + ai * 128 + wr * 64 + m * 16 + fr) * DFF + u.pn * 128 + wc * 32 + 8 * fq;
                float h[8];
#pragma unroll
                for (int n = 0; n < 2; ++n)
#pragma unroll
                    for (int i = 0; i < 4; ++i) h[n * 4 + i] = siluf_(acc[ai][0][m][n][i]) * acc[ai][1][m][n][i];
                u32x4 w; w.x = pk2bf(h[0], h[1]); w.y = pk2bf(h[2], h[3]); w.z = pk2bf(h[4], h[5]); w.w = pk2bf(h[6], h[7]); *(u32x4*)rowp = w; }
    }
};
struct PgResXB {
    static constexpr bool PERM = true, AFTER_DRAIN = false; const float* R; bf16_t* O;
    __device__ __forceinline__ void operator()(const f32x4 (&acc)[2][2][4][2], const pg8::Unit& u, int wr, int wc, int fr, int fq) const {
#pragma unroll
        for (int ai = 0; ai < 2; ++ai)
#pragma unroll
            for (int m = 0; m < 4; ++m) { const size_t off = (size_t)(u.pm * 256 + ai * 128 + wr * 64 + m * 16 + fr) * 1024 + u.pn * 256 + wc * 32 + 8 * fq;
#pragma unroll
                for (int bj = 0; bj < 2; ++bj) { const f32x4 r0 = *(const f32x4*)(R + off + bj * 128), r1 = *(const f32x4*)(R + off + bj * 128 + 4), v0 = r0 + acc[ai][bj][m][0], v1 = r1 + acc[ai][bj][m][1];
                    u32x4 w; w.x = cvtpk(v0[0], v0[1]); w.y = cvtpk(v0[2], v0[3]); w.z = cvtpk(v1[0], v1[1]); w.w = cvtpk(v1[2], v1[3]); *(u32x4*)(O + off + bj * 128) = w; } }
    }
};
struct PgResBB {
    static constexpr bool PERM = true, AFTER_DRAIN = false; const bf16_t* R; bf16_t* O;
    __device__ __forceinline__ void operator()(const f32x4 (&acc)[2][2][4][2], const pg8::Unit& u, int wr, int wc, int fr, int fq) const {
#pragma unroll
        for (int ai = 0; ai < 2; ++ai)
#pragma unroll
            for (int m = 0; m < 4; ++m) { const size_t off = (size_t)(u.pm * 256 + ai * 128 + wr * 64 + m * 16 + fr) * 1024 + u.pn * 256 + wc * 32 + 8 * fq;
#pragma unroll
                for (int bj = 0; bj < 2; ++bj) { float r[8]; bf8_to_f32(*(const bf16x8*)(R + off + bj * 128), r); const f32x4 a0 = acc[ai][bj][m][0], a1 = acc[ai][bj][m][1];
                    u32x4 w; w.x = cvtpk(r[0] + a0[0], r[1] + a0[1]); w.y = cvtpk(r[2] + a0[2], r[3] + a0[3]); w.z = cvtpk(r[4] + a1[0], r[5] + a1[1]); w.w = cvtpk(r[6] + a1[2], r[7] + a1[3]); *(u32x4*)(O + off + bj * 128) = w; } }
    }
};
struct PgPleB {
    static constexpr bool PERM = true, AFTER_DRAIN = false; const bf16_t* H2; const bf16_t* PP; float* out;
    __device__ __forceinline__ void operator()(const f32x4 (&acc)[2][2][4][2], const pg8::Unit& u, int wr, int wc, int fr, int fq) const {
#pragma unroll
        for (int ai = 0; ai < 2; ++ai)
#pragma unroll
            for (int m = 0; m < 4; ++m) { const size_t off = (size_t)(u.pm * 256 + ai * 128 + wr * 64 + m * 16 + fr) * 1024 + u.pn * 256 + wc * 32 + 8 * fq;
#pragma unroll
                for (int bj = 0; bj < 2; ++bj) { float h[8], pp[8]; bf8_to_f32(*(const bf16x8*)(H2 + off + bj * 128), h); bf8_to_f32(*(const bf16x8*)(PP + off + bj * 128), pp);
                    const f32x4 a0 = acc[ai][bj][m][0], a1 = acc[ai][bj][m][1]; f32x4 y0, y1;
#pragma unroll
                    for (int i = 0; i < 4; ++i) { y0[i] = h[i] + pp[i] * sigmoidf_(a0[i]); y1[i] = h[4 + i] + pp[4 + i] * sigmoidf_(a1[i]); }
                    *(f32x4*)(out + O_YP + off + bj * 128) = y0; *(f32x4*)(out + O_YP + off + bj * 128 + 4) = y1; } }
    }
};
template <class Epi>
__device__ __forceinline__ void pg_gemm(LAS unsigned char* lds, const bf16_t* A, const bf16_t* Bt, int M, int N, int K, const Epi& E, int glow = 0) {
    pg8::Gemm g{A, Bt, M, N, K}; pg8::StaticOrder S;
    if (glow > 0) { if ((int)blockIdx.x >= glow) return; S.init(M, N, glow, (int)blockIdx.x); }
    else S.init(M, N, (int)gridDim.x, (int)blockIdx.x);
    pg8::gemm_phase<Epi, pg8::StaticOrder, true, true>(lds, g, S, E);
}

constexpr size_t WOF_WinT = 0ull;
constexpr size_t WOF_WqbT = 5767168ull;
constexpr size_t WOF_WkvT = 6356992ull;
constexpr size_t WOF_WknT = 6881280ull;
constexpr size_t WOF_WoT = 7143424ull;
constexpr size_t WOF_WguT = 9240576ull;
constexpr size_t WOF_WdT = 20774912ull;
constexpr size_t WOF_WpgT = 26542080ull;
constexpr size_t WOF_WppT = 28639232ull;
constexpr size_t WOF_xn = 29163520ull;
constexpr size_t WOF_pb = 63242240ull;
constexpr size_t WOF_Z = 71761920ull;
constexpr size_t WOF_qkv = 165478400ull;
constexpr size_t WOF_ropecs = 216596480ull;
constexpr size_t WOF_gg = 216858880ull;
constexpr size_t WOF_bb = 217391360ull;
constexpr size_t WOF_goraw = 217923840ull;
constexpr size_t WOF_gUT = 252002560ull;
constexpr size_t WOF_ggam = 285556992ull;
constexpr size_t WOF_gWn = 285565184ull;
constexpr size_t WOF_gQg = 302342400ull;
constexpr size_t WOF_gQK = 319119616ull;
constexpr size_t WOF_gKd = 335896832ull;
constexpr size_t WOF_qan = 352674048ull;
constexpr size_t WOF_ckvb = 365453568ull;
constexpr size_t WOF_krf = 373973248ull;
constexpr size_t WOF_Q = 376103168ull;
constexpr size_t WOF_qh = 427221248ull;
constexpr size_t WOF_KV = 478339328ull;
constexpr size_t WOF_kh = 546496768ull;
constexpr size_t WOF_omix = 580575488ull;
constexpr size_t WOF_KN = 614654208ull;
constexpr size_t WOF_SC = 1151525120ull;
constexpr size_t WOF_part = 1168302336ull;
constexpr size_t WOF_H = 1170432256ull;
constexpr size_t WOF_un = 1238589696ull;
constexpr size_t WOF_G = 1272668416ull;
constexpr size_t WOF_hid = 1273028864ull;
constexpr size_t WOF_H2 = 1366745344ull;
constexpr size_t WOF_un2 = 1434902784ull;
constexpr size_t WOF_PP = 1468981504ull;
constexpr size_t WOF_qraw = 1537138944ull;
constexpr size_t WOF_kvraw = 1562304768ull;
constexpr size_t WOF_krb = 1595859200ull;
constexpr size_t WOF_ctl = 1596907776ull;
constexpr size_t WS_TOTAL = 1596924160ull;
struct MK {
    const float *x_prompt, *x_sample, *cache_ckv, *cache_krope, *state_gdn, *state_conv; const int* page_table; const float *p_prompt, *p_sample;
    const float *g_attn, *w_in, *w_conv, *a_log, *dt_bias, *g_gdn_out, *g_q_a, *w_q_b, *g_q_nope, *g_q_rope, *g_kv_a, *g_k_rope, *w_kv_b, *g_k_nope, *w_o, *g_ffn, *w_gate, *w_up, *w_down, *g_ple, *w_ple_gate, *w_ple_proj;
    float* out; char* ws;
    __device__ __forceinline__ unsigned* ctl() const { return (unsigned*)(ws + WOF_ctl); }
    __device__ __forceinline__ bf16_t* WinT() const { return (bf16_t*)(ws + WOF_WinT); }
    __device__ __forceinline__ bf16_t* WqbT() const { return (bf16_t*)(ws + WOF_WqbT); }
    __device__ __forceinline__ bf16_t* WkvT() const { return (bf16_t*)(ws + WOF_WkvT); }
    __device__ __forceinline__ bf16_t* WknT() const { return (bf16_t*)(ws + WOF_WknT); }
    __device__ __forceinline__ bf16_t* WoT() const { return (bf16_t*)(ws + WOF_WoT); }
    __device__ __forceinline__ bf16_t* WguT() const { return (bf16_t*)(ws + WOF_WguT); }
    __device__ __forceinline__ bf16_t* WdT() const { return (bf16_t*)(ws + WOF_WdT); }
    __device__ __forceinline__ bf16_t* WpgT() const { return (bf16_t*)(ws + WOF_WpgT); }
    __device__ __forceinline__ bf16_t* WppT() const { return (bf16_t*)(ws + WOF_WppT); }
    __device__ __forceinline__ bf16_t* xn() const { return (bf16_t*)(ws + WOF_xn); }
    __device__ __forceinline__ bf16_t* pb() const { return (bf16_t*)(ws + WOF_pb); }
    __device__ __forceinline__ bf16_t* Z() const { return (bf16_t*)(ws + WOF_Z); }
    __device__ __forceinline__ bf16_t* qkv() const { return (bf16_t*)(ws + WOF_qkv); }
    __device__ __forceinline__ float* ropecs() const { return (float*)(ws + WOF_ropecs); }
    __device__ __forceinline__ float* gg() const { return (float*)(ws + WOF_gg); }
    __device__ __forceinline__ float* bb() const { return (float*)(ws + WOF_bb); }
    __device__ __forceinline__ float* goraw() const { return (float*)(ws + WOF_goraw); }
    __device__ __forceinline__ float* gUT() const { return (float*)(ws + WOF_gUT); }
    __device__ __forceinline__ float* ggam() const { return (float*)(ws + WOF_ggam); }
    __device__ __forceinline__ bf16_t* gWn() const { return (bf16_t*)(ws + WOF_gWn); }
    __device__ __forceinline__ bf16_t* gQg() const { return (bf16_t*)(ws + WOF_gQg); }
    __device__ __forceinline__ bf16_t* gQK() const { return (bf16_t*)(ws + WOF_gQK); }
    __device__ __forceinline__ bf16_t* gKd() const { return (bf16_t*)(ws + WOF_gKd); }
    __device__ __forceinline__ bf16_t* qan() const { return (bf16_t*)(ws + WOF_qan); }
    __device__ __forceinline__ bf16_t* ckvb() const { return (bf16_t*)(ws + WOF_ckvb); }
    __device__ __forceinline__ float* krf() const { return (float*)(ws + WOF_krf); }
    __device__ __forceinline__ float* Q() const { return (float*)(ws + WOF_Q); }
    __device__ __forceinline__ float* qh() const { return (float*)(ws + WOF_qh); }
    __device__ __forceinline__ float* KV() const { return (float*)(ws + WOF_KV); }
    __device__ __forceinline__ float* kh() const { return (float*)(ws + WOF_kh); }
    __device__ __forceinline__ bf16_t* omix() const { return (bf16_t*)(ws + WOF_omix); }
    __device__ __forceinline__ bf16_t* KN() const { return (bf16_t*)(ws + WOF_KN); }
    __device__ __forceinline__ float* SC() const { return (float*)(ws + WOF_SC); }
    __device__ __forceinline__ float* part() const { return (float*)(ws + WOF_part); }
    __device__ __forceinline__ bf16_t* H() const { return (bf16_t*)(ws + WOF_H); }
    __device__ __forceinline__ bf16_t* un() const { return (bf16_t*)(ws + WOF_un); }
    __device__ __forceinline__ float* G() const { return (float*)(ws + WOF_G); }
    __device__ __forceinline__ bf16_t* hid() const { return (bf16_t*)(ws + WOF_hid); }
    __device__ __forceinline__ bf16_t* H2() const { return (bf16_t*)(ws + WOF_H2); }
    __device__ __forceinline__ bf16_t* un2() const { return (bf16_t*)(ws + WOF_un2); }
    __device__ __forceinline__ bf16_t* PP() const { return (bf16_t*)(ws + WOF_PP); }
    __device__ __forceinline__ bf16_t* qraw() const { return (bf16_t*)(ws + WOF_qraw); }
    __device__ __forceinline__ bf16_t* kvraw() const { return (bf16_t*)(ws + WOF_kvraw); }
    __device__ __forceinline__ bf16_t* krb() const { return (bf16_t*)(ws + WOF_krb); }
};

__device__ __forceinline__ float fast_sigmoid(float x) { return __builtin_amdgcn_rcpf(1.f + __builtin_amdgcn_exp2f(-1.44269504f * x)); }
struct PinTok { bf16x8 qa, cv, kr; float ab; };
struct PinGain { float gqa[8], gkv[8], gkr[8], dtb, alog; };
__device__ __forceinline__ PinTok pin_load(const MK& a, int row, int lane) {
    const bf16_t* z = a.Z() + (size_t)row * ZW; PinTok t; const bf16x8 zz = {0, 0, 0, 0, 0, 0, 0, 0};
    t.qa = lane < 48 ? *(const bf16x8*)(z + OFF_QA + 8 * lane) : zz; t.cv = lane < 32 ? *(const bf16x8*)(z + OFF_KVA + 8 * lane) : zz;
    t.kr = (lane >= 32 && lane < 36) ? *(const bf16x8*)(z + OFF_KR + 8 * (lane - 32)) : zz; t.ab = lane < 16 ? bf2f(z[OFF_A + lane]) : 0.f; return t;
}
__device__ __forceinline__ void post_in_token(const MK& a, int row, int lane, const float* wcs, const bf16x8 (&w0)[3], const bf16x8 (&w1)[3], const bf16x8 (&w2)[3], const bf16x8 (&wcur)[3], const PinTok& tk, const PinGain& gn) {
    const bool samp = row >= NPT;
    const int b = samp ? row - NPT : row >> 11, t = samp ? 0 : row & 2047, hd = lane >> 3;
    float y[24];
#pragma unroll
    for (int c3 = 0; c3 < 3; ++c3) {
        float p0[8], p1[8], p2[8], cu[8];
        bf8_to_f32(w0[c3], p0); bf8_to_f32(w1[c3], p1); bf8_to_f32(w2[c3], p2); bf8_to_f32(wcur[c3], cu);
        const float* wp = wcs + 512 * c3 + 8 * lane;
        const float4 a0 = *(const float4*)wp, a1 = *(const float4*)(wp + 4), b0 = *(const float4*)(wp + 1536), b1 = *(const float4*)(wp + 1540);
        const float4 c0 = *(const float4*)(wp + 3072), c1 = *(const float4*)(wp + 3076), d0 = *(const float4*)(wp + 4608), d1 = *(const float4*)(wp + 4612);
        const float k0[8] = {a0.x, a0.y, a0.z, a0.w, a1.x, a1.y, a1.z, a1.w}, k1[8] = {b0.x, b0.y, b0.z, b0.w, b1.x, b1.y, b1.z, b1.w};
        const float k2[8] = {c0.x, c0.y, c0.z, c0.w, c1.x, c1.y, c1.z, c1.w}, k3[8] = {d0.x, d0.y, d0.z, d0.w, d1.x, d1.y, d1.z, d1.w};
#pragma unroll
        for (int e = 0; e < 8; ++e) { const int c = 8 * c3 + e; const float v = k0[e] * p0[e] + k1[e] * p1[e] + k2[e] * p2[e] + k3[e] * cu[e]; y[c] = v * fast_sigmoid(v); }
        __builtin_amdgcn_sched_barrier(0);
    }
    float sq = 0.f, sk = 0.f;
#pragma unroll
    for (int e = 0; e < 8; ++e) { sq += y[e] * y[e]; sk += y[8 + e] * y[8 + e]; }
    sq = sum8(sq); sk = sum8(sk);
    const float rq = rsqrtf(sq + EPSV) * 0.125f, rk = rsqrtf(sk + EPSV);
#pragma unroll
    for (int e = 0; e < 8; ++e) { y[e] *= rq; y[8 + e] *= rk; }
    bf16_t* qo = a.qkv() + (size_t)row * 1536 + 8 * lane;
    *(bf16x8*)qo = f32_to_bf8(y); *(bf16x8*)(qo + 512) = f32_to_bf8(y + 8); *(bf16x8*)(qo + 1024) = f32_to_bf8(y + 16);
    if (!samp && t >= SEQ - 3) {
        float* cso = a.out + O_CSP + ((size_t)b * 3 + (t - (SEQ - 3))) * 1536 + 8 * lane;
#pragma unroll
        for (int j = 0; j < 3; ++j) { float cu[8]; bf8_to_f32(wcur[j], cu); *(float4*)(cso + 512 * j) = (float4){cu[0], cu[1], cu[2], cu[3]}; *(float4*)(cso + 512 * j + 4) = (float4){cu[4], cu[5], cu[6], cu[7]}; }
    }
    if (lane < 16) {
        const float v = tk.ab;
        if (lane < 8) { const float xx = v + gn.dtb; const float sp = xx > 20.f ? xx : 0.69314718f * __builtin_amdgcn_logf(1.f + __builtin_amdgcn_exp2f(1.44269504f * xx)); a.gg()[(size_t)row * 8 + lane] = -gn.alog * sp; }
        else a.bb()[(size_t)row * 8 + lane - 8] = sigmoidf_(v);
    }
    __builtin_amdgcn_sched_barrier(0);
    float qa[8], cv[8], kr[8];
    bf8_to_f32(tk.qa, qa); bf8_to_f32(tk.cv, cv); bf8_to_f32(tk.kr, kr);
    float s1 = 0.f, s2 = 0.f, s3 = 0.f;
#pragma unroll
    for (int e = 0; e < 8; ++e) { s1 += qa[e] * qa[e]; s2 += cv[e] * cv[e]; s3 += kr[e] * kr[e]; }
    s1 = wave_sum(s1); s2 = wave_sum(s2); s3 = wave_sum(s3);
    const float r1 = rsqrtf(s1 * (1.f / 384.f) + EPSV), r2 = rsqrtf(s2 * (1.f / 256.f) + EPSV), r3 = rsqrtf(s3 * (1.f / 32.f) + EPSV);
    if (lane < 48) {
        float o[8];
#pragma unroll
        for (int e = 0; e < 8; ++e) o[e] = qa[e] * r1 * gn.gqa[e];
        *(bf16x8*)(a.qan() + (size_t)row * 384 + 8 * lane) = f32_to_bf8(o);
    }
    if (lane < 32) {
        float o[8];
#pragma unroll
        for (int e = 0; e < 8; ++e) o[e] = cv[e] * r2 * gn.gkv[e];
        *(bf16x8*)(a.ckvb() + (size_t)row * 256 + 8 * lane) = f32_to_bf8(o);
        float* co = samp ? a.out + O_CKVS + (size_t)b * 256 + 8 * lane : a.out + O_CKVP + (size_t)row * 256 + 8 * lane;
        *(float4*)co = (float4){o[0], o[1], o[2], o[3]}; *(float4*)(co + 4) = (float4){o[4], o[5], o[6], o[7]};
    }
    __builtin_amdgcn_sched_barrier(0);
    {
        const int c4 = (lane - 32) & 3;
        float xn[8], ot[8];
#pragma unroll
        for (int e = 0; e < 8; ++e) xn[e] = kr[e] * r3 * gn.gkr[e];
#pragma unroll
        for (int e = 0; e < 8; ++e) ot[e] = dpp_mov<0x4E>(xn[e]);
        if (lane >= 32 && lane < 36) {
            const float* tb = a.ropecs() + (size_t)(samp ? 2048 : t) * 32 + ((8 * c4) & 15);
            const float4 c0 = *(const float4*)tb, c1 = *(const float4*)(tb + 4), s0 = *(const float4*)(tb + 16), s1 = *(const float4*)(tb + 20);
            const float csv[8] = {c0.x, c0.y, c0.z, c0.w, c1.x, c1.y, c1.z, c1.w}, snv[8] = {s0.x, s0.y, s0.z, s0.w, s1.x, s1.y, s1.z, s1.w};
            float o[8];
#pragma unroll
            for (int e = 0; e < 8; ++e) o[e] = c4 < 2 ? xn[e] * csv[e] - ot[e] * snv[e] : ot[e] * snv[e] + xn[e] * csv[e];
            float* kf_ = a.krf() + (size_t)row * 32 + 8 * c4; *(float4*)kf_ = (float4){o[0], o[1], o[2], o[3]}; *(float4*)(kf_ + 4) = (float4){o[4], o[5], o[6], o[7]};
            float* ko = samp ? a.out + O_KRS + (size_t)b * 32 + 8 * c4 : a.out + O_KRP + (size_t)row * 32 + 8 * c4;
            *(float4*)ko = (float4){o[0], o[1], o[2], o[3]}; *(float4*)(ko + 4) = (float4){o[4], o[5], o[6], o[7]};
            if (!samp) *(bf16x8*)(a.krb() + (size_t)row * 32 + 8 * c4) = f32_to_bf8(o);
        }
    }
    (void)hd;
}
__device__ __forceinline__ void post_in_run(const MK& a, int run, int lane_in, const float* wcs) {
    int lane = lane_in; asm volatile("" : "+v"(lane));
    PinGain gn;
    {
        const int lq = lane < 48 ? lane : 0, lk = lane < 32 ? lane : 0, c4 = (lane - 32) & 3;
#pragma unroll
        for (int e = 0; e < 8; ++e) { gn.gqa[e] = a.g_q_a[8 * lq + e]; gn.gkv[e] = a.g_kv_a[8 * lk + e]; gn.gkr[e] = a.g_k_rope[8 * c4 + e]; }
        gn.dtb = a.dt_bias[lane & 7]; gn.alog = expf(a.a_log[lane & 7]);
    }
    if (run < NPT / 8) {
        const int row0 = run * 8, t0 = row0 & 2047;
        bf16x8 w0[3], w1[3], w2[3], wcur[3];
#pragma unroll
        for (int c3 = 0; c3 < 3; ++c3) {
            const bf16x8 zz = {0, 0, 0, 0, 0, 0, 0, 0}; w0[c3] = zz; w1[c3] = zz; w2[c3] = zz;
            if (t0 > 0) { const bf16_t* zp = a.Z() + (size_t)(row0 - 3) * ZW + 512 * c3 + 8 * lane; w0[c3] = *(const bf16x8*)zp; w1[c3] = *(const bf16x8*)(zp + ZW); w2[c3] = *(const bf16x8*)(zp + 2 * ZW); }
        }
        bf16x8 wnext[3]; PinTok tk, tkn;
#pragma unroll
        for (int c3 = 0; c3 < 3; ++c3) wnext[c3] = *(const bf16x8*)(a.Z() + (size_t)row0 * ZW + 512 * c3 + 8 * lane);
        tkn = pin_load(a, row0, lane);
#pragma unroll 1
        for (int k = 0; k < 8; ++k) {
            const int row = row0 + k;
#pragma unroll
            for (int c3 = 0; c3 < 3; ++c3) wcur[c3] = wnext[c3];
            tk = tkn;
            if (k < 7) {
#pragma unroll
                for (int c3 = 0; c3 < 3; ++c3) wnext[c3] = *(const bf16x8*)(a.Z() + (size_t)(row + 1) * ZW + 512 * c3 + 8 * lane);
                tkn = pin_load(a, row + 1, lane);
            }
            post_in_token(a, row, lane, wcs, w0, w1, w2, wcur, tk, gn);
#pragma unroll
            for (int c3 = 0; c3 < 3; ++c3) { w0[c3] = w1[c3]; w1[c3] = w2[c3]; w2[c3] = wcur[c3]; }
        }
    } else {
        {
            const int bsm = run - NPT / 8, row = NPT + bsm;
            bf16x8 w0[3], w1[3], w2[3], wcur[3];
#pragma unroll
            for (int c3 = 0; c3 < 3; ++c3) {
                const float* sp = a.state_conv + (size_t)bsm * 3 * 1536 + 512 * c3 + 8 * lane;
                float* cso = a.out + O_CSS + (size_t)bsm * 3 * 1536 + 512 * c3 + 8 * lane;
                float t0_[8], t1_[8], t2_[8], tc_[8];
#pragma unroll
                for (int e = 0; e < 8; ++e) { t0_[e] = sp[e]; t1_[e] = sp[1536 + e]; t2_[e] = sp[2 * 1536 + e]; }
                wcur[c3] = *(const bf16x8*)(a.Z() + (size_t)row * ZW + 512 * c3 + 8 * lane); bf8_to_f32(wcur[c3], tc_);
#pragma unroll
                for (int e = 0; e < 8; ++e) { cso[e] = t1_[e]; cso[1536 + e] = t2_[e]; cso[2 * 1536 + e] = tc_[e]; }
                w0[c3] = f32_to_bf8(t0_); w1[c3] = f32_to_bf8(t1_); w2[c3] = f32_to_bf8(t2_);
            }
            post_in_token(a, row, lane, wcs, w0, w1, w2, wcur, pin_load(a, row, lane), gn);
        }
    }
}

__device__ __forceinline__ void post_q_item(const MK& a, int idx, int lane) {
    const int row = idx >> 3, h = idx & 7;
    const float* q = a.Q() + (size_t)row * 768 + h * 96;
    float* o = a.qh() + ((size_t)row * 8 + h) * 96;
    const float v = q[lane];
    const float ss = wave_sum(v * v);
    o[lane] = v * rsqrtf(ss * (1.f / 64.f) + EPSV) * a.g_q_nope[lane];
    const float r = lane < 32 ? q[64 + lane] : 0.f;
    const float s2 = wave_sum(r * r);
    const float xn = lane < 32 ? r * rsqrtf(s2 * (1.f / 32.f) + EPSV) * a.g_q_rope[lane] : 0.f;
    const float other = __shfl_xor(xn, 16);
    const int i = lane & 15;
    const float* tb = a.ropecs() + (size_t)(row >= NPT ? 2048 : (row & 2047)) * 32;
    const float cs = tb[i], sn = tb[16 + i];
    const float ov = lane < 16 ? xn * cs - other * sn : other * sn + xn * cs;
    if (lane < 32) o[64 + lane] = ov;
}
__device__ __forceinline__ void post_kv_item(const MK& a, int idx, int lane) {
    const int row = idx >> 3, h = idx & 7;
    const float v = a.KV()[(size_t)row * 1024 + h * 128 + lane];
    const float ss = wave_sum(v * v);
    const float kn = v * rsqrtf(ss * (1.f / 64.f) + EPSV) * a.g_k_nope[lane];
    a.kh()[((size_t)row * 8 + h) * 64 + lane] = kn;
}

typedef float f32x16 __attribute__((ext_vector_type(16)));
typedef short s16x4 __attribute__((ext_vector_type(4)));
#define KST 104
#define VST 72
#define ATT_BUF (64 * KST * 2 + 64 * VST * 2)
__device__ __forceinline__ int crow32(int r, int hi) { return (r & 3) + 8 * (r >> 2) + 4 * hi; }
__device__ __forceinline__ s16x4 tr_read(const bf16_t* p) { return __builtin_bit_cast(s16x4, __builtin_amdgcn_ds_read_tr16_b64_v4i16((LAS s16x4*)(LAS void*)(unsigned)(size_t)p)); }
__device__ __forceinline__ bf16x8 pack8(const f32x16& x, int s) {
    u32x4 w; w.x = cvtpk(x[8 * s], x[8 * s + 1]); w.y = cvtpk(x[8 * s + 2], x[8 * s + 3]); w.z = cvtpk(x[8 * s + 4], x[8 * s + 5]); w.w = cvtpk(x[8 * s + 6], x[8 * s + 7]);
    return __builtin_bit_cast(bf16x8, w);
}
__device__ __forceinline__ void attn_block(const MK& a, int b, int h, int qb, char* smem) {
    const int tid = otid(), lane = tid & 63, wid = tid >> 6, r32 = lane & 31, hi = lane >> 5;
    const int qrow = qb * 256 + wid * 32 + r32;
    const int wq0 = qb * 256 + wid * 32;
    bf16x8 qf[6];
    {
        const float SCL = 0.14724445f;
        const bf16_t* Qg = a.qraw() + ((size_t)b * SEQ + qrow) * 768 + h * 96 + 8 * hi;
        float qv[6][8];
#pragma unroll
        for (int ds = 0; ds < 6; ++ds) bf8_to_f32(*(const bf16x8*)(Qg + 16 * ds), qv[ds]);
        float sn_ = 0.f, sr_ = 0.f;
#pragma unroll
        for (int j = 0; j < 8; ++j) { sn_ += qv[0][j] * qv[0][j] + qv[1][j] * qv[1][j] + qv[2][j] * qv[2][j] + qv[3][j] * qv[3][j]; sr_ += qv[4][j] * qv[4][j] + qv[5][j] * qv[5][j]; }
        sn_ = add_x32(sn_); sr_ = add_x32(sr_);
        const float rsn = rsqrtf(sn_ * (1.f / 64.f) + EPSV) * SCL, rsr = rsqrtf(sr_ * (1.f / 32.f) + EPSV);
#pragma unroll
        for (int ds = 0; ds < 4; ++ds) {
            float o[8];
#pragma unroll
            for (int j = 0; j < 8; ++j) o[j] = qv[ds][j] * rsn * a.g_q_nope[16 * ds + 8 * hi + j];
            qf[ds] = f32_to_bf8(o);
        }
        const float* tb = a.ropecs() + (size_t)qrow * 32 + 8 * hi;
        float o4[8], o5[8];
#pragma unroll
        for (int j = 0; j < 8; ++j) {
            const float x1 = qv[4][j] * rsr * a.g_q_rope[8 * hi + j], x2 = qv[5][j] * rsr * a.g_q_rope[16 + 8 * hi + j], cs = tb[j], sn = tb[16 + j];
            o4[j] = (x1 * cs - x2 * sn) * SCL; o5[j] = (x1 * sn + x2 * cs) * SCL;
        }
        qf[4] = f32_to_bf8(o4); qf[5] = f32_to_bf8(o5);
    }
    f32x16 o0, o1;
#pragma unroll
    for (int r = 0; r < 16; ++r) { o0[r] = 0.f; o1[r] = 0.f; }
    float m = 0.f, l = 0.f;
    f32x16 negm;
#pragma unroll
    for (int r = 0; r < 16; ++r) negm[r] = 0.f;
    const int nt = qb * 4 + 4;
    const int vr = tid >> 3, vc = tid & 7, rr_ = (tid >> 2) & 63, rc = tid & 3;
    const bf16_t* KVg = a.kvraw() + (size_t)b * SEQ * 1024 + h * 128 + (size_t)vr * 1024 + vc * 8;
    const bf16_t* KRg = a.krb() + (size_t)b * SEQ * 32 + (size_t)rr_ * 32 + rc * 8;
    float gk[8];
#pragma unroll
    for (int j = 0; j < 8; ++j) gk[j] = a.g_k_nope[8 * vc + j];
    bf16x8 kr0, kr1, vr0;
#define ATT_LOAD(tt) do { kr0 = *(const bf16x8*)(KVg + (size_t)(tt) * 64 * 1024); vr0 = *(const bf16x8*)(KVg + (size_t)(tt) * 64 * 1024 + 64); if (tid < 256) kr1 = *(const bf16x8*)(KRg + (size_t)(tt) * 64 * 32); } while (0)
#define ATT_STORE(buf) do { bf16_t* Ks_ = (bf16_t*)(smem + (buf) * ATT_BUF); bf16_t* Vs_ = Ks_ + 64 * KST; \
        float x_[8]; bf8_to_f32(kr0, x_); float ss_ = 0.f; _Pragma("unroll") for (int j = 0; j < 8; ++j) ss_ += x_[j] * x_[j]; \
        ss_ = sum8(ss_); const float rs_ = rsqrtf(ss_ * (1.f / 64.f) + EPSV); \
        _Pragma("unroll") for (int j = 0; j < 8; ++j) x_[j] *= rs_ * gk[j]; \
        *(bf16x8*)(Ks_ + vr * KST + vc * 8) = f32_to_bf8(x_); *(bf16x8*)(Vs_ + vr * VST + vc * 8) = vr0; \
        if (tid < 256) *(bf16x8*)(Ks_ + rr_ * KST + 64 + rc * 8) = kr1; } while (0)
    ATT_LOAD(0);
    __syncthreads();
    ATT_STORE(0);
    __syncthreads();
    const int i16 = lane & 15, qq = i16 >> 2, pp = i16 & 3, g1 = (lane >> 4) & 1;
    for (int t = 0; t < nt; ++t) {
        const bf16_t* Ks = (const bf16_t*)(smem + (t & 1) * ATT_BUF); const bf16_t* Vs = Ks + 64 * KST;
        if (t + 1 < nt) ATT_LOAD(t + 1);
        if (64 * t <= wq0 + 31) {
            f32x16 p0, p1;
#pragma unroll
            for (int ds = 0; ds < 6; ++ds) {
                const bf16x8 k0 = *(const bf16x8*)(Ks + r32 * KST + 16 * ds + 8 * hi);
                const bf16x8 k1 = *(const bf16x8*)(Ks + (32 + r32) * KST + 16 * ds + 8 * hi);
                if (ds == 0) { p0 = __builtin_amdgcn_mfma_f32_32x32x16_bf16(k0, qf[ds], negm, 0, 0, 0); p1 = __builtin_amdgcn_mfma_f32_32x32x16_bf16(k1, qf[ds], negm, 0, 0, 0); }
                else { p0 = __builtin_amdgcn_mfma_f32_32x32x16_bf16(k0, qf[ds], p0, 0, 0, 0); p1 = __builtin_amdgcn_mfma_f32_32x32x16_bf16(k1, qf[ds], p1, 0, 0, 0); }
            }
            if (64 * t + 63 > wq0) {
#pragma unroll
                for (int r = 0; r < 16; ++r) { const int kv = 64 * t + crow32(r, hi); if (kv > qrow) p0[r] = -INFINITY; if (kv + 32 > qrow) p1[r] = -INFINITY; }
            }
            float mx = fmaxf(p0[0], p1[0]);
#pragma unroll
            for (int r = 1; r < 16; ++r) mx = fmaxf(mx, fmaxf(p0[r], p1[r]));
            mx = max_x32(mx);
            const float delta = t == 0 ? mx : fmaxf(mx, 0.f);
            if (__any(delta != 0.f)) {
                m += delta;
                const float f = t == 0 ? 1.f : __builtin_amdgcn_exp2f(-delta);
#pragma unroll
                for (int r = 0; r < 16; ++r) { p0[r] -= delta; p1[r] -= delta; negm[r] = -m; o0[r] *= f; o1[r] *= f; }
                l *= f;
            }
            float rs = 0.f;
#pragma unroll
            for (int r = 0; r < 16; ++r) { p0[r] = __builtin_amdgcn_exp2f(p0[r]); p1[r] = __builtin_amdgcn_exp2f(p1[r]); rs += p0[r] + p1[r]; }
            l += rs;
            bf16x8 pf[4];
            pf[0] = pack8(p0, 0); pf[1] = pack8(p0, 1); pf[2] = pack8(p1, 0); pf[3] = pack8(p1, 1);
#pragma unroll
            for (int ks = 0; ks < 4; ++ks) {
                const bf16_t* vb0 = Vs + (16 * ks + 4 * hi + qq) * VST + 16 * g1 + 4 * pp;
                const s16x4 a0 = tr_read(vb0), a1 = tr_read(vb0 + 8 * VST);
                const s16x4 c0 = tr_read(vb0 + 32), c1 = tr_read(vb0 + 8 * VST + 32);
                const bf16x8 va = __builtin_shufflevector(a0, a1, 0, 1, 2, 3, 4, 5, 6, 7);
                const bf16x8 vc_ = __builtin_shufflevector(c0, c1, 0, 1, 2, 3, 4, 5, 6, 7);
                o0 = __builtin_amdgcn_mfma_f32_32x32x16_bf16(va, pf[ks], o0, 0, 0, 0);
                o1 = __builtin_amdgcn_mfma_f32_32x32x16_bf16(vc_, pf[ks], o1, 0, 0, 0);
            }
        }
        if (t + 1 < nt) ATT_STORE((t + 1) & 1);
        __syncthreads();
    }
    l = add_x32(l);
    const float il = 1.f / l;
    bf16_t* op = a.omix() + ((size_t)b * SEQ + qrow) * 1024 + 512 + h * 64;
#pragma unroll
    for (int g = 0; g < 4; ++g) {
        uint2 w0, w1;
        w0.x = pk2bf(o0[4 * g] * il, o0[4 * g + 1] * il); w0.y = pk2bf(o0[4 * g + 2] * il, o0[4 * g + 3] * il);
        w1.x = pk2bf(o1[4 * g] * il, o1[4 * g + 1] * il); w1.y = pk2bf(o1[4 * g + 2] * il, o1[4 * g + 3] * il);
        *(uint2*)(op + 8 * g + 4 * hi) = w0;
        *(uint2*)(op + 32 + 8 * g + 4 * hi) = w1;
    }
#undef ATT_LOAD
#undef ATT_STORE
}

__device__ __forceinline__ void gdn_unit(const MK& a, int b, int h, int dvg, const float* s0, float* sout, int row0, int T, int lane, char* wsm) {
    float (*sq)[64] = (float (*)[64])wsm;
    float (*sk)[64] = (float (*)[64])(wsm + 4096);
    float (*sv)[8] = (float (*)[8])(wsm + 8192);
    float* sg = (float*)(wsm + 8704);
    float* sb = (float*)(wsm + 8768);
    const int e = lane & 7, ko = lane >> 3, col = dvg * 8 + e;
    float S[8];
#pragma unroll
    for (int d = 0; d < 8; ++d) S[d] = s0 ? s0[(((size_t)b * 8 + h) * 64 + ko * 8 + d) * 64 + col] : 0.f;
    const size_t rbase = (size_t)row0 + (size_t)b * T;
    float pq[16], pk[16], pv0, pv1, pgb;
    {
        const int nt = T < 16 ? T : 16;
#pragma unroll
        for (int j = 0; j < 16; ++j) { const bool ok = j < nt; const size_t r = rbase + (ok ? j : 0); pq[j] = ok ? bf2f(a.qkv()[r * 1536 + h * 64 + lane]) : 0.f; pk[j] = ok ? bf2f(a.qkv()[r * 1536 + 512 + h * 64 + lane]) : 0.f; }
        { const int j0 = lane >> 3, j1 = j0 + 8; pv0 = j0 < nt ? bf2f(a.qkv()[(rbase + j0) * 1536 + 1024 + h * 64 + dvg * 8 + (lane & 7)]) : 0.f; pv1 = j1 < nt ? bf2f(a.qkv()[(rbase + j1) * 1536 + 1024 + h * 64 + dvg * 8 + (lane & 7)]) : 0.f; }
        { const int j = lane & 15; pgb = j < nt ? (lane < 16 ? a.gg()[(rbase + j) * 8 + h] : a.bb()[(rbase + j) * 8 + h]) : 0.f; }
    }
    for (int t0 = 0; t0 < T; t0 += 16) {
        const int nt = (T - t0) < 16 ? (T - t0) : 16;
        WSYNC();
#pragma unroll
        for (int j = 0; j < 16; ++j) { sq[j][lane] = pq[j]; sk[j][lane] = pk[j]; }
        sv[lane >> 3][lane & 7] = pv0; sv[(lane >> 3) + 8][lane & 7] = pv1;
        if (lane < 16) sg[lane] = expf(pgb); else if (lane < 32) sb[lane - 16] = pgb;
        WSYNC();
        if (t0 + 16 < T) {
            const size_t rb = rbase + t0 + 16;
#pragma unroll
            for (int j = 0; j < 16; ++j) { pq[j] = bf2f(a.qkv()[(rb + j) * 1536 + h * 64 + lane]); pk[j] = bf2f(a.qkv()[(rb + j) * 1536 + 512 + h * 64 + lane]); }
            pv0 = bf2f(a.qkv()[(rb + (lane >> 3)) * 1536 + 1024 + h * 64 + dvg * 8 + (lane & 7)]); pv1 = bf2f(a.qkv()[(rb + (lane >> 3) + 8) * 1536 + 1024 + h * 64 + dvg * 8 + (lane & 7)]);
            pgb = lane < 16 ? a.gg()[(rb + (lane & 15)) * 8 + h] : a.bb()[(rb + (lane & 15)) * 8 + h];
        }
        for (int j = 0; j < nt; ++j) {
            const float dec = sg[j], be = sb[j], v = sv[j][e];
            const float4 k0 = *(const float4*)&sk[j][ko * 8], k1 = *(const float4*)&sk[j][ko * 8 + 4];
            const float4 q0 = *(const float4*)&sq[j][ko * 8], q1 = *(const float4*)&sq[j][ko * 8 + 4];
            const float kk[8] = {k0.x, k0.y, k0.z, k0.w, k1.x, k1.y, k1.z, k1.w};
            const float qq[8] = {q0.x, q0.y, q0.z, q0.w, q1.x, q1.y, q1.z, q1.w};
            float ks = 0.f;
#pragma unroll
            for (int d = 0; d < 8; ++d) { S[d] *= dec; ks += kk[d] * S[d]; }
            ks += __shfl_xor(ks, 8); ks += __shfl_xor(ks, 16); ks += __shfl_xor(ks, 32);
            const float delta = (v - ks) * be;
            float ov = 0.f;
#pragma unroll
            for (int d = 0; d < 8; ++d) { S[d] += kk[d] * delta; ov += qq[d] * S[d]; }
            ov += __shfl_xor(ov, 8); ov += __shfl_xor(ov, 16); ov += __shfl_xor(ov, 32);
            if (ko == 0) a.goraw()[(rbase + t0 + j) * 512 + h * 64 + col] = ov;
        }
    }
#pragma unroll
    for (int d = 0; d < 8; ++d) sout[(((size_t)b * 8 + h) * 64 + ko * 8 + d) * 64 + col] = S[d];
}
__device__ __forceinline__ int pi_pos(int k) { return (k & 32) + 8 * ((k >> 2) & 3) + 4 * ((k >> 4) & 1) + (k & 3); }
#define GDN_WLDS 17408
__device__ __forceinline__ void gdn_prep_unit(const MK& a, int u, int lane_in, char* wsm) {
    int lane = lane_in; asm volatile("" : "+v"(lane));
    const int bh = u >> 5, n = u & 31, b = bh >> 3, h = bh & 7, i16 = lane & 15, q4 = lane >> 4;
    const size_t row0 = (size_t)b * SEQ + n * 64;
    float* AT = (float*)wsm; float* GC = (float*)(wsm + 16384); float* BT = GC + 64;
    const bf16_t* qbase = a.qkv() + row0 * 1536 + h * 64; const bf16_t* kbase = qbase + 512; const bf16_t* vbase = qbase + 1024;
    float g = a.gg()[(row0 + lane) * 8 + h];
    const float be_l = a.bb()[(row0 + lane) * 8 + h];
#pragma unroll
    for (int o = 1; o < 64; o <<= 1) { const float t = __shfl_up(g, o); if (lane >= o) g += t; }
    WSYNC();
    GC[lane] = g; BT[lane] = be_l;
    WSYNC();
    const float gl = GC[63];
    float* EG = BT + 64; float* ED = EG + 64;
    EG[lane] = expf(g); ED[lane] = expf(gl - g);
    WSYNC();
    bf16x8 kf[4][2], qf[4][2];
#pragma unroll
    for (int mt = 0; mt < 4; ++mt)
#pragma unroll
        for (int ks = 0; ks < 2; ++ks) {
            const int off = (16 * mt + i16) * 1536 + 32 * ks + 8 * q4;
            kf[mt][ks] = *(const bf16x8*)(kbase + off); qf[mt][ks] = *(const bf16x8*)(qbase + off);
        }
    bf16_t* QKg = a.gQK() + (size_t)u * 4096;
#pragma unroll
    for (int mt = 0; mt < 4; ++mt)
#pragma unroll
        for (int nt = 0; nt < 4; ++nt) {
            const int j = 16 * nt + i16, pj = 32 * (nt >> 1) + 8 * (i16 >> 2) + 4 * (nt & 1) + (i16 & 3);
            if (nt <= mt) {
                f32x4 d1 = {0.f, 0.f, 0.f, 0.f}, d2 = {0.f, 0.f, 0.f, 0.f};
#pragma unroll
                for (int ks = 0; ks < 2; ++ks) {
                    d1 = __builtin_amdgcn_mfma_f32_16x16x32_bf16(kf[mt][ks], kf[nt][ks], d1, 0, 0, 0);
                    d2 = __builtin_amdgcn_mfma_f32_16x16x32_bf16(qf[mt][ks], kf[nt][ks], d2, 0, 0, 0);
                }
                const float gcj = GC[j];
#pragma unroll
                for (int r = 0; r < 4; ++r) {
                    const int i = 16 * mt + 4 * q4 + r;
                    const float dec = __builtin_amdgcn_exp2f(1.44269504f * (GC[i] - gcj));
                    AT[i * 64 + j] = (i > j) ? BT[i] * d1[r] * dec : 0.f;
                    QKg[i * 64 + (((pj >> 3) ^ (i & 7)) << 3) + (pj & 7)] = f2bf((i >= j) ? d2[r] * dec : 0.f);
                }
            } else {
#pragma unroll
                for (int r = 0; r < 4; ++r) { const int i = 16 * mt + 4 * q4 + r; QKg[i * 64 + (((pj >> 3) ^ (i & 7)) << 3) + (pj & 7)] = 0; }
            }
        }
    {
        bf16_t* Qgg = a.gQg() + (size_t)u * 4096;
#pragma unroll
        for (int mt = 0; mt < 4; ++mt) {
            const int i = 16 * mt + i16; const float e = EG[i];
#pragma unroll
            for (int ks = 0; ks < 2; ++ks) {
                float x[8]; bf8_to_f32(qf[mt][ks], x);
                uint2 w0, w1; w0.x = cvtpk(x[0] * e, x[1] * e); w0.y = cvtpk(x[2] * e, x[3] * e); w1.x = cvtpk(x[4] * e, x[5] * e); w1.y = cvtpk(x[6] * e, x[7] * e);
                const int p0 = 32 * ks + 16 * (q4 & 1) + 4 * (q4 >> 1);
                *(uint2*)(Qgg + i * 64 + (((p0 >> 3) ^ (i & 7)) << 3) + (p0 & 7)) = w0; *(uint2*)(Qgg + i * 64 + ((((p0 >> 3) + 1) ^ (i & 7)) << 3) + (p0 & 7)) = w1;
            }
        }
    }
    WSYNC();
    __builtin_amdgcn_sched_barrier(0);
    {
        float U[64];
#pragma unroll
        for (int i = 0; i < 64; ++i) { U[i] = bf2f(vbase[i * 1536 + lane]) * BT[i]; }
#pragma unroll
        for (int i = 1; i < 64; ++i) {
            float su = 0.f;
#pragma unroll
            for (int j4 = 0; j4 < i; j4 += 4) {
                const float4 av = *(const float4*)(AT + i * 64 + j4);
                su += av.x * U[j4];
                if (j4 + 1 < i) su += av.y * U[j4 + 1];
                if (j4 + 2 < i) su += av.z * U[j4 + 2];
                if (j4 + 3 < i) su += av.w * U[j4 + 3];
            }
            U[i] -= su;
            __builtin_amdgcn_sched_barrier(0);
        }
        float* UTg = a.gUT() + ((size_t)u * 64 + lane) * 64;
#pragma unroll
        for (int i = 0; i < 64; i += 4) *(float4*)(UTg + 4 * ((i >> 2) ^ (lane & 15))) = (float4){U[i], U[i + 1], U[i + 2], U[i + 3]};
    }
    asm volatile("" ::: "memory");
    __builtin_amdgcn_sched_barrier(0);
    {
        float W[64];
#pragma unroll
        for (int i = 0; i < 64; ++i) { W[i] = bf2f(kbase[i * 1536 + lane]); }
        bf16_t* Kdg = a.gKd() + ((size_t)u * 64 + lane) * 64;
#pragma unroll
        for (int pc = 0; pc < 8; ++pc) {
            float t[8];
#pragma unroll
            for (int jj = 0; jj < 8; ++jj) { const int j = 32 * (pc >> 2) + 16 * (jj >> 2) + 4 * (pc & 3) + (jj & 3); t[jj] = W[j] * ED[j]; }
            u32x4 w; w.x = cvtpk(t[0], t[1]); w.y = cvtpk(t[2], t[3]); w.z = cvtpk(t[4], t[5]); w.w = cvtpk(t[6], t[7]);
            *(u32x4*)(Kdg + 8 * (pc ^ (lane & 7))) = w;
        }
#pragma unroll
        for (int i = 0; i < 64; ++i) W[i] *= BT[i] * EG[i];
#pragma unroll
        for (int i = 1; i < 64; ++i) {
            float sw = 0.f;
#pragma unroll
            for (int j4 = 0; j4 < i; j4 += 4) {
                const float4 av = *(const float4*)(AT + i * 64 + j4);
                sw += av.x * W[j4];
                if (j4 + 1 < i) sw += av.y * W[j4 + 1];
                if (j4 + 2 < i) sw += av.z * W[j4 + 2];
                if (j4 + 3 < i) sw += av.w * W[j4 + 3];
            }
            W[i] -= sw;
            __builtin_amdgcn_sched_barrier(0);
        }
        bf16_t* Wng = a.gWn() + (size_t)u * 4096; const int pp = pi_pos(lane);
#pragma unroll
        for (int i = 0; i < 64; ++i) Wng[i * 64 + (((pp >> 3) ^ (i & 7)) << 3) + (pp & 7)] = f2bf(-W[i]);
    }
    if (lane == 0) a.ggam()[u] = expf(gl);
}
__device__ __forceinline__ bf16x8 pack_acc2(const f32x4& x, const f32x4& y) {
    u32x4 w; w.x = cvtpk(x[0], x[1]); w.y = cvtpk(x[2], x[3]); w.z = cvtpk(y[0], y[1]); w.w = cvtpk(y[2], y[3]);
    return __builtin_bit_cast(bf16x8, w);
}
#define G2_SLOT 49152
__device__ __forceinline__ void g2_issue(const MK& a, size_t u, int n, LAS unsigned char* lds, int lw, int lane) {
    LAS unsigned char* dst = lds + (n % 3) * G2_SLOT;
    const char* srcs[4] = {(const char*)(a.gWn() + u * 4096), (const char*)(a.gQg() + u * 4096), (const char*)(a.gQK() + u * 4096), (const char*)(a.gKd() + u * 4096)};
#pragma unroll
    for (int m = 0; m < 4; ++m)
#pragma unroll
        for (int i = 0; i < 2; ++i) { const int piece = 2 * lw + i;
            __builtin_amdgcn_global_load_lds((const unsigned*)(srcs[m] + piece * 1024 + lane * 16), (LAS unsigned*)(dst + m * 8192 + piece * 1024), 16, 0, 0); }
    const char* us = (const char*)(a.gUT() + u * 4096);
#pragma unroll
    for (int i = 0; i < 4; ++i) { const int piece = 4 * lw + i;
        __builtin_amdgcn_global_load_lds((const unsigned*)(us + piece * 1024 + lane * 16), (LAS unsigned*)(dst + 32768 + piece * 1024), 16, 0, 0); }
}
__device__ __forceinline__ void gdn_scan_block(const MK& a, int bh, LAS unsigned char* lds) {
    const int tid = otid(), lane = tid & 63, wid = __builtin_amdgcn_readfirstlane(tid >> 6), i16 = lane & 15, q4 = lane >> 4;
    const int b = bh >> 3, h = bh & 7, sl = wid & 3;
    const bool loader = wid >= 4;
    f32x4 S[4];
#pragma unroll
    for (int mt = 0; mt < 4; ++mt) S[mt] = (f32x4){0.f, 0.f, 0.f, 0.f};
    __syncthreads();
    if (loader) { g2_issue(a, (size_t)bh * 32, 0, lds, wid - 4, lane); g2_issue(a, (size_t)bh * 32 + 1, 1, lds, wid - 4, lane); }
    for (int n = 0; n < 32; ++n) {
        if (loader) { if (n < 31) asm volatile("s_waitcnt vmcnt(12)" ::: "memory"); else asm volatile("s_waitcnt vmcnt(0)" ::: "memory"); }
        asm volatile("s_waitcnt lgkmcnt(0)" ::: "memory"); __builtin_amdgcn_s_barrier(); asm volatile("" ::: "memory");
        if (loader) { if (n + 2 < 32) g2_issue(a, (size_t)bh * 32 + n + 2, n + 2, lds, wid - 4, lane); }
        else {
            const LAS unsigned char* sb = lds + (n % 3) * G2_SLOT;
            const float gam = a.ggam()[(size_t)bh * 32 + n];
            bf16x8 Sb[2]; Sb[0] = pack_acc2(S[0], S[1]); Sb[1] = pack_acc2(S[2], S[3]);
            f32x4 Vn[4];
#pragma unroll
            for (int mt = 0; mt < 4; ++mt) Vn[mt] = *(const LAS f32x4*)(sb + 32768 + (16 * sl + i16) * 256 + 16 * ((4 * mt + q4) ^ i16));
#pragma unroll
            for (int mt = 0; mt < 4; ++mt)
#pragma unroll
                for (int ks = 0; ks < 2; ++ks) Vn[mt] = __builtin_amdgcn_mfma_f32_16x16x32_bf16(*(const LAS bf16x8*)(sb + (16 * mt + i16) * 128 + 16 * ((4 * ks + q4) ^ (i16 & 7))), Sb[ks], Vn[mt], 0, 0, 0);
            bf16x8 Vb[2]; Vb[0] = pack_acc2(Vn[0], Vn[1]); Vb[1] = pack_acc2(Vn[2], Vn[3]);
            f32x4 O[4];
#pragma unroll
            for (int mt = 0; mt < 4; ++mt) {
                O[mt] = (f32x4){0.f, 0.f, 0.f, 0.f};
#pragma unroll
                for (int ks = 0; ks < 2; ++ks) {
                    const int fo = (16 * mt + i16) * 128 + 16 * ((4 * ks + q4) ^ (i16 & 7));
                    O[mt] = __builtin_amdgcn_mfma_f32_16x16x32_bf16(*(const LAS bf16x8*)(sb + 8192 + fo), Sb[ks], O[mt], 0, 0, 0);
                    O[mt] = __builtin_amdgcn_mfma_f32_16x16x32_bf16(*(const LAS bf16x8*)(sb + 16384 + fo), Vb[ks], O[mt], 0, 0, 0);
                }
            }
#pragma unroll
            for (int mt = 0; mt < 4; ++mt) {
                S[mt] = S[mt] * gam;
#pragma unroll
                for (int ks = 0; ks < 2; ++ks) S[mt] = __builtin_amdgcn_mfma_f32_16x16x32_bf16(*(const LAS bf16x8*)(sb + 24576 + (16 * mt + i16) * 128 + 16 * ((4 * ks + q4) ^ (i16 & 7))), Vb[ks], S[mt], 0, 0, 0);
            }
            float* og = a.goraw() + ((size_t)b * SEQ + n * 64 + 4 * q4) * 512 + h * 64 + 16 * sl + i16;
#pragma unroll
            for (int mt = 0; mt < 4; ++mt)
#pragma unroll
                for (int r = 0; r < 4; ++r) og[(size_t)(16 * mt + r) * 512] = O[mt][r];
        }
    }
    if (!loader) {
        float* so = a.out + O_GSP + ((size_t)bh * 64 + 4 * q4) * 64 + 16 * sl + i16;
#pragma unroll
        for (int mt = 0; mt < 4; ++mt)
#pragma unroll
            for (int r = 0; r < 4; ++r) so[(size_t)(16 * mt + r) * 64] = S[mt][r];
    }
    __syncthreads();
}
__device__ __forceinline__ void gdn_out_token(const MK& a, int row, int lane) {
    const float* op = a.goraw() + (size_t)row * 512 + 8 * lane;
    const float4 x0 = *(const float4*)op, x1 = *(const float4*)(op + 4);
    float o[8] = {x0.x, x0.y, x0.z, x0.w, x1.x, x1.y, x1.z, x1.w}, zg[8];
    bf8_to_f32(*(const bf16x8*)(a.Z() + (size_t)row * ZW + OFF_Z + 8 * lane), zg);
    float ss = 0.f;
#pragma unroll
    for (int e = 0; e < 8; ++e) ss += o[e] * o[e];
    ss = sum8(ss);
    const float rs = rsqrtf(ss * (1.f / 64.f) + EPSV);
    const float4 g0 = *(const float4*)(a.g_gdn_out + 8 * (lane & 7)), g1 = *(const float4*)(a.g_gdn_out + 8 * (lane & 7) + 4);
    const float gg_[8] = {g0.x, g0.y, g0.z, g0.w, g1.x, g1.y, g1.z, g1.w};
#pragma unroll
    for (int e = 0; e < 8; ++e) o[e] = o[e] * rs * gg_[e] * zg[e] * fast_sigmoid(zg[e]);
    *(bf16x8*)(a.omix() + (size_t)row * 1024 + 8 * lane) = f32_to_bf8(o);
}

#define SSLOT 32768
#define TL_OFF (3 * SSLOT)
#define CST 264
#define KR_OFF (TL_OFF + 2 * 32 * CST * 2)
#define WQ_OFF (KR_OFF + 4 * 4096)
#define QR_OFF (WQ_OFF + 2048)
#define PG_OFF (QR_OFF + 1024)
#define PT_OFF (PG_OFF + 64)
#define AL_OFF (PT_OFF + 1024)
#define SAMP_LDS_END (AL_OFF + 64)
__device__ __forceinline__ void samp_issue(const MK& a, int g, LAS unsigned char* lds, int wid, int lane) {
    const int phys = __builtin_amdgcn_readfirstlane(((const LAS int*)(lds + PG_OFF))[g >> 2]);
    const int tok0 = (g & 3) * 32 + 4 * wid;
    const float* cs = a.cache_ckv + ((size_t)phys * 128 + tok0) * 256 + lane * 4;
#pragma unroll
    for (int i = 0; i < 4; ++i) __builtin_amdgcn_global_load_lds((const unsigned*)(cs + i * 256), (LAS unsigned*)(lds + (g % 3) * SSLOT + (4 * wid + i) * 1024), 16, 0, 0);
    if (wid < 4) __builtin_amdgcn_global_load_lds((const unsigned*)(a.cache_krope + ((size_t)phys * 128 + (g & 3) * 32 + 8 * wid) * 32 + lane * 4), (LAS unsigned*)(lds + KR_OFF + (g & 3) * 4096 + wid * 1024), 16, 0, 0);
}
__device__ __forceinline__ void samp_convert(int g, LAS unsigned char* lds, int tid) {
    const int st = tid >> 4, c16 = (tid & 15) * 16;
    const LAS float* src = (const LAS float*)(lds + (g % 3) * SSLOT) + st * 256 + c16;
    const f32x4 x0 = *(const LAS f32x4*)src, x1 = *(const LAS f32x4*)(src + 4), x2 = *(const LAS f32x4*)(src + 8), x3 = *(const LAS f32x4*)(src + 12);
    u32x4 w0, w1; w0.x = cvtpk(x0[0], x0[1]); w0.y = cvtpk(x0[2], x0[3]); w0.z = cvtpk(x1[0], x1[1]); w0.w = cvtpk(x1[2], x1[3]);
    w1.x = cvtpk(x2[0], x2[1]); w1.y = cvtpk(x2[2], x2[3]); w1.z = cvtpk(x3[0], x3[1]); w1.w = cvtpk(x3[2], x3[3]);
    LAS bf16_t* dst = (LAS bf16_t*)(lds + TL_OFF + (g & 1) * 32 * CST * 2) + st * CST + c16;
    *(LAS u32x4*)dst = w0; *(LAS u32x4*)(dst + 8) = w1;
}
#define SAMP_WAITV(n5, n4) do { if (h < 4) asm volatile("s_waitcnt vmcnt(" #n5 ")" ::: "memory"); else asm volatile("s_waitcnt vmcnt(" #n4 ")" ::: "memory"); } while (0)
#define SAMP_BAR() do { asm volatile("s_waitcnt lgkmcnt(0)" ::: "memory"); __builtin_amdgcn_s_barrier(); asm volatile("" ::: "memory"); } while (0)
__device__ __forceinline__ void samp_attn_unit(const MK& a, int u, char* smem, LAS unsigned char* lds) {
    const int tid = otid(), lane = tid & 63, h = __builtin_amdgcn_readfirstlane(tid >> 6), i16 = lane & 15, q4 = lane >> 4;
    const int b = u >> 3, sp = u & 7;
    float* WQ = (float*)(smem + WQ_OFF);
    float* QR = (float*)(smem + QR_OFF);
    int* PG = (int*)(smem + PG_OFF);
    const float SCL = 0.14724445f;
    post_q_item(a, (NPT + b) * 8 + h, lane);
    __syncthreads();
    {
        const int h_ = tid >> 6, l_ = tid & 63, q4_ = l_ >> 4, idx = l_ & 15, d = 16 * (idx >> 2) + 4 * q4_ + (idx & 3);
        WQ[tid] = a.g_k_nope[d] * a.qh()[((size_t)(NPT + b) * 8 + h_) * 96 + d] * SCL;
        if (tid < 256) QR[tid] = a.qh()[((size_t)(NPT + b) * 8 + (tid >> 5)) * 96 + 64 + (tid & 31)] * SCL;
        if (tid < 16) PG[tid] = a.page_table[b * NPAGES + sp * 16 + tid];
    }
    bf16x8 wf[4][8];
#pragma unroll
    for (int mt = 0; mt < 4; ++mt)
#pragma unroll
        for (int ks = 0; ks < 8; ++ks) wf[mt][ks] = *(const bf16x8*)(a.WknT() + (size_t)(h * 64 + 16 * mt + i16) * 256 + 32 * ks + 8 * q4);
#pragma unroll
    for (int mt = 0; mt < 4; ++mt)
#pragma unroll
        for (int ks = 0; ks < 8; ++ks) asm volatile("" : "+v"(wf[mt][ks]));
    __syncthreads();
    samp_issue(a, 0, lds, h, lane); samp_issue(a, 1, lds, h, lane); samp_issue(a, 2, lds, h, lane);
    SAMP_WAITV(10, 8);
    SAMP_BAR();
    samp_convert(0, lds, tid);
    const LAS float* QRl = (const LAS float*)(lds + QR_OFF) + h * 32 + 8 * q4;
    const LAS float* WQl = (const LAS float*)(lds + WQ_OFF) + (h * 4 + q4) * 16;
    float m = -INFINITY, lsum = 0.f;
    f32x4 latv[2]; latv[0] = (f32x4){0.f, 0.f, 0.f, 0.f}; latv[1] = (f32x4){0.f, 0.f, 0.f, 0.f};
    for (int g = 0; g < 64; ++g) {
        SAMP_BAR();
        if (g + 3 < 64) samp_issue(a, g + 3, lds, h, lane);
        const LAS bf16_t* Tl = (const LAS bf16_t*)(lds + TL_OFF + (g & 1) * 32 * CST * 2); const LAS float* KR = (const LAS float*)(lds + KR_OFF + (g & 3) * 4096);
        float sc[2];
        {
            f32x4 acc[2][4];
#pragma unroll
            for (int hf = 0; hf < 2; ++hf)
#pragma unroll
                for (int mt = 0; mt < 4; ++mt) acc[hf][mt] = (f32x4){0.f, 0.f, 0.f, 0.f};
            const LAS bf16_t* cp0 = Tl + i16 * CST + 8 * q4; const LAS bf16_t* cp1 = cp0 + 16 * CST;
            bf16x8 c0 = *(const LAS bf16x8*)cp0, c1 = *(const LAS bf16x8*)cp1;
#pragma unroll
            for (int ks = 0; ks < 8; ++ks) {
                bf16x8 n0 = c0, n1 = c1;
                if (ks < 7) { n0 = *(const LAS bf16x8*)(cp0 + 32 * (ks + 1)); n1 = *(const LAS bf16x8*)(cp1 + 32 * (ks + 1)); }
#pragma unroll
                for (int mt = 0; mt < 4; ++mt) { acc[0][mt] = __builtin_amdgcn_mfma_f32_16x16x32_bf16(wf[mt][ks], c0, acc[0][mt], 0, 0, 0); acc[1][mt] = __builtin_amdgcn_mfma_f32_16x16x32_bf16(wf[mt][ks], c1, acc[1][mt], 0, 0, 0); }
                c0 = n0; c1 = n1;
            }
#pragma unroll
            for (int hf = 0; hf < 2; ++hf) {
                float ss = 0.f, dot = 0.f, rd = 0.f;
#pragma unroll
                for (int mt = 0; mt < 4; ++mt) {
                    const f32x4 wq = *(const LAS f32x4*)(WQl + 4 * mt);
                    ss += acc[hf][mt][0] * acc[hf][mt][0] + acc[hf][mt][1] * acc[hf][mt][1] + acc[hf][mt][2] * acc[hf][mt][2] + acc[hf][mt][3] * acc[hf][mt][3];
                    dot += acc[hf][mt][0] * wq[0] + acc[hf][mt][1] * wq[1] + acc[hf][mt][2] * wq[2] + acc[hf][mt][3] * wq[3];
                }
                {
                    const LAS float* kp = KR + (16 * hf + i16) * 32 + 8 * q4;
                    const f32x4 k0 = *(const LAS f32x4*)kp, k1 = *(const LAS f32x4*)(kp + 4), q0 = *(const LAS f32x4*)QRl, q1 = *(const LAS f32x4*)(QRl + 4);
                    rd = k0[0] * q0[0] + k0[1] * q0[1] + k0[2] * q0[2] + k0[3] * q0[3] + k1[0] * q1[0] + k1[1] * q1[1] + k1[2] * q1[2] + k1[3] * q1[3];
                }
                ss = add_x32(add_x16(ss)); dot = add_x32(add_x16(dot)); rd = add_x32(add_x16(rd));
                sc[hf] = dot * rsqrtf(ss * (1.f / 64.f) + EPSV) + rd;
            }
        }
        const float gm = max16(fmaxf(sc[0], sc[1]));
        const float mn = fmaxf(m, gm);
        const float alpha = __builtin_amdgcn_exp2f(m - mn), p0 = __builtin_amdgcn_exp2f(sc[0] - mn), p1 = __builtin_amdgcn_exp2f(sc[1] - mn);
        m = mn;
        lsum = lsum * alpha + p0 + p1;
        if (q4 == 0) { ((LAS float*)(lds + PT_OFF))[h * 32 + i16] = p0; ((LAS float*)(lds + PT_OFF))[h * 32 + 16 + i16] = p1; if (i16 == 0) ((LAS float*)(lds + AL_OFF))[h] = alpha; }
        if (g <= 60) SAMP_WAITV(10, 8); else if (g == 61) SAMP_WAITV(5, 4); else SAMP_WAITV(0, 0);
        SAMP_BAR();
        {
            u32x4 pw = {0u, 0u, 0u, 0u};
            if (i16 < 8) { const f32x4 pa = *(const LAS f32x4*)(lds + PT_OFF + (i16 * 32 + 8 * q4) * 4), pb_ = *(const LAS f32x4*)(lds + PT_OFF + (i16 * 32 + 8 * q4 + 4) * 4);
                pw.x = cvtpk(pa[0], pa[1]); pw.y = cvtpk(pa[2], pa[3]); pw.z = cvtpk(pb_[0], pb_[1]); pw.w = cvtpk(pb_[2], pb_[3]); }
            const bf16x8 pfr = __builtin_bit_cast(bf16x8, pw);
            const f32x4 al = *(const LAS f32x4*)(lds + AL_OFF + (q4 & 1) * 16);
            const bf16_t* tb0 = (const bf16_t*)(smem + TL_OFF + (g & 1) * 32 * CST * 2) + (8 * q4 + (i16 >> 2)) * CST + 32 * h + 4 * (i16 & 3);
#pragma unroll
            for (int nt = 0; nt < 2; ++nt) {
                const s16x4 c0 = tr_read(tb0 + 16 * nt), c1 = tr_read(tb0 + 16 * nt + 4 * CST);
                const bf16x8 cfr = __builtin_shufflevector(c0, c1, 0, 1, 2, 3, 4, 5, 6, 7);
                latv[nt] = latv[nt] * al;
                latv[nt] = __builtin_amdgcn_mfma_f32_16x16x32_bf16(pfr, cfr, latv[nt], 0, 0, 0);
            }
        }
        if (g + 1 < 64) samp_convert(g + 1, lds, tid);
    }
#pragma unroll
    for (int o = 1; o < 16; o <<= 1) lsum += __shfl_xor(lsum, o);
    if (lane == 0) { float* o = a.part() + ((size_t)u * 8 + h) * 260; o[0] = m * 0.69314718f; o[1] = lsum; }
    if (q4 < 2) {
#pragma unroll
        for (int nt = 0; nt < 2; ++nt)
#pragma unroll
            for (int r = 0; r < 4; ++r) a.part()[((size_t)u * 8 + 4 * q4 + r) * 260 + 4 + 32 * h + 16 * nt + i16] = latv[nt][r];
    }
}
__device__ __forceinline__ void samp_comb_unit(const MK& a, int u, char* smem) {
    float* slat = (float*)smem;
    const int b = u >> 3, h = u & 7, tid = otid() & 255;
    const size_t row = NPT + b;
    const float* q = a.qh() + (row * 8 + h) * 96;
    float s_self = 0.f;
    for (int d = 0; d < 64; ++d) s_self += q[d] * a.kh()[(row * 8 + h) * 64 + d];
    for (int d = 0; d < 32; ++d) s_self += q[64 + d] * a.krf()[row * 32 + d];
    s_self *= 0.10206207261596577f;
    float m = s_self;
    for (int s = 0; s < 8; ++s) m = fmaxf(m, a.part()[((size_t)(b * 8 + s) * 8 + h) * 260]);
    const float pself = expf(s_self - m);
    float l = pself, lat = 0.f;
    for (int s = 0; s < 8; ++s) {
        const float* p = a.part() + ((size_t)(b * 8 + s) * 8 + h) * 260;
        const float w = expf(p[0] - m);
        l += p[1] * w; lat += p[4 + tid] * w;
    }
    __syncthreads();
    slat[tid] = lat;
    __syncthreads();
    if (tid < 64) {
        float o = 0.f;
        for (int c = 0; c < 256; ++c) o += slat[c] * a.w_kv_b[(size_t)c * 1024 + h * 128 + 64 + tid];
        o += pself * a.KV()[row * 1024 + h * 128 + 64 + tid];
        a.omix()[row * 1024 + 512 + h * 64 + tid] = f2bf(o / l);
    }
}

#define XB_TMO      128
#define XB_XCNT(j)  (256  + 64 * (j))
#define XB_XSUB(j)  (1280 + 64 * (j))
#define XB_XGEN(j)  (2304 + 64 * (j))
#define XB_TOP      3328
#define XB_TOPGEN   3392
#define XCD_BAR_WORDS 3456
#define XB_SPIN_CAP (1u << 18)

__device__ __forceinline__ unsigned xb_ld(unsigned* p)              { return __hip_atomic_load(p, __ATOMIC_RELAXED, __HIP_MEMORY_SCOPE_AGENT); }
__device__ __forceinline__ unsigned xb_add(unsigned* p, unsigned v) { return __hip_atomic_fetch_add(p, v, __ATOMIC_RELAXED, __HIP_MEMORY_SCOPE_AGENT); }
__device__ __forceinline__ unsigned xb_xcc_id() { return (unsigned)__builtin_amdgcn_s_getreg((3 << 11) | 20) & 0xFu; }
#define XB_SPIN(cond, bar) do { unsigned _sp = 0; while (cond) { __builtin_amdgcn_s_sleep(1); \
    if ((++_sp & 255u) == 0u) { if (xb_ld(&(bar)[XB_TMO])) break; if (_sp > XB_SPIN_CAP) { atomicAdd(&(bar)[XB_TMO], 1u); break; } } } } while (0)

struct XcdBarrier {
    unsigned* bar; unsigned x;
    volatile LAS unsigned* st;
};

__device__ __forceinline__ XcdBarrier xcd_barrier_post(unsigned* bar, volatile LAS unsigned* st) {
    XcdBarrier b; b.bar = bar; b.x = xb_xcc_id(); b.st = st;
    if (threadIdx.x == 0) (void)xb_add(&bar[XB_XCNT(b.x)], 1u);
    return b;
}
__device__ __forceinline__ void xcd_barrier_complete(unsigned* bar, unsigned x, unsigned& nloc, unsigned& nx) {
    const unsigned G = gridDim.x * gridDim.y * gridDim.z;
    unsigned sum, cnt, mine, sp = 0u;
    for (;;) {
        sum = 0u; cnt = 0u; mine = 0u;
#pragma unroll
        for (unsigned j = 0; j < 16; ++j) { const unsigned c = xb_ld(&bar[XB_XCNT(j)]); sum += c; cnt += (c > 0u) ? 1u : 0u; mine = (j == x) ? c : mine; }
        if (sum == G) break;
        __builtin_amdgcn_s_sleep(1);
        if ((++sp & 255u) == 0u) { if (xb_ld(&bar[XB_TMO])) break; if (sp > XB_SPIN_CAP) { atomicAdd(&bar[XB_TMO], 1u); break; } }
    }
    nloc = mine > 0u ? mine : 1u; nx = cnt > 0u ? cnt : 1u;
}

__device__ __forceinline__ void xcd_barrier(const XcdBarrier& b) {
    asm volatile("s_waitcnt vmcnt(0)" ::: "memory");
    __syncthreads();
    if (threadIdx.x == 0) {
        unsigned* bar = b.bar;
        __builtin_amdgcn_s_waitcnt(0);
        unsigned nloc = b.st[0], nx = b.st[1];
        if (nloc == 0u) { xcd_barrier_complete(bar, b.x, nloc, nx); b.st[0] = nloc; b.st[1] = nx; }
        const unsigned old = xb_add(&bar[XB_XSUB(b.x)], 1u);
        const unsigned gen = old / nloc;
        if (old + 1u == (gen + 1u) * nloc) {
            __builtin_amdgcn_fence(__ATOMIC_RELEASE, "agent");
            asm volatile("s_waitcnt vmcnt(0)" ::: "memory");
            const unsigned og = xb_add(&bar[XB_TOP], 1u);
            const unsigned tg = og / nx;
            if (og + 1u == (tg + 1u) * nx) xb_add(&bar[XB_TOPGEN], 1u);
            else XB_SPIN(xb_ld(&bar[XB_TOPGEN]) == tg, bar);
            __builtin_amdgcn_fence(__ATOMIC_ACQUIRE, "agent");
            xb_add(&bar[XB_XGEN(b.x)], 1u);
            asm volatile("s_waitcnt vmcnt(0)" ::: "memory");
        } else {
            XB_SPIN(xb_ld(&bar[XB_XGEN(b.x)]) == gen, bar);
            __builtin_amdgcn_fence(__ATOMIC_ACQUIRE, "agent");
            asm volatile("s_waitcnt vmcnt(0)" ::: "memory");
        }
    }
    __syncthreads();
}

__device__ __forceinline__ void late_weight_items(const MK& a, int gwl, int ngwl, float* scr, int lane) {
    const int T4 = 32 * 16, T5 = 176 * 16, T7 = 32 * 44, T8 = 32 * 16, TT = T4 + T5 + T7 + T8;
    for (int it = gwl; it < TT; it += ngwl) {
        int r = it;
        if (r < T4) { const int nt_ = r % 32, kb = r / 32; wt_item(a.w_o, 1024, 32 * nt_, 32, a.WoT(), 1024, 32 * nt_, 64 * kb, scr, lane); continue; } r -= T4;
        if (r < T5) { const int nt_ = r % 176, kb = r / 176, pn = nt_ >> 3, wi = nt_ & 7;
            wt_item(wi < 4 ? a.w_gate : a.w_up, DFF, pn * 128 + (wi & 3) * 32, 32, a.WguT(), 1024, 32 * nt_, 64 * kb, scr, lane); continue; } r -= T5;
        if (r < T7) { const int nt_ = r % 32, kb = r / 32; wt_item(a.w_down, 1024, 32 * nt_, 32, a.WdT(), DFF, 32 * nt_, 64 * kb, scr, lane); continue; } r -= T7;
        { const int nt_ = r % 32, kb = r / 32; wt_item(a.w_ple_gate, 1024, 32 * nt_, 32, a.WpgT(), 1024, 32 * nt_, 64 * kb, scr, lane); }
    }
}

#define XB_ST_OFF 155648
#define LDS_BYTES 155904
static_assert(SAMP_LDS_END <= LDS_BYTES, "LDS map");
#define GSYNC() do { xcd_barrier(xbar); } while (0)
__global__ __launch_bounds__(NTHR, 2) void mega(MK a) {
    cg::grid_group grid = cg::this_grid();
    char* smem = (char*)lds_raw;
    LAS unsigned char* lds = (LAS unsigned char*)lds_raw;
    otid_init();
    if (threadIdx.x < 2) ((LAS unsigned*)(lds_raw + XB_ST_OFF))[threadIdx.x] = 0u;
    __syncthreads();
    const XcdBarrier xbar = xcd_barrier_post(a.ctl(), (volatile LAS unsigned*)(LAS void*)(lds_raw + XB_ST_OFF));
    const int bid = blockIdx.x, nb = gridDim.x, ngw = nb * NWAVE;
#define LOCAL_IDS const int tid = otid(), lane = tid & 63, wid = tid >> 6, half = tid >> 8, gw = bid * NWAVE + wid; (void)lane; (void)half; (void)gw; (void)wid;

    {
    LOCAL_IDS
    {
        const int T0 = 88 * 16, T1 = 24 * 6, T2 = 32 * 4, T3 = 16 * 4, T9 = 32 * 4;
        const int TT = T0 + T1 + T2 + T3 + T9;
        float* scr = (float*)(smem + wid * 8704);
        for (int it = gw; it < TT; it += ngw) {
            int r = it;
            if (r < T0) { const int nt_ = r % 88, kb = r / 88, nv = 2736 - 32 * nt_; wt_item(a.w_in, 2736, 32 * nt_, nv < 0 ? 0 : (nv > 32 ? 32 : nv), a.WinT(), 1024, 32 * nt_, 64 * kb, scr, lane); continue; } r -= T0;
            if (r < T1) { const int nt_ = r % 24, kb = r / 24; wt_item(a.w_q_b, 768, 32 * nt_, 32, a.WqbT(), 384, 32 * nt_, 64 * kb, scr, lane); continue; } r -= T1;
            if (r < T2) { const int nt_ = r % 32, kb = r / 32; wt_item(a.w_kv_b, 1024, 32 * nt_, 32, a.WkvT(), 256, 32 * nt_, 64 * kb, scr, lane); continue; } r -= T2;
            if (r < T3) { const int nt_ = r % 16, kb = r / 16, h = nt_ >> 1; wt_item(a.w_kv_b, 1024, h * 128 + 32 * (nt_ & 1), 32, a.WknT(), 256, 32 * nt_, 64 * kb, scr, lane); continue; } r -= T3;
            { const int nt_ = r % 32, kb = r / 32; wt_item(a.w_ple_proj, 1024, 32 * nt_, 32, a.WppT(), 256, 32 * nt_, 64 * kb, scr, lane); }
        }
        for (int e = (bid * NTHR + tid); e < 2049 * 16; e += nb * NTHR) {
            const int pos = e >> 4, i = e & 15; const float ang = (pos == 2048 ? (float)PAST : (float)pos) * powf(10000.f, -(float)i / 16.f);
            a.ropecs()[pos * 32 + i] = cosf(ang); a.ropecs()[pos * 32 + 16 + i] = sinf(ang);
        }
        for (int row = gw; row < MPAD; row += ngw) {
            const float* src = row < NPT ? a.x_prompt + (size_t)row * 1024 : a.x_sample + (size_t)(row < NTOK ? row - NPT : 0) * 1024;
            rms1024_row(src, a.g_attn, a.xn() + (size_t)row * 1024, row >= NTOK, lane);
            ushort4 w = {0, 0, 0, 0};
            if (row < NTOK) { const float* ps = row < NPT ? a.p_prompt + (size_t)row * 256 : a.p_sample + (size_t)(row - NPT) * 256; const float4 v = *(const float4*)(ps + lane * 4); w.x = f2bf(v.x); w.y = f2bf(v.y); w.z = f2bf(v.z); w.w = f2bf(v.w); }
            *(ushort4*)(a.pb() + (size_t)row * 256 + lane * 4) = w;
            if (row >= NTOK) { for (int j = 0; j < 4; ++j) { ushort4 z = {0, 0, 0, 0}; *(ushort4*)(a.omix() + (size_t)row * 1024 + lane * 4 + 256 * j) = z; } }
        }
    }
    }
    if (a.out == nullptr) grid.sync();
    GSYNC();
    {
    LOCAL_IDS
    pg_gemm(lds, a.xn(), a.WinT(), NPT, ZW, 1024, PgBf16{a.Z(), ZW});
    gemm_sample_rows_ks<false>(a.xn(), 1024, a.WinT(), 1024, ZW, EwBf16{a.Z(), ZW}, smem, bid, nb);
    }
    GSYNC();
    {
    LOCAL_IDS
    for (int e = tid; e < 4 * 1536 / 4; e += NTHR) ((float4*)smem)[e] = ((const float4*)a.w_conv)[e];
    __syncthreads();
    for (int run = gw; run < NPT / 8 + NST; run += ngw) post_in_run(a, run, lane, (const float*)smem);
    }
    GSYNC();
    {
    LOCAL_IDS
    for (int u = gw; u < 2048; u += ngw) gdn_prep_unit(a, u, lane, smem + wid * GDN_WLDS);
    }
    {
    LOCAL_IDS
    for (int v = gw; v < NST * 64; v += ngw) gdn_unit(a, v >> 6, (v >> 3) & 7, v & 7, a.state_gdn, a.out + O_GSS, NPT, 1, lane, smem + wid * GDN_WLDS);
    __syncthreads();
    }
    GSYNC();
    {
    LOCAL_IDS
    pg_gemm(lds, a.qan(), a.WqbT(), NPT, 768, 384, PgBf16{a.qraw(), 768});
    pg_gemm(lds, a.ckvb(), a.WkvT(), NPT, 1024, 256, PgBf16{a.kvraw(), 1024}, nb > 64 ? nb - 64 : 0);
    gemm_sample_rows<false>(a.qan(), 384, a.WqbT(), 384, 768, EwF32{a.Q(), 768}, smem, bid, nb, 64);
    gemm_sample_rows<false>(a.ckvb(), 256, a.WkvT(), 256, 1024, EwF32{a.KV(), 1024}, smem, bid, nb, 72);
    for (int bh_ = nb - 1 - bid; bh_ < 64; bh_ += nb) gdn_scan_block(a, bh_, lds);
    if (nb > 64 && bid < nb - 64) {
        pg_gemm(lds, a.pb(), a.WppT(), NPT, 1024, 256, PgBf16{a.PP(), 1024}, nb - 64);
        __syncthreads();
        late_weight_items(a, bid * NWAVE + wid, (nb - 64) * NWAVE, (float*)(smem + wid * 8704), lane);
    } else if (nb <= 64) { pg_gemm(lds, a.pb(), a.WppT(), NPT, 1024, 256, PgBf16{a.PP(), 1024}); __syncthreads(); late_weight_items(a, gw, ngw, (float*)(smem + wid * 8704), lane); }
    gemm_sample_rows<false>(a.pb(), 256, a.WppT(), 256, 1024, EwBf16{a.PP(), 1024}, smem, bid, nb, 80);
    }
    GSYNC();
    {
    LOCAL_IDS
    for (int idx = gw; idx < NST * 8; idx += ngw) { post_q_item(a, NPT * 8 + idx, lane); post_kv_item(a, NPT * 8 + idx, lane); }
    for (int row = gw; row < NTOK; row += ngw) gdn_out_token(a, row, lane);
    for (int pr = bid; pr < 256; pr += nb) { const int bh_ = pr >> 2, s_ = pr & 3; attn_block(a, bh_ >> 3, bh_ & 7, 7 - s_, smem); attn_block(a, bh_ >> 3, bh_ & 7, s_, smem); }
    for (int u = bid; u < NST * 8; u += nb) samp_attn_unit(a, u, smem, lds);
    }
    GSYNC();
    {
    LOCAL_IDS
    for (int u0 = bid * 2; u0 < NST * 8; u0 += nb * 2) samp_comb_unit(a, u0 + half, smem + half * 4096);
    }
    GSYNC();
    {
    LOCAL_IDS
    pg_gemm(lds, a.omix(), a.WoT(), NPT, 1024, 1024, PgResXB{a.x_prompt, a.H()});
    gemm_sample_rows_ks<false>(a.omix(), 1024, a.WoT(), 1024, 1024, EwResX{a.x_sample, a.H()}, smem, bid, nb);
    }
    GSYNC();
    {
    LOCAL_IDS
    for (int row = gw; row < MPAD; row += ngw) rms1024_row_b(a.H() + (size_t)row * 1024, a.g_ffn, a.un() + (size_t)row * 1024, row >= NTOK, lane);
    }
    GSYNC();
    {
    LOCAL_IDS
    pg_gemm(lds, a.un(), a.WguT(), NPT, 2 * DFF, 1024, PgSwiglu{a.hid()});
    gemm_sample_rows_ks<true>(a.un(), 1024, a.WguT(), 1024, 2 * DFF, EwBf16{a.hid(), DFF}, smem, bid, nb);
    }
    GSYNC();
    {
    LOCAL_IDS
    pg_gemm(lds, a.hid(), a.WdT(), NPT, 1024, DFF, PgResBB{a.H(), a.H2()});
    gemm_sample_rows_ks<false>(a.hid(), DFF, a.WdT(), DFF, 1024, EwResH{a.H(), a.H2()}, smem, bid, nb);
    }
    GSYNC();
    {
    LOCAL_IDS
    for (int row = gw; row < MPAD; row += ngw) rms1024_row_b(a.H2() + (size_t)row * 1024, a.g_ple, a.un2() + (size_t)row * 1024, row >= NTOK, lane);
    }
    GSYNC();
    {
    LOCAL_IDS
    pg_gemm(lds, a.un2(), a.WpgT(), NPT, 1024, 1024, PgPleB{a.H2(), a.PP(), a.out});
    gemm_sample_rows_ks<false>(a.un2(), 1024, a.WpgT(), 1024, 1024, EwPle{a.H2(), a.PP(), a.out}, smem, bid, nb);
    }
}

static inline char* carve(char*& p, size_t bytes) { char* r = p; p += (bytes + 255) & ~(size_t)255; return r; }

extern "C" void kernel_launch(void* const* d_in, const int* in_sizes, int n_in, void* d_out, int out_size, void* d_ws, size_t ws_size, hipStream_t stream) {
    MK a{};
    a.x_prompt = (const float*)d_in[0]; a.x_sample = (const float*)d_in[1]; a.cache_ckv = (const float*)d_in[2]; a.cache_krope = (const float*)d_in[3];
    a.state_gdn = (const float*)d_in[4]; a.state_conv = (const float*)d_in[5]; a.page_table = (const int*)d_in[6]; a.p_prompt = (const float*)d_in[7]; a.p_sample = (const float*)d_in[8];
    a.g_attn = (const float*)d_in[9]; a.w_in = (const float*)d_in[10]; a.w_conv = (const float*)d_in[11]; a.a_log = (const float*)d_in[12]; a.dt_bias = (const float*)d_in[13];
    a.g_gdn_out = (const float*)d_in[14]; a.g_q_a = (const float*)d_in[15]; a.w_q_b = (const float*)d_in[16]; a.g_q_nope = (const float*)d_in[17]; a.g_q_rope = (const float*)d_in[18];
    a.g_kv_a = (const float*)d_in[19]; a.g_k_rope = (const float*)d_in[20]; a.w_kv_b = (const float*)d_in[21]; a.g_k_nope = (const float*)d_in[22]; a.w_o = (const float*)d_in[23];
    a.g_ffn = (const float*)d_in[24]; a.w_gate = (const float*)d_in[25]; a.w_up = (const float*)d_in[26]; a.w_down = (const float*)d_in[27]; a.g_ple = (const float*)d_in[28];
    a.w_ple_gate = (const float*)d_in[29]; a.w_ple_proj = (const float*)d_in[30];
    a.out = (float*)d_out;
    a.ws = (char*)d_ws;
    if (WS_TOTAL > ws_size) { fprintf(stderr, "kernel_launch: workspace too small: need %zu have %zu\n", (size_t)WS_TOTAL, ws_size); return; }

    static int grid_blocks = 0;
    if (!grid_blocks) {
        int dev = 0, cus = 0, per_cu = 0;
        (void)hipGetDevice(&dev);
        (void)hipDeviceGetAttribute(&cus, hipDeviceAttributeMultiprocessorCount, dev);
        (void)hipFuncSetAttribute((const void*)mega, hipFuncAttributeMaxDynamicSharedMemorySize, LDS_BYTES);
        (void)hipOccupancyMaxActiveBlocksPerMultiprocessor(&per_cu, (const void*)mega, NTHR, LDS_BYTES);
        if (per_cu < 1) fprintf(stderr, "kernel_launch: occupancy query says %d blocks/CU\n", per_cu);
        grid_blocks = cus;
    }
    (void)hipMemsetAsync((char*)d_ws + WOF_ctl, 0, 16384, stream);
    void* args[] = {&a};
    hipError_t e = hipLaunchCooperativeKernel((const void*)mega, dim3(grid_blocks), dim3(NTHR), args, LDS_BYTES, stream);
    if (e != hipSuccess) fprintf(stderr, "cooperative launch failed: %s (grid %d)\n", hipGetErrorString(e), grid_blocks);
}
```

```cpp
#include <hip/hip_runtime.h>
#include <stdint.h>
#include <cstdio>
#include <hip/hip_cooperative_groups.h>
namespace cg = cooperative_groups;


__device__ __forceinline__ int otid();
#define PG8_TID() otid()
namespace pg8 {
#define PG8_LAS __attribute__((address_space(3)))
typedef unsigned short bf16_t;
typedef short bf16x8 __attribute__((ext_vector_type(8)));
typedef float f32x4 __attribute__((ext_vector_type(4)));
typedef unsigned u32x4 __attribute__((ext_vector_type(4)));
constexpr int BM = 256, BK = 64, HALF = 128, HTB = HALF * BK * 2  , STAGE_BYTES = 8 * HTB, NXCD = 8, WGM = 8;

__host__ __device__ __forceinline__ int lds_byte(int r, int c) { const int st = (r >> 4) * 2 + (c >> 5), rr = r & 15, cc = c & 31, ob = rr * 64 + cc * 2; return st * 1024 + (ob ^ (((ob >> 9) & 1) << 5)); }
__host__ __device__ __forceinline__ void stage_rc(int b, int& R, int& C) { const int st = b / 1024, sb = b % 1024, swz = sb ^ (((sb >> 9) & 1) << 5); R = (st >> 1) * 16 + swz / 64; C = (st & 1) * 32 + (swz % 64) / 2; }
__host__ __device__ __forceinline__ int perm32(int rho) { const int n = rho >> 4, i = rho & 15; return 8 * (i >> 2) + 4 * n + (i & 3); }

struct Unit { int pm, pn; };
struct Gemm { const bf16_t* A; const bf16_t* Bt; int M, N, K; };

struct StaticOrder {
    int nM, nN, nwg, G, c;
    __host__ __device__ void init(int M, int N, int G_, int c_) { nM = M / BM; nN = N / BM; nwg = nM * nN; G = G_; c = c_; }
    __host__ __device__ bool next(int i, Unit& u) const {
        const long L = (long)i * G + c; if (L >= nwg) return false;
        int wgid = (int)L; { const int q = nwg / NXCD, r = nwg % NXCD, xcd = wgid % NXCD, off = wgid / NXCD; wgid = (xcd < r ? xcd * (q + 1) : r * (q + 1) + (xcd - r) * q) + off; }
        const int nig = WGM * nN, gid = wgid / nig, fm = gid * WGM, gsz = (nM - fm) < WGM ? (nM - fm) : WGM;
        u.pm = fm + ((wgid % nig) % gsz); u.pn = (wgid % nig) / gsz; return true;
    }
    __device__ __forceinline__ void a_ready(const Unit&) const {}
    __device__ __forceinline__ void done(const Unit&) const {}
};

template <class Epi, class Sched, bool ALIGN_EPI = false, bool SP2 = false>
__device__ __forceinline__ void gemm_phase(PG8_LAS unsigned char* lds, const Gemm g, const Sched& S, const Epi& E) {
    const int tid = PG8_TID(), wid = __builtin_amdgcn_readfirstlane(tid >> 6), lane = tid & 63, wr = wid >> 2, wc = wid & 3, fr = lane & 15, fq = lane >> 4;
    const int K = g.K, nt = K / BK;
    unsigned voffA[2], voffB[2];
#pragma unroll
    for (int i = 0; i < 2; ++i) { int R, C; stage_rc(tid * 16 + i * 8192, R, C); const int Rb = Epi::PERM ? ((R & ~31) + perm32(R & 31)) : R;
        voffA[i] = (unsigned)(R * K + C) * 2u; voffB[i] = (unsigned)(Rb * K + C) * 2u; }
    const size_t kstep = (size_t)(BK * 2);
    const size_t hstep = (size_t)HALF * K * 2;
    const size_t tstep = 2 * hstep;
    const unsigned ldsw = (unsigned)wid * 1024u;
    const int aoff = lds_byte(wr * 64 + fr, fq * 8), boff = lds_byte(wc * 32 + fr, fq * 8);
#define PG8_SA(b, h) (((b) * 2 + (h)) * HTB)
#define PG8_SB(b, h) ((4 + (b) * 2 + (h)) * HTB)
#define PG8_STAGE(bufoff, gbase, voff) do { _Pragma("unroll") for (int _i = 0; _i < 2; ++_i) \
        __builtin_amdgcn_global_load_lds((const unsigned*)((const char*)(gbase) + (voff)[_i]), (PG8_LAS unsigned*)(lds + (bufoff) + ldsw + _i * 8192), 16, 0, 0); } while (0)
#define PG8_LDA(dst, b, h) do { _Pragma("unroll") for (int m = 0; m < 4; ++m) _Pragma("unroll") for (int k = 0; k < 2; ++k) dst[m][k] = *(const PG8_LAS bf16x8*)(lds + PG8_SA(b, h) + aoff + m * 2048 + k * 1024); } while (0)
#define PG8_LDB(dst, b, h) do { _Pragma("unroll") for (int n = 0; n < 2; ++n) _Pragma("unroll") for (int k = 0; k < 2; ++k) dst[n][k] = *(const PG8_LAS bf16x8*)(lds + PG8_SB(b, h) + boff + n * 2048 + k * 1024); } while (0)
#define PG8_MMA(ai, bj, At, Bt) do { __builtin_amdgcn_s_setprio(1); _Pragma("unroll") for (int m = 0; m < 4; ++m) _Pragma("unroll") for (int n = 0; n < 2; ++n) _Pragma("unroll") for (int k = 0; k < 2; ++k) \
        acc[ai][bj][m][n] = __builtin_amdgcn_mfma_f32_16x16x32_bf16(Bt[n][k], At[m][k], acc[ai][bj][m][n], 0, 0, 0); __builtin_amdgcn_s_setprio(0); } while (0)
#define PG8_WAIT_V(n) asm volatile("s_waitcnt vmcnt(" #n ")" ::: "memory")
#define PG8_WAIT_L(n) asm volatile("s_waitcnt lgkmcnt(" #n ")" ::: "memory")
#define PG8_BAR __builtin_amdgcn_s_barrier()
#define PG8_SCHED __builtin_amdgcn_sched_barrier(0)
    Unit cur, nxt; int ui = 0;
    if (!S.next(0, cur)) return;
    f32x4 acc[2][2][4][2];
#pragma unroll
    for (int a = 0; a < 2; ++a)
#pragma unroll
        for (int b = 0; b < 2; ++b)
#pragma unroll
            for (int m = 0; m < 4; ++m)
#pragma unroll
                for (int n = 0; n < 2; ++n) acc[a][b][m][n] = (f32x4){0.f, 0.f, 0.f, 0.f};
    bf16x8 At[4][2], B0[2][2], B1[2][2];
    const char* cA = (const char*)g.A + (size_t)cur.pm * tstep; const char* cB = (const char*)g.Bt + (size_t)cur.pn * tstep;
    S.a_ready(cur);
    if constexpr (SP2) {
        PG8_STAGE(PG8_SB(0, 0), cB, voffB); PG8_STAGE(PG8_SB(0, 1), cB + hstep, voffB); PG8_STAGE(PG8_SA(0, 0), cA, voffA); PG8_STAGE(PG8_SA(0, 1), cA + hstep, voffA);
        if (wr == 1) PG8_BAR;
        PG8_WAIT_V(2); PG8_BAR;
        PG8_STAGE(PG8_SB(1, 0), cB + kstep, voffB); PG8_STAGE(PG8_SA(1, 0), cA + kstep, voffA); PG8_STAGE(PG8_SB(1, 1), cB + hstep + kstep, voffB);
        PG8_WAIT_V(6); PG8_BAR;
    } else {
        PG8_STAGE(PG8_SB(0, 0), cB, voffB); PG8_STAGE(PG8_SA(0, 0), cA, voffA); PG8_STAGE(PG8_SB(0, 1), cB + hstep, voffB); PG8_STAGE(PG8_SA(0, 1), cA + hstep, voffA);
        if (wr == 1) PG8_BAR;
        PG8_WAIT_V(4); PG8_BAR;
        PG8_STAGE(PG8_SB(1, 0), cB + kstep, voffB); PG8_STAGE(PG8_SA(1, 0), cA + kstep, voffA); PG8_STAGE(PG8_SB(1, 1), cB + hstep + kstep, voffB);
        PG8_WAIT_V(6); PG8_BAR;
    }
    for (;;) {
        const bool has_next = S.next(ui + 1, nxt);
        const char* nA = has_next ? (const char*)g.A + (size_t)nxt.pm * tstep : cA; const char* nB = has_next ? (const char*)g.Bt + (size_t)nxt.pn * tstep : cB;
        for (int t = 0; t < nt; t += 2) {
            const bool last = (t == nt - 2);
            const char* a1 = cA + (size_t)(t + 1) * kstep;
            const char* a2 = last ? nA : cA + (size_t)(t + 2) * kstep; const char* b2 = last ? nB : cB + (size_t)(t + 2) * kstep;
            const char* a3 = a2 + kstep; const char* b3 = b2 + kstep;
            if (last && has_next) S.a_ready(nxt);
            if constexpr (SP2) {
            PG8_LDB(B0, 0, 0); PG8_LDB(B1, 0, 1); PG8_SCHED; PG8_LDA(At, 0, 0); PG8_STAGE(PG8_SA(1, 1), a1 + hstep, voffA);
            PG8_WAIT_V(8); PG8_WAIT_L(0); PG8_BAR; PG8_MMA(0, 0, At, B0); PG8_MMA(0, 1, At, B1); PG8_BAR; PG8_SCHED;
            PG8_LDA(At, 0, 1); PG8_STAGE(PG8_SB(0, 0), b2, voffB); PG8_STAGE(PG8_SB(0, 1), b2 + hstep, voffB); PG8_STAGE(PG8_SA(0, 0), a2, voffA);
            PG8_WAIT_V(8); PG8_WAIT_L(0); PG8_BAR; PG8_MMA(1, 0, At, B0); PG8_MMA(1, 1, At, B1); PG8_BAR; PG8_SCHED;
            PG8_LDB(B0, 1, 0); PG8_LDB(B1, 1, 1); PG8_SCHED; PG8_LDA(At, 1, 0); PG8_STAGE(PG8_SA(0, 1), a2 + hstep, voffA);
            PG8_WAIT_V(8); PG8_WAIT_L(0); PG8_BAR; PG8_MMA(0, 0, At, B0); PG8_MMA(0, 1, At, B1); PG8_BAR; PG8_SCHED;
            PG8_LDA(At, 1, 1); PG8_STAGE(PG8_SB(1, 0), b3, voffB); PG8_STAGE(PG8_SB(1, 1), b3 + hstep, voffB); PG8_STAGE(PG8_SA(1, 0), a3, voffA);
            PG8_WAIT_V(8); PG8_WAIT_L(0); PG8_BAR; PG8_MMA(1, 0, At, B0); PG8_MMA(1, 1, At, B1); PG8_BAR; PG8_SCHED;
            } else {
            PG8_LDB(B0, 0, 0); PG8_SCHED; PG8_LDA(At, 0, 0); PG8_STAGE(PG8_SA(1, 1), a1 + hstep, voffA);
            PG8_WAIT_L(8); PG8_BAR; PG8_WAIT_L(0); PG8_MMA(0, 0, At, B0); PG8_BAR; PG8_SCHED;
            PG8_LDB(B1, 0, 1); PG8_STAGE(PG8_SB(0, 0), b2, voffB);
            PG8_BAR; PG8_WAIT_L(0); PG8_MMA(0, 1, At, B1); PG8_BAR;
            PG8_LDA(At, 0, 1); PG8_STAGE(PG8_SA(0, 0), a2, voffA);
            PG8_BAR; PG8_WAIT_L(0); PG8_MMA(1, 0, At, B0); PG8_BAR; PG8_SCHED;
            PG8_STAGE(PG8_SB(0, 1), b2 + hstep, voffB);
            PG8_WAIT_V(6); PG8_BAR; PG8_MMA(1, 1, At, B1); PG8_BAR;
            PG8_LDB(B0, 1, 0); PG8_SCHED; PG8_LDA(At, 1, 0); PG8_STAGE(PG8_SA(0, 1), a2 + hstep, voffA);
            PG8_WAIT_L(8); PG8_BAR; PG8_WAIT_L(0); PG8_MMA(0, 0, At, B0); PG8_BAR; PG8_SCHED;
            PG8_LDB(B1, 1, 1); PG8_STAGE(PG8_SB(1, 0), b3, voffB);
            PG8_BAR; PG8_WAIT_L(0); PG8_MMA(0, 1, At, B1); PG8_BAR;
            PG8_LDA(At, 1, 1); PG8_STAGE(PG8_SA(1, 0), a3, voffA);
            PG8_BAR; PG8_WAIT_L(0); PG8_MMA(1, 0, At, B0); PG8_BAR; PG8_SCHED;
            PG8_STAGE(PG8_SB(1, 1), b3 + hstep, voffB);
            PG8_WAIT_V(6); PG8_BAR; PG8_MMA(1, 1, At, B1); PG8_BAR;
            }
        }
        if constexpr (ALIGN_EPI) { if (wr == 0) PG8_BAR; }
        if constexpr (!Epi::AFTER_DRAIN) { E(acc, cur, wr, wc, fr, fq); S.done(cur); }
        if (!has_next) break;
#pragma unroll
        for (int a = 0; a < 2; ++a)
#pragma unroll
            for (int b = 0; b < 2; ++b)
#pragma unroll
                for (int m = 0; m < 4; ++m)
#pragma unroll
                    for (int n = 0; n < 2; ++n) acc[a][b][m][n] = (f32x4){0.f, 0.f, 0.f, 0.f};
        cur = nxt; cA = nA; cB = nB; ++ui;
        if constexpr (ALIGN_EPI) { if (wr == 1) PG8_BAR; }
    }
    PG8_WAIT_V(0);
    if constexpr (!ALIGN_EPI) { if (wr == 0) PG8_BAR; }
    PG8_BAR;
    if constexpr (Epi::AFTER_DRAIN) { E.fused(acc, cur, wr, wc, fr, fq, lds, wid, lane); S.done(cur); }
#undef PG8_SA
#undef PG8_SB
#undef PG8_STAGE
#undef PG8_LDA
#undef PG8_LDB
#undef PG8_MMA
#undef PG8_WAIT_V
#undef PG8_WAIT_L
#undef PG8_BAR
#undef PG8_SCHED
}
}

#define WTAB_OFF 155392
extern __shared__ __attribute__((aligned(16))) unsigned char lds_raw[];
__device__ __forceinline__ int hw_slot() { return (int)(__builtin_amdgcn_s_getreg((5 << 11) | 4) & 63u); }
__device__ __forceinline__ void otid_init() { const int t = threadIdx.x; if ((t & 63) == 0) ((__attribute__((address_space(3))) int*)(__attribute__((address_space(3))) void*)(lds_raw + WTAB_OFF))[hw_slot()] = t >> 6; }
__device__ __forceinline__ int otid() {
    const int w = __builtin_amdgcn_readfirstlane(((const __attribute__((address_space(3))) int*)(__attribute__((address_space(3))) void*)(lds_raw + WTAB_OFF))[hw_slot()]);
    int l; asm volatile("v_mbcnt_lo_u32_b32 %0, -1, 0\n\tv_mbcnt_hi_u32_b32 %0, -1, %0" : "=v"(l));
    return (w << 6) + l;
}
using pg8::bf16_t; using pg8::bf16x8; using pg8::f32x4; using pg8::u32x4;
#define LAS __attribute__((address_space(3)))

#define DMODEL 1024
#define NPT 16384
#define NST 32
#define NTOK 16416
#define MPAD 16640
#define SEQ 2048
#define ZW 2816
#define OFF_A 1536
#define OFF_B 1544
#define OFF_Z 1552
#define OFF_QA 2064
#define OFF_KVA 2448
#define OFF_KR 2704
#define DFF 2816
#define PAST 16384
#define NPAGES 128
#define EPSV 1e-6f

#define O_YP 0
#define O_YS (O_YP + 16777216)
#define O_CKVP (O_YS + 32768)
#define O_KRP (O_CKVP + 4194304)
#define O_GSP (O_KRP + 524288)
#define O_CSP (O_GSP + 262144)
#define O_CKVS (O_CSP + 36864)
#define O_KRS (O_CKVS + 8192)
#define O_GSS (O_KRS + 1024)
#define O_CSS (O_GSS + 1048576)

__device__ __forceinline__ bf16_t f2bf(float f) { unsigned u = __float_as_uint(f); return (bf16_t)((u + 0x7fffu + ((u >> 16) & 1u)) >> 16); }
__device__ __forceinline__ float bf2f(bf16_t b) { return __uint_as_float(((unsigned)b) << 16); }
template <int CTRL> __device__ __forceinline__ float dpp_mov(float x) { return __uint_as_float((unsigned)__builtin_amdgcn_update_dpp((int)__float_as_uint(x), (int)__float_as_uint(x), CTRL, 0xF, 0xF, true)); }
__device__ __forceinline__ float add_x16(float x) { auto r = __builtin_amdgcn_permlane16_swap(__float_as_uint(x), __float_as_uint(x), false, false); return __uint_as_float(r[0]) + __uint_as_float(r[1]); }
__device__ __forceinline__ float add_x32(float x) { auto r = __builtin_amdgcn_permlane32_swap(__float_as_uint(x), __float_as_uint(x), false, false); return __uint_as_float(r[0]) + __uint_as_float(r[1]); }
__device__ __forceinline__ float max_x32(float x) { auto r = __builtin_amdgcn_permlane32_swap(__float_as_uint(x), __float_as_uint(x), false, false); return fmaxf(__uint_as_float(r[0]), __uint_as_float(r[1])); }
__device__ __forceinline__ float sum8(float x) { x += dpp_mov<0xB1>(x); x += dpp_mov<0x4E>(x); x += dpp_mov<0x141>(x); return x; }
__device__ __forceinline__ float sum16(float x) { x = sum8(x); x += dpp_mov<0x140>(x); return x; }
__device__ __forceinline__ float max16(float x) { x = fmaxf(x, dpp_mov<0xB1>(x)); x = fmaxf(x, dpp_mov<0x4E>(x)); x = fmaxf(x, dpp_mov<0x141>(x)); x = fmaxf(x, dpp_mov<0x140>(x)); return x; }
__device__ __forceinline__ float wave_sum(float v) { return add_x32(add_x16(sum16(v))); }
__device__ __forceinline__ float sigmoidf_(float x) { return __builtin_amdgcn_rcpf(1.f + __builtin_amdgcn_exp2f(-1.44269504f * x)); }
__device__ __forceinline__ float siluf_(float x) { return x * __builtin_amdgcn_rcpf(1.f + __builtin_amdgcn_exp2f(-1.44269504f * x)); }


#define WSYNC() do { __builtin_amdgcn_fence(__ATOMIC_ACQ_REL, "wavefront"); __builtin_amdgcn_wave_barrier(); } while (0)
#define NTHR 512
#define NWAVE 8

typedef float f32x2_t __attribute__((ext_vector_type(2)));
typedef __bf16 bf16x2_t __attribute__((ext_vector_type(2)));
__device__ __forceinline__ unsigned cvtpk(float lo, float hi) { f32x2_t v = {lo, hi}; bf16x2_t r = __builtin_convertvector(v, bf16x2_t); return __builtin_bit_cast(unsigned, r); }
__device__ __forceinline__ void bf8_to_f32(const bf16x8& v, float* o) {
#pragma unroll
    for (int e = 0; e < 8; ++e) o[e] = __uint_as_float(((unsigned)(unsigned short)v[e]) << 16);
}
__device__ __forceinline__ bf16x8 f32_to_bf8(const float* x) {
    u32x4 w; w.x = cvtpk(x[0], x[1]); w.y = cvtpk(x[2], x[3]); w.z = cvtpk(x[4], x[5]); w.w = cvtpk(x[6], x[7]);
    return __builtin_bit_cast(bf16x8, w);
}
__device__ __forceinline__ unsigned pk2bf(float lo, float hi) { return (unsigned)f2bf(lo) | ((unsigned)f2bf(hi) << 16); }

__device__ __forceinline__ void wt_item(const float* __restrict__ W, int ldw, int col0, int nvalid, bf16_t* __restrict__ WT, int ldt, int nrow0, int k0, float* scr, int lane) {
    WSYNC();
#pragma unroll 8
    for (int i = 0; i < 32; ++i) { const int kk = 2 * i + (lane >> 5), n = lane & 31; scr[kk * 33 + n] = n < nvalid ? W[(size_t)(k0 + kk) * ldw + col0 + n] : 0.f; }
    WSYNC();
    const int c = lane & 7;
#pragma unroll
    for (int j = 0; j < 4; ++j) { const int n = (lane >> 3) + 8 * j; const float* sp = scr + (8 * c) * 33 + n;
        u32x4 o; o.x = cvtpk(sp[0], sp[33]); o.y = cvtpk(sp[2 * 33], sp[3 * 33]); o.z = cvtpk(sp[4 * 33], sp[5 * 33]); o.w = cvtpk(sp[6 * 33], sp[7 * 33]);
        *(u32x4*)(WT + (size_t)(nrow0 + n) * ldt + k0 + 8 * c) = o; }
}

__device__ __forceinline__ void rms1024_row(const float* __restrict__ src, const float* __restrict__ g, bf16_t* __restrict__ o, bool zero, int lane) {
    if (zero) { for (int j = 0; j < 4; ++j) { ushort4 z = {0, 0, 0, 0}; *(ushort4*)(o + lane * 4 + 256 * j) = z; } return; }
    float4 v[4]; float ss = 0.f;
#pragma unroll
    for (int j = 0; j < 4; ++j) { v[j] = *(const float4*)(src + lane * 4 + 256 * j); ss += v[j].x * v[j].x + v[j].y * v[j].y + v[j].z * v[j].z + v[j].w * v[j].w; }
    ss = wave_sum(ss);
    const float rs = rsqrtf(ss * (1.f / 1024.f) + EPSV);
#pragma unroll
    for (int j = 0; j < 4; ++j) {
        const float4 gg = *(const float4*)(g + lane * 4 + 256 * j);
        ushort4 w; w.x = f2bf(v[j].x * rs * gg.x); w.y = f2bf(v[j].y * rs * gg.y); w.z = f2bf(v[j].z * rs * gg.z); w.w = f2bf(v[j].w * rs * gg.w);
        *(ushort4*)(o + lane * 4 + 256 * j) = w;
    }
}

__device__ __forceinline__ void rms1024_row_b(const bf16_t* __restrict__ src, const float* __restrict__ g, bf16_t* __restrict__ o, bool zero, int lane) {
    if (zero) { for (int j = 0; j < 2; ++j) { const u32x4 z = {0u, 0u, 0u, 0u}; *(u32x4*)(o + lane * 8 + 512 * j) = z; } return; }
    float v[2][8]; float ss = 0.f;
#pragma unroll
    for (int j = 0; j < 2; ++j) { bf8_to_f32(*(const bf16x8*)(src + lane * 8 + 512 * j), v[j]);
#pragma unroll
        for (int e = 0; e < 8; ++e) ss += v[j][e] * v[j][e]; }
    ss = wave_sum(ss);
    const float rs = rsqrtf(ss * (1.f / 1024.f) + EPSV);
#pragma unroll
    for (int j = 0; j < 2; ++j) {
        const float4 g0 = *(const float4*)(g + lane * 8 + 512 * j), g1 = *(const float4*)(g + lane * 8 + 512 * j + 4);
        float t[8] = {v[j][0] * rs * g0.x, v[j][1] * rs * g0.y, v[j][2] * rs * g0.z, v[j][3] * rs * g0.w, v[j][4] * rs * g1.x, v[j][5] * rs * g1.y, v[j][6] * rs * g1.z, v[j][7] * rs * g1.w};
        *(bf16x8*)(o + lane * 8 + 512 * j) = f32_to_bf8(t);
    }
}

struct ABf16 { const bf16_t* p; int lda; __device__ __forceinline__ bf16x8 load(int m, int k) const { return *(const bf16x8*)(p + (size_t)m * lda + k); } };
template <bool SWIGLU, class Epi>
__device__ __forceinline__ void gemm_sample_rows(const bf16_t* __restrict__ A, int lda, const bf16_t* __restrict__ Bt, int K, int N, const Epi& epi, char*  , int bid, int nb, int first = -1) {
    const int tid = otid(), lane = tid & 63, wid = tid >> 6, i16 = lane & 15, q4 = lane >> 4;
    for (int u = first >= 0 ? (bid - first + nb) % nb : nb - 1 - bid; u < N / 256; u += nb) {
        const int n0 = u * 256;
        const int c0 = SWIGLU ? n0 + 16 * wid : n0 + 32 * wid, c1 = SWIGLU ? n0 + 128 + 16 * wid : n0 + 32 * wid + 16;
        const bf16_t* a0p = A + (size_t)(NPT + i16) * lda + 8 * q4; const bf16_t* a1p = a0p + (size_t)16 * lda;
        const bf16_t* b0p = Bt + (size_t)(c0 + i16) * K + 8 * q4; const bf16_t* b1p = Bt + (size_t)(c1 + i16) * K + 8 * q4;
        f32x4 acc[2][2];
#pragma unroll
        for (int i = 0; i < 2; ++i)
#pragma unroll
            for (int j = 0; j < 2; ++j) acc[i][j] = (f32x4){0.f, 0.f, 0.f, 0.f};
#pragma unroll 4
        for (int k0 = 0; k0 < K; k0 += 32) {
            const bf16x8 a0 = *(const bf16x8*)(a0p + k0), a1 = *(const bf16x8*)(a1p + k0), b0 = *(const bf16x8*)(b0p + k0), b1 = *(const bf16x8*)(b1p + k0);
            acc[0][0] = __builtin_amdgcn_mfma_f32_16x16x32_bf16(a0, b0, acc[0][0], 0, 0, 0); acc[0][1] = __builtin_amdgcn_mfma_f32_16x16x32_bf16(a0, b1, acc[0][1], 0, 0, 0);
            acc[1][0] = __builtin_amdgcn_mfma_f32_16x16x32_bf16(a1, b0, acc[1][0], 0, 0, 0); acc[1][1] = __builtin_amdgcn_mfma_f32_16x16x32_bf16(a1, b1, acc[1][1], 0, 0, 0);
        }
#pragma unroll
        for (int i = 0; i < 2; ++i)
#pragma unroll
            for (int r = 0; r < 4; ++r) {
                const int m = NPT + 16 * i + 4 * q4 + r;
                if constexpr (SWIGLU) epi(m, (n0 >> 1) + 16 * wid + i16, siluf_(acc[i][0][r]) * acc[i][1][r]);
                else { epi(m, c0 + i16, acc[i][0][r]); epi(m, c1 + i16, acc[i][1][r]); }
            }
    }
}
template <bool SWIGLU, class Epi>
__device__ __forceinline__ void gemm_sample_rows_ks(const bf16_t* __restrict__ A, int lda, const bf16_t* __restrict__ Bt, int K, int N, const Epi& epi, char* smem, int bid, int nb) {
    const int tid = otid(), lane = tid & 63, wid = tid >> 6, i16 = lane & 15, q4 = lane >> 4;
    const int nunits = N / 64, ksl = K >> 3;
    f32x4* red = (f32x4*)smem;
    for (int u = nb - 1 - bid; u < nunits; u += nb) {
        int brow[4];
#pragma unroll
        for (int j = 0; j < 4; ++j) brow[j] = SWIGLU ? ((32 * u) >> 7) * 256 + ((32 * u) & 127) + 128 * (j >> 1) + 16 * (j & 1) + i16 : 64 * u + 16 * j + i16;
        const bf16_t* a0p = A + (size_t)(NPT + i16) * lda + wid * ksl + 8 * q4; const bf16_t* a1p = a0p + (size_t)16 * lda;
        f32x4 acc[2][4];
#pragma unroll
        for (int i = 0; i < 2; ++i)
#pragma unroll
            for (int j = 0; j < 4; ++j) acc[i][j] = (f32x4){0.f, 0.f, 0.f, 0.f};
        for (int k0 = 0; k0 < ksl; k0 += 32) {
            const bf16x8 a0 = *(const bf16x8*)(a0p + k0), a1 = *(const bf16x8*)(a1p + k0);
            bf16x8 b[4];
#pragma unroll
            for (int j = 0; j < 4; ++j) b[j] = *(const bf16x8*)(Bt + (size_t)brow[j] * K + wid * ksl + 8 * q4 + k0);
#pragma unroll
            for (int j = 0; j < 4; ++j) { acc[0][j] = __builtin_amdgcn_mfma_f32_16x16x32_bf16(a0, b[j], acc[0][j], 0, 0, 0); acc[1][j] = __builtin_amdgcn_mfma_f32_16x16x32_bf16(a1, b[j], acc[1][j], 0, 0, 0); }
        }
        __syncthreads();
#pragma unroll
        for (int i = 0; i < 2; ++i)
#pragma unroll
            for (int j = 0; j < 4; ++j) red[(wid * 8 + i * 4 + j) * 64 + lane] = acc[i][j];
        __syncthreads();
        if constexpr (SWIGLU) {
            if (tid < 256) {
                const int t4 = tid >> 6, i = t4 >> 1, jg = t4 & 1, l = tid & 63;
                f32x4 g = red[(i * 4 + jg) * 64 + l], up = red[(i * 4 + jg + 2) * 64 + l];
#pragma unroll
                for (int w = 1; w < 8; ++w) { g = g + red[(w * 8 + i * 4 + jg) * 64 + l]; up = up + red[(w * 8 + i * 4 + jg + 2) * 64 + l]; }
#pragma unroll
                for (int r = 0; r < 4; ++r) epi(NPT + 16 * i + 4 * (l >> 4) + r, 32 * u + 16 * jg + (l & 15), siluf_(g[r]) * up[r]);
            }
        } else {
            const int t8 = tid >> 6, l = tid & 63, i = t8 >> 2, j = t8 & 3;
            f32x4 v = red[t8 * 64 + l];
#pragma unroll
            for (int w = 1; w < 8; ++w) v = v + red[(w * 8 + t8) * 64 + l];
#pragma unroll
            for (int r = 0; r < 4; ++r) epi(NPT + 16 * i + 4 * (l >> 4) + r, 64 * u + 16 * j + (l & 15), v[r]);
        }
    }
    __syncthreads();
}
struct EwF32 { float* C; int ldc; __device__ __forceinline__ void operator()(int m, int n, float v) const { C[(size_t)m * ldc + n] = v; } };
struct EwBf16 { bf16_t* C; int ldc; __device__ __forceinline__ void operator()(int m, int n, float v) const { C[(size_t)m * ldc + n] = f2bf(v); } };
struct EwResX { const float* xs; bf16_t* C; __device__ __forceinline__ void operator()(int m, int n, float v) const { C[(size_t)m * 1024 + n] = f2bf(xs[(size_t)(m - NPT) * 1024 + n] + v); } };
struct EwResH { const bf16_t* H; bf16_t* C; __device__ __forceinline__ void operator()(int m, int n, float v) const { C[(size_t)m * 1024 + n] = f2bf(bf2f(H[(size_t)m * 1024 + n]) + v); } };
struct EwPle { const bf16_t* H2; const bf16_t* PP; float* out;
    __device__ __forceinline__ void operator()(int m, int n, float v) const { out[O_YS + (size_t)(m - NPT) * 1024 + n] = bf2f(H2[(size_t)m * 1024 + n]) + bf2f(PP[(size_t)m * 1024 + n]) * sigmoidf_(v); } };

struct PgBf16 {
    static constexpr bool PERM = true, AFTER_DRAIN = false; bf16_t* O; int ldc;
    __device__ __forceinline__ void operator()(const f32x4 (&acc)[2][2][4][2], const pg8::Unit& u, int wr, int wc, int fr, int fq) const {
#pragma unroll
        for (int ai = 0; ai < 2; ++ai)
#pragma unroll
            for (int m = 0; m < 4; ++m) { bf16_t* rowp = O + (size_t)(u.pm * 256 + ai * 128 + wr * 64 + m * 16 + fr) * ldc + u.pn * 256 + wc * 32 + 8 * fq;
#pragma unroll
                for (int bj = 0; bj < 2; ++bj) { const f32x4 v0 = acc[ai][bj][m][0], v1 = acc[ai][bj][m][1]; u32x4 w; w.x = pk2bf(v0[0], v0[1]); w.y = pk2bf(v0[2], v0[3]); w.z = pk2bf(v1[0], v1[1]); w.w = pk2bf(v1[2], v1[3]); *(u32x4*)(rowp + bj * 128) = w; } }
    }
};
struct PgF32 {
    static constexpr bool PERM = false, AFTER_DRAIN = false; float* O; int ldc;
    __device__ __forceinline__ void operator()(const f32x4 (&acc)[2][2][4][2], const pg8::Unit& u, int wr, int wc, int fr, int fq) const {
#pragma unroll
        for (int ai = 0; ai < 2; ++ai)
#pragma unroll
            for (int m = 0; m < 4; ++m) { float* rowp = O + (size_t)(u.pm * 256 + ai * 128 + wr * 64 + m * 16 + fr) * ldc + u.pn * 256 + wc * 32 + 4 * fq;
#pragma unroll
                for (int bj = 0; bj < 2; ++bj)
#pragma unroll
                    for (int n = 0; n < 2; ++n) *(f32x4*)(rowp + bj * 128 + n * 16) = acc[ai][bj][m][n]; }
    }
};
struct PgSwiglu {
    static constexpr bool PERM = true, AFTER_DRAIN = false; bf16_t* Hd;
    __device__ __forceinline__ void operator()(const f32x4 (&acc)[2][2][4][2], const pg8::Unit& u, int wr, int wc, int fr, int fq) const {
#pragma unroll
        for (int ai = 0; ai < 2; ++ai)
#pragma unroll
            for (int m = 0; m < 4; ++m) { bf16_t* rowp = Hd + (size_t)(u.pm * 256 + ai * 128 + wr * 64 + m * 16 + fr) * DFF + u.pn * 128 + wc * 32 + 8 * fq;
                float h[8];
#pragma unroll
                for (int n = 0; n < 2; ++n)
#pragma unroll
                    for (int i = 0; i < 4; ++i) h[n * 4 + i] = siluf_(acc[ai][0][m][n][i]) * acc[ai][1][m][n][i];
                u32x4 w; w.x = pk2bf(h[0], h[1]); w.y = pk2bf(h[2], h[3]); w.z = pk2bf(h[4], h[5]); w.w = pk2bf(h[6], h[7]); *(u32x4*)rowp = w; }
    }
};
struct PgResXB {
    static constexpr bool PERM = true, AFTER_DRAIN = false; const float* R; bf16_t* O;
    __device__ __forceinline__ void operator()(const f32x4 (&acc)[2][2][4][2], const pg8::Unit& u, int wr, int wc, int fr, int fq) const {
#pragma unroll
        for (int ai = 0; ai < 2; ++ai)
#pragma unroll
            for (int m = 0; m < 4; ++m) { const size_t off = (size_t)(u.pm * 256 + ai * 128 + wr * 64 + m * 16 + fr) * 1024 + u.pn * 256 + wc * 32 + 8 * fq;
#pragma unroll
                for (int bj = 0; bj < 2; ++bj) { const f32x4 r0 = *(const f32x4*)(R + off + bj * 128), r1 = *(const f32x4*)(R + off + bj * 128 + 4), v0 = r0 + acc[ai][bj][m][0], v1 = r1 + acc[ai][bj][m][1];
                    u32x4 w; w.x = cvtpk(v0[0], v0[1]); w.y = cvtpk(v0[2], v0[3]); w.z = cvtpk(v1[0], v1[1]); w.w = cvtpk(v1[2], v1[3]); *(u32x4*)(O + off + bj * 128) = w; } }
    }
};
struct PgResBB {
    static constexpr bool PERM = true, AFTER_DRAIN = false; const bf16_t* R; bf16_t* O;
    __device__ __forceinline__ void operator()(const f32x4 (&acc)[2][2][4][2], const pg8::Unit& u, int wr, int wc, int fr, int fq) const {
#pragma unroll
        for (int ai = 0; ai < 2; ++ai)
#pragma unroll
            for (int m = 0; m < 4; ++m) { const size_t off = (size_t)(u.pm * 256 + ai * 128 + wr * 64 + m * 16 + fr) * 1024 + u.pn * 256 + wc * 32 + 8 * fq;
#pragma unroll
                for (int bj = 0; bj < 2; ++bj) { float r[8]; bf8_to_f32(*(const bf16x8*)(R + off + bj * 128), r); const f32x4 a0 = acc[ai][bj][m][0], a1 = acc[ai][bj][m][1];
                    u32x4 w; w.x = cvtpk(r[0] + a0[0], r[1] + a0[1]); w.y = cvtpk(r[2] + a0[2], r[3] + a0[3]); w.z = cvtpk(r[4] + a1[0], r[5] + a1[1]); w.w = cvtpk(r[6] + a1[2], r[7] + a1[3]); *(u32x4*)(O + off + bj * 128) = w; } }
    }
};
struct PgPleB {
    static constexpr bool PERM = true, AFTER_DRAIN = false; const bf16_t* H2; const bf16_t* PP; float* out;
    __device__ __forceinline__ void operator()(const f32x4 (&acc)[2][2][4][2], const pg8::Unit& u, int wr, int wc, int fr, int fq) const {
#pragma unroll
        for (int ai = 0; ai < 2; ++ai)
#pragma unroll
            for (int m = 0; m < 4; ++m) { const size_t off = (size_t)(u.pm * 256 + ai * 128 + wr * 64 + m * 16 + fr) * 1024 + u.pn * 256 + wc * 32 + 8 * fq;
#pragma unroll
                for (int bj = 0; bj < 2; ++bj) { float h[8], pp[8]; bf8_to_f32(*(const bf16x8*)(H2 + off + bj * 128), h); bf8_to_f32(*(const bf16x8*)(PP + off + bj * 128), pp);
                    const f32x4 a0 = acc[ai][bj][m][0], a1 = acc[ai][bj][m][1]; f32x4 y0, y1;
#pragma unroll
                    for (int i = 0; i < 4; ++i) { y0[i] = h[i] + pp[i] * sigmoidf_(a0[i]); y1[i] = h[4 + i] + pp[4 + i] * sigmoidf_(a1[i]); }
                    *(f32x4*)(out + O_YP + off + bj * 128) = y0; *(f32x4*)(out + O_YP + off + bj * 128 + 4) = y1; } }
    }
};
template <class Epi>
__device__ __forceinline__ void pg_gemm(LAS unsigned char* lds, const bf16_t* A, const bf16_t* Bt, int M, int N, int K, const Epi& E, int glow = 0) {
    pg8::Gemm g{A, Bt, M, N, K}; pg8::StaticOrder S;
    if (glow > 0) { if ((int)blockIdx.x >= glow) return; S.init(M, N, glow, (int)blockIdx.x); }
    else S.init(M, N, (int)gridDim.x, (int)blockIdx.x);
    pg8::gemm_phase<Epi, pg8::StaticOrder, true, true>(lds, g, S, E);
}

constexpr size_t WOF_WinT = 0ull;
constexpr size_t WOF_WqbT = 5767168ull;
constexpr size_t WOF_WkvT = 6356992ull;
constexpr size_t WOF_WknT = 6881280ull;
constexpr size_t WOF_WoT = 7143424ull;
constexpr size_t WOF_WguT = 9240576ull;
constexpr size_t WOF_WdT = 20774912ull;
constexpr size_t WOF_WpgT = 26542080ull;
constexpr size_t WOF_WppT = 28639232ull;
constexpr size_t WOF_xn = 29163520ull;
constexpr size_t WOF_pb = 63242240ull;
constexpr size_t WOF_Z = 71761920ull;
constexpr size_t WOF_qkv = 165478400ull;
constexpr size_t WOF_ropecs = 216596480ull;
constexpr size_t WOF_gg = 216858880ull;
constexpr size_t WOF_bb = 217391360ull;
constexpr size_t WOF_goraw = 217923840ull;
constexpr size_t WOF_gUT = 252002560ull;
constexpr size_t WOF_ggam = 285556992ull;
constexpr size_t WOF_gWn = 285565184ull;
constexpr size_t WOF_gQg = 302342400ull;
constexpr size_t WOF_gQK = 319119616ull;
constexpr size_t WOF_gKd = 335896832ull;
constexpr size_t WOF_qan = 352674048ull;
constexpr size_t WOF_ckvb = 365453568ull;
constexpr size_t WOF_krf = 373973248ull;
constexpr size_t WOF_Q = 376103168ull;
constexpr size_t WOF_qh = 427221248ull;
constexpr size_t WOF_KV = 478339328ull;
constexpr size_t WOF_kh = 546496768ull;
constexpr size_t WOF_omix = 580575488ull;
constexpr size_t WOF_KN = 614654208ull;
constexpr size_t WOF_SC = 1151525120ull;
constexpr size_t WOF_part = 1168302336ull;
constexpr size_t WOF_H = 1170432256ull;
constexpr size_t WOF_un = 1238589696ull;
constexpr size_t WOF_G = 1272668416ull;
constexpr size_t WOF_hid = 1273028864ull;
constexpr size_t WOF_H2 = 1366745344ull;
constexpr size_t WOF_un2 = 1434902784ull;
constexpr size_t WOF_PP = 1468981504ull;
constexpr size_t WOF_qraw = 1537138944ull;
constexpr size_t WOF_kvraw = 1562304768ull;
constexpr size_t WOF_krb = 1595859200ull;
constexpr size_t WOF_ctl = 1596907776ull;
constexpr size_t WS_TOTAL = 1596924160ull;
struct MK {
    const float *x_prompt, *x_sample, *cache_ckv, *cache_krope, *state_gdn, *state_conv; const int* page_table; const float *p_prompt, *p_sample;
    const float *g_attn, *w_in, *w_conv, *a_log, *dt_bias, *g_gdn_out, *g_q_a, *w_q_b, *g_q_nope, *g_q_rope, *g_kv_a, *g_k_rope, *w_kv_b, *g_k_nope, *w_o, *g_ffn, *w_gate, *w_up, *w_down, *g_ple, *w_ple_gate, *w_ple_proj;
    float* out; char* ws;
    __device__ __forceinline__ unsigned* ctl() const { return (unsigned*)(ws + WOF_ctl); }
    __device__ __forceinline__ bf16_t* WinT() const { return (bf16_t*)(ws + WOF_WinT); }
    __device__ __forceinline__ bf16_t* WqbT() const { return (bf16_t*)(ws + WOF_WqbT); }
    __device__ __forceinline__ bf16_t* WkvT() const { return (bf16_t*)(ws + WOF_WkvT); }
    __device__ __forceinline__ bf16_t* WknT() const { return (bf16_t*)(ws + WOF_WknT); }
    __device__ __forceinline__ bf16_t* WoT() const { return (bf16_t*)(ws + WOF_WoT); }
    __device__ __forceinline__ bf16_t* WguT() const { return (bf16_t*)(ws + WOF_WguT); }
    __device__ __forceinline__ bf16_t* WdT() const { return (bf16_t*)(ws + WOF_WdT); }
    __device__ __forceinline__ bf16_t* WpgT() const { return (bf16_t*)(ws + WOF_WpgT); }
    __device__ __forceinline__ bf16_t* WppT() const { return (bf16_t*)(ws + WOF_WppT); }
    __device__ __forceinline__ bf16_t* xn() const { return (bf16_t*)(ws + WOF_xn); }
    __device__ __forceinline__ bf16_t* pb() const { return (bf16_t*)(ws + WOF_pb); }
    __device__ __forceinline__ bf16_t* Z() const { return (bf16_t*)(ws + WOF_Z); }
    __device__ __forceinline__ bf16_t* qkv() const { return (bf16_t*)(ws + WOF_qkv); }
    __device__ __forceinline__ float* ropecs() const { return (float*)(ws + WOF_ropecs); }
    __device__ __forceinline__ float* gg() const { return (float*)(ws + WOF_gg); }
    __device__ __forceinline__ float* bb() const { return (float*)(ws + WOF_bb); }
    __device__ __forceinline__ float* goraw() const { return (float*)(ws + WOF_goraw); }
    __device__ __forceinline__ float* gUT() const { return (float*)(ws + WOF_gUT); }
    __device__ __forceinline__ float* ggam() const { return (float*)(ws + WOF_ggam); }
    __device__ __forceinline__ bf16_t* gWn() const { return (bf16_t*)(ws + WOF_gWn); }
    __device__ __forceinline__ bf16_t* gQg() const { return (bf16_t*)(ws + WOF_gQg); }
    __device__ __forceinline__ bf16_t* gQK() const { return (bf16_t*)(ws + WOF_gQK); }
    __device__ __forceinline__ bf16_t* gKd() const { return (bf16_t*)(ws + WOF_gKd); }
    __device__ __forceinline__ bf16_t* qan() const { return (bf16_t*)(ws + WOF_qan); }
    __device__ __forceinline__ bf16_t* ckvb() const { return (bf16_t*)(ws + WOF_ckvb); }
    __device__ __forceinline__ float* krf() const { return (float*)(ws + WOF_krf); }
    __device__ __forceinline__ float* Q() const { return (float*)(ws + WOF_Q); }
    __device__ __forceinline__ float* qh() const { return (float*)(ws + WOF_qh); }
    __device__ __forceinline__ float* KV() const { return (float*)(ws + WOF_KV); }
    __device__ __forceinline__ float* kh() const { return (float*)(ws + WOF_kh); }
    __device__ __forceinline__ bf16_t* omix() const { return (bf16_t*)(ws + WOF_omix); }
    __device__ __forceinline__ bf16_t* KN() const { return (bf16_t*)(ws + WOF_KN); }
    __device__ __forceinline__ float* SC() const { return (float*)(ws + WOF_SC); }
    __device__ __forceinline__ float* part() const { return (float*)(ws + WOF_part); }
    __device__ __forceinline__ bf16_t* H() const { return (bf16_t*)(ws + WOF_H); }
    __device__ __forceinline__ bf16_t* un() const { return (bf16_t*)(ws + WOF_un); }
    __device__ __forceinline__ float* G() const { return (float*)(ws + WOF_G); }
    __device__ __forceinline__ bf16_t* hid() const { return (bf16_t*)(ws + WOF_hid); }
    __device__ __forceinline__ bf16_t* H2() const { return (bf16_t*)(ws + WOF_H2); }
    __device__ __forceinline__ bf16_t* un2() const { return (bf16_t*)(ws + WOF_un2); }
    __device__ __forceinline__ bf16_t* PP() const { return (bf16_t*)(ws + WOF_PP); }
    __device__ __forceinline__ bf16_t* qraw() const { return (bf16_t*)(ws + WOF_qraw); }
    __device__ __forceinline__ bf16_t* kvraw() const { return (bf16_t*)(ws + WOF_kvraw); }
    __device__ __forceinline__ bf16_t* krb() const { return (bf16_t*)(ws + WOF_krb); }
};

__device__ __forceinline__ float fast_sigmoid(float x) { return __builtin_amdgcn_rcpf(1.f + __builtin_amdgcn_exp2f(-1.44269504f * x)); }
struct PinTok { bf16x8 qa, cv, kr; float ab; };
struct PinGain { float gqa[8], gkv[8], gkr[8], dtb, alog; };
__device__ __forceinline__ PinTok pin_load(const MK& a, int row, int lane) {
    const bf16_t* z = a.Z() + (size_t)row * ZW; PinTok t; const bf16x8 zz = {0, 0, 0, 0, 0, 0, 0, 0};
    t.qa = lane < 48 ? *(const bf16x8*)(z + OFF_QA + 8 * lane) : zz; t.cv = lane < 32 ? *(const bf16x8*)(z + OFF_KVA + 8 * lane) : zz;
    t.kr = (lane >= 32 && lane < 36) ? *(const bf16x8*)(z + OFF_KR + 8 * (lane - 32)) : zz; t.ab = lane < 16 ? bf2f(z[OFF_A + lane]) : 0.f; return t;
}
__device__ __forceinline__ void post_in_token(const MK& a, int row, int lane, const float* wcs, const bf16x8 (&w0)[3], const bf16x8 (&w1)[3], const bf16x8 (&w2)[3], const bf16x8 (&wcur)[3], const PinTok& tk, const PinGain& gn) {
    const bool samp = row >= NPT;
    const int b = samp ? row - NPT : row >> 11, t = samp ? 0 : row & 2047, hd = lane >> 3;
    float y[24];
#pragma unroll
    for (int c3 = 0; c3 < 3; ++c3) {
        float p0[8], p1[8], p2[8], cu[8];
        bf8_to_f32(w0[c3], p0); bf8_to_f32(w1[c3], p1); bf8_to_f32(w2[c3], p2); bf8_to_f32(wcur[c3], cu);
        const float* wp = wcs + 512 * c3 + 8 * lane;
        const float4 a0 = *(const float4*)wp, a1 = *(const float4*)(wp + 4), b0 = *(const float4*)(wp + 1536), b1 = *(const float4*)(wp + 1540);
        const float4 c0 = *(const float4*)(wp + 3072), c1 = *(const float4*)(wp + 3076), d0 = *(const float4*)(wp + 4608), d1 = *(const float4*)(wp + 4612);
        const float k0[8] = {a0.x, a0.y, a0.z, a0.w, a1.x, a1.y, a1.z, a1.w}, k1[8] = {b0.x, b0.y, b0.z, b0.w, b1.x, b1.y, b1.z, b1.w};
        const float k2[8] = {c0.x, c0.y, c0.z, c0.w, c1.x, c1.y, c1.z, c1.w}, k3[8] = {d0.x, d0.y, d0.z, d0.w, d1.x, d1.y, d1.z, d1.w};
#pragma unroll
        for (int e = 0; e < 8; ++e) { const int c = 8 * c3 + e; const float v = k0[e] * p0[e] + k1[e] * p1[e] + k2[e] * p2[e] + k3[e] * cu[e]; y[c] = v * fast_sigmoid(v); }
        __builtin_amdgcn_sched_barrier(0);
    }
    float sq = 0.f, sk = 0.f;
#pragma unroll
    for (int e = 0; e < 8; ++e) { sq += y[e] * y[e]; sk += y[8 + e] * y[8 + e]; }
    sq = sum8(sq); sk = sum8(sk);
    const float rq = rsqrtf(sq + EPSV) * 0.125f, rk = rsqrtf(sk + EPSV);
#pragma unroll
    for (int e = 0; e < 8; ++e) { y[e] *= rq; y[8 + e] *= rk; }
    bf16_t* qo = a.qkv() + (size_t)row * 1536 + 8 * lane;
    *(bf16x8*)qo = f32_to_bf8(y); *(bf16x8*)(qo + 512) = f32_to_bf8(y + 8); *(bf16x8*)(qo + 1024) = f32_to_bf8(y + 16);
    if (!samp && t >= SEQ - 3) {
        float* cso = a.out + O_CSP + ((size_t)b * 3 + (t - (SEQ - 3))) * 1536 + 8 * lane;
#pragma unroll
        for (int j = 0; j < 3; ++j) { float cu[8]; bf8_to_f32(wcur[j], cu); *(float4*)(cso + 512 * j) = (float4){cu[0], cu[1], cu[2], cu[3]}; *(float4*)(cso + 512 * j + 4) = (float4){cu[4], cu[5], cu[6], cu[7]}; }
    }
    if (lane < 16) {
        const float v = tk.ab;
        if (lane < 8) { const float xx = v + gn.dtb; const float sp = xx > 20.f ? xx : 0.69314718f * __builtin_amdgcn_logf(1.f + __builtin_amdgcn_exp2f(1.44269504f * xx)); a.gg()[(size_t)row * 8 + lane] = -gn.alog * sp; }
        else a.bb()[(size_t)row * 8 + lane - 8] = sigmoidf_(v);
    }
    __builtin_amdgcn_sched_barrier(0);
    float qa[8], cv[8], kr[8];
    bf8_to_f32(tk.qa, qa); bf8_to_f32(tk.cv, cv); bf8_to_f32(tk.kr, kr);
    float s1 = 0.f, s2 = 0.f, s3 = 0.f;
#pragma unroll
    for (int e = 0; e < 8; ++e) { s1 += qa[e] * qa[e]; s2 += cv[e] * cv[e]; s3 += kr[e] * kr[e]; }
    s1 = wave_sum(s1); s2 = wave_sum(s2); s3 = wave_sum(s3);
    const float r1 = rsqrtf(s1 * (1.f / 384.f) + EPSV), r2 = rsqrtf(s2 * (1.f / 256.f) + EPSV), r3 = rsqrtf(s3 * (1.f / 32.f) + EPSV);
    if (lane < 48) {
        float o[8];
#pragma unroll
        for (int e = 0; e < 8; ++e) o[e] = qa[e] * r1 * gn.gqa[e];
        *(bf16x8*)(a.qan() + (size_t)row * 384 + 8 * lane) = f32_to_bf8(o);
    }
    if (lane < 32) {
        float o[8];
#pragma unroll
        for (int e = 0; e < 8; ++e) o[e] = cv[e] * r2 * gn.gkv[e];
        *(bf16x8*)(a.ckvb() + (size_t)row * 256 + 8 * lane) = f32_to_bf8(o);
        float* co = samp ? a.out + O_CKVS + (size_t)b * 256 + 8 * lane : a.out + O_CKVP + (size_t)row * 256 + 8 * lane;
        *(float4*)co = (float4){o[0], o[1], o[2], o[3]}; *(float4*)(co + 4) = (float4){o[4], o[5], o[6], o[7]};
    }
    __builtin_amdgcn_sched_barrier(0);
    {
        const int c4 = (lane - 32) & 3;
        float xn[8], ot[8];
#pragma unroll
        for (int e = 0; e < 8; ++e) xn[e] = kr[e] * r3 * gn.gkr[e];
#pragma unroll
        for (int e = 0; e < 8; ++e) ot[e] = dpp_mov<0x4E>(xn[e]);
        if (lane >= 32 && lane < 36) {
            const float* tb = a.ropecs() + (size_t)(samp ? 2048 : t) * 32 + ((8 * c4) & 15);
            const float4 c0 = *(const float4*)tb, c1 = *(const float4*)(tb + 4), s0 = *(const float4*)(tb + 16), s1 = *(const float4*)(tb + 20);
            const float csv[8] = {c0.x, c0.y, c0.z, c0.w, c1.x, c1.y, c1.z, c1.w}, snv[8] = {s0.x, s0.y, s0.z, s0.w, s1.x, s1.y, s1.z, s1.w};
            float o[8];
#pragma unroll
            for (int e = 0; e < 8; ++e) o[e] = c4 < 2 ? xn[e] * csv[e] - ot[e] * snv[e] : ot[e] * snv[e] + xn[e] * csv[e];
            float* kf_ = a.krf() + (size_t)row * 32 + 8 * c4; *(float4*)kf_ = (float4){o[0], o[1], o[2], o[3]}; *(float4*)(kf_ + 4) = (float4){o[4], o[5], o[6], o[7]};
            float* ko = samp ? a.out + O_KRS + (size_t)b * 32 + 8 * c4 : a.out + O_KRP + (size_t)row * 32 + 8 * c4;
            *(float4*)ko = (float4){o[0], o[1], o[2], o[3]}; *(float4*)(ko + 4) = (float4){o[4], o[5], o[6], o[7]};
            if (!samp) *(bf16x8*)(a.krb() + (size_t)row * 32 + 8 * c4) = f32_to_bf8(o);
        }
    }
    (void)hd;
}
__device__ __forceinline__ void post_in_run(const MK& a, int run, int lane_in, const float* wcs) {
    int lane = lane_in; asm volatile("" : "+v"(lane));
    PinGain gn;
    {
        const int lq = lane < 48 ? lane : 0, lk = lane < 32 ? lane : 0, c4 = (lane - 32) & 3;
#pragma unroll
        for (int e = 0; e < 8; ++e) { gn.gqa[e] = a.g_q_a[8 * lq + e]; gn.gkv[e] = a.g_kv_a[8 * lk + e]; gn.gkr[e] = a.g_k_rope[8 * c4 + e]; }
        gn.dtb = a.dt_bias[lane & 7]; gn.alog = expf(a.a_log[lane & 7]);
    }
    if (run < NPT / 8) {
        const int row0 = run * 8, t0 = row0 & 2047;
        bf16x8 w0[3], w1[3], w2[3], wcur[3];
#pragma unroll
        for (int c3 = 0; c3 < 3; ++c3) {
            const bf16x8 zz = {0, 0, 0, 0, 0, 0, 0, 0}; w0[c3] = zz; w1[c3] = zz; w2[c3] = zz;
            if (t0 > 0) { const bf16_t* zp = a.Z() + (size_t)(row0 - 3) * ZW + 512 * c3 + 8 * lane; w0[c3] = *(const bf16x8*)zp; w1[c3] = *(const bf16x8*)(zp + ZW); w2[c3] = *(const bf16x8*)(zp + 2 * ZW); }
        }
        bf16x8 wnext[3]; PinTok tk, tkn;
#pragma unroll
        for (int c3 = 0; c3 < 3; ++c3) wnext[c3] = *(const bf16x8*)(a.Z() + (size_t)row0 * ZW + 512 * c3 + 8 * lane);
        tkn = pin_load(a, row0, lane);
#pragma unroll 1
        for (int k = 0; k < 8; ++k) {
            const int row = row0 + k;
#pragma unroll
            for (int c3 = 0; c3 < 3; ++c3) wcur[c3] = wnext[c3];
            tk = tkn;
            if (k < 7) {
#pragma unroll
                for (int c3 = 0; c3 < 3; ++c3) wnext[c3] = *(const bf16x8*)(a.Z() + (size_t)(row + 1) * ZW + 512 * c3 + 8 * lane);
                tkn = pin_load(a, row + 1, lane);
            }
            post_in_token(a, row, lane, wcs, w0, w1, w2, wcur, tk, gn);
#pragma unroll
            for (int c3 = 0; c3 < 3; ++c3) { w0[c3] = w1[c3]; w1[c3] = w2[c3]; w2[c3] = wcur[c3]; }
        }
    } else {
        {
            const int bsm = run - NPT / 8, row = NPT + bsm;
            bf16x8 w0[3], w1[3], w2[3], wcur[3];
#pragma unroll
            for (int c3 = 0; c3 < 3; ++c3) {
                const float* sp = a.state_conv + (size_t)bsm * 3 * 1536 + 512 * c3 + 8 * lane;
                float* cso = a.out + O_CSS + (size_t)bsm * 3 * 1536 + 512 * c3 + 8 * lane;
                float t0_[8], t1_[8], t2_[8], tc_[8];
#pragma unroll
                for (int e = 0; e < 8; ++e) { t0_[e] = sp[e]; t1_[e] = sp[1536 + e]; t2_[e] = sp[2 * 1536 + e]; }
                wcur[c3] = *(const bf16x8*)(a.Z() + (size_t)row * ZW + 512 * c3 + 8 * lane); bf8_to_f32(wcur[c3], tc_);
#pragma unroll
                for (int e = 0; e < 8; ++e) { cso[e] = t1_[e]; cso[1536 + e] = t2_[e]; cso[2 * 1536 + e] = tc_[e]; }
                w0[c3] = f32_to_bf8(t0_); w1[c3] = f32_to_bf8(t1_); w2[c3] = f32_to_bf8(t2_);
            }
            post_in_token(a, row, lane, wcs, w0, w1, w2, wcur, pin_load(a, row, lane), gn);
        }
    }
}

__device__ __forceinline__ void post_q_item(const MK& a, int idx, int lane) {
    const int row = idx >> 3, h = idx & 7;
    const float* q = a.Q() + (size_t)row * 768 + h * 96;
    float* o = a.qh() + ((size_t)row * 8 + h) * 96;
    const float v = q[lane];
    const float ss = wave_sum(v * v);
    o[lane] = v * rsqrtf(ss * (1.f / 64.f) + EPSV) * a.g_q_nope[lane];
    const float r = lane < 32 ? q[64 + lane] : 0.f;
    const float s2 = wave_sum(r * r);
    const float xn = lane < 32 ? r * rsqrtf(s2 * (1.f / 32.f) + EPSV) * a.g_q_rope[lane] : 0.f;
    const float other = __shfl_xor(xn, 16);
    const int i = lane & 15;
    const float* tb = a.ropecs() + (size_t)(row >= NPT ? 2048 : (row & 2047)) * 32;
    const float cs = tb[i], sn = tb[16 + i];
    const float ov = lane < 16 ? xn * cs - other * sn : other * sn + xn * cs;
    if (lane < 32) o[64 + lane] = ov;
}
__device__ __forceinline__ void post_kv_item(const MK& a, int idx, int lane) {
    const int row = idx >> 3, h = idx & 7;
    const float v = a.KV()[(size_t)row * 1024 + h * 128 + lane];
    const float ss = wave_sum(v * v);
    const float kn = v * rsqrtf(ss * (1.f / 64.f) + EPSV) * a.g_k_nope[lane];
    a.kh()[((size_t)row * 8 + h) * 64 + lane] = kn;
}

typedef float f32x16 __attribute__((ext_vector_type(16)));
typedef short s16x4 __attribute__((ext_vector_type(4)));
#define KST 104
#define VST 72
#define ATT_BUF (64 * KST * 2 + 64 * VST * 2)
__device__ __forceinline__ int crow32(int r, int hi) { return (r & 3) + 8 * (r >> 2) + 4 * hi; }
__device__ __forceinline__ s16x4 tr_read(const bf16_t* p) { return __builtin_bit_cast(s16x4, __builtin_amdgcn_ds_read_tr16_b64_v4i16((LAS s16x4*)(LAS void*)(unsigned)(size_t)p)); }
__device__ __forceinline__ bf16x8 pack8(const f32x16& x, int s) {
    u32x4 w; w.x = cvtpk(x[8 * s], x[8 * s + 1]); w.y = cvtpk(x[8 * s + 2], x[8 * s + 3]); w.z = cvtpk(x[8 * s + 4], x[8 * s + 5]); w.w = cvtpk(x[8 * s + 6], x[8 * s + 7]);
    return __builtin_bit_cast(bf16x8, w);
}
__device__ __forceinline__ void attn_block(const MK& a, int b, int h, int qb, char* smem) {
    const int tid = otid(), lane = tid & 63, wid = tid >> 6, r32 = lane & 31, hi = lane >> 5;
    const int qrow = qb * 256 + wid * 32 + r32;
    const int wq0 = qb * 256 + wid * 32;
    bf16x8 qf[6];
    {
        const float SCL = 0.14724445f;
        const bf16_t* Qg = a.qraw() + ((size_t)b * SEQ + qrow) * 768 + h * 96 + 8 * hi;
        float qv[6][8];
#pragma unroll
        for (int ds = 0; ds < 6; ++ds) bf8_to_f32(*(const bf16x8*)(Qg + 16 * ds), qv[ds]);
        float sn_ = 0.f, sr_ = 0.f;
#pragma unroll
        for (int j = 0; j < 8; ++j) { sn_ += qv[0][j] * qv[0][j] + qv[1][j] * qv[1][j] + qv[2][j] * qv[2][j] + qv[3][j] * qv[3][j]; sr_ += qv[4][j] * qv[4][j] + qv[5][j] * qv[5][j]; }
        sn_ = add_x32(sn_); sr_ = add_x32(sr_);
        const float rsn = rsqrtf(sn_ * (1.f / 64.f) + EPSV) * SCL, rsr = rsqrtf(sr_ * (1.f / 32.f) + EPSV);
#pragma unroll
        for (int ds = 0; ds < 4; ++ds) {
            float o[8];
#pragma unroll
            for (int j = 0; j < 8; ++j) o[j] = qv[ds][j] * rsn * a.g_q_nope[16 * ds + 8 * hi + j];
            qf[ds] = f32_to_bf8(o);
        }
        const float* tb = a.ropecs() + (size_t)qrow * 32 + 8 * hi;
        float o4[8], o5[8];
#pragma unroll
        for (int j = 0; j < 8; ++j) {
            const float x1 = qv[4][j] * rsr * a.g_q_rope[8 * hi + j], x2 = qv[5][j] * rsr * a.g_q_rope[16 + 8 * hi + j], cs = tb[j], sn = tb[16 + j];
            o4[j] = (x1 * cs - x2 * sn) * SCL; o5[j] = (x1 * sn + x2 * cs) * SCL;
        }
        qf[4] = f32_to_bf8(o4); qf[5] = f32_to_bf8(o5);
    }
    f32x16 o0, o1;
#pragma unroll
    for (int r = 0; r < 16; ++r) { o0[r] = 0.f; o1[r] = 0.f; }
    float m = 0.f, l = 0.f;
    f32x16 negm;
#pragma unroll
    for (int r = 0; r < 16; ++r) negm[r] = 0.f;
    const int nt = qb * 4 + 4;
    const int vr = tid >> 3, vc = tid & 7, rr_ = (tid >> 2) & 63, rc = tid & 3;
    const bf16_t* KVg = a.kvraw() + (size_t)b * SEQ * 1024 + h * 128 + (size_t)vr * 1024 + vc * 8;
    const bf16_t* KRg = a.krb() + (size_t)b * SEQ * 32 + (size_t)rr_ * 32 + rc * 8;
    float gk[8];
#pragma unroll
    for (int j = 0; j < 8; ++j) gk[j] = a.g_k_nope[8 * vc + j];
    bf16x8 kr0, kr1, vr0;
#define ATT_LOAD(tt) do { kr0 = *(const bf16x8*)(KVg + (size_t)(tt) * 64 * 1024); vr0 = *(const bf16x8*)(KVg + (size_t)(tt) * 64 * 1024 + 64); if (tid < 256) kr1 = *(const bf16x8*)(KRg + (size_t)(tt) * 64 * 32); } while (0)
#define ATT_STORE(buf) do { bf16_t* Ks_ = (bf16_t*)(smem + (buf) * ATT_BUF); bf16_t* Vs_ = Ks_ + 64 * KST; \
        float x_[8]; bf8_to_f32(kr0, x_); float ss_ = 0.f; _Pragma("unroll") for (int j = 0; j < 8; ++j) ss_ += x_[j] * x_[j]; \
        ss_ = sum8(ss_); const float rs_ = rsqrtf(ss_ * (1.f / 64.f) + EPSV); \
        _Pragma("unroll") for (int j = 0; j < 8; ++j) x_[j] *= rs_ * gk[j]; \
        *(bf16x8*)(Ks_ + vr * KST + vc * 8) = f32_to_bf8(x_); *(bf16x8*)(Vs_ + vr * VST + vc * 8) = vr0; \
        if (tid < 256) *(bf16x8*)(Ks_ + rr_ * KST + 64 + rc * 8) = kr1; } while (0)
    ATT_LOAD(0);
    __syncthreads();
    ATT_STORE(0);
    __syncthreads();
    const int i16 = lane & 15, qq = i16 >> 2, pp = i16 & 3, g1 = (lane >> 4) & 1;
    for (int t = 0; t < nt; ++t) {
        const bf16_t* Ks = (const bf16_t*)(smem + (t & 1) * ATT_BUF); const bf16_t* Vs = Ks + 64 * KST;
        if (t + 1 < nt) ATT_LOAD(t + 1);
        if (64 * t <= wq0 + 31) {
            f32x16 p0, p1;
#pragma unroll
            for (int ds = 0; ds < 6; ++ds) {
                const bf16x8 k0 = *(const bf16x8*)(Ks + r32 * KST + 16 * ds + 8 * hi);
                const bf16x8 k1 = *(const bf16x8*)(Ks + (32 + r32) * KST + 16 * ds + 8 * hi);
                if (ds == 0) { p0 = __builtin_amdgcn_mfma_f32_32x32x16_bf16(k0, qf[ds], negm, 0, 0, 0); p1 = __builtin_amdgcn_mfma_f32_32x32x16_bf16(k1, qf[ds], negm, 0, 0, 0); }
                else { p0 = __builtin_amdgcn_mfma_f32_32x32x16_bf16(k0, qf[ds], p0, 0, 0, 0); p1 = __builtin_amdgcn_mfma_f32_32x32x16_bf16(k1, qf[ds], p1, 0, 0, 0); }
            }
            if (64 * t + 63 > wq0) {
#pragma unroll
                for (int r = 0; r < 16; ++r) { const int kv = 64 * t + crow32(r, hi); if (kv > qrow) p0[r] = -INFINITY; if (kv + 32 > qrow) p1[r] = -INFINITY; }
            }
            float mx = fmaxf(p0[0], p1[0]);
#pragma unroll
            for (int r = 1; r < 16; ++r) mx = fmaxf(mx, fmaxf(p0[r], p1[r]));
            mx = max_x32(mx);
            const float delta = t == 0 ? mx : fmaxf(mx, 0.f);
            if (__any(delta != 0.f)) {
                m += delta;
                const float f = t == 0 ? 1.f : __builtin_amdgcn_exp2f(-delta);
#pragma unroll
                for (int r = 0; r < 16; ++r) { p0[r] -= delta; p1[r] -= delta; negm[r] = -m; o0[r] *= f; o1[r] *= f; }
                l *= f;
            }
            float rs = 0.f;
#pragma unroll
            for (int r = 0; r < 16; ++r) { p0[r] = __builtin_amdgcn_exp2f(p0[r]); p1[r] = __builtin_amdgcn_exp2f(p1[r]); rs += p0[r] + p1[r]; }
            l += rs;
            bf16x8 pf[4];
            pf[0] = pack8(p0, 0); pf[1] = pack8(p0, 1); pf[2] = pack8(p1, 0); pf[3] = pack8(p1, 1);
#pragma unroll
            for (int ks = 0; ks < 4; ++ks) {
                const bf16_t* vb0 = Vs + (16 * ks + 4 * hi + qq) * VST + 16 * g1 + 4 * pp;
                const s16x4 a0 = tr_read(vb0), a1 = tr_read(vb0 + 8 * VST);
                const s16x4 c0 = tr_read(vb0 + 32), c1 = tr_read(vb0 + 8 * VST + 32);
                const bf16x8 va = __builtin_shufflevector(a0, a1, 0, 1, 2, 3, 4, 5, 6, 7);
                const bf16x8 vc_ = __builtin_shufflevector(c0, c1, 0, 1, 2, 3, 4, 5, 6, 7);
                o0 = __builtin_amdgcn_mfma_f32_32x32x16_bf16(va, pf[ks], o0, 0, 0, 0);
                o1 = __builtin_amdgcn_mfma_f32_32x32x16_bf16(vc_, pf[ks], o1, 0, 0, 0);
            }
        }
        if (t + 1 < nt) ATT_STORE((t + 1) & 1);
        __syncthreads();
    }
    l = add_x32(l);
    const float il = 1.f / l;
    bf16_t* op = a.omix() + ((size_t)b * SEQ + qrow) * 1024 + 512 + h * 64;
#pragma unroll
    for (int g = 0; g < 4; ++g) {
        uint2 w0, w1;
        w0.x = pk2bf(o0[4 * g] * il, o0[4 * g + 1] * il); w0.y = pk2bf(o0[4 * g + 2] * il, o0[4 * g + 3] * il);
        w1.x = pk2bf(o1[4 * g] * il, o1[4 * g + 1] * il); w1.y = pk2bf(o1[4 * g + 2] * il, o1[4 * g + 3] * il);
        *(uint2*)(op + 8 * g + 4 * hi) = w0;
        *(uint2*)(op + 32 + 8 * g + 4 * hi) = w1;
    }
#undef ATT_LOAD
#undef ATT_STORE
}

__device__ __forceinline__ void gdn_unit(const MK& a, int b, int h, int dvg, const float* s0, float* sout, int row0, int T, int lane, char* wsm) {
    float (*sq)[64] = (float (*)[64])wsm;
    float (*sk)[64] = (float (*)[64])(wsm + 4096);
    float (*sv)[8] = (float (*)[8])(wsm + 8192);
    float* sg = (float*)(wsm + 8704);
    float* sb = (float*)(wsm + 8768);
    const int e = lane & 7, ko = lane >> 3, col = dvg * 8 + e;
    float S[8];
#pragma unroll
    for (int d = 0; d < 8; ++d) S[d] = s0 ? s0[(((size_t)b * 8 + h) * 64 + ko * 8 + d) * 64 + col] : 0.f;
    const size_t rbase = (size_t)row0 + (size_t)b * T;
    float pq[16], pk[16], pv0, pv1, pgb;
    {
        const int nt = T < 16 ? T : 16;
#pragma unroll
        for (int j = 0; j < 16; ++j) { const bool ok = j < nt; const size_t r = rbase + (ok ? j : 0); pq[j] = ok ? bf2f(a.qkv()[r * 1536 + h * 64 + lane]) : 0.f; pk[j] = ok ? bf2f(a.qkv()[r * 1536 + 512 + h * 64 + lane]) : 0.f; }
        { const int j0 = lane >> 3, j1 = j0 + 8; pv0 = j0 < nt ? bf2f(a.qkv()[(rbase + j0) * 1536 + 1024 + h * 64 + dvg * 8 + (lane & 7)]) : 0.f; pv1 = j1 < nt ? bf2f(a.qkv()[(rbase + j1) * 1536 + 1024 + h * 64 + dvg * 8 + (lane & 7)]) : 0.f; }
        { const int j = lane & 15; pgb = j < nt ? (lane < 16 ? a.gg()[(rbase + j) * 8 + h] : a.bb()[(rbase + j) * 8 + h]) : 0.f; }
    }
    for (int t0 = 0; t0 < T; t0 += 16) {
        const int nt = (T - t0) < 16 ? (T - t0) : 16;
        WSYNC();
#pragma unroll
        for (int j = 0; j < 16; ++j) { sq[j][lane] = pq[j]; sk[j][lane] = pk[j]; }
        sv[lane >> 3][lane & 7] = pv0; sv[(lane >> 3) + 8][lane & 7] = pv1;
        if (lane < 16) sg[lane] = expf(pgb); else if (lane < 32) sb[lane - 16] = pgb;
        WSYNC();
        if (t0 + 16 < T) {
            const size_t rb = rbase + t0 + 16;
#pragma unroll
            for (int j = 0; j < 16; ++j) { pq[j] = bf2f(a.qkv()[(rb + j) * 1536 + h * 64 + lane]); pk[j] = bf2f(a.qkv()[(rb + j) * 1536 + 512 + h * 64 + lane]); }
            pv0 = bf2f(a.qkv()[(rb + (lane >> 3)) * 1536 + 1024 + h * 64 + dvg * 8 + (lane & 7)]); pv1 = bf2f(a.qkv()[(rb + (lane >> 3) + 8) * 1536 + 1024 + h * 64 + dvg * 8 + (lane & 7)]);
            pgb = lane < 16 ? a.gg()[(rb + (lane & 15)) * 8 + h] : a.bb()[(rb + (lane & 15)) * 8 + h];
        }
        for (int j = 0; j < nt; ++j) {
            const float dec = sg[j], be = sb[j], v = sv[j][e];
            const float4 k0 = *(const float4*)&sk[j][ko * 8], k1 = *(const float4*)&sk[j][ko * 8 + 4];
            const float4 q0 = *(const float4*)&sq[j][ko * 8], q1 = *(const float4*)&sq[j][ko * 8 + 4];
            const float kk[8] = {k0.x, k0.y, k0.z, k0.w, k1.x, k1.y, k1.z, k1.w};
            const float qq[8] = {q0.x, q0.y, q0.z, q0.w, q1.x, q1.y, q1.z, q1.w};
            float ks = 0.f;
#pragma unroll
            for (int d = 0; d < 8; ++d) { S[d] *= dec; ks += kk[d] * S[d]; }
            ks += __shfl_xor(ks, 8); ks += __shfl_xor(ks, 16); ks += __shfl_xor(ks, 32);
            const float delta = (v - ks) * be;
            float ov = 0.f;
#pragma unroll
            for (int d = 0; d < 8; ++d) { S[d] += kk[d] * delta; ov += qq[d] * S[d]; }
            ov += __shfl_xor(ov, 8); ov += __shfl_xor(ov, 16); ov += __shfl_xor(ov, 32);
            if (ko == 0) a.goraw()[(rbase + t0 + j) * 512 + h * 64 + col] = ov;
        }
    }
#pragma unroll
    for (int d = 0; d < 8; ++d) sout[(((size_t)b * 8 + h) * 64 + ko * 8 + d) * 64 + col] = S[d];
}
__device__ __forceinline__ int pi_pos(int k) { return (k & 32) + 8 * ((k >> 2) & 3) + 4 * ((k >> 4) & 1) + (k & 3); }
#define GDN_WLDS 17408
__device__ __forceinline__ void gdn_prep_unit(const MK& a, int u, int lane_in, char* wsm) {
    int lane = lane_in; asm volatile("" : "+v"(lane));
    const int bh = u >> 5, n = u & 31, b = bh >> 3, h = bh & 7, i16 = lane & 15, q4 = lane >> 4;
    const size_t row0 = (size_t)b * SEQ + n * 64;
    float* AT = (float*)wsm; float* GC = (float*)(wsm + 16384); float* BT = GC + 64;
    const bf16_t* qbase = a.qkv() + row0 * 1536 + h * 64; const bf16_t* kbase = qbase + 512; const bf16_t* vbase = qbase + 1024;
    float g = a.gg()[(row0 + lane) * 8 + h];
    const float be_l = a.bb()[(row0 + lane) * 8 + h];
#pragma unroll
    for (int o = 1; o < 64; o <<= 1) { const float t = __shfl_up(g, o); if (lane >= o) g += t; }
    WSYNC();
    GC[lane] = g; BT[lane] = be_l;
    WSYNC();
    const float gl = GC[63];
    float* EG = BT + 64; float* ED = EG + 64;
    EG[lane] = expf(g); ED[lane] = expf(gl - g);
    WSYNC();
    bf16x8 kf[4][2], qf[4][2];
#pragma unroll
    for (int mt = 0; mt < 4; ++mt)
#pragma unroll
        for (int ks = 0; ks < 2; ++ks) {
            const int off = (16 * mt + i16) * 1536 + 32 * ks + 8 * q4;
            kf[mt][ks] = *(const bf16x8*)(kbase + off); qf[mt][ks] = *(const bf16x8*)(qbase + off);
        }
    bf16_t* QKg = a.gQK() + (size_t)u * 4096;
#pragma unroll
    for (int mt = 0; mt < 4; ++mt)
#pragma unroll
        for (int nt = 0; nt < 4; ++nt) {
            const int j = 16 * nt + i16, pj = 32 * (nt >> 1) + 8 * (i16 >> 2) + 4 * (nt & 1) + (i16 & 3);
            if (nt <= mt) {
                f32x4 d1 = {0.f, 0.f, 0.f, 0.f}, d2 = {0.f, 0.f, 0.f, 0.f};
#pragma unroll
                for (int ks = 0; ks < 2; ++ks) {
                    d1 = __builtin_amdgcn_mfma_f32_16x16x32_bf16(kf[mt][ks], kf[nt][ks], d1, 0, 0, 0);
                    d2 = __builtin_amdgcn_mfma_f32_16x16x32_bf16(qf[mt][ks], kf[nt][ks], d2, 0, 0, 0);
                }
                const float gcj = GC[j];
#pragma unroll
                for (int r = 0; r < 4; ++r) {
                    const int i = 16 * mt + 4 * q4 + r;
                    const float dec = __builtin_amdgcn_exp2f(1.44269504f * (GC[i] - gcj));
                    AT[i * 64 + j] = (i > j) ? BT[i] * d1[r] * dec : 0.f;
                    QKg[i * 64 + (((pj >> 3) ^ (i & 7)) << 3) + (pj & 7)] = f2bf((i >= j) ? d2[r] * dec : 0.f);
                }
            } else {
#pragma unroll
                for (int r = 0; r < 4; ++r) { const int i = 16 * mt + 4 * q4 + r; QKg[i * 64 + (((pj >> 3) ^ (i & 7)) << 3) + (pj & 7)] = 0; }
            }
        }
    {
        bf16_t* Qgg = a.gQg() + (size_t)u * 4096;
#pragma unroll
        for (int mt = 0; mt < 4; ++mt) {
            const int i = 16 * mt + i16; const float e = EG[i];
#pragma unroll
            for (int ks = 0; ks < 2; ++ks) {
                float x[8]; bf8_to_f32(qf[mt][ks], x);
                uint2 w0, w1; w0.x = cvtpk(x[0] * e, x[1] * e); w0.y = cvtpk(x[2] * e, x[3] * e); w1.x = cvtpk(x[4] * e, x[5] * e); w1.y = cvtpk(x[6] * e, x[7] * e);
                const int p0 = 32 * ks + 16 * (q4 & 1) + 4 * (q4 >> 1);
                *(uint2*)(Qgg + i * 64 + (((p0 >> 3) ^ (i & 7)) << 3) + (p0 & 7)) = w0; *(uint2*)(Qgg + i * 64 + ((((p0 >> 3) + 1) ^ (i & 7)) << 3) + (p0 & 7)) = w1;
            }
        }
    }
    WSYNC();
    __builtin_amdgcn_sched_barrier(0);
    {
        float U[64];
#pragma unroll
        for (int i = 0; i < 64; ++i) { U[i] = bf2f(vbase[i * 1536 + lane]) * BT[i]; }
#pragma unroll
        for (int i = 1; i < 64; ++i) {
            float su = 0.f;
#pragma unroll
            for (int j4 = 0; j4 < i; j4 += 4) {
                const float4 av = *(const float4*)(AT + i * 64 + j4);
                su += av.x * U[j4];
                if (j4 + 1 < i) su += av.y * U[j4 + 1];
                if (j4 + 2 < i) su += av.z * U[j4 + 2];
                if (j4 + 3 < i) su += av.w * U[j4 + 3];
            }
            U[i] -= su;
            __builtin_amdgcn_sched_barrier(0);
        }
        float* UTg = a.gUT() + ((size_t)u * 64 + lane) * 64;
#pragma unroll
        for (int i = 0; i < 64; i += 4) *(float4*)(UTg + 4 * ((i >> 2) ^ (lane & 15))) = (float4){U[i], U[i + 1], U[i + 2], U[i + 3]};
    }
    asm volatile("" ::: "memory");
    __builtin_amdgcn_sched_barrier(0);
    {
        float W[64];
#pragma unroll
        for (int i = 0; i < 64; ++i) { W[i] = bf2f(kbase[i * 1536 + lane]); }
        bf16_t* Kdg = a.gKd() + ((size_t)u * 64 + lane) * 64;
#pragma unroll
        for (int pc = 0; pc < 8; ++pc) {
            float t[8];
#pragma unroll
            for (int jj = 0; jj < 8; ++jj) { const int j = 32 * (pc >> 2) + 16 * (jj >> 2) + 4 * (pc & 3) + (jj & 3); t[jj] = W[j] * ED[j]; }
            u32x4 w; w.x = cvtpk(t[0], t[1]); w.y = cvtpk(t[2], t[3]); w.z = cvtpk(t[4], t[5]); w.w = cvtpk(t[6], t[7]);
            *(u32x4*)(Kdg + 8 * (pc ^ (lane & 7))) = w;
        }
#pragma unroll
        for (int i = 0; i < 64; ++i) W[i] *= BT[i] * EG[i];
#pragma unroll
        for (int i = 1; i < 64; ++i) {
            float sw = 0.f;
#pragma unroll
            for (int j4 = 0; j4 < i; j4 += 4) {
                const float4 av = *(const float4*)(AT + i * 64 + j4);
                sw += av.x * W[j4];
                if (j4 + 1 < i) sw += av.y * W[j4 + 1];
                if (j4 + 2 < i) sw += av.z * W[j4 + 2];
                if (j4 + 3 < i) sw += av.w * W[j4 + 3];
            }
            W[i] -= sw;
            __builtin_amdgcn_sched_barrier(0);
        }
        bf16_t* Wng = a.gWn() + (size_t)u * 4096; const int pp = pi_pos(lane);
#pragma unroll
        for (int i = 0; i < 64; ++i) Wng[i * 64 + (((pp >> 3) ^ (i & 7)) << 3) + (pp & 7)] = f2bf(-W[i]);
    }
    if (lane == 0) a.ggam()[u] = expf(gl);
}
__device__ __forceinline__ bf16x8 pack_acc2(const f32x4& x, const f32x4& y) {
    u32x4 w; w.x = cvtpk(x[0], x[1]); w.y = cvtpk(x[2], x[3]); w.z = cvtpk(y[0], y[1]); w.w = cvtpk(y[2], y[3]);
    return __builtin_bit_cast(bf16x8, w);
}
#define G2_SLOT 49152
__device__ __forceinline__ void g2_issue(const MK& a, size_t u, int n, LAS unsigned char* lds, int lw, int lane) {
    LAS unsigned char* dst = lds + (n % 3) * G2_SLOT;
    const char* srcs[4] = {(const char*)(a.gWn() + u * 4096), (const char*)(a.gQg() + u * 4096), (const char*)(a.gQK() + u * 4096), (const char*)(a.gKd() + u * 4096)};
#pragma unroll
    for (int m = 0; m < 4; ++m)
#pragma unroll
        for (int i = 0; i < 2; ++i) { const int piece = 2 * lw + i;
            __builtin_amdgcn_global_load_lds((const unsigned*)(srcs[m] + piece * 1024 + lane * 16), (LAS unsigned*)(dst + m * 8192 + piece * 1024), 16, 0, 0); }
    const char* us = (const char*)(a.gUT() + u * 4096);
#pragma unroll
    for (int i = 0; i < 4; ++i) { const int piece = 4 * lw + i;
        __builtin_amdgcn_global_load_lds((const unsigned*)(us + piece * 1024 + lane * 16), (LAS unsigned*)(dst + 32768 + piece * 1024), 16, 0, 0); }
}
__device__ __forceinline__ void gdn_scan_block(const MK& a, int bh, LAS unsigned char* lds) {
    const int tid = otid(), lane = tid & 63, wid = __builtin_amdgcn_readfirstlane(tid >> 6), i16 = lane & 15, q4 = lane >> 4;
    const int b = bh >> 3, h = bh & 7, sl = wid & 3;
    const bool loader = wid >= 4;
    f32x4 S[4];
#pragma unroll
    for (int mt = 0; mt < 4; ++mt) S[mt] = (f32x4){0.f, 0.f, 0.f, 0.f};
    __syncthreads();
    if (loader) { g2_issue(a, (size_t)bh * 32, 0, lds, wid - 4, lane); g2_issue(a, (size_t)bh * 32 + 1, 1, lds, wid - 4, lane); }
    for (int n = 0; n < 32; ++n) {
        if (loader) { if (n < 31) asm volatile("s_waitcnt vmcnt(12)" ::: "memory"); else asm volatile("s_waitcnt vmcnt(0)" ::: "memory"); }
        asm volatile("s_waitcnt lgkmcnt(0)" ::: "memory"); __builtin_amdgcn_s_barrier(); asm volatile("" ::: "memory");
        if (loader) { if (n + 2 < 32) g2_issue(a, (size_t)bh * 32 + n + 2, n + 2, lds, wid - 4, lane); }
        else {
            const LAS unsigned char* sb = lds + (n % 3) * G2_SLOT;
            const float gam = a.ggam()[(size_t)bh * 32 + n];
            bf16x8 Sb[2]; Sb[0] = pack_acc2(S[0], S[1]); Sb[1] = pack_acc2(S[2], S[3]);
            f32x4 Vn[4];
#pragma unroll
            for (int mt = 0; mt < 4; ++mt) Vn[mt] = *(const LAS f32x4*)(sb + 32768 + (16 * sl + i16) * 256 + 16 * ((4 * mt + q4) ^ i16));
#pragma unroll
            for (int mt = 0; mt < 4; ++mt)
#pragma unroll
                for (int ks = 0; ks < 2; ++ks) Vn[mt] = __builtin_amdgcn_mfma_f32_16x16x32_bf16(*(const LAS bf16x8*)(sb + (16 * mt + i16) * 128 + 16 * ((4 * ks + q4) ^ (i16 & 7))), Sb[ks], Vn[mt], 0, 0, 0);
            bf16x8 Vb[2]; Vb[0] = pack_acc2(Vn[0], Vn[1]); Vb[1] = pack_acc2(Vn[2], Vn[3]);
            f32x4 O[4];
#pragma unroll
            for (int mt = 0; mt < 4; ++mt) {
                O[mt] = (f32x4){0.f, 0.f, 0.f, 0.f};
#pragma unroll
                for (int ks = 0; ks < 2; ++ks) {
                    const int fo = (16 * mt + i16) * 128 + 16 * ((4 * ks + q4) ^ (i16 & 7));
                    O[mt] = __builtin_amdgcn_mfma_f32_16x16x32_bf16(*(const LAS bf16x8*)(sb + 8192 + fo), Sb[ks], O[mt], 0, 0, 0);
                    O[mt] = __builtin_amdgcn_mfma_f32_16x16x32_bf16(*(const LAS bf16x8*)(sb + 16384 + fo), Vb[ks], O[mt], 0, 0, 0);
                }
            }
#pragma unroll
            for (int mt = 0; mt < 4; ++mt) {
                S[mt] = S[mt] * gam;
#pragma unroll
                for (int ks = 0; ks < 2; ++ks) S[mt] = __builtin_amdgcn_mfma_f32_16x16x32_bf16(*(const LAS bf16x8*)(sb + 24576 + (16 * mt + i16) * 128 + 16 * ((4 * ks + q4) ^ (i16 & 7))), Vb[ks], S[mt], 0, 0, 0);
            }
            float* og = a.goraw() + ((size_t)b * SEQ + n * 64 + 4 * q4) * 512 + h * 64 + 16 * sl + i16;
#pragma unroll
            for (int mt = 0; mt < 4; ++mt)
#pragma unroll
                for (int r = 0; r < 4; ++r) og[(size_t)(16 * mt + r) * 512] = O[mt][r];
        }
    }
    if (!loader) {
        float* so = a.out + O_GSP + ((size_t)bh * 64 + 4 * q4) * 64 + 16 * sl + i16;
#pragma unroll
        for (int mt = 0; mt < 4; ++mt)
#pragma unroll
            for (int r = 0; r < 4; ++r) so[(size_t)(16 * mt + r) * 64] = S[mt][r];
    }
    __syncthreads();
}
__device__ __forceinline__ void gdn_out_token(const MK& a, int row, int lane) {
    const float* op = a.goraw() + (size_t)row * 512 + 8 * lane;
    const float4 x0 = *(const float4*)op, x1 = *(const float4*)(op + 4);
    float o[8] = {x0.x, x0.y, x0.z, x0.w, x1.x, x1.y, x1.z, x1.w}, zg[8];
    bf8_to_f32(*(const bf16x8*)(a.Z() + (size_t)row * ZW + OFF_Z + 8 * lane), zg);
    float ss = 0.f;
#pragma unroll
    for (int e = 0; e < 8; ++e) ss += o[e] * o[e];
    ss = sum8(ss);
    const float rs = rsqrtf(ss * (1.f / 64.f) + EPSV);
    const float4 g0 = *(const float4*)(a.g_gdn_out + 8 * (lane & 7)), g1 = *(const float4*)(a.g_gdn_out + 8 * (lane & 7) + 4);
    const float gg_[8] = {g0.x, g0.y, g0.z, g0.w, g1.x, g1.y, g1.z, g1.w};
#pragma unroll
    for (int e = 0; e < 8; ++e) o[e] = o[e] * rs * gg_[e] * zg[e] * fast_sigmoid(zg[e]);
    *(bf16x8*)(a.omix() + (size_t)row * 1024 + 8 * lane) = f32_to_bf8(o);
}

#define SSLOT 32768
#define TL_OFF (3 * SSLOT)
#define CST 264
#define KR_OFF (TL_OFF + 2 * 32 * CST * 2)
#define WQ_OFF (KR_OFF + 4 * 4096)
#define QR_OFF (WQ_OFF + 2048)
#define PG_OFF (QR_OFF + 1024)
#define PT_OFF (PG_OFF + 64)
#define AL_OFF (PT_OFF + 1024)
#define SAMP_LDS_END (AL_OFF + 64)
__device__ __forceinline__ void samp_issue(const MK& a, int g, LAS unsigned char* lds, int wid, int lane) {
    const int phys = __builtin_amdgcn_readfirstlane(((const LAS int*)(lds + PG_OFF))[g >> 2]);
    const int tok0 = (g & 3) * 32 + 4 * wid;
    const float* cs = a.cache_ckv + ((size_t)phys * 128 + tok0) * 256 + lane * 4;
#pragma unroll
    for (int i = 0; i < 4; ++i) __builtin_amdgcn_global_load_lds((const unsigned*)(cs + i * 256), (LAS unsigned*)(lds + (g % 3) * SSLOT + (4 * wid + i) * 1024), 16, 0, 0);
    if (wid < 4) __builtin_amdgcn_global_load_lds((const unsigned*)(a.cache_krope + ((size_t)phys * 128 + (g & 3) * 32 + 8 * wid) * 32 + lane * 4), (LAS unsigned*)(lds + KR_OFF + (g & 3) * 4096 + wid * 1024), 16, 0, 0);
}
__device__ __forceinline__ void samp_convert(int g, LAS unsigned char* lds, int tid) {
    const int st = tid >> 4, c16 = (tid & 15) * 16;
    const LAS float* src = (const LAS float*)(lds + (g % 3) * SSLOT) + st * 256 + c16;
    const f32x4 x0 = *(const LAS f32x4*)src, x1 = *(const LAS f32x4*)(src + 4), x2 = *(const LAS f32x4*)(src + 8), x3 = *(const LAS f32x4*)(src + 12);
    u32x4 w0, w1; w0.x = cvtpk(x0[0], x0[1]); w0.y = cvtpk(x0[2], x0[3]); w0.z = cvtpk(x1[0], x1[1]); w0.w = cvtpk(x1[2], x1[3]);
    w1.x = cvtpk(x2[0], x2[1]); w1.y = cvtpk(x2[2], x2[3]); w1.z = cvtpk(x3[0], x3[1]); w1.w = cvtpk(x3[2], x3[3]);
    LAS bf16_t* dst = (LAS bf16_t*)(lds + TL_OFF + (g & 1) * 32 * CST * 2) + st * CST + c16;
    *(LAS u32x4*)dst = w0; *(LAS u32x4*)(dst + 8) = w1;
}
#define SAMP_WAITV(n5, n4) do { if (h < 4) asm volatile("s_waitcnt vmcnt(" #n5 ")" ::: "memory"); else asm volatile("s_waitcnt vmcnt(" #n4 ")" ::: "memory"); } while (0)
#define SAMP_BAR() do { asm volatile("s_waitcnt lgkmcnt(0)" ::: "memory"); __builtin_amdgcn_s_barrier(); asm volatile("" ::: "memory"); } while (0)
__device__ __forceinline__ void samp_attn_unit(const MK& a, int u, char* smem, LAS unsigned char* lds) {
    const int tid = otid(), lane = tid & 63, h = __builtin_amdgcn_readfirstlane(tid >> 6), i16 = lane & 15, q4 = lane >> 4;
    const int b = u >> 3, sp = u & 7;
    float* WQ = (float*)(smem + WQ_OFF);
    float* QR = (float*)(smem + QR_OFF);
    int* PG = (int*)(smem + PG_OFF);
    const float SCL = 0.14724445f;
    post_q_item(a, (NPT + b) * 8 + h, lane);
    __syncthreads();
    {
        const int h_ = tid >> 6, l_ = tid & 63, q4_ = l_ >> 4, idx = l_ & 15, d = 16 * (idx >> 2) + 4 * q4_ + (idx & 3);
        WQ[tid] = a.g_k_nope[d] * a.qh()[((size_t)(NPT + b) * 8 + h_) * 96 + d] * SCL;
        if (tid < 256) QR[tid] = a.qh()[((size_t)(NPT + b) * 8 + (tid >> 5)) * 96 + 64 + (tid & 31)] * SCL;
        if (tid < 16) PG[tid] = a.page_table[b * NPAGES + sp * 16 + tid];
    }
    bf16x8 wf[4][8];
#pragma unroll
    for (int mt = 0; mt < 4; ++mt)
#pragma unroll
        for (int ks = 0; ks < 8; ++ks) wf[mt][ks] = *(const bf16x8*)(a.WknT() + (size_t)(h * 64 + 16 * mt + i16) * 256 + 32 * ks + 8 * q4);
#pragma unroll
    for (int mt = 0; mt < 4; ++mt)
#pragma unroll
        for (int ks = 0; ks < 8; ++ks) asm volatile("" : "+v"(wf[mt][ks]));
    __syncthreads();
    samp_issue(a, 0, lds, h, lane); samp_issue(a, 1, lds, h, lane); samp_issue(a, 2, lds, h, lane);
    SAMP_WAITV(10, 8);
    SAMP_BAR();
    samp_convert(0, lds, tid);
    const LAS float* QRl = (const LAS float*)(lds + QR_OFF) + h * 32 + 8 * q4;
    const LAS float* WQl = (const LAS float*)(lds + WQ_OFF) + (h * 4 + q4) * 16;
    float m = -INFINITY, lsum = 0.f;
    f32x4 latv[2]; latv[0] = (f32x4){0.f, 0.f, 0.f, 0.f}; latv[1] = (f32x4){0.f, 0.f, 0.f, 0.f};
    for (int g = 0; g < 64; ++g) {
        SAMP_BAR();
        if (g + 3 < 64) samp_issue(a, g + 3, lds, h, lane);
        const LAS bf16_t* Tl = (const LAS bf16_t*)(lds + TL_OFF + (g & 1) * 32 * CST * 2); const LAS float* KR = (const LAS float*)(lds + KR_OFF + (g & 3) * 4096);
        float sc[2];
        {
            f32x4 acc[2][4];
#pragma unroll
            for (int hf = 0; hf < 2; ++hf)
#pragma unroll
                for (int mt = 0; mt < 4; ++mt) acc[hf][mt] = (f32x4){0.f, 0.f, 0.f, 0.f};
            const LAS bf16_t* cp0 = Tl + i16 * CST + 8 * q4; const LAS bf16_t* cp1 = cp0 + 16 * CST;
            bf16x8 c0 = *(const LAS bf16x8*)cp0, c1 = *(const LAS bf16x8*)cp1;
#pragma unroll
            for (int ks = 0; ks < 8; ++ks) {
                bf16x8 n0 = c0, n1 = c1;
                if (ks < 7) { n0 = *(const LAS bf16x8*)(cp0 + 32 * (ks + 1)); n1 = *(const LAS bf16x8*)(cp1 + 32 * (ks + 1)); }
#pragma unroll
                for (int mt = 0; mt < 4; ++mt) { acc[0][mt] = __builtin_amdgcn_mfma_f32_16x16x32_bf16(wf[mt][ks], c0, acc[0][mt], 0, 0, 0); acc[1][mt] = __builtin_amdgcn_mfma_f32_16x16x32_bf16(wf[mt][ks], c1, acc[1][mt], 0, 0, 0); }
                c0 = n0; c1 = n1;
            }
#pragma unroll
            for (int hf = 0; hf < 2; ++hf) {
                f32x2_t ss2 = {0.f, 0.f}, dot2 = {0.f, 0.f}, rd2 = {0.f, 0.f};
#pragma unroll
                for (int mt = 0; mt < 4; ++mt) {
                    const f32x4 wq = *(const LAS f32x4*)(WQl + 4 * mt);
                    const f32x4 av = acc[hf][mt];
                    const f32x2_t lo = __builtin_shufflevector(av, av, 0, 1), hi = __builtin_shufflevector(av, av, 2, 3);
                    ss2 = __builtin_elementwise_fma(lo, lo, ss2); ss2 = __builtin_elementwise_fma(hi, hi, ss2);
                    dot2 = __builtin_elementwise_fma(lo, __builtin_shufflevector(wq, wq, 0, 1), dot2); dot2 = __builtin_elementwise_fma(hi, __builtin_shufflevector(wq, wq, 2, 3), dot2);
                }
                {
                    const LAS float* kp = KR + (16 * hf + i16) * 32 + 8 * q4;
                    const f32x4 k0 = *(const LAS f32x4*)kp, k1 = *(const LAS f32x4*)(kp + 4), q0 = *(const LAS f32x4*)QRl, q1 = *(const LAS f32x4*)(QRl + 4);
                    rd2 = __builtin_elementwise_fma(__builtin_shufflevector(k0, k0, 0, 1), __builtin_shufflevector(q0, q0, 0, 1), rd2); rd2 = __builtin_elementwise_fma(__builtin_shufflevector(k0, k0, 2, 3), __builtin_shufflevector(q0, q0, 2, 3), rd2);
                    rd2 = __builtin_elementwise_fma(__builtin_shufflevector(k1, k1, 0, 1), __builtin_shufflevector(q1, q1, 0, 1), rd2); rd2 = __builtin_elementwise_fma(__builtin_shufflevector(k1, k1, 2, 3), __builtin_shufflevector(q1, q1, 2, 3), rd2);
                }
                float ss = ss2[0] + ss2[1], dot = dot2[0] + dot2[1], rd = rd2[0] + rd2[1];
                ss = add_x32(add_x16(ss)); dot = add_x32(add_x16(dot)); rd = add_x32(add_x16(rd));
                sc[hf] = dot * rsqrtf(ss * (1.f / 64.f) + EPSV) + rd;
            }
        }
        const float gm = max16(fmaxf(sc[0], sc[1]));
        const float mn = fmaxf(m, gm);
        const float alpha = __builtin_amdgcn_exp2f(m - mn), p0 = __builtin_amdgcn_exp2f(sc[0] - mn), p1 = __builtin_amdgcn_exp2f(sc[1] - mn);
        m = mn;
        lsum = lsum * alpha + p0 + p1;
        if (q4 == 0) { ((LAS float*)(lds + PT_OFF))[h * 32 + i16] = p0; ((LAS float*)(lds + PT_OFF))[h * 32 + 16 + i16] = p1; if (i16 == 0) ((LAS float*)(lds + AL_OFF))[h] = alpha; }
        if (g <= 60) SAMP_WAITV(10, 8); else if (g == 61) SAMP_WAITV(5, 4); else SAMP_WAITV(0, 0);
        SAMP_BAR();
        {
            u32x4 pw = {0u, 0u, 0u, 0u};
            if (i16 < 8) { const f32x4 pa = *(const LAS f32x4*)(lds + PT_OFF + (i16 * 32 + 8 * q4) * 4), pb_ = *(const LAS f32x4*)(lds + PT_OFF + (i16 * 32 + 8 * q4 + 4) * 4);
                pw.x = cvtpk(pa[0], pa[1]); pw.y = cvtpk(pa[2], pa[3]); pw.z = cvtpk(pb_[0], pb_[1]); pw.w = cvtpk(pb_[2], pb_[3]); }
            const bf16x8 pfr = __builtin_bit_cast(bf16x8, pw);
            const f32x4 al = *(const LAS f32x4*)(lds + AL_OFF + (q4 & 1) * 16);
            const unsigned tb0 = (unsigned)(size_t)((const LAS bf16_t*)(lds + TL_OFF + (g & 1) * 32 * CST * 2) + (8 * q4 + (i16 >> 2)) * CST + 32 * h + 4 * (i16 & 3));
            s16x4 c0[2], c1[2];
            static_assert(4 * CST * 2 == 2112, "tr offsets");
            asm volatile("ds_read_b64_tr_b16 %0, %4\n\tds_read_b64_tr_b16 %1, %4 offset:2112\n\tds_read_b64_tr_b16 %2, %4 offset:32\n\tds_read_b64_tr_b16 %3, %4 offset:2144\n\ts_waitcnt lgkmcnt(0)"
                         : "=&v"(c0[0]), "=&v"(c1[0]), "=&v"(c0[1]), "=&v"(c1[1]) : "v"(tb0) : "memory");
#pragma unroll
            for (int nt = 0; nt < 2; ++nt) {
                const bf16x8 cfr = __builtin_shufflevector(c0[nt], c1[nt], 0, 1, 2, 3, 4, 5, 6, 7);
                latv[nt] = latv[nt] * al;
                latv[nt] = __builtin_amdgcn_mfma_f32_16x16x32_bf16(pfr, cfr, latv[nt], 0, 0, 0);
            }
        }
        if (g + 1 < 64) samp_convert(g + 1, lds, tid);
    }
#pragma unroll
    for (int o = 1; o < 16; o <<= 1) lsum += __shfl_xor(lsum, o);
    if (lane == 0) { float* o = a.part() + ((size_t)u * 8 + h) * 260; o[0] = m * 0.69314718f; o[1] = lsum; }
    if (q4 < 2) {
#pragma unroll
        for (int nt = 0; nt < 2; ++nt)
#pragma unroll
            for (int r = 0; r < 4; ++r) a.part()[((size_t)u * 8 + 4 * q4 + r) * 260 + 4 + 32 * h + 16 * nt + i16] = latv[nt][r];
    }
}
__device__ __forceinline__ void samp_comb_unit(const MK& a, int u, char* smem) {
    float* slat = (float*)smem;
    const int b = u >> 3, h = u & 7, tid = otid() & 255;
    const size_t row = NPT + b;
    const float* q = a.qh() + (row * 8 + h) * 96;
    float s_self = 0.f;
    for (int d = 0; d < 64; ++d) s_self += q[d] * a.kh()[(row * 8 + h) * 64 + d];
    for (int d = 0; d < 32; ++d) s_self += q[64 + d] * a.krf()[row * 32 + d];
    s_self *= 0.10206207261596577f;
    float m = s_self;
    for (int s = 0; s < 8; ++s) m = fmaxf(m, a.part()[((size_t)(b * 8 + s) * 8 + h) * 260]);
    const float pself = expf(s_self - m);
    float l = pself, lat = 0.f;
    for (int s = 0; s < 8; ++s) {
        const float* p = a.part() + ((size_t)(b * 8 + s) * 8 + h) * 260;
        const float w = expf(p[0] - m);
        l += p[1] * w; lat += p[4 + tid] * w;
    }
    __syncthreads();
    slat[tid] = lat;
    __syncthreads();
    if (tid < 64) {
        float o = 0.f;
        for (int c = 0; c < 256; ++c) o += slat[c] * a.w_kv_b[(size_t)c * 1024 + h * 128 + 64 + tid];
        o += pself * a.KV()[row * 1024 + h * 128 + 64 + tid];
        a.omix()[row * 1024 + 512 + h * 64 + tid] = f2bf(o / l);
    }
}

#define XB_TMO      128
#define XB_XCNT(j)  (256  + 64 * (j))
#define XB_XSUB(j)  (1280 + 64 * (j))
#define XB_XGEN(j)  (2304 + 64 * (j))
#define XB_TOP      3328
#define XB_TOPGEN   3392
#define XCD_BAR_WORDS 3456
#define XB_SPIN_CAP (1u << 18)

__device__ __forceinline__ unsigned xb_ld(unsigned* p)              { return __hip_atomic_load(p, __ATOMIC_RELAXED, __HIP_MEMORY_SCOPE_AGENT); }
__device__ __forceinline__ unsigned xb_add(unsigned* p, unsigned v) { return __hip_atomic_fetch_add(p, v, __ATOMIC_RELAXED, __HIP_MEMORY_SCOPE_AGENT); }
__device__ __forceinline__ unsigned xb_xcc_id() { return (unsigned)__builtin_amdgcn_s_getreg((3 << 11) | 20) & 0xFu; }
#define XB_SPIN(cond, bar) do { unsigned _sp = 0; while (cond) { __builtin_amdgcn_s_sleep(1); \
    if ((++_sp & 255u) == 0u) { if (xb_ld(&(bar)[XB_TMO])) break; if (_sp > XB_SPIN_CAP) { atomicAdd(&(bar)[XB_TMO], 1u); break; } } } } while (0)

struct XcdBarrier {
    unsigned* bar; unsigned x;
    volatile LAS unsigned* st;
};

__device__ __forceinline__ XcdBarrier xcd_barrier_post(unsigned* bar, volatile LAS unsigned* st) {
    XcdBarrier b; b.bar = bar; b.x = xb_xcc_id(); b.st = st;
    if (threadIdx.x == 0) (void)xb_add(&bar[XB_XCNT(b.x)], 1u);
    return b;
}
__device__ __forceinline__ void xcd_barrier_complete(unsigned* bar, unsigned x, unsigned& nloc, unsigned& nx) {
    const unsigned G = gridDim.x * gridDim.y * gridDim.z;
    unsigned sum, cnt, mine, sp = 0u;
    for (;;) {
        sum = 0u; cnt = 0u; mine = 0u;
#pragma unroll
        for (unsigned j = 0; j < 16; ++j) { const unsigned c = xb_ld(&bar[XB_XCNT(j)]); sum += c; cnt += (c > 0u) ? 1u : 0u; mine = (j == x) ? c : mine; }
        if (sum == G) break;
        __builtin_amdgcn_s_sleep(1);
        if ((++sp & 255u) == 0u) { if (xb_ld(&bar[XB_TMO])) break; if (sp > XB_SPIN_CAP) { atomicAdd(&bar[XB_TMO], 1u); break; } }
    }
    nloc = mine > 0u ? mine : 1u; nx = cnt > 0u ? cnt : 1u;
}

__device__ __forceinline__ void xcd_barrier(const XcdBarrier& b) {
    asm volatile("s_waitcnt vmcnt(0)" ::: "memory");
    __syncthreads();
    if (threadIdx.x == 0) {
        unsigned* bar = b.bar;
        __builtin_amdgcn_s_waitcnt(0);
        unsigned nloc = b.st[0], nx = b.st[1];
        if (nloc == 0u) { xcd_barrier_complete(bar, b.x, nloc, nx); b.st[0] = nloc; b.st[1] = nx; }
        const unsigned old = xb_add(&bar[XB_XSUB(b.x)], 1u);
        const unsigned gen = old / nloc;
        if (old + 1u == (gen + 1u) * nloc) {
            __builtin_amdgcn_fence(__ATOMIC_RELEASE, "agent");
            asm volatile("s_waitcnt vmcnt(0)" ::: "memory");
            const unsigned og = xb_add(&bar[XB_TOP], 1u);
            const unsigned tg = og / nx;
            if (og + 1u == (tg + 1u) * nx) xb_add(&bar[XB_TOPGEN], 1u);
            else XB_SPIN(xb_ld(&bar[XB_TOPGEN]) == tg, bar);
            __builtin_amdgcn_fence(__ATOMIC_ACQUIRE, "agent");
            xb_add(&bar[XB_XGEN(b.x)], 1u);
            asm volatile("s_waitcnt vmcnt(0)" ::: "memory");
        } else {
            XB_SPIN(xb_ld(&bar[XB_XGEN(b.x)]) == gen, bar);
            __builtin_amdgcn_fence(__ATOMIC_ACQUIRE, "agent");
            asm volatile("s_waitcnt vmcnt(0)" ::: "memory");
        }
    }
    __syncthreads();
}

__device__ __forceinline__ void late_weight_items(const MK& a, int gwl, int ngwl, float* scr, int lane) {
    const int T4 = 32 * 16, T5 = 176 * 16, T7 = 32 * 44, T8 = 32 * 16, TT = T4 + T5 + T7 + T8;
    for (int it = gwl; it < TT; it += ngwl) {
        int r = it;
        if (r < T4) { const int nt_ = r % 32, kb = r / 32; wt_item(a.w_o, 1024, 32 * nt_, 32, a.WoT(), 1024, 32 * nt_, 64 * kb, scr, lane); continue; } r -= T4;
        if (r < T5) { const int nt_ = r % 176, kb = r / 176, pn = nt_ >> 3, wi = nt_ & 7;
            wt_item(wi < 4 ? a.w_gate : a.w_up, DFF, pn * 128 + (wi & 3) * 32, 32, a.WguT(), 1024, 32 * nt_, 64 * kb, scr, lane); continue; } r -= T5;
        if (r < T7) { const int nt_ = r % 32, kb = r / 32; wt_item(a.w_down, 1024, 32 * nt_, 32, a.WdT(), DFF, 32 * nt_, 64 * kb, scr, lane); continue; } r -= T7;
        { const int nt_ = r % 32, kb = r / 32; wt_item(a.w_ple_gate, 1024, 32 * nt_, 32, a.WpgT(), 1024, 32 * nt_, 64 * kb, scr, lane); }
    }
}

#define XB_ST_OFF 155648
#define LDS_BYTES 155904
static_assert(SAMP_LDS_END <= LDS_BYTES, "LDS map");
#define GSYNC() do { xcd_barrier(xbar); } while (0)
__global__ __launch_bounds__(NTHR, 2) void mega(MK a) {
    cg::grid_group grid = cg::this_grid();
    char* smem = (char*)lds_raw;
    LAS unsigned char* lds = (LAS unsigned char*)lds_raw;
    otid_init();
    if (threadIdx.x < 2) ((LAS unsigned*)(lds_raw + XB_ST_OFF))[threadIdx.x] = 0u;
    __syncthreads();
    const XcdBarrier xbar = xcd_barrier_post(a.ctl(), (volatile LAS unsigned*)(LAS void*)(lds_raw + XB_ST_OFF));
    const int bid = blockIdx.x, nb = gridDim.x, ngw = nb * NWAVE;
#define LOCAL_IDS const int tid = otid(), lane = tid & 63, wid = tid >> 6, half = tid >> 8, gw = bid * NWAVE + wid; (void)lane; (void)half; (void)gw; (void)wid;

    {
    LOCAL_IDS
    {
        const int T0 = 88 * 16, T1 = 24 * 6, T2 = 32 * 4, T3 = 16 * 4, T9 = 32 * 4;
        const int TT = T0 + T1 + T2 + T3 + T9;
        float* scr = (float*)(smem + wid * 8704);
        for (int it = gw; it < TT; it += ngw) {
            int r = it;
            if (r < T0) { const int nt_ = r % 88, kb = r / 88, nv = 2736 - 32 * nt_; wt_item(a.w_in, 2736, 32 * nt_, nv < 0 ? 0 : (nv > 32 ? 32 : nv), a.WinT(), 1024, 32 * nt_, 64 * kb, scr, lane); continue; } r -= T0;
            if (r < T1) { const int nt_ = r % 24, kb = r / 24; wt_item(a.w_q_b, 768, 32 * nt_, 32, a.WqbT(), 384, 32 * nt_, 64 * kb, scr, lane); continue; } r -= T1;
            if (r < T2) { const int nt_ = r % 32, kb = r / 32; wt_item(a.w_kv_b, 1024, 32 * nt_, 32, a.WkvT(), 256, 32 * nt_, 64 * kb, scr, lane); continue; } r -= T2;
            if (r < T3) { const int nt_ = r % 16, kb = r / 16, h = nt_ >> 1; wt_item(a.w_kv_b, 1024, h * 128 + 32 * (nt_ & 1), 32, a.WknT(), 256, 32 * nt_, 64 * kb, scr, lane); continue; } r -= T3;
            { const int nt_ = r % 32, kb = r / 32; wt_item(a.w_ple_proj, 1024, 32 * nt_, 32, a.WppT(), 256, 32 * nt_, 64 * kb, scr, lane); }
        }
        for (int e = (bid * NTHR + tid); e < 2049 * 16; e += nb * NTHR) {
            const int pos = e >> 4, i = e & 15; const float ang = (pos == 2048 ? (float)PAST : (float)pos) * powf(10000.f, -(float)i / 16.f);
            a.ropecs()[pos * 32 + i] = cosf(ang); a.ropecs()[pos * 32 + 16 + i] = sinf(ang);
        }
        for (int row = gw; row < MPAD; row += ngw) {
            const float* src = row < NPT ? a.x_prompt + (size_t)row * 1024 : a.x_sample + (size_t)(row < NTOK ? row - NPT : 0) * 1024;
            rms1024_row(src, a.g_attn, a.xn() + (size_t)row * 1024, row >= NTOK, lane);
            ushort4 w = {0, 0, 0, 0};
            if (row < NTOK) { const float* ps = row < NPT ? a.p_prompt + (size_t)row * 256 : a.p_sample + (size_t)(row - NPT) * 256; const float4 v = *(const float4*)(ps + lane * 4); w.x = f2bf(v.x); w.y = f2bf(v.y); w.z = f2bf(v.z); w.w = f2bf(v.w); }
            *(ushort4*)(a.pb() + (size_t)row * 256 + lane * 4) = w;
            if (row >= NTOK) { for (int j = 0; j < 4; ++j) { ushort4 z = {0, 0, 0, 0}; *(ushort4*)(a.omix() + (size_t)row * 1024 + lane * 4 + 256 * j) = z; } }
        }
    }
    }
    if (a.out == nullptr) grid.sync();
    GSYNC();
    {
    LOCAL_IDS
    pg_gemm(lds, a.xn(), a.WinT(), NPT, ZW, 1024, PgBf16{a.Z(), ZW});
    gemm_sample_rows_ks<false>(a.xn(), 1024, a.WinT(), 1024, ZW, EwBf16{a.Z(), ZW}, smem, bid, nb);
    }
    GSYNC();
    {
    LOCAL_IDS
    for (int e = tid; e < 4 * 1536 / 4; e += NTHR) ((float4*)smem)[e] = ((const float4*)a.w_conv)[e];
    __syncthreads();
    for (int run = gw; run < NPT / 8 + NST; run += ngw) post_in_run(a, run, lane, (const float*)smem);
    }
    GSYNC();
    {
    LOCAL_IDS
    for (int u = gw; u < 2048; u += ngw) gdn_prep_unit(a, u, lane, smem + wid * GDN_WLDS);
    }
    {
    LOCAL_IDS
    for (int v = gw; v < NST * 64; v += ngw) gdn_unit(a, v >> 6, (v >> 3) & 7, v & 7, a.state_gdn, a.out + O_GSS, NPT, 1, lane, smem + wid * GDN_WLDS);
    __syncthreads();
    }
    GSYNC();
    {
    LOCAL_IDS
    pg_gemm(lds, a.qan(), a.WqbT(), NPT, 768, 384, PgBf16{a.qraw(), 768});
    pg_gemm(lds, a.ckvb(), a.WkvT(), NPT, 1024, 256, PgBf16{a.kvraw(), 1024}, nb > 64 ? nb - 64 : 0);
    gemm_sample_rows<false>(a.qan(), 384, a.WqbT(), 384, 768, EwF32{a.Q(), 768}, smem, bid, nb, 64);
    gemm_sample_rows<false>(a.ckvb(), 256, a.WkvT(), 256, 1024, EwF32{a.KV(), 1024}, smem, bid, nb, 72);
    for (int bh_ = nb - 1 - bid; bh_ < 64; bh_ += nb) gdn_scan_block(a, bh_, lds);
    if (nb > 64 && bid < nb - 64) {
        pg_gemm(lds, a.pb(), a.WppT(), NPT, 1024, 256, PgBf16{a.PP(), 1024}, nb - 64);
        __syncthreads();
        late_weight_items(a, bid * NWAVE + wid, (nb - 64) * NWAVE, (float*)(smem + wid * 8704), lane);
    } else if (nb <= 64) { pg_gemm(lds, a.pb(), a.WppT(), NPT, 1024, 256, PgBf16{a.PP(), 1024}); __syncthreads(); late_weight_items(a, gw, ngw, (float*)(smem + wid * 8704), lane); }
    gemm_sample_rows<false>(a.pb(), 256, a.WppT(), 256, 1024, EwBf16{a.PP(), 1024}, smem, bid, nb, 80);
    }
    GSYNC();
    {
    LOCAL_IDS
    for (int idx = gw; idx < NST * 8; idx += ngw) { post_q_item(a, NPT * 8 + idx, lane); post_kv_item(a, NPT * 8 + idx, lane); }
    for (int row = gw; row < NTOK; row += ngw) gdn_out_token(a, row, lane);
    for (int pr = bid; pr < 256; pr += nb) { const int bh_ = pr >> 2, s_ = pr & 3; attn_block(a, bh_ >> 3, bh_ & 7, 7 - s_, smem); attn_block(a, bh_ >> 3, bh_ & 7, s_, smem); }
    for (int u = bid; u < NST * 8; u += nb) samp_attn_unit(a, u, smem, lds);
    }
    GSYNC();
    {
    LOCAL_IDS
    for (int u0 = bid * 2; u0 < NST * 8; u0 += nb * 2) samp_comb_unit(a, u0 + half, smem + half * 4096);
    }
    GSYNC();
    {
    LOCAL_IDS
    pg_gemm(lds, a.omix(), a.WoT(), NPT, 1024, 1024, PgResXB{a.x_prompt, a.H()});
    gemm_sample_rows_ks<false>(a.omix(), 1024, a.WoT(), 1024, 1024, EwResX{a.x_sample, a.H()}, smem, bid, nb);
    }
    GSYNC();
    {
    LOCAL_IDS
    for (int row = gw; row < MPAD; row += ngw) rms1024_row_b(a.H() + (size_t)row * 1024, a.g_ffn, a.un() + (size_t)row * 1024, row >= NTOK, lane);
    }
    GSYNC();
    {
    LOCAL_IDS
    pg_gemm(lds, a.un(), a.WguT(), NPT, 2 * DFF, 1024, PgSwiglu{a.hid()});
    gemm_sample_rows_ks<true>(a.un(), 1024, a.WguT(), 1024, 2 * DFF, EwBf16{a.hid(), DFF}, smem, bid, nb);
    }
    GSYNC();
    {
    LOCAL_IDS
    pg_gemm(lds, a.hid(), a.WdT(), NPT, 1024, DFF, PgResBB{a.H(), a.H2()});
    gemm_sample_rows_ks<false>(a.hid(), DFF, a.WdT(), DFF, 1024, EwResH{a.H(), a.H2()}, smem, bid, nb);
    }
    GSYNC();
    {
    LOCAL_IDS
    for (int row = gw; row < MPAD; row += ngw) rms1024_row_b(a.H2() + (size_t)row * 1024, a.g_ple, a.un2() + (size_t)row * 1024, row >= NTOK, lane);
    }
    GSYNC();
    {
    LOCAL_IDS
    pg_gemm(lds, a.un2(), a.WpgT(), NPT, 1024, 1024, PgPleB{a.H2(), a.PP(), a.out});
    gemm_sample_rows_ks<false>(a.un2(), 1024, a.WpgT(), 1024, 1024, EwPle{a.H2(), a.PP(), a.out}, smem, bid, nb);
    }
}

static inline char* carve(char*& p, size_t bytes) { char* r = p; p += (bytes + 255) & ~(size_t)255; return r; }

extern "C" void kernel_launch(void* const* d_in, const int* in_sizes, int n_in, void* d_out, int out_size, void* d_ws, size_t ws_size, hipStream_t stream) {
    MK a{};
    a.x_prompt = (const float*)d_in[0]; a.x_sample = (const float*)d_in[1]; a.cache_ckv = (const float*)d_in[2]; a.cache_krope = (const float*)d_in[3];
    a.state_gdn = (const float*)d_in[4]; a.state_conv = (const float*)d_in[5]; a.page_table = (const int*)d_in[6]; a.p_prompt = (const float*)d_in[7]; a.p_sample = (const float*)d_in[8];
    a.g_attn = (const float*)d_in[9]; a.w_in = (const float*)d_in[10]; a.w_conv = (const float*)d_in[11]; a.a_log = (const float*)d_in[12]; a.dt_bias = (const float*)d_in[13];
    a.g_gdn_out = (const float*)d_in[14]; a.g_q_a = (const float*)d_in[15]; a.w_q_b = (const float*)d_in[16]; a.g_q_nope = (const float*)d_in[17]; a.g_q_rope = (const float*)d_in[18];
    a.g_kv_a = (const float*)d_in[19]; a.g_k_rope = (const float*)d_in[20]; a.w_kv_b = (const float*)d_in[21]; a.g_k_nope = (const float*)d_in[22]; a.w_o = (const float*)d_in[23];
    a.g_ffn = (const float*)d_in[24]; a.w_gate = (const float*)d_in[25]; a.w_up = (const float*)d_in[26]; a.w_down = (const float*)d_in[27]; a.g_ple = (const float*)d_in[28];
    a.w_ple_gate = (const float*)d_in[29]; a.w_ple_proj = (const float*)d_in[30];
    a.out = (float*)d_out;
    a.ws = (char*)d_ws;
    if (WS_TOTAL > ws_size) { fprintf(stderr, "kernel_launch: workspace too small: need %zu have %zu\n", (size_t)WS_TOTAL, ws_size); return; }

    static int grid_blocks = 0;
    if (!grid_blocks) {
        int dev = 0, cus = 0, per_cu = 0;
        (void)hipGetDevice(&dev);
        (void)hipDeviceGetAttribute(&cus, hipDeviceAttributeMultiprocessorCount, dev);
        (void)hipFuncSetAttribute((const void*)mega, hipFuncAttributeMaxDynamicSharedMemorySize, LDS_BYTES);
        (void)hipOccupancyMaxActiveBlocksPerMultiprocessor(&per_cu, (const void*)mega, NTHR, LDS_BYTES);
        if (per_cu < 1) fprintf(stderr, "kernel_launch: occupancy query says %d blocks/CU\n", per_cu);
        grid_blocks = cus;
    }
    (void)hipMemsetAsync((char*)d_ws + WOF_ctl, 0, 16384, stream);
    void* args[] = {&a};
    hipError_t e = hipLaunchCooperativeKernel((const void*)mega, dim3(grid_blocks), dim3(NTHR), args, LDS_BYTES, stream);
    if (e != hipSuccess) fprintf(stderr, "cooperative launch failed: %s (grid %d)\n", hipGetErrorString(e), grid_blocks);
}
```

```cpp
#include <hip/hip_runtime.h>
#include <stdint.h>
#include <cstdio>
#include <hip/hip_cooperative_groups.h>
namespace cg = cooperative_groups;


__device__ __forceinline__ int otid();
#define PG8_TID() otid()
namespace pg8 {
#define PG8_LAS __attribute__((address_space(3)))
typedef unsigned short bf16_t;
typedef short bf16x8 __attribute__((ext_vector_type(8)));
typedef float f32x4 __attribute__((ext_vector_type(4)));
typedef unsigned u32x4 __attribute__((ext_vector_type(4)));
constexpr int BM = 256, BK = 64, HALF = 128, HTB = HALF * BK * 2  , STAGE_BYTES = 8 * HTB, NXCD = 8, WGM = 8;

__host__ __device__ __forceinline__ int lds_byte(int r, int c) { const int st = (r >> 4) * 2 + (c >> 5), rr = r & 15, cc = c & 31, ob = rr * 64 + cc * 2; return st * 1024 + (ob ^ (((ob >> 9) & 1) << 5)); }
__host__ __device__ __forceinline__ void stage_rc(int b, int& R, int& C) { const int st = b / 1024, sb = b % 1024, swz = sb ^ (((sb >> 9) & 1) << 5); R = (st >> 1) * 16 + swz / 64; C = (st & 1) * 32 + (swz % 64) / 2; }
__host__ __device__ __forceinline__ int perm32(int rho) { const int n = rho >> 4, i = rho & 15; return 8 * (i >> 2) + 4 * n + (i & 3); }

struct Unit { int pm, pn; };
struct Gemm { const bf16_t* A; const bf16_t* Bt; int M, N, K; };

struct StaticOrder {
    int nM, nN, nwg, G, c;
    __host__ __device__ void init(int M, int N, int G_, int c_) { nM = M / BM; nN = N / BM; nwg = nM * nN; G = G_; c = c_; }
    __host__ __device__ bool next(int i, Unit& u) const {
        const long L = (long)i * G + c; if (L >= nwg) return false;
        int wgid = (int)L; { const int q = nwg / NXCD, r = nwg % NXCD, xcd = wgid % NXCD, off = wgid / NXCD; wgid = (xcd < r ? xcd * (q + 1) : r * (q + 1) + (xcd - r) * q) + off; }
        const int nig = WGM * nN, gid = wgid / nig, fm = gid * WGM, gsz = (nM - fm) < WGM ? (nM - fm) : WGM;
        u.pm = fm + ((wgid % nig) % gsz); u.pn = (wgid % nig) / gsz; return true;
    }
    __device__ __forceinline__ void a_ready(const Unit&) const {}
    __device__ __forceinline__ void done(const Unit&) const {}
};

template <class Epi, class Sched, bool ALIGN_EPI = false, bool SP2 = false>
__device__ __forceinline__ void gemm_phase(PG8_LAS unsigned char* lds, const Gemm g, const Sched& S, const Epi& E) {
    const int tid = PG8_TID(), wid = __builtin_amdgcn_readfirstlane(tid >> 6), lane = tid & 63, wr = wid >> 2, wc = wid & 3, fr = lane & 15, fq = lane >> 4;
    const int K = g.K, nt = K / BK;
    unsigned voffA[2], voffB[2];
#pragma unroll
    for (int i = 0; i < 2; ++i) { int R, C; stage_rc(tid * 16 + i * 8192, R, C); const int Rb = Epi::PERM ? ((R & ~31) + perm32(R & 31)) : R;
        voffA[i] = (unsigned)(R * K + C) * 2u; voffB[i] = (unsigned)(Rb * K + C) * 2u; }
    const size_t kstep = (size_t)(BK * 2);
    const size_t hstep = (size_t)HALF * K * 2;
    const size_t tstep = 2 * hstep;
    const unsigned ldsw = (unsigned)wid * 1024u;
    const int aoff = lds_byte(wr * 64 + fr, fq * 8), boff = lds_byte(wc * 32 + fr, fq * 8);
#define PG8_SA(b, h) (((b) * 2 + (h)) * HTB)
#define PG8_SB(b, h) ((4 + (b) * 2 + (h)) * HTB)
#define PG8_STAGE(bufoff, gbase, voff) do { _Pragma("unroll") for (int _i = 0; _i < 2; ++_i) \
        __builtin_amdgcn_global_load_lds((const unsigned*)((const char*)(gbase) + (voff)[_i]), (PG8_LAS unsigned*)(lds + (bufoff) + ldsw + _i * 8192), 16, 0, 0); } while (0)
#define PG8_LDA(dst, b, h) do { _Pragma("unroll") for (int m = 0; m < 4; ++m) _Pragma("unroll") for (int k = 0; k < 2; ++k) dst[m][k] = *(const PG8_LAS bf16x8*)(lds + PG8_SA(b, h) + aoff + m * 2048 + k * 1024); } while (0)
#define PG8_LDB(dst, b, h) do { _Pragma("unroll") for (int n = 0; n < 2; ++n) _Pragma("unroll") for (int k = 0; k < 2; ++k) dst[n][k] = *(const PG8_LAS bf16x8*)(lds + PG8_SB(b, h) + boff + n * 2048 + k * 1024); } while (0)
#define PG8_MMA(ai, bj, At, Bt) do { __builtin_amdgcn_s_setprio(1); _Pragma("unroll") for (int m = 0; m < 4; ++m) _Pragma("unroll") for (int n = 0; n < 2; ++n) _Pragma("unroll") for (int k = 0; k < 2; ++k) \
        acc[ai][bj][m][n] = __builtin_amdgcn_mfma_f32_16x16x32_bf16(Bt[n][k], At[m][k], acc[ai][bj][m][n], 0, 0, 0); __builtin_amdgcn_s_setprio(0); } while (0)
#define PG8_WAIT_V(n) asm volatile("s_waitcnt vmcnt(" #n ")" ::: "memory")
#define PG8_WAIT_L(n) asm volatile("s_waitcnt lgkmcnt(" #n ")" ::: "memory")
#define PG8_BAR __builtin_amdgcn_s_barrier()
#define PG8_SCHED __builtin_amdgcn_sched_barrier(0)
    Unit cur, nxt; int ui = 0;
    if (!S.next(0, cur)) return;
    f32x4 acc[2][2][4][2];
#pragma unroll
    for (int a = 0; a < 2; ++a)
#pragma unroll
        for (int b = 0; b < 2; ++b)
#pragma unroll
            for (int m = 0; m < 4; ++m)
#pragma unroll
                for (int n = 0; n < 2; ++n) acc[a][b][m][n] = (f32x4){0.f, 0.f, 0.f, 0.f};
    bf16x8 At[4][2], B0[2][2], B1[2][2];
    const char* cA = (const char*)g.A + (size_t)cur.pm * tstep; const char* cB = (const char*)g.Bt + (size_t)cur.pn * tstep;
    S.a_ready(cur);
    if constexpr (SP2) {
        PG8_STAGE(PG8_SB(0, 0), cB, voffB); PG8_STAGE(PG8_SB(0, 1), cB + hstep, voffB); PG8_STAGE(PG8_SA(0, 0), cA, voffA); PG8_STAGE(PG8_SA(0, 1), cA + hstep, voffA);
        if (wr == 1) PG8_BAR;
        PG8_WAIT_V(2); PG8_BAR;
        PG8_STAGE(PG8_SB(1, 0), cB + kstep, voffB); PG8_STAGE(PG8_SA(1, 0), cA + kstep, voffA); PG8_STAGE(PG8_SB(1, 1), cB + hstep + kstep, voffB);
        PG8_WAIT_V(6); PG8_BAR;
    } else {
        PG8_STAGE(PG8_SB(0, 0), cB, voffB); PG8_STAGE(PG8_SA(0, 0), cA, voffA); PG8_STAGE(PG8_SB(0, 1), cB + hstep, voffB); PG8_STAGE(PG8_SA(0, 1), cA + hstep, voffA);
        if (wr == 1) PG8_BAR;
        PG8_WAIT_V(4); PG8_BAR;
        PG8_STAGE(PG8_SB(1, 0), cB + kstep, voffB); PG8_STAGE(PG8_SA(1, 0), cA + kstep, voffA); PG8_STAGE(PG8_SB(1, 1), cB + hstep + kstep, voffB);
        PG8_WAIT_V(6); PG8_BAR;
    }
    for (;;) {
        const bool has_next = S.next(ui + 1, nxt);
        const char* nA = has_next ? (const char*)g.A + (size_t)nxt.pm * tstep : cA; const char* nB = has_next ? (const char*)g.Bt + (size_t)nxt.pn * tstep : cB;
        for (int t = 0; t < nt; t += 2) {
            const bool last = (t == nt - 2);
            const char* a1 = cA + (size_t)(t + 1) * kstep;
            const char* a2 = last ? nA : cA + (size_t)(t + 2) * kstep; const char* b2 = last ? nB : cB + (size_t)(t + 2) * kstep;
            const char* a3 = a2 + kstep; const char* b3 = b2 + kstep;
            if (last && has_next) S.a_ready(nxt);
            if constexpr (SP2) {
            PG8_LDB(B0, 0, 0); PG8_LDB(B1, 0, 1); PG8_SCHED; PG8_LDA(At, 0, 0); PG8_STAGE(PG8_SA(1, 1), a1 + hstep, voffA);
            PG8_WAIT_V(8); PG8_WAIT_L(0); PG8_BAR; PG8_MMA(0, 0, At, B0); PG8_MMA(0, 1, At, B1); PG8_BAR; PG8_SCHED;
            PG8_LDA(At, 0, 1); PG8_STAGE(PG8_SB(0, 0), b2, voffB); PG8_STAGE(PG8_SB(0, 1), b2 + hstep, voffB); PG8_STAGE(PG8_SA(0, 0), a2, voffA);
            PG8_WAIT_V(8); PG8_WAIT_L(0); PG8_BAR; PG8_MMA(1, 0, At, B0); PG8_MMA(1, 1, At, B1); PG8_BAR; PG8_SCHED;
            PG8_LDB(B0, 1, 0); PG8_LDB(B1, 1, 1); PG8_SCHED; PG8_LDA(At, 1, 0); PG8_STAGE(PG8_SA(0, 1), a2 + hstep, voffA);
            PG8_WAIT_V(8); PG8_WAIT_L(0); PG8_BAR; PG8_MMA(0, 0, At, B0); PG8_MMA(0, 1, At, B1); PG8_BAR; PG8_SCHED;
            PG8_LDA(At, 1, 1); PG8_STAGE(PG8_SB(1, 0), b3, voffB); PG8_STAGE(PG8_SB(1, 1), b3 + hstep, voffB); PG8_STAGE(PG8_SA(1, 0), a3, voffA);
            PG8_WAIT_V(8); PG8_WAIT_L(0); PG8_BAR; PG8_MMA(1, 0, At, B0); PG8_MMA(1, 1, At, B1); PG8_BAR; PG8_SCHED;
            } else {
            PG8_LDB(B0, 0, 0); PG8_SCHED; PG8_LDA(At, 0, 0); PG8_STAGE(PG8_SA(1, 1), a1 + hstep, voffA);
            PG8_WAIT_L(8); PG8_BAR; PG8_WAIT_L(0); PG8_MMA(0, 0, At, B0); PG8_BAR; PG8_SCHED;
            PG8_LDB(B1, 0, 1); PG8_STAGE(PG8_SB(0, 0), b2, voffB);
            PG8_BAR; PG8_WAIT_L(0); PG8_MMA(0, 1, At, B1); PG8_BAR;
            PG8_LDA(At, 0, 1); PG8_STAGE(PG8_SA(0, 0), a2, voffA);
            PG8_BAR; PG8_WAIT_L(0); PG8_MMA(1, 0, At, B0); PG8_BAR; PG8_SCHED;
            PG8_STAGE(PG8_SB(0, 1), b2 + hstep, voffB);
            PG8_WAIT_V(6); PG8_BAR; PG8_MMA(1, 1, At, B1); PG8_BAR;
            PG8_LDB(B0, 1, 0); PG8_SCHED; PG8_LDA(At, 1, 0); PG8_STAGE(PG8_SA(0, 1), a2 + hstep, voffA);
            PG8_WAIT_L(8); PG8_BAR; PG8_WAIT_L(0); PG8_MMA(0, 0, At, B0); PG8_BAR; PG8_SCHED;
            PG8_LDB(B1, 1, 1); PG8_STAGE(PG8_SB(1, 0), b3, voffB);
            PG8_BAR; PG8_WAIT_L(0); PG8_MMA(0, 1, At, B1); PG8_BAR;
            PG8_LDA(At, 1, 1); PG8_STAGE(PG8_SA(1, 0), a3, voffA);
            PG8_BAR; PG8_WAIT_L(0); PG8_MMA(1, 0, At, B0); PG8_BAR; PG8_SCHED;
            PG8_STAGE(PG8_SB(1, 1), b3 + hstep, voffB);
            PG8_WAIT_V(6); PG8_BAR; PG8_MMA(1, 1, At, B1); PG8_BAR;
            }
        }
        if constexpr (ALIGN_EPI) { if (wr == 0) PG8_BAR; }
        if constexpr (!Epi::AFTER_DRAIN) { E(acc, cur, wr, wc, fr, fq); S.done(cur); }
        if (!has_next) break;
#pragma unroll
        for (int a = 0; a < 2; ++a)
#pragma unroll
            for (int b = 0; b < 2; ++b)
#pragma unroll
                for (int m = 0; m < 4; ++m)
#pragma unroll
                    for (int n = 0; n < 2; ++n) acc[a][b][m][n] = (f32x4){0.f, 0.f, 0.f, 0.f};
        cur = nxt; cA = nA; cB = nB; ++ui;
        if constexpr (ALIGN_EPI) { if (wr == 1) PG8_BAR; }
    }
    PG8_WAIT_V(0);
    if constexpr (!ALIGN_EPI) { if (wr == 0) PG8_BAR; }
    PG8_BAR;
    if constexpr (Epi::AFTER_DRAIN) { E.fused(acc, cur, wr, wc, fr, fq, lds, wid, lane); S.done(cur); }
#undef PG8_SA
#undef PG8_SB
#undef PG8_STAGE
#undef PG8_LDA
#undef PG8_LDB
#undef PG8_MMA
#undef PG8_WAIT_V
#undef PG8_WAIT_L
#undef PG8_BAR
#undef PG8_SCHED
}
}

#define WTAB_OFF 155392
extern __shared__ __attribute__((aligned(16))) unsigned char lds_raw[];
__device__ __forceinline__ int hw_slot() { return (int)(__builtin_amdgcn_s_getreg((5 << 11) | 4) & 63u); }
__device__ __forceinline__ void otid_init() { const int t = threadIdx.x; if ((t & 63) == 0) ((__attribute__((address_space(3))) int*)(__attribute__((address_space(3))) void*)(lds_raw + WTAB_OFF))[hw_slot()] = t >> 6; }
__device__ __forceinline__ int otid() {
    const int w = __builtin_amdgcn_readfirstlane(((const __attribute__((address_space(3))) int*)(__attribute__((address_space(3))) void*)(lds_raw + WTAB_OFF))[hw_slot()]);
    int l; asm volatile("v_mbcnt_lo_u32_b32 %0, -1, 0\n\tv_mbcnt_hi_u32_b32 %0, -1, %0" : "=v"(l));
    return (w << 6) + l;
}
using pg8::bf16_t; using pg8::bf16x8; using pg8::f32x4; using pg8::u32x4;
#define LAS __attribute__((address_space(3)))

#define DMODEL 1024
#define NPT 16384
#define NST 32
#define NTOK 16416
#define MPAD 16640
#define SEQ 2048
#define ZW 2816
#define OFF_A 1536
#define OFF_B 1544
#define OFF_Z 1552
#define OFF_QA 2064
#define OFF_KVA 2448
#define OFF_KR 2704
#define DFF 2816
#define PAST 16384
#define NPAGES 128
#define EPSV 1e-6f

#define O_YP 0
#define O_YS (O_YP + 16777216)
#define O_CKVP (O_YS + 32768)
#define O_KRP (O_CKVP + 4194304)
#define O_GSP (O_KRP + 524288)
#define O_CSP (O_GSP + 262144)
#define O_CKVS (O_CSP + 36864)
#define O_KRS (O_CKVS + 8192)
#define O_GSS (O_KRS + 1024)
#define O_CSS (O_GSS + 1048576)

__device__ __forceinline__ bf16_t f2bf(float f) { unsigned u = __float_as_uint(f); return (bf16_t)((u + 0x7fffu + ((u >> 16) & 1u)) >> 16); }
__device__ __forceinline__ float bf2f(bf16_t b) { return __uint_as_float(((unsigned)b) << 16); }
template <int CTRL> __device__ __forceinline__ float dpp_mov(float x) { return __uint_as_float((unsigned)__builtin_amdgcn_update_dpp((int)__float_as_uint(x), (int)__float_as_uint(x), CTRL, 0xF, 0xF, true)); }
__device__ __forceinline__ float add_x16(float x) { auto r = __builtin_amdgcn_permlane16_swap(__float_as_uint(x), __float_as_uint(x), false, false); return __uint_as_float(r[0]) + __uint_as_float(r[1]); }
__device__ __forceinline__ float add_x32(float x) { auto r = __builtin_amdgcn_permlane32_swap(__float_as_uint(x), __float_as_uint(x), false, false); return __uint_as_float(r[0]) + __uint_as_float(r[1]); }
__device__ __forceinline__ float max_x32(float x) { auto r = __builtin_amdgcn_permlane32_swap(__float_as_uint(x), __float_as_uint(x), false, false); return fmaxf(__uint_as_float(r[0]), __uint_as_float(r[1])); }
__device__ __forceinline__ float sum8(float x) { x += dpp_mov<0xB1>(x); x += dpp_mov<0x4E>(x); x += dpp_mov<0x141>(x); return x; }
__device__ __forceinline__ float sum16(float x) { x = sum8(x); x += dpp_mov<0x140>(x); return x; }
__device__ __forceinline__ float max16(float x) { x = fmaxf(x, dpp_mov<0xB1>(x)); x = fmaxf(x, dpp_mov<0x4E>(x)); x = fmaxf(x, dpp_mov<0x141>(x)); x = fmaxf(x, dpp_mov<0x140>(x)); return x; }
__device__ __forceinline__ float wave_sum(float v) { return add_x32(add_x16(sum16(v))); }
__device__ __forceinline__ float sigmoidf_(float x) { return __builtin_amdgcn_rcpf(1.f + __builtin_amdgcn_exp2f(-1.44269504f * x)); }
__device__ __forceinline__ float siluf_(float x) { return x * __builtin_amdgcn_rcpf(1.f + __builtin_amdgcn_exp2f(-1.44269504f * x)); }


#define WSYNC() do { __builtin_amdgcn_fence(__ATOMIC_ACQ_REL, "wavefront"); __builtin_amdgcn_wave_barrier(); } while (0)
#define NTHR 512
#define NWAVE 8

typedef float f32x2_t __attribute__((ext_vector_type(2)));
typedef __bf16 bf16x2_t __attribute__((ext_vector_type(2)));
__device__ __forceinline__ unsigned cvtpk(float lo, float hi) { f32x2_t v = {lo, hi}; bf16x2_t r = __builtin_convertvector(v, bf16x2_t); return __builtin_bit_cast(unsigned, r); }
__device__ __forceinline__ void bf8_to_f32(const bf16x8& v, float* o) {
#pragma unroll
    for (int e = 0; e < 8; ++e) o[e] = __uint_as_float(((unsigned)(unsigned short)v[e]) << 16);
}
__device__ __forceinline__ bf16x8 f32_to_bf8(const float* x) {
    u32x4 w; w.x = cvtpk(x[0], x[1]); w.y = cvtpk(x[2], x[3]); w.z = cvtpk(x[4], x[5]); w.w = cvtpk(x[6], x[7]);
    return __builtin_bit_cast(bf16x8, w);
}
__device__ __forceinline__ unsigned pk2bf(float lo, float hi) { return (unsigned)f2bf(lo) | ((unsigned)f2bf(hi) << 16); }

__device__ __forceinline__ void wt_item(const float* __restrict__ W, int ldw, int col0, int nvalid, bf16_t* __restrict__ WT, int ldt, int nrow0, int k0, float* scr, int lane) {
    WSYNC();
#pragma unroll 8
    for (int i = 0; i < 32; ++i) { const int kk = 2 * i + (lane >> 5), n = lane & 31; scr[kk * 33 + n] = n < nvalid ? W[(size_t)(k0 + kk) * ldw + col0 + n] : 0.f; }
    WSYNC();
    const int c = lane & 7;
#pragma unroll
    for (int j = 0; j < 4; ++j) { const int n = (lane >> 3) + 8 * j; const float* sp = scr + (8 * c) * 33 + n;
        u32x4 o; o.x = cvtpk(sp[0], sp[33]); o.y = cvtpk(sp[2 * 33], sp[3 * 33]); o.z = cvtpk(sp[4 * 33], sp[5 * 33]); o.w = cvtpk(sp[6 * 33], sp[7 * 33]);
        *(u32x4*)(WT + (size_t)(nrow0 + n) * ldt + k0 + 8 * c) = o; }
}

__device__ __forceinline__ void rms1024_row(const float* __restrict__ src, const float* __restrict__ g, bf16_t* __restrict__ o, bool zero, int lane) {
    if (zero) { for (int j = 0; j < 4; ++j) { ushort4 z = {0, 0, 0, 0}; *(ushort4*)(o + lane * 4 + 256 * j) = z; } return; }
    float4 v[4]; float ss = 0.f;
#pragma unroll
    for (int j = 0; j < 4; ++j) { v[j] = *(const float4*)(src + lane * 4 + 256 * j); ss += v[j].x * v[j].x + v[j].y * v[j].y + v[j].z * v[j].z + v[j].w * v[j].w; }
    ss = wave_sum(ss);
    const float rs = rsqrtf(ss * (1.f / 1024.f) + EPSV);
#pragma unroll
    for (int j = 0; j < 4; ++j) {
        const float4 gg = *(const float4*)(g + lane * 4 + 256 * j);
        ushort4 w; w.x = f2bf(v[j].x * rs * gg.x); w.y = f2bf(v[j].y * rs * gg.y); w.z = f2bf(v[j].z * rs * gg.z); w.w = f2bf(v[j].w * rs * gg.w);
        *(ushort4*)(o + lane * 4 + 256 * j) = w;
    }
}

__device__ __forceinline__ void rms1024_row_b(const bf16_t* __restrict__ src, const float* __restrict__ g, bf16_t* __restrict__ o, bool zero, int lane) {
    if (zero) { for (int j = 0; j < 2; ++j) { const u32x4 z = {0u, 0u, 0u, 0u}; *(u32x4*)(o + lane * 8 + 512 * j) = z; } return; }
    float v[2][8]; float ss = 0.f;
#pragma unroll
    for (int j = 0; j < 2; ++j) { bf8_to_f32(*(const bf16x8*)(src + lane * 8 + 512 * j), v[j]);
#pragma unroll
        for (int e = 0; e < 8; ++e) ss += v[j][e] * v[j][e]; }
    ss = wave_sum(ss);
    const float rs = rsqrtf(ss * (1.f / 1024.f) + EPSV);
#pragma unroll
    for (int j = 0; j < 2; ++j) {
        const float4 g0 = *(const float4*)(g + lane * 8 + 512 * j), g1 = *(const float4*)(g + lane * 8 + 512 * j + 4);
        float t[8] = {v[j][0] * rs * g0.x, v[j][1] * rs * g0.y, v[j][2] * rs * g0.z, v[j][3] * rs * g0.w, v[j][4] * rs * g1.x, v[j][5] * rs * g1.y, v[j][6] * rs * g1.z, v[j][7] * rs * g1.w};
        *(bf16x8*)(o + lane * 8 + 512 * j) = f32_to_bf8(t);
    }
}

struct ABf16 { const bf16_t* p; int lda; __device__ __forceinline__ bf16x8 load(int m, int k) const { return *(const bf16x8*)(p + (size_t)m * lda + k); } };
template <bool SWIGLU, class Epi>
__device__ __forceinline__ void gemm_sample_rows(const bf16_t* __restrict__ A, int lda, const bf16_t* __restrict__ Bt, int K, int N, const Epi& epi, char*  , int bid, int nb, int first = -1) {
    const int tid = otid(), lane = tid & 63, wid = tid >> 6, i16 = lane & 15, q4 = lane >> 4;
    for (int u = first >= 0 ? (bid - first + nb) % nb : nb - 1 - bid; u < N / 256; u += nb) {
        const int n0 = u * 256;
        const int c0 = SWIGLU ? n0 + 16 * wid : n0 + 32 * wid, c1 = SWIGLU ? n0 + 128 + 16 * wid : n0 + 32 * wid + 16;
        const bf16_t* a0p = A + (size_t)(NPT + i16) * lda + 8 * q4; const bf16_t* a1p = a0p + (size_t)16 * lda;
        const bf16_t* b0p = Bt + (size_t)(c0 + i16) * K + 8 * q4; const bf16_t* b1p = Bt + (size_t)(c1 + i16) * K + 8 * q4;
        f32x4 acc[2][2];
#pragma unroll
        for (int i = 0; i < 2; ++i)
#pragma unroll
            for (int j = 0; j < 2; ++j) acc[i][j] = (f32x4){0.f, 0.f, 0.f, 0.f};
#pragma unroll 4
        for (int k0 = 0; k0 < K; k0 += 32) {
            const bf16x8 a0 = *(const bf16x8*)(a0p + k0), a1 = *(const bf16x8*)(a1p + k0), b0 = *(const bf16x8*)(b0p + k0), b1 = *(const bf16x8*)(b1p + k0);
            acc[0][0] = __builtin_amdgcn_mfma_f32_16x16x32_bf16(a0, b0, acc[0][0], 0, 0, 0); acc[0][1] = __builtin_amdgcn_mfma_f32_16x16x32_bf16(a0, b1, acc[0][1], 0, 0, 0);
            acc[1][0] = __builtin_amdgcn_mfma_f32_16x16x32_bf16(a1, b0, acc[1][0], 0, 0, 0); acc[1][1] = __builtin_amdgcn_mfma_f32_16x16x32_bf16(a1, b1, acc[1][1], 0, 0, 0);
        }
#pragma unroll
        for (int i = 0; i < 2; ++i)
#pragma unroll
            for (int r = 0; r < 4; ++r) {
                const int m = NPT + 16 * i + 4 * q4 + r;
                if constexpr (SWIGLU) epi(m, (n0 >> 1) + 16 * wid + i16, siluf_(acc[i][0][r]) * acc[i][1][r]);
                else { epi(m, c0 + i16, acc[i][0][r]); epi(m, c1 + i16, acc[i][1][r]); }
            }
    }
}
template <bool SWIGLU, class Epi>
__device__ __forceinline__ void gemm_sample_rows_ks(const bf16_t* __restrict__ A, int lda, const bf16_t* __restrict__ Bt, int K, int N, const Epi& epi, char* smem, int bid, int nb) {
    const int tid = otid(), lane = tid & 63, wid = tid >> 6, i16 = lane & 15, q4 = lane >> 4;
    const int nunits = N / 64, ksl = K >> 3;
    f32x4* red = (f32x4*)smem;
    for (int u = nb - 1 - bid; u < nunits; u += nb) {
        int brow[4];
#pragma unroll
        for (int j = 0; j < 4; ++j) brow[j] = SWIGLU ? ((32 * u) >> 7) * 256 + ((32 * u) & 127) + 128 * (j >> 1) + 16 * (j & 1) + i16 : 64 * u + 16 * j + i16;
        const bf16_t* a0p = A + (size_t)(NPT + i16) * lda + wid * ksl + 8 * q4; const bf16_t* a1p = a0p + (size_t)16 * lda;
        f32x4 acc[2][4];
#pragma unroll
        for (int i = 0; i < 2; ++i)
#pragma unroll
            for (int j = 0; j < 4; ++j) acc[i][j] = (f32x4){0.f, 0.f, 0.f, 0.f};
        for (int k0 = 0; k0 < ksl; k0 += 32) {
            const bf16x8 a0 = *(const bf16x8*)(a0p + k0), a1 = *(const bf16x8*)(a1p + k0);
            bf16x8 b[4];
#pragma unroll
            for (int j = 0; j < 4; ++j) b[j] = *(const bf16x8*)(Bt + (size_t)brow[j] * K + wid * ksl + 8 * q4 + k0);
#pragma unroll
            for (int j = 0; j < 4; ++j) { acc[0][j] = __builtin_amdgcn_mfma_f32_16x16x32_bf16(a0, b[j], acc[0][j], 0, 0, 0); acc[1][j] = __builtin_amdgcn_mfma_f32_16x16x32_bf16(a1, b[j], acc[1][j], 0, 0, 0); }
        }
        __syncthreads();
#pragma unroll
        for (int i = 0; i < 2; ++i)
#pragma unroll
            for (int j = 0; j < 4; ++j) red[(wid * 8 + i * 4 + j) * 64 + lane] = acc[i][j];
        __syncthreads();
        if constexpr (SWIGLU) {
            if (tid < 256) {
                const int t4 = tid >> 6, i = t4 >> 1, jg = t4 & 1, l = tid & 63;
                f32x4 g = red[(i * 4 + jg) * 64 + l], up = red[(i * 4 + jg + 2) * 64 + l];
#pragma unroll
                for (int w = 1; w < 8; ++w) { g = g + red[(w * 8 + i * 4 + jg) * 64 + l]; up = up + red[(w * 8 + i * 4 + jg + 2) * 64 + l]; }
#pragma unroll
                for (int r = 0; r < 4; ++r) epi(NPT + 16 * i + 4 * (l >> 4) + r, 32 * u + 16 * jg + (l & 15), siluf_(g[r]) * up[r]);
            }
        } else {
            const int t8 = tid >> 6, l = tid & 63, i = t8 >> 2, j = t8 & 3;
            f32x4 v = red[t8 * 64 + l];
#pragma unroll
            for (int w = 1; w < 8; ++w) v = v + red[(w * 8 + t8) * 64 + l];
#pragma unroll
            for (int r = 0; r < 4; ++r) epi(NPT + 16 * i + 4 * (l >> 4) + r, 64 * u + 16 * j + (l & 15), v[r]);
        }
    }
    __syncthreads();
}
struct EwF32 { float* C; int ldc; __device__ __forceinline__ void operator()(int m, int n, float v) const { C[(size_t)m * ldc + n] = v; } };
struct EwBf16 { bf16_t* C; int ldc; __device__ __forceinline__ void operator()(int m, int n, float v) const { C[(size_t)m * ldc + n] = f2bf(v); } };
struct EwResX { const float* xs; bf16_t* C; __device__ __forceinline__ void operator()(int m, int n, float v) const { C[(size_t)m * 1024 + n] = f2bf(xs[(size_t)(m - NPT) * 1024 + n] + v); } };
struct EwResH { const bf16_t* H; bf16_t* C; __device__ __forceinline__ void operator()(int m, int n, float v) const { C[(size_t)m * 1024 + n] = f2bf(bf2f(H[(size_t)m * 1024 + n]) + v); } };
struct EwPle { const bf16_t* H2; const bf16_t* PP; float* out;
    __device__ __forceinline__ void operator()(int m, int n, float v) const { out[O_YS + (size_t)(m - NPT) * 1024 + n] = bf2f(H2[(size_t)m * 1024 + n]) + bf2f(PP[(size_t)m * 1024 + n]) * sigmoidf_(v); } };

struct PgBf16 {
    static constexpr bool PERM = true, AFTER_DRAIN = false; bf16_t* O; int ldc;
    __device__ __forceinline__ void operator()(const f32x4 (&acc)[2][2][4][2], const pg8::Unit& u, int wr, int wc, int fr, int fq) const {
#pragma unroll
        for (int ai = 0; ai < 2; ++ai)
#pragma unroll
            for (int m = 0; m < 4; ++m) { bf16_t* rowp = O + (size_t)(u.pm * 256 + ai * 128 + wr * 64 + m * 16 + fr) * ldc + u.pn * 256 + wc * 32 + 8 * fq;
#pragma unroll
                for (int bj = 0; bj < 2; ++bj) { const f32x4 v0 = acc[ai][bj][m][0], v1 = acc[ai][bj][m][1]; u32x4 w; w.x = pk2bf(v0[0], v0[1]); w.y = pk2bf(v0[2], v0[3]); w.z = pk2bf(v1[0], v1[1]); w.w = pk2bf(v1[2], v1[3]); *(u32x4*)(rowp + bj * 128) = w; } }
    }
};
struct PgF32 {
    static constexpr bool PERM = false, AFTER_DRAIN = false; float* O; int ldc;
    __device__ __forceinline__ void operator()(const f32x4 (&acc)[2][2][4][2], const pg8::Unit& u, int wr, int wc, int fr, int fq) const {
#pragma unroll
        for (int ai = 0; ai < 2; ++ai)
#pragma unroll
            for (int m = 0; m < 4; ++m) { float* rowp = O + (size_t)(u.pm * 256 + ai * 128 + wr * 64 + m * 16 + fr) * ldc + u.pn * 256 + wc * 32 + 4 * fq;
#pragma unroll
                for (int bj = 0; bj < 2; ++bj)
#pragma unroll
                    for (int n = 0; n < 2; ++n) *(f32x4*)(rowp + bj * 128 + n * 16) = acc[ai][bj][m][n]; }
    }
};
struct PgSwiglu {
    static constexpr bool PERM = true, AFTER_DRAIN = false; bf16_t* Hd;
    __device__ __forceinline__ void operator()(const f32x4 (&acc)[2][2][4][2], const pg8::Unit& u, int wr, int wc, int fr, int fq) const {
#pragma unroll
        for (int ai = 0; ai < 2; ++ai)
#pragma unroll
            for (int m = 0; m < 4; ++m) { bf16_t* rowp = Hd + (size_t)(u.pm * 256 + ai * 128 + wr * 64 + m * 16 + fr) * DFF + u.pn * 128 + wc * 32 + 8 * fq;
                float h[8];
#pragma unroll
                for (int n = 0; n < 2; ++n)
#pragma unroll
                    for (int i = 0; i < 4; ++i) h[n * 4 + i] = siluf_(acc[ai][0][m][n][i]) * acc[ai][1][m][n][i];
                u32x4 w; w.x = pk2bf(h[0], h[1]); w.y = pk2bf(h[2], h[3]); w.z = pk2bf(h[4], h[5]); w.w = pk2bf(h[6], h[7]); *(u32x4*)rowp = w; }
    }
};
struct PgResXB {
    static constexpr bool PERM = true, AFTER_DRAIN = false; const float* R; bf16_t* O;
    __device__ __forceinline__ void operator()(const f32x4 (&acc)[2][2][4][2], const pg8::Unit& u, int wr, int wc, int fr, int fq) const {
#pragma unroll
        for (int ai = 0; ai < 2; ++ai)
#pragma unroll
            for (int m = 0; m < 4; ++m) { const size_t off = (size_t)(u.pm * 256 + ai * 128 + wr * 64 + m * 16 + fr) * 1024 + u.pn * 256 + wc * 32 + 8 * fq;
#pragma unroll
                for (int bj = 0; bj < 2; ++bj) { const f32x4 r0 = *(const f32x4*)(R + off + bj * 128), r1 = *(const f32x4*)(R + off + bj * 128 + 4), v0 = r0 + acc[ai][bj][m][0], v1 = r1 + acc[ai][bj][m][1];
                    u32x4 w; w.x = cvtpk(v0[0], v0[1]); w.y = cvtpk(v0[2], v0[3]); w.z = cvtpk(v1[0], v1[1]); w.w = cvtpk(v1[2], v1[3]); *(u32x4*)(O + off + bj * 128) = w; } }
    }
};
struct PgResBB {
    static constexpr bool PERM = true, AFTER_DRAIN = false; const bf16_t* R; bf16_t* O;
    __device__ __forceinline__ void operator()(const f32x4 (&acc)[2][2][4][2], const pg8::Unit& u, int wr, int wc, int fr, int fq) const {
#pragma unroll
        for (int ai = 0; ai < 2; ++ai)
#pragma unroll
            for (int m = 0; m < 4; ++m) { const size_t off = (size_t)(u.pm * 256 + ai * 128 + wr * 64 + m * 16 + fr) * 1024 + u.pn * 256 + wc * 32 + 8 * fq;
#pragma unroll
                for (int bj = 0; bj < 2; ++bj) { float r[8]; bf8_to_f32(*(const bf16x8*)(R + off + bj * 128), r); const f32x4 a0 = acc[ai][bj][m][0], a1 = acc[ai][bj][m][1];
                    u32x4 w; w.x = cvtpk(r[0] + a0[0], r[1] + a0[1]); w.y = cvtpk(r[2] + a0[2], r[3] + a0[3]); w.z = cvtpk(r[4] + a1[0], r[5] + a1[1]); w.w = cvtpk(r[6] + a1[2], r[7] + a1[3]); *(u32x4*)(O + off + bj * 128) = w; } }
    }
};
struct PgPleB {
    static constexpr bool PERM = true, AFTER_DRAIN = false; const bf16_t* H2; const bf16_t* PP; float* out;
    __device__ __forceinline__ void operator()(const f32x4 (&acc)[2][2][4][2], const pg8::Unit& u, int wr, int wc, int fr, int fq) const {
#pragma unroll
        for (int ai = 0; ai < 2; ++ai)
#pragma unroll
            for (int m = 0; m < 4; ++m) { const size_t off = (size_t)(u.pm * 256 + ai * 128 + wr * 64 + m * 16 + fr) * 1024 + u.pn * 256 + wc * 32 + 8 * fq;
#pragma unroll
                for (int bj = 0; bj < 2; ++bj) { float h[8], pp[8]; bf8_to_f32(*(const bf16x8*)(H2 + off + bj * 128), h); bf8_to_f32(*(const bf16x8*)(PP + off + bj * 128), pp);
                    const f32x4 a0 = acc[ai][bj][m][0], a1 = acc[ai][bj][m][1]; f32x4 y0, y1;
#pragma unroll
                    for (int i = 0; i < 4; ++i) { y0[i] = h[i] + pp[i] * sigmoidf_(a0[i]); y1[i] = h[4 + i] + pp[4 + i] * sigmoidf_(a1[i]); }
                    *(f32x4*)(out + O_YP + off + bj * 128) = y0; *(f32x4*)(out + O_YP + off + bj * 128 + 4) = y1; } }
    }
};
template <class Epi>
__device__ __forceinline__ void pg_gemm(LAS unsigned char* lds, const bf16_t* A, const bf16_t* Bt, int M, int N, int K, const Epi& E, int glow = 0) {
    pg8::Gemm g{A, Bt, M, N, K}; pg8::StaticOrder S;
    if (glow > 0) { if ((int)blockIdx.x >= glow) return; S.init(M, N, glow, (int)blockIdx.x); }
    else S.init(M, N, (int)gridDim.x, (int)blockIdx.x);
    pg8::gemm_phase<Epi, pg8::StaticOrder, true, true>(lds, g, S, E);
}

constexpr size_t WOF_WinT = 0ull;
constexpr size_t WOF_WqbT = 5767168ull;
constexpr size_t WOF_WkvT = 6356992ull;
constexpr size_t WOF_WknT = 6881280ull;
constexpr size_t WOF_WoT = 7143424ull;
constexpr size_t WOF_WguT = 9240576ull;
constexpr size_t WOF_WdT = 20774912ull;
constexpr size_t WOF_WpgT = 26542080ull;
constexpr size_t WOF_WppT = 28639232ull;
constexpr size_t WOF_xn = 29163520ull;
constexpr size_t WOF_pb = 63242240ull;
constexpr size_t WOF_Z = 71761920ull;
constexpr size_t WOF_qkv = 165478400ull;
constexpr size_t WOF_ropecs = 216596480ull;
constexpr size_t WOF_gg = 216858880ull;
constexpr size_t WOF_bb = 217391360ull;
constexpr size_t WOF_goraw = 217923840ull;
constexpr size_t WOF_gUT = 252002560ull;
constexpr size_t WOF_ggam = 285556992ull;
constexpr size_t WOF_gWn = 285565184ull;
constexpr size_t WOF_gQg = 302342400ull;
constexpr size_t WOF_gQK = 319119616ull;
constexpr size_t WOF_gKd = 335896832ull;
constexpr size_t WOF_qan = 352674048ull;
constexpr size_t WOF_ckvb = 365453568ull;
constexpr size_t WOF_krf = 373973248ull;
constexpr size_t WOF_Q = 376103168ull;
constexpr size_t WOF_qh = 427221248ull;
constexpr size_t WOF_KV = 478339328ull;
constexpr size_t WOF_kh = 546496768ull;
constexpr size_t WOF_omix = 580575488ull;
constexpr size_t WOF_KN = 614654208ull;
constexpr size_t WOF_SC = 1151525120ull;
constexpr size_t WOF_part = 1168302336ull;
constexpr size_t WOF_H = 1170432256ull;
constexpr size_t WOF_un = 1238589696ull;
constexpr size_t WOF_G = 1272668416ull;
constexpr size_t WOF_hid = 1273028864ull;
constexpr size_t WOF_H2 = 1366745344ull;
constexpr size_t WOF_un2 = 1434902784ull;
constexpr size_t WOF_PP = 1468981504ull;
constexpr size_t WOF_qraw = 1537138944ull;
constexpr size_t WOF_kvraw = 1562304768ull;
constexpr size_t WOF_krb = 1595859200ull;
constexpr size_t WOF_ctl = 1596907776ull;
constexpr size_t WS_TOTAL = 1596924160ull;
struct MK {
    const float *x_prompt, *x_sample, *cache_ckv, *cache_krope, *state_gdn, *state_conv; const int* page_table; const float *p_prompt, *p_sample;
    const float *g_attn, *w_in, *w_conv, *a_log, *dt_bias, *g_gdn_out, *g_q_a, *w_q_b, *g_q_nope, *g_q_rope, *g_kv_a, *g_k_rope, *w_kv_b, *g_k_nope, *w_o, *g_ffn, *w_gate, *w_up, *w_down, *g_ple, *w_ple_gate, *w_ple_proj;
    float* out; char* ws;
    __device__ __forceinline__ unsigned* ctl() const { return (unsigned*)(ws + WOF_ctl); }
    __device__ __forceinline__ bf16_t* WinT() const { return (bf16_t*)(ws + WOF_WinT); }
    __device__ __forceinline__ bf16_t* WqbT() const { return (bf16_t*)(ws + WOF_WqbT); }
    __device__ __forceinline__ bf16_t* WkvT() const { return (bf16_t*)(ws + WOF_WkvT); }
    __device__ __forceinline__ bf16_t* WknT() const { return (bf16_t*)(ws + WOF_WknT); }
    __device__ __forceinline__ bf16_t* WoT() const { return (bf16_t*)(ws + WOF_WoT); }
    __device__ __forceinline__ bf16_t* WguT() const { return (bf16_t*)(ws + WOF_WguT); }
    __device__ __forceinline__ bf16_t* WdT() const { return (bf16_t*)(ws + WOF_WdT); }
    __device__ __forceinline__ bf16_t* WpgT() const { return (bf16_t*)(ws + WOF_WpgT); }
    __device__ __forceinline__ bf16_t* WppT() const { return (bf16_t*)(ws + WOF_WppT); }
    __device__ __forceinline__ bf16_t* xn() const { return (bf16_t*)(ws + WOF_xn); }
    __device__ __forceinline__ bf16_t* pb() const { return (bf16_t*)(ws + WOF_pb); }
    __device__ __forceinline__ bf16_t* Z() const { return (bf16_t*)(ws + WOF_Z); }
    __device__ __forceinline__ bf16_t* qkv() const { return (bf16_t*)(ws + WOF_qkv); }
    __device__ __forceinline__ float* ropecs() const { return (float*)(ws + WOF_ropecs); }
    __device__ __forceinline__ float* gg() const { return (float*)(ws + WOF_gg); }
    __device__ __forceinline__ float* bb() const { return (float*)(ws + WOF_bb); }
    __device__ __forceinline__ float* goraw() const { return (float*)(ws + WOF_goraw); }
    __device__ __forceinline__ float* gUT() const { return (float*)(ws + WOF_gUT); }
    __device__ __forceinline__ float* ggam() const { return (float*)(ws + WOF_ggam); }
    __device__ __forceinline__ bf16_t* gWn() const { return (bf16_t*)(ws + WOF_gWn); }
    __device__ __forceinline__ bf16_t* gQg() const { return (bf16_t*)(ws + WOF_gQg); }
    __device__ __forceinline__ bf16_t* gQK() const { return (bf16_t*)(ws + WOF_gQK); }
    __device__ __forceinline__ bf16_t* gKd() const { return (bf16_t*)(ws + WOF_gKd); }
    __device__ __forceinline__ bf16_t* qan() const { return (bf16_t*)(ws + WOF_qan); }
    __device__ __forceinline__ bf16_t* ckvb() const { return (bf16_t*)(ws + WOF_ckvb); }
    __device__ __forceinline__ float* krf() const { return (float*)(ws + WOF_krf); }
    __device__ __forceinline__ float* Q() const { return (float*)(ws + WOF_Q); }
    __device__ __forceinline__ float* qh() const { return (float*)(ws + WOF_qh); }
    __device__ __forceinline__ float* KV() const { return (float*)(ws + WOF_KV); }
    __device__ __forceinline__ float* kh() const { return (float*)(ws + WOF_kh); }
    __device__ __forceinline__ bf16_t* omix() const { return (bf16_t*)(ws + WOF_omix); }
    __device__ __forceinline__ bf16_t* KN() const { return (bf16_t*)(ws + WOF_KN); }
    __device__ __forceinline__ float* SC() const { return (float*)(ws + WOF_SC); }
    __device__ __forceinline__ float* part() const { return (float*)(ws + WOF_part); }
    __device__ __forceinline__ bf16_t* H() const { return (bf16_t*)(ws + WOF_H); }
    __device__ __forceinline__ bf16_t* un() const { return (bf16_t*)(ws + WOF_un); }
    __device__ __forceinline__ float* G() const { return (float*)(ws + WOF_G); }
    __device__ __forceinline__ bf16_t* hid() const { return (bf16_t*)(ws + WOF_hid); }
    __device__ __forceinline__ bf16_t* H2() const { return (bf16_t*)(ws + WOF_H2); }
    __device__ __forceinline__ bf16_t* un2() const { return (bf16_t*)(ws + WOF_un2); }
    __device__ __forceinline__ bf16_t* PP() const { return (bf16_t*)(ws + WOF_PP); }
    __device__ __forceinline__ bf16_t* qraw() const { return (bf16_t*)(ws + WOF_qraw); }
    __device__ __forceinline__ bf16_t* kvraw() const { return (bf16_t*)(ws + WOF_kvraw); }
    __device__ __forceinline__ bf16_t* krb() const { return (bf16_t*)(ws + WOF_krb); }
};

__device__ __forceinline__ float fast_sigmoid(float x) { return __builtin_amdgcn_rcpf(1.f + __builtin_amdgcn_exp2f(-1.44269504f * x)); }
struct PinTok { bf16x8 qa, cv, kr; float ab; };
struct PinGain { float gqa[8], gkv[8], gkr[8], dtb, alog; };
__device__ __forceinline__ PinTok pin_load(const MK& a, int row, int lane) {
    const bf16_t* z = a.Z() + (size_t)row * ZW; PinTok t; const bf16x8 zz = {0, 0, 0, 0, 0, 0, 0, 0};
    t.qa = lane < 48 ? *(const bf16x8*)(z + OFF_QA + 8 * lane) : zz; t.cv = lane < 32 ? *(const bf16x8*)(z + OFF_KVA + 8 * lane) : zz;
    t.kr = (lane >= 32 && lane < 36) ? *(const bf16x8*)(z + OFF_KR + 8 * (lane - 32)) : zz; t.ab = lane < 16 ? bf2f(z[OFF_A + lane]) : 0.f; return t;
}
__device__ __forceinline__ void post_in_token(const MK& a, int row, int lane, const float* wcs, const bf16x8 (&w0)[3], const bf16x8 (&w1)[3], const bf16x8 (&w2)[3], const bf16x8 (&wcur)[3], const PinTok& tk, const PinGain& gn) {
    const bool samp = row >= NPT;
    const int b = samp ? row - NPT : row >> 11, t = samp ? 0 : row & 2047, hd = lane >> 3;
    float y[24];
#pragma unroll
    for (int c3 = 0; c3 < 3; ++c3) {
        float p0[8], p1[8], p2[8], cu[8];
        bf8_to_f32(w0[c3], p0); bf8_to_f32(w1[c3], p1); bf8_to_f32(w2[c3], p2); bf8_to_f32(wcur[c3], cu);
        const float* wp = wcs + 512 * c3 + 8 * lane;
        const float4 a0 = *(const float4*)wp, a1 = *(const float4*)(wp + 4), b0 = *(const float4*)(wp + 1536), b1 = *(const float4*)(wp + 1540);
        const float4 c0 = *(const float4*)(wp + 3072), c1 = *(const float4*)(wp + 3076), d0 = *(const float4*)(wp + 4608), d1 = *(const float4*)(wp + 4612);
        const float k0[8] = {a0.x, a0.y, a0.z, a0.w, a1.x, a1.y, a1.z, a1.w}, k1[8] = {b0.x, b0.y, b0.z, b0.w, b1.x, b1.y, b1.z, b1.w};
        const float k2[8] = {c0.x, c0.y, c0.z, c0.w, c1.x, c1.y, c1.z, c1.w}, k3[8] = {d0.x, d0.y, d0.z, d0.w, d1.x, d1.y, d1.z, d1.w};
#pragma unroll
        for (int e = 0; e < 8; ++e) { const int c = 8 * c3 + e; const float v = k0[e] * p0[e] + k1[e] * p1[e] + k2[e] * p2[e] + k3[e] * cu[e]; y[c] = v * fast_sigmoid(v); }
        __builtin_amdgcn_sched_barrier(0);
    }
    float sq = 0.f, sk = 0.f;
#pragma unroll
    for (int e = 0; e < 8; ++e) { sq += y[e] * y[e]; sk += y[8 + e] * y[8 + e]; }
    sq = sum8(sq); sk = sum8(sk);
    const float rq = rsqrtf(sq + EPSV) * 0.125f, rk = rsqrtf(sk + EPSV);
#pragma unroll
    for (int e = 0; e < 8; ++e) { y[e] *= rq; y[8 + e] *= rk; }
    bf16_t* qo = a.qkv() + (size_t)row * 1536 + 8 * lane;
    *(bf16x8*)qo = f32_to_bf8(y); *(bf16x8*)(qo + 512) = f32_to_bf8(y + 8); *(bf16x8*)(qo + 1024) = f32_to_bf8(y + 16);
    if (!samp && t >= SEQ - 3) {
        float* cso = a.out + O_CSP + ((size_t)b * 3 + (t - (SEQ - 3))) * 1536 + 8 * lane;
#pragma unroll
        for (int j = 0; j < 3; ++j) { float cu[8]; bf8_to_f32(wcur[j], cu); *(float4*)(cso + 512 * j) = (float4){cu[0], cu[1], cu[2], cu[3]}; *(float4*)(cso + 512 * j + 4) = (float4){cu[4], cu[5], cu[6], cu[7]}; }
    }
    if (lane < 16) {
        const float v = tk.ab;
        if (lane < 8) { const float xx = v + gn.dtb; const float sp = xx > 20.f ? xx : 0.69314718f * __builtin_amdgcn_logf(1.f + __builtin_amdgcn_exp2f(1.44269504f * xx)); a.gg()[(size_t)row * 8 + lane] = -gn.alog * sp; }
        else a.bb()[(size_t)row * 8 + lane - 8] = sigmoidf_(v);
    }
    __builtin_amdgcn_sched_barrier(0);
    float qa[8], cv[8], kr[8];
    bf8_to_f32(tk.qa, qa); bf8_to_f32(tk.cv, cv); bf8_to_f32(tk.kr, kr);
    float s1 = 0.f, s2 = 0.f, s3 = 0.f;
#pragma unroll
    for (int e = 0; e < 8; ++e) { s1 += qa[e] * qa[e]; s2 += cv[e] * cv[e]; s3 += kr[e] * kr[e]; }
    s1 = wave_sum(s1); s2 = wave_sum(s2); s3 = wave_sum(s3);
    const float r1 = rsqrtf(s1 * (1.f / 384.f) + EPSV), r2 = rsqrtf(s2 * (1.f / 256.f) + EPSV), r3 = rsqrtf(s3 * (1.f / 32.f) + EPSV);
    if (lane < 48) {
        float o[8];
#pragma unroll
        for (int e = 0; e < 8; ++e) o[e] = qa[e] * r1 * gn.gqa[e];
        *(bf16x8*)(a.qan() + (size_t)row * 384 + 8 * lane) = f32_to_bf8(o);
    }
    if (lane < 32) {
        float o[8];
#pragma unroll
        for (int e = 0; e < 8; ++e) o[e] = cv[e] * r2 * gn.gkv[e];
        *(bf16x8*)(a.ckvb() + (size_t)row * 256 + 8 * lane) = f32_to_bf8(o);
        float* co = samp ? a.out + O_CKVS + (size_t)b * 256 + 8 * lane : a.out + O_CKVP + (size_t)row * 256 + 8 * lane;
        *(float4*)co = (float4){o[0], o[1], o[2], o[3]}; *(float4*)(co + 4) = (float4){o[4], o[5], o[6], o[7]};
    }
    __builtin_amdgcn_sched_barrier(0);
    {
        const int c4 = (lane - 32) & 3;
        float xn[8], ot[8];
#pragma unroll
        for (int e = 0; e < 8; ++e) xn[e] = kr[e] * r3 * gn.gkr[e];
#pragma unroll
        for (int e = 0; e < 8; ++e) ot[e] = dpp_mov<0x4E>(xn[e]);
        if (lane >= 32 && lane < 36) {
            const float* tb = a.ropecs() + (size_t)(samp ? 2048 : t) * 32 + ((8 * c4) & 15);
            const float4 c0 = *(const float4*)tb, c1 = *(const float4*)(tb + 4), s0 = *(const float4*)(tb + 16), s1 = *(const float4*)(tb + 20);
            const float csv[8] = {c0.x, c0.y, c0.z, c0.w, c1.x, c1.y, c1.z, c1.w}, snv[8] = {s0.x, s0.y, s0.z, s0.w, s1.x, s1.y, s1.z, s1.w};
            float o[8];
#pragma unroll
            for (int e = 0; e < 8; ++e) o[e] = c4 < 2 ? xn[e] * csv[e] - ot[e] * snv[e] : ot[e] * snv[e] + xn[e] * csv[e];
            float* kf_ = a.krf() + (size_t)row * 32 + 8 * c4; *(float4*)kf_ = (float4){o[0], o[1], o[2], o[3]}; *(float4*)(kf_ + 4) = (float4){o[4], o[5], o[6], o[7]};
            float* ko = samp ? a.out + O_KRS + (size_t)b * 32 + 8 * c4 : a.out + O_KRP + (size_t)row * 32 + 8 * c4;
            *(float4*)ko = (float4){o[0], o[1], o[2], o[3]}; *(float4*)(ko + 4) = (float4){o[4], o[5], o[6], o[7]};
            if (!samp) *(bf16x8*)(a.krb() + (size_t)row * 32 + 8 * c4) = f32_to_bf8(o);
        }
    }
    (void)hd;
}
__device__ __forceinline__ void post_in_run(const MK& a, int run, int lane_in, const float* wcs) {
    int lane = lane_in; asm volatile("" : "+v"(lane));
    PinGain gn;
    {
        const int lq = lane < 48 ? lane : 0, lk = lane < 32 ? lane : 0, c4 = (lane - 32) & 3;
#pragma unroll
        for (int e = 0; e < 8; ++e) { gn.gqa[e] = a.g_q_a[8 * lq + e]; gn.gkv[e] = a.g_kv_a[8 * lk + e]; gn.gkr[e] = a.g_k_rope[8 * c4 + e]; }
        gn.dtb = a.dt_bias[lane & 7]; gn.alog = expf(a.a_log[lane & 7]);
    }
    if (run < NPT / 8) {
        const int row0 = run * 8, t0 = row0 & 2047;
        bf16x8 w0[3], w1[3], w2[3], wcur[3];
#pragma unroll
        for (int c3 = 0; c3 < 3; ++c3) {
            const bf16x8 zz = {0, 0, 0, 0, 0, 0, 0, 0}; w0[c3] = zz; w1[c3] = zz; w2[c3] = zz;
            if (t0 > 0) { const bf16_t* zp = a.Z() + (size_t)(row0 - 3) * ZW + 512 * c3 + 8 * lane; w0[c3] = *(const bf16x8*)zp; w1[c3] = *(const bf16x8*)(zp + ZW); w2[c3] = *(const bf16x8*)(zp + 2 * ZW); }
        }
        bf16x8 wnext[3]; PinTok tk, tkn;
#pragma unroll
        for (int c3 = 0; c3 < 3; ++c3) wnext[c3] = *(const bf16x8*)(a.Z() + (size_t)row0 * ZW + 512 * c3 + 8 * lane);
        tkn = pin_load(a, row0, lane);
#pragma unroll 1
        for (int k = 0; k < 8; ++k) {
            const int row = row0 + k;
#pragma unroll
            for (int c3 = 0; c3 < 3; ++c3) wcur[c3] = wnext[c3];
            tk = tkn;
            if (k < 7) {
#pragma unroll
                for (int c3 = 0; c3 < 3; ++c3) wnext[c3] = *(const bf16x8*)(a.Z() + (size_t)(row + 1) * ZW + 512 * c3 + 8 * lane);
                tkn = pin_load(a, row + 1, lane);
            }
            post_in_token(a, row, lane, wcs, w0, w1, w2, wcur, tk, gn);
#pragma unroll
            for (int c3 = 0; c3 < 3; ++c3) { w0[c3] = w1[c3]; w1[c3] = w2[c3]; w2[c3] = wcur[c3]; }
        }
    } else {
        {
            const int bsm = run - NPT / 8, row = NPT + bsm;
            bf16x8 w0[3], w1[3], w2[3], wcur[3];
#pragma unroll
            for (int c3 = 0; c3 < 3; ++c3) {
                const float* sp = a.state_conv + (size_t)bsm * 3 * 1536 + 512 * c3 + 8 * lane;
                float* cso = a.out + O_CSS + (size_t)bsm * 3 * 1536 + 512 * c3 + 8 * lane;
                float t0_[8], t1_[8], t2_[8], tc_[8];
#pragma unroll
                for (int e = 0; e < 8; ++e) { t0_[e] = sp[e]; t1_[e] = sp[1536 + e]; t2_[e] = sp[2 * 1536 + e]; }
                wcur[c3] = *(const bf16x8*)(a.Z() + (size_t)row * ZW + 512 * c3 + 8 * lane); bf8_to_f32(wcur[c3], tc_);
#pragma unroll
                for (int e = 0; e < 8; ++e) { cso[e] = t1_[e]; cso[1536 + e] = t2_[e]; cso[2 * 1536 + e] = tc_[e]; }
                w0[c3] = f32_to_bf8(t0_); w1[c3] = f32_to_bf8(t1_); w2[c3] = f32_to_bf8(t2_);
            }
            post_in_token(a, row, lane, wcs, w0, w1, w2, wcur, pin_load(a, row, lane), gn);
        }
    }
}

__device__ __forceinline__ void post_q_item(const MK& a, int idx, int lane) {
    const int row = idx >> 3, h = idx & 7;
    const float* q = a.Q() + (size_t)row * 768 + h * 96;
    float* o = a.qh() + ((size_t)row * 8 + h) * 96;
    const float v = q[lane];
    const float ss = wave_sum(v * v);
    o[lane] = v * rsqrtf(ss * (1.f / 64.f) + EPSV) * a.g_q_nope[lane];
    const float r = lane < 32 ? q[64 + lane] : 0.f;
    const float s2 = wave_sum(r * r);
    const float xn = lane < 32 ? r * rsqrtf(s2 * (1.f / 32.f) + EPSV) * a.g_q_rope[lane] : 0.f;
    const float other = __shfl_xor(xn, 16);
    const int i = lane & 15;
    const float* tb = a.ropecs() + (size_t)(row >= NPT ? 2048 : (row & 2047)) * 32;
    const float cs = tb[i], sn = tb[16 + i];
    const float ov = lane < 16 ? xn * cs - other * sn : other * sn + xn * cs;
    if (lane < 32) o[64 + lane] = ov;
}
__device__ __forceinline__ void post_kv_item(const MK& a, int idx, int lane) {
    const int row = idx >> 3, h = idx & 7;
    const float v = a.KV()[(size_t)row * 1024 + h * 128 + lane];
    const float ss = wave_sum(v * v);
    const float kn = v * rsqrtf(ss * (1.f / 64.f) + EPSV) * a.g_k_nope[lane];
    a.kh()[((size_t)row * 8 + h) * 64 + lane] = kn;
}

typedef float f32x16 __attribute__((ext_vector_type(16)));
typedef short s16x4 __attribute__((ext_vector_type(4)));
#define KST 104
#define VST 72
#define ATT_BUF (64 * KST * 2 + 64 * VST * 2)
__device__ __forceinline__ int crow32(int r, int hi) { return (r & 3) + 8 * (r >> 2) + 4 * hi; }
__device__ __forceinline__ s16x4 tr_read(const bf16_t* p) { return __builtin_bit_cast(s16x4, __builtin_amdgcn_ds_read_tr16_b64_v4i16((LAS s16x4*)(LAS void*)(unsigned)(size_t)p)); }
__device__ __forceinline__ bf16x8 pack8(const f32x16& x, int s) {
    u32x4 w; w.x = cvtpk(x[8 * s], x[8 * s + 1]); w.y = cvtpk(x[8 * s + 2], x[8 * s + 3]); w.z = cvtpk(x[8 * s + 4], x[8 * s + 5]); w.w = cvtpk(x[8 * s + 6], x[8 * s + 7]);
    return __builtin_bit_cast(bf16x8, w);
}
__device__ __forceinline__ void attn_block(const MK& a, int b, int h, int qb, char* smem) {
    const int tid = otid(), lane = tid & 63, wid = tid >> 6, r32 = lane & 31, hi = lane >> 5;
    const int qrow = qb * 256 + wid * 32 + r32;
    const int wq0 = qb * 256 + wid * 32;
    bf16x8 qf[6];
    {
        const float SCL = 0.14724445f;
        const bf16_t* Qg = a.qraw() + ((size_t)b * SEQ + qrow) * 768 + h * 96 + 8 * hi;
        float qv[6][8];
#pragma unroll
        for (int ds = 0; ds < 6; ++ds) bf8_to_f32(*(const bf16x8*)(Qg + 16 * ds), qv[ds]);
        float sn_ = 0.f, sr_ = 0.f;
#pragma unroll
        for (int j = 0; j < 8; ++j) { sn_ += qv[0][j] * qv[0][j] + qv[1][j] * qv[1][j] + qv[2][j] * qv[2][j] + qv[3][j] * qv[3][j]; sr_ += qv[4][j] * qv[4][j] + qv[5][j] * qv[5][j]; }
        sn_ = add_x32(sn_); sr_ = add_x32(sr_);
        const float rsn = rsqrtf(sn_ * (1.f / 64.f) + EPSV) * SCL, rsr = rsqrtf(sr_ * (1.f / 32.f) + EPSV);
#pragma unroll
        for (int ds = 0; ds < 4; ++ds) {
            float o[8];
#pragma unroll
            for (int j = 0; j < 8; ++j) o[j] = qv[ds][j] * rsn * a.g_q_nope[16 * ds + 8 * hi + j];
            qf[ds] = f32_to_bf8(o);
        }
        const float* tb = a.ropecs() + (size_t)qrow * 32 + 8 * hi;
        float o4[8], o5[8];
#pragma unroll
        for (int j = 0; j < 8; ++j) {
            const float x1 = qv[4][j] * rsr * a.g_q_rope[8 * hi + j], x2 = qv[5][j] * rsr * a.g_q_rope[16 + 8 * hi + j], cs = tb[j], sn = tb[16 + j];
            o4[j] = (x1 * cs - x2 * sn) * SCL; o5[j] = (x1 * sn + x2 * cs) * SCL;
        }
        qf[4] = f32_to_bf8(o4); qf[5] = f32_to_bf8(o5);
    }
    f32x16 o0, o1;
#pragma unroll
    for (int r = 0; r < 16; ++r) { o0[r] = 0.f; o1[r] = 0.f; }
    float m = 0.f, l = 0.f;
    f32x16 negm;
#pragma unroll
    for (int r = 0; r < 16; ++r) negm[r] = 0.f;
    const int nt = qb * 4 + 4;
    const int vr = tid >> 3, vc = tid & 7, rr_ = (tid >> 2) & 63, rc = tid & 3;
    const bf16_t* KVg = a.kvraw() + (size_t)b * SEQ * 1024 + h * 128 + (size_t)vr * 1024 + vc * 8;
    const bf16_t* KRg = a.krb() + (size_t)b * SEQ * 32 + (size_t)rr_ * 32 + rc * 8;
    float gk[8];
#pragma unroll
    for (int j = 0; j < 8; ++j) gk[j] = a.g_k_nope[8 * vc + j];
    bf16x8 kr0, kr1, vr0;
#define ATT_LOAD(tt) do { kr0 = *(const bf16x8*)(KVg + (size_t)(tt) * 64 * 1024); vr0 = *(const bf16x8*)(KVg + (size_t)(tt) * 64 * 1024 + 64); if (tid < 256) kr1 = *(const bf16x8*)(KRg + (size_t)(tt) * 64 * 32); } while (0)
#define ATT_STORE(buf) do { bf16_t* Ks_ = (bf16_t*)(smem + (buf) * ATT_BUF); bf16_t* Vs_ = Ks_ + 64 * KST; \
        float x_[8]; bf8_to_f32(kr0, x_); float ss_ = 0.f; _Pragma("unroll") for (int j = 0; j < 8; ++j) ss_ += x_[j] * x_[j]; \
        ss_ = sum8(ss_); const float rs_ = rsqrtf(ss_ * (1.f / 64.f) + EPSV); \
        _Pragma("unroll") for (int j = 0; j < 8; ++j) x_[j] *= rs_ * gk[j]; \
        *(bf16x8*)(Ks_ + vr * KST + vc * 8) = f32_to_bf8(x_); *(bf16x8*)(Vs_ + vr * VST + vc * 8) = vr0; \
        if (tid < 256) *(bf16x8*)(Ks_ + rr_ * KST + 64 + rc * 8) = kr1; } while (0)
    ATT_LOAD(0);
    __syncthreads();
    ATT_STORE(0);
    __syncthreads();
    const int i16 = lane & 15, qq = i16 >> 2, pp = i16 & 3, g1 = (lane >> 4) & 1;
    for (int t = 0; t < nt; ++t) {
        const bf16_t* Ks = (const bf16_t*)(smem + (t & 1) * ATT_BUF); const bf16_t* Vs = Ks + 64 * KST;
        if (t + 1 < nt) ATT_LOAD(t + 1);
        if (64 * t <= wq0 + 31) {
            f32x16 p0, p1;
#pragma unroll
            for (int ds = 0; ds < 6; ++ds) {
                const bf16x8 k0 = *(const bf16x8*)(Ks + r32 * KST + 16 * ds + 8 * hi);
                const bf16x8 k1 = *(const bf16x8*)(Ks + (32 + r32) * KST + 16 * ds + 8 * hi);
                if (ds == 0) { p0 = __builtin_amdgcn_mfma_f32_32x32x16_bf16(k0, qf[ds], negm, 0, 0, 0); p1 = __builtin_amdgcn_mfma_f32_32x32x16_bf16(k1, qf[ds], negm, 0, 0, 0); }
                else { p0 = __builtin_amdgcn_mfma_f32_32x32x16_bf16(k0, qf[ds], p0, 0, 0, 0); p1 = __builtin_amdgcn_mfma_f32_32x32x16_bf16(k1, qf[ds], p1, 0, 0, 0); }
            }
            if (64 * t + 63 > wq0) {
#pragma unroll
                for (int r = 0; r < 16; ++r) { const int kv = 64 * t + crow32(r, hi); if (kv > qrow) p0[r] = -INFINITY; if (kv + 32 > qrow) p1[r] = -INFINITY; }
            }
            float mx = fmaxf(p0[0], p1[0]);
#pragma unroll
            for (int r = 1; r < 16; ++r) mx = fmaxf(mx, fmaxf(p0[r], p1[r]));
            mx = max_x32(mx);
            const float delta = t == 0 ? mx : fmaxf(mx, 0.f);
            if (__any(delta != 0.f)) {
                m += delta;
                const float f = t == 0 ? 1.f : __builtin_amdgcn_exp2f(-delta);
#pragma unroll
                for (int r = 0; r < 16; ++r) { p0[r] -= delta; p1[r] -= delta; negm[r] = -m; o0[r] *= f; o1[r] *= f; }
                l *= f;
            }
            float rs = 0.f;
#pragma unroll
            for (int r = 0; r < 16; ++r) { p0[r] = __builtin_amdgcn_exp2f(p0[r]); p1[r] = __builtin_amdgcn_exp2f(p1[r]); rs += p0[r] + p1[r]; }
            l += rs;
            bf16x8 pf[4];
            pf[0] = pack8(p0, 0); pf[1] = pack8(p0, 1); pf[2] = pack8(p1, 0); pf[3] = pack8(p1, 1);
#pragma unroll
            for (int ks = 0; ks < 4; ++ks) {
                const bf16_t* vb0 = Vs + (16 * ks + 4 * hi + qq) * VST + 16 * g1 + 4 * pp;
                const s16x4 a0 = tr_read(vb0), a1 = tr_read(vb0 + 8 * VST);
                const s16x4 c0 = tr_read(vb0 + 32), c1 = tr_read(vb0 + 8 * VST + 32);
                const bf16x8 va = __builtin_shufflevector(a0, a1, 0, 1, 2, 3, 4, 5, 6, 7);
                const bf16x8 vc_ = __builtin_shufflevector(c0, c1, 0, 1, 2, 3, 4, 5, 6, 7);
                o0 = __builtin_amdgcn_mfma_f32_32x32x16_bf16(va, pf[ks], o0, 0, 0, 0);
                o1 = __builtin_amdgcn_mfma_f32_32x32x16_bf16(vc_, pf[ks], o1, 0, 0, 0);
            }
        }
        if (t + 1 < nt) ATT_STORE((t + 1) & 1);
        __syncthreads();
    }
    l = add_x32(l);
    const float il = 1.f / l;
    bf16_t* op = a.omix() + ((size_t)b * SEQ + qrow) * 1024 + 512 + h * 64;
#pragma unroll
    for (int g = 0; g < 4; ++g) {
        uint2 w0, w1;
        w0.x = pk2bf(o0[4 * g] * il, o0[4 * g + 1] * il); w0.y = pk2bf(o0[4 * g + 2] * il, o0[4 * g + 3] * il);
        w1.x = pk2bf(o1[4 * g] * il, o1[4 * g + 1] * il); w1.y = pk2bf(o1[4 * g + 2] * il, o1[4 * g + 3] * il);
        *(uint2*)(op + 8 * g + 4 * hi) = w0;
        *(uint2*)(op + 32 + 8 * g + 4 * hi) = w1;
    }
#undef ATT_LOAD
#undef ATT_STORE
}

__device__ __forceinline__ void gdn_unit(const MK& a, int b, int h, int dvg, const float* s0, float* sout, int row0, int T, int lane, char* wsm) {
    float (*sq)[64] = (float (*)[64])wsm;
    float (*sk)[64] = (float (*)[64])(wsm + 4096);
    float (*sv)[8] = (float (*)[8])(wsm + 8192);
    float* sg = (float*)(wsm + 8704);
    float* sb = (float*)(wsm + 8768);
    const int e = lane & 7, ko = lane >> 3, col = dvg * 8 + e;
    float S[8];
#pragma unroll
    for (int d = 0; d < 8; ++d) S[d] = s0 ? s0[(((size_t)b * 8 + h) * 64 + ko * 8 + d) * 64 + col] : 0.f;
    const size_t rbase = (size_t)row0 + (size_t)b * T;
    float pq[16], pk[16], pv0, pv1, pgb;
    {
        const int nt = T < 16 ? T : 16;
#pragma unroll
        for (int j = 0; j < 16; ++j) { const bool ok = j < nt; const size_t r = rbase + (ok ? j : 0); pq[j] = ok ? bf2f(a.qkv()[r * 1536 + h * 64 + lane]) : 0.f; pk[j] = ok ? bf2f(a.qkv()[r * 1536 + 512 + h * 64 + lane]) : 0.f; }
        { const int j0 = lane >> 3, j1 = j0 + 8; pv0 = j0 < nt ? bf2f(a.qkv()[(rbase + j0) * 1536 + 1024 + h * 64 + dvg * 8 + (lane & 7)]) : 0.f; pv1 = j1 < nt ? bf2f(a.qkv()[(rbase + j1) * 1536 + 1024 + h * 64 + dvg * 8 + (lane & 7)]) : 0.f; }
        { const int j = lane & 15; pgb = j < nt ? (lane < 16 ? a.gg()[(rbase + j) * 8 + h] : a.bb()[(rbase + j) * 8 + h]) : 0.f; }
    }
    for (int t0 = 0; t0 < T; t0 += 16) {
        const int nt = (T - t0) < 16 ? (T - t0) : 16;
        WSYNC();
#pragma unroll
        for (int j = 0; j < 16; ++j) { sq[j][lane] = pq[j]; sk[j][lane] = pk[j]; }
        sv[lane >> 3][lane & 7] = pv0; sv[(lane >> 3) + 8][lane & 7] = pv1;
        if (lane < 16) sg[lane] = expf(pgb); else if (lane < 32) sb[lane - 16] = pgb;
        WSYNC();
        if (t0 + 16 < T) {
            const size_t rb = rbase + t0 + 16;
#pragma unroll
            for (int j = 0; j < 16; ++j) { pq[j] = bf2f(a.qkv()[(rb + j) * 1536 + h * 64 + lane]); pk[j] = bf2f(a.qkv()[(rb + j) * 1536 + 512 + h * 64 + lane]); }
            pv0 = bf2f(a.qkv()[(rb + (lane >> 3)) * 1536 + 1024 + h * 64 + dvg * 8 + (lane & 7)]); pv1 = bf2f(a.qkv()[(rb + (lane >> 3) + 8) * 1536 + 1024 + h * 64 + dvg * 8 + (lane & 7)]);
            pgb = lane < 16 ? a.gg()[(rb + (lane & 15)) * 8 + h] : a.bb()[(rb + (lane & 15)) * 8 + h];
        }
        for (int j = 0; j < nt; ++j) {
            const float dec = sg[j], be = sb[j], v = sv[j][e];
            const float4 k0 = *(const float4*)&sk[j][ko * 8], k1 = *(const float4*)&sk[j][ko * 8 + 4];
            const float4 q0 = *(const float4*)&sq[j][ko * 8], q1 = *(const float4*)&sq[j][ko * 8 + 4];
            const float kk[8] = {k0.x, k0.y, k0.z, k0.w, k1.x, k1.y, k1.z, k1.w};
            const float qq[8] = {q0.x, q0.y, q0.z, q0.w, q1.x, q1.y, q1.z, q1.w};
            float ks = 0.f;
#pragma unroll
            for (int d = 0; d < 8; ++d) { S[d] *= dec; ks += kk[d] * S[d]; }
            ks += __shfl_xor(ks, 8); ks += __shfl_xor(ks, 16); ks += __shfl_xor(ks, 32);
            const float delta = (v - ks) * be;
            float ov = 0.f;
#pragma unroll
            for (int d = 0; d < 8; ++d) { S[d] += kk[d] * delta; ov += qq[d] * S[d]; }
            ov += __shfl_xor(ov, 8); ov += __shfl_xor(ov, 16); ov += __shfl_xor(ov, 32);
            if (ko == 0) a.goraw()[(rbase + t0 + j) * 512 + h * 64 + col] = ov;
        }
    }
#pragma unroll
    for (int d = 0; d < 8; ++d) sout[(((size_t)b * 8 + h) * 64 + ko * 8 + d) * 64 + col] = S[d];
}
__device__ __forceinline__ int pi_pos(int k) { return (k & 32) + 8 * ((k >> 2) & 3) + 4 * ((k >> 4) & 1) + (k & 3); }
#define GDN_WLDS 17408
__device__ __forceinline__ void gdn_prep_unit(const MK& a, int u, int lane_in, char* wsm) {
    int lane = lane_in; asm volatile("" : "+v"(lane));
    const int bh = u >> 5, n = u & 31, b = bh >> 3, h = bh & 7, i16 = lane & 15, q4 = lane >> 4;
    const size_t row0 = (size_t)b * SEQ + n * 64;
    float* AT = (float*)wsm; float* GC = (float*)(wsm + 16384); float* BT = GC + 64;
    const bf16_t* qbase = a.qkv() + row0 * 1536 + h * 64; const bf16_t* kbase = qbase + 512; const bf16_t* vbase = qbase + 1024;
    float g = a.gg()[(row0 + lane) * 8 + h];
    const float be_l = a.bb()[(row0 + lane) * 8 + h];
#pragma unroll
    for (int o = 1; o < 64; o <<= 1) { const float t = __shfl_up(g, o); if (lane >= o) g += t; }
    WSYNC();
    GC[lane] = g; BT[lane] = be_l;
    WSYNC();
    const float gl = GC[63];
    float* EG = BT + 64; float* ED = EG + 64;
    EG[lane] = expf(g); ED[lane] = expf(gl - g);
    WSYNC();
    bf16x8 kf[4][2], qf[4][2];
#pragma unroll
    for (int mt = 0; mt < 4; ++mt)
#pragma unroll
        for (int ks = 0; ks < 2; ++ks) {
            const int off = (16 * mt + i16) * 1536 + 32 * ks + 8 * q4;
            kf[mt][ks] = *(const bf16x8*)(kbase + off); qf[mt][ks] = *(const bf16x8*)(qbase + off);
        }
    bf16_t* QKg = a.gQK() + (size_t)u * 4096;
#pragma unroll
    for (int mt = 0; mt < 4; ++mt)
#pragma unroll
        for (int nt = 0; nt < 4; ++nt) {
            const int j = 16 * nt + i16, pj = 32 * (nt >> 1) + 8 * (i16 >> 2) + 4 * (nt & 1) + (i16 & 3);
            if (nt <= mt) {
                f32x4 d1 = {0.f, 0.f, 0.f, 0.f}, d2 = {0.f, 0.f, 0.f, 0.f};
#pragma unroll
                for (int ks = 0; ks < 2; ++ks) {
                    d1 = __builtin_amdgcn_mfma_f32_16x16x32_bf16(kf[mt][ks], kf[nt][ks], d1, 0, 0, 0);
                    d2 = __builtin_amdgcn_mfma_f32_16x16x32_bf16(qf[mt][ks], kf[nt][ks], d2, 0, 0, 0);
                }
                const float gcj = GC[j];
#pragma unroll
                for (int r = 0; r < 4; ++r) {
                    const int i = 16 * mt + 4 * q4 + r;
                    const float dec = __builtin_amdgcn_exp2f(1.44269504f * (GC[i] - gcj));
                    AT[i * 64 + j] = (i > j) ? BT[i] * d1[r] * dec : 0.f;
                    QKg[i * 64 + (((pj >> 3) ^ (i & 7)) << 3) + (pj & 7)] = f2bf((i >= j) ? d2[r] * dec : 0.f);
                }
            } else {
#pragma unroll
                for (int r = 0; r < 4; ++r) { const int i = 16 * mt + 4 * q4 + r; QKg[i * 64 + (((pj >> 3) ^ (i & 7)) << 3) + (pj & 7)] = 0; }
            }
        }
    {
        bf16_t* Qgg = a.gQg() + (size_t)u * 4096;
#pragma unroll
        for (int mt = 0; mt < 4; ++mt) {
            const int i = 16 * mt + i16; const float e = EG[i];
#pragma unroll
            for (int ks = 0; ks < 2; ++ks) {
                float x[8]; bf8_to_f32(qf[mt][ks], x);
                uint2 w0, w1; w0.x = cvtpk(x[0] * e, x[1] * e); w0.y = cvtpk(x[2] * e, x[3] * e); w1.x = cvtpk(x[4] * e, x[5] * e); w1.y = cvtpk(x[6] * e, x[7] * e);
                const int p0 = 32 * ks + 16 * (q4 & 1) + 4 * (q4 >> 1);
                *(uint2*)(Qgg + i * 64 + (((p0 >> 3) ^ (i & 7)) << 3) + (p0 & 7)) = w0; *(uint2*)(Qgg + i * 64 + ((((p0 >> 3) + 1) ^ (i & 7)) << 3) + (p0 & 7)) = w1;
            }
        }
    }
    WSYNC();
    __builtin_amdgcn_sched_barrier(0);
    {
        float U[64];
#pragma unroll
        for (int i = 0; i < 64; ++i) { U[i] = bf2f(vbase[i * 1536 + lane]) * BT[i]; }
#pragma unroll
        for (int i = 1; i < 64; ++i) {
            float su = 0.f;
#pragma unroll
            for (int j4 = 0; j4 < i; j4 += 4) {
                const float4 av = *(const float4*)(AT + i * 64 + j4);
                su += av.x * U[j4];
                if (j4 + 1 < i) su += av.y * U[j4 + 1];
                if (j4 + 2 < i) su += av.z * U[j4 + 2];
                if (j4 + 3 < i) su += av.w * U[j4 + 3];
            }
            U[i] -= su;
            __builtin_amdgcn_sched_barrier(0);
        }
        float* UTg = a.gUT() + ((size_t)u * 64 + lane) * 64;
#pragma unroll
        for (int i = 0; i < 64; i += 4) *(float4*)(UTg + 4 * ((i >> 2) ^ (lane & 15))) = (float4){U[i], U[i + 1], U[i + 2], U[i + 3]};
    }
    asm volatile("" ::: "memory");
    __builtin_amdgcn_sched_barrier(0);
    {
        float W[64];
#pragma unroll
        for (int i = 0; i < 64; ++i) { W[i] = bf2f(kbase[i * 1536 + lane]); }
        bf16_t* Kdg = a.gKd() + ((size_t)u * 64 + lane) * 64;
#pragma unroll
        for (int pc = 0; pc < 8; ++pc) {
            float t[8];
#pragma unroll
            for (int jj = 0; jj < 8; ++jj) { const int j = 32 * (pc >> 2) + 16 * (jj >> 2) + 4 * (pc & 3) + (jj & 3); t[jj] = W[j] * ED[j]; }
            u32x4 w; w.x = cvtpk(t[0], t[1]); w.y = cvtpk(t[2], t[3]); w.z = cvtpk(t[4], t[5]); w.w = cvtpk(t[6], t[7]);
            *(u32x4*)(Kdg + 8 * (pc ^ (lane & 7))) = w;
        }
#pragma unroll
        for (int i = 0; i < 64; ++i) W[i] *= BT[i] * EG[i];
#pragma unroll
        for (int i = 1; i < 64; ++i) {
            float sw = 0.f;
#pragma unroll
            for (int j4 = 0; j4 < i; j4 += 4) {
                const float4 av = *(const float4*)(AT + i * 64 + j4);
                sw += av.x * W[j4];
                if (j4 + 1 < i) sw += av.y * W[j4 + 1];
                if (j4 + 2 < i) sw += av.z * W[j4 + 2];
                if (j4 + 3 < i) sw += av.w * W[j4 + 3];
            }
            W[i] -= sw;
            __builtin_amdgcn_sched_barrier(0);
        }
        bf16_t* Wng = a.gWn() + (size_t)u * 4096; const int pp = pi_pos(lane);
#pragma unroll
        for (int i = 0; i < 64; ++i) Wng[i * 64 + (((pp >> 3) ^ (i & 7)) << 3) + (pp & 7)] = f2bf(-W[i]);
    }
    if (lane == 0) a.ggam()[u] = expf(gl);
}
__device__ __forceinline__ bf16x8 pack_acc2(const f32x4& x, const f32x4& y) {
    u32x4 w; w.x = cvtpk(x[0], x[1]); w.y = cvtpk(x[2], x[3]); w.z = cvtpk(y[0], y[1]); w.w = cvtpk(y[2], y[3]);
    return __builtin_bit_cast(bf16x8, w);
}
#define G2_SLOT 49152
__device__ __forceinline__ void g2_issue(const MK& a, size_t u, int n, LAS unsigned char* lds, int lw, int lane) {
    LAS unsigned char* dst = lds + (n % 3) * G2_SLOT;
    const char* srcs[4] = {(const char*)(a.gWn() + u * 4096), (const char*)(a.gQg() + u * 4096), (const char*)(a.gQK() + u * 4096), (const char*)(a.gKd() + u * 4096)};
#pragma unroll
    for (int m = 0; m < 4; ++m)
#pragma unroll
        for (int i = 0; i < 2; ++i) { const int piece = 2 * lw + i;
            __builtin_amdgcn_global_load_lds((const unsigned*)(srcs[m] + piece * 1024 + lane * 16), (LAS unsigned*)(dst + m * 8192 + piece * 1024), 16, 0, 0); }
    const char* us = (const char*)(a.gUT() + u * 4096);
#pragma unroll
    for (int i = 0; i < 4; ++i) { const int piece = 4 * lw + i;
        __builtin_amdgcn_global_load_lds((const unsigned*)(us + piece * 1024 + lane * 16), (LAS unsigned*)(dst + 32768 + piece * 1024), 16, 0, 0); }
}
__device__ __forceinline__ void gdn_scan_block(const MK& a, int bh, LAS unsigned char* lds) {
    const int tid = otid(), lane = tid & 63, wid = __builtin_amdgcn_readfirstlane(tid >> 6), i16 = lane & 15, q4 = lane >> 4;
    const int b = bh >> 3, h = bh & 7, sl = wid & 3;
    const bool loader = wid >= 4;
    f32x4 S[4];
#pragma unroll
    for (int mt = 0; mt < 4; ++mt) S[mt] = (f32x4){0.f, 0.f, 0.f, 0.f};
    __syncthreads();
    if (loader) { g2_issue(a, (size_t)bh * 32, 0, lds, wid - 4, lane); g2_issue(a, (size_t)bh * 32 + 1, 1, lds, wid - 4, lane); }
    for (int n = 0; n < 32; ++n) {
        if (loader) { if (n < 31) asm volatile("s_waitcnt vmcnt(12)" ::: "memory"); else asm volatile("s_waitcnt vmcnt(0)" ::: "memory"); }
        asm volatile("s_waitcnt lgkmcnt(0)" ::: "memory"); __builtin_amdgcn_s_barrier(); asm volatile("" ::: "memory");
        if (loader) { if (n + 2 < 32) g2_issue(a, (size_t)bh * 32 + n + 2, n + 2, lds, wid - 4, lane); }
        else {
            const LAS unsigned char* sb = lds + (n % 3) * G2_SLOT;
            const float gam = a.ggam()[(size_t)bh * 32 + n];
            bf16x8 Sb[2]; Sb[0] = pack_acc2(S[0], S[1]); Sb[1] = pack_acc2(S[2], S[3]);
            f32x4 Vn[4];
#pragma unroll
            for (int mt = 0; mt < 4; ++mt) Vn[mt] = *(const LAS f32x4*)(sb + 32768 + (16 * sl + i16) * 256 + 16 * ((4 * mt + q4) ^ i16));
#pragma unroll
            for (int mt = 0; mt < 4; ++mt)
#pragma unroll
                for (int ks = 0; ks < 2; ++ks) Vn[mt] = __builtin_amdgcn_mfma_f32_16x16x32_bf16(*(const LAS bf16x8*)(sb + (16 * mt + i16) * 128 + 16 * ((4 * ks + q4) ^ (i16 & 7))), Sb[ks], Vn[mt], 0, 0, 0);
            bf16x8 Vb[2]; Vb[0] = pack_acc2(Vn[0], Vn[1]); Vb[1] = pack_acc2(Vn[2], Vn[3]);
            f32x4 O[4];
#pragma unroll
            for (int mt = 0; mt < 4; ++mt) {
                O[mt] = (f32x4){0.f, 0.f, 0.f, 0.f};
#pragma unroll
                for (int ks = 0; ks < 2; ++ks) {
                    const int fo = (16 * mt + i16) * 128 + 16 * ((4 * ks + q4) ^ (i16 & 7));
                    O[mt] = __builtin_amdgcn_mfma_f32_16x16x32_bf16(*(const LAS bf16x8*)(sb + 8192 + fo), Sb[ks], O[mt], 0, 0, 0);
                    O[mt] = __builtin_amdgcn_mfma_f32_16x16x32_bf16(*(const LAS bf16x8*)(sb + 16384 + fo), Vb[ks], O[mt], 0, 0, 0);
                }
            }
#pragma unroll
            for (int mt = 0; mt < 4; ++mt) {
                S[mt] = S[mt] * gam;
#pragma unroll
                for (int ks = 0; ks < 2; ++ks) S[mt] = __builtin_amdgcn_mfma_f32_16x16x32_bf16(*(const LAS bf16x8*)(sb + 24576 + (16 * mt + i16) * 128 + 16 * ((4 * ks + q4) ^ (i16 & 7))), Vb[ks], S[mt], 0, 0, 0);
            }
            float* og = a.goraw() + ((size_t)b * SEQ + n * 64 + 4 * q4) * 512 + h * 64 + 16 * sl + i16;
#pragma unroll
            for (int mt = 0; mt < 4; ++mt)
#pragma unroll
                for (int r = 0; r < 4; ++r) og[(size_t)(16 * mt + r) * 512] = O[mt][r];
        }
    }
    if (!loader) {
        float* so = a.out + O_GSP + ((size_t)bh * 64 + 4 * q4) * 64 + 16 * sl + i16;
#pragma unroll
        for (int mt = 0; mt < 4; ++mt)
#pragma unroll
            for (int r = 0; r < 4; ++r) so[(size_t)(16 * mt + r) * 64] = S[mt][r];
    }
    __syncthreads();
}
__device__ __forceinline__ void gdn_out_token(const MK& a, int row, int lane) {
    const float* op = a.goraw() + (size_t)row * 512 + 8 * lane;
    const float4 x0 = *(const float4*)op, x1 = *(const float4*)(op + 4);
    float o[8] = {x0.x, x0.y, x0.z, x0.w, x1.x, x1.y, x1.z, x1.w}, zg[8];
    bf8_to_f32(*(const bf16x8*)(a.Z() + (size_t)row * ZW + OFF_Z + 8 * lane), zg);
    float ss = 0.f;
#pragma unroll
    for (int e = 0; e < 8; ++e) ss += o[e] * o[e];
    ss = sum8(ss);
    const float rs = rsqrtf(ss * (1.f / 64.f) + EPSV);
    const float4 g0 = *(const float4*)(a.g_gdn_out + 8 * (lane & 7)), g1 = *(const float4*)(a.g_gdn_out + 8 * (lane & 7) + 4);
    const float gg_[8] = {g0.x, g0.y, g0.z, g0.w, g1.x, g1.y, g1.z, g1.w};
#pragma unroll
    for (int e = 0; e < 8; ++e) o[e] = o[e] * rs * gg_[e] * zg[e] * fast_sigmoid(zg[e]);
    *(bf16x8*)(a.omix() + (size_t)row * 1024 + 8 * lane) = f32_to_bf8(o);
}

#define SSLOT 32768
#define TL_OFF (3 * SSLOT)
#define CST 264
#define KR_OFF (TL_OFF + 2 * 32 * CST * 2)
#define WQ_OFF (KR_OFF + 4 * 4096)
#define QR_OFF (WQ_OFF + 2048)
#define PG_OFF (QR_OFF + 1024)
#define PT_OFF (PG_OFF + 64)
#define AL_OFF (PT_OFF + 1024)
#define SAMP_LDS_END (AL_OFF + 64)
__device__ __forceinline__ void samp_issue(const MK& a, int g, LAS unsigned char* lds, int wid, int lane) {
    const int phys = __builtin_amdgcn_readfirstlane(((const LAS int*)(lds + PG_OFF))[g >> 2]);
    const int tok0 = (g & 3) * 32 + 4 * wid;
    const float* cs = a.cache_ckv + ((size_t)phys * 128 + tok0) * 256 + lane * 4;
#pragma unroll
    for (int i = 0; i < 4; ++i) __builtin_amdgcn_global_load_lds((const unsigned*)(cs + i * 256), (LAS unsigned*)(lds + (g % 3) * SSLOT + (4 * wid + i) * 1024), 16, 0, 0);
    if (wid < 4) __builtin_amdgcn_global_load_lds((const unsigned*)(a.cache_krope + ((size_t)phys * 128 + (g & 3) * 32 + 8 * wid) * 32 + lane * 4), (LAS unsigned*)(lds + KR_OFF + (g & 3) * 4096 + wid * 1024), 16, 0, 0);
}
__device__ __forceinline__ void samp_convert(int g, LAS unsigned char* lds, int tid) {
    const int st = tid >> 4, c16 = (tid & 15) * 16;
    const LAS float* src = (const LAS float*)(lds + (g % 3) * SSLOT) + st * 256 + c16;
    const f32x4 x0 = *(const LAS f32x4*)src, x1 = *(const LAS f32x4*)(src + 4), x2 = *(const LAS f32x4*)(src + 8), x3 = *(const LAS f32x4*)(src + 12);
    u32x4 w0, w1; w0.x = cvtpk(x0[0], x0[1]); w0.y = cvtpk(x0[2], x0[3]); w0.z = cvtpk(x1[0], x1[1]); w0.w = cvtpk(x1[2], x1[3]);
    w1.x = cvtpk(x2[0], x2[1]); w1.y = cvtpk(x2[2], x2[3]); w1.z = cvtpk(x3[0], x3[1]); w1.w = cvtpk(x3[2], x3[3]);
    LAS bf16_t* dst = (LAS bf16_t*)(lds + TL_OFF + (g & 1) * 32 * CST * 2) + st * CST + c16;
    *(LAS u32x4*)dst = w0; *(LAS u32x4*)(dst + 8) = w1;
}
#define SAMP_WAITV(n5, n4) do { if (h < 4) asm volatile("s_waitcnt vmcnt(" #n5 ")" ::: "memory"); else asm volatile("s_waitcnt vmcnt(" #n4 ")" ::: "memory"); } while (0)
#define SAMP_BAR() do { asm volatile("s_waitcnt lgkmcnt(0)" ::: "memory"); __builtin_amdgcn_s_barrier(); asm volatile("" ::: "memory"); } while (0)
__device__ __forceinline__ void samp_attn_unit(const MK& a, int u, char* smem, LAS unsigned char* lds) {
    const int tid = otid(), lane = tid & 63, h = __builtin_amdgcn_readfirstlane(tid >> 6), i16 = lane & 15, q4 = lane >> 4;
    const int b = u >> 3, sp = u & 7;
    float* WQ = (float*)(smem + WQ_OFF);
    float* QR = (float*)(smem + QR_OFF);
    int* PG = (int*)(smem + PG_OFF);
    const float SCL = 0.14724445f;
    post_q_item(a, (NPT + b) * 8 + h, lane);
    __syncthreads();
    {
        const int h_ = tid >> 6, l_ = tid & 63, q4_ = l_ >> 4, idx = l_ & 15, d = 16 * (idx >> 2) + 4 * q4_ + (idx & 3);
        WQ[tid] = a.g_k_nope[d] * a.qh()[((size_t)(NPT + b) * 8 + h_) * 96 + d] * SCL;
        if (tid < 256) QR[tid] = a.qh()[((size_t)(NPT + b) * 8 + (tid >> 5)) * 96 + 64 + (tid & 31)] * SCL;
        if (tid < 16) PG[tid] = a.page_table[b * NPAGES + sp * 16 + tid];
    }
    bf16x8 wf[4][8];
#pragma unroll
    for (int mt = 0; mt < 4; ++mt)
#pragma unroll
        for (int ks = 0; ks < 8; ++ks) wf[mt][ks] = *(const bf16x8*)(a.WknT() + (size_t)(h * 64 + 16 * mt + i16) * 256 + 32 * ks + 8 * q4);
#pragma unroll
    for (int mt = 0; mt < 4; ++mt)
#pragma unroll
        for (int ks = 0; ks < 8; ++ks) asm volatile("" : "+v"(wf[mt][ks]));
    __syncthreads();
    samp_issue(a, 0, lds, h, lane); samp_issue(a, 1, lds, h, lane); samp_issue(a, 2, lds, h, lane);
    SAMP_WAITV(10, 8);
    SAMP_BAR();
    samp_convert(0, lds, tid);
    const LAS float* QRl = (const LAS float*)(lds + QR_OFF) + h * 32 + 8 * q4;
    const LAS float* WQl = (const LAS float*)(lds + WQ_OFF) + (h * 4 + q4) * 16;
    float m = -INFINITY, lsum = 0.f;
    f32x4 latv[2]; latv[0] = (f32x4){0.f, 0.f, 0.f, 0.f}; latv[1] = (f32x4){0.f, 0.f, 0.f, 0.f};
    for (int g = 0; g < 64; ++g) {
        SAMP_BAR();
        if (g + 3 < 64) samp_issue(a, g + 3, lds, h, lane);
        const LAS bf16_t* Tl = (const LAS bf16_t*)(lds + TL_OFF + (g & 1) * 32 * CST * 2); const LAS float* KR = (const LAS float*)(lds + KR_OFF + (g & 3) * 4096);
        float scv;
        {
            float ssp[2], dotp[2], rdp[2];
            f32x4 acc[2][4];
#pragma unroll
            for (int hf = 0; hf < 2; ++hf)
#pragma unroll
                for (int mt = 0; mt < 4; ++mt) acc[hf][mt] = (f32x4){0.f, 0.f, 0.f, 0.f};
            const LAS bf16_t* cp0 = Tl + i16 * CST + 8 * q4; const LAS bf16_t* cp1 = cp0 + 16 * CST;
            bf16x8 c0 = *(const LAS bf16x8*)cp0, c1 = *(const LAS bf16x8*)cp1;
#pragma unroll
            for (int ks = 0; ks < 8; ++ks) {
                bf16x8 n0 = c0, n1 = c1;
                if (ks < 7) { n0 = *(const LAS bf16x8*)(cp0 + 32 * (ks + 1)); n1 = *(const LAS bf16x8*)(cp1 + 32 * (ks + 1)); }
#pragma unroll
                for (int mt = 0; mt < 4; ++mt) { acc[0][mt] = __builtin_amdgcn_mfma_f32_16x16x32_bf16(wf[mt][ks], c0, acc[0][mt], 0, 0, 0); acc[1][mt] = __builtin_amdgcn_mfma_f32_16x16x32_bf16(wf[mt][ks], c1, acc[1][mt], 0, 0, 0); }
                c0 = n0; c1 = n1;
            }
#pragma unroll
            for (int hf = 0; hf < 2; ++hf) {
                f32x2_t ss2 = {0.f, 0.f}, dot2 = {0.f, 0.f}, rd2 = {0.f, 0.f};
#pragma unroll
                for (int mt = 0; mt < 4; ++mt) {
                    const f32x4 wq = *(const LAS f32x4*)(WQl + 4 * mt);
                    const f32x4 av = acc[hf][mt];
                    const f32x2_t lo = __builtin_shufflevector(av, av, 0, 1), hi = __builtin_shufflevector(av, av, 2, 3);
                    ss2 = __builtin_elementwise_fma(lo, lo, ss2); ss2 = __builtin_elementwise_fma(hi, hi, ss2);
                    dot2 = __builtin_elementwise_fma(lo, __builtin_shufflevector(wq, wq, 0, 1), dot2); dot2 = __builtin_elementwise_fma(hi, __builtin_shufflevector(wq, wq, 2, 3), dot2);
                }
                {
                    const LAS float* kp = KR + (16 * hf + i16) * 32 + 8 * q4;
                    const f32x4 k0 = *(const LAS f32x4*)kp, k1 = *(const LAS f32x4*)(kp + 4), q0 = *(const LAS f32x4*)QRl, q1 = *(const LAS f32x4*)(QRl + 4);
                    rd2 = __builtin_elementwise_fma(__builtin_shufflevector(k0, k0, 0, 1), __builtin_shufflevector(q0, q0, 0, 1), rd2); rd2 = __builtin_elementwise_fma(__builtin_shufflevector(k0, k0, 2, 3), __builtin_shufflevector(q0, q0, 2, 3), rd2);
                    rd2 = __builtin_elementwise_fma(__builtin_shufflevector(k1, k1, 0, 1), __builtin_shufflevector(q1, q1, 0, 1), rd2); rd2 = __builtin_elementwise_fma(__builtin_shufflevector(k1, k1, 2, 3), __builtin_shufflevector(q1, q1, 2, 3), rd2);
                }
                ssp[hf] = ss2[0] + ss2[1]; dotp[hf] = dot2[0] + dot2[1]; rdp[hf] = rd2[0] + rd2[1];
            }
            const auto s1 = __builtin_amdgcn_permlane16_swap(__float_as_uint(ssp[0]), __float_as_uint(ssp[1]), false, false);
            const auto s2 = __builtin_amdgcn_permlane16_swap(__float_as_uint(dotp[0]), __float_as_uint(dotp[1]), false, false);
            const auto s3 = __builtin_amdgcn_permlane16_swap(__float_as_uint(rdp[0]), __float_as_uint(rdp[1]), false, false);
            const float u1 = __uint_as_float(s1[0]) + __uint_as_float(s1[1]), u2 = __uint_as_float(s2[0]) + __uint_as_float(s2[1]), u3 = __uint_as_float(s3[0]) + __uint_as_float(s3[1]);
            const auto t1 = __builtin_amdgcn_permlane32_swap(__float_as_uint(u1), __float_as_uint(u2), false, false);
            const float t = __uint_as_float(t1[0]) + __uint_as_float(t1[1]);
            const auto t2 = __builtin_amdgcn_permlane32_swap(__float_as_uint(t), __float_as_uint(t), false, false);
            const float ssv = __uint_as_float(t2[0]), dotv = __uint_as_float(t2[1]);
            const float rdv = add_x32(u3);
            scv = dotv * rsqrtf(ssv * (1.f / 64.f) + EPSV) + rdv;
        }
        float gm = max16(scv);
        { const auto r = __builtin_amdgcn_permlane16_swap(__float_as_uint(gm), __float_as_uint(gm), false, false); gm = fmaxf(__uint_as_float(r[0]), __uint_as_float(r[1])); }
        const float mn = fmaxf(m, gm);
        const float alpha = __builtin_amdgcn_exp2f(m - mn), pv = __builtin_amdgcn_exp2f(scv - mn);
        m = mn;
        lsum = lsum * alpha + pv;
        if (q4 < 2) { ((LAS float*)(lds + PT_OFF))[h * 32 + lane] = pv; if (lane == 0) ((LAS float*)(lds + AL_OFF))[h] = alpha; }
        if (g <= 60) SAMP_WAITV(10, 8); else if (g == 61) SAMP_WAITV(5, 4); else SAMP_WAITV(0, 0);
        SAMP_BAR();
        {
            u32x4 pw = {0u, 0u, 0u, 0u};
            if (i16 < 8) { const f32x4 pa = *(const LAS f32x4*)(lds + PT_OFF + (i16 * 32 + 8 * q4) * 4), pb_ = *(const LAS f32x4*)(lds + PT_OFF + (i16 * 32 + 8 * q4 + 4) * 4);
                pw.x = cvtpk(pa[0], pa[1]); pw.y = cvtpk(pa[2], pa[3]); pw.z = cvtpk(pb_[0], pb_[1]); pw.w = cvtpk(pb_[2], pb_[3]); }
            const bf16x8 pfr = __builtin_bit_cast(bf16x8, pw);
            const f32x4 al = *(const LAS f32x4*)(lds + AL_OFF + (q4 & 1) * 16);
            const unsigned tb0 = (unsigned)(size_t)((const LAS bf16_t*)(lds + TL_OFF + (g & 1) * 32 * CST * 2) + (8 * q4 + (i16 >> 2)) * CST + 32 * h + 4 * (i16 & 3));
            s16x4 c0[2], c1[2];
            static_assert(4 * CST * 2 == 2112, "tr offsets");
            asm volatile("ds_read_b64_tr_b16 %0, %4\n\tds_read_b64_tr_b16 %1, %4 offset:2112\n\tds_read_b64_tr_b16 %2, %4 offset:32\n\tds_read_b64_tr_b16 %3, %4 offset:2144\n\ts_waitcnt lgkmcnt(0)"
                         : "=&v"(c0[0]), "=&v"(c1[0]), "=&v"(c0[1]), "=&v"(c1[1]) : "v"(tb0) : "memory");
#pragma unroll
            for (int nt = 0; nt < 2; ++nt) {
                const bf16x8 cfr = __builtin_shufflevector(c0[nt], c1[nt], 0, 1, 2, 3, 4, 5, 6, 7);
                latv[nt] = latv[nt] * al;
                latv[nt] = __builtin_amdgcn_mfma_f32_16x16x32_bf16(pfr, cfr, latv[nt], 0, 0, 0);
            }
        }
        if (g + 1 < 64) samp_convert(g + 1, lds, tid);
    }
    lsum = add_x16(sum16(lsum));
    if (lane == 0) { float* o = a.part() + ((size_t)u * 8 + h) * 260; o[0] = m * 0.69314718f; o[1] = lsum; }
    if (q4 < 2) {
#pragma unroll
        for (int nt = 0; nt < 2; ++nt)
#pragma unroll
            for (int r = 0; r < 4; ++r) a.part()[((size_t)u * 8 + 4 * q4 + r) * 260 + 4 + 32 * h + 16 * nt + i16] = latv[nt][r];
    }
}
__device__ __forceinline__ void samp_comb_unit(const MK& a, int u, char* smem) {
    float* slat = (float*)smem;
    const int b = u >> 3, h = u & 7, tid = otid() & 255;
    const size_t row = NPT + b;
    const float* q = a.qh() + (row * 8 + h) * 96;
    float s_self = 0.f;
    for (int d = 0; d < 64; ++d) s_self += q[d] * a.kh()[(row * 8 + h) * 64 + d];
    for (int d = 0; d < 32; ++d) s_self += q[64 + d] * a.krf()[row * 32 + d];
    s_self *= 0.10206207261596577f;
    float m = s_self;
    for (int s = 0; s < 8; ++s) m = fmaxf(m, a.part()[((size_t)(b * 8 + s) * 8 + h) * 260]);
    const float pself = expf(s_self - m);
    float l = pself, lat = 0.f;
    for (int s = 0; s < 8; ++s) {
        const float* p = a.part() + ((size_t)(b * 8 + s) * 8 + h) * 260;
        const float w = expf(p[0] - m);
        l += p[1] * w; lat += p[4 + tid] * w;
    }
    __syncthreads();
    slat[tid] = lat;
    __syncthreads();
    if (tid < 64) {
        float o = 0.f;
        for (int c = 0; c < 256; ++c) o += slat[c] * a.w_kv_b[(size_t)c * 1024 + h * 128 + 64 + tid];
        o += pself * a.KV()[row * 1024 + h * 128 + 64 + tid];
        a.omix()[row * 1024 + 512 + h * 64 + tid] = f2bf(o / l);
    }
}

#define XB_TMO      128
#define XB_XCNT(j)  (256  + 64 * (j))
#define XB_XSUB(j)  (1280 + 64 * (j))
#define XB_XGEN(j)  (2304 + 64 * (j))
#define XB_TOP      3328
#define XB_TOPGEN   3392
#define XCD_BAR_WORDS 3456
#define XB_SPIN_CAP (1u << 18)

__device__ __forceinline__ unsigned xb_ld(unsigned* p)              { return __hip_atomic_load(p, __ATOMIC_RELAXED, __HIP_MEMORY_SCOPE_AGENT); }
__device__ __forceinline__ unsigned xb_add(unsigned* p, unsigned v) { return __hip_atomic_fetch_add(p, v, __ATOMIC_RELAXED, __HIP_MEMORY_SCOPE_AGENT); }
__device__ __forceinline__ unsigned xb_xcc_id() { return (unsigned)__builtin_amdgcn_s_getreg((3 << 11) | 20) & 0xFu; }
#define XB_SPIN(cond, bar) do { unsigned _sp = 0; while (cond) { __builtin_amdgcn_s_sleep(1); \
    if ((++_sp & 255u) == 0u) { if (xb_ld(&(bar)[XB_TMO])) break; if (_sp > XB_SPIN_CAP) { atomicAdd(&(bar)[XB_TMO], 1u); break; } } } } while (0)

struct XcdBarrier {
    unsigned* bar; unsigned x;
    volatile LAS unsigned* st;
};

__device__ __forceinline__ XcdBarrier xcd_barrier_post(unsigned* bar, volatile LAS unsigned* st) {
    XcdBarrier b; b.bar = bar; b.x = xb_xcc_id(); b.st = st;
    if (threadIdx.x == 0) (void)xb_add(&bar[XB_XCNT(b.x)], 1u);
    return b;
}
__device__ __forceinline__ void xcd_barrier_complete(unsigned* bar, unsigned x, unsigned& nloc, unsigned& nx) {
    const unsigned G = gridDim.x * gridDim.y * gridDim.z;
    unsigned sum, cnt, mine, sp = 0u;
    for (;;) {
        sum = 0u; cnt = 0u; mine = 0u;
#pragma unroll
        for (unsigned j = 0; j < 16; ++j) { const unsigned c = xb_ld(&bar[XB_XCNT(j)]); sum += c; cnt += (c > 0u) ? 1u : 0u; mine = (j == x) ? c : mine; }
        if (sum == G) break;
        __builtin_amdgcn_s_sleep(1);
        if ((++sp & 255u) == 0u) { if (xb_ld(&bar[XB_TMO])) break; if (sp > XB_SPIN_CAP) { atomicAdd(&bar[XB_TMO], 1u); break; } }
    }
    nloc = mine > 0u ? mine : 1u; nx = cnt > 0u ? cnt : 1u;
}

__device__ __forceinline__ void xcd_barrier(const XcdBarrier& b) {
    asm volatile("s_waitcnt vmcnt(0)" ::: "memory");
    __syncthreads();
    if (threadIdx.x == 0) {
        unsigned* bar = b.bar;
        __builtin_amdgcn_s_waitcnt(0);
        unsigned nloc = b.st[0], nx = b.st[1];
        if (nloc == 0u) { xcd_barrier_complete(bar, b.x, nloc, nx); b.st[0] = nloc; b.st[1] = nx; }
        const unsigned old = xb_add(&bar[XB_XSUB(b.x)], 1u);
        const unsigned gen = old / nloc;
        if (old + 1u == (gen + 1u) * nloc) {
            __builtin_amdgcn_fence(__ATOMIC_RELEASE, "agent");
            asm volatile("s_waitcnt vmcnt(0)" ::: "memory");
            const unsigned og = xb_add(&bar[XB_TOP], 1u);
            const unsigned tg = og / nx;
            if (og + 1u == (tg + 1u) * nx) xb_add(&bar[XB_TOPGEN], 1u);
            else XB_SPIN(xb_ld(&bar[XB_TOPGEN]) == tg, bar);
            __builtin_amdgcn_fence(__ATOMIC_ACQUIRE, "agent");
            xb_add(&bar[XB_XGEN(b.x)], 1u);
            asm volatile("s_waitcnt vmcnt(0)" ::: "memory");
        } else {
            XB_SPIN(xb_ld(&bar[XB_XGEN(b.x)]) == gen, bar);
            __builtin_amdgcn_fence(__ATOMIC_ACQUIRE, "agent");
            asm volatile("s_waitcnt vmcnt(0)" ::: "memory");
        }
    }
    __syncthreads();
}

__device__ __forceinline__ void late_weight_items(const MK& a, int gwl, int ngwl, float* scr, int lane) {
    const int T4 = 32 * 16, T5 = 176 * 16, T7 = 32 * 44, T8 = 32 * 16, TT = T4 + T5 + T7 + T8;
    for (int it = gwl; it < TT; it += ngwl) {
        int r = it;
        if (r < T4) { const int nt_ = r % 32, kb = r / 32; wt_item(a.w_o, 1024, 32 * nt_, 32, a.WoT(), 1024, 32 * nt_, 64 * kb, scr, lane); continue; } r -= T4;
        if (r < T5) { const int nt_ = r % 176, kb = r / 176, pn = nt_ >> 3, wi = nt_ & 7;
            wt_item(wi < 4 ? a.w_gate : a.w_up, DFF, pn * 128 + (wi & 3) * 32, 32, a.WguT(), 1024, 32 * nt_, 64 * kb, scr, lane); continue; } r -= T5;
        if (r < T7) { const int nt_ = r % 32, kb = r / 32; wt_item(a.w_down, 1024, 32 * nt_, 32, a.WdT(), DFF, 32 * nt_, 64 * kb, scr, lane); continue; } r -= T7;
        { const int nt_ = r % 32, kb = r / 32; wt_item(a.w_ple_gate, 1024, 32 * nt_, 32, a.WpgT(), 1024, 32 * nt_, 64 * kb, scr, lane); }
    }
}

#define XB_ST_OFF 155648
#define LDS_BYTES 155904
static_assert(SAMP_LDS_END <= LDS_BYTES, "LDS map");
#define GSYNC() do { xcd_barrier(xbar); } while (0)
__global__ __launch_bounds__(NTHR, 2) void mega(MK a) {
    cg::grid_group grid = cg::this_grid();
    char* smem = (char*)lds_raw;
    LAS unsigned char* lds = (LAS unsigned char*)lds_raw;
    otid_init();
    if (threadIdx.x < 2) ((LAS unsigned*)(lds_raw + XB_ST_OFF))[threadIdx.x] = 0u;
    __syncthreads();
    const XcdBarrier xbar = xcd_barrier_post(a.ctl(), (volatile LAS unsigned*)(LAS void*)(lds_raw + XB_ST_OFF));
    const int bid = blockIdx.x, nb = gridDim.x, ngw = nb * NWAVE;
#define LOCAL_IDS const int tid = otid(), lane = tid & 63, wid = tid >> 6, half = tid >> 8, gw = bid * NWAVE + wid; (void)lane; (void)half; (void)gw; (void)wid;

    {
    LOCAL_IDS
    {
        const int T0 = 88 * 16, T1 = 24 * 6, T2 = 32 * 4, T3 = 16 * 4, T9 = 32 * 4;
        const int TT = T0 + T1 + T2 + T3 + T9;
        float* scr = (float*)(smem + wid * 8704);
        for (int it = gw; it < TT; it += ngw) {
            int r = it;
            if (r < T0) { const int nt_ = r % 88, kb = r / 88, nv = 2736 - 32 * nt_; wt_item(a.w_in, 2736, 32 * nt_, nv < 0 ? 0 : (nv > 32 ? 32 : nv), a.WinT(), 1024, 32 * nt_, 64 * kb, scr, lane); continue; } r -= T0;
            if (r < T1) { const int nt_ = r % 24, kb = r / 24; wt_item(a.w_q_b, 768, 32 * nt_, 32, a.WqbT(), 384, 32 * nt_, 64 * kb, scr, lane); continue; } r -= T1;
            if (r < T2) { const int nt_ = r % 32, kb = r / 32; wt_item(a.w_kv_b, 1024, 32 * nt_, 32, a.WkvT(), 256, 32 * nt_, 64 * kb, scr, lane); continue; } r -= T2;
            if (r < T3) { const int nt_ = r % 16, kb = r / 16, h = nt_ >> 1; wt_item(a.w_kv_b, 1024, h * 128 + 32 * (nt_ & 1), 32, a.WknT(), 256, 32 * nt_, 64 * kb, scr, lane); continue; } r -= T3;
            { const int nt_ = r % 32, kb = r / 32; wt_item(a.w_ple_proj, 1024, 32 * nt_, 32, a.WppT(), 256, 32 * nt_, 64 * kb, scr, lane); }
        }
        for (int e = (bid * NTHR + tid); e < 2049 * 16; e += nb * NTHR) {
            const int pos = e >> 4, i = e & 15; const float ang = (pos == 2048 ? (float)PAST : (float)pos) * powf(10000.f, -(float)i / 16.f);
            a.ropecs()[pos * 32 + i] = cosf(ang); a.ropecs()[pos * 32 + 16 + i] = sinf(ang);
        }
        for (int row = gw; row < MPAD; row += ngw) {
            const float* src = row < NPT ? a.x_prompt + (size_t)row * 1024 : a.x_sample + (size_t)(row < NTOK ? row - NPT : 0) * 1024;
            rms1024_row(src, a.g_attn, a.xn() + (size_t)row * 1024, row >= NTOK, lane);
            ushort4 w = {0, 0, 0, 0};
            if (row < NTOK) { const float* ps = row < NPT ? a.p_prompt + (size_t)row * 256 : a.p_sample + (size_t)(row - NPT) * 256; const float4 v = *(const float4*)(ps + lane * 4); w.x = f2bf(v.x); w.y = f2bf(v.y); w.z = f2bf(v.z); w.w = f2bf(v.w); }
            *(ushort4*)(a.pb() + (size_t)row * 256 + lane * 4) = w;
            if (row >= NTOK) { for (int j = 0; j < 4; ++j) { ushort4 z = {0, 0, 0, 0}; *(ushort4*)(a.omix() + (size_t)row * 1024 + lane * 4 + 256 * j) = z; } }
        }
    }
    }
    if (a.out == nullptr) grid.sync();
    GSYNC();
    {
    LOCAL_IDS
    pg_gemm(lds, a.xn(), a.WinT(), NPT, ZW, 1024, PgBf16{a.Z(), ZW});
    gemm_sample_rows_ks<false>(a.xn(), 1024, a.WinT(), 1024, ZW, EwBf16{a.Z(), ZW}, smem, bid, nb);
    }
    GSYNC();
    {
    LOCAL_IDS
    for (int e = tid; e < 4 * 1536 / 4; e += NTHR) ((float4*)smem)[e] = ((const float4*)a.w_conv)[e];
    __syncthreads();
    for (int run = gw; run < NPT / 8 + NST; run += ngw) post_in_run(a, run, lane, (const float*)smem);
    }
    GSYNC();
    {
    LOCAL_IDS
    for (int u = gw; u < 2048; u += ngw) gdn_prep_unit(a, u, lane, smem + wid * GDN_WLDS);
    }
    {
    LOCAL_IDS
    for (int v = gw; v < NST * 64; v += ngw) gdn_unit(a, v >> 6, (v >> 3) & 7, v & 7, a.state_gdn, a.out + O_GSS, NPT, 1, lane, smem + wid * GDN_WLDS);
    __syncthreads();
    }
    GSYNC();
    {
    LOCAL_IDS
    pg_gemm(lds, a.qan(), a.WqbT(), NPT, 768, 384, PgBf16{a.qraw(), 768});
    pg_gemm(lds, a.ckvb(), a.WkvT(), NPT, 1024, 256, PgBf16{a.kvraw(), 1024}, nb > 64 ? nb - 64 : 0);
    gemm_sample_rows<false>(a.qan(), 384, a.WqbT(), 384, 768, EwF32{a.Q(), 768}, smem, bid, nb, 64);
    gemm_sample_rows<false>(a.ckvb(), 256, a.WkvT(), 256, 1024, EwF32{a.KV(), 1024}, smem, bid, nb, 72);
    for (int bh_ = nb - 1 - bid; bh_ < 64; bh_ += nb) gdn_scan_block(a, bh_, lds);
    if (nb > 64 && bid < nb - 64) {
        pg_gemm(lds, a.pb(), a.WppT(), NPT, 1024, 256, PgBf16{a.PP(), 1024}, nb - 64);
        __syncthreads();
        late_weight_items(a, bid * NWAVE + wid, (nb - 64) * NWAVE, (float*)(smem + wid * 8704), lane);
    } else if (nb <= 64) { pg_gemm(lds, a.pb(), a.WppT(), NPT, 1024, 256, PgBf16{a.PP(), 1024}); __syncthreads(); late_weight_items(a, gw, ngw, (float*)(smem + wid * 8704), lane); }
    gemm_sample_rows<false>(a.pb(), 256, a.WppT(), 256, 1024, EwBf16{a.PP(), 1024}, smem, bid, nb, 80);
    }
    GSYNC();
    {
    LOCAL_IDS
    for (int idx = gw; idx < NST * 8; idx += ngw) { post_q_item(a, NPT * 8 + idx, lane); post_kv_item(a, NPT * 8 + idx, lane); }
    for (int row = gw; row < NTOK; row += ngw) gdn_out_token(a, row, lane);
    for (int pr = bid; pr < 256; pr += nb) { const int bh_ = pr >> 2, s_ = pr & 3; attn_block(a, bh_ >> 3, bh_ & 7, 7 - s_, smem); attn_block(a, bh_ >> 3, bh_ & 7, s_, smem); }
    for (int u = bid; u < NST * 8; u += nb) samp_attn_unit(a, u, smem, lds);
    }
    GSYNC();
    {
    LOCAL_IDS
    for (int u0 = bid * 2; u0 < NST * 8; u0 += nb * 2) samp_comb_unit(a, u0 + half, smem + half * 4096);
    }
    GSYNC();
    {
    LOCAL_IDS
    pg_gemm(lds, a.omix(), a.WoT(), NPT, 1024, 1024, PgResXB{a.x_prompt, a.H()});
    gemm_sample_rows_ks<false>(a.omix(), 1024, a.WoT(), 1024, 1024, EwResX{a.x_sample, a.H()}, smem, bid, nb);
    }
    GSYNC();
    {
    LOCAL_IDS
    for (int row = gw; row < MPAD; row += ngw) rms1024_row_b(a.H() + (size_t)row * 1024, a.g_ffn, a.un() + (size_t)row * 1024, row >= NTOK, lane);
    }
    GSYNC();
    {
    LOCAL_IDS
    pg_gemm(lds, a.un(), a.WguT(), NPT, 2 * DFF, 1024, PgSwiglu{a.hid()});
    gemm_sample_rows_ks<true>(a.un(), 1024, a.WguT(), 1024, 2 * DFF, EwBf16{a.hid(), DFF}, smem, bid, nb);
    }
    GSYNC();
    {
    LOCAL_IDS
    pg_gemm(lds, a.hid(), a.WdT(), NPT, 1024, DFF, PgResBB{a.H(), a.H2()});
    gemm_sample_rows_ks<false>(a.hid(), DFF, a.WdT(), DFF, 1024, EwResH{a.H(), a.H2()}, smem, bid, nb);
    }
    GSYNC();
    {
    LOCAL_IDS
    for (int row = gw; row < MPAD; row += ngw) rms1024_row_b(a.H2() + (size_t)row * 1024, a.g_ple, a.un2() + (size_t)row * 1024, row >= NTOK, lane);
    }
    GSYNC();
    {
    LOCAL_IDS
    pg_gemm(lds, a.un2(), a.WpgT(), NPT, 1024, 1024, PgPleB{a.H2(), a.PP(), a.out});
    gemm_sample_rows_ks<false>(a.un2(), 1024, a.WpgT(), 1024, 1024, EwPle{a.H2(), a.PP(), a.out}, smem, bid, nb);
    }
}

static inline char* carve(char*& p, size_t bytes) { char* r = p; p += (bytes + 255) & ~(size_t)255; return r; }

extern "C" void kernel_launch(void* const* d_in, const int* in_sizes, int n_in, void* d_out, int out_size, void* d_ws, size_t ws_size, hipStream_t stream) {
    MK a{};
    a.x_prompt = (const float*)d_in[0]; a.x_sample = (const float*)d_in[1]; a.cache_ckv = (const float*)d_in[2]; a.cache_krope = (const float*)d_in[3];
    a.state_gdn = (const float*)d_in[4]; a.state_conv = (const float*)d_in[5]; a.page_table = (const int*)d_in[6]; a.p_prompt = (const float*)d_in[7]; a.p_sample = (const float*)d_in[8];
    a.g_attn = (const float*)d_in[9]; a.w_in = (const float*)d_in[10]; a.w_conv = (const float*)d_in[11]; a.a_log = (const float*)d_in[12]; a.dt_bias = (const float*)d_in[13];
    a.g_gdn_out = (const float*)d_in[14]; a.g_q_a = (const float*)d_in[15]; a.w_q_b = (const float*)d_in[16]; a.g_q_nope = (const float*)d_in[17]; a.g_q_rope = (const float*)d_in[18];
    a.g_kv_a = (const float*)d_in[19]; a.g_k_rope = (const float*)d_in[20]; a.w_kv_b = (const float*)d_in[21]; a.g_k_nope = (const float*)d_in[22]; a.w_o = (const float*)d_in[23];
    a.g_ffn = (const float*)d_in[24]; a.w_gate = (const float*)d_in[25]; a.w_up = (const float*)d_in[26]; a.w_down = (const float*)d_in[27]; a.g_ple = (const float*)d_in[28];
    a.w_ple_gate = (const float*)d_in[29]; a.w_ple_proj = (const float*)d_in[30];
    a.out = (float*)d_out;
    a.ws = (char*)d_ws;
    if (WS_TOTAL > ws_size) { fprintf(stderr, "kernel_launch: workspace too small: need %zu have %zu\n", (size_t)WS_TOTAL, ws_size); return; }

    static int grid_blocks = 0;
    if (!grid_blocks) {
        int dev = 0, cus = 0, per_cu = 0;
        (void)hipGetDevice(&dev);
        (void)hipDeviceGetAttribute(&cus, hipDeviceAttributeMultiprocessorCount, dev);
        (void)hipFuncSetAttribute((const void*)mega, hipFuncAttributeMaxDynamicSharedMemorySize, LDS_BYTES);
        (void)hipOccupancyMaxActiveBlocksPerMultiprocessor(&per_cu, (const void*)mega, NTHR, LDS_BYTES);
        if (per_cu < 1) fprintf(stderr, "kernel_launch: occupancy query says %d blocks/CU\n", per_cu);
        grid_blocks = cus;
    }
    (void)hipMemsetAsync((char*)d_ws + WOF_ctl, 0, 16384, stream);
    void* args[] = {&a};
    hipError_t e = hipLaunchCooperativeKernel((const void*)mega, dim3(grid_blocks), dim3(NTHR), args, LDS_BYTES, stream);
    if (e != hipSuccess) fprintf(stderr, "cooperative launch failed: %s (grid %d)\n", hipGetErrorString(e), grid_blocks);
}
```

```cpp
#include <hip/hip_runtime.h>
#include <stdint.h>
#include <cstdio>
#include <hip/hip_cooperative_groups.h>
namespace cg = cooperative_groups;


__device__ __forceinline__ int otid();
#define PG8_TID() otid()
namespace pg8 {
#define PG8_LAS __attribute__((address_space(3)))
typedef unsigned short bf16_t;
typedef short bf16x8 __attribute__((ext_vector_type(8)));
typedef float f32x4 __attribute__((ext_vector_type(4)));
typedef unsigned u32x4 __attribute__((ext_vector_type(4)));
constexpr int BM = 256, BK = 64, HALF = 128, HTB = HALF * BK * 2  , STAGE_BYTES = 8 * HTB, NXCD = 8, WGM = 8;

__host__ __device__ __forceinline__ int lds_byte(int r, int c) { const int st = (r >> 4) * 2 + (c >> 5), rr = r & 15, cc = c & 31, ob = rr * 64 + cc * 2; return st * 1024 + (ob ^ (((ob >> 9) & 1) << 5)); }
__host__ __device__ __forceinline__ void stage_rc(int b, int& R, int& C) { const int st = b / 1024, sb = b % 1024, swz = sb ^ (((sb >> 9) & 1) << 5); R = (st >> 1) * 16 + swz / 64; C = (st & 1) * 32 + (swz % 64) / 2; }
__host__ __device__ __forceinline__ int perm32(int rho) { const int n = rho >> 4, i = rho & 15; return 8 * (i >> 2) + 4 * n + (i & 3); }

struct Unit { int pm, pn; };
struct Gemm { const bf16_t* A; const bf16_t* Bt; int M, N, K; };

struct StaticOrder {
    int nM, nN, nwg, G, c;
    __host__ __device__ void init(int M, int N, int G_, int c_) { nM = M / BM; nN = N / BM; nwg = nM * nN; G = G_; c = c_; }
    __host__ __device__ bool next(int i, Unit& u) const {
        const long L = (long)i * G + c; if (L >= nwg) return false;
        int wgid = (int)L; { const int q = nwg / NXCD, r = nwg % NXCD, xcd = wgid % NXCD, off = wgid / NXCD; wgid = (xcd < r ? xcd * (q + 1) : r * (q + 1) + (xcd - r) * q) + off; }
        const int nig = WGM * nN, gid = wgid / nig, fm = gid * WGM, gsz = (nM - fm) < WGM ? (nM - fm) : WGM;
        u.pm = fm + ((wgid % nig) % gsz); u.pn = (wgid % nig) / gsz; return true;
    }
    __device__ __forceinline__ void a_ready(const Unit&) const {}
    __device__ __forceinline__ void done(const Unit&) const {}
};

template <class Epi, class Sched, bool ALIGN_EPI = false, bool SP2 = false>
__device__ __forceinline__ void gemm_phase(PG8_LAS unsigned char* lds, const Gemm g, const Sched& S, const Epi& E) {
    const int tid = PG8_TID(), wid = __builtin_amdgcn_readfirstlane(tid >> 6), lane = tid & 63, wr = wid >> 2, wc = wid & 3, fr = lane & 15, fq = lane >> 4;
    const int K = g.K, nt = K / BK;
    unsigned voffA[2], voffB[2];
#pragma unroll
    for (int i = 0; i < 2; ++i) { int R, C; stage_rc(tid * 16 + i * 8192, R, C); const int Rb = Epi::PERM ? ((R & ~31) + perm32(R & 31)) : R;
        voffA[i] = (unsigned)(R * K + C) * 2u; voffB[i] = (unsigned)(Rb * K + C) * 2u; }
    const size_t kstep = (size_t)(BK * 2);
    const size_t hstep = (size_t)HALF * K * 2;
    const size_t tstep = 2 * hstep;
    const unsigned ldsw = (unsigned)wid * 1024u;
    const int aoff = lds_byte(wr * 64 + fr, fq * 8), boff = lds_byte(wc * 32 + fr, fq * 8);
#define PG8_SA(b, h) (((b) * 2 + (h)) * HTB)
#define PG8_SB(b, h) ((4 + (b) * 2 + (h)) * HTB)
#define PG8_STAGE(bufoff, gbase, voff) do { _Pragma("unroll") for (int _i = 0; _i < 2; ++_i) \
        __builtin_amdgcn_global_load_lds((const unsigned*)((const char*)(gbase) + (voff)[_i]), (PG8_LAS unsigned*)(lds + (bufoff) + ldsw + _i * 8192), 16, 0, 0); } while (0)
#define PG8_LDA(dst, b, h) do { _Pragma("unroll") for (int m = 0; m < 4; ++m) _Pragma("unroll") for (int k = 0; k < 2; ++k) dst[m][k] = *(const PG8_LAS bf16x8*)(lds + PG8_SA(b, h) + aoff + m * 2048 + k * 1024); } while (0)
#define PG8_LDB(dst, b, h) do { _Pragma("unroll") for (int n = 0; n < 2; ++n) _Pragma("unroll") for (int k = 0; k < 2; ++k) dst[n][k] = *(const PG8_LAS bf16x8*)(lds + PG8_SB(b, h) + boff + n * 2048 + k * 1024); } while (0)
#define PG8_MMA(ai, bj, At, Bt) do { __builtin_amdgcn_s_setprio(1); _Pragma("unroll") for (int m = 0; m < 4; ++m) _Pragma("unroll") for (int n = 0; n < 2; ++n) _Pragma("unroll") for (int k = 0; k < 2; ++k) \
        acc[ai][bj][m][n] = __builtin_amdgcn_mfma_f32_16x16x32_bf16(Bt[n][k], At[m][k], acc[ai][bj][m][n], 0, 0, 0); __builtin_amdgcn_s_setprio(0); } while (0)
#define PG8_WAIT_V(n) asm volatile("s_waitcnt vmcnt(" #n ")" ::: "memory")
#define PG8_WAIT_L(n) asm volatile("s_waitcnt lgkmcnt(" #n ")" ::: "memory")
#define PG8_BAR __builtin_amdgcn_s_barrier()
#define PG8_SCHED __builtin_amdgcn_sched_barrier(0)
    Unit cur, nxt; int ui = 0;
    if (!S.next(0, cur)) return;
    f32x4 acc[2][2][4][2];
#pragma unroll
    for (int a = 0; a < 2; ++a)
#pragma unroll
        for (int b = 0; b < 2; ++b)
#pragma unroll
            for (int m = 0; m < 4; ++m)
#pragma unroll
                for (int n = 0; n < 2; ++n) acc[a][b][m][n] = (f32x4){0.f, 0.f, 0.f, 0.f};
    bf16x8 At[4][2], B0[2][2], B1[2][2];
    const char* cA = (const char*)g.A + (size_t)cur.pm * tstep; const char* cB = (const char*)g.Bt + (size_t)cur.pn * tstep;
    S.a_ready(cur);
    if constexpr (SP2) {
        PG8_STAGE(PG8_SB(0, 0), cB, voffB); PG8_STAGE(PG8_SB(0, 1), cB + hstep, voffB); PG8_STAGE(PG8_SA(0, 0), cA, voffA); PG8_STAGE(PG8_SA(0, 1), cA + hstep, voffA);
        if (wr == 1) PG8_BAR;
        PG8_WAIT_V(2); PG8_BAR;
        PG8_STAGE(PG8_SB(1, 0), cB + kstep, voffB); PG8_STAGE(PG8_SA(1, 0), cA + kstep, voffA); PG8_STAGE(PG8_SB(1, 1), cB + hstep + kstep, voffB);
        PG8_WAIT_V(6); PG8_BAR;
    } else {
        PG8_STAGE(PG8_SB(0, 0), cB, voffB); PG8_STAGE(PG8_SA(0, 0), cA, voffA); PG8_STAGE(PG8_SB(0, 1), cB + hstep, voffB); PG8_STAGE(PG8_SA(0, 1), cA + hstep, voffA);
        if (wr == 1) PG8_BAR;
        PG8_WAIT_V(4); PG8_BAR;
        PG8_STAGE(PG8_SB(1, 0), cB + kstep, voffB); PG8_STAGE(PG8_SA(1, 0), cA + kstep, voffA); PG8_STAGE(PG8_SB(1, 1), cB + hstep + kstep, voffB);
        PG8_WAIT_V(6); PG8_BAR;
    }
    for (;;) {
        const bool has_next = S.next(ui + 1, nxt);
        const char* nA = has_next ? (const char*)g.A + (size_t)nxt.pm * tstep : cA; const char* nB = has_next ? (const char*)g.Bt + (size_t)nxt.pn * tstep : cB;
        for (int t = 0; t < nt; t += 2) {
            const bool last = (t == nt - 2);
            const char* a1 = cA + (size_t)(t + 1) * kstep;
            const char* a2 = last ? nA : cA + (size_t)(t + 2) * kstep; const char* b2 = last ? nB : cB + (size_t)(t + 2) * kstep;
            const char* a3 = a2 + kstep; const char* b3 = b2 + kstep;
            if (last && has_next) S.a_ready(nxt);
            if constexpr (SP2) {
            PG8_LDB(B0, 0, 0); PG8_LDB(B1, 0, 1); PG8_SCHED; PG8_LDA(At, 0, 0); PG8_STAGE(PG8_SA(1, 1), a1 + hstep, voffA);
            PG8_WAIT_V(8); PG8_WAIT_L(0); PG8_BAR; PG8_MMA(0, 0, At, B0); PG8_MMA(0, 1, At, B1); PG8_BAR; PG8_SCHED;
            PG8_LDA(At, 0, 1); PG8_STAGE(PG8_SB(0, 0), b2, voffB); PG8_STAGE(PG8_SB(0, 1), b2 + hstep, voffB); PG8_STAGE(PG8_SA(0, 0), a2, voffA);
            PG8_WAIT_V(8); PG8_WAIT_L(0); PG8_BAR; PG8_MMA(1, 0, At, B0); PG8_MMA(1, 1, At, B1); PG8_BAR; PG8_SCHED;
            PG8_LDB(B0, 1, 0); PG8_LDB(B1, 1, 1); PG8_SCHED; PG8_LDA(At, 1, 0); PG8_STAGE(PG8_SA(0, 1), a2 + hstep, voffA);
            PG8_WAIT_V(8); PG8_WAIT_L(0); PG8_BAR; PG8_MMA(0, 0, At, B0); PG8_MMA(0, 1, At, B1); PG8_BAR; PG8_SCHED;
            PG8_LDA(At, 1, 1); PG8_STAGE(PG8_SB(1, 0), b3, voffB); PG8_STAGE(PG8_SB(1, 1), b3 + hstep, voffB); PG8_STAGE(PG8_SA(1, 0), a3, voffA);
            PG8_WAIT_V(8); PG8_WAIT_L(0); PG8_BAR; PG8_MMA(1, 0, At, B0); PG8_MMA(1, 1, At, B1); PG8_BAR; PG8_SCHED;
            } else {
            PG8_LDB(B0, 0, 0); PG8_SCHED; PG8_LDA(At, 0, 0); PG8_STAGE(PG8_SA(1, 1), a1 + hstep, voffA);
            PG8_WAIT_L(8); PG8_BAR; PG8_WAIT_L(0); PG8_MMA(0, 0, At, B0); PG8_BAR; PG8_SCHED;
            PG8_LDB(B1, 0, 1); PG8_STAGE(PG8_SB(0, 0), b2, voffB);
            PG8_BAR; PG8_WAIT_L(0); PG8_MMA(0, 1, At, B1); PG8_BAR;
            PG8_LDA(At, 0, 1); PG8_STAGE(PG8_SA(0, 0), a2, voffA);
            PG8_BAR; PG8_WAIT_L(0); PG8_MMA(1, 0, At, B0); PG8_BAR; PG8_SCHED;
            PG8_STAGE(PG8_SB(0, 1), b2 + hstep, voffB);
            PG8_WAIT_V(6); PG8_BAR; PG8_MMA(1, 1, At, B1); PG8_BAR;
            PG8_LDB(B0, 1, 0); PG8_SCHED; PG8_LDA(At, 1, 0); PG8_STAGE(PG8_SA(0, 1), a2 + hstep, voffA);
            PG8_WAIT_L(8); PG8_BAR; PG8_WAIT_L(0); PG8_MMA(0, 0, At, B0); PG8_BAR; PG8_SCHED;
            PG8_LDB(B1, 1, 1); PG8_STAGE(PG8_SB(1, 0), b3, voffB);
            PG8_BAR; PG8_WAIT_L(0); PG8_MMA(0, 1, At, B1); PG8_BAR;
            PG8_LDA(At, 1, 1); PG8_STAGE(PG8_SA(1, 0), a3, voffA);
            PG8_BAR; PG8_WAIT_L(0); PG8_MMA(1, 0, At, B0); PG8_BAR; PG8_SCHED;
            PG8_STAGE(PG8_SB(1, 1), b3 + hstep, voffB);
            PG8_WAIT_V(6); PG8_BAR; PG8_MMA(1, 1, At, B1); PG8_BAR;
            }
        }
        if constexpr (ALIGN_EPI) { if (wr == 0) PG8_BAR; }
        if constexpr (!Epi::AFTER_DRAIN) { E(acc, cur, wr, wc, fr, fq); S.done(cur); }
        if (!has_next) break;
#pragma unroll
        for (int a = 0; a < 2; ++a)
#pragma unroll
            for (int b = 0; b < 2; ++b)
#pragma unroll
                for (int m = 0; m < 4; ++m)
#pragma unroll
                    for (int n = 0; n < 2; ++n) acc[a][b][m][n] = (f32x4){0.f, 0.f, 0.f, 0.f};
        cur = nxt; cA = nA; cB = nB; ++ui;
        if constexpr (ALIGN_EPI) { if (wr == 1) PG8_BAR; }
    }
    PG8_WAIT_V(0);
    if constexpr (!ALIGN_EPI) { if (wr == 0) PG8_BAR; }
    PG8_BAR;
    if constexpr (Epi::AFTER_DRAIN) { E.fused(acc, cur, wr, wc, fr, fq, lds, wid, lane); S.done(cur); }
#undef PG8_SA
#undef PG8_SB
#undef PG8_STAGE
#undef PG8_LDA
#undef PG8_LDB
#undef PG8_MMA
#undef PG8_WAIT_V
#undef PG8_WAIT_L
#undef PG8_BAR
#undef PG8_SCHED
}
}

#define WTAB_OFF 155392
extern __shared__ __attribute__((aligned(16))) unsigned char lds_raw[];
__device__ __forceinline__ int hw_slot() { return (int)(__builtin_amdgcn_s_getreg((5 << 11) | 4) & 63u); }
__device__ __forceinline__ void otid_init() { const int t = threadIdx.x; if ((t & 63) == 0) ((__attribute__((address_space(3))) int*)(__attribute__((address_space(3))) void*)(lds_raw + WTAB_OFF))[hw_slot()] = t >> 6; }
__device__ __forceinline__ int otid() {
    const int w = __builtin_amdgcn_readfirstlane(((const __attribute__((address_space(3))) int*)(__attribute__((address_space(3))) void*)(lds_raw + WTAB_OFF))[hw_slot()]);
    int l; asm volatile("v_mbcnt_lo_u32_b32 %0, -1, 0\n\tv_mbcnt_hi_u32_b32 %0, -1, %0" : "=v"(l));
    return (w << 6) + l;
}
using pg8::bf16_t; using pg8::bf16x8; using pg8::f32x4; using pg8::u32x4;
#define LAS __attribute__((address_space(3)))

#define DMODEL 1024
#define NPT 16384
#define NST 32
#define NTOK 16416
#define MPAD 16640
#define SEQ 2048
#define ZW 2816
#define OFF_A 1536
#define OFF_B 1544
#define OFF_Z 1552
#define OFF_QA 2064
#define OFF_KVA 2448
#define OFF_KR 2704
#define DFF 2816
#define PAST 16384
#define NPAGES 128
#define EPSV 1e-6f

#define O_YP 0
#define O_YS (O_YP + 16777216)
#define O_CKVP (O_YS + 32768)
#define O_KRP (O_CKVP + 4194304)
#define O_GSP (O_KRP + 524288)
#define O_CSP (O_GSP + 262144)
#define O_CKVS (O_CSP + 36864)
#define O_KRS (O_CKVS + 8192)
#define O_GSS (O_KRS + 1024)
#define O_CSS (O_GSS + 1048576)

__device__ __forceinline__ bf16_t f2bf(float f) { unsigned u = __float_as_uint(f); return (bf16_t)((u + 0x7fffu + ((u >> 16) & 1u)) >> 16); }
__device__ __forceinline__ float bf2f(bf16_t b) { return __uint_as_float(((unsigned)b) << 16); }
template <int CTRL> __device__ __forceinline__ float dpp_mov(float x) { return __uint_as_float((unsigned)__builtin_amdgcn_update_dpp((int)__float_as_uint(x), (int)__float_as_uint(x), CTRL, 0xF, 0xF, true)); }
__device__ __forceinline__ float add_x16(float x) { auto r = __builtin_amdgcn_permlane16_swap(__float_as_uint(x), __float_as_uint(x), false, false); return __uint_as_float(r[0]) + __uint_as_float(r[1]); }
__device__ __forceinline__ float add_x32(float x) { auto r = __builtin_amdgcn_permlane32_swap(__float_as_uint(x), __float_as_uint(x), false, false); return __uint_as_float(r[0]) + __uint_as_float(r[1]); }
__device__ __forceinline__ float max_x32(float x) { auto r = __builtin_amdgcn_permlane32_swap(__float_as_uint(x), __float_as_uint(x), false, false); return fmaxf(__uint_as_float(r[0]), __uint_as_float(r[1])); }
__device__ __forceinline__ float sum8(float x) { x += dpp_mov<0xB1>(x); x += dpp_mov<0x4E>(x); x += dpp_mov<0x141>(x); return x; }
__device__ __forceinline__ float sum16(float x) { x = sum8(x); x += dpp_mov<0x140>(x); return x; }
__device__ __forceinline__ float max16(float x) { x = fmaxf(x, dpp_mov<0xB1>(x)); x = fmaxf(x, dpp_mov<0x4E>(x)); x = fmaxf(x, dpp_mov<0x141>(x)); x = fmaxf(x, dpp_mov<0x140>(x)); return x; }
__device__ __forceinline__ float wave_sum(float v) { return add_x32(add_x16(sum16(v))); }
__device__ __forceinline__ float sigmoidf_(float x) { return __builtin_amdgcn_rcpf(1.f + __builtin_amdgcn_exp2f(-1.44269504f * x)); }
__device__ __forceinline__ float siluf_(float x) { return x * __builtin_amdgcn_rcpf(1.f + __builtin_amdgcn_exp2f(-1.44269504f * x)); }


#define WSYNC() do { __builtin_amdgcn_fence(__ATOMIC_ACQ_REL, "wavefront"); __builtin_amdgcn_wave_barrier(); } while (0)
#define NTHR 512
#define NWAVE 8

typedef float f32x2_t __attribute__((ext_vector_type(2)));
typedef __bf16 bf16x2_t __attribute__((ext_vector_type(2)));
__device__ __forceinline__ unsigned cvtpk(float lo, float hi) { f32x2_t v = {lo, hi}; bf16x2_t r = __builtin_convertvector(v, bf16x2_t); return __builtin_bit_cast(unsigned, r); }
__device__ __forceinline__ void bf8_to_f32(const bf16x8& v, float* o) {
#pragma unroll
    for (int e = 0; e < 8; ++e) o[e] = __uint_as_float(((unsigned)(unsigned short)v[e]) << 16);
}
__device__ __forceinline__ bf16x8 f32_to_bf8(const float* x) {
    u32x4 w; w.x = cvtpk(x[0], x[1]); w.y = cvtpk(x[2], x[3]); w.z = cvtpk(x[4], x[5]); w.w = cvtpk(x[6], x[7]);
    return __builtin_bit_cast(bf16x8, w);
}
__device__ __forceinline__ unsigned pk2bf(float lo, float hi) { return (unsigned)f2bf(lo) | ((unsigned)f2bf(hi) << 16); }

__device__ __forceinline__ void wt_item(const float* __restrict__ W, int ldw, int col0, int nvalid, bf16_t* __restrict__ WT, int ldt, int nrow0, int k0, float* scr, int lane) {
    WSYNC();
#pragma unroll 8
    for (int i = 0; i < 32; ++i) { const int kk = 2 * i + (lane >> 5), n = lane & 31; scr[kk * 33 + n] = n < nvalid ? W[(size_t)(k0 + kk) * ldw + col0 + n] : 0.f; }
    WSYNC();
    const int c = lane & 7;
#pragma unroll
    for (int j = 0; j < 4; ++j) { const int n = (lane >> 3) + 8 * j; const float* sp = scr + (8 * c) * 33 + n;
        u32x4 o; o.x = cvtpk(sp[0], sp[33]); o.y = cvtpk(sp[2 * 33], sp[3 * 33]); o.z = cvtpk(sp[4 * 33], sp[5 * 33]); o.w = cvtpk(sp[6 * 33], sp[7 * 33]);
        *(u32x4*)(WT + (size_t)(nrow0 + n) * ldt + k0 + 8 * c) = o; }
}

__device__ __forceinline__ void rms1024_row(const float* __restrict__ src, const float* __restrict__ g, bf16_t* __restrict__ o, bool zero, int lane) {
    if (zero) { for (int j = 0; j < 4; ++j) { ushort4 z = {0, 0, 0, 0}; *(ushort4*)(o + lane * 4 + 256 * j) = z; } return; }
    float4 v[4]; float ss = 0.f;
#pragma unroll
    for (int j = 0; j < 4; ++j) { v[j] = *(const float4*)(src + lane * 4 + 256 * j); ss += v[j].x * v[j].x + v[j].y * v[j].y + v[j].z * v[j].z + v[j].w * v[j].w; }
    ss = wave_sum(ss);
    const float rs = rsqrtf(ss * (1.f / 1024.f) + EPSV);
#pragma unroll
    for (int j = 0; j < 4; ++j) {
        const float4 gg = *(const float4*)(g + lane * 4 + 256 * j);
        ushort4 w; w.x = f2bf(v[j].x * rs * gg.x); w.y = f2bf(v[j].y * rs * gg.y); w.z = f2bf(v[j].z * rs * gg.z); w.w = f2bf(v[j].w * rs * gg.w);
        *(ushort4*)(o + lane * 4 + 256 * j) = w;
    }
}

__device__ __forceinline__ void rms1024_row_b(const bf16_t* __restrict__ src, const float* __restrict__ g, bf16_t* __restrict__ o, bool zero, int lane) {
    if (zero) { for (int j = 0; j < 2; ++j) { const u32x4 z = {0u, 0u, 0u, 0u}; *(u32x4*)(o + lane * 8 + 512 * j) = z; } return; }
    float v[2][8]; float ss = 0.f;
#pragma unroll
    for (int j = 0; j < 2; ++j) { bf8_to_f32(*(const bf16x8*)(src + lane * 8 + 512 * j), v[j]);
#pragma unroll
        for (int e = 0; e < 8; ++e) ss += v[j][e] * v[j][e]; }
    ss = wave_sum(ss);
    const float rs = rsqrtf(ss * (1.f / 1024.f) + EPSV);
#pragma unroll
    for (int j = 0; j < 2; ++j) {
        const float4 g0 = *(const float4*)(g + lane * 8 + 512 * j), g1 = *(const float4*)(g + lane * 8 + 512 * j + 4);
        float t[8] = {v[j][0] * rs * g0.x, v[j][1] * rs * g0.y, v[j][2] * rs * g0.z, v[j][3] * rs * g0.w, v[j][4] * rs * g1.x, v[j][5] * rs * g1.y, v[j][6] * rs * g1.z, v[j][7] * rs * g1.w};
        *(bf16x8*)(o + lane * 8 + 512 * j) = f32_to_bf8(t);
    }
}

struct ABf16 { const bf16_t* p; int lda; __device__ __forceinline__ bf16x8 load(int m, int k) const { return *(const bf16x8*)(p + (size_t)m * lda + k); } };
template <bool SWIGLU, class Epi>
__device__ __forceinline__ void gemm_sample_rows(const bf16_t* __restrict__ A, int lda, const bf16_t* __restrict__ Bt, int K, int N, const Epi& epi, char*  , int bid, int nb, int first = -1) {
    const int tid = otid(), lane = tid & 63, wid = tid >> 6, i16 = lane & 15, q4 = lane >> 4;
    for (int u = first >= 0 ? (bid - first + nb) % nb : nb - 1 - bid; u < N / 256; u += nb) {
        const int n0 = u * 256;
        const int c0 = SWIGLU ? n0 + 16 * wid : n0 + 32 * wid, c1 = SWIGLU ? n0 + 128 + 16 * wid : n0 + 32 * wid + 16;
        const bf16_t* a0p = A + (size_t)(NPT + i16) * lda + 8 * q4; const bf16_t* a1p = a0p + (size_t)16 * lda;
        const bf16_t* b0p = Bt + (size_t)(c0 + i16) * K + 8 * q4; const bf16_t* b1p = Bt + (size_t)(c1 + i16) * K + 8 * q4;
        f32x4 acc[2][2];
#pragma unroll
        for (int i = 0; i < 2; ++i)
#pragma unroll
            for (int j = 0; j < 2; ++j) acc[i][j] = (f32x4){0.f, 0.f, 0.f, 0.f};
#pragma unroll 4
        for (int k0 = 0; k0 < K; k0 += 32) {
            const bf16x8 a0 = *(const bf16x8*)(a0p + k0), a1 = *(const bf16x8*)(a1p + k0), b0 = *(const bf16x8*)(b0p + k0), b1 = *(const bf16x8*)(b1p + k0);
            acc[0][0] = __builtin_amdgcn_mfma_f32_16x16x32_bf16(a0, b0, acc[0][0], 0, 0, 0); acc[0][1] = __builtin_amdgcn_mfma_f32_16x16x32_bf16(a0, b1, acc[0][1], 0, 0, 0);
            acc[1][0] = __builtin_amdgcn_mfma_f32_16x16x32_bf16(a1, b0, acc[1][0], 0, 0, 0); acc[1][1] = __builtin_amdgcn_mfma_f32_16x16x32_bf16(a1, b1, acc[1][1], 0, 0, 0);
        }
#pragma unroll
        for (int i = 0; i < 2; ++i)
#pragma unroll
            for (int r = 0; r < 4; ++r) {
                const int m = NPT + 16 * i + 4 * q4 + r;
                if constexpr (SWIGLU) epi(m, (n0 >> 1) + 16 * wid + i16, siluf_(acc[i][0][r]) * acc[i][1][r]);
                else { epi(m, c0 + i16, acc[i][0][r]); epi(m, c1 + i16, acc[i][1][r]); }
            }
    }
}
template <bool SWIGLU, class Epi>
__device__ __forceinline__ void gemm_sample_rows_ks(const bf16_t* __restrict__ A, int lda, const bf16_t* __restrict__ Bt, int K, int N, const Epi& epi, char* smem, int bid, int nb) {
    const int tid = otid(), lane = tid & 63, wid = tid >> 6, i16 = lane & 15, q4 = lane >> 4;
    const int nunits = N / 64, ksl = K >> 3;
    f32x4* red = (f32x4*)smem;
    for (int u = nb - 1 - bid; u < nunits; u += nb) {
        int brow[4];
#pragma unroll
        for (int j = 0; j < 4; ++j) brow[j] = SWIGLU ? ((32 * u) >> 7) * 256 + ((32 * u) & 127) + 128 * (j >> 1) + 16 * (j & 1) + i16 : 64 * u + 16 * j + i16;
        const bf16_t* a0p = A + (size_t)(NPT + i16) * lda + wid * ksl + 8 * q4; const bf16_t* a1p = a0p + (size_t)16 * lda;
        f32x4 acc[2][4];
#pragma unroll
        for (int i = 0; i < 2; ++i)
#pragma unroll
            for (int j = 0; j < 4; ++j) acc[i][j] = (f32x4){0.f, 0.f, 0.f, 0.f};
        for (int k0 = 0; k0 < ksl; k0 += 32) {
            const bf16x8 a0 = *(const bf16x8*)(a0p + k0), a1 = *(const bf16x8*)(a1p + k0);
            bf16x8 b[4];
#pragma unroll
            for (int j = 0; j < 4; ++j) b[j] = *(const bf16x8*)(Bt + (size_t)brow[j] * K + wid * ksl + 8 * q4 + k0);
#pragma unroll
            for (int j = 0; j < 4; ++j) { acc[0][j] = __builtin_amdgcn_mfma_f32_16x16x32_bf16(a0, b[j], acc[0][j], 0, 0, 0); acc[1][j] = __builtin_amdgcn_mfma_f32_16x16x32_bf16(a1, b[j], acc[1][j], 0, 0, 0); }
        }
        __syncthreads();
#pragma unroll
        for (int i = 0; i < 2; ++i)
#pragma unroll
            for (int j = 0; j < 4; ++j) red[(wid * 8 + i * 4 + j) * 64 + lane] = acc[i][j];
        __syncthreads();
        if constexpr (SWIGLU) {
            if (tid < 256) {
                const int t4 = tid >> 6, i = t4 >> 1, jg = t4 & 1, l = tid & 63;
                f32x4 g = red[(i * 4 + jg) * 64 + l], up = red[(i * 4 + jg + 2) * 64 + l];
#pragma unroll
                for (int w = 1; w < 8; ++w) { g = g + red[(w * 8 + i * 4 + jg) * 64 + l]; up = up + red[(w * 8 + i * 4 + jg + 2) * 64 + l]; }
#pragma unroll
                for (int r = 0; r < 4; ++r) epi(NPT + 16 * i + 4 * (l >> 4) + r, 32 * u + 16 * jg + (l & 15), siluf_(g[r]) * up[r]);
            }
        } else {
            const int t8 = tid >> 6, l = tid & 63, i = t8 >> 2, j = t8 & 3;
            f32x4 v = red[t8 * 64 + l];
#pragma unroll
            for (int w = 1; w < 8; ++w) v = v + red[(w * 8 + t8) * 64 + l];
#pragma unroll
            for (int r = 0; r < 4; ++r) epi(NPT + 16 * i + 4 * (l >> 4) + r, 64 * u + 16 * j + (l & 15), v[r]);
        }
    }
    __syncthreads();
}
struct EwF32 { float* C; int ldc; __device__ __forceinline__ void operator()(int m, int n, float v) const { C[(size_t)m * ldc + n] = v; } };
struct EwBf16 { bf16_t* C; int ldc; __device__ __forceinline__ void operator()(int m, int n, float v) const { C[(size_t)m * ldc + n] = f2bf(v); } };
struct EwResX { const float* xs; bf16_t* C; __device__ __forceinline__ void operator()(int m, int n, float v) const { C[(size_t)m * 1024 + n] = f2bf(xs[(size_t)(m - NPT) * 1024 + n] + v); } };
struct EwResH { const bf16_t* H; bf16_t* C; __device__ __forceinline__ void operator()(int m, int n, float v) const { C[(size_t)m * 1024 + n] = f2bf(bf2f(H[(size_t)m * 1024 + n]) + v); } };
struct EwPle { const bf16_t* H2; const bf16_t* PP; float* out;
    __device__ __forceinline__ void operator()(int m, int n, float v) const { out[O_YS + (size_t)(m - NPT) * 1024 + n] = bf2f(H2[(size_t)m * 1024 + n]) + bf2f(PP[(size_t)m * 1024 + n]) * sigmoidf_(v); } };

struct PgBf16 {
    static constexpr bool PERM = true, AFTER_DRAIN = false; bf16_t* O; int ldc;
    __device__ __forceinline__ void operator()(const f32x4 (&acc)[2][2][4][2], const pg8::Unit& u, int wr, int wc, int fr, int fq) const {
#pragma unroll
        for (int ai = 0; ai < 2; ++ai)
#pragma unroll
            for (int m = 0; m < 4; ++m) { bf16_t* rowp = O + (size_t)(u.pm * 256 + ai * 128 + wr * 64 + m * 16 + fr) * ldc + u.pn * 256 + wc * 32 + 8 * fq;
#pragma unroll
                for (int bj = 0; bj < 2; ++bj) { const f32x4 v0 = acc[ai][bj][m][0], v1 = acc[ai][bj][m][1]; u32x4 w; w.x = pk2bf(v0[0], v0[1]); w.y = pk2bf(v0[2], v0[3]); w.z = pk2bf(v1[0], v1[1]); w.w = pk2bf(v1[2], v1[3]); *(u32x4*)(rowp + bj * 128) = w; } }
    }
};
struct PgF32 {
    static constexpr bool PERM = false, AFTER_DRAIN = false; float* O; int ldc;
    __device__ __forceinline__ void operator()(const f32x4 (&acc)[2][2][4][2], const pg8::Unit& u, int wr, int wc, int fr, int fq) const {
#pragma unroll
        for (int ai = 0; ai < 2; ++ai)
#pragma unroll
            for (int m = 0; m < 4; ++m) { float* rowp = O + (size_t)(u.pm * 256 + ai * 128 + wr * 64 + m * 16 + fr) * ldc + u.pn * 256 + wc * 32 + 4 * fq;
#pragma unroll
                for (int bj = 0; bj < 2; ++bj)
#pragma unroll
                    for (int n = 0; n < 2; ++n) *(f32x4*)(rowp + bj * 128 + n * 16) = acc[ai][bj][m][n]; }
    }
};
struct PgSwiglu {
    static constexpr bool PERM = true, AFTER_DRAIN = false; bf16_t* Hd;
    __device__ __forceinline__ void operator()(const f32x4 (&acc)[2][2][4][2], const pg8::Unit& u, int wr, int wc, int fr, int fq) const {
#pragma unroll
        for (int ai = 0; ai < 2; ++ai)
#pragma unroll
            for (int m = 0; m < 4; ++m) { bf16_t* rowp = Hd + (size_t)(u.pm * 256 + ai * 128 + wr * 64 + m * 16 + fr) * DFF + u.pn * 128 + wc * 32 + 8 * fq;
                float h[8];
#pragma unroll
                for (int n = 0; n < 2; ++n)
#pragma unroll
                    for (int i = 0; i < 4; ++i) h[n * 4 + i] = siluf_(acc[ai][0][m][n][i]) * acc[ai][1][m][n][i];
                u32x4 w; w.x = pk2bf(h[0], h[1]); w.y = pk2bf(h[2], h[3]); w.z = pk2bf(h[4], h[5]); w.w = pk2bf(h[6], h[7]); *(u32x4*)rowp = w; }
    }
};
struct PgResXB {
    static constexpr bool PERM = true, AFTER_DRAIN = false; const float* R; bf16_t* O;
    __device__ __forceinline__ void operator()(const f32x4 (&acc)[2][2][4][2], const pg8::Unit& u, int wr, int wc, int fr, int fq) const {
#pragma unroll
        for (int ai = 0; ai < 2; ++ai)
#pragma unroll
            for (int m = 0; m < 4; ++m) { const size_t off = (size_t)(u.pm * 256 + ai * 128 + wr * 64 + m * 16 + fr) * 1024 + u.pn * 256 + wc * 32 + 8 * fq;
#pragma unroll
                for (int bj = 0; bj < 2; ++bj) { const f32x4 r0 = *(const f32x4*)(R + off + bj * 128), r1 = *(const f32x4*)(R + off + bj * 128 + 4), v0 = r0 + acc[ai][bj][m][0], v1 = r1 + acc[ai][bj][m][1];
                    u32x4 w; w.x = cvtpk(v0[0], v0[1]); w.y = cvtpk(v0[2], v0[3]); w.z = cvtpk(v1[0], v1[1]); w.w = cvtpk(v1[2], v1[3]); *(u32x4*)(O + off + bj * 128) = w; } }
    }
};
struct PgResBB {
    static constexpr bool PERM = true, AFTER_DRAIN = false; const bf16_t* R; bf16_t* O;
    __device__ __forceinline__ void operator()(const f32x4 (&acc)[2][2][4][2], const pg8::Unit& u, int wr, int wc, int fr, int fq) const {
#pragma unroll
        for (int ai = 0; ai < 2; ++ai)
#pragma unroll
            for (int m = 0; m < 4; ++m) { const size_t off = (size_t)(u.pm * 256 + ai * 128 + wr * 64 + m * 16 + fr) * 1024 + u.pn * 256 + wc * 32 + 8 * fq;
#pragma unroll
                for (int bj = 0; bj < 2; ++bj) { float r[8]; bf8_to_f32(*(const bf16x8*)(R + off + bj * 128), r); const f32x4 a0 = acc[ai][bj][m][0], a1 = acc[ai][bj][m][1];
                    u32x4 w; w.x = cvtpk(r[0] + a0[0], r[1] + a0[1]); w.y = cvtpk(r[2] + a0[2], r[3] + a0[3]); w.z = cvtpk(r[4] + a1[0], r[5] + a1[1]); w.w = cvtpk(r[6] + a1[2], r[7] + a1[3]); *(u32x4*)(O + off + bj * 128) = w; } }
    }
};
struct PgPleB {
    static constexpr bool PERM = true, AFTER_DRAIN = false; const bf16_t* H2; const bf16_t* PP; float* out;
    __device__ __forceinline__ void operator()(const f32x4 (&acc)[2][2][4][2], const pg8::Unit& u, int wr, int wc, int fr, int fq) const {
#pragma unroll
        for (int ai = 0; ai < 2; ++ai)
#pragma unroll
            for (int m = 0; m < 4; ++m) { const size_t off = (size_t)(u.pm * 256 + ai * 128 + wr * 64 + m * 16 + fr) * 1024 + u.pn * 256 + wc * 32 + 8 * fq;
#pragma unroll
                for (int bj = 0; bj < 2; ++bj) { float h[8], pp[8]; bf8_to_f32(*(const bf16x8*)(H2 + off + bj * 128), h); bf8_to_f32(*(const bf16x8*)(PP + off + bj * 128), pp);
                    const f32x4 a0 = acc[ai][bj][m][0], a1 = acc[ai][bj][m][1]; f32x4 y0, y1;
#pragma unroll
                    for (int i = 0; i < 4; ++i) { y0[i] = h[i] + pp[i] * sigmoidf_(a0[i]); y1[i] = h[4 + i] + pp[4 + i] * sigmoidf_(a1[i]); }
                    *(f32x4*)(out + O_YP + off + bj * 128) = y0; *(f32x4*)(out + O_YP + off + bj * 128 + 4) = y1; } }
    }
};
template <class Epi>
__device__ __forceinline__ void pg_gemm(LAS unsigned char* lds, const bf16_t* A, const bf16_t* Bt, int M, int N, int K, const Epi& E, int glow = 0) {
    pg8::Gemm g{A, Bt, M, N, K}; pg8::StaticOrder S;
    if (glow > 0) { if ((int)blockIdx.x >= glow) return; S.init(M, N, glow, (int)blockIdx.x); }
    else S.init(M, N, (int)gridDim.x, (int)blockIdx.x);
    pg8::gemm_phase<Epi, pg8::StaticOrder, true, true>(lds, g, S, E);
}

constexpr size_t WOF_WinT = 0ull;
constexpr size_t WOF_WqbT = 5767168ull;
constexpr size_t WOF_WkvT = 6356992ull;
constexpr size_t WOF_WknT = 6881280ull;
constexpr size_t WOF_WoT = 7143424ull;
constexpr size_t WOF_WguT = 9240576ull;
constexpr size_t WOF_WdT = 20774912ull;
constexpr size_t WOF_WpgT = 26542080ull;
constexpr size_t WOF_WppT = 28639232ull;
constexpr size_t WOF_xn = 29163520ull;
constexpr size_t WOF_pb = 63242240ull;
constexpr size_t WOF_Z = 71761920ull;
constexpr size_t WOF_qkv = 165478400ull;
constexpr size_t WOF_ropecs = 216596480ull;
constexpr size_t WOF_gg = 216858880ull;
constexpr size_t WOF_bb = 217391360ull;
constexpr size_t WOF_goraw = 217923840ull;
constexpr size_t WOF_gUT = 252002560ull;
constexpr size_t WOF_ggam = 285556992ull;
constexpr size_t WOF_gWn = 285565184ull;
constexpr size_t WOF_gQg = 302342400ull;
constexpr size_t WOF_gQK = 319119616ull;
constexpr size_t WOF_gKd = 335896832ull;
constexpr size_t WOF_qan = 352674048ull;
constexpr size_t WOF_ckvb = 365453568ull;
constexpr size_t WOF_krf = 373973248ull;
constexpr size_t WOF_Q = 376103168ull;
constexpr size_t WOF_qh = 427221248ull;
constexpr size_t WOF_KV = 478339328ull;
constexpr size_t WOF_kh = 546496768ull;
constexpr size_t WOF_omix = 580575488ull;
constexpr size_t WOF_KN = 614654208ull;
constexpr size_t WOF_SC = 1151525120ull;
constexpr size_t WOF_part = 1168302336ull;
constexpr size_t WOF_H = 1170432256ull;
constexpr size_t WOF_un = 1238589696ull;
constexpr size_t WOF_G = 1272668416ull;
constexpr size_t WOF_hid = 1273028864ull;
constexpr size_t WOF_H2 = 1366745344ull;
constexpr size_t WOF_un2 = 1434902784ull;
constexpr size_t WOF_PP = 1468981504ull;
constexpr size_t WOF_qraw = 1537138944ull;
constexpr size_t WOF_kvraw = 1562304768ull;
constexpr size_t WOF_krb = 1595859200ull;
constexpr size_t WOF_ctl = 1596907776ull;
constexpr size_t WS_TOTAL = 1596924160ull;
struct MK {
    const float *x_prompt, *x_sample, *cache_ckv, *cache_krope, *state_gdn, *state_conv; const int* page_table; const float *p_prompt, *p_sample;
    const float *g_attn, *w_in, *w_conv, *a_log, *dt_bias, *g_gdn_out, *g_q_a, *w_q_b, *g_q_nope, *g_q_rope, *g_kv_a, *g_k_rope, *w_kv_b, *g_k_nope, *w_o, *g_ffn, *w_gate, *w_up, *w_down, *g_ple, *w_ple_gate, *w_ple_proj;
    float* out; char* ws;
    __device__ __forceinline__ unsigned* ctl() const { return (unsigned*)(ws + WOF_ctl); }
    __device__ __forceinline__ bf16_t* WinT() const { return (bf16_t*)(ws + WOF_WinT); }
    __device__ __forceinline__ bf16_t* WqbT() const { return (bf16_t*)(ws + WOF_WqbT); }
    __device__ __forceinline__ bf16_t* WkvT() const { return (bf16_t*)(ws + WOF_WkvT); }
    __device__ __forceinline__ bf16_t* WknT() const { return (bf16_t*)(ws + WOF_WknT); }
    __device__ __forceinline__ bf16_t* WoT() const { return (bf16_t*)(ws + WOF_WoT); }
    __device__ __forceinline__ bf16_t* WguT() const { return (bf16_t*)(ws + WOF_WguT); }
    __device__ __forceinline__ bf16_t* WdT() const { return (bf16_t*)(ws + WOF_WdT); }
    __device__ __forceinline__ bf16_t* WpgT() const { return (bf16_t*)(ws + WOF_WpgT); }
    __device__ __forceinline__ bf16_t* WppT() const { return (bf16_t*)(ws + WOF_WppT); }
    __device__ __forceinline__ bf16_t* xn() const { return (bf16_t*)(ws + WOF_xn); }
    __device__ __forceinline__ bf16_t* pb() const { return (bf16_t*)(ws + WOF_pb); }
    __device__ __forceinline__ bf16_t* Z() const { return (bf16_t*)(ws + WOF_Z); }
    __device__ __forceinline__ bf16_t* qkv() const { return (bf16_t*)(ws + WOF_qkv); }
    __device__ __forceinline__ float* ropecs() const { return (float*)(ws + WOF_ropecs); }
    __device__ __forceinline__ float* gg() const { return (float*)(ws + WOF_gg); }
    __device__ __forceinline__ float* bb() const { return (float*)(ws + WOF_bb); }
    __device__ __forceinline__ float* goraw() const { return (float*)(ws + WOF_goraw); }
    __device__ __forceinline__ float* gUT() const { return (float*)(ws + WOF_gUT); }
    __device__ __forceinline__ float* ggam() const { return (float*)(ws + WOF_ggam); }
    __device__ __forceinline__ bf16_t* gWn() const { return (bf16_t*)(ws + WOF_gWn); }
    __device__ __forceinline__ bf16_t* gQg() const { return (bf16_t*)(ws + WOF_gQg); }
    __device__ __forceinline__ bf16_t* gQK() const { return (bf16_t*)(ws + WOF_gQK); }
    __device__ __forceinline__ bf16_t* gKd() const { return (bf16_t*)(ws + WOF_gKd); }
    __device__ __forceinline__ bf16_t* qan() const { return (bf16_t*)(ws + WOF_qan); }
    __device__ __forceinline__ bf16_t* ckvb() const { return (bf16_t*)(ws + WOF_ckvb); }
    __device__ __forceinline__ float* krf() const { return (float*)(ws + WOF_krf); }
    __device__ __forceinline__ float* Q() const { return (float*)(ws + WOF_Q); }
    __device__ __forceinline__ float* qh() const { return (float*)(ws + WOF_qh); }
    __device__ __forceinline__ float* KV() const { return (float*)(ws + WOF_KV); }
    __device__ __forceinline__ float* kh() const { return (float*)(ws + WOF_kh); }
    __device__ __forceinline__ bf16_t* omix() const { return (bf16_t*)(ws + WOF_omix); }
    __device__ __forceinline__ bf16_t* KN() const { return (bf16_t*)(ws + WOF_KN); }
    __device__ __forceinline__ float* SC() const { return (float*)(ws + WOF_SC); }
    __device__ __forceinline__ float* part() const { return (float*)(ws + WOF_part); }
    __device__ __forceinline__ bf16_t* H() const { return (bf16_t*)(ws + WOF_H); }
    __device__ __forceinline__ bf16_t* un() const { return (bf16_t*)(ws + WOF_un); }
    __device__ __forceinline__ float* G() const { return (float*)(ws + WOF_G); }
    __device__ __forceinline__ bf16_t* hid() const { return (bf16_t*)(ws + WOF_hid); }
    __device__ __forceinline__ bf16_t* H2() const { return (bf16_t*)(ws + WOF_H2); }
    __device__ __forceinline__ bf16_t* un2() const { return (bf16_t*)(ws + WOF_un2); }
    __device__ __forceinline__ bf16_t* PP() const { return (bf16_t*)(ws + WOF_PP); }
    __device__ __forceinline__ bf16_t* qraw() const { return (bf16_t*)(ws + WOF_qraw); }
    __device__ __forceinline__ bf16_t* kvraw() const { return (bf16_t*)(ws + WOF_kvraw); }
    __device__ __forceinline__ bf16_t* krb() const { return (bf16_t*)(ws + WOF_krb); }
};

__device__ __forceinline__ float fast_sigmoid(float x) { return __builtin_amdgcn_rcpf(1.f + __builtin_amdgcn_exp2f(-1.44269504f * x)); }
struct PinTok { bf16x8 qa, cv, kr; float ab; };
struct PinGain { float gqa[8], gkv[8], gkr[8], dtb, alog; };
__device__ __forceinline__ PinTok pin_load(const MK& a, int row, int lane) {
    const bf16_t* z = a.Z() + (size_t)row * ZW; PinTok t; const bf16x8 zz = {0, 0, 0, 0, 0, 0, 0, 0};
    t.qa = lane < 48 ? *(const bf16x8*)(z + OFF_QA + 8 * lane) : zz; t.cv = lane < 32 ? *(const bf16x8*)(z + OFF_KVA + 8 * lane) : zz;
    t.kr = (lane >= 32 && lane < 36) ? *(const bf16x8*)(z + OFF_KR + 8 * (lane - 32)) : zz; t.ab = lane < 16 ? bf2f(z[OFF_A + lane]) : 0.f; return t;
}
__device__ __forceinline__ void post_in_token(const MK& a, int row, int lane, const float* wcs, const bf16x8 (&w0)[3], const bf16x8 (&w1)[3], const bf16x8 (&w2)[3], const bf16x8 (&wcur)[3], const PinTok& tk, const PinGain& gn) {
    const bool samp = row >= NPT;
    const int b = samp ? row - NPT : row >> 11, t = samp ? 0 : row & 2047, hd = lane >> 3;
    float y[24];
#pragma unroll
    for (int c3 = 0; c3 < 3; ++c3) {
        float p0[8], p1[8], p2[8], cu[8];
        bf8_to_f32(w0[c3], p0); bf8_to_f32(w1[c3], p1); bf8_to_f32(w2[c3], p2); bf8_to_f32(wcur[c3], cu);
        const float* wp = wcs + 512 * c3 + 8 * lane;
        const float4 a0 = *(const float4*)wp, a1 = *(const float4*)(wp + 4), b0 = *(const float4*)(wp + 1536), b1 = *(const float4*)(wp + 1540);
        const float4 c0 = *(const float4*)(wp + 3072), c1 = *(const float4*)(wp + 3076), d0 = *(const float4*)(wp + 4608), d1 = *(const float4*)(wp + 4612);
        const float k0[8] = {a0.x, a0.y, a0.z, a0.w, a1.x, a1.y, a1.z, a1.w}, k1[8] = {b0.x, b0.y, b0.z, b0.w, b1.x, b1.y, b1.z, b1.w};
        const float k2[8] = {c0.x, c0.y, c0.z, c0.w, c1.x, c1.y, c1.z, c1.w}, k3[8] = {d0.x, d0.y, d0.z, d0.w, d1.x, d1.y, d1.z, d1.w};
#pragma unroll
        for (int e = 0; e < 8; ++e) { const int c = 8 * c3 + e; const float v = k0[e] * p0[e] + k1[e] * p1[e] + k2[e] * p2[e] + k3[e] * cu[e]; y[c] = v * fast_sigmoid(v); }
        __builtin_amdgcn_sched_barrier(0);
    }
    float sq = 0.f, sk = 0.f;
#pragma unroll
    for (int e = 0; e < 8; ++e) { sq += y[e] * y[e]; sk += y[8 + e] * y[8 + e]; }
    sq = sum8(sq); sk = sum8(sk);
    const float rq = rsqrtf(sq + EPSV) * 0.125f, rk = rsqrtf(sk + EPSV);
#pragma unroll
    for (int e = 0; e < 8; ++e) { y[e] *= rq; y[8 + e] *= rk; }
    bf16_t* qo = a.qkv() + (size_t)row * 1536 + 8 * lane;
    *(bf16x8*)qo = f32_to_bf8(y); *(bf16x8*)(qo + 512) = f32_to_bf8(y + 8); *(bf16x8*)(qo + 1024) = f32_to_bf8(y + 16);
    if (!samp && t >= SEQ - 3) {
        float* cso = a.out + O_CSP + ((size_t)b * 3 + (t - (SEQ - 3))) * 1536 + 8 * lane;
#pragma unroll
        for (int j = 0; j < 3; ++j) { float cu[8]; bf8_to_f32(wcur[j], cu); *(float4*)(cso + 512 * j) = (float4){cu[0], cu[1], cu[2], cu[3]}; *(float4*)(cso + 512 * j + 4) = (float4){cu[4], cu[5], cu[6], cu[7]}; }
    }
    if (lane < 16) {
        const float v = tk.ab;
        if (lane < 8) { const float xx = v + gn.dtb; const float sp = xx > 20.f ? xx : 0.69314718f * __builtin_amdgcn_logf(1.f + __builtin_amdgcn_exp2f(1.44269504f * xx)); a.gg()[(size_t)row * 8 + lane] = -gn.alog * sp; }
        else a.bb()[(size_t)row * 8 + lane - 8] = sigmoidf_(v);
    }
    __builtin_amdgcn_sched_barrier(0);
    float qa[8], cv[8], kr[8];
    bf8_to_f32(tk.qa, qa); bf8_to_f32(tk.cv, cv); bf8_to_f32(tk.kr, kr);
    float s1 = 0.f, s2 = 0.f, s3 = 0.f;
#pragma unroll
    for (int e = 0; e < 8; ++e) { s1 += qa[e] * qa[e]; s2 += cv[e] * cv[e]; s3 += kr[e] * kr[e]; }
    s1 = wave_sum(s1); s2 = wave_sum(s2); s3 = wave_sum(s3);
    const float r1 = rsqrtf(s1 * (1.f / 384.f) + EPSV), r2 = rsqrtf(s2 * (1.f / 256.f) + EPSV), r3 = rsqrtf(s3 * (1.f / 32.f) + EPSV);
    if (lane < 48) {
        float o[8];
#pragma unroll
        for (int e = 0; e < 8; ++e) o[e] = qa[e] * r1 * gn.gqa[e];
        *(bf16x8*)(a.qan() + (size_t)row * 384 + 8 * lane) = f32_to_bf8(o);
    }
    if (lane < 32) {
        float o[8];
#pragma unroll
        for (int e = 0; e < 8; ++e) o[e] = cv[e] * r2 * gn.gkv[e];
        *(bf16x8*)(a.ckvb() + (size_t)row * 256 + 8 * lane) = f32_to_bf8(o);
        float* co = samp ? a.out + O_CKVS + (size_t)b * 256 + 8 * lane : a.out + O_CKVP + (size_t)row * 256 + 8 * lane;
        *(float4*)co = (float4){o[0], o[1], o[2], o[3]}; *(float4*)(co + 4) = (float4){o[4], o[5], o[6], o[7]};
    }
    __builtin_amdgcn_sched_barrier(0);
    {
        const int c4 = (lane - 32) & 3;
        float xn[8], ot[8];
#pragma unroll
        for (int e = 0; e < 8; ++e) xn[e] = kr[e] * r3 * gn.gkr[e];
#pragma unroll
        for (int e = 0; e < 8; ++e) ot[e] = dpp_mov<0x4E>(xn[e]);
        if (lane >= 32 && lane < 36) {
            const float* tb = a.ropecs() + (size_t)(samp ? 2048 : t) * 32 + ((8 * c4) & 15);
            const float4 c0 = *(const float4*)tb, c1 = *(const float4*)(tb + 4), s0 = *(const float4*)(tb + 16), s1 = *(const float4*)(tb + 20);
            const float csv[8] = {c0.x, c0.y, c0.z, c0.w, c1.x, c1.y, c1.z, c1.w}, snv[8] = {s0.x, s0.y, s0.z, s0.w, s1.x, s1.y, s1.z, s1.w};
            float o[8];
#pragma unroll
            for (int e = 0; e < 8; ++e) o[e] = c4 < 2 ? xn[e] * csv[e] - ot[e] * snv[e] : ot[e] * snv[e] + xn[e] * csv[e];
            float* kf_ = a.krf() + (size_t)row * 32 + 8 * c4; *(float4*)kf_ = (float4){o[0], o[1], o[2], o[3]}; *(float4*)(kf_ + 4) = (float4){o[4], o[5], o[6], o[7]};
            float* ko = samp ? a.out + O_KRS + (size_t)b * 32 + 8 * c4 : a.out + O_KRP + (size_t)row * 32 + 8 * c4;
            *(float4*)ko = (float4){o[0], o[1], o[2], o[3]}; *(float4*)(ko + 4) = (float4){o[4], o[5], o[6], o[7]};
            if (!samp) *(bf16x8*)(a.krb() + (size_t)row * 32 + 8 * c4) = f32_to_bf8(o);
        }
    }
    (void)hd;
}
__device__ __forceinline__ void post_in_run(const MK& a, int run, int lane_in, const float* wcs) {
    int lane = lane_in; asm volatile("" : "+v"(lane));
    PinGain gn;
    {
        const int lq = lane < 48 ? lane : 0, lk = lane < 32 ? lane : 0, c4 = (lane - 32) & 3;
#pragma unroll
        for (int e = 0; e < 8; ++e) { gn.gqa[e] = a.g_q_a[8 * lq + e]; gn.gkv[e] = a.g_kv_a[8 * lk + e]; gn.gkr[e] = a.g_k_rope[8 * c4 + e]; }
        gn.dtb = a.dt_bias[lane & 7]; gn.alog = expf(a.a_log[lane & 7]);
    }
    if (run < NPT / 8) {
        const int row0 = run * 8, t0 = row0 & 2047;
        bf16x8 w0[3], w1[3], w2[3], wcur[3];
#pragma unroll
        for (int c3 = 0; c3 < 3; ++c3) {
            const bf16x8 zz = {0, 0, 0, 0, 0, 0, 0, 0}; w0[c3] = zz; w1[c3] = zz; w2[c3] = zz;
            if (t0 > 0) { const bf16_t* zp = a.Z() + (size_t)(row0 - 3) * ZW + 512 * c3 + 8 * lane; w0[c3] = *(const bf16x8*)zp; w1[c3] = *(const bf16x8*)(zp + ZW); w2[c3] = *(const bf16x8*)(zp + 2 * ZW); }
        }
        bf16x8 wnext[3]; PinTok tk, tkn;
#pragma unroll
        for (int c3 = 0; c3 < 3; ++c3) wnext[c3] = *(const bf16x8*)(a.Z() + (size_t)row0 * ZW + 512 * c3 + 8 * lane);
        tkn = pin_load(a, row0, lane);
#pragma unroll 1
        for (int k = 0; k < 8; ++k) {
            const int row = row0 + k;
#pragma unroll
            for (int c3 = 0; c3 < 3; ++c3) wcur[c3] = wnext[c3];
            tk = tkn;
            if (k < 7) {
#pragma unroll
                for (int c3 = 0; c3 < 3; ++c3) wnext[c3] = *(const bf16x8*)(a.Z() + (size_t)(row + 1) * ZW + 512 * c3 + 8 * lane);
                tkn = pin_load(a, row + 1, lane);
            }
            post_in_token(a, row, lane, wcs, w0, w1, w2, wcur, tk, gn);
#pragma unroll
            for (int c3 = 0; c3 < 3; ++c3) { w0[c3] = w1[c3]; w1[c3] = w2[c3]; w2[c3] = wcur[c3]; }
        }
    } else {
        {
            const int bsm = run - NPT / 8, row = NPT + bsm;
            bf16x8 w0[3], w1[3], w2[3], wcur[3];
#pragma unroll
            for (int c3 = 0; c3 < 3; ++c3) {
                const float* sp = a.state_conv + (size_t)bsm * 3 * 1536 + 512 * c3 + 8 * lane;
                float* cso = a.out + O_CSS + (size_t)bsm * 3 * 1536 + 512 * c3 + 8 * lane;
                float t0_[8], t1_[8], t2_[8], tc_[8];
#pragma unroll
                for (int e = 0; e < 8; ++e) { t0_[e] = sp[e]; t1_[e] = sp[1536 + e]; t2_[e] = sp[2 * 1536 + e]; }
                wcur[c3] = *(const bf16x8*)(a.Z() + (size_t)row * ZW + 512 * c3 + 8 * lane); bf8_to_f32(wcur[c3], tc_);
#pragma unroll
                for (int e = 0; e < 8; ++e) { cso[e] = t1_[e]; cso[1536 + e] = t2_[e]; cso[2 * 1536 + e] = tc_[e]; }
                w0[c3] = f32_to_bf8(t0_); w1[c3] = f32_to_bf8(t1_); w2[c3] = f32_to_bf8(t2_);
            }
            post_in_token(a, row, lane, wcs, w0, w1, w2, wcur, pin_load(a, row, lane), gn);
        }
    }
}

__device__ __forceinline__ void post_q_item(const MK& a, int idx, int lane) {
    const int row = idx >> 3, h = idx & 7;
    const float* q = a.Q() + (size_t)row * 768 + h * 96;
    float* o = a.qh() + ((size_t)row * 8 + h) * 96;
    const float v = q[lane];
    const float ss = wave_sum(v * v);
    o[lane] = v * rsqrtf(ss * (1.f / 64.f) + EPSV) * a.g_q_nope[lane];
    const float r = lane < 32 ? q[64 + lane] : 0.f;
    const float s2 = wave_sum(r * r);
    const float xn = lane < 32 ? r * rsqrtf(s2 * (1.f / 32.f) + EPSV) * a.g_q_rope[lane] : 0.f;
    const float other = __shfl_xor(xn, 16);
    const int i = lane & 15;
    const float* tb = a.ropecs() + (size_t)(row >= NPT ? 2048 : (row & 2047)) * 32;
    const float cs = tb[i], sn = tb[16 + i];
    const float ov = lane < 16 ? xn * cs - other * sn : other * sn + xn * cs;
    if (lane < 32) o[64 + lane] = ov;
}
__device__ __forceinline__ void post_kv_item(const MK& a, int idx, int lane) {
    const int row = idx >> 3, h = idx & 7;
    const float v = a.KV()[(size_t)row * 1024 + h * 128 + lane];
    const float ss = wave_sum(v * v);
    const float kn = v * rsqrtf(ss * (1.f / 64.f) + EPSV) * a.g_k_nope[lane];
    a.kh()[((size_t)row * 8 + h) * 64 + lane] = kn;
}

typedef float f32x16 __attribute__((ext_vector_type(16)));
typedef short s16x4 __attribute__((ext_vector_type(4)));
#define KST 104
#define VST 72
#define ATT_BUF (64 * KST * 2 + 64 * VST * 2)
__device__ __forceinline__ int crow32(int r, int hi) { return (r & 3) + 8 * (r >> 2) + 4 * hi; }
__device__ __forceinline__ s16x4 tr_read(const bf16_t* p) { return __builtin_bit_cast(s16x4, __builtin_amdgcn_ds_read_tr16_b64_v4i16((LAS s16x4*)(LAS void*)(unsigned)(size_t)p)); }
__device__ __forceinline__ bf16x8 pack8(const f32x16& x, int s) {
    u32x4 w; w.x = cvtpk(x[8 * s], x[8 * s + 1]); w.y = cvtpk(x[8 * s + 2], x[8 * s + 3]); w.z = cvtpk(x[8 * s + 4], x[8 * s + 5]); w.w = cvtpk(x[8 * s + 6], x[8 * s + 7]);
    return __builtin_bit_cast(bf16x8, w);
}
__device__ __forceinline__ void attn_block(const MK& a, int b, int h, int qb, char* smem) {
    const int tid = otid(), lane = tid & 63, wid = tid >> 6, r32 = lane & 31, hi = lane >> 5;
    const int qrow = qb * 256 + wid * 32 + r32;
    const int wq0 = qb * 256 + wid * 32;
    bf16x8 qf[6];
    {
        const float SCL = 0.14724445f;
        const bf16_t* Qg = a.qraw() + ((size_t)b * SEQ + qrow) * 768 + h * 96 + 8 * hi;
        float qv[6][8];
#pragma unroll
        for (int ds = 0; ds < 6; ++ds) bf8_to_f32(*(const bf16x8*)(Qg + 16 * ds), qv[ds]);
        float sn_ = 0.f, sr_ = 0.f;
#pragma unroll
        for (int j = 0; j < 8; ++j) { sn_ += qv[0][j] * qv[0][j] + qv[1][j] * qv[1][j] + qv[2][j] * qv[2][j] + qv[3][j] * qv[3][j]; sr_ += qv[4][j] * qv[4][j] + qv[5][j] * qv[5][j]; }
        sn_ = add_x32(sn_); sr_ = add_x32(sr_);
        const float rsn = rsqrtf(sn_ * (1.f / 64.f) + EPSV) * SCL, rsr = rsqrtf(sr_ * (1.f / 32.f) + EPSV);
#pragma unroll
        for (int ds = 0; ds < 4; ++ds) {
            float o[8];
#pragma unroll
            for (int j = 0; j < 8; ++j) o[j] = qv[ds][j] * rsn * a.g_q_nope[16 * ds + 8 * hi + j];
            qf[ds] = f32_to_bf8(o);
        }
        const float* tb = a.ropecs() + (size_t)qrow * 32 + 8 * hi;
        float o4[8], o5[8];
#pragma unroll
        for (int j = 0; j < 8; ++j) {
            const float x1 = qv[4][j] * rsr * a.g_q_rope[8 * hi + j], x2 = qv[5][j] * rsr * a.g_q_rope[16 + 8 * hi + j], cs = tb[j], sn = tb[16 + j];
            o4[j] = (x1 * cs - x2 * sn) * SCL; o5[j] = (x1 * sn + x2 * cs) * SCL;
        }
        qf[4] = f32_to_bf8(o4); qf[5] = f32_to_bf8(o5);
    }
    f32x16 o0, o1;
#pragma unroll
    for (int r = 0; r < 16; ++r) { o0[r] = 0.f; o1[r] = 0.f; }
    float m = 0.f, l = 0.f;
    f32x16 negm;
#pragma unroll
    for (int r = 0; r < 16; ++r) negm[r] = 0.f;
    const int nt = qb * 4 + 4;
    const int vr = tid >> 3, vc = tid & 7, rr_ = (tid >> 2) & 63, rc = tid & 3;
    const bf16_t* KVg = a.kvraw() + (size_t)b * SEQ * 1024 + h * 128 + (size_t)vr * 1024 + vc * 8;
    const bf16_t* KRg = a.krb() + (size_t)b * SEQ * 32 + (size_t)rr_ * 32 + rc * 8;
    float gk[8];
#pragma unroll
    for (int j = 0; j < 8; ++j) gk[j] = a.g_k_nope[8 * vc + j];
    bf16x8 kr0, kr1, vr0;
#define ATT_LOAD(tt) do { kr0 = *(const bf16x8*)(KVg + (size_t)(tt) * 64 * 1024); vr0 = *(const bf16x8*)(KVg + (size_t)(tt) * 64 * 1024 + 64); if (tid < 256) kr1 = *(const bf16x8*)(KRg + (size_t)(tt) * 64 * 32); } while (0)
#define ATT_STORE(buf) do { bf16_t* Ks_ = (bf16_t*)(smem + (buf) * ATT_BUF); bf16_t* Vs_ = Ks_ + 64 * KST; \
        float x_[8]; bf8_to_f32(kr0, x_); float ss_ = 0.f; _Pragma("unroll") for (int j = 0; j < 8; ++j) ss_ += x_[j] * x_[j]; \
        ss_ = sum8(ss_); const float rs_ = rsqrtf(ss_ * (1.f / 64.f) + EPSV); \
        _Pragma("unroll") for (int j = 0; j < 8; ++j) x_[j] *= rs_ * gk[j]; \
        *(bf16x8*)(Ks_ + vr * KST + vc * 8) = f32_to_bf8(x_); *(bf16x8*)(Vs_ + vr * VST + vc * 8) = vr0; \
        if (tid < 256) *(bf16x8*)(Ks_ + rr_ * KST + 64 + rc * 8) = kr1; } while (0)
    ATT_LOAD(0);
    __syncthreads();
    ATT_STORE(0);
    __syncthreads();
    const int i16 = lane & 15, qq = i16 >> 2, pp = i16 & 3, g1 = (lane >> 4) & 1;
    for (int t = 0; t < nt; ++t) {
        const bf16_t* Ks = (const bf16_t*)(smem + (t & 1) * ATT_BUF); const bf16_t* Vs = Ks + 64 * KST;
        if (t + 1 < nt) ATT_LOAD(t + 1);
        if (64 * t <= wq0 + 31) {
            f32x16 p0, p1;
#pragma unroll
            for (int ds = 0; ds < 6; ++ds) {
                const bf16x8 k0 = *(const bf16x8*)(Ks + r32 * KST + 16 * ds + 8 * hi);
                const bf16x8 k1 = *(const bf16x8*)(Ks + (32 + r32) * KST + 16 * ds + 8 * hi);
                if (ds == 0) { p0 = __builtin_amdgcn_mfma_f32_32x32x16_bf16(k0, qf[ds], negm, 0, 0, 0); p1 = __builtin_amdgcn_mfma_f32_32x32x16_bf16(k1, qf[ds], negm, 0, 0, 0); }
                else { p0 = __builtin_amdgcn_mfma_f32_32x32x16_bf16(k0, qf[ds], p0, 0, 0, 0); p1 = __builtin_amdgcn_mfma_f32_32x32x16_bf16(k1, qf[ds], p1, 0, 0, 0); }
            }
            if (64 * t + 63 > wq0) {
#pragma unroll
                for (int r = 0; r < 16; ++r) { const int kv = 64 * t + crow32(r, hi); if (kv > qrow) p0[r] = -INFINITY; if (kv + 32 > qrow) p1[r] = -INFINITY; }
            }
            float mx = fmaxf(p0[0], p1[0]);
#pragma unroll
            for (int r = 1; r < 16; ++r) mx = fmaxf(mx, fmaxf(p0[r], p1[r]));
            mx = max_x32(mx);
            const float delta = t == 0 ? mx : fmaxf(mx, 0.f);
            if (__any(delta != 0.f)) {
                m += delta;
                const float f = t == 0 ? 1.f : __builtin_amdgcn_exp2f(-delta);
#pragma unroll
                for (int r = 0; r < 16; ++r) { p0[r] -= delta; p1[r] -= delta; negm[r] = -m; o0[r] *= f; o1[r] *= f; }
                l *= f;
            }
            float rs = 0.f;
#pragma unroll
            for (int r = 0; r < 16; ++r) { p0[r] = __builtin_amdgcn_exp2f(p0[r]); p1[r] = __builtin_amdgcn_exp2f(p1[r]); rs += p0[r] + p1[r]; }
            l += rs;
            bf16x8 pf[4];
            pf[0] = pack8(p0, 0); pf[1] = pack8(p0, 1); pf[2] = pack8(p1, 0); pf[3] = pack8(p1, 1);
#pragma unroll
            for (int ks = 0; ks < 4; ++ks) {
                const bf16_t* vb0 = Vs + (16 * ks + 4 * hi + qq) * VST + 16 * g1 + 4 * pp;
                const s16x4 a0 = tr_read(vb0), a1 = tr_read(vb0 + 8 * VST);
                const s16x4 c0 = tr_read(vb0 + 32), c1 = tr_read(vb0 + 8 * VST + 32);
                const bf16x8 va = __builtin_shufflevector(a0, a1, 0, 1, 2, 3, 4, 5, 6, 7);
                const bf16x8 vc_ = __builtin_shufflevector(c0, c1, 0, 1, 2, 3, 4, 5, 6, 7);
                o0 = __builtin_amdgcn_mfma_f32_32x32x16_bf16(va, pf[ks], o0, 0, 0, 0);
                o1 = __builtin_amdgcn_mfma_f32_32x32x16_bf16(vc_, pf[ks], o1, 0, 0, 0);
            }
        }
        if (t + 1 < nt) ATT_STORE((t + 1) & 1);
        __syncthreads();
    }
    l = add_x32(l);
    const float il = 1.f / l;
    bf16_t* op = a.omix() + ((size_t)b * SEQ + qrow) * 1024 + 512 + h * 64;
#pragma unroll
    for (int g = 0; g < 4; ++g) {
        uint2 w0, w1;
        w0.x = pk2bf(o0[4 * g] * il, o0[4 * g + 1] * il); w0.y = pk2bf(o0[4 * g + 2] * il, o0[4 * g + 3] * il);
        w1.x = pk2bf(o1[4 * g] * il, o1[4 * g + 1] * il); w1.y = pk2bf(o1[4 * g + 2] * il, o1[4 * g + 3] * il);
        *(uint2*)(op + 8 * g + 4 * hi) = w0;
        *(uint2*)(op + 32 + 8 * g + 4 * hi) = w1;
    }
#undef ATT_LOAD
#undef ATT_STORE
}

__device__ __forceinline__ void gdn_unit(const MK& a, int b, int h, int dvg, const float* s0, float* sout, int row0, int T, int lane, char* wsm) {
    float (*sq)[64] = (float (*)[64])wsm;
    float (*sk)[64] = (float (*)[64])(wsm + 4096);
    float (*sv)[8] = (float (*)[8])(wsm + 8192);
    float* sg = (float*)(wsm + 8704);
    float* sb = (float*)(wsm + 8768);
    const int e = lane & 7, ko = lane >> 3, col = dvg * 8 + e;
    float S[8];
#pragma unroll
    for (int d = 0; d < 8; ++d) S[d] = s0 ? s0[(((size_t)b * 8 + h) * 64 + ko * 8 + d) * 64 + col] : 0.f;
    const size_t rbase = (size_t)row0 + (size_t)b * T;
    float pq[16], pk[16], pv0, pv1, pgb;
    {
        const int nt = T < 16 ? T : 16;
#pragma unroll
        for (int j = 0; j < 16; ++j) { const bool ok = j < nt; const size_t r = rbase + (ok ? j : 0); pq[j] = ok ? bf2f(a.qkv()[r * 1536 + h * 64 + lane]) : 0.f; pk[j] = ok ? bf2f(a.qkv()[r * 1536 + 512 + h * 64 + lane]) : 0.f; }
        { const int j0 = lane >> 3, j1 = j0 + 8; pv0 = j0 < nt ? bf2f(a.qkv()[(rbase + j0) * 1536 + 1024 + h * 64 + dvg * 8 + (lane & 7)]) : 0.f; pv1 = j1 < nt ? bf2f(a.qkv()[(rbase + j1) * 1536 + 1024 + h * 64 + dvg * 8 + (lane & 7)]) : 0.f; }
        { const int j = lane & 15; pgb = j < nt ? (lane < 16 ? a.gg()[(rbase + j) * 8 + h] : a.bb()[(rbase + j) * 8 + h]) : 0.f; }
    }
    for (int t0 = 0; t0 < T; t0 += 16) {
        const int nt = (T - t0) < 16 ? (T - t0) : 16;
        WSYNC();
#pragma unroll
        for (int j = 0; j < 16; ++j) { sq[j][lane] = pq[j]; sk[j][lane] = pk[j]; }
        sv[lane >> 3][lane & 7] = pv0; sv[(lane >> 3) + 8][lane & 7] = pv1;
        if (lane < 16) sg[lane] = expf(pgb); else if (lane < 32) sb[lane - 16] = pgb;
        WSYNC();
        if (t0 + 16 < T) {
            const size_t rb = rbase + t0 + 16;
#pragma unroll
            for (int j = 0; j < 16; ++j) { pq[j] = bf2f(a.qkv()[(rb + j) * 1536 + h * 64 + lane]); pk[j] = bf2f(a.qkv()[(rb + j) * 1536 + 512 + h * 64 + lane]); }
            pv0 = bf2f(a.qkv()[(rb + (lane >> 3)) * 1536 + 1024 + h * 64 + dvg * 8 + (lane & 7)]); pv1 = bf2f(a.qkv()[(rb + (lane >> 3) + 8) * 1536 + 1024 + h * 64 + dvg * 8 + (lane & 7)]);
            pgb = lane < 16 ? a.gg()[(rb + (lane & 15)) * 8 + h] : a.bb()[(rb + (lane & 15)) * 8 + h];
        }
        for (int j = 0; j < nt; ++j) {
            const float dec = sg[j], be = sb[j], v = sv[j][e];
            const float4 k0 = *(const float4*)&sk[j][ko * 8], k1 = *(const float4*)&sk[j][ko * 8 + 4];
            const float4 q0 = *(const float4*)&sq[j][ko * 8], q1 = *(const float4*)&sq[j][ko * 8 + 4];
            const float kk[8] = {k0.x, k0.y, k0.z, k0.w, k1.x, k1.y, k1.z, k1.w};
            const float qq[8] = {q0.x, q0.y, q0.z, q0.w, q1.x, q1.y, q1.z, q1.w};
            float ks = 0.f;
#pragma unroll
            for (int d = 0; d < 8; ++d) { S[d] *= dec; ks += kk[d] * S[d]; }
            ks += __shfl_xor(ks, 8); ks += __shfl_xor(ks, 16); ks += __shfl_xor(ks, 32);
            const float delta = (v - ks) * be;
            float ov = 0.f;
#pragma unroll
            for (int d = 0; d < 8; ++d) { S[d] += kk[d] * delta; ov += qq[d] * S[d]; }
            ov += __shfl_xor(ov, 8); ov += __shfl_xor(ov, 16); ov += __shfl_xor(ov, 32);
            if (ko == 0) a.goraw()[(rbase + t0 + j) * 512 + h * 64 + col] = ov;
        }
    }
#pragma unroll
    for (int d = 0; d < 8; ++d) sout[(((size_t)b * 8 + h) * 64 + ko * 8 + d) * 64 + col] = S[d];
}
__device__ __forceinline__ int pi_pos(int k) { return (k & 32) + 8 * ((k >> 2) & 3) + 4 * ((k >> 4) & 1) + (k & 3); }
#define GDN_WLDS 17408
__device__ __forceinline__ void gdn_prep_unit(const MK& a, int u, int lane_in, char* wsm) {
    int lane = lane_in; asm volatile("" : "+v"(lane));
    const int bh = u >> 5, n = u & 31, b = bh >> 3, h = bh & 7, i16 = lane & 15, q4 = lane >> 4;
    const size_t row0 = (size_t)b * SEQ + n * 64;
    float* AT = (float*)wsm; float* GC = (float*)(wsm + 16384); float* BT = GC + 64;
    const bf16_t* qbase = a.qkv() + row0 * 1536 + h * 64; const bf16_t* kbase = qbase + 512; const bf16_t* vbase = qbase + 1024;
    float g = a.gg()[(row0 + lane) * 8 + h];
    const float be_l = a.bb()[(row0 + lane) * 8 + h];
#pragma unroll
    for (int o = 1; o < 64; o <<= 1) { const float t = __shfl_up(g, o); if (lane >= o) g += t; }
    WSYNC();
    GC[lane] = g; BT[lane] = be_l;
    WSYNC();
    const float gl = GC[63];
    float* EG = BT + 64; float* ED = EG + 64;
    EG[lane] = expf(g); ED[lane] = expf(gl - g);
    WSYNC();
    bf16x8 kf[4][2], qf[4][2];
#pragma unroll
    for (int mt = 0; mt < 4; ++mt)
#pragma unroll
        for (int ks = 0; ks < 2; ++ks) {
            const int off = (16 * mt + i16) * 1536 + 32 * ks + 8 * q4;
            kf[mt][ks] = *(const bf16x8*)(kbase + off); qf[mt][ks] = *(const bf16x8*)(qbase + off);
        }
    bf16_t* QKg = a.gQK() + (size_t)u * 4096;
#pragma unroll
    for (int mt = 0; mt < 4; ++mt)
#pragma unroll
        for (int nt = 0; nt < 4; ++nt) {
            const int j = 16 * nt + i16, pj = 32 * (nt >> 1) + 8 * (i16 >> 2) + 4 * (nt & 1) + (i16 & 3);
            if (nt <= mt) {
                f32x4 d1 = {0.f, 0.f, 0.f, 0.f}, d2 = {0.f, 0.f, 0.f, 0.f};
#pragma unroll
                for (int ks = 0; ks < 2; ++ks) {
                    d1 = __builtin_amdgcn_mfma_f32_16x16x32_bf16(kf[mt][ks], kf[nt][ks], d1, 0, 0, 0);
                    d2 = __builtin_amdgcn_mfma_f32_16x16x32_bf16(qf[mt][ks], kf[nt][ks], d2, 0, 0, 0);
                }
                const float gcj = GC[j];
#pragma unroll
                for (int r = 0; r < 4; ++r) {
                    const int i = 16 * mt + 4 * q4 + r;
                    const float dec = __builtin_amdgcn_exp2f(1.44269504f * (GC[i] - gcj));
                    AT[i * 64 + j] = (i > j) ? BT[i] * d1[r] * dec : 0.f;
                    QKg[i * 64 + (((pj >> 3) ^ (i & 7)) << 3) + (pj & 7)] = f2bf((i >= j) ? d2[r] * dec : 0.f);
                }
            } else {
#pragma unroll
                for (int r = 0; r < 4; ++r) { const int i = 16 * mt + 4 * q4 + r; QKg[i * 64 + (((pj >> 3) ^ (i & 7)) << 3) + (pj & 7)] = 0; }
            }
        }
    {
        bf16_t* Qgg = a.gQg() + (size_t)u * 4096;
#pragma unroll
        for (int mt = 0; mt < 4; ++mt) {
            const int i = 16 * mt + i16; const float e = EG[i];
#pragma unroll
            for (int ks = 0; ks < 2; ++ks) {
                float x[8]; bf8_to_f32(qf[mt][ks], x);
                uint2 w0, w1; w0.x = cvtpk(x[0] * e, x[1] * e); w0.y = cvtpk(x[2] * e, x[3] * e); w1.x = cvtpk(x[4] * e, x[5] * e); w1.y = cvtpk(x[6] * e, x[7] * e);
                const int p0 = 32 * ks + 16 * (q4 & 1) + 4 * (q4 >> 1);
                *(uint2*)(Qgg + i * 64 + (((p0 >> 3) ^ (i & 7)) << 3) + (p0 & 7)) = w0; *(uint2*)(Qgg + i * 64 + ((((p0 >> 3) + 1) ^ (i & 7)) << 3) + (p0 & 7)) = w1;
            }
        }
    }
    WSYNC();
    __builtin_amdgcn_sched_barrier(0);
    {
        float U[64];
#pragma unroll
        for (int i = 0; i < 64; ++i) { U[i] = bf2f(vbase[i * 1536 + lane]) * BT[i]; }
#pragma unroll
        for (int i = 1; i < 64; ++i) {
            float su = 0.f;
#pragma unroll
            for (int j4 = 0; j4 < i; j4 += 4) {
                const float4 av = *(const float4*)(AT + i * 64 + j4);
                su += av.x * U[j4];
                if (j4 + 1 < i) su += av.y * U[j4 + 1];
                if (j4 + 2 < i) su += av.z * U[j4 + 2];
                if (j4 + 3 < i) su += av.w * U[j4 + 3];
            }
            U[i] -= su;
            __builtin_amdgcn_sched_barrier(0);
        }
        float* UTg = a.gUT() + ((size_t)u * 64 + lane) * 64;
#pragma unroll
        for (int i = 0; i < 64; i += 4) *(float4*)(UTg + 4 * ((i >> 2) ^ (lane & 15))) = (float4){U[i], U[i + 1], U[i + 2], U[i + 3]};
    }
    asm volatile("" ::: "memory");
    __builtin_amdgcn_sched_barrier(0);
    {
        float W[64];
#pragma unroll
        for (int i = 0; i < 64; ++i) { W[i] = bf2f(kbase[i * 1536 + lane]); }
        bf16_t* Kdg = a.gKd() + ((size_t)u * 64 + lane) * 64;
#pragma unroll
        for (int pc = 0; pc < 8; ++pc) {
            float t[8];
#pragma unroll
            for (int jj = 0; jj < 8; ++jj) { const int j = 32 * (pc >> 2) + 16 * (jj >> 2) + 4 * (pc & 3) + (jj & 3); t[jj] = W[j] * ED[j]; }
            u32x4 w; w.x = cvtpk(t[0], t[1]); w.y = cvtpk(t[2], t[3]); w.z = cvtpk(t[4], t[5]); w.w = cvtpk(t[6], t[7]);
            *(u32x4*)(Kdg + 8 * (pc ^ (lane & 7))) = w;
        }
#pragma unroll
        for (int i = 0; i < 64; ++i) W[i] *= BT[i] * EG[i];
#pragma unroll
        for (int i = 1; i < 64; ++i) {
            float sw = 0.f;
#pragma unroll
            for (int j4 = 0; j4 < i; j4 += 4) {
                const float4 av = *(const float4*)(AT + i * 64 + j4);
                sw += av.x * W[j4];
                if (j4 + 1 < i) sw += av.y * W[j4 + 1];
                if (j4 + 2 < i) sw += av.z * W[j4 + 2];
                if (j4 + 3 < i) sw += av.w * W[j4 + 3];
            }
            W[i] -= sw;
            __builtin_amdgcn_sched_barrier(0);
        }
        bf16_t* Wng = a.gWn() + (size_t)u * 4096; const int pp = pi_pos(lane);
#pragma unroll
        for (int i = 0; i < 64; ++i) Wng[i * 64 + (((pp >> 3) ^ (i & 7)) << 3) + (pp & 7)] = f2bf(-W[i]);
    }
    if (lane == 0) a.ggam()[u] = expf(gl);
}
__device__ __forceinline__ bf16x8 pack_acc2(const f32x4& x, const f32x4& y) {
    u32x4 w; w.x = cvtpk(x[0], x[1]); w.y = cvtpk(x[2], x[3]); w.z = cvtpk(y[0], y[1]); w.w = cvtpk(y[2], y[3]);
    return __builtin_bit_cast(bf16x8, w);
}
#define G2_SLOT 49152
__device__ __forceinline__ void g2_issue(const MK& a, size_t u, int n, LAS unsigned char* lds, int lw, int lane) {
    LAS unsigned char* dst = lds + (n % 3) * G2_SLOT;
    const char* srcs[4] = {(const char*)(a.gWn() + u * 4096), (const char*)(a.gQg() + u * 4096), (const char*)(a.gQK() + u * 4096), (const char*)(a.gKd() + u * 4096)};
#pragma unroll
    for (int m = 0; m < 4; ++m)
#pragma unroll
        for (int i = 0; i < 2; ++i) { const int piece = 2 * lw + i;
            __builtin_amdgcn_global_load_lds((const unsigned*)(srcs[m] + piece * 1024 + lane * 16), (LAS unsigned*)(dst + m * 8192 + piece * 1024), 16, 0, 0); }
    const char* us = (const char*)(a.gUT() + u * 4096);
#pragma unroll
    for (int i = 0; i < 4; ++i) { const int piece = 4 * lw + i;
        __builtin_amdgcn_global_load_lds((const unsigned*)(us + piece * 1024 + lane * 16), (LAS unsigned*)(dst + 32768 + piece * 1024), 16, 0, 0); }
}
__device__ __forceinline__ void gdn_scan_block(const MK& a, int bh, LAS unsigned char* lds) {
    const int tid = otid(), lane = tid & 63, wid = __builtin_amdgcn_readfirstlane(tid >> 6), i16 = lane & 15, q4 = lane >> 4;
    const int b = bh >> 3, h = bh & 7, sl = wid & 3;
    const bool loader = wid >= 4;
    f32x4 S[4];
#pragma unroll
    for (int mt = 0; mt < 4; ++mt) S[mt] = (f32x4){0.f, 0.f, 0.f, 0.f};
    __syncthreads();
    if (loader) { g2_issue(a, (size_t)bh * 32, 0, lds, wid - 4, lane); g2_issue(a, (size_t)bh * 32 + 1, 1, lds, wid - 4, lane); }
    for (int n = 0; n < 32; ++n) {
        if (loader) { if (n < 31) asm volatile("s_waitcnt vmcnt(12)" ::: "memory"); else asm volatile("s_waitcnt vmcnt(0)" ::: "memory"); }
        asm volatile("s_waitcnt lgkmcnt(0)" ::: "memory"); __builtin_amdgcn_s_barrier(); asm volatile("" ::: "memory");
        if (loader) { if (n + 2 < 32) g2_issue(a, (size_t)bh * 32 + n + 2, n + 2, lds, wid - 4, lane); }
        else {
            const LAS unsigned char* sb = lds + (n % 3) * G2_SLOT;
            const float gam = a.ggam()[(size_t)bh * 32 + n];
            bf16x8 Sb[2]; Sb[0] = pack_acc2(S[0], S[1]); Sb[1] = pack_acc2(S[2], S[3]);
            f32x4 Vn[4];
#pragma unroll
            for (int mt = 0; mt < 4; ++mt) Vn[mt] = *(const LAS f32x4*)(sb + 32768 + (16 * sl + i16) * 256 + 16 * ((4 * mt + q4) ^ i16));
#pragma unroll
            for (int mt = 0; mt < 4; ++mt)
#pragma unroll
                for (int ks = 0; ks < 2; ++ks) Vn[mt] = __builtin_amdgcn_mfma_f32_16x16x32_bf16(*(const LAS bf16x8*)(sb + (16 * mt + i16) * 128 + 16 * ((4 * ks + q4) ^ (i16 & 7))), Sb[ks], Vn[mt], 0, 0, 0);
            bf16x8 Vb[2]; Vb[0] = pack_acc2(Vn[0], Vn[1]); Vb[1] = pack_acc2(Vn[2], Vn[3]);
            f32x4 O[4];
#pragma unroll
            for (int mt = 0; mt < 4; ++mt) {
                O[mt] = (f32x4){0.f, 0.f, 0.f, 0.f};
#pragma unroll
                for (int ks = 0; ks < 2; ++ks) {
                    const int fo = (16 * mt + i16) * 128 + 16 * ((4 * ks + q4) ^ (i16 & 7));
                    O[mt] = __builtin_amdgcn_mfma_f32_16x16x32_bf16(*(const LAS bf16x8*)(sb + 8192 + fo), Sb[ks], O[mt], 0, 0, 0);
                    O[mt] = __builtin_amdgcn_mfma_f32_16x16x32_bf16(*(const LAS bf16x8*)(sb + 16384 + fo), Vb[ks], O[mt], 0, 0, 0);
                }
            }
#pragma unroll
            for (int mt = 0; mt < 4; ++mt) {
                S[mt] = S[mt] * gam;
#pragma unroll
                for (int ks = 0; ks < 2; ++ks) S[mt] = __builtin_amdgcn_mfma_f32_16x16x32_bf16(*(const LAS bf16x8*)(sb + 24576 + (16 * mt + i16) * 128 + 16 * ((4 * ks + q4) ^ (i16 & 7))), Vb[ks], S[mt], 0, 0, 0);
            }
            float* og = a.goraw() + ((size_t)b * SEQ + n * 64 + 4 * q4) * 512 + h * 64 + 16 * sl + i16;
#pragma unroll
            for (int mt = 0; mt < 4; ++mt)
#pragma unroll
                for (int r = 0; r < 4; ++r) og[(size_t)(16 * mt + r) * 512] = O[mt][r];
        }
    }
    if (!loader) {
        float* so = a.out + O_GSP + ((size_t)bh * 64 + 4 * q4) * 64 + 16 * sl + i16;
#pragma unroll
        for (int mt = 0; mt < 4; ++mt)
#pragma unroll
            for (int r = 0; r < 4; ++r) so[(size_t)(16 * mt + r) * 64] = S[mt][r];
    }
    __syncthreads();
}
__device__ __forceinline__ void gdn_out_token(const MK& a, int row, int lane) {
    const float* op = a.goraw() + (size_t)row * 512 + 8 * lane;
    const float4 x0 = *(const float4*)op, x1 = *(const float4*)(op + 4);
    float o[8] = {x0.x, x0.y, x0.z, x0.w, x1.x, x1.y, x1.z, x1.w}, zg[8];
    bf8_to_f32(*(const bf16x8*)(a.Z() + (size_t)row * ZW + OFF_Z + 8 * lane), zg);
    float ss = 0.f;
#pragma unroll
    for (int e = 0; e < 8; ++e) ss += o[e] * o[e];
    ss = sum8(ss);
    const float rs = rsqrtf(ss * (1.f / 64.f) + EPSV);
    const float4 g0 = *(const float4*)(a.g_gdn_out + 8 * (lane & 7)), g1 = *(const float4*)(a.g_gdn_out + 8 * (lane & 7) + 4);
    const float gg_[8] = {g0.x, g0.y, g0.z, g0.w, g1.x, g1.y, g1.z, g1.w};
#pragma unroll
    for (int e = 0; e < 8; ++e) o[e] = o[e] * rs * gg_[e] * zg[e] * fast_sigmoid(zg[e]);
    *(bf16x8*)(a.omix() + (size_t)row * 1024 + 8 * lane) = f32_to_bf8(o);
}

#define SSLOT 32768
#define TL_OFF (3 * SSLOT)
#define CST 264
#define KR_OFF (TL_OFF + 2 * 32 * CST * 2)
#define WQ_OFF (KR_OFF + 4 * 4096)
#define QR_OFF (WQ_OFF + 2048)
#define PG_OFF (QR_OFF + 1024)
#define PT_OFF (PG_OFF + 64)
#define AL_OFF (PT_OFF + 1024)
#define SAMP_LDS_END (AL_OFF + 64)
__device__ __forceinline__ void samp_issue(const MK& a, int g, LAS unsigned char* lds, int wid, int lane) {
    const int phys = __builtin_amdgcn_readfirstlane(((const LAS int*)(lds + PG_OFF))[g >> 2]);
    const int tok0 = (g & 3) * 32 + 4 * wid;
    const float* cs = a.cache_ckv + ((size_t)phys * 128 + tok0) * 256 + lane * 4;
#pragma unroll
    for (int i = 0; i < 4; ++i) __builtin_amdgcn_global_load_lds((const unsigned*)(cs + i * 256), (LAS unsigned*)(lds + (g % 3) * SSLOT + (4 * wid + i) * 1024), 16, 0, 0);
    if (wid < 4) __builtin_amdgcn_global_load_lds((const unsigned*)(a.cache_krope + ((size_t)phys * 128 + (g & 3) * 32 + 8 * wid) * 32 + lane * 4), (LAS unsigned*)(lds + KR_OFF + (g & 3) * 4096 + wid * 1024), 16, 0, 0);
}
__device__ __forceinline__ void samp_convert(int g, LAS unsigned char* lds, int tid) {
    const int st = tid >> 4, c16 = (tid & 15) * 16;
    const LAS float* src = (const LAS float*)(lds + (g % 3) * SSLOT) + st * 256 + c16;
    const f32x4 x0 = *(const LAS f32x4*)src, x1 = *(const LAS f32x4*)(src + 4), x2 = *(const LAS f32x4*)(src + 8), x3 = *(const LAS f32x4*)(src + 12);
    u32x4 w0, w1; w0.x = cvtpk(x0[0], x0[1]); w0.y = cvtpk(x0[2], x0[3]); w0.z = cvtpk(x1[0], x1[1]); w0.w = cvtpk(x1[2], x1[3]);
    w1.x = cvtpk(x2[0], x2[1]); w1.y = cvtpk(x2[2], x2[3]); w1.z = cvtpk(x3[0], x3[1]); w1.w = cvtpk(x3[2], x3[3]);
    LAS bf16_t* dst = (LAS bf16_t*)(lds + TL_OFF + (g & 1) * 32 * CST * 2) + st * CST + c16;
    *(LAS u32x4*)dst = w0; *(LAS u32x4*)(dst + 8) = w1;
}
#define SAMP_WAITV(n5, n4) do { if (h < 4) asm volatile("s_waitcnt vmcnt(" #n5 ")" ::: "memory"); else asm volatile("s_waitcnt vmcnt(" #n4 ")" ::: "memory"); } while (0)
#define SAMP_BAR() do { asm volatile("s_waitcnt lgkmcnt(0)" ::: "memory"); __builtin_amdgcn_s_barrier(); asm volatile("" ::: "memory"); } while (0)
__device__ __forceinline__ void samp_attn_unit(const MK& a, int u, char* smem, LAS unsigned char* lds) {
    const int tid = otid(), lane = tid & 63, h = __builtin_amdgcn_readfirstlane(tid >> 6), i16 = lane & 15, q4 = lane >> 4;
    const int b = u >> 3, sp = u & 7;
    float* WQ = (float*)(smem + WQ_OFF);
    float* QR = (float*)(smem + QR_OFF);
    int* PG = (int*)(smem + PG_OFF);
    const float SCL = 0.14724445f;
    post_q_item(a, (NPT + b) * 8 + h, lane);
    __syncthreads();
    {
        const int h_ = tid >> 6, l_ = tid & 63, q4_ = l_ >> 4, idx = l_ & 15, d = 16 * (idx >> 2) + 4 * q4_ + (idx & 3);
        WQ[tid] = a.g_k_nope[d] * a.qh()[((size_t)(NPT + b) * 8 + h_) * 96 + d] * SCL;
        if (tid < 256) QR[tid] = a.qh()[((size_t)(NPT + b) * 8 + (tid >> 5)) * 96 + 64 + (tid & 31)] * SCL;
        if (tid < 16) PG[tid] = a.page_table[b * NPAGES + sp * 16 + tid];
    }
    bf16x8 wf[4][8];
#pragma unroll
    for (int mt = 0; mt < 4; ++mt)
#pragma unroll
        for (int ks = 0; ks < 8; ++ks) wf[mt][ks] = *(const bf16x8*)(a.WknT() + (size_t)(h * 64 + 16 * mt + i16) * 256 + 32 * ks + 8 * q4);
#pragma unroll
    for (int mt = 0; mt < 4; ++mt)
#pragma unroll
        for (int ks = 0; ks < 8; ++ks) asm volatile("" : "+v"(wf[mt][ks]));
    __syncthreads();
    samp_issue(a, 0, lds, h, lane); samp_issue(a, 1, lds, h, lane); samp_issue(a, 2, lds, h, lane);
    SAMP_WAITV(10, 8);
    SAMP_BAR();
    samp_convert(0, lds, tid);
    const LAS float* QRl = (const LAS float*)(lds + QR_OFF) + h * 32 + 8 * q4;
    const LAS float* WQl = (const LAS float*)(lds + WQ_OFF) + (h * 4 + q4) * 16;
    f32x4 wqr[4], qrr[2];
#pragma unroll
    for (int mt = 0; mt < 4; ++mt) wqr[mt] = *(const LAS f32x4*)(WQl + 4 * mt);
    qrr[0] = *(const LAS f32x4*)QRl; qrr[1] = *(const LAS f32x4*)(QRl + 4);
    float m = -INFINITY, lsum = 0.f;
    f32x4 latv[2]; latv[0] = (f32x4){0.f, 0.f, 0.f, 0.f}; latv[1] = (f32x4){0.f, 0.f, 0.f, 0.f};
    for (int g = 0; g < 64; ++g) {
        SAMP_BAR();
        if (g + 3 < 64) samp_issue(a, g + 3, lds, h, lane);
        const LAS bf16_t* Tl = (const LAS bf16_t*)(lds + TL_OFF + (g & 1) * 32 * CST * 2); const LAS float* KR = (const LAS float*)(lds + KR_OFF + (g & 3) * 4096);
        float scv;
        {
            float ssp[2], dotp[2], rdp[2];
            f32x4 acc[2][4];
#pragma unroll
            for (int hf = 0; hf < 2; ++hf)
#pragma unroll
                for (int mt = 0; mt < 4; ++mt) acc[hf][mt] = (f32x4){0.f, 0.f, 0.f, 0.f};
            const LAS bf16_t* cp0 = Tl + i16 * CST + 8 * q4; const LAS bf16_t* cp1 = cp0 + 16 * CST;
            bf16x8 c0 = *(const LAS bf16x8*)cp0, c1 = *(const LAS bf16x8*)cp1;
#pragma unroll
            for (int ks = 0; ks < 8; ++ks) {
                bf16x8 n0 = c0, n1 = c1;
                if (ks < 7) { n0 = *(const LAS bf16x8*)(cp0 + 32 * (ks + 1)); n1 = *(const LAS bf16x8*)(cp1 + 32 * (ks + 1)); }
#pragma unroll
                for (int mt = 0; mt < 4; ++mt) { acc[0][mt] = __builtin_amdgcn_mfma_f32_16x16x32_bf16(wf[mt][ks], c0, acc[0][mt], 0, 0, 0); acc[1][mt] = __builtin_amdgcn_mfma_f32_16x16x32_bf16(wf[mt][ks], c1, acc[1][mt], 0, 0, 0); }
                c0 = n0; c1 = n1;
            }
#pragma unroll
            for (int hf = 0; hf < 2; ++hf) {
                f32x2_t ss2 = {0.f, 0.f}, dot2 = {0.f, 0.f}, rd2 = {0.f, 0.f};
#pragma unroll
                for (int mt = 0; mt < 4; ++mt) {
                    const f32x4 wq = wqr[mt];
                    const f32x4 av = acc[hf][mt];
                    const f32x2_t lo = __builtin_shufflevector(av, av, 0, 1), hi = __builtin_shufflevector(av, av, 2, 3);
                    ss2 = __builtin_elementwise_fma(lo, lo, ss2); ss2 = __builtin_elementwise_fma(hi, hi, ss2);
                    dot2 = __builtin_elementwise_fma(lo, __builtin_shufflevector(wq, wq, 0, 1), dot2); dot2 = __builtin_elementwise_fma(hi, __builtin_shufflevector(wq, wq, 2, 3), dot2);
                }
                {
                    const LAS float* kp = KR + (16 * hf + i16) * 32 + 8 * q4;
                    const f32x4 k0 = *(const LAS f32x4*)kp, k1 = *(const LAS f32x4*)(kp + 4), q0 = qrr[0], q1 = qrr[1];
                    rd2 = __builtin_elementwise_fma(__builtin_shufflevector(k0, k0, 0, 1), __builtin_shufflevector(q0, q0, 0, 1), rd2); rd2 = __builtin_elementwise_fma(__builtin_shufflevector(k0, k0, 2, 3), __builtin_shufflevector(q0, q0, 2, 3), rd2);
                    rd2 = __builtin_elementwise_fma(__builtin_shufflevector(k1, k1, 0, 1), __builtin_shufflevector(q1, q1, 0, 1), rd2); rd2 = __builtin_elementwise_fma(__builtin_shufflevector(k1, k1, 2, 3), __builtin_shufflevector(q1, q1, 2, 3), rd2);
                }
                ssp[hf] = ss2[0] + ss2[1]; dotp[hf] = dot2[0] + dot2[1]; rdp[hf] = rd2[0] + rd2[1];
            }
            const auto s1 = __builtin_amdgcn_permlane16_swap(__float_as_uint(ssp[0]), __float_as_uint(ssp[1]), false, false);
            const auto s2 = __builtin_amdgcn_permlane16_swap(__float_as_uint(dotp[0]), __float_as_uint(dotp[1]), false, false);
            const auto s3 = __builtin_amdgcn_permlane16_swap(__float_as_uint(rdp[0]), __float_as_uint(rdp[1]), false, false);
            const float u1 = __uint_as_float(s1[0]) + __uint_as_float(s1[1]), u2 = __uint_as_float(s2[0]) + __uint_as_float(s2[1]), u3 = __uint_as_float(s3[0]) + __uint_as_float(s3[1]);
            const auto t1 = __builtin_amdgcn_permlane32_swap(__float_as_uint(u1), __float_as_uint(u2), false, false);
            const float t = __uint_as_float(t1[0]) + __uint_as_float(t1[1]);
            const auto t2 = __builtin_amdgcn_permlane32_swap(__float_as_uint(t), __float_as_uint(t), false, false);
            const float ssv = __uint_as_float(t2[0]), dotv = __uint_as_float(t2[1]);
            const float rdv = add_x32(u3);
            scv = dotv * rsqrtf(ssv * (1.f / 64.f) + EPSV) + rdv;
        }
        float gm = max16(scv);
        { const auto r = __builtin_amdgcn_permlane16_swap(__float_as_uint(gm), __float_as_uint(gm), false, false); gm = fmaxf(__uint_as_float(r[0]), __uint_as_float(r[1])); }
        const float mn = fmaxf(m, gm);
        const float alpha = __builtin_amdgcn_exp2f(m - mn), pv = __builtin_amdgcn_exp2f(scv - mn);
        m = mn;
        lsum = lsum * alpha + pv;
        if (q4 < 2) { ((LAS float*)(lds + PT_OFF))[h * 32 + lane] = pv; if (lane == 0) ((LAS float*)(lds + AL_OFF))[h] = alpha; }
        if (g <= 60) SAMP_WAITV(10, 8); else if (g == 61) SAMP_WAITV(5, 4); else SAMP_WAITV(0, 0);
        SAMP_BAR();
        {
            u32x4 pw = {0u, 0u, 0u, 0u};
            if (i16 < 8) { const f32x4 pa = *(const LAS f32x4*)(lds + PT_OFF + (i16 * 32 + 8 * q4) * 4), pb_ = *(const LAS f32x4*)(lds + PT_OFF + (i16 * 32 + 8 * q4 + 4) * 4);
                pw.x = cvtpk(pa[0], pa[1]); pw.y = cvtpk(pa[2], pa[3]); pw.z = cvtpk(pb_[0], pb_[1]); pw.w = cvtpk(pb_[2], pb_[3]); }
            const bf16x8 pfr = __builtin_bit_cast(bf16x8, pw);
            const f32x4 al = *(const LAS f32x4*)(lds + AL_OFF + (q4 & 1) * 16);
            const unsigned tb0 = (unsigned)(size_t)((const LAS bf16_t*)(lds + TL_OFF + (g & 1) * 32 * CST * 2) + (8 * q4 + (i16 >> 2)) * CST + 32 * h + 4 * (i16 & 3));
            s16x4 c0[2], c1[2];
            static_assert(4 * CST * 2 == 2112, "tr offsets");
            asm volatile("ds_read_b64_tr_b16 %0, %4\n\tds_read_b64_tr_b16 %1, %4 offset:2112\n\tds_read_b64_tr_b16 %2, %4 offset:32\n\tds_read_b64_tr_b16 %3, %4 offset:2144\n\ts_waitcnt lgkmcnt(0)"
                         : "=&v"(c0[0]), "=&v"(c1[0]), "=&v"(c0[1]), "=&v"(c1[1]) : "v"(tb0) : "memory");
#pragma unroll
            for (int nt = 0; nt < 2; ++nt) {
                const bf16x8 cfr = __builtin_shufflevector(c0[nt], c1[nt], 0, 1, 2, 3, 4, 5, 6, 7);
                latv[nt] = latv[nt] * al;
                latv[nt] = __builtin_amdgcn_mfma_f32_16x16x32_bf16(pfr, cfr, latv[nt], 0, 0, 0);
            }
        }
        if (g + 1 < 64) samp_convert(g + 1, lds, tid);
    }
    lsum = add_x16(sum16(lsum));
    if (lane == 0) { float* o = a.part() + ((size_t)u * 8 + h) * 260; o[0] = m * 0.69314718f; o[1] = lsum; }
    if (q4 < 2) {
#pragma unroll
        for (int nt = 0; nt < 2; ++nt)
#pragma unroll
            for (int r = 0; r < 4; ++r) a.part()[((size_t)u * 8 + 4 * q4 + r) * 260 + 4 + 32 * h + 16 * nt + i16] = latv[nt][r];
    }
}
__device__ __forceinline__ void samp_comb_unit(const MK& a, int u, char* smem) {
    float* slat = (float*)smem;
    const int b = u >> 3, h = u & 7, tid = otid() & 255;
    const size_t row = NPT + b;
    const float* q = a.qh() + (row * 8 + h) * 96;
    float s_self = 0.f;
    for (int d = 0; d < 64; ++d) s_self += q[d] * a.kh()[(row * 8 + h) * 64 + d];
    for (int d = 0; d < 32; ++d) s_self += q[64 + d] * a.krf()[row * 32 + d];
    s_self *= 0.10206207261596577f;
    float m = s_self;
    for (int s = 0; s < 8; ++s) m = fmaxf(m, a.part()[((size_t)(b * 8 + s) * 8 + h) * 260]);
    const float pself = expf(s_self - m);
    float l = pself, lat = 0.f;
    for (int s = 0; s < 8; ++s) {
        const float* p = a.part() + ((size_t)(b * 8 + s) * 8 + h) * 260;
        const float w = expf(p[0] - m);
        l += p[1] * w; lat += p[4 + tid] * w;
    }
    __syncthreads();
    slat[tid] = lat;
    __syncthreads();
    if (tid < 64) {
        float o = 0.f;
        for (int c = 0; c < 256; ++c) o += slat[c] * a.w_kv_b[(size_t)c * 1024 + h * 128 + 64 + tid];
        o += pself * a.KV()[row * 1024 + h * 128 + 64 + tid];
        a.omix()[row * 1024 + 512 + h * 64 + tid] = f2bf(o / l);
    }
}

#define XB_TMO      128
#define XB_XCNT(j)  (256  + 64 * (j))
#define XB_XSUB(j)  (1280 + 64 * (j))
#define XB_XGEN(j)  (2304 + 64 * (j))
#define XB_TOP      3328
#define XB_TOPGEN   3392
#define XCD_BAR_WORDS 3456
#define XB_SPIN_CAP (1u << 18)

__device__ __forceinline__ unsigned xb_ld(unsigned* p)              { return __hip_atomic_load(p, __ATOMIC_RELAXED, __HIP_MEMORY_SCOPE_AGENT); }
__device__ __forceinline__ unsigned xb_add(unsigned* p, unsigned v) { return __hip_atomic_fetch_add(p, v, __ATOMIC_RELAXED, __HIP_MEMORY_SCOPE_AGENT); }
__device__ __forceinline__ unsigned xb_xcc_id() { return (unsigned)__builtin_amdgcn_s_getreg((3 << 11) | 20) & 0xFu; }
#define XB_SPIN(cond, bar) do { unsigned _sp = 0; while (cond) { __builtin_amdgcn_s_sleep(1); \
    if ((++_sp & 255u) == 0u) { if (xb_ld(&(bar)[XB_TMO])) break; if (_sp > XB_SPIN_CAP) { atomicAdd(&(bar)[XB_TMO], 1u); break; } } } } while (0)

struct XcdBarrier {
    unsigned* bar; unsigned x;
    volatile LAS unsigned* st;
};

__device__ __forceinline__ XcdBarrier xcd_barrier_post(unsigned* bar, volatile LAS unsigned* st) {
    XcdBarrier b; b.bar = bar; b.x = xb_xcc_id(); b.st = st;
    if (threadIdx.x == 0) (void)xb_add(&bar[XB_XCNT(b.x)], 1u);
    return b;
}
__device__ __forceinline__ void xcd_barrier_complete(unsigned* bar, unsigned x, unsigned& nloc, unsigned& nx) {
    const unsigned G = gridDim.x * gridDim.y * gridDim.z;
    unsigned sum, cnt, mine, sp = 0u;
    for (;;) {
        sum = 0u; cnt = 0u; mine = 0u;
#pragma unroll
        for (unsigned j = 0; j < 16; ++j) { const unsigned c = xb_ld(&bar[XB_XCNT(j)]); sum += c; cnt += (c > 0u) ? 1u : 0u; mine = (j == x) ? c : mine; }
        if (sum == G) break;
        __builtin_amdgcn_s_sleep(1);
        if ((++sp & 255u) == 0u) { if (xb_ld(&bar[XB_TMO])) break; if (sp > XB_SPIN_CAP) { atomicAdd(&bar[XB_TMO], 1u); break; } }
    }
    nloc = mine > 0u ? mine : 1u; nx = cnt > 0u ? cnt : 1u;
}

__device__ __forceinline__ void xcd_barrier(const XcdBarrier& b) {
    asm volatile("s_waitcnt vmcnt(0)" ::: "memory");
    __syncthreads();
    if (threadIdx.x == 0) {
        unsigned* bar = b.bar;
        __builtin_amdgcn_s_waitcnt(0);
        unsigned nloc = b.st[0], nx = b.st[1];
        if (nloc == 0u) { xcd_barrier_complete(bar, b.x, nloc, nx); b.st[0] = nloc; b.st[1] = nx; }
        const unsigned old = xb_add(&bar[XB_XSUB(b.x)], 1u);
        const unsigned gen = old / nloc;
        if (old + 1u == (gen + 1u) * nloc) {
            __builtin_amdgcn_fence(__ATOMIC_RELEASE, "agent");
            asm volatile("s_waitcnt vmcnt(0)" ::: "memory");
            const unsigned og = xb_add(&bar[XB_TOP], 1u);
            const unsigned tg = og / nx;
            if (og + 1u == (tg + 1u) * nx) xb_add(&bar[XB_TOPGEN], 1u);
            else XB_SPIN(xb_ld(&bar[XB_TOPGEN]) == tg, bar);
            __builtin_amdgcn_fence(__ATOMIC_ACQUIRE, "agent");
            xb_add(&bar[XB_XGEN(b.x)], 1u);
            asm volatile("s_waitcnt vmcnt(0)" ::: "memory");
        } else {
            XB_SPIN(xb_ld(&bar[XB_XGEN(b.x)]) == gen, bar);
            __builtin_amdgcn_fence(__ATOMIC_ACQUIRE, "agent");
            asm volatile("s_waitcnt vmcnt(0)" ::: "memory");
        }
    }
    __syncthreads();
}

__device__ __forceinline__ void late_weight_items(const MK& a, int gwl, int ngwl, float* scr, int lane) {
    const int T4 = 32 * 16, T5 = 176 * 16, T7 = 32 * 44, T8 = 32 * 16, TT = T4 + T5 + T7 + T8;
    for (int it = gwl; it < TT; it += ngwl) {
        int r = it;
        if (r < T4) { const int nt_ = r % 32, kb = r / 32; wt_item(a.w_o, 1024, 32 * nt_, 32, a.WoT(), 1024, 32 * nt_, 64 * kb, scr, lane); continue; } r -= T4;
        if (r < T5) { const int nt_ = r % 176, kb = r / 176, pn = nt_ >> 3, wi = nt_ & 7;
            wt_item(wi < 4 ? a.w_gate : a.w_up, DFF, pn * 128 + (wi & 3) * 32, 32, a.WguT(), 1024, 32 * nt_, 64 * kb, scr, lane); continue; } r -= T5;
        if (r < T7) { const int nt_ = r % 32, kb = r / 32; wt_item(a.w_down, 1024, 32 * nt_, 32, a.WdT(), DFF, 32 * nt_, 64 * kb, scr, lane); continue; } r -= T7;
        { const int nt_ = r % 32, kb = r / 32; wt_item(a.w_ple_gate, 1024, 32 * nt_, 32, a.WpgT(), 1024, 32 * nt_, 64 * kb, scr, lane); }
    }
}

#define XB_ST_OFF 155648
#define LDS_BYTES 155904
static_assert(SAMP_LDS_END <= LDS_BYTES, "LDS map");
#define GSYNC() do { xcd_barrier(xbar); } while (0)
__global__ __launch_bounds__(NTHR, 2) void mega(MK a) {
    cg::grid_group grid = cg::this_grid();
    char* smem = (char*)lds_raw;
    LAS unsigned char* lds = (LAS unsigned char*)lds_raw;
    otid_init();
    if (threadIdx.x < 2) ((LAS unsigned*)(lds_raw + XB_ST_OFF))[threadIdx.x] = 0u;
    __syncthreads();
    const XcdBarrier xbar = xcd_barrier_post(a.ctl(), (volatile LAS unsigned*)(LAS void*)(lds_raw + XB_ST_OFF));
    const int bid = blockIdx.x, nb = gridDim.x, ngw = nb * NWAVE;
#define LOCAL_IDS const int tid = otid(), lane = tid & 63, wid = tid >> 6, half = tid >> 8, gw = bid * NWAVE + wid; (void)lane; (void)half; (void)gw; (void)wid;

    {
    LOCAL_IDS
    {
        const int T0 = 88 * 16, T1 = 24 * 6, T2 = 32 * 4, T3 = 16 * 4, T9 = 32 * 4;
        const int TT = T0 + T1 + T2 + T3 + T9;
        float* scr = (float*)(smem + wid * 8704);
        for (int it = gw; it < TT; it += ngw) {
            int r = it;
            if (r < T0) { const int nt_ = r % 88, kb = r / 88, nv = 2736 - 32 * nt_; wt_item(a.w_in, 2736, 32 * nt_, nv < 0 ? 0 : (nv > 32 ? 32 : nv), a.WinT(), 1024, 32 * nt_, 64 * kb, scr, lane); continue; } r -= T0;
            if (r < T1) { const int nt_ = r % 24, kb = r / 24; wt_item(a.w_q_b, 768, 32 * nt_, 32, a.WqbT(), 384, 32 * nt_, 64 * kb, scr, lane); continue; } r -= T1;
            if (r < T2) { const int nt_ = r % 32, kb = r / 32; wt_item(a.w_kv_b, 1024, 32 * nt_, 32, a.WkvT(), 256, 32 * nt_, 64 * kb, scr, lane); continue; } r -= T2;
            if (r < T3) { const int nt_ = r % 16, kb = r / 16, h = nt_ >> 1; wt_item(a.w_kv_b, 1024, h * 128 + 32 * (nt_ & 1), 32, a.WknT(), 256, 32 * nt_, 64 * kb, scr, lane); continue; } r -= T3;
            { const int nt_ = r % 32, kb = r / 32; wt_item(a.w_ple_proj, 1024, 32 * nt_, 32, a.WppT(), 256, 32 * nt_, 64 * kb, scr, lane); }
        }
        for (int e = (bid * NTHR + tid); e < 2049 * 16; e += nb * NTHR) {
            const int pos = e >> 4, i = e & 15; const float ang = (pos == 2048 ? (float)PAST : (float)pos) * powf(10000.f, -(float)i / 16.f);
            a.ropecs()[pos * 32 + i] = cosf(ang); a.ropecs()[pos * 32 + 16 + i] = sinf(ang);
        }
        for (int row = gw; row < MPAD; row += ngw) {
            const float* src = row < NPT ? a.x_prompt + (size_t)row * 1024 : a.x_sample + (size_t)(row < NTOK ? row - NPT : 0) * 1024;
            rms1024_row(src, a.g_attn, a.xn() + (size_t)row * 1024, row >= NTOK, lane);
            ushort4 w = {0, 0, 0, 0};
            if (row < NTOK) { const float* ps = row < NPT ? a.p_prompt + (size_t)row * 256 : a.p_sample + (size_t)(row - NPT) * 256; const float4 v = *(const float4*)(ps + lane * 4); w.x = f2bf(v.x); w.y = f2bf(v.y); w.z = f2bf(v.z); w.w = f2bf(v.w); }
            *(ushort4*)(a.pb() + (size_t)row * 256 + lane * 4) = w;
            if (row >= NTOK) { for (int j = 0; j < 4; ++j) { ushort4 z = {0, 0, 0, 0}; *(ushort4*)(a.omix() + (size_t)row * 1024 + lane * 4 + 256 * j) = z; } }
        }
    }
    }
    if (a.out == nullptr) grid.sync();
    GSYNC();
    {
    LOCAL_IDS
    pg_gemm(lds, a.xn(), a.WinT(), NPT, ZW, 1024, PgBf16{a.Z(), ZW});
    gemm_sample_rows_ks<false>(a.xn(), 1024, a.WinT(), 1024, ZW, EwBf16{a.Z(), ZW}, smem, bid, nb);
    }
    GSYNC();
    {
    LOCAL_IDS
    for (int e = tid; e < 4 * 1536 / 4; e += NTHR) ((float4*)smem)[e] = ((const float4*)a.w_conv)[e];
    __syncthreads();
    for (int run = gw; run < NPT / 8 + NST; run += ngw) post_in_run(a, run, lane, (const float*)smem);
    }
    GSYNC();
    {
    LOCAL_IDS
    for (int u = gw; u < 2048; u += ngw) gdn_prep_unit(a, u, lane, smem + wid * GDN_WLDS);
    }
    {
    LOCAL_IDS
    for (int v = gw; v < NST * 64; v += ngw) gdn_unit(a, v >> 6, (v >> 3) & 7, v & 7, a.state_gdn, a.out + O_GSS, NPT, 1, lane, smem + wid * GDN_WLDS);
    __syncthreads();
    }
    GSYNC();
    {
    LOCAL_IDS
    pg_gemm(lds, a.qan(), a.WqbT(), NPT, 768, 384, PgBf16{a.qraw(), 768});
    pg_gemm(lds, a.ckvb(), a.WkvT(), NPT, 1024, 256, PgBf16{a.kvraw(), 1024}, nb > 64 ? nb - 64 : 0);
    gemm_sample_rows<false>(a.qan(), 384, a.WqbT(), 384, 768, EwF32{a.Q(), 768}, smem, bid, nb, 64);
    gemm_sample_rows<false>(a.ckvb(), 256, a.WkvT(), 256, 1024, EwF32{a.KV(), 1024}, smem, bid, nb, 72);
    for (int bh_ = nb - 1 - bid; bh_ < 64; bh_ += nb) gdn_scan_block(a, bh_, lds);
    if (nb > 64 && bid < nb - 64) {
        pg_gemm(lds, a.pb(), a.WppT(), NPT, 1024, 256, PgBf16{a.PP(), 1024}, nb - 64);
        __syncthreads();
        late_weight_items(a, bid * NWAVE + wid, (nb - 64) * NWAVE, (float*)(smem + wid * 8704), lane);
    } else if (nb <= 64) { pg_gemm(lds, a.pb(), a.WppT(), NPT, 1024, 256, PgBf16{a.PP(), 1024}); __syncthreads(); late_weight_items(a, gw, ngw, (float*)(smem + wid * 8704), lane); }
    gemm_sample_rows<false>(a.pb(), 256, a.WppT(), 256, 1024, EwBf16{a.PP(), 1024}, smem, bid, nb, 80);
    }
    GSYNC();
    {
    LOCAL_IDS
    for (int idx = gw; idx < NST * 8; idx += ngw) { post_q_item(a, NPT * 8 + idx, lane); post_kv_item(a, NPT * 8 + idx, lane); }
    for (int row = gw; row < NTOK; row += ngw) gdn_out_token(a, row, lane);
    for (int pr = bid; pr < 256; pr += nb) { const int bh_ = pr >> 2, s_ = pr & 3; attn_block(a, bh_ >> 3, bh_ & 7, 7 - s_, smem); attn_block(a, bh_ >> 3, bh_ & 7, s_, smem); }
    for (int u = bid; u < NST * 8; u += nb) samp_attn_unit(a, u, smem, lds);
    }
    GSYNC();
    {
    LOCAL_IDS
    for (int u0 = bid * 2; u0 < NST * 8; u0 += nb * 2) samp_comb_unit(a, u0 + half, smem + half * 4096);
    }
    GSYNC();
    {
    LOCAL_IDS
    pg_gemm(lds, a.omix(), a.WoT(), NPT, 1024, 1024, PgResXB{a.x_prompt, a.H()});
    gemm_sample_rows_ks<false>(a.omix(), 1024, a.WoT(), 1024, 1024, EwResX{a.x_sample, a.H()}, smem, bid, nb);
    }
    GSYNC();
    {
    LOCAL_IDS
    for (int row = gw; row < MPAD; row += ngw) rms1024_row_b(a.H() + (size_t)row * 1024, a.g_ffn, a.un() + (size_t)row * 1024, row >= NTOK, lane);
    }
    GSYNC();
    {
    LOCAL_IDS
    pg_gemm(lds, a.un(), a.WguT(), NPT, 2 * DFF, 1024, PgSwiglu{a.hid()});
    gemm_sample_rows_ks<true>(a.un(), 1024, a.WguT(), 1024, 2 * DFF, EwBf16{a.hid(), DFF}, smem, bid, nb);
    }
    GSYNC();
    {
    LOCAL_IDS
    pg_gemm(lds, a.hid(), a.WdT(), NPT, 1024, DFF, PgResBB{a.H(), a.H2()});
    gemm_sample_rows_ks<false>(a.hid(), DFF, a.WdT(), DFF, 1024, EwResH{a.H(), a.H2()}, smem, bid, nb);
    }
    GSYNC();
    {
    LOCAL_IDS
    for (int row = gw; row < MPAD; row += ngw) rms1024_row_b(a.H2() + (size_t)row * 1024, a.g_ple, a.un2() + (size_t)row * 1024, row >= NTOK, lane);
    }
    GSYNC();
    {
    LOCAL_IDS
    pg_gemm(lds, a.un2(), a.WpgT(), NPT, 1024, 1024, PgPleB{a.H2(), a.PP(), a.out});
    gemm_sample_rows_ks<false>(a.un2(), 1024, a.WpgT(), 1024, 1024, EwPle{a.H2(), a.PP(), a.out}, smem, bid, nb);
    }
}

static inline char* carve(char*& p, size_t bytes) { char* r = p; p += (bytes + 255) & ~(size_t)255; return r; }

extern "C" void kernel_launch(void* const* d_in, const int* in_sizes, int n_in, void* d_out, int out_size, void* d_ws, size_t ws_size, hipStream_t stream) {
    MK a{};
    a.x_prompt = (const float*)d_in[0]; a.x_sample = (const float*)d_in[1]; a.cache_ckv = (const float*)d_in[2]; a.cache_krope = (const float*)d_in[3];
    a.state_gdn = (const float*)d_in[4]; a.state_conv = (const float*)d_in[5]; a.page_table = (const int*)d_in[6]; a.p_prompt = (const float*)d_in[7]; a.p_sample = (const float*)d_in[8];
    a.g_attn = (const float*)d_in[9]; a.w_in = (const float*)d_in[10]; a.w_conv = (const float*)d_in[11]; a.a_log = (const float*)d_in[12]; a.dt_bias = (const float*)d_in[13];
    a.g_gdn_out = (const float*)d_in[14]; a.g_q_a = (const float*)d_in[15]; a.w_q_b = (const float*)d_in[16]; a.g_q_nope = (const float*)d_in[17]; a.g_q_rope = (const float*)d_in[18];
    a.g_kv_a = (const float*)d_in[19]; a.g_k_rope = (const float*)d_in[20]; a.w_kv_b = (const float*)d_in[21]; a.g_k_nope = (const float*)d_in[22]; a.w_o = (const float*)d_in[23];
    a.g_ffn = (const float*)d_in[24]; a.w_gate = (const float*)d_in[25]; a.w_up = (const float*)d_in[26]; a.w_down = (const float*)d_in[27]; a.g_ple = (const float*)d_in[28];
    a.w_ple_gate = (const float*)d_in[29]; a.w_ple_proj = (const float*)d_in[30];
    a.out = (float*)d_out;
    a.ws = (char*)d_ws;
    if (WS_TOTAL > ws_size) { fprintf(stderr, "kernel_launch: workspace too small: need %zu have %zu\n", (size_t)WS_TOTAL, ws_size); return; }

    static int grid_blocks = 0;
    if (!grid_blocks) {
        int dev = 0, cus = 0, per_cu = 0;
        (void)hipGetDevice(&dev);
        (void)hipDeviceGetAttribute(&cus, hipDeviceAttributeMultiprocessorCount, dev);
        (void)hipFuncSetAttribute((const void*)mega, hipFuncAttributeMaxDynamicSharedMemorySize, LDS_BYTES);
        (void)hipOccupancyMaxActiveBlocksPerMultiprocessor(&per_cu, (const void*)mega, NTHR, LDS_BYTES);
        if (per_cu < 1) fprintf(stderr, "kernel_launch: occupancy query says %d blocks/CU\n", per_cu);
        grid_blocks = cus;
    }
    (void)hipMemsetAsync((char*)d_ws + WOF_ctl, 0, 16384, stream);
    void* args[] = {&a};
    hipError_t e = hipLaunchCooperativeKernel((const void*)mega, dim3(grid_blocks), dim3(NTHR), args, LDS_BYTES, stream);
    if (e != hipSuccess) fprintf(stderr, "cooperative launch failed: %s (grid %d)\n", hipGetErrorString(e), grid_blocks);
}
```

```cpp
#include <hip/hip_runtime.h>
#include <stdint.h>
#include <cstdio>
#include <hip/hip_cooperative_groups.h>
namespace cg = cooperative_groups;


__device__ __forceinline__ int otid();
#define PG8_TID() otid()
namespace pg8 {
#define PG8_LAS __attribute__((address_space(3)))
typedef unsigned short bf16_t;
typedef short bf16x8 __attribute__((ext_vector_type(8)));
typedef float f32x4 __attribute__((ext_vector_type(4)));
typedef unsigned u32x4 __attribute__((ext_vector_type(4)));
constexpr int BM = 256, BK = 64, HALF = 128, HTB = HALF * BK * 2  , STAGE_BYTES = 8 * HTB, NXCD = 8, WGM = 8;

__host__ __device__ __forceinline__ int lds_byte(int r, int c) { const int st = (r >> 4) * 2 + (c >> 5), rr = r & 15, cc = c & 31, ob = rr * 64 + cc * 2; return st * 1024 + (ob ^ (((ob >> 9) & 1) << 5)); }
__host__ __device__ __forceinline__ void stage_rc(int b, int& R, int& C) { const int st = b / 1024, sb = b % 1024, swz = sb ^ (((sb >> 9) & 1) << 5); R = (st >> 1) * 16 + swz / 64; C = (st & 1) * 32 + (swz % 64) / 2; }
__host__ __device__ __forceinline__ int perm32(int rho) { const int n = rho >> 4, i = rho & 15; return 8 * (i >> 2) + 4 * n + (i & 3); }

struct Unit { int pm, pn; };
struct Gemm { const bf16_t* A; const bf16_t* Bt; int M, N, K; };

struct StaticOrder {
    int nM, nN, nwg, G, c;
    __host__ __device__ void init(int M, int N, int G_, int c_) { nM = M / BM; nN = N / BM; nwg = nM * nN; G = G_; c = c_; }
    __host__ __device__ bool next(int i, Unit& u) const {
        const long L = (long)i * G + c; if (L >= nwg) return false;
        int wgid = (int)L; { const int q = nwg / NXCD, r = nwg % NXCD, xcd = wgid % NXCD, off = wgid / NXCD; wgid = (xcd < r ? xcd * (q + 1) : r * (q + 1) + (xcd - r) * q) + off; }
        const int nig = WGM * nN, gid = wgid / nig, fm = gid * WGM, gsz = (nM - fm) < WGM ? (nM - fm) : WGM;
        u.pm = fm + ((wgid % nig) % gsz); u.pn = (wgid % nig) / gsz; return true;
    }
    __device__ __forceinline__ void a_ready(const Unit&) const {}
    __device__ __forceinline__ void done(const Unit&) const {}
};

template <class Epi, class Sched, bool ALIGN_EPI = false, bool SP2 = false>
__device__ __forceinline__ void gemm_phase(PG8_LAS unsigned char* lds, const Gemm g, const Sched& S, const Epi& E) {
    const int tid = PG8_TID(), wid = __builtin_amdgcn_readfirstlane(tid >> 6), lane = tid & 63, wr = wid >> 2, wc = wid & 3, fr = lane & 15, fq = lane >> 4;
    const int K = g.K, nt = K / BK;
    unsigned voffA[2], voffB[2];
#pragma unroll
    for (int i = 0; i < 2; ++i) { int R, C; stage_rc(tid * 16 + i * 8192, R, C); const int Rb = Epi::PERM ? ((R & ~31) + perm32(R & 31)) : R;
        voffA[i] = (unsigned)(R * K + C) * 2u; voffB[i] = (unsigned)(Rb * K + C) * 2u; }
    const size_t kstep = (size_t)(BK * 2);
    const size_t hstep = (size_t)HALF * K * 2;
    const size_t tstep = 2 * hstep;
    const unsigned ldsw = (unsigned)wid * 1024u;
    const int aoff = lds_byte(wr * 64 + fr, fq * 8), boff = lds_byte(wc * 32 + fr, fq * 8);
#define PG8_SA(b, h) (((b) * 2 + (h)) * HTB)
#define PG8_SB(b, h) ((4 + (b) * 2 + (h)) * HTB)
#define PG8_STAGE(bufoff, gbase, voff) do { _Pragma("unroll") for (int _i = 0; _i < 2; ++_i) \
        __builtin_amdgcn_global_load_lds((const unsigned*)((const char*)(gbase) + (voff)[_i]), (PG8_LAS unsigned*)(lds + (bufoff) + ldsw + _i * 8192), 16, 0, 0); } while (0)
#define PG8_LDA(dst, b, h) do { _Pragma("unroll") for (int m = 0; m < 4; ++m) _Pragma("unroll") for (int k = 0; k < 2; ++k) dst[m][k] = *(const PG8_LAS bf16x8*)(lds + PG8_SA(b, h) + aoff + m * 2048 + k * 1024); } while (0)
#define PG8_LDB(dst, b, h) do { _Pragma("unroll") for (int n = 0; n < 2; ++n) _Pragma("unroll") for (int k = 0; k < 2; ++k) dst[n][k] = *(const PG8_LAS bf16x8*)(lds + PG8_SB(b, h) + boff + n * 2048 + k * 1024); } while (0)
#define PG8_MMA(ai, bj, At, Bt) do { __builtin_amdgcn_s_setprio(1); _Pragma("unroll") for (int m = 0; m < 4; ++m) _Pragma("unroll") for (int n = 0; n < 2; ++n) _Pragma("unroll") for (int k = 0; k < 2; ++k) \
        acc[ai][bj][m][n] = __builtin_amdgcn_mfma_f32_16x16x32_bf16(Bt[n][k], At[m][k], acc[ai][bj][m][n], 0, 0, 0); __builtin_amdgcn_s_setprio(0); } while (0)
#define PG8_WAIT_V(n) asm volatile("s_waitcnt vmcnt(" #n ")" ::: "memory")
#define PG8_WAIT_L(n) asm volatile("s_waitcnt lgkmcnt(" #n ")" ::: "memory")
#define PG8_BAR __builtin_amdgcn_s_barrier()
#define PG8_SCHED __builtin_amdgcn_sched_barrier(0)
    Unit cur, nxt; int ui = 0;
    if (!S.next(0, cur)) return;
    f32x4 acc[2][2][4][2];
#pragma unroll
    for (int a = 0; a < 2; ++a)
#pragma unroll
        for (int b = 0; b < 2; ++b)
#pragma unroll
            for (int m = 0; m < 4; ++m)
#pragma unroll
                for (int n = 0; n < 2; ++n) acc[a][b][m][n] = (f32x4){0.f, 0.f, 0.f, 0.f};
    bf16x8 At[4][2], B0[2][2], B1[2][2];
    const char* cA = (const char*)g.A + (size_t)cur.pm * tstep; const char* cB = (const char*)g.Bt + (size_t)cur.pn * tstep;
    S.a_ready(cur);
    if constexpr (SP2) {
        PG8_STAGE(PG8_SB(0, 0), cB, voffB); PG8_STAGE(PG8_SB(0, 1), cB + hstep, voffB); PG8_STAGE(PG8_SA(0, 0), cA, voffA); PG8_STAGE(PG8_SA(0, 1), cA + hstep, voffA);
        if (wr == 1) PG8_BAR;
        PG8_WAIT_V(2); PG8_BAR;
        PG8_STAGE(PG8_SB(1, 0), cB + kstep, voffB); PG8_STAGE(PG8_SA(1, 0), cA + kstep, voffA); PG8_STAGE(PG8_SB(1, 1), cB + hstep + kstep, voffB);
        PG8_WAIT_V(6); PG8_BAR;
    } else {
        PG8_STAGE(PG8_SB(0, 0), cB, voffB); PG8_STAGE(PG8_SA(0, 0), cA, voffA); PG8_STAGE(PG8_SB(0, 1), cB + hstep, voffB); PG8_STAGE(PG8_SA(0, 1), cA + hstep, voffA);
        if (wr == 1) PG8_BAR;
        PG8_WAIT_V(4); PG8_BAR;
        PG8_STAGE(PG8_SB(1, 0), cB + kstep, voffB); PG8_STAGE(PG8_SA(1, 0), cA + kstep, voffA); PG8_STAGE(PG8_SB(1, 1), cB + hstep + kstep, voffB);
        PG8_WAIT_V(6); PG8_BAR;
    }
    for (;;) {
        const bool has_next = S.next(ui + 1, nxt);
        const char* nA = has_next ? (const char*)g.A + (size_t)nxt.pm * tstep : cA; const char* nB = has_next ? (const char*)g.Bt + (size_t)nxt.pn * tstep : cB;
        for (int t = 0; t < nt; t += 2) {
            const bool last = (t == nt - 2);
            const char* a1 = cA + (size_t)(t + 1) * kstep;
            const char* a2 = last ? nA : cA + (size_t)(t + 2) * kstep; const char* b2 = last ? nB : cB + (size_t)(t + 2) * kstep;
            const char* a3 = a2 + kstep; const char* b3 = b2 + kstep;
            if (last && has_next) S.a_ready(nxt);
            if constexpr (SP2) {
            PG8_LDB(B0, 0, 0); PG8_LDB(B1, 0, 1); PG8_SCHED; PG8_LDA(At, 0, 0); PG8_STAGE(PG8_SA(1, 1), a1 + hstep, voffA);
            PG8_WAIT_V(8); PG8_WAIT_L(0); PG8_BAR; PG8_MMA(0, 0, At, B0); PG8_MMA(0, 1, At, B1); PG8_BAR; PG8_SCHED;
            PG8_LDA(At, 0, 1); PG8_STAGE(PG8_SB(0, 0), b2, voffB); PG8_STAGE(PG8_SB(0, 1), b2 + hstep, voffB); PG8_STAGE(PG8_SA(0, 0), a2, voffA);
            PG8_WAIT_V(8); PG8_WAIT_L(0); PG8_BAR; PG8_MMA(1, 0, At, B0); PG8_MMA(1, 1, At, B1); PG8_BAR; PG8_SCHED;
            PG8_LDB(B0, 1, 0); PG8_LDB(B1, 1, 1); PG8_SCHED; PG8_LDA(At, 1, 0); PG8_STAGE(PG8_SA(0, 1), a2 + hstep, voffA);
            PG8_WAIT_V(8); PG8_WAIT_L(0); PG8_BAR; PG8_MMA(0, 0, At, B0); PG8_MMA(0, 1, At, B1); PG8_BAR; PG8_SCHED;
            PG8_LDA(At, 1, 1); PG8_STAGE(PG8_SB(1, 0), b3, voffB); PG8_STAGE(PG8_SB(1, 1), b3 + hstep, voffB); PG8_STAGE(PG8_SA(1, 0), a3, voffA);
            PG8_WAIT_V(8); PG8_WAIT_L(0); PG8_BAR; PG8_MMA(1, 0, At, B0); PG8_MMA(1, 1, At, B1); PG8_BAR; PG8_SCHED;
            } else {
            PG8_LDB(B0, 0, 0); PG8_SCHED; PG8_LDA(At, 0, 0); PG8_STAGE(PG8_SA(1, 1), a1 + hstep, voffA);
            PG8_WAIT_L(8); PG8_BAR; PG8_WAIT_L(0); PG8_MMA(0, 0, At, B0); PG8_BAR; PG8_SCHED;
            PG8_LDB(B1, 0, 1); PG8_STAGE(PG8_SB(0, 0), b2, voffB);
            PG8_BAR; PG8_WAIT_L(0); PG8_MMA(0, 1, At, B1); PG8_BAR;
            PG8_LDA(At, 0, 1); PG8_STAGE(PG8_SA(0, 0), a2, voffA);
            PG8_BAR; PG8_WAIT_L(0); PG8_MMA(1, 0, At, B0); PG8_BAR; PG8_SCHED;
            PG8_STAGE(PG8_SB(0, 1), b2 + hstep, voffB);
            PG8_WAIT_V(6); PG8_BAR; PG8_MMA(1, 1, At, B1); PG8_BAR;
            PG8_LDB(B0, 1, 0); PG8_SCHED; PG8_LDA(At, 1, 0); PG8_STAGE(PG8_SA(0, 1), a2 + hstep, voffA);
            PG8_WAIT_L(8); PG8_BAR; PG8_WAIT_L(0); PG8_MMA(0, 0, At, B0); PG8_BAR; PG8_SCHED;
            PG8_LDB(B1, 1, 1); PG8_STAGE(PG8_SB(1, 0), b3, voffB);
            PG8_BAR; PG8_WAIT_L(0); PG8_MMA(0, 1, At, B1); PG8_BAR;
            PG8_LDA(At, 1, 1); PG8_STAGE(PG8_SA(1, 0), a3, voffA);
            PG8_BAR; PG8_WAIT_L(0); PG8_MMA(1, 0, At, B0); PG8_BAR; PG8_SCHED;
            PG8_STAGE(PG8_SB(1, 1), b3 + hstep, voffB);
            PG8_WAIT_V(6); PG8_BAR; PG8_MMA(1, 1, At, B1); PG8_BAR;
            }
        }
        if constexpr (ALIGN_EPI) { if (wr == 0) PG8_BAR; }
        if constexpr (!Epi::AFTER_DRAIN) { E(acc, cur, wr, wc, fr, fq); S.done(cur); }
        if (!has_next) break;
#pragma unroll
        for (int a = 0; a < 2; ++a)
#pragma unroll
            for (int b = 0; b < 2; ++b)
#pragma unroll
                for (int m = 0; m < 4; ++m)
#pragma unroll
                    for (int n = 0; n < 2; ++n) acc[a][b][m][n] = (f32x4){0.f, 0.f, 0.f, 0.f};
        cur = nxt; cA = nA; cB = nB; ++ui;
        if constexpr (ALIGN_EPI) { if (wr == 1) PG8_BAR; }
    }
    PG8_WAIT_V(0);
    if constexpr (!ALIGN_EPI) { if (wr == 0) PG8_BAR; }
    PG8_BAR;
    if constexpr (Epi::AFTER_DRAIN) { E.fused(acc, cur, wr, wc, fr, fq, lds, wid, lane); S.done(cur); }
#undef PG8_SA
#undef PG8_SB
#undef PG8_STAGE
#undef PG8_LDA
#undef PG8_LDB
#undef PG8_MMA
#undef PG8_WAIT_V
#undef PG8_WAIT_L
#undef PG8_BAR
#undef PG8_SCHED
}
}

#define WTAB_OFF 155392
extern __shared__ __attribute__((aligned(16))) unsigned char lds_raw[];
__device__ __forceinline__ int hw_slot() { return (int)(__builtin_amdgcn_s_getreg((5 << 11) | 4) & 63u); }
__device__ __forceinline__ void otid_init() { const int t = threadIdx.x; if ((t & 63) == 0) ((__attribute__((address_space(3))) int*)(__attribute__((address_space(3))) void*)(lds_raw + WTAB_OFF))[hw_slot()] = t >> 6; }
__device__ __forceinline__ int otid() {
    const int w = __builtin_amdgcn_readfirstlane(((const __attribute__((address_space(3))) int*)(__attribute__((address_space(3))) void*)(lds_raw + WTAB_OFF))[hw_slot()]);
    int l; asm volatile("v_mbcnt_lo_u32_b32 %0, -1, 0\n\tv_mbcnt_hi_u32_b32 %0, -1, %0" : "=v"(l));
    return (w << 6) + l;
}
using pg8::bf16_t; using pg8::bf16x8; using pg8::f32x4; using pg8::u32x4;
#define LAS __attribute__((address_space(3)))

#define DMODEL 1024
#define NPT 16384
#define NST 32
#define NTOK 16416
#define MPAD 16640
#define SEQ 2048
#define ZW 2816
#define OFF_A 1536
#define OFF_B 1544
#define OFF_Z 1552
#define OFF_QA 2064
#define OFF_KVA 2448
#define OFF_KR 2704
#define DFF 2816
#define PAST 16384
#define NPAGES 128
#define EPSV 1e-6f

#define O_YP 0
#define O_YS (O_YP + 16777216)
#define O_CKVP (O_YS + 32768)
#define O_KRP (O_CKVP + 4194304)
#define O_GSP (O_KRP + 524288)
#define O_CSP (O_GSP + 262144)
#define O_CKVS (O_CSP + 36864)
#define O_KRS (O_CKVS + 8192)
#define O_GSS (O_KRS + 1024)
#define O_CSS (O_GSS + 1048576)

__device__ __forceinline__ bf16_t f2bf(float f) { unsigned u = __float_as_uint(f); return (bf16_t)((u + 0x7fffu + ((u >> 16) & 1u)) >> 16); }
__device__ __forceinline__ float bf2f(bf16_t b) { return __uint_as_float(((unsigned)b) << 16); }
template <int CTRL> __device__ __forceinline__ float dpp_mov(float x) { return __uint_as_float((unsigned)__builtin_amdgcn_update_dpp((int)__float_as_uint(x), (int)__float_as_uint(x), CTRL, 0xF, 0xF, true)); }
__device__ __forceinline__ float add_x16(float x) { auto r = __builtin_amdgcn_permlane16_swap(__float_as_uint(x), __float_as_uint(x), false, false); return __uint_as_float(r[0]) + __uint_as_float(r[1]); }
__device__ __forceinline__ float add_x32(float x) { auto r = __builtin_amdgcn_permlane32_swap(__float_as_uint(x), __float_as_uint(x), false, false); return __uint_as_float(r[0]) + __uint_as_float(r[1]); }
__device__ __forceinline__ float max_x32(float x) { auto r = __builtin_amdgcn_permlane32_swap(__float_as_uint(x), __float_as_uint(x), false, false); return fmaxf(__uint_as_float(r[0]), __uint_as_float(r[1])); }
__device__ __forceinline__ float sum8(float x) { x += dpp_mov<0xB1>(x); x += dpp_mov<0x4E>(x); x += dpp_mov<0x141>(x); return x; }
__device__ __forceinline__ float sum16(float x) { x = sum8(x); x += dpp_mov<0x140>(x); return x; }
__device__ __forceinline__ float max16(float x) { x = fmaxf(x, dpp_mov<0xB1>(x)); x = fmaxf(x, dpp_mov<0x4E>(x)); x = fmaxf(x, dpp_mov<0x141>(x)); x = fmaxf(x, dpp_mov<0x140>(x)); return x; }
__device__ __forceinline__ float wave_sum(float v) { return add_x32(add_x16(sum16(v))); }
__device__ __forceinline__ float sigmoidf_(float x) { return __builtin_amdgcn_rcpf(1.f + __builtin_amdgcn_exp2f(-1.44269504f * x)); }
__device__ __forceinline__ float siluf_(float x) { return x * __builtin_amdgcn_rcpf(1.f + __builtin_amdgcn_exp2f(-1.44269504f * x)); }


#define WSYNC() do { __builtin_amdgcn_fence(__ATOMIC_ACQ_REL, "wavefront"); __builtin_amdgcn_wave_barrier(); } while (0)
#define NTHR 512
#define NWAVE 8

typedef float f32x2_t __attribute__((ext_vector_type(2)));
typedef __bf16 bf16x2_t __attribute__((ext_vector_type(2)));
__device__ __forceinline__ unsigned cvtpk(float lo, float hi) { f32x2_t v = {lo, hi}; bf16x2_t r = __builtin_convertvector(v, bf16x2_t); return __builtin_bit_cast(unsigned, r); }
__device__ __forceinline__ void bf8_to_f32(const bf16x8& v, float* o) {
#pragma unroll
    for (int e = 0; e < 8; ++e) o[e] = __uint_as_float(((unsigned)(unsigned short)v[e]) << 16);
}
__device__ __forceinline__ bf16x8 f32_to_bf8(const float* x) {
    u32x4 w; w.x = cvtpk(x[0], x[1]); w.y = cvtpk(x[2], x[3]); w.z = cvtpk(x[4], x[5]); w.w = cvtpk(x[6], x[7]);
    return __builtin_bit_cast(bf16x8, w);
}
__device__ __forceinline__ unsigned pk2bf(float lo, float hi) { return (unsigned)f2bf(lo) | ((unsigned)f2bf(hi) << 16); }

__device__ __forceinline__ void wt_item(const float* __restrict__ W, int ldw, int col0, int nvalid, bf16_t* __restrict__ WT, int ldt, int nrow0, int k0, float* scr, int lane) {
    WSYNC();
#pragma unroll 8
    for (int i = 0; i < 32; ++i) { const int kk = 2 * i + (lane >> 5), n = lane & 31; scr[kk * 33 + n] = n < nvalid ? W[(size_t)(k0 + kk) * ldw + col0 + n] : 0.f; }
    WSYNC();
    const int c = lane & 7;
#pragma unroll
    for (int j = 0; j < 4; ++j) { const int n = (lane >> 3) + 8 * j; const float* sp = scr + (8 * c) * 33 + n;
        u32x4 o; o.x = cvtpk(sp[0], sp[33]); o.y = cvtpk(sp[2 * 33], sp[3 * 33]); o.z = cvtpk(sp[4 * 33], sp[5 * 33]); o.w = cvtpk(sp[6 * 33], sp[7 * 33]);
        *(u32x4*)(WT + (size_t)(nrow0 + n) * ldt + k0 + 8 * c) = o; }
}

__device__ __forceinline__ void rms1024_row(const float* __restrict__ src, const float* __restrict__ g, bf16_t* __restrict__ o, bool zero, int lane) {
    if (zero) { for (int j = 0; j < 4; ++j) { ushort4 z = {0, 0, 0, 0}; *(ushort4*)(o + lane * 4 + 256 * j) = z; } return; }
    float4 v[4]; float ss = 0.f;
#pragma unroll
    for (int j = 0; j < 4; ++j) { v[j] = *(const float4*)(src + lane * 4 + 256 * j); ss += v[j].x * v[j].x + v[j].y * v[j].y + v[j].z * v[j].z + v[j].w * v[j].w; }
    ss = wave_sum(ss);
    const float rs = rsqrtf(ss * (1.f / 1024.f) + EPSV);
#pragma unroll
    for (int j = 0; j < 4; ++j) {
        const float4 gg = *(const float4*)(g + lane * 4 + 256 * j);
        ushort4 w; w.x = f2bf(v[j].x * rs * gg.x); w.y = f2bf(v[j].y * rs * gg.y); w.z = f2bf(v[j].z * rs * gg.z); w.w = f2bf(v[j].w * rs * gg.w);
        *(ushort4*)(o + lane * 4 + 256 * j) = w;
    }
}

__device__ __forceinline__ void rms1024_row_b(const bf16_t* __restrict__ src, const float* __restrict__ g, bf16_t* __restrict__ o, bool zero, int lane) {
    if (zero) { for (int j = 0; j < 2; ++j) { const u32x4 z = {0u, 0u, 0u, 0u}; *(u32x4*)(o + lane * 8 + 512 * j) = z; } return; }
    float v[2][8]; float ss = 0.f;
#pragma unroll
    for (int j = 0; j < 2; ++j) { bf8_to_f32(*(const bf16x8*)(src + lane * 8 + 512 * j), v[j]);
#pragma unroll
        for (int e = 0; e < 8; ++e) ss += v[j][e] * v[j][e]; }
    ss = wave_sum(ss);
    const float rs = rsqrtf(ss * (1.f / 1024.f) + EPSV);
#pragma unroll
    for (int j = 0; j < 2; ++j) {
        const float4 g0 = *(const float4*)(g + lane * 8 + 512 * j), g1 = *(const float4*)(g + lane * 8 + 512 * j + 4);
        float t[8] = {v[j][0] * rs * g0.x, v[j][1] * rs * g0.y, v[j][2] * rs * g0.z, v[j][3] * rs * g0.w, v[j][4] * rs * g1.x, v[j][5] * rs * g1.y, v[j][6] * rs * g1.z, v[j][7] * rs * g1.w};
        *(bf16x8*)(o + lane * 8 + 512 * j) = f32_to_bf8(t);
    }
}

struct ABf16 { const bf16_t* p; int lda; __device__ __forceinline__ bf16x8 load(int m, int k) const { return *(const bf16x8*)(p + (size_t)m * lda + k); } };
template <bool SWIGLU, class Epi>
__device__ __forceinline__ void gemm_sample_rows(const bf16_t* __restrict__ A, int lda, const bf16_t* __restrict__ Bt, int K, int N, const Epi& epi, char*  , int bid, int nb, int first = -1) {
    const int tid = otid(), lane = tid & 63, wid = tid >> 6, i16 = lane & 15, q4 = lane >> 4;
    for (int u = first >= 0 ? (bid - first + nb) % nb : nb - 1 - bid; u < N / 256; u += nb) {
        const int n0 = u * 256;
        const int c0 = SWIGLU ? n0 + 16 * wid : n0 + 32 * wid, c1 = SWIGLU ? n0 + 128 + 16 * wid : n0 + 32 * wid + 16;
        const bf16_t* a0p = A + (size_t)(NPT + i16) * lda + 8 * q4; const bf16_t* a1p = a0p + (size_t)16 * lda;
        const bf16_t* b0p = Bt + (size_t)(c0 + i16) * K + 8 * q4; const bf16_t* b1p = Bt + (size_t)(c1 + i16) * K + 8 * q4;
        f32x4 acc[2][2];
#pragma unroll
        for (int i = 0; i < 2; ++i)
#pragma unroll
            for (int j = 0; j < 2; ++j) acc[i][j] = (f32x4){0.f, 0.f, 0.f, 0.f};
#pragma unroll 4
        for (int k0 = 0; k0 < K; k0 += 32) {
            const bf16x8 a0 = *(const bf16x8*)(a0p + k0), a1 = *(const bf16x8*)(a1p + k0), b0 = *(const bf16x8*)(b0p + k0), b1 = *(const bf16x8*)(b1p + k0);
            acc[0][0] = __builtin_amdgcn_mfma_f32_16x16x32_bf16(a0, b0, acc[0][0], 0, 0, 0); acc[0][1] = __builtin_amdgcn_mfma_f32_16x16x32_bf16(a0, b1, acc[0][1], 0, 0, 0);
            acc[1][0] = __builtin_amdgcn_mfma_f32_16x16x32_bf16(a1, b0, acc[1][0], 0, 0, 0); acc[1][1] = __builtin_amdgcn_mfma_f32_16x16x32_bf16(a1, b1, acc[1][1], 0, 0, 0);
        }
#pragma unroll
        for (int i = 0; i < 2; ++i)
#pragma unroll
            for (int r = 0; r < 4; ++r) {
                const int m = NPT + 16 * i + 4 * q4 + r;
                if constexpr (SWIGLU) epi(m, (n0 >> 1) + 16 * wid + i16, siluf_(acc[i][0][r]) * acc[i][1][r]);
                else { epi(m, c0 + i16, acc[i][0][r]); epi(m, c1 + i16, acc[i][1][r]); }
            }
    }
}
template <bool SWIGLU, class Epi>
__device__ __forceinline__ void gemm_sample_rows_ks(const bf16_t* __restrict__ A, int lda, const bf16_t* __restrict__ Bt, int K, int N, const Epi& epi, char* smem, int bid, int nb) {
    const int tid = otid(), lane = tid & 63, wid = tid >> 6, i16 = lane & 15, q4 = lane >> 4;
    const int nunits = N / 64, ksl = K >> 3;
    f32x4* red = (f32x4*)smem;
    for (int u = nb - 1 - bid; u < nunits; u += nb) {
        int brow[4];
#pragma unroll
        for (int j = 0; j < 4; ++j) brow[j] = SWIGLU ? ((32 * u) >> 7) * 256 + ((32 * u) & 127) + 128 * (j >> 1) + 16 * (j & 1) + i16 : 64 * u + 16 * j + i16;
        const bf16_t* a0p = A + (size_t)(NPT + i16) * lda + wid * ksl + 8 * q4; const bf16_t* a1p = a0p + (size_t)16 * lda;
        f32x4 acc[2][4];
#pragma unroll
        for (int i = 0; i < 2; ++i)
#pragma unroll
            for (int j = 0; j < 4; ++j) acc[i][j] = (f32x4){0.f, 0.f, 0.f, 0.f};
        for (int k0 = 0; k0 < ksl; k0 += 32) {
            const bf16x8 a0 = *(const bf16x8*)(a0p + k0), a1 = *(const bf16x8*)(a1p + k0);
            bf16x8 b[4];
#pragma unroll
            for (int j = 0; j < 4; ++j) b[j] = *(const bf16x8*)(Bt + (size_t)brow[j] * K + wid * ksl + 8 * q4 + k0);
#pragma unroll
            for (int j = 0; j < 4; ++j) { acc[0][j] = __builtin_amdgcn_mfma_f32_16x16x32_bf16(a0, b[j], acc[0][j], 0, 0, 0); acc[1][j] = __builtin_amdgcn_mfma_f32_16x16x32_bf16(a1, b[j], acc[1][j], 0, 0, 0); }
        }
        __syncthreads();
#pragma unroll
        for (int i = 0; i < 2; ++i)
#pragma unroll
            for (int j = 0; j < 4; ++j) red[(wid * 8 + i * 4 + j) * 64 + lane] = acc[i][j];
        __syncthreads();
        if constexpr (SWIGLU) {
            if (tid < 256) {
                const int t4 = tid >> 6, i = t4 >> 1, jg = t4 & 1, l = tid & 63;
                f32x4 g = red[(i * 4 + jg) * 64 + l], up = red[(i * 4 + jg + 2) * 64 + l];
#pragma unroll
                for (int w = 1; w < 8; ++w) { g = g + red[(w * 8 + i * 4 + jg) * 64 + l]; up = up + red[(w * 8 + i * 4 + jg + 2) * 64 + l]; }
#pragma unroll
                for (int r = 0; r < 4; ++r) epi(NPT + 16 * i + 4 * (l >> 4) + r, 32 * u + 16 * jg + (l & 15), siluf_(g[r]) * up[r]);
            }
        } else {
            const int t8 = tid >> 6, l = tid & 63, i = t8 >> 2, j = t8 & 3;
            f32x4 v = red[t8 * 64 + l];
#pragma unroll
            for (int w = 1; w < 8; ++w) v = v + red[(w * 8 + t8) * 64 + l];
#pragma unroll
            for (int r = 0; r < 4; ++r) epi(NPT + 16 * i + 4 * (l >> 4) + r, 64 * u + 16 * j + (l & 15), v[r]);
        }
    }
    __syncthreads();
}
struct EwF32 { float* C; int ldc; __device__ __forceinline__ void operator()(int m, int n, float v) const { C[(size_t)m * ldc + n] = v; } };
struct EwBf16 { bf16_t* C; int ldc; __device__ __forceinline__ void operator()(int m, int n, float v) const { C[(size_t)m * ldc + n] = f2bf(v); } };
struct EwResX { const float* xs; bf16_t* C; __device__ __forceinline__ void operator()(int m, int n, float v) const { C[(size_t)m * 1024 + n] = f2bf(xs[(size_t)(m - NPT) * 1024 + n] + v); } };
struct EwResH { const bf16_t* H; bf16_t* C; __device__ __forceinline__ void operator()(int m, int n, float v) const { C[(size_t)m * 1024 + n] = f2bf(bf2f(H[(size_t)m * 1024 + n]) + v); } };
struct EwPle { const bf16_t* H2; const bf16_t* PP; float* out;
    __device__ __forceinline__ void operator()(int m, int n, float v) const { out[O_YS + (size_t)(m - NPT) * 1024 + n] = bf2f(H2[(size_t)m * 1024 + n]) + bf2f(PP[(size_t)m * 1024 + n]) * sigmoidf_(v); } };

struct PgBf16 {
    static constexpr bool PERM = true, AFTER_DRAIN = false; bf16_t* O; int ldc;
    __device__ __forceinline__ void operator()(const f32x4 (&acc)[2][2][4][2], const pg8::Unit& u, int wr, int wc, int fr, int fq) const {
#pragma unroll
        for (int ai = 0; ai < 2; ++ai)
#pragma unroll
            for (int m = 0; m < 4; ++m) { bf16_t* rowp = O + (size_t)(u.pm * 256 + ai * 128 + wr * 64 + m * 16 + fr) * ldc + u.pn * 256 + wc * 32 + 8 * fq;
#pragma unroll
                for (int bj = 0; bj < 2; ++bj) { const f32x4 v0 = acc[ai][bj][m][0], v1 = acc[ai][bj][m][1]; u32x4 w; w.x = pk2bf(v0[0], v0[1]); w.y = pk2bf(v0[2], v0[3]); w.z = pk2bf(v1[0], v1[1]); w.w = pk2bf(v1[2], v1[3]); *(u32x4*)(rowp + bj * 128) = w; } }
    }
};
struct PgF32 {
    static constexpr bool PERM = false, AFTER_DRAIN = false; float* O; int ldc;
    __device__ __forceinline__ void operator()(const f32x4 (&acc)[2][2][4][2], const pg8::Unit& u, int wr, int wc, int fr, int fq) const {
#pragma unroll
        for (int ai = 0; ai < 2; ++ai)
#pragma unroll
            for (int m = 0; m < 4; ++m) { float* rowp = O + (size_t)(u.pm * 256 + ai * 128 + wr * 64 + m * 16 + fr) * ldc + u.pn * 256 + wc * 32 + 4 * fq;
#pragma unroll
                for (int bj = 0; bj < 2; ++bj)
#pragma unroll
                    for (int n = 0; n < 2; ++n) *(f32x4*)(rowp + bj * 128 + n * 16) = acc[ai][bj][m][n]; }
    }
};
struct PgSwiglu {
    static constexpr bool PERM = true, AFTER_DRAIN = false; bf16_t* Hd;
    __device__ __forceinline__ void operator()(const f32x4 (&acc)[2][2][4][2], const pg8::Unit& u, int wr, int wc, int fr, int fq) const {
#pragma unroll
        for (int ai = 0; ai < 2; ++ai)
#pragma unroll
            for (int m = 0; m < 4; ++m) { bf16_t* rowp = Hd + (size_t)(u.pm * 256 + ai * 128 + wr * 64 + m * 16 + fr) * DFF + u.pn * 128 + wc * 32 + 8 * fq;
                float h[8];
#pragma unroll
                for (int n = 0; n < 2; ++n)
#pragma unroll
                    for (int i = 0; i < 4; ++i) h[n * 4 + i] = siluf_(acc[ai][0][m][n][i]) * acc[ai][1][m][n][i];
                u32x4 w; w.x = pk2bf(h[0], h[1]); w.y = pk2bf(h[2], h[3]); w.z = pk2bf(h[4], h[5]); w.w = pk2bf(h[6], h[7]); *(u32x4*)rowp = w; }
    }
};
struct PgResXB {
    static constexpr bool PERM = true, AFTER_DRAIN = false; const float* R; bf16_t* O;
    __device__ __forceinline__ void operator()(const f32x4 (&acc)[2][2][4][2], const pg8::Unit& u, int wr, int wc, int fr, int fq) const {
#pragma unroll
        for (int ai = 0; ai < 2; ++ai)
#pragma unroll
            for (int m = 0; m < 4; ++m) { const size_t off = (size_t)(u.pm * 256 + ai * 128 + wr * 64 + m * 16 + fr) * 1024 + u.pn * 256 + wc * 32 + 8 * fq;
#pragma unroll
                for (int bj = 0; bj < 2; ++bj) { const f32x4 r0 = *(const f32x4*)(R + off + bj * 128), r1 = *(const f32x4*)(R + off + bj * 128 + 4), v0 = r0 + acc[ai][bj][m][0], v1 = r1 + acc[ai][bj][m][1];
                    u32x4 w; w.x = cvtpk(v0[0], v0[1]); w.y = cvtpk(v0[2], v0[3]); w.z = cvtpk(v1[0], v1[1]); w.w = cvtpk(v1[2], v1[3]); *(u32x4*)(O + off + bj * 128) = w; } }
    }
};
struct PgResBB {
    static constexpr bool PERM = true, AFTER_DRAIN = false; const bf16_t* R; bf16_t* O;
    __device__ __forceinline__ void operator()(const f32x4 (&acc)[2][2][4][2], const pg8::Unit& u, int wr, int wc, int fr, int fq) const {
#pragma unroll
        for (int ai = 0; ai < 2; ++ai)
#pragma unroll
            for (int m = 0; m < 4; ++m) { const size_t off = (size_t)(u.pm * 256 + ai * 128 + wr * 64 + m * 16 + fr) * 1024 + u.pn * 256 + wc * 32 + 8 * fq;
#pragma unroll
                for (int bj = 0; bj < 2; ++bj) { float r[8]; bf8_to_f32(*(const bf16x8*)(R + off + bj * 128), r); const f32x4 a0 = acc[ai][bj][m][0], a1 = acc[ai][bj][m][1];
                    u32x4 w; w.x = cvtpk(r[0] + a0[0], r[1] + a0[1]); w.y = cvtpk(r[2] + a0[2], r[3] + a0[3]); w.z = cvtpk(r[4] + a1[0], r[5] + a1[1]); w.w = cvtpk(r[6] + a1[2], r[7] + a1[3]); *(u32x4*)(O + off + bj * 128) = w; } }
    }
};
struct PgPleB {
    static constexpr bool PERM = true, AFTER_DRAIN = false; const bf16_t* H2; const bf16_t* PP; float* out;
    __device__ __forceinline__ void operator()(const f32x4 (&acc)[2][2][4][2], const pg8::Unit& u, int wr, int wc, int fr, int fq) const {
#pragma unroll
        for (int ai = 0; ai < 2; ++ai)
#pragma unroll
            for (int m = 0; m < 4; ++m) { const size_t off = (size_t)(u.pm * 256 + ai * 128 + wr * 64 + m * 16 + fr) * 1024 + u.pn * 256 + wc * 32 + 8 * fq;
#pragma unroll
                for (int bj = 0; bj < 2; ++bj) { float h[8], pp[8]; bf8_to_f32(*(const bf16x8*)(H2 + off + bj * 128), h); bf8_to_f32(*(const bf16x8*)(PP + off + bj * 128), pp);
                    const f32x4 a0 = acc[ai][bj][m][0], a1 = acc[ai][bj][m][1]; f32x4 y0, y1;
#pragma unroll
                    for (int i = 0; i < 4; ++i) { y0[i] = h[i] + pp[i] * sigmoidf_(a0[i]); y1[i] = h[4 + i] + pp[4 + i] * sigmoidf_(a1[i]); }
                    *(f32x4*)(out + O_YP + off + bj * 128) = y0; *(f32x4*)(out + O_YP + off + bj * 128 + 4) = y1; } }
    }
};
template <class Epi>
__device__ __forceinline__ void pg_gemm(LAS unsigned char* lds, const bf16_t* A, const bf16_t* Bt, int M, int N, int K, const Epi& E, int glow = 0) {
    pg8::Gemm g{A, Bt, M, N, K}; pg8::StaticOrder S;
    if (glow > 0) { if ((int)blockIdx.x >= glow) return; S.init(M, N, glow, (int)blockIdx.x); }
    else S.init(M, N, (int)gridDim.x, (int)blockIdx.x);
    pg8::gemm_phase<Epi, pg8::StaticOrder, true, true>(lds, g, S, E);
}

constexpr size_t WOF_WinT = 0ull;
constexpr size_t WOF_WqbT = 5767168ull;
constexpr size_t WOF_WkvT = 6356992ull;
constexpr size_t WOF_WknT = 6881280ull;
constexpr size_t WOF_WoT = 7143424ull;
constexpr size_t WOF_WguT = 9240576ull;
constexpr size_t WOF_WdT = 20774912ull;
constexpr size_t WOF_WpgT = 26542080ull;
constexpr size_t WOF_WppT = 28639232ull;
constexpr size_t WOF_xn = 29163520ull;
constexpr size_t WOF_pb = 63242240ull;
constexpr size_t WOF_Z = 71761920ull;
constexpr size_t WOF_qkv = 165478400ull;
constexpr size_t WOF_ropecs = 216596480ull;
constexpr size_t WOF_gg = 216858880ull;
constexpr size_t WOF_bb = 217391360ull;
constexpr size_t WOF_goraw = 217923840ull;
constexpr size_t WOF_gUT = 252002560ull;
constexpr size_t WOF_ggam = 285556992ull;
constexpr size_t WOF_gWn = 285565184ull;
constexpr size_t WOF_gQg = 302342400ull;
constexpr size_t WOF_gQK = 319119616ull;
constexpr size_t WOF_gKd = 335896832ull;
constexpr size_t WOF_qan = 352674048ull;
constexpr size_t WOF_ckvb = 365453568ull;
constexpr size_t WOF_krf = 373973248ull;
constexpr size_t WOF_Q = 376103168ull;
constexpr size_t WOF_qh = 427221248ull;
constexpr size_t WOF_KV = 478339328ull;
constexpr size_t WOF_kh = 546496768ull;
constexpr size_t WOF_omix = 580575488ull;
constexpr size_t WOF_KN = 614654208ull;
constexpr size_t WOF_SC = 1151525120ull;
constexpr size_t WOF_part = 1168302336ull;
constexpr size_t WOF_H = 1170432256ull;
constexpr size_t WOF_un = 1238589696ull;
constexpr size_t WOF_G = 1272668416ull;
constexpr size_t WOF_hid = 1273028864ull;
constexpr size_t WOF_H2 = 1366745344ull;
constexpr size_t WOF_un2 = 1434902784ull;
constexpr size_t WOF_PP = 1468981504ull;
constexpr size_t WOF_qraw = 1537138944ull;
constexpr size_t WOF_kvraw = 1562304768ull;
constexpr size_t WOF_krb = 1595859200ull;
constexpr size_t WOF_ctl = 1596907776ull;
constexpr size_t WS_TOTAL = 1596924160ull;
struct MK {
    const float *x_prompt, *x_sample, *cache_ckv, *cache_krope, *state_gdn, *state_conv; const int* page_table; const float *p_prompt, *p_sample;
    const float *g_attn, *w_in, *w_conv, *a_log, *dt_bias, *g_gdn_out, *g_q_a, *w_q_b, *g_q_nope, *g_q_rope, *g_kv_a, *g_k_rope, *w_kv_b, *g_k_nope, *w_o, *g_ffn, *w_gate, *w_up, *w_down, *g_ple, *w_ple_gate, *w_ple_proj;
    float* out; char* ws;
    __device__ __forceinline__ unsigned* ctl() const { return (unsigned*)(ws + WOF_ctl); }
    __device__ __forceinline__ bf16_t* WinT() const { return (bf16_t*)(ws + WOF_WinT); }
    __device__ __forceinline__ bf16_t* WqbT() const { return (bf16_t*)(ws + WOF_WqbT); }
    __device__ __forceinline__ bf16_t* WkvT() const { return (bf16_t*)(ws + WOF_WkvT); }
    __device__ __forceinline__ bf16_t* WknT() const { return (bf16_t*)(ws + WOF_WknT); }
    __device__ __forceinline__ bf16_t* WoT() const { return (bf16_t*)(ws + WOF_WoT); }
    __device__ __forceinline__ bf16_t* WguT() const { return (bf16_t*)(ws + WOF_WguT); }
    __device__ __forceinline__ bf16_t* WdT() const { return (bf16_t*)(ws + WOF_WdT); }
    __device__ __forceinline__ bf16_t* WpgT() const { return (bf16_t*)(ws + WOF_WpgT); }
    __device__ __forceinline__ bf16_t* WppT() const { return (bf16_t*)(ws + WOF_WppT); }
    __device__ __forceinline__ bf16_t* xn() const { return (bf16_t*)(ws + WOF_xn); }
    __device__ __forceinline__ bf16_t* pb() const { return (bf16_t*)(ws + WOF_pb); }
    __device__ __forceinline__ bf16_t* Z() const { return (bf16_t*)(ws + WOF_Z); }
    __device__ __forceinline__ bf16_t* qkv() const { return (bf16_t*)(ws + WOF_qkv); }
    __device__ __forceinline__ float* ropecs() const { return (float*)(ws + WOF_ropecs); }
    __device__ __forceinline__ float* gg() const { return (float*)(ws + WOF_gg); }
    __device__ __forceinline__ float* bb() const { return (float*)(ws + WOF_bb); }
    __device__ __forceinline__ float* goraw() const { return (float*)(ws + WOF_goraw); }
    __device__ __forceinline__ float* gUT() const { return (float*)(ws + WOF_gUT); }
    __device__ __forceinline__ float* ggam() const { return (float*)(ws + WOF_ggam); }
    __device__ __forceinline__ bf16_t* gWn() const { return (bf16_t*)(ws + WOF_gWn); }
    __device__ __forceinline__ bf16_t* gQg() const { return (bf16_t*)(ws + WOF_gQg); }
    __device__ __forceinline__ bf16_t* gQK() const { return (bf16_t*)(ws + WOF_gQK); }
    __device__ __forceinline__ bf16_t* gKd() const { return (bf16_t*)(ws + WOF_gKd); }
    __device__ __forceinline__ bf16_t* qan() const { return (bf16_t*)(ws + WOF_qan); }
    __device__ __forceinline__ bf16_t* ckvb() const { return (bf16_t*)(ws + WOF_ckvb); }
    __device__ __forceinline__ float* krf() const { return (float*)(ws + WOF_krf); }
    __device__ __forceinline__ float* Q() const { return (float*)(ws + WOF_Q); }
    __device__ __forceinline__ float* qh() const { return (float*)(ws + WOF_qh); }
    __device__ __forceinline__ float* KV() const { return (float*)(ws + WOF_KV); }
    __device__ __forceinline__ float* kh() const { return (float*)(ws + WOF_kh); }
    __device__ __forceinline__ bf16_t* omix() const { return (bf16_t*)(ws + WOF_omix); }
    __device__ __forceinline__ bf16_t* KN() const { return (bf16_t*)(ws + WOF_KN); }
    __device__ __forceinline__ float* SC() const { return (float*)(ws + WOF_SC); }
    __device__ __forceinline__ float* part() const { return (float*)(ws + WOF_part); }
    __device__ __forceinline__ bf16_t* H() const { return (bf16_t*)(ws + WOF_H); }
    __device__ __forceinline__ bf16_t* un() const { return (bf16_t*)(ws + WOF_un); }
    __device__ __forceinline__ float* G() const { return (float*)(ws + WOF_G); }
    __device__ __forceinline__ bf16_t* hid() const { return (bf16_t*)(ws + WOF_hid); }
    __device__ __forceinline__ bf16_t* H2() const { return (bf16_t*)(ws + WOF_H2); }
    __device__ __forceinline__ bf16_t* un2() const { return (bf16_t*)(ws + WOF_un2); }
    __device__ __forceinline__ bf16_t* PP() const { return (bf16_t*)(ws + WOF_PP); }
    __device__ __forceinline__ bf16_t* qraw() const { return (bf16_t*)(ws + WOF_qraw); }
    __device__ __forceinline__ bf16_t* kvraw() const { return (bf16_t*)(ws + WOF_kvraw); }
    __device__ __forceinline__ bf16_t* krb() const { return (bf16_t*)(ws + WOF_krb); }
};

__device__ __forceinline__ float fast_sigmoid(float x) { return __builtin_amdgcn_rcpf(1.f + __builtin_amdgcn_exp2f(-1.44269504f * x)); }
struct PinTok { bf16x8 qa, cv, kr; float ab; };
struct PinGain { float gqa[8], gkv[8], gkr[8], dtb, alog; };
__device__ __forceinline__ PinTok pin_load(const MK& a, int row, int lane) {
    const bf16_t* z = a.Z() + (size_t)row * ZW; PinTok t; const bf16x8 zz = {0, 0, 0, 0, 0, 0, 0, 0};
    t.qa = lane < 48 ? *(const bf16x8*)(z + OFF_QA + 8 * lane) : zz; t.cv = lane < 32 ? *(const bf16x8*)(z + OFF_KVA + 8 * lane) : zz;
    t.kr = (lane >= 32 && lane < 36) ? *(const bf16x8*)(z + OFF_KR + 8 * (lane - 32)) : zz; t.ab = lane < 16 ? bf2f(z[OFF_A + lane]) : 0.f; return t;
}
__device__ __forceinline__ void post_in_token(const MK& a, int row, int lane, const float* wcs, const bf16x8 (&w0)[3], const bf16x8 (&w1)[3], const bf16x8 (&w2)[3], const bf16x8 (&wcur)[3], const PinTok& tk, const PinGain& gn) {
    const bool samp = row >= NPT;
    const int b = samp ? row - NPT : row >> 11, t = samp ? 0 : row & 2047, hd = lane >> 3;
    float y[24];
#pragma unroll
    for (int c3 = 0; c3 < 3; ++c3) {
        float p0[8], p1[8], p2[8], cu[8];
        bf8_to_f32(w0[c3], p0); bf8_to_f32(w1[c3], p1); bf8_to_f32(w2[c3], p2); bf8_to_f32(wcur[c3], cu);
        const float* wp = wcs + 512 * c3 + 8 * lane;
        const float4 a0 = *(const float4*)wp, a1 = *(const float4*)(wp + 4), b0 = *(const float4*)(wp + 1536), b1 = *(const float4*)(wp + 1540);
        const float4 c0 = *(const float4*)(wp + 3072), c1 = *(const float4*)(wp + 3076), d0 = *(const float4*)(wp + 4608), d1 = *(const float4*)(wp + 4612);
        const float k0[8] = {a0.x, a0.y, a0.z, a0.w, a1.x, a1.y, a1.z, a1.w}, k1[8] = {b0.x, b0.y, b0.z, b0.w, b1.x, b1.y, b1.z, b1.w};
        const float k2[8] = {c0.x, c0.y, c0.z, c0.w, c1.x, c1.y, c1.z, c1.w}, k3[8] = {d0.x, d0.y, d0.z, d0.w, d1.x, d1.y, d1.z, d1.w};
#pragma unroll
        for (int e = 0; e < 8; ++e) { const int c = 8 * c3 + e; const float v = k0[e] * p0[e] + k1[e] * p1[e] + k2[e] * p2[e] + k3[e] * cu[e]; y[c] = v * fast_sigmoid(v); }
        __builtin_amdgcn_sched_barrier(0);
    }
    float sq = 0.f, sk = 0.f;
#pragma unroll
    for (int e = 0; e < 8; ++e) { sq += y[e] * y[e]; sk += y[8 + e] * y[8 + e]; }
    sq = sum8(sq); sk = sum8(sk);
    const float rq = rsqrtf(sq + EPSV) * 0.125f, rk = rsqrtf(sk + EPSV);
#pragma unroll
    for (int e = 0; e < 8; ++e) { y[e] *= rq; y[8 + e] *= rk; }
    bf16_t* qo = a.qkv() + (size_t)row * 1536 + 8 * lane;
    *(bf16x8*)qo = f32_to_bf8(y); *(bf16x8*)(qo + 512) = f32_to_bf8(y + 8); *(bf16x8*)(qo + 1024) = f32_to_bf8(y + 16);
    if (!samp && t >= SEQ - 3) {
        float* cso = a.out + O_CSP + ((size_t)b * 3 + (t - (SEQ - 3))) * 1536 + 8 * lane;
#pragma unroll
        for (int j = 0; j < 3; ++j) { float cu[8]; bf8_to_f32(wcur[j], cu); *(float4*)(cso + 512 * j) = (float4){cu[0], cu[1], cu[2], cu[3]}; *(float4*)(cso + 512 * j + 4) = (float4){cu[4], cu[5], cu[6], cu[7]}; }
    }
    if (lane < 16) {
        const float v = tk.ab;
        if (lane < 8) { const float xx = v + gn.dtb; const float sp = xx > 20.f ? xx : 0.69314718f * __builtin_amdgcn_logf(1.f + __builtin_amdgcn_exp2f(1.44269504f * xx)); a.gg()[(size_t)row * 8 + lane] = -gn.alog * sp; }
        else a.bb()[(size_t)row * 8 + lane - 8] = sigmoidf_(v);
    }
    __builtin_amdgcn_sched_barrier(0);
    float qa[8], cv[8], kr[8];
    bf8_to_f32(tk.qa, qa); bf8_to_f32(tk.cv, cv); bf8_to_f32(tk.kr, kr);
    float s1 = 0.f, s2 = 0.f, s3 = 0.f;
#pragma unroll
    for (int e = 0; e < 8; ++e) { s1 += qa[e] * qa[e]; s2 += cv[e] * cv[e]; s3 += kr[e] * kr[e]; }
    s1 = wave_sum(s1); s2 = wave_sum(s2); s3 = wave_sum(s3);
    const float r1 = rsqrtf(s1 * (1.f / 384.f) + EPSV), r2 = rsqrtf(s2 * (1.f / 256.f) + EPSV), r3 = rsqrtf(s3 * (1.f / 32.f) + EPSV);
    if (lane < 48) {
        float o[8];
#pragma unroll
        for (int e = 0; e < 8; ++e) o[e] = qa[e] * r1 * gn.gqa[e];
        *(bf16x8*)(a.qan() + (size_t)row * 384 + 8 * lane) = f32_to_bf8(o);
    }
    if (lane < 32) {
        float o[8];
#pragma unroll
        for (int e = 0; e < 8; ++e) o[e] = cv[e] * r2 * gn.gkv[e];
        *(bf16x8*)(a.ckvb() + (size_t)row * 256 + 8 * lane) = f32_to_bf8(o);
        float* co = samp ? a.out + O_CKVS + (size_t)b * 256 + 8 * lane : a.out + O_CKVP + (size_t)row * 256 + 8 * lane;
        *(float4*)co = (float4){o[0], o[1], o[2], o[3]}; *(float4*)(co + 4) = (float4){o[4], o[5], o[6], o[7]};
    }
    __builtin_amdgcn_sched_barrier(0);
    {
        const int c4 = (lane - 32) & 3;
        float xn[8], ot[8];
#pragma unroll
        for (int e = 0; e < 8; ++e) xn[e] = kr[e] * r3 * gn.gkr[e];
#pragma unroll
        for (int e = 0; e < 8; ++e) ot[e] = dpp_mov<0x4E>(xn[e]);
        if (lane >= 32 && lane < 36) {
            const float* tb = a.ropecs() + (size_t)(samp ? 2048 : t) * 32 + ((8 * c4) & 15);
            const float4 c0 = *(const float4*)tb, c1 = *(const float4*)(tb + 4), s0 = *(const float4*)(tb + 16), s1 = *(const float4*)(tb + 20);
            const float csv[8] = {c0.x, c0.y, c0.z, c0.w, c1.x, c1.y, c1.z, c1.w}, snv[8] = {s0.x, s0.y, s0.z, s0.w, s1.x, s1.y, s1.z, s1.w};
            float o[8];
#pragma unroll
            for (int e = 0; e < 8; ++e) o[e] = c4 < 2 ? xn[e] * csv[e] - ot[e] * snv[e] : ot[e] * snv[e] + xn[e] * csv[e];
            float* kf_ = a.krf() + (size_t)row * 32 + 8 * c4; *(float4*)kf_ = (float4){o[0], o[1], o[2], o[3]}; *(float4*)(kf_ + 4) = (float4){o[4], o[5], o[6], o[7]};
            float* ko = samp ? a.out + O_KRS + (size_t)b * 32 + 8 * c4 : a.out + O_KRP + (size_t)row * 32 + 8 * c4;
            *(float4*)ko = (float4){o[0], o[1], o[2], o[3]}; *(float4*)(ko + 4) = (float4){o[4], o[5], o[6], o[7]};
            if (!samp) *(bf16x8*)(a.krb() + (size_t)row * 32 + 8 * c4) = f32_to_bf8(o);
        }
    }
    (void)hd;
}
__device__ __forceinline__ void post_in_run(const MK& a, int run, int lane_in, const float* wcs) {
    int lane = lane_in; asm volatile("" : "+v"(lane));
    PinGain gn;
    {
        const int lq = lane < 48 ? lane : 0, lk = lane < 32 ? lane : 0, c4 = (lane - 32) & 3;
#pragma unroll
        for (int e = 0; e < 8; ++e) { gn.gqa[e] = a.g_q_a[8 * lq + e]; gn.gkv[e] = a.g_kv_a[8 * lk + e]; gn.gkr[e] = a.g_k_rope[8 * c4 + e]; }
        gn.dtb = a.dt_bias[lane & 7]; gn.alog = expf(a.a_log[lane & 7]);
    }
    if (run < NPT / 8) {
        const int row0 = run * 8, t0 = row0 & 2047;
        bf16x8 w0[3], w1[3], w2[3], wcur[3];
#pragma unroll
        for (int c3 = 0; c3 < 3; ++c3) {
            const bf16x8 zz = {0, 0, 0, 0, 0, 0, 0, 0}; w0[c3] = zz; w1[c3] = zz; w2[c3] = zz;
            if (t0 > 0) { const bf16_t* zp = a.Z() + (size_t)(row0 - 3) * ZW + 512 * c3 + 8 * lane; w0[c3] = *(const bf16x8*)zp; w1[c3] = *(const bf16x8*)(zp + ZW); w2[c3] = *(const bf16x8*)(zp + 2 * ZW); }
        }
        bf16x8 wnext[3]; PinTok tk, tkn;
#pragma unroll
        for (int c3 = 0; c3 < 3; ++c3) wnext[c3] = *(const bf16x8*)(a.Z() + (size_t)row0 * ZW + 512 * c3 + 8 * lane);
        tkn = pin_load(a, row0, lane);
#pragma unroll 1
        for (int k = 0; k < 8; ++k) {
            const int row = row0 + k;
#pragma unroll
            for (int c3 = 0; c3 < 3; ++c3) wcur[c3] = wnext[c3];
            tk = tkn;
            if (k < 7) {
#pragma unroll
                for (int c3 = 0; c3 < 3; ++c3) wnext[c3] = *(const bf16x8*)(a.Z() + (size_t)(row + 1) * ZW + 512 * c3 + 8 * lane);
                tkn = pin_load(a, row + 1, lane);
            }
            post_in_token(a, row, lane, wcs, w0, w1, w2, wcur, tk, gn);
#pragma unroll
            for (int c3 = 0; c3 < 3; ++c3) { w0[c3] = w1[c3]; w1[c3] = w2[c3]; w2[c3] = wcur[c3]; }
        }
    } else {
        {
            const int bsm = run - NPT / 8, row = NPT + bsm;
            bf16x8 w0[3], w1[3], w2[3], wcur[3];
#pragma unroll
            for (int c3 = 0; c3 < 3; ++c3) {
                const float* sp = a.state_conv + (size_t)bsm * 3 * 1536 + 512 * c3 + 8 * lane;
                float* cso = a.out + O_CSS + (size_t)bsm * 3 * 1536 + 512 * c3 + 8 * lane;
                float t0_[8], t1_[8], t2_[8], tc_[8];
#pragma unroll
                for (int e = 0; e < 8; ++e) { t0_[e] = sp[e]; t1_[e] = sp[1536 + e]; t2_[e] = sp[2 * 1536 + e]; }
                wcur[c3] = *(const bf16x8*)(a.Z() + (size_t)row * ZW + 512 * c3 + 8 * lane); bf8_to_f32(wcur[c3], tc_);
#pragma unroll
                for (int e = 0; e < 8; ++e) { cso[e] = t1_[e]; cso[1536 + e] = t2_[e]; cso[2 * 1536 + e] = tc_[e]; }
                w0[c3] = f32_to_bf8(t0_); w1[c3] = f32_to_bf8(t1_); w2[c3] = f32_to_bf8(t2_);
            }
            post_in_token(a, row, lane, wcs, w0, w1, w2, wcur, pin_load(a, row, lane), gn);
        }
    }
}

__device__ __forceinline__ void post_q_item(const MK& a, int idx, int lane) {
    const int row = idx >> 3, h = idx & 7;
    const float* q = a.Q() + (size_t)row * 768 + h * 96;
    float* o = a.qh() + ((size_t)row * 8 + h) * 96;
    const float v = q[lane];
    const float ss = wave_sum(v * v);
    o[lane] = v * rsqrtf(ss * (1.f / 64.f) + EPSV) * a.g_q_nope[lane];
    const float r = lane < 32 ? q[64 + lane] : 0.f;
    const float s2 = wave_sum(r * r);
    const float xn = lane < 32 ? r * rsqrtf(s2 * (1.f / 32.f) + EPSV) * a.g_q_rope[lane] : 0.f;
    const float other = __shfl_xor(xn, 16);
    const int i = lane & 15;
    const float* tb = a.ropecs() + (size_t)(row >= NPT ? 2048 : (row & 2047)) * 32;
    const float cs = tb[i], sn = tb[16 + i];
    const float ov = lane < 16 ? xn * cs - other * sn : other * sn + xn * cs;
    if (lane < 32) o[64 + lane] = ov;
}
__device__ __forceinline__ void post_kv_item(const MK& a, int idx, int lane) {
    const int row = idx >> 3, h = idx & 7;
    const float v = a.KV()[(size_t)row * 1024 + h * 128 + lane];
    const float ss = wave_sum(v * v);
    const float kn = v * rsqrtf(ss * (1.f / 64.f) + EPSV) * a.g_k_nope[lane];
    a.kh()[((size_t)row * 8 + h) * 64 + lane] = kn;
}

typedef float f32x16 __attribute__((ext_vector_type(16)));
typedef short s16x4 __attribute__((ext_vector_type(4)));
#define KST 104
#define VST 72
#define ATT_BUF (64 * KST * 2 + 64 * VST * 2)
__device__ __forceinline__ int crow32(int r, int hi) { return (r & 3) + 8 * (r >> 2) + 4 * hi; }
__device__ __forceinline__ s16x4 tr_read(const bf16_t* p) { return __builtin_bit_cast(s16x4, __builtin_amdgcn_ds_read_tr16_b64_v4i16((LAS s16x4*)(LAS void*)(unsigned)(size_t)p)); }
__device__ __forceinline__ bf16x8 pack8(const f32x16& x, int s) {
    u32x4 w; w.x = cvtpk(x[8 * s], x[8 * s + 1]); w.y = cvtpk(x[8 * s + 2], x[8 * s + 3]); w.z = cvtpk(x[8 * s + 4], x[8 * s + 5]); w.w = cvtpk(x[8 * s + 6], x[8 * s + 7]);
    return __builtin_bit_cast(bf16x8, w);
}
__device__ __forceinline__ void attn_block(const MK& a, int b, int h, int qb, char* smem) {
    const int tid = otid(), lane = tid & 63, wid = tid >> 6, r32 = lane & 31, hi = lane >> 5;
    const int qrow = qb * 256 + wid * 32 + r32;
    const int wq0 = qb * 256 + wid * 32;
    bf16x8 qf[6];
    {
        const float SCL = 0.14724445f;
        const bf16_t* Qg = a.qraw() + ((size_t)b * SEQ + qrow) * 768 + h * 96 + 8 * hi;
        float qv[6][8];
#pragma unroll
        for (int ds = 0; ds < 6; ++ds) bf8_to_f32(*(const bf16x8*)(Qg + 16 * ds), qv[ds]);
        float sn_ = 0.f, sr_ = 0.f;
#pragma unroll
        for (int j = 0; j < 8; ++j) { sn_ += qv[0][j] * qv[0][j] + qv[1][j] * qv[1][j] + qv[2][j] * qv[2][j] + qv[3][j] * qv[3][j]; sr_ += qv[4][j] * qv[4][j] + qv[5][j] * qv[5][j]; }
        sn_ = add_x32(sn_); sr_ = add_x32(sr_);
        const float rsn = rsqrtf(sn_ * (1.f / 64.f) + EPSV) * SCL, rsr = rsqrtf(sr_ * (1.f / 32.f) + EPSV);
#pragma unroll
        for (int ds = 0; ds < 4; ++ds) {
            float o[8];
#pragma unroll
            for (int j = 0; j < 8; ++j) o[j] = qv[ds][j] * rsn * a.g_q_nope[16 * ds + 8 * hi + j];
            qf[ds] = f32_to_bf8(o);
        }
        const float* tb = a.ropecs() + (size_t)qrow * 32 + 8 * hi;
        float o4[8], o5[8];
#pragma unroll
        for (int j = 0; j < 8; ++j) {
            const float x1 = qv[4][j] * rsr * a.g_q_rope[8 * hi + j], x2 = qv[5][j] * rsr * a.g_q_rope[16 + 8 * hi + j], cs = tb[j], sn = tb[16 + j];
            o4[j] = (x1 * cs - x2 * sn) * SCL; o5[j] = (x1 * sn + x2 * cs) * SCL;
        }
        qf[4] = f32_to_bf8(o4); qf[5] = f32_to_bf8(o5);
    }
    f32x16 o0, o1;
#pragma unroll
    for (int r = 0; r < 16; ++r) { o0[r] = 0.f; o1[r] = 0.f; }
    float m = 0.f, l = 0.f;
    f32x16 negm;
#pragma unroll
    for (int r = 0; r < 16; ++r) negm[r] = 0.f;
    const int nt = qb * 4 + 4;
    const int vr = tid >> 3, vc = tid & 7, rr_ = (tid >> 2) & 63, rc = tid & 3;
    const bf16_t* KVg = a.kvraw() + (size_t)b * SEQ * 1024 + h * 128 + (size_t)vr * 1024 + vc * 8;
    const bf16_t* KRg = a.krb() + (size_t)b * SEQ * 32 + (size_t)rr_ * 32 + rc * 8;
    float gk[8];
#pragma unroll
    for (int j = 0; j < 8; ++j) gk[j] = a.g_k_nope[8 * vc + j];
    bf16x8 kr0, kr1, vr0;
#define ATT_LOAD(tt) do { kr0 = *(const bf16x8*)(KVg + (size_t)(tt) * 64 * 1024); vr0 = *(const bf16x8*)(KVg + (size_t)(tt) * 64 * 1024 + 64); if (tid < 256) kr1 = *(const bf16x8*)(KRg + (size_t)(tt) * 64 * 32); } while (0)
#define ATT_STORE(buf) do { bf16_t* Ks_ = (bf16_t*)(smem + (buf) * ATT_BUF); bf16_t* Vs_ = Ks_ + 64 * KST; \
        float x_[8]; bf8_to_f32(kr0, x_); float ss_ = 0.f; _Pragma("unroll") for (int j = 0; j < 8; ++j) ss_ += x_[j] * x_[j]; \
        ss_ = sum8(ss_); const float rs_ = rsqrtf(ss_ * (1.f / 64.f) + EPSV); \
        _Pragma("unroll") for (int j = 0; j < 8; ++j) x_[j] *= rs_ * gk[j]; \
        *(bf16x8*)(Ks_ + vr * KST + vc * 8) = f32_to_bf8(x_); *(bf16x8*)(Vs_ + vr * VST + vc * 8) = vr0; \
        if (tid < 256) *(bf16x8*)(Ks_ + rr_ * KST + 64 + rc * 8) = kr1; } while (0)
    ATT_LOAD(0);
    __syncthreads();
    ATT_STORE(0);
    __syncthreads();
    const int i16 = lane & 15, qq = i16 >> 2, pp = i16 & 3, g1 = (lane >> 4) & 1;
    for (int t = 0; t < nt; ++t) {
        const bf16_t* Ks = (const bf16_t*)(smem + (t & 1) * ATT_BUF); const bf16_t* Vs = Ks + 64 * KST;
        if (t + 1 < nt) ATT_LOAD(t + 1);
        if (64 * t <= wq0 + 31) {
            f32x16 p0, p1;
#pragma unroll
            for (int ds = 0; ds < 6; ++ds) {
                const bf16x8 k0 = *(const bf16x8*)(Ks + r32 * KST + 16 * ds + 8 * hi);
                const bf16x8 k1 = *(const bf16x8*)(Ks + (32 + r32) * KST + 16 * ds + 8 * hi);
                if (ds == 0) { p0 = __builtin_amdgcn_mfma_f32_32x32x16_bf16(k0, qf[ds], negm, 0, 0, 0); p1 = __builtin_amdgcn_mfma_f32_32x32x16_bf16(k1, qf[ds], negm, 0, 0, 0); }
                else { p0 = __builtin_amdgcn_mfma_f32_32x32x16_bf16(k0, qf[ds], p0, 0, 0, 0); p1 = __builtin_amdgcn_mfma_f32_32x32x16_bf16(k1, qf[ds], p1, 0, 0, 0); }
            }
            if (64 * t + 63 > wq0) {
#pragma unroll
                for (int r = 0; r < 16; ++r) { const int kv = 64 * t + crow32(r, hi); if (kv > qrow) p0[r] = -INFINITY; if (kv + 32 > qrow) p1[r] = -INFINITY; }
            }
            float mx = fmaxf(p0[0], p1[0]);
#pragma unroll
            for (int r = 1; r < 16; ++r) mx = fmaxf(mx, fmaxf(p0[r], p1[r]));
            mx = max_x32(mx);
            const float delta = t == 0 ? mx : fmaxf(mx, 0.f);
            if (__any(delta != 0.f)) {
                m += delta;
                const float f = t == 0 ? 1.f : __builtin_amdgcn_exp2f(-delta);
#pragma unroll
                for (int r = 0; r < 16; ++r) { p0[r] -= delta; p1[r] -= delta; negm[r] = -m; o0[r] *= f; o1[r] *= f; }
                l *= f;
            }
            float rs = 0.f;
#pragma unroll
            for (int r = 0; r < 16; ++r) { p0[r] = __builtin_amdgcn_exp2f(p0[r]); p1[r] = __builtin_amdgcn_exp2f(p1[r]); rs += p0[r] + p1[r]; }
            l += rs;
            bf16x8 pf[4];
            pf[0] = pack8(p0, 0); pf[1] = pack8(p0, 1); pf[2] = pack8(p1, 0); pf[3] = pack8(p1, 1);
#pragma unroll
            for (int ks = 0; ks < 4; ++ks) {
                const bf16_t* vb0 = Vs + (16 * ks + 4 * hi + qq) * VST + 16 * g1 + 4 * pp;
                const s16x4 a0 = tr_read(vb0), a1 = tr_read(vb0 + 8 * VST);
                const s16x4 c0 = tr_read(vb0 + 32), c1 = tr_read(vb0 + 8 * VST + 32);
                const bf16x8 va = __builtin_shufflevector(a0, a1, 0, 1, 2, 3, 4, 5, 6, 7);
                const bf16x8 vc_ = __builtin_shufflevector(c0, c1, 0, 1, 2, 3, 4, 5, 6, 7);
                o0 = __builtin_amdgcn_mfma_f32_32x32x16_bf16(va, pf[ks], o0, 0, 0, 0);
                o1 = __builtin_amdgcn_mfma_f32_32x32x16_bf16(vc_, pf[ks], o1, 0, 0, 0);
            }
        }
        if (t + 1 < nt) ATT_STORE((t + 1) & 1);
        __syncthreads();
    }
    l = add_x32(l);
    const float il = 1.f / l;
    bf16_t* op = a.omix() + ((size_t)b * SEQ + qrow) * 1024 + 512 + h * 64;
#pragma unroll
    for (int g = 0; g < 4; ++g) {
        uint2 w0, w1;
        w0.x = pk2bf(o0[4 * g] * il, o0[4 * g + 1] * il); w0.y = pk2bf(o0[4 * g + 2] * il, o0[4 * g + 3] * il);
        w1.x = pk2bf(o1[4 * g] * il, o1[4 * g + 1] * il); w1.y = pk2bf(o1[4 * g + 2] * il, o1[4 * g + 3] * il);
        *(uint2*)(op + 8 * g + 4 * hi) = w0;
        *(uint2*)(op + 32 + 8 * g + 4 * hi) = w1;
    }
#undef ATT_LOAD
#undef ATT_STORE
}

__device__ __forceinline__ void gdn_unit(const MK& a, int b, int h, int dvg, const float* s0, float* sout, int row0, int T, int lane, char* wsm) {
    float (*sq)[64] = (float (*)[64])wsm;
    float (*sk)[64] = (float (*)[64])(wsm + 4096);
    float (*sv)[8] = (float (*)[8])(wsm + 8192);
    float* sg = (float*)(wsm + 8704);
    float* sb = (float*)(wsm + 8768);
    const int e = lane & 7, ko = lane >> 3, col = dvg * 8 + e;
    float S[8];
#pragma unroll
    for (int d = 0; d < 8; ++d) S[d] = s0 ? s0[(((size_t)b * 8 + h) * 64 + ko * 8 + d) * 64 + col] : 0.f;
    const size_t rbase = (size_t)row0 + (size_t)b * T;
    float pq[16], pk[16], pv0, pv1, pgb;
    {
        const int nt = T < 16 ? T : 16;
#pragma unroll
        for (int j = 0; j < 16; ++j) { const bool ok = j < nt; const size_t r = rbase + (ok ? j : 0); pq[j] = ok ? bf2f(a.qkv()[r * 1536 + h * 64 + lane]) : 0.f; pk[j] = ok ? bf2f(a.qkv()[r * 1536 + 512 + h * 64 + lane]) : 0.f; }
        { const int j0 = lane >> 3, j1 = j0 + 8; pv0 = j0 < nt ? bf2f(a.qkv()[(rbase + j0) * 1536 + 1024 + h * 64 + dvg * 8 + (lane & 7)]) : 0.f; pv1 = j1 < nt ? bf2f(a.qkv()[(rbase + j1) * 1536 + 1024 + h * 64 + dvg * 8 + (lane & 7)]) : 0.f; }
        { const int j = lane & 15; pgb = j < nt ? (lane < 16 ? a.gg()[(rbase + j) * 8 + h] : a.bb()[(rbase + j) * 8 + h]) : 0.f; }
    }
    for (int t0 = 0; t0 < T; t0 += 16) {
        const int nt = (T - t0) < 16 ? (T - t0) : 16;
        WSYNC();
#pragma unroll
        for (int j = 0; j < 16; ++j) { sq[j][lane] = pq[j]; sk[j][lane] = pk[j]; }
        sv[lane >> 3][lane & 7] = pv0; sv[(lane >> 3) + 8][lane & 7] = pv1;
        if (lane < 16) sg[lane] = expf(pgb); else if (lane < 32) sb[lane - 16] = pgb;
        WSYNC();
        if (t0 + 16 < T) {
            const size_t rb = rbase + t0 + 16;
#pragma unroll
            for (int j = 0; j < 16; ++j) { pq[j] = bf2f(a.qkv()[(rb + j) * 1536 + h * 64 + lane]); pk[j] = bf2f(a.qkv()[(rb + j) * 1536 + 512 + h * 64 + lane]); }
            pv0 = bf2f(a.qkv()[(rb + (lane >> 3)) * 1536 + 1024 + h * 64 + dvg * 8 + (lane & 7)]); pv1 = bf2f(a.qkv()[(rb + (lane >> 3) + 8) * 1536 + 1024 + h * 64 + dvg * 8 + (lane & 7)]);
            pgb = lane < 16 ? a.gg()[(rb + (lane & 15)) * 8 + h] : a.bb()[(rb + (lane & 15)) * 8 + h];
        }
        for (int j = 0; j < nt; ++j) {
            const float dec = sg[j], be = sb[j], v = sv[j][e];
            const float4 k0 = *(const float4*)&sk[j][ko * 8], k1 = *(const float4*)&sk[j][ko * 8 + 4];
            const float4 q0 = *(const float4*)&sq[j][ko * 8], q1 = *(const float4*)&sq[j][ko * 8 + 4];
            const float kk[8] = {k0.x, k0.y, k0.z, k0.w, k1.x, k1.y, k1.z, k1.w};
            const float qq[8] = {q0.x, q0.y, q0.z, q0.w, q1.x, q1.y, q1.z, q1.w};
            float ks = 0.f;
#pragma unroll
            for (int d = 0; d < 8; ++d) { S[d] *= dec; ks += kk[d] * S[d]; }
            ks += __shfl_xor(ks, 8); ks += __shfl_xor(ks, 16); ks += __shfl_xor(ks, 32);
            const float delta = (v - ks) * be;
            float ov = 0.f;
#pragma unroll
            for (int d = 0; d < 8; ++d) { S[d] += kk[d] * delta; ov += qq[d] * S[d]; }
            ov += __shfl_xor(ov, 8); ov += __shfl_xor(ov, 16); ov += __shfl_xor(ov, 32);
            if (ko == 0) a.goraw()[(rbase + t0 + j) * 512 + h * 64 + col] = ov;
        }
    }
#pragma unroll
    for (int d = 0; d < 8; ++d) sout[(((size_t)b * 8 + h) * 64 + ko * 8 + d) * 64 + col] = S[d];
}
__device__ __forceinline__ int pi_pos(int k) { return (k & 32) + 8 * ((k >> 2) & 3) + 4 * ((k >> 4) & 1) + (k & 3); }
#define GDN_WLDS 17408
__device__ __forceinline__ void gdn_prep_unit(const MK& a, int u, int lane_in, char* wsm) {
    int lane = lane_in; asm volatile("" : "+v"(lane));
    const int bh = u >> 5, n = u & 31, b = bh >> 3, h = bh & 7, i16 = lane & 15, q4 = lane >> 4;
    const size_t row0 = (size_t)b * SEQ + n * 64;
    float* AT = (float*)wsm; float* GC = (float*)(wsm + 16384); float* BT = GC + 64;
    const bf16_t* qbase = a.qkv() + row0 * 1536 + h * 64; const bf16_t* kbase = qbase + 512; const bf16_t* vbase = qbase + 1024;
    float g = a.gg()[(row0 + lane) * 8 + h];
    const float be_l = a.bb()[(row0 + lane) * 8 + h];
#pragma unroll
    for (int o = 1; o < 64; o <<= 1) { const float t = __shfl_up(g, o); if (lane >= o) g += t; }
    WSYNC();
    GC[lane] = g; BT[lane] = be_l;
    WSYNC();
    const float gl = GC[63];
    float* EG = BT + 64; float* ED = EG + 64;
    EG[lane] = expf(g); ED[lane] = expf(gl - g);
    WSYNC();
    bf16x8 kf[4][2], qf[4][2];
#pragma unroll
    for (int mt = 0; mt < 4; ++mt)
#pragma unroll
        for (int ks = 0; ks < 2; ++ks) {
            const int off = (16 * mt + i16) * 1536 + 32 * ks + 8 * q4;
            kf[mt][ks] = *(const bf16x8*)(kbase + off); qf[mt][ks] = *(const bf16x8*)(qbase + off);
        }
    bf16_t* QKg = a.gQK() + (size_t)u * 4096;
#pragma unroll
    for (int mt = 0; mt < 4; ++mt)
#pragma unroll
        for (int nt = 0; nt < 4; ++nt) {
            const int j = 16 * nt + i16, pj = 32 * (nt >> 1) + 8 * (i16 >> 2) + 4 * (nt & 1) + (i16 & 3);
            if (nt <= mt) {
                f32x4 d1 = {0.f, 0.f, 0.f, 0.f}, d2 = {0.f, 0.f, 0.f, 0.f};
#pragma unroll
                for (int ks = 0; ks < 2; ++ks) {
                    d1 = __builtin_amdgcn_mfma_f32_16x16x32_bf16(kf[mt][ks], kf[nt][ks], d1, 0, 0, 0);
                    d2 = __builtin_amdgcn_mfma_f32_16x16x32_bf16(qf[mt][ks], kf[nt][ks], d2, 0, 0, 0);
                }
                const float gcj = GC[j];
#pragma unroll
                for (int r = 0; r < 4; ++r) {
                    const int i = 16 * mt + 4 * q4 + r;
                    const float dec = __builtin_amdgcn_exp2f(1.44269504f * (GC[i] - gcj));
                    AT[i * 64 + j] = (i > j) ? BT[i] * d1[r] * dec : 0.f;
                    QKg[i * 64 + (((pj >> 3) ^ (i & 7)) << 3) + (pj & 7)] = f2bf((i >= j) ? d2[r] * dec : 0.f);
                }
            } else {
#pragma unroll
                for (int r = 0; r < 4; ++r) { const int i = 16 * mt + 4 * q4 + r; QKg[i * 64 + (((pj >> 3) ^ (i & 7)) << 3) + (pj & 7)] = 0; }
            }
        }
    {
        bf16_t* Qgg = a.gQg() + (size_t)u * 4096;
#pragma unroll
        for (int mt = 0; mt < 4; ++mt) {
            const int i = 16 * mt + i16; const float e = EG[i];
#pragma unroll
            for (int ks = 0; ks < 2; ++ks) {
                float x[8]; bf8_to_f32(qf[mt][ks], x);
                uint2 w0, w1; w0.x = cvtpk(x[0] * e, x[1] * e); w0.y = cvtpk(x[2] * e, x[3] * e); w1.x = cvtpk(x[4] * e, x[5] * e); w1.y = cvtpk(x[6] * e, x[7] * e);
                const int p0 = 32 * ks + 16 * (q4 & 1) + 4 * (q4 >> 1);
                *(uint2*)(Qgg + i * 64 + (((p0 >> 3) ^ (i & 7)) << 3) + (p0 & 7)) = w0; *(uint2*)(Qgg + i * 64 + ((((p0 >> 3) + 1) ^ (i & 7)) << 3) + (p0 & 7)) = w1;
            }
        }
    }
    WSYNC();
    __builtin_amdgcn_sched_barrier(0);
    {
        float U[64];
#pragma unroll
        for (int i = 0; i < 64; ++i) { U[i] = bf2f(vbase[i * 1536 + lane]) * BT[i]; }
#pragma unroll
        for (int i = 1; i < 64; ++i) {
            float su = 0.f;
#pragma unroll
            for (int j4 = 0; j4 < i; j4 += 4) {
                const float4 av = *(const float4*)(AT + i * 64 + j4);
                su += av.x * U[j4];
                if (j4 + 1 < i) su += av.y * U[j4 + 1];
                if (j4 + 2 < i) su += av.z * U[j4 + 2];
                if (j4 + 3 < i) su += av.w * U[j4 + 3];
            }
            U[i] -= su;
            __builtin_amdgcn_sched_barrier(0);
        }
        float* UTg = a.gUT() + ((size_t)u * 64 + lane) * 64;
#pragma unroll
        for (int i = 0; i < 64; i += 4) *(float4*)(UTg + 4 * ((i >> 2) ^ (lane & 15))) = (float4){U[i], U[i + 1], U[i + 2], U[i + 3]};
    }
    asm volatile("" ::: "memory");
    __builtin_amdgcn_sched_barrier(0);
    {
        float W[64];
#pragma unroll
        for (int i = 0; i < 64; ++i) { W[i] = bf2f(kbase[i * 1536 + lane]); }
        bf16_t* Kdg = a.gKd() + ((size_t)u * 64 + lane) * 64;
#pragma unroll
        for (int pc = 0; pc < 8; ++pc) {
            float t[8];
#pragma unroll
            for (int jj = 0; jj < 8; ++jj) { const int j = 32 * (pc >> 2) + 16 * (jj >> 2) + 4 * (pc & 3) + (jj & 3); t[jj] = W[j] * ED[j]; }
            u32x4 w; w.x = cvtpk(t[0], t[1]); w.y = cvtpk(t[2], t[3]); w.z = cvtpk(t[4], t[5]); w.w = cvtpk(t[6], t[7]);
            *(u32x4*)(Kdg + 8 * (pc ^ (lane & 7))) = w;
        }
#pragma unroll
        for (int i = 0; i < 64; ++i) W[i] *= BT[i] * EG[i];
#pragma unroll
        for (int i = 1; i < 64; ++i) {
            float sw = 0.f;
#pragma unroll
            for (int j4 = 0; j4 < i; j4 += 4) {
                const float4 av = *(const float4*)(AT + i * 64 + j4);
                sw += av.x * W[j4];
                if (j4 + 1 < i) sw += av.y * W[j4 + 1];
                if (j4 + 2 < i) sw += av.z * W[j4 + 2];
                if (j4 + 3 < i) sw += av.w * W[j4 + 3];
            }
            W[i] -= sw;
            __builtin_amdgcn_sched_barrier(0);
        }
        bf16_t* Wng = a.gWn() + (size_t)u * 4096; const int pp = pi_pos(lane);
#pragma unroll
        for (int i = 0; i < 64; ++i) Wng[i * 64 + (((pp >> 3) ^ (i & 7)) << 3) + (pp & 7)] = f2bf(-W[i]);
    }
    if (lane == 0) a.ggam()[u] = expf(gl);
}
__device__ __forceinline__ bf16x8 pack_acc2(const f32x4& x, const f32x4& y) {
    u32x4 w; w.x = cvtpk(x[0], x[1]); w.y = cvtpk(x[2], x[3]); w.z = cvtpk(y[0], y[1]); w.w = cvtpk(y[2], y[3]);
    return __builtin_bit_cast(bf16x8, w);
}
#define G2_SLOT 49152
__device__ __forceinline__ void g2_issue(const MK& a, size_t u, int n, LAS unsigned char* lds, int lw, int lane) {
    LAS unsigned char* dst = lds + (n % 3) * G2_SLOT;
    const char* srcs[4] = {(const char*)(a.gWn() + u * 4096), (const char*)(a.gQg() + u * 4096), (const char*)(a.gQK() + u * 4096), (const char*)(a.gKd() + u * 4096)};
#pragma unroll
    for (int m = 0; m < 4; ++m)
#pragma unroll
        for (int i = 0; i < 2; ++i) { const int piece = 2 * lw + i;
            __builtin_amdgcn_global_load_lds((const unsigned*)(srcs[m] + piece * 1024 + lane * 16), (LAS unsigned*)(dst + m * 8192 + piece * 1024), 16, 0, 0); }
    const char* us = (const char*)(a.gUT() + u * 4096);
#pragma unroll
    for (int i = 0; i < 4; ++i) { const int piece = 4 * lw + i;
        __builtin_amdgcn_global_load_lds((const unsigned*)(us + piece * 1024 + lane * 16), (LAS unsigned*)(dst + 32768 + piece * 1024), 16, 0, 0); }
}
__device__ __forceinline__ void gdn_scan_block(const MK& a, int bh, LAS unsigned char* lds) {
    const int tid = otid(), lane = tid & 63, wid = __builtin_amdgcn_readfirstlane(tid >> 6), i16 = lane & 15, q4 = lane >> 4;
    const int b = bh >> 3, h = bh & 7, sl = wid & 3;
    const bool loader = wid >= 4;
    f32x4 S[4];
#pragma unroll
    for (int mt = 0; mt < 4; ++mt) S[mt] = (f32x4){0.f, 0.f, 0.f, 0.f};
    __syncthreads();
    if (loader) { g2_issue(a, (size_t)bh * 32, 0, lds, wid - 4, lane); g2_issue(a, (size_t)bh * 32 + 1, 1, lds, wid - 4, lane); }
    for (int n = 0; n < 32; ++n) {
        if (loader) { if (n < 31) asm volatile("s_waitcnt vmcnt(12)" ::: "memory"); else asm volatile("s_waitcnt vmcnt(0)" ::: "memory"); }
        asm volatile("s_waitcnt lgkmcnt(0)" ::: "memory"); __builtin_amdgcn_s_barrier(); asm volatile("" ::: "memory");
        if (loader) { if (n + 2 < 32) g2_issue(a, (size_t)bh * 32 + n + 2, n + 2, lds, wid - 4, lane); }
        else {
            const LAS unsigned char* sb = lds + (n % 3) * G2_SLOT;
            const float gam = a.ggam()[(size_t)bh * 32 + n];
            bf16x8 Sb[2]; Sb[0] = pack_acc2(S[0], S[1]); Sb[1] = pack_acc2(S[2], S[3]);
            f32x4 Vn[4];
#pragma unroll
            for (int mt = 0; mt < 4; ++mt) Vn[mt] = *(const LAS f32x4*)(sb + 32768 + (16 * sl + i16) * 256 + 16 * ((4 * mt + q4) ^ i16));
#pragma unroll
            for (int mt = 0; mt < 4; ++mt)
#pragma unroll
                for (int ks = 0; ks < 2; ++ks) Vn[mt] = __builtin_amdgcn_mfma_f32_16x16x32_bf16(*(const LAS bf16x8*)(sb + (16 * mt + i16) * 128 + 16 * ((4 * ks + q4) ^ (i16 & 7))), Sb[ks], Vn[mt], 0, 0, 0);
            bf16x8 Vb[2]; Vb[0] = pack_acc2(Vn[0], Vn[1]); Vb[1] = pack_acc2(Vn[2], Vn[3]);
            f32x4 O[4];
#pragma unroll
            for (int mt = 0; mt < 4; ++mt) {
                O[mt] = (f32x4){0.f, 0.f, 0.f, 0.f};
#pragma unroll
                for (int ks = 0; ks < 2; ++ks) {
                    const int fo = (16 * mt + i16) * 128 + 16 * ((4 * ks + q4) ^ (i16 & 7));
                    O[mt] = __builtin_amdgcn_mfma_f32_16x16x32_bf16(*(const LAS bf16x8*)(sb + 8192 + fo), Sb[ks], O[mt], 0, 0, 0);
                    O[mt] = __builtin_amdgcn_mfma_f32_16x16x32_bf16(*(const LAS bf16x8*)(sb + 16384 + fo), Vb[ks], O[mt], 0, 0, 0);
                }
            }
#pragma unroll
            for (int mt = 0; mt < 4; ++mt) {
                S[mt] = S[mt] * gam;
#pragma unroll
                for (int ks = 0; ks < 2; ++ks) S[mt] = __builtin_amdgcn_mfma_f32_16x16x32_bf16(*(const LAS bf16x8*)(sb + 24576 + (16 * mt + i16) * 128 + 16 * ((4 * ks + q4) ^ (i16 & 7))), Vb[ks], S[mt], 0, 0, 0);
            }
            float* og = a.goraw() + ((size_t)b * SEQ + n * 64 + 4 * q4) * 512 + h * 64 + 16 * sl + i16;
#pragma unroll
            for (int mt = 0; mt < 4; ++mt)
#pragma unroll
                for (int r = 0; r < 4; ++r) og[(size_t)(16 * mt + r) * 512] = O[mt][r];
        }
    }
    if (!loader) {
        float* so = a.out + O_GSP + ((size_t)bh * 64 + 4 * q4) * 64 + 16 * sl + i16;
#pragma unroll
        for (int mt = 0; mt < 4; ++mt)
#pragma unroll
            for (int r = 0; r < 4; ++r) so[(size_t)(16 * mt + r) * 64] = S[mt][r];
    }
    __syncthreads();
}
__device__ __forceinline__ void gdn_out_token(const MK& a, int row, int lane) {
    const float* op = a.goraw() + (size_t)row * 512 + 8 * lane;
    const float4 x0 = *(const float4*)op, x1 = *(const float4*)(op + 4);
    float o[8] = {x0.x, x0.y, x0.z, x0.w, x1.x, x1.y, x1.z, x1.w}, zg[8];
    bf8_to_f32(*(const bf16x8*)(a.Z() + (size_t)row * ZW + OFF_Z + 8 * lane), zg);
    float ss = 0.f;
#pragma unroll
    for (int e = 0; e < 8; ++e) ss += o[e] * o[e];
    ss = sum8(ss);
    const float rs = rsqrtf(ss * (1.f / 64.f) + EPSV);
    const float4 g0 = *(const float4*)(a.g_gdn_out + 8 * (lane & 7)), g1 = *(const float4*)(a.g_gdn_out + 8 * (lane & 7) + 4);
    const float gg_[8] = {g0.x, g0.y, g0.z, g0.w, g1.x, g1.y, g1.z, g1.w};
#pragma unroll
    for (int e = 0; e < 8; ++e) o[e] = o[e] * rs * gg_[e] * zg[e] * fast_sigmoid(zg[e]);
    *(bf16x8*)(a.omix() + (size_t)row * 1024 + 8 * lane) = f32_to_bf8(o);
}

#define SSLOT 32768
#define TL_OFF (3 * SSLOT)
#define CST 264
#define KR_OFF (TL_OFF + 2 * 32 * CST * 2)
#define WQ_OFF (KR_OFF + 4 * 4096)
#define QR_OFF (WQ_OFF + 2048)
#define PG_OFF (QR_OFF + 1024)
#define PT_OFF (PG_OFF + 64)
#define AL_OFF (PT_OFF + 1024)
#define SAMP_LDS_END (AL_OFF + 64)
__device__ __forceinline__ void samp_issue(const MK& a, int g, LAS unsigned char* lds, int wid, int lane) {
    const int phys = __builtin_amdgcn_readfirstlane(((const LAS int*)(lds + PG_OFF))[g >> 2]);
    const int tok0 = (g & 3) * 32 + 4 * wid;
    const float* cs = a.cache_ckv + ((size_t)phys * 128 + tok0) * 256 + lane * 4;
#pragma unroll
    for (int i = 0; i < 4; ++i) __builtin_amdgcn_global_load_lds((const unsigned*)(cs + i * 256), (LAS unsigned*)(lds + (g % 3) * SSLOT + (4 * wid + i) * 1024), 16, 0, 0);
    if (wid < 4) { const int tl = lane >> 3, cg = (lane & 7) ^ (((tl >> 1) & 1) | ((wid & 1) << 2));
        __builtin_amdgcn_global_load_lds((const unsigned*)(a.cache_krope + ((size_t)phys * 128 + (g & 3) * 32 + 8 * wid + tl) * 32 + cg * 4), (LAS unsigned*)(lds + KR_OFF + (g & 3) * 4096 + wid * 1024), 16, 0, 0); }
}
__device__ __forceinline__ void samp_convert(int g, LAS unsigned char* lds, int tid) {
    const int st = tid >> 4, c16 = (tid & 15) * 16;
    const LAS float* src = (const LAS float*)(lds + (g % 3) * SSLOT) + st * 256 + c16;
    const f32x4 x0 = *(const LAS f32x4*)src, x1 = *(const LAS f32x4*)(src + 4), x2 = *(const LAS f32x4*)(src + 8), x3 = *(const LAS f32x4*)(src + 12);
    u32x4 w0, w1; w0.x = cvtpk(x0[0], x0[1]); w0.y = cvtpk(x0[2], x0[3]); w0.z = cvtpk(x1[0], x1[1]); w0.w = cvtpk(x1[2], x1[3]);
    w1.x = cvtpk(x2[0], x2[1]); w1.y = cvtpk(x2[2], x2[3]); w1.z = cvtpk(x3[0], x3[1]); w1.w = cvtpk(x3[2], x3[3]);
    LAS bf16_t* dst = (LAS bf16_t*)(lds + TL_OFF + (g & 1) * 32 * CST * 2) + st * CST + c16;
    *(LAS u32x4*)dst = w0; *(LAS u32x4*)(dst + 8) = w1;
}
#define SAMP_WAITV(n5, n4) do { if (h < 4) asm volatile("s_waitcnt vmcnt(" #n5 ")" ::: "memory"); else asm volatile("s_waitcnt vmcnt(" #n4 ")" ::: "memory"); } while (0)
#define SAMP_BAR() do { asm volatile("s_waitcnt lgkmcnt(0)" ::: "memory"); __builtin_amdgcn_s_barrier(); asm volatile("" ::: "memory"); } while (0)
__device__ __forceinline__ void samp_attn_unit(const MK& a, int u, char* smem, LAS unsigned char* lds) {
    const int tid = otid(), lane = tid & 63, h = __builtin_amdgcn_readfirstlane(tid >> 6), i16 = lane & 15, q4 = lane >> 4;
    const int b = u >> 3, sp = u & 7;
    float* WQ = (float*)(smem + WQ_OFF);
    float* QR = (float*)(smem + QR_OFF);
    int* PG = (int*)(smem + PG_OFF);
    const float SCL = 0.14724445f;
    post_q_item(a, (NPT + b) * 8 + h, lane);
    __syncthreads();
    {
        const int h_ = tid >> 6, l_ = tid & 63, q4_ = l_ >> 4, idx = l_ & 15, d = 16 * (idx >> 2) + 4 * q4_ + (idx & 3);
        WQ[tid] = a.g_k_nope[d] * a.qh()[((size_t)(NPT + b) * 8 + h_) * 96 + d] * SCL;
        if (tid < 256) QR[tid] = a.qh()[((size_t)(NPT + b) * 8 + (tid >> 5)) * 96 + 64 + (tid & 31)] * SCL;
        if (tid < 16) PG[tid] = a.page_table[b * NPAGES + sp * 16 + tid];
    }
    bf16x8 wf[4][8];
#pragma unroll
    for (int mt = 0; mt < 4; ++mt)
#pragma unroll
        for (int ks = 0; ks < 8; ++ks) wf[mt][ks] = *(const bf16x8*)(a.WknT() + (size_t)(h * 64 + 16 * mt + i16) * 256 + 32 * ks + 8 * q4);
#pragma unroll
    for (int mt = 0; mt < 4; ++mt)
#pragma unroll
        for (int ks = 0; ks < 8; ++ks) asm volatile("" : "+v"(wf[mt][ks]));
    __syncthreads();
    samp_issue(a, 0, lds, h, lane); samp_issue(a, 1, lds, h, lane); samp_issue(a, 2, lds, h, lane);
    SAMP_WAITV(10, 8);
    SAMP_BAR();
    samp_convert(0, lds, tid);
    const LAS float* QRl = (const LAS float*)(lds + QR_OFF) + h * 32 + 8 * q4;
    const LAS float* WQl = (const LAS float*)(lds + WQ_OFF) + (h * 4 + q4) * 16;
    f32x4 wqr[4], qrr[2];
#pragma unroll
    for (int mt = 0; mt < 4; ++mt) wqr[mt] = *(const LAS f32x4*)(WQl + 4 * mt);
    qrr[0] = *(const LAS f32x4*)QRl; qrr[1] = *(const LAS f32x4*)(QRl + 4);
    float m = -INFINITY, lsum = 0.f;
    f32x4 latv[2]; latv[0] = (f32x4){0.f, 0.f, 0.f, 0.f}; latv[1] = (f32x4){0.f, 0.f, 0.f, 0.f};
    for (int g = 0; g < 64; ++g) {
        SAMP_BAR();
        if (g + 3 < 64) samp_issue(a, g + 3, lds, h, lane);
        const LAS bf16_t* Tl = (const LAS bf16_t*)(lds + TL_OFF + (g & 1) * 32 * CST * 2); const LAS float* KR = (const LAS float*)(lds + KR_OFF + (g & 3) * 4096);
        float scv;
        {
            float ssp[2], dotp[2], rdp[2];
            f32x4 acc[2][4];
#pragma unroll
            for (int hf = 0; hf < 2; ++hf)
#pragma unroll
                for (int mt = 0; mt < 4; ++mt) acc[hf][mt] = (f32x4){0.f, 0.f, 0.f, 0.f};
            const LAS bf16_t* cp0 = Tl + i16 * CST + 8 * q4; const LAS bf16_t* cp1 = cp0 + 16 * CST;
            bf16x8 c0 = *(const LAS bf16x8*)cp0, c1 = *(const LAS bf16x8*)cp1;
#pragma unroll
            for (int ks = 0; ks < 8; ++ks) {
                bf16x8 n0 = c0, n1 = c1;
                if (ks < 7) { n0 = *(const LAS bf16x8*)(cp0 + 32 * (ks + 1)); n1 = *(const LAS bf16x8*)(cp1 + 32 * (ks + 1)); }
#pragma unroll
                for (int mt = 0; mt < 4; ++mt) { acc[0][mt] = __builtin_amdgcn_mfma_f32_16x16x32_bf16(wf[mt][ks], c0, acc[0][mt], 0, 0, 0); acc[1][mt] = __builtin_amdgcn_mfma_f32_16x16x32_bf16(wf[mt][ks], c1, acc[1][mt], 0, 0, 0); }
                c0 = n0; c1 = n1;
            }
#pragma unroll
            for (int hf = 0; hf < 2; ++hf) {
                f32x2_t ss2 = {0.f, 0.f}, dot2 = {0.f, 0.f}, rd2 = {0.f, 0.f};
#pragma unroll
                for (int mt = 0; mt < 4; ++mt) {
                    const f32x4 wq = wqr[mt];
                    const f32x4 av = acc[hf][mt];
                    const f32x2_t lo = __builtin_shufflevector(av, av, 0, 1), hi = __builtin_shufflevector(av, av, 2, 3);
                    ss2 = __builtin_elementwise_fma(lo, lo, ss2); ss2 = __builtin_elementwise_fma(hi, hi, ss2);
                    dot2 = __builtin_elementwise_fma(lo, __builtin_shufflevector(wq, wq, 0, 1), dot2); dot2 = __builtin_elementwise_fma(hi, __builtin_shufflevector(wq, wq, 2, 3), dot2);
                }
                {
                    const int kc = (2 * q4) ^ ((i16 >> 1) & 5);
                    const LAS float* kp = KR + (16 * hf + i16) * 32;
                    const f32x4 k0 = *(const LAS f32x4*)(kp + 4 * kc), k1 = *(const LAS f32x4*)(kp + 4 * (kc ^ 1)), q0 = qrr[0], q1 = qrr[1];
                    rd2 = __builtin_elementwise_fma(__builtin_shufflevector(k0, k0, 0, 1), __builtin_shufflevector(q0, q0, 0, 1), rd2); rd2 = __builtin_elementwise_fma(__builtin_shufflevector(k0, k0, 2, 3), __builtin_shufflevector(q0, q0, 2, 3), rd2);
                    rd2 = __builtin_elementwise_fma(__builtin_shufflevector(k1, k1, 0, 1), __builtin_shufflevector(q1, q1, 0, 1), rd2); rd2 = __builtin_elementwise_fma(__builtin_shufflevector(k1, k1, 2, 3), __builtin_shufflevector(q1, q1, 2, 3), rd2);
                }
                ssp[hf] = ss2[0] + ss2[1]; dotp[hf] = dot2[0] + dot2[1]; rdp[hf] = rd2[0] + rd2[1];
            }
            const auto s1 = __builtin_amdgcn_permlane16_swap(__float_as_uint(ssp[0]), __float_as_uint(ssp[1]), false, false);
            const auto s2 = __builtin_amdgcn_permlane16_swap(__float_as_uint(dotp[0]), __float_as_uint(dotp[1]), false, false);
            const auto s3 = __builtin_amdgcn_permlane16_swap(__float_as_uint(rdp[0]), __float_as_uint(rdp[1]), false, false);
            const float u1 = __uint_as_float(s1[0]) + __uint_as_float(s1[1]), u2 = __uint_as_float(s2[0]) + __uint_as_float(s2[1]), u3 = __uint_as_float(s3[0]) + __uint_as_float(s3[1]);
            const auto t1 = __builtin_amdgcn_permlane32_swap(__float_as_uint(u1), __float_as_uint(u2), false, false);
            const float t = __uint_as_float(t1[0]) + __uint_as_float(t1[1]);
            const auto t2 = __builtin_amdgcn_permlane32_swap(__float_as_uint(t), __float_as_uint(t), false, false);
            const float ssv = __uint_as_float(t2[0]), dotv = __uint_as_float(t2[1]);
            const float rdv = add_x32(u3);
            scv = dotv * rsqrtf(ssv * (1.f / 64.f) + EPSV) + rdv;
        }
        float gm = max16(scv);
        { const auto r = __builtin_amdgcn_permlane16_swap(__float_as_uint(gm), __float_as_uint(gm), false, false); gm = fmaxf(__uint_as_float(r[0]), __uint_as_float(r[1])); }
        const float mn = fmaxf(m, gm);
        const float alpha = __builtin_amdgcn_exp2f(m - mn), pv = __builtin_amdgcn_exp2f(scv - mn);
        m = mn;
        lsum = lsum * alpha + pv;
        if (q4 < 2) { ((LAS float*)(lds + PT_OFF))[h * 32 + lane] = pv; if (lane == 0) ((LAS float*)(lds + AL_OFF))[h] = alpha; }
        if (g <= 60) SAMP_WAITV(10, 8); else if (g == 61) SAMP_WAITV(5, 4); else SAMP_WAITV(0, 0);
        SAMP_BAR();
        {
            u32x4 pw = {0u, 0u, 0u, 0u};
            if (i16 < 8) { const f32x4 pa = *(const LAS f32x4*)(lds + PT_OFF + (i16 * 32 + 8 * q4) * 4), pb_ = *(const LAS f32x4*)(lds + PT_OFF + (i16 * 32 + 8 * q4 + 4) * 4);
                pw.x = cvtpk(pa[0], pa[1]); pw.y = cvtpk(pa[2], pa[3]); pw.z = cvtpk(pb_[0], pb_[1]); pw.w = cvtpk(pb_[2], pb_[3]); }
            const bf16x8 pfr = __builtin_bit_cast(bf16x8, pw);
            const f32x4 al = *(const LAS f32x4*)(lds + AL_OFF + (q4 & 1) * 16);
            const unsigned tb0 = (unsigned)(size_t)((const LAS bf16_t*)(lds + TL_OFF + (g & 1) * 32 * CST * 2) + (8 * q4 + (i16 >> 2)) * CST + 32 * h + 4 * (i16 & 3));
            s16x4 c0[2], c1[2];
            static_assert(4 * CST * 2 == 2112, "tr offsets");
            asm volatile("ds_read_b64_tr_b16 %0, %4\n\tds_read_b64_tr_b16 %1, %4 offset:2112\n\tds_read_b64_tr_b16 %2, %4 offset:32\n\tds_read_b64_tr_b16 %3, %4 offset:2144\n\ts_waitcnt lgkmcnt(0)"
                         : "=&v"(c0[0]), "=&v"(c1[0]), "=&v"(c0[1]), "=&v"(c1[1]) : "v"(tb0) : "memory");
#pragma unroll
            for (int nt = 0; nt < 2; ++nt) {
                const bf16x8 cfr = __builtin_shufflevector(c0[nt], c1[nt], 0, 1, 2, 3, 4, 5, 6, 7);
                latv[nt] = latv[nt] * al;
                latv[nt] = __builtin_amdgcn_mfma_f32_16x16x32_bf16(pfr, cfr, latv[nt], 0, 0, 0);
            }
        }
        if (g + 1 < 64) samp_convert(g + 1, lds, tid);
    }
    lsum = add_x16(sum16(lsum));
    if (lane == 0) { float* o = a.part() + ((size_t)u * 8 + h) * 260; o[0] = m * 0.69314718f; o[1] = lsum; }
    if (q4 < 2) {
#pragma unroll
        for (int nt = 0; nt < 2; ++nt)
#pragma unroll
            for (int r = 0; r < 4; ++r) a.part()[((size_t)u * 8 + 4 * q4 + r) * 260 + 4 + 32 * h + 16 * nt + i16] = latv[nt][r];
    }
}
__device__ __forceinline__ void samp_comb_unit(const MK& a, int u, char* smem) {
    float* slat = (float*)smem;
    const int b = u >> 3, h = u & 7, tid = otid() & 255;
    const size_t row = NPT + b;
    const float* q = a.qh() + (row * 8 + h) * 96;
    float s_self = 0.f;
    for (int d = 0; d < 64; ++d) s_self += q[d] * a.kh()[(row * 8 + h) * 64 + d];
    for (int d = 0; d < 32; ++d) s_self += q[64 + d] * a.krf()[row * 32 + d];
    s_self *= 0.10206207261596577f;
    float m = s_self;
    for (int s = 0; s < 8; ++s) m = fmaxf(m, a.part()[((size_t)(b * 8 + s) * 8 + h) * 260]);
    const float pself = expf(s_self - m);
    float l = pself, lat = 0.f;
    for (int s = 0; s < 8; ++s) {
        const float* p = a.part() + ((size_t)(b * 8 + s) * 8 + h) * 260;
        const float w = expf(p[0] - m);
        l += p[1] * w; lat += p[4 + tid] * w;
    }
    __syncthreads();
    slat[tid] = lat;
    __syncthreads();
    if (tid < 64) {
        float o = 0.f;
        for (int c = 0; c < 256; ++c) o += slat[c] * a.w_kv_b[(size_t)c * 1024 + h * 128 + 64 + tid];
        o += pself * a.KV()[row * 1024 + h * 128 + 64 + tid];
        a.omix()[row * 1024 + 512 + h * 64 + tid] = f2bf(o / l);
    }
}

#define XB_TMO      128
#define XB_XCNT(j)  (256  + 64 * (j))
#define XB_XSUB(j)  (1280 + 64 * (j))
#define XB_XGEN(j)  (2304 + 64 * (j))
#define XB_TOP      3328
#define XB_TOPGEN   3392
#define XCD_BAR_WORDS 3456
#define XB_SPIN_CAP (1u << 18)

__device__ __forceinline__ unsigned xb_ld(unsigned* p)              { return __hip_atomic_load(p, __ATOMIC_RELAXED, __HIP_MEMORY_SCOPE_AGENT); }
__device__ __forceinline__ unsigned xb_add(unsigned* p, unsigned v) { return __hip_atomic_fetch_add(p, v, __ATOMIC_RELAXED, __HIP_MEMORY_SCOPE_AGENT); }
__device__ __forceinline__ unsigned xb_xcc_id() { return (unsigned)__builtin_amdgcn_s_getreg((3 << 11) | 20) & 0xFu; }
#define XB_SPIN(cond, bar) do { unsigned _sp = 0; while (cond) { __builtin_amdgcn_s_sleep(1); \
    if ((++_sp & 255u) == 0u) { if (xb_ld(&(bar)[XB_TMO])) break; if (_sp > XB_SPIN_CAP) { atomicAdd(&(bar)[XB_TMO], 1u); break; } } } } while (0)

struct XcdBarrier {
    unsigned* bar; unsigned x;
    volatile LAS unsigned* st;
};

__device__ __forceinline__ XcdBarrier xcd_barrier_post(unsigned* bar, volatile LAS unsigned* st) {
    XcdBarrier b; b.bar = bar; b.x = xb_xcc_id(); b.st = st;
    if (threadIdx.x == 0) (void)xb_add(&bar[XB_XCNT(b.x)], 1u);
    return b;
}
__device__ __forceinline__ void xcd_barrier_complete(unsigned* bar, unsigned x, unsigned& nloc, unsigned& nx) {
    const unsigned G = gridDim.x * gridDim.y * gridDim.z;
    unsigned sum, cnt, mine, sp = 0u;
    for (;;) {
        sum = 0u; cnt = 0u; mine = 0u;
#pragma unroll
        for (unsigned j = 0; j < 16; ++j) { const unsigned c = xb_ld(&bar[XB_XCNT(j)]); sum += c; cnt += (c > 0u) ? 1u : 0u; mine = (j == x) ? c : mine; }
        if (sum == G) break;
        __builtin_amdgcn_s_sleep(1);
        if ((++sp & 255u) == 0u) { if (xb_ld(&bar[XB_TMO])) break; if (sp > XB_SPIN_CAP) { atomicAdd(&bar[XB_TMO], 1u); break; } }
    }
    nloc = mine > 0u ? mine : 1u; nx = cnt > 0u ? cnt : 1u;
}

__device__ __forceinline__ void xcd_barrier(const XcdBarrier& b) {
    asm volatile("s_waitcnt vmcnt(0)" ::: "memory");
    __syncthreads();
    if (threadIdx.x == 0) {
        unsigned* bar = b.bar;
        __builtin_amdgcn_s_waitcnt(0);
        unsigned nloc = b.st[0], nx = b.st[1];
        if (nloc == 0u) { xcd_barrier_complete(bar, b.x, nloc, nx); b.st[0] = nloc; b.st[1] = nx; }
        const unsigned old = xb_add(&bar[XB_XSUB(b.x)], 1u);
        const unsigned gen = old / nloc;
        if (old + 1u == (gen + 1u) * nloc) {
            __builtin_amdgcn_fence(__ATOMIC_RELEASE, "agent");
            asm volatile("s_waitcnt vmcnt(0)" ::: "memory");
            const unsigned og = xb_add(&bar[XB_TOP], 1u);
            const unsigned tg = og / nx;
            if (og + 1u == (tg + 1u) * nx) xb_add(&bar[XB_TOPGEN], 1u);
            else XB_SPIN(xb_ld(&bar[XB_TOPGEN]) == tg, bar);
            __builtin_amdgcn_fence(__ATOMIC_ACQUIRE, "agent");
            xb_add(&bar[XB_XGEN(b.x)], 1u);
            asm volatile("s_waitcnt vmcnt(0)" ::: "memory");
        } else {
            XB_SPIN(xb_ld(&bar[XB_XGEN(b.x)]) == gen, bar);
            __builtin_amdgcn_fence(__ATOMIC_ACQUIRE, "agent");
            asm volatile("s_waitcnt vmcnt(0)" ::: "memory");
        }
    }
    __syncthreads();
}

__device__ __forceinline__ void late_weight_items(const MK& a, int gwl, int ngwl, float* scr, int lane) {
    const int T4 = 32 * 16, T5 = 176 * 16, T7 = 32 * 44, T8 = 32 * 16, TT = T4 + T5 + T7 + T8;
    for (int it = gwl; it < TT; it += ngwl) {
        int r = it;
        if (r < T4) { const int nt_ = r % 32, kb = r / 32; wt_item(a.w_o, 1024, 32 * nt_, 32, a.WoT(), 1024, 32 * nt_, 64 * kb, scr, lane); continue; } r -= T4;
        if (r < T5) { const int nt_ = r % 176, kb = r / 176, pn = nt_ >> 3, wi = nt_ & 7;
            wt_item(wi < 4 ? a.w_gate : a.w_up, DFF, pn * 128 + (wi & 3) * 32, 32, a.WguT(), 1024, 32 * nt_, 64 * kb, scr, lane); continue; } r -= T5;
        if (r < T7) { const int nt_ = r % 32, kb = r / 32; wt_item(a.w_down, 1024, 32 * nt_, 32, a.WdT(), DFF, 32 * nt_, 64 * kb, scr, lane); continue; } r -= T7;
        { const int nt_ = r % 32, kb = r / 32; wt_item(a.w_ple_gate, 1024, 32 * nt_, 32, a.WpgT(), 1024, 32 * nt_, 64 * kb, scr, lane); }
    }
}

#define XB_ST_OFF 155648
#define LDS_BYTES 155904
static_assert(SAMP_LDS_END <= LDS_BYTES, "LDS map");
#define GSYNC() do { xcd_barrier(xbar); } while (0)
__global__ __launch_bounds__(NTHR, 2) void mega(MK a) {
    cg::grid_group grid = cg::this_grid();
    char* smem = (char*)lds_raw;
    LAS unsigned char* lds = (LAS unsigned char*)lds_raw;
    otid_init();
    if (threadIdx.x < 2) ((LAS unsigned*)(lds_raw + XB_ST_OFF))[threadIdx.x] = 0u;
    __syncthreads();
    const XcdBarrier xbar = xcd_barrier_post(a.ctl(), (volatile LAS unsigned*)(LAS void*)(lds_raw + XB_ST_OFF));
    const int bid = blockIdx.x, nb = gridDim.x, ngw = nb * NWAVE;
#define LOCAL_IDS const int tid = otid(), lane = tid & 63, wid = tid >> 6, half = tid >> 8, gw = bid * NWAVE + wid; (void)lane; (void)half; (void)gw; (void)wid;

    {
    LOCAL_IDS
    {
        const int T0 = 88 * 16, T1 = 24 * 6, T2 = 32 * 4, T3 = 16 * 4, T9 = 32 * 4;
        const int TT = T0 + T1 + T2 + T3 + T9;
        float* scr = (float*)(smem + wid * 8704);
        for (int it = gw; it < TT; it += ngw) {
            int r = it;
            if (r < T0) { const int nt_ = r % 88, kb = r / 88, nv = 2736 - 32 * nt_; wt_item(a.w_in, 2736, 32 * nt_, nv < 0 ? 0 : (nv > 32 ? 32 : nv), a.WinT(), 1024, 32 * nt_, 64 * kb, scr, lane); continue; } r -= T0;
            if (r < T1) { const int nt_ = r % 24, kb = r / 24; wt_item(a.w_q_b, 768, 32 * nt_, 32, a.WqbT(), 384, 32 * nt_, 64 * kb, scr, lane); continue; } r -= T1;
            if (r < T2) { const int nt_ = r % 32, kb = r / 32; wt_item(a.w_kv_b, 1024, 32 * nt_, 32, a.WkvT(), 256, 32 * nt_, 64 * kb, scr, lane); continue; } r -= T2;
            if (r < T3) { const int nt_ = r % 16, kb = r / 16, h = nt_ >> 1; wt_item(a.w_kv_b, 1024, h * 128 + 32 * (nt_ & 1), 32, a.WknT(), 256, 32 * nt_, 64 * kb, scr, lane); continue; } r -= T3;
            { const int nt_ = r % 32, kb = r / 32; wt_item(a.w_ple_proj, 1024, 32 * nt_, 32, a.WppT(), 256, 32 * nt_, 64 * kb, scr, lane); }
        }
        for (int e = (bid * NTHR + tid); e < 2049 * 16; e += nb * NTHR) {
            const int pos = e >> 4, i = e & 15; const float ang = (pos == 2048 ? (float)PAST : (float)pos) * powf(10000.f, -(float)i / 16.f);
            a.ropecs()[pos * 32 + i] = cosf(ang); a.ropecs()[pos * 32 + 16 + i] = sinf(ang);
        }
        for (int row = gw; row < MPAD; row += ngw) {
            const float* src = row < NPT ? a.x_prompt + (size_t)row * 1024 : a.x_sample + (size_t)(row < NTOK ? row - NPT : 0) * 1024;
            rms1024_row(src, a.g_attn, a.xn() + (size_t)row * 1024, row >= NTOK, lane);
            ushort4 w = {0, 0, 0, 0};
            if (row < NTOK) { const float* ps = row < NPT ? a.p_prompt + (size_t)row * 256 : a.p_sample + (size_t)(row - NPT) * 256; const float4 v = *(const float4*)(ps + lane * 4); w.x = f2bf(v.x); w.y = f2bf(v.y); w.z = f2bf(v.z); w.w = f2bf(v.w); }
            *(ushort4*)(a.pb() + (size_t)row * 256 + lane * 4) = w;
            if (row >= NTOK) { for (int j = 0; j < 4; ++j) { ushort4 z = {0, 0, 0, 0}; *(ushort4*)(a.omix() + (size_t)row * 1024 + lane * 4 + 256 * j) = z; } }
        }
    }
    }
    if (a.out == nullptr) grid.sync();
    GSYNC();
    {
    LOCAL_IDS
    pg_gemm(lds, a.xn(), a.WinT(), NPT, ZW, 1024, PgBf16{a.Z(), ZW});
    gemm_sample_rows_ks<false>(a.xn(), 1024, a.WinT(), 1024, ZW, EwBf16{a.Z(), ZW}, smem, bid, nb);
    }
    GSYNC();
    {
    LOCAL_IDS
    for (int e = tid; e < 4 * 1536 / 4; e += NTHR) ((float4*)smem)[e] = ((const float4*)a.w_conv)[e];
    __syncthreads();
    for (int run = gw; run < NPT / 8 + NST; run += ngw) post_in_run(a, run, lane, (const float*)smem);
    }
    GSYNC();
    {
    LOCAL_IDS
    for (int u = gw; u < 2048; u += ngw) gdn_prep_unit(a, u, lane, smem + wid * GDN_WLDS);
    }
    {
    LOCAL_IDS
    for (int v = gw; v < NST * 64; v += ngw) gdn_unit(a, v >> 6, (v >> 3) & 7, v & 7, a.state_gdn, a.out + O_GSS, NPT, 1, lane, smem + wid * GDN_WLDS);
    __syncthreads();
    }
    GSYNC();
    {
    LOCAL_IDS
    pg_gemm(lds, a.qan(), a.WqbT(), NPT, 768, 384, PgBf16{a.qraw(), 768});
    pg_gemm(lds, a.ckvb(), a.WkvT(), NPT, 1024, 256, PgBf16{a.kvraw(), 1024}, nb > 64 ? nb - 64 : 0);
    gemm_sample_rows<false>(a.qan(), 384, a.WqbT(), 384, 768, EwF32{a.Q(), 768}, smem, bid, nb, 64);
    gemm_sample_rows<false>(a.ckvb(), 256, a.WkvT(), 256, 1024, EwF32{a.KV(), 1024}, smem, bid, nb, 72);
    for (int bh_ = nb - 1 - bid; bh_ < 64; bh_ += nb) gdn_scan_block(a, bh_, lds);
    if (nb > 64 && bid < nb - 64) {
        pg_gemm(lds, a.pb(), a.WppT(), NPT, 1024, 256, PgBf16{a.PP(), 1024}, nb - 64);
        __syncthreads();
        late_weight_items(a, bid * NWAVE + wid, (nb - 64) * NWAVE, (float*)(smem + wid * 8704), lane);
    } else if (nb <= 64) { pg_gemm(lds, a.pb(), a.WppT(), NPT, 1024, 256, PgBf16{a.PP(), 1024}); __syncthreads(); late_weight_items(a, gw, ngw, (float*)(smem + wid * 8704), lane); }
    gemm_sample_rows<false>(a.pb(), 256, a.WppT(), 256, 1024, EwBf16{a.PP(), 1024}, smem, bid, nb, 80);
    }
    GSYNC();
    {
    LOCAL_IDS
    for (int idx = gw; idx < NST * 8; idx += ngw) { post_q_item(a, NPT * 8 + idx, lane); post_kv_item(a, NPT * 8 + idx, lane); }
    for (int row = gw; row < NTOK; row += ngw) gdn_out_token(a, row, lane);
    for (int pr = bid; pr < 256; pr += nb) { const int bh_ = pr >> 2, s_ = pr & 3; attn_block(a, bh_ >> 3, bh_ & 7, 7 - s_, smem); attn_block(a, bh_ >> 3, bh_ & 7, s_, smem); }
    for (int u = bid; u < NST * 8; u += nb) samp_attn_unit(a, u, smem, lds);
    }
    GSYNC();
    {
    LOCAL_IDS
    for (int u0 = bid * 2; u0 < NST * 8; u0 += nb * 2) samp_comb_unit(a, u0 + half, smem + half * 4096);
    }
    GSYNC();
    {
    LOCAL_IDS
    pg_gemm(lds, a.omix(), a.WoT(), NPT, 1024, 1024, PgResXB{a.x_prompt, a.H()});
    gemm_sample_rows_ks<false>(a.omix(), 1024, a.WoT(), 1024, 1024, EwResX{a.x_sample, a.H()}, smem, bid, nb);
    }
    GSYNC();
    {
    LOCAL_IDS
    for (int row = gw; row < MPAD; row += ngw) rms1024_row_b(a.H() + (size_t)row * 1024, a.g_ffn, a.un() + (size_t)row * 1024, row >= NTOK, lane);
    }
    GSYNC();
    {
    LOCAL_IDS
    pg_gemm(lds, a.un(), a.WguT(), NPT, 2 * DFF, 1024, PgSwiglu{a.hid()});
    gemm_sample_rows_ks<true>(a.un(), 1024, a.WguT(), 1024, 2 * DFF, EwBf16{a.hid(), DFF}, smem, bid, nb);
    }
    GSYNC();
    {
    LOCAL_IDS
    pg_gemm(lds, a.hid(), a.WdT(), NPT, 1024, DFF, PgResBB{a.H(), a.H2()});
    gemm_sample_rows_ks<false>(a.hid(), DFF, a.WdT(), DFF, 1024, EwResH{a.H(), a.H2()}, smem, bid, nb);
    }
    GSYNC();
    {
    LOCAL_IDS
    for (int row = gw; row < MPAD; row += ngw) rms1024_row_b(a.H2() + (size_t)row * 1024, a.g_ple, a.un2() + (size_t)row * 1024, row >= NTOK, lane);
    }
    GSYNC();
    {
    LOCAL_IDS
    pg_gemm(lds, a.un2(), a.WpgT(), NPT, 1024, 1024, PgPleB{a.H2(), a.PP(), a.out});
    gemm_sample_rows_ks<false>(a.un2(), 1024, a.WpgT(), 1024, 1024, EwPle{a.H2(), a.PP(), a.out}, smem, bid, nb);
    }
}

static inline char* carve(char*& p, size_t bytes) { char* r = p; p += (bytes + 255) & ~(size_t)255; return r; }

extern "C" void kernel_launch(void* const* d_in, const int* in_sizes, int n_in, void* d_out, int out_size, void* d_ws, size_t ws_size, hipStream_t stream) {
    MK a{};
    a.x_prompt = (const float*)d_in[0]; a.x_sample = (const float*)d_in[1]; a.cache_ckv = (const float*)d_in[2]; a.cache_krope = (const float*)d_in[3];
    a.state_gdn = (const float*)d_in[4]; a.state_conv = (const float*)d_in[5]; a.page_table = (const int*)d_in[6]; a.p_prompt = (const float*)d_in[7]; a.p_sample = (const float*)d_in[8];
    a.g_attn = (const float*)d_in[9]; a.w_in = (const float*)d_in[10]; a.w_conv = (const float*)d_in[11]; a.a_log = (const float*)d_in[12]; a.dt_bias = (const float*)d_in[13];
    a.g_gdn_out = (const float*)d_in[14]; a.g_q_a = (const float*)d_in[15]; a.w_q_b = (const float*)d_in[16]; a.g_q_nope = (const float*)d_in[17]; a.g_q_rope = (const float*)d_in[18];
    a.g_kv_a = (const float*)d_in[19]; a.g_k_rope = (const float*)d_in[20]; a.w_kv_b = (const float*)d_in[21]; a.g_k_nope = (const float*)d_in[22]; a.w_o = (const float*)d_in[23];
    a.g_ffn = (const float*)d_in[24]; a.w_gate = (const float*)d_in[25]; a.w_up = (const float*)d_in[26]; a.w_down = (const float*)d_in[27]; a.g_ple = (const float*)d_in[28];
    a.w_ple_gate = (const float*)d_in[29]; a.w_ple_proj = (const float*)d_in[30];
    a.out = (float*)d_out;
    a.ws = (char*)d_ws;
    if (WS_TOTAL > ws_size) { fprintf(stderr, "kernel_launch: workspace too small: need %zu have %zu\n", (size_t)WS_TOTAL, ws_size); return; }

    static int grid_blocks = 0;
    if (!grid_blocks) {
        int dev = 0, cus = 0, per_cu = 0;
        (void)hipGetDevice(&dev);
        (void)hipDeviceGetAttribute(&cus, hipDeviceAttributeMultiprocessorCount, dev);
        (void)hipFuncSetAttribute((const void*)mega, hipFuncAttributeMaxDynamicSharedMemorySize, LDS_BYTES);
        (void)hipOccupancyMaxActiveBlocksPerMultiprocessor(&per_cu, (const void*)mega, NTHR, LDS_BYTES);
        if (per_cu < 1) fprintf(stderr, "kernel_launch: occupancy query says %d blocks/CU\n", per_cu);
        grid_blocks = cus;
    }
    (void)hipMemsetAsync((char*)d_ws + WOF_ctl, 0, 16384, stream);
    void* args[] = {&a};
    hipError_t e = hipLaunchCooperativeKernel((const void*)mega, dim3(grid_blocks), dim3(NTHR), args, LDS_BYTES, stream);
    if (e != hipSuccess) fprintf(stderr, "cooperative launch failed: %s (grid %d)\n", hipGetErrorString(e), grid_blocks);
}
```

```cpp
#include <hip/hip_runtime.h>
#include <stdint.h>
#include <cstdio>
#include <hip/hip_cooperative_groups.h>
namespace cg = cooperative_groups;


__device__ __forceinline__ int otid();
#define PG8_TID() otid()
namespace pg8 {
#define PG8_LAS __attribute__((address_space(3)))
typedef unsigned short bf16_t;
typedef short bf16x8 __attribute__((ext_vector_type(8)));
typedef float f32x4 __attribute__((ext_vector_type(4)));
typedef unsigned u32x4 __attribute__((ext_vector_type(4)));
constexpr int BM = 256, BK = 64, HALF = 128, HTB = HALF * BK * 2  , STAGE_BYTES = 8 * HTB, NXCD = 8, WGM = 8;

__host__ __device__ __forceinline__ int lds_byte(int r, int c) { const int st = (r >> 4) * 2 + (c >> 5), rr = r & 15, cc = c & 31, ob = rr * 64 + cc * 2; return st * 1024 + (ob ^ (((ob >> 9) & 1) << 5)); }
__host__ __device__ __forceinline__ void stage_rc(int b, int& R, int& C) { const int st = b / 1024, sb = b % 1024, swz = sb ^ (((sb >> 9) & 1) << 5); R = (st >> 1) * 16 + swz / 64; C = (st & 1) * 32 + (swz % 64) / 2; }
__host__ __device__ __forceinline__ int perm32(int rho) { const int n = rho >> 4, i = rho & 15; return 8 * (i >> 2) + 4 * n + (i & 3); }

struct Unit { int pm, pn; };
struct Gemm { const bf16_t* A; const bf16_t* Bt; int M, N, K; };

struct StaticOrder {
    int nM, nN, nwg, G, c;
    __host__ __device__ void init(int M, int N, int G_, int c_) { nM = M / BM; nN = N / BM; nwg = nM * nN; G = G_; c = c_; }
    __host__ __device__ bool next(int i, Unit& u) const {
        const long L = (long)i * G + c; if (L >= nwg) return false;
        int wgid = (int)L; { const int q = nwg / NXCD, r = nwg % NXCD, xcd = wgid % NXCD, off = wgid / NXCD; wgid = (xcd < r ? xcd * (q + 1) : r * (q + 1) + (xcd - r) * q) + off; }
        const int nig = WGM * nN, gid = wgid / nig, fm = gid * WGM, gsz = (nM - fm) < WGM ? (nM - fm) : WGM;
        u.pm = fm + ((wgid % nig) % gsz); u.pn = (wgid % nig) / gsz; return true;
    }
    __device__ __forceinline__ void a_ready(const Unit&) const {}
    __device__ __forceinline__ void done(const Unit&) const {}
};

template <class Epi, class Sched, bool ALIGN_EPI = false, bool SP2 = false>
__device__ __forceinline__ void gemm_phase(PG8_LAS unsigned char* lds, const Gemm g, const Sched& S, const Epi& E) {
    const int tid = PG8_TID(), wid = __builtin_amdgcn_readfirstlane(tid >> 6), lane = tid & 63, wr = wid >> 2, wc = wid & 3, fr = lane & 15, fq = lane >> 4;
    const int K = g.K, nt = K / BK;
    unsigned voffA[2], voffB[2];
#pragma unroll
    for (int i = 0; i < 2; ++i) { int R, C; stage_rc(tid * 16 + i * 8192, R, C); const int Rb = Epi::PERM ? ((R & ~31) + perm32(R & 31)) : R;
        voffA[i] = (unsigned)(R * K + C) * 2u; voffB[i] = (unsigned)(Rb * K + C) * 2u; }
    const size_t kstep = (size_t)(BK * 2);
    const size_t hstep = (size_t)HALF * K * 2;
    const size_t tstep = 2 * hstep;
    const unsigned ldsw = (unsigned)wid * 1024u;
    const int aoff = lds_byte(wr * 64 + fr, fq * 8), boff = lds_byte(wc * 32 + fr, fq * 8);
#define PG8_SA(b, h) (((b) * 2 + (h)) * HTB)
#define PG8_SB(b, h) ((4 + (b) * 2 + (h)) * HTB)
#define PG8_STAGE(bufoff, gbase, voff) do { _Pragma("unroll") for (int _i = 0; _i < 2; ++_i) \
        __builtin_amdgcn_global_load_lds((const unsigned*)((const char*)(gbase) + (voff)[_i]), (PG8_LAS unsigned*)(lds + (bufoff) + ldsw + _i * 8192), 16, 0, 0); } while (0)
#define PG8_LDA(dst, b, h) do { _Pragma("unroll") for (int m = 0; m < 4; ++m) _Pragma("unroll") for (int k = 0; k < 2; ++k) dst[m][k] = *(const PG8_LAS bf16x8*)(lds + PG8_SA(b, h) + aoff + m * 2048 + k * 1024); } while (0)
#define PG8_LDB(dst, b, h) do { _Pragma("unroll") for (int n = 0; n < 2; ++n) _Pragma("unroll") for (int k = 0; k < 2; ++k) dst[n][k] = *(const PG8_LAS bf16x8*)(lds + PG8_SB(b, h) + boff + n * 2048 + k * 1024); } while (0)
#define PG8_MMA(ai, bj, At, Bt) do { __builtin_amdgcn_s_setprio(1); _Pragma("unroll") for (int m = 0; m < 4; ++m) _Pragma("unroll") for (int n = 0; n < 2; ++n) _Pragma("unroll") for (int k = 0; k < 2; ++k) \
        acc[ai][bj][m][n] = __builtin_amdgcn_mfma_f32_16x16x32_bf16(Bt[n][k], At[m][k], acc[ai][bj][m][n], 0, 0, 0); __builtin_amdgcn_s_setprio(0); } while (0)
#define PG8_WAIT_V(n) asm volatile("s_waitcnt vmcnt(" #n ")" ::: "memory")
#define PG8_WAIT_L(n) asm volatile("s_waitcnt lgkmcnt(" #n ")" ::: "memory")
#define PG8_BAR __builtin_amdgcn_s_barrier()
#define PG8_SCHED __builtin_amdgcn_sched_barrier(0)
    Unit cur, nxt; int ui = 0;
    if (!S.next(0, cur)) return;
    f32x4 acc[2][2][4][2];
#pragma unroll
    for (int a = 0; a < 2; ++a)
#pragma unroll
        for (int b = 0; b < 2; ++b)
#pragma unroll
            for (int m = 0; m < 4; ++m)
#pragma unroll
                for (int n = 0; n < 2; ++n) acc[a][b][m][n] = (f32x4){0.f, 0.f, 0.f, 0.f};
    bf16x8 At[4][2], B0[2][2], B1[2][2];
    const char* cA = (const char*)g.A + (size_t)cur.pm * tstep; const char* cB = (const char*)g.Bt + (size_t)cur.pn * tstep;
    S.a_ready(cur);
    if constexpr (SP2) {
        PG8_STAGE(PG8_SB(0, 0), cB, voffB); PG8_STAGE(PG8_SB(0, 1), cB + hstep, voffB); PG8_STAGE(PG8_SA(0, 0), cA, voffA); PG8_STAGE(PG8_SA(0, 1), cA + hstep, voffA);
        if (wr == 1) PG8_BAR;
        PG8_WAIT_V(2); PG8_BAR;
        PG8_STAGE(PG8_SB(1, 0), cB + kstep, voffB); PG8_STAGE(PG8_SA(1, 0), cA + kstep, voffA); PG8_STAGE(PG8_SB(1, 1), cB + hstep + kstep, voffB);
        PG8_WAIT_V(6); PG8_BAR;
    } else {
        PG8_STAGE(PG8_SB(0, 0), cB, voffB); PG8_STAGE(PG8_SA(0, 0), cA, voffA); PG8_STAGE(PG8_SB(0, 1), cB + hstep, voffB); PG8_STAGE(PG8_SA(0, 1), cA + hstep, voffA);
        if (wr == 1) PG8_BAR;
        PG8_WAIT_V(4); PG8_BAR;
        PG8_STAGE(PG8_SB(1, 0), cB + kstep, voffB); PG8_STAGE(PG8_SA(1, 0), cA + kstep, voffA); PG8_STAGE(PG8_SB(1, 1), cB + hstep + kstep, voffB);
        PG8_WAIT_V(6); PG8_BAR;
    }
    for (;;) {
        const bool has_next = S.next(ui + 1, nxt);
        const char* nA = has_next ? (const char*)g.A + (size_t)nxt.pm * tstep : cA; const char* nB = has_next ? (const char*)g.Bt + (size_t)nxt.pn * tstep : cB;
        for (int t = 0; t < nt; t += 2) {
            const bool last = (t == nt - 2);
            const char* a1 = cA + (size_t)(t + 1) * kstep;
            const char* a2 = last ? nA : cA + (size_t)(t + 2) * kstep; const char* b2 = last ? nB : cB + (size_t)(t + 2) * kstep;
            const char* a3 = a2 + kstep; const char* b3 = b2 + kstep;
            if (last && has_next) S.a_ready(nxt);
            if constexpr (SP2) {
            PG8_LDB(B0, 0, 0); PG8_LDB(B1, 0, 1); PG8_SCHED; PG8_LDA(At, 0, 0); PG8_STAGE(PG8_SA(1, 1), a1 + hstep, voffA);
            PG8_WAIT_V(8); PG8_WAIT_L(0); PG8_BAR; PG8_MMA(0, 0, At, B0); PG8_MMA(0, 1, At, B1); PG8_BAR; PG8_SCHED;
            PG8_LDA(At, 0, 1); PG8_STAGE(PG8_SB(0, 0), b2, voffB); PG8_STAGE(PG8_SB(0, 1), b2 + hstep, voffB); PG8_STAGE(PG8_SA(0, 0), a2, voffA);
            PG8_WAIT_V(8); PG8_WAIT_L(0); PG8_BAR; PG8_MMA(1, 0, At, B0); PG8_MMA(1, 1, At, B1); PG8_BAR; PG8_SCHED;
            PG8_LDB(B0, 1, 0); PG8_LDB(B1, 1, 1); PG8_SCHED; PG8_LDA(At, 1, 0); PG8_STAGE(PG8_SA(0, 1), a2 + hstep, voffA);
            PG8_WAIT_V(8); PG8_WAIT_L(0); PG8_BAR; PG8_MMA(0, 0, At, B0); PG8_MMA(0, 1, At, B1); PG8_BAR; PG8_SCHED;
            PG8_LDA(At, 1, 1); PG8_STAGE(PG8_SB(1, 0), b3, voffB); PG8_STAGE(PG8_SB(1, 1), b3 + hstep, voffB); PG8_STAGE(PG8_SA(1, 0), a3, voffA);
            PG8_WAIT_V(8); PG8_WAIT_L(0); PG8_BAR; PG8_MMA(1, 0, At, B0); PG8_MMA(1, 1, At, B1); PG8_BAR; PG8_SCHED;
            } else {
            PG8_LDB(B0, 0, 0); PG8_SCHED; PG8_LDA(At, 0, 0); PG8_STAGE(PG8_SA(1, 1), a1 + hstep, voffA);
            PG8_WAIT_L(8); PG8_BAR; PG8_WAIT_L(0); PG8_MMA(0, 0, At, B0); PG8_BAR; PG8_SCHED;
            PG8_LDB(B1, 0, 1); PG8_STAGE(PG8_SB(0, 0), b2, voffB);
            PG8_BAR; PG8_WAIT_L(0); PG8_MMA(0, 1, At, B1); PG8_BAR;
            PG8_LDA(At, 0, 1); PG8_STAGE(PG8_SA(0, 0), a2, voffA);
            PG8_BAR; PG8_WAIT_L(0); PG8_MMA(1, 0, At, B0); PG8_BAR; PG8_SCHED;
            PG8_STAGE(PG8_SB(0, 1), b2 + hstep, voffB);
            PG8_WAIT_V(6); PG8_BAR; PG8_MMA(1, 1, At, B1); PG8_BAR;
            PG8_LDB(B0, 1, 0); PG8_SCHED; PG8_LDA(At, 1, 0); PG8_STAGE(PG8_SA(0, 1), a2 + hstep, voffA);
            PG8_WAIT_L(8); PG8_BAR; PG8_WAIT_L(0); PG8_MMA(0, 0, At, B0); PG8_BAR; PG8_SCHED;
            PG8_LDB(B1, 1, 1); PG8_STAGE(PG8_SB(1, 0), b3, voffB);
            PG8_BAR; PG8_WAIT_L(0); PG8_MMA(0, 1, At, B1); PG8_BAR;
            PG8_LDA(At, 1, 1); PG8_STAGE(PG8_SA(1, 0), a3, voffA);
            PG8_BAR; PG8_WAIT_L(0); PG8_MMA(1, 0, At, B0); PG8_BAR; PG8_SCHED;
            PG8_STAGE(PG8_SB(1, 1), b3 + hstep, voffB);
            PG8_WAIT_V(6); PG8_BAR; PG8_MMA(1, 1, At, B1); PG8_BAR;
            }
        }
        if constexpr (ALIGN_EPI) { if (wr == 0) PG8_BAR; }
        if constexpr (!Epi::AFTER_DRAIN) { E(acc, cur, wr, wc, fr, fq); S.done(cur); }
        if (!has_next) break;
#pragma unroll
        for (int a = 0; a < 2; ++a)
#pragma unroll
            for (int b = 0; b < 2; ++b)
#pragma unroll
                for (int m = 0; m < 4; ++m)
#pragma unroll
                    for (int n = 0; n < 2; ++n) acc[a][b][m][n] = (f32x4){0.f, 0.f, 0.f, 0.f};
        cur = nxt; cA = nA; cB = nB; ++ui;
        if constexpr (ALIGN_EPI) { if (wr == 1) PG8_BAR; }
    }
    PG8_WAIT_V(0);
    if constexpr (!ALIGN_EPI) { if (wr == 0) PG8_BAR; }
    PG8_BAR;
    if constexpr (Epi::AFTER_DRAIN) { E.fused(acc, cur, wr, wc, fr, fq, lds, wid, lane); S.done(cur); }
#undef PG8_SA
#undef PG8_SB
#undef PG8_STAGE
#undef PG8_LDA
#undef PG8_LDB
#undef PG8_MMA
#undef PG8_WAIT_V
#undef PG8_WAIT_L
#undef PG8_BAR
#undef PG8_SCHED
}
}

#define WTAB_OFF 155392
extern __shared__ __attribute__((aligned(16))) unsigned char lds_raw[];
__device__ __forceinline__ int hw_slot() { return (int)(__builtin_amdgcn_s_getreg((5 << 11) | 4) & 63u); }
__device__ __forceinline__ void otid_init() { const int t = threadIdx.x; if ((t & 63) == 0) ((__attribute__((address_space(3))) int*)(__attribute__((address_space(3))) void*)(lds_raw + WTAB_OFF))[hw_slot()] = t >> 6; }
__device__ __forceinline__ int otid() {
    const int w = __builtin_amdgcn_readfirstlane(((const __attribute__((address_space(3))) int*)(__attribute__((address_space(3))) void*)(lds_raw + WTAB_OFF))[hw_slot()]);
    int l; asm volatile("v_mbcnt_lo_u32_b32 %0, -1, 0\n\tv_mbcnt_hi_u32_b32 %0, -1, %0" : "=v"(l));
    return (w << 6) + l;
}
using pg8::bf16_t; using pg8::bf16x8; using pg8::f32x4; using pg8::u32x4;
#define LAS __attribute__((address_space(3)))

#define DMODEL 1024
#define NPT 16384
#define NST 32
#define NTOK 16416
#define MPAD 16640
#define SEQ 2048
#define ZW 2816
#define OFF_A 1536
#define OFF_B 1544
#define OFF_Z 1552
#define OFF_QA 2064
#define OFF_KVA 2448
#define OFF_KR 2704
#define DFF 2816
#define PAST 16384
#define NPAGES 128
#define EPSV 1e-6f

#define O_YP 0
#define O_YS (O_YP + 16777216)
#define O_CKVP (O_YS + 32768)
#define O_KRP (O_CKVP + 4194304)
#define O_GSP (O_KRP + 524288)
#define O_CSP (O_GSP + 262144)
#define O_CKVS (O_CSP + 36864)
#define O_KRS (O_CKVS + 8192)
#define O_GSS (O_KRS + 1024)
#define O_CSS (O_GSS + 1048576)

__device__ __forceinline__ bf16_t f2bf(float f) { unsigned u = __float_as_uint(f); return (bf16_t)((u + 0x7fffu + ((u >> 16) & 1u)) >> 16); }
__device__ __forceinline__ float bf2f(bf16_t b) { return __uint_as_float(((unsigned)b) << 16); }
template <int CTRL> __device__ __forceinline__ float dpp_mov(float x) { return __uint_as_float((unsigned)__builtin_amdgcn_update_dpp((int)__float_as_uint(x), (int)__float_as_uint(x), CTRL, 0xF, 0xF, true)); }
__device__ __forceinline__ float add_x16(float x) { auto r = __builtin_amdgcn_permlane16_swap(__float_as_uint(x), __float_as_uint(x), false, false); return __uint_as_float(r[0]) + __uint_as_float(r[1]); }
__device__ __forceinline__ float add_x32(float x) { auto r = __builtin_amdgcn_permlane32_swap(__float_as_uint(x), __float_as_uint(x), false, false); return __uint_as_float(r[0]) + __uint_as_float(r[1]); }
__device__ __forceinline__ float max_x32(float x) { auto r = __builtin_amdgcn_permlane32_swap(__float_as_uint(x), __float_as_uint(x), false, false); return fmaxf(__uint_as_float(r[0]), __uint_as_float(r[1])); }
__device__ __forceinline__ float sum8(float x) { x += dpp_mov<0xB1>(x); x += dpp_mov<0x4E>(x); x += dpp_mov<0x141>(x); return x; }
__device__ __forceinline__ float sum16(float x) { x = sum8(x); x += dpp_mov<0x140>(x); return x; }
__device__ __forceinline__ float max16(float x) { x = fmaxf(x, dpp_mov<0xB1>(x)); x = fmaxf(x, dpp_mov<0x4E>(x)); x = fmaxf(x, dpp_mov<0x141>(x)); x = fmaxf(x, dpp_mov<0x140>(x)); return x; }
__device__ __forceinline__ float wave_sum(float v) { return add_x32(add_x16(sum16(v))); }
__device__ __forceinline__ float sigmoidf_(float x) { return __builtin_amdgcn_rcpf(1.f + __builtin_amdgcn_exp2f(-1.44269504f * x)); }
__device__ __forceinline__ float siluf_(float x) { return x * __builtin_amdgcn_rcpf(1.f + __builtin_amdgcn_exp2f(-1.44269504f * x)); }


#define WSYNC() do { __builtin_amdgcn_fence(__ATOMIC_ACQ_REL, "wavefront"); __builtin_amdgcn_wave_barrier(); } while (0)
#define NTHR 512
#define NWAVE 8

typedef float f32x2_t __attribute__((ext_vector_type(2)));
typedef __bf16 bf16x2_t __attribute__((ext_vector_type(2)));
__device__ __forceinline__ unsigned cvtpk(float lo, float hi) { f32x2_t v = {lo, hi}; bf16x2_t r = __builtin_convertvector(v, bf16x2_t); return __builtin_bit_cast(unsigned, r); }
__device__ __forceinline__ void bf8_to_f32(const bf16x8& v, float* o) {
#pragma unroll
    for (int e = 0; e < 8; ++e) o[e] = __uint_as_float(((unsigned)(unsigned short)v[e]) << 16);
}
__device__ __forceinline__ bf16x8 f32_to_bf8(const float* x) {
    u32x4 w; w.x = cvtpk(x[0], x[1]); w.y = cvtpk(x[2], x[3]); w.z = cvtpk(x[4], x[5]); w.w = cvtpk(x[6], x[7]);
    return __builtin_bit_cast(bf16x8, w);
}
__device__ __forceinline__ unsigned pk2bf(float lo, float hi) { return (unsigned)f2bf(lo) | ((unsigned)f2bf(hi) << 16); }

__device__ __forceinline__ void wt_item(const float* __restrict__ W, int ldw, int col0, int nvalid, bf16_t* __restrict__ WT, int ldt, int nrow0, int k0, float* scr, int lane) {
    WSYNC();
#pragma unroll 8
    for (int i = 0; i < 32; ++i) { const int kk = 2 * i + (lane >> 5), n = lane & 31; scr[kk * 33 + n] = n < nvalid ? W[(size_t)(k0 + kk) * ldw + col0 + n] : 0.f; }
    WSYNC();
    const int c = lane & 7;
#pragma unroll
    for (int j = 0; j < 4; ++j) { const int n = (lane >> 3) + 8 * j; const float* sp = scr + (8 * c) * 33 + n;
        u32x4 o; o.x = cvtpk(sp[0], sp[33]); o.y = cvtpk(sp[2 * 33], sp[3 * 33]); o.z = cvtpk(sp[4 * 33], sp[5 * 33]); o.w = cvtpk(sp[6 * 33], sp[7 * 33]);
        *(u32x4*)(WT + (size_t)(nrow0 + n) * ldt + k0 + 8 * c) = o; }
}

__device__ __forceinline__ void rms1024_row(const float* __restrict__ src, const float* __restrict__ g, bf16_t* __restrict__ o, bool zero, int lane) {
    if (zero) { for (int j = 0; j < 4; ++j) { ushort4 z = {0, 0, 0, 0}; *(ushort4*)(o + lane * 4 + 256 * j) = z; } return; }
    float4 v[4]; float ss = 0.f;
#pragma unroll
    for (int j = 0; j < 4; ++j) { v[j] = *(const float4*)(src + lane * 4 + 256 * j); ss += v[j].x * v[j].x + v[j].y * v[j].y + v[j].z * v[j].z + v[j].w * v[j].w; }
    ss = wave_sum(ss);
    const float rs = rsqrtf(ss * (1.f / 1024.f) + EPSV);
#pragma unroll
    for (int j = 0; j < 4; ++j) {
        const float4 gg = *(const float4*)(g + lane * 4 + 256 * j);
        ushort4 w; w.x = f2bf(v[j].x * rs * gg.x); w.y = f2bf(v[j].y * rs * gg.y); w.z = f2bf(v[j].z * rs * gg.z); w.w = f2bf(v[j].w * rs * gg.w);
        *(ushort4*)(o + lane * 4 + 256 * j) = w;
    }
}

__device__ __forceinline__ void rms1024_row_b(const bf16_t* __restrict__ src, const float* __restrict__ g, bf16_t* __restrict__ o, bool zero, int lane) {
    if (zero) { for (int j = 0; j < 2; ++j) { const u32x4 z = {0u, 0u, 0u, 0u}; *(u32x4*)(o + lane * 8 + 512 * j) = z; } return; }
    float v[2][8]; float ss = 0.f;
#pragma unroll
    for (int j = 0; j < 2; ++j) { bf8_to_f32(*(const bf16x8*)(src + lane * 8 + 512 * j), v[j]);
#pragma unroll
        for (int e = 0; e < 8; ++e) ss += v[j][e] * v[j][e]; }
    ss = wave_sum(ss);
    const float rs = rsqrtf(ss * (1.f / 1024.f) + EPSV);
#pragma unroll
    for (int j = 0; j < 2; ++j) {
        const float4 g0 = *(const float4*)(g + lane * 8 + 512 * j), g1 = *(const float4*)(g + lane * 8 + 512 * j + 4);
        float t[8] = {v[j][0] * rs * g0.x, v[j][1] * rs * g0.y, v[j][2] * rs * g0.z, v[j][3] * rs * g0.w, v[j][4] * rs * g1.x, v[j][5] * rs * g1.y, v[j][6] * rs * g1.z, v[j][7] * rs * g1.w};
        *(bf16x8*)(o + lane * 8 + 512 * j) = f32_to_bf8(t);
    }
}

struct ABf16 { const bf16_t* p; int lda; __device__ __forceinline__ bf16x8 load(int m, int k) const { return *(const bf16x8*)(p + (size_t)m * lda + k); } };
template <bool SWIGLU, class Epi>
__device__ __forceinline__ void gemm_sample_rows(const bf16_t* __restrict__ A, int lda, const bf16_t* __restrict__ Bt, int K, int N, const Epi& epi, char*  , int bid, int nb, int first = -1) {
    const int tid = otid(), lane = tid & 63, wid = tid >> 6, i16 = lane & 15, q4 = lane >> 4;
    for (int u = first >= 0 ? (bid - first + nb) % nb : nb - 1 - bid; u < N / 256; u += nb) {
        const int n0 = u * 256;
        const int c0 = SWIGLU ? n0 + 16 * wid : n0 + 32 * wid, c1 = SWIGLU ? n0 + 128 + 16 * wid : n0 + 32 * wid + 16;
        const bf16_t* a0p = A + (size_t)(NPT + i16) * lda + 8 * q4; const bf16_t* a1p = a0p + (size_t)16 * lda;
        const bf16_t* b0p = Bt + (size_t)(c0 + i16) * K + 8 * q4; const bf16_t* b1p = Bt + (size_t)(c1 + i16) * K + 8 * q4;
        f32x4 acc[2][2];
#pragma unroll
        for (int i = 0; i < 2; ++i)
#pragma unroll
            for (int j = 0; j < 2; ++j) acc[i][j] = (f32x4){0.f, 0.f, 0.f, 0.f};
#pragma unroll 4
        for (int k0 = 0; k0 < K; k0 += 32) {
            const bf16x8 a0 = *(const bf16x8*)(a0p + k0), a1 = *(const bf16x8*)(a1p + k0), b0 = *(const bf16x8*)(b0p + k0), b1 = *(const bf16x8*)(b1p + k0);
            acc[0][0] = __builtin_amdgcn_mfma_f32_16x16x32_bf16(a0, b0, acc[0][0], 0, 0, 0); acc[0][1] = __builtin_amdgcn_mfma_f32_16x16x32_bf16(a0, b1, acc[0][1], 0, 0, 0);
            acc[1][0] = __builtin_amdgcn_mfma_f32_16x16x32_bf16(a1, b0, acc[1][0], 0, 0, 0); acc[1][1] = __builtin_amdgcn_mfma_f32_16x16x32_bf16(a1, b1, acc[1][1], 0, 0, 0);
        }
#pragma unroll
        for (int i = 0; i < 2; ++i)
#pragma unroll
            for (int r = 0; r < 4; ++r) {
                const int m = NPT + 16 * i + 4 * q4 + r;
                if constexpr (SWIGLU) epi(m, (n0 >> 1) + 16 * wid + i16, siluf_(acc[i][0][r]) * acc[i][1][r]);
                else { epi(m, c0 + i16, acc[i][0][r]); epi(m, c1 + i16, acc[i][1][r]); }
            }
    }
}
template <bool SWIGLU, class Epi>
__device__ __forceinline__ void gemm_sample_rows_ks(const bf16_t* __restrict__ A, int lda, const bf16_t* __restrict__ Bt, int K, int N, const Epi& epi, char* smem, int bid, int nb) {
    const int tid = otid(), lane = tid & 63, wid = tid >> 6, i16 = lane & 15, q4 = lane >> 4;
    const int nunits = N / 64, ksl = K >> 3;
    f32x4* red = (f32x4*)smem;
    for (int u = nb - 1 - bid; u < nunits; u += nb) {
        int brow[4];
#pragma unroll
        for (int j = 0; j < 4; ++j) brow[j] = SWIGLU ? ((32 * u) >> 7) * 256 + ((32 * u) & 127) + 128 * (j >> 1) + 16 * (j & 1) + i16 : 64 * u + 16 * j + i16;
        const bf16_t* a0p = A + (size_t)(NPT + i16) * lda + wid * ksl + 8 * q4; const bf16_t* a1p = a0p + (size_t)16 * lda;
        f32x4 acc[2][4];
#pragma unroll
        for (int i = 0; i < 2; ++i)
#pragma unroll
            for (int j = 0; j < 4; ++j) acc[i][j] = (f32x4){0.f, 0.f, 0.f, 0.f};
        for (int k0 = 0; k0 < ksl; k0 += 32) {
            const bf16x8 a0 = *(const bf16x8*)(a0p + k0), a1 = *(const bf16x8*)(a1p + k0);
            bf16x8 b[4];
#pragma unroll
            for (int j = 0; j < 4; ++j) b[j] = *(const bf16x8*)(Bt + (size_t)brow[j] * K + wid * ksl + 8 * q4 + k0);
#pragma unroll
            for (int j = 0; j < 4; ++j) { acc[0][j] = __builtin_amdgcn_mfma_f32_16x16x32_bf16(a0, b[j], acc[0][j], 0, 0, 0); acc[1][j] = __builtin_amdgcn_mfma_f32_16x16x32_bf16(a1, b[j], acc[1][j], 0, 0, 0); }
        }
        __syncthreads();
#pragma unroll
        for (int i = 0; i < 2; ++i)
#pragma unroll
            for (int j = 0; j < 4; ++j) red[(wid * 8 + i * 4 + j) * 64 + lane] = acc[i][j];
        __syncthreads();
        if constexpr (SWIGLU) {
            if (tid < 256) {
                const int t4 = tid >> 6, i = t4 >> 1, jg = t4 & 1, l = tid & 63;
                f32x4 g = red[(i * 4 + jg) * 64 + l], up = red[(i * 4 + jg + 2) * 64 + l];
#pragma unroll
                for (int w = 1; w < 8; ++w) { g = g + red[(w * 8 + i * 4 + jg) * 64 + l]; up = up + red[(w * 8 + i * 4 + jg + 2) * 64 + l]; }
#pragma unroll
                for (int r = 0; r < 4; ++r) epi(NPT + 16 * i + 4 * (l >> 4) + r, 32 * u + 16 * jg + (l & 15), siluf_(g[r]) * up[r]);
            }
        } else {
            const int t8 = tid >> 6, l = tid & 63, i = t8 >> 2, j = t8 & 3;
            f32x4 v = red[t8 * 64 + l];
#pragma unroll
            for (int w = 1; w < 8; ++w) v = v + red[(w * 8 + t8) * 64 + l];
#pragma unroll
            for (int r = 0; r < 4; ++r) epi(NPT + 16 * i + 4 * (l >> 4) + r, 64 * u + 16 * j + (l & 15), v[r]);
        }
    }
    __syncthreads();
}
struct EwF32 { float* C; int ldc; __device__ __forceinline__ void operator()(int m, int n, float v) const { C[(size_t)m * ldc + n] = v; } };
struct EwBf16 { bf16_t* C; int ldc; __device__ __forceinline__ void operator()(int m, int n, float v) const { C[(size_t)m * ldc + n] = f2bf(v); } };
struct EwResX { const float* xs; bf16_t* C; __device__ __forceinline__ void operator()(int m, int n, float v) const { C[(size_t)m * 1024 + n] = f2bf(xs[(size_t)(m - NPT) * 1024 + n] + v); } };
struct EwResH { const bf16_t* H; bf16_t* C; __device__ __forceinline__ void operator()(int m, int n, float v) const { C[(size_t)m * 1024 + n] = f2bf(bf2f(H[(size_t)m * 1024 + n]) + v); } };
struct EwPle { const bf16_t* H2; const bf16_t* PP; float* out;
    __device__ __forceinline__ void operator()(int m, int n, float v) const { out[O_YS + (size_t)(m - NPT) * 1024 + n] = bf2f(H2[(size_t)m * 1024 + n]) + bf2f(PP[(size_t)m * 1024 + n]) * sigmoidf_(v); } };

struct PgBf16 {
    static constexpr bool PERM = true, AFTER_DRAIN = false; bf16_t* O; int ldc;
    __device__ __forceinline__ void operator()(const f32x4 (&acc)[2][2][4][2], const pg8::Unit& u, int wr, int wc, int fr, int fq) const {
#pragma unroll
        for (int ai = 0; ai < 2; ++ai)
#pragma unroll
            for (int m = 0; m < 4; ++m) { bf16_t* rowp = O + (size_t)(u.pm * 256 + ai * 128 + wr * 64 + m * 16 + fr) * ldc + u.pn * 256 + wc * 32 + 8 * fq;
#pragma unroll
                for (int bj = 0; bj < 2; ++bj) { const f32x4 v0 = acc[ai][bj][m][0], v1 = acc[ai][bj][m][1]; u32x4 w; w.x = pk2bf(v0[0], v0[1]); w.y = pk2bf(v0[2], v0[3]); w.z = pk2bf(v1[0], v1[1]); w.w = pk2bf(v1[2], v1[3]); *(u32x4*)(rowp + bj * 128) = w; } }
    }
};
struct PgF32 {
    static constexpr bool PERM = false, AFTER_DRAIN = false; float* O; int ldc;
    __device__ __forceinline__ void operator()(const f32x4 (&acc)[2][2][4][2], const pg8::Unit& u, int wr, int wc, int fr, int fq) const {
#pragma unroll
        for (int ai = 0; ai < 2; ++ai)
#pragma unroll
            for (int m = 0; m < 4; ++m) { float* rowp = O + (size_t)(u.pm * 256 + ai * 128 + wr * 64 + m * 16 + fr) * ldc + u.pn * 256 + wc * 32 + 4 * fq;
#pragma unroll
                for (int bj = 0; bj < 2; ++bj)
#pragma unroll
                    for (int n = 0; n < 2; ++n) *(f32x4*)(rowp + bj * 128 + n * 16) = acc[ai][bj][m][n]; }
    }
};
struct PgSwiglu {
    static constexpr bool PERM = true, AFTER_DRAIN = false; bf16_t* Hd;
    __device__ __forceinline__ void operator()(const f32x4 (&acc)[2][2][4][2], const pg8::Unit& u, int wr, int wc, int fr, int fq) const {
#pragma unroll
        for (int ai = 0; ai < 2; ++ai)
#pragma unroll
            for (int m = 0; m < 4; ++m) { bf16_t* rowp = Hd + (size_t)(u.pm * 256 + ai * 128 + wr * 64 + m * 16 + fr) * DFF + u.pn * 128 + wc * 32 + 8 * fq;
                float h[8];
#pragma unroll
                for (int n = 0; n < 2; ++n)
#pragma unroll
                    for (int i = 0; i < 4; ++i) h[n * 4 + i] = siluf_(acc[ai][0][m][n][i]) * acc[ai][1][m][n][i];
                u32x4 w; w.x = pk2bf(h[0], h[1]); w.y = pk2bf(h[2], h[3]); w.z = pk2bf(h[4], h[5]); w.w = pk2bf(h[6], h[7]); *(u32x4*)rowp = w; }
    }
};
struct PgResXB {
    static constexpr bool PERM = true, AFTER_DRAIN = false; const float* R; bf16_t* O;
    __device__ __forceinline__ void operator()(const f32x4 (&acc)[2][2][4][2], const pg8::Unit& u, int wr, int wc, int fr, int fq) const {
#pragma unroll
        for (int ai = 0; ai < 2; ++ai)
#pragma unroll
            for (int m = 0; m < 4; ++m) { const size_t off = (size_t)(u.pm * 256 + ai * 128 + wr * 64 + m * 16 + fr) * 1024 + u.pn * 256 + wc * 32 + 8 * fq;
#pragma unroll
                for (int bj = 0; bj < 2; ++bj) { const f32x4 r0 = *(const f32x4*)(R + off + bj * 128), r1 = *(const f32x4*)(R + off + bj * 128 + 4), v0 = r0 + acc[ai][bj][m][0], v1 = r1 + acc[ai][bj][m][1];
                    u32x4 w; w.x = cvtpk(v0[0], v0[1]); w.y = cvtpk(v0[2], v0[3]); w.z = cvtpk(v1[0], v1[1]); w.w = cvtpk(v1[2], v1[3]); *(u32x4*)(O + off + bj * 128) = w; } }
    }
};
struct PgResBB {
    static constexpr bool PERM = true, AFTER_DRAIN = false; const bf16_t* R; bf16_t* O;
    __device__ __forceinline__ void operator()(const f32x4 (&acc)[2][2][4][2], const pg8::Unit& u, int wr, int wc, int fr, int fq) const {
#pragma unroll
        for (int ai = 0; ai < 2; ++ai)
#pragma unroll
            for (int m = 0; m < 4; ++m) { const size_t off = (size_t)(u.pm * 256 + ai * 128 + wr * 64 + m * 16 + fr) * 1024 + u.pn * 256 + wc * 32 + 8 * fq;
#pragma unroll
                for (int bj = 0; bj < 2; ++bj) { float r[8]; bf8_to_f32(*(const bf16x8*)(R + off + bj * 128), r); const f32x4 a0 = acc[ai][bj][m][0], a1 = acc[ai][bj][m][1];
                    u32x4 w; w.x = cvtpk(r[0] + a0[0], r[1] + a0[1]); w.y = cvtpk(r[2] + a0[2], r[3] + a0[3]); w.z = cvtpk(r[4] + a1[0], r[5] + a1[1]); w.w = cvtpk(r[6] + a1[2], r[7] + a1[3]); *(u32x4*)(O + off + bj * 128) = w; } }
    }
};
struct PgPleB {
    static constexpr bool PERM = true, AFTER_DRAIN = false; const bf16_t* H2; const bf16_t* PP; float* out;
    __device__ __forceinline__ void operator()(const f32x4 (&acc)[2][2][4][2], const pg8::Unit& u, int wr, int wc, int fr, int fq) const {
#pragma unroll
        for (int ai = 0; ai < 2; ++ai)
#pragma unroll
            for (int m = 0; m < 4; ++m) { const size_t off = (size_t)(u.pm * 256 + ai * 128 + wr * 64 + m * 16 + fr) * 1024 + u.pn * 256 + wc * 32 + 8 * fq;
#pragma unroll
                for (int bj = 0; bj < 2; ++bj) { float h[8], pp[8]; bf8_to_f32(*(const bf16x8*)(H2 + off + bj * 128), h); bf8_to_f32(*(const bf16x8*)(PP + off + bj * 128), pp);
                    const f32x4 a0 = acc[ai][bj][m][0], a1 = acc[ai][bj][m][1]; f32x4 y0, y1;
#pragma unroll
                    for (int i = 0; i < 4; ++i) { y0[i] = h[i] + pp[i] * sigmoidf_(a0[i]); y1[i] = h[4 + i] + pp[4 + i] * sigmoidf_(a1[i]); }
                    *(f32x4*)(out + O_YP + off + bj * 128) = y0; *(f32x4*)(out + O_YP + off + bj * 128 + 4) = y1; } }
    }
};
template <class Epi>
__device__ __forceinline__ void pg_gemm(LAS unsigned char* lds, const bf16_t* A, const bf16_t* Bt, int M, int N, int K, const Epi& E, int glow = 0) {
    pg8::Gemm g{A, Bt, M, N, K}; pg8::StaticOrder S;
    if (glow > 0) { if ((int)blockIdx.x >= glow) return; S.init(M, N, glow, (int)blockIdx.x); }
    else S.init(M, N, (int)gridDim.x, (int)blockIdx.x);
    pg8::gemm_phase<Epi, pg8::StaticOrder, true, true>(lds, g, S, E);
}

constexpr size_t WOF_WinT = 0ull;
constexpr size_t WOF_WqbT = 5767168ull;
constexpr size_t WOF_WkvT = 6356992ull;
constexpr size_t WOF_WknT = 6881280ull;
constexpr size_t WOF_WoT = 7143424ull;
constexpr size_t WOF_WguT = 9240576ull;
constexpr size_t WOF_WdT = 20774912ull;
constexpr size_t WOF_WpgT = 26542080ull;
constexpr size_t WOF_WppT = 28639232ull;
constexpr size_t WOF_xn = 29163520ull;
constexpr size_t WOF_pb = 63242240ull;
constexpr size_t WOF_Z = 71761920ull;
constexpr size_t WOF_qkv = 165478400ull;
constexpr size_t WOF_ropecs = 216596480ull;
constexpr size_t WOF_gg = 216858880ull;
constexpr size_t WOF_bb = 217391360ull;
constexpr size_t WOF_goraw = 217923840ull;
constexpr size_t WOF_gUT = 252002560ull;
constexpr size_t WOF_ggam = 285556992ull;
constexpr size_t WOF_gWn = 285565184ull;
constexpr size_t WOF_gQg = 302342400ull;
constexpr size_t WOF_gQK = 319119616ull;
constexpr size_t WOF_gKd = 335896832ull;
constexpr size_t WOF_qan = 352674048ull;
constexpr size_t WOF_ckvb = 365453568ull;
constexpr size_t WOF_krf = 373973248ull;
constexpr size_t WOF_Q = 376103168ull;
constexpr size_t WOF_qh = 427221248ull;
constexpr size_t WOF_KV = 478339328ull;
constexpr size_t WOF_kh = 546496768ull;
constexpr size_t WOF_omix = 580575488ull;
constexpr size_t WOF_KN = 614654208ull;
constexpr size_t WOF_SC = 1151525120ull;
constexpr size_t WOF_part = 1168302336ull;
constexpr size_t WOF_H = 1170432256ull;
constexpr size_t WOF_un = 1238589696ull;
constexpr size_t WOF_G = 1272668416ull;
constexpr size_t WOF_hid = 1273028864ull;
constexpr size_t WOF_H2 = 1366745344ull;
constexpr size_t WOF_un2 = 1434902784ull;
constexpr size_t WOF_PP = 1468981504ull;
constexpr size_t WOF_qraw = 1537138944ull;
constexpr size_t WOF_kvraw = 1562304768ull;
constexpr size_t WOF_krb = 1595859200ull;
constexpr size_t WOF_ctl = 1596907776ull;
constexpr size_t WS_TOTAL = 1596924160ull;
struct MK {
    const float *x_prompt, *x_sample, *cache_ckv, *cache_krope, *state_gdn, *state_conv; const int* page_table; const float *p_prompt, *p_sample;
    const float *g_attn, *w_in, *w_conv, *a_log, *dt_bias, *g_gdn_out, *g_q_a, *w_q_b, *g_q_nope, *g_q_rope, *g_kv_a, *g_k_rope, *w_kv_b, *g_k_nope, *w_o, *g_ffn, *w_gate, *w_up, *w_down, *g_ple, *w_ple_gate, *w_ple_proj;
    float* out; char* ws;
    __device__ __forceinline__ unsigned* ctl() const { return (unsigned*)(ws + WOF_ctl); }
    __device__ __forceinline__ bf16_t* WinT() const { return (bf16_t*)(ws + WOF_WinT); }
    __device__ __forceinline__ bf16_t* WqbT() const { return (bf16_t*)(ws + WOF_WqbT); }
    __device__ __forceinline__ bf16_t* WkvT() const { return (bf16_t*)(ws + WOF_WkvT); }
    __device__ __forceinline__ bf16_t* WknT() const { return (bf16_t*)(ws + WOF_WknT); }
    __device__ __forceinline__ bf16_t* WoT() const { return (bf16_t*)(ws + WOF_WoT); }
    __device__ __forceinline__ bf16_t* WguT() const { return (bf16_t*)(ws + WOF_WguT); }
    __device__ __forceinline__ bf16_t* WdT() const { return (bf16_t*)(ws + WOF_WdT); }
    __device__ __forceinline__ bf16_t* WpgT() const { return (bf16_t*)(ws + WOF_WpgT); }
    __device__ __forceinline__ bf16_t* WppT() const { return (bf16_t*)(ws + WOF_WppT); }
    __device__ __forceinline__ bf16_t* xn() const { return (bf16_t*)(ws + WOF_xn); }
    __device__ __forceinline__ bf16_t* pb() const { return (bf16_t*)(ws + WOF_pb); }
    __device__ __forceinline__ bf16_t* Z() const { return (bf16_t*)(ws + WOF_Z); }
    __device__ __forceinline__ bf16_t* qkv() const { return (bf16_t*)(ws + WOF_qkv); }
    __device__ __forceinline__ float* ropecs() const { return (float*)(ws + WOF_ropecs); }
    __device__ __forceinline__ float* gg() const { return (float*)(ws + WOF_gg); }
    __device__ __forceinline__ float* bb() const { return (float*)(ws + WOF_bb); }
    __device__ __forceinline__ float* goraw() const { return (float*)(ws + WOF_goraw); }
    __device__ __forceinline__ float* gUT() const { return (float*)(ws + WOF_gUT); }
    __device__ __forceinline__ float* ggam() const { return (float*)(ws + WOF_ggam); }
    __device__ __forceinline__ bf16_t* gWn() const { return (bf16_t*)(ws + WOF_gWn); }
    __device__ __forceinline__ bf16_t* gQg() const { return (bf16_t*)(ws + WOF_gQg); }
    __device__ __forceinline__ bf16_t* gQK() const { return (bf16_t*)(ws + WOF_gQK); }
    __device__ __forceinline__ bf16_t* gKd() const { return (bf16_t*)(ws + WOF_gKd); }
    __device__ __forceinline__ bf16_t* qan() const { return (bf16_t*)(ws + WOF_qan); }
    __device__ __forceinline__ bf16_t* ckvb() const { return (bf16_t*)(ws + WOF_ckvb); }
    __device__ __forceinline__ float* krf() const { return (float*)(ws + WOF_krf); }
    __device__ __forceinline__ float* Q() const { return (float*)(ws + WOF_Q); }
    __device__ __forceinline__ float* qh() const { return (float*)(ws + WOF_qh); }
    __device__ __forceinline__ float* KV() const { return (float*)(ws + WOF_KV); }
    __device__ __forceinline__ float* kh() const { return (float*)(ws + WOF_kh); }
    __device__ __forceinline__ bf16_t* omix() const { return (bf16_t*)(ws + WOF_omix); }
    __device__ __forceinline__ bf16_t* KN() const { return (bf16_t*)(ws + WOF_KN); }
    __device__ __forceinline__ float* SC() const { return (float*)(ws + WOF_SC); }
    __device__ __forceinline__ float* part() const { return (float*)(ws + WOF_part); }
    __device__ __forceinline__ bf16_t* H() const { return (bf16_t*)(ws + WOF_H); }
    __device__ __forceinline__ bf16_t* un() const { return (bf16_t*)(ws + WOF_un); }
    __device__ __forceinline__ float* G() const { return (float*)(ws + WOF_G); }
    __device__ __forceinline__ bf16_t* hid() const { return (bf16_t*)(ws + WOF_hid); }
    __device__ __forceinline__ bf16_t* H2() const { return (bf16_t*)(ws + WOF_H2); }
    __device__ __forceinline__ bf16_t* un2() const { return (bf16_t*)(ws + WOF_un2); }
    __device__ __forceinline__ bf16_t* PP() const { return (bf16_t*)(ws + WOF_PP); }
    __device__ __forceinline__ bf16_t* qraw() const { return (bf16_t*)(ws + WOF_qraw); }
    __device__ __forceinline__ bf16_t* kvraw() const { return (bf16_t*)(ws + WOF_kvraw); }
    __device__ __forceinline__ bf16_t* krb() const { return (bf16_t*)(ws + WOF_krb); }
};

__device__ __forceinline__ float fast_sigmoid(float x) { return __builtin_amdgcn_rcpf(1.f + __builtin_amdgcn_exp2f(-1.44269504f * x)); }
struct PinTok { bf16x8 qa, cv, kr; float ab; };
struct PinGain { float gqa[8], gkv[8], gkr[8], dtb, alog; };
__device__ __forceinline__ PinTok pin_load(const MK& a, int row, int lane) {
    const bf16_t* z = a.Z() + (size_t)row * ZW; PinTok t; const bf16x8 zz = {0, 0, 0, 0, 0, 0, 0, 0};
    t.qa = lane < 48 ? *(const bf16x8*)(z + OFF_QA + 8 * lane) : zz; t.cv = lane < 32 ? *(const bf16x8*)(z + OFF_KVA + 8 * lane) : zz;
    t.kr = (lane >= 32 && lane < 36) ? *(const bf16x8*)(z + OFF_KR + 8 * (lane - 32)) : zz; t.ab = lane < 16 ? bf2f(z[OFF_A + lane]) : 0.f; return t;
}
__device__ __forceinline__ void post_in_token(const MK& a, int row, int lane, const float* wcs, const bf16x8 (&w0)[3], const bf16x8 (&w1)[3], const bf16x8 (&w2)[3], const bf16x8 (&wcur)[3], const PinTok& tk, const PinGain& gn) {
    const bool samp = row >= NPT;
    const int b = samp ? row - NPT : row >> 11, t = samp ? 0 : row & 2047, hd = lane >> 3;
    float y[24];
#pragma unroll
    for (int c3 = 0; c3 < 3; ++c3) {
        float p0[8], p1[8], p2[8], cu[8];
        bf8_to_f32(w0[c3], p0); bf8_to_f32(w1[c3], p1); bf8_to_f32(w2[c3], p2); bf8_to_f32(wcur[c3], cu);
        const float* wp = wcs + 512 * c3 + 8 * lane;
        const float4 a0 = *(const float4*)wp, a1 = *(const float4*)(wp + 4), b0 = *(const float4*)(wp + 1536), b1 = *(const float4*)(wp + 1540);
        const float4 c0 = *(const float4*)(wp + 3072), c1 = *(const float4*)(wp + 3076), d0 = *(const float4*)(wp + 4608), d1 = *(const float4*)(wp + 4612);
        const float k0[8] = {a0.x, a0.y, a0.z, a0.w, a1.x, a1.y, a1.z, a1.w}, k1[8] = {b0.x, b0.y, b0.z, b0.w, b1.x, b1.y, b1.z, b1.w};
        const float k2[8] = {c0.x, c0.y, c0.z, c0.w, c1.x, c1.y, c1.z, c1.w}, k3[8] = {d0.x, d0.y, d0.z, d0.w, d1.x, d1.y, d1.z, d1.w};
#pragma unroll
        for (int e = 0; e < 8; ++e) { const int c = 8 * c3 + e; const float v = k0[e] * p0[e] + k1[e] * p1[e] + k2[e] * p2[e] + k3[e] * cu[e]; y[c] = v * fast_sigmoid(v); }
        __builtin_amdgcn_sched_barrier(0);
    }
    float sq = 0.f, sk = 0.f;
#pragma unroll
    for (int e = 0; e < 8; ++e) { sq += y[e] * y[e]; sk += y[8 + e] * y[8 + e]; }
    sq = sum8(sq); sk = sum8(sk);
    const float rq = rsqrtf(sq + EPSV) * 0.125f, rk = rsqrtf(sk + EPSV);
#pragma unroll
    for (int e = 0; e < 8; ++e) { y[e] *= rq; y[8 + e] *= rk; }
    bf16_t* qo = a.qkv() + (size_t)row * 1536 + 8 * lane;
    *(bf16x8*)qo = f32_to_bf8(y); *(bf16x8*)(qo + 512) = f32_to_bf8(y + 8); *(bf16x8*)(qo + 1024) = f32_to_bf8(y + 16);
    if (!samp && t >= SEQ - 3) {
        float* cso = a.out + O_CSP + ((size_t)b * 3 + (t - (SEQ - 3))) * 1536 + 8 * lane;
#pragma unroll
        for (int j = 0; j < 3; ++j) { float cu[8]; bf8_to_f32(wcur[j], cu); *(float4*)(cso + 512 * j) = (float4){cu[0], cu[1], cu[2], cu[3]}; *(float4*)(cso + 512 * j + 4) = (float4){cu[4], cu[5], cu[6], cu[7]}; }
    }
    if (lane < 16) {
        const float v = tk.ab;
        if (lane < 8) { const float xx = v + gn.dtb; const float sp = xx > 20.f ? xx : 0.69314718f * __builtin_amdgcn_logf(1.f + __builtin_amdgcn_exp2f(1.44269504f * xx)); a.gg()[(size_t)row * 8 + lane] = -gn.alog * sp; }
        else a.bb()[(size_t)row * 8 + lane - 8] = sigmoidf_(v);
    }
    __builtin_amdgcn_sched_barrier(0);
    float qa[8], cv[8], kr[8];
    bf8_to_f32(tk.qa, qa); bf8_to_f32(tk.cv, cv); bf8_to_f32(tk.kr, kr);
    float s1 = 0.f, s2 = 0.f, s3 = 0.f;
#pragma unroll
    for (int e = 0; e < 8; ++e) { s1 += qa[e] * qa[e]; s2 += cv[e] * cv[e]; s3 += kr[e] * kr[e]; }
    s1 = wave_sum(s1); s2 = wave_sum(s2); s3 = wave_sum(s3);
    const float r1 = rsqrtf(s1 * (1.f / 384.f) + EPSV), r2 = rsqrtf(s2 * (1.f / 256.f) + EPSV), r3 = rsqrtf(s3 * (1.f / 32.f) + EPSV);
    if (lane < 48) {
        float o[8];
#pragma unroll
        for (int e = 0; e < 8; ++e) o[e] = qa[e] * r1 * gn.gqa[e];
        *(bf16x8*)(a.qan() + (size_t)row * 384 + 8 * lane) = f32_to_bf8(o);
    }
    if (lane < 32) {
        float o[8];
#pragma unroll
        for (int e = 0; e < 8; ++e) o[e] = cv[e] * r2 * gn.gkv[e];
        *(bf16x8*)(a.ckvb() + (size_t)row * 256 + 8 * lane) = f32_to_bf8(o);
        float* co = samp ? a.out + O_CKVS + (size_t)b * 256 + 8 * lane : a.out + O_CKVP + (size_t)row * 256 + 8 * lane;
        *(float4*)co = (float4){o[0], o[1], o[2], o[3]}; *(float4*)(co + 4) = (float4){o[4], o[5], o[6], o[7]};
    }
    __builtin_amdgcn_sched_barrier(0);
    {
        const int c4 = (lane - 32) & 3;
        float xn[8], ot[8];
#pragma unroll
        for (int e = 0; e < 8; ++e) xn[e] = kr[e] * r3 * gn.gkr[e];
#pragma unroll
        for (int e = 0; e < 8; ++e) ot[e] = dpp_mov<0x4E>(xn[e]);
        if (lane >= 32 && lane < 36) {
            const float* tb = a.ropecs() + (size_t)(samp ? 2048 : t) * 32 + ((8 * c4) & 15);
            const float4 c0 = *(const float4*)tb, c1 = *(const float4*)(tb + 4), s0 = *(const float4*)(tb + 16), s1 = *(const float4*)(tb + 20);
            const float csv[8] = {c0.x, c0.y, c0.z, c0.w, c1.x, c1.y, c1.z, c1.w}, snv[8] = {s0.x, s0.y, s0.z, s0.w, s1.x, s1.y, s1.z, s1.w};
            float o[8];
#pragma unroll
            for (int e = 0; e < 8; ++e) o[e] = c4 < 2 ? xn[e] * csv[e] - ot[e] * snv[e] : ot[e] * snv[e] + xn[e] * csv[e];
            float* kf_ = a.krf() + (size_t)row * 32 + 8 * c4; *(float4*)kf_ = (float4){o[0], o[1], o[2], o[3]}; *(float4*)(kf_ + 4) = (float4){o[4], o[5], o[6], o[7]};
            float* ko = samp ? a.out + O_KRS + (size_t)b * 32 + 8 * c4 : a.out + O_KRP + (size_t)row * 32 + 8 * c4;
            *(float4*)ko = (float4){o[0], o[1], o[2], o[3]}; *(float4*)(ko + 4) = (float4){o[4], o[5], o[6], o[7]};
            if (!samp) *(bf16x8*)(a.krb() + (size_t)row * 32 + 8 * c4) = f32_to_bf8(o);
        }
    }
    (void)hd;
}
__device__ __forceinline__ void post_in_run(const MK& a, int run, int lane_in, const float* wcs) {
    int lane = lane_in; asm volatile("" : "+v"(lane));
    PinGain gn;
    {
        const int lq = lane < 48 ? lane : 0, lk = lane < 32 ? lane : 0, c4 = (lane - 32) & 3;
#pragma unroll
        for (int e = 0; e < 8; ++e) { gn.gqa[e] = a.g_q_a[8 * lq + e]; gn.gkv[e] = a.g_kv_a[8 * lk + e]; gn.gkr[e] = a.g_k_rope[8 * c4 + e]; }
        gn.dtb = a.dt_bias[lane & 7]; gn.alog = expf(a.a_log[lane & 7]);
    }
    if (run < NPT / 8) {
        const int row0 = run * 8, t0 = row0 & 2047;
        bf16x8 w0[3], w1[3], w2[3], wcur[3];
#pragma unroll
        for (int c3 = 0; c3 < 3; ++c3) {
            const bf16x8 zz = {0, 0, 0, 0, 0, 0, 0, 0}; w0[c3] = zz; w1[c3] = zz; w2[c3] = zz;
            if (t0 > 0) { const bf16_t* zp = a.Z() + (size_t)(row0 - 3) * ZW + 512 * c3 + 8 * lane; w0[c3] = *(const bf16x8*)zp; w1[c3] = *(const bf16x8*)(zp + ZW); w2[c3] = *(const bf16x8*)(zp + 2 * ZW); }
        }
        bf16x8 wnext[3]; PinTok tk, tkn;
#pragma unroll
        for (int c3 = 0; c3 < 3; ++c3) wnext[c3] = *(const bf16x8*)(a.Z() + (size_t)row0 * ZW + 512 * c3 + 8 * lane);
        tkn = pin_load(a, row0, lane);
#pragma unroll 1
        for (int k = 0; k < 8; ++k) {
            const int row = row0 + k;
#pragma unroll
            for (int c3 = 0; c3 < 3; ++c3) wcur[c3] = wnext[c3];
            tk = tkn;
            if (k < 7) {
#pragma unroll
                for (int c3 = 0; c3 < 3; ++c3) wnext[c3] = *(const bf16x8*)(a.Z() + (size_t)(row + 1) * ZW + 512 * c3 + 8 * lane);
                tkn = pin_load(a, row + 1, lane);
            }
            post_in_token(a, row, lane, wcs, w0, w1, w2, wcur, tk, gn);
#pragma unroll
            for (int c3 = 0; c3 < 3; ++c3) { w0[c3] = w1[c3]; w1[c3] = w2[c3]; w2[c3] = wcur[c3]; }
        }
    } else {
        {
            const int bsm = run - NPT / 8, row = NPT + bsm;
            bf16x8 w0[3], w1[3], w2[3], wcur[3];
#pragma unroll
            for (int c3 = 0; c3 < 3; ++c3) {
                const float* sp = a.state_conv + (size_t)bsm * 3 * 1536 + 512 * c3 + 8 * lane;
                float* cso = a.out + O_CSS + (size_t)bsm * 3 * 1536 + 512 * c3 + 8 * lane;
                float t0_[8], t1_[8], t2_[8], tc_[8];
#pragma unroll
                for (int e = 0; e < 8; ++e) { t0_[e] = sp[e]; t1_[e] = sp[1536 + e]; t2_[e] = sp[2 * 1536 + e]; }
                wcur[c3] = *(const bf16x8*)(a.Z() + (size_t)row * ZW + 512 * c3 + 8 * lane); bf8_to_f32(wcur[c3], tc_);
#pragma unroll
                for (int e = 0; e < 8; ++e) { cso[e] = t1_[e]; cso[1536 + e] = t2_[e]; cso[2 * 1536 + e] = tc_[e]; }
                w0[c3] = f32_to_bf8(t0_); w1[c3] = f32_to_bf8(t1_); w2[c3] = f32_to_bf8(t2_);
            }
            post_in_token(a, row, lane, wcs, w0, w1, w2, wcur, pin_load(a, row, lane), gn);
        }
    }
}

__device__ __forceinline__ void post_q_item(const MK& a, int idx, int lane) {
    const int row = idx >> 3, h = idx & 7;
    const float* q = a.Q() + (size_t)row * 768 + h * 96;
    float* o = a.qh() + ((size_t)row * 8 + h) * 96;
    const float v = q[lane];
    const float ss = wave_sum(v * v);
    o[lane] = v * rsqrtf(ss * (1.f / 64.f) + EPSV) * a.g_q_nope[lane];
    const float r = lane < 32 ? q[64 + lane] : 0.f;
    const float s2 = wave_sum(r * r);
    const float xn = lane < 32 ? r * rsqrtf(s2 * (1.f / 32.f) + EPSV) * a.g_q_rope[lane] : 0.f;
    const float other = __shfl_xor(xn, 16);
    const int i = lane & 15;
    const float* tb = a.ropecs() + (size_t)(row >= NPT ? 2048 : (row & 2047)) * 32;
    const float cs = tb[i], sn = tb[16 + i];
    const float ov = lane < 16 ? xn * cs - other * sn : other * sn + xn * cs;
    if (lane < 32) o[64 + lane] = ov;
}
__device__ __forceinline__ void post_kv_item(const MK& a, int idx, int lane) {
    const int row = idx >> 3, h = idx & 7;
    const float v = a.KV()[(size_t)row * 1024 + h * 128 + lane];
    const float ss = wave_sum(v * v);
    const float kn = v * rsqrtf(ss * (1.f / 64.f) + EPSV) * a.g_k_nope[lane];
    a.kh()[((size_t)row * 8 + h) * 64 + lane] = kn;
}

typedef float f32x16 __attribute__((ext_vector_type(16)));
typedef short s16x4 __attribute__((ext_vector_type(4)));
#define KST 104
#define VST 72
#define ATT_BUF (64 * KST * 2 + 64 * VST * 2)
__device__ __forceinline__ int crow32(int r, int hi) { return (r & 3) + 8 * (r >> 2) + 4 * hi; }
__device__ __forceinline__ s16x4 tr_read(const bf16_t* p) { return __builtin_bit_cast(s16x4, __builtin_amdgcn_ds_read_tr16_b64_v4i16((LAS s16x4*)(LAS void*)(unsigned)(size_t)p)); }
__device__ __forceinline__ bf16x8 pack8(const f32x16& x, int s) {
    u32x4 w; w.x = cvtpk(x[8 * s], x[8 * s + 1]); w.y = cvtpk(x[8 * s + 2], x[8 * s + 3]); w.z = cvtpk(x[8 * s + 4], x[8 * s + 5]); w.w = cvtpk(x[8 * s + 6], x[8 * s + 7]);
    return __builtin_bit_cast(bf16x8, w);
}
__device__ __forceinline__ void attn_block(const MK& a, int b, int h, int qb, char* smem) {
    const int tid = otid(), lane = tid & 63, wid = tid >> 6, r32 = lane & 31, hi = lane >> 5;
    const int qrow = qb * 256 + wid * 32 + r32;
    const int wq0 = qb * 256 + wid * 32;
    bf16x8 qf[6];
    {
        const float SCL = 0.14724445f;
        const bf16_t* Qg = a.qraw() + ((size_t)b * SEQ + qrow) * 768 + h * 96 + 8 * hi;
        float qv[6][8];
#pragma unroll
        for (int ds = 0; ds < 6; ++ds) bf8_to_f32(*(const bf16x8*)(Qg + 16 * ds), qv[ds]);
        float sn_ = 0.f, sr_ = 0.f;
#pragma unroll
        for (int j = 0; j < 8; ++j) { sn_ += qv[0][j] * qv[0][j] + qv[1][j] * qv[1][j] + qv[2][j] * qv[2][j] + qv[3][j] * qv[3][j]; sr_ += qv[4][j] * qv[4][j] + qv[5][j] * qv[5][j]; }
        sn_ = add_x32(sn_); sr_ = add_x32(sr_);
        const float rsn = rsqrtf(sn_ * (1.f / 64.f) + EPSV) * SCL, rsr = rsqrtf(sr_ * (1.f / 32.f) + EPSV);
#pragma unroll
        for (int ds = 0; ds < 4; ++ds) {
            float o[8];
#pragma unroll
            for (int j = 0; j < 8; ++j) o[j] = qv[ds][j] * rsn * a.g_q_nope[16 * ds + 8 * hi + j];
            qf[ds] = f32_to_bf8(o);
        }
        const float* tb = a.ropecs() + (size_t)qrow * 32 + 8 * hi;
        float o4[8], o5[8];
#pragma unroll
        for (int j = 0; j < 8; ++j) {
            const float x1 = qv[4][j] * rsr * a.g_q_rope[8 * hi + j], x2 = qv[5][j] * rsr * a.g_q_rope[16 + 8 * hi + j], cs = tb[j], sn = tb[16 + j];
            o4[j] = (x1 * cs - x2 * sn) * SCL; o5[j] = (x1 * sn + x2 * cs) * SCL;
        }
        qf[4] = f32_to_bf8(o4); qf[5] = f32_to_bf8(o5);
    }
    f32x16 o0, o1;
#pragma unroll
    for (int r = 0; r < 16; ++r) { o0[r] = 0.f; o1[r] = 0.f; }
    float m = 0.f, l = 0.f;
    f32x16 negm;
#pragma unroll
    for (int r = 0; r < 16; ++r) negm[r] = 0.f;
    const int nt = qb * 4 + 4;
    const int vr = tid >> 3, vc = tid & 7, rr_ = (tid >> 2) & 63, rc = tid & 3;
    const bf16_t* KVg = a.kvraw() + (size_t)b * SEQ * 1024 + h * 128 + (size_t)vr * 1024 + vc * 8;
    const bf16_t* KRg = a.krb() + (size_t)b * SEQ * 32 + (size_t)rr_ * 32 + rc * 8;
    float gk[8];
#pragma unroll
    for (int j = 0; j < 8; ++j) gk[j] = a.g_k_nope[8 * vc + j];
    bf16x8 kr0, kr1, vr0;
#define ATT_LOAD(tt) do { kr0 = *(const bf16x8*)(KVg + (size_t)(tt) * 64 * 1024); vr0 = *(const bf16x8*)(KVg + (size_t)(tt) * 64 * 1024 + 64); if (tid < 256) kr1 = *(const bf16x8*)(KRg + (size_t)(tt) * 64 * 32); } while (0)
#define ATT_STORE(buf) do { bf16_t* Ks_ = (bf16_t*)(smem + (buf) * ATT_BUF); bf16_t* Vs_ = Ks_ + 64 * KST; \
        float x_[8]; bf8_to_f32(kr0, x_); float ss_ = 0.f; _Pragma("unroll") for (int j = 0; j < 8; ++j) ss_ += x_[j] * x_[j]; \
        ss_ = sum8(ss_); const float rs_ = rsqrtf(ss_ * (1.f / 64.f) + EPSV); \
        _Pragma("unroll") for (int j = 0; j < 8; ++j) x_[j] *= rs_ * gk[j]; \
        *(bf16x8*)(Ks_ + vr * KST + vc * 8) = f32_to_bf8(x_); *(bf16x8*)(Vs_ + vr * VST + vc * 8) = vr0; \
        if (tid < 256) *(bf16x8*)(Ks_ + rr_ * KST + 64 + rc * 8) = kr1; } while (0)
    ATT_LOAD(0);
    __syncthreads();
    ATT_STORE(0);
    __syncthreads();
    const int i16 = lane & 15, qq = i16 >> 2, pp = i16 & 3, g1 = (lane >> 4) & 1;
    for (int t = 0; t < nt; ++t) {
        const bf16_t* Ks = (const bf16_t*)(smem + (t & 1) * ATT_BUF); const bf16_t* Vs = Ks + 64 * KST;
        if (t + 1 < nt) ATT_LOAD(t + 1);
        if (64 * t <= wq0 + 31) {
            f32x16 p0, p1;
#pragma unroll
            for (int ds = 0; ds < 6; ++ds) {
                const bf16x8 k0 = *(const bf16x8*)(Ks + r32 * KST + 16 * ds + 8 * hi);
                const bf16x8 k1 = *(const bf16x8*)(Ks + (32 + r32) * KST + 16 * ds + 8 * hi);
                if (ds == 0) { p0 = __builtin_amdgcn_mfma_f32_32x32x16_bf16(k0, qf[ds], negm, 0, 0, 0); p1 = __builtin_amdgcn_mfma_f32_32x32x16_bf16(k1, qf[ds], negm, 0, 0, 0); }
                else { p0 = __builtin_amdgcn_mfma_f32_32x32x16_bf16(k0, qf[ds], p0, 0, 0, 0); p1 = __builtin_amdgcn_mfma_f32_32x32x16_bf16(k1, qf[ds], p1, 0, 0, 0); }
            }
            if (64 * t + 63 > wq0) {
#pragma unroll
                for (int r = 0; r < 16; ++r) { const int kv = 64 * t + crow32(r, hi); if (kv > qrow) p0[r] = -INFINITY; if (kv + 32 > qrow) p1[r] = -INFINITY; }
            }
            float mx = fmaxf(p0[0], p1[0]);
#pragma unroll
            for (int r = 1; r < 16; ++r) mx = fmaxf(mx, fmaxf(p0[r], p1[r]));
            mx = max_x32(mx);
            const float delta = t == 0 ? mx : fmaxf(mx, 0.f);
            if (__any(delta != 0.f)) {
                m += delta;
                const float f = t == 0 ? 1.f : __builtin_amdgcn_exp2f(-delta);
#pragma unroll
                for (int r = 0; r < 16; ++r) { p0[r] -= delta; p1[r] -= delta; negm[r] = -m; o0[r] *= f; o1[r] *= f; }
                l *= f;
            }
            float rs = 0.f;
#pragma unroll
            for (int r = 0; r < 16; ++r) { p0[r] = __builtin_amdgcn_exp2f(p0[r]); p1[r] = __builtin_amdgcn_exp2f(p1[r]); rs += p0[r] + p1[r]; }
            l += rs;
            bf16x8 pf[4];
            pf[0] = pack8(p0, 0); pf[1] = pack8(p0, 1); pf[2] = pack8(p1, 0); pf[3] = pack8(p1, 1);
#pragma unroll
            for (int ks = 0; ks < 4; ++ks) {
                const bf16_t* vb0 = Vs + (16 * ks + 4 * hi + qq) * VST + 16 * g1 + 4 * pp;
                const s16x4 a0 = tr_read(vb0), a1 = tr_read(vb0 + 8 * VST);
                const s16x4 c0 = tr_read(vb0 + 32), c1 = tr_read(vb0 + 8 * VST + 32);
                const bf16x8 va = __builtin_shufflevector(a0, a1, 0, 1, 2, 3, 4, 5, 6, 7);
                const bf16x8 vc_ = __builtin_shufflevector(c0, c1, 0, 1, 2, 3, 4, 5, 6, 7);
                o0 = __builtin_amdgcn_mfma_f32_32x32x16_bf16(va, pf[ks], o0, 0, 0, 0);
                o1 = __builtin_amdgcn_mfma_f32_32x32x16_bf16(vc_, pf[ks], o1, 0, 0, 0);
            }
        }
        if (t + 1 < nt) ATT_STORE((t + 1) & 1);
        __syncthreads();
    }
    l = add_x32(l);
    const float il = 1.f / l;
    bf16_t* op = a.omix() + ((size_t)b * SEQ + qrow) * 1024 + 512 + h * 64;
#pragma unroll
    for (int g = 0; g < 4; ++g) {
        uint2 w0, w1;
        w0.x = pk2bf(o0[4 * g] * il, o0[4 * g + 1] * il); w0.y = pk2bf(o0[4 * g + 2] * il, o0[4 * g + 3] * il);
        w1.x = pk2bf(o1[4 * g] * il, o1[4 * g + 1] * il); w1.y = pk2bf(o1[4 * g + 2] * il, o1[4 * g + 3] * il);
        *(uint2*)(op + 8 * g + 4 * hi) = w0;
        *(uint2*)(op + 32 + 8 * g + 4 * hi) = w1;
    }
#undef ATT_LOAD
#undef ATT_STORE
}

__device__ __forceinline__ void gdn_unit(const MK& a, int b, int h, int dvg, const float* s0, float* sout, int row0, int T, int lane, char* wsm) {
    float (*sq)[64] = (float (*)[64])wsm;
    float (*sk)[64] = (float (*)[64])(wsm + 4096);
    float (*sv)[8] = (float (*)[8])(wsm + 8192);
    float* sg = (float*)(wsm + 8704);
    float* sb = (float*)(wsm + 8768);
    const int e = lane & 7, ko = lane >> 3, col = dvg * 8 + e;
    float S[8];
#pragma unroll
    for (int d = 0; d < 8; ++d) S[d] = s0 ? s0[(((size_t)b * 8 + h) * 64 + ko * 8 + d) * 64 + col] : 0.f;
    const size_t rbase = (size_t)row0 + (size_t)b * T;
    float pq[16], pk[16], pv0, pv1, pgb;
    {
        const int nt = T < 16 ? T : 16;
#pragma unroll
        for (int j = 0; j < 16; ++j) { const bool ok = j < nt; const size_t r = rbase + (ok ? j : 0); pq[j] = ok ? bf2f(a.qkv()[r * 1536 + h * 64 + lane]) : 0.f; pk[j] = ok ? bf2f(a.qkv()[r * 1536 + 512 + h * 64 + lane]) : 0.f; }
        { const int j0 = lane >> 3, j1 = j0 + 8; pv0 = j0 < nt ? bf2f(a.qkv()[(rbase + j0) * 1536 + 1024 + h * 64 + dvg * 8 + (lane & 7)]) : 0.f; pv1 = j1 < nt ? bf2f(a.qkv()[(rbase + j1) * 1536 + 1024 + h * 64 + dvg * 8 + (lane & 7)]) : 0.f; }
        { const int j = lane & 15; pgb = j < nt ? (lane < 16 ? a.gg()[(rbase + j) * 8 + h] : a.bb()[(rbase + j) * 8 + h]) : 0.f; }
    }
    for (int t0 = 0; t0 < T; t0 += 16) {
        const int nt = (T - t0) < 16 ? (T - t0) : 16;
        WSYNC();
#pragma unroll
        for (int j = 0; j < 16; ++j) { sq[j][lane] = pq[j]; sk[j][lane] = pk[j]; }
        sv[lane >> 3][lane & 7] = pv0; sv[(lane >> 3) + 8][lane & 7] = pv1;
        if (lane < 16) sg[lane] = expf(pgb); else if (lane < 32) sb[lane - 16] = pgb;
        WSYNC();
        if (t0 + 16 < T) {
            const size_t rb = rbase + t0 + 16;
#pragma unroll
            for (int j = 0; j < 16; ++j) { pq[j] = bf2f(a.qkv()[(rb + j) * 1536 + h * 64 + lane]); pk[j] = bf2f(a.qkv()[(rb + j) * 1536 + 512 + h * 64 + lane]); }
            pv0 = bf2f(a.qkv()[(rb + (lane >> 3)) * 1536 + 1024 + h * 64 + dvg * 8 + (lane & 7)]); pv1 = bf2f(a.qkv()[(rb + (lane >> 3) + 8) * 1536 + 1024 + h * 64 + dvg * 8 + (lane & 7)]);
            pgb = lane < 16 ? a.gg()[(rb + (lane & 15)) * 8 + h] : a.bb()[(rb + (lane & 15)) * 8 + h];
        }
        for (int j = 0; j < nt; ++j) {
            const float dec = sg[j], be = sb[j], v = sv[j][e];
            const float4 k0 = *(const float4*)&sk[j][ko * 8], k1 = *(const float4*)&sk[j][ko * 8 + 4];
            const float4 q0 = *(const float4*)&sq[j][ko * 8], q1 = *(const float4*)&sq[j][ko * 8 + 4];
            const float kk[8] = {k0.x, k0.y, k0.z, k0.w, k1.x, k1.y, k1.z, k1.w};
            const float qq[8] = {q0.x, q0.y, q0.z, q0.w, q1.x, q1.y, q1.z, q1.w};
            float ks = 0.f;
#pragma unroll
            for (int d = 0; d < 8; ++d) { S[d] *= dec; ks += kk[d] * S[d]; }
            ks += __shfl_xor(ks, 8); ks += __shfl_xor(ks, 16); ks += __shfl_xor(ks, 32);
            const float delta = (v - ks) * be;
            float ov = 0.f;
#pragma unroll
            for (int d = 0; d < 8; ++d) { S[d] += kk[d] * delta; ov += qq[d] * S[d]; }
            ov += __shfl_xor(ov, 8); ov += __shfl_xor(ov, 16); ov += __shfl_xor(ov, 32);
            if (ko == 0) a.goraw()[(rbase + t0 + j) * 512 + h * 64 + col] = ov;
        }
    }
#pragma unroll
    for (int d = 0; d < 8; ++d) sout[(((size_t)b * 8 + h) * 64 + ko * 8 + d) * 64 + col] = S[d];
}
__device__ __forceinline__ int pi_pos(int k) { return (k & 32) + 8 * ((k >> 2) & 3) + 4 * ((k >> 4) & 1) + (k & 3); }
#define GDN_WLDS 17408
__device__ __forceinline__ void gdn_prep_unit(const MK& a, int u, int lane_in, char* wsm) {
    int lane = lane_in; asm volatile("" : "+v"(lane));
    const int bh = u >> 5, n = u & 31, b = bh >> 3, h = bh & 7, i16 = lane & 15, q4 = lane >> 4;
    const size_t row0 = (size_t)b * SEQ + n * 64;
    float* AT = (float*)wsm; float* GC = (float*)(wsm + 16384); float* BT = GC + 64;
    const bf16_t* qbase = a.qkv() + row0 * 1536 + h * 64; const bf16_t* kbase = qbase + 512; const bf16_t* vbase = qbase + 1024;
    float g = a.gg()[(row0 + lane) * 8 + h];
    const float be_l = a.bb()[(row0 + lane) * 8 + h];
#pragma unroll
    for (int o = 1; o < 64; o <<= 1) { const float t = __shfl_up(g, o); if (lane >= o) g += t; }
    WSYNC();
    GC[lane] = g; BT[lane] = be_l;
    WSYNC();
    const float gl = GC[63];
    float* EG = BT + 64; float* ED = EG + 64;
    EG[lane] = expf(g); ED[lane] = expf(gl - g);
    WSYNC();
    bf16x8 kf[4][2], qf[4][2];
#pragma unroll
    for (int mt = 0; mt < 4; ++mt)
#pragma unroll
        for (int ks = 0; ks < 2; ++ks) {
            const int off = (16 * mt + i16) * 1536 + 32 * ks + 8 * q4;
            kf[mt][ks] = *(const bf16x8*)(kbase + off); qf[mt][ks] = *(const bf16x8*)(qbase + off);
        }
    bf16_t* QKg = a.gQK() + (size_t)u * 4096;
#pragma unroll
    for (int mt = 0; mt < 4; ++mt)
#pragma unroll
        for (int nt = 0; nt < 4; ++nt) {
            const int j = 16 * nt + i16, pj = 32 * (nt >> 1) + 8 * (i16 >> 2) + 4 * (nt & 1) + (i16 & 3);
            if (nt <= mt) {
                f32x4 d1 = {0.f, 0.f, 0.f, 0.f}, d2 = {0.f, 0.f, 0.f, 0.f};
#pragma unroll
                for (int ks = 0; ks < 2; ++ks) {
                    d1 = __builtin_amdgcn_mfma_f32_16x16x32_bf16(kf[mt][ks], kf[nt][ks], d1, 0, 0, 0);
                    d2 = __builtin_amdgcn_mfma_f32_16x16x32_bf16(qf[mt][ks], kf[nt][ks], d2, 0, 0, 0);
                }
                const float gcj = GC[j];
#pragma unroll
                for (int r = 0; r < 4; ++r) {
                    const int i = 16 * mt + 4 * q4 + r;
                    const float dec = __builtin_amdgcn_exp2f(1.44269504f * (GC[i] - gcj));
                    AT[i * 64 + j] = (i > j) ? BT[i] * d1[r] * dec : 0.f;
                    QKg[i * 64 + (((pj >> 3) ^ (i & 7)) << 3) + (pj & 7)] = f2bf((i >= j) ? d2[r] * dec : 0.f);
                }
            } else {
#pragma unroll
                for (int r = 0; r < 4; ++r) { const int i = 16 * mt + 4 * q4 + r; QKg[i * 64 + (((pj >> 3) ^ (i & 7)) << 3) + (pj & 7)] = 0; }
            }
        }
    {
        bf16_t* Qgg = a.gQg() + (size_t)u * 4096;
#pragma unroll
        for (int mt = 0; mt < 4; ++mt) {
            const int i = 16 * mt + i16; const float e = EG[i];
#pragma unroll
            for (int ks = 0; ks < 2; ++ks) {
                float x[8]; bf8_to_f32(qf[mt][ks], x);
                uint2 w0, w1; w0.x = cvtpk(x[0] * e, x[1] * e); w0.y = cvtpk(x[2] * e, x[3] * e); w1.x = cvtpk(x[4] * e, x[5] * e); w1.y = cvtpk(x[6] * e, x[7] * e);
                const int p0 = 32 * ks + 16 * (q4 & 1) + 4 * (q4 >> 1);
                *(uint2*)(Qgg + i * 64 + (((p0 >> 3) ^ (i & 7)) << 3) + (p0 & 7)) = w0; *(uint2*)(Qgg + i * 64 + ((((p0 >> 3) + 1) ^ (i & 7)) << 3) + (p0 & 7)) = w1;
            }
        }
    }
    WSYNC();
    __builtin_amdgcn_sched_barrier(0);
    {
        float U[64];
#pragma unroll
        for (int i = 0; i < 64; ++i) { U[i] = bf2f(vbase[i * 1536 + lane]) * BT[i]; }
#pragma unroll
        for (int i = 1; i < 64; ++i) {
            float su = 0.f;
#pragma unroll
            for (int j4 = 0; j4 < i; j4 += 4) {
                const float4 av = *(const float4*)(AT + i * 64 + j4);
                su += av.x * U[j4];
                if (j4 + 1 < i) su += av.y * U[j4 + 1];
                if (j4 + 2 < i) su += av.z * U[j4 + 2];
                if (j4 + 3 < i) su += av.w * U[j4 + 3];
            }
            U[i] -= su;
            __builtin_amdgcn_sched_barrier(0);
        }
        float* UTg = a.gUT() + ((size_t)u * 64 + lane) * 64;
#pragma unroll
        for (int i = 0; i < 64; i += 4) *(float4*)(UTg + 4 * ((i >> 2) ^ (lane & 15))) = (float4){U[i], U[i + 1], U[i + 2], U[i + 3]};
    }
    asm volatile("" ::: "memory");
    __builtin_amdgcn_sched_barrier(0);
    {
        float W[64];
#pragma unroll
        for (int i = 0; i < 64; ++i) { W[i] = bf2f(kbase[i * 1536 + lane]); }
        bf16_t* Kdg = a.gKd() + ((size_t)u * 64 + lane) * 64;
#pragma unroll
        for (int pc = 0; pc < 8; ++pc) {
            float t[8];
#pragma unroll
            for (int jj = 0; jj < 8; ++jj) { const int j = 32 * (pc >> 2) + 16 * (jj >> 2) + 4 * (pc & 3) + (jj & 3); t[jj] = W[j] * ED[j]; }
            u32x4 w; w.x = cvtpk(t[0], t[1]); w.y = cvtpk(t[2], t[3]); w.z = cvtpk(t[4], t[5]); w.w = cvtpk(t[6], t[7]);
            *(u32x4*)(Kdg + 8 * (pc ^ (lane & 7))) = w;
        }
#pragma unroll
        for (int i = 0; i < 64; ++i) W[i] *= BT[i] * EG[i];
#pragma unroll
        for (int i = 1; i < 64; ++i) {
            float sw = 0.f;
#pragma unroll
            for (int j4 = 0; j4 < i; j4 += 4) {
                const float4 av = *(const float4*)(AT + i * 64 + j4);
                sw += av.x * W[j4];
                if (j4 + 1 < i) sw += av.y * W[j4 + 1];
                if (j4 + 2 < i) sw += av.z * W[j4 + 2];
                if (j4 + 3 < i) sw += av.w * W[j4 + 3];
            }
            W[i] -= sw;
            __builtin_amdgcn_sched_barrier(0);
        }
        bf16_t* Wng = a.gWn() + (size_t)u * 4096; const int pp = pi_pos(lane);
#pragma unroll
        for (int i = 0; i < 64; ++i) Wng[i * 64 + (((pp >> 3) ^ (i & 7)) << 3) + (pp & 7)] = f2bf(-W[i]);
    }
    if (lane == 0) a.ggam()[u] = expf(gl);
}
__device__ __forceinline__ bf16x8 pack_acc2(const f32x4& x, const f32x4& y) {
    u32x4 w; w.x = cvtpk(x[0], x[1]); w.y = cvtpk(x[2], x[3]); w.z = cvtpk(y[0], y[1]); w.w = cvtpk(y[2], y[3]);
    return __builtin_bit_cast(bf16x8, w);
}
#define G2_SLOT 49152
__device__ __forceinline__ void g2_issue(const MK& a, size_t u, int n, LAS unsigned char* lds, int lw, int lane) {
    LAS unsigned char* dst = lds + (n % 3) * G2_SLOT;
    const char* srcs[4] = {(const char*)(a.gWn() + u * 4096), (const char*)(a.gQg() + u * 4096), (const char*)(a.gQK() + u * 4096), (const char*)(a.gKd() + u * 4096)};
#pragma unroll
    for (int m = 0; m < 4; ++m)
#pragma unroll
        for (int i = 0; i < 2; ++i) { const int piece = 2 * lw + i;
            __builtin_amdgcn_global_load_lds((const unsigned*)(srcs[m] + piece * 1024 + lane * 16), (LAS unsigned*)(dst + m * 8192 + piece * 1024), 16, 0, 0); }
    const char* us = (const char*)(a.gUT() + u * 4096);
#pragma unroll
    for (int i = 0; i < 4; ++i) { const int piece = 4 * lw + i;
        __builtin_amdgcn_global_load_lds((const unsigned*)(us + piece * 1024 + lane * 16), (LAS unsigned*)(dst + 32768 + piece * 1024), 16, 0, 0); }
}
__device__ __forceinline__ void gdn_scan_block(const MK& a, int bh, LAS unsigned char* lds) {
    const int tid = otid(), lane = tid & 63, wid = __builtin_amdgcn_readfirstlane(tid >> 6), i16 = lane & 15, q4 = lane >> 4;
    const int b = bh >> 3, h = bh & 7, sl = wid & 3;
    const bool loader = wid >= 4;
    f32x4 S[4];
#pragma unroll
    for (int mt = 0; mt < 4; ++mt) S[mt] = (f32x4){0.f, 0.f, 0.f, 0.f};
    __syncthreads();
    if (loader) { g2_issue(a, (size_t)bh * 32, 0, lds, wid - 4, lane); g2_issue(a, (size_t)bh * 32 + 1, 1, lds, wid - 4, lane); }
    for (int n = 0; n < 32; ++n) {
        if (loader) { if (n < 31) asm volatile("s_waitcnt vmcnt(12)" ::: "memory"); else asm volatile("s_waitcnt vmcnt(0)" ::: "memory"); }
        asm volatile("s_waitcnt lgkmcnt(0)" ::: "memory"); __builtin_amdgcn_s_barrier(); asm volatile("" ::: "memory");
        if (loader) { if (n + 2 < 32) g2_issue(a, (size_t)bh * 32 + n + 2, n + 2, lds, wid - 4, lane); }
        else {
            const LAS unsigned char* sb = lds + (n % 3) * G2_SLOT;
            const float gam = a.ggam()[(size_t)bh * 32 + n];
            bf16x8 Sb[2]; Sb[0] = pack_acc2(S[0], S[1]); Sb[1] = pack_acc2(S[2], S[3]);
            f32x4 Vn[4];
#pragma unroll
            for (int mt = 0; mt < 4; ++mt) Vn[mt] = *(const LAS f32x4*)(sb + 32768 + (16 * sl + i16) * 256 + 16 * ((4 * mt + q4) ^ i16));
#pragma unroll
            for (int mt = 0; mt < 4; ++mt)
#pragma unroll
                for (int ks = 0; ks < 2; ++ks) Vn[mt] = __builtin_amdgcn_mfma_f32_16x16x32_bf16(*(const LAS bf16x8*)(sb + (16 * mt + i16) * 128 + 16 * ((4 * ks + q4) ^ (i16 & 7))), Sb[ks], Vn[mt], 0, 0, 0);
            bf16x8 Vb[2]; Vb[0] = pack_acc2(Vn[0], Vn[1]); Vb[1] = pack_acc2(Vn[2], Vn[3]);
            f32x4 O[4];
#pragma unroll
            for (int mt = 0; mt < 4; ++mt) {
                O[mt] = (f32x4){0.f, 0.f, 0.f, 0.f};
#pragma unroll
                for (int ks = 0; ks < 2; ++ks) {
                    const int fo = (16 * mt + i16) * 128 + 16 * ((4 * ks + q4) ^ (i16 & 7));
                    O[mt] = __builtin_amdgcn_mfma_f32_16x16x32_bf16(*(const LAS bf16x8*)(sb + 8192 + fo), Sb[ks], O[mt], 0, 0, 0);
                    O[mt] = __builtin_amdgcn_mfma_f32_16x16x32_bf16(*(const LAS bf16x8*)(sb + 16384 + fo), Vb[ks], O[mt], 0, 0, 0);
                }
            }
#pragma unroll
            for (int mt = 0; mt < 4; ++mt) {
                S[mt] = S[mt] * gam;
#pragma unroll
                for (int ks = 0; ks < 2; ++ks) S[mt] = __builtin_amdgcn_mfma_f32_16x16x32_bf16(*(const LAS bf16x8*)(sb + 24576 + (16 * mt + i16) * 128 + 16 * ((4 * ks + q4) ^ (i16 & 7))), Vb[ks], S[mt], 0, 0, 0);
            }
            float* og = a.goraw() + ((size_t)b * SEQ + n * 64 + 4 * q4) * 512 + h * 64 + 16 * sl + i16;
#pragma unroll
            for (int mt = 0; mt < 4; ++mt)
#pragma unroll
                for (int r = 0; r < 4; ++r) og[(size_t)(16 * mt + r) * 512] = O[mt][r];
        }
    }
    if (!loader) {
        float* so = a.out + O_GSP + ((size_t)bh * 64 + 4 * q4) * 64 + 16 * sl + i16;
#pragma unroll
        for (int mt = 0; mt < 4; ++mt)
#pragma unroll
            for (int r = 0; r < 4; ++r) so[(size_t)(16 * mt + r) * 64] = S[mt][r];
    }
    __syncthreads();
}
__device__ __forceinline__ void gdn_out_token(const MK& a, int row, int lane) {
    const float* op = a.goraw() + (size_t)row * 512 + 8 * lane;
    const float4 x0 = *(const float4*)op, x1 = *(const float4*)(op + 4);
    float o[8] = {x0.x, x0.y, x0.z, x0.w, x1.x, x1.y, x1.z, x1.w}, zg[8];
    bf8_to_f32(*(const bf16x8*)(a.Z() + (size_t)row * ZW + OFF_Z + 8 * lane), zg);
    float ss = 0.f;
#pragma unroll
    for (int e = 0; e < 8; ++e) ss += o[e] * o[e];
    ss = sum8(ss);
    const float rs = rsqrtf(ss * (1.f / 64.f) + EPSV);
    const float4 g0 = *(const float4*)(a.g_gdn_out + 8 * (lane & 7)), g1 = *(const float4*)(a.g_gdn_out + 8 * (lane & 7) + 4);
    const float gg_[8] = {g0.x, g0.y, g0.z, g0.w, g1.x, g1.y, g1.z, g1.w};
#pragma unroll
    for (int e = 0; e < 8; ++e) o[e] = o[e] * rs * gg_[e] * zg[e] * fast_sigmoid(zg[e]);
    *(bf16x8*)(a.omix() + (size_t)row * 1024 + 8 * lane) = f32_to_bf8(o);
}

#define SSLOT 32768
#define TL_OFF (3 * SSLOT)
#define CST 264
#define KR_OFF (TL_OFF + 2 * 32 * CST * 2)
#define WQ_OFF (KR_OFF + 4 * 4096)
#define QR_OFF (WQ_OFF + 2048)
#define PG_OFF (QR_OFF + 1024)
#define PT_OFF (PG_OFF + 64)
#define AL_OFF (PT_OFF + 1024)
#define SAMP_LDS_END (AL_OFF + 64)
__device__ __forceinline__ void samp_issue(const MK& a, int g, LAS unsigned char* lds, int wid, int lane) {
    const int phys = __builtin_amdgcn_readfirstlane(((const LAS int*)(lds + PG_OFF))[g >> 2]);
    const int tok0 = (g & 3) * 32 + 4 * wid;
    const float* cs = a.cache_ckv + ((size_t)phys * 128 + tok0) * 256 + lane * 4;
#pragma unroll
    for (int i = 0; i < 4; ++i) __builtin_amdgcn_global_load_lds((const unsigned*)(cs + i * 256), (LAS unsigned*)(lds + (g % 3) * SSLOT + (4 * wid + i) * 1024), 16, 0, 0);
    if (wid < 4) { const int tl = lane >> 3, cg = (lane & 7) ^ (((tl >> 1) & 1) | ((wid & 1) << 2));
        __builtin_amdgcn_global_load_lds((const unsigned*)(a.cache_krope + ((size_t)phys * 128 + (g & 3) * 32 + 8 * wid + tl) * 32 + cg * 4), (LAS unsigned*)(lds + KR_OFF + (g & 3) * 4096 + wid * 1024), 16, 0, 0); }
}
typedef unsigned u32x2 __attribute__((ext_vector_type(2)));
__device__ __forceinline__ void samp_convert(int g, LAS unsigned char* lds, int tid) {
    const int st = tid >> 4, l16 = tid & 15;
    const LAS float* src = (const LAS float*)(lds + (g % 3) * SSLOT) + st * 256 + 4 * l16;
    LAS bf16_t* dst = (LAS bf16_t*)(lds + TL_OFF + (g & 1) * 32 * CST * 2) + st * CST + 4 * l16;
    f32x4 x[4];
#pragma unroll
    for (int k = 0; k < 4; ++k) x[k] = *(const LAS f32x4*)(src + 64 * k);
#pragma unroll
    for (int k = 0; k < 4; ++k) { u32x2 w; w.x = cvtpk(x[k][0], x[k][1]); w.y = cvtpk(x[k][2], x[k][3]); *(LAS u32x2*)(dst + 64 * k) = w; }
}
#define SAMP_WAITV(n5, n4) do { if (h < 4) asm volatile("s_waitcnt vmcnt(" #n5 ")" ::: "memory"); else asm volatile("s_waitcnt vmcnt(" #n4 ")" ::: "memory"); } while (0)
#define SAMP_BAR() do { asm volatile("s_waitcnt lgkmcnt(0)" ::: "memory"); __builtin_amdgcn_s_barrier(); asm volatile("" ::: "memory"); } while (0)
__device__ __forceinline__ void samp_attn_unit(const MK& a, int u, char* smem, LAS unsigned char* lds) {
    const int tid = otid(), lane = tid & 63, h = __builtin_amdgcn_readfirstlane(tid >> 6), i16 = lane & 15, q4 = lane >> 4;
    const int b = u >> 3, sp = u & 7;
    float* WQ = (float*)(smem + WQ_OFF);
    float* QR = (float*)(smem + QR_OFF);
    int* PG = (int*)(smem + PG_OFF);
    const float SCL = 0.14724445f;
    post_q_item(a, (NPT + b) * 8 + h, lane);
    __syncthreads();
    {
        const int h_ = tid >> 6, l_ = tid & 63, q4_ = l_ >> 4, idx = l_ & 15, d = 16 * (idx >> 2) + 4 * q4_ + (idx & 3);
        WQ[tid] = a.g_k_nope[d] * a.qh()[((size_t)(NPT + b) * 8 + h_) * 96 + d] * SCL;
        if (tid < 256) QR[tid] = a.qh()[((size_t)(NPT + b) * 8 + (tid >> 5)) * 96 + 64 + (tid & 31)] * SCL;
        if (tid < 16) PG[tid] = a.page_table[b * NPAGES + sp * 16 + tid];
    }
    bf16x8 wf[4][8];
#pragma unroll
    for (int mt = 0; mt < 4; ++mt)
#pragma unroll
        for (int ks = 0; ks < 8; ++ks) wf[mt][ks] = *(const bf16x8*)(a.WknT() + (size_t)(h * 64 + 16 * mt + i16) * 256 + 32 * ks + 8 * q4);
#pragma unroll
    for (int mt = 0; mt < 4; ++mt)
#pragma unroll
        for (int ks = 0; ks < 8; ++ks) asm volatile("" : "+v"(wf[mt][ks]));
    __syncthreads();
    samp_issue(a, 0, lds, h, lane); samp_issue(a, 1, lds, h, lane); samp_issue(a, 2, lds, h, lane);
    SAMP_WAITV(10, 8);
    SAMP_BAR();
    samp_convert(0, lds, tid);
    const LAS float* QRl = (const LAS float*)(lds + QR_OFF) + h * 32 + 8 * q4;
    const LAS float* WQl = (const LAS float*)(lds + WQ_OFF) + (h * 4 + q4) * 16;
    f32x4 wqr[4], qrr[2];
#pragma unroll
    for (int mt = 0; mt < 4; ++mt) wqr[mt] = *(const LAS f32x4*)(WQl + 4 * mt);
    qrr[0] = *(const LAS f32x4*)QRl; qrr[1] = *(const LAS f32x4*)(QRl + 4);
    float m = -INFINITY, lsum = 0.f;
    f32x4 latv[2]; latv[0] = (f32x4){0.f, 0.f, 0.f, 0.f}; latv[1] = (f32x4){0.f, 0.f, 0.f, 0.f};
    for (int g = 0; g < 64; ++g) {
        SAMP_BAR();
        if (g + 3 < 64) samp_issue(a, g + 3, lds, h, lane);
        const LAS bf16_t* Tl = (const LAS bf16_t*)(lds + TL_OFF + (g & 1) * 32 * CST * 2); const LAS float* KR = (const LAS float*)(lds + KR_OFF + (g & 3) * 4096);
        float scv;
        {
            float ssp[2], dotp[2], rdp[2];
            f32x4 acc[2][4];
#pragma unroll
            for (int hf = 0; hf < 2; ++hf)
#pragma unroll
                for (int mt = 0; mt < 4; ++mt) acc[hf][mt] = (f32x4){0.f, 0.f, 0.f, 0.f};
            const LAS bf16_t* cp0 = Tl + i16 * CST + 8 * q4; const LAS bf16_t* cp1 = cp0 + 16 * CST;
            bf16x8 c0 = *(const LAS bf16x8*)cp0, c1 = *(const LAS bf16x8*)cp1;
#pragma unroll
            for (int ks = 0; ks < 8; ++ks) {
                bf16x8 n0 = c0, n1 = c1;
                if (ks < 7) { n0 = *(const LAS bf16x8*)(cp0 + 32 * (ks + 1)); n1 = *(const LAS bf16x8*)(cp1 + 32 * (ks + 1)); }
#pragma unroll
                for (int mt = 0; mt < 4; ++mt) { acc[0][mt] = __builtin_amdgcn_mfma_f32_16x16x32_bf16(wf[mt][ks], c0, acc[0][mt], 0, 0, 0); acc[1][mt] = __builtin_amdgcn_mfma_f32_16x16x32_bf16(wf[mt][ks], c1, acc[1][mt], 0, 0, 0); }
                c0 = n0; c1 = n1;
            }
#pragma unroll
            for (int hf = 0; hf < 2; ++hf) {
                f32x2_t ss2 = {0.f, 0.f}, dot2 = {0.f, 0.f}, rd2 = {0.f, 0.f};
#pragma unroll
                for (int mt = 0; mt < 4; ++mt) {
                    const f32x4 wq = wqr[mt];
                    const f32x4 av = acc[hf][mt];
                    const f32x2_t lo = __builtin_shufflevector(av, av, 0, 1), hi = __builtin_shufflevector(av, av, 2, 3);
                    ss2 = __builtin_elementwise_fma(lo, lo, ss2); ss2 = __builtin_elementwise_fma(hi, hi, ss2);
                    dot2 = __builtin_elementwise_fma(lo, __builtin_shufflevector(wq, wq, 0, 1), dot2); dot2 = __builtin_elementwise_fma(hi, __builtin_shufflevector(wq, wq, 2, 3), dot2);
                }
                {
                    const int kc = (2 * q4) ^ ((i16 >> 1) & 5);
                    const LAS float* kp = KR + (16 * hf + i16) * 32;
                    const f32x4 k0 = *(const LAS f32x4*)(kp + 4 * kc), k1 = *(const LAS f32x4*)(kp + 4 * (kc ^ 1)), q0 = qrr[0], q1 = qrr[1];
                    rd2 = __builtin_elementwise_fma(__builtin_shufflevector(k0, k0, 0, 1), __builtin_shufflevector(q0, q0, 0, 1), rd2); rd2 = __builtin_elementwise_fma(__builtin_shufflevector(k0, k0, 2, 3), __builtin_shufflevector(q0, q0, 2, 3), rd2);
                    rd2 = __builtin_elementwise_fma(__builtin_shufflevector(k1, k1, 0, 1), __builtin_shufflevector(q1, q1, 0, 1), rd2); rd2 = __builtin_elementwise_fma(__builtin_shufflevector(k1, k1, 2, 3), __builtin_shufflevector(q1, q1, 2, 3), rd2);
                }
                ssp[hf] = ss2[0] + ss2[1]; dotp[hf] = dot2[0] + dot2[1]; rdp[hf] = rd2[0] + rd2[1];
            }
            const auto s1 = __builtin_amdgcn_permlane16_swap(__float_as_uint(ssp[0]), __float_as_uint(ssp[1]), false, false);
            const auto s2 = __builtin_amdgcn_permlane16_swap(__float_as_uint(dotp[0]), __float_as_uint(dotp[1]), false, false);
            const auto s3 = __builtin_amdgcn_permlane16_swap(__float_as_uint(rdp[0]), __float_as_uint(rdp[1]), false, false);
            const float u1 = __uint_as_float(s1[0]) + __uint_as_float(s1[1]), u2 = __uint_as_float(s2[0]) + __uint_as_float(s2[1]), u3 = __uint_as_float(s3[0]) + __uint_as_float(s3[1]);
            const auto t1 = __builtin_amdgcn_permlane32_swap(__float_as_uint(u1), __float_as_uint(u2), false, false);
            const float t = __uint_as_float(t1[0]) + __uint_as_float(t1[1]);
            const auto t2 = __builtin_amdgcn_permlane32_swap(__float_as_uint(t), __float_as_uint(t), false, false);
            const float ssv = __uint_as_float(t2[0]), dotv = __uint_as_float(t2[1]);
            const float rdv = add_x32(u3);
            scv = dotv * rsqrtf(ssv * (1.f / 64.f) + EPSV) + rdv;
        }
        float gm = max16(scv);
        { const auto r = __builtin_amdgcn_permlane16_swap(__float_as_uint(gm), __float_as_uint(gm), false, false); gm = fmaxf(__uint_as_float(r[0]), __uint_as_float(r[1])); }
        const float mn = fmaxf(m, gm);
        const float alpha = __builtin_amdgcn_exp2f(m - mn), pv = __builtin_amdgcn_exp2f(scv - mn);
        m = mn;
        lsum = lsum * alpha + pv;
        if (q4 < 2) { ((LAS float*)(lds + PT_OFF))[h * 32 + lane] = pv; if (lane == 0) ((LAS float*)(lds + AL_OFF))[h] = alpha; }
        if (g <= 60) SAMP_WAITV(10, 8); else if (g == 61) SAMP_WAITV(5, 4); else SAMP_WAITV(0, 0);
        SAMP_BAR();
        {
            u32x4 pw = {0u, 0u, 0u, 0u};
            if (i16 < 8) { const f32x4 pa = *(const LAS f32x4*)(lds + PT_OFF + (i16 * 32 + 8 * q4) * 4), pb_ = *(const LAS f32x4*)(lds + PT_OFF + (i16 * 32 + 8 * q4 + 4) * 4);
                pw.x = cvtpk(pa[0], pa[1]); pw.y = cvtpk(pa[2], pa[3]); pw.z = cvtpk(pb_[0], pb_[1]); pw.w = cvtpk(pb_[2], pb_[3]); }
            const bf16x8 pfr = __builtin_bit_cast(bf16x8, pw);
            const f32x4 al = *(const LAS f32x4*)(lds + AL_OFF + (q4 & 1) * 16);
            const unsigned tb0 = (unsigned)(size_t)((const LAS bf16_t*)(lds + TL_OFF + (g & 1) * 32 * CST * 2) + (8 * q4 + (i16 >> 2)) * CST + 32 * h + 4 * (i16 & 3));
            s16x4 c0[2], c1[2];
            static_assert(4 * CST * 2 == 2112, "tr offsets");
            asm volatile("ds_read_b64_tr_b16 %0, %4\n\tds_read_b64_tr_b16 %1, %4 offset:2112\n\tds_read_b64_tr_b16 %2, %4 offset:32\n\tds_read_b64_tr_b16 %3, %4 offset:2144\n\ts_waitcnt lgkmcnt(0)"
                         : "=&v"(c0[0]), "=&v"(c1[0]), "=&v"(c0[1]), "=&v"(c1[1]) : "v"(tb0) : "memory");
#pragma unroll
            for (int nt = 0; nt < 2; ++nt) {
                const bf16x8 cfr = __builtin_shufflevector(c0[nt], c1[nt], 0, 1, 2, 3, 4, 5, 6, 7);
                latv[nt] = latv[nt] * al;
                latv[nt] = __builtin_amdgcn_mfma_f32_16x16x32_bf16(pfr, cfr, latv[nt], 0, 0, 0);
            }
        }
        if (g + 1 < 64) samp_convert(g + 1, lds, tid);
    }
    lsum = add_x16(sum16(lsum));
    if (lane == 0) { float* o = a.part() + ((size_t)u * 8 + h) * 260; o[0] = m * 0.69314718f; o[1] = lsum; }
    if (q4 < 2) {
#pragma unroll
        for (int nt = 0; nt < 2; ++nt)
#pragma unroll
            for (int r = 0; r < 4; ++r) a.part()[((size_t)u * 8 + 4 * q4 + r) * 260 + 4 + 32 * h + 16 * nt + i16] = latv[nt][r];
    }
}
__device__ __forceinline__ void samp_comb_unit(const MK& a, int u, char* smem) {
    float* slat = (float*)smem;
    const int b = u >> 3, h = u & 7, tid = otid() & 255;
    const size_t row = NPT + b;
    const float* q = a.qh() + (row * 8 + h) * 96;
    float s_self = 0.f;
    for (int d = 0; d < 64; ++d) s_self += q[d] * a.kh()[(row * 8 + h) * 64 + d];
    for (int d = 0; d < 32; ++d) s_self += q[64 + d] * a.krf()[row * 32 + d];
    s_self *= 0.10206207261596577f;
    float m = s_self;
    for (int s = 0; s < 8; ++s) m = fmaxf(m, a.part()[((size_t)(b * 8 + s) * 8 + h) * 260]);
    const float pself = expf(s_self - m);
    float l = pself, lat = 0.f;
    for (int s = 0; s < 8; ++s) {
        const float* p = a.part() + ((size_t)(b * 8 + s) * 8 + h) * 260;
        const float w = expf(p[0] - m);
        l += p[1] * w; lat += p[4 + tid] * w;
    }
    __syncthreads();
    slat[tid] = lat;
    __syncthreads();
    if (tid < 64) {
        float o = 0.f;
        for (int c = 0; c < 256; ++c) o += slat[c] * a.w_kv_b[(size_t)c * 1024 + h * 128 + 64 + tid];
        o += pself * a.KV()[row * 1024 + h * 128 + 64 + tid];
        a.omix()[row * 1024 + 512 + h * 64 + tid] = f2bf(o / l);
    }
}

#define XB_TMO      128
#define XB_XCNT(j)  (256  + 64 * (j))
#define XB_XSUB(j)  (1280 + 64 * (j))
#define XB_XGEN(j)  (2304 + 64 * (j))
#define XB_TOP      3328
#define XB_TOPGEN   3392
#define XCD_BAR_WORDS 3456
#define XB_SPIN_CAP (1u << 18)

__device__ __forceinline__ unsigned xb_ld(unsigned* p)              { return __hip_atomic_load(p, __ATOMIC_RELAXED, __HIP_MEMORY_SCOPE_AGENT); }
__device__ __forceinline__ unsigned xb_add(unsigned* p, unsigned v) { return __hip_atomic_fetch_add(p, v, __ATOMIC_RELAXED, __HIP_MEMORY_SCOPE_AGENT); }
__device__ __forceinline__ unsigned xb_xcc_id() { return (unsigned)__builtin_amdgcn_s_getreg((3 << 11) | 20) & 0xFu; }
#define XB_SPIN(cond, bar) do { unsigned _sp = 0; while (cond) { __builtin_amdgcn_s_sleep(1); \
    if ((++_sp & 255u) == 0u) { if (xb_ld(&(bar)[XB_TMO])) break; if (_sp > XB_SPIN_CAP) { atomicAdd(&(bar)[XB_TMO], 1u); break; } } } } while (0)

struct XcdBarrier {
    unsigned* bar; unsigned x;
    volatile LAS unsigned* st;
};

__device__ __forceinline__ XcdBarrier xcd_barrier_post(unsigned* bar, volatile LAS unsigned* st) {
    XcdBarrier b; b.bar = bar; b.x = xb_xcc_id(); b.st = st;
    if (threadIdx.x == 0) (void)xb_add(&bar[XB_XCNT(b.x)], 1u);
    return b;
}
__device__ __forceinline__ void xcd_barrier_complete(unsigned* bar, unsigned x, unsigned& nloc, unsigned& nx) {
    const unsigned G = gridDim.x * gridDim.y * gridDim.z;
    unsigned sum, cnt, mine, sp = 0u;
    for (;;) {
        sum = 0u; cnt = 0u; mine = 0u;
#pragma unroll
        for (unsigned j = 0; j < 16; ++j) { const unsigned c = xb_ld(&bar[XB_XCNT(j)]); sum += c; cnt += (c > 0u) ? 1u : 0u; mine = (j == x) ? c : mine; }
        if (sum == G) break;
        __builtin_amdgcn_s_sleep(1);
        if ((++sp & 255u) == 0u) { if (xb_ld(&bar[XB_TMO])) break; if (sp > XB_SPIN_CAP) { atomicAdd(&bar[XB_TMO], 1u); break; } }
    }
    nloc = mine > 0u ? mine : 1u; nx = cnt > 0u ? cnt : 1u;
}

__device__ __forceinline__ void xcd_barrier(const XcdBarrier& b) {
    asm volatile("s_waitcnt vmcnt(0)" ::: "memory");
    __syncthreads();
    if (threadIdx.x == 0) {
        unsigned* bar = b.bar;
        __builtin_amdgcn_s_waitcnt(0);
        unsigned nloc = b.st[0], nx = b.st[1];
        if (nloc == 0u) { xcd_barrier_complete(bar, b.x, nloc, nx); b.st[0] = nloc; b.st[1] = nx; }
        const unsigned old = xb_add(&bar[XB_XSUB(b.x)], 1u);
        const unsigned gen = old / nloc;
        if (old + 1u == (gen + 1u) * nloc) {
            __builtin_amdgcn_fence(__ATOMIC_RELEASE, "agent");
            asm volatile("s_waitcnt vmcnt(0)" ::: "memory");
            const unsigned og = xb_add(&bar[XB_TOP], 1u);
            const unsigned tg = og / nx;
            if (og + 1u == (tg + 1u) * nx) xb_add(&bar[XB_TOPGEN], 1u);
            else XB_SPIN(xb_ld(&bar[XB_TOPGEN]) == tg, bar);
            __builtin_amdgcn_fence(__ATOMIC_ACQUIRE, "agent");
            xb_add(&bar[XB_XGEN(b.x)], 1u);
            asm volatile("s_waitcnt vmcnt(0)" ::: "memory");
        } else {
            XB_SPIN(xb_ld(&bar[XB_XGEN(b.x)]) == gen, bar);
            __builtin_amdgcn_fence(__ATOMIC_ACQUIRE, "agent");
            asm volatile("s_waitcnt vmcnt(0)" ::: "memory");
        }
    }
    __syncthreads();
}

__device__ __forceinline__ void late_weight_items(const MK& a, int gwl, int ngwl, float* scr, int lane) {
    const int T4 = 32 * 16, T5 = 176 * 16, T7 = 32 * 44, T8 = 32 * 16, TT = T4 + T5 + T7 + T8;
    for (int it = gwl; it < TT; it += ngwl) {
        int r = it;
        if (r < T4) { const int nt_ = r % 32, kb = r / 32; wt_item(a.w_o, 1024, 32 * nt_, 32, a.WoT(), 1024, 32 * nt_, 64 * kb, scr, lane); continue; } r -= T4;
        if (r < T5) { const int nt_ = r % 176, kb = r / 176, pn = nt_ >> 3, wi = nt_ & 7;
            wt_item(wi < 4 ? a.w_gate : a.w_up, DFF, pn * 128 + (wi & 3) * 32, 32, a.WguT(), 1024, 32 * nt_, 64 * kb, scr, lane); continue; } r -= T5;
        if (r < T7) { const int nt_ = r % 32, kb = r / 32; wt_item(a.w_down, 1024, 32 * nt_, 32, a.WdT(), DFF, 32 * nt_, 64 * kb, scr, lane); continue; } r -= T7;
        { const int nt_ = r % 32, kb = r / 32; wt_item(a.w_ple_gate, 1024, 32 * nt_, 32, a.WpgT(), 1024, 32 * nt_, 64 * kb, scr, lane); }
    }
}

#define XB_ST_OFF 155648
#define LDS_BYTES 155904
static_assert(SAMP_LDS_END <= LDS_BYTES, "LDS map");
#define GSYNC() do { xcd_barrier(xbar); } while (0)
__global__ __launch_bounds__(NTHR, 2) void mega(MK a) {
    cg::grid_group grid = cg::this_grid();
    char* smem = (char*)lds_raw;
    LAS unsigned char* lds = (LAS unsigned char*)lds_raw;
    otid_init();
    if (threadIdx.x < 2) ((LAS unsigned*)(lds_raw + XB_ST_OFF))[threadIdx.x] = 0u;
    __syncthreads();
    const XcdBarrier xbar = xcd_barrier_post(a.ctl(), (volatile LAS unsigned*)(LAS void*)(lds_raw + XB_ST_OFF));
    const int bid = blockIdx.x, nb = gridDim.x, ngw = nb * NWAVE;
#define LOCAL_IDS const int tid = otid(), lane = tid & 63, wid = tid >> 6, half = tid >> 8, gw = bid * NWAVE + wid; (void)lane; (void)half; (void)gw; (void)wid;

    {
    LOCAL_IDS
    {
        const int T0 = 88 * 16, T1 = 24 * 6, T2 = 32 * 4, T3 = 16 * 4, T9 = 32 * 4;
        const int TT = T0 + T1 + T2 + T3 + T9;
        float* scr = (float*)(smem + wid * 8704);
        for (int it = gw; it < TT; it += ngw) {
            int r = it;
            if (r < T0) { const int nt_ = r % 88, kb = r / 88, nv = 2736 - 32 * nt_; wt_item(a.w_in, 2736, 32 * nt_, nv < 0 ? 0 : (nv > 32 ? 32 : nv), a.WinT(), 1024, 32 * nt_, 64 * kb, scr, lane); continue; } r -= T0;
            if (r < T1) { const int nt_ = r % 24, kb = r / 24; wt_item(a.w_q_b, 768, 32 * nt_, 32, a.WqbT(), 384, 32 * nt_, 64 * kb, scr, lane); continue; } r -= T1;
            if (r < T2) { const int nt_ = r % 32, kb = r / 32; wt_item(a.w_kv_b, 1024, 32 * nt_, 32, a.WkvT(), 256, 32 * nt_, 64 * kb, scr, lane); continue; } r -= T2;
            if (r < T3) { const int nt_ = r % 16, kb = r / 16, h = nt_ >> 1; wt_item(a.w_kv_b, 1024, h * 128 + 32 * (nt_ & 1), 32, a.WknT(), 256, 32 * nt_, 64 * kb, scr, lane); continue; } r -= T3;
            { const int nt_ = r % 32, kb = r / 32; wt_item(a.w_ple_proj, 1024, 32 * nt_, 32, a.WppT(), 256, 32 * nt_, 64 * kb, scr, lane); }
        }
        for (int e = (bid * NTHR + tid); e < 2049 * 16; e += nb * NTHR) {
            const int pos = e >> 4, i = e & 15; const float ang = (pos == 2048 ? (float)PAST : (float)pos) * powf(10000.f, -(float)i / 16.f);
            a.ropecs()[pos * 32 + i] = cosf(ang); a.ropecs()[pos * 32 + 16 + i] = sinf(ang);
        }
        for (int row = gw; row < MPAD; row += ngw) {
            const float* src = row < NPT ? a.x_prompt + (size_t)row * 1024 : a.x_sample + (size_t)(row < NTOK ? row - NPT : 0) * 1024;
            rms1024_row(src, a.g_attn, a.xn() + (size_t)row * 1024, row >= NTOK, lane);
            ushort4 w = {0, 0, 0, 0};
            if (row < NTOK) { const float* ps = row < NPT ? a.p_prompt + (size_t)row * 256 : a.p_sample + (size_t)(row - NPT) * 256; const float4 v = *(const float4*)(ps + lane * 4); w.x = f2bf(v.x); w.y = f2bf(v.y); w.z = f2bf(v.z); w.w = f2bf(v.w); }
            *(ushort4*)(a.pb() + (size_t)row * 256 + lane * 4) = w;
            if (row >= NTOK) { for (int j = 0; j < 4; ++j) { ushort4 z = {0, 0, 0, 0}; *(ushort4*)(a.omix() + (size_t)row * 1024 + lane * 4 + 256 * j) = z; } }
        }
    }
    }
    if (a.out == nullptr) grid.sync();
    GSYNC();
    {
    LOCAL_IDS
    pg_gemm(lds, a.xn(), a.WinT(), NPT, ZW, 1024, PgBf16{a.Z(), ZW});
    gemm_sample_rows_ks<false>(a.xn(), 1024, a.WinT(), 1024, ZW, EwBf16{a.Z(), ZW}, smem, bid, nb);
    }
    GSYNC();
    {
    LOCAL_IDS
    for (int e = tid; e < 4 * 1536 / 4; e += NTHR) ((float4*)smem)[e] = ((const float4*)a.w_conv)[e];
    __syncthreads();
    for (int run = gw; run < NPT / 8 + NST; run += ngw) post_in_run(a, run, lane, (const float*)smem);
    }
    GSYNC();
    {
    LOCAL_IDS
    for (int u = gw; u < 2048; u += ngw) gdn_prep_unit(a, u, lane, smem + wid * GDN_WLDS);
    }
    {
    LOCAL_IDS
    for (int v = gw; v < NST * 64; v += ngw) gdn_unit(a, v >> 6, (v >> 3) & 7, v & 7, a.state_gdn, a.out + O_GSS, NPT, 1, lane, smem + wid * GDN_WLDS);
    __syncthreads();
    }
    GSYNC();
    {
    LOCAL_IDS
    pg_gemm(lds, a.qan(), a.WqbT(), NPT, 768, 384, PgBf16{a.qraw(), 768});
    pg_gemm(lds, a.ckvb(), a.WkvT(), NPT, 1024, 256, PgBf16{a.kvraw(), 1024}, nb > 64 ? nb - 64 : 0);
    gemm_sample_rows<false>(a.qan(), 384, a.WqbT(), 384, 768, EwF32{a.Q(), 768}, smem, bid, nb, 64);
    gemm_sample_rows<false>(a.ckvb(), 256, a.WkvT(), 256, 1024, EwF32{a.KV(), 1024}, smem, bid, nb, 72);
    for (int bh_ = nb - 1 - bid; bh_ < 64; bh_ += nb) gdn_scan_block(a, bh_, lds);
    if (nb > 64 && bid < nb - 64) {
        pg_gemm(lds, a.pb(), a.WppT(), NPT, 1024, 256, PgBf16{a.PP(), 1024}, nb - 64);
        __syncthreads();
        late_weight_items(a, bid * NWAVE + wid, (nb - 64) * NWAVE, (float*)(smem + wid * 8704), lane);
    } else if (nb <= 64) { pg_gemm(lds, a.pb(), a.WppT(), NPT, 1024, 256, PgBf16{a.PP(), 1024}); __syncthreads(); late_weight_items(a, gw, ngw, (float*)(smem + wid * 8704), lane); }
    gemm_sample_rows<false>(a.pb(), 256, a.WppT(), 256, 1024, EwBf16{a.PP(), 1024}, smem, bid, nb, 80);
    }
    GSYNC();
    {
    LOCAL_IDS
    for (int idx = gw; idx < NST * 8; idx += ngw) { post_q_item(a, NPT * 8 + idx, lane); post_kv_item(a, NPT * 8 + idx, lane); }
    for (int row = gw; row < NTOK; row += ngw) gdn_out_token(a, row, lane);
    for (int pr = bid; pr < 256; pr += nb) { const int bh_ = pr >> 2, s_ = pr & 3; attn_block(a, bh_ >> 3, bh_ & 7, 7 - s_, smem); attn_block(a, bh_ >> 3, bh_ & 7, s_, smem); }
    for (int u = bid; u < NST * 8; u += nb) samp_attn_unit(a, u, smem, lds);
    }
    GSYNC();
    {
    LOCAL_IDS
    for (int u0 = bid * 2; u0 < NST * 8; u0 += nb * 2) samp_comb_unit(a, u0 + half, smem + half * 4096);
    }
    GSYNC();
    {
    LOCAL_IDS
    pg_gemm(lds, a.omix(), a.WoT(), NPT, 1024, 1024, PgResXB{a.x_prompt, a.H()});
    gemm_sample_rows_ks<false>(a.omix(), 1024, a.WoT(), 1024, 1024, EwResX{a.x_sample, a.H()}, smem, bid, nb);
    }
    GSYNC();
    {
    LOCAL_IDS
    for (int row = gw; row < MPAD; row += ngw) rms1024_row_b(a.H() + (size_t)row * 1024, a.g_ffn, a.un() + (size_t)row * 1024, row >= NTOK, lane);
    }
    GSYNC();
    {
    LOCAL_IDS
    pg_gemm(lds, a.un(), a.WguT(), NPT, 2 * DFF, 1024, PgSwiglu{a.hid()});
    gemm_sample_rows_ks<true>(a.un(), 1024, a.WguT(), 1024, 2 * DFF, EwBf16{a.hid(), DFF}, smem, bid, nb);
    }
    GSYNC();
    {
    LOCAL_IDS
    pg_gemm(lds, a.hid(), a.WdT(), NPT, 1024, DFF, PgResBB{a.H(), a.H2()});
    gemm_sample_rows_ks<false>(a.hid(), DFF, a.WdT(), DFF, 1024, EwResH{a.H(), a.H2()}, smem, bid, nb);
    }
    GSYNC();
    {
    LOCAL_IDS
    for (int row = gw; row < MPAD; row += ngw) rms1024_row_b(a.H2() + (size_t)row * 1024, a.g_ple, a.un2() + (size_t)row * 1024, row >= NTOK, lane);
    }
    GSYNC();
    {
    LOCAL_IDS
    pg_gemm(lds, a.un2(), a.WpgT(), NPT, 1024, 1024, PgPleB{a.H2(), a.PP(), a.out});
    gemm_sample_rows_ks<false>(a.un2(), 1024, a.WpgT(), 1024, 1024, EwPle{a.H2(), a.PP(), a.out}, smem, bid, nb);
    }
}

static inline char* carve(char*& p, size_t bytes) { char* r = p; p += (bytes + 255) & ~(size_t)255; return r; }

extern "C" void kernel_launch(void* const* d_in, const int* in_sizes, int n_in, void* d_out, int out_size, void* d_ws, size_t ws_size, hipStream_t stream) {
    MK a{};
    a.x_prompt = (const float*)d_in[0]; a.x_sample = (const float*)d_in[1]; a.cache_ckv = (const float*)d_in[2]; a.cache_krope = (const float*)d_in[3];
    a.state_gdn = (const float*)d_in[4]; a.state_conv = (const float*)d_in[5]; a.page_table = (const int*)d_in[6]; a.p_prompt = (const float*)d_in[7]; a.p_sample = (const float*)d_in[8];
    a.g_attn = (const float*)d_in[9]; a.w_in = (const float*)d_in[10]; a.w_conv = (const float*)d_in[11]; a.a_log = (const float*)d_in[12]; a.dt_bias = (const float*)d_in[13];
    a.g_gdn_out = (const float*)d_in[14]; a.g_q_a = (const float*)d_in[15]; a.w_q_b = (const float*)d_in[16]; a.g_q_nope = (const float*)d_in[17]; a.g_q_rope = (const float*)d_in[18];
    a.g_kv_a = (const float*)d_in[19]; a.g_k_rope = (const float*)d_in[20]; a.w_kv_b = (const float*)d_in[21]; a.g_k_nope = (const float*)d_in[22]; a.w_o = (const float*)d_in[23];
    a.g_ffn = (const float*)d_in[24]; a.w_gate = (const float*)d_in[25]; a.w_up = (const float*)d_in[26]; a.w_down = (const float*)d_in[27]; a.g_ple = (const float*)d_in[28];
    a.w_ple_gate = (const float*)d_in[29]; a.w_ple_proj = (const float*)d_in[30];
    a.out = (float*)d_out;
    a.ws = (char*)d_ws;
    if (WS_TOTAL > ws_size) { fprintf(stderr, "kernel_launch: workspace too small: need %zu have %zu\n", (size_t)WS_TOTAL, ws_size); return; }

    static int grid_blocks = 0;
    if (!grid_blocks) {
        int dev = 0, cus = 0, per_cu = 0;
        (void)hipGetDevice(&dev);
        (void)hipDeviceGetAttribute(&cus, hipDeviceAttributeMultiprocessorCount, dev);
        (void)hipFuncSetAttribute((const void*)mega, hipFuncAttributeMaxDynamicSharedMemorySize, LDS_BYTES);
        (void)hipOccupancyMaxActiveBlocksPerMultiprocessor(&per_cu, (const void*)mega, NTHR, LDS_BYTES);
        if (per_cu < 1) fprintf(stderr, "kernel_launch: occupancy query says %d blocks/CU\n", per_cu);
        grid_blocks = cus;
    }
    (void)hipMemsetAsync((char*)d_ws + WOF_ctl, 0, 16384, stream);
    void* args[] = {&a};
    hipError_t e = hipLaunchCooperativeKernel((const void*)mega, dim3(grid_blocks), dim3(NTHR), args, LDS_BYTES, stream);
    if (e != hipSuccess) fprintf(stderr, "cooperative launch failed: %s (grid %d)\n", hipGetErrorString(e), grid_blocks);
}
```

```cpp
#include <hip/hip_runtime.h>
#include <stdint.h>
#include <cstdio>
#include <hip/hip_cooperative_groups.h>
namespace cg = cooperative_groups;


__device__ __forceinline__ int otid();
#define PG8_TID() otid()
namespace pg8 {
#define PG8_LAS __attribute__((address_space(3)))
typedef unsigned short bf16_t;
typedef short bf16x8 __attribute__((ext_vector_type(8)));
typedef float f32x4 __attribute__((ext_vector_type(4)));
typedef unsigned u32x4 __attribute__((ext_vector_type(4)));
constexpr int BM = 256, BK = 64, HALF = 128, HTB = HALF * BK * 2  , STAGE_BYTES = 8 * HTB, NXCD = 8, WGM = 8;

__host__ __device__ __forceinline__ int lds_byte(int r, int c) { const int st = (r >> 4) * 2 + (c >> 5), rr = r & 15, cc = c & 31, ob = rr * 64 + cc * 2; return st * 1024 + (ob ^ (((ob >> 9) & 1) << 5)); }
__host__ __device__ __forceinline__ void stage_rc(int b, int& R, int& C) { const int st = b / 1024, sb = b % 1024, swz = sb ^ (((sb >> 9) & 1) << 5); R = (st >> 1) * 16 + swz / 64; C = (st & 1) * 32 + (swz % 64) / 2; }
__host__ __device__ __forceinline__ int perm32(int rho) { const int n = rho >> 4, i = rho & 15; return 8 * (i >> 2) + 4 * n + (i & 3); }

struct Unit { int pm, pn; };
struct Gemm { const bf16_t* A; const bf16_t* Bt; int M, N, K; };

struct StaticOrder {
    int nM, nN, nwg, G, c;
    __host__ __device__ void init(int M, int N, int G_, int c_) { nM = M / BM; nN = N / BM; nwg = nM * nN; G = G_; c = c_; }
    __host__ __device__ bool next(int i, Unit& u) const {
        const long L = (long)i * G + c; if (L >= nwg) return false;
        int wgid = (int)L; { const int q = nwg / NXCD, r = nwg % NXCD, xcd = wgid % NXCD, off = wgid / NXCD; wgid = (xcd < r ? xcd * (q + 1) : r * (q + 1) + (xcd - r) * q) + off; }
        const int nig = WGM * nN, gid = wgid / nig, fm = gid * WGM, gsz = (nM - fm) < WGM ? (nM - fm) : WGM;
        u.pm = fm + ((wgid % nig) % gsz); u.pn = (wgid % nig) / gsz; return true;
    }
    __device__ __forceinline__ void a_ready(const Unit&) const {}
    __device__ __forceinline__ void done(const Unit&) const {}
};

template <class Epi, class Sched, bool ALIGN_EPI = false, bool SP2 = false>
__device__ __forceinline__ void gemm_phase(PG8_LAS unsigned char* lds, const Gemm g, const Sched& S, const Epi& E) {
    const int tid = PG8_TID(), wid = __builtin_amdgcn_readfirstlane(tid >> 6), lane = tid & 63, wr = wid >> 2, wc = wid & 3, fr = lane & 15, fq = lane >> 4;
    const int K = g.K, nt = K / BK;
    unsigned voffA[2], voffB[2];
#pragma unroll
    for (int i = 0; i < 2; ++i) { int R, C; stage_rc(tid * 16 + i * 8192, R, C); const int Rb = Epi::PERM ? ((R & ~31) + perm32(R & 31)) : R;
        voffA[i] = (unsigned)(R * K + C) * 2u; voffB[i] = (unsigned)(Rb * K + C) * 2u; }
    const size_t kstep = (size_t)(BK * 2);
    const size_t hstep = (size_t)HALF * K * 2;
    const size_t tstep = 2 * hstep;
    const unsigned ldsw = (unsigned)wid * 1024u;
    const int aoff = lds_byte(wr * 64 + fr, fq * 8), boff = lds_byte(wc * 32 + fr, fq * 8);
#define PG8_SA(b, h) (((b) * 2 + (h)) * HTB)
#define PG8_SB(b, h) ((4 + (b) * 2 + (h)) * HTB)
#define PG8_STAGE(bufoff, gbase, voff) do { _Pragma("unroll") for (int _i = 0; _i < 2; ++_i) \
        __builtin_amdgcn_global_load_lds((const unsigned*)((const char*)(gbase) + (voff)[_i]), (PG8_LAS unsigned*)(lds + (bufoff) + ldsw + _i * 8192), 16, 0, 0); } while (0)
#define PG8_LDA(dst, b, h) do { _Pragma("unroll") for (int m = 0; m < 4; ++m) _Pragma("unroll") for (int k = 0; k < 2; ++k) dst[m][k] = *(const PG8_LAS bf16x8*)(lds + PG8_SA(b, h) + aoff + m * 2048 + k * 1024); } while (0)
#define PG8_LDB(dst, b, h) do { _Pragma("unroll") for (int n = 0; n < 2; ++n) _Pragma("unroll") for (int k = 0; k < 2; ++k) dst[n][k] = *(const PG8_LAS bf16x8*)(lds + PG8_SB(b, h) + boff + n * 2048 + k * 1024); } while (0)
#define PG8_MMA(ai, bj, At, Bt) do { __builtin_amdgcn_s_setprio(1); _Pragma("unroll") for (int m = 0; m < 4; ++m) _Pragma("unroll") for (int n = 0; n < 2; ++n) _Pragma("unroll") for (int k = 0; k < 2; ++k) \
        acc[ai][bj][m][n] = __builtin_amdgcn_mfma_f32_16x16x32_bf16(Bt[n][k], At[m][k], acc[ai][bj][m][n], 0, 0, 0); __builtin_amdgcn_s_setprio(0); } while (0)
#define PG8_WAIT_V(n) asm volatile("s_waitcnt vmcnt(" #n ")" ::: "memory")
#define PG8_WAIT_L(n) asm volatile("s_waitcnt lgkmcnt(" #n ")" ::: "memory")
#define PG8_BAR __builtin_amdgcn_s_barrier()
#define PG8_SCHED __builtin_amdgcn_sched_barrier(0)
    Unit cur, nxt; int ui = 0;
    if (!S.next(0, cur)) return;
    f32x4 acc[2][2][4][2];
#pragma unroll
    for (int a = 0; a < 2; ++a)
#pragma unroll
        for (int b = 0; b < 2; ++b)
#pragma unroll
            for (int m = 0; m < 4; ++m)
#pragma unroll
                for (int n = 0; n < 2; ++n) acc[a][b][m][n] = (f32x4){0.f, 0.f, 0.f, 0.f};
    bf16x8 At[4][2], B0[2][2], B1[2][2];
    const char* cA = (const char*)g.A + (size_t)cur.pm * tstep; const char* cB = (const char*)g.Bt + (size_t)cur.pn * tstep;
    S.a_ready(cur);
    if constexpr (SP2) {
        PG8_STAGE(PG8_SB(0, 0), cB, voffB); PG8_STAGE(PG8_SB(0, 1), cB + hstep, voffB); PG8_STAGE(PG8_SA(0, 0), cA, voffA); PG8_STAGE(PG8_SA(0, 1), cA + hstep, voffA);
        if (wr == 1) PG8_BAR;
        PG8_WAIT_V(2); PG8_BAR;
        PG8_STAGE(PG8_SB(1, 0), cB + kstep, voffB); PG8_STAGE(PG8_SA(1, 0), cA + kstep, voffA); PG8_STAGE(PG8_SB(1, 1), cB + hstep + kstep, voffB);
        PG8_WAIT_V(6); PG8_BAR;
    } else {
        PG8_STAGE(PG8_SB(0, 0), cB, voffB); PG8_STAGE(PG8_SA(0, 0), cA, voffA); PG8_STAGE(PG8_SB(0, 1), cB + hstep, voffB); PG8_STAGE(PG8_SA(0, 1), cA + hstep, voffA);
        if (wr == 1) PG8_BAR;
        PG8_WAIT_V(4); PG8_BAR;
        PG8_STAGE(PG8_SB(1, 0), cB + kstep, voffB); PG8_STAGE(PG8_SA(1, 0), cA + kstep, voffA); PG8_STAGE(PG8_SB(1, 1), cB + hstep + kstep, voffB);
        PG8_WAIT_V(6); PG8_BAR;
    }
    for (;;) {
        const bool has_next = S.next(ui + 1, nxt);
        const char* nA = has_next ? (const char*)g.A + (size_t)nxt.pm * tstep : cA; const char* nB = has_next ? (const char*)g.Bt + (size_t)nxt.pn * tstep : cB;
        for (int t = 0; t < nt; t += 2) {
            const bool last = (t == nt - 2);
            const char* a1 = cA + (size_t)(t + 1) * kstep;
            const char* a2 = last ? nA : cA + (size_t)(t + 2) * kstep; const char* b2 = last ? nB : cB + (size_t)(t + 2) * kstep;
            const char* a3 = a2 + kstep; const char* b3 = b2 + kstep;
            if (last && has_next) S.a_ready(nxt);
            if constexpr (SP2) {
            PG8_LDB(B0, 0, 0); PG8_LDB(B1, 0, 1); PG8_SCHED; PG8_LDA(At, 0, 0); PG8_STAGE(PG8_SA(1, 1), a1 + hstep, voffA);
            PG8_WAIT_V(8); PG8_WAIT_L(0); PG8_BAR; PG8_MMA(0, 0, At, B0); PG8_MMA(0, 1, At, B1); PG8_BAR; PG8_SCHED;
            PG8_LDA(At, 0, 1); PG8_STAGE(PG8_SB(0, 0), b2, voffB); PG8_STAGE(PG8_SB(0, 1), b2 + hstep, voffB); PG8_STAGE(PG8_SA(0, 0), a2, voffA);
            PG8_WAIT_V(8); PG8_WAIT_L(0); PG8_BAR; PG8_MMA(1, 0, At, B0); PG8_MMA(1, 1, At, B1); PG8_BAR; PG8_SCHED;
            PG8_LDB(B0, 1, 0); PG8_LDB(B1, 1, 1); PG8_SCHED; PG8_LDA(At, 1, 0); PG8_STAGE(PG8_SA(0, 1), a2 + hstep, voffA);
            PG8_WAIT_V(8); PG8_WAIT_L(0); PG8_BAR; PG8_MMA(0, 0, At, B0); PG8_MMA(0, 1, At, B1); PG8_BAR; PG8_SCHED;
            PG8_LDA(At, 1, 1); PG8_STAGE(PG8_SB(1, 0), b3, voffB); PG8_STAGE(PG8_SB(1, 1), b3 + hstep, voffB); PG8_STAGE(PG8_SA(1, 0), a3, voffA);
            PG8_WAIT_V(8); PG8_WAIT_L(0); PG8_BAR; PG8_MMA(1, 0, At, B0); PG8_MMA(1, 1, At, B1); PG8_BAR; PG8_SCHED;
            } else {
            PG8_LDB(B0, 0, 0); PG8_SCHED; PG8_LDA(At, 0, 0); PG8_STAGE(PG8_SA(1, 1), a1 + hstep, voffA);
            PG8_WAIT_L(8); PG8_BAR; PG8_WAIT_L(0); PG8_MMA(0, 0, At, B0); PG8_BAR; PG8_SCHED;
            PG8_LDB(B1, 0, 1); PG8_STAGE(PG8_SB(0, 0), b2, voffB);
            PG8_BAR; PG8_WAIT_L(0); PG8_MMA(0, 1, At, B1); PG8_BAR;
            PG8_LDA(At, 0, 1); PG8_STAGE(PG8_SA(0, 0), a2, voffA);
            PG8_BAR; PG8_WAIT_L(0); PG8_MMA(1, 0, At, B0); PG8_BAR; PG8_SCHED;
            PG8_STAGE(PG8_SB(0, 1), b2 + hstep, voffB);
            PG8_WAIT_V(6); PG8_BAR; PG8_MMA(1, 1, At, B1); PG8_BAR;
            PG8_LDB(B0, 1, 0); PG8_SCHED; PG8_LDA(At, 1, 0); PG8_STAGE(PG8_SA(0, 1), a2 + hstep, voffA);
            PG8_WAIT_L(8); PG8_BAR; PG8_WAIT_L(0); PG8_MMA(0, 0, At, B0); PG8_BAR; PG8_SCHED;
            PG8_LDB(B1, 1, 1); PG8_STAGE(PG8_SB(1, 0), b3, voffB);
            PG8_BAR; PG8_WAIT_L(0); PG8_MMA(0, 1, At, B1); PG8_BAR;
            PG8_LDA(At, 1, 1); PG8_STAGE(PG8_SA(1, 0), a3, voffA);
            PG8_BAR; PG8_WAIT_L(0); PG8_MMA(1, 0, At, B0); PG8_BAR; PG8_SCHED;
            PG8_STAGE(PG8_SB(1, 1), b3 + hstep, voffB);
            PG8_WAIT_V(6); PG8_BAR; PG8_MMA(1, 1, At, B1); PG8_BAR;
            }
        }
        if constexpr (ALIGN_EPI) { if (wr == 0) PG8_BAR; }
        if constexpr (!Epi::AFTER_DRAIN) { E(acc, cur, wr, wc, fr, fq); S.done(cur); }
        if (!has_next) break;
#pragma unroll
        for (int a = 0; a < 2; ++a)
#pragma unroll
            for (int b = 0; b < 2; ++b)
#pragma unroll
                for (int m = 0; m < 4; ++m)
#pragma unroll
                    for (int n = 0; n < 2; ++n) acc[a][b][m][n] = (f32x4){0.f, 0.f, 0.f, 0.f};
        cur = nxt; cA = nA; cB = nB; ++ui;
        if constexpr (ALIGN_EPI) { if (wr == 1) PG8_BAR; }
    }
    PG8_WAIT_V(0);
    if constexpr (!ALIGN_EPI) { if (wr == 0) PG8_BAR; }
    PG8_BAR;
    if constexpr (Epi::AFTER_DRAIN) { E.fused(acc, cur, wr, wc, fr, fq, lds, wid, lane); S.done(cur); }
#undef PG8_SA
#undef PG8_SB
#undef PG8_STAGE
#undef PG8_LDA
#undef PG8_LDB
#undef PG8_MMA
#undef PG8_WAIT_V
#undef PG8_WAIT_L
#undef PG8_BAR
#undef PG8_SCHED
}
}

#define WTAB_OFF 155392
extern __shared__ __attribute__((aligned(16))) unsigned char lds_raw[];
__device__ __forceinline__ int hw_slot() { return (int)(__builtin_amdgcn_s_getreg((5 << 11) | 4) & 63u); }
__device__ __forceinline__ void otid_init() { const int t = threadIdx.x; if ((t & 63) == 0) ((__attribute__((address_space(3))) int*)(__attribute__((address_space(3))) void*)(lds_raw + WTAB_OFF))[hw_slot()] = t >> 6; }
__device__ __forceinline__ int otid() {
    const int w = __builtin_amdgcn_readfirstlane(((const __attribute__((address_space(3))) int*)(__attribute__((address_space(3))) void*)(lds_raw + WTAB_OFF))[hw_slot()]);
    int l; asm volatile("v_mbcnt_lo_u32_b32 %0, -1, 0\n\tv_mbcnt_hi_u32_b32 %0, -1, %0" : "=v"(l));
    return (w << 6) + l;
}
using pg8::bf16_t; using pg8::bf16x8; using pg8::f32x4; using pg8::u32x4;
#define LAS __attribute__((address_space(3)))

#define DMODEL 1024
#define NPT 16384
#define NST 32
#define NTOK 16416
#define MPAD 16640
#define SEQ 2048
#define ZW 2816
#define OFF_A 1536
#define OFF_B 1544
#define OFF_Z 1552
#define OFF_QA 2064
#define OFF_KVA 2448
#define OFF_KR 2704
#define DFF 2816
#define PAST 16384
#define NPAGES 128
#define EPSV 1e-6f

#define O_YP 0
#define O_YS (O_YP + 16777216)
#define O_CKVP (O_YS + 32768)
#define O_KRP (O_CKVP + 4194304)
#define O_GSP (O_KRP + 524288)
#define O_CSP (O_GSP + 262144)
#define O_CKVS (O_CSP + 36864)
#define O_KRS (O_CKVS + 8192)
#define O_GSS (O_KRS + 1024)
#define O_CSS (O_GSS + 1048576)

__device__ __forceinline__ bf16_t f2bf(float f) { unsigned u = __float_as_uint(f); return (bf16_t)((u + 0x7fffu + ((u >> 16) & 1u)) >> 16); }
__device__ __forceinline__ float bf2f(bf16_t b) { return __uint_as_float(((unsigned)b) << 16); }
template <int CTRL> __device__ __forceinline__ float dpp_mov(float x) { return __uint_as_float((unsigned)__builtin_amdgcn_update_dpp((int)__float_as_uint(x), (int)__float_as_uint(x), CTRL, 0xF, 0xF, true)); }
__device__ __forceinline__ float add_x16(float x) { auto r = __builtin_amdgcn_permlane16_swap(__float_as_uint(x), __float_as_uint(x), false, false); return __uint_as_float(r[0]) + __uint_as_float(r[1]); }
__device__ __forceinline__ float add_x32(float x) { auto r = __builtin_amdgcn_permlane32_swap(__float_as_uint(x), __float_as_uint(x), false, false); return __uint_as_float(r[0]) + __uint_as_float(r[1]); }
__device__ __forceinline__ float max_x32(float x) { auto r = __builtin_amdgcn_permlane32_swap(__float_as_uint(x), __float_as_uint(x), false, false); return fmaxf(__uint_as_float(r[0]), __uint_as_float(r[1])); }
__device__ __forceinline__ float sum8(float x) { x += dpp_mov<0xB1>(x); x += dpp_mov<0x4E>(x); x += dpp_mov<0x141>(x); return x; }
__device__ __forceinline__ float sum16(float x) { x = sum8(x); x += dpp_mov<0x140>(x); return x; }
__device__ __forceinline__ float max16(float x) { x = fmaxf(x, dpp_mov<0xB1>(x)); x = fmaxf(x, dpp_mov<0x4E>(x)); x = fmaxf(x, dpp_mov<0x141>(x)); x = fmaxf(x, dpp_mov<0x140>(x)); return x; }
__device__ __forceinline__ float wave_sum(float v) { return add_x32(add_x16(sum16(v))); }
__device__ __forceinline__ float sigmoidf_(float x) { return __builtin_amdgcn_rcpf(1.f + __builtin_amdgcn_exp2f(-1.44269504f * x)); }
__device__ __forceinline__ float siluf_(float x) { return x * __builtin_amdgcn_rcpf(1.f + __builtin_amdgcn_exp2f(-1.44269504f * x)); }


#define WSYNC() do { __builtin_amdgcn_fence(__ATOMIC_ACQ_REL, "wavefront"); __builtin_amdgcn_wave_barrier(); } while (0)
#define NTHR 512
#define NWAVE 8

typedef float f32x2_t __attribute__((ext_vector_type(2)));
typedef __bf16 bf16x2_t __attribute__((ext_vector_type(2)));
__device__ __forceinline__ unsigned cvtpk(float lo, float hi) { f32x2_t v = {lo, hi}; bf16x2_t r = __builtin_convertvector(v, bf16x2_t); return __builtin_bit_cast(unsigned, r); }
__device__ __forceinline__ void bf8_to_f32(const bf16x8& v, float* o) {
#pragma unroll
    for (int e = 0; e < 8; ++e) o[e] = __uint_as_float(((unsigned)(unsigned short)v[e]) << 16);
}
__device__ __forceinline__ bf16x8 f32_to_bf8(const float* x) {
    u32x4 w; w.x = cvtpk(x[0], x[1]); w.y = cvtpk(x[2], x[3]); w.z = cvtpk(x[4], x[5]); w.w = cvtpk(x[6], x[7]);
    return __builtin_bit_cast(bf16x8, w);
}
__device__ __forceinline__ unsigned pk2bf(float lo, float hi) { return (unsigned)f2bf(lo) | ((unsigned)f2bf(hi) << 16); }

__device__ __forceinline__ void wt_item(const float* __restrict__ W, int ldw, int col0, int nvalid, bf16_t* __restrict__ WT, int ldt, int nrow0, int k0, float* scr, int lane) {
    WSYNC();
#pragma unroll 8
    for (int i = 0; i < 32; ++i) { const int kk = 2 * i + (lane >> 5), n = lane & 31; scr[kk * 33 + n] = n < nvalid ? W[(size_t)(k0 + kk) * ldw + col0 + n] : 0.f; }
    WSYNC();
    const int c = lane & 7;
#pragma unroll
    for (int j = 0; j < 4; ++j) { const int n = (lane >> 3) + 8 * j; const float* sp = scr + (8 * c) * 33 + n;
        u32x4 o; o.x = cvtpk(sp[0], sp[33]); o.y = cvtpk(sp[2 * 33], sp[3 * 33]); o.z = cvtpk(sp[4 * 33], sp[5 * 33]); o.w = cvtpk(sp[6 * 33], sp[7 * 33]);
        *(u32x4*)(WT + (size_t)(nrow0 + n) * ldt + k0 + 8 * c) = o; }
}

__device__ __forceinline__ void rms1024_row(const float* __restrict__ src, const float* __restrict__ g, bf16_t* __restrict__ o, bool zero, int lane) {
    if (zero) { for (int j = 0; j < 4; ++j) { ushort4 z = {0, 0, 0, 0}; *(ushort4*)(o + lane * 4 + 256 * j) = z; } return; }
    float4 v[4]; float ss = 0.f;
#pragma unroll
    for (int j = 0; j < 4; ++j) { v[j] = *(const float4*)(src + lane * 4 + 256 * j); ss += v[j].x * v[j].x + v[j].y * v[j].y + v[j].z * v[j].z + v[j].w * v[j].w; }
    ss = wave_sum(ss);
    const float rs = rsqrtf(ss * (1.f / 1024.f) + EPSV);
#pragma unroll
    for (int j = 0; j < 4; ++j) {
        const float4 gg = *(const float4*)(g + lane * 4 + 256 * j);
        ushort4 w; w.x = f2bf(v[j].x * rs * gg.x); w.y = f2bf(v[j].y * rs * gg.y); w.z = f2bf(v[j].z * rs * gg.z); w.w = f2bf(v[j].w * rs * gg.w);
        *(ushort4*)(o + lane * 4 + 256 * j) = w;
    }
}

__device__ __forceinline__ void rms1024_row_b(const bf16_t* __restrict__ src, const float* __restrict__ g, bf16_t* __restrict__ o, bool zero, int lane) {
    if (zero) { for (int j = 0; j < 2; ++j) { const u32x4 z = {0u, 0u, 0u, 0u}; *(u32x4*)(o + lane * 8 + 512 * j) = z; } return; }
    float v[2][8]; float ss = 0.f;
#pragma unroll
    for (int j = 0; j < 2; ++j) { bf8_to_f32(*(const bf16x8*)(src + lane * 8 + 512 * j), v[j]);
#pragma unroll
        for (int e = 0; e < 8; ++e) ss += v[j][e] * v[j][e]; }
    ss = wave_sum(ss);
    const float rs = rsqrtf(ss * (1.f / 1024.f) + EPSV);
#pragma unroll
    for (int j = 0; j < 2; ++j) {
        const float4 g0 = *(const float4*)(g + lane * 8 + 512 * j), g1 = *(const float4*)(g + lane * 8 + 512 * j + 4);
        float t[8] = {v[j][0] * rs * g0.x, v[j][1] * rs * g0.y, v[j][2] * rs * g0.z, v[j][3] * rs * g0.w, v[j][4] * rs * g1.x, v[j][5] * rs * g1.y, v[j][6] * rs * g1.z, v[j][7] * rs * g1.w};
        *(bf16x8*)(o + lane * 8 + 512 * j) = f32_to_bf8(t);
    }
}

struct ABf16 { const bf16_t* p; int lda; __device__ __forceinline__ bf16x8 load(int m, int k) const { return *(const bf16x8*)(p + (size_t)m * lda + k); } };
template <bool SWIGLU, class Epi>
__device__ __forceinline__ void gemm_sample_rows(const bf16_t* __restrict__ A, int lda, const bf16_t* __restrict__ Bt, int K, int N, const Epi& epi, char*  , int bid, int nb, int first = -1) {
    const int tid = otid(), lane = tid & 63, wid = tid >> 6, i16 = lane & 15, q4 = lane >> 4;
    for (int u = first >= 0 ? (bid - first + nb) % nb : nb - 1 - bid; u < N / 256; u += nb) {
        const int n0 = u * 256;
        const int c0 = SWIGLU ? n0 + 16 * wid : n0 + 32 * wid, c1 = SWIGLU ? n0 + 128 + 16 * wid : n0 + 32 * wid + 16;
        const bf16_t* a0p = A + (size_t)(NPT + i16) * lda + 8 * q4; const bf16_t* a1p = a0p + (size_t)16 * lda;
        const bf16_t* b0p = Bt + (size_t)(c0 + i16) * K + 8 * q4; const bf16_t* b1p = Bt + (size_t)(c1 + i16) * K + 8 * q4;
        f32x4 acc[2][2];
#pragma unroll
        for (int i = 0; i < 2; ++i)
#pragma unroll
            for (int j = 0; j < 2; ++j) acc[i][j] = (f32x4){0.f, 0.f, 0.f, 0.f};
#pragma unroll 4
        for (int k0 = 0; k0 < K; k0 += 32) {
            const bf16x8 a0 = *(const bf16x8*)(a0p + k0), a1 = *(const bf16x8*)(a1p + k0), b0 = *(const bf16x8*)(b0p + k0), b1 = *(const bf16x8*)(b1p + k0);
            acc[0][0] = __builtin_amdgcn_mfma_f32_16x16x32_bf16(a0, b0, acc[0][0], 0, 0, 0); acc[0][1] = __builtin_amdgcn_mfma_f32_16x16x32_bf16(a0, b1, acc[0][1], 0, 0, 0);
            acc[1][0] = __builtin_amdgcn_mfma_f32_16x16x32_bf16(a1, b0, acc[1][0], 0, 0, 0); acc[1][1] = __builtin_amdgcn_mfma_f32_16x16x32_bf16(a1, b1, acc[1][1], 0, 0, 0);
        }
#pragma unroll
        for (int i = 0; i < 2; ++i)
#pragma unroll
            for (int r = 0; r < 4; ++r) {
                const int m = NPT + 16 * i + 4 * q4 + r;
                if constexpr (SWIGLU) epi(m, (n0 >> 1) + 16 * wid + i16, siluf_(acc[i][0][r]) * acc[i][1][r]);
                else { epi(m, c0 + i16, acc[i][0][r]); epi(m, c1 + i16, acc[i][1][r]); }
            }
    }
}
template <bool SWIGLU, class Epi>
__device__ __forceinline__ void gemm_sample_rows_ks(const bf16_t* __restrict__ A, int lda, const bf16_t* __restrict__ Bt, int K, int N, const Epi& epi, char* smem, int bid, int nb) {
    const int tid = otid(), lane = tid & 63, wid = tid >> 6, i16 = lane & 15, q4 = lane >> 4;
    const int nunits = N / 64, ksl = K >> 3;
    f32x4* red = (f32x4*)smem;
    for (int u = nb - 1 - bid; u < nunits; u += nb) {
        int brow[4];
#pragma unroll
        for (int j = 0; j < 4; ++j) brow[j] = SWIGLU ? ((32 * u) >> 7) * 256 + ((32 * u) & 127) + 128 * (j >> 1) + 16 * (j & 1) + i16 : 64 * u + 16 * j + i16;
        const bf16_t* a0p = A + (size_t)(NPT + i16) * lda + wid * ksl + 8 * q4; const bf16_t* a1p = a0p + (size_t)16 * lda;
        f32x4 acc[2][4];
#pragma unroll
        for (int i = 0; i < 2; ++i)
#pragma unroll
            for (int j = 0; j < 4; ++j) acc[i][j] = (f32x4){0.f, 0.f, 0.f, 0.f};
        for (int k0 = 0; k0 < ksl; k0 += 32) {
            const bf16x8 a0 = *(const bf16x8*)(a0p + k0), a1 = *(const bf16x8*)(a1p + k0);
            bf16x8 b[4];
#pragma unroll
            for (int j = 0; j < 4; ++j) b[j] = *(const bf16x8*)(Bt + (size_t)brow[j] * K + wid * ksl + 8 * q4 + k0);
#pragma unroll
            for (int j = 0; j < 4; ++j) { acc[0][j] = __builtin_amdgcn_mfma_f32_16x16x32_bf16(a0, b[j], acc[0][j], 0, 0, 0); acc[1][j] = __builtin_amdgcn_mfma_f32_16x16x32_bf16(a1, b[j], acc[1][j], 0, 0, 0); }
        }
        __syncthreads();
#pragma unroll
        for (int i = 0; i < 2; ++i)
#pragma unroll
            for (int j = 0; j < 4; ++j) red[(wid * 8 + i * 4 + j) * 64 + lane] = acc[i][j];
        __syncthreads();
        if constexpr (SWIGLU) {
            if (tid < 256) {
                const int t4 = tid >> 6, i = t4 >> 1, jg = t4 & 1, l = tid & 63;
                f32x4 g = red[(i * 4 + jg) * 64 + l], up = red[(i * 4 + jg + 2) * 64 + l];
#pragma unroll
                for (int w = 1; w < 8; ++w) { g = g + red[(w * 8 + i * 4 + jg) * 64 + l]; up = up + red[(w * 8 + i * 4 + jg + 2) * 64 + l]; }
#pragma unroll
                for (int r = 0; r < 4; ++r) epi(NPT + 16 * i + 4 * (l >> 4) + r, 32 * u + 16 * jg + (l & 15), siluf_(g[r]) * up[r]);
            }
        } else {
            const int t8 = tid >> 6, l = tid & 63, i = t8 >> 2, j = t8 & 3;
            f32x4 v = red[t8 * 64 + l];
#pragma unroll
            for (int w = 1; w < 8; ++w) v = v + red[(w * 8 + t8) * 64 + l];
#pragma unroll
            for (int r = 0; r < 4; ++r) epi(NPT + 16 * i + 4 * (l >> 4) + r, 64 * u + 16 * j + (l & 15), v[r]);
        }
    }
    __syncthreads();
}
struct EwF32 { float* C; int ldc; __device__ __forceinline__ void operator()(int m, int n, float v) const { C[(size_t)m * ldc + n] = v; } };
struct EwBf16 { bf16_t* C; int ldc; __device__ __forceinline__ void operator()(int m, int n, float v) const { C[(size_t)m * ldc + n] = f2bf(v); } };
struct EwResX { const float* xs; bf16_t* C; __device__ __forceinline__ void operator()(int m, int n, float v) const { C[(size_t)m * 1024 + n] = f2bf(xs[(size_t)(m - NPT) * 1024 + n] + v); } };
struct EwResH { const bf16_t* H; bf16_t* C; __device__ __forceinline__ void operator()(int m, int n, float v) const { C[(size_t)m * 1024 + n] = f2bf(bf2f(H[(size_t)m * 1024 + n]) + v); } };
struct EwPle { const bf16_t* H2; const bf16_t* PP; float* out;
    __device__ __forceinline__ void operator()(int m, int n, float v) const { out[O_YS + (size_t)(m - NPT) * 1024 + n] = bf2f(H2[(size_t)m * 1024 + n]) + bf2f(PP[(size_t)m * 1024 + n]) * sigmoidf_(v); } };

struct PgBf16 {
    static constexpr bool PERM = true, AFTER_DRAIN = false; bf16_t* O; int ldc;
    __device__ __forceinline__ void operator()(const f32x4 (&acc)[2][2][4][2], const pg8::Unit& u, int wr, int wc, int fr, int fq) const {
#pragma unroll
        for (int ai = 0; ai < 2; ++ai)
#pragma unroll
            for (int m = 0; m < 4; ++m) { bf16_t* rowp = O + (size_t)(u.pm * 256 + ai * 128 + wr * 64 + m * 16 + fr) * ldc + u.pn * 256 + wc * 32 + 8 * fq;
#pragma unroll
                for (int bj = 0; bj < 2; ++bj) { const f32x4 v0 = acc[ai][bj][m][0], v1 = acc[ai][bj][m][1]; u32x4 w; w.x = pk2bf(v0[0], v0[1]); w.y = pk2bf(v0[2], v0[3]); w.z = pk2bf(v1[0], v1[1]); w.w = pk2bf(v1[2], v1[3]); *(u32x4*)(rowp + bj * 128) = w; } }
    }
};
struct PgF32 {
    static constexpr bool PERM = false, AFTER_DRAIN = false; float* O; int ldc;
    __device__ __forceinline__ void operator()(const f32x4 (&acc)[2][2][4][2], const pg8::Unit& u, int wr, int wc, int fr, int fq) const {
#pragma unroll
        for (int ai = 0; ai < 2; ++ai)
#pragma unroll
            for (int m = 0; m < 4; ++m) { float* rowp = O + (size_t)(u.pm * 256 + ai * 128 + wr * 64 + m * 16 + fr) * ldc + u.pn * 256 + wc * 32 + 4 * fq;
#pragma unroll
                for (int bj = 0; bj < 2; ++bj)
#pragma unroll
                    for (int n = 0; n < 2; ++n) *(f32x4*)(rowp + bj * 128 + n * 16) = acc[ai][bj][m][n]; }
    }
};
struct PgSwiglu {
    static constexpr bool PERM = true, AFTER_DRAIN = false; bf16_t* Hd;
    __device__ __forceinline__ void operator()(const f32x4 (&acc)[2][2][4][2], const pg8::Unit& u, int wr, int wc, int fr, int fq) const {
#pragma unroll
        for (int ai = 0; ai < 2; ++ai)
#pragma unroll
            for (int m = 0; m < 4; ++m) { bf16_t* rowp = Hd + (size_t)(u.pm * 256 + ai * 128 + wr * 64 + m * 16 + fr) * DFF + u.pn * 128 + wc * 32 + 8 * fq;
                float h[8];
#pragma unroll
                for (int n = 0; n < 2; ++n)
#pragma unroll
                    for (int i = 0; i < 4; ++i) h[n * 4 + i] = siluf_(acc[ai][0][m][n][i]) * acc[ai][1][m][n][i];
                u32x4 w; w.x = pk2bf(h[0], h[1]); w.y = pk2bf(h[2], h[3]); w.z = pk2bf(h[4], h[5]); w.w = pk2bf(h[6], h[7]); *(u32x4*)rowp = w; }
    }
};
struct PgResXB {
    static constexpr bool PERM = true, AFTER_DRAIN = false; const float* R; bf16_t* O;
    __device__ __forceinline__ void operator()(const f32x4 (&acc)[2][2][4][2], const pg8::Unit& u, int wr, int wc, int fr, int fq) const {
#pragma unroll
        for (int ai = 0; ai < 2; ++ai)
#pragma unroll
            for (int m = 0; m < 4; ++m) { const size_t off = (size_t)(u.pm * 256 + ai * 128 + wr * 64 + m * 16 + fr) * 1024 + u.pn * 256 + wc * 32 + 8 * fq;
#pragma unroll
                for (int bj = 0; bj < 2; ++bj) { const f32x4 r0 = *(const f32x4*)(R + off + bj * 128), r1 = *(const f32x4*)(R + off + bj * 128 + 4), v0 = r0 + acc[ai][bj][m][0], v1 = r1 + acc[ai][bj][m][1];
                    u32x4 w; w.x = cvtpk(v0[0], v0[1]); w.y = cvtpk(v0[2], v0[3]); w.z = cvtpk(v1[0], v1[1]); w.w = cvtpk(v1[2], v1[3]); *(u32x4*)(O + off + bj * 128) = w; } }
    }
};
struct PgResBB {
    static constexpr bool PERM = true, AFTER_DRAIN = false; const bf16_t* R; bf16_t* O;
    __device__ __forceinline__ void operator()(const f32x4 (&acc)[2][2][4][2], const pg8::Unit& u, int wr, int wc, int fr, int fq) const {
#pragma unroll
        for (int ai = 0; ai < 2; ++ai)
#pragma unroll
            for (int m = 0; m < 4; ++m) { const size_t off = (size_t)(u.pm * 256 + ai * 128 + wr * 64 + m * 16 + fr) * 1024 + u.pn * 256 + wc * 32 + 8 * fq;
#pragma unroll
                for (int bj = 0; bj < 2; ++bj) { float r[8]; bf8_to_f32(*(const bf16x8*)(R + off + bj * 128), r); const f32x4 a0 = acc[ai][bj][m][0], a1 = acc[ai][bj][m][1];
                    u32x4 w; w.x = cvtpk(r[0] + a0[0], r[1] + a0[1]); w.y = cvtpk(r[2] + a0[2], r[3] + a0[3]); w.z = cvtpk(r[4] + a1[0], r[5] + a1[1]); w.w = cvtpk(r[6] + a1[2], r[7] + a1[3]); *(u32x4*)(O + off + bj * 128) = w; } }
    }
};
struct PgPleB {
    static constexpr bool PERM = true, AFTER_DRAIN = false; const bf16_t* H2; const bf16_t* PP; float* out;
    __device__ __forceinline__ void operator()(const f32x4 (&acc)[2][2][4][2], const pg8::Unit& u, int wr, int wc, int fr, int fq) const {
#pragma unroll
        for (int ai = 0; ai < 2; ++ai)
#pragma unroll
            for (int m = 0; m < 4; ++m) { const size_t off = (size_t)(u.pm * 256 + ai * 128 + wr * 64 + m * 16 + fr) * 1024 + u.pn * 256 + wc * 32 + 8 * fq;
#pragma unroll
                for (int bj = 0; bj < 2; ++bj) { float h[8], pp[8]; bf8_to_f32(*(const bf16x8*)(H2 + off + bj * 128), h); bf8_to_f32(*(const bf16x8*)(PP + off + bj * 128), pp);
                    const f32x4 a0 = acc[ai][bj][m][0], a1 = acc[ai][bj][m][1]; f32x4 y0, y1;
#pragma unroll
                    for (int i = 0; i < 4; ++i) { y0[i] = h[i] + pp[i] * sigmoidf_(a0[i]); y1[i] = h[4 + i] + pp[4 + i] * sigmoidf_(a1[i]); }
                    *(f32x4*)(out + O_YP + off + bj * 128) = y0; *(f32x4*)(out + O_YP + off + bj * 128 + 4) = y1; } }
    }
};
template <class Epi>
__device__ __forceinline__ void pg_gemm(LAS unsigned char* lds, const bf16_t* A, const bf16_t* Bt, int M, int N, int K, const Epi& E, int glow = 0) {
    pg8::Gemm g{A, Bt, M, N, K}; pg8::StaticOrder S;
    if (glow > 0) { if ((int)blockIdx.x >= glow) return; S.init(M, N, glow, (int)blockIdx.x); }
    else S.init(M, N, (int)gridDim.x, (int)blockIdx.x);
    pg8::gemm_phase<Epi, pg8::StaticOrder, true, true>(lds, g, S, E);
}

constexpr size_t WOF_WinT = 0ull;
constexpr size_t WOF_WqbT = 5767168ull;
constexpr size_t WOF_WkvT = 6356992ull;
constexpr size_t WOF_WknT = 6881280ull;
constexpr size_t WOF_WoT = 7143424ull;
constexpr size_t WOF_WguT = 9240576ull;
constexpr size_t WOF_WdT = 20774912ull;
constexpr size_t WOF_WpgT = 26542080ull;
constexpr size_t WOF_WppT = 28639232ull;
constexpr size_t WOF_xn = 29163520ull;
constexpr size_t WOF_pb = 63242240ull;
constexpr size_t WOF_Z = 71761920ull;
constexpr size_t WOF_qkv = 165478400ull;
constexpr size_t WOF_ropecs = 216596480ull;
constexpr size_t WOF_gg = 216858880ull;
constexpr size_t WOF_bb = 217391360ull;
constexpr size_t WOF_goraw = 217923840ull;
constexpr size_t WOF_gUT = 252002560ull;
constexpr size_t WOF_ggam = 285556992ull;
constexpr size_t WOF_gWn = 285565184ull;
constexpr size_t WOF_gQg = 302342400ull;
constexpr size_t WOF_gQK = 319119616ull;
constexpr size_t WOF_gKd = 335896832ull;
constexpr size_t WOF_qan = 352674048ull;
constexpr size_t WOF_ckvb = 365453568ull;
constexpr size_t WOF_krf = 373973248ull;
constexpr size_t WOF_Q = 376103168ull;
constexpr size_t WOF_qh = 427221248ull;
constexpr size_t WOF_KV = 478339328ull;
constexpr size_t WOF_kh = 546496768ull;
constexpr size_t WOF_omix = 580575488ull;
constexpr size_t WOF_KN = 614654208ull;
constexpr size_t WOF_SC = 1151525120ull;
constexpr size_t WOF_part = 1168302336ull;
constexpr size_t WOF_H = 1170432256ull;
constexpr size_t WOF_un = 1238589696ull;
constexpr size_t WOF_G = 1272668416ull;
constexpr size_t WOF_hid = 1273028864ull;
constexpr size_t WOF_H2 = 1366745344ull;
constexpr size_t WOF_un2 = 1434902784ull;
constexpr size_t WOF_PP = 1468981504ull;
constexpr size_t WOF_qraw = 1537138944ull;
constexpr size_t WOF_kvraw = 1562304768ull;
constexpr size_t WOF_krb = 1595859200ull;
constexpr size_t WOF_ctl = 1596907776ull;
constexpr size_t WS_TOTAL = 1596924160ull;
struct MK {
    const float *x_prompt, *x_sample, *cache_ckv, *cache_krope, *state_gdn, *state_conv; const int* page_table; const float *p_prompt, *p_sample;
    const float *g_attn, *w_in, *w_conv, *a_log, *dt_bias, *g_gdn_out, *g_q_a, *w_q_b, *g_q_nope, *g_q_rope, *g_kv_a, *g_k_rope, *w_kv_b, *g_k_nope, *w_o, *g_ffn, *w_gate, *w_up, *w_down, *g_ple, *w_ple_gate, *w_ple_proj;
    float* out; char* ws;
    __device__ __forceinline__ unsigned* ctl() const { return (unsigned*)(ws + WOF_ctl); }
    __device__ __forceinline__ bf16_t* WinT() const { return (bf16_t*)(ws + WOF_WinT); }
    __device__ __forceinline__ bf16_t* WqbT() const { return (bf16_t*)(ws + WOF_WqbT); }
    __device__ __forceinline__ bf16_t* WkvT() const { return (bf16_t*)(ws + WOF_WkvT); }
    __device__ __forceinline__ bf16_t* WknT() const { return (bf16_t*)(ws + WOF_WknT); }
    __device__ __forceinline__ bf16_t* WoT() const { return (bf16_t*)(ws + WOF_WoT); }
    __device__ __forceinline__ bf16_t* WguT() const { return (bf16_t*)(ws + WOF_WguT); }
    __device__ __forceinline__ bf16_t* WdT() const { return (bf16_t*)(ws + WOF_WdT); }
    __device__ __forceinline__ bf16_t* WpgT() const { return (bf16_t*)(ws + WOF_WpgT); }
    __device__ __forceinline__ bf16_t* WppT() const { return (bf16_t*)(ws + WOF_WppT); }
    __device__ __forceinline__ bf16_t* xn() const { return (bf16_t*)(ws + WOF_xn); }
    __device__ __forceinline__ bf16_t* pb() const { return (bf16_t*)(ws + WOF_pb); }
    __device__ __forceinline__ bf16_t* Z() const { return (bf16_t*)(ws + WOF_Z); }
    __device__ __forceinline__ bf16_t* qkv() const { return (bf16_t*)(ws + WOF_qkv); }
    __device__ __forceinline__ float* ropecs() const { return (float*)(ws + WOF_ropecs); }
    __device__ __forceinline__ float* gg() const { return (float*)(ws + WOF_gg); }
    __device__ __forceinline__ float* bb() const { return (float*)(ws + WOF_bb); }
    __device__ __forceinline__ float* goraw() const { return (float*)(ws + WOF_goraw); }
    __device__ __forceinline__ float* gUT() const { return (float*)(ws + WOF_gUT); }
    __device__ __forceinline__ float* ggam() const { return (float*)(ws + WOF_ggam); }
    __device__ __forceinline__ bf16_t* gWn() const { return (bf16_t*)(ws + WOF_gWn); }
    __device__ __forceinline__ bf16_t* gQg() const { return (bf16_t*)(ws + WOF_gQg); }
    __device__ __forceinline__ bf16_t* gQK() const { return (bf16_t*)(ws + WOF_gQK); }
    __device__ __forceinline__ bf16_t* gKd() const { return (bf16_t*)(ws + WOF_gKd); }
    __device__ __forceinline__ bf16_t* qan() const { return (bf16_t*)(ws + WOF_qan); }
    __device__ __forceinline__ bf16_t* ckvb() const { return (bf16_t*)(ws + WOF_ckvb); }
    __device__ __forceinline__ float* krf() const { return (float*)(ws + WOF_krf); }
    __device__ __forceinline__ float* Q() const { return (float*)(ws + WOF_Q); }
    __device__ __forceinline__ float* qh() const { return (float*)(ws + WOF_qh); }
    __device__ __forceinline__ float* KV() const { return (float*)(ws + WOF_KV); }
    __device__ __forceinline__ float* kh() const { return (float*)(ws + WOF_kh); }
    __device__ __forceinline__ bf16_t* omix() const { return (bf16_t*)(ws + WOF_omix); }
    __device__ __forceinline__ bf16_t* KN() const { return (bf16_t*)(ws + WOF_KN); }
    __device__ __forceinline__ float* SC() const { return (float*)(ws + WOF_SC); }
    __device__ __forceinline__ float* part() const { return (float*)(ws + WOF_part); }
    __device__ __forceinline__ bf16_t* H() const { return (bf16_t*)(ws + WOF_H); }
    __device__ __forceinline__ bf16_t* un() const { return (bf16_t*)(ws + WOF_un); }
    __device__ __forceinline__ float* G() const { return (float*)(ws + WOF_G); }
    __device__ __forceinline__ bf16_t* hid() const { return (bf16_t*)(ws + WOF_hid); }
    __device__ __forceinline__ bf16_t* H2() const { return (bf16_t*)(ws + WOF_H2); }
    __device__ __forceinline__ bf16_t* un2() const { return (bf16_t*)(ws + WOF_un2); }
    __device__ __forceinline__ bf16_t* PP() const { return (bf16_t*)(ws + WOF_PP); }
    __device__ __forceinline__ bf16_t* qraw() const { return (bf16_t*)(ws + WOF_qraw); }
    __device__ __forceinline__ bf16_t* kvraw() const { return (bf16_t*)(ws + WOF_kvraw); }
    __device__ __forceinline__ bf16_t* krb() const { return (bf16_t*)(ws + WOF_krb); }
};

__device__ __forceinline__ float fast_sigmoid(float x) { return __builtin_amdgcn_rcpf(1.f + __builtin_amdgcn_exp2f(-1.44269504f * x)); }
struct PinTok { bf16x8 qa, cv, kr; float ab; };
struct PinGain { float gqa[8], gkv[8], gkr[8], dtb, alog; };
__device__ __forceinline__ PinTok pin_load(const MK& a, int row, int lane) {
    const bf16_t* z = a.Z() + (size_t)row * ZW; PinTok t; const bf16x8 zz = {0, 0, 0, 0, 0, 0, 0, 0};
    t.qa = lane < 48 ? *(const bf16x8*)(z + OFF_QA + 8 * lane) : zz; t.cv = lane < 32 ? *(const bf16x8*)(z + OFF_KVA + 8 * lane) : zz;
    t.kr = (lane >= 32 && lane < 36) ? *(const bf16x8*)(z + OFF_KR + 8 * (lane - 32)) : zz; t.ab = lane < 16 ? bf2f(z[OFF_A + lane]) : 0.f; return t;
}
__device__ __forceinline__ void post_in_token(const MK& a, int row, int lane, const float* wcs, const bf16x8 (&w0)[3], const bf16x8 (&w1)[3], const bf16x8 (&w2)[3], const bf16x8 (&wcur)[3], const PinTok& tk, const PinGain& gn) {
    const bool samp = row >= NPT;
    const int b = samp ? row - NPT : row >> 11, t = samp ? 0 : row & 2047, hd = lane >> 3;
    float y[24];
#pragma unroll
    for (int c3 = 0; c3 < 3; ++c3) {
        float p0[8], p1[8], p2[8], cu[8];
        bf8_to_f32(w0[c3], p0); bf8_to_f32(w1[c3], p1); bf8_to_f32(w2[c3], p2); bf8_to_f32(wcur[c3], cu);
        const float* wp = wcs + 512 * c3 + 8 * lane;
        const float4 a0 = *(const float4*)wp, a1 = *(const float4*)(wp + 4), b0 = *(const float4*)(wp + 1536), b1 = *(const float4*)(wp + 1540);
        const float4 c0 = *(const float4*)(wp + 3072), c1 = *(const float4*)(wp + 3076), d0 = *(const float4*)(wp + 4608), d1 = *(const float4*)(wp + 4612);
        const float k0[8] = {a0.x, a0.y, a0.z, a0.w, a1.x, a1.y, a1.z, a1.w}, k1[8] = {b0.x, b0.y, b0.z, b0.w, b1.x, b1.y, b1.z, b1.w};
        const float k2[8] = {c0.x, c0.y, c0.z, c0.w, c1.x, c1.y, c1.z, c1.w}, k3[8] = {d0.x, d0.y, d0.z, d0.w, d1.x, d1.y, d1.z, d1.w};
#pragma unroll
        for (int e = 0; e < 8; ++e) { const int c = 8 * c3 + e; const float v = k0[e] * p0[e] + k1[e] * p1[e] + k2[e] * p2[e] + k3[e] * cu[e]; y[c] = v * fast_sigmoid(v); }
        __builtin_amdgcn_sched_barrier(0);
    }
    float sq = 0.f, sk = 0.f;
#pragma unroll
    for (int e = 0; e < 8; ++e) { sq += y[e] * y[e]; sk += y[8 + e] * y[8 + e]; }
    sq = sum8(sq); sk = sum8(sk);
    const float rq = rsqrtf(sq + EPSV) * 0.125f, rk = rsqrtf(sk + EPSV);
#pragma unroll
    for (int e = 0; e < 8; ++e) { y[e] *= rq; y[8 + e] *= rk; }
    bf16_t* qo = a.qkv() + (size_t)row * 1536 + 8 * lane;
    *(bf16x8*)qo = f32_to_bf8(y); *(bf16x8*)(qo + 512) = f32_to_bf8(y + 8); *(bf16x8*)(qo + 1024) = f32_to_bf8(y + 16);
    if (!samp && t >= SEQ - 3) {
        float* cso = a.out + O_CSP + ((size_t)b * 3 + (t - (SEQ - 3))) * 1536 + 8 * lane;
#pragma unroll
        for (int j = 0; j < 3; ++j) { float cu[8]; bf8_to_f32(wcur[j], cu); *(float4*)(cso + 512 * j) = (float4){cu[0], cu[1], cu[2], cu[3]}; *(float4*)(cso + 512 * j + 4) = (float4){cu[4], cu[5], cu[6], cu[7]}; }
    }
    if (lane < 16) {
        const float v = tk.ab;
        if (lane < 8) { const float xx = v + gn.dtb; const float sp = xx > 20.f ? xx : 0.69314718f * __builtin_amdgcn_logf(1.f + __builtin_amdgcn_exp2f(1.44269504f * xx)); a.gg()[(size_t)row * 8 + lane] = -gn.alog * sp; }
        else a.bb()[(size_t)row * 8 + lane - 8] = sigmoidf_(v);
    }
    __builtin_amdgcn_sched_barrier(0);
    float qa[8], cv[8], kr[8];
    bf8_to_f32(tk.qa, qa); bf8_to_f32(tk.cv, cv); bf8_to_f32(tk.kr, kr);
    float s1 = 0.f, s2 = 0.f, s3 = 0.f;
#pragma unroll
    for (int e = 0; e < 8; ++e) { s1 += qa[e] * qa[e]; s2 += cv[e] * cv[e]; s3 += kr[e] * kr[e]; }
    s1 = wave_sum(s1); s2 = wave_sum(s2); s3 = wave_sum(s3);
    const float r1 = rsqrtf(s1 * (1.f / 384.f) + EPSV), r2 = rsqrtf(s2 * (1.f / 256.f) + EPSV), r3 = rsqrtf(s3 * (1.f / 32.f) + EPSV);
    if (lane < 48) {
        float o[8];
#pragma unroll
        for (int e = 0; e < 8; ++e) o[e] = qa[e] * r1 * gn.gqa[e];
        *(bf16x8*)(a.qan() + (size_t)row * 384 + 8 * lane) = f32_to_bf8(o);
    }
    if (lane < 32) {
        float o[8];
#pragma unroll
        for (int e = 0; e < 8; ++e) o[e] = cv[e] * r2 * gn.gkv[e];
        *(bf16x8*)(a.ckvb() + (size_t)row * 256 + 8 * lane) = f32_to_bf8(o);
        float* co = samp ? a.out + O_CKVS + (size_t)b * 256 + 8 * lane : a.out + O_CKVP + (size_t)row * 256 + 8 * lane;
        *(float4*)co = (float4){o[0], o[1], o[2], o[3]}; *(float4*)(co + 4) = (float4){o[4], o[5], o[6], o[7]};
    }
    __builtin_amdgcn_sched_barrier(0);
    {
        const int c4 = (lane - 32) & 3;
        float xn[8], ot[8];
#pragma unroll
        for (int e = 0; e < 8; ++e) xn[e] = kr[e] * r3 * gn.gkr[e];
#pragma unroll
        for (int e = 0; e < 8; ++e) ot[e] = dpp_mov<0x4E>(xn[e]);
        if (lane >= 32 && lane < 36) {
            const float* tb = a.ropecs() + (size_t)(samp ? 2048 : t) * 32 + ((8 * c4) & 15);
            const float4 c0 = *(const float4*)tb, c1 = *(const float4*)(tb + 4), s0 = *(const float4*)(tb + 16), s1 = *(const float4*)(tb + 20);
            const float csv[8] = {c0.x, c0.y, c0.z, c0.w, c1.x, c1.y, c1.z, c1.w}, snv[8] = {s0.x, s0.y, s0.z, s0.w, s1.x, s1.y, s1.z, s1.w};
            float o[8];
#pragma unroll
            for (int e = 0; e < 8; ++e) o[e] = c4 < 2 ? xn[e] * csv[e] - ot[e] * snv[e] : ot[e] * snv[e] + xn[e] * csv[e];
            float* kf_ = a.krf() + (size_t)row * 32 + 8 * c4; *(float4*)kf_ = (float4){o[0], o[1], o[2], o[3]}; *(float4*)(kf_ + 4) = (float4){o[4], o[5], o[6], o[7]};
            float* ko = samp ? a.out + O_KRS + (size_t)b * 32 + 8 * c4 : a.out + O_KRP + (size_t)row * 32 + 8 * c4;
            *(float4*)ko = (float4){o[0], o[1], o[2], o[3]}; *(float4*)(ko + 4) = (float4){o[4], o[5], o[6], o[7]};
            if (!samp) *(bf16x8*)(a.krb() + (size_t)row * 32 + 8 * c4) = f32_to_bf8(o);
        }
    }
    (void)hd;
}
__device__ __forceinline__ void post_in_run(const MK& a, int run, int lane_in, const float* wcs) {
    int lane = lane_in; asm volatile("" : "+v"(lane));
    PinGain gn;
    {
        const int lq = lane < 48 ? lane : 0, lk = lane < 32 ? lane : 0, c4 = (lane - 32) & 3;
#pragma unroll
        for (int e = 0; e < 8; ++e) { gn.gqa[e] = a.g_q_a[8 * lq + e]; gn.gkv[e] = a.g_kv_a[8 * lk + e]; gn.gkr[e] = a.g_k_rope[8 * c4 + e]; }
        gn.dtb = a.dt_bias[lane & 7]; gn.alog = expf(a.a_log[lane & 7]);
    }
    if (run < NPT / 8) {
        const int row0 = run * 8, t0 = row0 & 2047;
        bf16x8 w0[3], w1[3], w2[3], wcur[3];
#pragma unroll
        for (int c3 = 0; c3 < 3; ++c3) {
            const bf16x8 zz = {0, 0, 0, 0, 0, 0, 0, 0}; w0[c3] = zz; w1[c3] = zz; w2[c3] = zz;
            if (t0 > 0) { const bf16_t* zp = a.Z() + (size_t)(row0 - 3) * ZW + 512 * c3 + 8 * lane; w0[c3] = *(const bf16x8*)zp; w1[c3] = *(const bf16x8*)(zp + ZW); w2[c3] = *(const bf16x8*)(zp + 2 * ZW); }
        }
        bf16x8 wnext[3]; PinTok tk, tkn;
#pragma unroll
        for (int c3 = 0; c3 < 3; ++c3) wnext[c3] = *(const bf16x8*)(a.Z() + (size_t)row0 * ZW + 512 * c3 + 8 * lane);
        tkn = pin_load(a, row0, lane);
#pragma unroll 1
        for (int k = 0; k < 8; ++k) {
            const int row = row0 + k;
#pragma unroll
            for (int c3 = 0; c3 < 3; ++c3) wcur[c3] = wnext[c3];
            tk = tkn;
            if (k < 7) {
#pragma unroll
                for (int c3 = 0; c3 < 3; ++c3) wnext[c3] = *(const bf16x8*)(a.Z() + (size_t)(row + 1) * ZW + 512 * c3 + 8 * lane);
                tkn = pin_load(a, row + 1, lane);
            }
            post_in_token(a, row, lane, wcs, w0, w1, w2, wcur, tk, gn);
#pragma unroll
            for (int c3 = 0; c3 < 3; ++c3) { w0[c3] = w1[c3]; w1[c3] = w2[c3]; w2[c3] = wcur[c3]; }
        }
    } else {
        {
            const int bsm = run - NPT / 8, row = NPT + bsm;
            bf16x8 w0[3], w1[3], w2[3], wcur[3];
#pragma unroll
            for (int c3 = 0; c3 < 3; ++c3) {
                const float* sp = a.state_conv + (size_t)bsm * 3 * 1536 + 512 * c3 + 8 * lane;
                float* cso = a.out + O_CSS + (size_t)bsm * 3 * 1536 + 512 * c3 + 8 * lane;
                float t0_[8], t1_[8], t2_[8], tc_[8];
#pragma unroll
                for (int e = 0; e < 8; ++e) { t0_[e] = sp[e]; t1_[e] = sp[1536 + e]; t2_[e] = sp[2 * 1536 + e]; }
                wcur[c3] = *(const bf16x8*)(a.Z() + (size_t)row * ZW + 512 * c3 + 8 * lane); bf8_to_f32(wcur[c3], tc_);
#pragma unroll
                for (int e = 0; e < 8; ++e) { cso[e] = t1_[e]; cso[1536 + e] = t2_[e]; cso[2 * 1536 + e] = tc_[e]; }
                w0[c3] = f32_to_bf8(t0_); w1[c3] = f32_to_bf8(t1_); w2[c3] = f32_to_bf8(t2_);
            }
            post_in_token(a, row, lane, wcs, w0, w1, w2, wcur, pin_load(a, row, lane), gn);
        }
    }
}

__device__ __forceinline__ void post_q_item(const MK& a, int idx, int lane) {
    const int row = idx >> 3, h = idx & 7;
    const float* q = a.Q() + (size_t)row * 768 + h * 96;
    float* o = a.qh() + ((size_t)row * 8 + h) * 96;
    const float v = q[lane];
    const float ss = wave_sum(v * v);
    o[lane] = v * rsqrtf(ss * (1.f / 64.f) + EPSV) * a.g_q_nope[lane];
    const float r = lane < 32 ? q[64 + lane] : 0.f;
    const float s2 = wave_sum(r * r);
    const float xn = lane < 32 ? r * rsqrtf(s2 * (1.f / 32.f) + EPSV) * a.g_q_rope[lane] : 0.f;
    const float other = __shfl_xor(xn, 16);
    const int i = lane & 15;
    const float* tb = a.ropecs() + (size_t)(row >= NPT ? 2048 : (row & 2047)) * 32;
    const float cs = tb[i], sn = tb[16 + i];
    const float ov = lane < 16 ? xn * cs - other * sn : other * sn + xn * cs;
    if (lane < 32) o[64 + lane] = ov;
}
__device__ __forceinline__ void post_kv_item(const MK& a, int idx, int lane) {
    const int row = idx >> 3, h = idx & 7;
    const float v = a.KV()[(size_t)row * 1024 + h * 128 + lane];
    const float ss = wave_sum(v * v);
    const float kn = v * rsqrtf(ss * (1.f / 64.f) + EPSV) * a.g_k_nope[lane];
    a.kh()[((size_t)row * 8 + h) * 64 + lane] = kn;
}

typedef float f32x16 __attribute__((ext_vector_type(16)));
typedef short s16x4 __attribute__((ext_vector_type(4)));
#define KST 104
#define VST 72
#define ATT_BUF (64 * KST * 2 + 64 * VST * 2)
__device__ __forceinline__ int crow32(int r, int hi) { return (r & 3) + 8 * (r >> 2) + 4 * hi; }
__device__ __forceinline__ s16x4 tr_read(const bf16_t* p) { return __builtin_bit_cast(s16x4, __builtin_amdgcn_ds_read_tr16_b64_v4i16((LAS s16x4*)(LAS void*)(unsigned)(size_t)p)); }
__device__ __forceinline__ bf16x8 pack8(const f32x16& x, int s) {
    u32x4 w; w.x = cvtpk(x[8 * s], x[8 * s + 1]); w.y = cvtpk(x[8 * s + 2], x[8 * s + 3]); w.z = cvtpk(x[8 * s + 4], x[8 * s + 5]); w.w = cvtpk(x[8 * s + 6], x[8 * s + 7]);
    return __builtin_bit_cast(bf16x8, w);
}
__device__ __forceinline__ void attn_block(const MK& a, int b, int h, int qb, char* smem) {
    const int tid = otid(), lane = tid & 63, wid = tid >> 6, r32 = lane & 31, hi = lane >> 5;
    const int qrow = qb * 256 + wid * 32 + r32;
    const int wq0 = qb * 256 + wid * 32;
    bf16x8 qf[6];
    {
        const float SCL = 0.14724445f;
        const bf16_t* Qg = a.qraw() + ((size_t)b * SEQ + qrow) * 768 + h * 96 + 8 * hi;
        float qv[6][8];
#pragma unroll
        for (int ds = 0; ds < 6; ++ds) bf8_to_f32(*(const bf16x8*)(Qg + 16 * ds), qv[ds]);
        float sn_ = 0.f, sr_ = 0.f;
#pragma unroll
        for (int j = 0; j < 8; ++j) { sn_ += qv[0][j] * qv[0][j] + qv[1][j] * qv[1][j] + qv[2][j] * qv[2][j] + qv[3][j] * qv[3][j]; sr_ += qv[4][j] * qv[4][j] + qv[5][j] * qv[5][j]; }
        sn_ = add_x32(sn_); sr_ = add_x32(sr_);
        const float rsn = rsqrtf(sn_ * (1.f / 64.f) + EPSV) * SCL, rsr = rsqrtf(sr_ * (1.f / 32.f) + EPSV);
#pragma unroll
        for (int ds = 0; ds < 4; ++ds) {
            float o[8];
#pragma unroll
            for (int j = 0; j < 8; ++j) o[j] = qv[ds][j] * rsn * a.g_q_nope[16 * ds + 8 * hi + j];
            qf[ds] = f32_to_bf8(o);
        }
        const float* tb = a.ropecs() + (size_t)qrow * 32 + 8 * hi;
        float o4[8], o5[8];
#pragma unroll
        for (int j = 0; j < 8; ++j) {
            const float x1 = qv[4][j] * rsr * a.g_q_rope[8 * hi + j], x2 = qv[5][j] * rsr * a.g_q_rope[16 + 8 * hi + j], cs = tb[j], sn = tb[16 + j];
            o4[j] = (x1 * cs - x2 * sn) * SCL; o5[j] = (x1 * sn + x2 * cs) * SCL;
        }
        qf[4] = f32_to_bf8(o4); qf[5] = f32_to_bf8(o5);
    }
    f32x16 o0, o1;
#pragma unroll
    for (int r = 0; r < 16; ++r) { o0[r] = 0.f; o1[r] = 0.f; }
    float m = 0.f, l = 0.f;
    f32x16 negm;
#pragma unroll
    for (int r = 0; r < 16; ++r) negm[r] = 0.f;
    const int nt = qb * 4 + 4;
    const int vr = tid >> 3, vc = tid & 7, rr_ = (tid >> 2) & 63, rc = tid & 3;
    const bf16_t* KVg = a.kvraw() + (size_t)b * SEQ * 1024 + h * 128 + (size_t)vr * 1024 + vc * 8;
    const bf16_t* KRg = a.krb() + (size_t)b * SEQ * 32 + (size_t)rr_ * 32 + rc * 8;
    float gk[8];
#pragma unroll
    for (int j = 0; j < 8; ++j) gk[j] = a.g_k_nope[8 * vc + j];
    bf16x8 kr0, kr1, vr0;
#define ATT_LOAD(tt) do { kr0 = *(const bf16x8*)(KVg + (size_t)(tt) * 64 * 1024); vr0 = *(const bf16x8*)(KVg + (size_t)(tt) * 64 * 1024 + 64); if (tid < 256) kr1 = *(const bf16x8*)(KRg + (size_t)(tt) * 64 * 32); } while (0)
#define ATT_STORE(buf) do { bf16_t* Ks_ = (bf16_t*)(smem + (buf) * ATT_BUF); bf16_t* Vs_ = Ks_ + 64 * KST; \
        float x_[8]; bf8_to_f32(kr0, x_); float ss_ = 0.f; _Pragma("unroll") for (int j = 0; j < 8; ++j) ss_ += x_[j] * x_[j]; \
        ss_ = sum8(ss_); const float rs_ = rsqrtf(ss_ * (1.f / 64.f) + EPSV); \
        _Pragma("unroll") for (int j = 0; j < 8; ++j) x_[j] *= rs_ * gk[j]; \
        *(bf16x8*)(Ks_ + vr * KST + vc * 8) = f32_to_bf8(x_); *(bf16x8*)(Vs_ + vr * VST + vc * 8) = vr0; \
        if (tid < 256) *(bf16x8*)(Ks_ + rr_ * KST + 64 + rc * 8) = kr1; } while (0)
    ATT_LOAD(0);
    __syncthreads();
    ATT_STORE(0);
    __syncthreads();
    const int i16 = lane & 15, qq = i16 >> 2, pp = i16 & 3, g1 = (lane >> 4) & 1;
    for (int t = 0; t < nt; ++t) {
        const bf16_t* Ks = (const bf16_t*)(smem + (t & 1) * ATT_BUF); const bf16_t* Vs = Ks + 64 * KST;
        if (t + 1 < nt) ATT_LOAD(t + 1);
        if (64 * t <= wq0 + 31) {
            f32x16 p0, p1;
#pragma unroll
            for (int ds = 0; ds < 6; ++ds) {
                const bf16x8 k0 = *(const bf16x8*)(Ks + r32 * KST + 16 * ds + 8 * hi);
                const bf16x8 k1 = *(const bf16x8*)(Ks + (32 + r32) * KST + 16 * ds + 8 * hi);
                if (ds == 0) { p0 = __builtin_amdgcn_mfma_f32_32x32x16_bf16(k0, qf[ds], negm, 0, 0, 0); p1 = __builtin_amdgcn_mfma_f32_32x32x16_bf16(k1, qf[ds], negm, 0, 0, 0); }
                else { p0 = __builtin_amdgcn_mfma_f32_32x32x16_bf16(k0, qf[ds], p0, 0, 0, 0); p1 = __builtin_amdgcn_mfma_f32_32x32x16_bf16(k1, qf[ds], p1, 0, 0, 0); }
            }
            if (64 * t + 63 > wq0) {
#pragma unroll
                for (int r = 0; r < 16; ++r) { const int kv = 64 * t + crow32(r, hi); if (kv > qrow) p0[r] = -INFINITY; if (kv + 32 > qrow) p1[r] = -INFINITY; }
            }
            float mx = fmaxf(p0[0], p1[0]);
#pragma unroll
            for (int r = 1; r < 16; ++r) mx = fmaxf(mx, fmaxf(p0[r], p1[r]));
            mx = max_x32(mx);
            const float delta = t == 0 ? mx : fmaxf(mx, 0.f);
            if (__any(delta != 0.f)) {
                m += delta;
                const float f = t == 0 ? 1.f : __builtin_amdgcn_exp2f(-delta);
#pragma unroll
                for (int r = 0; r < 16; ++r) { p0[r] -= delta; p1[r] -= delta; negm[r] = -m; o0[r] *= f; o1[r] *= f; }
                l *= f;
            }
            float rs = 0.f;
#pragma unroll
            for (int r = 0; r < 16; ++r) { p0[r] = __builtin_amdgcn_exp2f(p0[r]); p1[r] = __builtin_amdgcn_exp2f(p1[r]); rs += p0[r] + p1[r]; }
            l += rs;
            bf16x8 pf[4];
            pf[0] = pack8(p0, 0); pf[1] = pack8(p0, 1); pf[2] = pack8(p1, 0); pf[3] = pack8(p1, 1);
#pragma unroll
            for (int ks = 0; ks < 4; ++ks) {
                const bf16_t* vb0 = Vs + (16 * ks + 4 * hi + qq) * VST + 16 * g1 + 4 * pp;
                const s16x4 a0 = tr_read(vb0), a1 = tr_read(vb0 + 8 * VST);
                const s16x4 c0 = tr_read(vb0 + 32), c1 = tr_read(vb0 + 8 * VST + 32);
                const bf16x8 va = __builtin_shufflevector(a0, a1, 0, 1, 2, 3, 4, 5, 6, 7);
                const bf16x8 vc_ = __builtin_shufflevector(c0, c1, 0, 1, 2, 3, 4, 5, 6, 7);
                o0 = __builtin_amdgcn_mfma_f32_32x32x16_bf16(va, pf[ks], o0, 0, 0, 0);
                o1 = __builtin_amdgcn_mfma_f32_32x32x16_bf16(vc_, pf[ks], o1, 0, 0, 0);
            }
        }
        if (t + 1 < nt) ATT_STORE((t + 1) & 1);
        __syncthreads();
    }
    l = add_x32(l);
    const float il = 1.f / l;
    bf16_t* op = a.omix() + ((size_t)b * SEQ + qrow) * 1024 + 512 + h * 64;
#pragma unroll
    for (int g = 0; g < 4; ++g) {
        uint2 w0, w1;
        w0.x = pk2bf(o0[4 * g] * il, o0[4 * g + 1] * il); w0.y = pk2bf(o0[4 * g + 2] * il, o0[4 * g + 3] * il);
        w1.x = pk2bf(o1[4 * g] * il, o1[4 * g + 1] * il); w1.y = pk2bf(o1[4 * g + 2] * il, o1[4 * g + 3] * il);
        *(uint2*)(op + 8 * g + 4 * hi) = w0;
        *(uint2*)(op + 32 + 8 * g + 4 * hi) = w1;
    }
#undef ATT_LOAD
#undef ATT_STORE
}

__device__ __forceinline__ void gdn_unit(const MK& a, int b, int h, int dvg, const float* s0, float* sout, int row0, int T, int lane, char* wsm) {
    float (*sq)[64] = (float (*)[64])wsm;
    float (*sk)[64] = (float (*)[64])(wsm + 4096);
    float (*sv)[8] = (float (*)[8])(wsm + 8192);
    float* sg = (float*)(wsm + 8704);
    float* sb = (float*)(wsm + 8768);
    const int e = lane & 7, ko = lane >> 3, col = dvg * 8 + e;
    float S[8];
#pragma unroll
    for (int d = 0; d < 8; ++d) S[d] = s0 ? s0[(((size_t)b * 8 + h) * 64 + ko * 8 + d) * 64 + col] : 0.f;
    const size_t rbase = (size_t)row0 + (size_t)b * T;
    float pq[16], pk[16], pv0, pv1, pgb;
    {
        const int nt = T < 16 ? T : 16;
#pragma unroll
        for (int j = 0; j < 16; ++j) { const bool ok = j < nt; const size_t r = rbase + (ok ? j : 0); pq[j] = ok ? bf2f(a.qkv()[r * 1536 + h * 64 + lane]) : 0.f; pk[j] = ok ? bf2f(a.qkv()[r * 1536 + 512 + h * 64 + lane]) : 0.f; }
        { const int j0 = lane >> 3, j1 = j0 + 8; pv0 = j0 < nt ? bf2f(a.qkv()[(rbase + j0) * 1536 + 1024 + h * 64 + dvg * 8 + (lane & 7)]) : 0.f; pv1 = j1 < nt ? bf2f(a.qkv()[(rbase + j1) * 1536 + 1024 + h * 64 + dvg * 8 + (lane & 7)]) : 0.f; }
        { const int j = lane & 15; pgb = j < nt ? (lane < 16 ? a.gg()[(rbase + j) * 8 + h] : a.bb()[(rbase + j) * 8 + h]) : 0.f; }
    }
    for (int t0 = 0; t0 < T; t0 += 16) {
        const int nt = (T - t0) < 16 ? (T - t0) : 16;
        WSYNC();
#pragma unroll
        for (int j = 0; j < 16; ++j) { sq[j][lane] = pq[j]; sk[j][lane] = pk[j]; }
        sv[lane >> 3][lane & 7] = pv0; sv[(lane >> 3) + 8][lane & 7] = pv1;
        if (lane < 16) sg[lane] = expf(pgb); else if (lane < 32) sb[lane - 16] = pgb;
        WSYNC();
        if (t0 + 16 < T) {
            const size_t rb = rbase + t0 + 16;
#pragma unroll
            for (int j = 0; j < 16; ++j) { pq[j] = bf2f(a.qkv()[(rb + j) * 1536 + h * 64 + lane]); pk[j] = bf2f(a.qkv()[(rb + j) * 1536 + 512 + h * 64 + lane]); }
            pv0 = bf2f(a.qkv()[(rb + (lane >> 3)) * 1536 + 1024 + h * 64 + dvg * 8 + (lane & 7)]); pv1 = bf2f(a.qkv()[(rb + (lane >> 3) + 8) * 1536 + 1024 + h * 64 + dvg * 8 + (lane & 7)]);
            pgb = lane < 16 ? a.gg()[(rb + (lane & 15)) * 8 + h] : a.bb()[(rb + (lane & 15)) * 8 + h];
        }
        for (int j = 0; j < nt; ++j) {
            const float dec = sg[j], be = sb[j], v = sv[j][e];
            const float4 k0 = *(const float4*)&sk[j][ko * 8], k1 = *(const float4*)&sk[j][ko * 8 + 4];
            const float4 q0 = *(const float4*)&sq[j][ko * 8], q1 = *(const float4*)&sq[j][ko * 8 + 4];
            const float kk[8] = {k0.x, k0.y, k0.z, k0.w, k1.x, k1.y, k1.z, k1.w};
            const float qq[8] = {q0.x, q0.y, q0.z, q0.w, q1.x, q1.y, q1.z, q1.w};
            float ks = 0.f;
#pragma unroll
            for (int d = 0; d < 8; ++d) { S[d] *= dec; ks += kk[d] * S[d]; }
            ks += __shfl_xor(ks, 8); ks += __shfl_xor(ks, 16); ks += __shfl_xor(ks, 32);
            const float delta = (v - ks) * be;
            float ov = 0.f;
#pragma unroll
            for (int d = 0; d < 8; ++d) { S[d] += kk[d] * delta; ov += qq[d] * S[d]; }
            ov += __shfl_xor(ov, 8); ov += __shfl_xor(ov, 16); ov += __shfl_xor(ov, 32);
            if (ko == 0) a.goraw()[(rbase + t0 + j) * 512 + h * 64 + col] = ov;
        }
    }
#pragma unroll
    for (int d = 0; d < 8; ++d) sout[(((size_t)b * 8 + h) * 64 + ko * 8 + d) * 64 + col] = S[d];
}
__device__ __forceinline__ int pi_pos(int k) { return (k & 32) + 8 * ((k >> 2) & 3) + 4 * ((k >> 4) & 1) + (k & 3); }
#define GDN_WLDS 17408
__device__ __forceinline__ void gdn_prep_unit(const MK& a, int u, int lane_in, char* wsm) {
    int lane = lane_in; asm volatile("" : "+v"(lane));
    const int bh = u >> 5, n = u & 31, b = bh >> 3, h = bh & 7, i16 = lane & 15, q4 = lane >> 4;
    const size_t row0 = (size_t)b * SEQ + n * 64;
    float* AT = (float*)wsm; float* GC = (float*)(wsm + 16384); float* BT = GC + 64;
    const bf16_t* qbase = a.qkv() + row0 * 1536 + h * 64; const bf16_t* kbase = qbase + 512; const bf16_t* vbase = qbase + 1024;
    float g = a.gg()[(row0 + lane) * 8 + h];
    const float be_l = a.bb()[(row0 + lane) * 8 + h];
#pragma unroll
    for (int o = 1; o < 64; o <<= 1) { const float t = __shfl_up(g, o); if (lane >= o) g += t; }
    WSYNC();
    GC[lane] = g; BT[lane] = be_l;
    WSYNC();
    const float gl = GC[63];
    float* EG = BT + 64; float* ED = EG + 64;
    EG[lane] = expf(g); ED[lane] = expf(gl - g);
    WSYNC();
    bf16x8 kf[4][2], qf[4][2];
#pragma unroll
    for (int mt = 0; mt < 4; ++mt)
#pragma unroll
        for (int ks = 0; ks < 2; ++ks) {
            const int off = (16 * mt + i16) * 1536 + 32 * ks + 8 * q4;
            kf[mt][ks] = *(const bf16x8*)(kbase + off); qf[mt][ks] = *(const bf16x8*)(qbase + off);
        }
    bf16_t* QKg = a.gQK() + (size_t)u * 4096;
#pragma unroll
    for (int mt = 0; mt < 4; ++mt)
#pragma unroll
        for (int nt = 0; nt < 4; ++nt) {
            const int j = 16 * nt + i16, pj = 32 * (nt >> 1) + 8 * (i16 >> 2) + 4 * (nt & 1) + (i16 & 3);
            if (nt <= mt) {
                f32x4 d1 = {0.f, 0.f, 0.f, 0.f}, d2 = {0.f, 0.f, 0.f, 0.f};
#pragma unroll
                for (int ks = 0; ks < 2; ++ks) {
                    d1 = __builtin_amdgcn_mfma_f32_16x16x32_bf16(kf[mt][ks], kf[nt][ks], d1, 0, 0, 0);
                    d2 = __builtin_amdgcn_mfma_f32_16x16x32_bf16(qf[mt][ks], kf[nt][ks], d2, 0, 0, 0);
                }
                const float gcj = GC[j];
#pragma unroll
                for (int r = 0; r < 4; ++r) {
                    const int i = 16 * mt + 4 * q4 + r;
                    const float dec = __builtin_amdgcn_exp2f(1.44269504f * (GC[i] - gcj));
                    AT[i * 64 + j] = (i > j) ? BT[i] * d1[r] * dec : 0.f;
                    QKg[i * 64 + (((pj >> 3) ^ (i & 7)) << 3) + (pj & 7)] = f2bf((i >= j) ? d2[r] * dec : 0.f);
                }
            } else {
#pragma unroll
                for (int r = 0; r < 4; ++r) { const int i = 16 * mt + 4 * q4 + r; QKg[i * 64 + (((pj >> 3) ^ (i & 7)) << 3) + (pj & 7)] = 0; }
            }
        }
    {
        bf16_t* Qgg = a.gQg() + (size_t)u * 4096;
#pragma unroll
        for (int mt = 0; mt < 4; ++mt) {
            const int i = 16 * mt + i16; const float e = EG[i];
#pragma unroll
            for (int ks = 0; ks < 2; ++ks) {
                float x[8]; bf8_to_f32(qf[mt][ks], x);
                uint2 w0, w1; w0.x = cvtpk(x[0] * e, x[1] * e); w0.y = cvtpk(x[2] * e, x[3] * e); w1.x = cvtpk(x[4] * e, x[5] * e); w1.y = cvtpk(x[6] * e, x[7] * e);
                const int p0 = 32 * ks + 16 * (q4 & 1) + 4 * (q4 >> 1);
                *(uint2*)(Qgg + i * 64 + (((p0 >> 3) ^ (i & 7)) << 3) + (p0 & 7)) = w0; *(uint2*)(Qgg + i * 64 + ((((p0 >> 3) + 1) ^ (i & 7)) << 3) + (p0 & 7)) = w1;
            }
        }
    }
    WSYNC();
    __builtin_amdgcn_sched_barrier(0);
    {
        float U[64];
#pragma unroll
        for (int i = 0; i < 64; ++i) { U[i] = bf2f(vbase[i * 1536 + lane]) * BT[i]; }
#pragma unroll
        for (int i = 1; i < 64; ++i) {
            float su = 0.f;
#pragma unroll
            for (int j4 = 0; j4 < i; j4 += 4) {
                const float4 av = *(const float4*)(AT + i * 64 + j4);
                su += av.x * U[j4];
                if (j4 + 1 < i) su += av.y * U[j4 + 1];
                if (j4 + 2 < i) su += av.z * U[j4 + 2];
                if (j4 + 3 < i) su += av.w * U[j4 + 3];
            }
            U[i] -= su;
            __builtin_amdgcn_sched_barrier(0);
        }
        float* UTg = a.gUT() + ((size_t)u * 64 + lane) * 64;
#pragma unroll
        for (int i = 0; i < 64; i += 4) *(float4*)(UTg + 4 * ((i >> 2) ^ (lane & 15))) = (float4){U[i], U[i + 1], U[i + 2], U[i + 3]};
    }
    asm volatile("" ::: "memory");
    __builtin_amdgcn_sched_barrier(0);
    {
        float W[64];
#pragma unroll
        for (int i = 0; i < 64; ++i) { W[i] = bf2f(kbase[i * 1536 + lane]); }
        bf16_t* Kdg = a.gKd() + ((size_t)u * 64 + lane) * 64;
#pragma unroll
        for (int pc = 0; pc < 8; ++pc) {
            float t[8];
#pragma unroll
            for (int jj = 0; jj < 8; ++jj) { const int j = 32 * (pc >> 2) + 16 * (jj >> 2) + 4 * (pc & 3) + (jj & 3); t[jj] = W[j] * ED[j]; }
            u32x4 w; w.x = cvtpk(t[0], t[1]); w.y = cvtpk(t[2], t[3]); w.z = cvtpk(t[4], t[5]); w.w = cvtpk(t[6], t[7]);
            *(u32x4*)(Kdg + 8 * (pc ^ (lane & 7))) = w;
        }
#pragma unroll
        for (int i = 0; i < 64; ++i) W[i] *= BT[i] * EG[i];
#pragma unroll
        for (int i = 1; i < 64; ++i) {
            float sw = 0.f;
#pragma unroll
            for (int j4 = 0; j4 < i; j4 += 4) {
                const float4 av = *(const float4*)(AT + i * 64 + j4);
                sw += av.x * W[j4];
                if (j4 + 1 < i) sw += av.y * W[j4 + 1];
                if (j4 + 2 < i) sw += av.z * W[j4 + 2];
                if (j4 + 3 < i) sw += av.w * W[j4 + 3];
            }
            W[i] -= sw;
            __builtin_amdgcn_sched_barrier(0);
        }
        bf16_t* Wng = a.gWn() + (size_t)u * 4096; const int pp = pi_pos(lane);
#pragma unroll
        for (int i = 0; i < 64; ++i) Wng[i * 64 + (((pp >> 3) ^ (i & 7)) << 3) + (pp & 7)] = f2bf(-W[i]);
    }
    if (lane == 0) a.ggam()[u] = expf(gl);
}
__device__ __forceinline__ bf16x8 pack_acc2(const f32x4& x, const f32x4& y) {
    u32x4 w; w.x = cvtpk(x[0], x[1]); w.y = cvtpk(x[2], x[3]); w.z = cvtpk(y[0], y[1]); w.w = cvtpk(y[2], y[3]);
    return __builtin_bit_cast(bf16x8, w);
}
#define G2_SLOT 49152
__device__ __forceinline__ void g2_issue(const MK& a, size_t u, int n, LAS unsigned char* lds, int lw, int lane) {
    LAS unsigned char* dst = lds + (n % 3) * G2_SLOT;
    const char* srcs[4] = {(const char*)(a.gWn() + u * 4096), (const char*)(a.gQg() + u * 4096), (const char*)(a.gQK() + u * 4096), (const char*)(a.gKd() + u * 4096)};
#pragma unroll
    for (int m = 0; m < 4; ++m)
#pragma unroll
        for (int i = 0; i < 2; ++i) { const int piece = 2 * lw + i;
            __builtin_amdgcn_global_load_lds((const unsigned*)(srcs[m] + piece * 1024 + lane * 16), (LAS unsigned*)(dst + m * 8192 + piece * 1024), 16, 0, 0); }
    const char* us = (const char*)(a.gUT() + u * 4096);
#pragma unroll
    for (int i = 0; i < 4; ++i) { const int piece = 4 * lw + i;
        __builtin_amdgcn_global_load_lds((const unsigned*)(us + piece * 1024 + lane * 16), (LAS unsigned*)(dst + 32768 + piece * 1024), 16, 0, 0); }
}
__device__ __forceinline__ void gdn_scan_block(const MK& a, int bh, LAS unsigned char* lds) {
    const int tid = otid(), lane = tid & 63, wid = __builtin_amdgcn_readfirstlane(tid >> 6), i16 = lane & 15, q4 = lane >> 4;
    const int b = bh >> 3, h = bh & 7, sl = wid & 3;
    const bool loader = wid >= 4;
    f32x4 S[4];
#pragma unroll
    for (int mt = 0; mt < 4; ++mt) S[mt] = (f32x4){0.f, 0.f, 0.f, 0.f};
    __syncthreads();
    if (loader) { g2_issue(a, (size_t)bh * 32, 0, lds, wid - 4, lane); g2_issue(a, (size_t)bh * 32 + 1, 1, lds, wid - 4, lane); }
    for (int n = 0; n < 32; ++n) {
        if (loader) { if (n < 31) asm volatile("s_waitcnt vmcnt(12)" ::: "memory"); else asm volatile("s_waitcnt vmcnt(0)" ::: "memory"); }
        asm volatile("s_waitcnt lgkmcnt(0)" ::: "memory"); __builtin_amdgcn_s_barrier(); asm volatile("" ::: "memory");
        if (loader) { if (n + 2 < 32) g2_issue(a, (size_t)bh * 32 + n + 2, n + 2, lds, wid - 4, lane); }
        else {
            const LAS unsigned char* sb = lds + (n % 3) * G2_SLOT;
            const float gam = a.ggam()[(size_t)bh * 32 + n];
            bf16x8 Sb[2]; Sb[0] = pack_acc2(S[0], S[1]); Sb[1] = pack_acc2(S[2], S[3]);
            f32x4 Vn[4];
#pragma unroll
            for (int mt = 0; mt < 4; ++mt) Vn[mt] = *(const LAS f32x4*)(sb + 32768 + (16 * sl + i16) * 256 + 16 * ((4 * mt + q4) ^ i16));
#pragma unroll
            for (int mt = 0; mt < 4; ++mt)
#pragma unroll
                for (int ks = 0; ks < 2; ++ks) Vn[mt] = __builtin_amdgcn_mfma_f32_16x16x32_bf16(*(const LAS bf16x8*)(sb + (16 * mt + i16) * 128 + 16 * ((4 * ks + q4) ^ (i16 & 7))), Sb[ks], Vn[mt], 0, 0, 0);
            bf16x8 Vb[2]; Vb[0] = pack_acc2(Vn[0], Vn[1]); Vb[1] = pack_acc2(Vn[2], Vn[3]);
            f32x4 O[4];
#pragma unroll
            for (int mt = 0; mt < 4; ++mt) {
                O[mt] = (f32x4){0.f, 0.f, 0.f, 0.f};
#pragma unroll
                for (int ks = 0; ks < 2; ++ks) {
                    const int fo = (16 * mt + i16) * 128 + 16 * ((4 * ks + q4) ^ (i16 & 7));
                    O[mt] = __builtin_amdgcn_mfma_f32_16x16x32_bf16(*(const LAS bf16x8*)(sb + 8192 + fo), Sb[ks], O[mt], 0, 0, 0);
                    O[mt] = __builtin_amdgcn_mfma_f32_16x16x32_bf16(*(const LAS bf16x8*)(sb + 16384 + fo), Vb[ks], O[mt], 0, 0, 0);
                }
            }
#pragma unroll
            for (int mt = 0; mt < 4; ++mt) {
                S[mt] = S[mt] * gam;
#pragma unroll
                for (int ks = 0; ks < 2; ++ks) S[mt] = __builtin_amdgcn_mfma_f32_16x16x32_bf16(*(const LAS bf16x8*)(sb + 24576 + (16 * mt + i16) * 128 + 16 * ((4 * ks + q4) ^ (i16 & 7))), Vb[ks], S[mt], 0, 0, 0);
            }
            float* og = a.goraw() + ((size_t)b * SEQ + n * 64 + 4 * q4) * 512 + h * 64 + 16 * sl + i16;
#pragma unroll
            for (int mt = 0; mt < 4; ++mt)
#pragma unroll
                for (int r = 0; r < 4; ++r) og[(size_t)(16 * mt + r) * 512] = O[mt][r];
        }
    }
    if (!loader) {
        float* so = a.out + O_GSP + ((size_t)bh * 64 + 4 * q4) * 64 + 16 * sl + i16;
#pragma unroll
        for (int mt = 0; mt < 4; ++mt)
#pragma unroll
            for (int r = 0; r < 4; ++r) so[(size_t)(16 * mt + r) * 64] = S[mt][r];
    }
    __syncthreads();
}
__device__ __forceinline__ void gdn_out_token(const MK& a, int row, int lane) {
    const float* op = a.goraw() + (size_t)row * 512 + 8 * lane;
    const float4 x0 = *(const float4*)op, x1 = *(const float4*)(op + 4);
    float o[8] = {x0.x, x0.y, x0.z, x0.w, x1.x, x1.y, x1.z, x1.w}, zg[8];
    bf8_to_f32(*(const bf16x8*)(a.Z() + (size_t)row * ZW + OFF_Z + 8 * lane), zg);
    float ss = 0.f;
#pragma unroll
    for (int e = 0; e < 8; ++e) ss += o[e] * o[e];
    ss = sum8(ss);
    const float rs = rsqrtf(ss * (1.f / 64.f) + EPSV);
    const float4 g0 = *(const float4*)(a.g_gdn_out + 8 * (lane & 7)), g1 = *(const float4*)(a.g_gdn_out + 8 * (lane & 7) + 4);
    const float gg_[8] = {g0.x, g0.y, g0.z, g0.w, g1.x, g1.y, g1.z, g1.w};
#pragma unroll
    for (int e = 0; e < 8; ++e) o[e] = o[e] * rs * gg_[e] * zg[e] * fast_sigmoid(zg[e]);
    *(bf16x8*)(a.omix() + (size_t)row * 1024 + 8 * lane) = f32_to_bf8(o);
}

#define SSLOT 32768
#define TL_OFF (3 * SSLOT)
#define CST 264
#define KR_OFF (TL_OFF + 2 * 32 * CST * 2)
#define WQ_OFF (KR_OFF + 4 * 4096)
#define QR_OFF (WQ_OFF + 2048)
#define PG_OFF (QR_OFF + 1024)
#define PT_OFF (PG_OFF + 64)
#define AL_OFF (PT_OFF + 1024)
#define SAMP_LDS_END (AL_OFF + 64)
__device__ __forceinline__ void samp_issue(const MK& a, int g, LAS unsigned char* lds, int wid, int lane) {
    const int phys = __builtin_amdgcn_readfirstlane(((const LAS int*)(lds + PG_OFF))[g >> 2]);
    const int tok0 = (g & 3) * 32 + 4 * wid;
    const float* cs = a.cache_ckv + ((size_t)phys * 128 + tok0) * 256 + lane * 4;
#pragma unroll
    for (int i = 0; i < 4; ++i) __builtin_amdgcn_global_load_lds((const unsigned*)(cs + i * 256), (LAS unsigned*)(lds + (g % 3) * SSLOT + (4 * wid + i) * 1024), 16, 0, 0);
    if (wid < 4) { const int tl = lane >> 3, cg = (lane & 7) ^ (((tl >> 1) & 1) | ((wid & 1) << 2));
        __builtin_amdgcn_global_load_lds((const unsigned*)(a.cache_krope + ((size_t)phys * 128 + (g & 3) * 32 + 8 * wid + tl) * 32 + cg * 4), (LAS unsigned*)(lds + KR_OFF + (g & 3) * 4096 + wid * 1024), 16, 0, 0); }
}
typedef unsigned u32x2 __attribute__((ext_vector_type(2)));
__device__ __forceinline__ void samp_convert(int g, LAS unsigned char* lds, int tid) {
    const int st = tid >> 4, l16 = tid & 15;
    const LAS float* src = (const LAS float*)(lds + (g % 3) * SSLOT) + st * 256 + 4 * l16;
    LAS bf16_t* dst = (LAS bf16_t*)(lds + TL_OFF + (g & 1) * 32 * CST * 2) + st * CST + 4 * l16;
    f32x4 x[4];
#pragma unroll
    for (int k = 0; k < 4; ++k) x[k] = *(const LAS f32x4*)(src + 64 * k);
#pragma unroll
    for (int k = 0; k < 4; ++k) { u32x2 w; w.x = cvtpk(x[k][0], x[k][1]); w.y = cvtpk(x[k][2], x[k][3]); *(LAS u32x2*)(dst + 64 * k) = w; }
}
#define SAMP_WAITV(n5, n4) do { if (h < 4) asm volatile("s_waitcnt vmcnt(" #n5 ")" ::: "memory"); else asm volatile("s_waitcnt vmcnt(" #n4 ")" ::: "memory"); } while (0)
#define SAMP_BAR() do { asm volatile("s_waitcnt lgkmcnt(0)" ::: "memory"); __builtin_amdgcn_s_barrier(); asm volatile("" ::: "memory"); } while (0)
__device__ __forceinline__ void samp_attn_unit(const MK& a, int u, char* smem, LAS unsigned char* lds) {
    const int tid = otid(), lane = tid & 63, h = __builtin_amdgcn_readfirstlane(tid >> 6), i16 = lane & 15, q4 = lane >> 4;
    const int b = u >> 3, sp = u & 7;
    float* WQ = (float*)(smem + WQ_OFF);
    float* QR = (float*)(smem + QR_OFF);
    int* PG = (int*)(smem + PG_OFF);
    const float SCL = 0.14724445f;
    post_q_item(a, (NPT + b) * 8 + h, lane);
    __syncthreads();
    {
        const int h_ = tid >> 6, l_ = tid & 63, q4_ = l_ >> 4, idx = l_ & 15, d = 16 * (idx >> 2) + 4 * q4_ + (idx & 3);
        WQ[tid] = a.g_k_nope[d] * a.qh()[((size_t)(NPT + b) * 8 + h_) * 96 + d] * SCL;
        if (tid < 256) QR[tid] = a.qh()[((size_t)(NPT + b) * 8 + (tid >> 5)) * 96 + 64 + (tid & 31)] * SCL;
        if (tid < 16) PG[tid] = a.page_table[b * NPAGES + sp * 16 + tid];
    }
    bf16x8 wf[4][8];
#pragma unroll
    for (int mt = 0; mt < 4; ++mt)
#pragma unroll
        for (int ks = 0; ks < 8; ++ks) wf[mt][ks] = *(const bf16x8*)(a.WknT() + (size_t)(h * 64 + 16 * mt + i16) * 256 + 32 * ks + 8 * q4);
#pragma unroll
    for (int mt = 0; mt < 4; ++mt)
#pragma unroll
        for (int ks = 0; ks < 8; ++ks) asm volatile("" : "+v"(wf[mt][ks]));
    __syncthreads();
    samp_issue(a, 0, lds, h, lane); samp_issue(a, 1, lds, h, lane); samp_issue(a, 2, lds, h, lane);
    SAMP_WAITV(10, 8);
    SAMP_BAR();
    samp_convert(0, lds, tid);
    const LAS float* QRl = (const LAS float*)(lds + QR_OFF) + h * 32 + 8 * q4;
    const LAS float* WQl = (const LAS float*)(lds + WQ_OFF) + (h * 4 + q4) * 16;
    f32x4 wqr[4], qrr[2];
#pragma unroll
    for (int mt = 0; mt < 4; ++mt) wqr[mt] = *(const LAS f32x4*)(WQl + 4 * mt);
    qrr[0] = *(const LAS f32x4*)QRl; qrr[1] = *(const LAS f32x4*)(QRl + 4);
    float m = -INFINITY, lsum = 0.f;
    f32x4 latv[2]; latv[0] = (f32x4){0.f, 0.f, 0.f, 0.f}; latv[1] = (f32x4){0.f, 0.f, 0.f, 0.f};
    for (int g = 0; g < 64; ++g) {
        SAMP_BAR();
        if (g + 3 < 64) samp_issue(a, g + 3, lds, h, lane);
        const LAS bf16_t* Tl = (const LAS bf16_t*)(lds + TL_OFF + (g & 1) * 32 * CST * 2); const LAS float* KR = (const LAS float*)(lds + KR_OFF + (g & 3) * 4096);
        float scv;
        {
            float ssp[2], dotp[2], rdp[2];
            f32x4 acc[2][4];
#pragma unroll
            for (int hf = 0; hf < 2; ++hf)
#pragma unroll
                for (int mt = 0; mt < 4; ++mt) acc[hf][mt] = (f32x4){0.f, 0.f, 0.f, 0.f};
            const LAS bf16_t* cp0 = Tl + i16 * CST + 8 * q4; const LAS bf16_t* cp1 = cp0 + 16 * CST;
            bf16x8 c0 = *(const LAS bf16x8*)cp0, c1 = *(const LAS bf16x8*)cp1;
#pragma unroll
            for (int ks = 0; ks < 8; ++ks) {
                bf16x8 n0 = c0, n1 = c1;
                if (ks < 7) { n0 = *(const LAS bf16x8*)(cp0 + 32 * (ks + 1)); n1 = *(const LAS bf16x8*)(cp1 + 32 * (ks + 1)); }
#pragma unroll
                for (int mt = 0; mt < 4; ++mt) { acc[0][mt] = __builtin_amdgcn_mfma_f32_16x16x32_bf16(wf[mt][ks], c0, acc[0][mt], 0, 0, 0); acc[1][mt] = __builtin_amdgcn_mfma_f32_16x16x32_bf16(wf[mt][ks], c1, acc[1][mt], 0, 0, 0); }
                c0 = n0; c1 = n1;
            }
#pragma unroll
            for (int hf = 0; hf < 2; ++hf) {
                f32x2_t ss2 = {0.f, 0.f}, dot2 = {0.f, 0.f}, rd2 = {0.f, 0.f};
#pragma unroll
                for (int mt = 0; mt < 4; ++mt) {
                    const f32x4 wq = wqr[mt];
                    const f32x4 av = acc[hf][mt];
                    const f32x2_t lo = __builtin_shufflevector(av, av, 0, 1), hi = __builtin_shufflevector(av, av, 2, 3);
                    ss2 = __builtin_elementwise_fma(lo, lo, ss2); ss2 = __builtin_elementwise_fma(hi, hi, ss2);
                    dot2 = __builtin_elementwise_fma(lo, __builtin_shufflevector(wq, wq, 0, 1), dot2); dot2 = __builtin_elementwise_fma(hi, __builtin_shufflevector(wq, wq, 2, 3), dot2);
                }
                {
                    const int kc = (2 * q4) ^ ((i16 >> 1) & 5);
                    const LAS float* kp = KR + (16 * hf + i16) * 32;
                    const f32x4 k0 = *(const LAS f32x4*)(kp + 4 * kc), k1 = *(const LAS f32x4*)(kp + 4 * (kc ^ 1)), q0 = qrr[0], q1 = qrr[1];
                    rd2 = __builtin_elementwise_fma(__builtin_shufflevector(k0, k0, 0, 1), __builtin_shufflevector(q0, q0, 0, 1), rd2); rd2 = __builtin_elementwise_fma(__builtin_shufflevector(k0, k0, 2, 3), __builtin_shufflevector(q0, q0, 2, 3), rd2);
                    rd2 = __builtin_elementwise_fma(__builtin_shufflevector(k1, k1, 0, 1), __builtin_shufflevector(q1, q1, 0, 1), rd2); rd2 = __builtin_elementwise_fma(__builtin_shufflevector(k1, k1, 2, 3), __builtin_shufflevector(q1, q1, 2, 3), rd2);
                }
                ssp[hf] = ss2[0] + ss2[1]; dotp[hf] = dot2[0] + dot2[1]; rdp[hf] = rd2[0] + rd2[1];
            }
            const auto s1 = __builtin_amdgcn_permlane16_swap(__float_as_uint(ssp[0]), __float_as_uint(ssp[1]), false, false);
            const auto s2 = __builtin_amdgcn_permlane16_swap(__float_as_uint(dotp[0]), __float_as_uint(dotp[1]), false, false);
            const auto s3 = __builtin_amdgcn_permlane16_swap(__float_as_uint(rdp[0]), __float_as_uint(rdp[1]), false, false);
            const float u1 = __uint_as_float(s1[0]) + __uint_as_float(s1[1]), u2 = __uint_as_float(s2[0]) + __uint_as_float(s2[1]), u3 = __uint_as_float(s3[0]) + __uint_as_float(s3[1]);
            const auto t1 = __builtin_amdgcn_permlane32_swap(__float_as_uint(u1), __float_as_uint(u2), false, false);
            const float t = __uint_as_float(t1[0]) + __uint_as_float(t1[1]);
            const auto t2 = __builtin_amdgcn_permlane32_swap(__float_as_uint(t), __float_as_uint(t), false, false);
            const float ssv = __uint_as_float(t2[0]), dotv = __uint_as_float(t2[1]);
            const float rdv = add_x32(u3);
            scv = dotv * rsqrtf(ssv * (1.f / 64.f) + EPSV) + rdv;
        }
        float gm = max16(scv);
        { const auto r = __builtin_amdgcn_permlane16_swap(__float_as_uint(gm), __float_as_uint(gm), false, false); gm = fmaxf(__uint_as_float(r[0]), __uint_as_float(r[1])); }
        const float mn = fmaxf(m, gm);
        const float alpha = __builtin_amdgcn_exp2f(m - mn), pv = __builtin_amdgcn_exp2f(scv - mn);
        m = mn;
        lsum = lsum * alpha + pv;
        if (q4 < 2) { ((LAS float*)(lds + PT_OFF))[h * 32 + lane] = pv; if (lane == 0) ((LAS float*)(lds + AL_OFF))[h] = alpha; }
        if (g <= 60) SAMP_WAITV(10, 8); else if (g == 61) SAMP_WAITV(5, 4); else SAMP_WAITV(0, 0);
        SAMP_BAR();
        {
            u32x4 pw = {0u, 0u, 0u, 0u};
            if (i16 < 8) { const f32x4 pa = *(const LAS f32x4*)(lds + PT_OFF + (i16 * 32 + 8 * q4) * 4), pb_ = *(const LAS f32x4*)(lds + PT_OFF + (i16 * 32 + 8 * q4 + 4) * 4);
                pw.x = cvtpk(pa[0], pa[1]); pw.y = cvtpk(pa[2], pa[3]); pw.z = cvtpk(pb_[0], pb_[1]); pw.w = cvtpk(pb_[2], pb_[3]); }
            const bf16x8 pfr = __builtin_bit_cast(bf16x8, pw);
            const f32x4 al = *(const LAS f32x4*)(lds + AL_OFF + (q4 & 1) * 16);
            const unsigned tb0 = (unsigned)(size_t)((const LAS bf16_t*)(lds + TL_OFF + (g & 1) * 32 * CST * 2) + (8 * q4 + (i16 >> 2)) * CST + 32 * h + 4 * (i16 & 3));
            s16x4 c0[2], c1[2];
            static_assert(4 * CST * 2 == 2112, "tr offsets");
            asm volatile("ds_read_b64_tr_b16 %0, %4\n\tds_read_b64_tr_b16 %1, %4 offset:2112\n\tds_read_b64_tr_b16 %2, %4 offset:32\n\tds_read_b64_tr_b16 %3, %4 offset:2144\n\ts_waitcnt lgkmcnt(0)"
                         : "=&v"(c0[0]), "=&v"(c1[0]), "=&v"(c0[1]), "=&v"(c1[1]) : "v"(tb0) : "memory");
#pragma unroll
            for (int nt = 0; nt < 2; ++nt) {
                const bf16x8 cfr = __builtin_shufflevector(c0[nt], c1[nt], 0, 1, 2, 3, 4, 5, 6, 7);
                latv[nt] = latv[nt] * al;
                latv[nt] = __builtin_amdgcn_mfma_f32_16x16x32_bf16(pfr, cfr, latv[nt], 0, 0, 0);
            }
        }
        if (g + 1 < 64) samp_convert(g + 1, lds, tid);
    }
    lsum = add_x16(sum16(lsum));
    if (lane == 0) { float* o = a.part() + ((size_t)u * 8 + h) * 260; o[0] = m * 0.69314718f; o[1] = lsum; }
    if (q4 < 2) {
#pragma unroll
        for (int nt = 0; nt < 2; ++nt)
#pragma unroll
            for (int r = 0; r < 4; ++r) a.part()[((size_t)u * 8 + 4 * q4 + r) * 260 + 4 + 32 * h + 16 * nt + i16] = latv[nt][r];
    }
}
__device__ __forceinline__ void samp_comb_unit(const MK& a, int u, char* smem) {
    float* slat = (float*)smem; float* red = slat + 256;
    const int b = u >> 3, h = u & 7, tid = otid(), lane = tid & 63, wid = tid >> 6;
    const size_t row = NPT + b;
    const float* q = a.qh() + (row * 8 + h) * 96;
    float sp = q[lane] * a.kh()[(row * 8 + h) * 64 + lane];
    if (lane < 32) sp += q[64 + lane] * a.krf()[row * 32 + lane];
    const float s_self = wave_sum(sp) * 0.10206207261596577f;
    float pm[8], m = s_self;
#pragma unroll
    for (int s = 0; s < 8; ++s) { pm[s] = a.part()[((size_t)(b * 8 + s) * 8 + h) * 260]; m = fmaxf(m, pm[s]); }
    const float pself = __expf(s_self - m);
    float l = pself, lat = 0.f;
    __syncthreads();
#pragma unroll
    for (int s = 0; s < 8; ++s) {
        const float* p = a.part() + ((size_t)(b * 8 + s) * 8 + h) * 260;
        const float w = __expf(pm[s] - m);
        l += p[1] * w; if (tid < 256) lat += p[4 + tid] * w;
    }
    if (tid < 256) slat[tid] = lat;
    __syncthreads();
    {
        const float* wv = a.w_kv_b + (size_t)(32 * wid) * 1024 + h * 128 + 64 + lane;
        float o = 0.f;
#pragma unroll 8
        for (int c = 0; c < 32; ++c) o += slat[32 * wid + c] * wv[(size_t)c * 1024];
        red[wid * 64 + lane] = o;
    }
    __syncthreads();
    if (tid < 64) {
        float o = pself * a.KV()[row * 1024 + h * 128 + 64 + tid];
#pragma unroll
        for (int w = 0; w < 8; ++w) o += red[w * 64 + tid];
        a.omix()[row * 1024 + 512 + h * 64 + tid] = f2bf(o / l);
    }
}

#define XB_TMO      128
#define XB_XCNT(j)  (256  + 64 * (j))
#define XB_XSUB(j)  (1280 + 64 * (j))
#define XB_XGEN(j)  (2304 + 64 * (j))
#define XB_TOP      3328
#define XB_TOPGEN   3392
#define XCD_BAR_WORDS 3456
#define XB_SPIN_CAP (1u << 18)

__device__ __forceinline__ unsigned xb_ld(unsigned* p)              { return __hip_atomic_load(p, __ATOMIC_RELAXED, __HIP_MEMORY_SCOPE_AGENT); }
__device__ __forceinline__ unsigned xb_add(unsigned* p, unsigned v) { return __hip_atomic_fetch_add(p, v, __ATOMIC_RELAXED, __HIP_MEMORY_SCOPE_AGENT); }
__device__ __forceinline__ unsigned xb_xcc_id() { return (unsigned)__builtin_amdgcn_s_getreg((3 << 11) | 20) & 0xFu; }
#define XB_SPIN(cond, bar) do { unsigned _sp = 0; while (cond) { __builtin_amdgcn_s_sleep(1); \
    if ((++_sp & 255u) == 0u) { if (xb_ld(&(bar)[XB_TMO])) break; if (_sp > XB_SPIN_CAP) { atomicAdd(&(bar)[XB_TMO], 1u); break; } } } } while (0)

struct XcdBarrier {
    unsigned* bar; unsigned x;
    volatile LAS unsigned* st;
};

__device__ __forceinline__ XcdBarrier xcd_barrier_post(unsigned* bar, volatile LAS unsigned* st) {
    XcdBarrier b; b.bar = bar; b.x = xb_xcc_id(); b.st = st;
    if (threadIdx.x == 0) (void)xb_add(&bar[XB_XCNT(b.x)], 1u);
    return b;
}
__device__ __forceinline__ void xcd_barrier_complete(unsigned* bar, unsigned x, unsigned& nloc, unsigned& nx) {
    const unsigned G = gridDim.x * gridDim.y * gridDim.z;
    unsigned sum, cnt, mine, sp = 0u;
    for (;;) {
        sum = 0u; cnt = 0u; mine = 0u;
#pragma unroll
        for (unsigned j = 0; j < 16; ++j) { const unsigned c = xb_ld(&bar[XB_XCNT(j)]); sum += c; cnt += (c > 0u) ? 1u : 0u; mine = (j == x) ? c : mine; }
        if (sum == G) break;
        __builtin_amdgcn_s_sleep(1);
        if ((++sp & 255u) == 0u) { if (xb_ld(&bar[XB_TMO])) break; if (sp > XB_SPIN_CAP) { atomicAdd(&bar[XB_TMO], 1u); break; } }
    }
    nloc = mine > 0u ? mine : 1u; nx = cnt > 0u ? cnt : 1u;
}

__device__ __forceinline__ void xcd_barrier(const XcdBarrier& b) {
    asm volatile("s_waitcnt vmcnt(0)" ::: "memory");
    __syncthreads();
    if (threadIdx.x == 0) {
        unsigned* bar = b.bar;
        __builtin_amdgcn_s_waitcnt(0);
        unsigned nloc = b.st[0], nx = b.st[1];
        if (nloc == 0u) { xcd_barrier_complete(bar, b.x, nloc, nx); b.st[0] = nloc; b.st[1] = nx; }
        const unsigned old = xb_add(&bar[XB_XSUB(b.x)], 1u);
        const unsigned gen = old / nloc;
        if (old + 1u == (gen + 1u) * nloc) {
            __builtin_amdgcn_fence(__ATOMIC_RELEASE, "agent");
            asm volatile("s_waitcnt vmcnt(0)" ::: "memory");
            const unsigned og = xb_add(&bar[XB_TOP], 1u);
            const unsigned tg = og / nx;
            if (og + 1u == (tg + 1u) * nx) xb_add(&bar[XB_TOPGEN], 1u);
            else XB_SPIN(xb_ld(&bar[XB_TOPGEN]) == tg, bar);
            __builtin_amdgcn_fence(__ATOMIC_ACQUIRE, "agent");
            xb_add(&bar[XB_XGEN(b.x)], 1u);
            asm volatile("s_waitcnt vmcnt(0)" ::: "memory");
        } else {
            XB_SPIN(xb_ld(&bar[XB_XGEN(b.x)]) == gen, bar);
            __builtin_amdgcn_fence(__ATOMIC_ACQUIRE, "agent");
            asm volatile("s_waitcnt vmcnt(0)" ::: "memory");
        }
    }
    __syncthreads();
}

__device__ __forceinline__ void late_weight_items(const MK& a, int gwl, int ngwl, float* scr, int lane) {
    const int T4 = 32 * 16, T5 = 176 * 16, T7 = 32 * 44, T8 = 32 * 16, TT = T4 + T5 + T7 + T8;
    for (int it = gwl; it < TT; it += ngwl) {
        int r = it;
        if (r < T4) { const int nt_ = r % 32, kb = r / 32; wt_item(a.w_o, 1024, 32 * nt_, 32, a.WoT(), 1024, 32 * nt_, 64 * kb, scr, lane); continue; } r -= T4;
        if (r < T5) { const int nt_ = r % 176, kb = r / 176, pn = nt_ >> 3, wi = nt_ & 7;
            wt_item(wi < 4 ? a.w_gate : a.w_up, DFF, pn * 128 + (wi & 3) * 32, 32, a.WguT(), 1024, 32 * nt_, 64 * kb, scr, lane); continue; } r -= T5;
        if (r < T7) { const int nt_ = r % 32, kb = r / 32; wt_item(a.w_down, 1024, 32 * nt_, 32, a.WdT(), DFF, 32 * nt_, 64 * kb, scr, lane); continue; } r -= T7;
        { const int nt_ = r % 32, kb = r / 32; wt_item(a.w_ple_gate, 1024, 32 * nt_, 32, a.WpgT(), 1024, 32 * nt_, 64 * kb, scr, lane); }
    }
}

#define XB_ST_OFF 155648
#define LDS_BYTES 155904
static_assert(SAMP_LDS_END <= LDS_BYTES, "LDS map");
#define GSYNC() do { xcd_barrier(xbar); } while (0)
__global__ __launch_bounds__(NTHR, 2) void mega(MK a) {
    cg::grid_group grid = cg::this_grid();
    char* smem = (char*)lds_raw;
    LAS unsigned char* lds = (LAS unsigned char*)lds_raw;
    otid_init();
    if (threadIdx.x < 2) ((LAS unsigned*)(lds_raw + XB_ST_OFF))[threadIdx.x] = 0u;
    __syncthreads();
    const XcdBarrier xbar = xcd_barrier_post(a.ctl(), (volatile LAS unsigned*)(LAS void*)(lds_raw + XB_ST_OFF));
    const int bid = blockIdx.x, nb = gridDim.x, ngw = nb * NWAVE;
#define LOCAL_IDS const int tid = otid(), lane = tid & 63, wid = tid >> 6, half = tid >> 8, gw = bid * NWAVE + wid; (void)lane; (void)half; (void)gw; (void)wid;

    {
    LOCAL_IDS
    {
        const int T0 = 88 * 16, T1 = 24 * 6, T2 = 32 * 4, T3 = 16 * 4, T9 = 32 * 4;
        const int TT = T0 + T1 + T2 + T3 + T9;
        float* scr = (float*)(smem + wid * 8704);
        for (int it = gw; it < TT; it += ngw) {
            int r = it;
            if (r < T0) { const int nt_ = r % 88, kb = r / 88, nv = 2736 - 32 * nt_; wt_item(a.w_in, 2736, 32 * nt_, nv < 0 ? 0 : (nv > 32 ? 32 : nv), a.WinT(), 1024, 32 * nt_, 64 * kb, scr, lane); continue; } r -= T0;
            if (r < T1) { const int nt_ = r % 24, kb = r / 24; wt_item(a.w_q_b, 768, 32 * nt_, 32, a.WqbT(), 384, 32 * nt_, 64 * kb, scr, lane); continue; } r -= T1;
            if (r < T2) { const int nt_ = r % 32, kb = r / 32; wt_item(a.w_kv_b, 1024, 32 * nt_, 32, a.WkvT(), 256, 32 * nt_, 64 * kb, scr, lane); continue; } r -= T2;
            if (r < T3) { const int nt_ = r % 16, kb = r / 16, h = nt_ >> 1; wt_item(a.w_kv_b, 1024, h * 128 + 32 * (nt_ & 1), 32, a.WknT(), 256, 32 * nt_, 64 * kb, scr, lane); continue; } r -= T3;
            { const int nt_ = r % 32, kb = r / 32; wt_item(a.w_ple_proj, 1024, 32 * nt_, 32, a.WppT(), 256, 32 * nt_, 64 * kb, scr, lane); }
        }
        for (int e = (bid * NTHR + tid); e < 2049 * 16; e += nb * NTHR) {
            const int pos = e >> 4, i = e & 15; const float ang = (pos == 2048 ? (float)PAST : (float)pos) * powf(10000.f, -(float)i / 16.f);
            a.ropecs()[pos * 32 + i] = cosf(ang); a.ropecs()[pos * 32 + 16 + i] = sinf(ang);
        }
        for (int row = gw; row < MPAD; row += ngw) {
            const float* src = row < NPT ? a.x_prompt + (size_t)row * 1024 : a.x_sample + (size_t)(row < NTOK ? row - NPT : 0) * 1024;
            rms1024_row(src, a.g_attn, a.xn() + (size_t)row * 1024, row >= NTOK, lane);
            ushort4 w = {0, 0, 0, 0};
            if (row < NTOK) { const float* ps = row < NPT ? a.p_prompt + (size_t)row * 256 : a.p_sample + (size_t)(row - NPT) * 256; const float4 v = *(const float4*)(ps + lane * 4); w.x = f2bf(v.x); w.y = f2bf(v.y); w.z = f2bf(v.z); w.w = f2bf(v.w); }
            *(ushort4*)(a.pb() + (size_t)row * 256 + lane * 4) = w;
            if (row >= NTOK) { for (int j = 0; j < 4; ++j) { ushort4 z = {0, 0, 0, 0}; *(ushort4*)(a.omix() + (size_t)row * 1024 + lane * 4 + 256 * j) = z; } }
        }
    }
    }
    if (a.out == nullptr) grid.sync();
    GSYNC();
    {
    LOCAL_IDS
    pg_gemm(lds, a.xn(), a.WinT(), NPT, ZW, 1024, PgBf16{a.Z(), ZW});
    gemm_sample_rows_ks<false>(a.xn(), 1024, a.WinT(), 1024, ZW, EwBf16{a.Z(), ZW}, smem, bid, nb);
    }
    GSYNC();
    {
    LOCAL_IDS
    for (int e = tid; e < 4 * 1536 / 4; e += NTHR) ((float4*)smem)[e] = ((const float4*)a.w_conv)[e];
    __syncthreads();
    for (int run = gw; run < NPT / 8 + NST; run += ngw) post_in_run(a, run, lane, (const float*)smem);
    }
    GSYNC();
    {
    LOCAL_IDS
    for (int u = gw; u < 2048; u += ngw) gdn_prep_unit(a, u, lane, smem + wid * GDN_WLDS);
    }
    {
    LOCAL_IDS
    for (int v = gw; v < NST * 64; v += ngw) gdn_unit(a, v >> 6, (v >> 3) & 7, v & 7, a.state_gdn, a.out + O_GSS, NPT, 1, lane, smem + wid * GDN_WLDS);
    __syncthreads();
    }
    GSYNC();
    {
    LOCAL_IDS
    pg_gemm(lds, a.qan(), a.WqbT(), NPT, 768, 384, PgBf16{a.qraw(), 768});
    pg_gemm(lds, a.ckvb(), a.WkvT(), NPT, 1024, 256, PgBf16{a.kvraw(), 1024}, nb > 64 ? nb - 64 : 0);
    gemm_sample_rows<false>(a.qan(), 384, a.WqbT(), 384, 768, EwF32{a.Q(), 768}, smem, bid, nb, 64);
    gemm_sample_rows<false>(a.ckvb(), 256, a.WkvT(), 256, 1024, EwF32{a.KV(), 1024}, smem, bid, nb, 72);
    for (int bh_ = nb - 1 - bid; bh_ < 64; bh_ += nb) gdn_scan_block(a, bh_, lds);
    if (nb > 64 && bid < nb - 64) {
        pg_gemm(lds, a.pb(), a.WppT(), NPT, 1024, 256, PgBf16{a.PP(), 1024}, nb - 64);
        __syncthreads();
        late_weight_items(a, bid * NWAVE + wid, (nb - 64) * NWAVE, (float*)(smem + wid * 8704), lane);
    } else if (nb <= 64) { pg_gemm(lds, a.pb(), a.WppT(), NPT, 1024, 256, PgBf16{a.PP(), 1024}); __syncthreads(); late_weight_items(a, gw, ngw, (float*)(smem + wid * 8704), lane); }
    gemm_sample_rows<false>(a.pb(), 256, a.WppT(), 256, 1024, EwBf16{a.PP(), 1024}, smem, bid, nb, 80);
    }
    GSYNC();
    {
    LOCAL_IDS
    for (int idx = gw; idx < NST * 8; idx += ngw) { post_q_item(a, NPT * 8 + idx, lane); post_kv_item(a, NPT * 8 + idx, lane); }
    for (int row = gw; row < NTOK; row += ngw) gdn_out_token(a, row, lane);
    for (int pr = bid; pr < 256; pr += nb) { const int bh_ = pr >> 2, s_ = pr & 3; attn_block(a, bh_ >> 3, bh_ & 7, 7 - s_, smem); attn_block(a, bh_ >> 3, bh_ & 7, s_, smem); }
    for (int u = bid; u < NST * 8; u += nb) samp_attn_unit(a, u, smem, lds);
    }
    GSYNC();
    {
    LOCAL_IDS
    for (int u = bid; u < NST * 8; u += nb) samp_comb_unit(a, u, smem);
    }
    GSYNC();
    {
    LOCAL_IDS
    pg_gemm(lds, a.omix(), a.WoT(), NPT, 1024, 1024, PgResXB{a.x_prompt, a.H()});
    gemm_sample_rows_ks<false>(a.omix(), 1024, a.WoT(), 1024, 1024, EwResX{a.x_sample, a.H()}, smem, bid, nb);
    }
    GSYNC();
    {
    LOCAL_IDS
    for (int row = gw; row < MPAD; row += ngw) rms1024_row_b(a.H() + (size_t)row * 1024, a.g_ffn, a.un() + (size_t)row * 1024, row >= NTOK, lane);
    }
    GSYNC();
    {
    LOCAL_IDS
    pg_gemm(lds, a.un(), a.WguT(), NPT, 2 * DFF, 1024, PgSwiglu{a.hid()});
    gemm_sample_rows_ks<true>(a.un(), 1024, a.WguT(), 1024, 2 * DFF, EwBf16{a.hid(), DFF}, smem, bid, nb);
    }
    GSYNC();
    {
    LOCAL_IDS
    pg_gemm(lds, a.hid(), a.WdT(), NPT, 1024, DFF, PgResBB{a.H(), a.H2()});
    gemm_sample_rows_ks<false>(a.hid(), DFF, a.WdT(), DFF, 1024, EwResH{a.H(), a.H2()}, smem, bid, nb);
    }
    GSYNC();
    {
    LOCAL_IDS
    for (int row = gw; row < MPAD; row += ngw) rms1024_row_b(a.H2() + (size_t)row * 1024, a.g_ple, a.un2() + (size_t)row * 1024, row >= NTOK, lane);
    }
    GSYNC();
    {
    LOCAL_IDS
    pg_gemm(lds, a.un2(), a.WpgT(), NPT, 1024, 1024, PgPleB{a.H2(), a.PP(), a.out});
    gemm_sample_rows_ks<false>(a.un2(), 1024, a.WpgT(), 1024, 1024, EwPle{a.H2(), a.PP(), a.out}, smem, bid, nb);
    }
}

static inline char* carve(char*& p, size_t bytes) { char* r = p; p += (bytes + 255) & ~(size_t)255; return r; }

extern "C" void kernel_launch(void* const* d_in, const int* in_sizes, int n_in, void* d_out, int out_size, void* d_ws, size_t ws_size, hipStream_t stream) {
    MK a{};
    a.x_prompt = (const float*)d_in[0]; a.x_sample = (const float*)d_in[1]; a.cache_ckv = (const float*)d_in[2]; a.cache_krope = (const float*)d_in[3];
    a.state_gdn = (const float*)d_in[4]; a.state_conv = (const float*)d_in[5]; a.page_table = (const int*)d_in[6]; a.p_prompt = (const float*)d_in[7]; a.p_sample = (const float*)d_in[8];
    a.g_attn = (const float*)d_in[9]; a.w_in = (const float*)d_in[10]; a.w_conv = (const float*)d_in[11]; a.a_log = (const float*)d_in[12]; a.dt_bias = (const float*)d_in[13];
    a.g_gdn_out = (const float*)d_in[14]; a.g_q_a = (const float*)d_in[15]; a.w_q_b = (const float*)d_in[16]; a.g_q_nope = (const float*)d_in[17]; a.g_q_rope = (const float*)d_in[18];
    a.g_kv_a = (const float*)d_in[19]; a.g_k_rope = (const float*)d_in[20]; a.w_kv_b = (const float*)d_in[21]; a.g_k_nope = (const float*)d_in[22]; a.w_o = (const float*)d_in[23];
    a.g_ffn = (const float*)d_in[24]; a.w_gate = (const float*)d_in[25]; a.w_up = (const float*)d_in[26]; a.w_down = (const float*)d_in[27]; a.g_ple = (const float*)d_in[28];
    a.w_ple_gate = (const float*)d_in[29]; a.w_ple_proj = (const float*)d_in[30];
    a.out = (float*)d_out;
    a.ws = (char*)d_ws;
    if (WS_TOTAL > ws_size) { fprintf(stderr, "kernel_launch: workspace too small: need %zu have %zu\n", (size_t)WS_TOTAL, ws_size); return; }

    static int grid_blocks = 0;
    if (!grid_blocks) {
        int dev = 0, cus = 0, per_cu = 0;
        (void)hipGetDevice(&dev);
        (void)hipDeviceGetAttribute(&cus, hipDeviceAttributeMultiprocessorCount, dev);
        (void)hipFuncSetAttribute((const void*)mega, hipFuncAttributeMaxDynamicSharedMemorySize, LDS_BYTES);
        (void)hipOccupancyMaxActiveBlocksPerMultiprocessor(&per_cu, (const void*)mega, NTHR, LDS_BYTES);
        if (per_cu < 1) fprintf(stderr, "kernel_launch: occupancy query says %d blocks/CU\n", per_cu);
        grid_blocks = cus;
    }
    (void)hipMemsetAsync((char*)d_ws + WOF_ctl, 0, 16384, stream);
    void* args[] = {&a};
    hipError_t e = hipLaunchCooperativeKernel((const void*)mega, dim3(grid_blocks), dim3(NTHR), args, LDS_BYTES, stream);
    if (e != hipSuccess) fprintf(stderr, "cooperative launch failed: %s (grid %d)\n", hipGetErrorString(e), grid_blocks);
}
```

```cpp
#include <hip/hip_runtime.h>
#include <stdint.h>
#include <cstdio>
#include <hip/hip_cooperative_groups.h>
namespace cg = cooperative_groups;


__device__ __forceinline__ int otid();
#define PG8_TID() otid()
namespace pg8 {
#define PG8_LAS __attribute__((address_space(3)))
typedef unsigned short bf16_t;
typedef short bf16x8 __attribute__((ext_vector_type(8)));
typedef float f32x4 __attribute__((ext_vector_type(4)));
typedef unsigned u32x4 __attribute__((ext_vector_type(4)));
constexpr int BM = 256, BK = 64, HALF = 128, HTB = HALF * BK * 2  , STAGE_BYTES = 8 * HTB, NXCD = 8, WGM = 8;

__host__ __device__ __forceinline__ int lds_byte(int r, int c) { const int st = (r >> 4) * 2 + (c >> 5), rr = r & 15, cc = c & 31, ob = rr * 64 + cc * 2; return st * 1024 + (ob ^ (((ob >> 9) & 1) << 5)); }
__host__ __device__ __forceinline__ void stage_rc(int b, int& R, int& C) { const int st = b / 1024, sb = b % 1024, swz = sb ^ (((sb >> 9) & 1) << 5); R = (st >> 1) * 16 + swz / 64; C = (st & 1) * 32 + (swz % 64) / 2; }
__host__ __device__ __forceinline__ int perm32(int rho) { const int n = rho >> 4, i = rho & 15; return 8 * (i >> 2) + 4 * n + (i & 3); }

struct Unit { int pm, pn; };
struct Gemm { const bf16_t* A; const bf16_t* Bt; int M, N, K; };

struct StaticOrder {
    int nM, nN, nwg, G, c;
    __host__ __device__ void init(int M, int N, int G_, int c_) { nM = M / BM; nN = N / BM; nwg = nM * nN; G = G_; c = c_; }
    __host__ __device__ bool next(int i, Unit& u) const {
        const long L = (long)i * G + c; if (L >= nwg) return false;
        int wgid = (int)L; { const int q = nwg / NXCD, r = nwg % NXCD, xcd = wgid % NXCD, off = wgid / NXCD; wgid = (xcd < r ? xcd * (q + 1) : r * (q + 1) + (xcd - r) * q) + off; }
        const int nig = WGM * nN, gid = wgid / nig, fm = gid * WGM, gsz = (nM - fm) < WGM ? (nM - fm) : WGM;
        u.pm = fm + ((wgid % nig) % gsz); u.pn = (wgid % nig) / gsz; return true;
    }
    __device__ __forceinline__ void a_ready(const Unit&) const {}
    __device__ __forceinline__ void done(const Unit&) const {}
};

template <class Epi, class Sched, bool ALIGN_EPI = false, bool SP2 = false>
__device__ __forceinline__ void gemm_phase(PG8_LAS unsigned char* lds, const Gemm g, const Sched& S, const Epi& E) {
    const int tid = PG8_TID(), wid = __builtin_amdgcn_readfirstlane(tid >> 6), lane = tid & 63, wr = wid >> 2, wc = wid & 3, fr = lane & 15, fq = lane >> 4;
    const int K = g.K, nt = K / BK;
    unsigned voffA[2], voffB[2];
#pragma unroll
    for (int i = 0; i < 2; ++i) { int R, C; stage_rc(tid * 16 + i * 8192, R, C); const int Rb = Epi::PERM ? ((R & ~31) + perm32(R & 31)) : R;
        voffA[i] = (unsigned)(R * K + C) * 2u; voffB[i] = (unsigned)(Rb * K + C) * 2u; }
    const size_t kstep = (size_t)(BK * 2);
    const size_t hstep = (size_t)HALF * K * 2;
    const size_t tstep = 2 * hstep;
    const unsigned ldsw = (unsigned)wid * 1024u;
    const int aoff = lds_byte(wr * 64 + fr, fq * 8), boff = lds_byte(wc * 32 + fr, fq * 8);
#define PG8_SA(b, h) (((b) * 2 + (h)) * HTB)
#define PG8_SB(b, h) ((4 + (b) * 2 + (h)) * HTB)
#define PG8_STAGE(bufoff, gbase, voff) do { _Pragma("unroll") for (int _i = 0; _i < 2; ++_i) \
        __builtin_amdgcn_global_load_lds((const unsigned*)((const char*)(gbase) + (voff)[_i]), (PG8_LAS unsigned*)(lds + (bufoff) + ldsw + _i * 8192), 16, 0, 0); } while (0)
#define PG8_LDA(dst, b, h) do { _Pragma("unroll") for (int m = 0; m < 4; ++m) _Pragma("unroll") for (int k = 0; k < 2; ++k) dst[m][k] = *(const PG8_LAS bf16x8*)(lds + PG8_SA(b, h) + aoff + m * 2048 + k * 1024); } while (0)
#define PG8_LDB(dst, b, h) do { _Pragma("unroll") for (int n = 0; n < 2; ++n) _Pragma("unroll") for (int k = 0; k < 2; ++k) dst[n][k] = *(const PG8_LAS bf16x8*)(lds + PG8_SB(b, h) + boff + n * 2048 + k * 1024); } while (0)
#define PG8_MMA(ai, bj, At, Bt) do { __builtin_amdgcn_s_setprio(1); _Pragma("unroll") for (int m = 0; m < 4; ++m) _Pragma("unroll") for (int n = 0; n < 2; ++n) _Pragma("unroll") for (int k = 0; k < 2; ++k) \
        acc[ai][bj][m][n] = __builtin_amdgcn_mfma_f32_16x16x32_bf16(Bt[n][k], At[m][k], acc[ai][bj][m][n], 0, 0, 0); __builtin_amdgcn_s_setprio(0); } while (0)
#define PG8_WAIT_V(n) asm volatile("s_waitcnt vmcnt(" #n ")" ::: "memory")
#define PG8_WAIT_L(n) asm volatile("s_waitcnt lgkmcnt(" #n ")" ::: "memory")
#define PG8_BAR __builtin_amdgcn_s_barrier()
#define PG8_SCHED __builtin_amdgcn_sched_barrier(0)
    Unit cur, nxt; int ui = 0;
    if (!S.next(0, cur)) return;
    f32x4 acc[2][2][4][2];
#pragma unroll
    for (int a = 0; a < 2; ++a)
#pragma unroll
        for (int b = 0; b < 2; ++b)
#pragma unroll
            for (int m = 0; m < 4; ++m)
#pragma unroll
                for (int n = 0; n < 2; ++n) acc[a][b][m][n] = (f32x4){0.f, 0.f, 0.f, 0.f};
    bf16x8 At[4][2], B0[2][2], B1[2][2];
    const char* cA = (const char*)g.A + (size_t)cur.pm * tstep; const char* cB = (const char*)g.Bt + (size_t)cur.pn * tstep;
    S.a_ready(cur);
    if constexpr (SP2) {
        PG8_STAGE(PG8_SB(0, 0), cB, voffB); PG8_STAGE(PG8_SB(0, 1), cB + hstep, voffB); PG8_STAGE(PG8_SA(0, 0), cA, voffA); PG8_STAGE(PG8_SA(0, 1), cA + hstep, voffA);
        if (wr == 1) PG8_BAR;
        PG8_WAIT_V(2); PG8_BAR;
        PG8_STAGE(PG8_SB(1, 0), cB + kstep, voffB); PG8_STAGE(PG8_SA(1, 0), cA + kstep, voffA); PG8_STAGE(PG8_SB(1, 1), cB + hstep + kstep, voffB);
        PG8_WAIT_V(6); PG8_BAR;
    } else {
        PG8_STAGE(PG8_SB(0, 0), cB, voffB); PG8_STAGE(PG8_SA(0, 0), cA, voffA); PG8_STAGE(PG8_SB(0, 1), cB + hstep, voffB); PG8_STAGE(PG8_SA(0, 1), cA + hstep, voffA);
        if (wr == 1) PG8_BAR;
        PG8_WAIT_V(4); PG8_BAR;
        PG8_STAGE(PG8_SB(1, 0), cB + kstep, voffB); PG8_STAGE(PG8_SA(1, 0), cA + kstep, voffA); PG8_STAGE(PG8_SB(1, 1), cB + hstep + kstep, voffB);
        PG8_WAIT_V(6); PG8_BAR;
    }
    for (;;) {
        const bool has_next = S.next(ui + 1, nxt);
        const char* nA = has_next ? (const char*)g.A + (size_t)nxt.pm * tstep : cA; const char* nB = has_next ? (const char*)g.Bt + (size_t)nxt.pn * tstep : cB;
        for (int t = 0; t < nt; t += 2) {
            const bool last = (t == nt - 2);
            const char* a1 = cA + (size_t)(t + 1) * kstep;
            const char* a2 = last ? nA : cA + (size_t)(t + 2) * kstep; const char* b2 = last ? nB : cB + (size_t)(t + 2) * kstep;
            const char* a3 = a2 + kstep; const char* b3 = b2 + kstep;
            if (last && has_next) S.a_ready(nxt);
            if constexpr (SP2) {
            PG8_LDB(B0, 0, 0); PG8_LDB(B1, 0, 1); PG8_SCHED; PG8_LDA(At, 0, 0); PG8_STAGE(PG8_SA(1, 1), a1 + hstep, voffA);
            PG8_WAIT_V(8); PG8_WAIT_L(0); PG8_BAR; PG8_MMA(0, 0, At, B0); PG8_MMA(0, 1, At, B1); PG8_BAR; PG8_SCHED;
            PG8_LDA(At, 0, 1); PG8_STAGE(PG8_SB(0, 0), b2, voffB); PG8_STAGE(PG8_SB(0, 1), b2 + hstep, voffB); PG8_STAGE(PG8_SA(0, 0), a2, voffA);
            PG8_WAIT_V(8); PG8_WAIT_L(0); PG8_BAR; PG8_MMA(1, 0, At, B0); PG8_MMA(1, 1, At, B1); PG8_BAR; PG8_SCHED;
            PG8_LDB(B0, 1, 0); PG8_LDB(B1, 1, 1); PG8_SCHED; PG8_LDA(At, 1, 0); PG8_STAGE(PG8_SA(0, 1), a2 + hstep, voffA);
            PG8_WAIT_V(8); PG8_WAIT_L(0); PG8_BAR; PG8_MMA(0, 0, At, B0); PG8_MMA(0, 1, At, B1); PG8_BAR; PG8_SCHED;
            PG8_LDA(At, 1, 1); PG8_STAGE(PG8_SB(1, 0), b3, voffB); PG8_STAGE(PG8_SB(1, 1), b3 + hstep, voffB); PG8_STAGE(PG8_SA(1, 0), a3, voffA);
            PG8_WAIT_V(8); PG8_WAIT_L(0); PG8_BAR; PG8_MMA(1, 0, At, B0); PG8_MMA(1, 1, At, B1); PG8_BAR; PG8_SCHED;
            } else {
            PG8_LDB(B0, 0, 0); PG8_SCHED; PG8_LDA(At, 0, 0); PG8_STAGE(PG8_SA(1, 1), a1 + hstep, voffA);
            PG8_WAIT_L(8); PG8_BAR; PG8_WAIT_L(0); PG8_MMA(0, 0, At, B0); PG8_BAR; PG8_SCHED;
            PG8_LDB(B1, 0, 1); PG8_STAGE(PG8_SB(0, 0), b2, voffB);
            PG8_BAR; PG8_WAIT_L(0); PG8_MMA(0, 1, At, B1); PG8_BAR;
            PG8_LDA(At, 0, 1); PG8_STAGE(PG8_SA(0, 0), a2, voffA);
            PG8_BAR; PG8_WAIT_L(0); PG8_MMA(1, 0, At, B0); PG8_BAR; PG8_SCHED;
            PG8_STAGE(PG8_SB(0, 1), b2 + hstep, voffB);
            PG8_WAIT_V(6); PG8_BAR; PG8_MMA(1, 1, At, B1); PG8_BAR;
            PG8_LDB(B0, 1, 0); PG8_SCHED; PG8_LDA(At, 1, 0); PG8_STAGE(PG8_SA(0, 1), a2 + hstep, voffA);
            PG8_WAIT_L(8); PG8_BAR; PG8_WAIT_L(0); PG8_MMA(0, 0, At, B0); PG8_BAR; PG8_SCHED;
            PG8_LDB(B1, 1, 1); PG8_STAGE(PG8_SB(1, 0), b3, voffB);
            PG8_BAR; PG8_WAIT_L(0); PG8_MMA(0, 1, At, B1); PG8_BAR;
            PG8_LDA(At, 1, 1); PG8_STAGE(PG8_SA(1, 0), a3, voffA);
            PG8_BAR; PG8_WAIT_L(0); PG8_MMA(1, 0, At, B0); PG8_BAR; PG8_SCHED;
            PG8_STAGE(PG8_SB(1, 1), b3 + hstep, voffB);
            PG8_WAIT_V(6); PG8_BAR; PG8_MMA(1, 1, At, B1); PG8_BAR;
            }
        }
        if constexpr (ALIGN_EPI) { if (wr == 0) PG8_BAR; }
        if constexpr (!Epi::AFTER_DRAIN) { E(acc, cur, wr, wc, fr, fq); S.done(cur); }
        if (!has_next) break;
#pragma unroll
        for (int a = 0; a < 2; ++a)
#pragma unroll
            for (int b = 0; b < 2; ++b)
#pragma unroll
                for (int m = 0; m < 4; ++m)
#pragma unroll
                    for (int n = 0; n < 2; ++n) acc[a][b][m][n] = (f32x4){0.f, 0.f, 0.f, 0.f};
        cur = nxt; cA = nA; cB = nB; ++ui;
        if constexpr (ALIGN_EPI) { if (wr == 1) PG8_BAR; }
    }
    PG8_WAIT_V(0);
    if constexpr (!ALIGN_EPI) { if (wr == 0) PG8_BAR; }
    PG8_BAR;
    if constexpr (Epi::AFTER_DRAIN) { E.fused(acc, cur, wr, wc, fr, fq, lds, wid, lane); S.done(cur); }
#undef PG8_SA
#undef PG8_SB
#undef PG8_STAGE
#undef PG8_LDA
#undef PG8_LDB
#undef PG8_MMA
#undef PG8_WAIT_V
#undef PG8_WAIT_L
#undef PG8_BAR
#undef PG8_SCHED
}
}

#define WTAB_OFF 155392
extern __shared__ __attribute__((aligned(16))) unsigned char lds_raw[];
__device__ __forceinline__ int hw_slot() { return (int)(__builtin_amdgcn_s_getreg((5 << 11) | 4) & 63u); }
__device__ __forceinline__ void otid_init() { const int t = threadIdx.x; if ((t & 63) == 0) ((__attribute__((address_space(3))) int*)(__attribute__((address_space(3))) void*)(lds_raw + WTAB_OFF))[hw_slot()] = t >> 6; }
__device__ __forceinline__ int otid() {
    const int w = __builtin_amdgcn_readfirstlane(((const __attribute__((address_space(3))) int*)(__attribute__((address_space(3))) void*)(lds_raw + WTAB_OFF))[hw_slot()]);
    int l; asm volatile("v_mbcnt_lo_u32_b32 %0, -1, 0\n\tv_mbcnt_hi_u32_b32 %0, -1, %0" : "=v"(l));
    return (w << 6) + l;
}
using pg8::bf16_t; using pg8::bf16x8; using pg8::f32x4; using pg8::u32x4;
#define LAS __attribute__((address_space(3)))

#define DMODEL 1024
#define NPT 16384
#define NST 32
#define NTOK 16416
#define MPAD 16640
#define SEQ 2048
#define ZW 2816
#define OFF_A 1536
#define OFF_B 1544
#define OFF_Z 1552
#define OFF_QA 2064
#define OFF_KVA 2448
#define OFF_KR 2704
#define DFF 2816
#define PAST 16384
#define NPAGES 128
#define EPSV 1e-6f

#define O_YP 0
#define O_YS (O_YP + 16777216)
#define O_CKVP (O_YS + 32768)
#define O_KRP (O_CKVP + 4194304)
#define O_GSP (O_KRP + 524288)
#define O_CSP (O_GSP + 262144)
#define O_CKVS (O_CSP + 36864)
#define O_KRS (O_CKVS + 8192)
#define O_GSS (O_KRS + 1024)
#define O_CSS (O_GSS + 1048576)

__device__ __forceinline__ bf16_t f2bf(float f) { unsigned u = __float_as_uint(f); return (bf16_t)((u + 0x7fffu + ((u >> 16) & 1u)) >> 16); }
__device__ __forceinline__ float bf2f(bf16_t b) { return __uint_as_float(((unsigned)b) << 16); }
template <int CTRL> __device__ __forceinline__ float dpp_mov(float x) { return __uint_as_float((unsigned)__builtin_amdgcn_update_dpp((int)__float_as_uint(x), (int)__float_as_uint(x), CTRL, 0xF, 0xF, true)); }
__device__ __forceinline__ float add_x16(float x) { auto r = __builtin_amdgcn_permlane16_swap(__float_as_uint(x), __float_as_uint(x), false, false); return __uint_as_float(r[0]) + __uint_as_float(r[1]); }
__device__ __forceinline__ float add_x32(float x) { auto r = __builtin_amdgcn_permlane32_swap(__float_as_uint(x), __float_as_uint(x), false, false); return __uint_as_float(r[0]) + __uint_as_float(r[1]); }
__device__ __forceinline__ float max_x32(float x) { auto r = __builtin_amdgcn_permlane32_swap(__float_as_uint(x), __float_as_uint(x), false, false); return fmaxf(__uint_as_float(r[0]), __uint_as_float(r[1])); }
__device__ __forceinline__ float sum8(float x) { x += dpp_mov<0xB1>(x); x += dpp_mov<0x4E>(x); x += dpp_mov<0x141>(x); return x; }
__device__ __forceinline__ float sum16(float x) { x = sum8(x); x += dpp_mov<0x140>(x); return x; }
__device__ __forceinline__ float max16(float x) { x = fmaxf(x, dpp_mov<0xB1>(x)); x = fmaxf(x, dpp_mov<0x4E>(x)); x = fmaxf(x, dpp_mov<0x141>(x)); x = fmaxf(x, dpp_mov<0x140>(x)); return x; }
__device__ __forceinline__ float wave_sum(float v) { return add_x32(add_x16(sum16(v))); }
__device__ __forceinline__ float sigmoidf_(float x) { return __builtin_amdgcn_rcpf(1.f + __builtin_amdgcn_exp2f(-1.44269504f * x)); }
__device__ __forceinline__ float siluf_(float x) { return x * __builtin_amdgcn_rcpf(1.f + __builtin_amdgcn_exp2f(-1.44269504f * x)); }


#define WSYNC() do { __builtin_amdgcn_fence(__ATOMIC_ACQ_REL, "wavefront"); __builtin_amdgcn_wave_barrier(); } while (0)
#define NTHR 512
#define NWAVE 8

typedef float f32x2_t __attribute__((ext_vector_type(2)));
typedef __bf16 bf16x2_t __attribute__((ext_vector_type(2)));
__device__ __forceinline__ unsigned cvtpk(float lo, float hi) { f32x2_t v = {lo, hi}; bf16x2_t r = __builtin_convertvector(v, bf16x2_t); return __builtin_bit_cast(unsigned, r); }
__device__ __forceinline__ void bf8_to_f32(const bf16x8& v, float* o) {
#pragma unroll
    for (int e = 0; e < 8; ++e) o[e] = __uint_as_float(((unsigned)(unsigned short)v[e]) << 16);
}
__device__ __forceinline__ bf16x8 f32_to_bf8(const float* x) {
    u32x4 w; w.x = cvtpk(x[0], x[1]); w.y = cvtpk(x[2], x[3]); w.z = cvtpk(x[4], x[5]); w.w = cvtpk(x[6], x[7]);
    return __builtin_bit_cast(bf16x8, w);
}
__device__ __forceinline__ unsigned pk2bf(float lo, float hi) { return (unsigned)f2bf(lo) | ((unsigned)f2bf(hi) << 16); }

__device__ __forceinline__ void wt_item(const float* __restrict__ W, int ldw, int col0, int nvalid, bf16_t* __restrict__ WT, int ldt, int nrow0, int k0, float* scr, int lane) {
    WSYNC();
#pragma unroll 8
    for (int i = 0; i < 32; ++i) { const int kk = 2 * i + (lane >> 5), n = lane & 31; scr[kk * 33 + n] = n < nvalid ? W[(size_t)(k0 + kk) * ldw + col0 + n] : 0.f; }
    WSYNC();
    const int c = lane & 7;
#pragma unroll
    for (int j = 0; j < 4; ++j) { const int n = (lane >> 3) + 8 * j; const float* sp = scr + (8 * c) * 33 + n;
        u32x4 o; o.x = cvtpk(sp[0], sp[33]); o.y = cvtpk(sp[2 * 33], sp[3 * 33]); o.z = cvtpk(sp[4 * 33], sp[5 * 33]); o.w = cvtpk(sp[6 * 33], sp[7 * 33]);
        *(u32x4*)(WT + (size_t)(nrow0 + n) * ldt + k0 + 8 * c) = o; }
}

__device__ __forceinline__ void rms1024_row(const float* __restrict__ src, const float* __restrict__ g, bf16_t* __restrict__ o, bool zero, int lane) {
    if (zero) { for (int j = 0; j < 4; ++j) { ushort4 z = {0, 0, 0, 0}; *(ushort4*)(o + lane * 4 + 256 * j) = z; } return; }
    float4 v[4]; float ss = 0.f;
#pragma unroll
    for (int j = 0; j < 4; ++j) { v[j] = *(const float4*)(src + lane * 4 + 256 * j); ss += v[j].x * v[j].x + v[j].y * v[j].y + v[j].z * v[j].z + v[j].w * v[j].w; }
    ss = wave_sum(ss);
    const float rs = rsqrtf(ss * (1.f / 1024.f) + EPSV);
#pragma unroll
    for (int j = 0; j < 4; ++j) {
        const float4 gg = *(const float4*)(g + lane * 4 + 256 * j);
        ushort4 w; w.x = f2bf(v[j].x * rs * gg.x); w.y = f2bf(v[j].y * rs * gg.y); w.z = f2bf(v[j].z * rs * gg.z); w.w = f2bf(v[j].w * rs * gg.w);
        *(ushort4*)(o + lane * 4 + 256 * j) = w;
    }
}

__device__ __forceinline__ void rms1024_row_b(const bf16_t* __restrict__ src, const float* __restrict__ g, bf16_t* __restrict__ o, bool zero, int lane) {
    if (zero) { for (int j = 0; j < 2; ++j) { const u32x4 z = {0u, 0u, 0u, 0u}; *(u32x4*)(o + lane * 8 + 512 * j) = z; } return; }
    float v[2][8]; float ss = 0.f;
#pragma unroll
    for (int j = 0; j < 2; ++j) { bf8_to_f32(*(const bf16x8*)(src + lane * 8 + 512 * j), v[j]);
#pragma unroll
        for (int e = 0; e < 8; ++e) ss += v[j][e] * v[j][e]; }
    ss = wave_sum(ss);
    const float rs = rsqrtf(ss * (1.f / 1024.f) + EPSV);
#pragma unroll
    for (int j = 0; j < 2; ++j) {
        const float4 g0 = *(const float4*)(g + lane * 8 + 512 * j), g1 = *(const float4*)(g + lane * 8 + 512 * j + 4);
        float t[8] = {v[j][0] * rs * g0.x, v[j][1] * rs * g0.y, v[j][2] * rs * g0.z, v[j][3] * rs * g0.w, v[j][4] * rs * g1.x, v[j][5] * rs * g1.y, v[j][6] * rs * g1.z, v[j][7] * rs * g1.w};
        *(bf16x8*)(o + lane * 8 + 512 * j) = f32_to_bf8(t);
    }
}

struct ABf16 { const bf16_t* p; int lda; __device__ __forceinline__ bf16x8 load(int m, int k) const { return *(const bf16x8*)(p + (size_t)m * lda + k); } };
template <bool SWIGLU, class Epi>
__device__ __forceinline__ void gemm_sample_rows(const bf16_t* __restrict__ A, int lda, const bf16_t* __restrict__ Bt, int K, int N, const Epi& epi, char*  , int bid, int nb, int first = -1) {
    const int tid = otid(), lane = tid & 63, wid = tid >> 6, i16 = lane & 15, q4 = lane >> 4;
    for (int u = first >= 0 ? (bid - first + nb) % nb : nb - 1 - bid; u < N / 256; u += nb) {
        const int n0 = u * 256;
        const int c0 = SWIGLU ? n0 + 16 * wid : n0 + 32 * wid, c1 = SWIGLU ? n0 + 128 + 16 * wid : n0 + 32 * wid + 16;
        const bf16_t* a0p = A + (size_t)(NPT + i16) * lda + 8 * q4; const bf16_t* a1p = a0p + (size_t)16 * lda;
        const bf16_t* b0p = Bt + (size_t)(c0 + i16) * K + 8 * q4; const bf16_t* b1p = Bt + (size_t)(c1 + i16) * K + 8 * q4;
        f32x4 acc[2][2];
#pragma unroll
        for (int i = 0; i < 2; ++i)
#pragma unroll
            for (int j = 0; j < 2; ++j) acc[i][j] = (f32x4){0.f, 0.f, 0.f, 0.f};
#pragma unroll 4
        for (int k0 = 0; k0 < K; k0 += 32) {
            const bf16x8 a0 = *(const bf16x8*)(a0p + k0), a1 = *(const bf16x8*)(a1p + k0), b0 = *(const bf16x8*)(b0p + k0), b1 = *(const bf16x8*)(b1p + k0);
            acc[0][0] = __builtin_amdgcn_mfma_f32_16x16x32_bf16(a0, b0, acc[0][0], 0, 0, 0); acc[0][1] = __builtin_amdgcn_mfma_f32_16x16x32_bf16(a0, b1, acc[0][1], 0, 0, 0);
            acc[1][0] = __builtin_amdgcn_mfma_f32_16x16x32_bf16(a1, b0, acc[1][0], 0, 0, 0); acc[1][1] = __builtin_amdgcn_mfma_f32_16x16x32_bf16(a1, b1, acc[1][1], 0, 0, 0);
        }
#pragma unroll
        for (int i = 0; i < 2; ++i)
#pragma unroll
            for (int r = 0; r < 4; ++r) {
                const int m = NPT + 16 * i + 4 * q4 + r;
                if constexpr (SWIGLU) epi(m, (n0 >> 1) + 16 * wid + i16, siluf_(acc[i][0][r]) * acc[i][1][r]);
                else { epi(m, c0 + i16, acc[i][0][r]); epi(m, c1 + i16, acc[i][1][r]); }
            }
    }
}
template <bool SWIGLU, class Epi, int NJ = 4>
__device__ __forceinline__ void gemm_sample_rows_ks(const bf16_t* __restrict__ A, int lda, const bf16_t* __restrict__ Bt, int K, int N, const Epi& epi, char* smem, int bid, int nb) {
    const int tid = otid(), lane = tid & 63, wid = tid >> 6, i16 = lane & 15, q4 = lane >> 4;
    static_assert(!SWIGLU || NJ == 4, "swiglu units are 64 rows wide");
    const int nunits = N / (16 * NJ), ksl = K >> 3;
    f32x4* red = (f32x4*)smem;
    for (int u = nb - 1 - bid; u < nunits; u += nb) {
        int brow[NJ];
#pragma unroll
        for (int j = 0; j < NJ; ++j) brow[j] = SWIGLU ? ((32 * u) >> 7) * 256 + ((32 * u) & 127) + 128 * (j >> 1) + 16 * (j & 1) + i16 : 16 * NJ * u + 16 * j + i16;
        const bf16_t* a0p = A + (size_t)(NPT + i16) * lda + wid * ksl + 8 * q4; const bf16_t* a1p = a0p + (size_t)16 * lda;
        f32x4 acc[2][NJ];
#pragma unroll
        for (int i = 0; i < 2; ++i)
#pragma unroll
            for (int j = 0; j < NJ; ++j) acc[i][j] = (f32x4){0.f, 0.f, 0.f, 0.f};
        for (int k0 = 0; k0 < ksl; k0 += 32) {
            const bf16x8 a0 = *(const bf16x8*)(a0p + k0), a1 = *(const bf16x8*)(a1p + k0);
            bf16x8 b[NJ];
#pragma unroll
            for (int j = 0; j < NJ; ++j) b[j] = *(const bf16x8*)(Bt + (size_t)brow[j] * K + wid * ksl + 8 * q4 + k0);
#pragma unroll
            for (int j = 0; j < NJ; ++j) { acc[0][j] = __builtin_amdgcn_mfma_f32_16x16x32_bf16(a0, b[j], acc[0][j], 0, 0, 0); acc[1][j] = __builtin_amdgcn_mfma_f32_16x16x32_bf16(a1, b[j], acc[1][j], 0, 0, 0); }
        }
        __syncthreads();
#pragma unroll
        for (int i = 0; i < 2; ++i)
#pragma unroll
            for (int j = 0; j < NJ; ++j) red[(wid * 2 * NJ + i * NJ + j) * 64 + lane] = acc[i][j];
        __syncthreads();
        if constexpr (SWIGLU) {
            if (tid < 256) {
                const int t4 = tid >> 6, i = t4 >> 1, jg = t4 & 1, l = tid & 63;
                f32x4 g = red[(i * 4 + jg) * 64 + l], up = red[(i * 4 + jg + 2) * 64 + l];
#pragma unroll
                for (int w = 1; w < 8; ++w) { g = g + red[(w * 8 + i * 4 + jg) * 64 + l]; up = up + red[(w * 8 + i * 4 + jg + 2) * 64 + l]; }
#pragma unroll
                for (int r = 0; r < 4; ++r) epi(NPT + 16 * i + 4 * (l >> 4) + r, 32 * u + 16 * jg + (l & 15), siluf_(g[r]) * up[r]);
            }
        } else {
            const int t8 = tid >> 6, l = tid & 63, i = t8 / NJ, j = t8 % NJ;
            if (t8 < 2 * NJ) {
                f32x4 v = red[t8 * 64 + l];
#pragma unroll
                for (int w = 1; w < 8; ++w) v = v + red[(w * 2 * NJ + t8) * 64 + l];
#pragma unroll
                for (int r = 0; r < 4; ++r) epi(NPT + 16 * i + 4 * (l >> 4) + r, 16 * NJ * u + 16 * j + (l & 15), v[r]);
            }
        }
    }
    __syncthreads();
}
struct EwF32 { float* C; int ldc; __device__ __forceinline__ void operator()(int m, int n, float v) const { C[(size_t)m * ldc + n] = v; } };
struct EwBf16 { bf16_t* C; int ldc; __device__ __forceinline__ void operator()(int m, int n, float v) const { C[(size_t)m * ldc + n] = f2bf(v); } };
struct EwResX { const float* xs; bf16_t* C; __device__ __forceinline__ void operator()(int m, int n, float v) const { C[(size_t)m * 1024 + n] = f2bf(xs[(size_t)(m - NPT) * 1024 + n] + v); } };
struct EwResH { const bf16_t* H; bf16_t* C; __device__ __forceinline__ void operator()(int m, int n, float v) const { C[(size_t)m * 1024 + n] = f2bf(bf2f(H[(size_t)m * 1024 + n]) + v); } };
struct EwPle { const bf16_t* H2; const bf16_t* PP; float* out;
    __device__ __forceinline__ void operator()(int m, int n, float v) const { out[O_YS + (size_t)(m - NPT) * 1024 + n] = bf2f(H2[(size_t)m * 1024 + n]) + bf2f(PP[(size_t)m * 1024 + n]) * sigmoidf_(v); } };

struct PgBf16 {
    static constexpr bool PERM = true, AFTER_DRAIN = false; bf16_t* O; int ldc;
    __device__ __forceinline__ void operator()(const f32x4 (&acc)[2][2][4][2], const pg8::Unit& u, int wr, int wc, int fr, int fq) const {
#pragma unroll
        for (int ai = 0; ai < 2; ++ai)
#pragma unroll
            for (int m = 0; m < 4; ++m) { bf16_t* rowp = O + (size_t)(u.pm * 256 + ai * 128 + wr * 64 + m * 16 + fr) * ldc + u.pn * 256 + wc * 32 + 8 * fq;
#pragma unroll
                for (int bj = 0; bj < 2; ++bj) { const f32x4 v0 = acc[ai][bj][m][0], v1 = acc[ai][bj][m][1]; u32x4 w; w.x = pk2bf(v0[0], v0[1]); w.y = pk2bf(v0[2], v0[3]); w.z = pk2bf(v1[0], v1[1]); w.w = pk2bf(v1[2], v1[3]); *(u32x4*)(rowp + bj * 128) = w; } }
    }
};
struct PgF32 {
    static constexpr bool PERM = false, AFTER_DRAIN = false; float* O; int ldc;
    __device__ __forceinline__ void operator()(const f32x4 (&acc)[2][2][4][2], const pg8::Unit& u, int wr, int wc, int fr, int fq) const {
#pragma unroll
        for (int ai = 0; ai < 2; ++ai)
#pragma unroll
            for (int m = 0; m < 4; ++m) { float* rowp = O + (size_t)(u.pm * 256 + ai * 128 + wr * 64 + m * 16 + fr) * ldc + u.pn * 256 + wc * 32 + 4 * fq;
#pragma unroll
                for (int bj = 0; bj < 2; ++bj)
#pragma unroll
                    for (int n = 0; n < 2; ++n) *(f32x4*)(rowp + bj * 128 + n * 16) = acc[ai][bj][m][n]; }
    }
};
struct PgSwiglu {
    static constexpr bool PERM = true, AFTER_DRAIN = false; bf16_t* Hd;
    __device__ __forceinline__ void operator()(const f32x4 (&acc)[2][2][4][2], const pg8::Unit& u, int wr, int wc, int fr, int fq) const {
#pragma unroll
        for (int ai = 0; ai < 2; ++ai)
#pragma unroll
            for (int m = 0; m < 4; ++m) { bf16_t* rowp = Hd + (size_t)(u.pm * 256 + ai * 128 + wr * 64 + m * 16 + fr) * DFF + u.pn * 128 + wc * 32 + 8 * fq;
                float h[8];
#pragma unroll
                for (int n = 0; n < 2; ++n)
#pragma unroll
                    for (int i = 0; i < 4; ++i) h[n * 4 + i] = siluf_(acc[ai][0][m][n][i]) * acc[ai][1][m][n][i];
                u32x4 w; w.x = pk2bf(h[0], h[1]); w.y = pk2bf(h[2], h[3]); w.z = pk2bf(h[4], h[5]); w.w = pk2bf(h[6], h[7]); *(u32x4*)rowp = w; }
    }
};
struct PgResXB {
    static constexpr bool PERM = true, AFTER_DRAIN = false; const float* R; bf16_t* O;
    __device__ __forceinline__ void operator()(const f32x4 (&acc)[2][2][4][2], const pg8::Unit& u, int wr, int wc, int fr, int fq) const {
#pragma unroll
        for (int ai = 0; ai < 2; ++ai)
#pragma unroll
            for (int m = 0; m < 4; ++m) { const size_t off = (size_t)(u.pm * 256 + ai * 128 + wr * 64 + m * 16 + fr) * 1024 + u.pn * 256 + wc * 32 + 8 * fq;
#pragma unroll
                for (int bj = 0; bj < 2; ++bj) { const f32x4 r0 = *(const f32x4*)(R + off + bj * 128), r1 = *(const f32x4*)(R + off + bj * 128 + 4), v0 = r0 + acc[ai][bj][m][0], v1 = r1 + acc[ai][bj][m][1];
                    u32x4 w; w.x = cvtpk(v0[0], v0[1]); w.y = cvtpk(v0[2], v0[3]); w.z = cvtpk(v1[0], v1[1]); w.w = cvtpk(v1[2], v1[3]); *(u32x4*)(O + off + bj * 128) = w; } }
    }
};
struct PgResBB {
    static constexpr bool PERM = true, AFTER_DRAIN = false; const bf16_t* R; bf16_t* O;
    __device__ __forceinline__ void operator()(const f32x4 (&acc)[2][2][4][2], const pg8::Unit& u, int wr, int wc, int fr, int fq) const {
#pragma unroll
        for (int ai = 0; ai < 2; ++ai)
#pragma unroll
            for (int m = 0; m < 4; ++m) { const size_t off = (size_t)(u.pm * 256 + ai * 128 + wr * 64 + m * 16 + fr) * 1024 + u.pn * 256 + wc * 32 + 8 * fq;
#pragma unroll
                for (int bj = 0; bj < 2; ++bj) { float r[8]; bf8_to_f32(*(const bf16x8*)(R + off + bj * 128), r); const f32x4 a0 = acc[ai][bj][m][0], a1 = acc[ai][bj][m][1];
                    u32x4 w; w.x = cvtpk(r[0] + a0[0], r[1] + a0[1]); w.y = cvtpk(r[2] + a0[2], r[3] + a0[3]); w.z = cvtpk(r[4] + a1[0], r[5] + a1[1]); w.w = cvtpk(r[6] + a1[2], r[7] + a1[3]); *(u32x4*)(O + off + bj * 128) = w; } }
    }
};
struct PgPleB {
    static constexpr bool PERM = true, AFTER_DRAIN = false; const bf16_t* H2; const bf16_t* PP; float* out;
    __device__ __forceinline__ void operator()(const f32x4 (&acc)[2][2][4][2], const pg8::Unit& u, int wr, int wc, int fr, int fq) const {
#pragma unroll
        for (int ai = 0; ai < 2; ++ai)
#pragma unroll
            for (int m = 0; m < 4; ++m) { const size_t off = (size_t)(u.pm * 256 + ai * 128 + wr * 64 + m * 16 + fr) * 1024 + u.pn * 256 + wc * 32 + 8 * fq;
#pragma unroll
                for (int bj = 0; bj < 2; ++bj) { float h[8], pp[8]; bf8_to_f32(*(const bf16x8*)(H2 + off + bj * 128), h); bf8_to_f32(*(const bf16x8*)(PP + off + bj * 128), pp);
                    const f32x4 a0 = acc[ai][bj][m][0], a1 = acc[ai][bj][m][1]; f32x4 y0, y1;
#pragma unroll
                    for (int i = 0; i < 4; ++i) { y0[i] = h[i] + pp[i] * sigmoidf_(a0[i]); y1[i] = h[4 + i] + pp[4 + i] * sigmoidf_(a1[i]); }
                    *(f32x4*)(out + O_YP + off + bj * 128) = y0; *(f32x4*)(out + O_YP + off + bj * 128 + 4) = y1; } }
    }
};
template <class Epi>
__device__ __forceinline__ void pg_gemm(LAS unsigned char* lds, const bf16_t* A, const bf16_t* Bt, int M, int N, int K, const Epi& E, int glow = 0) {
    pg8::Gemm g{A, Bt, M, N, K}; pg8::StaticOrder S;
    if (glow > 0) { if ((int)blockIdx.x >= glow) return; S.init(M, N, glow, (int)blockIdx.x); }
    else S.init(M, N, (int)gridDim.x, (int)blockIdx.x);
    pg8::gemm_phase<Epi, pg8::StaticOrder, true, true>(lds, g, S, E);
}

constexpr size_t WOF_WinT = 0ull;
constexpr size_t WOF_WqbT = 5767168ull;
constexpr size_t WOF_WkvT = 6356992ull;
constexpr size_t WOF_WknT = 6881280ull;
constexpr size_t WOF_WoT = 7143424ull;
constexpr size_t WOF_WguT = 9240576ull;
constexpr size_t WOF_WdT = 20774912ull;
constexpr size_t WOF_WpgT = 26542080ull;
constexpr size_t WOF_WppT = 28639232ull;
constexpr size_t WOF_xn = 29163520ull;
constexpr size_t WOF_pb = 63242240ull;
constexpr size_t WOF_Z = 71761920ull;
constexpr size_t WOF_qkv = 165478400ull;
constexpr size_t WOF_ropecs = 216596480ull;
constexpr size_t WOF_gg = 216858880ull;
constexpr size_t WOF_bb = 217391360ull;
constexpr size_t WOF_goraw = 217923840ull;
constexpr size_t WOF_gUT = 252002560ull;
constexpr size_t WOF_ggam = 285556992ull;
constexpr size_t WOF_gWn = 285565184ull;
constexpr size_t WOF_gQg = 302342400ull;
constexpr size_t WOF_gQK = 319119616ull;
constexpr size_t WOF_gKd = 335896832ull;
constexpr size_t WOF_qan = 352674048ull;
constexpr size_t WOF_ckvb = 365453568ull;
constexpr size_t WOF_krf = 373973248ull;
constexpr size_t WOF_Q = 376103168ull;
constexpr size_t WOF_qh = 427221248ull;
constexpr size_t WOF_KV = 478339328ull;
constexpr size_t WOF_kh = 546496768ull;
constexpr size_t WOF_omix = 580575488ull;
constexpr size_t WOF_KN = 614654208ull;
constexpr size_t WOF_SC = 1151525120ull;
constexpr size_t WOF_part = 1168302336ull;
constexpr size_t WOF_H = 1170432256ull;
constexpr size_t WOF_un = 1238589696ull;
constexpr size_t WOF_G = 1272668416ull;
constexpr size_t WOF_hid = 1273028864ull;
constexpr size_t WOF_H2 = 1366745344ull;
constexpr size_t WOF_un2 = 1434902784ull;
constexpr size_t WOF_PP = 1468981504ull;
constexpr size_t WOF_qraw = 1537138944ull;
constexpr size_t WOF_kvraw = 1562304768ull;
constexpr size_t WOF_krb = 1595859200ull;
constexpr size_t WOF_ctl = 1596907776ull;
constexpr size_t WS_TOTAL = 1596924160ull;
struct MK {
    const float *x_prompt, *x_sample, *cache_ckv, *cache_krope, *state_gdn, *state_conv; const int* page_table; const float *p_prompt, *p_sample;
    const float *g_attn, *w_in, *w_conv, *a_log, *dt_bias, *g_gdn_out, *g_q_a, *w_q_b, *g_q_nope, *g_q_rope, *g_kv_a, *g_k_rope, *w_kv_b, *g_k_nope, *w_o, *g_ffn, *w_gate, *w_up, *w_down, *g_ple, *w_ple_gate, *w_ple_proj;
    float* out; char* ws;
    __device__ __forceinline__ unsigned* ctl() const { return (unsigned*)(ws + WOF_ctl); }
    __device__ __forceinline__ bf16_t* WinT() const { return (bf16_t*)(ws + WOF_WinT); }
    __device__ __forceinline__ bf16_t* WqbT() const { return (bf16_t*)(ws + WOF_WqbT); }
    __device__ __forceinline__ bf16_t* WkvT() const { return (bf16_t*)(ws + WOF_WkvT); }
    __device__ __forceinline__ bf16_t* WknT() const { return (bf16_t*)(ws + WOF_WknT); }
    __device__ __forceinline__ bf16_t* WoT() const { return (bf16_t*)(ws + WOF_WoT); }
    __device__ __forceinline__ bf16_t* WguT() const { return (bf16_t*)(ws + WOF_WguT); }
    __device__ __forceinline__ bf16_t* WdT() const { return (bf16_t*)(ws + WOF_WdT); }
    __device__ __forceinline__ bf16_t* WpgT() const { return (bf16_t*)(ws + WOF_WpgT); }
    __device__ __forceinline__ bf16_t* WppT() const { return (bf16_t*)(ws + WOF_WppT); }
    __device__ __forceinline__ bf16_t* xn() const { return (bf16_t*)(ws + WOF_xn); }
    __device__ __forceinline__ bf16_t* pb() const { return (bf16_t*)(ws + WOF_pb); }
    __device__ __forceinline__ bf16_t* Z() const { return (bf16_t*)(ws + WOF_Z); }
    __device__ __forceinline__ bf16_t* qkv() const { return (bf16_t*)(ws + WOF_qkv); }
    __device__ __forceinline__ float* ropecs() const { return (float*)(ws + WOF_ropecs); }
    __device__ __forceinline__ float* gg() const { return (float*)(ws + WOF_gg); }
    __device__ __forceinline__ float* bb() const { return (float*)(ws + WOF_bb); }
    __device__ __forceinline__ float* goraw() const { return (float*)(ws + WOF_goraw); }
    __device__ __forceinline__ float* gUT() const { return (float*)(ws + WOF_gUT); }
    __device__ __forceinline__ float* ggam() const { return (float*)(ws + WOF_ggam); }
    __device__ __forceinline__ bf16_t* gWn() const { return (bf16_t*)(ws + WOF_gWn); }
    __device__ __forceinline__ bf16_t* gQg() const { return (bf16_t*)(ws + WOF_gQg); }
    __device__ __forceinline__ bf16_t* gQK() const { return (bf16_t*)(ws + WOF_gQK); }
    __device__ __forceinline__ bf16_t* gKd() const { return (bf16_t*)(ws + WOF_gKd); }
    __device__ __forceinline__ bf16_t* qan() const { return (bf16_t*)(ws + WOF_qan); }
    __device__ __forceinline__ bf16_t* ckvb() const { return (bf16_t*)(ws + WOF_ckvb); }
    __device__ __forceinline__ float* krf() const { return (float*)(ws + WOF_krf); }
    __device__ __forceinline__ float* Q() const { return (float*)(ws + WOF_Q); }
    __device__ __forceinline__ float* qh() const { return (float*)(ws + WOF_qh); }
    __device__ __forceinline__ float* KV() const { return (float*)(ws + WOF_KV); }
    __device__ __forceinline__ float* kh() const { return (float*)(ws + WOF_kh); }
    __device__ __forceinline__ bf16_t* omix() const { return (bf16_t*)(ws + WOF_omix); }
    __device__ __forceinline__ bf16_t* KN() const { return (bf16_t*)(ws + WOF_KN); }
    __device__ __forceinline__ float* SC() const { return (float*)(ws + WOF_SC); }
    __device__ __forceinline__ float* part() const { return (float*)(ws + WOF_part); }
    __device__ __forceinline__ bf16_t* H() const { return (bf16_t*)(ws + WOF_H); }
    __device__ __forceinline__ bf16_t* un() const { return (bf16_t*)(ws + WOF_un); }
    __device__ __forceinline__ float* G() const { return (float*)(ws + WOF_G); }
    __device__ __forceinline__ bf16_t* hid() const { return (bf16_t*)(ws + WOF_hid); }
    __device__ __forceinline__ bf16_t* H2() const { return (bf16_t*)(ws + WOF_H2); }
    __device__ __forceinline__ bf16_t* un2() const { return (bf16_t*)(ws + WOF_un2); }
    __device__ __forceinline__ bf16_t* PP() const { return (bf16_t*)(ws + WOF_PP); }
    __device__ __forceinline__ bf16_t* qraw() const { return (bf16_t*)(ws + WOF_qraw); }
    __device__ __forceinline__ bf16_t* kvraw() const { return (bf16_t*)(ws + WOF_kvraw); }
    __device__ __forceinline__ bf16_t* krb() const { return (bf16_t*)(ws + WOF_krb); }
};

__device__ __forceinline__ float fast_sigmoid(float x) { return __builtin_amdgcn_rcpf(1.f + __builtin_amdgcn_exp2f(-1.44269504f * x)); }
struct PinTok { bf16x8 qa, cv, kr; float ab; };
struct PinGain { float gqa[8], gkv[8], gkr[8], dtb, alog; };
__device__ __forceinline__ PinTok pin_load(const MK& a, int row, int lane) {
    const bf16_t* z = a.Z() + (size_t)row * ZW; PinTok t; const bf16x8 zz = {0, 0, 0, 0, 0, 0, 0, 0};
    t.qa = lane < 48 ? *(const bf16x8*)(z + OFF_QA + 8 * lane) : zz; t.cv = lane < 32 ? *(const bf16x8*)(z + OFF_KVA + 8 * lane) : zz;
    t.kr = (lane >= 32 && lane < 36) ? *(const bf16x8*)(z + OFF_KR + 8 * (lane - 32)) : zz; t.ab = lane < 16 ? bf2f(z[OFF_A + lane]) : 0.f; return t;
}
__device__ __forceinline__ void post_in_token(const MK& a, int row, int lane, const float* wcs, const bf16x8 (&w0)[3], const bf16x8 (&w1)[3], const bf16x8 (&w2)[3], const bf16x8 (&wcur)[3], const PinTok& tk, const PinGain& gn) {
    const bool samp = row >= NPT;
    const int b = samp ? row - NPT : row >> 11, t = samp ? 0 : row & 2047, hd = lane >> 3;
    float y[24];
#pragma unroll
    for (int c3 = 0; c3 < 3; ++c3) {
        float p0[8], p1[8], p2[8], cu[8];
        bf8_to_f32(w0[c3], p0); bf8_to_f32(w1[c3], p1); bf8_to_f32(w2[c3], p2); bf8_to_f32(wcur[c3], cu);
        const float* wp = wcs + 512 * c3 + 8 * lane;
        const float4 a0 = *(const float4*)wp, a1 = *(const float4*)(wp + 4), b0 = *(const float4*)(wp + 1536), b1 = *(const float4*)(wp + 1540);
        const float4 c0 = *(const float4*)(wp + 3072), c1 = *(const float4*)(wp + 3076), d0 = *(const float4*)(wp + 4608), d1 = *(const float4*)(wp + 4612);
        const float k0[8] = {a0.x, a0.y, a0.z, a0.w, a1.x, a1.y, a1.z, a1.w}, k1[8] = {b0.x, b0.y, b0.z, b0.w, b1.x, b1.y, b1.z, b1.w};
        const float k2[8] = {c0.x, c0.y, c0.z, c0.w, c1.x, c1.y, c1.z, c1.w}, k3[8] = {d0.x, d0.y, d0.z, d0.w, d1.x, d1.y, d1.z, d1.w};
#pragma unroll
        for (int e = 0; e < 8; ++e) { const int c = 8 * c3 + e; const float v = k0[e] * p0[e] + k1[e] * p1[e] + k2[e] * p2[e] + k3[e] * cu[e]; y[c] = v * fast_sigmoid(v); }
        __builtin_amdgcn_sched_barrier(0);
    }
    float sq = 0.f, sk = 0.f;
#pragma unroll
    for (int e = 0; e < 8; ++e) { sq += y[e] * y[e]; sk += y[8 + e] * y[8 + e]; }
    sq = sum8(sq); sk = sum8(sk);
    const float rq = rsqrtf(sq + EPSV) * 0.125f, rk = rsqrtf(sk + EPSV);
#pragma unroll
    for (int e = 0; e < 8; ++e) { y[e] *= rq; y[8 + e] *= rk; }
    bf16_t* qo = a.qkv() + (size_t)row * 1536 + 8 * lane;
    *(bf16x8*)qo = f32_to_bf8(y); *(bf16x8*)(qo + 512) = f32_to_bf8(y + 8); *(bf16x8*)(qo + 1024) = f32_to_bf8(y + 16);
    if (!samp && t >= SEQ - 3) {
        float* cso = a.out + O_CSP + ((size_t)b * 3 + (t - (SEQ - 3))) * 1536 + 8 * lane;
#pragma unroll
        for (int j = 0; j < 3; ++j) { float cu[8]; bf8_to_f32(wcur[j], cu); *(float4*)(cso + 512 * j) = (float4){cu[0], cu[1], cu[2], cu[3]}; *(float4*)(cso + 512 * j + 4) = (float4){cu[4], cu[5], cu[6], cu[7]}; }
    }
    if (lane < 16) {
        const float v = tk.ab;
        if (lane < 8) { const float xx = v + gn.dtb; const float sp = xx > 20.f ? xx : 0.69314718f * __builtin_amdgcn_logf(1.f + __builtin_amdgcn_exp2f(1.44269504f * xx)); a.gg()[(size_t)row * 8 + lane] = -gn.alog * sp; }
        else a.bb()[(size_t)row * 8 + lane - 8] = sigmoidf_(v);
    }
    __builtin_amdgcn_sched_barrier(0);
    float qa[8], cv[8], kr[8];
    bf8_to_f32(tk.qa, qa); bf8_to_f32(tk.cv, cv); bf8_to_f32(tk.kr, kr);
    float s1 = 0.f, s2 = 0.f, s3 = 0.f;
#pragma unroll
    for (int e = 0; e < 8; ++e) { s1 += qa[e] * qa[e]; s2 += cv[e] * cv[e]; s3 += kr[e] * kr[e]; }
    s1 = wave_sum(s1); s2 = wave_sum(s2); s3 = wave_sum(s3);
    const float r1 = rsqrtf(s1 * (1.f / 384.f) + EPSV), r2 = rsqrtf(s2 * (1.f / 256.f) + EPSV), r3 = rsqrtf(s3 * (1.f / 32.f) + EPSV);
    if (lane < 48) {
        float o[8];
#pragma unroll
        for (int e = 0; e < 8; ++e) o[e] = qa[e] * r1 * gn.gqa[e];
        *(bf16x8*)(a.qan() + (size_t)row * 384 + 8 * lane) = f32_to_bf8(o);
    }
    if (lane < 32) {
        float o[8];
#pragma unroll
        for (int e = 0; e < 8; ++e) o[e] = cv[e] * r2 * gn.gkv[e];
        *(bf16x8*)(a.ckvb() + (size_t)row * 256 + 8 * lane) = f32_to_bf8(o);
        float* co = samp ? a.out + O_CKVS + (size_t)b * 256 + 8 * lane : a.out + O_CKVP + (size_t)row * 256 + 8 * lane;
        *(float4*)co = (float4){o[0], o[1], o[2], o[3]}; *(float4*)(co + 4) = (float4){o[4], o[5], o[6], o[7]};
    }
    __builtin_amdgcn_sched_barrier(0);
    {
        const int c4 = (lane - 32) & 3;
        float xn[8], ot[8];
#pragma unroll
        for (int e = 0; e < 8; ++e) xn[e] = kr[e] * r3 * gn.gkr[e];
#pragma unroll
        for (int e = 0; e < 8; ++e) ot[e] = dpp_mov<0x4E>(xn[e]);
        if (lane >= 32 && lane < 36) {
            const float* tb = a.ropecs() + (size_t)(samp ? 2048 : t) * 32 + ((8 * c4) & 15);
            const float4 c0 = *(const float4*)tb, c1 = *(const float4*)(tb + 4), s0 = *(const float4*)(tb + 16), s1 = *(const float4*)(tb + 20);
            const float csv[8] = {c0.x, c0.y, c0.z, c0.w, c1.x, c1.y, c1.z, c1.w}, snv[8] = {s0.x, s0.y, s0.z, s0.w, s1.x, s1.y, s1.z, s1.w};
            float o[8];
#pragma unroll
            for (int e = 0; e < 8; ++e) o[e] = c4 < 2 ? xn[e] * csv[e] - ot[e] * snv[e] : ot[e] * snv[e] + xn[e] * csv[e];
            float* kf_ = a.krf() + (size_t)row * 32 + 8 * c4; *(float4*)kf_ = (float4){o[0], o[1], o[2], o[3]}; *(float4*)(kf_ + 4) = (float4){o[4], o[5], o[6], o[7]};
            float* ko = samp ? a.out + O_KRS + (size_t)b * 32 + 8 * c4 : a.out + O_KRP + (size_t)row * 32 + 8 * c4;
            *(float4*)ko = (float4){o[0], o[1], o[2], o[3]}; *(float4*)(ko + 4) = (float4){o[4], o[5], o[6], o[7]};
            if (!samp) *(bf16x8*)(a.krb() + (size_t)row * 32 + 8 * c4) = f32_to_bf8(o);
        }
    }
    (void)hd;
}
__device__ __forceinline__ void post_in_run(const MK& a, int run, int lane_in, const float* wcs) {
    int lane = lane_in; asm volatile("" : "+v"(lane));
    PinGain gn;
    {
        const int lq = lane < 48 ? lane : 0, lk = lane < 32 ? lane : 0, c4 = (lane - 32) & 3;
#pragma unroll
        for (int e = 0; e < 8; ++e) { gn.gqa[e] = a.g_q_a[8 * lq + e]; gn.gkv[e] = a.g_kv_a[8 * lk + e]; gn.gkr[e] = a.g_k_rope[8 * c4 + e]; }
        gn.dtb = a.dt_bias[lane & 7]; gn.alog = expf(a.a_log[lane & 7]);
    }
    if (run < NPT / 8) {
        const int row0 = run * 8, t0 = row0 & 2047;
        bf16x8 w0[3], w1[3], w2[3], wcur[3];
#pragma unroll
        for (int c3 = 0; c3 < 3; ++c3) {
            const bf16x8 zz = {0, 0, 0, 0, 0, 0, 0, 0}; w0[c3] = zz; w1[c3] = zz; w2[c3] = zz;
            if (t0 > 0) { const bf16_t* zp = a.Z() + (size_t)(row0 - 3) * ZW + 512 * c3 + 8 * lane; w0[c3] = *(const bf16x8*)zp; w1[c3] = *(const bf16x8*)(zp + ZW); w2[c3] = *(const bf16x8*)(zp + 2 * ZW); }
        }
        bf16x8 wnext[3]; PinTok tk, tkn;
#pragma unroll
        for (int c3 = 0; c3 < 3; ++c3) wnext[c3] = *(const bf16x8*)(a.Z() + (size_t)row0 * ZW + 512 * c3 + 8 * lane);
        tkn = pin_load(a, row0, lane);
#pragma unroll 1
        for (int k = 0; k < 8; ++k) {
            const int row = row0 + k;
#pragma unroll
            for (int c3 = 0; c3 < 3; ++c3) wcur[c3] = wnext[c3];
            tk = tkn;
            if (k < 7) {
#pragma unroll
                for (int c3 = 0; c3 < 3; ++c3) wnext[c3] = *(const bf16x8*)(a.Z() + (size_t)(row + 1) * ZW + 512 * c3 + 8 * lane);
                tkn = pin_load(a, row + 1, lane);
            }
            post_in_token(a, row, lane, wcs, w0, w1, w2, wcur, tk, gn);
#pragma unroll
            for (int c3 = 0; c3 < 3; ++c3) { w0[c3] = w1[c3]; w1[c3] = w2[c3]; w2[c3] = wcur[c3]; }
        }
    } else {
        {
            const int bsm = run - NPT / 8, row = NPT + bsm;
            bf16x8 w0[3], w1[3], w2[3], wcur[3];
#pragma unroll
            for (int c3 = 0; c3 < 3; ++c3) {
                const float* sp = a.state_conv + (size_t)bsm * 3 * 1536 + 512 * c3 + 8 * lane;
                float* cso = a.out + O_CSS + (size_t)bsm * 3 * 1536 + 512 * c3 + 8 * lane;
                float t0_[8], t1_[8], t2_[8], tc_[8];
#pragma unroll
                for (int e = 0; e < 8; ++e) { t0_[e] = sp[e]; t1_[e] = sp[1536 + e]; t2_[e] = sp[2 * 1536 + e]; }
                wcur[c3] = *(const bf16x8*)(a.Z() + (size_t)row * ZW + 512 * c3 + 8 * lane); bf8_to_f32(wcur[c3], tc_);
#pragma unroll
                for (int e = 0; e < 8; ++e) { cso[e] = t1_[e]; cso[1536 + e] = t2_[e]; cso[2 * 1536 + e] = tc_[e]; }
                w0[c3] = f32_to_bf8(t0_); w1[c3] = f32_to_bf8(t1_); w2[c3] = f32_to_bf8(t2_);
            }
            post_in_token(a, row, lane, wcs, w0, w1, w2, wcur, pin_load(a, row, lane), gn);
        }
    }
}

__device__ __forceinline__ void post_q_item(const MK& a, int idx, int lane) {
    const int row = idx >> 3, h = idx & 7;
    const float* q = a.Q() + (size_t)row * 768 + h * 96;
    float* o = a.qh() + ((size_t)row * 8 + h) * 96;
    const float v = q[lane];
    const float ss = wave_sum(v * v);
    o[lane] = v * rsqrtf(ss * (1.f / 64.f) + EPSV) * a.g_q_nope[lane];
    const float r = lane < 32 ? q[64 + lane] : 0.f;
    const float s2 = wave_sum(r * r);
    const float xn = lane < 32 ? r * rsqrtf(s2 * (1.f / 32.f) + EPSV) * a.g_q_rope[lane] : 0.f;
    const float other = __shfl_xor(xn, 16);
    const int i = lane & 15;
    const float* tb = a.ropecs() + (size_t)(row >= NPT ? 2048 : (row & 2047)) * 32;
    const float cs = tb[i], sn = tb[16 + i];
    const float ov = lane < 16 ? xn * cs - other * sn : other * sn + xn * cs;
    if (lane < 32) o[64 + lane] = ov;
}
__device__ __forceinline__ void post_kv_item(const MK& a, int idx, int lane) {
    const int row = idx >> 3, h = idx & 7;
    const float v = a.KV()[(size_t)row * 1024 + h * 128 + lane];
    const float ss = wave_sum(v * v);
    const float kn = v * rsqrtf(ss * (1.f / 64.f) + EPSV) * a.g_k_nope[lane];
    a.kh()[((size_t)row * 8 + h) * 64 + lane] = kn;
}

typedef float f32x16 __attribute__((ext_vector_type(16)));
typedef short s16x4 __attribute__((ext_vector_type(4)));
#define KST 104
#define VST 72
#define ATT_BUF (64 * KST * 2 + 64 * VST * 2)
__device__ __forceinline__ int crow32(int r, int hi) { return (r & 3) + 8 * (r >> 2) + 4 * hi; }
__device__ __forceinline__ s16x4 tr_read(const bf16_t* p) { return __builtin_bit_cast(s16x4, __builtin_amdgcn_ds_read_tr16_b64_v4i16((LAS s16x4*)(LAS void*)(unsigned)(size_t)p)); }
__device__ __forceinline__ bf16x8 pack8(const f32x16& x, int s) {
    u32x4 w; w.x = cvtpk(x[8 * s], x[8 * s + 1]); w.y = cvtpk(x[8 * s + 2], x[8 * s + 3]); w.z = cvtpk(x[8 * s + 4], x[8 * s + 5]); w.w = cvtpk(x[8 * s + 6], x[8 * s + 7]);
    return __builtin_bit_cast(bf16x8, w);
}
__device__ __forceinline__ void attn_block(const MK& a, int b, int h, int qb, char* smem) {
    const int tid = otid(), lane = tid & 63, wid = tid >> 6, r32 = lane & 31, hi = lane >> 5;
    const int qrow = qb * 256 + wid * 32 + r32;
    const int wq0 = qb * 256 + wid * 32;
    bf16x8 qf[6];
    {
        const float SCL = 0.14724445f;
        const bf16_t* Qg = a.qraw() + ((size_t)b * SEQ + qrow) * 768 + h * 96 + 8 * hi;
        float qv[6][8];
#pragma unroll
        for (int ds = 0; ds < 6; ++ds) bf8_to_f32(*(const bf16x8*)(Qg + 16 * ds), qv[ds]);
        float sn_ = 0.f, sr_ = 0.f;
#pragma unroll
        for (int j = 0; j < 8; ++j) { sn_ += qv[0][j] * qv[0][j] + qv[1][j] * qv[1][j] + qv[2][j] * qv[2][j] + qv[3][j] * qv[3][j]; sr_ += qv[4][j] * qv[4][j] + qv[5][j] * qv[5][j]; }
        sn_ = add_x32(sn_); sr_ = add_x32(sr_);
        const float rsn = rsqrtf(sn_ * (1.f / 64.f) + EPSV) * SCL, rsr = rsqrtf(sr_ * (1.f / 32.f) + EPSV);
#pragma unroll
        for (int ds = 0; ds < 4; ++ds) {
            float o[8];
#pragma unroll
            for (int j = 0; j < 8; ++j) o[j] = qv[ds][j] * rsn * a.g_q_nope[16 * ds + 8 * hi + j];
            qf[ds] = f32_to_bf8(o);
        }
        const float* tb = a.ropecs() + (size_t)qrow * 32 + 8 * hi;
        float o4[8], o5[8];
#pragma unroll
        for (int j = 0; j < 8; ++j) {
            const float x1 = qv[4][j] * rsr * a.g_q_rope[8 * hi + j], x2 = qv[5][j] * rsr * a.g_q_rope[16 + 8 * hi + j], cs = tb[j], sn = tb[16 + j];
            o4[j] = (x1 * cs - x2 * sn) * SCL; o5[j] = (x1 * sn + x2 * cs) * SCL;
        }
        qf[4] = f32_to_bf8(o4); qf[5] = f32_to_bf8(o5);
    }
    f32x16 o0, o1;
#pragma unroll
    for (int r = 0; r < 16; ++r) { o0[r] = 0.f; o1[r] = 0.f; }
    float m = 0.f, l = 0.f;
    f32x16 negm;
#pragma unroll
    for (int r = 0; r < 16; ++r) negm[r] = 0.f;
    const int nt = qb * 4 + 4;
    const int vr = tid >> 3, vc = tid & 7, rr_ = (tid >> 2) & 63, rc = tid & 3;
    const bf16_t* KVg = a.kvraw() + (size_t)b * SEQ * 1024 + h * 128 + (size_t)vr * 1024 + vc * 8;
    const bf16_t* KRg = a.krb() + (size_t)b * SEQ * 32 + (size_t)rr_ * 32 + rc * 8;
    float gk[8];
#pragma unroll
    for (int j = 0; j < 8; ++j) gk[j] = a.g_k_nope[8 * vc + j];
    bf16x8 kr0, kr1, vr0;
#define ATT_LOAD(tt) do { kr0 = *(const bf16x8*)(KVg + (size_t)(tt) * 64 * 1024); vr0 = *(const bf16x8*)(KVg + (size_t)(tt) * 64 * 1024 + 64); if (tid < 256) kr1 = *(const bf16x8*)(KRg + (size_t)(tt) * 64 * 32); } while (0)
#define ATT_STORE(buf) do { bf16_t* Ks_ = (bf16_t*)(smem + (buf) * ATT_BUF); bf16_t* Vs_ = Ks_ + 64 * KST; \
        float x_[8]; bf8_to_f32(kr0, x_); float ss_ = 0.f; _Pragma("unroll") for (int j = 0; j < 8; ++j) ss_ += x_[j] * x_[j]; \
        ss_ = sum8(ss_); const float rs_ = rsqrtf(ss_ * (1.f / 64.f) + EPSV); \
        _Pragma("unroll") for (int j = 0; j < 8; ++j) x_[j] *= rs_ * gk[j]; \
        *(bf16x8*)(Ks_ + vr * KST + vc * 8) = f32_to_bf8(x_); *(bf16x8*)(Vs_ + vr * VST + vc * 8) = vr0; \
        if (tid < 256) *(bf16x8*)(Ks_ + rr_ * KST + 64 + rc * 8) = kr1; } while (0)
    ATT_LOAD(0);
    __syncthreads();
    ATT_STORE(0);
    __syncthreads();
    const int i16 = lane & 15, qq = i16 >> 2, pp = i16 & 3, g1 = (lane >> 4) & 1;
    for (int t = 0; t < nt; ++t) {
        const bf16_t* Ks = (const bf16_t*)(smem + (t & 1) * ATT_BUF); const bf16_t* Vs = Ks + 64 * KST;
        if (t + 1 < nt) ATT_LOAD(t + 1);
        if (64 * t <= wq0 + 31) {
            f32x16 p0, p1;
#pragma unroll
            for (int ds = 0; ds < 6; ++ds) {
                const bf16x8 k0 = *(const bf16x8*)(Ks + r32 * KST + 16 * ds + 8 * hi);
                const bf16x8 k1 = *(const bf16x8*)(Ks + (32 + r32) * KST + 16 * ds + 8 * hi);
                if (ds == 0) { p0 = __builtin_amdgcn_mfma_f32_32x32x16_bf16(k0, qf[ds], negm, 0, 0, 0); p1 = __builtin_amdgcn_mfma_f32_32x32x16_bf16(k1, qf[ds], negm, 0, 0, 0); }
                else { p0 = __builtin_amdgcn_mfma_f32_32x32x16_bf16(k0, qf[ds], p0, 0, 0, 0); p1 = __builtin_amdgcn_mfma_f32_32x32x16_bf16(k1, qf[ds], p1, 0, 0, 0); }
            }
            if (64 * t + 63 > wq0) {
#pragma unroll
                for (int r = 0; r < 16; ++r) { const int kv = 64 * t + crow32(r, hi); if (kv > qrow) p0[r] = -INFINITY; if (kv + 32 > qrow) p1[r] = -INFINITY; }
            }
            float mx = fmaxf(p0[0], p1[0]);
#pragma unroll
            for (int r = 1; r < 16; ++r) mx = fmaxf(mx, fmaxf(p0[r], p1[r]));
            mx = max_x32(mx);
            const float delta = t == 0 ? mx : fmaxf(mx, 0.f);
            if (__any(delta != 0.f)) {
                m += delta;
                const float f = t == 0 ? 1.f : __builtin_amdgcn_exp2f(-delta);
#pragma unroll
                for (int r = 0; r < 16; ++r) { p0[r] -= delta; p1[r] -= delta; negm[r] = -m; o0[r] *= f; o1[r] *= f; }
                l *= f;
            }
            float rs = 0.f;
#pragma unroll
            for (int r = 0; r < 16; ++r) { p0[r] = __builtin_amdgcn_exp2f(p0[r]); p1[r] = __builtin_amdgcn_exp2f(p1[r]); rs += p0[r] + p1[r]; }
            l += rs;
            bf16x8 pf[4];
            pf[0] = pack8(p0, 0); pf[1] = pack8(p0, 1); pf[2] = pack8(p1, 0); pf[3] = pack8(p1, 1);
#pragma unroll
            for (int ks = 0; ks < 4; ++ks) {
                const bf16_t* vb0 = Vs + (16 * ks + 4 * hi + qq) * VST + 16 * g1 + 4 * pp;
                const s16x4 a0 = tr_read(vb0), a1 = tr_read(vb0 + 8 * VST);
                const s16x4 c0 = tr_read(vb0 + 32), c1 = tr_read(vb0 + 8 * VST + 32);
                const bf16x8 va = __builtin_shufflevector(a0, a1, 0, 1, 2, 3, 4, 5, 6, 7);
                const bf16x8 vc_ = __builtin_shufflevector(c0, c1, 0, 1, 2, 3, 4, 5, 6, 7);
                o0 = __builtin_amdgcn_mfma_f32_32x32x16_bf16(va, pf[ks], o0, 0, 0, 0);
                o1 = __builtin_amdgcn_mfma_f32_32x32x16_bf16(vc_, pf[ks], o1, 0, 0, 0);
            }
        }
        if (t + 1 < nt) ATT_STORE((t + 1) & 1);
        __syncthreads();
    }
    l = add_x32(l);
    const float il = 1.f / l;
    bf16_t* op = a.omix() + ((size_t)b * SEQ + qrow) * 1024 + 512 + h * 64;
#pragma unroll
    for (int g = 0; g < 4; ++g) {
        uint2 w0, w1;
        w0.x = pk2bf(o0[4 * g] * il, o0[4 * g + 1] * il); w0.y = pk2bf(o0[4 * g + 2] * il, o0[4 * g + 3] * il);
        w1.x = pk2bf(o1[4 * g] * il, o1[4 * g + 1] * il); w1.y = pk2bf(o1[4 * g + 2] * il, o1[4 * g + 3] * il);
        *(uint2*)(op + 8 * g + 4 * hi) = w0;
        *(uint2*)(op + 32 + 8 * g + 4 * hi) = w1;
    }
#undef ATT_LOAD
#undef ATT_STORE
}

__device__ __forceinline__ void gdn_unit(const MK& a, int b, int h, int dvg, const float* s0, float* sout, int row0, int T, int lane, char* wsm) {
    float (*sq)[64] = (float (*)[64])wsm;
    float (*sk)[64] = (float (*)[64])(wsm + 4096);
    float (*sv)[8] = (float (*)[8])(wsm + 8192);
    float* sg = (float*)(wsm + 8704);
    float* sb = (float*)(wsm + 8768);
    const int e = lane & 7, ko = lane >> 3, col = dvg * 8 + e;
    float S[8];
#pragma unroll
    for (int d = 0; d < 8; ++d) S[d] = s0 ? s0[(((size_t)b * 8 + h) * 64 + ko * 8 + d) * 64 + col] : 0.f;
    const size_t rbase = (size_t)row0 + (size_t)b * T;
    float pq[16], pk[16], pv0, pv1, pgb;
    {
        const int nt = T < 16 ? T : 16;
#pragma unroll
        for (int j = 0; j < 16; ++j) { const bool ok = j < nt; const size_t r = rbase + (ok ? j : 0); pq[j] = ok ? bf2f(a.qkv()[r * 1536 + h * 64 + lane]) : 0.f; pk[j] = ok ? bf2f(a.qkv()[r * 1536 + 512 + h * 64 + lane]) : 0.f; }
        { const int j0 = lane >> 3, j1 = j0 + 8; pv0 = j0 < nt ? bf2f(a.qkv()[(rbase + j0) * 1536 + 1024 + h * 64 + dvg * 8 + (lane & 7)]) : 0.f; pv1 = j1 < nt ? bf2f(a.qkv()[(rbase + j1) * 1536 + 1024 + h * 64 + dvg * 8 + (lane & 7)]) : 0.f; }
        { const int j = lane & 15; pgb = j < nt ? (lane < 16 ? a.gg()[(rbase + j) * 8 + h] : a.bb()[(rbase + j) * 8 + h]) : 0.f; }
    }
    for (int t0 = 0; t0 < T; t0 += 16) {
        const int nt = (T - t0) < 16 ? (T - t0) : 16;
        WSYNC();
#pragma unroll
        for (int j = 0; j < 16; ++j) { sq[j][lane] = pq[j]; sk[j][lane] = pk[j]; }
        sv[lane >> 3][lane & 7] = pv0; sv[(lane >> 3) + 8][lane & 7] = pv1;
        if (lane < 16) sg[lane] = expf(pgb); else if (lane < 32) sb[lane - 16] = pgb;
        WSYNC();
        if (t0 + 16 < T) {
            const size_t rb = rbase + t0 + 16;
#pragma unroll
            for (int j = 0; j < 16; ++j) { pq[j] = bf2f(a.qkv()[(rb + j) * 1536 + h * 64 + lane]); pk[j] = bf2f(a.qkv()[(rb + j) * 1536 + 512 + h * 64 + lane]); }
            pv0 = bf2f(a.qkv()[(rb + (lane >> 3)) * 1536 + 1024 + h * 64 + dvg * 8 + (lane & 7)]); pv1 = bf2f(a.qkv()[(rb + (lane >> 3) + 8) * 1536 + 1024 + h * 64 + dvg * 8 + (lane & 7)]);
            pgb = lane < 16 ? a.gg()[(rb + (lane & 15)) * 8 + h] : a.bb()[(rb + (lane & 15)) * 8 + h];
        }
        for (int j = 0; j < nt; ++j) {
            const float dec = sg[j], be = sb[j], v = sv[j][e];
            const float4 k0 = *(const float4*)&sk[j][ko * 8], k1 = *(const float4*)&sk[j][ko * 8 + 4];
            const float4 q0 = *(const float4*)&sq[j][ko * 8], q1 = *(const float4*)&sq[j][ko * 8 + 4];
            const float kk[8] = {k0.x, k0.y, k0.z, k0.w, k1.x, k1.y, k1.z, k1.w};
            const float qq[8] = {q0.x, q0.y, q0.z, q0.w, q1.x, q1.y, q1.z, q1.w};
            float ks = 0.f;
#pragma unroll
            for (int d = 0; d < 8; ++d) { S[d] *= dec; ks += kk[d] * S[d]; }
            ks += __shfl_xor(ks, 8); ks += __shfl_xor(ks, 16); ks += __shfl_xor(ks, 32);
            const float delta = (v - ks) * be;
            float ov = 0.f;
#pragma unroll
            for (int d = 0; d < 8; ++d) { S[d] += kk[d] * delta; ov += qq[d] * S[d]; }
            ov += __shfl_xor(ov, 8); ov += __shfl_xor(ov, 16); ov += __shfl_xor(ov, 32);
            if (ko == 0) a.goraw()[(rbase + t0 + j) * 512 + h * 64 + col] = ov;
        }
    }
#pragma unroll
    for (int d = 0; d < 8; ++d) sout[(((size_t)b * 8 + h) * 64 + ko * 8 + d) * 64 + col] = S[d];
}
__device__ __forceinline__ int pi_pos(int k) { return (k & 32) + 8 * ((k >> 2) & 3) + 4 * ((k >> 4) & 1) + (k & 3); }
#define GDN_WLDS 17408
__device__ __forceinline__ void gdn_prep_unit(const MK& a, int u, int lane_in, char* wsm) {
    int lane = lane_in; asm volatile("" : "+v"(lane));
    const int bh = u >> 5, n = u & 31, b = bh >> 3, h = bh & 7, i16 = lane & 15, q4 = lane >> 4;
    const size_t row0 = (size_t)b * SEQ + n * 64;
    float* AT = (float*)wsm; float* GC = (float*)(wsm + 16384); float* BT = GC + 64;
    const bf16_t* qbase = a.qkv() + row0 * 1536 + h * 64; const bf16_t* kbase = qbase + 512; const bf16_t* vbase = qbase + 1024;
    float g = a.gg()[(row0 + lane) * 8 + h];
    const float be_l = a.bb()[(row0 + lane) * 8 + h];
#pragma unroll
    for (int o = 1; o < 64; o <<= 1) { const float t = __shfl_up(g, o); if (lane >= o) g += t; }
    WSYNC();
    GC[lane] = g; BT[lane] = be_l;
    WSYNC();
    const float gl = GC[63];
    float* EG = BT + 64; float* ED = EG + 64;
    EG[lane] = expf(g); ED[lane] = expf(gl - g);
    WSYNC();
    bf16x8 kf[4][2], qf[4][2];
#pragma unroll
    for (int mt = 0; mt < 4; ++mt)
#pragma unroll
        for (int ks = 0; ks < 2; ++ks) {
            const int off = (16 * mt + i16) * 1536 + 32 * ks + 8 * q4;
            kf[mt][ks] = *(const bf16x8*)(kbase + off); qf[mt][ks] = *(const bf16x8*)(qbase + off);
        }
    bf16_t* QKg = a.gQK() + (size_t)u * 4096;
#pragma unroll
    for (int mt = 0; mt < 4; ++mt)
#pragma unroll
        for (int nt = 0; nt < 4; ++nt) {
            const int j = 16 * nt + i16, pj = 32 * (nt >> 1) + 8 * (i16 >> 2) + 4 * (nt & 1) + (i16 & 3);
            if (nt <= mt) {
                f32x4 d1 = {0.f, 0.f, 0.f, 0.f}, d2 = {0.f, 0.f, 0.f, 0.f};
#pragma unroll
                for (int ks = 0; ks < 2; ++ks) {
                    d1 = __builtin_amdgcn_mfma_f32_16x16x32_bf16(kf[mt][ks], kf[nt][ks], d1, 0, 0, 0);
                    d2 = __builtin_amdgcn_mfma_f32_16x16x32_bf16(qf[mt][ks], kf[nt][ks], d2, 0, 0, 0);
                }
                const float gcj = GC[j];
#pragma unroll
                for (int r = 0; r < 4; ++r) {
                    const int i = 16 * mt + 4 * q4 + r;
                    const float dec = __builtin_amdgcn_exp2f(1.44269504f * (GC[i] - gcj));
                    AT[i * 64 + j] = (i > j) ? BT[i] * d1[r] * dec : 0.f;
                    QKg[i * 64 + (((pj >> 3) ^ (i & 7)) << 3) + (pj & 7)] = f2bf((i >= j) ? d2[r] * dec : 0.f);
                }
            } else {
#pragma unroll
                for (int r = 0; r < 4; ++r) { const int i = 16 * mt + 4 * q4 + r; QKg[i * 64 + (((pj >> 3) ^ (i & 7)) << 3) + (pj & 7)] = 0; }
            }
        }
    {
        bf16_t* Qgg = a.gQg() + (size_t)u * 4096;
#pragma unroll
        for (int mt = 0; mt < 4; ++mt) {
            const int i = 16 * mt + i16; const float e = EG[i];
#pragma unroll
            for (int ks = 0; ks < 2; ++ks) {
                float x[8]; bf8_to_f32(qf[mt][ks], x);
                uint2 w0, w1; w0.x = cvtpk(x[0] * e, x[1] * e); w0.y = cvtpk(x[2] * e, x[3] * e); w1.x = cvtpk(x[4] * e, x[5] * e); w1.y = cvtpk(x[6] * e, x[7] * e);
                const int p0 = 32 * ks + 16 * (q4 & 1) + 4 * (q4 >> 1);
                *(uint2*)(Qgg + i * 64 + (((p0 >> 3) ^ (i & 7)) << 3) + (p0 & 7)) = w0; *(uint2*)(Qgg + i * 64 + ((((p0 >> 3) + 1) ^ (i & 7)) << 3) + (p0 & 7)) = w1;
            }
        }
    }
    WSYNC();
    __builtin_amdgcn_sched_barrier(0);
    {
        float U[64];
#pragma unroll
        for (int i = 0; i < 64; ++i) { U[i] = bf2f(vbase[i * 1536 + lane]) * BT[i]; }
#pragma unroll
        for (int i = 1; i < 64; ++i) {
            float su = 0.f;
#pragma unroll
            for (int j4 = 0; j4 < i; j4 += 4) {
                const float4 av = *(const float4*)(AT + i * 64 + j4);
                su += av.x * U[j4];
                if (j4 + 1 < i) su += av.y * U[j4 + 1];
                if (j4 + 2 < i) su += av.z * U[j4 + 2];
                if (j4 + 3 < i) su += av.w * U[j4 + 3];
            }
            U[i] -= su;
            __builtin_amdgcn_sched_barrier(0);
        }
        float* UTg = a.gUT() + ((size_t)u * 64 + lane) * 64;
#pragma unroll
        for (int i = 0; i < 64; i += 4) *(float4*)(UTg + 4 * ((i >> 2) ^ (lane & 15))) = (float4){U[i], U[i + 1], U[i + 2], U[i + 3]};
    }
    asm volatile("" ::: "memory");
    __builtin_amdgcn_sched_barrier(0);
    {
        float W[64];
#pragma unroll
        for (int i = 0; i < 64; ++i) { W[i] = bf2f(kbase[i * 1536 + lane]); }
        bf16_t* Kdg = a.gKd() + ((size_t)u * 64 + lane) * 64;
#pragma unroll
        for (int pc = 0; pc < 8; ++pc) {
            float t[8];
#pragma unroll
            for (int jj = 0; jj < 8; ++jj) { const int j = 32 * (pc >> 2) + 16 * (jj >> 2) + 4 * (pc & 3) + (jj & 3); t[jj] = W[j] * ED[j]; }
            u32x4 w; w.x = cvtpk(t[0], t[1]); w.y = cvtpk(t[2], t[3]); w.z = cvtpk(t[4], t[5]); w.w = cvtpk(t[6], t[7]);
            *(u32x4*)(Kdg + 8 * (pc ^ (lane & 7))) = w;
        }
#pragma unroll
        for (int i = 0; i < 64; ++i) W[i] *= BT[i] * EG[i];
#pragma unroll
        for (int i = 1; i < 64; ++i) {
            float sw = 0.f;
#pragma unroll
            for (int j4 = 0; j4 < i; j4 += 4) {
                const float4 av = *(const float4*)(AT + i * 64 + j4);
                sw += av.x * W[j4];
                if (j4 + 1 < i) sw += av.y * W[j4 + 1];
                if (j4 + 2 < i) sw += av.z * W[j4 + 2];
                if (j4 + 3 < i) sw += av.w * W[j4 + 3];
            }
            W[i] -= sw;
            __builtin_amdgcn_sched_barrier(0);
        }
        bf16_t* Wng = a.gWn() + (size_t)u * 4096; const int pp = pi_pos(lane);
#pragma unroll
        for (int i = 0; i < 64; ++i) Wng[i * 64 + (((pp >> 3) ^ (i & 7)) << 3) + (pp & 7)] = f2bf(-W[i]);
    }
    if (lane == 0) a.ggam()[u] = expf(gl);
}
__device__ __forceinline__ bf16x8 pack_acc2(const f32x4& x, const f32x4& y) {
    u32x4 w; w.x = cvtpk(x[0], x[1]); w.y = cvtpk(x[2], x[3]); w.z = cvtpk(y[0], y[1]); w.w = cvtpk(y[2], y[3]);
    return __builtin_bit_cast(bf16x8, w);
}
#define G2_SLOT 49152
__device__ __forceinline__ void g2_issue(const MK& a, size_t u, int n, LAS unsigned char* lds, int lw, int lane) {
    LAS unsigned char* dst = lds + (n % 3) * G2_SLOT;
    const char* srcs[4] = {(const char*)(a.gWn() + u * 4096), (const char*)(a.gQg() + u * 4096), (const char*)(a.gQK() + u * 4096), (const char*)(a.gKd() + u * 4096)};
#pragma unroll
    for (int m = 0; m < 4; ++m)
#pragma unroll
        for (int i = 0; i < 2; ++i) { const int piece = 2 * lw + i;
            __builtin_amdgcn_global_load_lds((const unsigned*)(srcs[m] + piece * 1024 + lane * 16), (LAS unsigned*)(dst + m * 8192 + piece * 1024), 16, 0, 0); }
    const char* us = (const char*)(a.gUT() + u * 4096);
#pragma unroll
    for (int i = 0; i < 4; ++i) { const int piece = 4 * lw + i;
        __builtin_amdgcn_global_load_lds((const unsigned*)(us + piece * 1024 + lane * 16), (LAS unsigned*)(dst + 32768 + piece * 1024), 16, 0, 0); }
}
__device__ __forceinline__ void gdn_scan_block(const MK& a, int bh, LAS unsigned char* lds) {
    const int tid = otid(), lane = tid & 63, wid = __builtin_amdgcn_readfirstlane(tid >> 6), i16 = lane & 15, q4 = lane >> 4;
    const int b = bh >> 3, h = bh & 7, sl = wid & 3;
    const bool loader = wid >= 4;
    f32x4 S[4];
#pragma unroll
    for (int mt = 0; mt < 4; ++mt) S[mt] = (f32x4){0.f, 0.f, 0.f, 0.f};
    __syncthreads();
    if (loader) { g2_issue(a, (size_t)bh * 32, 0, lds, wid - 4, lane); g2_issue(a, (size_t)bh * 32 + 1, 1, lds, wid - 4, lane); }
    for (int n = 0; n < 32; ++n) {
        if (loader) { if (n < 31) asm volatile("s_waitcnt vmcnt(12)" ::: "memory"); else asm volatile("s_waitcnt vmcnt(0)" ::: "memory"); }
        asm volatile("s_waitcnt lgkmcnt(0)" ::: "memory"); __builtin_amdgcn_s_barrier(); asm volatile("" ::: "memory");
        if (loader) { if (n + 2 < 32) g2_issue(a, (size_t)bh * 32 + n + 2, n + 2, lds, wid - 4, lane); }
        else {
            const LAS unsigned char* sb = lds + (n % 3) * G2_SLOT;
            const float gam = a.ggam()[(size_t)bh * 32 + n];
            bf16x8 Sb[2]; Sb[0] = pack_acc2(S[0], S[1]); Sb[1] = pack_acc2(S[2], S[3]);
            f32x4 Vn[4];
#pragma unroll
            for (int mt = 0; mt < 4; ++mt) Vn[mt] = *(const LAS f32x4*)(sb + 32768 + (16 * sl + i16) * 256 + 16 * ((4 * mt + q4) ^ i16));
#pragma unroll
            for (int mt = 0; mt < 4; ++mt)
#pragma unroll
                for (int ks = 0; ks < 2; ++ks) Vn[mt] = __builtin_amdgcn_mfma_f32_16x16x32_bf16(*(const LAS bf16x8*)(sb + (16 * mt + i16) * 128 + 16 * ((4 * ks + q4) ^ (i16 & 7))), Sb[ks], Vn[mt], 0, 0, 0);
            bf16x8 Vb[2]; Vb[0] = pack_acc2(Vn[0], Vn[1]); Vb[1] = pack_acc2(Vn[2], Vn[3]);
            f32x4 O[4];
#pragma unroll
            for (int mt = 0; mt < 4; ++mt) {
                O[mt] = (f32x4){0.f, 0.f, 0.f, 0.f};
#pragma unroll
                for (int ks = 0; ks < 2; ++ks) {
                    const int fo = (16 * mt + i16) * 128 + 16 * ((4 * ks + q4) ^ (i16 & 7));
                    O[mt] = __builtin_amdgcn_mfma_f32_16x16x32_bf16(*(const LAS bf16x8*)(sb + 8192 + fo), Sb[ks], O[mt], 0, 0, 0);
                    O[mt] = __builtin_amdgcn_mfma_f32_16x16x32_bf16(*(const LAS bf16x8*)(sb + 16384 + fo), Vb[ks], O[mt], 0, 0, 0);
                }
            }
#pragma unroll
            for (int mt = 0; mt < 4; ++mt) {
                S[mt] = S[mt] * gam;
#pragma unroll
                for (int ks = 0; ks < 2; ++ks) S[mt] = __builtin_amdgcn_mfma_f32_16x16x32_bf16(*(const LAS bf16x8*)(sb + 24576 + (16 * mt + i16) * 128 + 16 * ((4 * ks + q4) ^ (i16 & 7))), Vb[ks], S[mt], 0, 0, 0);
            }
            float* og = a.goraw() + ((size_t)b * SEQ + n * 64 + 4 * q4) * 512 + h * 64 + 16 * sl + i16;
#pragma unroll
            for (int mt = 0; mt < 4; ++mt)
#pragma unroll
                for (int r = 0; r < 4; ++r) og[(size_t)(16 * mt + r) * 512] = O[mt][r];
        }
    }
    if (!loader) {
        float* so = a.out + O_GSP + ((size_t)bh * 64 + 4 * q4) * 64 + 16 * sl + i16;
#pragma unroll
        for (int mt = 0; mt < 4; ++mt)
#pragma unroll
            for (int r = 0; r < 4; ++r) so[(size_t)(16 * mt + r) * 64] = S[mt][r];
    }
    __syncthreads();
}
__device__ __forceinline__ void gdn_out_token(const MK& a, int row, int lane) {
    const float* op = a.goraw() + (size_t)row * 512 + 8 * lane;
    const float4 x0 = *(const float4*)op, x1 = *(const float4*)(op + 4);
    float o[8] = {x0.x, x0.y, x0.z, x0.w, x1.x, x1.y, x1.z, x1.w}, zg[8];
    bf8_to_f32(*(const bf16x8*)(a.Z() + (size_t)row * ZW + OFF_Z + 8 * lane), zg);
    float ss = 0.f;
#pragma unroll
    for (int e = 0; e < 8; ++e) ss += o[e] * o[e];
    ss = sum8(ss);
    const float rs = rsqrtf(ss * (1.f / 64.f) + EPSV);
    const float4 g0 = *(const float4*)(a.g_gdn_out + 8 * (lane & 7)), g1 = *(const float4*)(a.g_gdn_out + 8 * (lane & 7) + 4);
    const float gg_[8] = {g0.x, g0.y, g0.z, g0.w, g1.x, g1.y, g1.z, g1.w};
#pragma unroll
    for (int e = 0; e < 8; ++e) o[e] = o[e] * rs * gg_[e] * zg[e] * fast_sigmoid(zg[e]);
    *(bf16x8*)(a.omix() + (size_t)row * 1024 + 8 * lane) = f32_to_bf8(o);
}

#define SSLOT 32768
#define TL_OFF (3 * SSLOT)
#define CST 264
#define KR_OFF (TL_OFF + 2 * 32 * CST * 2)
#define WQ_OFF (KR_OFF + 4 * 4096)
#define QR_OFF (WQ_OFF + 2048)
#define PG_OFF (QR_OFF + 1024)
#define PT_OFF (PG_OFF + 64)
#define AL_OFF (PT_OFF + 1024)
#define SAMP_LDS_END (AL_OFF + 64)
__device__ __forceinline__ void samp_issue(const MK& a, int g, LAS unsigned char* lds, int wid, int lane) {
    const int phys = __builtin_amdgcn_readfirstlane(((const LAS int*)(lds + PG_OFF))[g >> 2]);
    const int tok0 = (g & 3) * 32 + 4 * wid;
    const float* cs = a.cache_ckv + ((size_t)phys * 128 + tok0) * 256 + lane * 4;
#pragma unroll
    for (int i = 0; i < 4; ++i) __builtin_amdgcn_global_load_lds((const unsigned*)(cs + i * 256), (LAS unsigned*)(lds + (g % 3) * SSLOT + (4 * wid + i) * 1024), 16, 0, 0);
    if (wid < 4) { const int tl = lane >> 3, cg = (lane & 7) ^ (((tl >> 1) & 1) | ((wid & 1) << 2));
        __builtin_amdgcn_global_load_lds((const unsigned*)(a.cache_krope + ((size_t)phys * 128 + (g & 3) * 32 + 8 * wid + tl) * 32 + cg * 4), (LAS unsigned*)(lds + KR_OFF + (g & 3) * 4096 + wid * 1024), 16, 0, 0); }
}
typedef unsigned u32x2 __attribute__((ext_vector_type(2)));
__device__ __forceinline__ void samp_convert(int g, LAS unsigned char* lds, int tid) {
    const int st = tid >> 4, l16 = tid & 15;
    const LAS float* src = (const LAS float*)(lds + (g % 3) * SSLOT) + st * 256 + 4 * l16;
    LAS bf16_t* dst = (LAS bf16_t*)(lds + TL_OFF + (g & 1) * 32 * CST * 2) + st * CST + 4 * l16;
    f32x4 x[4];
#pragma unroll
    for (int k = 0; k < 4; ++k) x[k] = *(const LAS f32x4*)(src + 64 * k);
#pragma unroll
    for (int k = 0; k < 4; ++k) { u32x2 w; w.x = cvtpk(x[k][0], x[k][1]); w.y = cvtpk(x[k][2], x[k][3]); *(LAS u32x2*)(dst + 64 * k) = w; }
}
#define SAMP_WAITV(n5, n4) do { if (h < 4) asm volatile("s_waitcnt vmcnt(" #n5 ")" ::: "memory"); else asm volatile("s_waitcnt vmcnt(" #n4 ")" ::: "memory"); } while (0)
#define SAMP_BAR() do { asm volatile("s_waitcnt lgkmcnt(0)" ::: "memory"); __builtin_amdgcn_s_barrier(); asm volatile("" ::: "memory"); } while (0)
__device__ __forceinline__ void samp_attn_unit(const MK& a, int u, char* smem, LAS unsigned char* lds) {
    const int tid = otid(), lane = tid & 63, h = __builtin_amdgcn_readfirstlane(tid >> 6), i16 = lane & 15, q4 = lane >> 4;
    const int b = u >> 3, sp = u & 7;
    float* WQ = (float*)(smem + WQ_OFF);
    float* QR = (float*)(smem + QR_OFF);
    int* PG = (int*)(smem + PG_OFF);
    const float SCL = 0.14724445f;
    post_q_item(a, (NPT + b) * 8 + h, lane);
    __syncthreads();
    {
        const int h_ = tid >> 6, l_ = tid & 63, q4_ = l_ >> 4, idx = l_ & 15, d = 16 * (idx >> 2) + 4 * q4_ + (idx & 3);
        WQ[tid] = a.g_k_nope[d] * a.qh()[((size_t)(NPT + b) * 8 + h_) * 96 + d] * SCL;
        if (tid < 256) QR[tid] = a.qh()[((size_t)(NPT + b) * 8 + (tid >> 5)) * 96 + 64 + (tid & 31)] * SCL;
        if (tid < 16) PG[tid] = a.page_table[b * NPAGES + sp * 16 + tid];
    }
    bf16x8 wf[4][8];
#pragma unroll
    for (int mt = 0; mt < 4; ++mt)
#pragma unroll
        for (int ks = 0; ks < 8; ++ks) wf[mt][ks] = *(const bf16x8*)(a.WknT() + (size_t)(h * 64 + 16 * mt + i16) * 256 + 32 * ks + 8 * q4);
#pragma unroll
    for (int mt = 0; mt < 4; ++mt)
#pragma unroll
        for (int ks = 0; ks < 8; ++ks) asm volatile("" : "+v"(wf[mt][ks]));
    __syncthreads();
    samp_issue(a, 0, lds, h, lane); samp_issue(a, 1, lds, h, lane); samp_issue(a, 2, lds, h, lane);
    SAMP_WAITV(10, 8);
    SAMP_BAR();
    samp_convert(0, lds, tid);
    const LAS float* QRl = (const LAS float*)(lds + QR_OFF) + h * 32 + 8 * q4;
    const LAS float* WQl = (const LAS float*)(lds + WQ_OFF) + (h * 4 + q4) * 16;
    f32x4 wqr[4], qrr[2];
#pragma unroll
    for (int mt = 0; mt < 4; ++mt) wqr[mt] = *(const LAS f32x4*)(WQl + 4 * mt);
    qrr[0] = *(const LAS f32x4*)QRl; qrr[1] = *(const LAS f32x4*)(QRl + 4);
    float m = -INFINITY, lsum = 0.f;
    f32x4 latv[2]; latv[0] = (f32x4){0.f, 0.f, 0.f, 0.f}; latv[1] = (f32x4){0.f, 0.f, 0.f, 0.f};
    for (int g = 0; g < 64; ++g) {
        SAMP_BAR();
        if (g + 3 < 64) samp_issue(a, g + 3, lds, h, lane);
        const LAS bf16_t* Tl = (const LAS bf16_t*)(lds + TL_OFF + (g & 1) * 32 * CST * 2); const LAS float* KR = (const LAS float*)(lds + KR_OFF + (g & 3) * 4096);
        float scv;
        {
            float ssp[2], dotp[2], rdp[2];
            f32x4 acc[2][4];
#pragma unroll
            for (int hf = 0; hf < 2; ++hf)
#pragma unroll
                for (int mt = 0; mt < 4; ++mt) acc[hf][mt] = (f32x4){0.f, 0.f, 0.f, 0.f};
            const LAS bf16_t* cp0 = Tl + i16 * CST + 8 * q4; const LAS bf16_t* cp1 = cp0 + 16 * CST;
            bf16x8 c0 = *(const LAS bf16x8*)cp0, c1 = *(const LAS bf16x8*)cp1;
#pragma unroll
            for (int ks = 0; ks < 8; ++ks) {
                bf16x8 n0 = c0, n1 = c1;
                if (ks < 7) { n0 = *(const LAS bf16x8*)(cp0 + 32 * (ks + 1)); n1 = *(const LAS bf16x8*)(cp1 + 32 * (ks + 1)); }
#pragma unroll
                for (int mt = 0; mt < 4; ++mt) { acc[0][mt] = __builtin_amdgcn_mfma_f32_16x16x32_bf16(wf[mt][ks], c0, acc[0][mt], 0, 0, 0); acc[1][mt] = __builtin_amdgcn_mfma_f32_16x16x32_bf16(wf[mt][ks], c1, acc[1][mt], 0, 0, 0); }
                c0 = n0; c1 = n1;
            }
#pragma unroll
            for (int hf = 0; hf < 2; ++hf) {
                f32x2_t ss2 = {0.f, 0.f}, dot2 = {0.f, 0.f}, rd2 = {0.f, 0.f};
#pragma unroll
                for (int mt = 0; mt < 4; ++mt) {
                    const f32x4 wq = wqr[mt];
                    const f32x4 av = acc[hf][mt];
                    const f32x2_t lo = __builtin_shufflevector(av, av, 0, 1), hi = __builtin_shufflevector(av, av, 2, 3);
                    ss2 = __builtin_elementwise_fma(lo, lo, ss2); ss2 = __builtin_elementwise_fma(hi, hi, ss2);
                    dot2 = __builtin_elementwise_fma(lo, __builtin_shufflevector(wq, wq, 0, 1), dot2); dot2 = __builtin_elementwise_fma(hi, __builtin_shufflevector(wq, wq, 2, 3), dot2);
                }
                {
                    const int kc = (2 * q4) ^ ((i16 >> 1) & 5);
                    const LAS float* kp = KR + (16 * hf + i16) * 32;
                    const f32x4 k0 = *(const LAS f32x4*)(kp + 4 * kc), k1 = *(const LAS f32x4*)(kp + 4 * (kc ^ 1)), q0 = qrr[0], q1 = qrr[1];
                    rd2 = __builtin_elementwise_fma(__builtin_shufflevector(k0, k0, 0, 1), __builtin_shufflevector(q0, q0, 0, 1), rd2); rd2 = __builtin_elementwise_fma(__builtin_shufflevector(k0, k0, 2, 3), __builtin_shufflevector(q0, q0, 2, 3), rd2);
                    rd2 = __builtin_elementwise_fma(__builtin_shufflevector(k1, k1, 0, 1), __builtin_shufflevector(q1, q1, 0, 1), rd2); rd2 = __builtin_elementwise_fma(__builtin_shufflevector(k1, k1, 2, 3), __builtin_shufflevector(q1, q1, 2, 3), rd2);
                }
                ssp[hf] = ss2[0] + ss2[1]; dotp[hf] = dot2[0] + dot2[1]; rdp[hf] = rd2[0] + rd2[1];
            }
            const auto s1 = __builtin_amdgcn_permlane16_swap(__float_as_uint(ssp[0]), __float_as_uint(ssp[1]), false, false);
            const auto s2 = __builtin_amdgcn_permlane16_swap(__float_as_uint(dotp[0]), __float_as_uint(dotp[1]), false, false);
            const auto s3 = __builtin_amdgcn_permlane16_swap(__float_as_uint(rdp[0]), __float_as_uint(rdp[1]), false, false);
            const float u1 = __uint_as_float(s1[0]) + __uint_as_float(s1[1]), u2 = __uint_as_float(s2[0]) + __uint_as_float(s2[1]), u3 = __uint_as_float(s3[0]) + __uint_as_float(s3[1]);
            const auto t1 = __builtin_amdgcn_permlane32_swap(__float_as_uint(u1), __float_as_uint(u2), false, false);
            const float t = __uint_as_float(t1[0]) + __uint_as_float(t1[1]);
            const auto t2 = __builtin_amdgcn_permlane32_swap(__float_as_uint(t), __float_as_uint(t), false, false);
            const float ssv = __uint_as_float(t2[0]), dotv = __uint_as_float(t2[1]);
            const float rdv = add_x32(u3);
            scv = dotv * rsqrtf(ssv * (1.f / 64.f) + EPSV) + rdv;
        }
        float gm = max16(scv);
        { const auto r = __builtin_amdgcn_permlane16_swap(__float_as_uint(gm), __float_as_uint(gm), false, false); gm = fmaxf(__uint_as_float(r[0]), __uint_as_float(r[1])); }
        const float mn = fmaxf(m, gm);
        const float alpha = __builtin_amdgcn_exp2f(m - mn), pv = __builtin_amdgcn_exp2f(scv - mn);
        m = mn;
        lsum = lsum * alpha + pv;
        if (q4 < 2) { ((LAS float*)(lds + PT_OFF))[h * 32 + lane] = pv; if (lane == 0) ((LAS float*)(lds + AL_OFF))[h] = alpha; }
        if (g <= 60) SAMP_WAITV(10, 8); else if (g == 61) SAMP_WAITV(5, 4); else SAMP_WAITV(0, 0);
        SAMP_BAR();
        {
            u32x4 pw = {0u, 0u, 0u, 0u};
            if (i16 < 8) { const f32x4 pa = *(const LAS f32x4*)(lds + PT_OFF + (i16 * 32 + 8 * q4) * 4), pb_ = *(const LAS f32x4*)(lds + PT_OFF + (i16 * 32 + 8 * q4 + 4) * 4);
                pw.x = cvtpk(pa[0], pa[1]); pw.y = cvtpk(pa[2], pa[3]); pw.z = cvtpk(pb_[0], pb_[1]); pw.w = cvtpk(pb_[2], pb_[3]); }
            const bf16x8 pfr = __builtin_bit_cast(bf16x8, pw);
            const f32x4 al = *(const LAS f32x4*)(lds + AL_OFF + (q4 & 1) * 16);
            const unsigned tb0 = (unsigned)(size_t)((const LAS bf16_t*)(lds + TL_OFF + (g & 1) * 32 * CST * 2) + (8 * q4 + (i16 >> 2)) * CST + 32 * h + 4 * (i16 & 3));
            s16x4 c0[2], c1[2];
            static_assert(4 * CST * 2 == 2112, "tr offsets");
            asm volatile("ds_read_b64_tr_b16 %0, %4\n\tds_read_b64_tr_b16 %1, %4 offset:2112\n\tds_read_b64_tr_b16 %2, %4 offset:32\n\tds_read_b64_tr_b16 %3, %4 offset:2144\n\ts_waitcnt lgkmcnt(0)"
                         : "=&v"(c0[0]), "=&v"(c1[0]), "=&v"(c0[1]), "=&v"(c1[1]) : "v"(tb0) : "memory");
#pragma unroll
            for (int nt = 0; nt < 2; ++nt) {
                const bf16x8 cfr = __builtin_shufflevector(c0[nt], c1[nt], 0, 1, 2, 3, 4, 5, 6, 7);
                latv[nt] = latv[nt] * al;
                latv[nt] = __builtin_amdgcn_mfma_f32_16x16x32_bf16(pfr, cfr, latv[nt], 0, 0, 0);
            }
        }
        if (g + 1 < 64) samp_convert(g + 1, lds, tid);
    }
    lsum = add_x16(sum16(lsum));
    if (lane == 0) { float* o = a.part() + ((size_t)u * 8 + h) * 260; o[0] = m * 0.69314718f; o[1] = lsum; }
    if (q4 < 2) {
#pragma unroll
        for (int nt = 0; nt < 2; ++nt)
#pragma unroll
            for (int r = 0; r < 4; ++r) a.part()[((size_t)u * 8 + 4 * q4 + r) * 260 + 4 + 32 * h + 16 * nt + i16] = latv[nt][r];
    }
}
__device__ __forceinline__ void samp_comb_unit(const MK& a, int u, char* smem) {
    float* slat = (float*)smem; float* red = slat + 256;
    const int b = u >> 3, h = u & 7, tid = otid(), lane = tid & 63, wid = tid >> 6;
    const size_t row = NPT + b;
    const float* q = a.qh() + (row * 8 + h) * 96;
    float sp = q[lane] * a.kh()[(row * 8 + h) * 64 + lane];
    if (lane < 32) sp += q[64 + lane] * a.krf()[row * 32 + lane];
    const float s_self = wave_sum(sp) * 0.10206207261596577f;
    float pm[8], m = s_self;
#pragma unroll
    for (int s = 0; s < 8; ++s) { pm[s] = a.part()[((size_t)(b * 8 + s) * 8 + h) * 260]; m = fmaxf(m, pm[s]); }
    const float pself = __expf(s_self - m);
    float l = pself, lat = 0.f;
    __syncthreads();
#pragma unroll
    for (int s = 0; s < 8; ++s) {
        const float* p = a.part() + ((size_t)(b * 8 + s) * 8 + h) * 260;
        const float w = __expf(pm[s] - m);
        l += p[1] * w; if (tid < 256) lat += p[4 + tid] * w;
    }
    if (tid < 256) slat[tid] = lat;
    __syncthreads();
    {
        const float* wv = a.w_kv_b + (size_t)(32 * wid) * 1024 + h * 128 + 64 + lane;
        float o = 0.f;
#pragma unroll 8
        for (int c = 0; c < 32; ++c) o += slat[32 * wid + c] * wv[(size_t)c * 1024];
        red[wid * 64 + lane] = o;
    }
    __syncthreads();
    if (tid < 64) {
        float o = pself * a.KV()[row * 1024 + h * 128 + 64 + tid];
#pragma unroll
        for (int w = 0; w < 8; ++w) o += red[w * 64 + tid];
        a.omix()[row * 1024 + 512 + h * 64 + tid] = f2bf(o / l);
    }
}

#define XB_TMO      128
#define XB_XCNT(j)  (256  + 64 * (j))
#define XB_XSUB(j)  (1280 + 64 * (j))
#define XB_XGEN(j)  (2304 + 64 * (j))
#define XB_TOP      3328
#define XB_TOPGEN   3392
#define XCD_BAR_WORDS 3456
#define XB_SPIN_CAP (1u << 18)

__device__ __forceinline__ unsigned xb_ld(unsigned* p)              { return __hip_atomic_load(p, __ATOMIC_RELAXED, __HIP_MEMORY_SCOPE_AGENT); }
__device__ __forceinline__ unsigned xb_add(unsigned* p, unsigned v) { return __hip_atomic_fetch_add(p, v, __ATOMIC_RELAXED, __HIP_MEMORY_SCOPE_AGENT); }
__device__ __forceinline__ unsigned xb_xcc_id() { return (unsigned)__builtin_amdgcn_s_getreg((3 << 11) | 20) & 0xFu; }
#define XB_SPIN(cond, bar) do { unsigned _sp = 0; while (cond) { __builtin_amdgcn_s_sleep(1); \
    if ((++_sp & 255u) == 0u) { if (xb_ld(&(bar)[XB_TMO])) break; if (_sp > XB_SPIN_CAP) { atomicAdd(&(bar)[XB_TMO], 1u); break; } } } } while (0)

struct XcdBarrier {
    unsigned* bar; unsigned x;
    volatile LAS unsigned* st;
};

__device__ __forceinline__ XcdBarrier xcd_barrier_post(unsigned* bar, volatile LAS unsigned* st) {
    XcdBarrier b; b.bar = bar; b.x = xb_xcc_id(); b.st = st;
    if (threadIdx.x == 0) (void)xb_add(&bar[XB_XCNT(b.x)], 1u);
    return b;
}
__device__ __forceinline__ void xcd_barrier_complete(unsigned* bar, unsigned x, unsigned& nloc, unsigned& nx) {
    const unsigned G = gridDim.x * gridDim.y * gridDim.z;
    unsigned sum, cnt, mine, sp = 0u;
    for (;;) {
        sum = 0u; cnt = 0u; mine = 0u;
#pragma unroll
        for (unsigned j = 0; j < 16; ++j) { const unsigned c = xb_ld(&bar[XB_XCNT(j)]); sum += c; cnt += (c > 0u) ? 1u : 0u; mine = (j == x) ? c : mine; }
        if (sum == G) break;
        __builtin_amdgcn_s_sleep(1);
        if ((++sp & 255u) == 0u) { if (xb_ld(&bar[XB_TMO])) break; if (sp > XB_SPIN_CAP) { atomicAdd(&bar[XB_TMO], 1u); break; } }
    }
    nloc = mine > 0u ? mine : 1u; nx = cnt > 0u ? cnt : 1u;
}

__device__ __forceinline__ void xcd_barrier(const XcdBarrier& b) {
    asm volatile("s_waitcnt vmcnt(0)" ::: "memory");
    __syncthreads();
    if (threadIdx.x == 0) {
        unsigned* bar = b.bar;
        __builtin_amdgcn_s_waitcnt(0);
        unsigned nloc = b.st[0], nx = b.st[1];
        if (nloc == 0u) { xcd_barrier_complete(bar, b.x, nloc, nx); b.st[0] = nloc; b.st[1] = nx; }
        const unsigned old = xb_add(&bar[XB_XSUB(b.x)], 1u);
        const unsigned gen = old / nloc;
        if (old + 1u == (gen + 1u) * nloc) {
            __builtin_amdgcn_fence(__ATOMIC_RELEASE, "agent");
            asm volatile("s_waitcnt vmcnt(0)" ::: "memory");
            const unsigned og = xb_add(&bar[XB_TOP], 1u);
            const unsigned tg = og / nx;
            if (og + 1u == (tg + 1u) * nx) xb_add(&bar[XB_TOPGEN], 1u);
            else XB_SPIN(xb_ld(&bar[XB_TOPGEN]) == tg, bar);
            __builtin_amdgcn_fence(__ATOMIC_ACQUIRE, "agent");
            xb_add(&bar[XB_XGEN(b.x)], 1u);
            asm volatile("s_waitcnt vmcnt(0)" ::: "memory");
        } else {
            XB_SPIN(xb_ld(&bar[XB_XGEN(b.x)]) == gen, bar);
            __builtin_amdgcn_fence(__ATOMIC_ACQUIRE, "agent");
            asm volatile("s_waitcnt vmcnt(0)" ::: "memory");
        }
    }
    __syncthreads();
}

__device__ __forceinline__ void late_weight_items(const MK& a, int gwl, int ngwl, float* scr, int lane) {
    const int T4 = 32 * 16, T5 = 176 * 16, T7 = 32 * 44, T8 = 32 * 16, TT = T4 + T5 + T7 + T8;
    for (int it = gwl; it < TT; it += ngwl) {
        int r = it;
        if (r < T4) { const int nt_ = r % 32, kb = r / 32; wt_item(a.w_o, 1024, 32 * nt_, 32, a.WoT(), 1024, 32 * nt_, 64 * kb, scr, lane); continue; } r -= T4;
        if (r < T5) { const int nt_ = r % 176, kb = r / 176, pn = nt_ >> 3, wi = nt_ & 7;
            wt_item(wi < 4 ? a.w_gate : a.w_up, DFF, pn * 128 + (wi & 3) * 32, 32, a.WguT(), 1024, 32 * nt_, 64 * kb, scr, lane); continue; } r -= T5;
        if (r < T7) { const int nt_ = r % 32, kb = r / 32; wt_item(a.w_down, 1024, 32 * nt_, 32, a.WdT(), DFF, 32 * nt_, 64 * kb, scr, lane); continue; } r -= T7;
        { const int nt_ = r % 32, kb = r / 32; wt_item(a.w_ple_gate, 1024, 32 * nt_, 32, a.WpgT(), 1024, 32 * nt_, 64 * kb, scr, lane); }
    }
}

#define XB_ST_OFF 155648
#define LDS_BYTES 155904
static_assert(SAMP_LDS_END <= LDS_BYTES, "LDS map");
#define GSYNC() do { xcd_barrier(xbar); } while (0)
__global__ __launch_bounds__(NTHR, 2) void mega(MK a) {
    cg::grid_group grid = cg::this_grid();
    char* smem = (char*)lds_raw;
    LAS unsigned char* lds = (LAS unsigned char*)lds_raw;
    otid_init();
    if (threadIdx.x < 2) ((LAS unsigned*)(lds_raw + XB_ST_OFF))[threadIdx.x] = 0u;
    __syncthreads();
    const XcdBarrier xbar = xcd_barrier_post(a.ctl(), (volatile LAS unsigned*)(LAS void*)(lds_raw + XB_ST_OFF));
    const int bid = blockIdx.x, nb = gridDim.x, ngw = nb * NWAVE;
#define LOCAL_IDS const int tid = otid(), lane = tid & 63, wid = tid >> 6, half = tid >> 8, gw = bid * NWAVE + wid; (void)lane; (void)half; (void)gw; (void)wid;

    {
    LOCAL_IDS
    {
        const int T0 = 88 * 16, T1 = 24 * 6, T2 = 32 * 4, T3 = 16 * 4, T9 = 32 * 4;
        const int TT = T0 + T1 + T2 + T3 + T9;
        float* scr = (float*)(smem + wid * 8704);
        for (int it = gw; it < TT; it += ngw) {
            int r = it;
            if (r < T0) { const int nt_ = r % 88, kb = r / 88, nv = 2736 - 32 * nt_; wt_item(a.w_in, 2736, 32 * nt_, nv < 0 ? 0 : (nv > 32 ? 32 : nv), a.WinT(), 1024, 32 * nt_, 64 * kb, scr, lane); continue; } r -= T0;
            if (r < T1) { const int nt_ = r % 24, kb = r / 24; wt_item(a.w_q_b, 768, 32 * nt_, 32, a.WqbT(), 384, 32 * nt_, 64 * kb, scr, lane); continue; } r -= T1;
            if (r < T2) { const int nt_ = r % 32, kb = r / 32; wt_item(a.w_kv_b, 1024, 32 * nt_, 32, a.WkvT(), 256, 32 * nt_, 64 * kb, scr, lane); continue; } r -= T2;
            if (r < T3) { const int nt_ = r % 16, kb = r / 16, h = nt_ >> 1; wt_item(a.w_kv_b, 1024, h * 128 + 32 * (nt_ & 1), 32, a.WknT(), 256, 32 * nt_, 64 * kb, scr, lane); continue; } r -= T3;
            { const int nt_ = r % 32, kb = r / 32; wt_item(a.w_ple_proj, 1024, 32 * nt_, 32, a.WppT(), 256, 32 * nt_, 64 * kb, scr, lane); }
        }
        for (int e = (bid * NTHR + tid); e < 2049 * 16; e += nb * NTHR) {
            const int pos = e >> 4, i = e & 15; const float ang = (pos == 2048 ? (float)PAST : (float)pos) * powf(10000.f, -(float)i / 16.f);
            a.ropecs()[pos * 32 + i] = cosf(ang); a.ropecs()[pos * 32 + 16 + i] = sinf(ang);
        }
        for (int row = gw; row < MPAD; row += ngw) {
            const float* src = row < NPT ? a.x_prompt + (size_t)row * 1024 : a.x_sample + (size_t)(row < NTOK ? row - NPT : 0) * 1024;
            rms1024_row(src, a.g_attn, a.xn() + (size_t)row * 1024, row >= NTOK, lane);
            ushort4 w = {0, 0, 0, 0};
            if (row < NTOK) { const float* ps = row < NPT ? a.p_prompt + (size_t)row * 256 : a.p_sample + (size_t)(row - NPT) * 256; const float4 v = *(const float4*)(ps + lane * 4); w.x = f2bf(v.x); w.y = f2bf(v.y); w.z = f2bf(v.z); w.w = f2bf(v.w); }
            *(ushort4*)(a.pb() + (size_t)row * 256 + lane * 4) = w;
            if (row >= NTOK) { for (int j = 0; j < 4; ++j) { ushort4 z = {0, 0, 0, 0}; *(ushort4*)(a.omix() + (size_t)row * 1024 + lane * 4 + 256 * j) = z; } }
        }
    }
    }
    if (a.out == nullptr) grid.sync();
    GSYNC();
    {
    LOCAL_IDS
    pg_gemm(lds, a.xn(), a.WinT(), NPT, ZW, 1024, PgBf16{a.Z(), ZW});
    gemm_sample_rows_ks<false>(a.xn(), 1024, a.WinT(), 1024, ZW, EwBf16{a.Z(), ZW}, smem, bid, nb);
    }
    GSYNC();
    {
    LOCAL_IDS
    for (int e = tid; e < 4 * 1536 / 4; e += NTHR) ((float4*)smem)[e] = ((const float4*)a.w_conv)[e];
    __syncthreads();
    for (int run = gw; run < NPT / 8 + NST; run += ngw) post_in_run(a, run, lane, (const float*)smem);
    }
    GSYNC();
    {
    LOCAL_IDS
    for (int u = gw; u < 2048; u += ngw) gdn_prep_unit(a, u, lane, smem + wid * GDN_WLDS);
    }
    {
    LOCAL_IDS
    for (int v = gw; v < NST * 64; v += ngw) gdn_unit(a, v >> 6, (v >> 3) & 7, v & 7, a.state_gdn, a.out + O_GSS, NPT, 1, lane, smem + wid * GDN_WLDS);
    __syncthreads();
    }
    GSYNC();
    {
    LOCAL_IDS
    pg_gemm(lds, a.qan(), a.WqbT(), NPT, 768, 384, PgBf16{a.qraw(), 768});
    pg_gemm(lds, a.ckvb(), a.WkvT(), NPT, 1024, 256, PgBf16{a.kvraw(), 1024}, nb > 64 ? nb - 64 : 0);
    gemm_sample_rows<false>(a.qan(), 384, a.WqbT(), 384, 768, EwF32{a.Q(), 768}, smem, bid, nb, 64);
    gemm_sample_rows<false>(a.ckvb(), 256, a.WkvT(), 256, 1024, EwF32{a.KV(), 1024}, smem, bid, nb, 72);
    for (int bh_ = nb - 1 - bid; bh_ < 64; bh_ += nb) gdn_scan_block(a, bh_, lds);
    if (nb > 64 && bid < nb - 64) {
        pg_gemm(lds, a.pb(), a.WppT(), NPT, 1024, 256, PgBf16{a.PP(), 1024}, nb - 64);
        __syncthreads();
        late_weight_items(a, bid * NWAVE + wid, (nb - 64) * NWAVE, (float*)(smem + wid * 8704), lane);
    } else if (nb <= 64) { pg_gemm(lds, a.pb(), a.WppT(), NPT, 1024, 256, PgBf16{a.PP(), 1024}); __syncthreads(); late_weight_items(a, gw, ngw, (float*)(smem + wid * 8704), lane); }
    gemm_sample_rows<false>(a.pb(), 256, a.WppT(), 256, 1024, EwBf16{a.PP(), 1024}, smem, bid, nb, 80);
    }
    GSYNC();
    {
    LOCAL_IDS
    for (int idx = gw; idx < NST * 8; idx += ngw) { post_q_item(a, NPT * 8 + idx, lane); post_kv_item(a, NPT * 8 + idx, lane); }
    for (int row = gw; row < NTOK; row += ngw) gdn_out_token(a, row, lane);
    for (int pr = bid; pr < 256; pr += nb) { const int bh_ = pr >> 2, s_ = pr & 3; attn_block(a, bh_ >> 3, bh_ & 7, 7 - s_, smem); attn_block(a, bh_ >> 3, bh_ & 7, s_, smem); }
    for (int u = bid; u < NST * 8; u += nb) samp_attn_unit(a, u, smem, lds);
    }
    GSYNC();
    {
    LOCAL_IDS
    for (int u = bid; u < NST * 8; u += nb) samp_comb_unit(a, u, smem);
    }
    GSYNC();
    {
    LOCAL_IDS
    pg_gemm(lds, a.omix(), a.WoT(), NPT, 1024, 1024, PgResXB{a.x_prompt, a.H()});
    gemm_sample_rows_ks<false, EwResX, 1>(a.omix(), 1024, a.WoT(), 1024, 1024, EwResX{a.x_sample, a.H()}, smem, bid, nb);
    }
    GSYNC();
    {
    LOCAL_IDS
    for (int row = gw; row < MPAD; row += ngw) rms1024_row_b(a.H() + (size_t)row * 1024, a.g_ffn, a.un() + (size_t)row * 1024, row >= NTOK, lane);
    }
    GSYNC();
    {
    LOCAL_IDS
    pg_gemm(lds, a.un(), a.WguT(), NPT, 2 * DFF, 1024, PgSwiglu{a.hid()});
    gemm_sample_rows_ks<true>(a.un(), 1024, a.WguT(), 1024, 2 * DFF, EwBf16{a.hid(), DFF}, smem, bid, nb);
    }
    GSYNC();
    {
    LOCAL_IDS
    pg_gemm(lds, a.hid(), a.WdT(), NPT, 1024, DFF, PgResBB{a.H(), a.H2()});
    gemm_sample_rows_ks<false, EwResH, 1>(a.hid(), DFF, a.WdT(), DFF, 1024, EwResH{a.H(), a.H2()}, smem, bid, nb);
    }
    GSYNC();
    {
    LOCAL_IDS
    for (int row = gw; row < MPAD; row += ngw) rms1024_row_b(a.H2() + (size_t)row * 1024, a.g_ple, a.un2() + (size_t)row * 1024, row >= NTOK, lane);
    }
    GSYNC();
    {
    LOCAL_IDS
    pg_gemm(lds, a.un2(), a.WpgT(), NPT, 1024, 1024, PgPleB{a.H2(), a.PP(), a.out});
    gemm_sample_rows_ks<false, EwPle, 1>(a.un2(), 1024, a.WpgT(), 1024, 1024, EwPle{a.H2(), a.PP(), a.out}, smem, bid, nb);
    }
}

static inline char* carve(char*& p, size_t bytes) { char* r = p; p += (bytes + 255) & ~(size_t)255; return r; }

extern "C" void kernel_launch(void* const* d_in, const int* in_sizes, int n_in, void* d_out, int out_size, void* d_ws, size_t ws_size, hipStream_t stream) {
    MK a{};
    a.x_prompt = (const float*)d_in[0]; a.x_sample = (const float*)d_in[1]; a.cache_ckv = (const float*)d_in[2]; a.cache_krope = (const float*)d_in[3];
    a.state_gdn = (const float*)d_in[4]; a.state_conv = (const float*)d_in[5]; a.page_table = (const int*)d_in[6]; a.p_prompt = (const float*)d_in[7]; a.p_sample = (const float*)d_in[8];
    a.g_attn = (const float*)d_in[9]; a.w_in = (const float*)d_in[10]; a.w_conv = (const float*)d_in[11]; a.a_log = (const float*)d_in[12]; a.dt_bias = (const float*)d_in[13];
    a.g_gdn_out = (const float*)d_in[14]; a.g_q_a = (const float*)d_in[15]; a.w_q_b = (const float*)d_in[16]; a.g_q_nope = (const float*)d_in[17]; a.g_q_rope = (const float*)d_in[18];
    a.g_kv_a = (const float*)d_in[19]; a.g_k_rope = (const float*)d_in[20]; a.w_kv_b = (const float*)d_in[21]; a.g_k_nope = (const float*)d_in[22]; a.w_o = (const float*)d_in[23];
    a.g_ffn = (const float*)d_in[24]; a.w_gate = (const float*)d_in[25]; a.w_up = (const float*)d_in[26]; a.w_down = (const float*)d_in[27]; a.g_ple = (const float*)d_in[28];
    a.w_ple_gate = (const float*)d_in[29]; a.w_ple_proj = (const float*)d_in[30];
    a.out = (float*)d_out;
    a.ws = (char*)d_ws;
    if (WS_TOTAL > ws_size) { fprintf(stderr, "kernel_launch: workspace too small: need %zu have %zu\n", (size_t)WS_TOTAL, ws_size); return; }

    static int grid_blocks = 0;
    if (!grid_blocks) {
        int dev = 0, cus = 0, per_cu = 0;
        (void)hipGetDevice(&dev);
        (void)hipDeviceGetAttribute(&cus, hipDeviceAttributeMultiprocessorCount, dev);
        (void)hipFuncSetAttribute((const void*)mega, hipFuncAttributeMaxDynamicSharedMemorySize, LDS_BYTES);
        (void)hipOccupancyMaxActiveBlocksPerMultiprocessor(&per_cu, (const void*)mega, NTHR, LDS_BYTES);
        if (per_cu < 1) fprintf(stderr, "kernel_launch: occupancy query says %d blocks/CU\n", per_cu);
        grid_blocks = cus;
    }
    (void)hipMemsetAsync((char*)d_ws + WOF_ctl, 0, 16384, stream);
    void* args[] = {&a};
    hipError_t e = hipLaunchCooperativeKernel((const void*)mega, dim3(grid_blocks), dim3(NTHR), args, LDS_BYTES, stream);
    if (e != hipSuccess) fprintf(stderr, "cooperative launch failed: %s (grid %d)\n", hipGetErrorString(e), grid_blocks);
}
```

```cpp
#include <hip/hip_runtime.h>
#include <stdint.h>
#include <cstdio>
#include <hip/hip_cooperative_groups.h>
namespace cg = cooperative_groups;


__device__ __forceinline__ int otid();
#define PG8_TID() otid()
namespace pg8 {
#define PG8_LAS __attribute__((address_space(3)))
typedef unsigned short bf16_t;
typedef short bf16x8 __attribute__((ext_vector_type(8)));
typedef float f32x4 __attribute__((ext_vector_type(4)));
typedef unsigned u32x4 __attribute__((ext_vector_type(4)));
constexpr int BM = 256, BK = 64, HALF = 128, HTB = HALF * BK * 2  , STAGE_BYTES = 8 * HTB, NXCD = 8, WGM = 8;

__host__ __device__ __forceinline__ int lds_byte(int r, int c) { const int st = (r >> 4) * 2 + (c >> 5), rr = r & 15, cc = c & 31, ob = rr * 64 + cc * 2; return st * 1024 + (ob ^ (((ob >> 9) & 1) << 5)); }
__host__ __device__ __forceinline__ void stage_rc(int b, int& R, int& C) { const int st = b / 1024, sb = b % 1024, swz = sb ^ (((sb >> 9) & 1) << 5); R = (st >> 1) * 16 + swz / 64; C = (st & 1) * 32 + (swz % 64) / 2; }
__host__ __device__ __forceinline__ int perm32(int rho) { const int n = rho >> 4, i = rho & 15; return 8 * (i >> 2) + 4 * n + (i & 3); }

struct Unit { int pm, pn; };
struct Gemm { const bf16_t* A; const bf16_t* Bt; int M, N, K; };

struct StaticOrder {
    int nM, nN, nwg, G, c;
    __host__ __device__ void init(int M, int N, int G_, int c_) { nM = M / BM; nN = N / BM; nwg = nM * nN; G = G_; c = c_; }
    __host__ __device__ bool next(int i, Unit& u) const {
        const long L = (long)i * G + c; if (L >= nwg) return false;
        int wgid = (int)L; { const int q = nwg / NXCD, r = nwg % NXCD, xcd = wgid % NXCD, off = wgid / NXCD; wgid = (xcd < r ? xcd * (q + 1) : r * (q + 1) + (xcd - r) * q) + off; }
        const int nig = WGM * nN, gid = wgid / nig, fm = gid * WGM, gsz = (nM - fm) < WGM ? (nM - fm) : WGM;
        u.pm = fm + ((wgid % nig) % gsz); u.pn = (wgid % nig) / gsz; return true;
    }
    __device__ __forceinline__ void a_ready(const Unit&) const {}
    __device__ __forceinline__ void done(const Unit&) const {}
};

template <class Epi, class Sched, bool ALIGN_EPI = false, bool SP2 = false>
__device__ __forceinline__ void gemm_phase(PG8_LAS unsigned char* lds, const Gemm g, const Sched& S, const Epi& E) {
    const int tid = PG8_TID(), wid = __builtin_amdgcn_readfirstlane(tid >> 6), lane = tid & 63, wr = wid >> 2, wc = wid & 3, fr = lane & 15, fq = lane >> 4;
    const int K = g.K, nt = K / BK;
    unsigned voffA[2], voffB[2];
#pragma unroll
    for (int i = 0; i < 2; ++i) { int R, C; stage_rc(tid * 16 + i * 8192, R, C); const int Rb = Epi::PERM ? ((R & ~31) + perm32(R & 31)) : R;
        voffA[i] = (unsigned)(R * K + C) * 2u; voffB[i] = (unsigned)(Rb * K + C) * 2u; }
    const size_t kstep = (size_t)(BK * 2);
    const size_t hstep = (size_t)HALF * K * 2;
    const size_t tstep = 2 * hstep;
    const unsigned ldsw = (unsigned)wid * 1024u;
    const int aoff = lds_byte(wr * 64 + fr, fq * 8), boff = lds_byte(wc * 32 + fr, fq * 8);
#define PG8_SA(b, h) (((b) * 2 + (h)) * HTB)
#define PG8_SB(b, h) ((4 + (b) * 2 + (h)) * HTB)
#define PG8_STAGE(bufoff, gbase, voff) do { _Pragma("unroll") for (int _i = 0; _i < 2; ++_i) \
        __builtin_amdgcn_global_load_lds((const unsigned*)((const char*)(gbase) + (voff)[_i]), (PG8_LAS unsigned*)(lds + (bufoff) + ldsw + _i * 8192), 16, 0, 0); } while (0)
#define PG8_LDA(dst, b, h) do { _Pragma("unroll") for (int m = 0; m < 4; ++m) _Pragma("unroll") for (int k = 0; k < 2; ++k) dst[m][k] = *(const PG8_LAS bf16x8*)(lds + PG8_SA(b, h) + aoff + m * 2048 + k * 1024); } while (0)
#define PG8_LDB(dst, b, h) do { _Pragma("unroll") for (int n = 0; n < 2; ++n) _Pragma("unroll") for (int k = 0; k < 2; ++k) dst[n][k] = *(const PG8_LAS bf16x8*)(lds + PG8_SB(b, h) + boff + n * 2048 + k * 1024); } while (0)
#define PG8_MMA(ai, bj, At, Bt) do { __builtin_amdgcn_s_setprio(1); _Pragma("unroll") for (int m = 0; m < 4; ++m) _Pragma("unroll") for (int n = 0; n < 2; ++n) _Pragma("unroll") for (int k = 0; k < 2; ++k) \
        acc[ai][bj][m][n] = __builtin_amdgcn_mfma_f32_16x16x32_bf16(Bt[n][k], At[m][k], acc[ai][bj][m][n], 0, 0, 0); __builtin_amdgcn_s_setprio(0); } while (0)
#define PG8_WAIT_V(n) asm volatile("s_waitcnt vmcnt(" #n ")" ::: "memory")
#define PG8_WAIT_L(n) asm volatile("s_waitcnt lgkmcnt(" #n ")" ::: "memory")
#define PG8_BAR __builtin_amdgcn_s_barrier()
#define PG8_SCHED __builtin_amdgcn_sched_barrier(0)
    Unit cur, nxt; int ui = 0;
    if (!S.next(0, cur)) return;
    f32x4 acc[2][2][4][2];
#pragma unroll
    for (int a = 0; a < 2; ++a)
#pragma unroll
        for (int b = 0; b < 2; ++b)
#pragma unroll
            for (int m = 0; m < 4; ++m)
#pragma unroll
                for (int n = 0; n < 2; ++n) acc[a][b][m][n] = (f32x4){0.f, 0.f, 0.f, 0.f};
    bf16x8 At[4][2], B0[2][2], B1[2][2];
    const char* cA = (const char*)g.A + (size_t)cur.pm * tstep; const char* cB = (const char*)g.Bt + (size_t)cur.pn * tstep;
    S.a_ready(cur);
    if constexpr (SP2) {
        PG8_STAGE(PG8_SB(0, 0), cB, voffB); PG8_STAGE(PG8_SB(0, 1), cB + hstep, voffB); PG8_STAGE(PG8_SA(0, 0), cA, voffA); PG8_STAGE(PG8_SA(0, 1), cA + hstep, voffA);
        if (wr == 1) PG8_BAR;
        PG8_WAIT_V(2); PG8_BAR;
        PG8_STAGE(PG8_SB(1, 0), cB + kstep, voffB); PG8_STAGE(PG8_SA(1, 0), cA + kstep, voffA); PG8_STAGE(PG8_SB(1, 1), cB + hstep + kstep, voffB);
        PG8_WAIT_V(6); PG8_BAR;
    } else {
        PG8_STAGE(PG8_SB(0, 0), cB, voffB); PG8_STAGE(PG8_SA(0, 0), cA, voffA); PG8_STAGE(PG8_SB(0, 1), cB + hstep, voffB); PG8_STAGE(PG8_SA(0, 1), cA + hstep, voffA);
        if (wr == 1) PG8_BAR;
        PG8_WAIT_V(4); PG8_BAR;
        PG8_STAGE(PG8_SB(1, 0), cB + kstep, voffB); PG8_STAGE(PG8_SA(1, 0), cA + kstep, voffA); PG8_STAGE(PG8_SB(1, 1), cB + hstep + kstep, voffB);
        PG8_WAIT_V(6); PG8_BAR;
    }
    for (;;) {
        const bool has_next = S.next(ui + 1, nxt);
        const char* nA = has_next ? (const char*)g.A + (size_t)nxt.pm * tstep : cA; const char* nB = has_next ? (const char*)g.Bt + (size_t)nxt.pn * tstep : cB;
        for (int t = 0; t < nt; t += 2) {
            const bool last = (t == nt - 2);
            const char* a1 = cA + (size_t)(t + 1) * kstep;
            const char* a2 = last ? nA : cA + (size_t)(t + 2) * kstep; const char* b2 = last ? nB : cB + (size_t)(t + 2) * kstep;
            const char* a3 = a2 + kstep; const char* b3 = b2 + kstep;
            if (last && has_next) S.a_ready(nxt);
            if constexpr (SP2) {
            PG8_LDB(B0, 0, 0); PG8_LDB(B1, 0, 1); PG8_SCHED; PG8_LDA(At, 0, 0); PG8_STAGE(PG8_SA(1, 1), a1 + hstep, voffA);
            PG8_WAIT_V(8); PG8_WAIT_L(0); PG8_BAR; PG8_MMA(0, 0, At, B0); PG8_MMA(0, 1, At, B1); PG8_BAR; PG8_SCHED;
            PG8_LDA(At, 0, 1); PG8_STAGE(PG8_SB(0, 0), b2, voffB); PG8_STAGE(PG8_SB(0, 1), b2 + hstep, voffB); PG8_STAGE(PG8_SA(0, 0), a2, voffA);
            PG8_WAIT_V(8); PG8_WAIT_L(0); PG8_BAR; PG8_MMA(1, 0, At, B0); PG8_MMA(1, 1, At, B1); PG8_BAR; PG8_SCHED;
            PG8_LDB(B0, 1, 0); PG8_LDB(B1, 1, 1); PG8_SCHED; PG8_LDA(At, 1, 0); PG8_STAGE(PG8_SA(0, 1), a2 + hstep, voffA);
            PG8_WAIT_V(8); PG8_WAIT_L(0); PG8_BAR; PG8_MMA(0, 0, At, B0); PG8_MMA(0, 1, At, B1); PG8_BAR; PG8_SCHED;
            PG8_LDA(At, 1, 1); PG8_STAGE(PG8_SB(1, 0), b3, voffB); PG8_STAGE(PG8_SB(1, 1), b3 + hstep, voffB); PG8_STAGE(PG8_SA(1, 0), a3, voffA);
            PG8_WAIT_V(8); PG8_WAIT_L(0); PG8_BAR; PG8_MMA(1, 0, At, B0); PG8_MMA(1, 1, At, B1); PG8_BAR; PG8_SCHED;
            } else {
            PG8_LDB(B0, 0, 0); PG8_SCHED; PG8_LDA(At, 0, 0); PG8_STAGE(PG8_SA(1, 1), a1 + hstep, voffA);
            PG8_WAIT_L(8); PG8_BAR; PG8_WAIT_L(0); PG8_MMA(0, 0, At, B0); PG8_BAR; PG8_SCHED;
            PG8_LDB(B1, 0, 1); PG8_STAGE(PG8_SB(0, 0), b2, voffB);
            PG8_BAR; PG8_WAIT_L(0); PG8_MMA(0, 1, At, B1); PG8_BAR;
            PG8_LDA(At, 0, 1); PG8_STAGE(PG8_SA(0, 0), a2, voffA);
            PG8_BAR; PG8_WAIT_L(0); PG8_MMA(1, 0, At, B0); PG8_BAR; PG8_SCHED;
            PG8_STAGE(PG8_SB(0, 1), b2 + hstep, voffB);
            PG8_WAIT_V(6); PG8_BAR; PG8_MMA(1, 1, At, B1); PG8_BAR;
            PG8_LDB(B0, 1, 0); PG8_SCHED; PG8_LDA(At, 1, 0); PG8_STAGE(PG8_SA(0, 1), a2 + hstep, voffA);
            PG8_WAIT_L(8); PG8_BAR; PG8_WAIT_L(0); PG8_MMA(0, 0, At, B0); PG8_BAR; PG8_SCHED;
            PG8_LDB(B1, 1, 1); PG8_STAGE(PG8_SB(1, 0), b3, voffB);
            PG8_BAR; PG8_WAIT_L(0); PG8_MMA(0, 1, At, B1); PG8_BAR;
            PG8_LDA(At, 1, 1); PG8_STAGE(PG8_SA(1, 0), a3, voffA);
            PG8_BAR; PG8_WAIT_L(0); PG8_MMA(1, 0, At, B0); PG8_BAR; PG8_SCHED;
            PG8_STAGE(PG8_SB(1, 1), b3 + hstep, voffB);
            PG8_WAIT_V(6); PG8_BAR; PG8_MMA(1, 1, At, B1); PG8_BAR;
            }
        }
        if constexpr (ALIGN_EPI) { if (wr == 0) PG8_BAR; }
        if constexpr (!Epi::AFTER_DRAIN) { E(acc, cur, wr, wc, fr, fq); S.done(cur); }
        if (!has_next) break;
#pragma unroll
        for (int a = 0; a < 2; ++a)
#pragma unroll
            for (int b = 0; b < 2; ++b)
#pragma unroll
                for (int m = 0; m < 4; ++m)
#pragma unroll
                    for (int n = 0; n < 2; ++n) acc[a][b][m][n] = (f32x4){0.f, 0.f, 0.f, 0.f};
        cur = nxt; cA = nA; cB = nB; ++ui;
        if constexpr (ALIGN_EPI) { if (wr == 1) PG8_BAR; }
    }
    PG8_WAIT_V(0);
    if constexpr (!ALIGN_EPI) { if (wr == 0) PG8_BAR; }
    PG8_BAR;
    if constexpr (Epi::AFTER_DRAIN) { E.fused(acc, cur, wr, wc, fr, fq, lds, wid, lane); S.done(cur); }
#undef PG8_SA
#undef PG8_SB
#undef PG8_STAGE
#undef PG8_LDA
#undef PG8_LDB
#undef PG8_MMA
#undef PG8_WAIT_V
#undef PG8_WAIT_L
#undef PG8_BAR
#undef PG8_SCHED
}
}

#define WTAB_OFF 155392
extern __shared__ __attribute__((aligned(16))) unsigned char lds_raw[];
__device__ __forceinline__ int hw_slot() { return (int)(__builtin_amdgcn_s_getreg((5 << 11) | 4) & 63u); }
__device__ __forceinline__ void otid_init() { const int t = threadIdx.x; if ((t & 63) == 0) ((__attribute__((address_space(3))) int*)(__attribute__((address_space(3))) void*)(lds_raw + WTAB_OFF))[hw_slot()] = t >> 6; }
__device__ __forceinline__ int otid() {
    const int w = __builtin_amdgcn_readfirstlane(((const __attribute__((address_space(3))) int*)(__attribute__((address_space(3))) void*)(lds_raw + WTAB_OFF))[hw_slot()]);
    int l; asm volatile("v_mbcnt_lo_u32_b32 %0, -1, 0\n\tv_mbcnt_hi_u32_b32 %0, -1, %0" : "=v"(l));
    return (w << 6) + l;
}
using pg8::bf16_t; using pg8::bf16x8; using pg8::f32x4; using pg8::u32x4;
#define LAS __attribute__((address_space(3)))

#define DMODEL 1024
#define NPT 16384
#define NST 32
#define NTOK 16416
#define MPAD 16640
#define SEQ 2048
#define ZW 2816
#define OFF_A 1536
#define OFF_B 1544
#define OFF_Z 1552
#define OFF_QA 2064
#define OFF_KVA 2448
#define OFF_KR 2704
#define DFF 2816
#define PAST 16384
#define NPAGES 128
#define EPSV 1e-6f

#define O_YP 0
#define O_YS (O_YP + 16777216)
#define O_CKVP (O_YS + 32768)
#define O_KRP (O_CKVP + 4194304)
#define O_GSP (O_KRP + 524288)
#define O_CSP (O_GSP + 262144)
#define O_CKVS (O_CSP + 36864)
#define O_KRS (O_CKVS + 8192)
#define O_GSS (O_KRS + 1024)
#define O_CSS (O_GSS + 1048576)

__device__ __forceinline__ bf16_t f2bf(float f) { unsigned u = __float_as_uint(f); return (bf16_t)((u + 0x7fffu + ((u >> 16) & 1u)) >> 16); }
__device__ __forceinline__ float bf2f(bf16_t b) { return __uint_as_float(((unsigned)b) << 16); }
template <int CTRL> __device__ __forceinline__ float dpp_mov(float x) { return __uint_as_float((unsigned)__builtin_amdgcn_update_dpp((int)__float_as_uint(x), (int)__float_as_uint(x), CTRL, 0xF, 0xF, true)); }
__device__ __forceinline__ float add_x16(float x) { auto r = __builtin_amdgcn_permlane16_swap(__float_as_uint(x), __float_as_uint(x), false, false); return __uint_as_float(r[0]) + __uint_as_float(r[1]); }
__device__ __forceinline__ float add_x32(float x) { auto r = __builtin_amdgcn_permlane32_swap(__float_as_uint(x), __float_as_uint(x), false, false); return __uint_as_float(r[0]) + __uint_as_float(r[1]); }
__device__ __forceinline__ float max_x32(float x) { auto r = __builtin_amdgcn_permlane32_swap(__float_as_uint(x), __float_as_uint(x), false, false); return fmaxf(__uint_as_float(r[0]), __uint_as_float(r[1])); }
__device__ __forceinline__ float sum8(float x) { x += dpp_mov<0xB1>(x); x += dpp_mov<0x4E>(x); x += dpp_mov<0x141>(x); return x; }
__device__ __forceinline__ float sum16(float x) { x = sum8(x); x += dpp_mov<0x140>(x); return x; }
__device__ __forceinline__ float max16(float x) { x = fmaxf(x, dpp_mov<0xB1>(x)); x = fmaxf(x, dpp_mov<0x4E>(x)); x = fmaxf(x, dpp_mov<0x141>(x)); x = fmaxf(x, dpp_mov<0x140>(x)); return x; }
__device__ __forceinline__ float wave_sum(float v) { return add_x32(add_x16(sum16(v))); }
__device__ __forceinline__ float sigmoidf_(float x) { return __builtin_amdgcn_rcpf(1.f + __builtin_amdgcn_exp2f(-1.44269504f * x)); }
__device__ __forceinline__ float siluf_(float x) { return x * __builtin_amdgcn_rcpf(1.f + __builtin_amdgcn_exp2f(-1.44269504f * x)); }


#define WSYNC() do { __builtin_amdgcn_fence(__ATOMIC_ACQ_REL, "wavefront"); __builtin_amdgcn_wave_barrier(); } while (0)
#define NTHR 512
#define NWAVE 8

typedef float f32x2_t __attribute__((ext_vector_type(2)));
typedef __bf16 bf16x2_t __attribute__((ext_vector_type(2)));
__device__ __forceinline__ unsigned cvtpk(float lo, float hi) { f32x2_t v = {lo, hi}; bf16x2_t r = __builtin_convertvector(v, bf16x2_t); return __builtin_bit_cast(unsigned, r); }
__device__ __forceinline__ void bf8_to_f32(const bf16x8& v, float* o) {
#pragma unroll
    for (int e = 0; e < 8; ++e) o[e] = __uint_as_float(((unsigned)(unsigned short)v[e]) << 16);
}
__device__ __forceinline__ bf16x8 f32_to_bf8(const float* x) {
    u32x4 w; w.x = cvtpk(x[0], x[1]); w.y = cvtpk(x[2], x[3]); w.z = cvtpk(x[4], x[5]); w.w = cvtpk(x[6], x[7]);
    return __builtin_bit_cast(bf16x8, w);
}
__device__ __forceinline__ unsigned pk2bf(float lo, float hi) { return (unsigned)f2bf(lo) | ((unsigned)f2bf(hi) << 16); }

__device__ __forceinline__ void wt_item(const float* __restrict__ W, int ldw, int col0, int nvalid, bf16_t* __restrict__ WT, int ldt, int nrow0, int k0, float* scr, int lane) {
    WSYNC();
#pragma unroll 8
    for (int i = 0; i < 32; ++i) { const int kk = 2 * i + (lane >> 5), n = lane & 31; scr[kk * 33 + n] = n < nvalid ? W[(size_t)(k0 + kk) * ldw + col0 + n] : 0.f; }
    WSYNC();
    const int c = lane & 7;
#pragma unroll
    for (int j = 0; j < 4; ++j) { const int n = (lane >> 3) + 8 * j; const float* sp = scr + (8 * c) * 33 + n;
        u32x4 o; o.x = cvtpk(sp[0], sp[33]); o.y = cvtpk(sp[2 * 33], sp[3 * 33]); o.z = cvtpk(sp[4 * 33], sp[5 * 33]); o.w = cvtpk(sp[6 * 33], sp[7 * 33]);
        *(u32x4*)(WT + (size_t)(nrow0 + n) * ldt + k0 + 8 * c) = o; }
}

__device__ __forceinline__ void rms1024_row(const float* __restrict__ src, const float* __restrict__ g, bf16_t* __restrict__ o, bool zero, int lane) {
    if (zero) { for (int j = 0; j < 4; ++j) { ushort4 z = {0, 0, 0, 0}; *(ushort4*)(o + lane * 4 + 256 * j) = z; } return; }
    float4 v[4]; float ss = 0.f;
#pragma unroll
    for (int j = 0; j < 4; ++j) { v[j] = *(const float4*)(src + lane * 4 + 256 * j); ss += v[j].x * v[j].x + v[j].y * v[j].y + v[j].z * v[j].z + v[j].w * v[j].w; }
    ss = wave_sum(ss);
    const float rs = rsqrtf(ss * (1.f / 1024.f) + EPSV);
#pragma unroll
    for (int j = 0; j < 4; ++j) {
        const float4 gg = *(const float4*)(g + lane * 4 + 256 * j);
        ushort4 w; w.x = f2bf(v[j].x * rs * gg.x); w.y = f2bf(v[j].y * rs * gg.y); w.z = f2bf(v[j].z * rs * gg.z); w.w = f2bf(v[j].w * rs * gg.w);
        *(ushort4*)(o + lane * 4 + 256 * j) = w;
    }
}

__device__ __forceinline__ void rms1024_row_b(const bf16_t* __restrict__ src, const float* __restrict__ g, bf16_t* __restrict__ o, bool zero, int lane) {
    if (zero) { for (int j = 0; j < 2; ++j) { const u32x4 z = {0u, 0u, 0u, 0u}; *(u32x4*)(o + lane * 8 + 512 * j) = z; } return; }
    float v[2][8]; float ss = 0.f;
#pragma unroll
    for (int j = 0; j < 2; ++j) { bf8_to_f32(*(const bf16x8*)(src + lane * 8 + 512 * j), v[j]);
#pragma unroll
        for (int e = 0; e < 8; ++e) ss += v[j][e] * v[j][e]; }
    ss = wave_sum(ss);
    const float rs = rsqrtf(ss * (1.f / 1024.f) + EPSV);
#pragma unroll
    for (int j = 0; j < 2; ++j) {
        const float4 g0 = *(const float4*)(g + lane * 8 + 512 * j), g1 = *(const float4*)(g + lane * 8 + 512 * j + 4);
        float t[8] = {v[j][0] * rs * g0.x, v[j][1] * rs * g0.y, v[j][2] * rs * g0.z, v[j][3] * rs * g0.w, v[j][4] * rs * g1.x, v[j][5] * rs * g1.y, v[j][6] * rs * g1.z, v[j][7] * rs * g1.w};
        *(bf16x8*)(o + lane * 8 + 512 * j) = f32_to_bf8(t);
    }
}

struct ABf16 { const bf16_t* p; int lda; __device__ __forceinline__ bf16x8 load(int m, int k) const { return *(const bf16x8*)(p + (size_t)m * lda + k); } };
template <bool SWIGLU, class Epi>
__device__ __forceinline__ void gemm_sample_rows(const bf16_t* __restrict__ A, int lda, const bf16_t* __restrict__ Bt, int K, int N, const Epi& epi, char*  , int bid, int nb, int first = -1) {
    const int tid = otid(), lane = tid & 63, wid = tid >> 6, i16 = lane & 15, q4 = lane >> 4;
    for (int u = first >= 0 ? (bid - first + nb) % nb : nb - 1 - bid; u < N / 256; u += nb) {
        const int n0 = u * 256;
        const int c0 = SWIGLU ? n0 + 16 * wid : n0 + 32 * wid, c1 = SWIGLU ? n0 + 128 + 16 * wid : n0 + 32 * wid + 16;
        const bf16_t* a0p = A + (size_t)(NPT + i16) * lda + 8 * q4; const bf16_t* a1p = a0p + (size_t)16 * lda;
        const bf16_t* b0p = Bt + (size_t)(c0 + i16) * K + 8 * q4; const bf16_t* b1p = Bt + (size_t)(c1 + i16) * K + 8 * q4;
        f32x4 acc[2][2];
#pragma unroll
        for (int i = 0; i < 2; ++i)
#pragma unroll
            for (int j = 0; j < 2; ++j) acc[i][j] = (f32x4){0.f, 0.f, 0.f, 0.f};
#pragma unroll 4
        for (int k0 = 0; k0 < K; k0 += 32) {
            const bf16x8 a0 = *(const bf16x8*)(a0p + k0), a1 = *(const bf16x8*)(a1p + k0), b0 = *(const bf16x8*)(b0p + k0), b1 = *(const bf16x8*)(b1p + k0);
            acc[0][0] = __builtin_amdgcn_mfma_f32_16x16x32_bf16(a0, b0, acc[0][0], 0, 0, 0); acc[0][1] = __builtin_amdgcn_mfma_f32_16x16x32_bf16(a0, b1, acc[0][1], 0, 0, 0);
            acc[1][0] = __builtin_amdgcn_mfma_f32_16x16x32_bf16(a1, b0, acc[1][0], 0, 0, 0); acc[1][1] = __builtin_amdgcn_mfma_f32_16x16x32_bf16(a1, b1, acc[1][1], 0, 0, 0);
        }
#pragma unroll
        for (int i = 0; i < 2; ++i)
#pragma unroll
            for (int r = 0; r < 4; ++r) {
                const int m = NPT + 16 * i + 4 * q4 + r;
                if constexpr (SWIGLU) epi(m, (n0 >> 1) + 16 * wid + i16, siluf_(acc[i][0][r]) * acc[i][1][r]);
                else { epi(m, c0 + i16, acc[i][0][r]); epi(m, c1 + i16, acc[i][1][r]); }
            }
    }
}
template <bool SWIGLU, class Epi, int NJ = 4>
__device__ __forceinline__ void gemm_sample_rows_ks(const bf16_t* __restrict__ A, int lda, const bf16_t* __restrict__ Bt, int K, int N, const Epi& epi, char* smem, int bid, int nb) {
    const int tid = otid(), lane = tid & 63, wid = tid >> 6, i16 = lane & 15, q4 = lane >> 4;
    static_assert(!SWIGLU || NJ == 4, "swiglu units are 64 rows wide");
    const int nunits = N / (16 * NJ), ksl = K >> 3;
    f32x4* red = (f32x4*)smem;
    for (int u = nb - 1 - bid; u < nunits; u += nb) {
        int brow[NJ];
#pragma unroll
        for (int j = 0; j < NJ; ++j) brow[j] = SWIGLU ? ((32 * u) >> 7) * 256 + ((32 * u) & 127) + 128 * (j >> 1) + 16 * (j & 1) + i16 : 16 * NJ * u + 16 * j + i16;
        const bf16_t* a0p = A + (size_t)(NPT + i16) * lda + wid * ksl + 8 * q4; const bf16_t* a1p = a0p + (size_t)16 * lda;
        f32x4 acc[2][NJ];
#pragma unroll
        for (int i = 0; i < 2; ++i)
#pragma unroll
            for (int j = 0; j < NJ; ++j) acc[i][j] = (f32x4){0.f, 0.f, 0.f, 0.f};
        for (int k0 = 0; k0 < ksl; k0 += 32) {
            const bf16x8 a0 = *(const bf16x8*)(a0p + k0), a1 = *(const bf16x8*)(a1p + k0);
            bf16x8 b[NJ];
#pragma unroll
            for (int j = 0; j < NJ; ++j) b[j] = *(const bf16x8*)(Bt + (size_t)brow[j] * K + wid * ksl + 8 * q4 + k0);
#pragma unroll
            for (int j = 0; j < NJ; ++j) { acc[0][j] = __builtin_amdgcn_mfma_f32_16x16x32_bf16(a0, b[j], acc[0][j], 0, 0, 0); acc[1][j] = __builtin_amdgcn_mfma_f32_16x16x32_bf16(a1, b[j], acc[1][j], 0, 0, 0); }
        }
        __syncthreads();
#pragma unroll
        for (int i = 0; i < 2; ++i)
#pragma unroll
            for (int j = 0; j < NJ; ++j) red[(wid * 2 * NJ + i * NJ + j) * 64 + lane] = acc[i][j];
        __syncthreads();
        if constexpr (SWIGLU) {
            if (tid < 256) {
                const int t4 = tid >> 6, i = t4 >> 1, jg = t4 & 1, l = tid & 63;
                f32x4 g = red[(i * 4 + jg) * 64 + l], up = red[(i * 4 + jg + 2) * 64 + l];
#pragma unroll
                for (int w = 1; w < 8; ++w) { g = g + red[(w * 8 + i * 4 + jg) * 64 + l]; up = up + red[(w * 8 + i * 4 + jg + 2) * 64 + l]; }
#pragma unroll
                for (int r = 0; r < 4; ++r) epi(NPT + 16 * i + 4 * (l >> 4) + r, 32 * u + 16 * jg + (l & 15), siluf_(g[r]) * up[r]);
            }
        } else {
            const int t8 = tid >> 6, l = tid & 63, i = t8 / NJ, j = t8 % NJ;
            if (t8 < 2 * NJ) {
                f32x4 v = red[t8 * 64 + l];
#pragma unroll
                for (int w = 1; w < 8; ++w) v = v + red[(w * 2 * NJ + t8) * 64 + l];
#pragma unroll
                for (int r = 0; r < 4; ++r) epi(NPT + 16 * i + 4 * (l >> 4) + r, 16 * NJ * u + 16 * j + (l & 15), v[r]);
            }
        }
    }
    __syncthreads();
}
struct EwF32 { float* C; int ldc; __device__ __forceinline__ void operator()(int m, int n, float v) const { C[(size_t)m * ldc + n] = v; } };
struct EwBf16 { bf16_t* C; int ldc; __device__ __forceinline__ void operator()(int m, int n, float v) const { C[(size_t)m * ldc + n] = f2bf(v); } };
struct EwResX { const float* xs; bf16_t* C; __device__ __forceinline__ void operator()(int m, int n, float v) const { C[(size_t)m * 1024 + n] = f2bf(xs[(size_t)(m - NPT) * 1024 + n] + v); } };
struct EwResH { const bf16_t* H; bf16_t* C; __device__ __forceinline__ void operator()(int m, int n, float v) const { C[(size_t)m * 1024 + n] = f2bf(bf2f(H[(size_t)m * 1024 + n]) + v); } };
struct EwPle { const bf16_t* H2; const bf16_t* PP; float* out;
    __device__ __forceinline__ void operator()(int m, int n, float v) const { out[O_YS + (size_t)(m - NPT) * 1024 + n] = bf2f(H2[(size_t)m * 1024 + n]) + bf2f(PP[(size_t)m * 1024 + n]) * sigmoidf_(v); } };

struct PgBf16 {
    static constexpr bool PERM = true, AFTER_DRAIN = false; bf16_t* O; int ldc;
    __device__ __forceinline__ void operator()(const f32x4 (&acc)[2][2][4][2], const pg8::Unit& u, int wr, int wc, int fr, int fq) const {
#pragma unroll
        for (int ai = 0; ai < 2; ++ai)
#pragma unroll
            for (int m = 0; m < 4; ++m) { bf16_t* rowp = O + (size_t)(u.pm * 256 + ai * 128 + wr * 64 + m * 16 + fr) * ldc + u.pn * 256 + wc * 32 + 8 * fq;
#pragma unroll
                for (int bj = 0; bj < 2; ++bj) { const f32x4 v0 = acc[ai][bj][m][0], v1 = acc[ai][bj][m][1]; u32x4 w; w.x = pk2bf(v0[0], v0[1]); w.y = pk2bf(v0[2], v0[3]); w.z = pk2bf(v1[0], v1[1]); w.w = pk2bf(v1[2], v1[3]); *(u32x4*)(rowp + bj * 128) = w; } }
    }
};
struct PgF32 {
    static constexpr bool PERM = false, AFTER_DRAIN = false; float* O; int ldc;
    __device__ __forceinline__ void operator()(const f32x4 (&acc)[2][2][4][2], const pg8::Unit& u, int wr, int wc, int fr, int fq) const {
#pragma unroll
        for (int ai = 0; ai < 2; ++ai)
#pragma unroll
            for (int m = 0; m < 4; ++m) { float* rowp = O + (size_t)(u.pm * 256 + ai * 128 + wr * 64 + m * 16 + fr) * ldc + u.pn * 256 + wc * 32 + 4 * fq;
#pragma unroll
                for (int bj = 0; bj < 2; ++bj)
#pragma unroll
                    for (int n = 0; n < 2; ++n) *(f32x4*)(rowp + bj * 128 + n * 16) = acc[ai][bj][m][n]; }
    }
};
struct PgSwiglu {
    static constexpr bool PERM = true, AFTER_DRAIN = false; bf16_t* Hd;
    __device__ __forceinline__ void operator()(const f32x4 (&acc)[2][2][4][2], const pg8::Unit& u, int wr, int wc, int fr, int fq) const {
#pragma unroll
        for (int ai = 0; ai < 2; ++ai)
#pragma unroll
            for (int m = 0; m < 4; ++m) { bf16_t* rowp = Hd + (size_t)(u.pm * 256 + ai * 128 + wr * 64 + m * 16 + fr) * DFF + u.pn * 128 + wc * 32 + 8 * fq;
                float h[8];
#pragma unroll
                for (int n = 0; n < 2; ++n)
#pragma unroll
                    for (int i = 0; i < 4; ++i) h[n * 4 + i] = siluf_(acc[ai][0][m][n][i]) * acc[ai][1][m][n][i];
                u32x4 w; w.x = pk2bf(h[0], h[1]); w.y = pk2bf(h[2], h[3]); w.z = pk2bf(h[4], h[5]); w.w = pk2bf(h[6], h[7]); *(u32x4*)rowp = w; }
    }
};
struct PgResXB {
    static constexpr bool PERM = true, AFTER_DRAIN = false; const float* R; bf16_t* O;
    __device__ __forceinline__ void operator()(const f32x4 (&acc)[2][2][4][2], const pg8::Unit& u, int wr, int wc, int fr, int fq) const {
#pragma unroll
        for (int ai = 0; ai < 2; ++ai)
#pragma unroll
            for (int m = 0; m < 4; ++m) { const size_t off = (size_t)(u.pm * 256 + ai * 128 + wr * 64 + m * 16 + fr) * 1024 + u.pn * 256 + wc * 32 + 8 * fq;
#pragma unroll
                for (int bj = 0; bj < 2; ++bj) { const f32x4 r0 = *(const f32x4*)(R + off + bj * 128), r1 = *(const f32x4*)(R + off + bj * 128 + 4), v0 = r0 + acc[ai][bj][m][0], v1 = r1 + acc[ai][bj][m][1];
                    u32x4 w; w.x = cvtpk(v0[0], v0[1]); w.y = cvtpk(v0[2], v0[3]); w.z = cvtpk(v1[0], v1[1]); w.w = cvtpk(v1[2], v1[3]); *(u32x4*)(O + off + bj * 128) = w; } }
    }
};
struct PgResBB {
    static constexpr bool PERM = true, AFTER_DRAIN = false; const bf16_t* R; bf16_t* O;
    __device__ __forceinline__ void operator()(const f32x4 (&acc)[2][2][4][2], const pg8::Unit& u, int wr, int wc, int fr, int fq) const {
#pragma unroll
        for (int ai = 0; ai < 2; ++ai)
#pragma unroll
            for (int m = 0; m < 4; ++m) { const size_t off = (size_t)(u.pm * 256 + ai * 128 + wr * 64 + m * 16 + fr) * 1024 + u.pn * 256 + wc * 32 + 8 * fq;
#pragma unroll
                for (int bj = 0; bj < 2; ++bj) { float r[8]; bf8_to_f32(*(const bf16x8*)(R + off + bj * 128), r); const f32x4 a0 = acc[ai][bj][m][0], a1 = acc[ai][bj][m][1];
                    u32x4 w; w.x = cvtpk(r[0] + a0[0], r[1] + a0[1]); w.y = cvtpk(r[2] + a0[2], r[3] + a0[3]); w.z = cvtpk(r[4] + a1[0], r[5] + a1[1]); w.w = cvtpk(r[6] + a1[2], r[7] + a1[3]); *(u32x4*)(O + off + bj * 128) = w; } }
    }
};
struct PgPleB {
    static constexpr bool PERM = true, AFTER_DRAIN = false; const bf16_t* H2; const bf16_t* PP; float* out;
    __device__ __forceinline__ void operator()(const f32x4 (&acc)[2][2][4][2], const pg8::Unit& u, int wr, int wc, int fr, int fq) const {
#pragma unroll
        for (int ai = 0; ai < 2; ++ai)
#pragma unroll
            for (int m = 0; m < 4; ++m) { const size_t off = (size_t)(u.pm * 256 + ai * 128 + wr * 64 + m * 16 + fr) * 1024 + u.pn * 256 + wc * 32 + 8 * fq;
#pragma unroll
                for (int bj = 0; bj < 2; ++bj) { float h[8], pp[8]; bf8_to_f32(*(const bf16x8*)(H2 + off + bj * 128), h); bf8_to_f32(*(const bf16x8*)(PP + off + bj * 128), pp);
                    const f32x4 a0 = acc[ai][bj][m][0], a1 = acc[ai][bj][m][1]; f32x4 y0, y1;
#pragma unroll
                    for (int i = 0; i < 4; ++i) { y0[i] = h[i] + pp[i] * sigmoidf_(a0[i]); y1[i] = h[4 + i] + pp[4 + i] * sigmoidf_(a1[i]); }
                    *(f32x4*)(out + O_YP + off + bj * 128) = y0; *(f32x4*)(out + O_YP + off + bj * 128 + 4) = y1; } }
    }
};
template <class Epi>
__device__ __forceinline__ void pg_gemm(LAS unsigned char* lds, const bf16_t* A, const bf16_t* Bt, int M, int N, int K, const Epi& E, int glow = 0) {
    pg8::Gemm g{A, Bt, M, N, K}; pg8::StaticOrder S;
    if (glow > 0) { if ((int)blockIdx.x >= glow) return; S.init(M, N, glow, (int)blockIdx.x); }
    else S.init(M, N, (int)gridDim.x, (int)blockIdx.x);
    pg8::gemm_phase<Epi, pg8::StaticOrder, true, true>(lds, g, S, E);
}

constexpr size_t WOF_WinT = 0ull;
constexpr size_t WOF_WqbT = 5767168ull;
constexpr size_t WOF_WkvT = 6356992ull;
constexpr size_t WOF_WknT = 6881280ull;
constexpr size_t WOF_WoT = 7143424ull;
constexpr size_t WOF_WguT = 9240576ull;
constexpr size_t WOF_WdT = 20774912ull;
constexpr size_t WOF_WpgT = 26542080ull;
constexpr size_t WOF_WppT = 28639232ull;
constexpr size_t WOF_xn = 29163520ull;
constexpr size_t WOF_pb = 63242240ull;
constexpr size_t WOF_Z = 71761920ull;
constexpr size_t WOF_qkv = 165478400ull;
constexpr size_t WOF_ropecs = 216596480ull;
constexpr size_t WOF_gg = 216858880ull;
constexpr size_t WOF_bb = 217391360ull;
constexpr size_t WOF_goraw = 217923840ull;
constexpr size_t WOF_gUT = 252002560ull;
constexpr size_t WOF_ggam = 285556992ull;
constexpr size_t WOF_gWn = 285565184ull;
constexpr size_t WOF_gQg = 302342400ull;
constexpr size_t WOF_gQK = 319119616ull;
constexpr size_t WOF_gKd = 335896832ull;
constexpr size_t WOF_qan = 352674048ull;
constexpr size_t WOF_ckvb = 365453568ull;
constexpr size_t WOF_krf = 373973248ull;
constexpr size_t WOF_Q = 376103168ull;
constexpr size_t WOF_qh = 427221248ull;
constexpr size_t WOF_KV = 478339328ull;
constexpr size_t WOF_kh = 546496768ull;
constexpr size_t WOF_omix = 580575488ull;
constexpr size_t WOF_KN = 614654208ull;
constexpr size_t WOF_SC = 1151525120ull;
constexpr size_t WOF_part = 1168302336ull;
constexpr size_t WOF_H = 1170432256ull;
constexpr size_t WOF_un = 1238589696ull;
constexpr size_t WOF_G = 1272668416ull;
constexpr size_t WOF_hid = 1273028864ull;
constexpr size_t WOF_H2 = 1366745344ull;
constexpr size_t WOF_un2 = 1434902784ull;
constexpr size_t WOF_PP = 1468981504ull;
constexpr size_t WOF_qraw = 1537138944ull;
constexpr size_t WOF_kvraw = 1562304768ull;
constexpr size_t WOF_krb = 1595859200ull;
constexpr size_t WOF_ctl = 1596907776ull;
constexpr size_t WS_TOTAL = 1596924160ull;
struct MK {
    const float *x_prompt, *x_sample, *cache_ckv, *cache_krope, *state_gdn, *state_conv; const int* page_table; const float *p_prompt, *p_sample;
    const float *g_attn, *w_in, *w_conv, *a_log, *dt_bias, *g_gdn_out, *g_q_a, *w_q_b, *g_q_nope, *g_q_rope, *g_kv_a, *g_k_rope, *w_kv_b, *g_k_nope, *w_o, *g_ffn, *w_gate, *w_up, *w_down, *g_ple, *w_ple_gate, *w_ple_proj;
    float* out; char* ws;
    __device__ __forceinline__ unsigned* ctl() const { return (unsigned*)(ws + WOF_ctl); }
    __device__ __forceinline__ bf16_t* WinT() const { return (bf16_t*)(ws + WOF_WinT); }
    __device__ __forceinline__ bf16_t* WqbT() const { return (bf16_t*)(ws + WOF_WqbT); }
    __device__ __forceinline__ bf16_t* WkvT() const { return (bf16_t*)(ws + WOF_WkvT); }
    __device__ __forceinline__ bf16_t* WknT() const { return (bf16_t*)(ws + WOF_WknT); }
    __device__ __forceinline__ bf16_t* WoT() const { return (bf16_t*)(ws + WOF_WoT); }
    __device__ __forceinline__ bf16_t* WguT() const { return (bf16_t*)(ws + WOF_WguT); }
    __device__ __forceinline__ bf16_t* WdT() const { return (bf16_t*)(ws + WOF_WdT); }
    __device__ __forceinline__ bf16_t* WpgT() const { return (bf16_t*)(ws + WOF_WpgT); }
    __device__ __forceinline__ bf16_t* WppT() const { return (bf16_t*)(ws + WOF_WppT); }
    __device__ __forceinline__ bf16_t* xn() const { return (bf16_t*)(ws + WOF_xn); }
    __device__ __forceinline__ bf16_t* pb() const { return (bf16_t*)(ws + WOF_pb); }
    __device__ __forceinline__ bf16_t* Z() const { return (bf16_t*)(ws + WOF_Z); }
    __device__ __forceinline__ bf16_t* qkv() const { return (bf16_t*)(ws + WOF_qkv); }
    __device__ __forceinline__ float* ropecs() const { return (float*)(ws + WOF_ropecs); }
    __device__ __forceinline__ float* gg() const { return (float*)(ws + WOF_gg); }
    __device__ __forceinline__ float* bb() const { return (float*)(ws + WOF_bb); }
    __device__ __forceinline__ float* goraw() const { return (float*)(ws + WOF_goraw); }
    __device__ __forceinline__ float* gUT() const { return (float*)(ws + WOF_gUT); }
    __device__ __forceinline__ float* ggam() const { return (float*)(ws + WOF_ggam); }
    __device__ __forceinline__ bf16_t* gWn() const { return (bf16_t*)(ws + WOF_gWn); }
    __device__ __forceinline__ bf16_t* gQg() const { return (bf16_t*)(ws + WOF_gQg); }
    __device__ __forceinline__ bf16_t* gQK() const { return (bf16_t*)(ws + WOF_gQK); }
    __device__ __forceinline__ bf16_t* gKd() const { return (bf16_t*)(ws + WOF_gKd); }
    __device__ __forceinline__ bf16_t* qan() const { return (bf16_t*)(ws + WOF_qan); }
    __device__ __forceinline__ bf16_t* ckvb() const { return (bf16_t*)(ws + WOF_ckvb); }
    __device__ __forceinline__ float* krf() const { return (float*)(ws + WOF_krf); }
    __device__ __forceinline__ float* Q() const { return (float*)(ws + WOF_Q); }
    __device__ __forceinline__ float* qh() const { return (float*)(ws + WOF_qh); }
    __device__ __forceinline__ float* KV() const { return (float*)(ws + WOF_KV); }
    __device__ __forceinline__ float* kh() const { return (float*)(ws + WOF_kh); }
    __device__ __forceinline__ bf16_t* omix() const { return (bf16_t*)(ws + WOF_omix); }
    __device__ __forceinline__ bf16_t* KN() const { return (bf16_t*)(ws + WOF_KN); }
    __device__ __forceinline__ float* SC() const { return (float*)(ws + WOF_SC); }
    __device__ __forceinline__ float* part() const { return (float*)(ws + WOF_part); }
    __device__ __forceinline__ bf16_t* H() const { return (bf16_t*)(ws + WOF_H); }
    __device__ __forceinline__ bf16_t* un() const { return (bf16_t*)(ws + WOF_un); }
    __device__ __forceinline__ float* G() const { return (float*)(ws + WOF_G); }
    __device__ __forceinline__ bf16_t* hid() const { return (bf16_t*)(ws + WOF_hid); }
    __device__ __forceinline__ bf16_t* H2() const { return (bf16_t*)(ws + WOF_H2); }
    __device__ __forceinline__ bf16_t* un2() const { return (bf16_t*)(ws + WOF_un2); }
    __device__ __forceinline__ bf16_t* PP() const { return (bf16_t*)(ws + WOF_PP); }
    __device__ __forceinline__ bf16_t* qraw() const { return (bf16_t*)(ws + WOF_qraw); }
    __device__ __forceinline__ bf16_t* kvraw() const { return (bf16_t*)(ws + WOF_kvraw); }
    __device__ __forceinline__ bf16_t* krb() const { return (bf16_t*)(ws + WOF_krb); }
};

__device__ __forceinline__ float fast_sigmoid(float x) { return __builtin_amdgcn_rcpf(1.f + __builtin_amdgcn_exp2f(-1.44269504f * x)); }
struct PinTok { bf16x8 qa, cv, kr; float ab; };
struct PinGain { float gqa[8], gkv[8], gkr[8], dtb, alog; };
__device__ __forceinline__ PinTok pin_load(const MK& a, int row, int lane) {
    const bf16_t* z = a.Z() + (size_t)row * ZW; PinTok t; const bf16x8 zz = {0, 0, 0, 0, 0, 0, 0, 0};
    t.qa = lane < 48 ? *(const bf16x8*)(z + OFF_QA + 8 * lane) : zz; t.cv = lane < 32 ? *(const bf16x8*)(z + OFF_KVA + 8 * lane) : zz;
    t.kr = (lane >= 32 && lane < 36) ? *(const bf16x8*)(z + OFF_KR + 8 * (lane - 32)) : zz; t.ab = lane < 16 ? bf2f(z[OFF_A + lane]) : 0.f; return t;
}
__device__ __forceinline__ void post_in_token(const MK& a, int row, int lane, const float* wcs, const bf16x8 (&w0)[3], const bf16x8 (&w1)[3], const bf16x8 (&w2)[3], const bf16x8 (&wcur)[3], const PinTok& tk, const PinGain& gn) {
    const bool samp = row >= NPT;
    const int b = samp ? row - NPT : row >> 11, t = samp ? 0 : row & 2047, hd = lane >> 3;
    float y[24];
#pragma unroll
    for (int c3 = 0; c3 < 3; ++c3) {
        float p0[8], p1[8], p2[8], cu[8];
        bf8_to_f32(w0[c3], p0); bf8_to_f32(w1[c3], p1); bf8_to_f32(w2[c3], p2); bf8_to_f32(wcur[c3], cu);
        const float* wp = wcs + 512 * c3 + 8 * lane;
        const float4 a0 = *(const float4*)wp, a1 = *(const float4*)(wp + 4), b0 = *(const float4*)(wp + 1536), b1 = *(const float4*)(wp + 1540);
        const float4 c0 = *(const float4*)(wp + 3072), c1 = *(const float4*)(wp + 3076), d0 = *(const float4*)(wp + 4608), d1 = *(const float4*)(wp + 4612);
        const float k0[8] = {a0.x, a0.y, a0.z, a0.w, a1.x, a1.y, a1.z, a1.w}, k1[8] = {b0.x, b0.y, b0.z, b0.w, b1.x, b1.y, b1.z, b1.w};
        const float k2[8] = {c0.x, c0.y, c0.z, c0.w, c1.x, c1.y, c1.z, c1.w}, k3[8] = {d0.x, d0.y, d0.z, d0.w, d1.x, d1.y, d1.z, d1.w};
#pragma unroll
        for (int e = 0; e < 8; ++e) { const int c = 8 * c3 + e; const float v = k0[e] * p0[e] + k1[e] * p1[e] + k2[e] * p2[e] + k3[e] * cu[e]; y[c] = v * fast_sigmoid(v); }
        __builtin_amdgcn_sched_barrier(0);
    }
    float sq = 0.f, sk = 0.f;
#pragma unroll
    for (int e = 0; e < 8; ++e) { sq += y[e] * y[e]; sk += y[8 + e] * y[8 + e]; }
    sq = sum8(sq); sk = sum8(sk);
    const float rq = rsqrtf(sq + EPSV) * 0.125f, rk = rsqrtf(sk + EPSV);
#pragma unroll
    for (int e = 0; e < 8; ++e) { y[e] *= rq; y[8 + e] *= rk; }
    bf16_t* qo = a.qkv() + (size_t)row * 1536 + 8 * lane;
    *(bf16x8*)qo = f32_to_bf8(y); *(bf16x8*)(qo + 512) = f32_to_bf8(y + 8); *(bf16x8*)(qo + 1024) = f32_to_bf8(y + 16);
    if (!samp && t >= SEQ - 3) {
        float* cso = a.out + O_CSP + ((size_t)b * 3 + (t - (SEQ - 3))) * 1536 + 8 * lane;
#pragma unroll
        for (int j = 0; j < 3; ++j) { float cu[8]; bf8_to_f32(wcur[j], cu); *(float4*)(cso + 512 * j) = (float4){cu[0], cu[1], cu[2], cu[3]}; *(float4*)(cso + 512 * j + 4) = (float4){cu[4], cu[5], cu[6], cu[7]}; }
    }
    if (lane < 16) {
        const float v = tk.ab;
        if (lane < 8) { const float xx = v + gn.dtb; const float sp = xx > 20.f ? xx : 0.69314718f * __builtin_amdgcn_logf(1.f + __builtin_amdgcn_exp2f(1.44269504f * xx)); a.gg()[(size_t)row * 8 + lane] = -gn.alog * sp; }
        else a.bb()[(size_t)row * 8 + lane - 8] = sigmoidf_(v);
    }
    __builtin_amdgcn_sched_barrier(0);
    float qa[8], cv[8], kr[8];
    bf8_to_f32(tk.qa, qa); bf8_to_f32(tk.cv, cv); bf8_to_f32(tk.kr, kr);
    float s1 = 0.f, s2 = 0.f, s3 = 0.f;
#pragma unroll
    for (int e = 0; e < 8; ++e) { s1 += qa[e] * qa[e]; s2 += cv[e] * cv[e]; s3 += kr[e] * kr[e]; }
    s1 = wave_sum(s1); s2 = wave_sum(s2); s3 = wave_sum(s3);
    const float r1 = rsqrtf(s1 * (1.f / 384.f) + EPSV), r2 = rsqrtf(s2 * (1.f / 256.f) + EPSV), r3 = rsqrtf(s3 * (1.f / 32.f) + EPSV);
    if (lane < 48) {
        float o[8];
#pragma unroll
        for (int e = 0; e < 8; ++e) o[e] = qa[e] * r1 * gn.gqa[e];
        *(bf16x8*)(a.qan() + (size_t)row * 384 + 8 * lane) = f32_to_bf8(o);
    }
    if (lane < 32) {
        float o[8];
#pragma unroll
        for (int e = 0; e < 8; ++e) o[e] = cv[e] * r2 * gn.gkv[e];
        *(bf16x8*)(a.ckvb() + (size_t)row * 256 + 8 * lane) = f32_to_bf8(o);
        float* co = samp ? a.out + O_CKVS + (size_t)b * 256 + 8 * lane : a.out + O_CKVP + (size_t)row * 256 + 8 * lane;
        *(float4*)co = (float4){o[0], o[1], o[2], o[3]}; *(float4*)(co + 4) = (float4){o[4], o[5], o[6], o[7]};
    }
    __builtin_amdgcn_sched_barrier(0);
    {
        const int c4 = (lane - 32) & 3;
        float xn[8], ot[8];
#pragma unroll
        for (int e = 0; e < 8; ++e) xn[e] = kr[e] * r3 * gn.gkr[e];
#pragma unroll
        for (int e = 0; e < 8; ++e) ot[e] = dpp_mov<0x4E>(xn[e]);
        if (lane >= 32 && lane < 36) {
            const float* tb = a.ropecs() + (size_t)(samp ? 2048 : t) * 32 + ((8 * c4) & 15);
            const float4 c0 = *(const float4*)tb, c1 = *(const float4*)(tb + 4), s0 = *(const float4*)(tb + 16), s1 = *(const float4*)(tb + 20);
            const float csv[8] = {c0.x, c0.y, c0.z, c0.w, c1.x, c1.y, c1.z, c1.w}, snv[8] = {s0.x, s0.y, s0.z, s0.w, s1.x, s1.y, s1.z, s1.w};
            float o[8];
#pragma unroll
            for (int e = 0; e < 8; ++e) o[e] = c4 < 2 ? xn[e] * csv[e] - ot[e] * snv[e] : ot[e] * snv[e] + xn[e] * csv[e];
            float* kf_ = a.krf() + (size_t)row * 32 + 8 * c4; *(float4*)kf_ = (float4){o[0], o[1], o[2], o[3]}; *(float4*)(kf_ + 4) = (float4){o[4], o[5], o[6], o[7]};
            float* ko = samp ? a.out + O_KRS + (size_t)b * 32 + 8 * c4 : a.out + O_KRP + (size_t)row * 32 + 8 * c4;
            *(float4*)ko = (float4){o[0], o[1], o[2], o[3]}; *(float4*)(ko + 4) = (float4){o[4], o[5], o[6], o[7]};
            if (!samp) *(bf16x8*)(a.krb() + (size_t)row * 32 + 8 * c4) = f32_to_bf8(o);
        }
    }
    (void)hd;
}
__device__ __forceinline__ void post_in_run(const MK& a, int run, int lane_in, const float* wcs) {
    int lane = lane_in; asm volatile("" : "+v"(lane));
    PinGain gn;
    {
        const int lq = lane < 48 ? lane : 0, lk = lane < 32 ? lane : 0, c4 = (lane - 32) & 3;
#pragma unroll
        for (int e = 0; e < 8; ++e) { gn.gqa[e] = a.g_q_a[8 * lq + e]; gn.gkv[e] = a.g_kv_a[8 * lk + e]; gn.gkr[e] = a.g_k_rope[8 * c4 + e]; }
        gn.dtb = a.dt_bias[lane & 7]; gn.alog = expf(a.a_log[lane & 7]);
    }
    if (run < NPT / 8) {
        const int row0 = run * 8, t0 = row0 & 2047;
        bf16x8 w0[3], w1[3], w2[3], wcur[3];
#pragma unroll
        for (int c3 = 0; c3 < 3; ++c3) {
            const bf16x8 zz = {0, 0, 0, 0, 0, 0, 0, 0}; w0[c3] = zz; w1[c3] = zz; w2[c3] = zz;
            if (t0 > 0) { const bf16_t* zp = a.Z() + (size_t)(row0 - 3) * ZW + 512 * c3 + 8 * lane; w0[c3] = *(const bf16x8*)zp; w1[c3] = *(const bf16x8*)(zp + ZW); w2[c3] = *(const bf16x8*)(zp + 2 * ZW); }
        }
        bf16x8 wnext[3]; PinTok tk, tkn;
#pragma unroll
        for (int c3 = 0; c3 < 3; ++c3) wnext[c3] = *(const bf16x8*)(a.Z() + (size_t)row0 * ZW + 512 * c3 + 8 * lane);
        tkn = pin_load(a, row0, lane);
#pragma unroll 1
        for (int k = 0; k < 8; ++k) {
            const int row = row0 + k;
#pragma unroll
            for (int c3 = 0; c3 < 3; ++c3) wcur[c3] = wnext[c3];
            tk = tkn;
            if (k < 7) {
#pragma unroll
                for (int c3 = 0; c3 < 3; ++c3) wnext[c3] = *(const bf16x8*)(a.Z() + (size_t)(row + 1) * ZW + 512 * c3 + 8 * lane);
                tkn = pin_load(a, row + 1, lane);
            }
            post_in_token(a, row, lane, wcs, w0, w1, w2, wcur, tk, gn);
#pragma unroll
            for (int c3 = 0; c3 < 3; ++c3) { w0[c3] = w1[c3]; w1[c3] = w2[c3]; w2[c3] = wcur[c3]; }
        }
    } else {
        {
            const int bsm = run - NPT / 8, row = NPT + bsm;
            bf16x8 w0[3], w1[3], w2[3], wcur[3];
#pragma unroll
            for (int c3 = 0; c3 < 3; ++c3) {
                const float* sp = a.state_conv + (size_t)bsm * 3 * 1536 + 512 * c3 + 8 * lane;
                float* cso = a.out + O_CSS + (size_t)bsm * 3 * 1536 + 512 * c3 + 8 * lane;
                float t0_[8], t1_[8], t2_[8], tc_[8];
#pragma unroll
                for (int e = 0; e < 8; ++e) { t0_[e] = sp[e]; t1_[e] = sp[1536 + e]; t2_[e] = sp[2 * 1536 + e]; }
                wcur[c3] = *(const bf16x8*)(a.Z() + (size_t)row * ZW + 512 * c3 + 8 * lane); bf8_to_f32(wcur[c3], tc_);
#pragma unroll
                for (int e = 0; e < 8; ++e) { cso[e] = t1_[e]; cso[1536 + e] = t2_[e]; cso[2 * 1536 + e] = tc_[e]; }
                w0[c3] = f32_to_bf8(t0_); w1[c3] = f32_to_bf8(t1_); w2[c3] = f32_to_bf8(t2_);
            }
            post_in_token(a, row, lane, wcs, w0, w1, w2, wcur, pin_load(a, row, lane), gn);
        }
    }
}

__device__ __forceinline__ void post_q_item(const MK& a, int idx, int lane) {
    const int row = idx >> 3, h = idx & 7;
    const float* q = a.Q() + (size_t)row * 768 + h * 96;
    float* o = a.qh() + ((size_t)row * 8 + h) * 96;
    const float v = q[lane];
    const float ss = wave_sum(v * v);
    o[lane] = v * rsqrtf(ss * (1.f / 64.f) + EPSV) * a.g_q_nope[lane];
    const float r = lane < 32 ? q[64 + lane] : 0.f;
    const float s2 = wave_sum(r * r);
    const float xn = lane < 32 ? r * rsqrtf(s2 * (1.f / 32.f) + EPSV) * a.g_q_rope[lane] : 0.f;
    const float other = __shfl_xor(xn, 16);
    const int i = lane & 15;
    const float* tb = a.ropecs() + (size_t)(row >= NPT ? 2048 : (row & 2047)) * 32;
    const float cs = tb[i], sn = tb[16 + i];
    const float ov = lane < 16 ? xn * cs - other * sn : other * sn + xn * cs;
    if (lane < 32) o[64 + lane] = ov;
}
__device__ __forceinline__ void post_kv_item(const MK& a, int idx, int lane) {
    const int row = idx >> 3, h = idx & 7;
    const float v = a.KV()[(size_t)row * 1024 + h * 128 + lane];
    const float ss = wave_sum(v * v);
    const float kn = v * rsqrtf(ss * (1.f / 64.f) + EPSV) * a.g_k_nope[lane];
    a.kh()[((size_t)row * 8 + h) * 64 + lane] = kn;
}

typedef float f32x16 __attribute__((ext_vector_type(16)));
typedef short s16x4 __attribute__((ext_vector_type(4)));
#define KST 104
#define VST 72
#define ATT_BUF (64 * KST * 2 + 64 * VST * 2)
__device__ __forceinline__ int crow32(int r, int hi) { return (r & 3) + 8 * (r >> 2) + 4 * hi; }
__device__ __forceinline__ s16x4 tr_read(const bf16_t* p) { return __builtin_bit_cast(s16x4, __builtin_amdgcn_ds_read_tr16_b64_v4i16((LAS s16x4*)(LAS void*)(unsigned)(size_t)p)); }
__device__ __forceinline__ bf16x8 pack8(const f32x16& x, int s) {
    u32x4 w; w.x = cvtpk(x[8 * s], x[8 * s + 1]); w.y = cvtpk(x[8 * s + 2], x[8 * s + 3]); w.z = cvtpk(x[8 * s + 4], x[8 * s + 5]); w.w = cvtpk(x[8 * s + 6], x[8 * s + 7]);
    return __builtin_bit_cast(bf16x8, w);
}
__device__ __forceinline__ void attn_block(const MK& a, int b, int h, int qb, char* smem) {
    const int tid = otid(), lane = tid & 63, wid = tid >> 6, r32 = lane & 31, hi = lane >> 5;
    const int qrow = qb * 256 + wid * 32 + r32;
    const int wq0 = qb * 256 + wid * 32;
    bf16x8 qf[6];
    {
        const float SCL = 0.14724445f;
        const bf16_t* Qg = a.qraw() + ((size_t)b * SEQ + qrow) * 768 + h * 96 + 8 * hi;
        float qv[6][8];
#pragma unroll
        for (int ds = 0; ds < 6; ++ds) bf8_to_f32(*(const bf16x8*)(Qg + 16 * ds), qv[ds]);
        float sn_ = 0.f, sr_ = 0.f;
#pragma unroll
        for (int j = 0; j < 8; ++j) { sn_ += qv[0][j] * qv[0][j] + qv[1][j] * qv[1][j] + qv[2][j] * qv[2][j] + qv[3][j] * qv[3][j]; sr_ += qv[4][j] * qv[4][j] + qv[5][j] * qv[5][j]; }
        sn_ = add_x32(sn_); sr_ = add_x32(sr_);
        const float rsn = rsqrtf(sn_ * (1.f / 64.f) + EPSV) * SCL, rsr = rsqrtf(sr_ * (1.f / 32.f) + EPSV);
#pragma unroll
        for (int ds = 0; ds < 4; ++ds) {
            float o[8];
#pragma unroll
            for (int j = 0; j < 8; ++j) o[j] = qv[ds][j] * rsn * a.g_q_nope[16 * ds + 8 * hi + j];
            qf[ds] = f32_to_bf8(o);
        }
        const float* tb = a.ropecs() + (size_t)qrow * 32 + 8 * hi;
        float o4[8], o5[8];
#pragma unroll
        for (int j = 0; j < 8; ++j) {
            const float x1 = qv[4][j] * rsr * a.g_q_rope[8 * hi + j], x2 = qv[5][j] * rsr * a.g_q_rope[16 + 8 * hi + j], cs = tb[j], sn = tb[16 + j];
            o4[j] = (x1 * cs - x2 * sn) * SCL; o5[j] = (x1 * sn + x2 * cs) * SCL;
        }
        qf[4] = f32_to_bf8(o4); qf[5] = f32_to_bf8(o5);
    }
    f32x16 o0, o1;
#pragma unroll
    for (int r = 0; r < 16; ++r) { o0[r] = 0.f; o1[r] = 0.f; }
    float m = 0.f, l = 0.f;
    f32x16 negm;
#pragma unroll
    for (int r = 0; r < 16; ++r) negm[r] = 0.f;
    const int nt = qb * 4 + 4;
    const int vr = tid >> 3, vc = tid & 7, rr_ = (tid >> 2) & 63, rc = tid & 3;
    const bf16_t* KVg = a.kvraw() + (size_t)b * SEQ * 1024 + h * 128 + (size_t)vr * 1024 + vc * 8;
    const bf16_t* KRg = a.krb() + (size_t)b * SEQ * 32 + (size_t)rr_ * 32 + rc * 8;
    float gk[8];
#pragma unroll
    for (int j = 0; j < 8; ++j) gk[j] = a.g_k_nope[8 * vc + j];
    bf16x8 kr0, kr1, vr0;
#define ATT_LOAD(tt) do { kr0 = *(const bf16x8*)(KVg + (size_t)(tt) * 64 * 1024); vr0 = *(const bf16x8*)(KVg + (size_t)(tt) * 64 * 1024 + 64); if (tid < 256) kr1 = *(const bf16x8*)(KRg + (size_t)(tt) * 64 * 32); } while (0)
#define ATT_STORE(buf) do { bf16_t* Ks_ = (bf16_t*)(smem + (buf) * ATT_BUF); bf16_t* Vs_ = Ks_ + 64 * KST; \
        float x_[8]; bf8_to_f32(kr0, x_); float ss_ = 0.f; _Pragma("unroll") for (int j = 0; j < 8; ++j) ss_ += x_[j] * x_[j]; \
        ss_ = sum8(ss_); const float rs_ = rsqrtf(ss_ * (1.f / 64.f) + EPSV); \
        _Pragma("unroll") for (int j = 0; j < 8; ++j) x_[j] *= rs_ * gk[j]; \
        *(bf16x8*)(Ks_ + vr * KST + vc * 8) = f32_to_bf8(x_); *(bf16x8*)(Vs_ + vr * VST + vc * 8) = vr0; \
        if (tid < 256) *(bf16x8*)(Ks_ + rr_ * KST + 64 + rc * 8) = kr1; } while (0)
    ATT_LOAD(0);
    __syncthreads();
    ATT_STORE(0);
    __syncthreads();
    const int i16 = lane & 15, qq = i16 >> 2, pp = i16 & 3, g1 = (lane >> 4) & 1;
    for (int t = 0; t < nt; ++t) {
        const bf16_t* Ks = (const bf16_t*)(smem + (t & 1) * ATT_BUF); const bf16_t* Vs = Ks + 64 * KST;
        if (t + 1 < nt) ATT_LOAD(t + 1);
        if (64 * t <= wq0 + 31) {
            f32x16 p0, p1;
#pragma unroll
            for (int ds = 0; ds < 6; ++ds) {
                const bf16x8 k0 = *(const bf16x8*)(Ks + r32 * KST + 16 * ds + 8 * hi);
                const bf16x8 k1 = *(const bf16x8*)(Ks + (32 + r32) * KST + 16 * ds + 8 * hi);
                if (ds == 0) { p0 = __builtin_amdgcn_mfma_f32_32x32x16_bf16(k0, qf[ds], negm, 0, 0, 0); p1 = __builtin_amdgcn_mfma_f32_32x32x16_bf16(k1, qf[ds], negm, 0, 0, 0); }
                else { p0 = __builtin_amdgcn_mfma_f32_32x32x16_bf16(k0, qf[ds], p0, 0, 0, 0); p1 = __builtin_amdgcn_mfma_f32_32x32x16_bf16(k1, qf[ds], p1, 0, 0, 0); }
            }
            if (64 * t + 63 > wq0) {
#pragma unroll
                for (int r = 0; r < 16; ++r) { const int kv = 64 * t + crow32(r, hi); if (kv > qrow) p0[r] = -INFINITY; if (kv + 32 > qrow) p1[r] = -INFINITY; }
            }
            float mx = fmaxf(p0[0], p1[0]);
#pragma unroll
            for (int r = 1; r < 16; ++r) mx = fmaxf(mx, fmaxf(p0[r], p1[r]));
            mx = max_x32(mx);
            const float delta = t == 0 ? mx : fmaxf(mx, 0.f);
            if (__any(delta != 0.f)) {
                m += delta;
                const float f = t == 0 ? 1.f : __builtin_amdgcn_exp2f(-delta);
#pragma unroll
                for (int r = 0; r < 16; ++r) { p0[r] -= delta; p1[r] -= delta; negm[r] = -m; o0[r] *= f; o1[r] *= f; }
                l *= f;
            }
            float rs = 0.f;
#pragma unroll
            for (int r = 0; r < 16; ++r) { p0[r] = __builtin_amdgcn_exp2f(p0[r]); p1[r] = __builtin_amdgcn_exp2f(p1[r]); rs += p0[r] + p1[r]; }
            l += rs;
            bf16x8 pf[4];
            pf[0] = pack8(p0, 0); pf[1] = pack8(p0, 1); pf[2] = pack8(p1, 0); pf[3] = pack8(p1, 1);
#pragma unroll
            for (int ks = 0; ks < 4; ++ks) {
                const bf16_t* vb0 = Vs + (16 * ks + 4 * hi + qq) * VST + 16 * g1 + 4 * pp;
                const s16x4 a0 = tr_read(vb0), a1 = tr_read(vb0 + 8 * VST);
                const s16x4 c0 = tr_read(vb0 + 32), c1 = tr_read(vb0 + 8 * VST + 32);
                const bf16x8 va = __builtin_shufflevector(a0, a1, 0, 1, 2, 3, 4, 5, 6, 7);
                const bf16x8 vc_ = __builtin_shufflevector(c0, c1, 0, 1, 2, 3, 4, 5, 6, 7);
                o0 = __builtin_amdgcn_mfma_f32_32x32x16_bf16(va, pf[ks], o0, 0, 0, 0);
                o1 = __builtin_amdgcn_mfma_f32_32x32x16_bf16(vc_, pf[ks], o1, 0, 0, 0);
            }
        }
        if (t + 1 < nt) ATT_STORE((t + 1) & 1);
        __syncthreads();
    }
    l = add_x32(l);
    const float il = 1.f / l;
    bf16_t* op = a.omix() + ((size_t)b * SEQ + qrow) * 1024 + 512 + h * 64;
#pragma unroll
    for (int g = 0; g < 4; ++g) {
        uint2 w0, w1;
        w0.x = pk2bf(o0[4 * g] * il, o0[4 * g + 1] * il); w0.y = pk2bf(o0[4 * g + 2] * il, o0[4 * g + 3] * il);
        w1.x = pk2bf(o1[4 * g] * il, o1[4 * g + 1] * il); w1.y = pk2bf(o1[4 * g + 2] * il, o1[4 * g + 3] * il);
        *(uint2*)(op + 8 * g + 4 * hi) = w0;
        *(uint2*)(op + 32 + 8 * g + 4 * hi) = w1;
    }
#undef ATT_LOAD
#undef ATT_STORE
}

__device__ __forceinline__ void gdn_unit(const MK& a, int b, int h, int dvg, const float* s0, float* sout, int row0, int T, int lane, char* wsm) {
    float (*sq)[64] = (float (*)[64])wsm;
    float (*sk)[64] = (float (*)[64])(wsm + 4096);
    float (*sv)[8] = (float (*)[8])(wsm + 8192);
    float* sg = (float*)(wsm + 8704);
    float* sb = (float*)(wsm + 8768);
    const int e = lane & 7, ko = lane >> 3, col = dvg * 8 + e;
    float S[8];
#pragma unroll
    for (int d = 0; d < 8; ++d) S[d] = s0 ? s0[(((size_t)b * 8 + h) * 64 + ko * 8 + d) * 64 + col] : 0.f;
    const size_t rbase = (size_t)row0 + (size_t)b * T;
    float pq[16], pk[16], pv0, pv1, pgb;
    {
        const int nt = T < 16 ? T : 16;
#pragma unroll
        for (int j = 0; j < 16; ++j) { const bool ok = j < nt; const size_t r = rbase + (ok ? j : 0); pq[j] = ok ? bf2f(a.qkv()[r * 1536 + h * 64 + lane]) : 0.f; pk[j] = ok ? bf2f(a.qkv()[r * 1536 + 512 + h * 64 + lane]) : 0.f; }
        { const int j0 = lane >> 3, j1 = j0 + 8; pv0 = j0 < nt ? bf2f(a.qkv()[(rbase + j0) * 1536 + 1024 + h * 64 + dvg * 8 + (lane & 7)]) : 0.f; pv1 = j1 < nt ? bf2f(a.qkv()[(rbase + j1) * 1536 + 1024 + h * 64 + dvg * 8 + (lane & 7)]) : 0.f; }
        { const int j = lane & 15; pgb = j < nt ? (lane < 16 ? a.gg()[(rbase + j) * 8 + h] : a.bb()[(rbase + j) * 8 + h]) : 0.f; }
    }
    for (int t0 = 0; t0 < T; t0 += 16) {
        const int nt = (T - t0) < 16 ? (T - t0) : 16;
        WSYNC();
#pragma unroll
        for (int j = 0; j < 16; ++j) { sq[j][lane] = pq[j]; sk[j][lane] = pk[j]; }
        sv[lane >> 3][lane & 7] = pv0; sv[(lane >> 3) + 8][lane & 7] = pv1;
        if (lane < 16) sg[lane] = expf(pgb); else if (lane < 32) sb[lane - 16] = pgb;
        WSYNC();
        if (t0 + 16 < T) {
            const size_t rb = rbase + t0 + 16;
#pragma unroll
            for (int j = 0; j < 16; ++j) { pq[j] = bf2f(a.qkv()[(rb + j) * 1536 + h * 64 + lane]); pk[j] = bf2f(a.qkv()[(rb + j) * 1536 + 512 + h * 64 + lane]); }
            pv0 = bf2f(a.qkv()[(rb + (lane >> 3)) * 1536 + 1024 + h * 64 + dvg * 8 + (lane & 7)]); pv1 = bf2f(a.qkv()[(rb + (lane >> 3) + 8) * 1536 + 1024 + h * 64 + dvg * 8 + (lane & 7)]);
            pgb = lane < 16 ? a.gg()[(rb + (lane & 15)) * 8 + h] : a.bb()[(rb + (lane & 15)) * 8 + h];
        }
        for (int j = 0; j < nt; ++j) {
            const float dec = sg[j], be = sb[j], v = sv[j][e];
            const float4 k0 = *(const float4*)&sk[j][ko * 8], k1 = *(const float4*)&sk[j][ko * 8 + 4];
            const float4 q0 = *(const float4*)&sq[j][ko * 8], q1 = *(const float4*)&sq[j][ko * 8 + 4];
            const float kk[8] = {k0.x, k0.y, k0.z, k0.w, k1.x, k1.y, k1.z, k1.w};
            const float qq[8] = {q0.x, q0.y, q0.z, q0.w, q1.x, q1.y, q1.z, q1.w};
            float ks = 0.f;
#pragma unroll
            for (int d = 0; d < 8; ++d) { S[d] *= dec; ks += kk[d] * S[d]; }
            ks += __shfl_xor(ks, 8); ks += __shfl_xor(ks, 16); ks += __shfl_xor(ks, 32);
            const float delta = (v - ks) * be;
            float ov = 0.f;
#pragma unroll
            for (int d = 0; d < 8; ++d) { S[d] += kk[d] * delta; ov += qq[d] * S[d]; }
            ov += __shfl_xor(ov, 8); ov += __shfl_xor(ov, 16); ov += __shfl_xor(ov, 32);
            if (ko == 0) a.goraw()[(rbase + t0 + j) * 512 + h * 64 + col] = ov;
        }
    }
#pragma unroll
    for (int d = 0; d < 8; ++d) sout[(((size_t)b * 8 + h) * 64 + ko * 8 + d) * 64 + col] = S[d];
}
__device__ __forceinline__ int pi_pos(int k) { return (k & 32) + 8 * ((k >> 2) & 3) + 4 * ((k >> 4) & 1) + (k & 3); }
#define GDN_WLDS 17408
__device__ __forceinline__ void gdn_prep_unit(const MK& a, int u, int lane_in, char* wsm) {
    int lane = lane_in; asm volatile("" : "+v"(lane));
    const int bh = u >> 5, n = u & 31, b = bh >> 3, h = bh & 7, i16 = lane & 15, q4 = lane >> 4;
    const size_t row0 = (size_t)b * SEQ + n * 64;
    float* AT = (float*)wsm; float* GC = (float*)(wsm + 16384); float* BT = GC + 64;
    const bf16_t* qbase = a.qkv() + row0 * 1536 + h * 64; const bf16_t* kbase = qbase + 512; const bf16_t* vbase = qbase + 1024;
    float g = a.gg()[(row0 + lane) * 8 + h];
    const float be_l = a.bb()[(row0 + lane) * 8 + h];
#pragma unroll
    for (int o = 1; o < 64; o <<= 1) { const float t = __shfl_up(g, o); if (lane >= o) g += t; }
    WSYNC();
    GC[lane] = g; BT[lane] = be_l;
    WSYNC();
    const float gl = GC[63];
    float* EG = BT + 64; float* ED = EG + 64;
    EG[lane] = expf(g); ED[lane] = expf(gl - g);
    WSYNC();
    bf16x8 kf[4][2], qf[4][2];
#pragma unroll
    for (int mt = 0; mt < 4; ++mt)
#pragma unroll
        for (int ks = 0; ks < 2; ++ks) {
            const int off = (16 * mt + i16) * 1536 + 32 * ks + 8 * q4;
            kf[mt][ks] = *(const bf16x8*)(kbase + off); qf[mt][ks] = *(const bf16x8*)(qbase + off);
        }
    bf16_t* QKg = a.gQK() + (size_t)u * 4096;
#pragma unroll
    for (int mt = 0; mt < 4; ++mt)
#pragma unroll
        for (int nt = 0; nt < 4; ++nt) {
            const int j = 16 * nt + i16, pj = 32 * (nt >> 1) + 8 * (i16 >> 2) + 4 * (nt & 1) + (i16 & 3);
            if (nt <= mt) {
                f32x4 d1 = {0.f, 0.f, 0.f, 0.f}, d2 = {0.f, 0.f, 0.f, 0.f};
#pragma unroll
                for (int ks = 0; ks < 2; ++ks) {
                    d1 = __builtin_amdgcn_mfma_f32_16x16x32_bf16(kf[mt][ks], kf[nt][ks], d1, 0, 0, 0);
                    d2 = __builtin_amdgcn_mfma_f32_16x16x32_bf16(qf[mt][ks], kf[nt][ks], d2, 0, 0, 0);
                }
                const float gcj = GC[j];
#pragma unroll
                for (int r = 0; r < 4; ++r) {
                    const int i = 16 * mt + 4 * q4 + r;
                    const float dec = __builtin_amdgcn_exp2f(1.44269504f * (GC[i] - gcj));
                    AT[i * 64 + j] = (i > j) ? BT[i] * d1[r] * dec : 0.f;
                    QKg[i * 64 + (((pj >> 3) ^ (i & 7)) << 3) + (pj & 7)] = f2bf((i >= j) ? d2[r] * dec : 0.f);
                }
            } else {
#pragma unroll
                for (int r = 0; r < 4; ++r) { const int i = 16 * mt + 4 * q4 + r; QKg[i * 64 + (((pj >> 3) ^ (i & 7)) << 3) + (pj & 7)] = 0; }
            }
        }
    {
        bf16_t* Qgg = a.gQg() + (size_t)u * 4096;
#pragma unroll
        for (int mt = 0; mt < 4; ++mt) {
            const int i = 16 * mt + i16; const float e = EG[i];
#pragma unroll
            for (int ks = 0; ks < 2; ++ks) {
                float x[8]; bf8_to_f32(qf[mt][ks], x);
                uint2 w0, w1; w0.x = cvtpk(x[0] * e, x[1] * e); w0.y = cvtpk(x[2] * e, x[3] * e); w1.x = cvtpk(x[4] * e, x[5] * e); w1.y = cvtpk(x[6] * e, x[7] * e);
                const int p0 = 32 * ks + 16 * (q4 & 1) + 4 * (q4 >> 1);
                *(uint2*)(Qgg + i * 64 + (((p0 >> 3) ^ (i & 7)) << 3) + (p0 & 7)) = w0; *(uint2*)(Qgg + i * 64 + ((((p0 >> 3) + 1) ^ (i & 7)) << 3) + (p0 & 7)) = w1;
            }
        }
    }
    WSYNC();
    __builtin_amdgcn_sched_barrier(0);
    {
        const float* Nb = AT + (16 * q4) * 64 + 16 * q4;
        float t[16];
#pragma unroll
        for (int r = 0; r < 16; ++r) t[r] = (r == i16) ? 1.f : 0.f;
#pragma unroll
        for (int r = 1; r < 16; ++r) {
            float sacc = 0.f;
#pragma unroll
            for (int j4 = 0; j4 < r; j4 += 4) {
                const float4 av = *(const float4*)(Nb + r * 64 + j4);
                sacc += av.x * t[j4];
                if (j4 + 1 < r) sacc += av.y * t[j4 + 1];
                if (j4 + 2 < r) sacc += av.z * t[j4 + 2];
                if (j4 + 3 < r) sacc += av.w * t[j4 + 3];
            }
            t[r] -= sacc;
        }
        WSYNC();
#pragma unroll
        for (int r = 0; r < 16; ++r) AT[(16 * q4 + r) * 64 + 16 * q4 + i16] = t[r];
        WSYNC();
    }
    __builtin_amdgcn_sched_barrier(0);
    {
#pragma unroll
        for (int pass = 0; pass < 2; ++pass) {
            f32x4 Y[4][4];
            const bf16_t* src = pass == 0 ? vbase : kbase;
#pragma unroll
            for (int bi = 0; bi < 4; ++bi)
#pragma unroll
                for (int nt = 0; nt < 4; ++nt)
#pragma unroll
                    for (int r = 0; r < 4; ++r) Y[bi][nt][r] = bf2f(src[(16 * bi + 4 * q4 + r) * 1536 + 16 * nt + i16]);
            if (pass == 1) {
#pragma unroll
                for (int nt = 0; nt < 4; ++nt) {
                    bf16_t* Kdg = a.gKd() + ((size_t)u * 64 + 16 * nt + i16) * 64;
#pragma unroll
                    for (int bi = 0; bi < 4; ++bi) {
                        const float4 ed = *(const float4*)(ED + 16 * bi + 4 * q4);
                        uint2 w; w.x = cvtpk(Y[bi][nt][0] * ed.x, Y[bi][nt][1] * ed.y); w.y = cvtpk(Y[bi][nt][2] * ed.z, Y[bi][nt][3] * ed.w);
                        *(uint2*)(Kdg + 8 * ((4 * (bi >> 1) + q4) ^ (i16 & 7)) + 4 * (bi & 1)) = w;
                    }
                }
            }
#pragma unroll
            for (int bi = 0; bi < 4; ++bi) {
                const float4 btv = *(const float4*)(BT + 16 * bi + 4 * q4), egv = *(const float4*)(EG + 16 * bi + 4 * q4);
                const f32x4 sc = pass == 0 ? (f32x4){btv.x, btv.y, btv.z, btv.w} : (f32x4){btv.x * egv.x, btv.y * egv.y, btv.z * egv.z, btv.w * egv.w};
#pragma unroll
                for (int nt = 0; nt < 4; ++nt) Y[bi][nt] = Y[bi][nt] * sc;
            }
#pragma unroll
            for (int bi = 0; bi < 4; ++bi) {
                f32x4 mfr[4];
#pragma unroll
                for (int bj = 0; bj <= bi; ++bj) { const f32x4 v = *(const f32x4*)(AT + (16 * bi + i16) * 64 + 16 * bj + 4 * q4); mfr[bj] = (bi == bj) ? v : -v; }
#pragma unroll
                for (int bj = 0; bj < bi; ++bj)
#pragma unroll
                    for (int s4 = 0; s4 < 4; ++s4)
#pragma unroll
                        for (int nt = 0; nt < 4; ++nt) Y[bi][nt] = __builtin_amdgcn_mfma_f32_16x16x4f32(mfr[bj][s4], Y[bj][nt][s4], Y[bi][nt], 0, 0, 0);
                f32x4 X[4];
#pragma unroll
                for (int nt = 0; nt < 4; ++nt) X[nt] = (f32x4){0.f, 0.f, 0.f, 0.f};
#pragma unroll
                for (int s4 = 0; s4 < 4; ++s4)
#pragma unroll
                    for (int nt = 0; nt < 4; ++nt) X[nt] = __builtin_amdgcn_mfma_f32_16x16x4f32(mfr[bi][s4], Y[bi][nt][s4], X[nt], 0, 0, 0);
#pragma unroll
                for (int nt = 0; nt < 4; ++nt) Y[bi][nt] = X[nt];
            }
            if (pass == 0) {
#pragma unroll
                for (int nt = 0; nt < 4; ++nt) {
                    float* UTg = a.gUT() + ((size_t)u * 64 + 16 * nt + i16) * 64;
#pragma unroll
                    for (int bi = 0; bi < 4; ++bi) *(float4*)(UTg + 4 * ((4 * bi + q4) ^ i16)) = (float4){Y[bi][nt][0], Y[bi][nt][1], Y[bi][nt][2], Y[bi][nt][3]};
                }
            } else {
                bf16_t* Wng = a.gWn() + (size_t)u * 4096;
#pragma unroll
                for (int nt = 0; nt < 4; ++nt) {
                    const int pp = pi_pos(16 * nt + i16);
#pragma unroll
                    for (int bi = 0; bi < 4; ++bi)
#pragma unroll
                        for (int r = 0; r < 4; ++r) { const int i = 16 * bi + 4 * q4 + r; Wng[i * 64 + (((pp >> 3) ^ (i & 7)) << 3) + (pp & 7)] = f2bf(-Y[bi][nt][r]); }
                }
            }
            __builtin_amdgcn_sched_barrier(0);
        }
    }
    if (lane == 0) a.ggam()[u] = expf(gl);
}
__device__ __forceinline__ bf16x8 pack_acc2(const f32x4& x, const f32x4& y) {
    u32x4 w; w.x = cvtpk(x[0], x[1]); w.y = cvtpk(x[2], x[3]); w.z = cvtpk(y[0], y[1]); w.w = cvtpk(y[2], y[3]);
    return __builtin_bit_cast(bf16x8, w);
}
#define G2_SLOT 49152
__device__ __forceinline__ void g2_issue(const MK& a, size_t u, int n, LAS unsigned char* lds, int lw, int lane) {
    LAS unsigned char* dst = lds + (n % 3) * G2_SLOT;
    const char* srcs[4] = {(const char*)(a.gWn() + u * 4096), (const char*)(a.gQg() + u * 4096), (const char*)(a.gQK() + u * 4096), (const char*)(a.gKd() + u * 4096)};
#pragma unroll
    for (int m = 0; m < 4; ++m)
#pragma unroll
        for (int i = 0; i < 2; ++i) { const int piece = 2 * lw + i;
            __builtin_amdgcn_global_load_lds((const unsigned*)(srcs[m] + piece * 1024 + lane * 16), (LAS unsigned*)(dst + m * 8192 + piece * 1024), 16, 0, 0); }
    const char* us = (const char*)(a.gUT() + u * 4096);
#pragma unroll
    for (int i = 0; i < 4; ++i) { const int piece = 4 * lw + i;
        __builtin_amdgcn_global_load_lds((const unsigned*)(us + piece * 1024 + lane * 16), (LAS unsigned*)(dst + 32768 + piece * 1024), 16, 0, 0); }
}
__device__ __forceinline__ void gdn_scan_block(const MK& a, int bh, LAS unsigned char* lds) {
    const int tid = otid(), lane = tid & 63, wid = __builtin_amdgcn_readfirstlane(tid >> 6), i16 = lane & 15, q4 = lane >> 4;
    const int b = bh >> 3, h = bh & 7, sl = wid & 3;
    const bool loader = wid >= 4;
    f32x4 S[4];
#pragma unroll
    for (int mt = 0; mt < 4; ++mt) S[mt] = (f32x4){0.f, 0.f, 0.f, 0.f};
    __syncthreads();
    if (loader) { g2_issue(a, (size_t)bh * 32, 0, lds, wid - 4, lane); g2_issue(a, (size_t)bh * 32 + 1, 1, lds, wid - 4, lane); }
    for (int n = 0; n < 32; ++n) {
        if (loader) { if (n < 31) asm volatile("s_waitcnt vmcnt(12)" ::: "memory"); else asm volatile("s_waitcnt vmcnt(0)" ::: "memory"); }
        asm volatile("s_waitcnt lgkmcnt(0)" ::: "memory"); __builtin_amdgcn_s_barrier(); asm volatile("" ::: "memory");
        if (loader) { if (n + 2 < 32) g2_issue(a, (size_t)bh * 32 + n + 2, n + 2, lds, wid - 4, lane); }
        else {
            const LAS unsigned char* sb = lds + (n % 3) * G2_SLOT;
            const float gam = a.ggam()[(size_t)bh * 32 + n];
            bf16x8 Sb[2]; Sb[0] = pack_acc2(S[0], S[1]); Sb[1] = pack_acc2(S[2], S[3]);
            f32x4 Vn[4];
#pragma unroll
            for (int mt = 0; mt < 4; ++mt) Vn[mt] = *(const LAS f32x4*)(sb + 32768 + (16 * sl + i16) * 256 + 16 * ((4 * mt + q4) ^ i16));
#pragma unroll
            for (int mt = 0; mt < 4; ++mt)
#pragma unroll
                for (int ks = 0; ks < 2; ++ks) Vn[mt] = __builtin_amdgcn_mfma_f32_16x16x32_bf16(*(const LAS bf16x8*)(sb + (16 * mt + i16) * 128 + 16 * ((4 * ks + q4) ^ (i16 & 7))), Sb[ks], Vn[mt], 0, 0, 0);
            bf16x8 Vb[2]; Vb[0] = pack_acc2(Vn[0], Vn[1]); Vb[1] = pack_acc2(Vn[2], Vn[3]);
            f32x4 O[4];
#pragma unroll
            for (int mt = 0; mt < 4; ++mt) {
                O[mt] = (f32x4){0.f, 0.f, 0.f, 0.f};
#pragma unroll
                for (int ks = 0; ks < 2; ++ks) {
                    const int fo = (16 * mt + i16) * 128 + 16 * ((4 * ks + q4) ^ (i16 & 7));
                    O[mt] = __builtin_amdgcn_mfma_f32_16x16x32_bf16(*(const LAS bf16x8*)(sb + 8192 + fo), Sb[ks], O[mt], 0, 0, 0);
                    O[mt] = __builtin_amdgcn_mfma_f32_16x16x32_bf16(*(const LAS bf16x8*)(sb + 16384 + fo), Vb[ks], O[mt], 0, 0, 0);
                }
            }
#pragma unroll
            for (int mt = 0; mt < 4; ++mt) {
                S[mt] = S[mt] * gam;
#pragma unroll
                for (int ks = 0; ks < 2; ++ks) S[mt] = __builtin_amdgcn_mfma_f32_16x16x32_bf16(*(const LAS bf16x8*)(sb + 24576 + (16 * mt + i16) * 128 + 16 * ((4 * ks + q4) ^ (i16 & 7))), Vb[ks], S[mt], 0, 0, 0);
            }
            float* og = a.goraw() + ((size_t)b * SEQ + n * 64 + 4 * q4) * 512 + h * 64 + 16 * sl + i16;
#pragma unroll
            for (int mt = 0; mt < 4; ++mt)
#pragma unroll
                for (int r = 0; r < 4; ++r) og[(size_t)(16 * mt + r) * 512] = O[mt][r];
        }
    }
    if (!loader) {
        float* so = a.out + O_GSP + ((size_t)bh * 64 + 4 * q4) * 64 + 16 * sl + i16;
#pragma unroll
        for (int mt = 0; mt < 4; ++mt)
#pragma unroll
            for (int r = 0; r < 4; ++r) so[(size_t)(16 * mt + r) * 64] = S[mt][r];
    }
    __syncthreads();
}
__device__ __forceinline__ void gdn_out_token(const MK& a, int row, int lane) {
    const float* op = a.goraw() + (size_t)row * 512 + 8 * lane;
    const float4 x0 = *(const float4*)op, x1 = *(const float4*)(op + 4);
    float o[8] = {x0.x, x0.y, x0.z, x0.w, x1.x, x1.y, x1.z, x1.w}, zg[8];
    bf8_to_f32(*(const bf16x8*)(a.Z() + (size_t)row * ZW + OFF_Z + 8 * lane), zg);
    float ss = 0.f;
#pragma unroll
    for (int e = 0; e < 8; ++e) ss += o[e] * o[e];
    ss = sum8(ss);
    const float rs = rsqrtf(ss * (1.f / 64.f) + EPSV);
    const float4 g0 = *(const float4*)(a.g_gdn_out + 8 * (lane & 7)), g1 = *(const float4*)(a.g_gdn_out + 8 * (lane & 7) + 4);
    const float gg_[8] = {g0.x, g0.y, g0.z, g0.w, g1.x, g1.y, g1.z, g1.w};
#pragma unroll
    for (int e = 0; e < 8; ++e) o[e] = o[e] * rs * gg_[e] * zg[e] * fast_sigmoid(zg[e]);
    *(bf16x8*)(a.omix() + (size_t)row * 1024 + 8 * lane) = f32_to_bf8(o);
}

#define SSLOT 32768
#define TL_OFF (3 * SSLOT)
#define CST 264
#define KR_OFF (TL_OFF + 2 * 32 * CST * 2)
#define WQ_OFF (KR_OFF + 4 * 4096)
#define QR_OFF (WQ_OFF + 2048)
#define PG_OFF (QR_OFF + 1024)
#define PT_OFF (PG_OFF + 64)
#define AL_OFF (PT_OFF + 1024)
#define SAMP_LDS_END (AL_OFF + 64)
__device__ __forceinline__ void samp_issue(const MK& a, int g, LAS unsigned char* lds, int wid, int lane) {
    const int phys = __builtin_amdgcn_readfirstlane(((const LAS int*)(lds + PG_OFF))[g >> 2]);
    const int tok0 = (g & 3) * 32 + 4 * wid;
    const float* cs = a.cache_ckv + ((size_t)phys * 128 + tok0) * 256 + lane * 4;
#pragma unroll
    for (int i = 0; i < 4; ++i) __builtin_amdgcn_global_load_lds((const unsigned*)(cs + i * 256), (LAS unsigned*)(lds + (g % 3) * SSLOT + (4 * wid + i) * 1024), 16, 0, 0);
    if (wid < 4) { const int tl = lane >> 3, cg = (lane & 7) ^ (((tl >> 1) & 1) | ((wid & 1) << 2));
        __builtin_amdgcn_global_load_lds((const unsigned*)(a.cache_krope + ((size_t)phys * 128 + (g & 3) * 32 + 8 * wid + tl) * 32 + cg * 4), (LAS unsigned*)(lds + KR_OFF + (g & 3) * 4096 + wid * 1024), 16, 0, 0); }
}
typedef unsigned u32x2 __attribute__((ext_vector_type(2)));
__device__ __forceinline__ void samp_convert(int g, LAS unsigned char* lds, int tid) {
    const int st = tid >> 4, l16 = tid & 15;
    const LAS float* src = (const LAS float*)(lds + (g % 3) * SSLOT) + st * 256 + 4 * l16;
    LAS bf16_t* dst = (LAS bf16_t*)(lds + TL_OFF + (g & 1) * 32 * CST * 2) + st * CST + 4 * l16;
    f32x4 x[4];
#pragma unroll
    for (int k = 0; k < 4; ++k) x[k] = *(const LAS f32x4*)(src + 64 * k);
#pragma unroll
    for (int k = 0; k < 4; ++k) { u32x2 w; w.x = cvtpk(x[k][0], x[k][1]); w.y = cvtpk(x[k][2], x[k][3]); *(LAS u32x2*)(dst + 64 * k) = w; }
}
#define SAMP_WAITV(n5, n4) do { if (h < 4) asm volatile("s_waitcnt vmcnt(" #n5 ")" ::: "memory"); else asm volatile("s_waitcnt vmcnt(" #n4 ")" ::: "memory"); } while (0)
#define SAMP_BAR() do { asm volatile("s_waitcnt lgkmcnt(0)" ::: "memory"); __builtin_amdgcn_s_barrier(); asm volatile("" ::: "memory"); } while (0)
__device__ __forceinline__ void samp_attn_unit(const MK& a, int u, char* smem, LAS unsigned char* lds) {
    const int tid = otid(), lane = tid & 63, h = __builtin_amdgcn_readfirstlane(tid >> 6), i16 = lane & 15, q4 = lane >> 4;
    const int b = u >> 3, sp = u & 7;
    float* WQ = (float*)(smem + WQ_OFF);
    float* QR = (float*)(smem + QR_OFF);
    int* PG = (int*)(smem + PG_OFF);
    const float SCL = 0.14724445f;
    post_q_item(a, (NPT + b) * 8 + h, lane);
    __syncthreads();
    {
        const int h_ = tid >> 6, l_ = tid & 63, q4_ = l_ >> 4, idx = l_ & 15, d = 16 * (idx >> 2) + 4 * q4_ + (idx & 3);
        WQ[tid] = a.g_k_nope[d] * a.qh()[((size_t)(NPT + b) * 8 + h_) * 96 + d] * SCL;
        if (tid < 256) QR[tid] = a.qh()[((size_t)(NPT + b) * 8 + (tid >> 5)) * 96 + 64 + (tid & 31)] * SCL;
        if (tid < 16) PG[tid] = a.page_table[b * NPAGES + sp * 16 + tid];
    }
    bf16x8 wf[4][8];
#pragma unroll
    for (int mt = 0; mt < 4; ++mt)
#pragma unroll
        for (int ks = 0; ks < 8; ++ks) wf[mt][ks] = *(const bf16x8*)(a.WknT() + (size_t)(h * 64 + 16 * mt + i16) * 256 + 32 * ks + 8 * q4);
#pragma unroll
    for (int mt = 0; mt < 4; ++mt)
#pragma unroll
        for (int ks = 0; ks < 8; ++ks) asm volatile("" : "+v"(wf[mt][ks]));
    __syncthreads();
    samp_issue(a, 0, lds, h, lane); samp_issue(a, 1, lds, h, lane); samp_issue(a, 2, lds, h, lane);
    SAMP_WAITV(10, 8);
    SAMP_BAR();
    samp_convert(0, lds, tid);
    const LAS float* QRl = (const LAS float*)(lds + QR_OFF) + h * 32 + 8 * q4;
    const LAS float* WQl = (const LAS float*)(lds + WQ_OFF) + (h * 4 + q4) * 16;
    f32x4 wqr[4], qrr[2];
#pragma unroll
    for (int mt = 0; mt < 4; ++mt) wqr[mt] = *(const LAS f32x4*)(WQl + 4 * mt);
    qrr[0] = *(const LAS f32x4*)QRl; qrr[1] = *(const LAS f32x4*)(QRl + 4);
    float m = -INFINITY, lsum = 0.f;
    f32x4 latv[2]; latv[0] = (f32x4){0.f, 0.f, 0.f, 0.f}; latv[1] = (f32x4){0.f, 0.f, 0.f, 0.f};
    for (int g = 0; g < 64; ++g) {
        SAMP_BAR();
        if (g + 3 < 64) samp_issue(a, g + 3, lds, h, lane);
        const LAS bf16_t* Tl = (const LAS bf16_t*)(lds + TL_OFF + (g & 1) * 32 * CST * 2); const LAS float* KR = (const LAS float*)(lds + KR_OFF + (g & 3) * 4096);
        float scv;
        {
            float ssp[2], dotp[2], rdp[2];
            f32x4 acc[2][4];
#pragma unroll
            for (int hf = 0; hf < 2; ++hf)
#pragma unroll
                for (int mt = 0; mt < 4; ++mt) acc[hf][mt] = (f32x4){0.f, 0.f, 0.f, 0.f};
            const LAS bf16_t* cp0 = Tl + i16 * CST + 8 * q4; const LAS bf16_t* cp1 = cp0 + 16 * CST;
            bf16x8 c0 = *(const LAS bf16x8*)cp0, c1 = *(const LAS bf16x8*)cp1;
#pragma unroll
            for (int ks = 0; ks < 8; ++ks) {
                bf16x8 n0 = c0, n1 = c1;
                if (ks < 7) { n0 = *(const LAS bf16x8*)(cp0 + 32 * (ks + 1)); n1 = *(const LAS bf16x8*)(cp1 + 32 * (ks + 1)); }
#pragma unroll
                for (int mt = 0; mt < 4; ++mt) { acc[0][mt] = __builtin_amdgcn_mfma_f32_16x16x32_bf16(wf[mt][ks], c0, acc[0][mt], 0, 0, 0); acc[1][mt] = __builtin_amdgcn_mfma_f32_16x16x32_bf16(wf[mt][ks], c1, acc[1][mt], 0, 0, 0); }
                c0 = n0; c1 = n1;
            }
#pragma unroll
            for (int hf = 0; hf < 2; ++hf) {
                f32x2_t ss2 = {0.f, 0.f}, dot2 = {0.f, 0.f}, rd2 = {0.f, 0.f};
#pragma unroll
                for (int mt = 0; mt < 4; ++mt) {
                    const f32x4 wq = wqr[mt];
                    const f32x4 av = acc[hf][mt];
                    const f32x2_t lo = __builtin_shufflevector(av, av, 0, 1), hi = __builtin_shufflevector(av, av, 2, 3);
                    ss2 = __builtin_elementwise_fma(lo, lo, ss2); ss2 = __builtin_elementwise_fma(hi, hi, ss2);
                    dot2 = __builtin_elementwise_fma(lo, __builtin_shufflevector(wq, wq, 0, 1), dot2); dot2 = __builtin_elementwise_fma(hi, __builtin_shufflevector(wq, wq, 2, 3), dot2);
                }
                {
                    const int kc = (2 * q4) ^ ((i16 >> 1) & 5);
                    const LAS float* kp = KR + (16 * hf + i16) * 32;
                    const f32x4 k0 = *(const LAS f32x4*)(kp + 4 * kc), k1 = *(const LAS f32x4*)(kp + 4 * (kc ^ 1)), q0 = qrr[0], q1 = qrr[1];
                    rd2 = __builtin_elementwise_fma(__builtin_shufflevector(k0, k0, 0, 1), __builtin_shufflevector(q0, q0, 0, 1), rd2); rd2 = __builtin_elementwise_fma(__builtin_shufflevector(k0, k0, 2, 3), __builtin_shufflevector(q0, q0, 2, 3), rd2);
                    rd2 = __builtin_elementwise_fma(__builtin_shufflevector(k1, k1, 0, 1), __builtin_shufflevector(q1, q1, 0, 1), rd2); rd2 = __builtin_elementwise_fma(__builtin_shufflevector(k1, k1, 2, 3), __builtin_shufflevector(q1, q1, 2, 3), rd2);
                }
                ssp[hf] = ss2[0] + ss2[1]; dotp[hf] = dot2[0] + dot2[1]; rdp[hf] = rd2[0] + rd2[1];
            }
            const auto s1 = __builtin_amdgcn_permlane16_swap(__float_as_uint(ssp[0]), __float_as_uint(ssp[1]), false, false);
            const auto s2 = __builtin_amdgcn_permlane16_swap(__float_as_uint(dotp[0]), __float_as_uint(dotp[1]), false, false);
            const auto s3 = __builtin_amdgcn_permlane16_swap(__float_as_uint(rdp[0]), __float_as_uint(rdp[1]), false, false);
            const float u1 = __uint_as_float(s1[0]) + __uint_as_float(s1[1]), u2 = __uint_as_float(s2[0]) + __uint_as_float(s2[1]), u3 = __uint_as_float(s3[0]) + __uint_as_float(s3[1]);
            const auto t1 = __builtin_amdgcn_permlane32_swap(__float_as_uint(u1), __float_as_uint(u2), false, false);
            const float t = __uint_as_float(t1[0]) + __uint_as_float(t1[1]);
            const auto t2 = __builtin_amdgcn_permlane32_swap(__float_as_uint(t), __float_as_uint(t), false, false);
            const float ssv = __uint_as_float(t2[0]), dotv = __uint_as_float(t2[1]);
            const float rdv = add_x32(u3);
            scv = dotv * rsqrtf(ssv * (1.f / 64.f) + EPSV) + rdv;
        }
        float gm = max16(scv);
        { const auto r = __builtin_amdgcn_permlane16_swap(__float_as_uint(gm), __float_as_uint(gm), false, false); gm = fmaxf(__uint_as_float(r[0]), __uint_as_float(r[1])); }
        const float mn = fmaxf(m, gm);
        const float alpha = __builtin_amdgcn_exp2f(m - mn), pv = __builtin_amdgcn_exp2f(scv - mn);
        m = mn;
        lsum = lsum * alpha + pv;
        if (q4 < 2) { ((LAS float*)(lds + PT_OFF))[h * 32 + lane] = pv; if (lane == 0) ((LAS float*)(lds + AL_OFF))[h] = alpha; }
        if (g <= 60) SAMP_WAITV(10, 8); else if (g == 61) SAMP_WAITV(5, 4); else SAMP_WAITV(0, 0);
        SAMP_BAR();
        {
            u32x4 pw = {0u, 0u, 0u, 0u};
            if (i16 < 8) { const f32x4 pa = *(const LAS f32x4*)(lds + PT_OFF + (i16 * 32 + 8 * q4) * 4), pb_ = *(const LAS f32x4*)(lds + PT_OFF + (i16 * 32 + 8 * q4 + 4) * 4);
                pw.x = cvtpk(pa[0], pa[1]); pw.y = cvtpk(pa[2], pa[3]); pw.z = cvtpk(pb_[0], pb_[1]); pw.w = cvtpk(pb_[2], pb_[3]); }
            const bf16x8 pfr = __builtin_bit_cast(bf16x8, pw);
            const f32x4 al = *(const LAS f32x4*)(lds + AL_OFF + (q4 & 1) * 16);
            const unsigned tb0 = (unsigned)(size_t)((const LAS bf16_t*)(lds + TL_OFF + (g & 1) * 32 * CST * 2) + (8 * q4 + (i16 >> 2)) * CST + 32 * h + 4 * (i16 & 3));
            s16x4 c0[2], c1[2];
            static_assert(4 * CST * 2 == 2112, "tr offsets");
            asm volatile("ds_read_b64_tr_b16 %0, %4\n\tds_read_b64_tr_b16 %1, %4 offset:2112\n\tds_read_b64_tr_b16 %2, %4 offset:32\n\tds_read_b64_tr_b16 %3, %4 offset:2144\n\ts_waitcnt lgkmcnt(0)"
                         : "=&v"(c0[0]), "=&v"(c1[0]), "=&v"(c0[1]), "=&v"(c1[1]) : "v"(tb0) : "memory");
#pragma unroll
            for (int nt = 0; nt < 2; ++nt) {
                const bf16x8 cfr = __builtin_shufflevector(c0[nt], c1[nt], 0, 1, 2, 3, 4, 5, 6, 7);
                latv[nt] = latv[nt] * al;
                latv[nt] = __builtin_amdgcn_mfma_f32_16x16x32_bf16(pfr, cfr, latv[nt], 0, 0, 0);
            }
        }
        if (g + 1 < 64) samp_convert(g + 1, lds, tid);
    }
    lsum = add_x16(sum16(lsum));
    if (lane == 0) { float* o = a.part() + ((size_t)u * 8 + h) * 260; o[0] = m * 0.69314718f; o[1] = lsum; }
    if (q4 < 2) {
#pragma unroll
        for (int nt = 0; nt < 2; ++nt)
#pragma unroll
            for (int r = 0; r < 4; ++r) a.part()[((size_t)u * 8 + 4 * q4 + r) * 260 + 4 + 32 * h + 16 * nt + i16] = latv[nt][r];
    }
}
__device__ __forceinline__ void samp_comb_unit(const MK& a, int u, char* smem) {
    float* slat = (float*)smem; float* red = slat + 256;
    const int b = u >> 3, h = u & 7, tid = otid(), lane = tid & 63, wid = tid >> 6;
    const size_t row = NPT + b;
    const float* q = a.qh() + (row * 8 + h) * 96;
    float sp = q[lane] * a.kh()[(row * 8 + h) * 64 + lane];
    if (lane < 32) sp += q[64 + lane] * a.krf()[row * 32 + lane];
    const float s_self = wave_sum(sp) * 0.10206207261596577f;
    float pm[8], m = s_self;
#pragma unroll
    for (int s = 0; s < 8; ++s) { pm[s] = a.part()[((size_t)(b * 8 + s) * 8 + h) * 260]; m = fmaxf(m, pm[s]); }
    const float pself = __expf(s_self - m);
    float l = pself, lat = 0.f;
    __syncthreads();
#pragma unroll
    for (int s = 0; s < 8; ++s) {
        const float* p = a.part() + ((size_t)(b * 8 + s) * 8 + h) * 260;
        const float w = __expf(pm[s] - m);
        l += p[1] * w; if (tid < 256) lat += p[4 + tid] * w;
    }
    if (tid < 256) slat[tid] = lat;
    __syncthreads();
    {
        const float* wv = a.w_kv_b + (size_t)(32 * wid) * 1024 + h * 128 + 64 + lane;
        float o = 0.f;
#pragma unroll 8
        for (int c = 0; c < 32; ++c) o += slat[32 * wid + c] * wv[(size_t)c * 1024];
        red[wid * 64 + lane] = o;
    }
    __syncthreads();
    if (tid < 64) {
        float o = pself * a.KV()[row * 1024 + h * 128 + 64 + tid];
#pragma unroll
        for (int w = 0; w < 8; ++w) o += red[w * 64 + tid];
        a.omix()[row * 1024 + 512 + h * 64 + tid] = f2bf(o / l);
    }
}

#define XB_TMO      128
#define XB_XCNT(j)  (256  + 64 * (j))
#define XB_XSUB(j)  (1280 + 64 * (j))
#define XB_XGEN(j)  (2304 + 64 * (j))
#define XB_TOP      3328
#define XB_TOPGEN   3392
#define XCD_BAR_WORDS 3456
#define XB_SPIN_CAP (1u << 18)

__device__ __forceinline__ unsigned xb_ld(unsigned* p)              { return __hip_atomic_load(p, __ATOMIC_RELAXED, __HIP_MEMORY_SCOPE_AGENT); }
__device__ __forceinline__ unsigned xb_add(unsigned* p, unsigned v) { return __hip_atomic_fetch_add(p, v, __ATOMIC_RELAXED, __HIP_MEMORY_SCOPE_AGENT); }
__device__ __forceinline__ unsigned xb_xcc_id() { return (unsigned)__builtin_amdgcn_s_getreg((3 << 11) | 20) & 0xFu; }
#define XB_SPIN(cond, bar) do { unsigned _sp = 0; while (cond) { __builtin_amdgcn_s_sleep(1); \
    if ((++_sp & 255u) == 0u) { if (xb_ld(&(bar)[XB_TMO])) break; if (_sp > XB_SPIN_CAP) { atomicAdd(&(bar)[XB_TMO], 1u); break; } } } } while (0)

struct XcdBarrier {
    unsigned* bar; unsigned x;
    volatile LAS unsigned* st;
};

__device__ __forceinline__ XcdBarrier xcd_barrier_post(unsigned* bar, volatile LAS unsigned* st) {
    XcdBarrier b; b.bar = bar; b.x = xb_xcc_id(); b.st = st;
    if (threadIdx.x == 0) (void)xb_add(&bar[XB_XCNT(b.x)], 1u);
    return b;
}
__device__ __forceinline__ void xcd_barrier_complete(unsigned* bar, unsigned x, unsigned& nloc, unsigned& nx) {
    const unsigned G = gridDim.x * gridDim.y * gridDim.z;
    unsigned sum, cnt, mine, sp = 0u;
    for (;;) {
        sum = 0u; cnt = 0u; mine = 0u;
#pragma unroll
        for (unsigned j = 0; j < 16; ++j) { const unsigned c = xb_ld(&bar[XB_XCNT(j)]); sum += c; cnt += (c > 0u) ? 1u : 0u; mine = (j == x) ? c : mine; }
        if (sum == G) break;
        __builtin_amdgcn_s_sleep(1);
        if ((++sp & 255u) == 0u) { if (xb_ld(&bar[XB_TMO])) break; if (sp > XB_SPIN_CAP) { atomicAdd(&bar[XB_TMO], 1u); break; } }
    }
    nloc = mine > 0u ? mine : 1u; nx = cnt > 0u ? cnt : 1u;
}

__device__ __forceinline__ void xcd_barrier(const XcdBarrier& b) {
    asm volatile("s_waitcnt vmcnt(0)" ::: "memory");
    __syncthreads();
    if (threadIdx.x == 0) {
        unsigned* bar = b.bar;
        __builtin_amdgcn_s_waitcnt(0);
        unsigned nloc = b.st[0], nx = b.st[1];
        if (nloc == 0u) { xcd_barrier_complete(bar, b.x, nloc, nx); b.st[0] = nloc; b.st[1] = nx; }
        const unsigned old = xb_add(&bar[XB_XSUB(b.x)], 1u);
        const unsigned gen = old / nloc;
        if (old + 1u == (gen + 1u) * nloc) {
            __builtin_amdgcn_fence(__ATOMIC_RELEASE, "agent");
            asm volatile("s_waitcnt vmcnt(0)" ::: "memory");
            const unsigned og = xb_add(&bar[XB_TOP], 1u);
            const unsigned tg = og / nx;
            if (og + 1u == (tg + 1u) * nx) xb_add(&bar[XB_TOPGEN], 1u);
            else XB_SPIN(xb_ld(&bar[XB_TOPGEN]) == tg, bar);
            __builtin_amdgcn_fence(__ATOMIC_ACQUIRE, "agent");
            xb_add(&bar[XB_XGEN(b.x)], 1u);
            asm volatile("s_waitcnt vmcnt(0)" ::: "memory");
        } else {
            XB_SPIN(xb_ld(&bar[XB_XGEN(b.x)]) == gen, bar);
            __builtin_amdgcn_fence(__ATOMIC_ACQUIRE, "agent");
            asm volatile("s_waitcnt vmcnt(0)" ::: "memory");
        }
    }
    __syncthreads();
}

__device__ __forceinline__ void late_weight_items(const MK& a, int gwl, int ngwl, float* scr, int lane) {
    const int T4 = 32 * 16, T5 = 176 * 16, T7 = 32 * 44, T8 = 32 * 16, TT = T4 + T5 + T7 + T8;
    for (int it = gwl; it < TT; it += ngwl) {
        int r = it;
        if (r < T4) { const int nt_ = r % 32, kb = r / 32; wt_item(a.w_o, 1024, 32 * nt_, 32, a.WoT(), 1024, 32 * nt_, 64 * kb, scr, lane); continue; } r -= T4;
        if (r < T5) { const int nt_ = r % 176, kb = r / 176, pn = nt_ >> 3, wi = nt_ & 7;
            wt_item(wi < 4 ? a.w_gate : a.w_up, DFF, pn * 128 + (wi & 3) * 32, 32, a.WguT(), 1024, 32 * nt_, 64 * kb, scr, lane); continue; } r -= T5;
        if (r < T7) { const int nt_ = r % 32, kb = r / 32; wt_item(a.w_down, 1024, 32 * nt_, 32, a.WdT(), DFF, 32 * nt_, 64 * kb, scr, lane); continue; } r -= T7;
        { const int nt_ = r % 32, kb = r / 32; wt_item(a.w_ple_gate, 1024, 32 * nt_, 32, a.WpgT(), 1024, 32 * nt_, 64 * kb, scr, lane); }
    }
}

#define XB_ST_OFF 155648
#define LDS_BYTES 155904
static_assert(SAMP_LDS_END <= LDS_BYTES, "LDS map");
#define GSYNC() do { xcd_barrier(xbar); } while (0)
__global__ __launch_bounds__(NTHR, 2) void mega(MK a) {
    cg::grid_group grid = cg::this_grid();
    char* smem = (char*)lds_raw;
    LAS unsigned char* lds = (LAS unsigned char*)lds_raw;
    otid_init();
    if (threadIdx.x < 2) ((LAS unsigned*)(lds_raw + XB_ST_OFF))[threadIdx.x] = 0u;
    __syncthreads();
    const XcdBarrier xbar = xcd_barrier_post(a.ctl(), (volatile LAS unsigned*)(LAS void*)(lds_raw + XB_ST_OFF));
    const int bid = blockIdx.x, nb = gridDim.x, ngw = nb * NWAVE;
#define LOCAL_IDS const int tid = otid(), lane = tid & 63, wid = tid >> 6, half = tid >> 8, gw = bid * NWAVE + wid; (void)lane; (void)half; (void)gw; (void)wid;

    {
    LOCAL_IDS
    {
        const int T0 = 88 * 16, T1 = 24 * 6, T2 = 32 * 4, T3 = 16 * 4, T9 = 32 * 4;
        const int TT = T0 + T1 + T2 + T3 + T9;
        float* scr = (float*)(smem + wid * 8704);
        for (int it = gw; it < TT; it += ngw) {
            int r = it;
            if (r < T0) { const int nt_ = r % 88, kb = r / 88, nv = 2736 - 32 * nt_; wt_item(a.w_in, 2736, 32 * nt_, nv < 0 ? 0 : (nv > 32 ? 32 : nv), a.WinT(), 1024, 32 * nt_, 64 * kb, scr, lane); continue; } r -= T0;
            if (r < T1) { const int nt_ = r % 24, kb = r / 24; wt_item(a.w_q_b, 768, 32 * nt_, 32, a.WqbT(), 384, 32 * nt_, 64 * kb, scr, lane); continue; } r -= T1;
            if (r < T2) { const int nt_ = r % 32, kb = r / 32; wt_item(a.w_kv_b, 1024, 32 * nt_, 32, a.WkvT(), 256, 32 * nt_, 64 * kb, scr, lane); continue; } r -= T2;
            if (r < T3) { const int nt_ = r % 16, kb = r / 16, h = nt_ >> 1; wt_item(a.w_kv_b, 1024, h * 128 + 32 * (nt_ & 1), 32, a.WknT(), 256, 32 * nt_, 64 * kb, scr, lane); continue; } r -= T3;
            { const int nt_ = r % 32, kb = r / 32; wt_item(a.w_ple_proj, 1024, 32 * nt_, 32, a.WppT(), 256, 32 * nt_, 64 * kb, scr, lane); }
        }
        for (int e = (bid * NTHR + tid); e < 2049 * 16; e += nb * NTHR) {
            const int pos = e >> 4, i = e & 15; const float ang = (pos == 2048 ? (float)PAST : (float)pos) * powf(10000.f, -(float)i / 16.f);
            a.ropecs()[pos * 32 + i] = cosf(ang); a.ropecs()[pos * 32 + 16 + i] = sinf(ang);
        }
        for (int row = gw; row < MPAD; row += ngw) {
            const float* src = row < NPT ? a.x_prompt + (size_t)row * 1024 : a.x_sample + (size_t)(row < NTOK ? row - NPT : 0) * 1024;
            rms1024_row(src, a.g_attn, a.xn() + (size_t)row * 1024, row >= NTOK, lane);
            ushort4 w = {0, 0, 0, 0};
            if (row < NTOK) { const float* ps = row < NPT ? a.p_prompt + (size_t)row * 256 : a.p_sample + (size_t)(row - NPT) * 256; const float4 v = *(const float4*)(ps + lane * 4); w.x = f2bf(v.x); w.y = f2bf(v.y); w.z = f2bf(v.z); w.w = f2bf(v.w); }
            *(ushort4*)(a.pb() + (size_t)row * 256 + lane * 4) = w;
            if (row >= NTOK) { for (int j = 0; j < 4; ++j) { ushort4 z = {0, 0, 0, 0}; *(ushort4*)(a.omix() + (size_t)row * 1024 + lane * 4 + 256 * j) = z; } }
        }
    }
    }
    if (a.out == nullptr) grid.sync();
    GSYNC();
    {
    LOCAL_IDS
    pg_gemm(lds, a.xn(), a.WinT(), NPT, ZW, 1024, PgBf16{a.Z(), ZW});
    gemm_sample_rows_ks<false>(a.xn(), 1024, a.WinT(), 1024, ZW, EwBf16{a.Z(), ZW}, smem, bid, nb);
    }
    GSYNC();
    {
    LOCAL_IDS
    for (int e = tid; e < 4 * 1536 / 4; e += NTHR) ((float4*)smem)[e] = ((const float4*)a.w_conv)[e];
    __syncthreads();
    for (int run = gw; run < NPT / 8 + NST; run += ngw) post_in_run(a, run, lane, (const float*)smem);
    }
    GSYNC();
    {
    LOCAL_IDS
    for (int u = gw; u < 2048; u += ngw) gdn_prep_unit(a, u, lane, smem + wid * GDN_WLDS);
    }
    {
    LOCAL_IDS
    for (int v = gw; v < NST * 64; v += ngw) gdn_unit(a, v >> 6, (v >> 3) & 7, v & 7, a.state_gdn, a.out + O_GSS, NPT, 1, lane, smem + wid * GDN_WLDS);
    __syncthreads();
    }
    GSYNC();
    {
    LOCAL_IDS
    pg_gemm(lds, a.qan(), a.WqbT(), NPT, 768, 384, PgBf16{a.qraw(), 768});
    pg_gemm(lds, a.ckvb(), a.WkvT(), NPT, 1024, 256, PgBf16{a.kvraw(), 1024}, nb > 64 ? nb - 64 : 0);
    gemm_sample_rows<false>(a.qan(), 384, a.WqbT(), 384, 768, EwF32{a.Q(), 768}, smem, bid, nb, 64);
    gemm_sample_rows<false>(a.ckvb(), 256, a.WkvT(), 256, 1024, EwF32{a.KV(), 1024}, smem, bid, nb, 72);
    for (int bh_ = nb - 1 - bid; bh_ < 64; bh_ += nb) gdn_scan_block(a, bh_, lds);
    if (nb > 64 && bid < nb - 64) {
        pg_gemm(lds, a.pb(), a.WppT(), NPT, 1024, 256, PgBf16{a.PP(), 1024}, nb - 64);
        __syncthreads();
        late_weight_items(a, bid * NWAVE + wid, (nb - 64) * NWAVE, (float*)(smem + wid * 8704), lane);
    } else if (nb <= 64) { pg_gemm(lds, a.pb(), a.WppT(), NPT, 1024, 256, PgBf16{a.PP(), 1024}); __syncthreads(); late_weight_items(a, gw, ngw, (float*)(smem + wid * 8704), lane); }
    gemm_sample_rows<false>(a.pb(), 256, a.WppT(), 256, 1024, EwBf16{a.PP(), 1024}, smem, bid, nb, 80);
    }
    GSYNC();
    {
    LOCAL_IDS
    for (int idx = gw; idx < NST * 8; idx += ngw) { post_q_item(a, NPT * 8 + idx, lane); post_kv_item(a, NPT * 8 + idx, lane); }
    for (int row = gw; row < NTOK; row += ngw) gdn_out_token(a, row, lane);
    for (int pr = bid; pr < 256; pr += nb) { const int bh_ = pr >> 2, s_ = pr & 3; attn_block(a, bh_ >> 3, bh_ & 7, 7 - s_, smem); attn_block(a, bh_ >> 3, bh_ & 7, s_, smem); }
    for (int u = bid; u < NST * 8; u += nb) samp_attn_unit(a, u, smem, lds);
    }
    GSYNC();
    {
    LOCAL_IDS
    for (int u = bid; u < NST * 8; u += nb) samp_comb_unit(a, u, smem);
    }
    GSYNC();
    {
    LOCAL_IDS
    pg_gemm(lds, a.omix(), a.WoT(), NPT, 1024, 1024, PgResXB{a.x_prompt, a.H()});
    gemm_sample_rows_ks<false, EwResX, 1>(a.omix(), 1024, a.WoT(), 1024, 1024, EwResX{a.x_sample, a.H()}, smem, bid, nb);
    }
    GSYNC();
    {
    LOCAL_IDS
    for (int row = gw; row < MPAD; row += ngw) rms1024_row_b(a.H() + (size_t)row * 1024, a.g_ffn, a.un() + (size_t)row * 1024, row >= NTOK, lane);
    }
    GSYNC();
    {
    LOCAL_IDS
    pg_gemm(lds, a.un(), a.WguT(), NPT, 2 * DFF, 1024, PgSwiglu{a.hid()});
    gemm_sample_rows_ks<true>(a.un(), 1024, a.WguT(), 1024, 2 * DFF, EwBf16{a.hid(), DFF}, smem, bid, nb);
    }
    GSYNC();
    {
    LOCAL_IDS
    pg_gemm(lds, a.hid(), a.WdT(), NPT, 1024, DFF, PgResBB{a.H(), a.H2()});
    gemm_sample_rows_ks<false, EwResH, 1>(a.hid(), DFF, a.WdT(), DFF, 1024, EwResH{a.H(), a.H2()}, smem, bid, nb);
    }
    GSYNC();
    {
    LOCAL_IDS
    for (int row = gw; row < MPAD; row += ngw) rms1024_row_b(a.H2() + (size_t)row * 1024, a.g_ple, a.un2() + (size_t)row * 1024, row >= NTOK, lane);
    }
    GSYNC();
    {
    LOCAL_IDS
    pg_gemm(lds, a.un2(), a.WpgT(), NPT, 1024, 1024, PgPleB{a.H2(), a.PP(), a.out});
    gemm_sample_rows_ks<false, EwPle, 1>(a.un2(), 1024, a.WpgT(), 1024, 1024, EwPle{a.H2(), a.PP(), a.out}, smem, bid, nb);
    }
}

static inline char* carve(char*& p, size_t bytes) { char* r = p; p += (bytes + 255) & ~(size_t)255; return r; }

extern "C" void kernel_launch(void* const* d_in, const int* in_sizes, int n_in, void* d_out, int out_size, void* d_ws, size_t ws_size, hipStream_t stream) {
    MK a{};
    a.x_prompt = (const float*)d_in[0]; a.x_sample = (const float*)d_in[1]; a.cache_ckv = (const float*)d_in[2]; a.cache_krope = (const float*)d_in[3];
    a.state_gdn = (const float*)d_in[4]; a.state_conv = (const float*)d_in[5]; a.page_table = (const int*)d_in[6]; a.p_prompt = (const float*)d_in[7]; a.p_sample = (const float*)d_in[8];
    a.g_attn = (const float*)d_in[9]; a.w_in = (const float*)d_in[10]; a.w_conv = (const float*)d_in[11]; a.a_log = (const float*)d_in[12]; a.dt_bias = (const float*)d_in[13];
    a.g_gdn_out = (const float*)d_in[14]; a.g_q_a = (const float*)d_in[15]; a.w_q_b = (const float*)d_in[16]; a.g_q_nope = (const float*)d_in[17]; a.g_q_rope = (const float*)d_in[18];
    a.g_kv_a = (const float*)d_in[19]; a.g_k_rope = (const float*)d_in[20]; a.w_kv_b = (const float*)d_in[21]; a.g_k_nope = (const float*)d_in[22]; a.w_o = (const float*)d_in[23];
    a.g_ffn = (const float*)d_in[24]; a.w_gate = (const float*)d_in[25]; a.w_up = (const float*)d_in[26]; a.w_down = (const float*)d_in[27]; a.g_ple = (const float*)d_in[28];
    a.w_ple_gate = (const float*)d_in[29]; a.w_ple_proj = (const float*)d_in[30];
    a.out = (float*)d_out;
    a.ws = (char*)d_ws;
    if (WS_TOTAL > ws_size) { fprintf(stderr, "kernel_launch: workspace too small: need %zu have %zu\n", (size_t)WS_TOTAL, ws_size); return; }

    static int grid_blocks = 0;
    if (!grid_blocks) {
        int dev = 0, cus = 0, per_cu = 0;
        (void)hipGetDevice(&dev);
        (void)hipDeviceGetAttribute(&cus, hipDeviceAttributeMultiprocessorCount, dev);
        (void)hipFuncSetAttribute((const void*)mega, hipFuncAttributeMaxDynamicSharedMemorySize, LDS_BYTES);
        (void)hipOccupancyMaxActiveBlocksPerMultiprocessor(&per_cu, (const void*)mega, NTHR, LDS_BYTES);
        if (per_cu < 1) fprintf(stderr, "kernel_launch: occupancy query says %d blocks/CU\n", per_cu);
        grid_blocks = cus;
    }
    (void)hipMemsetAsync((char*)d_ws + WOF_ctl, 0, 16384, stream);
    void* args[] = {&a};
    hipError_t e = hipLaunchCooperativeKernel((const void*)mega, dim3(grid_blocks), dim3(NTHR), args, LDS_BYTES, stream);
    if (e != hipSuccess) fprintf(stderr, "cooperative launch failed: %s (grid %d)\n", hipGetErrorString(e), grid_blocks);
}
```

```cpp
#include <hip/hip_runtime.h>
#include <stdint.h>
#include <cstdio>
#include <hip/hip_cooperative_groups.h>
namespace cg = cooperative_groups;


__device__ __forceinline__ int otid();
#define PG8_TID() otid()
namespace pg8 {
#define PG8_LAS __attribute__((address_space(3)))
typedef unsigned short bf16_t;
typedef short bf16x8 __attribute__((ext_vector_type(8)));
typedef float f32x4 __attribute__((ext_vector_type(4)));
typedef unsigned u32x4 __attribute__((ext_vector_type(4)));
constexpr int BM = 256, BK = 64, HALF = 128, HTB = HALF * BK * 2  , STAGE_BYTES = 8 * HTB, NXCD = 8, WGM = 8;

__host__ __device__ __forceinline__ int lds_byte(int r, int c) { const int st = (r >> 4) * 2 + (c >> 5), rr = r & 15, cc = c & 31, ob = rr * 64 + cc * 2; return st * 1024 + (ob ^ (((ob >> 9) & 1) << 5)); }
__host__ __device__ __forceinline__ void stage_rc(int b, int& R, int& C) { const int st = b / 1024, sb = b % 1024, swz = sb ^ (((sb >> 9) & 1) << 5); R = (st >> 1) * 16 + swz / 64; C = (st & 1) * 32 + (swz % 64) / 2; }
__host__ __device__ __forceinline__ int perm32(int rho) { const int n = rho >> 4, i = rho & 15; return 8 * (i >> 2) + 4 * n + (i & 3); }

struct Unit { int pm, pn; };
struct Gemm { const bf16_t* A; const bf16_t* Bt; int M, N, K; };

struct StaticOrder {
    int nM, nN, nwg, G, c;
    __host__ __device__ void init(int M, int N, int G_, int c_) { nM = M / BM; nN = N / BM; nwg = nM * nN; G = G_; c = c_; }
    __host__ __device__ bool next(int i, Unit& u) const {
        const long L = (long)i * G + c; if (L >= nwg) return false;
        int wgid = (int)L; { const int q = nwg / NXCD, r = nwg % NXCD, xcd = wgid % NXCD, off = wgid / NXCD; wgid = (xcd < r ? xcd * (q + 1) : r * (q + 1) + (xcd - r) * q) + off; }
        const int nig = WGM * nN, gid = wgid / nig, fm = gid * WGM, gsz = (nM - fm) < WGM ? (nM - fm) : WGM;
        u.pm = fm + ((wgid % nig) % gsz); u.pn = (wgid % nig) / gsz; return true;
    }
    __device__ __forceinline__ void a_ready(const Unit&) const {}
    __device__ __forceinline__ void done(const Unit&) const {}
};

template <class Epi, class Sched, bool ALIGN_EPI = false, bool SP2 = false>
__device__ __forceinline__ void gemm_phase(PG8_LAS unsigned char* lds, const Gemm g, const Sched& S, const Epi& E) {
    const int tid = PG8_TID(), wid = __builtin_amdgcn_readfirstlane(tid >> 6), lane = tid & 63, wr = wid >> 2, wc = wid & 3, fr = lane & 15, fq = lane >> 4;
    const int K = g.K, nt = K / BK;
    unsigned voffA[2], voffB[2];
#pragma unroll
    for (int i = 0; i < 2; ++i) { int R, C; stage_rc(tid * 16 + i * 8192, R, C); const int Rb = Epi::PERM ? ((R & ~31) + perm32(R & 31)) : R;
        voffA[i] = (unsigned)(R * K + C) * 2u; voffB[i] = (unsigned)(Rb * K + C) * 2u; }
    const size_t kstep = (size_t)(BK * 2);
    const size_t hstep = (size_t)HALF * K * 2;
    const size_t tstep = 2 * hstep;
    const unsigned ldsw = (unsigned)wid * 1024u;
    const int aoff = lds_byte(wr * 64 + fr, fq * 8), boff = lds_byte(wc * 32 + fr, fq * 8);
#define PG8_SA(b, h) (((b) * 2 + (h)) * HTB)
#define PG8_SB(b, h) ((4 + (b) * 2 + (h)) * HTB)
#define PG8_STAGE(bufoff, gbase, voff) do { _Pragma("unroll") for (int _i = 0; _i < 2; ++_i) \
        __builtin_amdgcn_global_load_lds((const unsigned*)((const char*)(gbase) + (voff)[_i]), (PG8_LAS unsigned*)(lds + (bufoff) + ldsw + _i * 8192), 16, 0, 0); } while (0)
#define PG8_LDA(dst, b, h) do { _Pragma("unroll") for (int m = 0; m < 4; ++m) _Pragma("unroll") for (int k = 0; k < 2; ++k) dst[m][k] = *(const PG8_LAS bf16x8*)(lds + PG8_SA(b, h) + aoff + m * 2048 + k * 1024); } while (0)
#define PG8_LDB(dst, b, h) do { _Pragma("unroll") for (int n = 0; n < 2; ++n) _Pragma("unroll") for (int k = 0; k < 2; ++k) dst[n][k] = *(const PG8_LAS bf16x8*)(lds + PG8_SB(b, h) + boff + n * 2048 + k * 1024); } while (0)
#define PG8_MMA(ai, bj, At, Bt) do { __builtin_amdgcn_s_setprio(1); _Pragma("unroll") for (int m = 0; m < 4; ++m) _Pragma("unroll") for (int n = 0; n < 2; ++n) _Pragma("unroll") for (int k = 0; k < 2; ++k) \
        acc[ai][bj][m][n] = __builtin_amdgcn_mfma_f32_16x16x32_bf16(Bt[n][k], At[m][k], acc[ai][bj][m][n], 0, 0, 0); __builtin_amdgcn_s_setprio(0); } while (0)
#define PG8_WAIT_V(n) asm volatile("s_waitcnt vmcnt(" #n ")" ::: "memory")
#define PG8_WAIT_L(n) asm volatile("s_waitcnt lgkmcnt(" #n ")" ::: "memory")
#define PG8_BAR __builtin_amdgcn_s_barrier()
#define PG8_SCHED __builtin_amdgcn_sched_barrier(0)
    Unit cur, nxt; int ui = 0;
    if (!S.next(0, cur)) return;
    f32x4 acc[2][2][4][2];
#pragma unroll
    for (int a = 0; a < 2; ++a)
#pragma unroll
        for (int b = 0; b < 2; ++b)
#pragma unroll
            for (int m = 0; m < 4; ++m)
#pragma unroll
                for (int n = 0; n < 2; ++n) acc[a][b][m][n] = (f32x4){0.f, 0.f, 0.f, 0.f};
    bf16x8 At[4][2], B0[2][2], B1[2][2];
    const char* cA = (const char*)g.A + (size_t)cur.pm * tstep; const char* cB = (const char*)g.Bt + (size_t)cur.pn * tstep;
    S.a_ready(cur);
    if constexpr (SP2) {
        PG8_STAGE(PG8_SB(0, 0), cB, voffB); PG8_STAGE(PG8_SB(0, 1), cB + hstep, voffB); PG8_STAGE(PG8_SA(0, 0), cA, voffA); PG8_STAGE(PG8_SA(0, 1), cA + hstep, voffA);
        if (wr == 1) PG8_BAR;
        PG8_WAIT_V(2); PG8_BAR;
        PG8_STAGE(PG8_SB(1, 0), cB + kstep, voffB); PG8_STAGE(PG8_SA(1, 0), cA + kstep, voffA); PG8_STAGE(PG8_SB(1, 1), cB + hstep + kstep, voffB);
        PG8_WAIT_V(6); PG8_BAR;
    } else {
        PG8_STAGE(PG8_SB(0, 0), cB, voffB); PG8_STAGE(PG8_SA(0, 0), cA, voffA); PG8_STAGE(PG8_SB(0, 1), cB + hstep, voffB); PG8_STAGE(PG8_SA(0, 1), cA + hstep, voffA);
        if (wr == 1) PG8_BAR;
        PG8_WAIT_V(4); PG8_BAR;
        PG8_STAGE(PG8_SB(1, 0), cB + kstep, voffB); PG8_STAGE(PG8_SA(1, 0), cA + kstep, voffA); PG8_STAGE(PG8_SB(1, 1), cB + hstep + kstep, voffB);
        PG8_WAIT_V(6); PG8_BAR;
    }
    for (;;) {
        const bool has_next = S.next(ui + 1, nxt);
        const char* nA = has_next ? (const char*)g.A + (size_t)nxt.pm * tstep : cA; const char* nB = has_next ? (const char*)g.Bt + (size_t)nxt.pn * tstep : cB;
        for (int t = 0; t < nt; t += 2) {
            const bool last = (t == nt - 2);
            const char* a1 = cA + (size_t)(t + 1) * kstep;
            const char* a2 = last ? nA : cA + (size_t)(t + 2) * kstep; const char* b2 = last ? nB : cB + (size_t)(t + 2) * kstep;
            const char* a3 = a2 + kstep; const char* b3 = b2 + kstep;
            if (last && has_next) S.a_ready(nxt);
            if constexpr (SP2) {
            PG8_LDB(B0, 0, 0); PG8_LDB(B1, 0, 1); PG8_SCHED; PG8_LDA(At, 0, 0); PG8_STAGE(PG8_SA(1, 1), a1 + hstep, voffA);
            PG8_WAIT_V(8); PG8_WAIT_L(0); PG8_BAR; PG8_MMA(0, 0, At, B0); PG8_MMA(0, 1, At, B1); PG8_BAR; PG8_SCHED;
            PG8_LDA(At, 0, 1); PG8_STAGE(PG8_SB(0, 0), b2, voffB); PG8_STAGE(PG8_SB(0, 1), b2 + hstep, voffB); PG8_STAGE(PG8_SA(0, 0), a2, voffA);
            PG8_WAIT_V(8); PG8_WAIT_L(0); PG8_BAR; PG8_MMA(1, 0, At, B0); PG8_MMA(1, 1, At, B1); PG8_BAR; PG8_SCHED;
            PG8_LDB(B0, 1, 0); PG8_LDB(B1, 1, 1); PG8_SCHED; PG8_LDA(At, 1, 0); PG8_STAGE(PG8_SA(0, 1), a2 + hstep, voffA);
            PG8_WAIT_V(8); PG8_WAIT_L(0); PG8_BAR; PG8_MMA(0, 0, At, B0); PG8_MMA(0, 1, At, B1); PG8_BAR; PG8_SCHED;
            PG8_LDA(At, 1, 1); PG8_STAGE(PG8_SB(1, 0), b3, voffB); PG8_STAGE(PG8_SB(1, 1), b3 + hstep, voffB); PG8_STAGE(PG8_SA(1, 0), a3, voffA);
            PG8_WAIT_V(8); PG8_WAIT_L(0); PG8_BAR; PG8_MMA(1, 0, At, B0); PG8_MMA(1, 1, At, B1); PG8_BAR; PG8_SCHED;
            } else {
            PG8_LDB(B0, 0, 0); PG8_SCHED; PG8_LDA(At, 0, 0); PG8_STAGE(PG8_SA(1, 1), a1 + hstep, voffA);
            PG8_WAIT_L(8); PG8_BAR; PG8_WAIT_L(0); PG8_MMA(0, 0, At, B0); PG8_BAR; PG8_SCHED;
            PG8_LDB(B1, 0, 1); PG8_STAGE(PG8_SB(0, 0), b2, voffB);
            PG8_BAR; PG8_WAIT_L(0); PG8_MMA(0, 1, At, B1); PG8_BAR;
            PG8_LDA(At, 0, 1); PG8_STAGE(PG8_SA(0, 0), a2, voffA);
            PG8_BAR; PG8_WAIT_L(0); PG8_MMA(1, 0, At, B0); PG8_BAR; PG8_SCHED;
            PG8_STAGE(PG8_SB(0, 1), b2 + hstep, voffB);
            PG8_WAIT_V(6); PG8_BAR; PG8_MMA(1, 1, At, B1); PG8_BAR;
            PG8_LDB(B0, 1, 0); PG8_SCHED; PG8_LDA(At, 1, 0); PG8_STAGE(PG8_SA(0, 1), a2 + hstep, voffA);
            PG8_WAIT_L(8); PG8_BAR; PG8_WAIT_L(0); PG8_MMA(0, 0, At, B0); PG8_BAR; PG8_SCHED;
            PG8_LDB(B1, 1, 1); PG8_STAGE(PG8_SB(1, 0), b3, voffB);
            PG8_BAR; PG8_WAIT_L(0); PG8_MMA(0, 1, At, B1); PG8_BAR;
            PG8_LDA(At, 1, 1); PG8_STAGE(PG8_SA(1, 0), a3, voffA);
            PG8_BAR; PG8_WAIT_L(0); PG8_MMA(1, 0, At, B0); PG8_BAR; PG8_SCHED;
            PG8_STAGE(PG8_SB(1, 1), b3 + hstep, voffB);
            PG8_WAIT_V(6); PG8_BAR; PG8_MMA(1, 1, At, B1); PG8_BAR;
            }
        }
        if constexpr (ALIGN_EPI) { if (wr == 0) PG8_BAR; }
        if constexpr (!Epi::AFTER_DRAIN) { E(acc, cur, wr, wc, fr, fq); S.done(cur); }
        if (!has_next) break;
#pragma unroll
        for (int a = 0; a < 2; ++a)
#pragma unroll
            for (int b = 0; b < 2; ++b)
#pragma unroll
                for (int m = 0; m < 4; ++m)
#pragma unroll
                    for (int n = 0; n < 2; ++n) acc[a][b][m][n] = (f32x4){0.f, 0.f, 0.f, 0.f};
        cur = nxt; cA = nA; cB = nB; ++ui;
        if constexpr (ALIGN_EPI) { if (wr == 1) PG8_BAR; }
    }
    PG8_WAIT_V(0);
    if constexpr (!ALIGN_EPI) { if (wr == 0) PG8_BAR; }
    PG8_BAR;
    if constexpr (Epi::AFTER_DRAIN) { E.fused(acc, cur, wr, wc, fr, fq, lds, wid, lane); S.done(cur); }
#undef PG8_SA
#undef PG8_SB
#undef PG8_STAGE
#undef PG8_LDA
#undef PG8_LDB
#undef PG8_MMA
#undef PG8_WAIT_V
#undef PG8_WAIT_L
#undef PG8_BAR
#undef PG8_SCHED
}
}

#define WTAB_OFF 155392
extern __shared__ __attribute__((aligned(16))) unsigned char lds_raw[];
__device__ __forceinline__ int hw_slot() { return (int)(__builtin_amdgcn_s_getreg((5 << 11) | 4) & 63u); }
__device__ __forceinline__ void otid_init() { const int t = threadIdx.x; if ((t & 63) == 0) ((__attribute__((address_space(3))) int*)(__attribute__((address_space(3))) void*)(lds_raw + WTAB_OFF))[hw_slot()] = t >> 6; }
__device__ __forceinline__ int otid() {
    const int w = __builtin_amdgcn_readfirstlane(((const __attribute__((address_space(3))) int*)(__attribute__((address_space(3))) void*)(lds_raw + WTAB_OFF))[hw_slot()]);
    int l; asm volatile("v_mbcnt_lo_u32_b32 %0, -1, 0\n\tv_mbcnt_hi_u32_b32 %0, -1, %0" : "=v"(l));
    return (w << 6) + l;
}
using pg8::bf16_t; using pg8::bf16x8; using pg8::f32x4; using pg8::u32x4;
#define LAS __attribute__((address_space(3)))

#define DMODEL 1024
#define NPT 16384
#define NST 32
#define NTOK 16416
#define MPAD 16640
#define SEQ 2048
#define ZW 2816
#define OFF_A 1536
#define OFF_B 1544
#define OFF_Z 1552
#define OFF_QA 2064
#define OFF_KVA 2448
#define OFF_KR 2704
#define DFF 2816
#define PAST 16384
#define NPAGES 128
#define EPSV 1e-6f

#define O_YP 0
#define O_YS (O_YP + 16777216)
#define O_CKVP (O_YS + 32768)
#define O_KRP (O_CKVP + 4194304)
#define O_GSP (O_KRP + 524288)
#define O_CSP (O_GSP + 262144)
#define O_CKVS (O_CSP + 36864)
#define O_KRS (O_CKVS + 8192)
#define O_GSS (O_KRS + 1024)
#define O_CSS (O_GSS + 1048576)

__device__ __forceinline__ bf16_t f2bf(float f) { unsigned u = __float_as_uint(f); return (bf16_t)((u + 0x7fffu + ((u >> 16) & 1u)) >> 16); }
__device__ __forceinline__ float bf2f(bf16_t b) { return __uint_as_float(((unsigned)b) << 16); }
template <int CTRL> __device__ __forceinline__ float dpp_mov(float x) { return __uint_as_float((unsigned)__builtin_amdgcn_update_dpp((int)__float_as_uint(x), (int)__float_as_uint(x), CTRL, 0xF, 0xF, true)); }
__device__ __forceinline__ float add_x16(float x) { auto r = __builtin_amdgcn_permlane16_swap(__float_as_uint(x), __float_as_uint(x), false, false); return __uint_as_float(r[0]) + __uint_as_float(r[1]); }
__device__ __forceinline__ float add_x32(float x) { auto r = __builtin_amdgcn_permlane32_swap(__float_as_uint(x), __float_as_uint(x), false, false); return __uint_as_float(r[0]) + __uint_as_float(r[1]); }
__device__ __forceinline__ float max_x32(float x) { auto r = __builtin_amdgcn_permlane32_swap(__float_as_uint(x), __float_as_uint(x), false, false); return fmaxf(__uint_as_float(r[0]), __uint_as_float(r[1])); }
__device__ __forceinline__ float sum8(float x) { x += dpp_mov<0xB1>(x); x += dpp_mov<0x4E>(x); x += dpp_mov<0x141>(x); return x; }
__device__ __forceinline__ float sum16(float x) { x = sum8(x); x += dpp_mov<0x140>(x); return x; }
__device__ __forceinline__ float max16(float x) { x = fmaxf(x, dpp_mov<0xB1>(x)); x = fmaxf(x, dpp_mov<0x4E>(x)); x = fmaxf(x, dpp_mov<0x141>(x)); x = fmaxf(x, dpp_mov<0x140>(x)); return x; }
__device__ __forceinline__ float wave_sum(float v) { return add_x32(add_x16(sum16(v))); }
__device__ __forceinline__ float sigmoidf_(float x) { return __builtin_amdgcn_rcpf(1.f + __builtin_amdgcn_exp2f(-1.44269504f * x)); }
__device__ __forceinline__ float siluf_(float x) { return x * __builtin_amdgcn_rcpf(1.f + __builtin_amdgcn_exp2f(-1.44269504f * x)); }


#define WSYNC() do { __builtin_amdgcn_fence(__ATOMIC_ACQ_REL, "wavefront"); __builtin_amdgcn_wave_barrier(); } while (0)
#define NTHR 512
#define NWAVE 8

typedef float f32x2_t __attribute__((ext_vector_type(2)));
typedef __bf16 bf16x2_t __attribute__((ext_vector_type(2)));
__device__ __forceinline__ unsigned cvtpk(float lo, float hi) { f32x2_t v = {lo, hi}; bf16x2_t r = __builtin_convertvector(v, bf16x2_t); return __builtin_bit_cast(unsigned, r); }
__device__ __forceinline__ void bf8_to_f32(const bf16x8& v, float* o) {
#pragma unroll
    for (int e = 0; e < 8; ++e) o[e] = __uint_as_float(((unsigned)(unsigned short)v[e]) << 16);
}
__device__ __forceinline__ bf16x8 f32_to_bf8(const float* x) {
    u32x4 w; w.x = cvtpk(x[0], x[1]); w.y = cvtpk(x[2], x[3]); w.z = cvtpk(x[4], x[5]); w.w = cvtpk(x[6], x[7]);
    return __builtin_bit_cast(bf16x8, w);
}
__device__ __forceinline__ unsigned pk2bf(float lo, float hi) { return (unsigned)f2bf(lo) | ((unsigned)f2bf(hi) << 16); }

__device__ __forceinline__ void wt_item(const float* __restrict__ W, int ldw, int col0, int nvalid, bf16_t* __restrict__ WT, int ldt, int nrow0, int k0, float* scr, int lane) {
    WSYNC();
#pragma unroll 8
    for (int i = 0; i < 32; ++i) { const int kk = 2 * i + (lane >> 5), n = lane & 31; scr[kk * 33 + n] = n < nvalid ? W[(size_t)(k0 + kk) * ldw + col0 + n] : 0.f; }
    WSYNC();
    const int c = lane & 7;
#pragma unroll
    for (int j = 0; j < 4; ++j) { const int n = (lane >> 3) + 8 * j; const float* sp = scr + (8 * c) * 33 + n;
        u32x4 o; o.x = cvtpk(sp[0], sp[33]); o.y = cvtpk(sp[2 * 33], sp[3 * 33]); o.z = cvtpk(sp[4 * 33], sp[5 * 33]); o.w = cvtpk(sp[6 * 33], sp[7 * 33]);
        *(u32x4*)(WT + (size_t)(nrow0 + n) * ldt + k0 + 8 * c) = o; }
}

__device__ __forceinline__ void rms1024_row(const float* __restrict__ src, const float* __restrict__ g, bf16_t* __restrict__ o, bool zero, int lane) {
    if (zero) { for (int j = 0; j < 4; ++j) { ushort4 z = {0, 0, 0, 0}; *(ushort4*)(o + lane * 4 + 256 * j) = z; } return; }
    float4 v[4]; float ss = 0.f;
#pragma unroll
    for (int j = 0; j < 4; ++j) { v[j] = *(const float4*)(src + lane * 4 + 256 * j); ss += v[j].x * v[j].x + v[j].y * v[j].y + v[j].z * v[j].z + v[j].w * v[j].w; }
    ss = wave_sum(ss);
    const float rs = rsqrtf(ss * (1.f / 1024.f) + EPSV);
#pragma unroll
    for (int j = 0; j < 4; ++j) {
        const float4 gg = *(const float4*)(g + lane * 4 + 256 * j);
        ushort4 w; w.x = f2bf(v[j].x * rs * gg.x); w.y = f2bf(v[j].y * rs * gg.y); w.z = f2bf(v[j].z * rs * gg.z); w.w = f2bf(v[j].w * rs * gg.w);
        *(ushort4*)(o + lane * 4 + 256 * j) = w;
    }
}

__device__ __forceinline__ void rms1024_row_b(const bf16_t* __restrict__ src, const float* __restrict__ g, bf16_t* __restrict__ o, bool zero, int lane) {
    if (zero) { for (int j = 0; j < 2; ++j) { const u32x4 z = {0u, 0u, 0u, 0u}; *(u32x4*)(o + lane * 8 + 512 * j) = z; } return; }
    float v[2][8]; float ss = 0.f;
#pragma unroll
    for (int j = 0; j < 2; ++j) { bf8_to_f32(*(const bf16x8*)(src + lane * 8 + 512 * j), v[j]);
#pragma unroll
        for (int e = 0; e < 8; ++e) ss += v[j][e] * v[j][e]; }
    ss = wave_sum(ss);
    const float rs = rsqrtf(ss * (1.f / 1024.f) + EPSV);
#pragma unroll
    for (int j = 0; j < 2; ++j) {
        const float4 g0 = *(const float4*)(g + lane * 8 + 512 * j), g1 = *(const float4*)(g + lane * 8 + 512 * j + 4);
        float t[8] = {v[j][0] * rs * g0.x, v[j][1] * rs * g0.y, v[j][2] * rs * g0.z, v[j][3] * rs * g0.w, v[j][4] * rs * g1.x, v[j][5] * rs * g1.y, v[j][6] * rs * g1.z, v[j][7] * rs * g1.w};
        *(bf16x8*)(o + lane * 8 + 512 * j) = f32_to_bf8(t);
    }
}

struct ABf16 { const bf16_t* p; int lda; __device__ __forceinline__ bf16x8 load(int m, int k) const { return *(const bf16x8*)(p + (size_t)m * lda + k); } };
template <bool SWIGLU, class Epi>
__device__ __forceinline__ void gemm_sample_rows(const bf16_t* __restrict__ A, int lda, const bf16_t* __restrict__ Bt, int K, int N, const Epi& epi, char*  , int bid, int nb, int first = -1) {
    const int tid = otid(), lane = tid & 63, wid = tid >> 6, i16 = lane & 15, q4 = lane >> 4;
    for (int u = first >= 0 ? (bid - first + nb) % nb : nb - 1 - bid; u < N / 256; u += nb) {
        const int n0 = u * 256;
        const int c0 = SWIGLU ? n0 + 16 * wid : n0 + 32 * wid, c1 = SWIGLU ? n0 + 128 + 16 * wid : n0 + 32 * wid + 16;
        const bf16_t* a0p = A + (size_t)(NPT + i16) * lda + 8 * q4; const bf16_t* a1p = a0p + (size_t)16 * lda;
        const bf16_t* b0p = Bt + (size_t)(c0 + i16) * K + 8 * q4; const bf16_t* b1p = Bt + (size_t)(c1 + i16) * K + 8 * q4;
        f32x4 acc[2][2];
#pragma unroll
        for (int i = 0; i < 2; ++i)
#pragma unroll
            for (int j = 0; j < 2; ++j) acc[i][j] = (f32x4){0.f, 0.f, 0.f, 0.f};
#pragma unroll 4
        for (int k0 = 0; k0 < K; k0 += 32) {
            const bf16x8 a0 = *(const bf16x8*)(a0p + k0), a1 = *(const bf16x8*)(a1p + k0), b0 = *(const bf16x8*)(b0p + k0), b1 = *(const bf16x8*)(b1p + k0);
            acc[0][0] = __builtin_amdgcn_mfma_f32_16x16x32_bf16(a0, b0, acc[0][0], 0, 0, 0); acc[0][1] = __builtin_amdgcn_mfma_f32_16x16x32_bf16(a0, b1, acc[0][1], 0, 0, 0);
            acc[1][0] = __builtin_amdgcn_mfma_f32_16x16x32_bf16(a1, b0, acc[1][0], 0, 0, 0); acc[1][1] = __builtin_amdgcn_mfma_f32_16x16x32_bf16(a1, b1, acc[1][1], 0, 0, 0);
        }
#pragma unroll
        for (int i = 0; i < 2; ++i)
#pragma unroll
            for (int r = 0; r < 4; ++r) {
                const int m = NPT + 16 * i + 4 * q4 + r;
                if constexpr (SWIGLU) epi(m, (n0 >> 1) + 16 * wid + i16, siluf_(acc[i][0][r]) * acc[i][1][r]);
                else { epi(m, c0 + i16, acc[i][0][r]); epi(m, c1 + i16, acc[i][1][r]); }
            }
    }
}
template <bool SWIGLU, class Epi, int NJ = 4>
__device__ __forceinline__ void gemm_sample_rows_ks(const bf16_t* __restrict__ A, int lda, const bf16_t* __restrict__ Bt, int K, int N, const Epi& epi, char* smem, int bid, int nb) {
    const int tid = otid(), lane = tid & 63, wid = tid >> 6, i16 = lane & 15, q4 = lane >> 4;
    static_assert(!SWIGLU || NJ == 4, "swiglu units are 64 rows wide");
    const int nunits = N / (16 * NJ), ksl = K >> 3;
    f32x4* red = (f32x4*)smem;
    for (int u = nb - 1 - bid; u < nunits; u += nb) {
        int brow[NJ];
#pragma unroll
        for (int j = 0; j < NJ; ++j) brow[j] = SWIGLU ? ((32 * u) >> 7) * 256 + ((32 * u) & 127) + 128 * (j >> 1) + 16 * (j & 1) + i16 : 16 * NJ * u + 16 * j + i16;
        const bf16_t* a0p = A + (size_t)(NPT + i16) * lda + wid * ksl + 8 * q4; const bf16_t* a1p = a0p + (size_t)16 * lda;
        f32x4 acc[2][NJ];
#pragma unroll
        for (int i = 0; i < 2; ++i)
#pragma unroll
            for (int j = 0; j < NJ; ++j) acc[i][j] = (f32x4){0.f, 0.f, 0.f, 0.f};
        for (int k0 = 0; k0 < ksl; k0 += 32) {
            const bf16x8 a0 = *(const bf16x8*)(a0p + k0), a1 = *(const bf16x8*)(a1p + k0);
            bf16x8 b[NJ];
#pragma unroll
            for (int j = 0; j < NJ; ++j) b[j] = *(const bf16x8*)(Bt + (size_t)brow[j] * K + wid * ksl + 8 * q4 + k0);
#pragma unroll
            for (int j = 0; j < NJ; ++j) { acc[0][j] = __builtin_amdgcn_mfma_f32_16x16x32_bf16(a0, b[j], acc[0][j], 0, 0, 0); acc[1][j] = __builtin_amdgcn_mfma_f32_16x16x32_bf16(a1, b[j], acc[1][j], 0, 0, 0); }
        }
        __syncthreads();
#pragma unroll
        for (int i = 0; i < 2; ++i)
#pragma unroll
            for (int j = 0; j < NJ; ++j) red[(wid * 2 * NJ + i * NJ + j) * 64 + lane] = acc[i][j];
        __syncthreads();
        if constexpr (SWIGLU) {
            if (tid < 256) {
                const int t4 = tid >> 6, i = t4 >> 1, jg = t4 & 1, l = tid & 63;
                f32x4 g = red[(i * 4 + jg) * 64 + l], up = red[(i * 4 + jg + 2) * 64 + l];
#pragma unroll
                for (int w = 1; w < 8; ++w) { g = g + red[(w * 8 + i * 4 + jg) * 64 + l]; up = up + red[(w * 8 + i * 4 + jg + 2) * 64 + l]; }
#pragma unroll
                for (int r = 0; r < 4; ++r) epi(NPT + 16 * i + 4 * (l >> 4) + r, 32 * u + 16 * jg + (l & 15), siluf_(g[r]) * up[r]);
            }
        } else {
            const int t8 = tid >> 6, l = tid & 63, i = t8 / NJ, j = t8 % NJ;
            if (t8 < 2 * NJ) {
                f32x4 v = red[t8 * 64 + l];
#pragma unroll
                for (int w = 1; w < 8; ++w) v = v + red[(w * 2 * NJ + t8) * 64 + l];
#pragma unroll
                for (int r = 0; r < 4; ++r) epi(NPT + 16 * i + 4 * (l >> 4) + r, 16 * NJ * u + 16 * j + (l & 15), v[r]);
            }
        }
    }
    __syncthreads();
}
struct EwF32 { float* C; int ldc; __device__ __forceinline__ void operator()(int m, int n, float v) const { C[(size_t)m * ldc + n] = v; } };
struct EwBf16 { bf16_t* C; int ldc; __device__ __forceinline__ void operator()(int m, int n, float v) const { C[(size_t)m * ldc + n] = f2bf(v); } };
struct EwResX { const float* xs; bf16_t* C; __device__ __forceinline__ void operator()(int m, int n, float v) const { C[(size_t)m * 1024 + n] = f2bf(xs[(size_t)(m - NPT) * 1024 + n] + v); } };
struct EwResH { const bf16_t* H; bf16_t* C; __device__ __forceinline__ void operator()(int m, int n, float v) const { C[(size_t)m * 1024 + n] = f2bf(bf2f(H[(size_t)m * 1024 + n]) + v); } };
struct EwPle { const bf16_t* H2; const bf16_t* PP; float* out;
    __device__ __forceinline__ void operator()(int m, int n, float v) const { out[O_YS + (size_t)(m - NPT) * 1024 + n] = bf2f(H2[(size_t)m * 1024 + n]) + bf2f(PP[(size_t)m * 1024 + n]) * sigmoidf_(v); } };

struct PgBf16 {
    static constexpr bool PERM = true, AFTER_DRAIN = false; bf16_t* O; int ldc;
    __device__ __forceinline__ void operator()(const f32x4 (&acc)[2][2][4][2], const pg8::Unit& u, int wr, int wc, int fr, int fq) const {
#pragma unroll
        for (int ai = 0; ai < 2; ++ai)
#pragma unroll
            for (int m = 0; m < 4; ++m) { bf16_t* rowp = O + (size_t)(u.pm * 256 + ai * 128 + wr * 64 + m * 16 + fr) * ldc + u.pn * 256 + wc * 32 + 8 * fq;
#pragma unroll
                for (int bj = 0; bj < 2; ++bj) { const f32x4 v0 = acc[ai][bj][m][0], v1 = acc[ai][bj][m][1]; u32x4 w; w.x = pk2bf(v0[0], v0[1]); w.y = pk2bf(v0[2], v0[3]); w.z = pk2bf(v1[0], v1[1]); w.w = pk2bf(v1[2], v1[3]); *(u32x4*)(rowp + bj * 128) = w; } }
    }
};
struct PgF32 {
    static constexpr bool PERM = false, AFTER_DRAIN = false; float* O; int ldc;
    __device__ __forceinline__ void operator()(const f32x4 (&acc)[2][2][4][2], const pg8::Unit& u, int wr, int wc, int fr, int fq) const {
#pragma unroll
        for (int ai = 0; ai < 2; ++ai)
#pragma unroll
            for (int m = 0; m < 4; ++m) { float* rowp = O + (size_t)(u.pm * 256 + ai * 128 + wr * 64 + m * 16 + fr) * ldc + u.pn * 256 + wc * 32 + 4 * fq;
#pragma unroll
                for (int bj = 0; bj < 2; ++bj)
#pragma unroll
                    for (int n = 0; n < 2; ++n) *(f32x4*)(rowp + bj * 128 + n * 16) = acc[ai][bj][m][n]; }
    }
};
struct PgSwiglu {
    static constexpr bool PERM = true, AFTER_DRAIN = false; bf16_t* Hd;
    __device__ __forceinline__ void operator()(const f32x4 (&acc)[2][2][4][2], const pg8::Unit& u, int wr, int wc, int fr, int fq) const {
#pragma unroll
        for (int ai = 0; ai < 2; ++ai)
#pragma unroll
            for (int m = 0; m < 4; ++m) { bf16_t* rowp = Hd + (size_t)(u.pm * 256 + ai * 128 + wr * 64 + m * 16 + fr) * DFF + u.pn * 128 + wc * 32 + 8 * fq;
                float h[8];
#pragma unroll
                for (int n = 0; n < 2; ++n)
#pragma unroll
                    for (int i = 0; i < 4; ++i) h[n * 4 + i] = siluf_(acc[ai][0][m][n][i]) * acc[ai][1][m][n][i];
                u32x4 w; w.x = pk2bf(h[0], h[1]); w.y = pk2bf(h[2], h[3]); w.z = pk2bf(h[4], h[5]); w.w = pk2bf(h[6], h[7]); *(u32x4*)rowp = w; }
    }
};
struct PgResXB {
    static constexpr bool PERM = true, AFTER_DRAIN = false; const float* R; bf16_t* O;
    __device__ __forceinline__ void operator()(const f32x4 (&acc)[2][2][4][2], const pg8::Unit& u, int wr, int wc, int fr, int fq) const {
#pragma unroll
        for (int ai = 0; ai < 2; ++ai)
#pragma unroll
            for (int m = 0; m < 4; ++m) { const size_t off = (size_t)(u.pm * 256 + ai * 128 + wr * 64 + m * 16 + fr) * 1024 + u.pn * 256 + wc * 32 + 8 * fq;
#pragma unroll
                for (int bj = 0; bj < 2; ++bj) { const f32x4 r0 = *(const f32x4*)(R + off + bj * 128), r1 = *(const f32x4*)(R + off + bj * 128 + 4), v0 = r0 + acc[ai][bj][m][0], v1 = r1 + acc[ai][bj][m][1];
                    u32x4 w; w.x = cvtpk(v0[0], v0[1]); w.y = cvtpk(v0[2], v0[3]); w.z = cvtpk(v1[0], v1[1]); w.w = cvtpk(v1[2], v1[3]); *(u32x4*)(O + off + bj * 128) = w; } }
    }
};
struct PgResBB {
    static constexpr bool PERM = true, AFTER_DRAIN = false; const bf16_t* R; bf16_t* O;
    __device__ __forceinline__ void operator()(const f32x4 (&acc)[2][2][4][2], const pg8::Unit& u, int wr, int wc, int fr, int fq) const {
#pragma unroll
        for (int ai = 0; ai < 2; ++ai)
#pragma unroll
            for (int m = 0; m < 4; ++m) { const size_t off = (size_t)(u.pm * 256 + ai * 128 + wr * 64 + m * 16 + fr) * 1024 + u.pn * 256 + wc * 32 + 8 * fq;
#pragma unroll
                for (int bj = 0; bj < 2; ++bj) { float r[8]; bf8_to_f32(*(const bf16x8*)(R + off + bj * 128), r); const f32x4 a0 = acc[ai][bj][m][0], a1 = acc[ai][bj][m][1];
                    u32x4 w; w.x = cvtpk(r[0] + a0[0], r[1] + a0[1]); w.y = cvtpk(r[2] + a0[2], r[3] + a0[3]); w.z = cvtpk(r[4] + a1[0], r[5] + a1[1]); w.w = cvtpk(r[6] + a1[2], r[7] + a1[3]); *(u32x4*)(O + off + bj * 128) = w; } }
    }
};
struct PgPleB {
    static constexpr bool PERM = true, AFTER_DRAIN = false; const bf16_t* H2; const bf16_t* PP; float* out;
    __device__ __forceinline__ void operator()(const f32x4 (&acc)[2][2][4][2], const pg8::Unit& u, int wr, int wc, int fr, int fq) const {
#pragma unroll
        for (int ai = 0; ai < 2; ++ai)
#pragma unroll
            for (int m = 0; m < 4; ++m) { const size_t off = (size_t)(u.pm * 256 + ai * 128 + wr * 64 + m * 16 + fr) * 1024 + u.pn * 256 + wc * 32 + 8 * fq;
#pragma unroll
                for (int bj = 0; bj < 2; ++bj) { float h[8], pp[8]; bf8_to_f32(*(const bf16x8*)(H2 + off + bj * 128), h); bf8_to_f32(*(const bf16x8*)(PP + off + bj * 128), pp);
                    const f32x4 a0 = acc[ai][bj][m][0], a1 = acc[ai][bj][m][1]; f32x4 y0, y1;
#pragma unroll
                    for (int i = 0; i < 4; ++i) { y0[i] = h[i] + pp[i] * sigmoidf_(a0[i]); y1[i] = h[4 + i] + pp[4 + i] * sigmoidf_(a1[i]); }
                    *(f32x4*)(out + O_YP + off + bj * 128) = y0; *(f32x4*)(out + O_YP + off + bj * 128 + 4) = y1; } }
    }
};
template <class Epi>
__device__ __forceinline__ void pg_gemm(LAS unsigned char* lds, const bf16_t* A, const bf16_t* Bt, int M, int N, int K, const Epi& E, int glow = 0) {
    pg8::Gemm g{A, Bt, M, N, K}; pg8::StaticOrder S;
    if (glow > 0) { if ((int)blockIdx.x >= glow) return; S.init(M, N, glow, (int)blockIdx.x); }
    else S.init(M, N, (int)gridDim.x, (int)blockIdx.x);
    pg8::gemm_phase<Epi, pg8::StaticOrder, true, true>(lds, g, S, E);
}

constexpr size_t WOF_WinT = 0ull;
constexpr size_t WOF_WqbT = 5767168ull;
constexpr size_t WOF_WkvT = 6356992ull;
constexpr size_t WOF_WknT = 6881280ull;
constexpr size_t WOF_WoT = 7143424ull;
constexpr size_t WOF_WguT = 9240576ull;
constexpr size_t WOF_WdT = 20774912ull;
constexpr size_t WOF_WpgT = 26542080ull;
constexpr size_t WOF_WppT = 28639232ull;
constexpr size_t WOF_xn = 29163520ull;
constexpr size_t WOF_pb = 63242240ull;
constexpr size_t WOF_Z = 71761920ull;
constexpr size_t WOF_qkv = 165478400ull;
constexpr size_t WOF_ropecs = 216596480ull;
constexpr size_t WOF_gg = 216858880ull;
constexpr size_t WOF_bb = 217391360ull;
constexpr size_t WOF_goraw = 217923840ull;
constexpr size_t WOF_gUT = 252002560ull;
constexpr size_t WOF_ggam = 285556992ull;
constexpr size_t WOF_gWn = 285565184ull;
constexpr size_t WOF_gQg = 302342400ull;
constexpr size_t WOF_gQK = 319119616ull;
constexpr size_t WOF_gKd = 335896832ull;
constexpr size_t WOF_qan = 352674048ull;
constexpr size_t WOF_ckvb = 365453568ull;
constexpr size_t WOF_krf = 373973248ull;
constexpr size_t WOF_Q = 376103168ull;
constexpr size_t WOF_qh = 427221248ull;
constexpr size_t WOF_KV = 478339328ull;
constexpr size_t WOF_kh = 546496768ull;
constexpr size_t WOF_omix = 580575488ull;
constexpr size_t WOF_KN = 614654208ull;
constexpr size_t WOF_SC = 1151525120ull;
constexpr size_t WOF_part = 1168302336ull;
constexpr size_t WOF_H = 1170432256ull;
constexpr size_t WOF_un = 1238589696ull;
constexpr size_t WOF_G = 1272668416ull;
constexpr size_t WOF_hid = 1273028864ull;
constexpr size_t WOF_H2 = 1366745344ull;
constexpr size_t WOF_un2 = 1434902784ull;
constexpr size_t WOF_PP = 1468981504ull;
constexpr size_t WOF_qraw = 1537138944ull;
constexpr size_t WOF_kvraw = 1562304768ull;
constexpr size_t WOF_krb = 1595859200ull;
constexpr size_t WOF_ctl = 1596907776ull;
constexpr size_t WS_TOTAL = 1596924160ull;
struct MK {
    const float *x_prompt, *x_sample, *cache_ckv, *cache_krope, *state_gdn, *state_conv; const int* page_table; const float *p_prompt, *p_sample;
    const float *g_attn, *w_in, *w_conv, *a_log, *dt_bias, *g_gdn_out, *g_q_a, *w_q_b, *g_q_nope, *g_q_rope, *g_kv_a, *g_k_rope, *w_kv_b, *g_k_nope, *w_o, *g_ffn, *w_gate, *w_up, *w_down, *g_ple, *w_ple_gate, *w_ple_proj;
    float* out; char* ws;
    __device__ __forceinline__ unsigned* ctl() const { return (unsigned*)(ws + WOF_ctl); }
    __device__ __forceinline__ bf16_t* WinT() const { return (bf16_t*)(ws + WOF_WinT); }
    __device__ __forceinline__ bf16_t* WqbT() const { return (bf16_t*)(ws + WOF_WqbT); }
    __device__ __forceinline__ bf16_t* WkvT() const { return (bf16_t*)(ws + WOF_WkvT); }
    __device__ __forceinline__ bf16_t* WknT() const { return (bf16_t*)(ws + WOF_WknT); }
    __device__ __forceinline__ bf16_t* WoT() const { return (bf16_t*)(ws + WOF_WoT); }
    __device__ __forceinline__ bf16_t* WguT() const { return (bf16_t*)(ws + WOF_WguT); }
    __device__ __forceinline__ bf16_t* WdT() const { return (bf16_t*)(ws + WOF_WdT); }
    __device__ __forceinline__ bf16_t* WpgT() const { return (bf16_t*)(ws + WOF_WpgT); }
    __device__ __forceinline__ bf16_t* WppT() const { return (bf16_t*)(ws + WOF_WppT); }
    __device__ __forceinline__ bf16_t* xn() const { return (bf16_t*)(ws + WOF_xn); }
    __device__ __forceinline__ bf16_t* pb() const { return (bf16_t*)(ws + WOF_pb); }
    __device__ __forceinline__ bf16_t* Z() const { return (bf16_t*)(ws + WOF_Z); }
    __device__ __forceinline__ bf16_t* qkv() const { return (bf16_t*)(ws + WOF_qkv); }
    __device__ __forceinline__ float* ropecs() const { return (float*)(ws + WOF_ropecs); }
    __device__ __forceinline__ float* gg() const { return (float*)(ws + WOF_gg); }
    __device__ __forceinline__ float* bb() const { return (float*)(ws + WOF_bb); }
    __device__ __forceinline__ float* goraw() const { return (float*)(ws + WOF_goraw); }
    __device__ __forceinline__ float* gUT() const { return (float*)(ws + WOF_gUT); }
    __device__ __forceinline__ float* ggam() const { return (float*)(ws + WOF_ggam); }
    __device__ __forceinline__ bf16_t* gWn() const { return (bf16_t*)(ws + WOF_gWn); }
    __device__ __forceinline__ bf16_t* gQg() const { return (bf16_t*)(ws + WOF_gQg); }
    __device__ __forceinline__ bf16_t* gQK() const { return (bf16_t*)(ws + WOF_gQK); }
    __device__ __forceinline__ bf16_t* gKd() const { return (bf16_t*)(ws + WOF_gKd); }
    __device__ __forceinline__ bf16_t* qan() const { return (bf16_t*)(ws + WOF_qan); }
    __device__ __forceinline__ bf16_t* ckvb() const { return (bf16_t*)(ws + WOF_ckvb); }
    __device__ __forceinline__ float* krf() const { return (float*)(ws + WOF_krf); }
    __device__ __forceinline__ float* Q() const { return (float*)(ws + WOF_Q); }
    __device__ __forceinline__ float* qh() const { return (float*)(ws + WOF_qh); }
    __device__ __forceinline__ float* KV() const { return (float*)(ws + WOF_KV); }
    __device__ __forceinline__ float* kh() const { return (float*)(ws + WOF_kh); }
    __device__ __forceinline__ bf16_t* omix() const { return (bf16_t*)(ws + WOF_omix); }
    __device__ __forceinline__ bf16_t* KN() const { return (bf16_t*)(ws + WOF_KN); }
    __device__ __forceinline__ float* SC() const { return (float*)(ws + WOF_SC); }
    __device__ __forceinline__ float* part() const { return (float*)(ws + WOF_part); }
    __device__ __forceinline__ bf16_t* H() const { return (bf16_t*)(ws + WOF_H); }
    __device__ __forceinline__ bf16_t* un() const { return (bf16_t*)(ws + WOF_un); }
    __device__ __forceinline__ float* G() const { return (float*)(ws + WOF_G); }
    __device__ __forceinline__ bf16_t* hid() const { return (bf16_t*)(ws + WOF_hid); }
    __device__ __forceinline__ bf16_t* H2() const { return (bf16_t*)(ws + WOF_H2); }
    __device__ __forceinline__ bf16_t* un2() const { return (bf16_t*)(ws + WOF_un2); }
    __device__ __forceinline__ bf16_t* PP() const { return (bf16_t*)(ws + WOF_PP); }
    __device__ __forceinline__ bf16_t* qraw() const { return (bf16_t*)(ws + WOF_qraw); }
    __device__ __forceinline__ bf16_t* kvraw() const { return (bf16_t*)(ws + WOF_kvraw); }
    __device__ __forceinline__ bf16_t* krb() const { return (bf16_t*)(ws + WOF_krb); }
};

__device__ __forceinline__ float fast_sigmoid(float x) { return __builtin_amdgcn_rcpf(1.f + __builtin_amdgcn_exp2f(-1.44269504f * x)); }
struct PinTok { bf16x8 qa, cv, kr; float ab; };
struct PinGain { float gqa[8], gkv[8], gkr[8], dtb, alog; };
__device__ __forceinline__ PinTok pin_load(const MK& a, int row, int lane) {
    const bf16_t* z = a.Z() + (size_t)row * ZW; PinTok t; const bf16x8 zz = {0, 0, 0, 0, 0, 0, 0, 0};
    t.qa = lane < 48 ? *(const bf16x8*)(z + OFF_QA + 8 * lane) : zz; t.cv = lane < 32 ? *(const bf16x8*)(z + OFF_KVA + 8 * lane) : zz;
    t.kr = (lane >= 32 && lane < 36) ? *(const bf16x8*)(z + OFF_KR + 8 * (lane - 32)) : zz; t.ab = lane < 16 ? bf2f(z[OFF_A + lane]) : 0.f; return t;
}
__device__ __forceinline__ void post_in_token(const MK& a, int row, int lane, const float* wcs, const bf16x8 (&w0)[3], const bf16x8 (&w1)[3], const bf16x8 (&w2)[3], const bf16x8 (&wcur)[3], const PinTok& tk, const PinGain& gn) {
    const bool samp = row >= NPT;
    const int b = samp ? row - NPT : row >> 11, t = samp ? 0 : row & 2047, hd = lane >> 3;
    float y[24];
#pragma unroll
    for (int c3 = 0; c3 < 3; ++c3) {
        float p0[8], p1[8], p2[8], cu[8];
        bf8_to_f32(w0[c3], p0); bf8_to_f32(w1[c3], p1); bf8_to_f32(w2[c3], p2); bf8_to_f32(wcur[c3], cu);
        const float* wp = wcs + 512 * c3 + 8 * lane;
        const float4 a0 = *(const float4*)wp, a1 = *(const float4*)(wp + 4), b0 = *(const float4*)(wp + 1536), b1 = *(const float4*)(wp + 1540);
        const float4 c0 = *(const float4*)(wp + 3072), c1 = *(const float4*)(wp + 3076), d0 = *(const float4*)(wp + 4608), d1 = *(const float4*)(wp + 4612);
        const float k0[8] = {a0.x, a0.y, a0.z, a0.w, a1.x, a1.y, a1.z, a1.w}, k1[8] = {b0.x, b0.y, b0.z, b0.w, b1.x, b1.y, b1.z, b1.w};
        const float k2[8] = {c0.x, c0.y, c0.z, c0.w, c1.x, c1.y, c1.z, c1.w}, k3[8] = {d0.x, d0.y, d0.z, d0.w, d1.x, d1.y, d1.z, d1.w};
#pragma unroll
        for (int e = 0; e < 8; ++e) { const int c = 8 * c3 + e; const float v = k0[e] * p0[e] + k1[e] * p1[e] + k2[e] * p2[e] + k3[e] * cu[e]; y[c] = v * fast_sigmoid(v); }
        __builtin_amdgcn_sched_barrier(0);
    }
    float sq = 0.f, sk = 0.f;
#pragma unroll
    for (int e = 0; e < 8; ++e) { sq += y[e] * y[e]; sk += y[8 + e] * y[8 + e]; }
    sq = sum8(sq); sk = sum8(sk);
    const float rq = rsqrtf(sq + EPSV) * 0.125f, rk = rsqrtf(sk + EPSV);
#pragma unroll
    for (int e = 0; e < 8; ++e) { y[e] *= rq; y[8 + e] *= rk; }
    bf16_t* qo = a.qkv() + (size_t)row * 1536 + 8 * lane;
    *(bf16x8*)qo = f32_to_bf8(y); *(bf16x8*)(qo + 512) = f32_to_bf8(y + 8); *(bf16x8*)(qo + 1024) = f32_to_bf8(y + 16);
    if (!samp && t >= SEQ - 3) {
        float* cso = a.out + O_CSP + ((size_t)b * 3 + (t - (SEQ - 3))) * 1536 + 8 * lane;
#pragma unroll
        for (int j = 0; j < 3; ++j) { float cu[8]; bf8_to_f32(wcur[j], cu); *(float4*)(cso + 512 * j) = (float4){cu[0], cu[1], cu[2], cu[3]}; *(float4*)(cso + 512 * j + 4) = (float4){cu[4], cu[5], cu[6], cu[7]}; }
    }
    if (lane < 16) {
        const float v = tk.ab;
        if (lane < 8) { const float xx = v + gn.dtb; const float sp = xx > 20.f ? xx : 0.69314718f * __builtin_amdgcn_logf(1.f + __builtin_amdgcn_exp2f(1.44269504f * xx)); a.gg()[(size_t)row * 8 + lane] = -gn.alog * sp; }
        else a.bb()[(size_t)row * 8 + lane - 8] = sigmoidf_(v);
    }
    __builtin_amdgcn_sched_barrier(0);
    float qa[8], cv[8], kr[8];
    bf8_to_f32(tk.qa, qa); bf8_to_f32(tk.cv, cv); bf8_to_f32(tk.kr, kr);
    float s1 = 0.f, s2 = 0.f, s3 = 0.f;
#pragma unroll
    for (int e = 0; e < 8; ++e) { s1 += qa[e] * qa[e]; s2 += cv[e] * cv[e]; s3 += kr[e] * kr[e]; }
    s1 = wave_sum(s1); s2 = wave_sum(s2); s3 = wave_sum(s3);
    const float r1 = rsqrtf(s1 * (1.f / 384.f) + EPSV), r2 = rsqrtf(s2 * (1.f / 256.f) + EPSV), r3 = rsqrtf(s3 * (1.f / 32.f) + EPSV);
    if (lane < 48) {
        float o[8];
#pragma unroll
        for (int e = 0; e < 8; ++e) o[e] = qa[e] * r1 * gn.gqa[e];
        *(bf16x8*)(a.qan() + (size_t)row * 384 + 8 * lane) = f32_to_bf8(o);
    }
    if (lane < 32) {
        float o[8];
#pragma unroll
        for (int e = 0; e < 8; ++e) o[e] = cv[e] * r2 * gn.gkv[e];
        *(bf16x8*)(a.ckvb() + (size_t)row * 256 + 8 * lane) = f32_to_bf8(o);
        float* co = samp ? a.out + O_CKVS + (size_t)b * 256 + 8 * lane : a.out + O_CKVP + (size_t)row * 256 + 8 * lane;
        *(float4*)co = (float4){o[0], o[1], o[2], o[3]}; *(float4*)(co + 4) = (float4){o[4], o[5], o[6], o[7]};
    }
    __builtin_amdgcn_sched_barrier(0);
    {
        const int c4 = (lane - 32) & 3;
        float xn[8], ot[8];
#pragma unroll
        for (int e = 0; e < 8; ++e) xn[e] = kr[e] * r3 * gn.gkr[e];
#pragma unroll
        for (int e = 0; e < 8; ++e) ot[e] = dpp_mov<0x4E>(xn[e]);
        if (lane >= 32 && lane < 36) {
            const float* tb = a.ropecs() + (size_t)(samp ? 2048 : t) * 32 + ((8 * c4) & 15);
            const float4 c0 = *(const float4*)tb, c1 = *(const float4*)(tb + 4), s0 = *(const float4*)(tb + 16), s1 = *(const float4*)(tb + 20);
            const float csv[8] = {c0.x, c0.y, c0.z, c0.w, c1.x, c1.y, c1.z, c1.w}, snv[8] = {s0.x, s0.y, s0.z, s0.w, s1.x, s1.y, s1.z, s1.w};
            float o[8];
#pragma unroll
            for (int e = 0; e < 8; ++e) o[e] = c4 < 2 ? xn[e] * csv[e] - ot[e] * snv[e] : ot[e] * snv[e] + xn[e] * csv[e];
            float* kf_ = a.krf() + (size_t)row * 32 + 8 * c4; *(float4*)kf_ = (float4){o[0], o[1], o[2], o[3]}; *(float4*)(kf_ + 4) = (float4){o[4], o[5], o[6], o[7]};
            float* ko = samp ? a.out + O_KRS + (size_t)b * 32 + 8 * c4 : a.out + O_KRP + (size_t)row * 32 + 8 * c4;
            *(float4*)ko = (float4){o[0], o[1], o[2], o[3]}; *(float4*)(ko + 4) = (float4){o[4], o[5], o[6], o[7]};
            if (!samp) *(bf16x8*)(a.krb() + (size_t)row * 32 + 8 * c4) = f32_to_bf8(o);
        }
    }
    (void)hd;
}
__device__ __forceinline__ void post_in_run(const MK& a, int run, int lane_in, const float* wcs) {
    int lane = lane_in; asm volatile("" : "+v"(lane));
    PinGain gn;
    {
        const int lq = lane < 48 ? lane : 0, lk = lane < 32 ? lane : 0, c4 = (lane - 32) & 3;
#pragma unroll
        for (int e = 0; e < 8; ++e) { gn.gqa[e] = a.g_q_a[8 * lq + e]; gn.gkv[e] = a.g_kv_a[8 * lk + e]; gn.gkr[e] = a.g_k_rope[8 * c4 + e]; }
        gn.dtb = a.dt_bias[lane & 7]; gn.alog = expf(a.a_log[lane & 7]);
    }
    if (run < NPT / 8) {
        const int row0 = run * 8, t0 = row0 & 2047;
        bf16x8 w0[3], w1[3], w2[3], wcur[3];
#pragma unroll
        for (int c3 = 0; c3 < 3; ++c3) {
            const bf16x8 zz = {0, 0, 0, 0, 0, 0, 0, 0}; w0[c3] = zz; w1[c3] = zz; w2[c3] = zz;
            if (t0 > 0) { const bf16_t* zp = a.Z() + (size_t)(row0 - 3) * ZW + 512 * c3 + 8 * lane; w0[c3] = *(const bf16x8*)zp; w1[c3] = *(const bf16x8*)(zp + ZW); w2[c3] = *(const bf16x8*)(zp + 2 * ZW); }
        }
        bf16x8 wnext[3]; PinTok tk, tkn;
#pragma unroll
        for (int c3 = 0; c3 < 3; ++c3) wnext[c3] = *(const bf16x8*)(a.Z() + (size_t)row0 * ZW + 512 * c3 + 8 * lane);
        tkn = pin_load(a, row0, lane);
#pragma unroll 1
        for (int k = 0; k < 8; ++k) {
            const int row = row0 + k;
#pragma unroll
            for (int c3 = 0; c3 < 3; ++c3) wcur[c3] = wnext[c3];
            tk = tkn;
            if (k < 7) {
#pragma unroll
                for (int c3 = 0; c3 < 3; ++c3) wnext[c3] = *(const bf16x8*)(a.Z() + (size_t)(row + 1) * ZW + 512 * c3 + 8 * lane);
                tkn = pin_load(a, row + 1, lane);
            }
            post_in_token(a, row, lane, wcs, w0, w1, w2, wcur, tk, gn);
#pragma unroll
            for (int c3 = 0; c3 < 3; ++c3) { w0[c3] = w1[c3]; w1[c3] = w2[c3]; w2[c3] = wcur[c3]; }
        }
    } else {
        {
            const int bsm = run - NPT / 8, row = NPT + bsm;
            bf16x8 w0[3], w1[3], w2[3], wcur[3];
#pragma unroll
            for (int c3 = 0; c3 < 3; ++c3) {
                const float* sp = a.state_conv + (size_t)bsm * 3 * 1536 + 512 * c3 + 8 * lane;
                float* cso = a.out + O_CSS + (size_t)bsm * 3 * 1536 + 512 * c3 + 8 * lane;
                float t0_[8], t1_[8], t2_[8], tc_[8];
#pragma unroll
                for (int e = 0; e < 8; ++e) { t0_[e] = sp[e]; t1_[e] = sp[1536 + e]; t2_[e] = sp[2 * 1536 + e]; }
                wcur[c3] = *(const bf16x8*)(a.Z() + (size_t)row * ZW + 512 * c3 + 8 * lane); bf8_to_f32(wcur[c3], tc_);
#pragma unroll
                for (int e = 0; e < 8; ++e) { cso[e] = t1_[e]; cso[1536 + e] = t2_[e]; cso[2 * 1536 + e] = tc_[e]; }
                w0[c3] = f32_to_bf8(t0_); w1[c3] = f32_to_bf8(t1_); w2[c3] = f32_to_bf8(t2_);
            }
            post_in_token(a, row, lane, wcs, w0, w1, w2, wcur, pin_load(a, row, lane), gn);
        }
    }
}

__device__ __forceinline__ void post_q_item(const MK& a, int idx, int lane) {
    const int row = idx >> 3, h = idx & 7;
    const float* q = a.Q() + (size_t)row * 768 + h * 96;
    float* o = a.qh() + ((size_t)row * 8 + h) * 96;
    const float v = q[lane];
    const float ss = wave_sum(v * v);
    o[lane] = v * rsqrtf(ss * (1.f / 64.f) + EPSV) * a.g_q_nope[lane];
    const float r = lane < 32 ? q[64 + lane] : 0.f;
    const float s2 = wave_sum(r * r);
    const float xn = lane < 32 ? r * rsqrtf(s2 * (1.f / 32.f) + EPSV) * a.g_q_rope[lane] : 0.f;
    const float other = __shfl_xor(xn, 16);
    const int i = lane & 15;
    const float* tb = a.ropecs() + (size_t)(row >= NPT ? 2048 : (row & 2047)) * 32;
    const float cs = tb[i], sn = tb[16 + i];
    const float ov = lane < 16 ? xn * cs - other * sn : other * sn + xn * cs;
    if (lane < 32) o[64 + lane] = ov;
}
__device__ __forceinline__ void post_kv_item(const MK& a, int idx, int lane) {
    const int row = idx >> 3, h = idx & 7;
    const float v = a.KV()[(size_t)row * 1024 + h * 128 + lane];
    const float ss = wave_sum(v * v);
    const float kn = v * rsqrtf(ss * (1.f / 64.f) + EPSV) * a.g_k_nope[lane];
    a.kh()[((size_t)row * 8 + h) * 64 + lane] = kn;
}

typedef float f32x16 __attribute__((ext_vector_type(16)));
typedef short s16x4 __attribute__((ext_vector_type(4)));
#define KST 104
#define VST 72
#define ATT_BUF (64 * KST * 2 + 64 * VST * 2)
__device__ __forceinline__ int crow32(int r, int hi) { return (r & 3) + 8 * (r >> 2) + 4 * hi; }
__device__ __forceinline__ s16x4 tr_read(const bf16_t* p) { return __builtin_bit_cast(s16x4, __builtin_amdgcn_ds_read_tr16_b64_v4i16((LAS s16x4*)(LAS void*)(unsigned)(size_t)p)); }
__device__ __forceinline__ bf16x8 pack8(const f32x16& x, int s) {
    u32x4 w; w.x = cvtpk(x[8 * s], x[8 * s + 1]); w.y = cvtpk(x[8 * s + 2], x[8 * s + 3]); w.z = cvtpk(x[8 * s + 4], x[8 * s + 5]); w.w = cvtpk(x[8 * s + 6], x[8 * s + 7]);
    return __builtin_bit_cast(bf16x8, w);
}
__device__ __forceinline__ void attn_block(const MK& a, int b, int h, int qb, char* smem) {
    const int tid = otid(), lane = tid & 63, wid = tid >> 6, r32 = lane & 31, hi = lane >> 5;
    const int qrow = qb * 256 + wid * 32 + r32;
    const int wq0 = qb * 256 + wid * 32;
    bf16x8 qf[6];
    {
        const float SCL = 0.14724445f;
        const bf16_t* Qg = a.qraw() + ((size_t)b * SEQ + qrow) * 768 + h * 96 + 8 * hi;
        float qv[6][8];
#pragma unroll
        for (int ds = 0; ds < 6; ++ds) bf8_to_f32(*(const bf16x8*)(Qg + 16 * ds), qv[ds]);
        float sn_ = 0.f, sr_ = 0.f;
#pragma unroll
        for (int j = 0; j < 8; ++j) { sn_ += qv[0][j] * qv[0][j] + qv[1][j] * qv[1][j] + qv[2][j] * qv[2][j] + qv[3][j] * qv[3][j]; sr_ += qv[4][j] * qv[4][j] + qv[5][j] * qv[5][j]; }
        sn_ = add_x32(sn_); sr_ = add_x32(sr_);
        const float rsn = rsqrtf(sn_ * (1.f / 64.f) + EPSV) * SCL, rsr = rsqrtf(sr_ * (1.f / 32.f) + EPSV);
#pragma unroll
        for (int ds = 0; ds < 4; ++ds) {
            float o[8];
#pragma unroll
            for (int j = 0; j < 8; ++j) o[j] = qv[ds][j] * rsn * a.g_q_nope[16 * ds + 8 * hi + j];
            qf[ds] = f32_to_bf8(o);
        }
        const float* tb = a.ropecs() + (size_t)qrow * 32 + 8 * hi;
        float o4[8], o5[8];
#pragma unroll
        for (int j = 0; j < 8; ++j) {
            const float x1 = qv[4][j] * rsr * a.g_q_rope[8 * hi + j], x2 = qv[5][j] * rsr * a.g_q_rope[16 + 8 * hi + j], cs = tb[j], sn = tb[16 + j];
            o4[j] = (x1 * cs - x2 * sn) * SCL; o5[j] = (x1 * sn + x2 * cs) * SCL;
        }
        qf[4] = f32_to_bf8(o4); qf[5] = f32_to_bf8(o5);
    }
    f32x16 o0, o1;
#pragma unroll
    for (int r = 0; r < 16; ++r) { o0[r] = 0.f; o1[r] = 0.f; }
    float m = 0.f, l = 0.f;
    f32x16 negm;
#pragma unroll
    for (int r = 0; r < 16; ++r) negm[r] = 0.f;
    const int nt = qb * 4 + 4;
    const int vr = tid >> 3, vc = tid & 7, rr_ = (tid >> 2) & 63, rc = tid & 3;
    const bf16_t* KVg = a.kvraw() + (size_t)b * SEQ * 1024 + h * 128 + (size_t)vr * 1024 + vc * 8;
    const bf16_t* KRg = a.krb() + (size_t)b * SEQ * 32 + (size_t)rr_ * 32 + rc * 8;
    float gk[8];
#pragma unroll
    for (int j = 0; j < 8; ++j) gk[j] = a.g_k_nope[8 * vc + j];
    bf16x8 kr0, kr1, vr0;
#define ATT_LOAD(tt) do { kr0 = *(const bf16x8*)(KVg + (size_t)(tt) * 64 * 1024); vr0 = *(const bf16x8*)(KVg + (size_t)(tt) * 64 * 1024 + 64); if (tid < 256) kr1 = *(const bf16x8*)(KRg + (size_t)(tt) * 64 * 32); } while (0)
#define ATT_STORE(buf) do { bf16_t* Ks_ = (bf16_t*)(smem + (buf) * ATT_BUF); bf16_t* Vs_ = Ks_ + 64 * KST; \
        float x_[8]; bf8_to_f32(kr0, x_); float ss_ = 0.f; _Pragma("unroll") for (int j = 0; j < 8; ++j) ss_ += x_[j] * x_[j]; \
        ss_ = sum8(ss_); const float rs_ = rsqrtf(ss_ * (1.f / 64.f) + EPSV); \
        _Pragma("unroll") for (int j = 0; j < 8; ++j) x_[j] *= rs_ * gk[j]; \
        *(bf16x8*)(Ks_ + vr * KST + vc * 8) = f32_to_bf8(x_); *(bf16x8*)(Vs_ + vr * VST + vc * 8) = vr0; \
        if (tid < 256) *(bf16x8*)(Ks_ + rr_ * KST + 64 + rc * 8) = kr1; } while (0)
    ATT_LOAD(0);
    __syncthreads();
    ATT_STORE(0);
    __syncthreads();
    const int i16 = lane & 15, qq = i16 >> 2, pp = i16 & 3, g1 = (lane >> 4) & 1;
    for (int t = 0; t < nt; ++t) {
        const bf16_t* Ks = (const bf16_t*)(smem + (t & 1) * ATT_BUF); const bf16_t* Vs = Ks + 64 * KST;
        if (t + 1 < nt) ATT_LOAD(t + 1);
        if (64 * t <= wq0 + 31) {
            f32x16 p0, p1;
#pragma unroll
            for (int ds = 0; ds < 6; ++ds) {
                const bf16x8 k0 = *(const bf16x8*)(Ks + r32 * KST + 16 * ds + 8 * hi);
                const bf16x8 k1 = *(const bf16x8*)(Ks + (32 + r32) * KST + 16 * ds + 8 * hi);
                if (ds == 0) { p0 = __builtin_amdgcn_mfma_f32_32x32x16_bf16(k0, qf[ds], negm, 0, 0, 0); p1 = __builtin_amdgcn_mfma_f32_32x32x16_bf16(k1, qf[ds], negm, 0, 0, 0); }
                else { p0 = __builtin_amdgcn_mfma_f32_32x32x16_bf16(k0, qf[ds], p0, 0, 0, 0); p1 = __builtin_amdgcn_mfma_f32_32x32x16_bf16(k1, qf[ds], p1, 0, 0, 0); }
            }
            if (64 * t + 63 > wq0) {
#pragma unroll
                for (int r = 0; r < 16; ++r) { const int kv = 64 * t + crow32(r, hi); if (kv > qrow) p0[r] = -INFINITY; if (kv + 32 > qrow) p1[r] = -INFINITY; }
            }
            float mx = fmaxf(p0[0], p1[0]);
#pragma unroll
            for (int r = 1; r < 16; ++r) mx = fmaxf(mx, fmaxf(p0[r], p1[r]));
            mx = max_x32(mx);
            const float delta = t == 0 ? mx : fmaxf(mx, 0.f);
            if (__any(delta != 0.f)) {
                m += delta;
                const float f = t == 0 ? 1.f : __builtin_amdgcn_exp2f(-delta);
#pragma unroll
                for (int r = 0; r < 16; ++r) { p0[r] -= delta; p1[r] -= delta; negm[r] = -m; o0[r] *= f; o1[r] *= f; }
                l *= f;
            }
            float rs = 0.f;
#pragma unroll
            for (int r = 0; r < 16; ++r) { p0[r] = __builtin_amdgcn_exp2f(p0[r]); p1[r] = __builtin_amdgcn_exp2f(p1[r]); rs += p0[r] + p1[r]; }
            l += rs;
            bf16x8 pf[4];
            pf[0] = pack8(p0, 0); pf[1] = pack8(p0, 1); pf[2] = pack8(p1, 0); pf[3] = pack8(p1, 1);
#pragma unroll
            for (int ks = 0; ks < 4; ++ks) {
                const bf16_t* vb0 = Vs + (16 * ks + 4 * hi + qq) * VST + 16 * g1 + 4 * pp;
                const s16x4 a0 = tr_read(vb0), a1 = tr_read(vb0 + 8 * VST);
                const s16x4 c0 = tr_read(vb0 + 32), c1 = tr_read(vb0 + 8 * VST + 32);
                const bf16x8 va = __builtin_shufflevector(a0, a1, 0, 1, 2, 3, 4, 5, 6, 7);
                const bf16x8 vc_ = __builtin_shufflevector(c0, c1, 0, 1, 2, 3, 4, 5, 6, 7);
                o0 = __builtin_amdgcn_mfma_f32_32x32x16_bf16(va, pf[ks], o0, 0, 0, 0);
                o1 = __builtin_amdgcn_mfma_f32_32x32x16_bf16(vc_, pf[ks], o1, 0, 0, 0);
            }
        }
        if (t + 1 < nt) ATT_STORE((t + 1) & 1);
        __syncthreads();
    }
    l = add_x32(l);
    const float il = 1.f / l;
    bf16_t* op = a.omix() + ((size_t)b * SEQ + qrow) * 1024 + 512 + h * 64;
#pragma unroll
    for (int g = 0; g < 4; ++g) {
        uint2 w0, w1;
        w0.x = pk2bf(o0[4 * g] * il, o0[4 * g + 1] * il); w0.y = pk2bf(o0[4 * g + 2] * il, o0[4 * g + 3] * il);
        w1.x = pk2bf(o1[4 * g] * il, o1[4 * g + 1] * il); w1.y = pk2bf(o1[4 * g + 2] * il, o1[4 * g + 3] * il);
        *(uint2*)(op + 8 * g + 4 * hi) = w0;
        *(uint2*)(op + 32 + 8 * g + 4 * hi) = w1;
    }
#undef ATT_LOAD
#undef ATT_STORE
}

__device__ __forceinline__ void gdn_unit(const MK& a, int b, int h, int dvg, const float* s0, float* sout, int row0, int T, int lane, char* wsm) {
    float (*sq)[64] = (float (*)[64])wsm;
    float (*sk)[64] = (float (*)[64])(wsm + 4096);
    float (*sv)[8] = (float (*)[8])(wsm + 8192);
    float* sg = (float*)(wsm + 8704);
    float* sb = (float*)(wsm + 8768);
    const int e = lane & 7, ko = lane >> 3, col = dvg * 8 + e;
    float S[8];
#pragma unroll
    for (int d = 0; d < 8; ++d) S[d] = s0 ? s0[(((size_t)b * 8 + h) * 64 + ko * 8 + d) * 64 + col] : 0.f;
    const size_t rbase = (size_t)row0 + (size_t)b * T;
    float pq[16], pk[16], pv0, pv1, pgb;
    {
        const int nt = T < 16 ? T : 16;
#pragma unroll
        for (int j = 0; j < 16; ++j) { const bool ok = j < nt; const size_t r = rbase + (ok ? j : 0); pq[j] = ok ? bf2f(a.qkv()[r * 1536 + h * 64 + lane]) : 0.f; pk[j] = ok ? bf2f(a.qkv()[r * 1536 + 512 + h * 64 + lane]) : 0.f; }
        { const int j0 = lane >> 3, j1 = j0 + 8; pv0 = j0 < nt ? bf2f(a.qkv()[(rbase + j0) * 1536 + 1024 + h * 64 + dvg * 8 + (lane & 7)]) : 0.f; pv1 = j1 < nt ? bf2f(a.qkv()[(rbase + j1) * 1536 + 1024 + h * 64 + dvg * 8 + (lane & 7)]) : 0.f; }
        { const int j = lane & 15; pgb = j < nt ? (lane < 16 ? a.gg()[(rbase + j) * 8 + h] : a.bb()[(rbase + j) * 8 + h]) : 0.f; }
    }
    for (int t0 = 0; t0 < T; t0 += 16) {
        const int nt = (T - t0) < 16 ? (T - t0) : 16;
        WSYNC();
#pragma unroll
        for (int j = 0; j < 16; ++j) { sq[j][lane] = pq[j]; sk[j][lane] = pk[j]; }
        sv[lane >> 3][lane & 7] = pv0; sv[(lane >> 3) + 8][lane & 7] = pv1;
        if (lane < 16) sg[lane] = expf(pgb); else if (lane < 32) sb[lane - 16] = pgb;
        WSYNC();
        if (t0 + 16 < T) {
            const size_t rb = rbase + t0 + 16;
#pragma unroll
            for (int j = 0; j < 16; ++j) { pq[j] = bf2f(a.qkv()[(rb + j) * 1536 + h * 64 + lane]); pk[j] = bf2f(a.qkv()[(rb + j) * 1536 + 512 + h * 64 + lane]); }
            pv0 = bf2f(a.qkv()[(rb + (lane >> 3)) * 1536 + 1024 + h * 64 + dvg * 8 + (lane & 7)]); pv1 = bf2f(a.qkv()[(rb + (lane >> 3) + 8) * 1536 + 1024 + h * 64 + dvg * 8 + (lane & 7)]);
            pgb = lane < 16 ? a.gg()[(rb + (lane & 15)) * 8 + h] : a.bb()[(rb + (lane & 15)) * 8 + h];
        }
        for (int j = 0; j < nt; ++j) {
            const float dec = sg[j], be = sb[j], v = sv[j][e];
            const float4 k0 = *(const float4*)&sk[j][ko * 8], k1 = *(const float4*)&sk[j][ko * 8 + 4];
            const float4 q0 = *(const float4*)&sq[j][ko * 8], q1 = *(const float4*)&sq[j][ko * 8 + 4];
            const float kk[8] = {k0.x, k0.y, k0.z, k0.w, k1.x, k1.y, k1.z, k1.w};
            const float qq[8] = {q0.x, q0.y, q0.z, q0.w, q1.x, q1.y, q1.z, q1.w};
            float ks = 0.f;
#pragma unroll
            for (int d = 0; d < 8; ++d) { S[d] *= dec; ks += kk[d] * S[d]; }
            ks += __shfl_xor(ks, 8); ks += __shfl_xor(ks, 16); ks += __shfl_xor(ks, 32);
            const float delta = (v - ks) * be;
            float ov = 0.f;
#pragma unroll
            for (int d = 0; d < 8; ++d) { S[d] += kk[d] * delta; ov += qq[d] * S[d]; }
            ov += __shfl_xor(ov, 8); ov += __shfl_xor(ov, 16); ov += __shfl_xor(ov, 32);
            if (ko == 0) a.goraw()[(rbase + t0 + j) * 512 + h * 64 + col] = ov;
        }
    }
#pragma unroll
    for (int d = 0; d < 8; ++d) sout[(((size_t)b * 8 + h) * 64 + ko * 8 + d) * 64 + col] = S[d];
}
__device__ __forceinline__ int pi_pos(int k) { return (k & 32) + 8 * ((k >> 2) & 3) + 4 * ((k >> 4) & 1) + (k & 3); }
#define GDN_WLDS 17408
__device__ __forceinline__ void gdn_prep_unit(const MK& a, int u, int lane_in, char* wsm) {
    int lane = lane_in; asm volatile("" : "+v"(lane));
    const int bh = u >> 5, n = u & 31, b = bh >> 3, h = bh & 7, i16 = lane & 15, q4 = lane >> 4;
    const size_t row0 = (size_t)b * SEQ + n * 64;
    float* AT = (float*)wsm; float* GC = (float*)(wsm + 16384); float* BT = GC + 64;
    const bf16_t* qbase = a.qkv() + row0 * 1536 + h * 64; const bf16_t* kbase = qbase + 512; const bf16_t* vbase = qbase + 1024;
    float g = a.gg()[(row0 + lane) * 8 + h];
    const float be_l = a.bb()[(row0 + lane) * 8 + h];
#pragma unroll
    for (int o = 1; o < 64; o <<= 1) { const float t = __shfl_up(g, o); if (lane >= o) g += t; }
    WSYNC();
    GC[lane] = g; BT[lane] = be_l;
    WSYNC();
    const float gl = GC[63];
    float* EG = BT + 64; float* ED = EG + 64;
    EG[lane] = expf(g); ED[lane] = expf(gl - g);
    WSYNC();
    bf16x8 kf[4][2], qf[4][2];
#pragma unroll
    for (int mt = 0; mt < 4; ++mt)
#pragma unroll
        for (int ks = 0; ks < 2; ++ks) {
            const int off = (16 * mt + i16) * 1536 + 32 * ks + 8 * q4;
            kf[mt][ks] = *(const bf16x8*)(kbase + off); qf[mt][ks] = *(const bf16x8*)(qbase + off);
        }
    bf16_t* QKg = a.gQK() + (size_t)u * 4096;
#pragma unroll
    for (int mt = 0; mt < 4; ++mt)
#pragma unroll
        for (int nt = 0; nt < 4; ++nt) {
            const int j = 16 * nt + i16, pj = 32 * (nt >> 1) + 8 * (i16 >> 2) + 4 * (nt & 1) + (i16 & 3);
            if (nt <= mt) {
                f32x4 d1 = {0.f, 0.f, 0.f, 0.f}, d2 = {0.f, 0.f, 0.f, 0.f};
#pragma unroll
                for (int ks = 0; ks < 2; ++ks) {
                    d1 = __builtin_amdgcn_mfma_f32_16x16x32_bf16(kf[mt][ks], kf[nt][ks], d1, 0, 0, 0);
                    d2 = __builtin_amdgcn_mfma_f32_16x16x32_bf16(qf[mt][ks], kf[nt][ks], d2, 0, 0, 0);
                }
                const float gcj = GC[j];
#pragma unroll
                for (int r = 0; r < 4; ++r) {
                    const int i = 16 * mt + 4 * q4 + r;
                    const float dec = __builtin_amdgcn_exp2f(1.44269504f * (GC[i] - gcj));
                    AT[i * 64 + j] = (i > j) ? BT[i] * d1[r] * dec : 0.f;
                    QKg[i * 64 + (((pj >> 3) ^ (i & 7)) << 3) + (pj & 7)] = f2bf((i >= j) ? d2[r] * dec : 0.f);
                }
            } else {
#pragma unroll
                for (int r = 0; r < 4; ++r) { const int i = 16 * mt + 4 * q4 + r; QKg[i * 64 + (((pj >> 3) ^ (i & 7)) << 3) + (pj & 7)] = 0; }
            }
        }
    {
        bf16_t* Qgg = a.gQg() + (size_t)u * 4096;
#pragma unroll
        for (int mt = 0; mt < 4; ++mt) {
            const int i = 16 * mt + i16; const float e = EG[i];
#pragma unroll
            for (int ks = 0; ks < 2; ++ks) {
                float x[8]; bf8_to_f32(qf[mt][ks], x);
                uint2 w0, w1; w0.x = cvtpk(x[0] * e, x[1] * e); w0.y = cvtpk(x[2] * e, x[3] * e); w1.x = cvtpk(x[4] * e, x[5] * e); w1.y = cvtpk(x[6] * e, x[7] * e);
                const int p0 = 32 * ks + 16 * (q4 & 1) + 4 * (q4 >> 1);
                *(uint2*)(Qgg + i * 64 + (((p0 >> 3) ^ (i & 7)) << 3) + (p0 & 7)) = w0; *(uint2*)(Qgg + i * 64 + ((((p0 >> 3) + 1) ^ (i & 7)) << 3) + (p0 & 7)) = w1;
            }
        }
    }
    WSYNC();
    __builtin_amdgcn_sched_barrier(0);
    {
        const float* Nb = AT + (16 * q4) * 64 + 16 * q4;
        float t[16];
#pragma unroll
        for (int r = 0; r < 16; ++r) t[r] = (r == i16) ? 1.f : 0.f;
#pragma unroll
        for (int r = 1; r < 16; ++r) {
            float sacc = 0.f;
#pragma unroll
            for (int j4 = 0; j4 < r; j4 += 4) {
                const float4 av = *(const float4*)(Nb + r * 64 + j4);
                sacc += av.x * t[j4];
                if (j4 + 1 < r) sacc += av.y * t[j4 + 1];
                if (j4 + 2 < r) sacc += av.z * t[j4 + 2];
                if (j4 + 3 < r) sacc += av.w * t[j4 + 3];
            }
            t[r] -= sacc;
        }
        WSYNC();
#pragma unroll
        for (int r = 0; r < 16; ++r) AT[(16 * q4 + r) * 64 + 16 * q4 + i16] = t[r];
        WSYNC();
    }
    __builtin_amdgcn_sched_barrier(0);
    {
#pragma unroll
        for (int pass = 0; pass < 2; ++pass) {
            f32x4 Y[4][4];
            const bf16_t* src = pass == 0 ? vbase : kbase;
#pragma unroll
            for (int bi = 0; bi < 4; ++bi)
#pragma unroll
                for (int r = 0; r < 4; ++r) {
                    const uint2 w = *(const uint2*)(src + (16 * bi + 4 * q4 + r) * 1536 + 4 * i16);
                    Y[bi][0][r] = __uint_as_float(w.x << 16); Y[bi][1][r] = __uint_as_float(w.x & 0xffff0000u); Y[bi][2][r] = __uint_as_float(w.y << 16); Y[bi][3][r] = __uint_as_float(w.y & 0xffff0000u);
                }
            if (pass == 1) {
#pragma unroll
                for (int nt = 0; nt < 4; ++nt) {
                    bf16_t* Kdg = a.gKd() + ((size_t)u * 64 + 4 * i16 + nt) * 64;
#pragma unroll
                    for (int bi = 0; bi < 4; ++bi) {
                        const float4 ed = *(const float4*)(ED + 16 * bi + 4 * q4);
                        uint2 w; w.x = cvtpk(Y[bi][nt][0] * ed.x, Y[bi][nt][1] * ed.y); w.y = cvtpk(Y[bi][nt][2] * ed.z, Y[bi][nt][3] * ed.w);
                        *(uint2*)(Kdg + 8 * ((4 * (bi >> 1) + q4) ^ ((4 * i16 + nt) & 7)) + 4 * (bi & 1)) = w;
                    }
                }
            }
#pragma unroll
            for (int bi = 0; bi < 4; ++bi) {
                const float4 btv = *(const float4*)(BT + 16 * bi + 4 * q4), egv = *(const float4*)(EG + 16 * bi + 4 * q4);
                const f32x4 sc = pass == 0 ? (f32x4){btv.x, btv.y, btv.z, btv.w} : (f32x4){btv.x * egv.x, btv.y * egv.y, btv.z * egv.z, btv.w * egv.w};
#pragma unroll
                for (int nt = 0; nt < 4; ++nt) Y[bi][nt] = Y[bi][nt] * sc;
            }
#pragma unroll
            for (int bi = 0; bi < 4; ++bi) {
                f32x4 mfr[4];
#pragma unroll
                for (int bj = 0; bj <= bi; ++bj) { const f32x4 v = *(const f32x4*)(AT + (16 * bi + i16) * 64 + 16 * bj + 4 * q4); mfr[bj] = (bi == bj) ? v : -v; }
#pragma unroll
                for (int bj = 0; bj < bi; ++bj)
#pragma unroll
                    for (int s4 = 0; s4 < 4; ++s4)
#pragma unroll
                        for (int nt = 0; nt < 4; ++nt) Y[bi][nt] = __builtin_amdgcn_mfma_f32_16x16x4f32(mfr[bj][s4], Y[bj][nt][s4], Y[bi][nt], 0, 0, 0);
                f32x4 X[4];
#pragma unroll
                for (int nt = 0; nt < 4; ++nt) X[nt] = (f32x4){0.f, 0.f, 0.f, 0.f};
#pragma unroll
                for (int s4 = 0; s4 < 4; ++s4)
#pragma unroll
                    for (int nt = 0; nt < 4; ++nt) X[nt] = __builtin_amdgcn_mfma_f32_16x16x4f32(mfr[bi][s4], Y[bi][nt][s4], X[nt], 0, 0, 0);
#pragma unroll
                for (int nt = 0; nt < 4; ++nt) Y[bi][nt] = X[nt];
            }
            if (pass == 0) {
#pragma unroll
                for (int nt = 0; nt < 4; ++nt) {
                    float* UTg = a.gUT() + ((size_t)u * 64 + 4 * i16 + nt) * 64;
#pragma unroll
                    for (int bi = 0; bi < 4; ++bi) *(float4*)(UTg + 4 * ((4 * bi + q4) ^ ((4 * i16 + nt) & 15))) = (float4){Y[bi][nt][0], Y[bi][nt][1], Y[bi][nt][2], Y[bi][nt][3]};
                }
            } else {
                bf16_t* Wng = a.gWn() + (size_t)u * 4096; const int pp = pi_pos(4 * i16);
#pragma unroll
                for (int bi = 0; bi < 4; ++bi)
#pragma unroll
                    for (int r = 0; r < 4; ++r) { const int i = 16 * bi + 4 * q4 + r;
                        uint2 w; w.x = cvtpk(-Y[bi][0][r], -Y[bi][1][r]); w.y = cvtpk(-Y[bi][2][r], -Y[bi][3][r]);
                        *(uint2*)(Wng + i * 64 + (((pp >> 3) ^ (i & 7)) << 3) + (pp & 7)) = w; }
            }
            __builtin_amdgcn_sched_barrier(0);
        }
    }
    if (lane == 0) a.ggam()[u] = expf(gl);
}
__device__ __forceinline__ bf16x8 pack_acc2(const f32x4& x, const f32x4& y) {
    u32x4 w; w.x = cvtpk(x[0], x[1]); w.y = cvtpk(x[2], x[3]); w.z = cvtpk(y[0], y[1]); w.w = cvtpk(y[2], y[3]);
    return __builtin_bit_cast(bf16x8, w);
}
#define G2_SLOT 49152
__device__ __forceinline__ void g2_issue(const MK& a, size_t u, int n, LAS unsigned char* lds, int lw, int lane) {
    LAS unsigned char* dst = lds + (n % 3) * G2_SLOT;
    const char* srcs[4] = {(const char*)(a.gWn() + u * 4096), (const char*)(a.gQg() + u * 4096), (const char*)(a.gQK() + u * 4096), (const char*)(a.gKd() + u * 4096)};
#pragma unroll
    for (int m = 0; m < 4; ++m)
#pragma unroll
        for (int i = 0; i < 2; ++i) { const int piece = 2 * lw + i;
            __builtin_amdgcn_global_load_lds((const unsigned*)(srcs[m] + piece * 1024 + lane * 16), (LAS unsigned*)(dst + m * 8192 + piece * 1024), 16, 0, 0); }
    const char* us = (const char*)(a.gUT() + u * 4096);
#pragma unroll
    for (int i = 0; i < 4; ++i) { const int piece = 4 * lw + i;
        __builtin_amdgcn_global_load_lds((const unsigned*)(us + piece * 1024 + lane * 16), (LAS unsigned*)(dst + 32768 + piece * 1024), 16, 0, 0); }
}
__device__ __forceinline__ void gdn_scan_block(const MK& a, int bh, LAS unsigned char* lds) {
    const int tid = otid(), lane = tid & 63, wid = __builtin_amdgcn_readfirstlane(tid >> 6), i16 = lane & 15, q4 = lane >> 4;
    const int b = bh >> 3, h = bh & 7, sl = wid & 3;
    const bool loader = wid >= 4;
    f32x4 S[4];
#pragma unroll
    for (int mt = 0; mt < 4; ++mt) S[mt] = (f32x4){0.f, 0.f, 0.f, 0.f};
    __syncthreads();
    if (loader) { g2_issue(a, (size_t)bh * 32, 0, lds, wid - 4, lane); g2_issue(a, (size_t)bh * 32 + 1, 1, lds, wid - 4, lane); }
    for (int n = 0; n < 32; ++n) {
        if (loader) { if (n < 31) asm volatile("s_waitcnt vmcnt(12)" ::: "memory"); else asm volatile("s_waitcnt vmcnt(0)" ::: "memory"); }
        asm volatile("s_waitcnt lgkmcnt(0)" ::: "memory"); __builtin_amdgcn_s_barrier(); asm volatile("" ::: "memory");
        if (loader) { if (n + 2 < 32) g2_issue(a, (size_t)bh * 32 + n + 2, n + 2, lds, wid - 4, lane); }
        else {
            const LAS unsigned char* sb = lds + (n % 3) * G2_SLOT;
            const float gam = a.ggam()[(size_t)bh * 32 + n];
            bf16x8 Sb[2]; Sb[0] = pack_acc2(S[0], S[1]); Sb[1] = pack_acc2(S[2], S[3]);
            f32x4 Vn[4];
#pragma unroll
            for (int mt = 0; mt < 4; ++mt) Vn[mt] = *(const LAS f32x4*)(sb + 32768 + (16 * sl + i16) * 256 + 16 * ((4 * mt + q4) ^ i16));
#pragma unroll
            for (int mt = 0; mt < 4; ++mt)
#pragma unroll
                for (int ks = 0; ks < 2; ++ks) Vn[mt] = __builtin_amdgcn_mfma_f32_16x16x32_bf16(*(const LAS bf16x8*)(sb + (16 * mt + i16) * 128 + 16 * ((4 * ks + q4) ^ (i16 & 7))), Sb[ks], Vn[mt], 0, 0, 0);
            bf16x8 Vb[2]; Vb[0] = pack_acc2(Vn[0], Vn[1]); Vb[1] = pack_acc2(Vn[2], Vn[3]);
            f32x4 O[4];
#pragma unroll
            for (int mt = 0; mt < 4; ++mt) {
                O[mt] = (f32x4){0.f, 0.f, 0.f, 0.f};
#pragma unroll
                for (int ks = 0; ks < 2; ++ks) {
                    const int fo = (16 * mt + i16) * 128 + 16 * ((4 * ks + q4) ^ (i16 & 7));
                    O[mt] = __builtin_amdgcn_mfma_f32_16x16x32_bf16(*(const LAS bf16x8*)(sb + 8192 + fo), Sb[ks], O[mt], 0, 0, 0);
                    O[mt] = __builtin_amdgcn_mfma_f32_16x16x32_bf16(*(const LAS bf16x8*)(sb + 16384 + fo), Vb[ks], O[mt], 0, 0, 0);
                }
            }
#pragma unroll
            for (int mt = 0; mt < 4; ++mt) {
                S[mt] = S[mt] * gam;
#pragma unroll
                for (int ks = 0; ks < 2; ++ks) S[mt] = __builtin_amdgcn_mfma_f32_16x16x32_bf16(*(const LAS bf16x8*)(sb + 24576 + (16 * mt + i16) * 128 + 16 * ((4 * ks + q4) ^ (i16 & 7))), Vb[ks], S[mt], 0, 0, 0);
            }
            float* og = a.goraw() + ((size_t)b * SEQ + n * 64 + 4 * q4) * 512 + h * 64 + 16 * sl + i16;
#pragma unroll
            for (int mt = 0; mt < 4; ++mt)
#pragma unroll
                for (int r = 0; r < 4; ++r) og[(size_t)(16 * mt + r) * 512] = O[mt][r];
        }
    }
    if (!loader) {
        float* so = a.out + O_GSP + ((size_t)bh * 64 + 4 * q4) * 64 + 16 * sl + i16;
#pragma unroll
        for (int mt = 0; mt < 4; ++mt)
#pragma unroll
            for (int r = 0; r < 4; ++r) so[(size_t)(16 * mt + r) * 64] = S[mt][r];
    }
    __syncthreads();
}
__device__ __forceinline__ void gdn_out_token(const MK& a, int row, int lane) {
    const float* op = a.goraw() + (size_t)row * 512 + 8 * lane;
    const float4 x0 = *(const float4*)op, x1 = *(const float4*)(op + 4);
    float o[8] = {x0.x, x0.y, x0.z, x0.w, x1.x, x1.y, x1.z, x1.w}, zg[8];
    bf8_to_f32(*(const bf16x8*)(a.Z() + (size_t)row * ZW + OFF_Z + 8 * lane), zg);
    float ss = 0.f;
#pragma unroll
    for (int e = 0; e < 8; ++e) ss += o[e] * o[e];
    ss = sum8(ss);
    const float rs = rsqrtf(ss * (1.f / 64.f) + EPSV);
    const float4 g0 = *(const float4*)(a.g_gdn_out + 8 * (lane & 7)), g1 = *(const float4*)(a.g_gdn_out + 8 * (lane & 7) + 4);
    const float gg_[8] = {g0.x, g0.y, g0.z, g0.w, g1.x, g1.y, g1.z, g1.w};
#pragma unroll
    for (int e = 0; e < 8; ++e) o[e] = o[e] * rs * gg_[e] * zg[e] * fast_sigmoid(zg[e]);
    *(bf16x8*)(a.omix() + (size_t)row * 1024 + 8 * lane) = f32_to_bf8(o);
}

#define SSLOT 32768
#define TL_OFF (3 * SSLOT)
#define CST 264
#define KR_OFF (TL_OFF + 2 * 32 * CST * 2)
#define WQ_OFF (KR_OFF + 4 * 4096)
#define QR_OFF (WQ_OFF + 2048)
#define PG_OFF (QR_OFF + 1024)
#define PT_OFF (PG_OFF + 64)
#define AL_OFF (PT_OFF + 1024)
#define SAMP_LDS_END (AL_OFF + 64)
__device__ __forceinline__ void samp_issue(const MK& a, int g, LAS unsigned char* lds, int wid, int lane) {
    const int phys = __builtin_amdgcn_readfirstlane(((const LAS int*)(lds + PG_OFF))[g >> 2]);
    const int tok0 = (g & 3) * 32 + 4 * wid;
    const float* cs = a.cache_ckv + ((size_t)phys * 128 + tok0) * 256 + lane * 4;
#pragma unroll
    for (int i = 0; i < 4; ++i) __builtin_amdgcn_global_load_lds((const unsigned*)(cs + i * 256), (LAS unsigned*)(lds + (g % 3) * SSLOT + (4 * wid + i) * 1024), 16, 0, 0);
    if (wid < 4) { const int tl = lane >> 3, cg = (lane & 7) ^ (((tl >> 1) & 1) | ((wid & 1) << 2));
        __builtin_amdgcn_global_load_lds((const unsigned*)(a.cache_krope + ((size_t)phys * 128 + (g & 3) * 32 + 8 * wid + tl) * 32 + cg * 4), (LAS unsigned*)(lds + KR_OFF + (g & 3) * 4096 + wid * 1024), 16, 0, 0); }
}
typedef unsigned u32x2 __attribute__((ext_vector_type(2)));
__device__ __forceinline__ void samp_convert(int g, LAS unsigned char* lds, int tid) {
    const int st = tid >> 4, l16 = tid & 15;
    const LAS float* src = (const LAS float*)(lds + (g % 3) * SSLOT) + st * 256 + 4 * l16;
    LAS bf16_t* dst = (LAS bf16_t*)(lds + TL_OFF + (g & 1) * 32 * CST * 2) + st * CST + 4 * l16;
    f32x4 x[4];
#pragma unroll
    for (int k = 0; k < 4; ++k) x[k] = *(const LAS f32x4*)(src + 64 * k);
#pragma unroll
    for (int k = 0; k < 4; ++k) { u32x2 w; w.x = cvtpk(x[k][0], x[k][1]); w.y = cvtpk(x[k][2], x[k][3]); *(LAS u32x2*)(dst + 64 * k) = w; }
}
#define SAMP_WAITV(n5, n4) do { if (h < 4) asm volatile("s_waitcnt vmcnt(" #n5 ")" ::: "memory"); else asm volatile("s_waitcnt vmcnt(" #n4 ")" ::: "memory"); } while (0)
#define SAMP_BAR() do { asm volatile("s_waitcnt lgkmcnt(0)" ::: "memory"); __builtin_amdgcn_s_barrier(); asm volatile("" ::: "memory"); } while (0)
__device__ __forceinline__ void samp_attn_unit(const MK& a, int u, char* smem, LAS unsigned char* lds) {
    const int tid = otid(), lane = tid & 63, h = __builtin_amdgcn_readfirstlane(tid >> 6), i16 = lane & 15, q4 = lane >> 4;
    const int b = u >> 3, sp = u & 7;
    float* WQ = (float*)(smem + WQ_OFF);
    float* QR = (float*)(smem + QR_OFF);
    int* PG = (int*)(smem + PG_OFF);
    const float SCL = 0.14724445f;
    post_q_item(a, (NPT + b) * 8 + h, lane);
    __syncthreads();
    {
        const int h_ = tid >> 6, l_ = tid & 63, q4_ = l_ >> 4, idx = l_ & 15, d = 16 * (idx >> 2) + 4 * q4_ + (idx & 3);
        WQ[tid] = a.g_k_nope[d] * a.qh()[((size_t)(NPT + b) * 8 + h_) * 96 + d] * SCL;
        if (tid < 256) QR[tid] = a.qh()[((size_t)(NPT + b) * 8 + (tid >> 5)) * 96 + 64 + (tid & 31)] * SCL;
        if (tid < 16) PG[tid] = a.page_table[b * NPAGES + sp * 16 + tid];
    }
    bf16x8 wf[4][8];
#pragma unroll
    for (int mt = 0; mt < 4; ++mt)
#pragma unroll
        for (int ks = 0; ks < 8; ++ks) wf[mt][ks] = *(const bf16x8*)(a.WknT() + (size_t)(h * 64 + 16 * mt + i16) * 256 + 32 * ks + 8 * q4);
#pragma unroll
    for (int mt = 0; mt < 4; ++mt)
#pragma unroll
        for (int ks = 0; ks < 8; ++ks) asm volatile("" : "+v"(wf[mt][ks]));
    __syncthreads();
    samp_issue(a, 0, lds, h, lane); samp_issue(a, 1, lds, h, lane); samp_issue(a, 2, lds, h, lane);
    SAMP_WAITV(10, 8);
    SAMP_BAR();
    samp_convert(0, lds, tid);
    const LAS float* QRl = (const LAS float*)(lds + QR_OFF) + h * 32 + 8 * q4;
    const LAS float* WQl = (const LAS float*)(lds + WQ_OFF) + (h * 4 + q4) * 16;
    f32x4 wqr[4], qrr[2];
#pragma unroll
    for (int mt = 0; mt < 4; ++mt) wqr[mt] = *(const LAS f32x4*)(WQl + 4 * mt);
    qrr[0] = *(const LAS f32x4*)QRl; qrr[1] = *(const LAS f32x4*)(QRl + 4);
    float m = -INFINITY, lsum = 0.f;
    f32x4 latv[2]; latv[0] = (f32x4){0.f, 0.f, 0.f, 0.f}; latv[1] = (f32x4){0.f, 0.f, 0.f, 0.f};
    for (int g = 0; g < 64; ++g) {
        SAMP_BAR();
        if (g + 3 < 64) samp_issue(a, g + 3, lds, h, lane);
        const LAS bf16_t* Tl = (const LAS bf16_t*)(lds + TL_OFF + (g & 1) * 32 * CST * 2); const LAS float* KR = (const LAS float*)(lds + KR_OFF + (g & 3) * 4096);
        float scv;
        {
            float ssp[2], dotp[2], rdp[2];
            f32x4 acc[2][4];
#pragma unroll
            for (int hf = 0; hf < 2; ++hf)
#pragma unroll
                for (int mt = 0; mt < 4; ++mt) acc[hf][mt] = (f32x4){0.f, 0.f, 0.f, 0.f};
            const LAS bf16_t* cp0 = Tl + i16 * CST + 8 * q4; const LAS bf16_t* cp1 = cp0 + 16 * CST;
            bf16x8 c0 = *(const LAS bf16x8*)cp0, c1 = *(const LAS bf16x8*)cp1;
#pragma unroll
            for (int ks = 0; ks < 8; ++ks) {
                bf16x8 n0 = c0, n1 = c1;
                if (ks < 7) { n0 = *(const LAS bf16x8*)(cp0 + 32 * (ks + 1)); n1 = *(const LAS bf16x8*)(cp1 + 32 * (ks + 1)); }
#pragma unroll
                for (int mt = 0; mt < 4; ++mt) { acc[0][mt] = __builtin_amdgcn_mfma_f32_16x16x32_bf16(wf[mt][ks], c0, acc[0][mt], 0, 0, 0); acc[1][mt] = __builtin_amdgcn_mfma_f32_16x16x32_bf16(wf[mt][ks], c1, acc[1][mt], 0, 0, 0); }
                c0 = n0; c1 = n1;
            }
#pragma unroll
            for (int hf = 0; hf < 2; ++hf) {
                f32x2_t ss2 = {0.f, 0.f}, dot2 = {0.f, 0.f}, rd2 = {0.f, 0.f};
#pragma unroll
                for (int mt = 0; mt < 4; ++mt) {
                    const f32x4 wq = wqr[mt];
                    const f32x4 av = acc[hf][mt];
                    const f32x2_t lo = __builtin_shufflevector(av, av, 0, 1), hi = __builtin_shufflevector(av, av, 2, 3);
                    ss2 = __builtin_elementwise_fma(lo, lo, ss2); ss2 = __builtin_elementwise_fma(hi, hi, ss2);
                    dot2 = __builtin_elementwise_fma(lo, __builtin_shufflevector(wq, wq, 0, 1), dot2); dot2 = __builtin_elementwise_fma(hi, __builtin_shufflevector(wq, wq, 2, 3), dot2);
                }
                {
                    const int kc = (2 * q4) ^ ((i16 >> 1) & 5);
                    const LAS float* kp = KR + (16 * hf + i16) * 32;
                    const f32x4 k0 = *(const LAS f32x4*)(kp + 4 * kc), k1 = *(const LAS f32x4*)(kp + 4 * (kc ^ 1)), q0 = qrr[0], q1 = qrr[1];
                    rd2 = __builtin_elementwise_fma(__builtin_shufflevector(k0, k0, 0, 1), __builtin_shufflevector(q0, q0, 0, 1), rd2); rd2 = __builtin_elementwise_fma(__builtin_shufflevector(k0, k0, 2, 3), __builtin_shufflevector(q0, q0, 2, 3), rd2);
                    rd2 = __builtin_elementwise_fma(__builtin_shufflevector(k1, k1, 0, 1), __builtin_shufflevector(q1, q1, 0, 1), rd2); rd2 = __builtin_elementwise_fma(__builtin_shufflevector(k1, k1, 2, 3), __builtin_shufflevector(q1, q1, 2, 3), rd2);
                }
                ssp[hf] = ss2[0] + ss2[1]; dotp[hf] = dot2[0] + dot2[1]; rdp[hf] = rd2[0] + rd2[1];
            }
            const auto s1 = __builtin_amdgcn_permlane16_swap(__float_as_uint(ssp[0]), __float_as_uint(ssp[1]), false, false);
            const auto s2 = __builtin_amdgcn_permlane16_swap(__float_as_uint(dotp[0]), __float_as_uint(dotp[1]), false, false);
            const auto s3 = __builtin_amdgcn_permlane16_swap(__float_as_uint(rdp[0]), __float_as_uint(rdp[1]), false, false);
            const float u1 = __uint_as_float(s1[0]) + __uint_as_float(s1[1]), u2 = __uint_as_float(s2[0]) + __uint_as_float(s2[1]), u3 = __uint_as_float(s3[0]) + __uint_as_float(s3[1]);
            const auto t1 = __builtin_amdgcn_permlane32_swap(__float_as_uint(u1), __float_as_uint(u2), false, false);
            const float t = __uint_as_float(t1[0]) + __uint_as_float(t1[1]);
            const auto t2 = __builtin_amdgcn_permlane32_swap(__float_as_uint(t), __float_as_uint(t), false, false);
            const float ssv = __uint_as_float(t2[0]), dotv = __uint_as_float(t2[1]);
            const float rdv = add_x32(u3);
            scv = dotv * rsqrtf(ssv * (1.f / 64.f) + EPSV) + rdv;
        }
        float gm = max16(scv);
        { const auto r = __builtin_amdgcn_permlane16_swap(__float_as_uint(gm), __float_as_uint(gm), false, false); gm = fmaxf(__uint_as_float(r[0]), __uint_as_float(r[1])); }
        const float mn = fmaxf(m, gm);
        const float alpha = __builtin_amdgcn_exp2f(m - mn), pv = __builtin_amdgcn_exp2f(scv - mn);
        m = mn;
        lsum = lsum * alpha + pv;
        if (q4 < 2) { ((LAS float*)(lds + PT_OFF))[h * 32 + lane] = pv; if (lane == 0) ((LAS float*)(lds + AL_OFF))[h] = alpha; }
        if (g <= 60) SAMP_WAITV(10, 8); else if (g == 61) SAMP_WAITV(5, 4); else SAMP_WAITV(0, 0);
        SAMP_BAR();
        {
            u32x4 pw = {0u, 0u, 0u, 0u};
            if (i16 < 8) { const f32x4 pa = *(const LAS f32x4*)(lds + PT_OFF + (i16 * 32 + 8 * q4) * 4), pb_ = *(const LAS f32x4*)(lds + PT_OFF + (i16 * 32 + 8 * q4 + 4) * 4);
                pw.x = cvtpk(pa[0], pa[1]); pw.y = cvtpk(pa[2], pa[3]); pw.z = cvtpk(pb_[0], pb_[1]); pw.w = cvtpk(pb_[2], pb_[3]); }
            const bf16x8 pfr = __builtin_bit_cast(bf16x8, pw);
            const f32x4 al = *(const LAS f32x4*)(lds + AL_OFF + (q4 & 1) * 16);
            const unsigned tb0 = (unsigned)(size_t)((const LAS bf16_t*)(lds + TL_OFF + (g & 1) * 32 * CST * 2) + (8 * q4 + (i16 >> 2)) * CST + 32 * h + 4 * (i16 & 3));
            s16x4 c0[2], c1[2];
            static_assert(4 * CST * 2 == 2112, "tr offsets");
            asm volatile("ds_read_b64_tr_b16 %0, %4\n\tds_read_b64_tr_b16 %1, %4 offset:2112\n\tds_read_b64_tr_b16 %2, %4 offset:32\n\tds_read_b64_tr_b16 %3, %4 offset:2144\n\ts_waitcnt lgkmcnt(0)"
                         : "=&v"(c0[0]), "=&v"(c1[0]), "=&v"(c0[1]), "=&v"(c1[1]) : "v"(tb0) : "memory");
#pragma unroll
            for (int nt = 0; nt < 2; ++nt) {
                const bf16x8 cfr = __builtin_shufflevector(c0[nt], c1[nt], 0, 1, 2, 3, 4, 5, 6, 7);
                latv[nt] = latv[nt] * al;
                latv[nt] = __builtin_amdgcn_mfma_f32_16x16x32_bf16(pfr, cfr, latv[nt], 0, 0, 0);
            }
        }
        if (g + 1 < 64) samp_convert(g + 1, lds, tid);
    }
    lsum = add_x16(sum16(lsum));
    if (lane == 0) { float* o = a.part() + ((size_t)u * 8 + h) * 260; o[0] = m * 0.69314718f; o[1] = lsum; }
    if (q4 < 2) {
#pragma unroll
        for (int nt = 0; nt < 2; ++nt)
#pragma unroll
            for (int r = 0; r < 4; ++r) a.part()[((size_t)u * 8 + 4 * q4 + r) * 260 + 4 + 32 * h + 16 * nt + i16] = latv[nt][r];
    }
}
__device__ __forceinline__ void samp_comb_unit(const MK& a, int u, char* smem) {
    float* slat = (float*)smem; float* red = slat + 256;
    const int b = u >> 3, h = u & 7, tid = otid(), lane = tid & 63, wid = tid >> 6;
    const size_t row = NPT + b;
    const float* q = a.qh() + (row * 8 + h) * 96;
    float sp = q[lane] * a.kh()[(row * 8 + h) * 64 + lane];
    if (lane < 32) sp += q[64 + lane] * a.krf()[row * 32 + lane];
    const float s_self = wave_sum(sp) * 0.10206207261596577f;
    float pm[8], m = s_self;
#pragma unroll
    for (int s = 0; s < 8; ++s) { pm[s] = a.part()[((size_t)(b * 8 + s) * 8 + h) * 260]; m = fmaxf(m, pm[s]); }
    const float pself = __expf(s_self - m);
    float l = pself, lat = 0.f;
    __syncthreads();
#pragma unroll
    for (int s = 0; s < 8; ++s) {
        const float* p = a.part() + ((size_t)(b * 8 + s) * 8 + h) * 260;
        const float w = __expf(pm[s] - m);
        l += p[1] * w; if (tid < 256) lat += p[4 + tid] * w;
    }
    if (tid < 256) slat[tid] = lat;
    __syncthreads();
    {
        const float* wv = a.w_kv_b + (size_t)(32 * wid) * 1024 + h * 128 + 64 + lane;
        float o = 0.f;
#pragma unroll 8
        for (int c = 0; c < 32; ++c) o += slat[32 * wid + c] * wv[(size_t)c * 1024];
        red[wid * 64 + lane] = o;
    }
    __syncthreads();
    if (tid < 64) {
        float o = pself * a.KV()[row * 1024 + h * 128 + 64 + tid];
#pragma unroll
        for (int w = 0; w < 8; ++w) o += red[w * 64 + tid];
        a.omix()[row * 1024 + 512 + h * 64 + tid] = f2bf(o / l);
    }
}

#define XB_TMO      128
#define XB_XCNT(j)  (256  + 64 * (j))
#define XB_XSUB(j)  (1280 + 64 * (j))
#define XB_XGEN(j)  (2304 + 64 * (j))
#define XB_TOP      3328
#define XB_TOPGEN   3392
#define XCD_BAR_WORDS 3456
#define XB_SPIN_CAP (1u << 18)

__device__ __forceinline__ unsigned xb_ld(unsigned* p)              { return __hip_atomic_load(p, __ATOMIC_RELAXED, __HIP_MEMORY_SCOPE_AGENT); }
__device__ __forceinline__ unsigned xb_add(unsigned* p, unsigned v) { return __hip_atomic_fetch_add(p, v, __ATOMIC_RELAXED, __HIP_MEMORY_SCOPE_AGENT); }
__device__ __forceinline__ unsigned xb_xcc_id() { return (unsigned)__builtin_amdgcn_s_getreg((3 << 11) | 20) & 0xFu; }
#define XB_SPIN(cond, bar) do { unsigned _sp = 0; while (cond) { __builtin_amdgcn_s_sleep(1); \
    if ((++_sp & 255u) == 0u) { if (xb_ld(&(bar)[XB_TMO])) break; if (_sp > XB_SPIN_CAP) { atomicAdd(&(bar)[XB_TMO], 1u); break; } } } } while (0)

struct XcdBarrier {
    unsigned* bar; unsigned x;
    volatile LAS unsigned* st;
};

__device__ __forceinline__ XcdBarrier xcd_barrier_post(unsigned* bar, volatile LAS unsigned* st) {
    XcdBarrier b; b.bar = bar; b.x = xb_xcc_id(); b.st = st;
    if (threadIdx.x == 0) (void)xb_add(&bar[XB_XCNT(b.x)], 1u);
    return b;
}
__device__ __forceinline__ void xcd_barrier_complete(unsigned* bar, unsigned x, unsigned& nloc, unsigned& nx) {
    const unsigned G = gridDim.x * gridDim.y * gridDim.z;
    unsigned sum, cnt, mine, sp = 0u;
    for (;;) {
        sum = 0u; cnt = 0u; mine = 0u;
#pragma unroll
        for (unsigned j = 0; j < 16; ++j) { const unsigned c = xb_ld(&bar[XB_XCNT(j)]); sum += c; cnt += (c > 0u) ? 1u : 0u; mine = (j == x) ? c : mine; }
        if (sum == G) break;
        __builtin_amdgcn_s_sleep(1);
        if ((++sp & 255u) == 0u) { if (xb_ld(&bar[XB_TMO])) break; if (sp > XB_SPIN_CAP) { atomicAdd(&bar[XB_TMO], 1u); break; } }
    }
    nloc = mine > 0u ? mine : 1u; nx = cnt > 0u ? cnt : 1u;
}

__device__ __forceinline__ void xcd_barrier(const XcdBarrier& b) {
    asm volatile("s_waitcnt vmcnt(0)" ::: "memory");
    __syncthreads();
    if (threadIdx.x == 0) {
        unsigned* bar = b.bar;
        __builtin_amdgcn_s_waitcnt(0);
        unsigned nloc = b.st[0], nx = b.st[1];
        if (nloc == 0u) { xcd_barrier_complete(bar, b.x, nloc, nx); b.st[0] = nloc; b.st[1] = nx; }
        const unsigned old = xb_add(&bar[XB_XSUB(b.x)], 1u);
        const unsigned gen = old / nloc;
        if (old + 1u == (gen + 1u) * nloc) {
            __builtin_amdgcn_fence(__ATOMIC_RELEASE, "agent");
            asm volatile("s_waitcnt vmcnt(0)" ::: "memory");
            const unsigned og = xb_add(&bar[XB_TOP], 1u);
            const unsigned tg = og / nx;
            if (og + 1u == (tg + 1u) * nx) xb_add(&bar[XB_TOPGEN], 1u);
            else XB_SPIN(xb_ld(&bar[XB_TOPGEN]) == tg, bar);
            __builtin_amdgcn_fence(__ATOMIC_ACQUIRE, "agent");
            xb_add(&bar[XB_XGEN(b.x)], 1u);
            asm volatile("s_waitcnt vmcnt(0)" ::: "memory");
        } else {
            XB_SPIN(xb_ld(&bar[XB_XGEN(b.x)]) == gen, bar);
            __builtin_amdgcn_fence(__ATOMIC_ACQUIRE, "agent");
            asm volatile("s_waitcnt vmcnt(0)" ::: "memory");
        }
    }
    __syncthreads();
}

__device__ __forceinline__ void late_weight_items(const MK& a, int gwl, int ngwl, float* scr, int lane) {
    const int T4 = 32 * 16, T5 = 176 * 16, T7 = 32 * 44, T8 = 32 * 16, TT = T4 + T5 + T7 + T8;
    for (int it = gwl; it < TT; it += ngwl) {
        int r = it;
        if (r < T4) { const int nt_ = r % 32, kb = r / 32; wt_item(a.w_o, 1024, 32 * nt_, 32, a.WoT(), 1024, 32 * nt_, 64 * kb, scr, lane); continue; } r -= T4;
        if (r < T5) { const int nt_ = r % 176, kb = r / 176, pn = nt_ >> 3, wi = nt_ & 7;
            wt_item(wi < 4 ? a.w_gate : a.w_up, DFF, pn * 128 + (wi & 3) * 32, 32, a.WguT(), 1024, 32 * nt_, 64 * kb, scr, lane); continue; } r -= T5;
        if (r < T7) { const int nt_ = r % 32, kb = r / 32; wt_item(a.w_down, 1024, 32 * nt_, 32, a.WdT(), DFF, 32 * nt_, 64 * kb, scr, lane); continue; } r -= T7;
        { const int nt_ = r % 32, kb = r / 32; wt_item(a.w_ple_gate, 1024, 32 * nt_, 32, a.WpgT(), 1024, 32 * nt_, 64 * kb, scr, lane); }
    }
}

#define XB_ST_OFF 155648
#define LDS_BYTES 155904
static_assert(SAMP_LDS_END <= LDS_BYTES, "LDS map");
#define GSYNC() do { xcd_barrier(xbar); } while (0)
__global__ __launch_bounds__(NTHR, 2) void mega(MK a) {
    cg::grid_group grid = cg::this_grid();
    char* smem = (char*)lds_raw;
    LAS unsigned char* lds = (LAS unsigned char*)lds_raw;
    otid_init();
    if (threadIdx.x < 2) ((LAS unsigned*)(lds_raw + XB_ST_OFF))[threadIdx.x] = 0u;
    __syncthreads();
    const XcdBarrier xbar = xcd_barrier_post(a.ctl(), (volatile LAS unsigned*)(LAS void*)(lds_raw + XB_ST_OFF));
    const int bid = blockIdx.x, nb = gridDim.x, ngw = nb * NWAVE;
#define LOCAL_IDS const int tid = otid(), lane = tid & 63, wid = tid >> 6, half = tid >> 8, gw = bid * NWAVE + wid; (void)lane; (void)half; (void)gw; (void)wid;

    {
    LOCAL_IDS
    {
        const int T0 = 88 * 16, T1 = 24 * 6, T2 = 32 * 4, T3 = 16 * 4, T9 = 32 * 4;
        const int TT = T0 + T1 + T2 + T3 + T9;
        float* scr = (float*)(smem + wid * 8704);
        for (int it = gw; it < TT; it += ngw) {
            int r = it;
            if (r < T0) { const int nt_ = r % 88, kb = r / 88, nv = 2736 - 32 * nt_; wt_item(a.w_in, 2736, 32 * nt_, nv < 0 ? 0 : (nv > 32 ? 32 : nv), a.WinT(), 1024, 32 * nt_, 64 * kb, scr, lane); continue; } r -= T0;
            if (r < T1) { const int nt_ = r % 24, kb = r / 24; wt_item(a.w_q_b, 768, 32 * nt_, 32, a.WqbT(), 384, 32 * nt_, 64 * kb, scr, lane); continue; } r -= T1;
            if (r < T2) { const int nt_ = r % 32, kb = r / 32; wt_item(a.w_kv_b, 1024, 32 * nt_, 32, a.WkvT(), 256, 32 * nt_, 64 * kb, scr, lane); continue; } r -= T2;
            if (r < T3) { const int nt_ = r % 16, kb = r / 16, h = nt_ >> 1; wt_item(a.w_kv_b, 1024, h * 128 + 32 * (nt_ & 1), 32, a.WknT(), 256, 32 * nt_, 64 * kb, scr, lane); continue; } r -= T3;
            { const int nt_ = r % 32, kb = r / 32; wt_item(a.w_ple_proj, 1024, 32 * nt_, 32, a.WppT(), 256, 32 * nt_, 64 * kb, scr, lane); }
        }
        for (int e = (bid * NTHR + tid); e < 2049 * 16; e += nb * NTHR) {
            const int pos = e >> 4, i = e & 15; const float ang = (pos == 2048 ? (float)PAST : (float)pos) * powf(10000.f, -(float)i / 16.f);
            a.ropecs()[pos * 32 + i] = cosf(ang); a.ropecs()[pos * 32 + 16 + i] = sinf(ang);
        }
        for (int row = gw; row < MPAD; row += ngw) {
            const float* src = row < NPT ? a.x_prompt + (size_t)row * 1024 : a.x_sample + (size_t)(row < NTOK ? row - NPT : 0) * 1024;
            rms1024_row(src, a.g_attn, a.xn() + (size_t)row * 1024, row >= NTOK, lane);
            ushort4 w = {0, 0, 0, 0};
            if (row < NTOK) { const float* ps = row < NPT ? a.p_prompt + (size_t)row * 256 : a.p_sample + (size_t)(row - NPT) * 256; const float4 v = *(const float4*)(ps + lane * 4); w.x = f2bf(v.x); w.y = f2bf(v.y); w.z = f2bf(v.z); w.w = f2bf(v.w); }
            *(ushort4*)(a.pb() + (size_t)row * 256 + lane * 4) = w;
            if (row >= NTOK) { for (int j = 0; j < 4; ++j) { ushort4 z = {0, 0, 0, 0}; *(ushort4*)(a.omix() + (size_t)row * 1024 + lane * 4 + 256 * j) = z; } }
        }
    }
    }
    if (a.out == nullptr) grid.sync();
    GSYNC();
    {
    LOCAL_IDS
    pg_gemm(lds, a.xn(), a.WinT(), NPT, ZW, 1024, PgBf16{a.Z(), ZW});
    gemm_sample_rows_ks<false>(a.xn(), 1024, a.WinT(), 1024, ZW, EwBf16{a.Z(), ZW}, smem, bid, nb);
    }
    GSYNC();
    {
    LOCAL_IDS
    for (int e = tid; e < 4 * 1536 / 4; e += NTHR) ((float4*)smem)[e] = ((const float4*)a.w_conv)[e];
    __syncthreads();
    for (int run = gw; run < NPT / 8 + NST; run += ngw) post_in_run(a, run, lane, (const float*)smem);
    }
    GSYNC();
    {
    LOCAL_IDS
    for (int u = gw; u < 2048; u += ngw) gdn_prep_unit(a, u, lane, smem + wid * GDN_WLDS);
    }
    {
    LOCAL_IDS
    for (int v = gw; v < NST * 64; v += ngw) gdn_unit(a, v >> 6, (v >> 3) & 7, v & 7, a.state_gdn, a.out + O_GSS, NPT, 1, lane, smem + wid * GDN_WLDS);
    __syncthreads();
    }
    GSYNC();
    {
    LOCAL_IDS
    pg_gemm(lds, a.qan(), a.WqbT(), NPT, 768, 384, PgBf16{a.qraw(), 768});
    pg_gemm(lds, a.ckvb(), a.WkvT(), NPT, 1024, 256, PgBf16{a.kvraw(), 1024}, nb > 64 ? nb - 64 : 0);
    gemm_sample_rows<false>(a.qan(), 384, a.WqbT(), 384, 768, EwF32{a.Q(), 768}, smem, bid, nb, 64);
    gemm_sample_rows<false>(a.ckvb(), 256, a.WkvT(), 256, 1024, EwF32{a.KV(), 1024}, smem, bid, nb, 72);
    for (int bh_ = nb - 1 - bid; bh_ < 64; bh_ += nb) gdn_scan_block(a, bh_, lds);
    if (nb > 64 && bid < nb - 64) {
        pg_gemm(lds, a.pb(), a.WppT(), NPT, 1024, 256, PgBf16{a.PP(), 1024}, nb - 64);
        __syncthreads();
        late_weight_items(a, bid * NWAVE + wid, (nb - 64) * NWAVE, (float*)(smem + wid * 8704), lane);
    } else if (nb <= 64) { pg_gemm(lds, a.pb(), a.WppT(), NPT, 1024, 256, PgBf16{a.PP(), 1024}); __syncthreads(); late_weight_items(a, gw, ngw, (float*)(smem + wid * 8704), lane); }
    gemm_sample_rows<false>(a.pb(), 256, a.WppT(), 256, 1024, EwBf16{a.PP(), 1024}, smem, bid, nb, 80);
    }
    GSYNC();
    {
    LOCAL_IDS
    for (int idx = gw; idx < NST * 8; idx += ngw) { post_q_item(a, NPT * 8 + idx, lane); post_kv_item(a, NPT * 8 + idx, lane); }
    for (int row = gw; row < NTOK; row += ngw) gdn_out_token(a, row, lane);
    for (int pr = bid; pr < 256; pr += nb) { const int bh_ = pr >> 2, s_ = pr & 3; attn_block(a, bh_ >> 3, bh_ & 7, 7 - s_, smem); attn_block(a, bh_ >> 3, bh_ & 7, s_, smem); }
    for (int u = bid; u < NST * 8; u += nb) samp_attn_unit(a, u, smem, lds);
    }
    GSYNC();
    {
    LOCAL_IDS
    for (int u = bid; u < NST * 8; u += nb) samp_comb_unit(a, u, smem);
    }
    GSYNC();
    {
    LOCAL_IDS
    pg_gemm(lds, a.omix(), a.WoT(), NPT, 1024, 1024, PgResXB{a.x_prompt, a.H()});
    gemm_sample_rows_ks<false, EwResX, 1>(a.omix(), 1024, a.WoT(), 1024, 1024, EwResX{a.x_sample, a.H()}, smem, bid, nb);
    }
    GSYNC();
    {
    LOCAL_IDS
    for (int row = gw; row < MPAD; row += ngw) rms1024_row_b(a.H() + (size_t)row * 1024, a.g_ffn, a.un() + (size_t)row * 1024, row >= NTOK, lane);
    }
    GSYNC();
    {
    LOCAL_IDS
    pg_gemm(lds, a.un(), a.WguT(), NPT, 2 * DFF, 1024, PgSwiglu{a.hid()});
    gemm_sample_rows_ks<true>(a.un(), 1024, a.WguT(), 1024, 2 * DFF, EwBf16{a.hid(), DFF}, smem, bid, nb);
    }
    GSYNC();
    {
    LOCAL_IDS
    pg_gemm(lds, a.hid(), a.WdT(), NPT, 1024, DFF, PgResBB{a.H(), a.H2()});
    gemm_sample_rows_ks<false, EwResH, 1>(a.hid(), DFF, a.WdT(), DFF, 1024, EwResH{a.H(), a.H2()}, smem, bid, nb);
    }
    GSYNC();
    {
    LOCAL_IDS
    for (int row = gw; row < MPAD; row += ngw) rms1024_row_b(a.H2() + (size_t)row * 1024, a.g_ple, a.un2() + (size_t)row * 1024, row >= NTOK, lane);
    }
    GSYNC();
    {
    LOCAL_IDS
    pg_gemm(lds, a.un2(), a.WpgT(), NPT, 1024, 1024, PgPleB{a.H2(), a.PP(), a.out});
    gemm_sample_rows_ks<false, EwPle, 1>(a.un2(), 1024, a.WpgT(), 1024, 1024, EwPle{a.H2(), a.PP(), a.out}, smem, bid, nb);
    }
}

static inline char* carve(char*& p, size_t bytes) { char* r = p; p += (bytes + 255) & ~(size_t)255; return r; }

extern "C" void kernel_launch(void* const* d_in, const int* in_sizes, int n_in, void* d_out, int out_size, void* d_ws, size_t ws_size, hipStream_t stream) {
    MK a{};
    a.x_prompt = (const float*)d_in[0]; a.x_sample = (const float*)d_in[1]; a.cache_ckv = (const float*)d_in[2]; a.cache_krope = (const float*)d_in[3];
    a.state_gdn = (const float*)d_in[4]; a.state_conv = (const float*)d_in[5]; a.page_table = (const int*)d_in[6]; a.p_prompt = (const float*)d_in[7]; a.p_sample = (const float*)d_in[8];
    a.g_attn = (const float*)d_in[9]; a.w_in = (const float*)d_in[10]; a.w_conv = (const float*)d_in[11]; a.a_log = (const float*)d_in[12]; a.dt_bias = (const float*)d_in[13];
    a.g_gdn_out = (const float*)d_in[14]; a.g_q_a = (const float*)d_in[15]; a.w_q_b = (const float*)d_in[16]; a.g_q_nope = (const float*)d_in[17]; a.g_q_rope = (const float*)d_in[18];
    a.g_kv_a = (const float*)d_in[19]; a.g_k_rope = (const float*)d_in[20]; a.w_kv_b = (const float*)d_in[21]; a.g_k_nope = (const float*)d_in[22]; a.w_o = (const float*)d_in[23];
    a.g_ffn = (const float*)d_in[24]; a.w_gate = (const float*)d_in[25]; a.w_up = (const float*)d_in[26]; a.w_down = (const float*)d_in[27]; a.g_ple = (const float*)d_in[28];
    a.w_ple_gate = (const float*)d_in[29]; a.w_ple_proj = (const float*)d_in[30];
    a.out = (float*)d_out;
    a.ws = (char*)d_ws;
    if (WS_TOTAL > ws_size) { fprintf(stderr, "kernel_launch: workspace too small: need %zu have %zu\n", (size_t)WS_TOTAL, ws_size); return; }

    static int grid_blocks = 0;
    if (!grid_blocks) {
        int dev = 0, cus = 0, per_cu = 0;
        (void)hipGetDevice(&dev);
        (void)hipDeviceGetAttribute(&cus, hipDeviceAttributeMultiprocessorCount, dev);
        (void)hipFuncSetAttribute((const void*)mega, hipFuncAttributeMaxDynamicSharedMemorySize, LDS_BYTES);
        (void)hipOccupancyMaxActiveBlocksPerMultiprocessor(&per_cu, (const void*)mega, NTHR, LDS_BYTES);
        if (per_cu < 1) fprintf(stderr, "kernel_launch: occupancy query says %d blocks/CU\n", per_cu);
        grid_blocks = cus;
    }
    (void)hipMemsetAsync((char*)d_ws + WOF_ctl, 0, 16384, stream);
    void* args[] = {&a};
    hipError_t e = hipLaunchCooperativeKernel((const void*)mega, dim3(grid_blocks), dim3(NTHR), args, LDS_BYTES, stream);
    if (e != hipSuccess) fprintf(stderr, "cooperative launch failed: %s (grid %d)\n", hipGetErrorString(e), grid_blocks);
}
```

```cpp
#include <hip/hip_runtime.h>
#include <stdint.h>
#include <cstdio>
#include <hip/hip_cooperative_groups.h>
namespace cg = cooperative_groups;


__device__ __forceinline__ int otid();
#define PG8_TID() otid()
namespace pg8 {
#define PG8_LAS __attribute__((address_space(3)))
typedef unsigned short bf16_t;
typedef short bf16x8 __attribute__((ext_vector_type(8)));
typedef float f32x4 __attribute__((ext_vector_type(4)));
typedef unsigned u32x4 __attribute__((ext_vector_type(4)));
constexpr int BM = 256, BK = 64, HALF = 128, HTB = HALF * BK * 2  , STAGE_BYTES = 8 * HTB, NXCD = 8, WGM = 8;

__host__ __device__ __forceinline__ int lds_byte(int r, int c) { const int st = (r >> 4) * 2 + (c >> 5), rr = r & 15, cc = c & 31, ob = rr * 64 + cc * 2; return st * 1024 + (ob ^ (((ob >> 9) & 1) << 5)); }
__host__ __device__ __forceinline__ void stage_rc(int b, int& R, int& C) { const int st = b / 1024, sb = b % 1024, swz = sb ^ (((sb >> 9) & 1) << 5); R = (st >> 1) * 16 + swz / 64; C = (st & 1) * 32 + (swz % 64) / 2; }
__host__ __device__ __forceinline__ int perm32(int rho) { const int n = rho >> 4, i = rho & 15; return 8 * (i >> 2) + 4 * n + (i & 3); }

struct Unit { int pm, pn; };
struct Gemm { const bf16_t* A; const bf16_t* Bt; int M, N, K; };

struct StaticOrder {
    int nM, nN, nwg, G, c;
    __host__ __device__ void init(int M, int N, int G_, int c_) { nM = M / BM; nN = N / BM; nwg = nM * nN; G = G_; c = c_; }
    __host__ __device__ bool next(int i, Unit& u) const {
        const long L = (long)i * G + c; if (L >= nwg) return false;
        int wgid = (int)L; { const int q = nwg / NXCD, r = nwg % NXCD, xcd = wgid % NXCD, off = wgid / NXCD; wgid = (xcd < r ? xcd * (q + 1) : r * (q + 1) + (xcd - r) * q) + off; }
        const int nig = WGM * nN, gid = wgid / nig, fm = gid * WGM, gsz = (nM - fm) < WGM ? (nM - fm) : WGM;
        u.pm = fm + ((wgid % nig) % gsz); u.pn = (wgid % nig) / gsz; return true;
    }
    __device__ __forceinline__ void a_ready(const Unit&) const {}
    __device__ __forceinline__ void done(const Unit&) const {}
};

template <class Epi, class Sched, bool ALIGN_EPI = false, bool SP2 = false>
__device__ __forceinline__ void gemm_phase(PG8_LAS unsigned char* lds, const Gemm g, const Sched& S, const Epi& E) {
    const int tid = PG8_TID(), wid = __builtin_amdgcn_readfirstlane(tid >> 6), lane = tid & 63, wr = wid >> 2, wc = wid & 3, fr = lane & 15, fq = lane >> 4;
    const int K = g.K, nt = K / BK;
    unsigned voffA[2], voffB[2];
#pragma unroll
    for (int i = 0; i < 2; ++i) { int R, C; stage_rc(tid * 16 + i * 8192, R, C); const int Rb = Epi::PERM ? ((R & ~31) + perm32(R & 31)) : R;
        voffA[i] = (unsigned)(R * K + C) * 2u; voffB[i] = (unsigned)(Rb * K + C) * 2u; }
    const size_t kstep = (size_t)(BK * 2);
    const size_t hstep = (size_t)HALF * K * 2;
    const size_t tstep = 2 * hstep;
    const unsigned ldsw = (unsigned)wid * 1024u;
    const int aoff = lds_byte(wr * 64 + fr, fq * 8), boff = lds_byte(wc * 32 + fr, fq * 8);
#define PG8_SA(b, h) (((b) * 2 + (h)) * HTB)
#define PG8_SB(b, h) ((4 + (b) * 2 + (h)) * HTB)
#define PG8_STAGE(bufoff, gbase, voff) do { _Pragma("unroll") for (int _i = 0; _i < 2; ++_i) \
        __builtin_amdgcn_global_load_lds((const unsigned*)((const char*)(gbase) + (voff)[_i]), (PG8_LAS unsigned*)(lds + (bufoff) + ldsw + _i * 8192), 16, 0, 0); } while (0)
#define PG8_LDA(dst, b, h) do { _Pragma("unroll") for (int m = 0; m < 4; ++m) _Pragma("unroll") for (int k = 0; k < 2; ++k) dst[m][k] = *(const PG8_LAS bf16x8*)(lds + PG8_SA(b, h) + aoff + m * 2048 + k * 1024); } while (0)
#define PG8_LDB(dst, b, h) do { _Pragma("unroll") for (int n = 0; n < 2; ++n) _Pragma("unroll") for (int k = 0; k < 2; ++k) dst[n][k] = *(const PG8_LAS bf16x8*)(lds + PG8_SB(b, h) + boff + n * 2048 + k * 1024); } while (0)
#define PG8_MMA(ai, bj, At, Bt) do { __builtin_amdgcn_s_setprio(1); _Pragma("unroll") for (int m = 0; m < 4; ++m) _Pragma("unroll") for (int n = 0; n < 2; ++n) _Pragma("unroll") for (int k = 0; k < 2; ++k) \
        acc[ai][bj][m][n] = __builtin_amdgcn_mfma_f32_16x16x32_bf16(Bt[n][k], At[m][k], acc[ai][bj][m][n], 0, 0, 0); __builtin_amdgcn_s_setprio(0); } while (0)
#define PG8_WAIT_V(n) asm volatile("s_waitcnt vmcnt(" #n ")" ::: "memory")
#define PG8_WAIT_L(n) asm volatile("s_waitcnt lgkmcnt(" #n ")" ::: "memory")
#define PG8_BAR __builtin_amdgcn_s_barrier()
#define PG8_SCHED __builtin_amdgcn_sched_barrier(0)
    Unit cur, nxt; int ui = 0;
    if (!S.next(0, cur)) return;
    f32x4 acc[2][2][4][2];
#pragma unroll
    for (int a = 0; a < 2; ++a)
#pragma unroll
        for (int b = 0; b < 2; ++b)
#pragma unroll
            for (int m = 0; m < 4; ++m)
#pragma unroll
                for (int n = 0; n < 2; ++n) acc[a][b][m][n] = (f32x4){0.f, 0.f, 0.f, 0.f};
    bf16x8 At[4][2], B0[2][2], B1[2][2];
    const char* cA = (const char*)g.A + (size_t)cur.pm * tstep; const char* cB = (const char*)g.Bt + (size_t)cur.pn * tstep;
    S.a_ready(cur);
    if constexpr (SP2) {
        PG8_STAGE(PG8_SB(0, 0), cB, voffB); PG8_STAGE(PG8_SB(0, 1), cB + hstep, voffB); PG8_STAGE(PG8_SA(0, 0), cA, voffA); PG8_STAGE(PG8_SA(0, 1), cA + hstep, voffA);
        if (wr == 1) PG8_BAR;
        PG8_WAIT_V(2); PG8_BAR;
        PG8_STAGE(PG8_SB(1, 0), cB + kstep, voffB); PG8_STAGE(PG8_SA(1, 0), cA + kstep, voffA); PG8_STAGE(PG8_SB(1, 1), cB + hstep + kstep, voffB);
        PG8_WAIT_V(6); PG8_BAR;
    } else {
        PG8_STAGE(PG8_SB(0, 0), cB, voffB); PG8_STAGE(PG8_SA(0, 0), cA, voffA); PG8_STAGE(PG8_SB(0, 1), cB + hstep, voffB); PG8_STAGE(PG8_SA(0, 1), cA + hstep, voffA);
        if (wr == 1) PG8_BAR;
        PG8_WAIT_V(4); PG8_BAR;
        PG8_STAGE(PG8_SB(1, 0), cB + kstep, voffB); PG8_STAGE(PG8_SA(1, 0), cA + kstep, voffA); PG8_STAGE(PG8_SB(1, 1), cB + hstep + kstep, voffB);
        PG8_WAIT_V(6); PG8_BAR;
    }
    for (;;) {
        const bool has_next = S.next(ui + 1, nxt);
        const char* nA = has_next ? (const char*)g.A + (size_t)nxt.pm * tstep : cA; const char* nB = has_next ? (const char*)g.Bt + (size_t)nxt.pn * tstep : cB;
        for (int t = 0; t < nt; t += 2) {
            const bool last = (t == nt - 2);
            const char* a1 = cA + (size_t)(t + 1) * kstep;
            const char* a2 = last ? nA : cA + (size_t)(t + 2) * kstep; const char* b2 = last ? nB : cB + (size_t)(t + 2) * kstep;
            const char* a3 = a2 + kstep; const char* b3 = b2 + kstep;
            if (last && has_next) S.a_ready(nxt);
            if constexpr (SP2) {
            PG8_LDB(B0, 0, 0); PG8_LDB(B1, 0, 1); PG8_SCHED; PG8_LDA(At, 0, 0); PG8_STAGE(PG8_SA(1, 1), a1 + hstep, voffA);
            PG8_WAIT_V(8); PG8_WAIT_L(0); PG8_BAR; PG8_MMA(0, 0, At, B0); PG8_MMA(0, 1, At, B1); PG8_BAR; PG8_SCHED;
            PG8_LDA(At, 0, 1); PG8_STAGE(PG8_SB(0, 0), b2, voffB); PG8_STAGE(PG8_SB(0, 1), b2 + hstep, voffB); PG8_STAGE(PG8_SA(0, 0), a2, voffA);
            PG8_WAIT_V(8); PG8_WAIT_L(0); PG8_BAR; PG8_MMA(1, 0, At, B0); PG8_MMA(1, 1, At, B1); PG8_BAR; PG8_SCHED;
            PG8_LDB(B0, 1, 0); PG8_LDB(B1, 1, 1); PG8_SCHED; PG8_LDA(At, 1, 0); PG8_STAGE(PG8_SA(0, 1), a2 + hstep, voffA);
            PG8_WAIT_V(8); PG8_WAIT_L(0); PG8_BAR; PG8_MMA(0, 0, At, B0); PG8_MMA(0, 1, At, B1); PG8_BAR; PG8_SCHED;
            PG8_LDA(At, 1, 1); PG8_STAGE(PG8_SB(1, 0), b3, voffB); PG8_STAGE(PG8_SB(1, 1), b3 + hstep, voffB); PG8_STAGE(PG8_SA(1, 0), a3, voffA);
            PG8_WAIT_V(8); PG8_WAIT_L(0); PG8_BAR; PG8_MMA(1, 0, At, B0); PG8_MMA(1, 1, At, B1); PG8_BAR; PG8_SCHED;
            } else {
            PG8_LDB(B0, 0, 0); PG8_SCHED; PG8_LDA(At, 0, 0); PG8_STAGE(PG8_SA(1, 1), a1 + hstep, voffA);
            PG8_WAIT_L(8); PG8_BAR; PG8_WAIT_L(0); PG8_MMA(0, 0, At, B0); PG8_BAR; PG8_SCHED;
            PG8_LDB(B1, 0, 1); PG8_STAGE(PG8_SB(0, 0), b2, voffB);
            PG8_BAR; PG8_WAIT_L(0); PG8_MMA(0, 1, At, B1); PG8_BAR;
            PG8_LDA(At, 0, 1); PG8_STAGE(PG8_SA(0, 0), a2, voffA);
            PG8_BAR; PG8_WAIT_L(0); PG8_MMA(1, 0, At, B0); PG8_BAR; PG8_SCHED;
            PG8_STAGE(PG8_SB(0, 1), b2 + hstep, voffB);
            PG8_WAIT_V(6); PG8_BAR; PG8_MMA(1, 1, At, B1); PG8_BAR;
            PG8_LDB(B0, 1, 0); PG8_SCHED; PG8_LDA(At, 1, 0); PG8_STAGE(PG8_SA(0, 1), a2 + hstep, voffA);
            PG8_WAIT_L(8); PG8_BAR; PG8_WAIT_L(0); PG8_MMA(0, 0, At, B0); PG8_BAR; PG8_SCHED;
            PG8_LDB(B1, 1, 1); PG8_STAGE(PG8_SB(1, 0), b3, voffB);
            PG8_BAR; PG8_WAIT_L(0); PG8_MMA(0, 1, At, B1); PG8_BAR;
            PG8_LDA(At, 1, 1); PG8_STAGE(PG8_SA(1, 0), a3, voffA);
            PG8_BAR; PG8_WAIT_L(0); PG8_MMA(1, 0, At, B0); PG8_BAR; PG8_SCHED;
            PG8_STAGE(PG8_SB(1, 1), b3 + hstep, voffB);
            PG8_WAIT_V(6); PG8_BAR; PG8_MMA(1, 1, At, B1); PG8_BAR;
            }
        }
        if constexpr (ALIGN_EPI) { if (wr == 0) PG8_BAR; }
        if constexpr (!Epi::AFTER_DRAIN) { E(acc, cur, wr, wc, fr, fq); S.done(cur); }
        if (!has_next) break;
#pragma unroll
        for (int a = 0; a < 2; ++a)
#pragma unroll
            for (int b = 0; b < 2; ++b)
#pragma unroll
                for (int m = 0; m < 4; ++m)
#pragma unroll
                    for (int n = 0; n < 2; ++n) acc[a][b][m][n] = (f32x4){0.f, 0.f, 0.f, 0.f};
        cur = nxt; cA = nA; cB = nB; ++ui;
        if constexpr (ALIGN_EPI) { if (wr == 1) PG8_BAR; }
    }
    PG8_WAIT_V(0);
    if constexpr (!ALIGN_EPI) { if (wr == 0) PG8_BAR; }
    PG8_BAR;
    if constexpr (Epi::AFTER_DRAIN) { E.fused(acc, cur, wr, wc, fr, fq, lds, wid, lane); S.done(cur); }
#undef PG8_SA
#undef PG8_SB
#undef PG8_STAGE
#undef PG8_LDA
#undef PG8_LDB
#undef PG8_MMA
#undef PG8_WAIT_V
#undef PG8_WAIT_L
#undef PG8_BAR
#undef PG8_SCHED
}
}

#define WTAB_OFF 155392
extern __shared__ __attribute__((aligned(16))) unsigned char lds_raw[];
__device__ __forceinline__ int hw_slot() { return (int)(__builtin_amdgcn_s_getreg((5 << 11) | 4) & 63u); }
__device__ __forceinline__ void otid_init() { const int t = threadIdx.x; if ((t & 63) == 0) ((__attribute__((address_space(3))) int*)(__attribute__((address_space(3))) void*)(lds_raw + WTAB_OFF))[hw_slot()] = t >> 6; }
__device__ __forceinline__ int otid() {
    const int w = __builtin_amdgcn_readfirstlane(((const __attribute__((address_space(3))) int*)(__attribute__((address_space(3))) void*)(lds_raw + WTAB_OFF))[hw_slot()]);
    int l; asm volatile("v_mbcnt_lo_u32_b32 %0, -1, 0\n\tv_mbcnt_hi_u32_b32 %0, -1, %0" : "=v"(l));
    return (w << 6) + l;
}
using pg8::bf16_t; using pg8::bf16x8; using pg8::f32x4; using pg8::u32x4;
#define LAS __attribute__((address_space(3)))

#define DMODEL 1024
#define NPT 16384
#define NST 32
#define NTOK 16416
#define MPAD 16640
#define SEQ 2048
#define ZW 2816
#define OFF_A 1536
#define OFF_B 1544
#define OFF_Z 1552
#define OFF_QA 2064
#define OFF_KVA 2448
#define OFF_KR 2704
#define DFF 2816
#define PAST 16384
#define NPAGES 128
#define EPSV 1e-6f

#define O_YP 0
#define O_YS (O_YP + 16777216)
#define O_CKVP (O_YS + 32768)
#define O_KRP (O_CKVP + 4194304)
#define O_GSP (O_KRP + 524288)
#define O_CSP (O_GSP + 262144)
#define O_CKVS (O_CSP + 36864)
#define O_KRS (O_CKVS + 8192)
#define O_GSS (O_KRS + 1024)
#define O_CSS (O_GSS + 1048576)

__device__ __forceinline__ bf16_t f2bf(float f) { unsigned u = __float_as_uint(f); return (bf16_t)((u + 0x7fffu + ((u >> 16) & 1u)) >> 16); }
__device__ __forceinline__ float bf2f(bf16_t b) { return __uint_as_float(((unsigned)b) << 16); }
template <int CTRL> __device__ __forceinline__ float dpp_mov(float x) { return __uint_as_float((unsigned)__builtin_amdgcn_update_dpp((int)__float_as_uint(x), (int)__float_as_uint(x), CTRL, 0xF, 0xF, true)); }
__device__ __forceinline__ float add_x16(float x) { auto r = __builtin_amdgcn_permlane16_swap(__float_as_uint(x), __float_as_uint(x), false, false); return __uint_as_float(r[0]) + __uint_as_float(r[1]); }
__device__ __forceinline__ float add_x32(float x) { auto r = __builtin_amdgcn_permlane32_swap(__float_as_uint(x), __float_as_uint(x), false, false); return __uint_as_float(r[0]) + __uint_as_float(r[1]); }
__device__ __forceinline__ float max_x32(float x) { auto r = __builtin_amdgcn_permlane32_swap(__float_as_uint(x), __float_as_uint(x), false, false); return fmaxf(__uint_as_float(r[0]), __uint_as_float(r[1])); }
__device__ __forceinline__ float sum8(float x) { x += dpp_mov<0xB1>(x); x += dpp_mov<0x4E>(x); x += dpp_mov<0x141>(x); return x; }
__device__ __forceinline__ float sum16(float x) { x = sum8(x); x += dpp_mov<0x140>(x); return x; }
__device__ __forceinline__ float max16(float x) { x = fmaxf(x, dpp_mov<0xB1>(x)); x = fmaxf(x, dpp_mov<0x4E>(x)); x = fmaxf(x, dpp_mov<0x141>(x)); x = fmaxf(x, dpp_mov<0x140>(x)); return x; }
__device__ __forceinline__ float wave_sum(float v) { return add_x32(add_x16(sum16(v))); }
__device__ __forceinline__ float sigmoidf_(float x) { return __builtin_amdgcn_rcpf(1.f + __builtin_amdgcn_exp2f(-1.44269504f * x)); }
__device__ __forceinline__ float siluf_(float x) { return x * __builtin_amdgcn_rcpf(1.f + __builtin_amdgcn_exp2f(-1.44269504f * x)); }


#define WSYNC() do { __builtin_amdgcn_fence(__ATOMIC_ACQ_REL, "wavefront"); __builtin_amdgcn_wave_barrier(); } while (0)
#define NTHR 512
#define NWAVE 8

typedef float f32x2_t __attribute__((ext_vector_type(2)));
typedef __bf16 bf16x2_t __attribute__((ext_vector_type(2)));
__device__ __forceinline__ unsigned cvtpk(float lo, float hi) { f32x2_t v = {lo, hi}; bf16x2_t r = __builtin_convertvector(v, bf16x2_t); return __builtin_bit_cast(unsigned, r); }
__device__ __forceinline__ void bf8_to_f32(const bf16x8& v, float* o) {
#pragma unroll
    for (int e = 0; e < 8; ++e) o[e] = __uint_as_float(((unsigned)(unsigned short)v[e]) << 16);
}
__device__ __forceinline__ bf16x8 f32_to_bf8(const float* x) {
    u32x4 w; w.x = cvtpk(x[0], x[1]); w.y = cvtpk(x[2], x[3]); w.z = cvtpk(x[4], x[5]); w.w = cvtpk(x[6], x[7]);
    return __builtin_bit_cast(bf16x8, w);
}
__device__ __forceinline__ unsigned pk2bf(float lo, float hi) { return (unsigned)f2bf(lo) | ((unsigned)f2bf(hi) << 16); }

__device__ __forceinline__ void wt_item(const float* __restrict__ W, int ldw, int col0, int nvalid, bf16_t* __restrict__ WT, int ldt, int nrow0, int k0, float* scr, int lane) {
    WSYNC();
#pragma unroll 8
    for (int i = 0; i < 32; ++i) { const int kk = 2 * i + (lane >> 5), n = lane & 31; scr[kk * 33 + n] = n < nvalid ? W[(size_t)(k0 + kk) * ldw + col0 + n] : 0.f; }
    WSYNC();
    const int c = lane & 7;
#pragma unroll
    for (int j = 0; j < 4; ++j) { const int n = (lane >> 3) + 8 * j; const float* sp = scr + (8 * c) * 33 + n;
        u32x4 o; o.x = cvtpk(sp[0], sp[33]); o.y = cvtpk(sp[2 * 33], sp[3 * 33]); o.z = cvtpk(sp[4 * 33], sp[5 * 33]); o.w = cvtpk(sp[6 * 33], sp[7 * 33]);
        *(u32x4*)(WT + (size_t)(nrow0 + n) * ldt + k0 + 8 * c) = o; }
}

__device__ __forceinline__ void rms1024_row(const float* __restrict__ src, const float* __restrict__ g, bf16_t* __restrict__ o, bool zero, int lane) {
    if (zero) { for (int j = 0; j < 4; ++j) { ushort4 z = {0, 0, 0, 0}; *(ushort4*)(o + lane * 4 + 256 * j) = z; } return; }
    float4 v[4]; float ss = 0.f;
#pragma unroll
    for (int j = 0; j < 4; ++j) { v[j] = *(const float4*)(src + lane * 4 + 256 * j); ss += v[j].x * v[j].x + v[j].y * v[j].y + v[j].z * v[j].z + v[j].w * v[j].w; }
    ss = wave_sum(ss);
    const float rs = rsqrtf(ss * (1.f / 1024.f) + EPSV);
#pragma unroll
    for (int j = 0; j < 4; ++j) {
        const float4 gg = *(const float4*)(g + lane * 4 + 256 * j);
        ushort4 w; w.x = f2bf(v[j].x * rs * gg.x); w.y = f2bf(v[j].y * rs * gg.y); w.z = f2bf(v[j].z * rs * gg.z); w.w = f2bf(v[j].w * rs * gg.w);
        *(ushort4*)(o + lane * 4 + 256 * j) = w;
    }
}

__device__ __forceinline__ void rms1024_row_b(const bf16_t* __restrict__ src, const float* __restrict__ g, bf16_t* __restrict__ o, bool zero, int lane) {
    if (zero) { for (int j = 0; j < 2; ++j) { const u32x4 z = {0u, 0u, 0u, 0u}; *(u32x4*)(o + lane * 8 + 512 * j) = z; } return; }
    float v[2][8]; float ss = 0.f;
#pragma unroll
    for (int j = 0; j < 2; ++j) { bf8_to_f32(*(const bf16x8*)(src + lane * 8 + 512 * j), v[j]);
#pragma unroll
        for (int e = 0; e < 8; ++e) ss += v[j][e] * v[j][e]; }
    ss = wave_sum(ss);
    const float rs = rsqrtf(ss * (1.f / 1024.f) + EPSV);
#pragma unroll
    for (int j = 0; j < 2; ++j) {
        const float4 g0 = *(const float4*)(g + lane * 8 + 512 * j), g1 = *(const float4*)(g + lane * 8 + 512 * j + 4);
        float t[8] = {v[j][0] * rs * g0.x, v[j][1] * rs * g0.y, v[j][2] * rs * g0.z, v[j][3] * rs * g0.w, v[j][4] * rs * g1.x, v[j][5] * rs * g1.y, v[j][6] * rs * g1.z, v[j][7] * rs * g1.w};
        *(bf16x8*)(o + lane * 8 + 512 * j) = f32_to_bf8(t);
    }
}

struct ABf16 { const bf16_t* p; int lda; __device__ __forceinline__ bf16x8 load(int m, int k) const { return *(const bf16x8*)(p + (size_t)m * lda + k); } };
template <bool SWIGLU, class Epi>
__device__ __forceinline__ void gemm_sample_rows(const bf16_t* __restrict__ A, int lda, const bf16_t* __restrict__ Bt, int K, int N, const Epi& epi, char*  , int bid, int nb, int first = -1) {
    const int tid = otid(), lane = tid & 63, wid = tid >> 6, i16 = lane & 15, q4 = lane >> 4;
    for (int u = first >= 0 ? (bid - first + nb) % nb : nb - 1 - bid; u < N / 256; u += nb) {
        const int n0 = u * 256;
        const int c0 = SWIGLU ? n0 + 16 * wid : n0 + 32 * wid, c1 = SWIGLU ? n0 + 128 + 16 * wid : n0 + 32 * wid + 16;
        const bf16_t* a0p = A + (size_t)(NPT + i16) * lda + 8 * q4; const bf16_t* a1p = a0p + (size_t)16 * lda;
        const bf16_t* b0p = Bt + (size_t)(c0 + i16) * K + 8 * q4; const bf16_t* b1p = Bt + (size_t)(c1 + i16) * K + 8 * q4;
        f32x4 acc[2][2];
#pragma unroll
        for (int i = 0; i < 2; ++i)
#pragma unroll
            for (int j = 0; j < 2; ++j) acc[i][j] = (f32x4){0.f, 0.f, 0.f, 0.f};
#pragma unroll 4
        for (int k0 = 0; k0 < K; k0 += 32) {
            const bf16x8 a0 = *(const bf16x8*)(a0p + k0), a1 = *(const bf16x8*)(a1p + k0), b0 = *(const bf16x8*)(b0p + k0), b1 = *(const bf16x8*)(b1p + k0);
            acc[0][0] = __builtin_amdgcn_mfma_f32_16x16x32_bf16(a0, b0, acc[0][0], 0, 0, 0); acc[0][1] = __builtin_amdgcn_mfma_f32_16x16x32_bf16(a0, b1, acc[0][1], 0, 0, 0);
            acc[1][0] = __builtin_amdgcn_mfma_f32_16x16x32_bf16(a1, b0, acc[1][0], 0, 0, 0); acc[1][1] = __builtin_amdgcn_mfma_f32_16x16x32_bf16(a1, b1, acc[1][1], 0, 0, 0);
        }
#pragma unroll
        for (int i = 0; i < 2; ++i)
#pragma unroll
            for (int r = 0; r < 4; ++r) {
                const int m = NPT + 16 * i + 4 * q4 + r;
                if constexpr (SWIGLU) epi(m, (n0 >> 1) + 16 * wid + i16, siluf_(acc[i][0][r]) * acc[i][1][r]);
                else { epi(m, c0 + i16, acc[i][0][r]); epi(m, c1 + i16, acc[i][1][r]); }
            }
    }
}
template <bool SWIGLU, class Epi, int NJ = 4>
__device__ __forceinline__ void gemm_sample_rows_ks(const bf16_t* __restrict__ A, int lda, const bf16_t* __restrict__ Bt, int K, int N, const Epi& epi, char* smem, int bid, int nb) {
    const int tid = otid(), lane = tid & 63, wid = tid >> 6, i16 = lane & 15, q4 = lane >> 4;
    static_assert(!SWIGLU || NJ == 4, "swiglu units are 64 rows wide");
    const int nunits = N / (16 * NJ), ksl = K >> 3;
    f32x4* red = (f32x4*)smem;
    for (int u = nb - 1 - bid; u < nunits; u += nb) {
        int brow[NJ];
#pragma unroll
        for (int j = 0; j < NJ; ++j) brow[j] = SWIGLU ? ((32 * u) >> 7) * 256 + ((32 * u) & 127) + 128 * (j >> 1) + 16 * (j & 1) + i16 : 16 * NJ * u + 16 * j + i16;
        const bf16_t* a0p = A + (size_t)(NPT + i16) * lda + wid * ksl + 8 * q4; const bf16_t* a1p = a0p + (size_t)16 * lda;
        f32x4 acc[2][NJ];
#pragma unroll
        for (int i = 0; i < 2; ++i)
#pragma unroll
            for (int j = 0; j < NJ; ++j) acc[i][j] = (f32x4){0.f, 0.f, 0.f, 0.f};
        for (int k0 = 0; k0 < ksl; k0 += 32) {
            const bf16x8 a0 = *(const bf16x8*)(a0p + k0), a1 = *(const bf16x8*)(a1p + k0);
            bf16x8 b[NJ];
#pragma unroll
            for (int j = 0; j < NJ; ++j) b[j] = *(const bf16x8*)(Bt + (size_t)brow[j] * K + wid * ksl + 8 * q4 + k0);
#pragma unroll
            for (int j = 0; j < NJ; ++j) { acc[0][j] = __builtin_amdgcn_mfma_f32_16x16x32_bf16(a0, b[j], acc[0][j], 0, 0, 0); acc[1][j] = __builtin_amdgcn_mfma_f32_16x16x32_bf16(a1, b[j], acc[1][j], 0, 0, 0); }
        }
        __syncthreads();
#pragma unroll
        for (int i = 0; i < 2; ++i)
#pragma unroll
            for (int j = 0; j < NJ; ++j) red[(wid * 2 * NJ + i * NJ + j) * 64 + lane] = acc[i][j];
        __syncthreads();
        if constexpr (SWIGLU) {
            if (tid < 256) {
                const int t4 = tid >> 6, i = t4 >> 1, jg = t4 & 1, l = tid & 63;
                f32x4 g = red[(i * 4 + jg) * 64 + l], up = red[(i * 4 + jg + 2) * 64 + l];
#pragma unroll
                for (int w = 1; w < 8; ++w) { g = g + red[(w * 8 + i * 4 + jg) * 64 + l]; up = up + red[(w * 8 + i * 4 + jg + 2) * 64 + l]; }
#pragma unroll
                for (int r = 0; r < 4; ++r) epi(NPT + 16 * i + 4 * (l >> 4) + r, 32 * u + 16 * jg + (l & 15), siluf_(g[r]) * up[r]);
            }
        } else {
            const int t8 = tid >> 6, l = tid & 63, i = t8 / NJ, j = t8 % NJ;
            if (t8 < 2 * NJ) {
                f32x4 v = red[t8 * 64 + l];
#pragma unroll
                for (int w = 1; w < 8; ++w) v = v + red[(w * 2 * NJ + t8) * 64 + l];
#pragma unroll
                for (int r = 0; r < 4; ++r) epi(NPT + 16 * i + 4 * (l >> 4) + r, 16 * NJ * u + 16 * j + (l & 15), v[r]);
            }
        }
    }
    __syncthreads();
}
struct EwF32 { float* C; int ldc; __device__ __forceinline__ void operator()(int m, int n, float v) const { C[(size_t)m * ldc + n] = v; } };
struct EwBf16 { bf16_t* C; int ldc; __device__ __forceinline__ void operator()(int m, int n, float v) const { C[(size_t)m * ldc + n] = f2bf(v); } };
struct EwResX { const float* xs; bf16_t* C; __device__ __forceinline__ void operator()(int m, int n, float v) const { C[(size_t)m * 1024 + n] = f2bf(xs[(size_t)(m - NPT) * 1024 + n] + v); } };
struct EwResH { const bf16_t* H; bf16_t* C; __device__ __forceinline__ void operator()(int m, int n, float v) const { C[(size_t)m * 1024 + n] = f2bf(bf2f(H[(size_t)m * 1024 + n]) + v); } };
struct EwPle { const bf16_t* H2; const bf16_t* PP; float* out;
    __device__ __forceinline__ void operator()(int m, int n, float v) const { out[O_YS + (size_t)(m - NPT) * 1024 + n] = bf2f(H2[(size_t)m * 1024 + n]) + bf2f(PP[(size_t)m * 1024 + n]) * sigmoidf_(v); } };

struct PgBf16 {
    static constexpr bool PERM = true, AFTER_DRAIN = false; bf16_t* O; int ldc;
    __device__ __forceinline__ void operator()(const f32x4 (&acc)[2][2][4][2], const pg8::Unit& u, int wr, int wc, int fr, int fq) const {
#pragma unroll
        for (int ai = 0; ai < 2; ++ai)
#pragma unroll
            for (int m = 0; m < 4; ++m) { bf16_t* rowp = O + (size_t)(u.pm * 256 + ai * 128 + wr * 64 + m * 16 + fr) * ldc + u.pn * 256 + wc * 32 + 8 * fq;
#pragma unroll
                for (int bj = 0; bj < 2; ++bj) { const f32x4 v0 = acc[ai][bj][m][0], v1 = acc[ai][bj][m][1]; u32x4 w; w.x = pk2bf(v0[0], v0[1]); w.y = pk2bf(v0[2], v0[3]); w.z = pk2bf(v1[0], v1[1]); w.w = pk2bf(v1[2], v1[3]); *(u32x4*)(rowp + bj * 128) = w; } }
    }
};
struct PgF32 {
    static constexpr bool PERM = false, AFTER_DRAIN = false; float* O; int ldc;
    __device__ __forceinline__ void operator()(const f32x4 (&acc)[2][2][4][2], const pg8::Unit& u, int wr, int wc, int fr, int fq) const {
#pragma unroll
        for (int ai = 0; ai < 2; ++ai)
#pragma unroll
            for (int m = 0; m < 4; ++m) { float* rowp = O + (size_t)(u.pm * 256 + ai * 128 + wr * 64 + m * 16 + fr) * ldc + u.pn * 256 + wc * 32 + 4 * fq;
#pragma unroll
                for (int bj = 0; bj < 2; ++bj)
#pragma unroll
                    for (int n = 0; n < 2; ++n) *(f32x4*)(rowp + bj * 128 + n * 16) = acc[ai][bj][m][n]; }
    }
};
struct PgSwiglu {
    static constexpr bool PERM = true, AFTER_DRAIN = false; bf16_t* Hd;
    __device__ __forceinline__ void operator()(const f32x4 (&acc)[2][2][4][2], const pg8::Unit& u, int wr, int wc, int fr, int fq) const {
#pragma unroll
        for (int ai = 0; ai < 2; ++ai)
#pragma unroll
            for (int m = 0; m < 4; ++m) { bf16_t* rowp = Hd + (size_t)(u.pm * 256 + ai * 128 + wr * 64 + m * 16 + fr) * DFF + u.pn * 128 + wc * 32 + 8 * fq;
                float h[8];
#pragma unroll
                for (int n = 0; n < 2; ++n)
#pragma unroll
                    for (int i = 0; i < 4; ++i) h[n * 4 + i] = siluf_(acc[ai][0][m][n][i]) * acc[ai][1][m][n][i];
                u32x4 w; w.x = pk2bf(h[0], h[1]); w.y = pk2bf(h[2], h[3]); w.z = pk2bf(h[4], h[5]); w.w = pk2bf(h[6], h[7]); *(u32x4*)rowp = w; }
    }
};
struct PgResXB {
    static constexpr bool PERM = true, AFTER_DRAIN = false; const float* R; bf16_t* O;
    __device__ __forceinline__ void operator()(const f32x4 (&acc)[2][2][4][2], const pg8::Unit& u, int wr, int wc, int fr, int fq) const {
#pragma unroll
        for (int ai = 0; ai < 2; ++ai)
#pragma unroll
            for (int m = 0; m < 4; ++m) { const size_t off = (size_t)(u.pm * 256 + ai * 128 + wr * 64 + m * 16 + fr) * 1024 + u.pn * 256 + wc * 32 + 8 * fq;
#pragma unroll
                for (int bj = 0; bj < 2; ++bj) { const f32x4 r0 = *(const f32x4*)(R + off + bj * 128), r1 = *(const f32x4*)(R + off + bj * 128 + 4), v0 = r0 + acc[ai][bj][m][0], v1 = r1 + acc[ai][bj][m][1];
                    u32x4 w; w.x = cvtpk(v0[0], v0[1]); w.y = cvtpk(v0[2], v0[3]); w.z = cvtpk(v1[0], v1[1]); w.w = cvtpk(v1[2], v1[3]); *(u32x4*)(O + off + bj * 128) = w; } }
    }
};
struct PgResBB {
    static constexpr bool PERM = true, AFTER_DRAIN = false; const bf16_t* R; bf16_t* O;
    __device__ __forceinline__ void operator()(const f32x4 (&acc)[2][2][4][2], const pg8::Unit& u, int wr, int wc, int fr, int fq) const {
#pragma unroll
        for (int ai = 0; ai < 2; ++ai)
#pragma unroll
            for (int m = 0; m < 4; ++m) { const size_t off = (size_t)(u.pm * 256 + ai * 128 + wr * 64 + m * 16 + fr) * 1024 + u.pn * 256 + wc * 32 + 8 * fq;
#pragma unroll
                for (int bj = 0; bj < 2; ++bj) { float r[8]; bf8_to_f32(*(const bf16x8*)(R + off + bj * 128), r); const f32x4 a0 = acc[ai][bj][m][0], a1 = acc[ai][bj][m][1];
                    u32x4 w; w.x = cvtpk(r[0] + a0[0], r[1] + a0[1]); w.y = cvtpk(r[2] + a0[2], r[3] + a0[3]); w.z = cvtpk(r[4] + a1[0], r[5] + a1[1]); w.w = cvtpk(r[6] + a1[2], r[7] + a1[3]); *(u32x4*)(O + off + bj * 128) = w; } }
    }
};
struct PgPleB {
    static constexpr bool PERM = true, AFTER_DRAIN = false; const bf16_t* H2; const bf16_t* PP; float* out;
    __device__ __forceinline__ void operator()(const f32x4 (&acc)[2][2][4][2], const pg8::Unit& u, int wr, int wc, int fr, int fq) const {
#pragma unroll
        for (int ai = 0; ai < 2; ++ai)
#pragma unroll
            for (int m = 0; m < 4; ++m) { const size_t off = (size_t)(u.pm * 256 + ai * 128 + wr * 64 + m * 16 + fr) * 1024 + u.pn * 256 + wc * 32 + 8 * fq;
#pragma unroll
                for (int bj = 0; bj < 2; ++bj) { float h[8], pp[8]; bf8_to_f32(*(const bf16x8*)(H2 + off + bj * 128), h); bf8_to_f32(*(const bf16x8*)(PP + off + bj * 128), pp);
                    const f32x4 a0 = acc[ai][bj][m][0], a1 = acc[ai][bj][m][1]; f32x4 y0, y1;
#pragma unroll
                    for (int i = 0; i < 4; ++i) { y0[i] = h[i] + pp[i] * sigmoidf_(a0[i]); y1[i] = h[4 + i] + pp[4 + i] * sigmoidf_(a1[i]); }
                    *(f32x4*)(out + O_YP + off + bj * 128) = y0; *(f32x4*)(out + O_YP + off + bj * 128 + 4) = y1; } }
    }
};
template <class Epi>
__device__ __forceinline__ void pg_gemm(LAS unsigned char* lds, const bf16_t* A, const bf16_t* Bt, int M, int N, int K, const Epi& E, int glow = 0) {
    pg8::Gemm g{A, Bt, M, N, K}; pg8::StaticOrder S;
    if (glow > 0) { if ((int)blockIdx.x >= glow) return; S.init(M, N, glow, (int)blockIdx.x); }
    else S.init(M, N, (int)gridDim.x, (int)blockIdx.x);
    pg8::gemm_phase<Epi, pg8::StaticOrder, true, true>(lds, g, S, E);
}

constexpr size_t WOF_WinT = 0ull;
constexpr size_t WOF_WqbT = 5767168ull;
constexpr size_t WOF_WkvT = 6356992ull;
constexpr size_t WOF_WknT = 6881280ull;
constexpr size_t WOF_WoT = 7143424ull;
constexpr size_t WOF_WguT = 9240576ull;
constexpr size_t WOF_WdT = 20774912ull;
constexpr size_t WOF_WpgT = 26542080ull;
constexpr size_t WOF_WppT = 28639232ull;
constexpr size_t WOF_xn = 29163520ull;
constexpr size_t WOF_pb = 63242240ull;
constexpr size_t WOF_Z = 71761920ull;
constexpr size_t WOF_qkv = 165478400ull;
constexpr size_t WOF_ropecs = 216596480ull;
constexpr size_t WOF_gg = 216858880ull;
constexpr size_t WOF_bb = 217391360ull;
constexpr size_t WOF_goraw = 217923840ull;
constexpr size_t WOF_gUT = 252002560ull;
constexpr size_t WOF_ggam = 285556992ull;
constexpr size_t WOF_gWn = 285565184ull;
constexpr size_t WOF_gQg = 302342400ull;
constexpr size_t WOF_gQK = 319119616ull;
constexpr size_t WOF_gKd = 335896832ull;
constexpr size_t WOF_qan = 352674048ull;
constexpr size_t WOF_ckvb = 365453568ull;
constexpr size_t WOF_krf = 373973248ull;
constexpr size_t WOF_Q = 376103168ull;
constexpr size_t WOF_qh = 427221248ull;
constexpr size_t WOF_KV = 478339328ull;
constexpr size_t WOF_kh = 546496768ull;
constexpr size_t WOF_omix = 580575488ull;
constexpr size_t WOF_KN = 614654208ull;
constexpr size_t WOF_SC = 1151525120ull;
constexpr size_t WOF_part = 1168302336ull;
constexpr size_t WOF_H = 1170432256ull;
constexpr size_t WOF_un = 1238589696ull;
constexpr size_t WOF_G = 1272668416ull;
constexpr size_t WOF_hid = 1273028864ull;
constexpr size_t WOF_H2 = 1366745344ull;
constexpr size_t WOF_un2 = 1434902784ull;
constexpr size_t WOF_PP = 1468981504ull;
constexpr size_t WOF_qraw = 1537138944ull;
constexpr size_t WOF_kvraw = 1562304768ull;
constexpr size_t WOF_krb = 1595859200ull;
constexpr size_t WOF_ctl = 1596907776ull;
constexpr size_t WS_TOTAL = 1596924160ull;
struct MK {
    const float *x_prompt, *x_sample, *cache_ckv, *cache_krope, *state_gdn, *state_conv; const int* page_table; const float *p_prompt, *p_sample;
    const float *g_attn, *w_in, *w_conv, *a_log, *dt_bias, *g_gdn_out, *g_q_a, *w_q_b, *g_q_nope, *g_q_rope, *g_kv_a, *g_k_rope, *w_kv_b, *g_k_nope, *w_o, *g_ffn, *w_gate, *w_up, *w_down, *g_ple, *w_ple_gate, *w_ple_proj;
    float* out; char* ws;
    __device__ __forceinline__ unsigned* ctl() const { return (unsigned*)(ws + WOF_ctl); }
    __device__ __forceinline__ bf16_t* WinT() const { return (bf16_t*)(ws + WOF_WinT); }
    __device__ __forceinline__ bf16_t* WqbT() const { return (bf16_t*)(ws + WOF_WqbT); }
    __device__ __forceinline__ bf16_t* WkvT() const { return (bf16_t*)(ws + WOF_WkvT); }
    __device__ __forceinline__ bf16_t* WknT() const { return (bf16_t*)(ws + WOF_WknT); }
    __device__ __forceinline__ bf16_t* WoT() const { return (bf16_t*)(ws + WOF_WoT); }
    __device__ __forceinline__ bf16_t* WguT() const { return (bf16_t*)(ws + WOF_WguT); }
    __device__ __forceinline__ bf16_t* WdT() const { return (bf16_t*)(ws + WOF_WdT); }
    __device__ __forceinline__ bf16_t* WpgT() const { return (bf16_t*)(ws + WOF_WpgT); }
    __device__ __forceinline__ bf16_t* WppT() const { return (bf16_t*)(ws + WOF_WppT); }
    __device__ __forceinline__ bf16_t* xn() const { return (bf16_t*)(ws + WOF_xn); }
    __device__ __forceinline__ bf16_t* pb() const { return (bf16_t*)(ws + WOF_pb); }
    __device__ __forceinline__ bf16_t* Z() const { return (bf16_t*)(ws + WOF_Z); }
    __device__ __forceinline__ bf16_t* qkv() const { return (bf16_t*)(ws + WOF_qkv); }
    __device__ __forceinline__ float* ropecs() const { return (float*)(ws + WOF_ropecs); }
    __device__ __forceinline__ float* gg() const { return (float*)(ws + WOF_gg); }
    __device__ __forceinline__ float* bb() const { return (float*)(ws + WOF_bb); }
    __device__ __forceinline__ float* goraw() const { return (float*)(ws + WOF_goraw); }
    __device__ __forceinline__ float* gUT() const { return (float*)(ws + WOF_gUT); }
    __device__ __forceinline__ float* ggam() const { return (float*)(ws + WOF_ggam); }
    __device__ __forceinline__ bf16_t* gWn() const { return (bf16_t*)(ws + WOF_gWn); }
    __device__ __forceinline__ bf16_t* gQg() const { return (bf16_t*)(ws + WOF_gQg); }
    __device__ __forceinline__ bf16_t* gQK() const { return (bf16_t*)(ws + WOF_gQK); }
    __device__ __forceinline__ bf16_t* gKd() const { return (bf16_t*)(ws + WOF_gKd); }
    __device__ __forceinline__ bf16_t* qan() const { return (bf16_t*)(ws + WOF_qan); }
    __device__ __forceinline__ bf16_t* ckvb() const { return (bf16_t*)(ws + WOF_ckvb); }
    __device__ __forceinline__ float* krf() const { return (float*)(ws + WOF_krf); }
    __device__ __forceinline__ float* Q() const { return (float*)(ws + WOF_Q); }
    __device__ __forceinline__ float* qh() const { return (float*)(ws + WOF_qh); }
    __device__ __forceinline__ float* KV() const { return (float*)(ws + WOF_KV); }
    __device__ __forceinline__ float* kh() const { return (float*)(ws + WOF_kh); }
    __device__ __forceinline__ bf16_t* omix() const { return (bf16_t*)(ws + WOF_omix); }
    __device__ __forceinline__ bf16_t* KN() const { return (bf16_t*)(ws + WOF_KN); }
    __device__ __forceinline__ float* SC() const { return (float*)(ws + WOF_SC); }
    __device__ __forceinline__ float* part() const { return (float*)(ws + WOF_part); }
    __device__ __forceinline__ bf16_t* H() const { return (bf16_t*)(ws + WOF_H); }
    __device__ __forceinline__ bf16_t* un() const { return (bf16_t*)(ws + WOF_un); }
    __device__ __forceinline__ float* G() const { return (float*)(ws + WOF_G); }
    __device__ __forceinline__ bf16_t* hid() const { return (bf16_t*)(ws + WOF_hid); }
    __device__ __forceinline__ bf16_t* H2() const { return (bf16_t*)(ws + WOF_H2); }
    __device__ __forceinline__ bf16_t* un2() const { return (bf16_t*)(ws + WOF_un2); }
    __device__ __forceinline__ bf16_t* PP() const { return (bf16_t*)(ws + WOF_PP); }
    __device__ __forceinline__ bf16_t* qraw() const { return (bf16_t*)(ws + WOF_qraw); }
    __device__ __forceinline__ bf16_t* kvraw() const { return (bf16_t*)(ws + WOF_kvraw); }
    __device__ __forceinline__ bf16_t* krb() const { return (bf16_t*)(ws + WOF_krb); }
};

__device__ __forceinline__ float fast_sigmoid(float x) { return __builtin_amdgcn_rcpf(1.f + __builtin_amdgcn_exp2f(-1.44269504f * x)); }
struct PinTok { bf16x8 qa, cv, kr; float ab; };
struct PinGain { float gqa[8], gkv[8], gkr[8], dtb, alog; };
__device__ __forceinline__ PinTok pin_load(const MK& a, int row, int lane) {
    const bf16_t* z = a.Z() + (size_t)row * ZW; PinTok t; const bf16x8 zz = {0, 0, 0, 0, 0, 0, 0, 0};
    t.qa = lane < 48 ? *(const bf16x8*)(z + OFF_QA + 8 * lane) : zz; t.cv = lane < 32 ? *(const bf16x8*)(z + OFF_KVA + 8 * lane) : zz;
    t.kr = (lane >= 32 && lane < 36) ? *(const bf16x8*)(z + OFF_KR + 8 * (lane - 32)) : zz; t.ab = lane < 16 ? bf2f(z[OFF_A + lane]) : 0.f; return t;
}
__device__ __forceinline__ void post_in_token(const MK& a, int row, int lane, const float* wcs, const bf16x8 (&w0)[3], const bf16x8 (&w1)[3], const bf16x8 (&w2)[3], const bf16x8 (&wcur)[3], const PinTok& tk, const PinGain& gn) {
    const bool samp = row >= NPT;
    const int b = samp ? row - NPT : row >> 11, t = samp ? 0 : row & 2047, hd = lane >> 3;
    float y[24];
#pragma unroll
    for (int c3 = 0; c3 < 3; ++c3) {
        float p0[8], p1[8], p2[8], cu[8];
        bf8_to_f32(w0[c3], p0); bf8_to_f32(w1[c3], p1); bf8_to_f32(w2[c3], p2); bf8_to_f32(wcur[c3], cu);
        const float* wp = wcs + 512 * c3 + 8 * lane;
        const float4 a0 = *(const float4*)wp, a1 = *(const float4*)(wp + 4), b0 = *(const float4*)(wp + 1536), b1 = *(const float4*)(wp + 1540);
        const float4 c0 = *(const float4*)(wp + 3072), c1 = *(const float4*)(wp + 3076), d0 = *(const float4*)(wp + 4608), d1 = *(const float4*)(wp + 4612);
        const float k0[8] = {a0.x, a0.y, a0.z, a0.w, a1.x, a1.y, a1.z, a1.w}, k1[8] = {b0.x, b0.y, b0.z, b0.w, b1.x, b1.y, b1.z, b1.w};
        const float k2[8] = {c0.x, c0.y, c0.z, c0.w, c1.x, c1.y, c1.z, c1.w}, k3[8] = {d0.x, d0.y, d0.z, d0.w, d1.x, d1.y, d1.z, d1.w};
#pragma unroll
        for (int e = 0; e < 8; ++e) { const int c = 8 * c3 + e; const float v = k0[e] * p0[e] + k1[e] * p1[e] + k2[e] * p2[e] + k3[e] * cu[e]; y[c] = v * fast_sigmoid(v); }
        __builtin_amdgcn_sched_barrier(0);
    }
    float sq = 0.f, sk = 0.f;
#pragma unroll
    for (int e = 0; e < 8; ++e) { sq += y[e] * y[e]; sk += y[8 + e] * y[8 + e]; }
    sq = sum8(sq); sk = sum8(sk);
    const float rq = rsqrtf(sq + EPSV) * 0.125f, rk = rsqrtf(sk + EPSV);
#pragma unroll
    for (int e = 0; e < 8; ++e) { y[e] *= rq; y[8 + e] *= rk; }
    bf16_t* qo = a.qkv() + (size_t)row * 1536 + 8 * lane;
    *(bf16x8*)qo = f32_to_bf8(y); *(bf16x8*)(qo + 512) = f32_to_bf8(y + 8); *(bf16x8*)(qo + 1024) = f32_to_bf8(y + 16);
    if (!samp && t >= SEQ - 3) {
        float* cso = a.out + O_CSP + ((size_t)b * 3 + (t - (SEQ - 3))) * 1536 + 8 * lane;
#pragma unroll
        for (int j = 0; j < 3; ++j) { float cu[8]; bf8_to_f32(wcur[j], cu); *(float4*)(cso + 512 * j) = (float4){cu[0], cu[1], cu[2], cu[3]}; *(float4*)(cso + 512 * j + 4) = (float4){cu[4], cu[5], cu[6], cu[7]}; }
    }
    if (lane < 16) {
        const float v = tk.ab;
        if (lane < 8) { const float xx = v + gn.dtb; const float sp = xx > 20.f ? xx : 0.69314718f * __builtin_amdgcn_logf(1.f + __builtin_amdgcn_exp2f(1.44269504f * xx)); a.gg()[(size_t)row * 8 + lane] = -gn.alog * sp; }
        else a.bb()[(size_t)row * 8 + lane - 8] = sigmoidf_(v);
    }
    __builtin_amdgcn_sched_barrier(0);
    float qa[8], cv[8], kr[8];
    bf8_to_f32(tk.qa, qa); bf8_to_f32(tk.cv, cv); bf8_to_f32(tk.kr, kr);
    float s1 = 0.f, s2 = 0.f, s3 = 0.f;
#pragma unroll
    for (int e = 0; e < 8; ++e) { s1 += qa[e] * qa[e]; s2 += cv[e] * cv[e]; s3 += kr[e] * kr[e]; }
    s1 = wave_sum(s1); s2 = wave_sum(s2); s3 = wave_sum(s3);
    const float r1 = rsqrtf(s1 * (1.f / 384.f) + EPSV), r2 = rsqrtf(s2 * (1.f / 256.f) + EPSV), r3 = rsqrtf(s3 * (1.f / 32.f) + EPSV);
    if (lane < 48) {
        float o[8];
#pragma unroll
        for (int e = 0; e < 8; ++e) o[e] = qa[e] * r1 * gn.gqa[e];
        *(bf16x8*)(a.qan() + (size_t)row * 384 + 8 * lane) = f32_to_bf8(o);
    }
    if (lane < 32) {
        float o[8];
#pragma unroll
        for (int e = 0; e < 8; ++e) o[e] = cv[e] * r2 * gn.gkv[e];
        *(bf16x8*)(a.ckvb() + (size_t)row * 256 + 8 * lane) = f32_to_bf8(o);
        float* co = samp ? a.out + O_CKVS + (size_t)b * 256 + 8 * lane : a.out + O_CKVP + (size_t)row * 256 + 8 * lane;
        *(float4*)co = (float4){o[0], o[1], o[2], o[3]}; *(float4*)(co + 4) = (float4){o[4], o[5], o[6], o[7]};
    }
    __builtin_amdgcn_sched_barrier(0);
    {
        const int c4 = (lane - 32) & 3;
        float xn[8], ot[8];
#pragma unroll
        for (int e = 0; e < 8; ++e) xn[e] = kr[e] * r3 * gn.gkr[e];
#pragma unroll
        for (int e = 0; e < 8; ++e) ot[e] = dpp_mov<0x4E>(xn[e]);
        if (lane >= 32 && lane < 36) {
            const float* tb = a.ropecs() + (size_t)(samp ? 2048 : t) * 32 + ((8 * c4) & 15);
            const float4 c0 = *(const float4*)tb, c1 = *(const float4*)(tb + 4), s0 = *(const float4*)(tb + 16), s1 = *(const float4*)(tb + 20);
            const float csv[8] = {c0.x, c0.y, c0.z, c0.w, c1.x, c1.y, c1.z, c1.w}, snv[8] = {s0.x, s0.y, s0.z, s0.w, s1.x, s1.y, s1.z, s1.w};
            float o[8];
#pragma unroll
            for (int e = 0; e < 8; ++e) o[e] = c4 < 2 ? xn[e] * csv[e] - ot[e] * snv[e] : ot[e] * snv[e] + xn[e] * csv[e];
            float* kf_ = a.krf() + (size_t)row * 32 + 8 * c4; *(float4*)kf_ = (float4){o[0], o[1], o[2], o[3]}; *(float4*)(kf_ + 4) = (float4){o[4], o[5], o[6], o[7]};
            float* ko = samp ? a.out + O_KRS + (size_t)b * 32 + 8 * c4 : a.out + O_KRP + (size_t)row * 32 + 8 * c4;
            *(float4*)ko = (float4){o[0], o[1], o[2], o[3]}; *(float4*)(ko + 4) = (float4){o[4], o[5], o[6], o[7]};
            if (!samp) *(bf16x8*)(a.krb() + (size_t)row * 32 + 8 * c4) = f32_to_bf8(o);
        }
    }
    (void)hd;
}
__device__ __forceinline__ void post_in_run(const MK& a, int run, int lane_in, const float* wcs) {
    int lane = lane_in; asm volatile("" : "+v"(lane));
    PinGain gn;
    {
        const int lq = lane < 48 ? lane : 0, lk = lane < 32 ? lane : 0, c4 = (lane - 32) & 3;
#pragma unroll
        for (int e = 0; e < 8; ++e) { gn.gqa[e] = a.g_q_a[8 * lq + e]; gn.gkv[e] = a.g_kv_a[8 * lk + e]; gn.gkr[e] = a.g_k_rope[8 * c4 + e]; }
        gn.dtb = a.dt_bias[lane & 7]; gn.alog = expf(a.a_log[lane & 7]);
    }
    if (run < NPT / 8) {
        const int row0 = run * 8, t0 = row0 & 2047;
        bf16x8 w0[3], w1[3], w2[3], wcur[3];
#pragma unroll
        for (int c3 = 0; c3 < 3; ++c3) {
            const bf16x8 zz = {0, 0, 0, 0, 0, 0, 0, 0}; w0[c3] = zz; w1[c3] = zz; w2[c3] = zz;
            if (t0 > 0) { const bf16_t* zp = a.Z() + (size_t)(row0 - 3) * ZW + 512 * c3 + 8 * lane; w0[c3] = *(const bf16x8*)zp; w1[c3] = *(const bf16x8*)(zp + ZW); w2[c3] = *(const bf16x8*)(zp + 2 * ZW); }
        }
        bf16x8 wnext[3]; PinTok tk, tkn;
#pragma unroll
        for (int c3 = 0; c3 < 3; ++c3) wnext[c3] = *(const bf16x8*)(a.Z() + (size_t)row0 * ZW + 512 * c3 + 8 * lane);
        tkn = pin_load(a, row0, lane);
#pragma unroll 1
        for (int k = 0; k < 8; ++k) {
            const int row = row0 + k;
#pragma unroll
            for (int c3 = 0; c3 < 3; ++c3) wcur[c3] = wnext[c3];
            tk = tkn;
            if (k < 7) {
#pragma unroll
                for (int c3 = 0; c3 < 3; ++c3) wnext[c3] = *(const bf16x8*)(a.Z() + (size_t)(row + 1) * ZW + 512 * c3 + 8 * lane);
                tkn = pin_load(a, row + 1, lane);
            }
            post_in_token(a, row, lane, wcs, w0, w1, w2, wcur, tk, gn);
#pragma unroll
            for (int c3 = 0; c3 < 3; ++c3) { w0[c3] = w1[c3]; w1[c3] = w2[c3]; w2[c3] = wcur[c3]; }
        }
    } else {
        {
            const int bsm = run - NPT / 8, row = NPT + bsm;
            bf16x8 w0[3], w1[3], w2[3], wcur[3];
#pragma unroll
            for (int c3 = 0; c3 < 3; ++c3) {
                const float* sp = a.state_conv + (size_t)bsm * 3 * 1536 + 512 * c3 + 8 * lane;
                float* cso = a.out + O_CSS + (size_t)bsm * 3 * 1536 + 512 * c3 + 8 * lane;
                float t0_[8], t1_[8], t2_[8], tc_[8];
#pragma unroll
                for (int e = 0; e < 8; ++e) { t0_[e] = sp[e]; t1_[e] = sp[1536 + e]; t2_[e] = sp[2 * 1536 + e]; }
                wcur[c3] = *(const bf16x8*)(a.Z() + (size_t)row * ZW + 512 * c3 + 8 * lane); bf8_to_f32(wcur[c3], tc_);
#pragma unroll
                for (int e = 0; e < 8; ++e) { cso[e] = t1_[e]; cso[1536 + e] = t2_[e]; cso[2 * 1536 + e] = tc_[e]; }
                w0[c3] = f32_to_bf8(t0_); w1[c3] = f32_to_bf8(t1_); w2[c3] = f32_to_bf8(t2_);
            }
            post_in_token(a, row, lane, wcs, w0, w1, w2, wcur, pin_load(a, row, lane), gn);
        }
    }
}

__device__ __forceinline__ void post_q_item(const MK& a, int idx, int lane) {
    const int row = idx >> 3, h = idx & 7;
    const float* q = a.Q() + (size_t)row * 768 + h * 96;
    float* o = a.qh() + ((size_t)row * 8 + h) * 96;
    const float v = q[lane];
    const float ss = wave_sum(v * v);
    o[lane] = v * rsqrtf(ss * (1.f / 64.f) + EPSV) * a.g_q_nope[lane];
    const float r = lane < 32 ? q[64 + lane] : 0.f;
    const float s2 = wave_sum(r * r);
    const float xn = lane < 32 ? r * rsqrtf(s2 * (1.f / 32.f) + EPSV) * a.g_q_rope[lane] : 0.f;
    const float other = __shfl_xor(xn, 16);
    const int i = lane & 15;
    const float* tb = a.ropecs() + (size_t)(row >= NPT ? 2048 : (row & 2047)) * 32;
    const float cs = tb[i], sn = tb[16 + i];
    const float ov = lane < 16 ? xn * cs - other * sn : other * sn + xn * cs;
    if (lane < 32) o[64 + lane] = ov;
}
__device__ __forceinline__ void post_kv_item(const MK& a, int idx, int lane) {
    const int row = idx >> 3, h = idx & 7;
    const float v = a.KV()[(size_t)row * 1024 + h * 128 + lane];
    const float ss = wave_sum(v * v);
    const float kn = v * rsqrtf(ss * (1.f / 64.f) + EPSV) * a.g_k_nope[lane];
    a.kh()[((size_t)row * 8 + h) * 64 + lane] = kn;
}

typedef float f32x16 __attribute__((ext_vector_type(16)));
typedef short s16x4 __attribute__((ext_vector_type(4)));
#define KST 104
#define VST 72
#define ATT_BUF (64 * KST * 2 + 64 * VST * 2)
__device__ __forceinline__ int crow32(int r, int hi) { return (r & 3) + 8 * (r >> 2) + 4 * hi; }
__device__ __forceinline__ s16x4 tr_read(const bf16_t* p) { return __builtin_bit_cast(s16x4, __builtin_amdgcn_ds_read_tr16_b64_v4i16((LAS s16x4*)(LAS void*)(unsigned)(size_t)p)); }
__device__ __forceinline__ bf16x8 pack8(const f32x16& x, int s) {
    u32x4 w; w.x = cvtpk(x[8 * s], x[8 * s + 1]); w.y = cvtpk(x[8 * s + 2], x[8 * s + 3]); w.z = cvtpk(x[8 * s + 4], x[8 * s + 5]); w.w = cvtpk(x[8 * s + 6], x[8 * s + 7]);
    return __builtin_bit_cast(bf16x8, w);
}
__device__ __forceinline__ void attn_block(const MK& a, int b, int h, int qb, char* smem) {
    const int tid = otid(), lane = tid & 63, wid = tid >> 6, r32 = lane & 31, hi = lane >> 5;
    const int qrow = qb * 256 + wid * 32 + r32;
    const int wq0 = qb * 256 + wid * 32;
    bf16x8 qf[6];
    {
        const float SCL = 0.14724445f;
        const bf16_t* Qg = a.qraw() + ((size_t)b * SEQ + qrow) * 768 + h * 96 + 8 * hi;
        float qv[6][8];
#pragma unroll
        for (int ds = 0; ds < 6; ++ds) bf8_to_f32(*(const bf16x8*)(Qg + 16 * ds), qv[ds]);
        float sn_ = 0.f, sr_ = 0.f;
#pragma unroll
        for (int j = 0; j < 8; ++j) { sn_ += qv[0][j] * qv[0][j] + qv[1][j] * qv[1][j] + qv[2][j] * qv[2][j] + qv[3][j] * qv[3][j]; sr_ += qv[4][j] * qv[4][j] + qv[5][j] * qv[5][j]; }
        sn_ = add_x32(sn_); sr_ = add_x32(sr_);
        const float rsn = rsqrtf(sn_ * (1.f / 64.f) + EPSV) * SCL, rsr = rsqrtf(sr_ * (1.f / 32.f) + EPSV);
#pragma unroll
        for (int ds = 0; ds < 4; ++ds) {
            float o[8];
#pragma unroll
            for (int j = 0; j < 8; ++j) o[j] = qv[ds][j] * rsn * a.g_q_nope[16 * ds + 8 * hi + j];
            qf[ds] = f32_to_bf8(o);
        }
        const float* tb = a.ropecs() + (size_t)qrow * 32 + 8 * hi;
        float o4[8], o5[8];
#pragma unroll
        for (int j = 0; j < 8; ++j) {
            const float x1 = qv[4][j] * rsr * a.g_q_rope[8 * hi + j], x2 = qv[5][j] * rsr * a.g_q_rope[16 + 8 * hi + j], cs = tb[j], sn = tb[16 + j];
            o4[j] = (x1 * cs - x2 * sn) * SCL; o5[j] = (x1 * sn + x2 * cs) * SCL;
        }
        qf[4] = f32_to_bf8(o4); qf[5] = f32_to_bf8(o5);
    }
    f32x16 o0, o1;
#pragma unroll
    for (int r = 0; r < 16; ++r) { o0[r] = 0.f; o1[r] = 0.f; }
    float m = 0.f, l = 0.f;
    f32x16 negm;
#pragma unroll
    for (int r = 0; r < 16; ++r) negm[r] = 0.f;
    const int nt = qb * 4 + 4;
    const int vr = tid >> 3, vc = tid & 7, rr_ = (tid >> 2) & 63, rc = tid & 3;
    const bf16_t* KVg = a.kvraw() + (size_t)b * SEQ * 1024 + h * 128 + (size_t)vr * 1024 + vc * 8;
    const bf16_t* KRg = a.krb() + (size_t)b * SEQ * 32 + (size_t)rr_ * 32 + rc * 8;
    float gk[8];
#pragma unroll
    for (int j = 0; j < 8; ++j) gk[j] = a.g_k_nope[8 * vc + j];
    bf16x8 kr0, kr1, vr0;
#define ATT_LOAD(tt) do { kr0 = *(const bf16x8*)(KVg + (size_t)(tt) * 64 * 1024); vr0 = *(const bf16x8*)(KVg + (size_t)(tt) * 64 * 1024 + 64); if (tid < 256) kr1 = *(const bf16x8*)(KRg + (size_t)(tt) * 64 * 32); } while (0)
#define ATT_STORE(buf) do { bf16_t* Ks_ = (bf16_t*)(smem + (buf) * ATT_BUF); bf16_t* Vs_ = Ks_ + 64 * KST; \
        float x_[8]; bf8_to_f32(kr0, x_); float ss_ = 0.f; _Pragma("unroll") for (int j = 0; j < 8; ++j) ss_ += x_[j] * x_[j]; \
        ss_ = sum8(ss_); const float rs_ = rsqrtf(ss_ * (1.f / 64.f) + EPSV); \
        _Pragma("unroll") for (int j = 0; j < 8; ++j) x_[j] *= rs_ * gk[j]; \
        *(bf16x8*)(Ks_ + vr * KST + vc * 8) = f32_to_bf8(x_); *(bf16x8*)(Vs_ + vr * VST + vc * 8) = vr0; \
        if (tid < 256) *(bf16x8*)(Ks_ + rr_ * KST + 64 + rc * 8) = kr1; } while (0)
    ATT_LOAD(0);
    __syncthreads();
    ATT_STORE(0);
    __syncthreads();
    const int i16 = lane & 15, qq = i16 >> 2, pp = i16 & 3, g1 = (lane >> 4) & 1;
    for (int t = 0; t < nt; ++t) {
        const bf16_t* Ks = (const bf16_t*)(smem + (t & 1) * ATT_BUF); const bf16_t* Vs = Ks + 64 * KST;
        if (t + 1 < nt) ATT_LOAD(t + 1);
        if (64 * t <= wq0 + 31) {
            f32x16 p0, p1;
#pragma unroll
            for (int ds = 0; ds < 6; ++ds) {
                const bf16x8 k0 = *(const bf16x8*)(Ks + r32 * KST + 16 * ds + 8 * hi);
                const bf16x8 k1 = *(const bf16x8*)(Ks + (32 + r32) * KST + 16 * ds + 8 * hi);
                if (ds == 0) { p0 = __builtin_amdgcn_mfma_f32_32x32x16_bf16(k0, qf[ds], negm, 0, 0, 0); p1 = __builtin_amdgcn_mfma_f32_32x32x16_bf16(k1, qf[ds], negm, 0, 0, 0); }
                else { p0 = __builtin_amdgcn_mfma_f32_32x32x16_bf16(k0, qf[ds], p0, 0, 0, 0); p1 = __builtin_amdgcn_mfma_f32_32x32x16_bf16(k1, qf[ds], p1, 0, 0, 0); }
            }
            if (64 * t + 63 > wq0) {
#pragma unroll
                for (int r = 0; r < 16; ++r) { const int kv = 64 * t + crow32(r, hi); if (kv > qrow) p0[r] = -INFINITY; if (kv + 32 > qrow) p1[r] = -INFINITY; }
            }
            float mx = fmaxf(p0[0], p1[0]);
#pragma unroll
            for (int r = 1; r < 16; ++r) mx = fmaxf(mx, fmaxf(p0[r], p1[r]));
            mx = max_x32(mx);
            const float delta = t == 0 ? mx : fmaxf(mx, 0.f);
            if (__any(delta != 0.f)) {
                m += delta;
                const float f = t == 0 ? 1.f : __builtin_amdgcn_exp2f(-delta);
#pragma unroll
                for (int r = 0; r < 16; ++r) { p0[r] -= delta; p1[r] -= delta; negm[r] = -m; o0[r] *= f; o1[r] *= f; }
                l *= f;
            }
            float rs = 0.f;
#pragma unroll
            for (int r = 0; r < 16; ++r) { p0[r] = __builtin_amdgcn_exp2f(p0[r]); p1[r] = __builtin_amdgcn_exp2f(p1[r]); rs += p0[r] + p1[r]; }
            l += rs;
            bf16x8 pf[4];
            pf[0] = pack8(p0, 0); pf[1] = pack8(p0, 1); pf[2] = pack8(p1, 0); pf[3] = pack8(p1, 1);
#pragma unroll
            for (int ks = 0; ks < 4; ++ks) {
                const bf16_t* vb0 = Vs + (16 * ks + 4 * hi + qq) * VST + 16 * g1 + 4 * pp;
                const s16x4 a0 = tr_read(vb0), a1 = tr_read(vb0 + 8 * VST);
                const s16x4 c0 = tr_read(vb0 + 32), c1 = tr_read(vb0 + 8 * VST + 32);
                const bf16x8 va = __builtin_shufflevector(a0, a1, 0, 1, 2, 3, 4, 5, 6, 7);
                const bf16x8 vc_ = __builtin_shufflevector(c0, c1, 0, 1, 2, 3, 4, 5, 6, 7);
                o0 = __builtin_amdgcn_mfma_f32_32x32x16_bf16(va, pf[ks], o0, 0, 0, 0);
                o1 = __builtin_amdgcn_mfma_f32_32x32x16_bf16(vc_, pf[ks], o1, 0, 0, 0);
            }
        }
        if (t + 1 < nt) ATT_STORE((t + 1) & 1);
        __syncthreads();
    }
    l = add_x32(l);
    const float il = 1.f / l;
    bf16_t* op = a.omix() + ((size_t)b * SEQ + qrow) * 1024 + 512 + h * 64;
#pragma unroll
    for (int g = 0; g < 4; ++g) {
        uint2 w0, w1;
        w0.x = pk2bf(o0[4 * g] * il, o0[4 * g + 1] * il); w0.y = pk2bf(o0[4 * g + 2] * il, o0[4 * g + 3] * il);
        w1.x = pk2bf(o1[4 * g] * il, o1[4 * g + 1] * il); w1.y = pk2bf(o1[4 * g + 2] * il, o1[4 * g + 3] * il);
        *(uint2*)(op + 8 * g + 4 * hi) = w0;
        *(uint2*)(op + 32 + 8 * g + 4 * hi) = w1;
    }
#undef ATT_LOAD
#undef ATT_STORE
}

__device__ __forceinline__ void gdn_unit(const MK& a, int b, int h, int dvg, const float* s0, float* sout, int row0, int T, int lane, char* wsm) {
    float (*sq)[64] = (float (*)[64])wsm;
    float (*sk)[64] = (float (*)[64])(wsm + 4096);
    float (*sv)[8] = (float (*)[8])(wsm + 8192);
    float* sg = (float*)(wsm + 8704);
    float* sb = (float*)(wsm + 8768);
    const int e = lane & 7, ko = lane >> 3, col = dvg * 8 + e;
    float S[8];
#pragma unroll
    for (int d = 0; d < 8; ++d) S[d] = s0 ? s0[(((size_t)b * 8 + h) * 64 + ko * 8 + d) * 64 + col] : 0.f;
    const size_t rbase = (size_t)row0 + (size_t)b * T;
    float pq[16], pk[16], pv0, pv1, pgb;
    {
        const int nt = T < 16 ? T : 16;
#pragma unroll
        for (int j = 0; j < 16; ++j) { const bool ok = j < nt; const size_t r = rbase + (ok ? j : 0); pq[j] = ok ? bf2f(a.qkv()[r * 1536 + h * 64 + lane]) : 0.f; pk[j] = ok ? bf2f(a.qkv()[r * 1536 + 512 + h * 64 + lane]) : 0.f; }
        { const int j0 = lane >> 3, j1 = j0 + 8; pv0 = j0 < nt ? bf2f(a.qkv()[(rbase + j0) * 1536 + 1024 + h * 64 + dvg * 8 + (lane & 7)]) : 0.f; pv1 = j1 < nt ? bf2f(a.qkv()[(rbase + j1) * 1536 + 1024 + h * 64 + dvg * 8 + (lane & 7)]) : 0.f; }
        { const int j = lane & 15; pgb = j < nt ? (lane < 16 ? a.gg()[(rbase + j) * 8 + h] : a.bb()[(rbase + j) * 8 + h]) : 0.f; }
    }
    for (int t0 = 0; t0 < T; t0 += 16) {
        const int nt = (T - t0) < 16 ? (T - t0) : 16;
        WSYNC();
#pragma unroll
        for (int j = 0; j < 16; ++j) { sq[j][lane] = pq[j]; sk[j][lane] = pk[j]; }
        sv[lane >> 3][lane & 7] = pv0; sv[(lane >> 3) + 8][lane & 7] = pv1;
        if (lane < 16) sg[lane] = expf(pgb); else if (lane < 32) sb[lane - 16] = pgb;
        WSYNC();
        if (t0 + 16 < T) {
            const size_t rb = rbase + t0 + 16;
#pragma unroll
            for (int j = 0; j < 16; ++j) { pq[j] = bf2f(a.qkv()[(rb + j) * 1536 + h * 64 + lane]); pk[j] = bf2f(a.qkv()[(rb + j) * 1536 + 512 + h * 64 + lane]); }
            pv0 = bf2f(a.qkv()[(rb + (lane >> 3)) * 1536 + 1024 + h * 64 + dvg * 8 + (lane & 7)]); pv1 = bf2f(a.qkv()[(rb + (lane >> 3) + 8) * 1536 + 1024 + h * 64 + dvg * 8 + (lane & 7)]);
            pgb = lane < 16 ? a.gg()[(rb + (lane & 15)) * 8 + h] : a.bb()[(rb + (lane & 15)) * 8 + h];
        }
        for (int j = 0; j < nt; ++j) {
            const float dec = sg[j], be = sb[j], v = sv[j][e];
            const float4 k0 = *(const float4*)&sk[j][ko * 8], k1 = *(const float4*)&sk[j][ko * 8 + 4];
            const float4 q0 = *(const float4*)&sq[j][ko * 8], q1 = *(const float4*)&sq[j][ko * 8 + 4];
            const float kk[8] = {k0.x, k0.y, k0.z, k0.w, k1.x, k1.y, k1.z, k1.w};
            const float qq[8] = {q0.x, q0.y, q0.z, q0.w, q1.x, q1.y, q1.z, q1.w};
            float ks = 0.f;
#pragma unroll
            for (int d = 0; d < 8; ++d) { S[d] *= dec; ks += kk[d] * S[d]; }
            ks += __shfl_xor(ks, 8); ks += __shfl_xor(ks, 16); ks += __shfl_xor(ks, 32);
            const float delta = (v - ks) * be;
            float ov = 0.f;
#pragma unroll
            for (int d = 0; d < 8; ++d) { S[d] += kk[d] * delta; ov += qq[d] * S[d]; }
            ov += __shfl_xor(ov, 8); ov += __shfl_xor(ov, 16); ov += __shfl_xor(ov, 32);
            if (ko == 0) a.goraw()[(rbase + t0 + j) * 512 + h * 64 + col] = ov;
        }
    }
#pragma unroll
    for (int d = 0; d < 8; ++d) sout[(((size_t)b * 8 + h) * 64 + ko * 8 + d) * 64 + col] = S[d];
}
__device__ __forceinline__ int pi_pos(int k) { return (k & 32) + 8 * ((k >> 2) & 3) + 4 * ((k >> 4) & 1) + (k & 3); }
#define GDN_WLDS 17408
__device__ __forceinline__ void gdn_prep_unit(const MK& a, int u, int lane_in, char* wsm) {
    int lane = lane_in; asm volatile("" : "+v"(lane));
    u = __builtin_amdgcn_readfirstlane(u);
    const int bh = u >> 5, n = u & 31, b = bh >> 3, h = bh & 7, i16 = lane & 15, q4 = lane >> 4;
    const size_t row0 = (size_t)b * SEQ + n * 64;
    float* AT = (float*)wsm; float* GC = (float*)(wsm + 16384); float* BT = GC + 64;
    const bf16_t* qbase = a.qkv() + row0 * 1536 + h * 64; const bf16_t* kbase = qbase + 512; const bf16_t* vbase = qbase + 1024;
    float g = a.gg()[(row0 + lane) * 8 + h];
    const float be_l = a.bb()[(row0 + lane) * 8 + h];
#pragma unroll
    for (int o = 1; o < 64; o <<= 1) { const float t = __shfl_up(g, o); if (lane >= o) g += t; }
    WSYNC();
    GC[lane] = g; BT[lane] = be_l;
    WSYNC();
    const float gl = GC[63];
    float* EG = BT + 64; float* ED = EG + 64;
    EG[lane] = expf(g); ED[lane] = expf(gl - g);
    WSYNC();
    bf16x8 kf[4][2], qf[4][2];
#pragma unroll
    for (int mt = 0; mt < 4; ++mt)
#pragma unroll
        for (int ks = 0; ks < 2; ++ks) {
            const int off = (16 * mt + i16) * 1536 + 32 * ks + 8 * q4;
            kf[mt][ks] = *(const bf16x8*)(kbase + off); qf[mt][ks] = *(const bf16x8*)(qbase + off);
        }
    char* QKg = (char*)(a.gQK() + (size_t)u * 4096);
    unsigned qoff[2][4];
#pragma unroll
    for (int r = 0; r < 4; ++r) { qoff[0][r] = (unsigned)((4 * q4 + r) * 128 + 16 * ((i16 >> 2) ^ r) + 2 * (i16 & 3) + 64 * (q4 & 1)); qoff[1][r] = qoff[0][r] ^ 64u; }
#pragma unroll
    for (int mt = 0; mt < 4; ++mt) {
        const float4 gci4 = *(const float4*)(GC + 16 * mt + 4 * q4), bti4 = *(const float4*)(BT + 16 * mt + 4 * q4);
        const float gci[4] = {gci4.x, gci4.y, gci4.z, gci4.w}, bti[4] = {bti4.x, bti4.y, bti4.z, bti4.w};
#pragma unroll
        for (int nt = 0; nt < 4; ++nt) {
            if (nt <= mt) {
                f32x4 d1 = {0.f, 0.f, 0.f, 0.f}, d2 = {0.f, 0.f, 0.f, 0.f};
#pragma unroll
                for (int ks = 0; ks < 2; ++ks) {
                    d1 = __builtin_amdgcn_mfma_f32_16x16x32_bf16(kf[mt][ks], kf[nt][ks], d1, 0, 0, 0);
                    d2 = __builtin_amdgcn_mfma_f32_16x16x32_bf16(qf[mt][ks], kf[nt][ks], d2, 0, 0, 0);
                }
                const float gcj = GC[16 * nt + i16];
#pragma unroll
                for (int r = 0; r < 4; ++r) {
                    const float dec = __builtin_amdgcn_exp2f(1.44269504f * (gci[r] - gcj));
                    float av = bti[r] * d1[r] * dec, qv = d2[r] * dec;
                    if (nt == mt) { av = (4 * q4 + r > i16) ? av : 0.f; qv = (4 * q4 + r >= i16) ? qv : 0.f; }
                    AT[(16 * mt + 4 * q4 + r) * 64 + 16 * nt + i16] = av;
                    *(bf16_t*)(QKg + 2048 * mt + qoff[nt >> 1][r] + 8 * (nt & 1)) = f2bf(qv);
                }
            } else {
#pragma unroll
                for (int r = 0; r < 4; ++r) *(bf16_t*)(QKg + 2048 * mt + qoff[nt >> 1][r] + 8 * (nt & 1)) = 0;
            }
        }
    }
    {
        bf16_t* Qgg = a.gQg() + (size_t)u * 4096;
#pragma unroll
        for (int mt = 0; mt < 4; ++mt) {
            const int i = 16 * mt + i16; const float e = EG[i];
#pragma unroll
            for (int ks = 0; ks < 2; ++ks) {
                float x[8]; bf8_to_f32(qf[mt][ks], x);
                uint2 w0, w1; w0.x = cvtpk(x[0] * e, x[1] * e); w0.y = cvtpk(x[2] * e, x[3] * e); w1.x = cvtpk(x[4] * e, x[5] * e); w1.y = cvtpk(x[6] * e, x[7] * e);
                const int p0 = 32 * ks + 16 * (q4 & 1) + 4 * (q4 >> 1);
                *(uint2*)(Qgg + i * 64 + (((p0 >> 3) ^ (i & 7)) << 3) + (p0 & 7)) = w0; *(uint2*)(Qgg + i * 64 + ((((p0 >> 3) + 1) ^ (i & 7)) << 3) + (p0 & 7)) = w1;
            }
        }
    }
    WSYNC();
    __builtin_amdgcn_sched_barrier(0);
    {
        const float* Nb = AT + (16 * q4) * 64 + 16 * q4;
        float t[16];
#pragma unroll
        for (int r = 0; r < 16; ++r) t[r] = (r == i16) ? 1.f : 0.f;
#pragma unroll
        for (int r = 1; r < 16; ++r) {
            float sacc = 0.f;
#pragma unroll
            for (int j4 = 0; j4 < r; j4 += 4) {
                const float4 av = *(const float4*)(Nb + r * 64 + j4);
                sacc += av.x * t[j4];
                if (j4 + 1 < r) sacc += av.y * t[j4 + 1];
                if (j4 + 2 < r) sacc += av.z * t[j4 + 2];
                if (j4 + 3 < r) sacc += av.w * t[j4 + 3];
            }
            t[r] -= sacc;
        }
        WSYNC();
#pragma unroll
        for (int r = 0; r < 16; ++r) AT[(16 * q4 + r) * 64 + 16 * q4 + i16] = t[r];
        WSYNC();
    }
    __builtin_amdgcn_sched_barrier(0);
    {
#pragma unroll
        for (int pass = 0; pass < 2; ++pass) {
            f32x4 Y[4][4];
            const bf16_t* src = pass == 0 ? vbase : kbase;
#pragma unroll
            for (int bi = 0; bi < 4; ++bi)
#pragma unroll
                for (int r = 0; r < 4; ++r) {
                    const uint2 w = *(const uint2*)(src + (16 * bi + 4 * q4 + r) * 1536 + 4 * i16);
                    Y[bi][0][r] = __uint_as_float(w.x << 16); Y[bi][1][r] = __uint_as_float(w.x & 0xffff0000u); Y[bi][2][r] = __uint_as_float(w.y << 16); Y[bi][3][r] = __uint_as_float(w.y & 0xffff0000u);
                }
            if (pass == 1) {
#pragma unroll
                for (int nt = 0; nt < 4; ++nt) {
                    bf16_t* Kdg = a.gKd() + ((size_t)u * 64 + 4 * i16 + nt) * 64;
#pragma unroll
                    for (int bi = 0; bi < 4; ++bi) {
                        const float4 ed = *(const float4*)(ED + 16 * bi + 4 * q4);
                        uint2 w; w.x = cvtpk(Y[bi][nt][0] * ed.x, Y[bi][nt][1] * ed.y); w.y = cvtpk(Y[bi][nt][2] * ed.z, Y[bi][nt][3] * ed.w);
                        *(uint2*)(Kdg + 8 * ((4 * (bi >> 1) + q4) ^ ((4 * i16 + nt) & 7)) + 4 * (bi & 1)) = w;
                    }
                }
            }
#pragma unroll
            for (int bi = 0; bi < 4; ++bi) {
                const float4 btv = *(const float4*)(BT + 16 * bi + 4 * q4), egv = *(const float4*)(EG + 16 * bi + 4 * q4);
                const f32x4 sc = pass == 0 ? (f32x4){btv.x, btv.y, btv.z, btv.w} : (f32x4){btv.x * egv.x, btv.y * egv.y, btv.z * egv.z, btv.w * egv.w};
#pragma unroll
                for (int nt = 0; nt < 4; ++nt) Y[bi][nt] = Y[bi][nt] * sc;
            }
#pragma unroll
            for (int bi = 0; bi < 4; ++bi) {
                f32x4 mfr[4];
#pragma unroll
                for (int bj = 0; bj <= bi; ++bj) { const f32x4 v = *(const f32x4*)(AT + (16 * bi + i16) * 64 + 16 * bj + 4 * q4); mfr[bj] = (bi == bj) ? v : -v; }
#pragma unroll
                for (int bj = 0; bj < bi; ++bj)
#pragma unroll
                    for (int s4 = 0; s4 < 4; ++s4)
#pragma unroll
                        for (int nt = 0; nt < 4; ++nt) Y[bi][nt] = __builtin_amdgcn_mfma_f32_16x16x4f32(mfr[bj][s4], Y[bj][nt][s4], Y[bi][nt], 0, 0, 0);
                f32x4 X[4];
#pragma unroll
                for (int nt = 0; nt < 4; ++nt) X[nt] = (f32x4){0.f, 0.f, 0.f, 0.f};
#pragma unroll
                for (int s4 = 0; s4 < 4; ++s4)
#pragma unroll
                    for (int nt = 0; nt < 4; ++nt) X[nt] = __builtin_amdgcn_mfma_f32_16x16x4f32(mfr[bi][s4], Y[bi][nt][s4], X[nt], 0, 0, 0);
#pragma unroll
                for (int nt = 0; nt < 4; ++nt) Y[bi][nt] = X[nt];
            }
            if (pass == 0) {
#pragma unroll
                for (int nt = 0; nt < 4; ++nt) {
                    float* UTg = a.gUT() + ((size_t)u * 64 + 4 * i16 + nt) * 64;
#pragma unroll
                    for (int bi = 0; bi < 4; ++bi) *(float4*)(UTg + 4 * ((4 * bi + q4) ^ ((4 * i16 + nt) & 15))) = (float4){Y[bi][nt][0], Y[bi][nt][1], Y[bi][nt][2], Y[bi][nt][3]};
                }
            } else {
                bf16_t* Wng = a.gWn() + (size_t)u * 4096; const int pp = pi_pos(4 * i16);
#pragma unroll
                for (int bi = 0; bi < 4; ++bi)
#pragma unroll
                    for (int r = 0; r < 4; ++r) { const int i = 16 * bi + 4 * q4 + r;
                        uint2 w; w.x = cvtpk(-Y[bi][0][r], -Y[bi][1][r]); w.y = cvtpk(-Y[bi][2][r], -Y[bi][3][r]);
                        *(uint2*)(Wng + i * 64 + (((pp >> 3) ^ (i & 7)) << 3) + (pp & 7)) = w; }
            }
            __builtin_amdgcn_sched_barrier(0);
        }
    }
    if (lane == 0) a.ggam()[u] = expf(gl);
}
__device__ __forceinline__ bf16x8 pack_acc2(const f32x4& x, const f32x4& y) {
    u32x4 w; w.x = cvtpk(x[0], x[1]); w.y = cvtpk(x[2], x[3]); w.z = cvtpk(y[0], y[1]); w.w = cvtpk(y[2], y[3]);
    return __builtin_bit_cast(bf16x8, w);
}
#define G2_SLOT 49152
__device__ __forceinline__ void g2_issue(const MK& a, size_t u, int n, LAS unsigned char* lds, int lw, int lane) {
    LAS unsigned char* dst = lds + (n % 3) * G2_SLOT;
    const char* srcs[4] = {(const char*)(a.gWn() + u * 4096), (const char*)(a.gQg() + u * 4096), (const char*)(a.gQK() + u * 4096), (const char*)(a.gKd() + u * 4096)};
#pragma unroll
    for (int m = 0; m < 4; ++m)
#pragma unroll
        for (int i = 0; i < 2; ++i) { const int piece = 2 * lw + i;
            __builtin_amdgcn_global_load_lds((const unsigned*)(srcs[m] + piece * 1024 + lane * 16), (LAS unsigned*)(dst + m * 8192 + piece * 1024), 16, 0, 0); }
    const char* us = (const char*)(a.gUT() + u * 4096);
#pragma unroll
    for (int i = 0; i < 4; ++i) { const int piece = 4 * lw + i;
        __builtin_amdgcn_global_load_lds((const unsigned*)(us + piece * 1024 + lane * 16), (LAS unsigned*)(dst + 32768 + piece * 1024), 16, 0, 0); }
}
__device__ __forceinline__ void gdn_scan_block(const MK& a, int bh, LAS unsigned char* lds) {
    const int tid = otid(), lane = tid & 63, wid = __builtin_amdgcn_readfirstlane(tid >> 6), i16 = lane & 15, q4 = lane >> 4;
    const int b = bh >> 3, h = bh & 7, sl = wid & 3;
    const bool loader = wid >= 4;
    f32x4 S[4];
#pragma unroll
    for (int mt = 0; mt < 4; ++mt) S[mt] = (f32x4){0.f, 0.f, 0.f, 0.f};
    __syncthreads();
    if (loader) { g2_issue(a, (size_t)bh * 32, 0, lds, wid - 4, lane); g2_issue(a, (size_t)bh * 32 + 1, 1, lds, wid - 4, lane); }
    for (int n = 0; n < 32; ++n) {
        if (loader) { if (n < 31) asm volatile("s_waitcnt vmcnt(12)" ::: "memory"); else asm volatile("s_waitcnt vmcnt(0)" ::: "memory"); }
        asm volatile("s_waitcnt lgkmcnt(0)" ::: "memory"); __builtin_amdgcn_s_barrier(); asm volatile("" ::: "memory");
        if (loader) { if (n + 2 < 32) g2_issue(a, (size_t)bh * 32 + n + 2, n + 2, lds, wid - 4, lane); }
        else {
            const LAS unsigned char* sb = lds + (n % 3) * G2_SLOT;
            const float gam = a.ggam()[(size_t)bh * 32 + n];
            bf16x8 Sb[2]; Sb[0] = pack_acc2(S[0], S[1]); Sb[1] = pack_acc2(S[2], S[3]);
            f32x4 Vn[4];
#pragma unroll
            for (int mt = 0; mt < 4; ++mt) Vn[mt] = *(const LAS f32x4*)(sb + 32768 + (16 * sl + i16) * 256 + 16 * ((4 * mt + q4) ^ i16));
#pragma unroll
            for (int mt = 0; mt < 4; ++mt)
#pragma unroll
                for (int ks = 0; ks < 2; ++ks) Vn[mt] = __builtin_amdgcn_mfma_f32_16x16x32_bf16(*(const LAS bf16x8*)(sb + (16 * mt + i16) * 128 + 16 * ((4 * ks + q4) ^ (i16 & 7))), Sb[ks], Vn[mt], 0, 0, 0);
            bf16x8 Vb[2]; Vb[0] = pack_acc2(Vn[0], Vn[1]); Vb[1] = pack_acc2(Vn[2], Vn[3]);
            f32x4 O[4];
#pragma unroll
            for (int mt = 0; mt < 4; ++mt) {
                O[mt] = (f32x4){0.f, 0.f, 0.f, 0.f};
#pragma unroll
                for (int ks = 0; ks < 2; ++ks) {
                    const int fo = (16 * mt + i16) * 128 + 16 * ((4 * ks + q4) ^ (i16 & 7));
                    O[mt] = __builtin_amdgcn_mfma_f32_16x16x32_bf16(*(const LAS bf16x8*)(sb + 8192 + fo), Sb[ks], O[mt], 0, 0, 0);
                    O[mt] = __builtin_amdgcn_mfma_f32_16x16x32_bf16(*(const LAS bf16x8*)(sb + 16384 + fo), Vb[ks], O[mt], 0, 0, 0);
                }
            }
#pragma unroll
            for (int mt = 0; mt < 4; ++mt) {
                S[mt] = S[mt] * gam;
#pragma unroll
                for (int ks = 0; ks < 2; ++ks) S[mt] = __builtin_amdgcn_mfma_f32_16x16x32_bf16(*(const LAS bf16x8*)(sb + 24576 + (16 * mt + i16) * 128 + 16 * ((4 * ks + q4) ^ (i16 & 7))), Vb[ks], S[mt], 0, 0, 0);
            }
            float* og = a.goraw() + ((size_t)b * SEQ + n * 64 + 4 * q4) * 512 + h * 64 + 16 * sl + i16;
#pragma unroll
            for (int mt = 0; mt < 4; ++mt)
#pragma unroll
                for (int r = 0; r < 4; ++r) og[(size_t)(16 * mt + r) * 512] = O[mt][r];
        }
    }
    if (!loader) {
        float* so = a.out + O_GSP + ((size_t)bh * 64 + 4 * q4) * 64 + 16 * sl + i16;
#pragma unroll
        for (int mt = 0; mt < 4; ++mt)
#pragma unroll
            for (int r = 0; r < 4; ++r) so[(size_t)(16 * mt + r) * 64] = S[mt][r];
    }
    __syncthreads();
}
__device__ __forceinline__ void gdn_out_token(const MK& a, int row, int lane) {
    const float* op = a.goraw() + (size_t)row * 512 + 8 * lane;
    const float4 x0 = *(const float4*)op, x1 = *(const float4*)(op + 4);
    float o[8] = {x0.x, x0.y, x0.z, x0.w, x1.x, x1.y, x1.z, x1.w}, zg[8];
    bf8_to_f32(*(const bf16x8*)(a.Z() + (size_t)row * ZW + OFF_Z + 8 * lane), zg);
    float ss = 0.f;
#pragma unroll
    for (int e = 0; e < 8; ++e) ss += o[e] * o[e];
    ss = sum8(ss);
    const float rs = rsqrtf(ss * (1.f / 64.f) + EPSV);
    const float4 g0 = *(const float4*)(a.g_gdn_out + 8 * (lane & 7)), g1 = *(const float4*)(a.g_gdn_out + 8 * (lane & 7) + 4);
    const float gg_[8] = {g0.x, g0.y, g0.z, g0.w, g1.x, g1.y, g1.z, g1.w};
#pragma unroll
    for (int e = 0; e < 8; ++e) o[e] = o[e] * rs * gg_[e] * zg[e] * fast_sigmoid(zg[e]);
    *(bf16x8*)(a.omix() + (size_t)row * 1024 + 8 * lane) = f32_to_bf8(o);
}

#define SSLOT 32768
#define TL_OFF (3 * SSLOT)
#define CST 264
#define KR_OFF (TL_OFF + 2 * 32 * CST * 2)
#define WQ_OFF (KR_OFF + 4 * 4096)
#define QR_OFF (WQ_OFF + 2048)
#define PG_OFF (QR_OFF + 1024)
#define PT_OFF (PG_OFF + 64)
#define AL_OFF (PT_OFF + 1024)
#define SAMP_LDS_END (AL_OFF + 64)
__device__ __forceinline__ void samp_issue(const MK& a, int g, LAS unsigned char* lds, int wid, int lane) {
    const int phys = __builtin_amdgcn_readfirstlane(((const LAS int*)(lds + PG_OFF))[g >> 2]);
    const int tok0 = (g & 3) * 32 + 4 * wid;
    const float* cs = a.cache_ckv + ((size_t)phys * 128 + tok0) * 256 + lane * 4;
#pragma unroll
    for (int i = 0; i < 4; ++i) __builtin_amdgcn_global_load_lds((const unsigned*)(cs + i * 256), (LAS unsigned*)(lds + (g % 3) * SSLOT + (4 * wid + i) * 1024), 16, 0, 0);
    if (wid < 4) { const int tl = lane >> 3, cg = (lane & 7) ^ (((tl >> 1) & 1) | ((wid & 1) << 2));
        __builtin_amdgcn_global_load_lds((const unsigned*)(a.cache_krope + ((size_t)phys * 128 + (g & 3) * 32 + 8 * wid + tl) * 32 + cg * 4), (LAS unsigned*)(lds + KR_OFF + (g & 3) * 4096 + wid * 1024), 16, 0, 0); }
}
typedef unsigned u32x2 __attribute__((ext_vector_type(2)));
__device__ __forceinline__ void samp_convert(int g, LAS unsigned char* lds, int tid) {
    const int st = tid >> 4, l16 = tid & 15;
    const LAS float* src = (const LAS float*)(lds + (g % 3) * SSLOT) + st * 256 + 4 * l16;
    LAS bf16_t* dst = (LAS bf16_t*)(lds + TL_OFF + (g & 1) * 32 * CST * 2) + st * CST + 4 * l16;
    f32x4 x[4];
#pragma unroll
    for (int k = 0; k < 4; ++k) x[k] = *(const LAS f32x4*)(src + 64 * k);
#pragma unroll
    for (int k = 0; k < 4; ++k) { u32x2 w; w.x = cvtpk(x[k][0], x[k][1]); w.y = cvtpk(x[k][2], x[k][3]); *(LAS u32x2*)(dst + 64 * k) = w; }
}
#define SAMP_WAITV(n5, n4) do { if (h < 4) asm volatile("s_waitcnt vmcnt(" #n5 ")" ::: "memory"); else asm volatile("s_waitcnt vmcnt(" #n4 ")" ::: "memory"); } while (0)
#define SAMP_BAR() do { asm volatile("s_waitcnt lgkmcnt(0)" ::: "memory"); __builtin_amdgcn_s_barrier(); asm volatile("" ::: "memory"); } while (0)
__device__ __forceinline__ void samp_attn_unit(const MK& a, int u, char* smem, LAS unsigned char* lds) {
    const int tid = otid(), lane = tid & 63, h = __builtin_amdgcn_readfirstlane(tid >> 6), i16 = lane & 15, q4 = lane >> 4;
    const int b = u >> 3, sp = u & 7;
    float* WQ = (float*)(smem + WQ_OFF);
    float* QR = (float*)(smem + QR_OFF);
    int* PG = (int*)(smem + PG_OFF);
    const float SCL = 0.14724445f;
    post_q_item(a, (NPT + b) * 8 + h, lane);
    __syncthreads();
    {
        const int h_ = tid >> 6, l_ = tid & 63, q4_ = l_ >> 4, idx = l_ & 15, d = 16 * (idx >> 2) + 4 * q4_ + (idx & 3);
        WQ[tid] = a.g_k_nope[d] * a.qh()[((size_t)(NPT + b) * 8 + h_) * 96 + d] * SCL;
        if (tid < 256) QR[tid] = a.qh()[((size_t)(NPT + b) * 8 + (tid >> 5)) * 96 + 64 + (tid & 31)] * SCL;
        if (tid < 16) PG[tid] = a.page_table[b * NPAGES + sp * 16 + tid];
    }
    bf16x8 wf[4][8];
#pragma unroll
    for (int mt = 0; mt < 4; ++mt)
#pragma unroll
        for (int ks = 0; ks < 8; ++ks) wf[mt][ks] = *(const bf16x8*)(a.WknT() + (size_t)(h * 64 + 16 * mt + i16) * 256 + 32 * ks + 8 * q4);
#pragma unroll
    for (int mt = 0; mt < 4; ++mt)
#pragma unroll
        for (int ks = 0; ks < 8; ++ks) asm volatile("" : "+v"(wf[mt][ks]));
    __syncthreads();
    samp_issue(a, 0, lds, h, lane); samp_issue(a, 1, lds, h, lane); samp_issue(a, 2, lds, h, lane);
    SAMP_WAITV(10, 8);
    SAMP_BAR();
    samp_convert(0, lds, tid);
    const LAS float* QRl = (const LAS float*)(lds + QR_OFF) + h * 32 + 8 * q4;
    const LAS float* WQl = (const LAS float*)(lds + WQ_OFF) + (h * 4 + q4) * 16;
    f32x4 wqr[4], qrr[2];
#pragma unroll
    for (int mt = 0; mt < 4; ++mt) wqr[mt] = *(const LAS f32x4*)(WQl + 4 * mt);
    qrr[0] = *(const LAS f32x4*)QRl; qrr[1] = *(const LAS f32x4*)(QRl + 4);
    float m = -INFINITY, lsum = 0.f;
    f32x4 latv[2]; latv[0] = (f32x4){0.f, 0.f, 0.f, 0.f}; latv[1] = (f32x4){0.f, 0.f, 0.f, 0.f};
    for (int g = 0; g < 64; ++g) {
        SAMP_BAR();
        if (g + 3 < 64) samp_issue(a, g + 3, lds, h, lane);
        const LAS bf16_t* Tl = (const LAS bf16_t*)(lds + TL_OFF + (g & 1) * 32 * CST * 2); const LAS float* KR = (const LAS float*)(lds + KR_OFF + (g & 3) * 4096);
        float scv;
        {
            float ssp[2], dotp[2], rdp[2];
            f32x4 acc[2][4];
#pragma unroll
            for (int hf = 0; hf < 2; ++hf)
#pragma unroll
                for (int mt = 0; mt < 4; ++mt) acc[hf][mt] = (f32x4){0.f, 0.f, 0.f, 0.f};
            const LAS bf16_t* cp0 = Tl + i16 * CST + 8 * q4; const LAS bf16_t* cp1 = cp0 + 16 * CST;
            bf16x8 c0 = *(const LAS bf16x8*)cp0, c1 = *(const LAS bf16x8*)cp1;
#pragma unroll
            for (int ks = 0; ks < 8; ++ks) {
                bf16x8 n0 = c0, n1 = c1;
                if (ks < 7) { n0 = *(const LAS bf16x8*)(cp0 + 32 * (ks + 1)); n1 = *(const LAS bf16x8*)(cp1 + 32 * (ks + 1)); }
#pragma unroll
                for (int mt = 0; mt < 4; ++mt) { acc[0][mt] = __builtin_amdgcn_mfma_f32_16x16x32_bf16(wf[mt][ks], c0, acc[0][mt], 0, 0, 0); acc[1][mt] = __builtin_amdgcn_mfma_f32_16x16x32_bf16(wf[mt][ks], c1, acc[1][mt], 0, 0, 0); }
                c0 = n0; c1 = n1;
            }
#pragma unroll
            for (int hf = 0; hf < 2; ++hf) {
                f32x2_t ss2 = {0.f, 0.f}, dot2 = {0.f, 0.f}, rd2 = {0.f, 0.f};
#pragma unroll
                for (int mt = 0; mt < 4; ++mt) {
                    const f32x4 wq = wqr[mt];
                    const f32x4 av = acc[hf][mt];
                    const f32x2_t lo = __builtin_shufflevector(av, av, 0, 1), hi = __builtin_shufflevector(av, av, 2, 3);
                    ss2 = __builtin_elementwise_fma(lo, lo, ss2); ss2 = __builtin_elementwise_fma(hi, hi, ss2);
                    dot2 = __builtin_elementwise_fma(lo, __builtin_shufflevector(wq, wq, 0, 1), dot2); dot2 = __builtin_elementwise_fma(hi, __builtin_shufflevector(wq, wq, 2, 3), dot2);
                }
                {
                    const int kc = (2 * q4) ^ ((i16 >> 1) & 5);
                    const LAS float* kp = KR + (16 * hf + i16) * 32;
                    const f32x4 k0 = *(const LAS f32x4*)(kp + 4 * kc), k1 = *(const LAS f32x4*)(kp + 4 * (kc ^ 1)), q0 = qrr[0], q1 = qrr[1];
                    rd2 = __builtin_elementwise_fma(__builtin_shufflevector(k0, k0, 0, 1), __builtin_shufflevector(q0, q0, 0, 1), rd2); rd2 = __builtin_elementwise_fma(__builtin_shufflevector(k0, k0, 2, 3), __builtin_shufflevector(q0, q0, 2, 3), rd2);
                    rd2 = __builtin_elementwise_fma(__builtin_shufflevector(k1, k1, 0, 1), __builtin_shufflevector(q1, q1, 0, 1), rd2); rd2 = __builtin_elementwise_fma(__builtin_shufflevector(k1, k1, 2, 3), __builtin_shufflevector(q1, q1, 2, 3), rd2);
                }
                ssp[hf] = ss2[0] + ss2[1]; dotp[hf] = dot2[0] + dot2[1]; rdp[hf] = rd2[0] + rd2[1];
            }
            const auto s1 = __builtin_amdgcn_permlane16_swap(__float_as_uint(ssp[0]), __float_as_uint(ssp[1]), false, false);
            const auto s2 = __builtin_amdgcn_permlane16_swap(__float_as_uint(dotp[0]), __float_as_uint(dotp[1]), false, false);
            const auto s3 = __builtin_amdgcn_permlane16_swap(__float_as_uint(rdp[0]), __float_as_uint(rdp[1]), false, false);
            const float u1 = __uint_as_float(s1[0]) + __uint_as_float(s1[1]), u2 = __uint_as_float(s2[0]) + __uint_as_float(s2[1]), u3 = __uint_as_float(s3[0]) + __uint_as_float(s3[1]);
            const auto t1 = __builtin_amdgcn_permlane32_swap(__float_as_uint(u1), __float_as_uint(u2), false, false);
            const float t = __uint_as_float(t1[0]) + __uint_as_float(t1[1]);
            const auto t2 = __builtin_amdgcn_permlane32_swap(__float_as_uint(t), __float_as_uint(t), false, false);
            const float ssv = __uint_as_float(t2[0]), dotv = __uint_as_float(t2[1]);
            const float rdv = add_x32(u3);
            scv = dotv * rsqrtf(ssv * (1.f / 64.f) + EPSV) + rdv;
        }
        float gm = max16(scv);
        { const auto r = __builtin_amdgcn_permlane16_swap(__float_as_uint(gm), __float_as_uint(gm), false, false); gm = fmaxf(__uint_as_float(r[0]), __uint_as_float(r[1])); }
        const float mn = fmaxf(m, gm);
        const float alpha = __builtin_amdgcn_exp2f(m - mn), pv = __builtin_amdgcn_exp2f(scv - mn);
        m = mn;
        lsum = lsum * alpha + pv;
        if (q4 < 2) { ((LAS float*)(lds + PT_OFF))[h * 32 + lane] = pv; if (lane == 0) ((LAS float*)(lds + AL_OFF))[h] = alpha; }
        if (g <= 60) SAMP_WAITV(10, 8); else if (g == 61) SAMP_WAITV(5, 4); else SAMP_WAITV(0, 0);
        SAMP_BAR();
        {
            u32x4 pw = {0u, 0u, 0u, 0u};
            if (i16 < 8) { const f32x4 pa = *(const LAS f32x4*)(lds + PT_OFF + (i16 * 32 + 8 * q4) * 4), pb_ = *(const LAS f32x4*)(lds + PT_OFF + (i16 * 32 + 8 * q4 + 4) * 4);
                pw.x = cvtpk(pa[0], pa[1]); pw.y = cvtpk(pa[2], pa[3]); pw.z = cvtpk(pb_[0], pb_[1]); pw.w = cvtpk(pb_[2], pb_[3]); }
            const bf16x8 pfr = __builtin_bit_cast(bf16x8, pw);
            const f32x4 al = *(const LAS f32x4*)(lds + AL_OFF + (q4 & 1) * 16);
            const unsigned tb0 = (unsigned)(size_t)((const LAS bf16_t*)(lds + TL_OFF + (g & 1) * 32 * CST * 2) + (8 * q4 + (i16 >> 2)) * CST + 32 * h + 4 * (i16 & 3));
            s16x4 c0[2], c1[2];
            static_assert(4 * CST * 2 == 2112, "tr offsets");
            asm volatile("ds_read_b64_tr_b16 %0, %4\n\tds_read_b64_tr_b16 %1, %4 offset:2112\n\tds_read_b64_tr_b16 %2, %4 offset:32\n\tds_read_b64_tr_b16 %3, %4 offset:2144\n\ts_waitcnt lgkmcnt(0)"
                         : "=&v"(c0[0]), "=&v"(c1[0]), "=&v"(c0[1]), "=&v"(c1[1]) : "v"(tb0) : "memory");
#pragma unroll
            for (int nt = 0; nt < 2; ++nt) {
                const bf16x8 cfr = __builtin_shufflevector(c0[nt], c1[nt], 0, 1, 2, 3, 4, 5, 6, 7);
                latv[nt] = latv[nt] * al;
                latv[nt] = __builtin_amdgcn_mfma_f32_16x16x32_bf16(pfr, cfr, latv[nt], 0, 0, 0);
            }
        }
        if (g + 1 < 64) samp_convert(g + 1, lds, tid);
    }
    lsum = add_x16(sum16(lsum));
    if (lane == 0) { float* o = a.part() + ((size_t)u * 8 + h) * 260; o[0] = m * 0.69314718f; o[1] = lsum; }
    if (q4 < 2) {
#pragma unroll
        for (int nt = 0; nt < 2; ++nt)
#pragma unroll
            for (int r = 0; r < 4; ++r) a.part()[((size_t)u * 8 + 4 * q4 + r) * 260 + 4 + 32 * h + 16 * nt + i16] = latv[nt][r];
    }
}
__device__ __forceinline__ void samp_comb_unit(const MK& a, int u, char* smem) {
    float* slat = (float*)smem; float* red = slat + 256;
    const int b = u >> 3, h = u & 7, tid = otid(), lane = tid & 63, wid = tid >> 6;
    const size_t row = NPT + b;
    const float* q = a.qh() + (row * 8 + h) * 96;
    float sp = q[lane] * a.kh()[(row * 8 + h) * 64 + lane];
    if (lane < 32) sp += q[64 + lane] * a.krf()[row * 32 + lane];
    const float s_self = wave_sum(sp) * 0.10206207261596577f;
    float pm[8], m = s_self;
#pragma unroll
    for (int s = 0; s < 8; ++s) { pm[s] = a.part()[((size_t)(b * 8 + s) * 8 + h) * 260]; m = fmaxf(m, pm[s]); }
    const float pself = __expf(s_self - m);
    float l = pself, lat = 0.f;
    __syncthreads();
#pragma unroll
    for (int s = 0; s < 8; ++s) {
        const float* p = a.part() + ((size_t)(b * 8 + s) * 8 + h) * 260;
        const float w = __expf(pm[s] - m);
        l += p[1] * w; if (tid < 256) lat += p[4 + tid] * w;
    }
    if (tid < 256) slat[tid] = lat;
    __syncthreads();
    {
        const float* wv = a.w_kv_b + (size_t)(32 * wid) * 1024 + h * 128 + 64 + lane;
        float o = 0.f;
#pragma unroll 8
        for (int c = 0; c < 32; ++c) o += slat[32 * wid + c] * wv[(size_t)c * 1024];
        red[wid * 64 + lane] = o;
    }
    __syncthreads();
    if (tid < 64) {
        float o = pself * a.KV()[row * 1024 + h * 128 + 64 + tid];
#pragma unroll
        for (int w = 0; w < 8; ++w) o += red[w * 64 + tid];
        a.omix()[row * 1024 + 512 + h * 64 + tid] = f2bf(o / l);
    }
}

#define XB_TMO      128
#define XB_XCNT(j)  (256  + 64 * (j))
#define XB_XSUB(j)  (1280 + 64 * (j))
#define XB_XGEN(j)  (2304 + 64 * (j))
#define XB_TOP      3328
#define XB_TOPGEN   3392
#define XCD_BAR_WORDS 3456
#define XB_SPIN_CAP (1u << 18)

__device__ __forceinline__ unsigned xb_ld(unsigned* p)              { return __hip_atomic_load(p, __ATOMIC_RELAXED, __HIP_MEMORY_SCOPE_AGENT); }
__device__ __forceinline__ unsigned xb_add(unsigned* p, unsigned v) { return __hip_atomic_fetch_add(p, v, __ATOMIC_RELAXED, __HIP_MEMORY_SCOPE_AGENT); }
__device__ __forceinline__ unsigned xb_xcc_id() { return (unsigned)__builtin_amdgcn_s_getreg((3 << 11) | 20) & 0xFu; }
#define XB_SPIN(cond, bar) do { unsigned _sp = 0; while (cond) { __builtin_amdgcn_s_sleep(1); \
    if ((++_sp & 255u) == 0u) { if (xb_ld(&(bar)[XB_TMO])) break; if (_sp > XB_SPIN_CAP) { atomicAdd(&(bar)[XB_TMO], 1u); break; } } } } while (0)

struct XcdBarrier {
    unsigned* bar; unsigned x;
    volatile LAS unsigned* st;
};

__device__ __forceinline__ XcdBarrier xcd_barrier_post(unsigned* bar, volatile LAS unsigned* st) {
    XcdBarrier b; b.bar = bar; b.x = xb_xcc_id(); b.st = st;
    if (threadIdx.x == 0) (void)xb_add(&bar[XB_XCNT(b.x)], 1u);
    return b;
}
__device__ __forceinline__ void xcd_barrier_complete(unsigned* bar, unsigned x, unsigned& nloc, unsigned& nx) {
    const unsigned G = gridDim.x * gridDim.y * gridDim.z;
    unsigned sum, cnt, mine, sp = 0u;
    for (;;) {
        sum = 0u; cnt = 0u; mine = 0u;
#pragma unroll
        for (unsigned j = 0; j < 16; ++j) { const unsigned c = xb_ld(&bar[XB_XCNT(j)]); sum += c; cnt += (c > 0u) ? 1u : 0u; mine = (j == x) ? c : mine; }
        if (sum == G) break;
        __builtin_amdgcn_s_sleep(1);
        if ((++sp & 255u) == 0u) { if (xb_ld(&bar[XB_TMO])) break; if (sp > XB_SPIN_CAP) { atomicAdd(&bar[XB_TMO], 1u); break; } }
    }
    nloc = mine > 0u ? mine : 1u; nx = cnt > 0u ? cnt : 1u;
}

__device__ __forceinline__ void xcd_barrier(const XcdBarrier& b) {
    asm volatile("s_waitcnt vmcnt(0)" ::: "memory");
    __syncthreads();
    if (threadIdx.x == 0) {
        unsigned* bar = b.bar;
        __builtin_amdgcn_s_waitcnt(0);
        unsigned nloc = b.st[0], nx = b.st[1];
        if (nloc == 0u) { xcd_barrier_complete(bar, b.x, nloc, nx); b.st[0] = nloc; b.st[1] = nx; }
        const unsigned old = xb_add(&bar[XB_XSUB(b.x)], 1u);
        const unsigned gen = old / nloc;
        if (old + 1u == (gen + 1u) * nloc) {
            __builtin_amdgcn_fence(__ATOMIC_RELEASE, "agent");
            asm volatile("s_waitcnt vmcnt(0)" ::: "memory");
            const unsigned og = xb_add(&bar[XB_TOP], 1u);
            const unsigned tg = og / nx;
            if (og + 1u == (tg + 1u) * nx) xb_add(&bar[XB_TOPGEN], 1u);
            else XB_SPIN(xb_ld(&bar[XB_TOPGEN]) == tg, bar);
            __builtin_amdgcn_fence(__ATOMIC_ACQUIRE, "agent");
            xb_add(&bar[XB_XGEN(b.x)], 1u);
            asm volatile("s_waitcnt vmcnt(0)" ::: "memory");
        } else {
            XB_SPIN(xb_ld(&bar[XB_XGEN(b.x)]) == gen, bar);
            __builtin_amdgcn_fence(__ATOMIC_ACQUIRE, "agent");
            asm volatile("s_waitcnt vmcnt(0)" ::: "memory");
        }
    }
    __syncthreads();
}

__device__ __forceinline__ void late_weight_items(const MK& a, int gwl, int ngwl, float* scr, int lane) {
    const int T4 = 32 * 16, T5 = 176 * 16, T7 = 32 * 44, T8 = 32 * 16, TT = T4 + T5 + T7 + T8;
    for (int it = gwl; it < TT; it += ngwl) {
        int r = it;
        if (r < T4) { const int nt_ = r % 32, kb = r / 32; wt_item(a.w_o, 1024, 32 * nt_, 32, a.WoT(), 1024, 32 * nt_, 64 * kb, scr, lane); continue; } r -= T4;
        if (r < T5) { const int nt_ = r % 176, kb = r / 176, pn = nt_ >> 3, wi = nt_ & 7;
            wt_item(wi < 4 ? a.w_gate : a.w_up, DFF, pn * 128 + (wi & 3) * 32, 32, a.WguT(), 1024, 32 * nt_, 64 * kb, scr, lane); continue; } r -= T5;
        if (r < T7) { const int nt_ = r % 32, kb = r / 32; wt_item(a.w_down, 1024, 32 * nt_, 32, a.WdT(), DFF, 32 * nt_, 64 * kb, scr, lane); continue; } r -= T7;
        { const int nt_ = r % 32, kb = r / 32; wt_item(a.w_ple_gate, 1024, 32 * nt_, 32, a.WpgT(), 1024, 32 * nt_, 64 * kb, scr, lane); }
    }
}

#define XB_ST_OFF 155648
#define LDS_BYTES 155904
static_assert(SAMP_LDS_END <= LDS_BYTES, "LDS map");
#define GSYNC() do { xcd_barrier(xbar); } while (0)
__global__ __launch_bounds__(NTHR, 2) void mega(MK a) {
    cg::grid_group grid = cg::this_grid();
    char* smem = (char*)lds_raw;
    LAS unsigned char* lds = (LAS unsigned char*)lds_raw;
    otid_init();
    if (threadIdx.x < 2) ((LAS unsigned*)(lds_raw + XB_ST_OFF))[threadIdx.x] = 0u;
    __syncthreads();
    const XcdBarrier xbar = xcd_barrier_post(a.ctl(), (volatile LAS unsigned*)(LAS void*)(lds_raw + XB_ST_OFF));
    const int bid = blockIdx.x, nb = gridDim.x, ngw = nb * NWAVE;
#define LOCAL_IDS const int tid = otid(), lane = tid & 63, wid = __builtin_amdgcn_readfirstlane(tid >> 6), half = tid >> 8, gw = bid * NWAVE + wid; (void)lane; (void)half; (void)gw; (void)wid;

    {
    LOCAL_IDS
    {
        const int T0 = 88 * 16, T1 = 24 * 6, T2 = 32 * 4, T3 = 16 * 4, T9 = 32 * 4;
        const int TT = T0 + T1 + T2 + T3 + T9;
        float* scr = (float*)(smem + wid * 8704);
        for (int it = gw; it < TT; it += ngw) {
            int r = it;
            if (r < T0) { const int nt_ = r % 88, kb = r / 88, nv = 2736 - 32 * nt_; wt_item(a.w_in, 2736, 32 * nt_, nv < 0 ? 0 : (nv > 32 ? 32 : nv), a.WinT(), 1024, 32 * nt_, 64 * kb, scr, lane); continue; } r -= T0;
            if (r < T1) { const int nt_ = r % 24, kb = r / 24; wt_item(a.w_q_b, 768, 32 * nt_, 32, a.WqbT(), 384, 32 * nt_, 64 * kb, scr, lane); continue; } r -= T1;
            if (r < T2) { const int nt_ = r % 32, kb = r / 32; wt_item(a.w_kv_b, 1024, 32 * nt_, 32, a.WkvT(), 256, 32 * nt_, 64 * kb, scr, lane); continue; } r -= T2;
            if (r < T3) { const int nt_ = r % 16, kb = r / 16, h = nt_ >> 1; wt_item(a.w_kv_b, 1024, h * 128 + 32 * (nt_ & 1), 32, a.WknT(), 256, 32 * nt_, 64 * kb, scr, lane); continue; } r -= T3;
            { const int nt_ = r % 32, kb = r / 32; wt_item(a.w_ple_proj, 1024, 32 * nt_, 32, a.WppT(), 256, 32 * nt_, 64 * kb, scr, lane); }
        }
        for (int e = (bid * NTHR + tid); e < 2049 * 16; e += nb * NTHR) {
            const int pos = e >> 4, i = e & 15; const float ang = (pos == 2048 ? (float)PAST : (float)pos) * powf(10000.f, -(float)i / 16.f);
            a.ropecs()[pos * 32 + i] = cosf(ang); a.ropecs()[pos * 32 + 16 + i] = sinf(ang);
        }
        for (int row = gw; row < MPAD; row += ngw) {
            const float* src = row < NPT ? a.x_prompt + (size_t)row * 1024 : a.x_sample + (size_t)(row < NTOK ? row - NPT : 0) * 1024;
            rms1024_row(src, a.g_attn, a.xn() + (size_t)row * 1024, row >= NTOK, lane);
            ushort4 w = {0, 0, 0, 0};
            if (row < NTOK) { const float* ps = row < NPT ? a.p_prompt + (size_t)row * 256 : a.p_sample + (size_t)(row - NPT) * 256; const float4 v = *(const float4*)(ps + lane * 4); w.x = f2bf(v.x); w.y = f2bf(v.y); w.z = f2bf(v.z); w.w = f2bf(v.w); }
            *(ushort4*)(a.pb() + (size_t)row * 256 + lane * 4) = w;
            if (row >= NTOK) { for (int j = 0; j < 4; ++j) { ushort4 z = {0, 0, 0, 0}; *(ushort4*)(a.omix() + (size_t)row * 1024 + lane * 4 + 256 * j) = z; } }
        }
    }
    }
    if (a.out == nullptr) grid.sync();
    GSYNC();
    {
    LOCAL_IDS
    pg_gemm(lds, a.xn(), a.WinT(), NPT, ZW, 1024, PgBf16{a.Z(), ZW});
    gemm_sample_rows_ks<false>(a.xn(), 1024, a.WinT(), 1024, ZW, EwBf16{a.Z(), ZW}, smem, bid, nb);
    }
    GSYNC();
    {
    LOCAL_IDS
    for (int e = tid; e < 4 * 1536 / 4; e += NTHR) ((float4*)smem)[e] = ((const float4*)a.w_conv)[e];
    __syncthreads();
    for (int run = gw; run < NPT / 8 + NST; run += ngw) post_in_run(a, run, lane, (const float*)smem);
    }
    GSYNC();
    {
    LOCAL_IDS
    for (int u = gw; u < 2048; u += ngw) gdn_prep_unit(a, u, lane, smem + wid * GDN_WLDS);
    }
    {
    LOCAL_IDS
    for (int v = gw; v < NST * 64; v += ngw) gdn_unit(a, v >> 6, (v >> 3) & 7, v & 7, a.state_gdn, a.out + O_GSS, NPT, 1, lane, smem + wid * GDN_WLDS);
    __syncthreads();
    }
    GSYNC();
    {
    LOCAL_IDS
    pg_gemm(lds, a.qan(), a.WqbT(), NPT, 768, 384, PgBf16{a.qraw(), 768});
    pg_gemm(lds, a.ckvb(), a.WkvT(), NPT, 1024, 256, PgBf16{a.kvraw(), 1024}, nb > 64 ? nb - 64 : 0);
    gemm_sample_rows<false>(a.qan(), 384, a.WqbT(), 384, 768, EwF32{a.Q(), 768}, smem, bid, nb, 64);
    gemm_sample_rows<false>(a.ckvb(), 256, a.WkvT(), 256, 1024, EwF32{a.KV(), 1024}, smem, bid, nb, 72);
    for (int bh_ = nb - 1 - bid; bh_ < 64; bh_ += nb) gdn_scan_block(a, bh_, lds);
    if (nb > 64 && bid < nb - 64) {
        pg_gemm(lds, a.pb(), a.WppT(), NPT, 1024, 256, PgBf16{a.PP(), 1024}, nb - 64);
        __syncthreads();
        late_weight_items(a, bid * NWAVE + wid, (nb - 64) * NWAVE, (float*)(smem + wid * 8704), lane);
    } else if (nb <= 64) { pg_gemm(lds, a.pb(), a.WppT(), NPT, 1024, 256, PgBf16{a.PP(), 1024}); __syncthreads(); late_weight_items(a, gw, ngw, (float*)(smem + wid * 8704), lane); }
    gemm_sample_rows<false>(a.pb(), 256, a.WppT(), 256, 1024, EwBf16{a.PP(), 1024}, smem, bid, nb, 80);
    }
    GSYNC();
    {
    LOCAL_IDS
    for (int idx = gw; idx < NST * 8; idx += ngw) { post_q_item(a, NPT * 8 + idx, lane); post_kv_item(a, NPT * 8 + idx, lane); }
    for (int row = gw; row < NTOK; row += ngw) gdn_out_token(a, row, lane);
    for (int pr = bid; pr < 256; pr += nb) { const int bh_ = pr >> 2, s_ = pr & 3; attn_block(a, bh_ >> 3, bh_ & 7, 7 - s_, smem); attn_block(a, bh_ >> 3, bh_ & 7, s_, smem); }
    for (int u = bid; u < NST * 8; u += nb) samp_attn_unit(a, u, smem, lds);
    }
    GSYNC();
    {
    LOCAL_IDS
    for (int u = bid; u < NST * 8; u += nb) samp_comb_unit(a, u, smem);
    }
    GSYNC();
    {
    LOCAL_IDS
    pg_gemm(lds, a.omix(), a.WoT(), NPT, 1024, 1024, PgResXB{a.x_prompt, a.H()});
    gemm_sample_rows_ks<false, EwResX, 1>(a.omix(), 1024, a.WoT(), 1024, 1024, EwResX{a.x_sample, a.H()}, smem, bid, nb);
    }
    GSYNC();
    {
    LOCAL_IDS
    for (int row = gw; row < MPAD; row += ngw) rms1024_row_b(a.H() + (size_t)row * 1024, a.g_ffn, a.un() + (size_t)row * 1024, row >= NTOK, lane);
    }
    GSYNC();
    {
    LOCAL_IDS
    pg_gemm(lds, a.un(), a.WguT(), NPT, 2 * DFF, 1024, PgSwiglu{a.hid()});
    gemm_sample_rows_ks<true>(a.un(), 1024, a.WguT(), 1024, 2 * DFF, EwBf16{a.hid(), DFF}, smem, bid, nb);
    }
    GSYNC();
    {
    LOCAL_IDS
    pg_gemm(lds, a.hid(), a.WdT(), NPT, 1024, DFF, PgResBB{a.H(), a.H2()});
    gemm_sample_rows_ks<false, EwResH, 1>(a.hid(), DFF, a.WdT(), DFF, 1024, EwResH{a.H(), a.H2()}, smem, bid, nb);
    }
    GSYNC();
    {
    LOCAL_IDS
    for (int row = gw; row < MPAD; row += ngw) rms1024_row_b(a.H2() + (size_t)row * 1024, a.g_ple, a.un2() + (size_t)row * 1024, row >= NTOK, lane);
    }
    GSYNC();
    {
    LOCAL_IDS
    pg_gemm(lds, a.un2(), a.WpgT(), NPT, 1024, 1024, PgPleB{a.H2(), a.PP(), a.out});
    gemm_sample_rows_ks<false, EwPle, 1>(a.un2(), 1024, a.WpgT(), 1024, 1024, EwPle{a.H2(), a.PP(), a.out}, smem, bid, nb);
    }
}

static inline char* carve(char*& p, size_t bytes) { char* r = p; p += (bytes + 255) & ~(size_t)255; return r; }

extern "C" void kernel_launch(void* const* d_in, const int* in_sizes, int n_in, void* d_out, int out_size, void* d_ws, size_t ws_size, hipStream_t stream) {
    MK a{};
    a.x_prompt = (const float*)d_in[0]; a.x_sample = (const float*)d_in[1]; a.cache_ckv = (const float*)d_in[2]; a.cache_krope = (const float*)d_in[3];
    a.state_gdn = (const float*)d_in[4]; a.state_conv = (const float*)d_in[5]; a.page_table = (const int*)d_in[6]; a.p_prompt = (const float*)d_in[7]; a.p_sample = (const float*)d_in[8];
    a.g_attn = (const float*)d_in[9]; a.w_in = (const float*)d_in[10]; a.w_conv = (const float*)d_in[11]; a.a_log = (const float*)d_in[12]; a.dt_bias = (const float*)d_in[13];
    a.g_gdn_out = (const float*)d_in[14]; a.g_q_a = (const float*)d_in[15]; a.w_q_b = (const float*)d_in[16]; a.g_q_nope = (const float*)d_in[17]; a.g_q_rope = (const float*)d_in[18];
    a.g_kv_a = (const float*)d_in[19]; a.g_k_rope = (const float*)d_in[20]; a.w_kv_b = (const float*)d_in[21]; a.g_k_nope = (const float*)d_in[22]; a.w_o = (const float*)d_in[23];
    a.g_ffn = (const float*)d_in[24]; a.w_gate = (const float*)d_in[25]; a.w_up = (const float*)d_in[26]; a.w_down = (const float*)d_in[27]; a.g_ple = (const float*)d_in[28];
    a.w_ple_gate = (const float*)d_in[29]; a.w_ple_proj = (const float*)d_in[30];
    a.out = (float*)d_out;
    a.ws = (char*)d_ws;
    if (WS_TOTAL > ws_size) { fprintf(stderr, "kernel_launch: workspace too small: need %zu have %zu\n", (size_t)WS_TOTAL, ws_size); return; }

    static int grid_blocks = 0;
    if (!grid_blocks) {
        int dev = 0, cus = 0, per_cu = 0;
        (void)hipGetDevice(&dev);
        (void)hipDeviceGetAttribute(&cus, hipDeviceAttributeMultiprocessorCount, dev);
        (void)hipFuncSetAttribute((const void*)mega, hipFuncAttributeMaxDynamicSharedMemorySize, LDS_BYTES);
        (void)hipOccupancyMaxActiveBlocksPerMultiprocessor(&per_cu, (const void*)mega, NTHR, LDS_BYTES);
        if (per_cu < 1) fprintf(stderr, "kernel_launch: occupancy query says %d blocks/CU\n", per_cu);
        grid_blocks = cus;
    }
    (void)hipMemsetAsync((char*)d_ws + WOF_ctl, 0, 16384, stream);
    void* args[] = {&a};
    hipError_t e = hipLaunchCooperativeKernel((const void*)mega, dim3(grid_blocks), dim3(NTHR), args, LDS_BYTES, stream);
    if (e != hipSuccess) fprintf(stderr, "cooperative launch failed: %s (grid %d)\n", hipGetErrorString(e), grid_blocks);
}
```

```cpp
#include <hip/hip_runtime.h>
#include <stdint.h>
#include <cstdio>
#include <hip/hip_cooperative_groups.h>
namespace cg = cooperative_groups;


__device__ __forceinline__ int otid();
#define PG8_TID() otid()
namespace pg8 {
#define PG8_LAS __attribute__((address_space(3)))
typedef unsigned short bf16_t;
typedef short bf16x8 __attribute__((ext_vector_type(8)));
typedef float f32x4 __attribute__((ext_vector_type(4)));
typedef unsigned u32x4 __attribute__((ext_vector_type(4)));
constexpr int BM = 256, BK = 64, HALF = 128, HTB = HALF * BK * 2  , STAGE_BYTES = 8 * HTB, NXCD = 8, WGM = 8;

__host__ __device__ __forceinline__ int lds_byte(int r, int c) { const int st = (r >> 4) * 2 + (c >> 5), rr = r & 15, cc = c & 31, ob = rr * 64 + cc * 2; return st * 1024 + (ob ^ (((ob >> 9) & 1) << 5)); }
__host__ __device__ __forceinline__ void stage_rc(int b, int& R, int& C) { const int st = b / 1024, sb = b % 1024, swz = sb ^ (((sb >> 9) & 1) << 5); R = (st >> 1) * 16 + swz / 64; C = (st & 1) * 32 + (swz % 64) / 2; }
__host__ __device__ __forceinline__ int perm32(int rho) { const int n = rho >> 4, i = rho & 15; return 8 * (i >> 2) + 4 * n + (i & 3); }

struct Unit { int pm, pn; };
struct Gemm { const bf16_t* A; const bf16_t* Bt; int M, N, K; };

struct StaticOrder {
    int nM, nN, nwg, G, c;
    __host__ __device__ void init(int M, int N, int G_, int c_) { nM = M / BM; nN = N / BM; nwg = nM * nN; G = G_; c = c_; }
    __host__ __device__ bool next(int i, Unit& u) const {
        const long L = (long)i * G + c; if (L >= nwg) return false;
        int wgid = (int)L; { const int q = nwg / NXCD, r = nwg % NXCD, xcd = wgid % NXCD, off = wgid / NXCD; wgid = (xcd < r ? xcd * (q + 1) : r * (q + 1) + (xcd - r) * q) + off; }
        const int nig = WGM * nN, gid = wgid / nig, fm = gid * WGM, gsz = (nM - fm) < WGM ? (nM - fm) : WGM;
        u.pm = fm + ((wgid % nig) % gsz); u.pn = (wgid % nig) / gsz; return true;
    }
    __device__ __forceinline__ void a_ready(const Unit&) const {}
    __device__ __forceinline__ void done(const Unit&) const {}
};

template <class Epi, class Sched, bool ALIGN_EPI = false, bool SP2 = false>
__device__ __forceinline__ void gemm_phase(PG8_LAS unsigned char* lds, const Gemm g, const Sched& S, const Epi& E) {
    const int tid = PG8_TID(), wid = __builtin_amdgcn_readfirstlane(tid >> 6), lane = tid & 63, wr = wid >> 2, wc = wid & 3, fr = lane & 15, fq = lane >> 4;
    const int K = g.K, nt = K / BK;
    unsigned voffA[2], voffB[2];
#pragma unroll
    for (int i = 0; i < 2; ++i) { int R, C; stage_rc(tid * 16 + i * 8192, R, C); const int Rb = Epi::PERM ? ((R & ~31) + perm32(R & 31)) : R;
        voffA[i] = (unsigned)(R * K + C) * 2u; voffB[i] = (unsigned)(Rb * K + C) * 2u; }
    const size_t kstep = (size_t)(BK * 2);
    const size_t hstep = (size_t)HALF * K * 2;
    const size_t tstep = 2 * hstep;
    const unsigned ldsw = (unsigned)wid * 1024u;
    const int aoff = lds_byte(wr * 64 + fr, fq * 8), boff = lds_byte(wc * 32 + fr, fq * 8);
#define PG8_SA(b, h) (((b) * 2 + (h)) * HTB)
#define PG8_SB(b, h) ((4 + (b) * 2 + (h)) * HTB)
#define PG8_STAGE(bufoff, gbase, voff) do { _Pragma("unroll") for (int _i = 0; _i < 2; ++_i) \
        __builtin_amdgcn_global_load_lds((const unsigned*)((const char*)(gbase) + (voff)[_i]), (PG8_LAS unsigned*)(lds + (bufoff) + ldsw + _i * 8192), 16, 0, 0); } while (0)
#define PG8_LDA(dst, b, h) do { _Pragma("unroll") for (int m = 0; m < 4; ++m) _Pragma("unroll") for (int k = 0; k < 2; ++k) dst[m][k] = *(const PG8_LAS bf16x8*)(lds + PG8_SA(b, h) + aoff + m * 2048 + k * 1024); } while (0)
#define PG8_LDB(dst, b, h) do { _Pragma("unroll") for (int n = 0; n < 2; ++n) _Pragma("unroll") for (int k = 0; k < 2; ++k) dst[n][k] = *(const PG8_LAS bf16x8*)(lds + PG8_SB(b, h) + boff + n * 2048 + k * 1024); } while (0)
#define PG8_MMA(ai, bj, At, Bt) do { __builtin_amdgcn_s_setprio(1); _Pragma("unroll") for (int m = 0; m < 4; ++m) _Pragma("unroll") for (int n = 0; n < 2; ++n) _Pragma("unroll") for (int k = 0; k < 2; ++k) \
        acc[ai][bj][m][n] = __builtin_amdgcn_mfma_f32_16x16x32_bf16(Bt[n][k], At[m][k], acc[ai][bj][m][n], 0, 0, 0); __builtin_amdgcn_s_setprio(0); } while (0)
#define PG8_WAIT_V(n) asm volatile("s_waitcnt vmcnt(" #n ")" ::: "memory")
#define PG8_WAIT_L(n) asm volatile("s_waitcnt lgkmcnt(" #n ")" ::: "memory")
#define PG8_BAR __builtin_amdgcn_s_barrier()
#define PG8_SCHED __builtin_amdgcn_sched_barrier(0)
    Unit cur, nxt; int ui = 0;
    if (!S.next(0, cur)) return;
    f32x4 acc[2][2][4][2];
#pragma unroll
    for (int a = 0; a < 2; ++a)
#pragma unroll
        for (int b = 0; b < 2; ++b)
#pragma unroll
            for (int m = 0; m < 4; ++m)
#pragma unroll
                for (int n = 0; n < 2; ++n) acc[a][b][m][n] = (f32x4){0.f, 0.f, 0.f, 0.f};
    bf16x8 At[4][2], B0[2][2], B1[2][2];
    const char* cA = (const char*)g.A + (size_t)cur.pm * tstep; const char* cB = (const char*)g.Bt + (size_t)cur.pn * tstep;
    S.a_ready(cur);
    if constexpr (SP2) {
        PG8_STAGE(PG8_SB(0, 0), cB, voffB); PG8_STAGE(PG8_SB(0, 1), cB + hstep, voffB); PG8_STAGE(PG8_SA(0, 0), cA, voffA); PG8_STAGE(PG8_SA(0, 1), cA + hstep, voffA);
        if (wr == 1) PG8_BAR;
        PG8_WAIT_V(2); PG8_BAR;
        PG8_STAGE(PG8_SB(1, 0), cB + kstep, voffB); PG8_STAGE(PG8_SA(1, 0), cA + kstep, voffA); PG8_STAGE(PG8_SB(1, 1), cB + hstep + kstep, voffB);
        PG8_WAIT_V(6); PG8_BAR;
    } else {
        PG8_STAGE(PG8_SB(0, 0), cB, voffB); PG8_STAGE(PG8_SA(0, 0), cA, voffA); PG8_STAGE(PG8_SB(0, 1), cB + hstep, voffB); PG8_STAGE(PG8_SA(0, 1), cA + hstep, voffA);
        if (wr == 1) PG8_BAR;
        PG8_WAIT_V(4); PG8_BAR;
        PG8_STAGE(PG8_SB(1, 0), cB + kstep, voffB); PG8_STAGE(PG8_SA(1, 0), cA + kstep, voffA); PG8_STAGE(PG8_SB(1, 1), cB + hstep + kstep, voffB);
        PG8_WAIT_V(6); PG8_BAR;
    }
    for (;;) {
        const bool has_next = S.next(ui + 1, nxt);
        const char* nA = has_next ? (const char*)g.A + (size_t)nxt.pm * tstep : cA; const char* nB = has_next ? (const char*)g.Bt + (size_t)nxt.pn * tstep : cB;
        for (int t = 0; t < nt; t += 2) {
            const bool last = (t == nt - 2);
            const char* a1 = cA + (size_t)(t + 1) * kstep;
            const char* a2 = last ? nA : cA + (size_t)(t + 2) * kstep; const char* b2 = last ? nB : cB + (size_t)(t + 2) * kstep;
            const char* a3 = a2 + kstep; const char* b3 = b2 + kstep;
            if (last && has_next) S.a_ready(nxt);
            if constexpr (SP2) {
            PG8_LDB(B0, 0, 0); PG8_LDB(B1, 0, 1); PG8_SCHED; PG8_LDA(At, 0, 0); PG8_STAGE(PG8_SA(1, 1), a1 + hstep, voffA);
            PG8_WAIT_V(8); PG8_WAIT_L(0); PG8_BAR; PG8_MMA(0, 0, At, B0); PG8_MMA(0, 1, At, B1); PG8_BAR; PG8_SCHED;
            PG8_LDA(At, 0, 1); PG8_STAGE(PG8_SB(0, 0), b2, voffB); PG8_STAGE(PG8_SB(0, 1), b2 + hstep, voffB); PG8_STAGE(PG8_SA(0, 0), a2, voffA);
            PG8_WAIT_V(8); PG8_WAIT_L(0); PG8_BAR; PG8_MMA(1, 0, At, B0); PG8_MMA(1, 1, At, B1); PG8_BAR; PG8_SCHED;
            PG8_LDB(B0, 1, 0); PG8_LDB(B1, 1, 1); PG8_SCHED; PG8_LDA(At, 1, 0); PG8_STAGE(PG8_SA(0, 1), a2 + hstep, voffA);
            PG8_WAIT_V(8); PG8_WAIT_L(0); PG8_BAR; PG8_MMA(0, 0, At, B0); PG8_MMA(0, 1, At, B1); PG8_BAR; PG8_SCHED;
            PG8_LDA(At, 1, 1); PG8_STAGE(PG8_SB(1, 0), b3, voffB); PG8_STAGE(PG8_SB(1, 1), b3 + hstep, voffB); PG8_STAGE(PG8_SA(1, 0), a3, voffA);
            PG8_WAIT_V(8); PG8_WAIT_L(0); PG8_BAR; PG8_MMA(1, 0, At, B0); PG8_MMA(1, 1, At, B1); PG8_BAR; PG8_SCHED;
            } else {
            PG8_LDB(B0, 0, 0); PG8_SCHED; PG8_LDA(At, 0, 0); PG8_STAGE(PG8_SA(1, 1), a1 + hstep, voffA);
            PG8_WAIT_L(8); PG8_BAR; PG8_WAIT_L(0); PG8_MMA(0, 0, At, B0); PG8_BAR; PG8_SCHED;
            PG8_LDB(B1, 0, 1); PG8_STAGE(PG8_SB(0, 0), b2, voffB);
            PG8_BAR; PG8_WAIT_L(0); PG8_MMA(0, 1, At, B1); PG8_BAR;
            PG8_LDA(At, 0, 1); PG8_STAGE(PG8_SA(0, 0), a2, voffA);
            PG8_BAR; PG8_WAIT_L(0); PG8_MMA(1, 0, At, B0); PG8_BAR; PG8_SCHED;
            PG8_STAGE(PG8_SB(0, 1), b2 + hstep, voffB);
            PG8_WAIT_V(6); PG8_BAR; PG8_MMA(1, 1, At, B1); PG8_BAR;
            PG8_LDB(B0, 1, 0); PG8_SCHED; PG8_LDA(At, 1, 0); PG8_STAGE(PG8_SA(0, 1), a2 + hstep, voffA);
            PG8_WAIT_L(8); PG8_BAR; PG8_WAIT_L(0); PG8_MMA(0, 0, At, B0); PG8_BAR; PG8_SCHED;
            PG8_LDB(B1, 1, 1); PG8_STAGE(PG8_SB(1, 0), b3, voffB);
            PG8_BAR; PG8_WAIT_L(0); PG8_MMA(0, 1, At, B1); PG8_BAR;
            PG8_LDA(At, 1, 1); PG8_STAGE(PG8_SA(1, 0), a3, voffA);
            PG8_BAR; PG8_WAIT_L(0); PG8_MMA(1, 0, At, B0); PG8_BAR; PG8_SCHED;
            PG8_STAGE(PG8_SB(1, 1), b3 + hstep, voffB);
            PG8_WAIT_V(6); PG8_BAR; PG8_MMA(1, 1, At, B1); PG8_BAR;
            }
        }
        if constexpr (ALIGN_EPI) { if (wr == 0) PG8_BAR; }
        if constexpr (!Epi::AFTER_DRAIN) { E(acc, cur, wr, wc, fr, fq); S.done(cur); }
        if (!has_next) break;
#pragma unroll
        for (int a = 0; a < 2; ++a)
#pragma unroll
            for (int b = 0; b < 2; ++b)
#pragma unroll
                for (int m = 0; m < 4; ++m)
#pragma unroll
                    for (int n = 0; n < 2; ++n) acc[a][b][m][n] = (f32x4){0.f, 0.f, 0.f, 0.f};
        cur = nxt; cA = nA; cB = nB; ++ui;
        if constexpr (ALIGN_EPI) { if (wr == 1) PG8_BAR; }
    }
    PG8_WAIT_V(0);
    if constexpr (!ALIGN_EPI) { if (wr == 0) PG8_BAR; }
    PG8_BAR;
    if constexpr (Epi::AFTER_DRAIN) { E.fused(acc, cur, wr, wc, fr, fq, lds, wid, lane); S.done(cur); }
#undef PG8_SA
#undef PG8_SB
#undef PG8_STAGE
#undef PG8_LDA
#undef PG8_LDB
#undef PG8_MMA
#undef PG8_WAIT_V
#undef PG8_WAIT_L
#undef PG8_BAR
#undef PG8_SCHED
}
}

#define WTAB_OFF 155392
extern __shared__ __attribute__((aligned(16))) unsigned char lds_raw[];
__device__ __forceinline__ int hw_slot() { return (int)(__builtin_amdgcn_s_getreg((5 << 11) | 4) & 63u); }
__device__ __forceinline__ void otid_init() { const int t = threadIdx.x; if ((t & 63) == 0) ((__attribute__((address_space(3))) int*)(__attribute__((address_space(3))) void*)(lds_raw + WTAB_OFF))[hw_slot()] = t >> 6; }
__device__ __forceinline__ int otid() {
    const int w = __builtin_amdgcn_readfirstlane(((const __attribute__((address_space(3))) int*)(__attribute__((address_space(3))) void*)(lds_raw + WTAB_OFF))[hw_slot()]);
    int l; asm volatile("v_mbcnt_lo_u32_b32 %0, -1, 0\n\tv_mbcnt_hi_u32_b32 %0, -1, %0" : "=v"(l));
    return (w << 6) + l;
}
using pg8::bf16_t; using pg8::bf16x8; using pg8::f32x4; using pg8::u32x4;
#define LAS __attribute__((address_space(3)))

#define DMODEL 1024
#define NPT 16384
#define NST 32
#define NTOK 16416
#define MPAD 16640
#define SEQ 2048
#define ZW 2816
#define OFF_A 1536
#define OFF_B 1544
#define OFF_Z 1552
#define OFF_QA 2064
#define OFF_KVA 2448
#define OFF_KR 2704
#define DFF 2816
#define PAST 16384
#define NPAGES 128
#define EPSV 1e-6f

#define O_YP 0
#define O_YS (O_YP + 16777216)
#define O_CKVP (O_YS + 32768)
#define O_KRP (O_CKVP + 4194304)
#define O_GSP (O_KRP + 524288)
#define O_CSP (O_GSP + 262144)
#define O_CKVS (O_CSP + 36864)
#define O_KRS (O_CKVS + 8192)
#define O_GSS (O_KRS + 1024)
#define O_CSS (O_GSS + 1048576)

__device__ __forceinline__ bf16_t f2bf(float f) { unsigned u = __float_as_uint(f); return (bf16_t)((u + 0x7fffu + ((u >> 16) & 1u)) >> 16); }
__device__ __forceinline__ float bf2f(bf16_t b) { return __uint_as_float(((unsigned)b) << 16); }
template <int CTRL> __device__ __forceinline__ float dpp_mov(float x) { return __uint_as_float((unsigned)__builtin_amdgcn_update_dpp((int)__float_as_uint(x), (int)__float_as_uint(x), CTRL, 0xF, 0xF, true)); }
__device__ __forceinline__ float add_x16(float x) { auto r = __builtin_amdgcn_permlane16_swap(__float_as_uint(x), __float_as_uint(x), false, false); return __uint_as_float(r[0]) + __uint_as_float(r[1]); }
__device__ __forceinline__ float add_x32(float x) { auto r = __builtin_amdgcn_permlane32_swap(__float_as_uint(x), __float_as_uint(x), false, false); return __uint_as_float(r[0]) + __uint_as_float(r[1]); }
__device__ __forceinline__ float max_x32(float x) { auto r = __builtin_amdgcn_permlane32_swap(__float_as_uint(x), __float_as_uint(x), false, false); return fmaxf(__uint_as_float(r[0]), __uint_as_float(r[1])); }
__device__ __forceinline__ float sum8(float x) { x += dpp_mov<0xB1>(x); x += dpp_mov<0x4E>(x); x += dpp_mov<0x141>(x); return x; }
__device__ __forceinline__ float sum16(float x) { x = sum8(x); x += dpp_mov<0x140>(x); return x; }
__device__ __forceinline__ float max16(float x) { x = fmaxf(x, dpp_mov<0xB1>(x)); x = fmaxf(x, dpp_mov<0x4E>(x)); x = fmaxf(x, dpp_mov<0x141>(x)); x = fmaxf(x, dpp_mov<0x140>(x)); return x; }
__device__ __forceinline__ float wave_sum(float v) { return add_x32(add_x16(sum16(v))); }
__device__ __forceinline__ float sigmoidf_(float x) { return __builtin_amdgcn_rcpf(1.f + __builtin_amdgcn_exp2f(-1.44269504f * x)); }
__device__ __forceinline__ float siluf_(float x) { return x * __builtin_amdgcn_rcpf(1.f + __builtin_amdgcn_exp2f(-1.44269504f * x)); }


#define WSYNC() do { __builtin_amdgcn_fence(__ATOMIC_ACQ_REL, "wavefront"); __builtin_amdgcn_wave_barrier(); } while (0)
#define NTHR 512
#define NWAVE 8

typedef float f32x2_t __attribute__((ext_vector_type(2)));
typedef __bf16 bf16x2_t __attribute__((ext_vector_type(2)));
__device__ __forceinline__ unsigned cvtpk(float lo, float hi) { f32x2_t v = {lo, hi}; bf16x2_t r = __builtin_convertvector(v, bf16x2_t); return __builtin_bit_cast(unsigned, r); }
__device__ __forceinline__ void bf8_to_f32(const bf16x8& v, float* o) {
#pragma unroll
    for (int e = 0; e < 8; ++e) o[e] = __uint_as_float(((unsigned)(unsigned short)v[e]) << 16);
}
__device__ __forceinline__ bf16x8 f32_to_bf8(const float* x) {
    u32x4 w; w.x = cvtpk(x[0], x[1]); w.y = cvtpk(x[2], x[3]); w.z = cvtpk(x[4], x[5]); w.w = cvtpk(x[6], x[7]);
    return __builtin_bit_cast(bf16x8, w);
}
__device__ __forceinline__ unsigned pk2bf(float lo, float hi) { return (unsigned)f2bf(lo) | ((unsigned)f2bf(hi) << 16); }

__device__ __forceinline__ void wt_item(const float* __restrict__ W, int ldw, int col0, int nvalid, bf16_t* __restrict__ WT, int ldt, int nrow0, int k0, float* scr, int lane) {
    WSYNC();
#pragma unroll 8
    for (int i = 0; i < 32; ++i) { const int kk = 2 * i + (lane >> 5), n = lane & 31; scr[kk * 33 + n] = n < nvalid ? W[(size_t)(k0 + kk) * ldw + col0 + n] : 0.f; }
    WSYNC();
    const int c = lane & 7;
#pragma unroll
    for (int j = 0; j < 4; ++j) { const int n = (lane >> 3) + 8 * j; const float* sp = scr + (8 * c) * 33 + n;
        u32x4 o; o.x = cvtpk(sp[0], sp[33]); o.y = cvtpk(sp[2 * 33], sp[3 * 33]); o.z = cvtpk(sp[4 * 33], sp[5 * 33]); o.w = cvtpk(sp[6 * 33], sp[7 * 33]);
        *(u32x4*)(WT + (size_t)(nrow0 + n) * ldt + k0 + 8 * c) = o; }
}

__device__ __forceinline__ void rms1024_row(const float* __restrict__ src, const float* __restrict__ g, bf16_t* __restrict__ o, bool zero, int lane) {
    if (zero) { for (int j = 0; j < 4; ++j) { ushort4 z = {0, 0, 0, 0}; *(ushort4*)(o + lane * 4 + 256 * j) = z; } return; }
    float4 v[4]; float ss = 0.f;
#pragma unroll
    for (int j = 0; j < 4; ++j) { v[j] = *(const float4*)(src + lane * 4 + 256 * j); ss += v[j].x * v[j].x + v[j].y * v[j].y + v[j].z * v[j].z + v[j].w * v[j].w; }
    ss = wave_sum(ss);
    const float rs = rsqrtf(ss * (1.f / 1024.f) + EPSV);
#pragma unroll
    for (int j = 0; j < 4; ++j) {
        const float4 gg = *(const float4*)(g + lane * 4 + 256 * j);
        ushort4 w; w.x = f2bf(v[j].x * rs * gg.x); w.y = f2bf(v[j].y * rs * gg.y); w.z = f2bf(v[j].z * rs * gg.z); w.w = f2bf(v[j].w * rs * gg.w);
        *(ushort4*)(o + lane * 4 + 256 * j) = w;
    }
}

__device__ __forceinline__ void rms1024_row_b(const bf16_t* __restrict__ src, const float* __restrict__ g, bf16_t* __restrict__ o, bool zero, int lane) {
    if (zero) { for (int j = 0; j < 2; ++j) { const u32x4 z = {0u, 0u, 0u, 0u}; *(u32x4*)(o + lane * 8 + 512 * j) = z; } return; }
    float v[2][8]; float ss = 0.f;
#pragma unroll
    for (int j = 0; j < 2; ++j) { bf8_to_f32(*(const bf16x8*)(src + lane * 8 + 512 * j), v[j]);
#pragma unroll
        for (int e = 0; e < 8; ++e) ss += v[j][e] * v[j][e]; }
    ss = wave_sum(ss);
    const float rs = rsqrtf(ss * (1.f / 1024.f) + EPSV);
#pragma unroll
    for (int j = 0; j < 2; ++j) {
        const float4 g0 = *(const float4*)(g + lane * 8 + 512 * j), g1 = *(const float4*)(g + lane * 8 + 512 * j + 4);
        float t[8] = {v[j][0] * rs * g0.x, v[j][1] * rs * g0.y, v[j][2] * rs * g0.z, v[j][3] * rs * g0.w, v[j][4] * rs * g1.x, v[j][5] * rs * g1.y, v[j][6] * rs * g1.z, v[j][7] * rs * g1.w};
        *(bf16x8*)(o + lane * 8 + 512 * j) = f32_to_bf8(t);
    }
}

struct ABf16 { const bf16_t* p; int lda; __device__ __forceinline__ bf16x8 load(int m, int k) const { return *(const bf16x8*)(p + (size_t)m * lda + k); } };
template <bool SWIGLU, class Epi>
__device__ __forceinline__ void gemm_sample_rows(const bf16_t* __restrict__ A, int lda, const bf16_t* __restrict__ Bt, int K, int N, const Epi& epi, char*  , int bid, int nb, int first = -1) {
    const int tid = otid(), lane = tid & 63, wid = tid >> 6, i16 = lane & 15, q4 = lane >> 4;
    for (int u = first >= 0 ? (bid - first + nb) % nb : nb - 1 - bid; u < N / 256; u += nb) {
        const int n0 = u * 256;
        const int c0 = SWIGLU ? n0 + 16 * wid : n0 + 32 * wid, c1 = SWIGLU ? n0 + 128 + 16 * wid : n0 + 32 * wid + 16;
        const bf16_t* a0p = A + (size_t)(NPT + i16) * lda + 8 * q4; const bf16_t* a1p = a0p + (size_t)16 * lda;
        const bf16_t* b0p = Bt + (size_t)(c0 + i16) * K + 8 * q4; const bf16_t* b1p = Bt + (size_t)(c1 + i16) * K + 8 * q4;
        f32x4 acc[2][2];
#pragma unroll
        for (int i = 0; i < 2; ++i)
#pragma unroll
            for (int j = 0; j < 2; ++j) acc[i][j] = (f32x4){0.f, 0.f, 0.f, 0.f};
#pragma unroll 4
        for (int k0 = 0; k0 < K; k0 += 32) {
            const bf16x8 a0 = *(const bf16x8*)(a0p + k0), a1 = *(const bf16x8*)(a1p + k0), b0 = *(const bf16x8*)(b0p + k0), b1 = *(const bf16x8*)(b1p + k0);
            acc[0][0] = __builtin_amdgcn_mfma_f32_16x16x32_bf16(a0, b0, acc[0][0], 0, 0, 0); acc[0][1] = __builtin_amdgcn_mfma_f32_16x16x32_bf16(a0, b1, acc[0][1], 0, 0, 0);
            acc[1][0] = __builtin_amdgcn_mfma_f32_16x16x32_bf16(a1, b0, acc[1][0], 0, 0, 0); acc[1][1] = __builtin_amdgcn_mfma_f32_16x16x32_bf16(a1, b1, acc[1][1], 0, 0, 0);
        }
#pragma unroll
        for (int i = 0; i < 2; ++i)
#pragma unroll
            for (int r = 0; r < 4; ++r) {
                const int m = NPT + 16 * i + 4 * q4 + r;
                if constexpr (SWIGLU) epi(m, (n0 >> 1) + 16 * wid + i16, siluf_(acc[i][0][r]) * acc[i][1][r]);
                else { epi(m, c0 + i16, acc[i][0][r]); epi(m, c1 + i16, acc[i][1][r]); }
            }
    }
}
template <bool SWIGLU, class Epi, int NJ = 4>
__device__ __forceinline__ void gemm_sample_rows_ks(const bf16_t* __restrict__ A, int lda, const bf16_t* __restrict__ Bt, int K, int N, const Epi& epi, char* smem, int bid, int nb) {
    const int tid = otid(), lane = tid & 63, wid = tid >> 6, i16 = lane & 15, q4 = lane >> 4;
    static_assert(!SWIGLU || NJ == 4, "swiglu units are 64 rows wide");
    const int nunits = N / (16 * NJ), ksl = K >> 3;
    f32x4* red = (f32x4*)smem;
    for (int u = nb - 1 - bid; u < nunits; u += nb) {
        int brow[NJ];
#pragma unroll
        for (int j = 0; j < NJ; ++j) brow[j] = SWIGLU ? ((32 * u) >> 7) * 256 + ((32 * u) & 127) + 128 * (j >> 1) + 16 * (j & 1) + i16 : 16 * NJ * u + 16 * j + i16;
        const bf16_t* a0p = A + (size_t)(NPT + i16) * lda + wid * ksl + 8 * q4; const bf16_t* a1p = a0p + (size_t)16 * lda;
        f32x4 acc[2][NJ];
#pragma unroll
        for (int i = 0; i < 2; ++i)
#pragma unroll
            for (int j = 0; j < NJ; ++j) acc[i][j] = (f32x4){0.f, 0.f, 0.f, 0.f};
        for (int k0 = 0; k0 < ksl; k0 += 32) {
            const bf16x8 a0 = *(const bf16x8*)(a0p + k0), a1 = *(const bf16x8*)(a1p + k0);
            bf16x8 b[NJ];
#pragma unroll
            for (int j = 0; j < NJ; ++j) b[j] = *(const bf16x8*)(Bt + (size_t)brow[j] * K + wid * ksl + 8 * q4 + k0);
#pragma unroll
            for (int j = 0; j < NJ; ++j) { acc[0][j] = __builtin_amdgcn_mfma_f32_16x16x32_bf16(a0, b[j], acc[0][j], 0, 0, 0); acc[1][j] = __builtin_amdgcn_mfma_f32_16x16x32_bf16(a1, b[j], acc[1][j], 0, 0, 0); }
        }
        __syncthreads();
#pragma unroll
        for (int i = 0; i < 2; ++i)
#pragma unroll
            for (int j = 0; j < NJ; ++j) red[(wid * 2 * NJ + i * NJ + j) * 64 + lane] = acc[i][j];
        __syncthreads();
        if constexpr (SWIGLU) {
            if (tid < 256) {
                const int t4 = tid >> 6, i = t4 >> 1, jg = t4 & 1, l = tid & 63;
                f32x4 g = red[(i * 4 + jg) * 64 + l], up = red[(i * 4 + jg + 2) * 64 + l];
#pragma unroll
                for (int w = 1; w < 8; ++w) { g = g + red[(w * 8 + i * 4 + jg) * 64 + l]; up = up + red[(w * 8 + i * 4 + jg + 2) * 64 + l]; }
#pragma unroll
                for (int r = 0; r < 4; ++r) epi(NPT + 16 * i + 4 * (l >> 4) + r, 32 * u + 16 * jg + (l & 15), siluf_(g[r]) * up[r]);
            }
        } else {
            const int t8 = tid >> 6, l = tid & 63, i = t8 / NJ, j = t8 % NJ;
            if (t8 < 2 * NJ) {
                f32x4 v = red[t8 * 64 + l];
#pragma unroll
                for (int w = 1; w < 8; ++w) v = v + red[(w * 2 * NJ + t8) * 64 + l];
#pragma unroll
                for (int r = 0; r < 4; ++r) epi(NPT + 16 * i + 4 * (l >> 4) + r, 16 * NJ * u + 16 * j + (l & 15), v[r]);
            }
        }
    }
    __syncthreads();
}
struct EwF32 { float* C; int ldc; __device__ __forceinline__ void operator()(int m, int n, float v) const { C[(size_t)m * ldc + n] = v; } };
struct EwBf16 { bf16_t* C; int ldc; __device__ __forceinline__ void operator()(int m, int n, float v) const { C[(size_t)m * ldc + n] = f2bf(v); } };
struct EwResX { const float* xs; bf16_t* C; __device__ __forceinline__ void operator()(int m, int n, float v) const { C[(size_t)m * 1024 + n] = f2bf(xs[(size_t)(m - NPT) * 1024 + n] + v); } };
struct EwResH { const bf16_t* H; bf16_t* C; __device__ __forceinline__ void operator()(int m, int n, float v) const { C[(size_t)m * 1024 + n] = f2bf(bf2f(H[(size_t)m * 1024 + n]) + v); } };
struct EwPle { const bf16_t* H2; const bf16_t* PP; float* out;
    __device__ __forceinline__ void operator()(int m, int n, float v) const { out[O_YS + (size_t)(m - NPT) * 1024 + n] = bf2f(H2[(size_t)m * 1024 + n]) + bf2f(PP[(size_t)m * 1024 + n]) * sigmoidf_(v); } };

struct PgBf16 {
    static constexpr bool PERM = true, AFTER_DRAIN = false; bf16_t* O; int ldc;
    __device__ __forceinline__ void operator()(const f32x4 (&acc)[2][2][4][2], const pg8::Unit& u, int wr, int wc, int fr, int fq) const {
#pragma unroll
        for (int ai = 0; ai < 2; ++ai)
#pragma unroll
            for (int m = 0; m < 4; ++m) { bf16_t* rowp = O + (size_t)(u.pm * 256 + ai * 128 + wr * 64 + m * 16 + fr) * ldc + u.pn * 256 + wc * 32 + 8 * fq;
#pragma unroll
                for (int bj = 0; bj < 2; ++bj) { const f32x4 v0 = acc[ai][bj][m][0], v1 = acc[ai][bj][m][1]; u32x4 w; w.x = pk2bf(v0[0], v0[1]); w.y = pk2bf(v0[2], v0[3]); w.z = pk2bf(v1[0], v1[1]); w.w = pk2bf(v1[2], v1[3]); *(u32x4*)(rowp + bj * 128) = w; } }
    }
};
struct PgF32 {
    static constexpr bool PERM = false, AFTER_DRAIN = false; float* O; int ldc;
    __device__ __forceinline__ void operator()(const f32x4 (&acc)[2][2][4][2], const pg8::Unit& u, int wr, int wc, int fr, int fq) const {
#pragma unroll
        for (int ai = 0; ai < 2; ++ai)
#pragma unroll
            for (int m = 0; m < 4; ++m) { float* rowp = O + (size_t)(u.pm * 256 + ai * 128 + wr * 64 + m * 16 + fr) * ldc + u.pn * 256 + wc * 32 + 4 * fq;
#pragma unroll
                for (int bj = 0; bj < 2; ++bj)
#pragma unroll
                    for (int n = 0; n < 2; ++n) *(f32x4*)(rowp + bj * 128 + n * 16) = acc[ai][bj][m][n]; }
    }
};
struct PgSwiglu {
    static constexpr bool PERM = true, AFTER_DRAIN = false; bf16_t* Hd;
    __device__ __forceinline__ void operator()(const f32x4 (&acc)[2][2][4][2], const pg8::Unit& u, int wr, int wc, int fr, int fq) const {
#pragma unroll
        for (int ai = 0; ai < 2; ++ai)
#pragma unroll
            for (int m = 0; m < 4; ++m) { bf16_t* rowp = Hd + (size_t)(u.pm * 256 + ai * 128 + wr * 64 + m * 16 + fr) * DFF + u.pn * 128 + wc * 32 + 8 * fq;
                float h[8];
#pragma unroll
                for (int n = 0; n < 2; ++n)
#pragma unroll
                    for (int i = 0; i < 4; ++i) h[n * 4 + i] = siluf_(acc[ai][0][m][n][i]) * acc[ai][1][m][n][i];
                u32x4 w; w.x = pk2bf(h[0], h[1]); w.y = pk2bf(h[2], h[3]); w.z = pk2bf(h[4], h[5]); w.w = pk2bf(h[6], h[7]); *(u32x4*)rowp = w; }
    }
};
struct PgResXB {
    static constexpr bool PERM = true, AFTER_DRAIN = false; const float* R; bf16_t* O;
    __device__ __forceinline__ void operator()(const f32x4 (&acc)[2][2][4][2], const pg8::Unit& u, int wr, int wc, int fr, int fq) const {
#pragma unroll
        for (int ai = 0; ai < 2; ++ai)
#pragma unroll
            for (int m = 0; m < 4; ++m) { const size_t off = (size_t)(u.pm * 256 + ai * 128 + wr * 64 + m * 16 + fr) * 1024 + u.pn * 256 + wc * 32 + 8 * fq;
#pragma unroll
                for (int bj = 0; bj < 2; ++bj) { const f32x4 r0 = *(const f32x4*)(R + off + bj * 128), r1 = *(const f32x4*)(R + off + bj * 128 + 4), v0 = r0 + acc[ai][bj][m][0], v1 = r1 + acc[ai][bj][m][1];
                    u32x4 w; w.x = cvtpk(v0[0], v0[1]); w.y = cvtpk(v0[2], v0[3]); w.z = cvtpk(v1[0], v1[1]); w.w = cvtpk(v1[2], v1[3]); *(u32x4*)(O + off + bj * 128) = w; } }
    }
};
struct PgResBB {
    static constexpr bool PERM = true, AFTER_DRAIN = false; const bf16_t* R; bf16_t* O;
    __device__ __forceinline__ void operator()(const f32x4 (&acc)[2][2][4][2], const pg8::Unit& u, int wr, int wc, int fr, int fq) const {
#pragma unroll
        for (int ai = 0; ai < 2; ++ai)
#pragma unroll
            for (int m = 0; m < 4; ++m) { const size_t off = (size_t)(u.pm * 256 + ai * 128 + wr * 64 + m * 16 + fr) * 1024 + u.pn * 256 + wc * 32 + 8 * fq;
#pragma unroll
                for (int bj = 0; bj < 2; ++bj) { float r[8]; bf8_to_f32(*(const bf16x8*)(R + off + bj * 128), r); const f32x4 a0 = acc[ai][bj][m][0], a1 = acc[ai][bj][m][1];
                    u32x4 w; w.x = cvtpk(r[0] + a0[0], r[1] + a0[1]); w.y = cvtpk(r[2] + a0[2], r[3] + a0[3]); w.z = cvtpk(r[4] + a1[0], r[5] + a1[1]); w.w = cvtpk(r[6] + a1[2], r[7] + a1[3]); *(u32x4*)(O + off + bj * 128) = w; } }
    }
};
struct PgPleB {
    static constexpr bool PERM = true, AFTER_DRAIN = false; const bf16_t* H2; const bf16_t* PP; float* out;
    __device__ __forceinline__ void operator()(const f32x4 (&acc)[2][2][4][2], const pg8::Unit& u, int wr, int wc, int fr, int fq) const {
#pragma unroll
        for (int ai = 0; ai < 2; ++ai)
#pragma unroll
            for (int m = 0; m < 4; ++m) { const size_t off = (size_t)(u.pm * 256 + ai * 128 + wr * 64 + m * 16 + fr) * 1024 + u.pn * 256 + wc * 32 + 8 * fq;
#pragma unroll
                for (int bj = 0; bj < 2; ++bj) { float h[8], pp[8]; bf8_to_f32(*(const bf16x8*)(H2 + off + bj * 128), h); bf8_to_f32(*(const bf16x8*)(PP + off + bj * 128), pp);
                    const f32x4 a0 = acc[ai][bj][m][0], a1 = acc[ai][bj][m][1]; f32x4 y0, y1;
#pragma unroll
                    for (int i = 0; i < 4; ++i) { y0[i] = h[i] + pp[i] * sigmoidf_(a0[i]); y1[i] = h[4 + i] + pp[4 + i] * sigmoidf_(a1[i]); }
                    *(f32x4*)(out + O_YP + off + bj * 128) = y0; *(f32x4*)(out + O_YP + off + bj * 128 + 4) = y1; } }
    }
};
template <class Epi>
__device__ __forceinline__ void pg_gemm(LAS unsigned char* lds, const bf16_t* A, const bf16_t* Bt, int M, int N, int K, const Epi& E, int glow = 0, int grot = 0) {
    pg8::Gemm g{A, Bt, M, N, K}; pg8::StaticOrder S;
    if (glow > 0) { if ((int)blockIdx.x >= glow) return; S.init(M, N, glow, ((int)blockIdx.x + grot) % glow); }
    else S.init(M, N, (int)gridDim.x, (int)blockIdx.x);
    pg8::gemm_phase<Epi, pg8::StaticOrder, true, true>(lds, g, S, E);
}

constexpr size_t WOF_WinT = 0ull;
constexpr size_t WOF_WqbT = 5767168ull;
constexpr size_t WOF_WkvT = 6356992ull;
constexpr size_t WOF_WknT = 6881280ull;
constexpr size_t WOF_WoT = 7143424ull;
constexpr size_t WOF_WguT = 9240576ull;
constexpr size_t WOF_WdT = 20774912ull;
constexpr size_t WOF_WpgT = 26542080ull;
constexpr size_t WOF_WppT = 28639232ull;
constexpr size_t WOF_xn = 29163520ull;
constexpr size_t WOF_pb = 63242240ull;
constexpr size_t WOF_Z = 71761920ull;
constexpr size_t WOF_qkv = 165478400ull;
constexpr size_t WOF_ropecs = 216596480ull;
constexpr size_t WOF_gg = 216858880ull;
constexpr size_t WOF_bb = 217391360ull;
constexpr size_t WOF_goraw = 217923840ull;
constexpr size_t WOF_gUT = 252002560ull;
constexpr size_t WOF_ggam = 285556992ull;
constexpr size_t WOF_gWn = 285565184ull;
constexpr size_t WOF_gQg = 302342400ull;
constexpr size_t WOF_gQK = 319119616ull;
constexpr size_t WOF_gKd = 335896832ull;
constexpr size_t WOF_qan = 352674048ull;
constexpr size_t WOF_ckvb = 365453568ull;
constexpr size_t WOF_krf = 373973248ull;
constexpr size_t WOF_Q = 376103168ull;
constexpr size_t WOF_qh = 427221248ull;
constexpr size_t WOF_KV = 478339328ull;
constexpr size_t WOF_kh = 546496768ull;
constexpr size_t WOF_omix = 580575488ull;
constexpr size_t WOF_KN = 614654208ull;
constexpr size_t WOF_SC = 1151525120ull;
constexpr size_t WOF_part = 1168302336ull;
constexpr size_t WOF_H = 1170432256ull;
constexpr size_t WOF_un = 1238589696ull;
constexpr size_t WOF_G = 1272668416ull;
constexpr size_t WOF_hid = 1273028864ull;
constexpr size_t WOF_H2 = 1366745344ull;
constexpr size_t WOF_un2 = 1434902784ull;
constexpr size_t WOF_PP = 1468981504ull;
constexpr size_t WOF_qraw = 1537138944ull;
constexpr size_t WOF_kvraw = 1562304768ull;
constexpr size_t WOF_krb = 1595859200ull;
constexpr size_t WOF_ctl = 1596907776ull;
constexpr size_t WS_TOTAL = 1596924160ull;
struct MK {
    const float *x_prompt, *x_sample, *cache_ckv, *cache_krope, *state_gdn, *state_conv; const int* page_table; const float *p_prompt, *p_sample;
    const float *g_attn, *w_in, *w_conv, *a_log, *dt_bias, *g_gdn_out, *g_q_a, *w_q_b, *g_q_nope, *g_q_rope, *g_kv_a, *g_k_rope, *w_kv_b, *g_k_nope, *w_o, *g_ffn, *w_gate, *w_up, *w_down, *g_ple, *w_ple_gate, *w_ple_proj;
    float* out; char* ws;
    __device__ __forceinline__ unsigned* ctl() const { return (unsigned*)(ws + WOF_ctl); }
    __device__ __forceinline__ bf16_t* WinT() const { return (bf16_t*)(ws + WOF_WinT); }
    __device__ __forceinline__ bf16_t* WqbT() const { return (bf16_t*)(ws + WOF_WqbT); }
    __device__ __forceinline__ bf16_t* WkvT() const { return (bf16_t*)(ws + WOF_WkvT); }
    __device__ __forceinline__ bf16_t* WknT() const { return (bf16_t*)(ws + WOF_WknT); }
    __device__ __forceinline__ bf16_t* WoT() const { return (bf16_t*)(ws + WOF_WoT); }
    __device__ __forceinline__ bf16_t* WguT() const { return (bf16_t*)(ws + WOF_WguT); }
    __device__ __forceinline__ bf16_t* WdT() const { return (bf16_t*)(ws + WOF_WdT); }
    __device__ __forceinline__ bf16_t* WpgT() const { return (bf16_t*)(ws + WOF_WpgT); }
    __device__ __forceinline__ bf16_t* WppT() const { return (bf16_t*)(ws + WOF_WppT); }
    __device__ __forceinline__ bf16_t* xn() const { return (bf16_t*)(ws + WOF_xn); }
    __device__ __forceinline__ bf16_t* pb() const { return (bf16_t*)(ws + WOF_pb); }
    __device__ __forceinline__ bf16_t* Z() const { return (bf16_t*)(ws + WOF_Z); }
    __device__ __forceinline__ bf16_t* qkv() const { return (bf16_t*)(ws + WOF_qkv); }
    __device__ __forceinline__ float* ropecs() const { return (float*)(ws + WOF_ropecs); }
    __device__ __forceinline__ float* gg() const { return (float*)(ws + WOF_gg); }
    __device__ __forceinline__ float* bb() const { return (float*)(ws + WOF_bb); }
    __device__ __forceinline__ float* goraw() const { return (float*)(ws + WOF_goraw); }
    __device__ __forceinline__ float* gUT() const { return (float*)(ws + WOF_gUT); }
    __device__ __forceinline__ float* ggam() const { return (float*)(ws + WOF_ggam); }
    __device__ __forceinline__ bf16_t* gWn() const { return (bf16_t*)(ws + WOF_gWn); }
    __device__ __forceinline__ bf16_t* gQg() const { return (bf16_t*)(ws + WOF_gQg); }
    __device__ __forceinline__ bf16_t* gQK() const { return (bf16_t*)(ws + WOF_gQK); }
    __device__ __forceinline__ bf16_t* gKd() const { return (bf16_t*)(ws + WOF_gKd); }
    __device__ __forceinline__ bf16_t* qan() const { return (bf16_t*)(ws + WOF_qan); }
    __device__ __forceinline__ bf16_t* ckvb() const { return (bf16_t*)(ws + WOF_ckvb); }
    __device__ __forceinline__ float* krf() const { return (float*)(ws + WOF_krf); }
    __device__ __forceinline__ float* Q() const { return (float*)(ws + WOF_Q); }
    __device__ __forceinline__ float* qh() const { return (float*)(ws + WOF_qh); }
    __device__ __forceinline__ float* KV() const { return (float*)(ws + WOF_KV); }
    __device__ __forceinline__ float* kh() const { return (float*)(ws + WOF_kh); }
    __device__ __forceinline__ bf16_t* omix() const { return (bf16_t*)(ws + WOF_omix); }
    __device__ __forceinline__ bf16_t* KN() const { return (bf16_t*)(ws + WOF_KN); }
    __device__ __forceinline__ float* SC() const { return (float*)(ws + WOF_SC); }
    __device__ __forceinline__ float* part() const { return (float*)(ws + WOF_part); }
    __device__ __forceinline__ bf16_t* H() const { return (bf16_t*)(ws + WOF_H); }
    __device__ __forceinline__ bf16_t* un() const { return (bf16_t*)(ws + WOF_un); }
    __device__ __forceinline__ float* G() const { return (float*)(ws + WOF_G); }
    __device__ __forceinline__ bf16_t* hid() const { return (bf16_t*)(ws + WOF_hid); }
    __device__ __forceinline__ bf16_t* H2() const { return (bf16_t*)(ws + WOF_H2); }
    __device__ __forceinline__ bf16_t* un2() const { return (bf16_t*)(ws + WOF_un2); }
    __device__ __forceinline__ bf16_t* PP() const { return (bf16_t*)(ws + WOF_PP); }
    __device__ __forceinline__ bf16_t* qraw() const { return (bf16_t*)(ws + WOF_qraw); }
    __device__ __forceinline__ bf16_t* kvraw() const { return (bf16_t*)(ws + WOF_kvraw); }
    __device__ __forceinline__ bf16_t* krb() const { return (bf16_t*)(ws + WOF_krb); }
};

__device__ __forceinline__ float fast_sigmoid(float x) { return __builtin_amdgcn_rcpf(1.f + __builtin_amdgcn_exp2f(-1.44269504f * x)); }
struct PinTok { bf16x8 qa, cv, kr; float ab; };
struct PinGain { float gqa[8], gkv[8], gkr[8], dtb, alog; };
__device__ __forceinline__ PinTok pin_load(const MK& a, int row, int lane) {
    const bf16_t* z = a.Z() + (size_t)row * ZW; PinTok t; const bf16x8 zz = {0, 0, 0, 0, 0, 0, 0, 0};
    t.qa = lane < 48 ? *(const bf16x8*)(z + OFF_QA + 8 * lane) : zz; t.cv = lane < 32 ? *(const bf16x8*)(z + OFF_KVA + 8 * lane) : zz;
    t.kr = (lane >= 32 && lane < 36) ? *(const bf16x8*)(z + OFF_KR + 8 * (lane - 32)) : zz; t.ab = lane < 16 ? bf2f(z[OFF_A + lane]) : 0.f; return t;
}
__device__ __forceinline__ void post_in_token(const MK& a, int row, int lane, const float* wcs, const bf16x8 (&w0)[3], const bf16x8 (&w1)[3], const bf16x8 (&w2)[3], const bf16x8 (&wcur)[3], const PinTok& tk, const PinGain& gn) {
    const bool samp = row >= NPT;
    const int b = samp ? row - NPT : row >> 11, t = samp ? 0 : row & 2047, hd = lane >> 3;
    float y[24];
#pragma unroll
    for (int c3 = 0; c3 < 3; ++c3) {
        float p0[8], p1[8], p2[8], cu[8];
        bf8_to_f32(w0[c3], p0); bf8_to_f32(w1[c3], p1); bf8_to_f32(w2[c3], p2); bf8_to_f32(wcur[c3], cu);
        const float* wp = wcs + 512 * c3 + 8 * lane;
        const float4 a0 = *(const float4*)wp, a1 = *(const float4*)(wp + 4), b0 = *(const float4*)(wp + 1536), b1 = *(const float4*)(wp + 1540);
        const float4 c0 = *(const float4*)(wp + 3072), c1 = *(const float4*)(wp + 3076), d0 = *(const float4*)(wp + 4608), d1 = *(const float4*)(wp + 4612);
        const float k0[8] = {a0.x, a0.y, a0.z, a0.w, a1.x, a1.y, a1.z, a1.w}, k1[8] = {b0.x, b0.y, b0.z, b0.w, b1.x, b1.y, b1.z, b1.w};
        const float k2[8] = {c0.x, c0.y, c0.z, c0.w, c1.x, c1.y, c1.z, c1.w}, k3[8] = {d0.x, d0.y, d0.z, d0.w, d1.x, d1.y, d1.z, d1.w};
#pragma unroll
        for (int e = 0; e < 8; ++e) { const int c = 8 * c3 + e; const float v = k0[e] * p0[e] + k1[e] * p1[e] + k2[e] * p2[e] + k3[e] * cu[e]; y[c] = v * fast_sigmoid(v); }
        __builtin_amdgcn_sched_barrier(0);
    }
    float sq = 0.f, sk = 0.f;
#pragma unroll
    for (int e = 0; e < 8; ++e) { sq += y[e] * y[e]; sk += y[8 + e] * y[8 + e]; }
    sq = sum8(sq); sk = sum8(sk);
    const float rq = rsqrtf(sq + EPSV) * 0.125f, rk = rsqrtf(sk + EPSV);
#pragma unroll
    for (int e = 0; e < 8; ++e) { y[e] *= rq; y[8 + e] *= rk; }
    bf16_t* qo = a.qkv() + (size_t)row * 1536 + 8 * lane;
    *(bf16x8*)qo = f32_to_bf8(y); *(bf16x8*)(qo + 512) = f32_to_bf8(y + 8); *(bf16x8*)(qo + 1024) = f32_to_bf8(y + 16);
    if (!samp && t >= SEQ - 3) {
        float* cso = a.out + O_CSP + ((size_t)b * 3 + (t - (SEQ - 3))) * 1536 + 8 * lane;
#pragma unroll
        for (int j = 0; j < 3; ++j) { float cu[8]; bf8_to_f32(wcur[j], cu); *(float4*)(cso + 512 * j) = (float4){cu[0], cu[1], cu[2], cu[3]}; *(float4*)(cso + 512 * j + 4) = (float4){cu[4], cu[5], cu[6], cu[7]}; }
    }
    if (lane < 16) {
        const float v = tk.ab;
        if (lane < 8) { const float xx = v + gn.dtb; const float sp = xx > 20.f ? xx : 0.69314718f * __builtin_amdgcn_logf(1.f + __builtin_amdgcn_exp2f(1.44269504f * xx)); a.gg()[(size_t)row * 8 + lane] = -gn.alog * sp; }
        else a.bb()[(size_t)row * 8 + lane - 8] = sigmoidf_(v);
    }
    __builtin_amdgcn_sched_barrier(0);
    float qa[8], cv[8], kr[8];
    bf8_to_f32(tk.qa, qa); bf8_to_f32(tk.cv, cv); bf8_to_f32(tk.kr, kr);
    float s1 = 0.f, s2 = 0.f, s3 = 0.f;
#pragma unroll
    for (int e = 0; e < 8; ++e) { s1 += qa[e] * qa[e]; s2 += cv[e] * cv[e]; s3 += kr[e] * kr[e]; }
    s1 = wave_sum(s1); s2 = wave_sum(s2); s3 = wave_sum(s3);
    const float r1 = rsqrtf(s1 * (1.f / 384.f) + EPSV), r2 = rsqrtf(s2 * (1.f / 256.f) + EPSV), r3 = rsqrtf(s3 * (1.f / 32.f) + EPSV);
    if (lane < 48) {
        float o[8];
#pragma unroll
        for (int e = 0; e < 8; ++e) o[e] = qa[e] * r1 * gn.gqa[e];
        *(bf16x8*)(a.qan() + (size_t)row * 384 + 8 * lane) = f32_to_bf8(o);
    }
    if (lane < 32) {
        float o[8];
#pragma unroll
        for (int e = 0; e < 8; ++e) o[e] = cv[e] * r2 * gn.gkv[e];
        *(bf16x8*)(a.ckvb() + (size_t)row * 256 + 8 * lane) = f32_to_bf8(o);
        float* co = samp ? a.out + O_CKVS + (size_t)b * 256 + 8 * lane : a.out + O_CKVP + (size_t)row * 256 + 8 * lane;
        *(float4*)co = (float4){o[0], o[1], o[2], o[3]}; *(float4*)(co + 4) = (float4){o[4], o[5], o[6], o[7]};
    }
    __builtin_amdgcn_sched_barrier(0);
    {
        const int c4 = (lane - 32) & 3;
        float xn[8], ot[8];
#pragma unroll
        for (int e = 0; e < 8; ++e) xn[e] = kr[e] * r3 * gn.gkr[e];
#pragma unroll
        for (int e = 0; e < 8; ++e) ot[e] = dpp_mov<0x4E>(xn[e]);
        if (lane >= 32 && lane < 36) {
            const float* tb = a.ropecs() + (size_t)(samp ? 2048 : t) * 32 + ((8 * c4) & 15);
            const float4 c0 = *(const float4*)tb, c1 = *(const float4*)(tb + 4), s0 = *(const float4*)(tb + 16), s1 = *(const float4*)(tb + 20);
            const float csv[8] = {c0.x, c0.y, c0.z, c0.w, c1.x, c1.y, c1.z, c1.w}, snv[8] = {s0.x, s0.y, s0.z, s0.w, s1.x, s1.y, s1.z, s1.w};
            float o[8];
#pragma unroll
            for (int e = 0; e < 8; ++e) o[e] = c4 < 2 ? xn[e] * csv[e] - ot[e] * snv[e] : ot[e] * snv[e] + xn[e] * csv[e];
            float* kf_ = a.krf() + (size_t)row * 32 + 8 * c4; *(float4*)kf_ = (float4){o[0], o[1], o[2], o[3]}; *(float4*)(kf_ + 4) = (float4){o[4], o[5], o[6], o[7]};
            float* ko = samp ? a.out + O_KRS + (size_t)b * 32 + 8 * c4 : a.out + O_KRP + (size_t)row * 32 + 8 * c4;
            *(float4*)ko = (float4){o[0], o[1], o[2], o[3]}; *(float4*)(ko + 4) = (float4){o[4], o[5], o[6], o[7]};
            if (!samp) *(bf16x8*)(a.krb() + (size_t)row * 32 + 8 * c4) = f32_to_bf8(o);
        }
    }
    (void)hd;
}
__device__ __forceinline__ void post_in_run(const MK& a, int run, int lane_in, const float* wcs) {
    int lane = lane_in; asm volatile("" : "+v"(lane));
    PinGain gn;
    {
        const int lq = lane < 48 ? lane : 0, lk = lane < 32 ? lane : 0, c4 = (lane - 32) & 3;
#pragma unroll
        for (int e = 0; e < 8; ++e) { gn.gqa[e] = a.g_q_a[8 * lq + e]; gn.gkv[e] = a.g_kv_a[8 * lk + e]; gn.gkr[e] = a.g_k_rope[8 * c4 + e]; }
        gn.dtb = a.dt_bias[lane & 7]; gn.alog = expf(a.a_log[lane & 7]);
    }
    if (run < NPT / 8) {
        const int row0 = run * 8, t0 = row0 & 2047;
        bf16x8 w0[3], w1[3], w2[3], wcur[3];
#pragma unroll
        for (int c3 = 0; c3 < 3; ++c3) {
            const bf16x8 zz = {0, 0, 0, 0, 0, 0, 0, 0}; w0[c3] = zz; w1[c3] = zz; w2[c3] = zz;
            if (t0 > 0) { const bf16_t* zp = a.Z() + (size_t)(row0 - 3) * ZW + 512 * c3 + 8 * lane; w0[c3] = *(const bf16x8*)zp; w1[c3] = *(const bf16x8*)(zp + ZW); w2[c3] = *(const bf16x8*)(zp + 2 * ZW); }
        }
        bf16x8 wnext[3]; PinTok tk, tkn;
#pragma unroll
        for (int c3 = 0; c3 < 3; ++c3) wnext[c3] = *(const bf16x8*)(a.Z() + (size_t)row0 * ZW + 512 * c3 + 8 * lane);
        tkn = pin_load(a, row0, lane);
#pragma unroll 1
        for (int k = 0; k < 8; ++k) {
            const int row = row0 + k;
#pragma unroll
            for (int c3 = 0; c3 < 3; ++c3) wcur[c3] = wnext[c3];
            tk = tkn;
            if (k < 7) {
#pragma unroll
                for (int c3 = 0; c3 < 3; ++c3) wnext[c3] = *(const bf16x8*)(a.Z() + (size_t)(row + 1) * ZW + 512 * c3 + 8 * lane);
                tkn = pin_load(a, row + 1, lane);
            }
            post_in_token(a, row, lane, wcs, w0, w1, w2, wcur, tk, gn);
#pragma unroll
            for (int c3 = 0; c3 < 3; ++c3) { w0[c3] = w1[c3]; w1[c3] = w2[c3]; w2[c3] = wcur[c3]; }
        }
    } else {
        {
            const int bsm = run - NPT / 8, row = NPT + bsm;
            bf16x8 w0[3], w1[3], w2[3], wcur[3];
#pragma unroll
            for (int c3 = 0; c3 < 3; ++c3) {
                const float* sp = a.state_conv + (size_t)bsm * 3 * 1536 + 512 * c3 + 8 * lane;
                float* cso = a.out + O_CSS + (size_t)bsm * 3 * 1536 + 512 * c3 + 8 * lane;
                float t0_[8], t1_[8], t2_[8], tc_[8];
#pragma unroll
                for (int e = 0; e < 8; ++e) { t0_[e] = sp[e]; t1_[e] = sp[1536 + e]; t2_[e] = sp[2 * 1536 + e]; }
                wcur[c3] = *(const bf16x8*)(a.Z() + (size_t)row * ZW + 512 * c3 + 8 * lane); bf8_to_f32(wcur[c3], tc_);
#pragma unroll
                for (int e = 0; e < 8; ++e) { cso[e] = t1_[e]; cso[1536 + e] = t2_[e]; cso[2 * 1536 + e] = tc_[e]; }
                w0[c3] = f32_to_bf8(t0_); w1[c3] = f32_to_bf8(t1_); w2[c3] = f32_to_bf8(t2_);
            }
            post_in_token(a, row, lane, wcs, w0, w1, w2, wcur, pin_load(a, row, lane), gn);
        }
    }
}

__device__ __forceinline__ void post_q_item(const MK& a, int idx, int lane) {
    const int row = idx >> 3, h = idx & 7;
    const float* q = a.Q() + (size_t)row * 768 + h * 96;
    float* o = a.qh() + ((size_t)row * 8 + h) * 96;
    const float v = q[lane];
    const float ss = wave_sum(v * v);
    o[lane] = v * rsqrtf(ss * (1.f / 64.f) + EPSV) * a.g_q_nope[lane];
    const float r = lane < 32 ? q[64 + lane] : 0.f;
    const float s2 = wave_sum(r * r);
    const float xn = lane < 32 ? r * rsqrtf(s2 * (1.f / 32.f) + EPSV) * a.g_q_rope[lane] : 0.f;
    const float other = __shfl_xor(xn, 16);
    const int i = lane & 15;
    const float* tb = a.ropecs() + (size_t)(row >= NPT ? 2048 : (row & 2047)) * 32;
    const float cs = tb[i], sn = tb[16 + i];
    const float ov = lane < 16 ? xn * cs - other * sn : other * sn + xn * cs;
    if (lane < 32) o[64 + lane] = ov;
}
__device__ __forceinline__ void post_kv_item(const MK& a, int idx, int lane) {
    const int row = idx >> 3, h = idx & 7;
    const float v = a.KV()[(size_t)row * 1024 + h * 128 + lane];
    const float ss = wave_sum(v * v);
    const float kn = v * rsqrtf(ss * (1.f / 64.f) + EPSV) * a.g_k_nope[lane];
    a.kh()[((size_t)row * 8 + h) * 64 + lane] = kn;
}

typedef float f32x16 __attribute__((ext_vector_type(16)));
typedef short s16x4 __attribute__((ext_vector_type(4)));
#define KST 104
#define VST 72
#define ATT_BUF (64 * KST * 2 + 64 * VST * 2)
__device__ __forceinline__ int crow32(int r, int hi) { return (r & 3) + 8 * (r >> 2) + 4 * hi; }
__device__ __forceinline__ s16x4 tr_read(const bf16_t* p) { return __builtin_bit_cast(s16x4, __builtin_amdgcn_ds_read_tr16_b64_v4i16((LAS s16x4*)(LAS void*)(unsigned)(size_t)p)); }
__device__ __forceinline__ bf16x8 pack8(const f32x16& x, int s) {
    u32x4 w; w.x = cvtpk(x[8 * s], x[8 * s + 1]); w.y = cvtpk(x[8 * s + 2], x[8 * s + 3]); w.z = cvtpk(x[8 * s + 4], x[8 * s + 5]); w.w = cvtpk(x[8 * s + 6], x[8 * s + 7]);
    return __builtin_bit_cast(bf16x8, w);
}
__device__ __forceinline__ void attn_block(const MK& a, int b, int h, int qb, char* smem) {
    const int tid = otid(), lane = tid & 63, wid = tid >> 6, r32 = lane & 31, hi = lane >> 5;
    const int qrow = qb * 256 + wid * 32 + r32;
    const int wq0 = qb * 256 + wid * 32;
    const int vr = tid >> 3, vc = tid & 7, rr_ = (tid >> 2) & 63, rc = tid & 3;
    const bf16_t* KVg = a.kvraw() + (size_t)b * SEQ * 1024 + h * 128 + (size_t)vr * 1024 + vc * 8;
    const bf16_t* KRg = a.krb() + (size_t)b * SEQ * 32 + (size_t)rr_ * 32 + rc * 8;
    float gk[8];
#pragma unroll
    for (int j = 0; j < 8; ++j) gk[j] = a.g_k_nope[8 * vc + j];
    bf16x8 krA, k1A, vrA, krB, k1B, vrB;
#define ATT_LOAD(tt, K0, V0, K1) do { K0 = *(const bf16x8*)(KVg + (size_t)(tt) * 64 * 1024); V0 = *(const bf16x8*)(KVg + (size_t)(tt) * 64 * 1024 + 64); if (tid < 256) K1 = *(const bf16x8*)(KRg + (size_t)(tt) * 64 * 32); } while (0)
#define ATT_STORE(buf, K0, V0, K1) do { bf16_t* Ks_ = (bf16_t*)(smem + (buf) * ATT_BUF); bf16_t* Vs_ = Ks_ + 64 * KST; \
        float x_[8]; bf8_to_f32(K0, x_); float ss_ = 0.f; _Pragma("unroll") for (int j = 0; j < 8; ++j) ss_ += x_[j] * x_[j]; \
        ss_ = sum8(ss_); const float rs_ = rsqrtf(ss_ * (1.f / 64.f) + EPSV); \
        _Pragma("unroll") for (int j = 0; j < 8; ++j) x_[j] *= rs_ * gk[j]; \
        *(bf16x8*)(Ks_ + vr * KST + vc * 8) = f32_to_bf8(x_); *(bf16x8*)(Vs_ + vr * VST + vc * 8) = V0; \
        if (tid < 256) *(bf16x8*)(Ks_ + rr_ * KST + 64 + rc * 8) = K1; } while (0)
    ATT_LOAD(0, krA, vrA, k1A); ATT_LOAD(1, krB, vrB, k1B);
    bf16x8 qf[6];
    {
        const float SCL = 0.14724445f;
        const bf16_t* Qg = a.qraw() + ((size_t)b * SEQ + qrow) * 768 + h * 96 + 8 * hi;
        float qv[6][8];
#pragma unroll
        for (int ds = 0; ds < 6; ++ds) bf8_to_f32(*(const bf16x8*)(Qg + 16 * ds), qv[ds]);
        float sn_ = 0.f, sr_ = 0.f;
#pragma unroll
        for (int j = 0; j < 8; ++j) { sn_ += qv[0][j] * qv[0][j] + qv[1][j] * qv[1][j] + qv[2][j] * qv[2][j] + qv[3][j] * qv[3][j]; sr_ += qv[4][j] * qv[4][j] + qv[5][j] * qv[5][j]; }
        sn_ = add_x32(sn_); sr_ = add_x32(sr_);
        const float rsn = rsqrtf(sn_ * (1.f / 64.f) + EPSV) * SCL, rsr = rsqrtf(sr_ * (1.f / 32.f) + EPSV);
#pragma unroll
        for (int ds = 0; ds < 4; ++ds) {
            float o[8];
#pragma unroll
            for (int j = 0; j < 8; ++j) o[j] = qv[ds][j] * rsn * a.g_q_nope[16 * ds + 8 * hi + j];
            qf[ds] = f32_to_bf8(o);
        }
        const float* tb = a.ropecs() + (size_t)qrow * 32 + 8 * hi;
        float o4[8], o5[8];
#pragma unroll
        for (int j = 0; j < 8; ++j) {
            const float x1 = qv[4][j] * rsr * a.g_q_rope[8 * hi + j], x2 = qv[5][j] * rsr * a.g_q_rope[16 + 8 * hi + j], cs = tb[j], sn = tb[16 + j];
            o4[j] = (x1 * cs - x2 * sn) * SCL; o5[j] = (x1 * sn + x2 * cs) * SCL;
        }
        qf[4] = f32_to_bf8(o4); qf[5] = f32_to_bf8(o5);
    }
    f32x16 o0, o1;
#pragma unroll
    for (int r = 0; r < 16; ++r) { o0[r] = 0.f; o1[r] = 0.f; }
    float m = 0.f, l = 0.f;
    f32x16 negm;
#pragma unroll
    for (int r = 0; r < 16; ++r) negm[r] = 0.f;
    const int nt = qb * 4 + 4;
    __syncthreads();
    ATT_STORE(0, krA, vrA, k1A); ATT_STORE(1, krB, vrB, k1B);
    __syncthreads();
    const int i16 = lane & 15, qq = i16 >> 2, pp = i16 & 3, g1 = (lane >> 4) & 1;
    auto tile_compute = [&](const int t) {
        const bf16_t* Ks = (const bf16_t*)(smem + (t & 3) * ATT_BUF); const bf16_t* Vs = Ks + 64 * KST;
        if (64 * t <= wq0 + 31) {
            f32x16 p0, p1;
#pragma unroll
            for (int ds = 0; ds < 6; ++ds) {
                const bf16x8 k0 = *(const bf16x8*)(Ks + r32 * KST + 16 * ds + 8 * hi);
                const bf16x8 k1 = *(const bf16x8*)(Ks + (32 + r32) * KST + 16 * ds + 8 * hi);
                if (ds == 0) { p0 = __builtin_amdgcn_mfma_f32_32x32x16_bf16(k0, qf[ds], negm, 0, 0, 0); p1 = __builtin_amdgcn_mfma_f32_32x32x16_bf16(k1, qf[ds], negm, 0, 0, 0); }
                else { p0 = __builtin_amdgcn_mfma_f32_32x32x16_bf16(k0, qf[ds], p0, 0, 0, 0); p1 = __builtin_amdgcn_mfma_f32_32x32x16_bf16(k1, qf[ds], p1, 0, 0, 0); }
            }
            if (64 * t + 63 > wq0) {
#pragma unroll
                for (int r = 0; r < 16; ++r) { const int kv = 64 * t + crow32(r, hi); if (kv > qrow) p0[r] = -INFINITY; if (kv + 32 > qrow) p1[r] = -INFINITY; }
            }
            float mx = fmaxf(p0[0], p1[0]);
#pragma unroll
            for (int r = 1; r < 16; ++r) mx = fmaxf(mx, fmaxf(p0[r], p1[r]));
            mx = max_x32(mx);
            const float delta = t == 0 ? mx : (mx > 8.f ? mx : 0.f);
            if (__any(delta != 0.f)) {
                m += delta;
                const float f = t == 0 ? 1.f : __builtin_amdgcn_exp2f(-delta);
#pragma unroll
                for (int r = 0; r < 16; ++r) { p0[r] -= delta; p1[r] -= delta; negm[r] = -m; o0[r] *= f; o1[r] *= f; }
                l *= f;
            }
            float rs = 0.f;
#pragma unroll
            for (int r = 0; r < 16; ++r) { p0[r] = __builtin_amdgcn_exp2f(p0[r]); p1[r] = __builtin_amdgcn_exp2f(p1[r]); rs += p0[r] + p1[r]; }
            l += rs;
            bf16x8 pf[4];
            pf[0] = pack8(p0, 0); pf[1] = pack8(p0, 1); pf[2] = pack8(p1, 0); pf[3] = pack8(p1, 1);
#pragma unroll
            for (int ks = 0; ks < 4; ++ks) {
                const bf16_t* vb0 = Vs + (16 * ks + 4 * hi + qq) * VST + 16 * g1 + 4 * pp;
                const s16x4 a0 = tr_read(vb0), a1 = tr_read(vb0 + 8 * VST);
                const s16x4 c0 = tr_read(vb0 + 32), c1 = tr_read(vb0 + 8 * VST + 32);
                const bf16x8 va = __builtin_shufflevector(a0, a1, 0, 1, 2, 3, 4, 5, 6, 7);
                const bf16x8 vc_ = __builtin_shufflevector(c0, c1, 0, 1, 2, 3, 4, 5, 6, 7);
                o0 = __builtin_amdgcn_mfma_f32_32x32x16_bf16(va, pf[ks], o0, 0, 0, 0);
                o1 = __builtin_amdgcn_mfma_f32_32x32x16_bf16(vc_, pf[ks], o1, 0, 0, 0);
            }
        }
    };
    for (int t = 0; t < nt; t += 2) {
        if (t + 2 < nt) { ATT_LOAD(t + 2, krA, vrA, k1A); ATT_LOAD(t + 3, krB, vrB, k1B); }
        tile_compute(t); tile_compute(t + 1);
        if (t + 2 < nt) { ATT_STORE((t + 2) & 3, krA, vrA, k1A); ATT_STORE((t + 3) & 3, krB, vrB, k1B); }
        __syncthreads();
    }
    l = add_x32(l);
    const float il = 1.f / l;
    bf16_t* op = a.omix() + ((size_t)b * SEQ + qrow) * 1024 + 512 + h * 64;
#pragma unroll
    for (int g = 0; g < 4; ++g) {
        uint2 w0, w1;
        w0.x = pk2bf(o0[4 * g] * il, o0[4 * g + 1] * il); w0.y = pk2bf(o0[4 * g + 2] * il, o0[4 * g + 3] * il);
        w1.x = pk2bf(o1[4 * g] * il, o1[4 * g + 1] * il); w1.y = pk2bf(o1[4 * g + 2] * il, o1[4 * g + 3] * il);
        *(uint2*)(op + 8 * g + 4 * hi) = w0;
        *(uint2*)(op + 32 + 8 * g + 4 * hi) = w1;
    }
#undef ATT_LOAD
#undef ATT_STORE
}

__device__ __forceinline__ void gdn_unit(const MK& a, int b, int h, int dvg, const float* s0, float* sout, int row0, int T, int lane, char* wsm) {
    float (*sq)[64] = (float (*)[64])wsm;
    float (*sk)[64] = (float (*)[64])(wsm + 4096);
    float (*sv)[8] = (float (*)[8])(wsm + 8192);
    float* sg = (float*)(wsm + 8704);
    float* sb = (float*)(wsm + 8768);
    const int e = lane & 7, ko = lane >> 3, col = dvg * 8 + e;
    float S[8];
#pragma unroll
    for (int d = 0; d < 8; ++d) S[d] = s0 ? s0[(((size_t)b * 8 + h) * 64 + ko * 8 + d) * 64 + col] : 0.f;
    const size_t rbase = (size_t)row0 + (size_t)b * T;
    float pq[16], pk[16], pv0, pv1, pgb;
    {
        const int nt = T < 16 ? T : 16;
#pragma unroll
        for (int j = 0; j < 16; ++j) { const bool ok = j < nt; const size_t r = rbase + (ok ? j : 0); pq[j] = ok ? bf2f(a.qkv()[r * 1536 + h * 64 + lane]) : 0.f; pk[j] = ok ? bf2f(a.qkv()[r * 1536 + 512 + h * 64 + lane]) : 0.f; }
        { const int j0 = lane >> 3, j1 = j0 + 8; pv0 = j0 < nt ? bf2f(a.qkv()[(rbase + j0) * 1536 + 1024 + h * 64 + dvg * 8 + (lane & 7)]) : 0.f; pv1 = j1 < nt ? bf2f(a.qkv()[(rbase + j1) * 1536 + 1024 + h * 64 + dvg * 8 + (lane & 7)]) : 0.f; }
        { const int j = lane & 15; pgb = j < nt ? (lane < 16 ? a.gg()[(rbase + j) * 8 + h] : a.bb()[(rbase + j) * 8 + h]) : 0.f; }
    }
    for (int t0 = 0; t0 < T; t0 += 16) {
        const int nt = (T - t0) < 16 ? (T - t0) : 16;
        WSYNC();
#pragma unroll
        for (int j = 0; j < 16; ++j) { sq[j][lane] = pq[j]; sk[j][lane] = pk[j]; }
        sv[lane >> 3][lane & 7] = pv0; sv[(lane >> 3) + 8][lane & 7] = pv1;
        if (lane < 16) sg[lane] = expf(pgb); else if (lane < 32) sb[lane - 16] = pgb;
        WSYNC();
        if (t0 + 16 < T) {
            const size_t rb = rbase + t0 + 16;
#pragma unroll
            for (int j = 0; j < 16; ++j) { pq[j] = bf2f(a.qkv()[(rb + j) * 1536 + h * 64 + lane]); pk[j] = bf2f(a.qkv()[(rb + j) * 1536 + 512 + h * 64 + lane]); }
            pv0 = bf2f(a.qkv()[(rb + (lane >> 3)) * 1536 + 1024 + h * 64 + dvg * 8 + (lane & 7)]); pv1 = bf2f(a.qkv()[(rb + (lane >> 3) + 8) * 1536 + 1024 + h * 64 + dvg * 8 + (lane & 7)]);
            pgb = lane < 16 ? a.gg()[(rb + (lane & 15)) * 8 + h] : a.bb()[(rb + (lane & 15)) * 8 + h];
        }
        for (int j = 0; j < nt; ++j) {
            const float dec = sg[j], be = sb[j], v = sv[j][e];
            const float4 k0 = *(const float4*)&sk[j][ko * 8], k1 = *(const float4*)&sk[j][ko * 8 + 4];
            const float4 q0 = *(const float4*)&sq[j][ko * 8], q1 = *(const float4*)&sq[j][ko * 8 + 4];
            const float kk[8] = {k0.x, k0.y, k0.z, k0.w, k1.x, k1.y, k1.z, k1.w};
            const float qq[8] = {q0.x, q0.y, q0.z, q0.w, q1.x, q1.y, q1.z, q1.w};
            float ks = 0.f;
#pragma unroll
            for (int d = 0; d < 8; ++d) { S[d] *= dec; ks += kk[d] * S[d]; }
            ks += __shfl_xor(ks, 8); ks += __shfl_xor(ks, 16); ks += __shfl_xor(ks, 32);
            const float delta = (v - ks) * be;
            float ov = 0.f;
#pragma unroll
            for (int d = 0; d < 8; ++d) { S[d] += kk[d] * delta; ov += qq[d] * S[d]; }
            ov += __shfl_xor(ov, 8); ov += __shfl_xor(ov, 16); ov += __shfl_xor(ov, 32);
            if (ko == 0) a.goraw()[(rbase + t0 + j) * 512 + h * 64 + col] = ov;
        }
    }
#pragma unroll
    for (int d = 0; d < 8; ++d) sout[(((size_t)b * 8 + h) * 64 + ko * 8 + d) * 64 + col] = S[d];
}
__device__ __forceinline__ int pi_pos(int k) { return (k & 32) + 8 * ((k >> 2) & 3) + 4 * ((k >> 4) & 1) + (k & 3); }
#define GDN_WLDS 17408
__device__ __forceinline__ void gdn_prep_unit(const MK& a, int u, int lane_in, char* wsm) {
    int lane = lane_in; asm volatile("" : "+v"(lane));
    u = __builtin_amdgcn_readfirstlane(u);
    const int bh = u >> 5, n = u & 31, b = bh >> 3, h = bh & 7, i16 = lane & 15, q4 = lane >> 4;
    const size_t row0 = (size_t)b * SEQ + n * 64;
    float* AT = (float*)wsm; float* GC = (float*)(wsm + 16384); float* BT = GC + 64;
    const bf16_t* qbase = a.qkv() + row0 * 1536 + h * 64; const bf16_t* kbase = qbase + 512; const bf16_t* vbase = qbase + 1024;
    bf16x8 kf[4][2], qf[4][2];
#pragma unroll
    for (int mt = 0; mt < 4; ++mt)
#pragma unroll
        for (int ks = 0; ks < 2; ++ks) {
            const int off = (16 * mt + i16) * 1536 + 32 * ks + 8 * q4;
            kf[mt][ks] = *(const bf16x8*)(kbase + off); qf[mt][ks] = *(const bf16x8*)(qbase + off);
        }
    float g = a.gg()[(row0 + lane) * 8 + h];
    const float be_l = a.bb()[(row0 + lane) * 8 + h];
#pragma unroll
    for (int o = 1; o < 64; o <<= 1) { const float t = __shfl_up(g, o); if (lane >= o) g += t; }
    WSYNC();
    GC[lane] = g; BT[lane] = be_l;
    WSYNC();
    const float gl = GC[63];
    float* EG = BT + 64; float* ED = EG + 64;
    EG[lane] = expf(g); ED[lane] = expf(gl - g);
    WSYNC();
    char* QKg = (char*)(a.gQK() + (size_t)u * 4096);
    unsigned qoff[2][4];
#pragma unroll
    for (int r = 0; r < 4; ++r) { qoff[0][r] = (unsigned)((4 * q4 + r) * 128 + 16 * ((i16 >> 2) ^ r) + 2 * (i16 & 3) + 64 * (q4 & 1)); qoff[1][r] = qoff[0][r] ^ 64u; }
#pragma unroll
    for (int mt = 0; mt < 4; ++mt) {
        const float4 gci4 = *(const float4*)(GC + 16 * mt + 4 * q4), bti4 = *(const float4*)(BT + 16 * mt + 4 * q4);
        const float gci[4] = {gci4.x, gci4.y, gci4.z, gci4.w}, bti[4] = {bti4.x, bti4.y, bti4.z, bti4.w};
#pragma unroll
        for (int nt = 0; nt < 4; ++nt) {
            if (nt <= mt) {
                f32x4 d1 = {0.f, 0.f, 0.f, 0.f}, d2 = {0.f, 0.f, 0.f, 0.f};
#pragma unroll
                for (int ks = 0; ks < 2; ++ks) {
                    d1 = __builtin_amdgcn_mfma_f32_16x16x32_bf16(kf[mt][ks], kf[nt][ks], d1, 0, 0, 0);
                    d2 = __builtin_amdgcn_mfma_f32_16x16x32_bf16(qf[mt][ks], kf[nt][ks], d2, 0, 0, 0);
                }
                const float gcj = GC[16 * nt + i16];
#pragma unroll
                for (int r = 0; r < 4; ++r) {
                    const float dec = __builtin_amdgcn_exp2f(1.44269504f * (gci[r] - gcj));
                    float av = bti[r] * d1[r] * dec, qv = d2[r] * dec;
                    if (nt == mt) { av = (4 * q4 + r > i16) ? av : 0.f; qv = (4 * q4 + r >= i16) ? qv : 0.f; }
                    AT[(16 * mt + 4 * q4 + r) * 64 + 16 * nt + i16] = av;
                    *(bf16_t*)(QKg + 2048 * mt + qoff[nt >> 1][r] + 8 * (nt & 1)) = f2bf(qv);
                }
            } else {
#pragma unroll
                for (int r = 0; r < 4; ++r) *(bf16_t*)(QKg + 2048 * mt + qoff[nt >> 1][r] + 8 * (nt & 1)) = 0;
            }
        }
    }
    {
        bf16_t* Qgg = a.gQg() + (size_t)u * 4096;
#pragma unroll
        for (int mt = 0; mt < 4; ++mt) {
            const int i = 16 * mt + i16; const float e = EG[i];
#pragma unroll
            for (int ks = 0; ks < 2; ++ks) {
                float x[8]; bf8_to_f32(qf[mt][ks], x);
                uint2 w0, w1; w0.x = cvtpk(x[0] * e, x[1] * e); w0.y = cvtpk(x[2] * e, x[3] * e); w1.x = cvtpk(x[4] * e, x[5] * e); w1.y = cvtpk(x[6] * e, x[7] * e);
                const int p0 = 32 * ks + 16 * (q4 & 1) + 4 * (q4 >> 1);
                *(uint2*)(Qgg + i * 64 + (((p0 >> 3) ^ (i & 7)) << 3) + (p0 & 7)) = w0; *(uint2*)(Qgg + i * 64 + ((((p0 >> 3) + 1) ^ (i & 7)) << 3) + (p0 & 7)) = w1;
            }
        }
    }
    WSYNC();
    __builtin_amdgcn_sched_barrier(0);
    {
        const float* Nb = AT + (16 * q4) * 64 + 16 * q4;
        float t[16];
#pragma unroll
        for (int r = 0; r < 16; ++r) t[r] = (r == i16) ? 1.f : 0.f;
#pragma unroll
        for (int r = 1; r < 16; ++r) {
            float sacc = 0.f;
#pragma unroll
            for (int j4 = 0; j4 < r; j4 += 4) {
                const float4 av = *(const float4*)(Nb + r * 64 + j4);
                sacc += av.x * t[j4];
                if (j4 + 1 < r) sacc += av.y * t[j4 + 1];
                if (j4 + 2 < r) sacc += av.z * t[j4 + 2];
                if (j4 + 3 < r) sacc += av.w * t[j4 + 3];
            }
            t[r] -= sacc;
        }
        WSYNC();
#pragma unroll
        for (int r = 0; r < 16; ++r) AT[(16 * q4 + r) * 64 + 16 * q4 + i16] = t[r];
        WSYNC();
    }
    __builtin_amdgcn_sched_barrier(0);
    {
#pragma unroll
        for (int pass = 0; pass < 2; ++pass) {
            f32x4 Y[4][4];
            const bf16_t* src = pass == 0 ? vbase : kbase;
#pragma unroll
            for (int bi = 0; bi < 4; ++bi)
#pragma unroll
                for (int r = 0; r < 4; ++r) {
                    const uint2 w = *(const uint2*)(src + (16 * bi + 4 * q4 + r) * 1536 + 4 * i16);
                    Y[bi][0][r] = __uint_as_float(w.x << 16); Y[bi][1][r] = __uint_as_float(w.x & 0xffff0000u); Y[bi][2][r] = __uint_as_float(w.y << 16); Y[bi][3][r] = __uint_as_float(w.y & 0xffff0000u);
                }
            if (pass == 1) {
#pragma unroll
                for (int nt = 0; nt < 4; ++nt) {
                    bf16_t* Kdg = a.gKd() + ((size_t)u * 64 + 4 * i16 + nt) * 64;
#pragma unroll
                    for (int bi = 0; bi < 4; ++bi) {
                        const float4 ed = *(const float4*)(ED + 16 * bi + 4 * q4);
                        uint2 w; w.x = cvtpk(Y[bi][nt][0] * ed.x, Y[bi][nt][1] * ed.y); w.y = cvtpk(Y[bi][nt][2] * ed.z, Y[bi][nt][3] * ed.w);
                        *(uint2*)(Kdg + 8 * ((4 * (bi >> 1) + q4) ^ ((4 * i16 + nt) & 7)) + 4 * (bi & 1)) = w;
                    }
                }
            }
#pragma unroll
            for (int bi = 0; bi < 4; ++bi) {
                const float4 btv = *(const float4*)(BT + 16 * bi + 4 * q4), egv = *(const float4*)(EG + 16 * bi + 4 * q4);
                const f32x4 sc = pass == 0 ? (f32x4){btv.x, btv.y, btv.z, btv.w} : (f32x4){btv.x * egv.x, btv.y * egv.y, btv.z * egv.z, btv.w * egv.w};
#pragma unroll
                for (int nt = 0; nt < 4; ++nt) Y[bi][nt] = Y[bi][nt] * sc;
            }
#pragma unroll
            for (int bi = 0; bi < 4; ++bi) {
                f32x4 mfr[4];
#pragma unroll
                for (int bj = 0; bj <= bi; ++bj) { const f32x4 v = *(const f32x4*)(AT + (16 * bi + i16) * 64 + 16 * bj + 4 * q4); mfr[bj] = (bi == bj) ? v : -v; }
#pragma unroll
                for (int bj = 0; bj < bi; ++bj)
#pragma unroll
                    for (int s4 = 0; s4 < 4; ++s4)
#pragma unroll
                        for (int nt = 0; nt < 4; ++nt) Y[bi][nt] = __builtin_amdgcn_mfma_f32_16x16x4f32(mfr[bj][s4], Y[bj][nt][s4], Y[bi][nt], 0, 0, 0);
                f32x4 X[4];
#pragma unroll
                for (int nt = 0; nt < 4; ++nt) X[nt] = (f32x4){0.f, 0.f, 0.f, 0.f};
#pragma unroll
                for (int s4 = 0; s4 < 4; ++s4)
#pragma unroll
                    for (int nt = 0; nt < 4; ++nt) X[nt] = __builtin_amdgcn_mfma_f32_16x16x4f32(mfr[bi][s4], Y[bi][nt][s4], X[nt], 0, 0, 0);
#pragma unroll
                for (int nt = 0; nt < 4; ++nt) Y[bi][nt] = X[nt];
            }
            if (pass == 0) {
#pragma unroll
                for (int nt = 0; nt < 4; ++nt) {
                    bf16_t* UTg = (bf16_t*)a.gUT() + ((size_t)u * 64 + 4 * i16 + nt) * 64;
#pragma unroll
                    for (int bi = 0; bi < 4; ++bi) { uint2 w; w.x = cvtpk(Y[bi][nt][0], Y[bi][nt][1]); w.y = cvtpk(Y[bi][nt][2], Y[bi][nt][3]);
                        *(uint2*)(UTg + 4 * ((4 * bi + q4) ^ ((4 * i16 + nt) & 15))) = w; }
                }
            } else {
                bf16_t* Wng = a.gWn() + (size_t)u * 4096; const int pp = pi_pos(4 * i16);
#pragma unroll
                for (int bi = 0; bi < 4; ++bi)
#pragma unroll
                    for (int r = 0; r < 4; ++r) { const int i = 16 * bi + 4 * q4 + r;
                        uint2 w; w.x = cvtpk(-Y[bi][0][r], -Y[bi][1][r]); w.y = cvtpk(-Y[bi][2][r], -Y[bi][3][r]);
                        *(uint2*)(Wng + i * 64 + (((pp >> 3) ^ (i & 7)) << 3) + (pp & 7)) = w; }
            }
            __builtin_amdgcn_sched_barrier(0);
        }
    }
    if (lane == 0) a.ggam()[u] = expf(gl);
}
__device__ __forceinline__ bf16x8 pack_acc2(const f32x4& x, const f32x4& y) {
    u32x4 w; w.x = cvtpk(x[0], x[1]); w.y = cvtpk(x[2], x[3]); w.z = cvtpk(y[0], y[1]); w.w = cvtpk(y[2], y[3]);
    return __builtin_bit_cast(bf16x8, w);
}
typedef unsigned u32x2 __attribute__((ext_vector_type(2)));
#define G2_SLOT 49152
__device__ __forceinline__ void g2_issue(const MK& a, size_t u, int n, LAS unsigned char* lds, int lw, int lane) {
    LAS unsigned char* dst = lds + (n % 3) * G2_SLOT;
    const char* srcs[4] = {(const char*)(a.gWn() + u * 4096), (const char*)(a.gQg() + u * 4096), (const char*)(a.gQK() + u * 4096), (const char*)(a.gKd() + u * 4096)};
#pragma unroll
    for (int m = 0; m < 4; ++m)
#pragma unroll
        for (int i = 0; i < 2; ++i) { const int piece = 2 * lw + i;
            __builtin_amdgcn_global_load_lds((const unsigned*)(srcs[m] + piece * 1024 + lane * 16), (LAS unsigned*)(dst + m * 8192 + piece * 1024), 16, 0, 0); }
    const char* us = (const char*)((const bf16_t*)a.gUT() + u * 4096);
#pragma unroll
    for (int i = 0; i < 2; ++i) { const int piece = 2 * lw + i;
        __builtin_amdgcn_global_load_lds((const unsigned*)(us + piece * 1024 + lane * 16), (LAS unsigned*)(dst + 32768 + piece * 1024), 16, 0, 0); }
}
__device__ __forceinline__ void gdn_scan_block(const MK& a, int bh, LAS unsigned char* lds) {
    const int tid = otid(), lane = tid & 63, wid = __builtin_amdgcn_readfirstlane(tid >> 6), i16 = lane & 15, q4 = lane >> 4;
    const int b = bh >> 3, h = bh & 7, sl = wid & 3;
    const bool loader = wid >= 4;
    f32x4 S[4];
#pragma unroll
    for (int mt = 0; mt < 4; ++mt) S[mt] = (f32x4){0.f, 0.f, 0.f, 0.f};
    __syncthreads();
    const float gamv = a.ggam()[(size_t)bh * 32 + (lane & 31)];
    if (loader) { g2_issue(a, (size_t)bh * 32, 0, lds, wid - 4, lane); g2_issue(a, (size_t)bh * 32 + 1, 1, lds, wid - 4, lane); }
    for (int n = 0; n < 32; ++n) {
        if (loader) { if (n < 31) asm volatile("s_waitcnt vmcnt(10)" ::: "memory"); else asm volatile("s_waitcnt vmcnt(0)" ::: "memory"); }
        asm volatile("s_waitcnt lgkmcnt(0)" ::: "memory"); __builtin_amdgcn_s_barrier(); asm volatile("" ::: "memory");
        if (loader) { if (n + 2 < 32) g2_issue(a, (size_t)bh * 32 + n + 2, n + 2, lds, wid - 4, lane); }
        else {
            const LAS unsigned char* sb = lds + (n % 3) * G2_SLOT;
            const float gam = __builtin_bit_cast(float, __builtin_amdgcn_readlane(__builtin_bit_cast(int, gamv), n));
            bf16x8 fW[4][2], fQg[4][2], fQK[4][2], fKd[4][2];
            f32x4 Vn[4];
#pragma unroll
            for (int mt = 0; mt < 4; ++mt) {
                { const u32x2 uw = *(const LAS u32x2*)(sb + 32768 + (16 * sl + i16) * 128 + 8 * ((4 * mt + q4) ^ i16));
                  Vn[mt] = (f32x4){__uint_as_float(uw.x << 16), __uint_as_float(uw.x & 0xffff0000u), __uint_as_float(uw.y << 16), __uint_as_float(uw.y & 0xffff0000u)}; }
#pragma unroll
                for (int ks = 0; ks < 2; ++ks) {
                    const int fo = (16 * mt + i16) * 128 + 16 * ((4 * ks + q4) ^ (i16 & 7));
                    fW[mt][ks] = *(const LAS bf16x8*)(sb + fo); fQg[mt][ks] = *(const LAS bf16x8*)(sb + 8192 + fo); fQK[mt][ks] = *(const LAS bf16x8*)(sb + 16384 + fo); fKd[mt][ks] = *(const LAS bf16x8*)(sb + 24576 + fo);
                }
            }
            __builtin_amdgcn_sched_barrier(0);
            bf16x8 Sb[2]; Sb[0] = pack_acc2(S[0], S[1]); Sb[1] = pack_acc2(S[2], S[3]);
#pragma unroll
            for (int mt = 0; mt < 4; ++mt)
#pragma unroll
                for (int ks = 0; ks < 2; ++ks) Vn[mt] = __builtin_amdgcn_mfma_f32_16x16x32_bf16(fW[mt][ks], Sb[ks], Vn[mt], 0, 0, 0);
            bf16x8 Vb[2]; Vb[0] = pack_acc2(Vn[0], Vn[1]); Vb[1] = pack_acc2(Vn[2], Vn[3]);
            f32x4 O[4];
#pragma unroll
            for (int mt = 0; mt < 4; ++mt) {
                O[mt] = (f32x4){0.f, 0.f, 0.f, 0.f};
#pragma unroll
                for (int ks = 0; ks < 2; ++ks) {
                    O[mt] = __builtin_amdgcn_mfma_f32_16x16x32_bf16(fQg[mt][ks], Sb[ks], O[mt], 0, 0, 0);
                    O[mt] = __builtin_amdgcn_mfma_f32_16x16x32_bf16(fQK[mt][ks], Vb[ks], O[mt], 0, 0, 0);
                }
            }
#pragma unroll
            for (int mt = 0; mt < 4; ++mt) {
                S[mt] = S[mt] * gam;
#pragma unroll
                for (int ks = 0; ks < 2; ++ks) S[mt] = __builtin_amdgcn_mfma_f32_16x16x32_bf16(fKd[mt][ks], Vb[ks], S[mt], 0, 0, 0);
            }
            float* og = a.goraw() + ((size_t)b * SEQ + n * 64 + 4 * q4) * 512 + h * 64 + 16 * sl + i16;
#pragma unroll
            for (int mt = 0; mt < 4; ++mt)
#pragma unroll
                for (int r = 0; r < 4; ++r) og[(size_t)(16 * mt + r) * 512] = O[mt][r];
        }
    }
    if (!loader) {
        float* so = a.out + O_GSP + ((size_t)bh * 64 + 4 * q4) * 64 + 16 * sl + i16;
#pragma unroll
        for (int mt = 0; mt < 4; ++mt)
#pragma unroll
            for (int r = 0; r < 4; ++r) so[(size_t)(16 * mt + r) * 64] = S[mt][r];
    }
    __syncthreads();
}
__device__ __forceinline__ void gdn_out_token(const MK& a, int row, int lane) {
    const float* op = a.goraw() + (size_t)row * 512 + 8 * lane;
    const float4 x0 = *(const float4*)op, x1 = *(const float4*)(op + 4);
    float o[8] = {x0.x, x0.y, x0.z, x0.w, x1.x, x1.y, x1.z, x1.w}, zg[8];
    bf8_to_f32(*(const bf16x8*)(a.Z() + (size_t)row * ZW + OFF_Z + 8 * lane), zg);
    float ss = 0.f;
#pragma unroll
    for (int e = 0; e < 8; ++e) ss += o[e] * o[e];
    ss = sum8(ss);
    const float rs = rsqrtf(ss * (1.f / 64.f) + EPSV);
    const float4 g0 = *(const float4*)(a.g_gdn_out + 8 * (lane & 7)), g1 = *(const float4*)(a.g_gdn_out + 8 * (lane & 7) + 4);
    const float gg_[8] = {g0.x, g0.y, g0.z, g0.w, g1.x, g1.y, g1.z, g1.w};
#pragma unroll
    for (int e = 0; e < 8; ++e) o[e] = o[e] * rs * gg_[e] * zg[e] * fast_sigmoid(zg[e]);
    *(bf16x8*)(a.omix() + (size_t)row * 1024 + 8 * lane) = f32_to_bf8(o);
}

#define SSLOT 32768
#define TL_OFF (3 * SSLOT)
#define CST 264
#define KR_OFF (TL_OFF + 2 * 32 * CST * 2)
#define WQ_OFF (KR_OFF + 4 * 4096)
#define QR_OFF (WQ_OFF + 2048)
#define PG_OFF (QR_OFF + 1024)
#define PT_OFF (PG_OFF + 64)
#define AL_OFF (PT_OFF + 1024)
#define SAMP_LDS_END (AL_OFF + 64)
__device__ __forceinline__ void samp_issue_phys(const MK& a, int g, int phys, LAS unsigned char* lds, int wid, int lane) {
    const int tok0 = (g & 3) * 32 + 4 * wid;
    const float* cs = a.cache_ckv + ((size_t)phys * 128 + tok0) * 256 + lane * 4;
#pragma unroll
    for (int i = 0; i < 4; ++i) __builtin_amdgcn_global_load_lds((const unsigned*)(cs + i * 256), (LAS unsigned*)(lds + (g % 3) * SSLOT + (4 * wid + i) * 1024), 16, 0, 2);
    if (wid < 4) { const int tl = lane >> 3, cg = (lane & 7) ^ (((tl >> 1) & 1) | ((wid & 1) << 2));
        __builtin_amdgcn_global_load_lds((const unsigned*)(a.cache_krope + ((size_t)phys * 128 + (g & 3) * 32 + 8 * wid + tl) * 32 + cg * 4), (LAS unsigned*)(lds + KR_OFF + (g & 3) * 4096 + wid * 1024), 16, 0, 2); }
}
__device__ __forceinline__ void samp_issue(const MK& a, int g, LAS unsigned char* lds, int wid, int lane) {
    samp_issue_phys(a, g, __builtin_amdgcn_readfirstlane(((const LAS int*)(lds + PG_OFF))[g >> 2]), lds, wid, lane);
}
__device__ __forceinline__ void samp_convert(int g, LAS unsigned char* lds, int tid) {
    const int st = tid >> 4, l16 = tid & 15;
    const LAS float* src = (const LAS float*)(lds + (g % 3) * SSLOT) + st * 256 + 4 * l16;
    LAS bf16_t* dst = (LAS bf16_t*)(lds + TL_OFF + (g & 1) * 32 * CST * 2) + st * CST + 4 * l16;
    f32x4 x[4];
#pragma unroll
    for (int k = 0; k < 4; ++k) x[k] = *(const LAS f32x4*)(src + 64 * k);
#pragma unroll
    for (int k = 0; k < 4; ++k) { u32x2 w; w.x = cvtpk(x[k][0], x[k][1]); w.y = cvtpk(x[k][2], x[k][3]); *(LAS u32x2*)(dst + 64 * k) = w; }
}
#define SAMP_WAITV(n5, n4) do { if (h < 4) asm volatile("s_waitcnt vmcnt(" #n5 ")" ::: "memory"); else asm volatile("s_waitcnt vmcnt(" #n4 ")" ::: "memory"); } while (0)
#define SAMP_BAR() do { asm volatile("s_waitcnt lgkmcnt(0)" ::: "memory"); __builtin_amdgcn_s_barrier(); asm volatile("" ::: "memory"); } while (0)
__device__ __forceinline__ void samp_attn_unit(const MK& a, int u, char* smem, LAS unsigned char* lds) {
    const int tid = otid(), lane = tid & 63, h = __builtin_amdgcn_readfirstlane(tid >> 6), i16 = lane & 15, q4 = lane >> 4;
    const int b = u >> 3, sp = u & 7;
    float* WQ = (float*)(smem + WQ_OFF);
    float* QR = (float*)(smem + QR_OFF);
    int* PG = (int*)(smem + PG_OFF);
    const float SCL = 0.14724445f;
    { const int phys0 = __builtin_amdgcn_readfirstlane(a.page_table[b * NPAGES + sp * 16]);
      samp_issue_phys(a, 0, phys0, lds, h, lane); samp_issue_phys(a, 1, phys0, lds, h, lane); samp_issue_phys(a, 2, phys0, lds, h, lane); }
    post_q_item(a, (NPT + b) * 8 + h, lane);
    __syncthreads();
    {
        const int h_ = tid >> 6, l_ = tid & 63, q4_ = l_ >> 4, idx = l_ & 15, d = 16 * (idx >> 2) + 4 * q4_ + (idx & 3);
        WQ[tid] = a.g_k_nope[d] * a.qh()[((size_t)(NPT + b) * 8 + h_) * 96 + d] * SCL;
        if (tid < 256) QR[tid] = a.qh()[((size_t)(NPT + b) * 8 + (tid >> 5)) * 96 + 64 + (tid & 31)] * SCL;
        if (tid < 16) PG[tid] = a.page_table[b * NPAGES + sp * 16 + tid];
    }
    bf16x8 wf[4][8];
#pragma unroll
    for (int mt = 0; mt < 4; ++mt)
#pragma unroll
        for (int ks = 0; ks < 8; ++ks) wf[mt][ks] = *(const bf16x8*)(a.WknT() + (size_t)(h * 64 + 16 * mt + i16) * 256 + 32 * ks + 8 * q4);
#pragma unroll
    for (int mt = 0; mt < 4; ++mt)
#pragma unroll
        for (int ks = 0; ks < 8; ++ks) asm volatile("" : "+v"(wf[mt][ks]));
    SAMP_WAITV(10, 8);
    SAMP_BAR();
    samp_convert(0, lds, tid);
    const LAS float* QRl = (const LAS float*)(lds + QR_OFF) + h * 32 + 8 * q4;
    const LAS float* WQl = (const LAS float*)(lds + WQ_OFF) + (h * 4 + q4) * 16;
    f32x4 wqr[4], qrr[2];
#pragma unroll
    for (int mt = 0; mt < 4; ++mt) wqr[mt] = *(const LAS f32x4*)(WQl + 4 * mt);
    qrr[0] = *(const LAS f32x4*)QRl; qrr[1] = *(const LAS f32x4*)(QRl + 4);
    float m = -INFINITY, lsum = 0.f;
    f32x4 latv[2]; latv[0] = (f32x4){0.f, 0.f, 0.f, 0.f}; latv[1] = (f32x4){0.f, 0.f, 0.f, 0.f};
    for (int g = 0; g < 64; ++g) {
        SAMP_BAR();
        if (g + 3 < 64) samp_issue(a, g + 3, lds, h, lane);
        const LAS bf16_t* Tl = (const LAS bf16_t*)(lds + TL_OFF + (g & 1) * 32 * CST * 2); const LAS float* KR = (const LAS float*)(lds + KR_OFF + (g & 3) * 4096);
        float scv;
        {
            float ssp[2], dotp[2], rdp[2];
            f32x4 acc[2][4];
#pragma unroll
            for (int hf = 0; hf < 2; ++hf)
#pragma unroll
                for (int mt = 0; mt < 4; ++mt) acc[hf][mt] = (f32x4){0.f, 0.f, 0.f, 0.f};
            const LAS bf16_t* cp0 = Tl + i16 * CST + 8 * q4; const LAS bf16_t* cp1 = cp0 + 16 * CST;
            bf16x8 c0 = *(const LAS bf16x8*)cp0, c1 = *(const LAS bf16x8*)cp1;
#pragma unroll
            for (int ks = 0; ks < 8; ++ks) {
                bf16x8 n0 = c0, n1 = c1;
                if (ks < 7) { n0 = *(const LAS bf16x8*)(cp0 + 32 * (ks + 1)); n1 = *(const LAS bf16x8*)(cp1 + 32 * (ks + 1)); }
#pragma unroll
                for (int mt = 0; mt < 4; ++mt) { acc[0][mt] = __builtin_amdgcn_mfma_f32_16x16x32_bf16(wf[mt][ks], c0, acc[0][mt], 0, 0, 0); acc[1][mt] = __builtin_amdgcn_mfma_f32_16x16x32_bf16(wf[mt][ks], c1, acc[1][mt], 0, 0, 0); }
                c0 = n0; c1 = n1;
            }
#pragma unroll
            for (int hf = 0; hf < 2; ++hf) {
                f32x2_t ss2 = {0.f, 0.f}, dot2 = {0.f, 0.f}, rd2 = {0.f, 0.f};
#pragma unroll
                for (int mt = 0; mt < 4; ++mt) {
                    const f32x4 wq = wqr[mt];
                    const f32x4 av = acc[hf][mt];
                    const f32x2_t lo = __builtin_shufflevector(av, av, 0, 1), hi = __builtin_shufflevector(av, av, 2, 3);
                    ss2 = __builtin_elementwise_fma(lo, lo, ss2); ss2 = __builtin_elementwise_fma(hi, hi, ss2);
                    dot2 = __builtin_elementwise_fma(lo, __builtin_shufflevector(wq, wq, 0, 1), dot2); dot2 = __builtin_elementwise_fma(hi, __builtin_shufflevector(wq, wq, 2, 3), dot2);
                }
                {
                    const int kc = (2 * q4) ^ ((i16 >> 1) & 5);
                    const LAS float* kp = KR + (16 * hf + i16) * 32;
                    const f32x4 k0 = *(const LAS f32x4*)(kp + 4 * kc), k1 = *(const LAS f32x4*)(kp + 4 * (kc ^ 1)), q0 = qrr[0], q1 = qrr[1];
                    rd2 = __builtin_elementwise_fma(__builtin_shufflevector(k0, k0, 0, 1), __builtin_shufflevector(q0, q0, 0, 1), rd2); rd2 = __builtin_elementwise_fma(__builtin_shufflevector(k0, k0, 2, 3), __builtin_shufflevector(q0, q0, 2, 3), rd2);
                    rd2 = __builtin_elementwise_fma(__builtin_shufflevector(k1, k1, 0, 1), __builtin_shufflevector(q1, q1, 0, 1), rd2); rd2 = __builtin_elementwise_fma(__builtin_shufflevector(k1, k1, 2, 3), __builtin_shufflevector(q1, q1, 2, 3), rd2);
                }
                ssp[hf] = ss2[0] + ss2[1]; dotp[hf] = dot2[0] + dot2[1]; rdp[hf] = rd2[0] + rd2[1];
            }
            const auto s1 = __builtin_amdgcn_permlane16_swap(__float_as_uint(ssp[0]), __float_as_uint(ssp[1]), false, false);
            const auto s2 = __builtin_amdgcn_permlane16_swap(__float_as_uint(dotp[0]), __float_as_uint(dotp[1]), false, false);
            const auto s3 = __builtin_amdgcn_permlane16_swap(__float_as_uint(rdp[0]), __float_as_uint(rdp[1]), false, false);
            const float u1 = __uint_as_float(s1[0]) + __uint_as_float(s1[1]), u2 = __uint_as_float(s2[0]) + __uint_as_float(s2[1]), u3 = __uint_as_float(s3[0]) + __uint_as_float(s3[1]);
            const auto t1 = __builtin_amdgcn_permlane32_swap(__float_as_uint(u1), __float_as_uint(u2), false, false);
            const float t = __uint_as_float(t1[0]) + __uint_as_float(t1[1]);
            const auto t2 = __builtin_amdgcn_permlane32_swap(__float_as_uint(t), __float_as_uint(t), false, false);
            const float ssv = __uint_as_float(t2[0]), dotv = __uint_as_float(t2[1]);
            const float rdv = add_x32(u3);
            scv = dotv * rsqrtf(ssv * (1.f / 64.f) + EPSV) + rdv;
        }
        float gm = max16(scv);
        { const auto r = __builtin_amdgcn_permlane16_swap(__float_as_uint(gm), __float_as_uint(gm), false, false); gm = fmaxf(__uint_as_float(r[0]), __uint_as_float(r[1])); }
        const float mn = fmaxf(m, gm);
        const float alpha = __builtin_amdgcn_exp2f(m - mn), pv = __builtin_amdgcn_exp2f(scv - mn);
        m = mn;
        lsum = lsum * alpha + pv;
        if (q4 < 2) { ((LAS float*)(lds + PT_OFF))[h * 32 + lane] = pv; if (lane == 0) ((LAS float*)(lds + AL_OFF))[h] = alpha; }
        if (g <= 60) SAMP_WAITV(10, 8); else if (g == 61) SAMP_WAITV(5, 4); else SAMP_WAITV(0, 0);
        SAMP_BAR();
        {
            u32x4 pw = {0u, 0u, 0u, 0u};
            if (i16 < 8) { const f32x4 pa = *(const LAS f32x4*)(lds + PT_OFF + (i16 * 32 + 8 * q4) * 4), pb_ = *(const LAS f32x4*)(lds + PT_OFF + (i16 * 32 + 8 * q4 + 4) * 4);
                pw.x = cvtpk(pa[0], pa[1]); pw.y = cvtpk(pa[2], pa[3]); pw.z = cvtpk(pb_[0], pb_[1]); pw.w = cvtpk(pb_[2], pb_[3]); }
            const bf16x8 pfr = __builtin_bit_cast(bf16x8, pw);
            const f32x4 al = *(const LAS f32x4*)(lds + AL_OFF + (q4 & 1) * 16);
            const unsigned tb0 = (unsigned)(size_t)((const LAS bf16_t*)(lds + TL_OFF + (g & 1) * 32 * CST * 2) + (8 * q4 + (i16 >> 2)) * CST + 32 * h + 4 * (i16 & 3));
            s16x4 c0[2], c1[2];
            static_assert(4 * CST * 2 == 2112, "tr offsets");
            asm volatile("ds_read_b64_tr_b16 %0, %4\n\tds_read_b64_tr_b16 %1, %4 offset:2112\n\tds_read_b64_tr_b16 %2, %4 offset:32\n\tds_read_b64_tr_b16 %3, %4 offset:2144\n\ts_waitcnt lgkmcnt(0)"
                         : "=&v"(c0[0]), "=&v"(c1[0]), "=&v"(c0[1]), "=&v"(c1[1]) : "v"(tb0) : "memory");
#pragma unroll
            for (int nt = 0; nt < 2; ++nt) {
                const bf16x8 cfr = __builtin_shufflevector(c0[nt], c1[nt], 0, 1, 2, 3, 4, 5, 6, 7);
                latv[nt] = latv[nt] * al;
                latv[nt] = __builtin_amdgcn_mfma_f32_16x16x32_bf16(pfr, cfr, latv[nt], 0, 0, 0);
            }
        }
        if (g + 1 < 64) samp_convert(g + 1, lds, tid);
    }
    lsum = add_x16(sum16(lsum));
    if (lane == 0) { float* o = a.part() + ((size_t)u * 8 + h) * 260; o[0] = m * 0.69314718f; o[1] = lsum; }
    if (q4 < 2) {
#pragma unroll
        for (int nt = 0; nt < 2; ++nt)
#pragma unroll
            for (int r = 0; r < 4; ++r) a.part()[((size_t)u * 8 + 4 * q4 + r) * 260 + 4 + 32 * h + 16 * nt + i16] = latv[nt][r];
    }
}
__device__ __forceinline__ void samp_comb_unit(const MK& a, int u, char* smem) {
    float* slat = (float*)smem; float* red = slat + 256;
    const int b = u >> 3, h = u & 7, tid = otid(), lane = tid & 63, wid = tid >> 6;
    const size_t row = NPT + b;
    const float* q = a.qh() + (row * 8 + h) * 96;
    float sp = q[lane] * a.kh()[(row * 8 + h) * 64 + lane];
    if (lane < 32) sp += q[64 + lane] * a.krf()[row * 32 + lane];
    const float s_self = wave_sum(sp) * 0.10206207261596577f;
    float pm[8], m = s_self;
#pragma unroll
    for (int s = 0; s < 8; ++s) { pm[s] = a.part()[((size_t)(b * 8 + s) * 8 + h) * 260]; m = fmaxf(m, pm[s]); }
    const float pself = __expf(s_self - m);
    float l = pself, lat = 0.f;
    __syncthreads();
#pragma unroll
    for (int s = 0; s < 8; ++s) {
        const float* p = a.part() + ((size_t)(b * 8 + s) * 8 + h) * 260;
        const float w = __expf(pm[s] - m);
        l += p[1] * w; if (tid < 256) lat += p[4 + tid] * w;
    }
    if (tid < 256) slat[tid] = lat;
    __syncthreads();
    {
        const float* wv = a.w_kv_b + (size_t)(32 * wid) * 1024 + h * 128 + 64 + lane;
        float o = 0.f;
#pragma unroll 8
        for (int c = 0; c < 32; ++c) o += slat[32 * wid + c] * wv[(size_t)c * 1024];
        red[wid * 64 + lane] = o;
    }
    __syncthreads();
    if (tid < 64) {
        float o = pself * a.KV()[row * 1024 + h * 128 + 64 + tid];
#pragma unroll
        for (int w = 0; w < 8; ++w) o += red[w * 64 + tid];
        a.omix()[row * 1024 + 512 + h * 64 + tid] = f2bf(o / l);
    }
}

#define XB_TMO      128
#define XB_XCNT(j)  (256  + 64 * (j))
#define XB_XSUB(j)  (1280 + 64 * (j))
#define XB_XGEN(j)  (2304 + 64 * (j))
#define XB_TOP      3328
#define XB_TOPGEN   3392
#define XCD_BAR_WORDS 3456
#define XB_SPIN_CAP (1u << 18)

__device__ __forceinline__ unsigned xb_ld(unsigned* p)              { return __hip_atomic_load(p, __ATOMIC_RELAXED, __HIP_MEMORY_SCOPE_AGENT); }
__device__ __forceinline__ unsigned xb_add(unsigned* p, unsigned v) { return __hip_atomic_fetch_add(p, v, __ATOMIC_RELAXED, __HIP_MEMORY_SCOPE_AGENT); }
__device__ __forceinline__ unsigned xb_xcc_id() { return (unsigned)__builtin_amdgcn_s_getreg((3 << 11) | 20) & 0xFu; }
#define XB_SPIN(cond, bar) do { unsigned _sp = 0; while (cond) { __builtin_amdgcn_s_sleep(1); \
    if ((++_sp & 255u) == 0u) { if (xb_ld(&(bar)[XB_TMO])) break; if (_sp > XB_SPIN_CAP) { atomicAdd(&(bar)[XB_TMO], 1u); break; } } } } while (0)

struct XcdBarrier {
    unsigned* bar; unsigned x;
    volatile LAS unsigned* st;
};

__device__ __forceinline__ XcdBarrier xcd_barrier_post(unsigned* bar, volatile LAS unsigned* st) {
    XcdBarrier b; b.bar = bar; b.x = xb_xcc_id(); b.st = st;
    if (threadIdx.x == 0) (void)xb_add(&bar[XB_XCNT(b.x)], 1u);
    return b;
}
__device__ __forceinline__ void xcd_barrier_complete(unsigned* bar, unsigned x, unsigned& nloc, unsigned& nx) {
    const unsigned G = gridDim.x * gridDim.y * gridDim.z;
    unsigned sum, cnt, mine, sp = 0u;
    for (;;) {
        sum = 0u; cnt = 0u; mine = 0u;
#pragma unroll
        for (unsigned j = 0; j < 16; ++j) { const unsigned c = xb_ld(&bar[XB_XCNT(j)]); sum += c; cnt += (c > 0u) ? 1u : 0u; mine = (j == x) ? c : mine; }
        if (sum == G) break;
        __builtin_amdgcn_s_sleep(1);
        if ((++sp & 255u) == 0u) { if (xb_ld(&bar[XB_TMO])) break; if (sp > XB_SPIN_CAP) { atomicAdd(&bar[XB_TMO], 1u); break; } }
    }
    nloc = mine > 0u ? mine : 1u; nx = cnt > 0u ? cnt : 1u;
}

__device__ __forceinline__ void xcd_barrier(const XcdBarrier& b) {
    asm volatile("s_waitcnt vmcnt(0)" ::: "memory");
    __syncthreads();
    if (threadIdx.x == 0) {
        unsigned* bar = b.bar;
        __builtin_amdgcn_s_waitcnt(0);
        unsigned nloc = b.st[0], nx = b.st[1];
        if (nloc == 0u) { xcd_barrier_complete(bar, b.x, nloc, nx); b.st[0] = nloc; b.st[1] = nx; }
        const unsigned old = xb_add(&bar[XB_XSUB(b.x)], 1u);
        const unsigned gen = old / nloc;
        if (old + 1u == (gen + 1u) * nloc) {
            __builtin_amdgcn_fence(__ATOMIC_RELEASE, "agent");
            asm volatile("s_waitcnt vmcnt(0)" ::: "memory");
            const unsigned og = xb_add(&bar[XB_TOP], 1u);
            const unsigned tg = og / nx;
            if (og + 1u == (tg + 1u) * nx) xb_add(&bar[XB_TOPGEN], 1u);
            else XB_SPIN(xb_ld(&bar[XB_TOPGEN]) == tg, bar);
            __builtin_amdgcn_fence(__ATOMIC_ACQUIRE, "agent");
            xb_add(&bar[XB_XGEN(b.x)], 1u);
            asm volatile("s_waitcnt vmcnt(0)" ::: "memory");
        } else {
            XB_SPIN(xb_ld(&bar[XB_XGEN(b.x)]) == gen, bar);
            __builtin_amdgcn_fence(__ATOMIC_ACQUIRE, "agent");
            asm volatile("s_waitcnt vmcnt(0)" ::: "memory");
        }
    }
    __syncthreads();
}

__device__ __forceinline__ void late_weight_items(const MK& a, int gwl, int ngwl, float* scr, int lane) {
    const int T4 = 32 * 16, T5 = 176 * 16, T7 = 32 * 44, T8 = 32 * 16, TT = T4 + T5 + T7 + T8;
    for (int it = gwl; it < TT; it += ngwl) {
        int r = it;
        if (r < T4) { const int nt_ = r % 32, kb = r / 32; wt_item(a.w_o, 1024, 32 * nt_, 32, a.WoT(), 1024, 32 * nt_, 64 * kb, scr, lane); continue; } r -= T4;
        if (r < T5) { const int nt_ = r % 176, kb = r / 176, pn = nt_ >> 3, wi = nt_ & 7;
            wt_item(wi < 4 ? a.w_gate : a.w_up, DFF, pn * 128 + (wi & 3) * 32, 32, a.WguT(), 1024, 32 * nt_, 64 * kb, scr, lane); continue; } r -= T5;
        if (r < T7) { const int nt_ = r % 32, kb = r / 32; wt_item(a.w_down, 1024, 32 * nt_, 32, a.WdT(), DFF, 32 * nt_, 64 * kb, scr, lane); continue; } r -= T7;
        { const int nt_ = r % 32, kb = r / 32; wt_item(a.w_ple_gate, 1024, 32 * nt_, 32, a.WpgT(), 1024, 32 * nt_, 64 * kb, scr, lane); }
    }
}

#define XB_ST_OFF 155648
#define LDS_BYTES 155904
static_assert(SAMP_LDS_END <= LDS_BYTES, "LDS map");
#define GSYNC() do { xcd_barrier(xbar); } while (0)
__global__ __launch_bounds__(NTHR, 2) void mega(MK a) {
    cg::grid_group grid = cg::this_grid();
    char* smem = (char*)lds_raw;
    LAS unsigned char* lds = (LAS unsigned char*)lds_raw;
    otid_init();
    if (threadIdx.x < 2) ((LAS unsigned*)(lds_raw + XB_ST_OFF))[threadIdx.x] = 0u;
    __syncthreads();
    const XcdBarrier xbar = xcd_barrier_post(a.ctl(), (volatile LAS unsigned*)(LAS void*)(lds_raw + XB_ST_OFF));
    const int bid = blockIdx.x, nb = gridDim.x, ngw = nb * NWAVE;
#define LOCAL_IDS const int tid = otid(), lane = tid & 63, wid = __builtin_amdgcn_readfirstlane(tid >> 6), half = tid >> 8, gw = bid * NWAVE + wid; (void)lane; (void)half; (void)gw; (void)wid;

    {
    LOCAL_IDS
    {
        const int T0 = 88 * 16, T1 = 24 * 6, T2 = 32 * 4, T3 = 16 * 4, T9 = 32 * 4;
        const int TT = T0 + T1 + T2 + T3 + T9;
        float* scr = (float*)(smem + wid * 8704);
        for (int it = gw; it < TT; it += ngw) {
            int r = it;
            if (r < T0) { const int nt_ = r % 88, kb = r / 88, nv = 2736 - 32 * nt_; wt_item(a.w_in, 2736, 32 * nt_, nv < 0 ? 0 : (nv > 32 ? 32 : nv), a.WinT(), 1024, 32 * nt_, 64 * kb, scr, lane); continue; } r -= T0;
            if (r < T1) { const int nt_ = r % 24, kb = r / 24; wt_item(a.w_q_b, 768, 32 * nt_, 32, a.WqbT(), 384, 32 * nt_, 64 * kb, scr, lane); continue; } r -= T1;
            if (r < T2) { const int nt_ = r % 32, kb = r / 32; wt_item(a.w_kv_b, 1024, 32 * nt_, 32, a.WkvT(), 256, 32 * nt_, 64 * kb, scr, lane); continue; } r -= T2;
            if (r < T3) { const int nt_ = r % 16, kb = r / 16, h = nt_ >> 1; wt_item(a.w_kv_b, 1024, h * 128 + 32 * (nt_ & 1), 32, a.WknT(), 256, 32 * nt_, 64 * kb, scr, lane); continue; } r -= T3;
            { const int nt_ = r % 32, kb = r / 32; wt_item(a.w_ple_proj, 1024, 32 * nt_, 32, a.WppT(), 256, 32 * nt_, 64 * kb, scr, lane); }
        }
        for (int e = (bid * NTHR + tid); e < 2049 * 16; e += nb * NTHR) {
            const int pos = e >> 4, i = e & 15; const float ang = (pos == 2048 ? (float)PAST : (float)pos) * powf(10000.f, -(float)i / 16.f);
            a.ropecs()[pos * 32 + i] = cosf(ang); a.ropecs()[pos * 32 + 16 + i] = sinf(ang);
        }
        for (int row = gw; row < MPAD; row += ngw) {
            const float* src = row < NPT ? a.x_prompt + (size_t)row * 1024 : a.x_sample + (size_t)(row < NTOK ? row - NPT : 0) * 1024;
            rms1024_row(src, a.g_attn, a.xn() + (size_t)row * 1024, row >= NTOK, lane);
            ushort4 w = {0, 0, 0, 0};
            if (row < NTOK) { const float* ps = row < NPT ? a.p_prompt + (size_t)row * 256 : a.p_sample + (size_t)(row - NPT) * 256; const float4 v = *(const float4*)(ps + lane * 4); w.x = f2bf(v.x); w.y = f2bf(v.y); w.z = f2bf(v.z); w.w = f2bf(v.w); }
            *(ushort4*)(a.pb() + (size_t)row * 256 + lane * 4) = w;
            if (row >= NTOK) { for (int j = 0; j < 4; ++j) { ushort4 z = {0, 0, 0, 0}; *(ushort4*)(a.omix() + (size_t)row * 1024 + lane * 4 + 256 * j) = z; } }
        }
    }
    }
    if (a.out == nullptr) grid.sync();
    GSYNC();
    {
    LOCAL_IDS
    pg_gemm(lds, a.xn(), a.WinT(), NPT, ZW, 1024, PgBf16{a.Z(), ZW});
    gemm_sample_rows_ks<false>(a.xn(), 1024, a.WinT(), 1024, ZW, EwBf16{a.Z(), ZW}, smem, bid, nb);
    }
    GSYNC();
    {
    LOCAL_IDS
    for (int e = tid; e < 4 * 1536 / 4; e += NTHR) ((float4*)smem)[e] = ((const float4*)a.w_conv)[e];
    __syncthreads();
    const bool merged23 = (ngw == 2048);
    if (merged23) {
        post_in_run(a, gw, lane, (const float*)smem);
        if (wid == 0) post_in_run(a, NPT / 8 + (bid >> 3), lane, (const float*)smem);
    } else {
        for (int run = gw; run < NPT / 8 + NST; run += ngw) post_in_run(a, run, lane, (const float*)smem);
    }
    }
    if (gridDim.x * NWAVE != 2048) GSYNC();
    else __syncthreads();
    {
    LOCAL_IDS
    if (ngw == 2048) gdn_prep_unit(a, (((bid >> 5) * 8 + wid) << 5) + (bid & 31), lane, smem + wid * GDN_WLDS);
    else for (int u = gw; u < 2048; u += ngw) gdn_prep_unit(a, u, lane, smem + wid * GDN_WLDS);
    }
    {
    LOCAL_IDS
    for (int v = gw; v < NST * 64; v += ngw) gdn_unit(a, v >> 6, (v >> 3) & 7, v & 7, a.state_gdn, a.out + O_GSS, NPT, 1, lane, smem + wid * GDN_WLDS);
    __syncthreads();
    }
    GSYNC();
    {
    LOCAL_IDS
    pg_gemm(lds, a.qan(), a.WqbT(), NPT, 768, 384, PgBf16{a.qraw(), 768});
    pg_gemm(lds, a.ckvb(), a.WkvT(), NPT, 1024, 256, PgBf16{a.kvraw(), 1024}, nb > 64 ? nb - 64 : 0);
    gemm_sample_rows<false>(a.qan(), 384, a.WqbT(), 384, 768, EwF32{a.Q(), 768}, smem, bid, nb, 128);
    gemm_sample_rows<false>(a.ckvb(), 256, a.WkvT(), 256, 1024, EwF32{a.KV(), 1024}, smem, bid, nb, 136);
    for (int bh_ = nb - 1 - bid; bh_ < 64; bh_ += nb) gdn_scan_block(a, bh_, lds);
    if (nb > 64 && bid < nb - 64) {
        pg_gemm(lds, a.pb(), a.WppT(), NPT, 1024, 256, PgBf16{a.PP(), 1024}, nb - 64, 2 * (nb - 64) / 3);
    } else if (nb <= 64) { pg_gemm(lds, a.pb(), a.WppT(), NPT, 1024, 256, PgBf16{a.PP(), 1024}); }
    __syncthreads();
    late_weight_items(a, gw, ngw, (float*)(smem + wid * 8704), lane);
    gemm_sample_rows<false>(a.pb(), 256, a.WppT(), 256, 1024, EwBf16{a.PP(), 1024}, smem, bid, nb, 144);
    }
    GSYNC();
    {
    LOCAL_IDS
    for (int idx = gw; idx < NST * 8; idx += ngw) { post_q_item(a, NPT * 8 + idx, lane); post_kv_item(a, NPT * 8 + idx, lane); }
    for (int row = gw; row < NTOK; row += ngw) gdn_out_token(a, row, lane);
    for (int pr = bid; pr < 256; pr += nb) { const int bh_ = (pr & 7) * 8 + (pr >> 5), s_ = (pr >> 3) & 3; attn_block(a, bh_ >> 3, bh_ & 7, 7 - s_, smem); attn_block(a, bh_ >> 3, bh_ & 7, s_, smem); }
    for (int u = bid; u < NST * 8; u += nb) samp_attn_unit(a, u, smem, lds);
    }
    GSYNC();
    {
    LOCAL_IDS
    for (int u = bid; u < NST * 8; u += nb) samp_comb_unit(a, u, smem);
    }
    GSYNC();
    {
    LOCAL_IDS
    pg_gemm(lds, a.omix(), a.WoT(), NPT, 1024, 1024, PgResXB{a.x_prompt, a.H()});
    gemm_sample_rows_ks<false, EwResX, 1>(a.omix(), 1024, a.WoT(), 1024, 1024, EwResX{a.x_sample, a.H()}, smem, bid, nb);
    }
    GSYNC();
    {
    LOCAL_IDS
    for (int row = gw; row < MPAD; row += ngw) rms1024_row_b(a.H() + (size_t)row * 1024, a.g_ffn, a.un() + (size_t)row * 1024, row >= NTOK, lane);
    }
    GSYNC();
    {
    LOCAL_IDS
    pg_gemm(lds, a.un(), a.WguT(), NPT, 2 * DFF, 1024, PgSwiglu{a.hid()});
    gemm_sample_rows_ks<true>(a.un(), 1024, a.WguT(), 1024, 2 * DFF, EwBf16{a.hid(), DFF}, smem, bid, nb);
    }
    GSYNC();
    {
    LOCAL_IDS
    pg_gemm(lds, a.hid(), a.WdT(), NPT, 1024, DFF, PgResBB{a.H(), a.H2()});
    gemm_sample_rows_ks<false, EwResH, 1>(a.hid(), DFF, a.WdT(), DFF, 1024, EwResH{a.H(), a.H2()}, smem, bid, nb);
    }
    GSYNC();
    {
    LOCAL_IDS
    for (int row = gw; row < MPAD; row += ngw) rms1024_row_b(a.H2() + (size_t)row * 1024, a.g_ple, a.un2() + (size_t)row * 1024, row >= NTOK, lane);
    }
    GSYNC();
    {
    LOCAL_IDS
    pg_gemm(lds, a.un2(), a.WpgT(), NPT, 1024, 1024, PgPleB{a.H2(), a.PP(), a.out});
    gemm_sample_rows_ks<false, EwPle, 1>(a.un2(), 1024, a.WpgT(), 1024, 1024, EwPle{a.H2(), a.PP(), a.out}, smem, bid, nb);
    }
}

static inline char* carve(char*& p, size_t bytes) { char* r = p; p += (bytes + 255) & ~(size_t)255; return r; }

extern "C" void kernel_launch(void* const* d_in, const int* in_sizes, int n_in, void* d_out, int out_size, void* d_ws, size_t ws_size, hipStream_t stream) {
    MK a{};
    a.x_prompt = (const float*)d_in[0]; a.x_sample = (const float*)d_in[1]; a.cache_ckv = (const float*)d_in[2]; a.cache_krope = (const float*)d_in[3];
    a.state_gdn = (const float*)d_in[4]; a.state_conv = (const float*)d_in[5]; a.page_table = (const int*)d_in[6]; a.p_prompt = (const float*)d_in[7]; a.p_sample = (const float*)d_in[8];
    a.g_attn = (const float*)d_in[9]; a.w_in = (const float*)d_in[10]; a.w_conv = (const float*)d_in[11]; a.a_log = (const float*)d_in[12]; a.dt_bias = (const float*)d_in[13];
    a.g_gdn_out = (const float*)d_in[14]; a.g_q_a = (const float*)d_in[15]; a.w_q_b = (const float*)d_in[16]; a.g_q_nope = (const float*)d_in[17]; a.g_q_rope = (const float*)d_in[18];
    a.g_kv_a = (const float*)d_in[19]; a.g_k_rope = (const float*)d_in[20]; a.w_kv_b = (const float*)d_in[21]; a.g_k_nope = (const float*)d_in[22]; a.w_o = (const float*)d_in[23];
    a.g_ffn = (const float*)d_in[24]; a.w_gate = (const float*)d_in[25]; a.w_up = (const float*)d_in[26]; a.w_down = (const float*)d_in[27]; a.g_ple = (const float*)d_in[28];
    a.w_ple_gate = (const float*)d_in[29]; a.w_ple_proj = (const float*)d_in[30];
    a.out = (float*)d_out;
    a.ws = (char*)d_ws;
    if (WS_TOTAL > ws_size) { fprintf(stderr, "kernel_launch: workspace too small: need %zu have %zu\n", (size_t)WS_TOTAL, ws_size); return; }

    static int grid_blocks = 0;
    if (!grid_blocks) {
        int dev = 0, cus = 0, per_cu = 0;
        (void)hipGetDevice(&dev);
        (void)hipDeviceGetAttribute(&cus, hipDeviceAttributeMultiprocessorCount, dev);
        (void)hipFuncSetAttribute((const void*)mega, hipFuncAttributeMaxDynamicSharedMemorySize, LDS_BYTES);
        (void)hipOccupancyMaxActiveBlocksPerMultiprocessor(&per_cu, (const void*)mega, NTHR, LDS_BYTES);
        if (per_cu < 1) fprintf(stderr, "kernel_launch: occupancy query says %d blocks/CU\n", per_cu);
        grid_blocks = cus;
    }
    (void)hipMemsetAsync((char*)d_ws + WOF_ctl, 0, 16384, stream);
    void* args[] = {&a};
    hipError_t e = hipLaunchCooperativeKernel((const void*)mega, dim3(grid_blocks), dim3(NTHR), args, LDS_BYTES, stream);
    if (e != hipSuccess) fprintf(stderr, "cooperative launch failed: %s (grid %d)\n", hipGetErrorString(e), grid_blocks);
}
```
